# Optimizing an MI355X kernel written in HIP

```python
import jax
import jax.numpy as jnp
from jax import lax
import numpy as np

D_MODEL = 1024
BATCH = 16
SEQ = 2048
DEPTH = 1

RWKV_HEADS = 8
RWKV_HEAD = 64
RWKV_WIDTH = RWKV_HEADS * RWKV_HEAD
DECAY_LORA = 64
AAA_LORA = 64
GATE_LORA = 128
RWKV_COLS = 3 * RWKV_WIDTH + DECAY_LORA + AAA_LORA + GATE_LORA
RWKV_SPLITS = [RWKV_WIDTH, 2 * RWKV_WIDTH, 3 * RWKV_WIDTH,
               3 * RWKV_WIDTH + DECAY_LORA, 3 * RWKV_WIDTH + DECAY_LORA + AAA_LORA]
DECAY_SCALE = 0.606531
LN_X_EPS = 64e-5
ATT_HEADS = 8
ATT_HEAD = 64
ATT_WIDTH = ATT_HEADS * ATT_HEAD
ATT_COLS = 3 * ATT_WIDTH
MOBA_BLOCK = 256
MOBA_TOPK = 3
Q_BLOCK = 128
ROPE_THETA = 10000.0
GATE_COLS = 2 * D_MODEL
IN_COLS = RWKV_COLS + ATT_COLS + GATE_COLS
N_GROUPS = 4
EXPERTS_PER_GROUP = 8
N_EXPERTS = N_GROUPS * EXPERTS_PER_GROUP
EXPERT_TOPK = 2
D_EXPERT = D_MODEL // 2
NORM_EPS = 1e-6
NEG_INF = -1e30

kernel_name = 'hybrid_rwkv7_moba_hmoe'


def rms_norm(x, g, eps=NORM_EPS):
    xf = x.astype(jnp.float32)
    y = xf * lax.rsqrt(jnp.mean(xf * xf, axis=-1, keepdims=True) + eps)
    return (y * g.astype(jnp.float32)).astype(x.dtype)


def token_shift(z, mu):
    z_prev = jnp.pad(z, ((0, 0), (1, 0), (0, 0)))[:, :-1]
    return z + (z_prev - z) * mu


def rope(x, positions):
    half = x.shape[-1] // 2
    inv_freq = ROPE_THETA ** (-jnp.arange(half, dtype=jnp.float32) / half)
    ang = positions[:, None] * inv_freq[None, :]
    cos = jnp.cos(ang)[None, :, None, :]
    sin = jnp.sin(ang)[None, :, None, :]
    xf = x.astype(jnp.float32)
    x1, x2 = xf[..., :half], xf[..., half:]
    return jnp.concatenate([x1 * cos - x2 * sin, x2 * cos + x1 * sin], axis=-1).astype(x.dtype)


def rwkv7_time_mix(z, mu_shift, w0, w_lora_up, a0, a_lora_up, g_lora_up,
                   k_k, k_a, r_k, lnx_g, lnx_b):
    f32 = jnp.float32
    out_dtype = z.dtype
    B, S, _ = z.shape
    H, N = RWKV_HEADS, RWKV_HEAD
    z = token_shift(z.astype(f32), mu_shift.astype(f32))
    r, k, v, dw, da, dg = jnp.split(z, RWKV_SPLITS, axis=-1)
    log_w = -DECAY_SCALE * jax.nn.sigmoid(w0.astype(f32) + jnp.tanh(dw) @ w_lora_up.astype(f32))
    a = jax.nn.sigmoid(a0.astype(f32) + da @ a_lora_up.astype(f32))
    g = jax.nn.sigmoid(dg) @ g_lora_up.astype(f32)

    def heads(t):
        return t.reshape(B, S, H, N)

    kk = heads(k * k_k.astype(f32))
    kk = kk / jnp.maximum(jnp.sqrt(jnp.sum(kk * kk, axis=-1, keepdims=True)), 1e-12)
    k = heads(k * (1.0 + (a - 1.0) * k_a.astype(f32)))
    r, v, a, w = heads(r), heads(v), heads(a), heads(jnp.exp(log_w))

    def step(state, inp):
        r_t, w_t, k_t, v_t, a_t, b_t = inp
        sa = jnp.einsum('bhij,bhj->bhi', state, a_t)
        state = (state * w_t[:, :, None, :] + sa[..., None] * b_t[:, :, None, :]
                 + v_t[..., None] * k_t[:, :, None, :])
        y_t = jnp.einsum('bhij,bhj->bhi', state, r_t)
        return state, y_t

    xs = tuple(jnp.moveaxis(t, 1, 0) for t in (r, w, k, v, -kk, kk * a))
    s0 = jnp.zeros((B, H, N, N), f32)
    _, ys = lax.scan(step, s0, xs)
    y = jnp.moveaxis(ys, 0, 1)
    mean = jnp.mean(y, axis=-1, keepdims=True)
    var = jnp.mean(jnp.square(y - mean), axis=-1, keepdims=True)
    yn = ((y - mean) * lax.rsqrt(var + LN_X_EPS)).reshape(B, S, H * N)
    yn = yn * lnx_g.astype(f32) + lnx_b.astype(f32)
    bonus = (jnp.sum(r * k * r_k.astype(f32), axis=-1, keepdims=True) * v).reshape(B, S, H * N)
    return ((yn + bonus) * g).astype(out_dtype)


def moba_attention(z, q_norm_g, k_norm_g):
    f32 = jnp.float32
    B, S, _ = z.shape
    H, hd = ATT_HEADS, ATT_HEAD
    q, k, v = jnp.split(z, 3, axis=-1)
    q = q.reshape(B, S, H, hd)
    k = k.reshape(B, S, H, hd)
    v = v.reshape(B, S, H, hd)
    q = rms_norm(q, q_norm_g)
    k = rms_norm(k, k_norm_g)
    pos = jnp.arange(S, dtype=f32)
    q = rope(q, pos)
    k = rope(k, pos)

    n_blk = -(-S // MOBA_BLOCK)
    s_pad = n_blk * MOBA_BLOCK
    padw = ((0, 0), (0, s_pad - S), (0, 0), (0, 0))
    q = jnp.pad(q, padw).transpose(0, 2, 1, 3)
    k = jnp.pad(k, padw).transpose(0, 2, 1, 3)
    v = jnp.pad(v, padw).transpose(0, 2, 1, 3)
    kb = k.reshape(B, H, n_blk, MOBA_BLOCK, hd)
    vb = v.reshape(B, H, n_blk, MOBA_BLOCK, hd)

    k_mean = jnp.mean(kb.astype(f32), axis=3)
    gate = jnp.einsum('bhsd,bhnd->bhsn', q.astype(f32), k_mean)
    q_blk = jnp.arange(s_pad) // MOBA_BLOCK
    past = jnp.arange(n_blk)[None, :] < q_blk[:, None]
    gate = jnp.where(past, gate, NEG_INF)
    n_sel = min(MOBA_TOPK, n_blk)
    top_val, top_idx = lax.top_k(gate, n_sel)
    top_ok = top_val > 0.5 * NEG_INF

    n_qc = s_pad // Q_BLOCK

    def to_chunks(t):
        t = t.reshape((B, H, n_qc, Q_BLOCK) + t.shape[3:])
        t = jnp.moveaxis(t, 2, 1)
        return t.reshape((B * n_qc, H, Q_BLOCK) + t.shape[4:])

    qc, ic, oc = to_chunks(q), to_chunks(top_idx), to_chunks(top_ok)
    b_ids = jnp.repeat(jnp.arange(B, dtype=jnp.int32), n_qc)
    c_ids = jnp.tile(jnp.arange(n_qc, dtype=jnp.int32), B)
    h_ids = jnp.arange(H)[:, None, None]
    scale = ATT_HEAD ** -0.5

    def attend(args):
        q_c, idx_c, ok_c, b, ci = args
        kbb = kb[b]
        vbb = vb[b]
        k_sel = kbb[h_ids, idx_c]
        v_sel = vbb[h_ids, idx_c]
        s_sel = jnp.einsum('hqd,hqnld->hqnl', q_c, k_sel).astype(f32) * scale
        s_sel = jnp.where(ok_c[..., None], s_sel, NEG_INF).reshape(H, Q_BLOCK, n_sel * MOBA_BLOCK)
        own = (ci * Q_BLOCK) // MOBA_BLOCK
        k_own = lax.dynamic_index_in_dim(kbb, own, axis=1, keepdims=False)
        v_own = lax.dynamic_index_in_dim(vbb, own, axis=1, keepdims=False)
        s_own = jnp.einsum('hqd,hld->hql', q_c, k_own).astype(f32) * scale
        q_pos = ci * Q_BLOCK + jnp.arange(Q_BLOCK)
        k_pos = own * MOBA_BLOCK + jnp.arange(MOBA_BLOCK)
        s_own = jnp.where(k_pos[None, None, :] <= q_pos[None, :, None], s_own, NEG_INF)
        p = jax.nn.softmax(jnp.concatenate([s_sel, s_own], axis=-1), axis=-1).astype(v_own.dtype)
        p_sel = p[..., :n_sel * MOBA_BLOCK].reshape(H, Q_BLOCK, n_sel, MOBA_BLOCK)
        p_own = p[..., n_sel * MOBA_BLOCK:]
        return (jnp.einsum('hqnl,hqnld->hqd', p_sel, v_sel)
                + jnp.einsum('hql,hld->hqd', p_own, v_own))

    out = lax.map(attend, (qc, ic, oc, b_ids, c_ids))
    out = out.reshape(B, n_qc, H, Q_BLOCK, hd).transpose(0, 1, 3, 2, 4).reshape(B, s_pad, H * hd)
    return out[:, :S]


def hierarchical_moe(h, w_rg, b_rg, w_re, b_re, w1, w3, w2):
    f32 = jnp.float32
    B, S, D = h.shape
    T = B * S
    ht = h.reshape(T, D)
    p_group = jax.nn.softmax((ht @ w_rg + b_rg).astype(f32), axis=-1)
    pg_top, g_idx = lax.top_k(p_group, 1)
    e_logits = (ht @ w_re + b_re).astype(f32).reshape(T, N_GROUPS, EXPERTS_PER_GROUP)
    e_logits = jnp.take_along_axis(e_logits, g_idx[:, :, None], axis=1)[:, 0]
    p_exp = jax.nn.softmax(e_logits, axis=-1)
    pe_top, e_idx = lax.top_k(p_exp, EXPERT_TOPK)
    weights = pg_top * pe_top / jnp.sum(pe_top, axis=-1, keepdims=True)
    expert = g_idx * EXPERTS_PER_GROUP + e_idx
    flat = expert.reshape(-1)
    order = jnp.argsort(flat)
    tok = order // EXPERT_TOPK
    sizes = jnp.bincount(flat, length=N_EXPERTS).astype(jnp.int32)
    xs = ht[tok]
    hid = jax.nn.silu(lax.ragged_dot(xs, w1, sizes)) * lax.ragged_dot(xs, w3, sizes)
    ys = lax.ragged_dot(hid, w2, sizes) * weights.reshape(-1)[order][:, None].astype(h.dtype)
    out = jax.ops.segment_sum(ys, tok, num_segments=T)
    return out.reshape(B, S, D)


def setup_inputs(seed: int = 0) -> dict:
    key = jax.random.key(seed)
    ks = jax.random.split(key, 32)
    f32 = jnp.float32
    L = DEPTH

    def nrm(k, shape, scale):
        return jax.random.normal(k, shape, f32) * scale

    def gain(k, shape):
        return 1.0 + 0.05 * jax.random.normal(k, shape, f32)

    return {
        'x': nrm(ks[0], (BATCH, SEQ, D_MODEL), 1.0),
        'c': nrm(ks[1], (BATCH, D_MODEL), 1.0),
        'w_ada': nrm(ks[2], (L, D_MODEL, 6 * D_MODEL), 0.02),
        'b_ada': nrm(ks[3], (L, 6 * D_MODEL), 0.02),
        'ln1_g': gain(ks[4], (L, D_MODEL)),
        'ln2_g': gain(ks[5], (L, D_MODEL)),
        'w_in': nrm(ks[6], (L, D_MODEL, IN_COLS), D_MODEL ** -0.5),
        'mu_shift': jax.random.uniform(ks[7], (L, RWKV_COLS), f32, 0.1, 0.9),
        'w0': jax.random.uniform(ks[8], (L, RWKV_WIDTH), f32, -5.0, 1.0),
        'w_lora_up': nrm(ks[9], (L, DECAY_LORA, RWKV_WIDTH), 0.1),
        'a0': nrm(ks[10], (L, RWKV_WIDTH), 0.5),
        'a_lora_up': nrm(ks[11], (L, AAA_LORA, RWKV_WIDTH), 0.1),
        'g_lora_up': nrm(ks[12], (L, GATE_LORA, RWKV_WIDTH), GATE_LORA ** -0.5),
        'k_k': 0.85 + 0.05 * jax.random.normal(ks[13], (L, RWKV_WIDTH), f32),
        'k_a': gain(ks[14], (L, RWKV_WIDTH)),
        'r_k': nrm(ks[15], (L, RWKV_HEADS, RWKV_HEAD), 0.1),
        'lnx_g': gain(ks[16], (L, RWKV_WIDTH)),
        'lnx_b': nrm(ks[17], (L, RWKV_WIDTH), 0.01),
        'q_norm_g': gain(ks[18], (L, ATT_HEAD)),
        'k_norm_g': gain(ks[19], (L, ATT_HEAD)),
        'w_br_rwkv': nrm(ks[20], (L, RWKV_WIDTH, D_MODEL), RWKV_WIDTH ** -0.5),
        'w_br_moba': nrm(ks[21], (L, ATT_WIDTH, D_MODEL), ATT_WIDTH ** -0.5),
        'w_out': nrm(ks[22], (L, D_MODEL, D_MODEL), D_MODEL ** -0.5),
        'w_rg': nrm(ks[23], (L, D_MODEL, N_GROUPS), D_MODEL ** -0.5),
        'b_rg': nrm(ks[24], (L, N_GROUPS), 0.01),
        'w_re': nrm(ks[25], (L, D_MODEL, N_EXPERTS), D_MODEL ** -0.5),
        'b_re': nrm(ks[26], (L, N_EXPERTS), 0.01),
        'w1': nrm(ks[27], (L, N_EXPERTS, D_MODEL, D_EXPERT), D_MODEL ** -0.5),
        'w3': nrm(ks[28], (L, N_EXPERTS, D_MODEL, D_EXPERT), D_MODEL ** -0.5),
        'w2': nrm(ks[29], (L, N_EXPERTS, D_EXPERT, D_MODEL), D_EXPERT ** -0.5),
    }


def reference(x, c, w_ada, b_ada, ln1_g, ln2_g, w_in, mu_shift, w0, w_lora_up, a0,
              a_lora_up, g_lora_up, k_k, k_a, r_k, lnx_g, lnx_b, q_norm_g, k_norm_g,
              w_br_rwkv, w_br_moba, w_out, w_rg, b_rg, w_re, b_re, w1, w3, w2):
    for l in range(DEPTH):
        mod = jnp.einsum('bd,de->be', jax.nn.silu(c), w_ada[l]) + b_ada[l]
        shift1, scale1, gate1, shift2, scale2, gate2 = jnp.split(mod[:, None, :], 6, axis=-1)

        h = rms_norm(x, ln1_g[l]) * (1.0 + scale1) + shift1
        z = jnp.einsum('bsd,de->bse', h, w_in[l])
        z_rwkv = z[..., :RWKV_COLS]
        z_att = z[..., RWKV_COLS:RWKV_COLS + ATT_COLS]
        z_gate = z[..., RWKV_COLS + ATT_COLS:]
        y_a = rwkv7_time_mix(z_rwkv, mu_shift[l], w0[l], w_lora_up[l], a0[l], a_lora_up[l],
                             g_lora_up[l], k_k[l], k_a[l], r_k[l], lnx_g[l], lnx_b[l])
        y_b = moba_attention(z_att, q_norm_g[l], k_norm_g[l])
        g_a, g_b = jnp.split(jax.nn.sigmoid(z_gate), 2, axis=-1)
        merged = (g_a * jnp.einsum('bsc,cd->bsd', y_a, w_br_rwkv[l])
                  + g_b * jnp.einsum('bsc,cd->bsd', y_b, w_br_moba[l]))
        x = x + gate1 * jnp.einsum('bsd,de->bse', merged, w_out[l])

        h2 = rms_norm(x, ln2_g[l]) * (1.0 + scale2) + shift2
        x = x + gate2 * hierarchical_moe(h2, w_rg[l], b_rg[l], w_re[l], b_re[l], w1[l], w3[l], w2[l])
    return x
```

```cpp
#include <hip/hip_runtime.h>
#include <cstdio>
#include <cstdint>
namespace pg8 {
#define PG8_LAS __attribute__((address_space(3)))
typedef unsigned short bf16_t;
typedef short bf16x8 __attribute__((ext_vector_type(8)));
typedef float f32x4 __attribute__((ext_vector_type(4)));
typedef unsigned u32x4 __attribute__((ext_vector_type(4)));
constexpr int BM = 256, BK = 64, HALF = 128, HTB = HALF * BK * 2  , STAGE_BYTES = 8 * HTB, NXCD = 8, WGM = 8;

__host__ __device__ __forceinline__ int lds_byte(int r, int c) { const int st = (r >> 4) * 2 + (c >> 5), rr = r & 15, cc = c & 31, ob = rr * 64 + cc * 2; return st * 1024 + (ob ^ (((ob >> 9) & 1) << 5)); }
__host__ __device__ __forceinline__ void stage_rc(int b, int& R, int& C) { const int st = b / 1024, sb = b % 1024, swz = sb ^ (((sb >> 9) & 1) << 5); R = (st >> 1) * 16 + swz / 64; C = (st & 1) * 32 + (swz % 64) / 2; }
__host__ __device__ __forceinline__ int perm32(int rho) { const int n = rho >> 4, i = rho & 15; return 8 * (i >> 2) + 4 * n + (i & 3); }
struct Unit { int pm, pn; const char* a; const char* b; };
struct Gemm { int K; };

struct StaticOrder {
    int nM, nN, nwg, G, c; const char* A; const char* Bt; size_t tstep;
    __device__ void init(const void* A_, const void* Bt_, int M, int N, int K, int G_, int c_) { nM = M / BM; nN = N / BM; nwg = nM * nN; G = G_; c = c_; A = (const char*)A_; Bt = (const char*)Bt_; tstep = (size_t)BM * K * 2; }
    __device__ bool next(int i, Unit& u) const {
        const long L = (long)i * G + c; if (L >= nwg) return false;
        int wgid = (int)L; { const int q = nwg / NXCD, r = nwg % NXCD, xcd = wgid % NXCD, off = wgid / NXCD; wgid = (xcd < r ? xcd * (q + 1) : r * (q + 1) + (xcd - r) * q) + off; }
        const int nig = WGM * nN, gid = wgid / nig, fm = gid * WGM, gsz = (nM - fm) < WGM ? (nM - fm) : WGM;
        u.pm = fm + ((wgid % nig) % gsz); u.pn = (wgid % nig) / gsz; u.a = A + (size_t)u.pm * tstep; u.b = Bt + (size_t)u.pn * tstep; return true;
    }
    __device__ __forceinline__ void a_ready(const Unit&) const {}
    __device__ __forceinline__ void done(const Unit&) const {}
};
__device__ __forceinline__ unsigned cvt_pk_bf16(float lo, float hi) { unsigned r; asm volatile("v_cvt_pk_bf16_f32 %0, %1, %2" : "=v"(r) : "v"(lo), "v"(hi)); return r; }
template <class Epi, class Sched, bool ALIGN_EPI = false, bool SP2 = false>
__device__ __forceinline__ void gemm_phase(PG8_LAS unsigned char* lds, const Gemm g, const Sched& S, const Epi& E) {
    const int tid = threadIdx.x, wid = __builtin_amdgcn_readfirstlane(tid >> 6), lane = tid & 63, wr = wid >> 2, wc = wid & 3, fr = lane & 15, fq = lane >> 4;
    const int K = g.K, nt = K / BK;
    unsigned voffA[2], voffB[2];
#pragma unroll
    for (int i = 0; i < 2; ++i) { int R, C; stage_rc(tid * 16 + i * 8192, R, C); const int Rb = Epi::PERM ? ((R & ~31) + perm32(R & 31)) : R;
        voffA[i] = (unsigned)(R * K + C) * 2u; voffB[i] = (unsigned)(Rb * K + C) * 2u; }
    const size_t kstep = (size_t)(BK * 2);
    const size_t hstep = (size_t)HALF * K * 2;
        const unsigned ldsw = (unsigned)wid * 1024u;
    const int aoff = lds_byte(wr * 64 + fr, fq * 8), boff = lds_byte(wc * 32 + fr, fq * 8);
#define PG8_SA(b, h) (((b) * 2 + (h)) * HTB)
#define PG8_SB(b, h) ((4 + (b) * 2 + (h)) * HTB)
#define PG8_STAGE(bufoff, gbase, voff) do { _Pragma("unroll") for (int _i = 0; _i < 2; ++_i) \
        __builtin_amdgcn_global_load_lds((const unsigned*)((const char*)(gbase) + (voff)[_i]), (PG8_LAS unsigned*)(lds + (bufoff) + ldsw + _i * 8192), 16, 0, 0); } while (0)
#define PG8_LDA(dst, b, h) do { _Pragma("unroll") for (int m = 0; m < 4; ++m) _Pragma("unroll") for (int k = 0; k < 2; ++k) dst[m][k] = *(const PG8_LAS bf16x8*)(lds + PG8_SA(b, h) + aoff + m * 2048 + k * 1024); } while (0)
#define PG8_LDB(dst, b, h) do { _Pragma("unroll") for (int n = 0; n < 2; ++n) _Pragma("unroll") for (int k = 0; k < 2; ++k) dst[n][k] = *(const PG8_LAS bf16x8*)(lds + PG8_SB(b, h) + boff + n * 2048 + k * 1024); } while (0)
#define PG8_MMA(ai, bj, At, Bt) do { __builtin_amdgcn_s_setprio(1); _Pragma("unroll") for (int m = 0; m < 4; ++m) _Pragma("unroll") for (int n = 0; n < 2; ++n) _Pragma("unroll") for (int k = 0; k < 2; ++k) \
        acc[ai][bj][m][n] = __builtin_amdgcn_mfma_f32_16x16x32_bf16(Bt[n][k], At[m][k], acc[ai][bj][m][n], 0, 0, 0); __builtin_amdgcn_s_setprio(0); } while (0)
#define PG8_WAIT_V(n) asm volatile("s_waitcnt vmcnt(" #n ")" ::: "memory")
#define PG8_WAIT_L(n) asm volatile("s_waitcnt lgkmcnt(" #n ")" ::: "memory")
#define PG8_BAR __builtin_amdgcn_s_barrier()
#define PG8_SCHED __builtin_amdgcn_sched_barrier(0)
    Unit cur, nxt; int ui = 0;
    if (!S.next(0, cur)) return;
    f32x4 acc[2][2][4][2];
#pragma unroll
    for (int a = 0; a < 2; ++a)
#pragma unroll
        for (int b = 0; b < 2; ++b)
#pragma unroll
            for (int m = 0; m < 4; ++m)
#pragma unroll
                for (int n = 0; n < 2; ++n) acc[a][b][m][n] = (f32x4){0.f, 0.f, 0.f, 0.f};
    bf16x8 At[4][2], B0[2][2], B1[2][2];
    const char* cA = cur.a; const char* cB = cur.b;
    S.a_ready(cur);
    if constexpr (SP2) {
        PG8_STAGE(PG8_SB(0, 0), cB, voffB); PG8_STAGE(PG8_SB(0, 1), cB + hstep, voffB); PG8_STAGE(PG8_SA(0, 0), cA, voffA); PG8_STAGE(PG8_SA(0, 1), cA + hstep, voffA);
        if (wr == 1) PG8_BAR;
        PG8_WAIT_V(2); PG8_BAR;
        PG8_STAGE(PG8_SB(1, 0), cB + kstep, voffB); PG8_STAGE(PG8_SA(1, 0), cA + kstep, voffA); PG8_STAGE(PG8_SB(1, 1), cB + hstep + kstep, voffB);
        PG8_WAIT_V(6); PG8_BAR;
    } else {
        PG8_STAGE(PG8_SB(0, 0), cB, voffB); PG8_STAGE(PG8_SA(0, 0), cA, voffA); PG8_STAGE(PG8_SB(0, 1), cB + hstep, voffB); PG8_STAGE(PG8_SA(0, 1), cA + hstep, voffA);
        if (wr == 1) PG8_BAR;
        PG8_WAIT_V(4); PG8_BAR;
        PG8_STAGE(PG8_SB(1, 0), cB + kstep, voffB); PG8_STAGE(PG8_SA(1, 0), cA + kstep, voffA); PG8_STAGE(PG8_SB(1, 1), cB + hstep + kstep, voffB);
        PG8_WAIT_V(6); PG8_BAR;
    }
    for (;;) {
        const bool has_next = S.next(ui + 1, nxt);
        const char* nA = has_next ? nxt.a : cA; const char* nB = has_next ? nxt.b : cB;
        for (int t = 0; t < nt; t += 2) {
            const bool last = (t == nt - 2);
            const char* a1 = cA + (size_t)(t + 1) * kstep;
            const char* a2 = last ? nA : cA + (size_t)(t + 2) * kstep; const char* b2 = last ? nB : cB + (size_t)(t + 2) * kstep;
            const char* a3 = a2 + kstep; const char* b3 = b2 + kstep;
            if (last && has_next) S.a_ready(nxt);
            if constexpr (SP2) {
            PG8_LDB(B0, 0, 0); PG8_LDB(B1, 0, 1); PG8_SCHED; PG8_LDA(At, 0, 0); PG8_STAGE(PG8_SA(1, 1), a1 + hstep, voffA);
            PG8_WAIT_V(8); PG8_WAIT_L(0); PG8_BAR; PG8_MMA(0, 0, At, B0); PG8_MMA(0, 1, At, B1); PG8_BAR; PG8_SCHED;
            PG8_LDA(At, 0, 1); PG8_STAGE(PG8_SB(0, 0), b2, voffB); PG8_STAGE(PG8_SB(0, 1), b2 + hstep, voffB); PG8_STAGE(PG8_SA(0, 0), a2, voffA);
            PG8_WAIT_V(8); PG8_WAIT_L(0); PG8_BAR; PG8_MMA(1, 0, At, B0); PG8_MMA(1, 1, At, B1); PG8_BAR; PG8_SCHED;
            PG8_LDB(B0, 1, 0); PG8_LDB(B1, 1, 1); PG8_SCHED; PG8_LDA(At, 1, 0); PG8_STAGE(PG8_SA(0, 1), a2 + hstep, voffA);
            PG8_WAIT_V(8); PG8_WAIT_L(0); PG8_BAR; PG8_MMA(0, 0, At, B0); PG8_MMA(0, 1, At, B1); PG8_BAR; PG8_SCHED;
            PG8_LDA(At, 1, 1); PG8_STAGE(PG8_SB(1, 0), b3, voffB); PG8_STAGE(PG8_SB(1, 1), b3 + hstep, voffB); PG8_STAGE(PG8_SA(1, 0), a3, voffA);
            PG8_WAIT_V(8); PG8_WAIT_L(0); PG8_BAR; PG8_MMA(1, 0, At, B0); PG8_MMA(1, 1, At, B1); PG8_BAR; PG8_SCHED;
            } else {
            PG8_LDB(B0, 0, 0); PG8_SCHED; PG8_LDA(At, 0, 0); PG8_STAGE(PG8_SA(1, 1), a1 + hstep, voffA);
            PG8_WAIT_L(8); PG8_BAR; PG8_WAIT_L(0); PG8_MMA(0, 0, At, B0); PG8_BAR; PG8_SCHED;
            PG8_LDB(B1, 0, 1); PG8_STAGE(PG8_SB(0, 0), b2, voffB);
            PG8_BAR; PG8_WAIT_L(0); PG8_MMA(0, 1, At, B1); PG8_BAR;
            PG8_LDA(At, 0, 1); PG8_STAGE(PG8_SA(0, 0), a2, voffA);
            PG8_BAR; PG8_WAIT_L(0); PG8_MMA(1, 0, At, B0); PG8_BAR; PG8_SCHED;
            PG8_STAGE(PG8_SB(0, 1), b2 + hstep, voffB);
            PG8_WAIT_V(6); PG8_BAR; PG8_MMA(1, 1, At, B1); PG8_BAR;
            PG8_LDB(B0, 1, 0); PG8_SCHED; PG8_LDA(At, 1, 0); PG8_STAGE(PG8_SA(0, 1), a2 + hstep, voffA);
            PG8_WAIT_L(8); PG8_BAR; PG8_WAIT_L(0); PG8_MMA(0, 0, At, B0); PG8_BAR; PG8_SCHED;
            PG8_LDB(B1, 1, 1); PG8_STAGE(PG8_SB(1, 0), b3, voffB);
            PG8_BAR; PG8_WAIT_L(0); PG8_MMA(0, 1, At, B1); PG8_BAR;
            PG8_LDA(At, 1, 1); PG8_STAGE(PG8_SA(1, 0), a3, voffA);
            PG8_BAR; PG8_WAIT_L(0); PG8_MMA(1, 0, At, B0); PG8_BAR; PG8_SCHED;
            PG8_STAGE(PG8_SB(1, 1), b3 + hstep, voffB);
            PG8_WAIT_V(6); PG8_BAR; PG8_MMA(1, 1, At, B1); PG8_BAR;
            }
        }
        if constexpr (ALIGN_EPI) { if (wr == 0) PG8_BAR; }
        if constexpr (!Epi::AFTER_DRAIN) { E(acc, cur, wr, wc, fr, fq); S.done(cur); }
        if (!has_next) break;
#pragma unroll
        for (int a = 0; a < 2; ++a)
#pragma unroll
            for (int b = 0; b < 2; ++b)
#pragma unroll
                for (int m = 0; m < 4; ++m)
#pragma unroll
                    for (int n = 0; n < 2; ++n) acc[a][b][m][n] = (f32x4){0.f, 0.f, 0.f, 0.f};
        cur = nxt; cA = nA; cB = nB; ++ui;
        if constexpr (ALIGN_EPI) { if (wr == 1) PG8_BAR; }
    }
    PG8_WAIT_V(0);
    if constexpr (!ALIGN_EPI) { if (wr == 0) PG8_BAR; }
    PG8_BAR;
    if constexpr (Epi::AFTER_DRAIN) { E.fused(acc, cur, wr, wc, fr, fq, lds, wid, lane); S.done(cur); }
#undef PG8_SA
#undef PG8_SB
#undef PG8_STAGE
#undef PG8_LDA
#undef PG8_LDB
#undef PG8_MMA
#undef PG8_WAIT_V
#undef PG8_WAIT_L
#undef PG8_BAR
#undef PG8_SCHED
}
}
#include <hip/hip_bf16.h>
#include <cmath>
namespace attn_body {
using bf16=__hip_bfloat16;
using bf16x8=__attribute__((ext_vector_type(8)))short;
using s16x4=__attribute__((ext_vector_type(4)))short;
using f32x16=__attribute__((ext_vector_type(16)))float;
using u32x4=__attribute__((ext_vector_type(4)))unsigned;
constexpr int NHEAD=8,SEQ=2048,D=64,PQ=512,PK=512,PV=5376,PO=512;
constexpr int NW=8,QBLK=32,QB=QBLK*NW,KVBLK=64,NQB=SEQ/QB;
__device__ __forceinline__ int crow(int r,int hi){return (r&3)+8*(r>>2)+4*hi;}
#define SBAR() __builtin_amdgcn_sched_barrier(0)
__device__ __forceinline__ void cmask(f32x16&p0,f32x16&p1,int jb,int qrel,int hi){
  const float NEG=-INFINITY; int kb=64*jb+4*hi;
  #pragma unroll
  for(int r=0;r<16;++r){int kv=kb+(r&3)+8*(r>>2); if(kv>qrel)p0[r]=NEG; if(kv+32>qrel)p1[r]=NEG;}
}

constexpr int NSLOT=3, SLOTB=8192;
constexpr int LDS_K=0, LDS_V=NSLOT*SLOTB, LDS_WS=2*NSLOT*SLOTB, LDS_OST=LDS_WS+NW*64*4, LDS_BYTES=LDS_OST+NW*4096;
constexpr float C2=0.125f*1.4426950408889634f;
__device__ __forceinline__ void glds16(const void*gsrc,unsigned lds_dst){unsigned keep;
  asm volatile("s_mov_b32 %0, m0\n\ts_mov_b32 m0, %2\n\ts_nop 0\n\tglobal_load_lds_dwordx4 %1, off\n\ts_mov_b32 m0, %0":"=&s"(keep):"v"(gsrc),"s"(lds_dst):"memory");}
__device__ __forceinline__ float max3f(float a,float b,float c){float r;asm("v_max3_f32 %0, %1, %2, %3":"=v"(r):"v"(a),"v"(b),"v"(c));return r;}
__device__ __forceinline__ float max2f(float a,float b){float r;asm("v_max_f32_e32 %0, %1, %2":"=v"(r):"v"(a),"v"(b));return r;}
__device__ __forceinline__ float fadd_s(float a,float b){float r;asm("v_add_f32_e32 %0, %1, %2":"=v"(r):"v"(a),"v"(b));return r;}
__device__ __forceinline__ float fsub_s(float a,float b){float r;asm("v_sub_f32_e32 %0, %1, %2":"=v"(r):"v"(a),"v"(b));return r;}
typedef float f32x2_t __attribute__((ext_vector_type(2))); typedef __bf16 bf16x2_t __attribute__((ext_vector_type(2)));
__device__ __forceinline__ unsigned cvtpk_s(float lo,float hi){f32x2_t v={lo,hi};bf16x2_t b=__builtin_convertvector(v,bf16x2_t);return __builtin_bit_cast(unsigned,b);}
#define WAIT_BAR(N) asm volatile("s_waitcnt vmcnt(" #N ") lgkmcnt(0)\n\ts_barrier":::"memory")

__device__ __forceinline__ void qkt(f32x16&p0,f32x16&p1,const char*Kslot,const bf16x8*qr,const f32x16&negm,int r32,int hi){
  const char*kb=Kslot+hi*1024+r32*16;
  #pragma unroll
  for(int d0=0;d0<4;++d0){
    const bf16x8 b0=*reinterpret_cast<const bf16x8*>(kb+d0*2048);
    const bf16x8 b1=*reinterpret_cast<const bf16x8*>(kb+d0*2048+512);
    if(d0==0){p0=__builtin_amdgcn_mfma_f32_32x32x16_bf16(b0,qr[0],negm,0,0,0);p1=__builtin_amdgcn_mfma_f32_32x32x16_bf16(b1,qr[0],negm,0,0,0);}
    else{p0=__builtin_amdgcn_mfma_f32_32x32x16_bf16(b0,qr[d0],p0,0,0,0);p1=__builtin_amdgcn_mfma_f32_32x32x16_bf16(b1,qr[d0],p1,0,0,0);}}
}
typedef __attribute__((address_space(3))) const char* lds_cptr;
typedef short v4i16_t __attribute__((ext_vector_type(4)));
__device__ __forceinline__ void kload8(bf16x8*kf,lds_cptr kp){
  kf[0]=*(const __attribute__((address_space(3))) bf16x8*)(kp);      kf[1]=*(const __attribute__((address_space(3))) bf16x8*)(kp+512);
  kf[2]=*(const __attribute__((address_space(3))) bf16x8*)(kp+2048); kf[3]=*(const __attribute__((address_space(3))) bf16x8*)(kp+2560);
  kf[4]=*(const __attribute__((address_space(3))) bf16x8*)(kp+4096); kf[5]=*(const __attribute__((address_space(3))) bf16x8*)(kp+4608);
  kf[6]=*(const __attribute__((address_space(3))) bf16x8*)(kp+6144); kf[7]=*(const __attribute__((address_space(3))) bf16x8*)(kp+6656);
}
__device__ __forceinline__ void kload2(bf16x8*kf,lds_cptr kp,int j){ kf[2*j]=*(const __attribute__((address_space(3))) bf16x8*)(kp+j*2048); kf[2*j+1]=*(const __attribute__((address_space(3))) bf16x8*)(kp+j*2048+512); }
__device__ __forceinline__ s16x4 vtr(lds_cptr p){ return __builtin_bit_cast(s16x4,__builtin_amdgcn_ds_read_tr16_b64_v4i16((__attribute__((address_space(3))) v4i16_t*)p)); }
__device__ __forceinline__ float rowmax(const f32x16&p0,const f32x16&p1){
  float a=max3f(p0[0],p0[1],p1[0]),b=max3f(p0[2],p0[3],p1[1]);a=max3f(a,p1[2],p1[3]);
  #pragma unroll
  for(int r=4;r<16;r+=4){a=max3f(a,p0[r],p0[r+1]);b=max3f(b,p0[r+2],p0[r+3]);a=max3f(a,p1[r],p1[r+1]);b=max3f(b,p1[r+2],p1[r+3]);}
  const float m=max2f(a,b);
  auto rr=__builtin_amdgcn_permlane32_swap(__float_as_uint(m),__float_as_uint(m),false,false);
  return max2f(__uint_as_float(rr[0]),__uint_as_float(rr[1]));
}
__device__ __forceinline__ void pv(f32x16*o,int vb,bf16x8 pa0,bf16x8 pa1,bf16x8 pa2,bf16x8 pa3){
  #pragma unroll
  for(int d0=0;d0<2;++d0){s16x4 lo[4],hi[4];
    #pragma unroll
    for(int ks=0;ks<4;++ks){
      asm volatile("ds_read_b64_tr_b16 %0,%1 offset:%c2":"=&v"(lo[ks]):"v"(vb),"i"(d0*4096+ks*1024):"memory");
      asm volatile("ds_read_b64_tr_b16 %0,%1 offset:%c2":"=&v"(hi[ks]):"v"(vb),"i"(d0*4096+ks*1024+512):"memory");}
    asm volatile("s_waitcnt lgkmcnt(0)":::"memory");SBAR();
    #define PK(k) (bf16x8){lo[k][0],lo[k][1],lo[k][2],lo[k][3],hi[k][0],hi[k][1],hi[k][2],hi[k][3]}
    o[d0]=__builtin_amdgcn_mfma_f32_32x32x16_bf16(pa0,PK(0),o[d0],0,0,0);
    o[d0]=__builtin_amdgcn_mfma_f32_32x32x16_bf16(pa1,PK(1),o[d0],0,0,0);
    o[d0]=__builtin_amdgcn_mfma_f32_32x32x16_bf16(pa2,PK(2),o[d0],0,0,0);
    o[d0]=__builtin_amdgcn_mfma_f32_32x32x16_bf16(pa3,PK(3),o[d0],0,0,0);
    #undef PK
  }
}

#ifndef ATTN_STORE16
#define ATTN_STORE16(p,v) (*(u32x4*)(p)=(v))
#endif
template<int THRL> __device__ __forceinline__ void attn_unit(int b,int h,int qb,const bf16*Q,const bf16*__restrict__ K,const bf16*__restrict__ V,bf16*O,const unsigned char*__restrict__ SEL,char*shm){
  int tid_=threadIdx.x; asm volatile("":"+v"(tid_)); const int tid=tid_,lane=tid&63,r32=lane&31,hi=lane>>5;     const int wid=__builtin_amdgcn_readfirstlane(tid>>6);
  const long rowbase=(long)b*SEQ; const int q0=qb*QB;
  const bf16*Qw=Q+(rowbase+q0+wid*QBLK)*PQ+h*D;
  const bf16*Kh=K+rowbase*PK+h*D,*Vh=V+rowbase*PV+h*D;
  const unsigned lds0=(unsigned)(uintptr_t)shm;
  float*wsf=(float*)(shm+LDS_WS)+wid*64;
  const bf16*ksrc=Kh+(long)lane*PK+wid*8;
  const bf16*vsrc=Vh+(long)(16*(wid&3)+(lane>>2))*PV+(wid>>2)*32+(lane&3)*8;
  const unsigned kdst=lds0+LDS_K+wid*1024, vdst=lds0+LDS_V+wid*1024;
  #define TROW(t) ((long)(((t)<4)?(q0+(t)*KVBLK):(((t)-4)*KVBLK)))
  #define DMA_K(t,slot) glds16(ksrc+TROW(t)*PK,(unsigned)__builtin_amdgcn_readfirstlane(kdst+(slot)))
  #define DMA_V(t,slot) glds16(vsrc+TROW(t)*PV,(unsigned)__builtin_amdgcn_readfirstlane(vdst+(slot)))
  const int vb0=(int)(lds0+LDS_V)+((lane>>4)&1)*32+(lane&3)*8+(4*hi+((lane&15)>>2))*64;
  const char*Kbase=shm+LDS_K; bf16x8 kf[8];
  const lds_cptr shm3=(lds_cptr)shm; const lds_cptr kp0=shm3+LDS_K+hi*1024+r32*16; const lds_cptr vp0=shm3+LDS_V+((lane>>4)&1)*32+(lane&3)*8+(4*hi+((lane&15)>>2))*64;
  const int NT=(q0+QB)/KVBLK;
  DMA_K(0,0);DMA_V(0,0);DMA_K(1,SLOTB);
  bf16x8 qr[4];
  #pragma unroll
  for(int d0=0;d0<4;++d0)qr[d0]=*reinterpret_cast<const bf16x8*>(&Qw[(long)r32*PQ+d0*16+hi*8]);
  float mhat=0.f,l_reg=0.f;f32x16 o[2];o[0]=f32x16{};o[1]=f32x16{};
  const int qrel=wid*QBLK+r32;
  const unsigned selb=(unsigned)SEL[((long)(b*NHEAD+h))*SEQ+q0+qrel];
  #define CMASK(P0,P1,t) cmask(P0,P1,(t),qrel,hi)
  #define SUBREF(C0,C1,t) do{ const float sb_=(((t)<4)||((selb>>(((t)-4)>>2))&1u))?mhat:INFINITY; _Pragma("unroll") for(int r_=0;r_<16;++r_){C0[r_]-=sb_;C1[r_]-=sb_;} }while(0)
  bool resc=false;
  #define START(P0,P1) do{ const float rm=rowmax(P0,P1); resc=false; \
    { const float dl=rm; mhat=fadd_s(mhat,dl); \
      _Pragma("unroll") for(int r=0;r<16;++r){P0[r]=fsub_s(P0[r],dl);P1[r]=fsub_s(P1[r],dl);} \
      } \
    _Pragma("unroll") for(int r=0;r<16;++r)P0[r]=__builtin_amdgcn_exp2f(P0[r]); }while(0)
  #define RESC() do{ if(resc){ asm volatile("s_waitcnt lgkmcnt(0)":::"memory"); \
      _Pragma("unroll") for(int d_=0;d_<2;++d_) _Pragma("unroll") for(int r=0;r<16;++r)o[d_][r]*=wsf[crow(r,hi)]; } }while(0)
  f32x16 pA0,pA1,pB0,pB1;
  int sl_prev=0,sl_cur=0,sl_next=SLOTB;
  #define ROT() do{sl_prev=sl_cur;sl_cur=sl_next;sl_next=(sl_next==(NSLOT-1)*SLOTB)?0:sl_next+SLOTB;}while(0)
  DMA_K(2,2*SLOTB);
  WAIT_BAR(3);
  qkt(pA0,pA1,Kbase,qr,f32x16{},r32,hi);asm volatile("s_nop 15\n\ts_nop 7":"+v"(pA0),"+v"(pA1));CMASK(pA0,pA1,0);
  START(pA0,pA1);
  _Pragma("unroll") for(int r=0;r<16;++r)pA1[r]=__builtin_amdgcn_exp2f(pA1[r]);
  WAIT_BAR(0);
  DMA_K(3,0);DMA_V(1,SLOTB);
  ROT();
  kload8(kf,kp0+sl_cur);
  WAIT_BAR(2);
  s16x4 vlo[8],vhi[8]; u32x4 pw0,pw1,pw2,pw3;
  #define PKW(P,B) cvtpk_s(P[B],P[B+1])
  #define PAF(k) __builtin_bit_cast(bf16x8,pw##k)
  #define VFR(i) (bf16x8){vlo[i][0],vlo[i][1],vlo[i][2],vlo[i][3],vhi[i][0],vhi[i][1],vhi[i][2],vhi[i][3]}
  #define PIN(x) asm volatile("":"+v"(x))
  #define MX3(a,b,c) __builtin_fmaxf(__builtin_fmaxf((a),(b)),(c))
  #define GAPA(MF,A0,A1,A2,A3,W0,W1,PW) do{ MF; sacc+=A0; sacc+=A1; sacc+=A2; sacc+=A3; PIN(sacc); W0; W1; PIN(PW); SBAR(); }while(0)
  #define EX(v) __builtin_amdgcn_exp2f(v)
  #define GAPB(MF,X,B) do{ MF; X[B]=EX(X[B]); X[B+1]=EX(X[B+1]); X[B+2]=EX(X[B+2]); X[B+3]=EX(X[B+3]); PIN(X); SBAR(); }while(0)
  #define VRD(i) do{ vlo[i]=vtr(vp_+(((i)>>2)*4096+((i)&3)*1024)); vhi[i]=vtr(vp_+(((i)>>2)*4096+((i)&3)*1024+512)); }while(0)
  #define KRD(G,j) do{ if(G){ kload2(kf,kp0+sl_next,j); SBAR(); } }while(0)
  #define STEP(C0,C1,P0,P1,t,GK,GV,GL,MB) do{ SBAR(); \
    const lds_cptr vp_=vp0+sl_prev; \
    VRD(0); SBAR(); float sacc=(P0[0]+P0[1]); \
    GAPA(C0=__builtin_amdgcn_mfma_f32_32x32x16_bf16(kf[0],qr[0],f32x16{},0,0,0), P0[2],P0[3],P0[4],P0[5],     pw0[0]=PKW(P0,0), pw0[1]=PKW(P0,2), pw0); \
    VRD(4); SBAR(); GAPA(C1=__builtin_amdgcn_mfma_f32_32x32x16_bf16(kf[1],qr[0],f32x16{},0,0,0), P0[6],P0[7],P0[8],P0[9],     pw0[2]=PKW(P0,4), pw0[3]=PKW(P0,6), pw0); \
    VRD(1); SBAR(); GAPA(C0=__builtin_amdgcn_mfma_f32_32x32x16_bf16(kf[2],qr[1],C0,0,0,0),   P0[10],P0[11],P0[12],P0[13], pw1[0]=PKW(P0,8), pw1[1]=PKW(P0,10), pw1); \
    VRD(5); SBAR(); GAPA(C1=__builtin_amdgcn_mfma_f32_32x32x16_bf16(kf[3],qr[1],C1,0,0,0),   P0[14],P0[15],P1[0],P1[1],   pw1[2]=PKW(P0,12),pw1[3]=PKW(P0,14), pw1); \
    VRD(2); SBAR(); GAPA(C0=__builtin_amdgcn_mfma_f32_32x32x16_bf16(kf[4],qr[2],C0,0,0,0),   P1[2],P1[3],P1[4],P1[5],     pw2[0]=PKW(P1,0), pw2[1]=PKW(P1,2), pw2); \
    VRD(6); SBAR(); GAPA(C1=__builtin_amdgcn_mfma_f32_32x32x16_bf16(kf[5],qr[2],C1,0,0,0),   P1[6],P1[7],P1[8],P1[9],     pw2[2]=PKW(P1,4), pw2[3]=PKW(P1,6), pw2); \
    VRD(3); SBAR(); GAPA(C0=__builtin_amdgcn_mfma_f32_32x32x16_bf16(kf[6],qr[3],C0,0,0,0),   P1[10],P1[11],P1[12],P1[13], pw3[0]=PKW(P1,8), pw3[1]=PKW(P1,10), pw3); \
    VRD(7); SBAR(); GAPA(C1=__builtin_amdgcn_mfma_f32_32x32x16_bf16(kf[7],qr[3],C1,0,0,0),   P1[14],P1[15],0.f,0.f,       pw3[2]=PKW(P1,12),pw3[3]=PKW(P1,14), pw3); \
    l_reg+=sacc; \
    if(GK){DMA_K((t)+3,sl_cur);} if(GV){DMA_V((t)+1,sl_next);} \
    SUBREF(C0,C1,t); if(MB){CMASK(C0,C1,t);} \
    { float a=MX3(C0[0],C0[1],C1[0]),b=MX3(C0[2],C0[3],C1[1]); a=MX3(a,C1[2],C1[3]); \
      _Pragma("unroll") for(int r=4;r<16;r+=4){a=MX3(a,C0[r],C0[r+1]);b=MX3(b,C0[r+2],C0[r+3]);a=MX3(a,C1[r],C1[r+1]);b=MX3(b,C1[r+2],C1[r+3]);} \
      float rm=__builtin_fmaxf(a,b); { auto rr=__builtin_amdgcn_permlane32_swap(__float_as_uint(rm),__float_as_uint(rm),false,false); rm=__builtin_fmaxf(__uint_as_float(rr[0]),__uint_as_float(rr[1])); } \
      resc=false; \
      if(__builtin_expect(__any(rm>(float)THRL),0)){ const float dl=__builtin_fmaxf(rm,0.f); mhat+=dl; \
        _Pragma("unroll") for(int r=0;r<16;++r){C0[r]-=dl;C1[r]-=dl;} \
        const float f=__builtin_amdgcn_exp2f(-dl); l_reg*=f; if(hi==0)wsf[r32]=f; resc=true; } } \
    SBAR(); \
    GAPB(o[0]=__builtin_amdgcn_mfma_f32_32x32x16_bf16(PAF(0),VFR(0),o[0],0,0,0), C0,0); \
    GAPB(o[1]=__builtin_amdgcn_mfma_f32_32x32x16_bf16(PAF(0),VFR(4),o[1],0,0,0), C0,4); \
    KRD(GL,0); GAPB(o[0]=__builtin_amdgcn_mfma_f32_32x32x16_bf16(PAF(1),VFR(1),o[0],0,0,0), C0,8); \
    KRD(GL,1); GAPB(o[1]=__builtin_amdgcn_mfma_f32_32x32x16_bf16(PAF(1),VFR(5),o[1],0,0,0), C0,12); \
    KRD(GL,2); GAPB(o[0]=__builtin_amdgcn_mfma_f32_32x32x16_bf16(PAF(2),VFR(2),o[0],0,0,0), C1,0); \
    KRD(GL,3); GAPB(o[1]=__builtin_amdgcn_mfma_f32_32x32x16_bf16(PAF(2),VFR(6),o[1],0,0,0), C1,4); \
    GAPB(o[0]=__builtin_amdgcn_mfma_f32_32x32x16_bf16(PAF(3),VFR(3),o[0],0,0,0), C1,8); \
    GAPB(o[1]=__builtin_amdgcn_mfma_f32_32x32x16_bf16(PAF(3),VFR(7),o[1],0,0,0), C1,12); \
    }while(0)
  #define ENDW(tt) do{ if((tt)+3<NT){WAIT_BAR(2);} else if((tt)+2<NT){WAIT_BAR(1);} else {WAIT_BAR(0);} }while(0)
  { int t=1;
    for(;t+1<NT;t+=2){
      STEP(pB0,pB1,pA0,pA1,t,(t+3<NT),(t+1<NT),(t+1<NT),(t<4));       ENDW(t);   RESC(); ROT();
      STEP(pA0,pA1,pB0,pB1,t+1,(t+4<NT),(t+2<NT),(t+2<NT),(t+1<4));     ENDW(t+1); RESC(); ROT();
    }
    STEP(pB0,pB1,pA0,pA1,NT-1,false,false,false,(NT==4)); RESC();
  }
  { float sacc=pB0[0]+pB0[1]; _Pragma("unroll") for(int r=2;r<16;++r)sacc+=pB0[r]; _Pragma("unroll") for(int r=0;r<16;++r)sacc+=pB1[r]; l_reg+=sacc;
    pw0=(u32x4){PKW(pB0,0),PKW(pB0,2),PKW(pB0,4),PKW(pB0,6)};pw1=(u32x4){PKW(pB0,8),PKW(pB0,10),PKW(pB0,12),PKW(pB0,14)};pw2=(u32x4){PKW(pB1,0),PKW(pB1,2),PKW(pB1,4),PKW(pB1,6)};pw3=(u32x4){PKW(pB1,8),PKW(pB1,10),PKW(pB1,12),PKW(pB1,14)};
    SBAR(); pv(o,vb0+sl_cur,PAF(0),PAF(1),PAF(2),PAF(3)); }
  #undef PKW
  #undef PAF
  #undef VFR
  #undef PIN
  #undef MX3
  #undef GAPA
  #undef GAPB
  #undef EX
  #undef VRD
  #undef KRD
  #undef STEP
  #undef ENDW
  {auto rr=__builtin_amdgcn_permlane32_swap(__float_as_uint(l_reg),__float_as_uint(l_reg),false,false);l_reg=__uint_as_float(rr[0])+__uint_as_float(rr[1]);}
  if(hi==0)wsf[32+r32]=l_reg;asm volatile("s_waitcnt lgkmcnt(0)":::"memory");
  float rli[16];
  #pragma unroll
  for(int r=0;r<16;++r)rli[r]=__builtin_amdgcn_rcpf(wsf[32+crow(r,hi)]);
  bf16*Ow=O+(rowbase+q0+wid*QBLK)*PO+h*D;
  { bf16*stg=(bf16*)(shm+LDS_OST)+wid*2048;
    #pragma unroll
    for(int r=0;r<16;++r){const int orow=crow(r,hi);
      #pragma unroll
      for(int d0=0;d0<2;++d0)stg[orow*64+d0*32+r32]=__float2bfloat16(o[d0][r]*rli[r]);}
    asm volatile("s_waitcnt lgkmcnt(0)":::"memory");
    #pragma unroll
    for(int i=0;i<4;++i){const int row=i*8+(lane>>3),ch=lane&7; const u32x4 v=*(const u32x4*)(stg+row*64+ch*8); ATTN_STORE16(Ow+(long)row*PO+ch*8,v);} }
  asm volatile("s_waitcnt lgkmcnt(0)\n\ts_barrier":::"memory");
  #undef DMA_K
  #undef TROW
  #undef SUBREF
  #undef DMA_V
  #undef CMASK
  #undef START
  #undef RESC
  #undef ROT
}
constexpr int ATTN_LDS_BYTES=LDS_BYTES;
#undef SBAR
#undef WAIT_BAR
}
constexpr int DM = 1024, NB = 16, SEQ = 2048, NT = NB * SEQ;
constexpr int RWW = 512, INC = 5376, ZA = 1792, ZG = 3328;
constexpr int NEXP = 32, DEXP = 512;
constexpr int XS_ROWS = 2 * NT + NEXP * 256;
constexpr float C2 = 0.125f * 1.4426950408889634f;

#define LAS __attribute__((address_space(3)))
#define GAS __attribute__((address_space(1)))
typedef unsigned short bf16;
typedef unsigned v4u __attribute__((ext_vector_type(4)));
typedef unsigned v2u __attribute__((ext_vector_type(2)));
typedef float f32x4 __attribute__((ext_vector_type(4)));

__device__ __forceinline__ unsigned f2bf(float f) { unsigned u = __builtin_bit_cast(unsigned, f); return (u + 0x7fffu + ((u >> 16) & 1u)) >> 16; }
__device__ __forceinline__ unsigned pk2(float lo, float hi) { return f2bf(lo) | (f2bf(hi) << 16); }
__device__ __forceinline__ float bflo(unsigned w) { return __builtin_bit_cast(float, w << 16); }
__device__ __forceinline__ float bfhi(unsigned w) { return __builtin_bit_cast(float, w & 0xffff0000u); }
__device__ __forceinline__ float sigm(float x) { return 1.0f / (1.0f + __expf(-x)); }
__device__ __forceinline__ float wave_sum(float v) {
#pragma unroll
    for (int o = 1; o < 64; o <<= 1) v += __shfl_xor(v, o);
    return v;
}

constexpr size_t MiB = 1u << 20;
constexpr size_t WS_CTL = 0;
constexpr size_t WS_MOD = 1 * MiB;
constexpr size_t WS_COS = 2 * MiB;
constexpr size_t WS_SIN = 2 * MiB + 512 * 1024;
constexpr size_t WS_KMEAN = 3 * MiB;
constexpr size_t WS_WRT = 3 * MiB + 512 * 1024;
constexpr size_t WS_SEL = 4 * MiB;
constexpr size_t WS_RTE = 5 * MiB;
constexpr size_t WS_RTW = 5 * MiB + 256 * 1024;
constexpr size_t WS_RNK = 5 * MiB + 512 * 1024;
constexpr size_t WS_POS = 5 * MiB + 768 * 1024;
constexpr size_t WS_WIN = 16 * MiB;
constexpr size_t WS_WBA = 27 * MiB;
constexpr size_t WS_WBB = 28 * MiB;
constexpr size_t WS_WOUT = 29 * MiB;
constexpr size_t WS_Z = 32 * MiB;
constexpr size_t WS_H = 368 * MiB;
constexpr size_t WS_Q = 368 * MiB, WS_K = 400 * MiB, WS_MRG = 368 * MiB;
constexpr size_t WS_YA = 432 * MiB, WS_YB = 464 * MiB;
constexpr size_t WS_WUP = 32 * MiB;
constexpr size_t WS_W2T = 96 * MiB;
constexpr size_t WS_H2 = 128 * MiB;
constexpr size_t WS_XS = 192 * MiB;
constexpr size_t WS_HID = 336 * MiB;
constexpr size_t WS_END = 496 * MiB;
constexpr int CW_CNT = 64;
constexpr int CW_NT = 128;
constexpr int CW_TEXP = 256;

__device__ __forceinline__ void tr_item(const float* W, int K, int N, bf16* WT, int kb, int nb, int dst_row0, LAS float* scr, int lane) {
    const int k0 = 64 * kb, n0 = 32 * nb;
#pragma unroll 8
    for (int i = 0; i < 32; ++i) { const int kk = 2 * i + (lane >> 5); scr[kk * 33 + (lane & 31)] = W[(size_t)(k0 + kk) * N + n0 + (lane & 31)]; }
    asm volatile("s_waitcnt lgkmcnt(0)" ::: "memory");
    const int c = lane & 7;
#pragma unroll
    for (int j = 0; j < 4; ++j) { const int n = (lane >> 3) + 8 * j; const LAS float* s = scr + (8 * c) * 33 + n;
        v4u o; o.x = pk2(s[0 * 33], s[1 * 33]); o.y = pk2(s[2 * 33], s[3 * 33]); o.z = pk2(s[4 * 33], s[5 * 33]); o.w = pk2(s[6 * 33], s[7 * 33]);
        *(v4u*)(WT + (size_t)(dst_row0 + n) * K + k0 + 8 * c) = o; }
    asm volatile("s_waitcnt lgkmcnt(0)" ::: "memory");
}

struct PArgs { const float* in[30]; float* out; unsigned char* ws; };

__global__ void __launch_bounds__(512) k_prep_weights(PArgs a) {
    extern __shared__ __attribute__((aligned(16))) unsigned char lds[];
    const int tid = threadIdx.x, lane = tid & 63, wave = tid >> 6;
    LAS float* scr = (LAS float*)lds + wave * (64 * 33);
    const int gw = blockIdx.x * 8 + wave, NGW = gridDim.x * 8;
    unsigned char* ws = a.ws;
    constexpr int I_IN = 16 * 168, I_BR = 8 * 32, I_OUT = 16 * 32;
    for (int it = gw; it < I_IN + 2 * I_BR + I_OUT; it += NGW) {
        int r = it;
        if (r < I_IN) { const int kb = r / 168, nb = r % 168; tr_item(a.in[6], 1024, INC, (bf16*)(ws + WS_WIN), kb, nb, 32 * nb, scr, lane); continue; } r -= I_IN;
        if (r < I_BR) { const int kb = r / 32, nb = r % 32; tr_item(a.in[20], 512, 1024, (bf16*)(ws + WS_WBA), kb, nb, 32 * nb, scr, lane); continue; } r -= I_BR;
        if (r < I_BR) { const int kb = r / 32, nb = r % 32; tr_item(a.in[21], 512, 1024, (bf16*)(ws + WS_WBB), kb, nb, 32 * nb, scr, lane); continue; } r -= I_BR;
        { const int kb = r / 32, nb = r % 32; tr_item(a.in[22], 1024, 1024, (bf16*)(ws + WS_WOUT), kb, nb, 32 * nb, scr, lane); }
    }
    const int gt = blockIdx.x * 512 + tid, NGT = gridDim.x * 512;
    float* cosT = (float*)(ws + WS_COS); float* sinT = (float*)(ws + WS_SIN);
    for (int i = gt; i < SEQ * 32; i += NGT) { const int s = i >> 5, f = i & 31; const float inv = powf(10000.0f, -(float)f / 32.0f); const float ang = (float)s * inv; cosT[i] = cosf(ang); sinT[i] = sinf(ang); }
    float* wrt = (float*)(ws + WS_WRT);
    for (int i = gt; i < 36 * 1024; i += NGT) { const int e = i >> 10, k = i & 1023; wrt[i] = e < 4 ? a.in[23][k * 4 + e] : a.in[25][k * 32 + (e - 4)]; }
}

__global__ void __launch_bounds__(512) k_prep_experts(PArgs a) {
    extern __shared__ __attribute__((aligned(16))) unsigned char lds[];
    const int tid = threadIdx.x, lane = tid & 63, wave = tid >> 6;
    LAS float* scr = (LAS float*)lds + wave * (64 * 33);
    const int gw = blockIdx.x * 8 + wave, NGW = gridDim.x * 8;
    unsigned char* ws = a.ws;
    for (int it = gw; it < NEXP * 768; it += NGW) {
        const int e = it / 768; int r = it % 768;
        bf16* wup = (bf16*)(ws + WS_WUP) + (size_t)e * 1024 * 1024;
        if (r < 256) { const int kb = r / 16, nb = r % 16, n0 = 32 * nb; tr_item(a.in[27] + (size_t)e * 1024 * 512, 1024, 512, wup, kb, nb, (n0 >> 7) * 256 + (n0 & 127), scr, lane); continue; } r -= 256;
        if (r < 256) { const int kb = r / 16, nb = r % 16, n0 = 32 * nb; tr_item(a.in[28] + (size_t)e * 1024 * 512, 1024, 512, wup, kb, nb, (n0 >> 7) * 256 + 128 + (n0 & 127), scr, lane); continue; } r -= 256;
        { const int kb = r / 32, nb = r % 32; tr_item(a.in[29] + (size_t)e * 512 * 1024, 512, 1024, (bf16*)(ws + WS_W2T) + (size_t)e * 1024 * 512, kb, nb, 32 * nb, scr, lane); }
    }
}

__global__ void __launch_bounds__(256) k_ada(PArgs a) {
    extern __shared__ __attribute__((aligned(16))) unsigned char lds[];
    float* sc = (float*)lds; float* red = sc + 16 * 1024;
    const float* c = a.in[1]; const float* w = a.in[2]; const float* bias = a.in[3];
    float* mod = (float*)(a.ws + WS_MOD);
    const int tid = threadIdx.x;
    for (int i = tid; i < 16 * 1024; i += 256) { const float v = c[i]; sc[i] = v / (1.0f + __expf(-v)); }
    __syncthreads();
    const int col = tid & 31, kg = tid >> 5, e = blockIdx.x * 32 + col;
    float acc[16];
#pragma unroll
    for (int b = 0; b < 16; ++b) acc[b] = 0.f;
    for (int d = kg * 128; d < kg * 128 + 128; ++d) { const float wv = w[(size_t)d * 6144 + e];
#pragma unroll
        for (int b = 0; b < 16; ++b) acc[b] += sc[b * 1024 + d] * wv; }
#pragma unroll
    for (int b = 0; b < 16; ++b) red[(kg * 16 + b) * 32 + col] = acc[b];
    __syncthreads();
    for (int i = tid; i < 16 * 32; i += 256) { const int b = i >> 5, cc = i & 31; float s = 0.f;
#pragma unroll
        for (int k = 0; k < 8; ++k) s += red[(k * 16 + b) * 32 + cc];
        mod[b * 6144 + blockIdx.x * 32 + cc] = s + bias[blockIdx.x * 32 + cc]; }
}

__global__ void __launch_bounds__(512) k_norm1(PArgs a) {
    const int lane = threadIdx.x & 63, gw = blockIdx.x * 8 + (threadIdx.x >> 6), NGW = gridDim.x * 8;
    const float* x = a.in[0]; const float* g = a.in[4]; const float* mod = (const float*)(a.ws + WS_MOD);
    bf16* h = (bf16*)(a.ws + WS_H);
    for (int m = gw; m < NT; m += NGW) {
        const int b = m >> 11; const f32x4* xr = (const f32x4*)(x + (size_t)m * DM) + lane; f32x4 v[4]; float s = 0.f;
#pragma unroll
        for (int j = 0; j < 4; ++j) { v[j] = xr[64 * j]; s += (v[j].x * v[j].x + v[j].y * v[j].y) + (v[j].z * v[j].z + v[j].w * v[j].w); }
        const float rstd = rsqrtf(wave_sum(s) * (1.0f / DM) + 1e-6f);
        v2u* o = (v2u*)(h + (size_t)m * DM) + lane;
#pragma unroll
        for (int j = 0; j < 4; ++j) { const int col = 4 * (lane + 64 * j);
            const f32x4 gg = *(const f32x4*)(g + col), sh = *(const f32x4*)(mod + b * 6144 + col), scl = *(const f32x4*)(mod + b * 6144 + 1024 + col);
            const f32x4 r = v[j] * rstd * gg * (scl + 1.0f) + sh; v2u w; w.x = pk2(r.x, r.y); w.y = pk2(r.z, r.w); o[64 * j] = w; }
    }
}

using pg8::Unit; using pg8::HALF; using pg8::BM; using pg8::cvt_pk_bf16;
typedef pg8::f32x4 pf4; typedef pg8::u32x4 pu4;

struct EpiStoreBf16 {
    static constexpr bool PERM = true, AFTER_DRAIN = false;
    bf16* O; int ldc;
    __device__ __forceinline__ void operator()(const pf4 (&acc)[2][2][4][2], const Unit& u, int wr, int wc, int fr, int fq) const {
        const int row0 = u.pm * BM + wr * 64 + fr, col0 = u.pn * BM + wc * 32 + 8 * fq;
#pragma unroll
        for (int ai = 0; ai < 2; ++ai)
#pragma unroll
            for (int m = 0; m < 4; ++m) { bf16* rowp = O + (size_t)(row0 + ai * HALF + m * 16) * ldc + col0;
#pragma unroll
                for (int bj = 0; bj < 2; ++bj) { const pf4 v0 = acc[ai][bj][m][0], v1 = acc[ai][bj][m][1]; pu4 w;
                    w.x = cvt_pk_bf16(v0[0], v0[1]); w.y = cvt_pk_bf16(v0[2], v0[3]); w.z = cvt_pk_bf16(v1[0], v1[1]); w.w = cvt_pk_bf16(v1[2], v1[3]);
                    *(pu4*)(rowp + bj * HALF) = w; } }
    }
};
struct EpiBranchA {
    static constexpr bool PERM = false, AFTER_DRAIN = false;
    float* tmp; const bf16* z;
    __device__ __forceinline__ void operator()(const pf4 (&acc)[2][2][4][2], const Unit& u, int wr, int wc, int fr, int fq) const {
        const int row0 = u.pm * BM + wr * 64 + fr, col0 = u.pn * BM + wc * 32 + 4 * fq;
#pragma unroll
        for (int ai = 0; ai < 2; ++ai)
#pragma unroll
            for (int m = 0; m < 4; ++m) { const size_t row = (size_t)(row0 + ai * HALF + m * 16);
#pragma unroll
                for (int bj = 0; bj < 2; ++bj)
#pragma unroll
                    for (int n = 0; n < 2; ++n) { const int col = col0 + bj * HALF + n * 16; const v2u gz = *(const v2u*)(z + row * INC + ZG + col); const pf4 v = acc[ai][bj][m][n];
                        pf4 o; o[0] = sigm(bflo(gz.x)) * v[0]; o[1] = sigm(bfhi(gz.x)) * v[1]; o[2] = sigm(bflo(gz.y)) * v[2]; o[3] = sigm(bfhi(gz.y)) * v[3];
                        *(pf4*)(tmp + row * DM + col) = o; } }
    }
};
struct EpiBranchB {
    static constexpr bool PERM = true, AFTER_DRAIN = false;
    const float* tmp; const bf16* z; bf16* mrg;
    __device__ __forceinline__ void operator()(const pf4 (&acc)[2][2][4][2], const Unit& u, int wr, int wc, int fr, int fq) const {
        const int row0 = u.pm * BM + wr * 64 + fr, col0 = u.pn * BM + wc * 32 + 8 * fq;
#pragma unroll
        for (int ai = 0; ai < 2; ++ai)
#pragma unroll
            for (int m = 0; m < 4; ++m) { const size_t row = (size_t)(row0 + ai * HALF + m * 16);
#pragma unroll
                for (int bj = 0; bj < 2; ++bj) { const int col = col0 + bj * HALF; const pu4 gz = *(const pu4*)(z + row * INC + ZG + 1024 + col);
                    const pf4 t0 = *(const pf4*)(tmp + row * DM + col), t1 = *(const pf4*)(tmp + row * DM + col + 4); const pf4 v0 = acc[ai][bj][m][0], v1 = acc[ai][bj][m][1];
                    pu4 w;
                    w.x = cvt_pk_bf16(t0[0] + sigm(bflo(gz.x)) * v0[0], t0[1] + sigm(bfhi(gz.x)) * v0[1]);
                    w.y = cvt_pk_bf16(t0[2] + sigm(bflo(gz.y)) * v0[2], t0[3] + sigm(bfhi(gz.y)) * v0[3]);
                    w.z = cvt_pk_bf16(t1[0] + sigm(bflo(gz.z)) * v1[0], t1[1] + sigm(bfhi(gz.z)) * v1[1]);
                    w.w = cvt_pk_bf16(t1[2] + sigm(bflo(gz.w)) * v1[2], t1[3] + sigm(bfhi(gz.w)) * v1[3]);
                    *(pu4*)(mrg + row * DM + col) = w; } }
    }
};
struct EpiOut {
    static constexpr bool PERM = false, AFTER_DRAIN = false;
    const float* x; const float* mod; float* out;
    __device__ __forceinline__ void operator()(const pf4 (&acc)[2][2][4][2], const Unit& u, int wr, int wc, int fr, int fq) const {
        const int row0 = u.pm * BM + wr * 64 + fr, col0 = u.pn * BM + wc * 32 + 4 * fq; const int b = u.pm >> 3;
        pf4 gt[2][2];
#pragma unroll
        for (int bj = 0; bj < 2; ++bj)
#pragma unroll
            for (int n = 0; n < 2; ++n) gt[bj][n] = *(const pf4*)(mod + b * 6144 + 2048 + col0 + bj * HALF + n * 16);
#pragma unroll
        for (int ai = 0; ai < 2; ++ai)
#pragma unroll
            for (int m = 0; m < 4; ++m) { const size_t off = (size_t)(row0 + ai * HALF + m * 16) * DM + col0;
#pragma unroll
                for (int bj = 0; bj < 2; ++bj)
#pragma unroll
                    for (int n = 0; n < 2; ++n) { const pf4 xv = *(const pf4*)(x + off + bj * HALF + n * 16); *(pf4*)(out + off + bj * HALF + n * 16) = xv + gt[bj][n] * acc[ai][bj][m][n]; } }
    }
};
struct EpiUp {
    static constexpr bool PERM = true, AFTER_DRAIN = false;
    bf16* hid;
    __device__ __forceinline__ void operator()(const pf4 (&acc)[2][2][4][2], const Unit& u, int wr, int wc, int fr, int fq) const {
        const int row0 = u.pm * BM + wr * 64 + fr, col0 = u.pn * 128 + wc * 32 + 8 * fq;
#pragma unroll
        for (int ai = 0; ai < 2; ++ai)
#pragma unroll
            for (int m = 0; m < 4; ++m) { const size_t row = (size_t)(row0 + ai * HALF + m * 16); float o[8];
#pragma unroll
                for (int n = 0; n < 2; ++n)
#pragma unroll
                    for (int e = 0; e < 4; ++e) { const float g = acc[ai][0][m][n][e], l = acc[ai][1][m][n][e]; o[4 * n + e] = g * sigm(g) * l; }
                pu4 w; w.x = cvt_pk_bf16(o[0], o[1]); w.y = cvt_pk_bf16(o[2], o[3]); w.z = cvt_pk_bf16(o[4], o[5]); w.w = cvt_pk_bf16(o[6], o[7]);
                *(pu4*)(hid + row * DEXP + col0) = w; }
    }
};

struct GemmArgs { unsigned char* ws; const float* x; float* out; };
template <class Epi> __device__ __forceinline__ void run_dense(const void* A, const void* Bt, int M, int N, int K, const Epi& E, unsigned char* lds) {
    pg8::Gemm g{K}; pg8::StaticOrder S; S.init(A, Bt, M, N, K, (int)gridDim.x, (int)blockIdx.x);
    pg8::gemm_phase<Epi, pg8::StaticOrder, true, true>((PG8_LAS unsigned char*)lds, g, S, E);
}
__global__ void __launch_bounds__(512, 2) k_gemm_in(GemmArgs a) {
    extern __shared__ __attribute__((aligned(16))) unsigned char lds[];
    EpiStoreBf16 E{(bf16*)(a.ws + WS_Z), INC};
    run_dense(a.ws + WS_H, a.ws + WS_WIN, NT, INC, 1024, E, lds);
}
__global__ void __launch_bounds__(512, 2) k_gemm_bra(GemmArgs a) {
    extern __shared__ __attribute__((aligned(16))) unsigned char lds[];
    EpiBranchA E{a.out, (const bf16*)(a.ws + WS_Z)};
    run_dense(a.ws + WS_YA, a.ws + WS_WBA, NT, 1024, 512, E, lds);
}
__global__ void __launch_bounds__(512, 2) k_gemm_brb(GemmArgs a) {
    extern __shared__ __attribute__((aligned(16))) unsigned char lds[];
    EpiBranchB E{a.out, (const bf16*)(a.ws + WS_Z), (bf16*)(a.ws + WS_MRG)};
    run_dense(a.ws + WS_YB, a.ws + WS_WBB, NT, 1024, 512, E, lds);
}
__global__ void __launch_bounds__(512, 2) k_gemm_out(GemmArgs a) {
    extern __shared__ __attribute__((aligned(16))) unsigned char lds[];
    EpiOut E{a.x, (const float*)(a.ws + WS_MOD), a.out};
    run_dense(a.ws + WS_MRG, a.ws + WS_WOUT, NT, 1024, 1024, E, lds);
}
struct GroupedOrder {
    const int* texp; int nT, nN, G, c; const char* A; size_t a_tile; const char* B; size_t b_exp, b_tile;
    __device__ bool next(int i, Unit& u) const {
        const long L = (long)i * G + c; if (L >= (long)nT * nN) return false;
        const int tile = (int)(L / nN), pn = (int)(L % nN); u.pm = tile; u.pn = pn; u.a = A + (size_t)tile * a_tile; u.b = B + (size_t)texp[tile] * b_exp + (size_t)pn * b_tile; return true;
    }
    __device__ __forceinline__ void a_ready(const Unit&) const {}
    __device__ __forceinline__ void done(const Unit&) const {}
};
__global__ void __launch_bounds__(512, 2) k_gemm_up(GemmArgs a) {
    extern __shared__ __attribute__((aligned(16))) unsigned char lds[];
    const int* ctl = (const int*)(a.ws + WS_CTL);
    GroupedOrder S{ctl + CW_TEXP, ctl[CW_NT], 4, (int)gridDim.x, (int)blockIdx.x, (const char*)(a.ws + WS_XS), (size_t)256 * 1024 * 2, (const char*)(a.ws + WS_WUP), (size_t)1024 * 1024 * 2, (size_t)256 * 1024 * 2};
    EpiUp E{(bf16*)(a.ws + WS_HID)}; pg8::Gemm g{1024};
    pg8::gemm_phase<EpiUp, GroupedOrder, true, true>((PG8_LAS unsigned char*)lds, g, S, E);
}
__global__ void __launch_bounds__(512, 2) k_gemm_down(GemmArgs a) {
    extern __shared__ __attribute__((aligned(16))) unsigned char lds[];
    const int* ctl = (const int*)(a.ws + WS_CTL);
    GroupedOrder S{ctl + CW_TEXP, ctl[CW_NT], 4, (int)gridDim.x, (int)blockIdx.x, (const char*)(a.ws + WS_HID), (size_t)256 * 512 * 2, (const char*)(a.ws + WS_W2T), (size_t)1024 * 512 * 2, (size_t)256 * 512 * 2};
    EpiStoreBf16 E{(bf16*)(a.ws + WS_XS), 1024}; pg8::Gemm g{512};
    pg8::gemm_phase<EpiStoreBf16, GroupedOrder, true, true>((PG8_LAS unsigned char*)lds, g, S, E);
}

__device__ __forceinline__ void load64bf(const bf16* p, float (&v)[64]) {
#pragma unroll
    for (int i = 0; i < 8; ++i) { const v4u w = *(const v4u*)(p + 8 * i);
        v[8 * i + 0] = bflo(w.x); v[8 * i + 1] = bfhi(w.x); v[8 * i + 2] = bflo(w.y); v[8 * i + 3] = bfhi(w.y);
        v[8 * i + 4] = bflo(w.z); v[8 * i + 5] = bfhi(w.z); v[8 * i + 6] = bflo(w.w); v[8 * i + 7] = bfhi(w.w); }
}
__device__ __forceinline__ void store64bf(bf16* p, const float (&v)[64], float sc) {
#pragma unroll
    for (int i = 0; i < 8; ++i) { v4u w; w.x = pk2(v[8 * i] * sc, v[8 * i + 1] * sc); w.y = pk2(v[8 * i + 2] * sc, v[8 * i + 3] * sc); w.z = pk2(v[8 * i + 4] * sc, v[8 * i + 5] * sc); w.w = pk2(v[8 * i + 6] * sc, v[8 * i + 7] * sc);
        *(v4u*)(p + 8 * i) = w; }
}
__device__ __forceinline__ void norm_rope(float (&v)[64], const float* g, const float* cosT, const float* sinT, int s) {
    float ss = 0.f;
#pragma unroll
    for (int d = 0; d < 64; ++d) ss += v[d] * v[d];
    const float rstd = rsqrtf(ss * (1.0f / 64.0f) + 1e-6f);
#pragma unroll
    for (int d = 0; d < 64; ++d) v[d] = v[d] * rstd * g[d];
#pragma unroll
    for (int i = 0; i < 32; ++i) { const float c = cosT[s * 32 + i], sn = sinT[s * 32 + i]; const float x1 = v[i], x2 = v[i + 32]; v[i] = x1 * c - x2 * sn; v[i + 32] = x2 * c + x1 * sn; }
}
__global__ void __launch_bounds__(256) k_kprep(PArgs a) {
    __shared__ float red[4][64];
    const int tid = threadIdx.x, blk = blockIdx.x, h = blk & 7, n = (blk >> 3) & 7, b = blk >> 6;
    const int s = n * 256 + tid; const size_t t = (size_t)b * SEQ + s;
    const bf16* z = (const bf16*)(a.ws + WS_Z);
    float v[64]; load64bf(z + t * INC + ZA + 512 + h * 64, v);
    norm_rope(v, a.in[19], (const float*)(a.ws + WS_COS), (const float*)(a.ws + WS_SIN), s);
    store64bf((bf16*)(a.ws + WS_K) + t * 512 + h * 64, v, 1.0f);
#pragma unroll
    for (int d = 0; d < 64; ++d) { const float sm = wave_sum(v[d]); if ((tid & 63) == 0) red[tid >> 6][d] = sm; }
    __syncthreads();
    if (tid < 64) ((float*)(a.ws + WS_KMEAN))[(size_t)((b * 8 + h) * 8 + n) * 64 + tid] = ((red[0][tid] + red[1][tid]) + (red[2][tid] + red[3][tid])) * (1.0f / 256.0f);
}
__global__ void __launch_bounds__(256) k_qprep(PArgs a) {
    const int tid = threadIdx.x, blk = blockIdx.x, h = blk & 7, n = (blk >> 3) & 7, b = blk >> 6;
    const int s = n * 256 + tid; const size_t t = (size_t)b * SEQ + s;
    const bf16* z = (const bf16*)(a.ws + WS_Z);
    float v[64]; load64bf(z + t * INC + ZA + h * 64, v);
    norm_rope(v, a.in[18], (const float*)(a.ws + WS_COS), (const float*)(a.ws + WS_SIN), s);
    const float* km = (const float*)(a.ws + WS_KMEAN) + (size_t)((b * 8 + h) * 8) * 64;
    float gate[7];
#pragma unroll
    for (int j = 0; j < 7; ++j) { float g = 0.f; if (j < n) {
#pragma unroll
            for (int d = 0; d < 64; ++d) g += v[d] * km[j * 64 + d]; }
        gate[j] = g; }
    unsigned sel = 0;
    if (n <= 3) sel = (1u << n) - 1u;
    else {
#pragma unroll
        for (int rep = 0; rep < 3; ++rep) { float best = -INFINITY; int bi = 0;
#pragma unroll
            for (int j = 0; j < 7; ++j) if (j < n && !((sel >> j) & 1u) && gate[j] > best) { best = gate[j]; bi = j; }
            sel |= 1u << bi; }
    }
    ((unsigned char*)(a.ws + WS_SEL))[(size_t)(b * 8 + h) * SEQ + s] = (unsigned char)sel;
    store64bf((bf16*)(a.ws + WS_Q) + t * 512 + h * 64, v, C2);
}

__global__ void __launch_bounds__(512, 2) k_attn(PArgs a) {
    extern __shared__ __attribute__((aligned(16))) unsigned char lds[];
    const attn_body::bf16* Q = (const attn_body::bf16*)(a.ws + WS_Q); const attn_body::bf16* K = (const attn_body::bf16*)(a.ws + WS_K);
    const attn_body::bf16* V = (const attn_body::bf16*)(a.ws + WS_Z) + (ZA + 1024); attn_body::bf16* O = (attn_body::bf16*)(a.ws + WS_YB);
    const unsigned char* SEL = (const unsigned char*)(a.ws + WS_SEL);
    for (int p = blockIdx.x; p < 512; p += gridDim.x)
        for (int which = 0; which < 2; ++which) { const int bh = p >> 2, s = p & 3, qb = which ? 7 - s : s;
            attn_body::attn_unit<8>(bh >> 3, bh & 7, qb, Q, K, V, O, SEL, (char*)lds); }
}

__device__ __forceinline__ f32x4 shift4(const bf16* zp, int off, bool hasp, f32x4 mu) {
    const v2u cw = *(const v2u*)(zp + off); v2u pw = {0u, 0u}; if (hasp) pw = *(const v2u*)(zp - INC + off);
    const f32x4 cv = {bflo(cw.x), bfhi(cw.x), bflo(cw.y), bfhi(cw.y)}, pv = {bflo(pw.x), bfhi(pw.x), bflo(pw.y), bfhi(pw.y)};
    return cv + (pv - cv) * mu;
}
__device__ __forceinline__ float red16(float v) { v += __shfl_xor(v, 1); v += __shfl_xor(v, 2); v += __shfl_xor(v, 4); v += __shfl_xor(v, 8); return v; }
__device__ __forceinline__ float red8(float v) { v += __shfl_xor(v, 1); v += __shfl_xor(v, 2); v += __shfl_xor(v, 4); return v; }
__global__ void __launch_bounds__(512) k_scan(PArgs a) {
    extern __shared__ __attribute__((aligned(16))) unsigned char lds[];
    float* L = (float*)lds;
    float* WL = L; float* WA = L + 4096; float* WG = L + 8192;
    float* R = L + 16384; float* KX = R + 2048; float* V = KX + 2048;
    float* AW = V + 2048; float* AA = AW + 2048; float* AG = AA + 2048;
    float* W = AG + 4096; float* A2 = W + 2048; float* B2 = A2 + 2048; float* G = B2 + 2048;
    float* BON = G + 2048;
    float* Y = AW;
    const int tid = threadIdx.x, bh = blockIdx.x, b = bh >> 3, h = bh & 7;
    const float* mu = a.in[7]; const float* w0 = a.in[8]; const float* wl = a.in[9]; const float* a0 = a.in[10]; const float* al = a.in[11]; const float* gl = a.in[12];
    const float* k_k = a.in[13]; const float* k_a = a.in[14]; const float* r_k = a.in[15]; const float* lng = a.in[16]; const float* lnb = a.in[17];
    const bf16* z = (const bf16*)(a.ws + WS_Z); bf16* ya = (bf16*)(a.ws + WS_YA);
    for (int i = tid; i < 4096; i += 512) { const int m = i >> 6, j = i & 63; WL[i] = wl[m * 512 + h * 64 + j]; WA[i] = al[m * 512 + h * 64 + j]; }
    for (int i = tid; i < 8192; i += 512) { const int m = i >> 6, j = i & 63; WG[i] = gl[m * 512 + h * 64 + j]; }
    const int tt = tid >> 4, jg = tid & 15;
    const int si = tid >> 3, c8 = tid & 7;
    float st[8];
#pragma unroll
    for (int j = 0; j < 8; ++j) st[j] = 0.f;
    const int colh = h * 64 + 4 * jg;
    const f32x4 mu_r = *(const f32x4*)(mu + colh), mu_k = *(const f32x4*)(mu + 512 + colh), mu_v = *(const f32x4*)(mu + 1024 + colh);
    const f32x4 mu_w = *(const f32x4*)(mu + 1536 + 4 * jg), mu_a = *(const f32x4*)(mu + 1600 + 4 * jg), mu_g0 = *(const f32x4*)(mu + 1664 + 8 * jg), mu_g1 = *(const f32x4*)(mu + 1668 + 8 * jg);
    const f32x4 w0v = *(const f32x4*)(w0 + colh), a0v = *(const f32x4*)(a0 + colh), kkv = *(const f32x4*)(k_k + colh), kav = *(const f32x4*)(k_a + colh), rkv = *(const f32x4*)(r_k + colh);
    const f32x4 lgv = *(const f32x4*)(lng + colh), lbv = *(const f32x4*)(lnb + colh);
    __syncthreads();
    for (int c = 0; c < SEQ / 32; ++c) {
        const int s = c * 32 + tt; const size_t t = (size_t)b * SEQ + s; const bf16* zp = z + t * INC; const bool hasp = s > 0;
        {
            *(f32x4*)(R + tt * 64 + 4 * jg) = shift4(zp, colh, hasp, mu_r);
            *(f32x4*)(KX + tt * 64 + 4 * jg) = shift4(zp, 512 + colh, hasp, mu_k);
            *(f32x4*)(V + tt * 64 + 4 * jg) = shift4(zp, 1024 + colh, hasp, mu_v);
            { const f32x4 x = shift4(zp, 1536 + 4 * jg, hasp, mu_w); *(f32x4*)(AW + tt * 64 + 4 * jg) = (f32x4){tanhf(x.x), tanhf(x.y), tanhf(x.z), tanhf(x.w)}; }
            *(f32x4*)(AA + tt * 64 + 4 * jg) = shift4(zp, 1600 + 4 * jg, hasp, mu_a);
            { const f32x4 x = shift4(zp, 1664 + 8 * jg, hasp, mu_g0); *(f32x4*)(AG + tt * 128 + 8 * jg) = (f32x4){sigm(x.x), sigm(x.y), sigm(x.z), sigm(x.w)}; }
            { const f32x4 x = shift4(zp, 1668 + 8 * jg, hasp, mu_g1); *(f32x4*)(AG + tt * 128 + 8 * jg + 4) = (f32x4){sigm(x.x), sigm(x.y), sigm(x.z), sigm(x.w)}; }
        }
        __syncthreads();
        {
            f32x4 lw = {0.f, 0.f, 0.f, 0.f}, la = lw, lg = lw;
#pragma unroll 4
            for (int m = 0; m < 64; ++m) { const float aw = AW[tt * 64 + m], aa = AA[tt * 64 + m]; lw += *(const f32x4*)(WL + m * 64 + 4 * jg) * aw; la += *(const f32x4*)(WA + m * 64 + 4 * jg) * aa; }
#pragma unroll 4
            for (int m = 0; m < 128; ++m) { const float ag = AG[tt * 128 + m]; lg += *(const f32x4*)(WG + m * 64 + 4 * jg) * ag; }
            const f32x4 kx = *(const f32x4*)(KX + tt * 64 + 4 * jg), rr = *(const f32x4*)(R + tt * 64 + 4 * jg);
            f32x4 wv, av, kk, k2; float ss = 0.f, bon = 0.f;
#pragma unroll
            for (int e = 0; e < 4; ++e) { wv[e] = __expf(-0.606531f * sigm(w0v[e] + lw[e])); av[e] = sigm(a0v[e] + la[e]); kk[e] = kx[e] * kkv[e]; ss += kk[e] * kk[e];
                k2[e] = kx[e] * (1.0f + (av[e] - 1.0f) * kav[e]); bon += rr[e] * k2[e] * rkv[e]; }
            ss = red16(ss); bon = red16(bon);
            const float inv = 1.0f / fmaxf(sqrtf(ss), 1e-12f);
            kk = kk * inv;
            *(f32x4*)(W + tt * 64 + 4 * jg) = wv; *(f32x4*)(KX + tt * 64 + 4 * jg) = k2; *(f32x4*)(A2 + tt * 64 + 4 * jg) = -kk; *(f32x4*)(B2 + tt * 64 + 4 * jg) = kk * av; *(f32x4*)(G + tt * 64 + 4 * jg) = lg;
            if (jg == 0) BON[tt] = bon;
        }
        __syncthreads();
        for (int q = 0; q < 32; ++q) {
            const f32x4 a_0 = *(const f32x4*)(A2 + q * 64 + 8 * c8), a_1 = *(const f32x4*)(A2 + q * 64 + 8 * c8 + 4);
            const f32x4 b_0 = *(const f32x4*)(B2 + q * 64 + 8 * c8), b_1 = *(const f32x4*)(B2 + q * 64 + 8 * c8 + 4);
            const f32x4 w_0 = *(const f32x4*)(W + q * 64 + 8 * c8), w_1 = *(const f32x4*)(W + q * 64 + 8 * c8 + 4);
            const f32x4 k_0 = *(const f32x4*)(KX + q * 64 + 8 * c8), k_1 = *(const f32x4*)(KX + q * 64 + 8 * c8 + 4);
            const f32x4 r_0 = *(const f32x4*)(R + q * 64 + 8 * c8), r_1 = *(const f32x4*)(R + q * 64 + 8 * c8 + 4);
            const float vi = V[q * 64 + si];
            float sa = 0.f;
#pragma unroll
            for (int j = 0; j < 4; ++j) { sa += st[j] * a_0[j]; sa += st[4 + j] * a_1[j]; }
            sa = red8(sa);
            float y = 0.f;
#pragma unroll
            for (int j = 0; j < 4; ++j) { st[j] = st[j] * w_0[j] + sa * b_0[j] + vi * k_0[j]; st[4 + j] = st[4 + j] * w_1[j] + sa * b_1[j] + vi * k_1[j]; y += st[j] * r_0[j]; y += st[4 + j] * r_1[j]; }
            y = red8(y);
            if (c8 == 0) Y[q * 64 + si] = y;
        }
        __syncthreads();
        {
            const f32x4 yv = *(const f32x4*)(Y + tt * 64 + 4 * jg);
            const float mean = red16((yv.x + yv.y) + (yv.z + yv.w)) * (1.0f / 64.0f);
            const f32x4 dv = yv - mean;
            const float var = red16((dv.x * dv.x + dv.y * dv.y) + (dv.z * dv.z + dv.w * dv.w)) * (1.0f / 64.0f);
            const float rstd = rsqrtf(var + 64e-5f);
            const f32x4 vv = *(const f32x4*)(V + tt * 64 + 4 * jg), gg = *(const f32x4*)(G + tt * 64 + 4 * jg);
            const f32x4 o = (dv * rstd * lgv + lbv + vv * BON[tt]) * gg;
            v2u w; w.x = pk2(o.x, o.y); w.y = pk2(o.z, o.w);
            *(v2u*)(ya + t * RWW + colh) = w;
        }
        __syncthreads();
    }
}

__global__ void __launch_bounds__(512) k_norm2_route(PArgs a) {
    const int lane = threadIdx.x & 63, gw = blockIdx.x * 8 + (threadIdx.x >> 6), NGW = gridDim.x * 8;
    const float* x1 = a.out; const float* g = a.in[5]; const float* mod = (const float*)(a.ws + WS_MOD);
    const float* wrt = (const float*)(a.ws + WS_WRT); const float* brg = a.in[24]; const float* bre = a.in[26];
    bf16* h2 = (bf16*)(a.ws + WS_H2);
    int* rte = (int*)(a.ws + WS_RTE); float* rtw = (float*)(a.ws + WS_RTW); int* rnk = (int*)(a.ws + WS_RNK); unsigned* cnt = (unsigned*)(a.ws + WS_CTL) + CW_CNT;
    for (int rg = gw; rg < NT / 4; rg += NGW) {
        f32x4 hv[4][4];
#pragma unroll
        for (int rr = 0; rr < 4; ++rr) { const int m = rg * 4 + rr, b = m >> 11; const f32x4* xr = (const f32x4*)(x1 + (size_t)m * DM) + lane; float s = 0.f;
#pragma unroll
            for (int j = 0; j < 4; ++j) { hv[rr][j] = xr[64 * j]; const f32x4 v = hv[rr][j]; s += (v.x * v.x + v.y * v.y) + (v.z * v.z + v.w * v.w); }
            const float rstd = rsqrtf(wave_sum(s) * (1.0f / DM) + 1e-6f);
            v2u* o = (v2u*)(h2 + (size_t)m * DM) + lane;
#pragma unroll
            for (int j = 0; j < 4; ++j) { const int col = 4 * (lane + 64 * j);
                const f32x4 gg = *(const f32x4*)(g + col), sh = *(const f32x4*)(mod + b * 6144 + 3072 + col), scl = *(const f32x4*)(mod + b * 6144 + 4096 + col);
                const f32x4 r = hv[rr][j] * rstd * gg * (scl + 1.0f) + sh; hv[rr][j] = r; v2u w; w.x = pk2(r.x, r.y); w.y = pk2(r.z, r.w); o[64 * j] = w; } }
        float mylog[4] = {0.f, 0.f, 0.f, 0.f};
        for (int e = 0; e < 36; ++e) { float p[4] = {0.f, 0.f, 0.f, 0.f};
#pragma unroll
            for (int j = 0; j < 4; ++j) { const f32x4 w4 = *(const f32x4*)(wrt + e * 1024 + 4 * (lane + 64 * j));
#pragma unroll
                for (int rr = 0; rr < 4; ++rr) { const f32x4 v = hv[rr][j]; p[rr] += (v.x * w4.x + v.y * w4.y) + (v.z * w4.z + v.w * w4.w); } }
#pragma unroll
            for (int rr = 0; rr < 4; ++rr) { const float sm = wave_sum(p[rr]); if (lane == e) mylog[rr] = sm; } }
#pragma unroll
        for (int rr = 0; rr < 4; ++rr) { const int m = rg * 4 + rr;
            float gl4[4];
#pragma unroll
            for (int i = 0; i < 4; ++i) gl4[i] = __shfl(mylog[rr], i) + brg[i];
            int gi = 0; float gm = gl4[0];
#pragma unroll
            for (int i = 1; i < 4; ++i) if (gl4[i] > gm) { gm = gl4[i]; gi = i; }
            float gs = 0.f;
#pragma unroll
            for (int i = 0; i < 4; ++i) gs += __expf(gl4[i] - gm);
            const float pg = 1.0f / gs;
            float el[8];
#pragma unroll
            for (int k = 0; k < 8; ++k) el[k] = __shfl(mylog[rr], 4 + gi * 8 + k) + bre[gi * 8 + k];
            int e1 = 0; float m1 = el[0];
#pragma unroll
            for (int k = 1; k < 8; ++k) if (el[k] > m1) { m1 = el[k]; e1 = k; }
            int e2 = -1; float m2 = -INFINITY;
#pragma unroll
            for (int k = 0; k < 8; ++k) if (k != e1 && el[k] > m2) { m2 = el[k]; e2 = k; }
            const float q2 = __expf(m2 - m1); const float w1 = pg / (1.0f + q2), w2 = pg * q2 / (1.0f + q2);
            if (lane == 0) { const int ea = gi * 8 + e1, eb = gi * 8 + e2; rte[2 * m] = ea; rte[2 * m + 1] = eb; rtw[2 * m] = w1; rtw[2 * m + 1] = w2;
                rnk[2 * m] = (int)atomicAdd(cnt + ea, 1u); rnk[2 * m + 1] = (int)atomicAdd(cnt + eb, 1u); } }
    }
}
__global__ void __launch_bounds__(512) k_moe_gather(PArgs a) {
    __shared__ int off[NEXP];
    const int tid = threadIdx.x, lane = tid & 63, gw = blockIdx.x * 8 + (tid >> 6), NGW = gridDim.x * 8;
    int* ctl = (int*)(a.ws + WS_CTL); const unsigned* cnt = (const unsigned*)ctl + CW_CNT;
    if (tid == 0) { int o = 0, nt = 0;
        for (int e = 0; e < NEXP; ++e) { off[e] = o; const int tiles = ((int)cnt[e] + 255) >> 8;
            if (blockIdx.x == 0) for (int i = 0; i < tiles; ++i) ctl[CW_TEXP + nt + i] = e;
            nt += tiles; o += tiles * 256; }
        if (blockIdx.x == 0) ctl[CW_NT] = nt; }
    __syncthreads();
    const int* rte = (const int*)(a.ws + WS_RTE); const int* rnk = (const int*)(a.ws + WS_RNK); int* pos = (int*)(a.ws + WS_POS);
    const bf16* h2 = (const bf16*)(a.ws + WS_H2); bf16* xs = (bf16*)(a.ws + WS_XS);
    for (int i = gw; i < 2 * NT; i += NGW) { const int p = off[rte[i]] + rnk[i]; if (lane == 0) pos[i] = p;
        const v4u* src = (const v4u*)(h2 + (size_t)(i >> 1) * DM) + lane; v4u* dst = (v4u*)(xs + (size_t)p * DM) + lane;
        dst[0] = src[0]; dst[64] = src[64]; }
}
__global__ void __launch_bounds__(512) k_combine(PArgs a) {
    const int lane = threadIdx.x & 63, gw = blockIdx.x * 8 + (threadIdx.x >> 6), NGW = gridDim.x * 8;
    const float* mod = (const float*)(a.ws + WS_MOD); const int* pos = (const int*)(a.ws + WS_POS); const float* rtw = (const float*)(a.ws + WS_RTW);
    const bf16* ys = (const bf16*)(a.ws + WS_XS); float* out = a.out;
    for (int m = gw; m < NT; m += NGW) { const int b = m >> 11; const int p0 = pos[2 * m], p1 = pos[2 * m + 1]; const float w0 = rtw[2 * m], w1 = rtw[2 * m + 1];
        f32x4* o = (f32x4*)(out + (size_t)m * DM) + lane; const v2u* y0 = (const v2u*)(ys + (size_t)p0 * DM) + lane; const v2u* y1 = (const v2u*)(ys + (size_t)p1 * DM) + lane;
#pragma unroll
        for (int j = 0; j < 4; ++j) { const int col = 4 * (lane + 64 * j); const f32x4 g2 = *(const f32x4*)(mod + b * 6144 + 5120 + col); const v2u a0 = y0[64 * j], a1 = y1[64 * j];
            const f32x4 e0 = {bflo(a0.x), bfhi(a0.x), bflo(a0.y), bfhi(a0.y)}, e1 = {bflo(a1.x), bfhi(a1.x), bflo(a1.y), bfhi(a1.y)};
            o[64 * j] = o[64 * j] + g2 * (e0 * w0 + e1 * w1); } }
}

extern "C" void kernel_launch(void* const* d_in, const int* in_sizes, int n_in, void* d_out, int out_size, void* d_ws, size_t ws_size, hipStream_t stream) {
    static int grid = 0;
    if (grid == 0) {
        if (n_in != 30 || out_size != NT * DM || ws_size < WS_END) { fprintf(stderr, "kernel_launch: unexpected shapes (n_in %d, out %d, ws %zu)\n", n_in, out_size, ws_size); grid = -1; return; }
        int dev = 0, cus = 0; hipGetDevice(&dev); hipDeviceGetAttribute(&cus, hipDeviceAttributeMultiprocessorCount, dev);
        hipFuncSetAttribute((const void*)k_prep_weights, hipFuncAttributeMaxDynamicSharedMemorySize, 8 * 64 * 33 * 4);
        hipFuncSetAttribute((const void*)k_prep_experts, hipFuncAttributeMaxDynamicSharedMemorySize, 8 * 64 * 33 * 4);
        hipFuncSetAttribute((const void*)k_gemm_in, hipFuncAttributeMaxDynamicSharedMemorySize, pg8::STAGE_BYTES);
        hipFuncSetAttribute((const void*)k_gemm_bra, hipFuncAttributeMaxDynamicSharedMemorySize, pg8::STAGE_BYTES);
        hipFuncSetAttribute((const void*)k_gemm_brb, hipFuncAttributeMaxDynamicSharedMemorySize, pg8::STAGE_BYTES);
        hipFuncSetAttribute((const void*)k_gemm_out, hipFuncAttributeMaxDynamicSharedMemorySize, pg8::STAGE_BYTES);
        hipFuncSetAttribute((const void*)k_gemm_up, hipFuncAttributeMaxDynamicSharedMemorySize, pg8::STAGE_BYTES);
        hipFuncSetAttribute((const void*)k_gemm_down, hipFuncAttributeMaxDynamicSharedMemorySize, pg8::STAGE_BYTES);
        hipFuncSetAttribute((const void*)k_ada, hipFuncAttributeMaxDynamicSharedMemorySize, (16 * 1024 + 8 * 16 * 32) * 4);
        hipFuncSetAttribute((const void*)k_attn, hipFuncAttributeMaxDynamicSharedMemorySize, attn_body::ATTN_LDS_BYTES);
        hipFuncSetAttribute((const void*)k_scan, hipFuncAttributeMaxDynamicSharedMemorySize, 38944 * 4);
        (void)hipGetLastError();
        grid = cus > 0 ? cus : 256;
    }
    if (grid < 0) return;
    PArgs p{}; for (int i = 0; i < 30; ++i) p.in[i] = (const float*)d_in[i]; p.out = (float*)d_out; p.ws = (unsigned char*)d_ws;
    GemmArgs g{}; g.ws = (unsigned char*)d_ws; g.x = (const float*)d_in[0]; g.out = (float*)d_out;
    hipMemsetAsync((char*)d_ws + WS_CTL, 0, 65536, stream);
    const int TRL = 8 * 64 * 33 * 4;
    hipLaunchKernelGGL(k_prep_weights, dim3(grid), dim3(512), TRL, stream, p);
    hipLaunchKernelGGL(k_ada, dim3(192), dim3(256), (16 * 1024 + 8 * 16 * 32) * 4, stream, p);
    hipLaunchKernelGGL(k_norm1, dim3(grid * 4), dim3(512), 0, stream, p);
    hipLaunchKernelGGL(k_gemm_in, dim3(grid), dim3(512), pg8::STAGE_BYTES, stream, g);
    hipLaunchKernelGGL(k_kprep, dim3(1024), dim3(256), 0, stream, p);
    hipLaunchKernelGGL(k_qprep, dim3(1024), dim3(256), 0, stream, p);
    hipLaunchKernelGGL(k_scan, dim3(128), dim3(512), 38944 * 4, stream, p);
    hipLaunchKernelGGL(k_attn, dim3(grid), dim3(512), attn_body::ATTN_LDS_BYTES, stream, p);
    hipLaunchKernelGGL(k_gemm_bra, dim3(grid), dim3(512), pg8::STAGE_BYTES, stream, g);
    hipLaunchKernelGGL(k_gemm_brb, dim3(grid), dim3(512), pg8::STAGE_BYTES, stream, g);
    hipLaunchKernelGGL(k_gemm_out, dim3(grid), dim3(512), pg8::STAGE_BYTES, stream, g);
    hipLaunchKernelGGL(k_prep_experts, dim3(grid), dim3(512), TRL, stream, p);
    hipLaunchKernelGGL(k_norm2_route, dim3(grid * 2), dim3(512), 0, stream, p);
    hipLaunchKernelGGL(k_moe_gather, dim3(grid * 2), dim3(512), 0, stream, p);
    hipLaunchKernelGGL(k_gemm_up, dim3(grid), dim3(512), pg8::STAGE_BYTES, stream, g);
    hipLaunchKernelGGL(k_gemm_down, dim3(grid), dim3(512), pg8::STAGE_BYTES, stream, g);
    hipLaunchKernelGGL(k_combine, dim3(grid * 4), dim3(512), 0, stream, p);
}
```

```cpp
#include <hip/hip_runtime.h>
#include <cstdio>
#include <cstdint>
__device__ __forceinline__ int ltid() { int t = threadIdx.x; asm volatile("" : "+v"(t)); return t; }
namespace pg8 {
#define PG8_LAS __attribute__((address_space(3)))
typedef unsigned short bf16_t;
typedef short bf16x8 __attribute__((ext_vector_type(8)));
typedef float f32x4 __attribute__((ext_vector_type(4)));
typedef unsigned u32x4 __attribute__((ext_vector_type(4)));
constexpr int BM = 256, BK = 64, HALF = 128, HTB = HALF * BK * 2  , STAGE_BYTES = 8 * HTB, NXCD = 8, WGM = 8;

__host__ __device__ __forceinline__ int lds_byte(int r, int c) { const int st = (r >> 4) * 2 + (c >> 5), rr = r & 15, cc = c & 31, ob = rr * 64 + cc * 2; return st * 1024 + (ob ^ (((ob >> 9) & 1) << 5)); }
__host__ __device__ __forceinline__ void stage_rc(int b, int& R, int& C) { const int st = b / 1024, sb = b % 1024, swz = sb ^ (((sb >> 9) & 1) << 5); R = (st >> 1) * 16 + swz / 64; C = (st & 1) * 32 + (swz % 64) / 2; }
__host__ __device__ __forceinline__ int perm32(int rho) { const int n = rho >> 4, i = rho & 15; return 8 * (i >> 2) + 4 * n + (i & 3); }
struct Unit { int pm, pn; const char* a; const char* b; };
struct Gemm { int K; };

struct StaticOrder {
    int nM, nN, nwg, G, c; const char* A; const char* Bt; size_t tstep;
    __device__ void init(const void* A_, const void* Bt_, int M, int N, int K, int G_, int c_) { nM = M / BM; nN = N / BM; nwg = nM * nN; G = G_; c = c_; A = (const char*)A_; Bt = (const char*)Bt_; tstep = (size_t)BM * K * 2; }
    __device__ bool next(int i, Unit& u) const {
        const long L = (long)i * G + c; if (L >= nwg) return false;
        int wgid = (int)L; { const int q = nwg / NXCD, r = nwg % NXCD, xcd = wgid % NXCD, off = wgid / NXCD; wgid = (xcd < r ? xcd * (q + 1) : r * (q + 1) + (xcd - r) * q) + off; }
        const int nig = WGM * nN, gid = wgid / nig, fm = gid * WGM, gsz = (nM - fm) < WGM ? (nM - fm) : WGM;
        u.pm = fm + ((wgid % nig) % gsz); u.pn = (wgid % nig) / gsz; u.a = A + (size_t)u.pm * tstep; u.b = Bt + (size_t)u.pn * tstep; return true;
    }
    __device__ __forceinline__ void a_ready(const Unit&) const {}
    __device__ __forceinline__ void done(const Unit&) const {}
};
__device__ __forceinline__ unsigned cvt_pk_bf16(float lo, float hi) { unsigned r; asm volatile("v_cvt_pk_bf16_f32 %0, %1, %2" : "=v"(r) : "v"(lo), "v"(hi)); return r; }
template <class Epi, class Sched, bool ALIGN_EPI = false, bool SP2 = false>
__device__ __forceinline__ void gemm_phase(PG8_LAS unsigned char* lds, const Gemm g, const Sched& S, const Epi& E) {
    const int tid = ltid(), wid = __builtin_amdgcn_readfirstlane(tid >> 6), lane = tid & 63, wr = wid >> 2, wc = wid & 3, fr = lane & 15, fq = lane >> 4;
    const int K = g.K, nt = K / BK;
    unsigned voffA[2], voffB[2];
#pragma unroll
    for (int i = 0; i < 2; ++i) { int R, C; stage_rc(tid * 16 + i * 8192, R, C); const int Rb = Epi::PERM ? ((R & ~31) + perm32(R & 31)) : R;
        voffA[i] = (unsigned)(R * K + C) * 2u; voffB[i] = (unsigned)(Rb * K + C) * 2u; }
    const size_t kstep = (size_t)(BK * 2);
    const size_t hstep = (size_t)HALF * K * 2;
        const unsigned ldsw = (unsigned)wid * 1024u;
    const int aoff = lds_byte(wr * 64 + fr, fq * 8), boff = lds_byte(wc * 32 + fr, fq * 8);
#define PG8_SA(b, h) (((b) * 2 + (h)) * HTB)
#define PG8_SB(b, h) ((4 + (b) * 2 + (h)) * HTB)
#define PG8_STAGE(bufoff, gbase, voff) do { _Pragma("unroll") for (int _i = 0; _i < 2; ++_i) \
        __builtin_amdgcn_global_load_lds((const unsigned*)((const char*)(gbase) + (voff)[_i]), (PG8_LAS unsigned*)(lds + (bufoff) + ldsw + _i * 8192), 16, 0, 0); } while (0)
#define PG8_LDA(dst, b, h) do { _Pragma("unroll") for (int m = 0; m < 4; ++m) _Pragma("unroll") for (int k = 0; k < 2; ++k) dst[m][k] = *(const PG8_LAS bf16x8*)(lds + PG8_SA(b, h) + aoff + m * 2048 + k * 1024); } while (0)
#define PG8_LDB(dst, b, h) do { _Pragma("unroll") for (int n = 0; n < 2; ++n) _Pragma("unroll") for (int k = 0; k < 2; ++k) dst[n][k] = *(const PG8_LAS bf16x8*)(lds + PG8_SB(b, h) + boff + n * 2048 + k * 1024); } while (0)
#define PG8_MMA(ai, bj, At, Bt) do { __builtin_amdgcn_s_setprio(1); _Pragma("unroll") for (int m = 0; m < 4; ++m) _Pragma("unroll") for (int n = 0; n < 2; ++n) _Pragma("unroll") for (int k = 0; k < 2; ++k) \
        acc[ai][bj][m][n] = __builtin_amdgcn_mfma_f32_16x16x32_bf16(Bt[n][k], At[m][k], acc[ai][bj][m][n], 0, 0, 0); __builtin_amdgcn_s_setprio(0); } while (0)
#define PG8_WAIT_V(n) asm volatile("s_waitcnt vmcnt(" #n ")" ::: "memory")
#define PG8_WAIT_L(n) asm volatile("s_waitcnt lgkmcnt(" #n ")" ::: "memory")
#define PG8_BAR __builtin_amdgcn_s_barrier()
#define PG8_SCHED __builtin_amdgcn_sched_barrier(0)
    Unit cur, nxt; int ui = 0;
    if (!S.next(0, cur)) return;
    f32x4 acc[2][2][4][2];
#pragma unroll
    for (int a = 0; a < 2; ++a)
#pragma unroll
        for (int b = 0; b < 2; ++b)
#pragma unroll
            for (int m = 0; m < 4; ++m)
#pragma unroll
                for (int n = 0; n < 2; ++n) acc[a][b][m][n] = (f32x4){0.f, 0.f, 0.f, 0.f};
    bf16x8 At[4][2], B0[2][2], B1[2][2];
    const char* cA = cur.a; const char* cB = cur.b;
    S.a_ready(cur);
    if constexpr (SP2) {
        PG8_STAGE(PG8_SB(0, 0), cB, voffB); PG8_STAGE(PG8_SB(0, 1), cB + hstep, voffB); PG8_STAGE(PG8_SA(0, 0), cA, voffA); PG8_STAGE(PG8_SA(0, 1), cA + hstep, voffA);
        if (wr == 1) PG8_BAR;
        PG8_WAIT_V(2); PG8_BAR;
        PG8_STAGE(PG8_SB(1, 0), cB + kstep, voffB); PG8_STAGE(PG8_SA(1, 0), cA + kstep, voffA); PG8_STAGE(PG8_SB(1, 1), cB + hstep + kstep, voffB);
        PG8_WAIT_V(6); PG8_BAR;
    } else {
        PG8_STAGE(PG8_SB(0, 0), cB, voffB); PG8_STAGE(PG8_SA(0, 0), cA, voffA); PG8_STAGE(PG8_SB(0, 1), cB + hstep, voffB); PG8_STAGE(PG8_SA(0, 1), cA + hstep, voffA);
        if (wr == 1) PG8_BAR;
        PG8_WAIT_V(4); PG8_BAR;
        PG8_STAGE(PG8_SB(1, 0), cB + kstep, voffB); PG8_STAGE(PG8_SA(1, 0), cA + kstep, voffA); PG8_STAGE(PG8_SB(1, 1), cB + hstep + kstep, voffB);
        PG8_WAIT_V(6); PG8_BAR;
    }
    for (;;) {
        const bool has_next = S.next(ui + 1, nxt);
        const char* nA = has_next ? nxt.a : cA; const char* nB = has_next ? nxt.b : cB;
        for (int t = 0; t < nt; t += 2) {
            const bool last = (t == nt - 2);
            const char* a1 = cA + (size_t)(t + 1) * kstep;
            const char* a2 = last ? nA : cA + (size_t)(t + 2) * kstep; const char* b2 = last ? nB : cB + (size_t)(t + 2) * kstep;
            const char* a3 = a2 + kstep; const char* b3 = b2 + kstep;
            if (last && has_next) S.a_ready(nxt);
            if constexpr (SP2) {
            PG8_LDB(B0, 0, 0); PG8_LDB(B1, 0, 1); PG8_SCHED; PG8_LDA(At, 0, 0); PG8_STAGE(PG8_SA(1, 1), a1 + hstep, voffA);
            PG8_WAIT_V(8); PG8_WAIT_L(0); PG8_BAR; PG8_MMA(0, 0, At, B0); PG8_MMA(0, 1, At, B1); PG8_BAR; PG8_SCHED;
            PG8_LDA(At, 0, 1); PG8_STAGE(PG8_SB(0, 0), b2, voffB); PG8_STAGE(PG8_SB(0, 1), b2 + hstep, voffB); PG8_STAGE(PG8_SA(0, 0), a2, voffA);
            PG8_WAIT_V(8); PG8_WAIT_L(0); PG8_BAR; PG8_MMA(1, 0, At, B0); PG8_MMA(1, 1, At, B1); PG8_BAR; PG8_SCHED;
            PG8_LDB(B0, 1, 0); PG8_LDB(B1, 1, 1); PG8_SCHED; PG8_LDA(At, 1, 0); PG8_STAGE(PG8_SA(0, 1), a2 + hstep, voffA);
            PG8_WAIT_V(8); PG8_WAIT_L(0); PG8_BAR; PG8_MMA(0, 0, At, B0); PG8_MMA(0, 1, At, B1); PG8_BAR; PG8_SCHED;
            PG8_LDA(At, 1, 1); PG8_STAGE(PG8_SB(1, 0), b3, voffB); PG8_STAGE(PG8_SB(1, 1), b3 + hstep, voffB); PG8_STAGE(PG8_SA(1, 0), a3, voffA);
            PG8_WAIT_V(8); PG8_WAIT_L(0); PG8_BAR; PG8_MMA(1, 0, At, B0); PG8_MMA(1, 1, At, B1); PG8_BAR; PG8_SCHED;
            } else {
            PG8_LDB(B0, 0, 0); PG8_SCHED; PG8_LDA(At, 0, 0); PG8_STAGE(PG8_SA(1, 1), a1 + hstep, voffA);
            PG8_WAIT_L(8); PG8_BAR; PG8_WAIT_L(0); PG8_MMA(0, 0, At, B0); PG8_BAR; PG8_SCHED;
            PG8_LDB(B1, 0, 1); PG8_STAGE(PG8_SB(0, 0), b2, voffB);
            PG8_BAR; PG8_WAIT_L(0); PG8_MMA(0, 1, At, B1); PG8_BAR;
            PG8_LDA(At, 0, 1); PG8_STAGE(PG8_SA(0, 0), a2, voffA);
            PG8_BAR; PG8_WAIT_L(0); PG8_MMA(1, 0, At, B0); PG8_BAR; PG8_SCHED;
            PG8_STAGE(PG8_SB(0, 1), b2 + hstep, voffB);
            PG8_WAIT_V(6); PG8_BAR; PG8_MMA(1, 1, At, B1); PG8_BAR;
            PG8_LDB(B0, 1, 0); PG8_SCHED; PG8_LDA(At, 1, 0); PG8_STAGE(PG8_SA(0, 1), a2 + hstep, voffA);
            PG8_WAIT_L(8); PG8_BAR; PG8_WAIT_L(0); PG8_MMA(0, 0, At, B0); PG8_BAR; PG8_SCHED;
            PG8_LDB(B1, 1, 1); PG8_STAGE(PG8_SB(1, 0), b3, voffB);
            PG8_BAR; PG8_WAIT_L(0); PG8_MMA(0, 1, At, B1); PG8_BAR;
            PG8_LDA(At, 1, 1); PG8_STAGE(PG8_SA(1, 0), a3, voffA);
            PG8_BAR; PG8_WAIT_L(0); PG8_MMA(1, 0, At, B0); PG8_BAR; PG8_SCHED;
            PG8_STAGE(PG8_SB(1, 1), b3 + hstep, voffB);
            PG8_WAIT_V(6); PG8_BAR; PG8_MMA(1, 1, At, B1); PG8_BAR;
            }
        }
        if constexpr (ALIGN_EPI) { if (wr == 0) PG8_BAR; }
        if constexpr (!Epi::AFTER_DRAIN) { E(acc, cur, wr, wc, fr, fq); S.done(cur); }
        if (!has_next) break;
#pragma unroll
        for (int a = 0; a < 2; ++a)
#pragma unroll
            for (int b = 0; b < 2; ++b)
#pragma unroll
                for (int m = 0; m < 4; ++m)
#pragma unroll
                    for (int n = 0; n < 2; ++n) acc[a][b][m][n] = (f32x4){0.f, 0.f, 0.f, 0.f};
        cur = nxt; cA = nA; cB = nB; ++ui;
        if constexpr (ALIGN_EPI) { if (wr == 1) PG8_BAR; }
    }
    PG8_WAIT_V(0);
    if constexpr (!ALIGN_EPI) { if (wr == 0) PG8_BAR; }
    PG8_BAR;
    if constexpr (Epi::AFTER_DRAIN) { E.fused(acc, cur, wr, wc, fr, fq, lds, wid, lane); S.done(cur); }
#undef PG8_SA
#undef PG8_SB
#undef PG8_STAGE
#undef PG8_LDA
#undef PG8_LDB
#undef PG8_MMA
#undef PG8_WAIT_V
#undef PG8_WAIT_L
#undef PG8_BAR
#undef PG8_SCHED
}
}
#include <hip/hip_bf16.h>
#include <cmath>
namespace attn_body {
using bf16=__hip_bfloat16;
using bf16x8=__attribute__((ext_vector_type(8)))short;
using s16x4=__attribute__((ext_vector_type(4)))short;
using f32x16=__attribute__((ext_vector_type(16)))float;
using u32x4=__attribute__((ext_vector_type(4)))unsigned;
constexpr int NHEAD=8,SEQ=2048,D=64,PQ=512,PK=512,PV=5376,PO=512;
constexpr int NW=8,QBLK=32,QB=QBLK*NW,KVBLK=64,NQB=SEQ/QB;
__device__ __forceinline__ int crow(int r,int hi){return (r&3)+8*(r>>2)+4*hi;}
#define SBAR() __builtin_amdgcn_sched_barrier(0)
__device__ __forceinline__ void cmask(f32x16&p0,f32x16&p1,int jb,int qrel,int hi){
  const float NEG=-INFINITY; int kb=64*jb+4*hi;
  #pragma unroll
  for(int r=0;r<16;++r){int kv=kb+(r&3)+8*(r>>2); if(kv>qrel)p0[r]=NEG; if(kv+32>qrel)p1[r]=NEG;}
}

constexpr int NSLOT=3, SLOTB=8192;
constexpr int LDS_K=0, LDS_V=NSLOT*SLOTB, LDS_WS=2*NSLOT*SLOTB, LDS_OST=LDS_WS+NW*64*4, LDS_BYTES=LDS_OST+NW*4096;
constexpr float C2=0.125f*1.4426950408889634f;
__device__ __forceinline__ void glds16(const void*gsrc,unsigned lds_dst){unsigned keep;
  asm volatile("s_mov_b32 %0, m0\n\ts_mov_b32 m0, %2\n\ts_nop 0\n\tglobal_load_lds_dwordx4 %1, off\n\ts_mov_b32 m0, %0":"=&s"(keep):"v"(gsrc),"s"(lds_dst):"memory");}
__device__ __forceinline__ float max3f(float a,float b,float c){float r;asm("v_max3_f32 %0, %1, %2, %3":"=v"(r):"v"(a),"v"(b),"v"(c));return r;}
__device__ __forceinline__ float max2f(float a,float b){float r;asm("v_max_f32_e32 %0, %1, %2":"=v"(r):"v"(a),"v"(b));return r;}
__device__ __forceinline__ float fadd_s(float a,float b){float r;asm("v_add_f32_e32 %0, %1, %2":"=v"(r):"v"(a),"v"(b));return r;}
__device__ __forceinline__ float fsub_s(float a,float b){float r;asm("v_sub_f32_e32 %0, %1, %2":"=v"(r):"v"(a),"v"(b));return r;}
typedef float f32x2_t __attribute__((ext_vector_type(2))); typedef __bf16 bf16x2_t __attribute__((ext_vector_type(2)));
__device__ __forceinline__ unsigned cvtpk_s(float lo,float hi){f32x2_t v={lo,hi};bf16x2_t b=__builtin_convertvector(v,bf16x2_t);return __builtin_bit_cast(unsigned,b);}
#define WAIT_BAR(N) asm volatile("s_waitcnt vmcnt(" #N ") lgkmcnt(0)\n\ts_barrier":::"memory")

__device__ __forceinline__ void qkt(f32x16&p0,f32x16&p1,const char*Kslot,const bf16x8*qr,const f32x16&negm,int r32,int hi){
  const char*kb=Kslot+hi*1024+r32*16;
  #pragma unroll
  for(int d0=0;d0<4;++d0){
    const bf16x8 b0=*reinterpret_cast<const bf16x8*>(kb+d0*2048);
    const bf16x8 b1=*reinterpret_cast<const bf16x8*>(kb+d0*2048+512);
    if(d0==0){p0=__builtin_amdgcn_mfma_f32_32x32x16_bf16(b0,qr[0],negm,0,0,0);p1=__builtin_amdgcn_mfma_f32_32x32x16_bf16(b1,qr[0],negm,0,0,0);}
    else{p0=__builtin_amdgcn_mfma_f32_32x32x16_bf16(b0,qr[d0],p0,0,0,0);p1=__builtin_amdgcn_mfma_f32_32x32x16_bf16(b1,qr[d0],p1,0,0,0);}}
}
typedef __attribute__((address_space(3))) const char* lds_cptr;
typedef short v4i16_t __attribute__((ext_vector_type(4)));
__device__ __forceinline__ void kload8(bf16x8*kf,lds_cptr kp){
  kf[0]=*(const __attribute__((address_space(3))) bf16x8*)(kp);      kf[1]=*(const __attribute__((address_space(3))) bf16x8*)(kp+512);
  kf[2]=*(const __attribute__((address_space(3))) bf16x8*)(kp+2048); kf[3]=*(const __attribute__((address_space(3))) bf16x8*)(kp+2560);
  kf[4]=*(const __attribute__((address_space(3))) bf16x8*)(kp+4096); kf[5]=*(const __attribute__((address_space(3))) bf16x8*)(kp+4608);
  kf[6]=*(const __attribute__((address_space(3))) bf16x8*)(kp+6144); kf[7]=*(const __attribute__((address_space(3))) bf16x8*)(kp+6656);
}
__device__ __forceinline__ void kload2(bf16x8*kf,lds_cptr kp,int j){ kf[2*j]=*(const __attribute__((address_space(3))) bf16x8*)(kp+j*2048); kf[2*j+1]=*(const __attribute__((address_space(3))) bf16x8*)(kp+j*2048+512); }
__device__ __forceinline__ s16x4 vtr(lds_cptr p){ return __builtin_bit_cast(s16x4,__builtin_amdgcn_ds_read_tr16_b64_v4i16((__attribute__((address_space(3))) v4i16_t*)p)); }
__device__ __forceinline__ float rowmax(const f32x16&p0,const f32x16&p1){
  float a=max3f(p0[0],p0[1],p1[0]),b=max3f(p0[2],p0[3],p1[1]);a=max3f(a,p1[2],p1[3]);
  #pragma unroll
  for(int r=4;r<16;r+=4){a=max3f(a,p0[r],p0[r+1]);b=max3f(b,p0[r+2],p0[r+3]);a=max3f(a,p1[r],p1[r+1]);b=max3f(b,p1[r+2],p1[r+3]);}
  const float m=max2f(a,b);
  auto rr=__builtin_amdgcn_permlane32_swap(__float_as_uint(m),__float_as_uint(m),false,false);
  return max2f(__uint_as_float(rr[0]),__uint_as_float(rr[1]));
}
__device__ __forceinline__ void pv(f32x16*o,int vb,bf16x8 pa0,bf16x8 pa1,bf16x8 pa2,bf16x8 pa3){
  #pragma unroll
  for(int d0=0;d0<2;++d0){s16x4 lo[4],hi[4];
    #pragma unroll
    for(int ks=0;ks<4;++ks){
      asm volatile("ds_read_b64_tr_b16 %0,%1 offset:%c2":"=&v"(lo[ks]):"v"(vb),"i"(d0*4096+ks*1024):"memory");
      asm volatile("ds_read_b64_tr_b16 %0,%1 offset:%c2":"=&v"(hi[ks]):"v"(vb),"i"(d0*4096+ks*1024+512):"memory");}
    asm volatile("s_waitcnt lgkmcnt(0)":::"memory");SBAR();
    #define PK(k) (bf16x8){lo[k][0],lo[k][1],lo[k][2],lo[k][3],hi[k][0],hi[k][1],hi[k][2],hi[k][3]}
    o[d0]=__builtin_amdgcn_mfma_f32_32x32x16_bf16(pa0,PK(0),o[d0],0,0,0);
    o[d0]=__builtin_amdgcn_mfma_f32_32x32x16_bf16(pa1,PK(1),o[d0],0,0,0);
    o[d0]=__builtin_amdgcn_mfma_f32_32x32x16_bf16(pa2,PK(2),o[d0],0,0,0);
    o[d0]=__builtin_amdgcn_mfma_f32_32x32x16_bf16(pa3,PK(3),o[d0],0,0,0);
    #undef PK
  }
}

#ifndef ATTN_STORE16
#define ATTN_STORE16(p,v) (*(u32x4*)(p)=(v))
#endif
template<int THRL> __device__ __forceinline__ void attn_unit(int b,int h,int qb,const bf16*Q,const bf16*__restrict__ K,const bf16*__restrict__ V,bf16*O,const unsigned char*__restrict__ SEL,char*shm){
  int tid_=threadIdx.x; asm volatile("":"+v"(tid_)); const int tid=tid_,lane=tid&63,r32=lane&31,hi=lane>>5;     const int wid=__builtin_amdgcn_readfirstlane(tid>>6);
  const long rowbase=(long)b*SEQ; const int q0=qb*QB;
  const bf16*Qw=Q+(rowbase+q0+wid*QBLK)*PQ+h*D;
  const bf16*Kh=K+rowbase*PK+h*D,*Vh=V+rowbase*PV+h*D;
  const unsigned lds0=(unsigned)(uintptr_t)shm;
  float*wsf=(float*)(shm+LDS_WS)+wid*64;
  const bf16*ksrc=Kh+(long)lane*PK+wid*8;
  const bf16*vsrc=Vh+(long)(16*(wid&3)+(lane>>2))*PV+(wid>>2)*32+(lane&3)*8;
  const unsigned kdst=lds0+LDS_K+wid*1024, vdst=lds0+LDS_V+wid*1024;
  #define TROW(t) ((long)(((t)<4)?(q0+(t)*KVBLK):(((t)-4)*KVBLK)))
  #define DMA_K(t,slot) glds16(ksrc+TROW(t)*PK,(unsigned)__builtin_amdgcn_readfirstlane(kdst+(slot)))
  #define DMA_V(t,slot) glds16(vsrc+TROW(t)*PV,(unsigned)__builtin_amdgcn_readfirstlane(vdst+(slot)))
  const int vb0=(int)(lds0+LDS_V)+((lane>>4)&1)*32+(lane&3)*8+(4*hi+((lane&15)>>2))*64;
  const char*Kbase=shm+LDS_K; bf16x8 kf[8];
  const lds_cptr shm3=(lds_cptr)shm; const lds_cptr kp0=shm3+LDS_K+hi*1024+r32*16; const lds_cptr vp0=shm3+LDS_V+((lane>>4)&1)*32+(lane&3)*8+(4*hi+((lane&15)>>2))*64;
  const int NT=(q0+QB)/KVBLK;
  DMA_K(0,0);DMA_V(0,0);DMA_K(1,SLOTB);
  bf16x8 qr[4];
  #pragma unroll
  for(int d0=0;d0<4;++d0)qr[d0]=*reinterpret_cast<const bf16x8*>(&Qw[(long)r32*PQ+d0*16+hi*8]);
  float mhat=0.f,l_reg=0.f;f32x16 o[2];o[0]=f32x16{};o[1]=f32x16{};
  const int qrel=wid*QBLK+r32;
  const unsigned selb=(unsigned)SEL[((long)(b*NHEAD+h))*SEQ+q0+qrel];
  #define CMASK(P0,P1,t) cmask(P0,P1,(t),qrel,hi)
  #define SUBREF(C0,C1,t) do{ const float sb_=(((t)<4)||((selb>>(((t)-4)>>2))&1u))?mhat:INFINITY; _Pragma("unroll") for(int r_=0;r_<16;++r_){C0[r_]-=sb_;C1[r_]-=sb_;} }while(0)
  bool resc=false;
  #define START(P0,P1) do{ const float rm=rowmax(P0,P1); resc=false; \
    { const float dl=rm; mhat=fadd_s(mhat,dl); \
      _Pragma("unroll") for(int r=0;r<16;++r){P0[r]=fsub_s(P0[r],dl);P1[r]=fsub_s(P1[r],dl);} \
      } \
    _Pragma("unroll") for(int r=0;r<16;++r)P0[r]=__builtin_amdgcn_exp2f(P0[r]); }while(0)
  #define RESC() do{ if(resc){ asm volatile("s_waitcnt lgkmcnt(0)":::"memory"); \
      _Pragma("unroll") for(int d_=0;d_<2;++d_) _Pragma("unroll") for(int r=0;r<16;++r)o[d_][r]*=wsf[crow(r,hi)]; } }while(0)
  f32x16 pA0,pA1,pB0,pB1;
  int sl_prev=0,sl_cur=0,sl_next=SLOTB;
  #define ROT() do{sl_prev=sl_cur;sl_cur=sl_next;sl_next=(sl_next==(NSLOT-1)*SLOTB)?0:sl_next+SLOTB;}while(0)
  DMA_K(2,2*SLOTB);
  WAIT_BAR(3);
  qkt(pA0,pA1,Kbase,qr,f32x16{},r32,hi);asm volatile("s_nop 15\n\ts_nop 7":"+v"(pA0),"+v"(pA1));CMASK(pA0,pA1,0);
  START(pA0,pA1);
  _Pragma("unroll") for(int r=0;r<16;++r)pA1[r]=__builtin_amdgcn_exp2f(pA1[r]);
  WAIT_BAR(0);
  DMA_K(3,0);DMA_V(1,SLOTB);
  ROT();
  kload8(kf,kp0+sl_cur);
  WAIT_BAR(2);
  s16x4 vlo[8],vhi[8]; u32x4 pw0,pw1,pw2,pw3;
  #define PKW(P,B) cvtpk_s(P[B],P[B+1])
  #define PAF(k) __builtin_bit_cast(bf16x8,pw##k)
  #define VFR(i) (bf16x8){vlo[i][0],vlo[i][1],vlo[i][2],vlo[i][3],vhi[i][0],vhi[i][1],vhi[i][2],vhi[i][3]}
  #define PIN(x) asm volatile("":"+v"(x))
  #define MX3(a,b,c) __builtin_fmaxf(__builtin_fmaxf((a),(b)),(c))
  #define GAPA(MF,A0,A1,A2,A3,W0,W1,PW) do{ MF; sacc+=A0; sacc+=A1; sacc+=A2; sacc+=A3; PIN(sacc); W0; W1; PIN(PW); SBAR(); }while(0)
  #define EX(v) __builtin_amdgcn_exp2f(v)
  #define GAPB(MF,X,B) do{ MF; X[B]=EX(X[B]); X[B+1]=EX(X[B+1]); X[B+2]=EX(X[B+2]); X[B+3]=EX(X[B+3]); PIN(X); SBAR(); }while(0)
  #define VRD(i) do{ vlo[i]=vtr(vp_+(((i)>>2)*4096+((i)&3)*1024)); vhi[i]=vtr(vp_+(((i)>>2)*4096+((i)&3)*1024+512)); }while(0)
  #define KRD(G,j) do{ if(G){ kload2(kf,kp0+sl_next,j); SBAR(); } }while(0)
  #define STEP(C0,C1,P0,P1,t,GK,GV,GL,MB) do{ SBAR(); \
    const lds_cptr vp_=vp0+sl_prev; \
    VRD(0); SBAR(); float sacc=(P0[0]+P0[1]); \
    GAPA(C0=__builtin_amdgcn_mfma_f32_32x32x16_bf16(kf[0],qr[0],f32x16{},0,0,0), P0[2],P0[3],P0[4],P0[5],     pw0[0]=PKW(P0,0), pw0[1]=PKW(P0,2), pw0); \
    VRD(4); SBAR(); GAPA(C1=__builtin_amdgcn_mfma_f32_32x32x16_bf16(kf[1],qr[0],f32x16{},0,0,0), P0[6],P0[7],P0[8],P0[9],     pw0[2]=PKW(P0,4), pw0[3]=PKW(P0,6), pw0); \
    VRD(1); SBAR(); GAPA(C0=__builtin_amdgcn_mfma_f32_32x32x16_bf16(kf[2],qr[1],C0,0,0,0),   P0[10],P0[11],P0[12],P0[13], pw1[0]=PKW(P0,8), pw1[1]=PKW(P0,10), pw1); \
    VRD(5); SBAR(); GAPA(C1=__builtin_amdgcn_mfma_f32_32x32x16_bf16(kf[3],qr[1],C1,0,0,0),   P0[14],P0[15],P1[0],P1[1],   pw1[2]=PKW(P0,12),pw1[3]=PKW(P0,14), pw1); \
    VRD(2); SBAR(); GAPA(C0=__builtin_amdgcn_mfma_f32_32x32x16_bf16(kf[4],qr[2],C0,0,0,0),   P1[2],P1[3],P1[4],P1[5],     pw2[0]=PKW(P1,0), pw2[1]=PKW(P1,2), pw2); \
    VRD(6); SBAR(); GAPA(C1=__builtin_amdgcn_mfma_f32_32x32x16_bf16(kf[5],qr[2],C1,0,0,0),   P1[6],P1[7],P1[8],P1[9],     pw2[2]=PKW(P1,4), pw2[3]=PKW(P1,6), pw2); \
    VRD(3); SBAR(); GAPA(C0=__builtin_amdgcn_mfma_f32_32x32x16_bf16(kf[6],qr[3],C0,0,0,0),   P1[10],P1[11],P1[12],P1[13], pw3[0]=PKW(P1,8), pw3[1]=PKW(P1,10), pw3); \
    VRD(7); SBAR(); GAPA(C1=__builtin_amdgcn_mfma_f32_32x32x16_bf16(kf[7],qr[3],C1,0,0,0),   P1[14],P1[15],0.f,0.f,       pw3[2]=PKW(P1,12),pw3[3]=PKW(P1,14), pw3); \
    l_reg+=sacc; \
    if(GK){DMA_K((t)+3,sl_cur);} if(GV){DMA_V((t)+1,sl_next);} \
    SUBREF(C0,C1,t); if(MB){CMASK(C0,C1,t);} \
    { float a=MX3(C0[0],C0[1],C1[0]),b=MX3(C0[2],C0[3],C1[1]); a=MX3(a,C1[2],C1[3]); \
      _Pragma("unroll") for(int r=4;r<16;r+=4){a=MX3(a,C0[r],C0[r+1]);b=MX3(b,C0[r+2],C0[r+3]);a=MX3(a,C1[r],C1[r+1]);b=MX3(b,C1[r+2],C1[r+3]);} \
      float rm=__builtin_fmaxf(a,b); { auto rr=__builtin_amdgcn_permlane32_swap(__float_as_uint(rm),__float_as_uint(rm),false,false); rm=__builtin_fmaxf(__uint_as_float(rr[0]),__uint_as_float(rr[1])); } \
      resc=false; \
      if(__builtin_expect(__any(rm>(float)THRL),0)){ const float dl=__builtin_fmaxf(rm,0.f); mhat+=dl; \
        _Pragma("unroll") for(int r=0;r<16;++r){C0[r]-=dl;C1[r]-=dl;} \
        const float f=__builtin_amdgcn_exp2f(-dl); l_reg*=f; if(hi==0)wsf[r32]=f; resc=true; } } \
    SBAR(); \
    GAPB(o[0]=__builtin_amdgcn_mfma_f32_32x32x16_bf16(PAF(0),VFR(0),o[0],0,0,0), C0,0); \
    GAPB(o[1]=__builtin_amdgcn_mfma_f32_32x32x16_bf16(PAF(0),VFR(4),o[1],0,0,0), C0,4); \
    KRD(GL,0); GAPB(o[0]=__builtin_amdgcn_mfma_f32_32x32x16_bf16(PAF(1),VFR(1),o[0],0,0,0), C0,8); \
    KRD(GL,1); GAPB(o[1]=__builtin_amdgcn_mfma_f32_32x32x16_bf16(PAF(1),VFR(5),o[1],0,0,0), C0,12); \
    KRD(GL,2); GAPB(o[0]=__builtin_amdgcn_mfma_f32_32x32x16_bf16(PAF(2),VFR(2),o[0],0,0,0), C1,0); \
    KRD(GL,3); GAPB(o[1]=__builtin_amdgcn_mfma_f32_32x32x16_bf16(PAF(2),VFR(6),o[1],0,0,0), C1,4); \
    GAPB(o[0]=__builtin_amdgcn_mfma_f32_32x32x16_bf16(PAF(3),VFR(3),o[0],0,0,0), C1,8); \
    GAPB(o[1]=__builtin_amdgcn_mfma_f32_32x32x16_bf16(PAF(3),VFR(7),o[1],0,0,0), C1,12); \
    }while(0)
  #define ENDW(tt) do{ if((tt)+3<NT){WAIT_BAR(2);} else if((tt)+2<NT){WAIT_BAR(1);} else {WAIT_BAR(0);} }while(0)
  { int t=1;
    for(;t+1<NT;t+=2){
      STEP(pB0,pB1,pA0,pA1,t,(t+3<NT),(t+1<NT),(t+1<NT),(t<4));       ENDW(t);   RESC(); ROT();
      STEP(pA0,pA1,pB0,pB1,t+1,(t+4<NT),(t+2<NT),(t+2<NT),(t+1<4));     ENDW(t+1); RESC(); ROT();
    }
    STEP(pB0,pB1,pA0,pA1,NT-1,false,false,false,(NT==4)); RESC();
  }
  { float sacc=pB0[0]+pB0[1]; _Pragma("unroll") for(int r=2;r<16;++r)sacc+=pB0[r]; _Pragma("unroll") for(int r=0;r<16;++r)sacc+=pB1[r]; l_reg+=sacc;
    pw0=(u32x4){PKW(pB0,0),PKW(pB0,2),PKW(pB0,4),PKW(pB0,6)};pw1=(u32x4){PKW(pB0,8),PKW(pB0,10),PKW(pB0,12),PKW(pB0,14)};pw2=(u32x4){PKW(pB1,0),PKW(pB1,2),PKW(pB1,4),PKW(pB1,6)};pw3=(u32x4){PKW(pB1,8),PKW(pB1,10),PKW(pB1,12),PKW(pB1,14)};
    SBAR(); pv(o,vb0+sl_cur,PAF(0),PAF(1),PAF(2),PAF(3)); }
  #undef PKW
  #undef PAF
  #undef VFR
  #undef PIN
  #undef MX3
  #undef GAPA
  #undef GAPB
  #undef EX
  #undef VRD
  #undef KRD
  #undef STEP
  #undef ENDW
  {auto rr=__builtin_amdgcn_permlane32_swap(__float_as_uint(l_reg),__float_as_uint(l_reg),false,false);l_reg=__uint_as_float(rr[0])+__uint_as_float(rr[1]);}
  if(hi==0)wsf[32+r32]=l_reg;asm volatile("s_waitcnt lgkmcnt(0)":::"memory");
  float rli[16];
  #pragma unroll
  for(int r=0;r<16;++r)rli[r]=__builtin_amdgcn_rcpf(wsf[32+crow(r,hi)]);
  bf16*Ow=O+(rowbase+q0+wid*QBLK)*PO+h*D;
  { bf16*stg=(bf16*)(shm+LDS_OST)+wid*2048;
    #pragma unroll
    for(int r=0;r<16;++r){const int orow=crow(r,hi);
      #pragma unroll
      for(int d0=0;d0<2;++d0)stg[orow*64+d0*32+r32]=__float2bfloat16(o[d0][r]*rli[r]);}
    asm volatile("s_waitcnt lgkmcnt(0)":::"memory");
    #pragma unroll
    for(int i=0;i<4;++i){const int row=i*8+(lane>>3),ch=lane&7; const u32x4 v=*(const u32x4*)(stg+row*64+ch*8); ATTN_STORE16(Ow+(long)row*PO+ch*8,v);} }
  asm volatile("s_waitcnt lgkmcnt(0)\n\ts_barrier":::"memory");
  #undef DMA_K
  #undef TROW
  #undef SUBREF
  #undef DMA_V
  #undef CMASK
  #undef START
  #undef RESC
  #undef ROT
}
constexpr int ATTN_LDS_BYTES=LDS_BYTES;
#undef SBAR
#undef WAIT_BAR
}
constexpr int DM = 1024, NB = 16, SEQ = 2048, NT = NB * SEQ;
constexpr int RWW = 512, INC = 5376, ZA = 1792, ZG = 3328;
constexpr int NEXP = 32, DEXP = 512;
constexpr int XS_ROWS = 2 * NT + NEXP * 256;
constexpr float C2 = 0.125f * 1.4426950408889634f;

#define LAS __attribute__((address_space(3)))
#define GAS __attribute__((address_space(1)))
typedef unsigned short bf16;
typedef unsigned v4u __attribute__((ext_vector_type(4)));
typedef unsigned v2u __attribute__((ext_vector_type(2)));
typedef float f32x4 __attribute__((ext_vector_type(4)));

__device__ __forceinline__ unsigned f2bf(float f) { unsigned u = __builtin_bit_cast(unsigned, f); return (u + 0x7fffu + ((u >> 16) & 1u)) >> 16; }
__device__ __forceinline__ unsigned pk2(float lo, float hi) { return f2bf(lo) | (f2bf(hi) << 16); }
__device__ __forceinline__ float bflo(unsigned w) { return __builtin_bit_cast(float, w << 16); }
__device__ __forceinline__ float bfhi(unsigned w) { return __builtin_bit_cast(float, w & 0xffff0000u); }
__device__ __forceinline__ float sigm(float x) { return 1.0f / (1.0f + __expf(-x)); }
__device__ __forceinline__ float wave_sum(float v) {
#pragma unroll
    for (int o = 1; o < 64; o <<= 1) v += __shfl_xor(v, o);
    return v;
}

constexpr size_t MiB = 1u << 20;
constexpr size_t WS_CTL = 0;
constexpr size_t WS_MOD = 1 * MiB;
constexpr size_t WS_COS = 2 * MiB;
constexpr size_t WS_SIN = 2 * MiB + 512 * 1024;
constexpr size_t WS_KMEAN = 3 * MiB;
constexpr size_t WS_WRT = 3 * MiB + 512 * 1024;
constexpr size_t WS_SEL = 4 * MiB;
constexpr size_t WS_RTE = 5 * MiB;
constexpr size_t WS_RTW = 5 * MiB + 256 * 1024;
constexpr size_t WS_RNK = 5 * MiB + 512 * 1024;
constexpr size_t WS_POS = 5 * MiB + 768 * 1024;
constexpr size_t WS_WIN = 16 * MiB;
constexpr size_t WS_WBA = 27 * MiB;
constexpr size_t WS_WBB = 28 * MiB;
constexpr size_t WS_WOUT = 29 * MiB;
constexpr size_t WS_Z = 32 * MiB;
constexpr size_t WS_H = 368 * MiB;
constexpr size_t WS_Q = 368 * MiB, WS_K = 400 * MiB, WS_MRG = 368 * MiB;
constexpr size_t WS_YA = 432 * MiB, WS_YB = 464 * MiB;
constexpr size_t WS_WUP = 32 * MiB;
constexpr size_t WS_W2T = 96 * MiB;
constexpr size_t WS_H2 = 128 * MiB;
constexpr size_t WS_XS = 192 * MiB;
constexpr size_t WS_HID = 336 * MiB;
constexpr size_t WS_END = 496 * MiB;
constexpr int CW_CNT = 64;
constexpr int CW_NT = 128;
constexpr int CW_TEXP = 256;

__device__ __forceinline__ void tr_item(const float* W, int K, int N, bf16* WT, int kb, int nb, int dst_row0, LAS float* scr, int lane) {
    const int k0 = 64 * kb, n0 = 32 * nb;
#pragma unroll 8
    for (int i = 0; i < 32; ++i) { const int kk = 2 * i + (lane >> 5); scr[kk * 33 + (lane & 31)] = W[(size_t)(k0 + kk) * N + n0 + (lane & 31)]; }
    asm volatile("s_waitcnt lgkmcnt(0)" ::: "memory");
    const int c = lane & 7;
#pragma unroll
    for (int j = 0; j < 4; ++j) { const int n = (lane >> 3) + 8 * j; const LAS float* s = scr + (8 * c) * 33 + n;
        v4u o; o.x = pk2(s[0 * 33], s[1 * 33]); o.y = pk2(s[2 * 33], s[3 * 33]); o.z = pk2(s[4 * 33], s[5 * 33]); o.w = pk2(s[6 * 33], s[7 * 33]);
        *(v4u*)(WT + (size_t)(dst_row0 + n) * K + k0 + 8 * c) = o; }
    asm volatile("s_waitcnt lgkmcnt(0)" ::: "memory");
}

struct PArgs { const float* in[30]; float* out; unsigned char* ws; };

__device__ __forceinline__ void p_prep_weights(const PArgs& a, unsigned char* lds) {
    const int tid = ltid(), lane = tid & 63, wave = tid >> 6;
    LAS float* scr = (LAS float*)lds + wave * (64 * 33);
    const int gw = blockIdx.x * 8 + wave, NGW = gridDim.x * 8;
    unsigned char* ws = a.ws;
    constexpr int I_IN = 16 * 168, I_BR = 8 * 32, I_OUT = 16 * 32;
    for (int it = gw; it < I_IN + 2 * I_BR + I_OUT; it += NGW) {
        int r = it;
        if (r < I_IN) { const int kb = r / 168, nb = r % 168; tr_item(a.in[6], 1024, INC, (bf16*)(ws + WS_WIN), kb, nb, 32 * nb, scr, lane); continue; } r -= I_IN;
        if (r < I_BR) { const int kb = r / 32, nb = r % 32; tr_item(a.in[20], 512, 1024, (bf16*)(ws + WS_WBA), kb, nb, 32 * nb, scr, lane); continue; } r -= I_BR;
        if (r < I_BR) { const int kb = r / 32, nb = r % 32; tr_item(a.in[21], 512, 1024, (bf16*)(ws + WS_WBB), kb, nb, 32 * nb, scr, lane); continue; } r -= I_BR;
        { const int kb = r / 32, nb = r % 32; tr_item(a.in[22], 1024, 1024, (bf16*)(ws + WS_WOUT), kb, nb, 32 * nb, scr, lane); }
    }
    const int gt = blockIdx.x * 512 + tid, NGT = gridDim.x * 512;
    float* cosT = (float*)(ws + WS_COS); float* sinT = (float*)(ws + WS_SIN);
    for (int i = gt; i < SEQ * 32; i += NGT) { const int s = i >> 5, f = i & 31; const float inv = powf(10000.0f, -(float)f / 32.0f); const float ang = (float)s * inv; cosT[i] = cosf(ang); sinT[i] = sinf(ang); }
    float* wrt = (float*)(ws + WS_WRT);
    for (int i = gt; i < 36 * 1024; i += NGT) { const int e = i >> 10, k = i & 1023; wrt[i] = e < 4 ? a.in[23][k * 4 + e] : a.in[25][k * 32 + (e - 4)]; }
}

__device__ __forceinline__ void p_prep_experts(const PArgs& a, unsigned char* lds) {
    const int tid = ltid(), lane = tid & 63, wave = tid >> 6;
    LAS float* scr = (LAS float*)lds + wave * (64 * 33);
    const int gw = blockIdx.x * 8 + wave, NGW = gridDim.x * 8;
    unsigned char* ws = a.ws;
    for (int it = gw; it < NEXP * 768; it += NGW) {
        const int e = it / 768; int r = it % 768;
        bf16* wup = (bf16*)(ws + WS_WUP) + (size_t)e * 1024 * 1024;
        if (r < 256) { const int kb = r / 16, nb = r % 16, n0 = 32 * nb; tr_item(a.in[27] + (size_t)e * 1024 * 512, 1024, 512, wup, kb, nb, (n0 >> 7) * 256 + (n0 & 127), scr, lane); continue; } r -= 256;
        if (r < 256) { const int kb = r / 16, nb = r % 16, n0 = 32 * nb; tr_item(a.in[28] + (size_t)e * 1024 * 512, 1024, 512, wup, kb, nb, (n0 >> 7) * 256 + 128 + (n0 & 127), scr, lane); continue; } r -= 256;
        { const int kb = r / 32, nb = r % 32; tr_item(a.in[29] + (size_t)e * 512 * 1024, 512, 1024, (bf16*)(ws + WS_W2T) + (size_t)e * 1024 * 512, kb, nb, 32 * nb, scr, lane); }
    }
}

__device__ __forceinline__ void p_ada(const PArgs& a, unsigned char* lds) {
    float* sc = (float*)lds; float* red = sc + 16 * 1024;
    const float* c = a.in[1]; const float* w = a.in[2]; const float* bias = a.in[3];
    float* mod = (float*)(a.ws + WS_MOD);
    const int tid = ltid();
    for (int i = tid; i < 16 * 1024; i += 512) { const float v = c[i]; sc[i] = v / (1.0f + __expf(-v)); }
    __syncthreads();
    const int col = tid & 31, kg = tid >> 5;
    for (int tile = blockIdx.x; tile < 192; tile += gridDim.x) {
        const int e = tile * 32 + col;
        float acc[16];
#pragma unroll
        for (int b = 0; b < 16; ++b) acc[b] = 0.f;
        for (int d = kg * 64; d < kg * 64 + 64; ++d) { const float wv = w[(size_t)d * 6144 + e];
#pragma unroll
            for (int b = 0; b < 16; ++b) acc[b] += sc[b * 1024 + d] * wv; }
#pragma unroll
        for (int b = 0; b < 16; ++b) red[(kg * 16 + b) * 32 + col] = acc[b];
        __syncthreads();
        { const int b = tid >> 5, cc = tid & 31; float sm = 0.f;
#pragma unroll
            for (int k = 0; k < 16; ++k) sm += red[(k * 16 + b) * 32 + cc];
            mod[b * 6144 + tile * 32 + cc] = sm + bias[tile * 32 + cc]; }
        __syncthreads();
    }
}

__device__ __forceinline__ void p_norm1(const PArgs& a, unsigned char* lds) {
    const int tid = ltid(), lane = tid & 63, gw = blockIdx.x * 8 + (tid >> 6), NGW = gridDim.x * 8;
    const float* x = a.in[0]; const float* g = a.in[4]; const float* mod = (const float*)(a.ws + WS_MOD);
    bf16* h = (bf16*)(a.ws + WS_H);
    for (int m = gw; m < NT; m += NGW) {
        const int b = m >> 11; const f32x4* xr = (const f32x4*)(x + (size_t)m * DM) + lane; f32x4 v[4]; float s = 0.f;
#pragma unroll
        for (int j = 0; j < 4; ++j) { v[j] = xr[64 * j]; s += (v[j].x * v[j].x + v[j].y * v[j].y) + (v[j].z * v[j].z + v[j].w * v[j].w); }
        const float rstd = rsqrtf(wave_sum(s) * (1.0f / DM) + 1e-6f);
        v2u* o = (v2u*)(h + (size_t)m * DM) + lane;
#pragma unroll
        for (int j = 0; j < 4; ++j) { const int col = 4 * (lane + 64 * j);
            const f32x4 gg = *(const f32x4*)(g + col), sh = *(const f32x4*)(mod + b * 6144 + col), scl = *(const f32x4*)(mod + b * 6144 + 1024 + col);
            const f32x4 r = v[j] * rstd * gg * (scl + 1.0f) + sh; v2u w; w.x = pk2(r.x, r.y); w.y = pk2(r.z, r.w); o[64 * j] = w; }
    }
}

using pg8::Unit; using pg8::HALF; using pg8::BM; using pg8::cvt_pk_bf16;
typedef pg8::f32x4 pf4; typedef pg8::u32x4 pu4;

struct EpiStoreBf16 {
    static constexpr bool PERM = true, AFTER_DRAIN = false;
    bf16* O; int ldc;
    __device__ __forceinline__ void operator()(const pf4 (&acc)[2][2][4][2], const Unit& u, int wr, int wc, int fr, int fq) const {
        const int row0 = u.pm * BM + wr * 64 + fr, col0 = u.pn * BM + wc * 32 + 8 * fq;
#pragma unroll
        for (int ai = 0; ai < 2; ++ai)
#pragma unroll
            for (int m = 0; m < 4; ++m) { bf16* rowp = O + (size_t)(row0 + ai * HALF + m * 16) * ldc + col0;
#pragma unroll
                for (int bj = 0; bj < 2; ++bj) { const pf4 v0 = acc[ai][bj][m][0], v1 = acc[ai][bj][m][1]; pu4 w;
                    w.x = cvt_pk_bf16(v0[0], v0[1]); w.y = cvt_pk_bf16(v0[2], v0[3]); w.z = cvt_pk_bf16(v1[0], v1[1]); w.w = cvt_pk_bf16(v1[2], v1[3]);
                    *(pu4*)(rowp + bj * HALF) = w; } }
    }
};
struct EpiBranchA {
    static constexpr bool PERM = false, AFTER_DRAIN = false;
    float* tmp; const bf16* z;
    __device__ __forceinline__ void operator()(const pf4 (&acc)[2][2][4][2], const Unit& u, int wr, int wc, int fr, int fq) const {
        const int row0 = u.pm * BM + wr * 64 + fr, col0 = u.pn * BM + wc * 32 + 4 * fq;
#pragma unroll
        for (int ai = 0; ai < 2; ++ai)
#pragma unroll
            for (int m = 0; m < 4; ++m) { const size_t row = (size_t)(row0 + ai * HALF + m * 16);
#pragma unroll
                for (int bj = 0; bj < 2; ++bj)
#pragma unroll
                    for (int n = 0; n < 2; ++n) { const int col = col0 + bj * HALF + n * 16; const v2u gz = *(const v2u*)(z + row * INC + ZG + col); const pf4 v = acc[ai][bj][m][n];
                        pf4 o; o[0] = sigm(bflo(gz.x)) * v[0]; o[1] = sigm(bfhi(gz.x)) * v[1]; o[2] = sigm(bflo(gz.y)) * v[2]; o[3] = sigm(bfhi(gz.y)) * v[3];
                        *(pf4*)(tmp + row * DM + col) = o; } }
    }
};
struct EpiBranchB {
    static constexpr bool PERM = true, AFTER_DRAIN = false;
    const float* tmp; const bf16* z; bf16* mrg;
    __device__ __forceinline__ void operator()(const pf4 (&acc)[2][2][4][2], const Unit& u, int wr, int wc, int fr, int fq) const {
        const int row0 = u.pm * BM + wr * 64 + fr, col0 = u.pn * BM + wc * 32 + 8 * fq;
#pragma unroll
        for (int ai = 0; ai < 2; ++ai)
#pragma unroll
            for (int m = 0; m < 4; ++m) { const size_t row = (size_t)(row0 + ai * HALF + m * 16);
#pragma unroll
                for (int bj = 0; bj < 2; ++bj) { const int col = col0 + bj * HALF; const pu4 gz = *(const pu4*)(z + row * INC + ZG + 1024 + col);
                    const pf4 t0 = *(const pf4*)(tmp + row * DM + col), t1 = *(const pf4*)(tmp + row * DM + col + 4); const pf4 v0 = acc[ai][bj][m][0], v1 = acc[ai][bj][m][1];
                    pu4 w;
                    w.x = cvt_pk_bf16(t0[0] + sigm(bflo(gz.x)) * v0[0], t0[1] + sigm(bfhi(gz.x)) * v0[1]);
                    w.y = cvt_pk_bf16(t0[2] + sigm(bflo(gz.y)) * v0[2], t0[3] + sigm(bfhi(gz.y)) * v0[3]);
                    w.z = cvt_pk_bf16(t1[0] + sigm(bflo(gz.z)) * v1[0], t1[1] + sigm(bfhi(gz.z)) * v1[1]);
                    w.w = cvt_pk_bf16(t1[2] + sigm(bflo(gz.w)) * v1[2], t1[3] + sigm(bfhi(gz.w)) * v1[3]);
                    *(pu4*)(mrg + row * DM + col) = w; } }
    }
};
struct EpiOut {
    static constexpr bool PERM = false, AFTER_DRAIN = false;
    const float* x; const float* mod; float* out;
    __device__ __forceinline__ void operator()(const pf4 (&acc)[2][2][4][2], const Unit& u, int wr, int wc, int fr, int fq) const {
        const int row0 = u.pm * BM + wr * 64 + fr, col0 = u.pn * BM + wc * 32 + 4 * fq; const int b = u.pm >> 3;
        pf4 gt[2][2];
#pragma unroll
        for (int bj = 0; bj < 2; ++bj)
#pragma unroll
            for (int n = 0; n < 2; ++n) gt[bj][n] = *(const pf4*)(mod + b * 6144 + 2048 + col0 + bj * HALF + n * 16);
#pragma unroll
        for (int ai = 0; ai < 2; ++ai)
#pragma unroll
            for (int m = 0; m < 4; ++m) { const size_t off = (size_t)(row0 + ai * HALF + m * 16) * DM + col0;
#pragma unroll
                for (int bj = 0; bj < 2; ++bj)
#pragma unroll
                    for (int n = 0; n < 2; ++n) { const pf4 xv = *(const pf4*)(x + off + bj * HALF + n * 16); *(pf4*)(out + off + bj * HALF + n * 16) = xv + gt[bj][n] * acc[ai][bj][m][n]; } }
    }
};
struct EpiUp {
    static constexpr bool PERM = true, AFTER_DRAIN = false;
    bf16* hid;
    __device__ __forceinline__ void operator()(const pf4 (&acc)[2][2][4][2], const Unit& u, int wr, int wc, int fr, int fq) const {
        const int row0 = u.pm * BM + wr * 64 + fr, col0 = u.pn * 128 + wc * 32 + 8 * fq;
#pragma unroll
        for (int ai = 0; ai < 2; ++ai)
#pragma unroll
            for (int m = 0; m < 4; ++m) { const size_t row = (size_t)(row0 + ai * HALF + m * 16); float o[8];
#pragma unroll
                for (int n = 0; n < 2; ++n)
#pragma unroll
                    for (int e = 0; e < 4; ++e) { const float g = acc[ai][0][m][n][e], l = acc[ai][1][m][n][e]; o[4 * n + e] = g * sigm(g) * l; }
                pu4 w; w.x = cvt_pk_bf16(o[0], o[1]); w.y = cvt_pk_bf16(o[2], o[3]); w.z = cvt_pk_bf16(o[4], o[5]); w.w = cvt_pk_bf16(o[6], o[7]);
                *(pu4*)(hid + row * DEXP + col0) = w; }
    }
};

struct GemmArgs { unsigned char* ws; const float* x; float* out; };
template <class Epi> __device__ __forceinline__ void run_dense(const void* A, const void* Bt, int M, int N, int K, const Epi& E, unsigned char* lds) {
    pg8::Gemm g{K}; pg8::StaticOrder S; S.init(A, Bt, M, N, K, (int)gridDim.x, (int)blockIdx.x);
    pg8::gemm_phase<Epi, pg8::StaticOrder, true, true>((PG8_LAS unsigned char*)lds, g, S, E);
}
__device__ __forceinline__ void p_gemm_in(const GemmArgs& a, unsigned char* lds) {
    EpiStoreBf16 E{(bf16*)(a.ws + WS_Z), INC};
    run_dense(a.ws + WS_H, a.ws + WS_WIN, NT, INC, 1024, E, lds);
}
__device__ __forceinline__ void p_gemm_bra(const GemmArgs& a, unsigned char* lds) {
    EpiBranchA E{a.out, (const bf16*)(a.ws + WS_Z)};
    run_dense(a.ws + WS_YA, a.ws + WS_WBA, NT, 1024, 512, E, lds);
}
__device__ __forceinline__ void p_gemm_brb(const GemmArgs& a, unsigned char* lds) {
    EpiBranchB E{a.out, (const bf16*)(a.ws + WS_Z), (bf16*)(a.ws + WS_MRG)};
    run_dense(a.ws + WS_YB, a.ws + WS_WBB, NT, 1024, 512, E, lds);
}
__device__ __forceinline__ void p_gemm_out(const GemmArgs& a, unsigned char* lds) {
    EpiOut E{a.x, (const float*)(a.ws + WS_MOD), a.out};
    run_dense(a.ws + WS_MRG, a.ws + WS_WOUT, NT, 1024, 1024, E, lds);
}
struct GroupedOrder {
    const int* texp; int nT, nN, G, c; const char* A; size_t a_tile; const char* B; size_t b_exp, b_tile;
    __device__ bool next(int i, Unit& u) const {
        const long L = (long)i * G + c; if (L >= (long)nT * nN) return false;
        const int tile = (int)(L / nN), pn = (int)(L % nN); u.pm = tile; u.pn = pn; u.a = A + (size_t)tile * a_tile; u.b = B + (size_t)texp[tile] * b_exp + (size_t)pn * b_tile; return true;
    }
    __device__ __forceinline__ void a_ready(const Unit&) const {}
    __device__ __forceinline__ void done(const Unit&) const {}
};
__device__ __forceinline__ void p_gemm_up(const GemmArgs& a, unsigned char* lds) {
    const int* ctl = (const int*)(a.ws + WS_CTL);
    GroupedOrder S{ctl + CW_TEXP, ctl[CW_NT], 4, (int)gridDim.x, (int)blockIdx.x, (const char*)(a.ws + WS_XS), (size_t)256 * 1024 * 2, (const char*)(a.ws + WS_WUP), (size_t)1024 * 1024 * 2, (size_t)256 * 1024 * 2};
    EpiUp E{(bf16*)(a.ws + WS_HID)}; pg8::Gemm g{1024};
    pg8::gemm_phase<EpiUp, GroupedOrder, true, true>((PG8_LAS unsigned char*)lds, g, S, E);
}
__device__ __forceinline__ void p_gemm_down(const GemmArgs& a, unsigned char* lds) {
    const int* ctl = (const int*)(a.ws + WS_CTL);
    GroupedOrder S{ctl + CW_TEXP, ctl[CW_NT], 4, (int)gridDim.x, (int)blockIdx.x, (const char*)(a.ws + WS_HID), (size_t)256 * 512 * 2, (const char*)(a.ws + WS_W2T), (size_t)1024 * 512 * 2, (size_t)256 * 512 * 2};
    EpiStoreBf16 E{(bf16*)(a.ws + WS_XS), 1024}; pg8::Gemm g{512};
    pg8::gemm_phase<EpiStoreBf16, GroupedOrder, true, true>((PG8_LAS unsigned char*)lds, g, S, E);
}

__device__ __forceinline__ void load64bf(const bf16* p, float (&v)[64]) {
#pragma unroll
    for (int i = 0; i < 8; ++i) { const v4u w = *(const v4u*)(p + 8 * i);
        v[8 * i + 0] = bflo(w.x); v[8 * i + 1] = bfhi(w.x); v[8 * i + 2] = bflo(w.y); v[8 * i + 3] = bfhi(w.y);
        v[8 * i + 4] = bflo(w.z); v[8 * i + 5] = bfhi(w.z); v[8 * i + 6] = bflo(w.w); v[8 * i + 7] = bfhi(w.w); }
}
__device__ __forceinline__ void store64bf(bf16* p, const float (&v)[64], float sc) {
#pragma unroll
    for (int i = 0; i < 8; ++i) { v4u w; w.x = pk2(v[8 * i] * sc, v[8 * i + 1] * sc); w.y = pk2(v[8 * i + 2] * sc, v[8 * i + 3] * sc); w.z = pk2(v[8 * i + 4] * sc, v[8 * i + 5] * sc); w.w = pk2(v[8 * i + 6] * sc, v[8 * i + 7] * sc);
        *(v4u*)(p + 8 * i) = w; }
}
__device__ __forceinline__ void norm_rope(float (&v)[64], const float* g, const float* cosT, const float* sinT, int s) {
    float ss = 0.f;
#pragma unroll
    for (int d = 0; d < 64; ++d) ss += v[d] * v[d];
    const float rstd = rsqrtf(ss * (1.0f / 64.0f) + 1e-6f);
#pragma unroll
    for (int d = 0; d < 64; ++d) v[d] = v[d] * rstd * g[d];
#pragma unroll
    for (int i = 0; i < 32; ++i) { const float c = cosT[s * 32 + i], sn = sinT[s * 32 + i]; const float x1 = v[i], x2 = v[i + 32]; v[i] = x1 * c - x2 * sn; v[i + 32] = x2 * c + x1 * sn; }
}
__device__ __forceinline__ void p_kprep(const PArgs& a, unsigned char* lds) {
    float* tile = (float*)lds + (ltid() >> 8) * (256 * 65); float* red = (float*)lds + 2 * 256 * 65;
    const int tid = ltid(), half = tid >> 8, t256 = tid & 255;
    const bf16* z = (const bf16*)(a.ws + WS_Z);
    for (int base = blockIdx.x * 2; base < 1024; base += gridDim.x * 2) {
        const int blk = base + half; const bool ok = blk < 1024; const int h = blk & 7, n = (blk >> 3) & 7, b = (blk >> 6) & 15;
        const int s = n * 256 + t256; const size_t t = (size_t)b * SEQ + s;
        float v[64]; load64bf(z + t * INC + ZA + 512 + h * 64, v);
        norm_rope(v, a.in[19], (const float*)(a.ws + WS_COS), (const float*)(a.ws + WS_SIN), s);
        if (ok) store64bf((bf16*)(a.ws + WS_K) + t * 512 + h * 64, v, 1.0f);
#pragma unroll
        for (int d = 0; d < 64; ++d) tile[t256 * 65 + d] = v[d];
        __syncthreads();
        { const int d = t256 & 63, part = t256 >> 6; float sm = 0.f;
#pragma unroll 8
            for (int r = 0; r < 64; ++r) sm += tile[(part * 64 + r) * 65 + d];
            red[(half * 4 + part) * 64 + d] = sm; }
        __syncthreads();
        if (t256 < 64 && ok) { const float* r = red + half * 256; ((float*)(a.ws + WS_KMEAN))[(size_t)((b * 8 + h) * 8 + n) * 64 + t256] = ((r[t256] + r[64 + t256]) + (r[128 + t256] + r[192 + t256])) * (1.0f / 256.0f); }
        __syncthreads();
    }
}
__device__ __forceinline__ void p_qprep(const PArgs& a, unsigned char* lds) {
    const int tid = ltid(), half = tid >> 8, t256 = tid & 255;
    const bf16* z = (const bf16*)(a.ws + WS_Z);
    for (int base = blockIdx.x * 2; base < 1024; base += gridDim.x * 2) {
        const int blk = base + half; if (blk >= 1024) continue;
        const int h = blk & 7, n = (blk >> 3) & 7, b = blk >> 6;
        const int s = n * 256 + t256; const size_t t = (size_t)b * SEQ + s;
        float v[64]; load64bf(z + t * INC + ZA + h * 64, v);
        norm_rope(v, a.in[18], (const float*)(a.ws + WS_COS), (const float*)(a.ws + WS_SIN), s);
        const float* km = (const float*)(a.ws + WS_KMEAN) + (size_t)((b * 8 + h) * 8) * 64;
        float gate[7];
#pragma unroll
        for (int j = 0; j < 7; ++j) { float g = 0.f; if (j < n) {
#pragma unroll
                for (int d = 0; d < 64; ++d) g += v[d] * km[j * 64 + d]; }
            gate[j] = g; }
        unsigned sel = 0;
        if (n <= 3) sel = (1u << n) - 1u;
        else {
#pragma unroll
            for (int rep = 0; rep < 3; ++rep) { float best = -INFINITY; int bi = 0;
#pragma unroll
                for (int j = 0; j < 7; ++j) if (j < n && !((sel >> j) & 1u) && gate[j] > best) { best = gate[j]; bi = j; }
                sel |= 1u << bi; }
        }
        ((unsigned char*)(a.ws + WS_SEL))[(size_t)(b * 8 + h) * SEQ + s] = (unsigned char)sel;
        store64bf((bf16*)(a.ws + WS_Q) + t * 512 + h * 64, v, C2);
    }
}

__device__ __forceinline__ void p_attn(const PArgs& a, unsigned char* lds, int vb, int nvb) {
    const attn_body::bf16* Q = (const attn_body::bf16*)(a.ws + WS_Q); const attn_body::bf16* K = (const attn_body::bf16*)(a.ws + WS_K);
    const attn_body::bf16* V = (const attn_body::bf16*)(a.ws + WS_Z) + (ZA + 1024); attn_body::bf16* O = (attn_body::bf16*)(a.ws + WS_YB);
    const unsigned char* SEL = (const unsigned char*)(a.ws + WS_SEL);
    for (int p = vb; p < 512; p += nvb)
        for (int which = 0; which < 2; ++which) { const int bh = p >> 2, s = p & 3, qb = which ? 7 - s : s;
            attn_body::attn_unit<8>(bh >> 3, bh & 7, qb, Q, K, V, O, SEL, (char*)lds); }
}

__device__ __forceinline__ f32x4 shift4(const bf16* zp, int off, bool hasp, f32x4 mu) {
    const v2u cw = *(const v2u*)(zp + off); v2u pw = {0u, 0u}; if (hasp) pw = *(const v2u*)(zp - INC + off);
    const f32x4 cv = {bflo(cw.x), bfhi(cw.x), bflo(cw.y), bfhi(cw.y)}, pv = {bflo(pw.x), bfhi(pw.x), bflo(pw.y), bfhi(pw.y)};
    return cv + (pv - cv) * mu;
}
__device__ __forceinline__ float red16(float v) { v += __shfl_xor(v, 1); v += __shfl_xor(v, 2); v += __shfl_xor(v, 4); v += __shfl_xor(v, 8); return v; }
__device__ __forceinline__ float red8(float v) { v += __shfl_xor(v, 1); v += __shfl_xor(v, 2); v += __shfl_xor(v, 4); return v; }
__device__ __forceinline__ void p_scan_unit(const PArgs& a, unsigned char* lds, int bh) {
    float* L = (float*)lds;
    float* WL = L; float* WA = L + 4096; float* WG = L + 8192;
    float* R = L + 16384; float* KX = R + 2048; float* V = KX + 2048;
    float* AW = V + 2048; float* AA = AW + 2048; float* AG = AA + 2048;
    float* W = AG + 4096; float* A2 = W + 2048; float* B2 = A2 + 2048; float* G = B2 + 2048;
    float* BON = G + 2048;
    float* Y = AW;
    const int tid = ltid(), b = bh >> 3, h = bh & 7;
    const float* mu = a.in[7]; const float* w0 = a.in[8]; const float* wl = a.in[9]; const float* a0 = a.in[10]; const float* al = a.in[11]; const float* gl = a.in[12];
    const float* k_k = a.in[13]; const float* k_a = a.in[14]; const float* r_k = a.in[15]; const float* lng = a.in[16]; const float* lnb = a.in[17];
    const bf16* z = (const bf16*)(a.ws + WS_Z); bf16* ya = (bf16*)(a.ws + WS_YA);
    for (int i = tid; i < 4096; i += 512) { const int m = i >> 6, j = i & 63; WL[i] = wl[m * 512 + h * 64 + j]; WA[i] = al[m * 512 + h * 64 + j]; }
    for (int i = tid; i < 8192; i += 512) { const int m = i >> 6, j = i & 63; WG[i] = gl[m * 512 + h * 64 + j]; }
    const int tt = tid >> 4, jg = tid & 15;
    const int si = tid >> 3, c8 = tid & 7;
    float st[8];
#pragma unroll
    for (int j = 0; j < 8; ++j) st[j] = 0.f;
    const int colh = h * 64 + 4 * jg;
    const f32x4 mu_r = *(const f32x4*)(mu + colh), mu_k = *(const f32x4*)(mu + 512 + colh), mu_v = *(const f32x4*)(mu + 1024 + colh);
    const f32x4 mu_w = *(const f32x4*)(mu + 1536 + 4 * jg), mu_a = *(const f32x4*)(mu + 1600 + 4 * jg), mu_g0 = *(const f32x4*)(mu + 1664 + 8 * jg), mu_g1 = *(const f32x4*)(mu + 1668 + 8 * jg);
    const f32x4 w0v = *(const f32x4*)(w0 + colh), a0v = *(const f32x4*)(a0 + colh), kkv = *(const f32x4*)(k_k + colh), kav = *(const f32x4*)(k_a + colh), rkv = *(const f32x4*)(r_k + colh);
    const f32x4 lgv = *(const f32x4*)(lng + colh), lbv = *(const f32x4*)(lnb + colh);
    __syncthreads();
    for (int c = 0; c < SEQ / 32; ++c) {
        const int s = c * 32 + tt; const size_t t = (size_t)b * SEQ + s; const bf16* zp = z + t * INC; const bool hasp = s > 0;
        {
            *(f32x4*)(R + tt * 64 + 4 * jg) = shift4(zp, colh, hasp, mu_r);
            *(f32x4*)(KX + tt * 64 + 4 * jg) = shift4(zp, 512 + colh, hasp, mu_k);
            *(f32x4*)(V + tt * 64 + 4 * jg) = shift4(zp, 1024 + colh, hasp, mu_v);
            { const f32x4 x = shift4(zp, 1536 + 4 * jg, hasp, mu_w); *(f32x4*)(AW + tt * 64 + 4 * jg) = (f32x4){tanhf(x.x), tanhf(x.y), tanhf(x.z), tanhf(x.w)}; }
            *(f32x4*)(AA + tt * 64 + 4 * jg) = shift4(zp, 1600 + 4 * jg, hasp, mu_a);
            { const f32x4 x = shift4(zp, 1664 + 8 * jg, hasp, mu_g0); *(f32x4*)(AG + tt * 128 + 8 * jg) = (f32x4){sigm(x.x), sigm(x.y), sigm(x.z), sigm(x.w)}; }
            { const f32x4 x = shift4(zp, 1668 + 8 * jg, hasp, mu_g1); *(f32x4*)(AG + tt * 128 + 8 * jg + 4) = (f32x4){sigm(x.x), sigm(x.y), sigm(x.z), sigm(x.w)}; }
        }
        __syncthreads();
        {
            f32x4 lw = {0.f, 0.f, 0.f, 0.f}, la = lw, lg = lw;
#pragma unroll 4
            for (int m = 0; m < 64; ++m) { const float aw = AW[tt * 64 + m], aa = AA[tt * 64 + m]; lw += *(const f32x4*)(WL + m * 64 + 4 * jg) * aw; la += *(const f32x4*)(WA + m * 64 + 4 * jg) * aa; }
#pragma unroll 4
            for (int m = 0; m < 128; ++m) { const float ag = AG[tt * 128 + m]; lg += *(const f32x4*)(WG + m * 64 + 4 * jg) * ag; }
            const f32x4 kx = *(const f32x4*)(KX + tt * 64 + 4 * jg), rr = *(const f32x4*)(R + tt * 64 + 4 * jg);
            f32x4 wv, av, kk, k2; float ss = 0.f, bon = 0.f;
#pragma unroll
            for (int e = 0; e < 4; ++e) { wv[e] = __expf(-0.606531f * sigm(w0v[e] + lw[e])); av[e] = sigm(a0v[e] + la[e]); kk[e] = kx[e] * kkv[e]; ss += kk[e] * kk[e];
                k2[e] = kx[e] * (1.0f + (av[e] - 1.0f) * kav[e]); bon += rr[e] * k2[e] * rkv[e]; }
            ss = red16(ss); bon = red16(bon);
            const float inv = 1.0f / fmaxf(sqrtf(ss), 1e-12f);
            kk = kk * inv;
            *(f32x4*)(W + tt * 64 + 4 * jg) = wv; *(f32x4*)(KX + tt * 64 + 4 * jg) = k2; *(f32x4*)(A2 + tt * 64 + 4 * jg) = -kk; *(f32x4*)(B2 + tt * 64 + 4 * jg) = kk * av; *(f32x4*)(G + tt * 64 + 4 * jg) = lg;
            if (jg == 0) BON[tt] = bon;
        }
        __syncthreads();
        for (int q = 0; q < 32; ++q) {
            const f32x4 a_0 = *(const f32x4*)(A2 + q * 64 + 8 * c8), a_1 = *(const f32x4*)(A2 + q * 64 + 8 * c8 + 4);
            const f32x4 b_0 = *(const f32x4*)(B2 + q * 64 + 8 * c8), b_1 = *(const f32x4*)(B2 + q * 64 + 8 * c8 + 4);
            const f32x4 w_0 = *(const f32x4*)(W + q * 64 + 8 * c8), w_1 = *(const f32x4*)(W + q * 64 + 8 * c8 + 4);
            const f32x4 k_0 = *(const f32x4*)(KX + q * 64 + 8 * c8), k_1 = *(const f32x4*)(KX + q * 64 + 8 * c8 + 4);
            const f32x4 r_0 = *(const f32x4*)(R + q * 64 + 8 * c8), r_1 = *(const f32x4*)(R + q * 64 + 8 * c8 + 4);
            const float vi = V[q * 64 + si];
            float sa = 0.f;
#pragma unroll
            for (int j = 0; j < 4; ++j) { sa += st[j] * a_0[j]; sa += st[4 + j] * a_1[j]; }
            sa = red8(sa);
            float y = 0.f;
#pragma unroll
            for (int j = 0; j < 4; ++j) { st[j] = st[j] * w_0[j] + sa * b_0[j] + vi * k_0[j]; st[4 + j] = st[4 + j] * w_1[j] + sa * b_1[j] + vi * k_1[j]; y += st[j] * r_0[j]; y += st[4 + j] * r_1[j]; }
            y = red8(y);
            if (c8 == 0) Y[q * 64 + si] = y;
        }
        __syncthreads();
        {
            const f32x4 yv = *(const f32x4*)(Y + tt * 64 + 4 * jg);
            const float mean = red16((yv.x + yv.y) + (yv.z + yv.w)) * (1.0f / 64.0f);
            const f32x4 dv = yv - mean;
            const float var = red16((dv.x * dv.x + dv.y * dv.y) + (dv.z * dv.z + dv.w * dv.w)) * (1.0f / 64.0f);
            const float rstd = rsqrtf(var + 64e-5f);
            const f32x4 vv = *(const f32x4*)(V + tt * 64 + 4 * jg), gg = *(const f32x4*)(G + tt * 64 + 4 * jg);
            const f32x4 o = (dv * rstd * lgv + lbv + vv * BON[tt]) * gg;
            v2u w; w.x = pk2(o.x, o.y); w.y = pk2(o.z, o.w);
            *(v2u*)(ya + t * RWW + colh) = w;
        }
        __syncthreads();
    }
}

__device__ __forceinline__ void p_norm2_route(const PArgs& a, unsigned char* lds) {
    const int tid = ltid(), lane = tid & 63, gw = blockIdx.x * 8 + (tid >> 6), NGW = gridDim.x * 8;
    const float* x1 = a.out; const float* g = a.in[5]; const float* mod = (const float*)(a.ws + WS_MOD);
    const float* wrt = (const float*)(a.ws + WS_WRT); const float* brg = a.in[24]; const float* bre = a.in[26];
    bf16* h2 = (bf16*)(a.ws + WS_H2);
    int* rte = (int*)(a.ws + WS_RTE); float* rtw = (float*)(a.ws + WS_RTW); int* rnk = (int*)(a.ws + WS_RNK); unsigned* cnt = (unsigned*)(a.ws + WS_CTL) + CW_CNT;
    for (int rg = gw; rg < NT / 4; rg += NGW) {
        f32x4 hv[4][4];
#pragma unroll
        for (int rr = 0; rr < 4; ++rr) { const int m = rg * 4 + rr, b = m >> 11; const f32x4* xr = (const f32x4*)(x1 + (size_t)m * DM) + lane; float s = 0.f;
#pragma unroll
            for (int j = 0; j < 4; ++j) { hv[rr][j] = xr[64 * j]; const f32x4 v = hv[rr][j]; s += (v.x * v.x + v.y * v.y) + (v.z * v.z + v.w * v.w); }
            const float rstd = rsqrtf(wave_sum(s) * (1.0f / DM) + 1e-6f);
            v2u* o = (v2u*)(h2 + (size_t)m * DM) + lane;
#pragma unroll
            for (int j = 0; j < 4; ++j) { const int col = 4 * (lane + 64 * j);
                const f32x4 gg = *(const f32x4*)(g + col), sh = *(const f32x4*)(mod + b * 6144 + 3072 + col), scl = *(const f32x4*)(mod + b * 6144 + 4096 + col);
                const f32x4 r = hv[rr][j] * rstd * gg * (scl + 1.0f) + sh; hv[rr][j] = r; v2u w; w.x = pk2(r.x, r.y); w.y = pk2(r.z, r.w); o[64 * j] = w; } }
        float mylog[4] = {0.f, 0.f, 0.f, 0.f};
        for (int e = 0; e < 36; ++e) { float p[4] = {0.f, 0.f, 0.f, 0.f};
#pragma unroll
            for (int j = 0; j < 4; ++j) { const f32x4 w4 = *(const f32x4*)(wrt + e * 1024 + 4 * (lane + 64 * j));
#pragma unroll
                for (int rr = 0; rr < 4; ++rr) { const f32x4 v = hv[rr][j]; p[rr] += (v.x * w4.x + v.y * w4.y) + (v.z * w4.z + v.w * w4.w); } }
#pragma unroll
            for (int rr = 0; rr < 4; ++rr) { const float sm = wave_sum(p[rr]); if (lane == e) mylog[rr] = sm; } }
#pragma unroll
        for (int rr = 0; rr < 4; ++rr) { const int m = rg * 4 + rr;
            float gl4[4];
#pragma unroll
            for (int i = 0; i < 4; ++i) gl4[i] = __shfl(mylog[rr], i) + brg[i];
            int gi = 0; float gm = gl4[0];
#pragma unroll
            for (int i = 1; i < 4; ++i) if (gl4[i] > gm) { gm = gl4[i]; gi = i; }
            float gs = 0.f;
#pragma unroll
            for (int i = 0; i < 4; ++i) gs += __expf(gl4[i] - gm);
            const float pg = 1.0f / gs;
            float el[8];
#pragma unroll
            for (int k = 0; k < 8; ++k) el[k] = __shfl(mylog[rr], 4 + gi * 8 + k) + bre[gi * 8 + k];
            int e1 = 0; float m1 = el[0];
#pragma unroll
            for (int k = 1; k < 8; ++k) if (el[k] > m1) { m1 = el[k]; e1 = k; }
            int e2 = -1; float m2 = -INFINITY;
#pragma unroll
            for (int k = 0; k < 8; ++k) if (k != e1 && el[k] > m2) { m2 = el[k]; e2 = k; }
            const float q2 = __expf(m2 - m1); const float w1 = pg / (1.0f + q2), w2 = pg * q2 / (1.0f + q2);
            if (lane == 0) { const int ea = gi * 8 + e1, eb = gi * 8 + e2; rte[2 * m] = ea; rte[2 * m + 1] = eb; rtw[2 * m] = w1; rtw[2 * m + 1] = w2;
                rnk[2 * m] = (int)atomicAdd(cnt + ea, 1u); rnk[2 * m + 1] = (int)atomicAdd(cnt + eb, 1u); } }
    }
}
__device__ __forceinline__ void p_moe_gather(const PArgs& a, unsigned char* lds) {
    int* off = (int*)lds;
    const int tid = ltid(), lane = tid & 63, gw = blockIdx.x * 8 + (tid >> 6), NGW = gridDim.x * 8;
    int* ctl = (int*)(a.ws + WS_CTL); const unsigned* cnt = (const unsigned*)ctl + CW_CNT;
    if (tid == 0) { int o = 0, nt = 0;
        for (int e = 0; e < NEXP; ++e) { off[e] = o; const int tiles = ((int)cnt[e] + 255) >> 8;
            if (blockIdx.x == 0) for (int i = 0; i < tiles; ++i) ctl[CW_TEXP + nt + i] = e;
            nt += tiles; o += tiles * 256; }
        if (blockIdx.x == 0) ctl[CW_NT] = nt; }
    __syncthreads();
    const int* rte = (const int*)(a.ws + WS_RTE); const int* rnk = (const int*)(a.ws + WS_RNK); int* pos = (int*)(a.ws + WS_POS);
    const bf16* h2 = (const bf16*)(a.ws + WS_H2); bf16* xs = (bf16*)(a.ws + WS_XS);
    for (int i = gw; i < 2 * NT; i += NGW) { const int p = off[rte[i]] + rnk[i]; if (lane == 0) pos[i] = p;
        const v4u* src = (const v4u*)(h2 + (size_t)(i >> 1) * DM) + lane; v4u* dst = (v4u*)(xs + (size_t)p * DM) + lane;
        dst[0] = src[0]; dst[64] = src[64]; }
}
__device__ __forceinline__ void p_combine(const PArgs& a, unsigned char* lds) {
    const int tid = ltid(), lane = tid & 63, gw = blockIdx.x * 8 + (tid >> 6), NGW = gridDim.x * 8;
    const float* mod = (const float*)(a.ws + WS_MOD); const int* pos = (const int*)(a.ws + WS_POS); const float* rtw = (const float*)(a.ws + WS_RTW);
    const bf16* ys = (const bf16*)(a.ws + WS_XS); float* out = a.out;
    for (int m = gw; m < NT; m += NGW) { const int b = m >> 11; const int p0 = pos[2 * m], p1 = pos[2 * m + 1]; const float w0 = rtw[2 * m], w1 = rtw[2 * m + 1];
        f32x4* o = (f32x4*)(out + (size_t)m * DM) + lane; const v2u* y0 = (const v2u*)(ys + (size_t)p0 * DM) + lane; const v2u* y1 = (const v2u*)(ys + (size_t)p1 * DM) + lane;
#pragma unroll
        for (int j = 0; j < 4; ++j) { const int col = 4 * (lane + 64 * j); const f32x4 g2 = *(const f32x4*)(mod + b * 6144 + 5120 + col); const v2u a0 = y0[64 * j], a1 = y1[64 * j];
            const f32x4 e0 = {bflo(a0.x), bfhi(a0.x), bflo(a0.y), bfhi(a0.y)}, e1 = {bflo(a1.x), bfhi(a1.x), bflo(a1.y), bfhi(a1.y)};
            o[64 * j] = o[64 * j] + g2 * (e0 * w0 + e1 * w1); } }
}

#define XB_TMO      128
#define XB_XCNT(j)  (256  + 64 * (j))
#define XB_XSUB(j)  (1280 + 64 * (j))
#define XB_XGEN(j)  (2304 + 64 * (j))
#define XB_TOP      3328
#define XB_TOPGEN   3392
#define XCD_BAR_WORDS 3456
#define XB_SPIN_CAP (1u << 22)

__device__ __forceinline__ unsigned xb_ld(unsigned* p)              { return __hip_atomic_load(p, __ATOMIC_RELAXED, __HIP_MEMORY_SCOPE_AGENT); }
__device__ __forceinline__ unsigned xb_add(unsigned* p, unsigned v) { return __hip_atomic_fetch_add(p, v, __ATOMIC_RELAXED, __HIP_MEMORY_SCOPE_AGENT); }
__device__ __forceinline__ unsigned xb_xcc_id() { return (unsigned)__builtin_amdgcn_s_getreg((3 << 11) | 20) & 0xFu; }
#define XB_SPIN(cond, bar) do { unsigned _sp = 0; while (cond) { __builtin_amdgcn_s_sleep(1); \
    if ((++_sp & 255u) == 0u) { if (xb_ld(&(bar)[XB_TMO])) break; if (_sp > XB_SPIN_CAP) { atomicAdd(&(bar)[XB_TMO], 1u); break; } } } } while (0)

struct XcdBarrier {
    unsigned* bar; unsigned x;
    volatile LAS unsigned* st;
};

__device__ __forceinline__ XcdBarrier xcd_barrier_post(unsigned* bar, volatile LAS unsigned* st) {
    XcdBarrier b; b.bar = bar; b.x = xb_xcc_id(); b.st = st;
    if (threadIdx.x == 0) (void)xb_add(&bar[XB_XCNT(b.x)], 1u);
    return b;
}
__device__ __forceinline__ void xcd_barrier_complete(unsigned* bar, unsigned x, unsigned& nloc, unsigned& nx) {
    const unsigned G = gridDim.x * gridDim.y * gridDim.z;
    unsigned sum, cnt, mine, sp = 0u;
    for (;;) {
        sum = 0u; cnt = 0u; mine = 0u;
#pragma unroll
        for (unsigned j = 0; j < 16; ++j) { const unsigned c = xb_ld(&bar[XB_XCNT(j)]); sum += c; cnt += (c > 0u) ? 1u : 0u; mine = (j == x) ? c : mine; }
        if (sum == G) break;
        __builtin_amdgcn_s_sleep(1);
        if ((++sp & 255u) == 0u) { if (xb_ld(&bar[XB_TMO])) break; if (sp > XB_SPIN_CAP) { atomicAdd(&bar[XB_TMO], 1u); break; } }
    }
    nloc = mine > 0u ? mine : 1u; nx = cnt > 0u ? cnt : 1u;
}

__device__ __forceinline__ void xcd_barrier(const XcdBarrier& b) {
    asm volatile("s_waitcnt vmcnt(0)" ::: "memory");
    __syncthreads();
    if (threadIdx.x == 0) {
        unsigned* bar = b.bar;
        __builtin_amdgcn_s_waitcnt(0);
        unsigned nloc = b.st[0], nx = b.st[1];
        if (nloc == 0u) { xcd_barrier_complete(bar, b.x, nloc, nx); b.st[0] = nloc; b.st[1] = nx; }
        const unsigned old = xb_add(&bar[XB_XSUB(b.x)], 1u);
        const unsigned gen = old / nloc;
        if (old + 1u == (gen + 1u) * nloc) {
            __builtin_amdgcn_fence(__ATOMIC_RELEASE, "agent");
            asm volatile("s_waitcnt vmcnt(0)" ::: "memory");
            const unsigned og = xb_add(&bar[XB_TOP], 1u);
            const unsigned tg = og / nx;
            if (og + 1u == (tg + 1u) * nx) xb_add(&bar[XB_TOPGEN], 1u);
            else XB_SPIN(xb_ld(&bar[XB_TOPGEN]) == tg, bar);
            __builtin_amdgcn_fence(__ATOMIC_ACQUIRE, "agent");
            xb_add(&bar[XB_XGEN(b.x)], 1u);
            asm volatile("s_waitcnt vmcnt(0)" ::: "memory");
        } else {
            XB_SPIN(xb_ld(&bar[XB_XGEN(b.x)]) == gen, bar);
            __builtin_amdgcn_fence(__ATOMIC_ACQUIRE, "agent");
            asm volatile("s_waitcnt vmcnt(0)" ::: "memory");
        }
    }
    __syncthreads();
}

constexpr int LDS_BYTES = 160 * 1024, MISC_OFF = LDS_BYTES - 256;
constexpr int CW_BAR = 4096;

__global__ void __launch_bounds__(512, 2) mega_fwd(PArgs a) {
    extern __shared__ __attribute__((aligned(16))) unsigned char lds[];
    volatile LAS unsigned* MISC = (volatile LAS unsigned*)((LAS unsigned char*)lds + MISC_OFF);
    if (threadIdx.x < 64) MISC[threadIdx.x] = 0u;
    __syncthreads();
    XcdBarrier bar = xcd_barrier_post((unsigned*)(a.ws + WS_CTL) + CW_BAR, MISC + 8);
    GemmArgs g; g.ws = a.ws; g.x = a.in[0]; g.out = a.out;
    const int G = (int)gridDim.x, bx = (int)blockIdx.x;

    p_prep_weights(a, lds); __syncthreads(); p_ada(a, lds);
    xcd_barrier(bar);
    p_norm1(a, lds);
    xcd_barrier(bar);
    p_gemm_in(g, lds);
    xcd_barrier(bar);
    p_kprep(a, lds);
    xcd_barrier(bar);
    p_qprep(a, lds);
    xcd_barrier(bar);
    { const int nscan = G / 2;
      if (bx < nscan) { for (int bh = bx; bh < 128; bh += nscan) p_scan_unit(a, lds, bh); }
      else p_attn(a, lds, bx - nscan, G - nscan); }
    xcd_barrier(bar);
    p_gemm_bra(g, lds);
    xcd_barrier(bar);
    p_gemm_brb(g, lds);
    xcd_barrier(bar);
    p_gemm_out(g, lds); __syncthreads(); p_prep_experts(a, lds);
    xcd_barrier(bar);
    p_norm2_route(a, lds);
    xcd_barrier(bar);
    p_moe_gather(a, lds);
    xcd_barrier(bar);
    p_gemm_up(g, lds);
    xcd_barrier(bar);
    p_gemm_down(g, lds);
    xcd_barrier(bar);
    p_combine(a, lds);
}

extern "C" void kernel_launch(void* const* d_in, const int* in_sizes, int n_in, void* d_out, int out_size, void* d_ws, size_t ws_size, hipStream_t stream) {
    static int grid = 0;
    if (grid == 0) {
        if (n_in != 30 || out_size != NT * DM || ws_size < WS_END) { fprintf(stderr, "kernel_launch: unexpected shapes (n_in %d, out %d, ws %zu)\n", n_in, out_size, ws_size); grid = -1; return; }
        int dev = 0, cus = 0, per_cu = 0;
        if (hipGetDevice(&dev) != hipSuccess || hipDeviceGetAttribute(&cus, hipDeviceAttributeMultiprocessorCount, dev) != hipSuccess) { grid = -1; return; }
        if (hipFuncSetAttribute((const void*)mega_fwd, hipFuncAttributeMaxDynamicSharedMemorySize, LDS_BYTES) != hipSuccess) { fprintf(stderr, "kernel_launch: hipFuncSetAttribute failed\n"); grid = -1; return; }
        if (hipOccupancyMaxActiveBlocksPerMultiprocessor(&per_cu, (const void*)mega_fwd, 512, LDS_BYTES) != hipSuccess || per_cu < 1) { fprintf(stderr, "kernel_launch: occupancy query says %d blocks per CU\n", per_cu); (void)hipGetLastError(); grid = -1; return; }
        grid = cus;
    }
    if (grid < 0) return;
    (void)hipMemsetAsync((char*)d_ws + WS_CTL, 0, 65536, stream);
    PArgs p{}; for (int i = 0; i < 30; ++i) p.in[i] = (const float*)d_in[i]; p.out = (float*)d_out; p.ws = (unsigned char*)d_ws;
    hipLaunchKernelGGL(mega_fwd, dim3(grid), dim3(512), LDS_BYTES, stream, p);
}
```

```cpp
#include <hip/hip_runtime.h>
#include <cstdio>
#include <cstdint>
__device__ __forceinline__ int ltid() { int t = threadIdx.x; asm volatile("" : "+v"(t)); return t; }
namespace pg8 {
#define PG8_LAS __attribute__((address_space(3)))
typedef unsigned short bf16_t;
typedef short bf16x8 __attribute__((ext_vector_type(8)));
typedef float f32x4 __attribute__((ext_vector_type(4)));
typedef unsigned u32x4 __attribute__((ext_vector_type(4)));
constexpr int BM = 256, BK = 64, HALF = 128, HTB = HALF * BK * 2  , STAGE_BYTES = 8 * HTB, NXCD = 8, WGM = 8;

__host__ __device__ __forceinline__ int lds_byte(int r, int c) { const int st = (r >> 4) * 2 + (c >> 5), rr = r & 15, cc = c & 31, ob = rr * 64 + cc * 2; return st * 1024 + (ob ^ (((ob >> 9) & 1) << 5)); }
__host__ __device__ __forceinline__ void stage_rc(int b, int& R, int& C) { const int st = b / 1024, sb = b % 1024, swz = sb ^ (((sb >> 9) & 1) << 5); R = (st >> 1) * 16 + swz / 64; C = (st & 1) * 32 + (swz % 64) / 2; }
__host__ __device__ __forceinline__ int perm32(int rho) { const int n = rho >> 4, i = rho & 15; return 8 * (i >> 2) + 4 * n + (i & 3); }
struct Unit { int pm, pn; const char* a; const char* b; };
struct Gemm { int K; };

struct StaticOrder {
    int nM, nN, nwg, G, c; const char* A; const char* Bt; size_t tstep;
    __device__ void init(const void* A_, const void* Bt_, int M, int N, int K, int G_, int c_) { nM = M / BM; nN = N / BM; nwg = nM * nN; G = G_; c = c_; A = (const char*)A_; Bt = (const char*)Bt_; tstep = (size_t)BM * K * 2; }
    __device__ bool next(int i, Unit& u) const {
        const long L = (long)i * G + c; if (L >= nwg) return false;
        int wgid = (int)L; { const int q = nwg / NXCD, r = nwg % NXCD, xcd = wgid % NXCD, off = wgid / NXCD; wgid = (xcd < r ? xcd * (q + 1) : r * (q + 1) + (xcd - r) * q) + off; }
        const int nig = WGM * nN, gid = wgid / nig, fm = gid * WGM, gsz = (nM - fm) < WGM ? (nM - fm) : WGM;
        u.pm = fm + ((wgid % nig) % gsz); u.pn = (wgid % nig) / gsz; u.a = A + (size_t)u.pm * tstep; u.b = Bt + (size_t)u.pn * tstep; return true;
    }
    __device__ __forceinline__ void a_ready(const Unit&) const {}
    __device__ __forceinline__ void done(const Unit&) const {}
};
__device__ __forceinline__ unsigned cvt_pk_bf16(float lo, float hi) { unsigned r; asm volatile("v_cvt_pk_bf16_f32 %0, %1, %2" : "=v"(r) : "v"(lo), "v"(hi)); return r; }
template <class Epi, class Sched, bool ALIGN_EPI = false, bool SP2 = false>
__device__ __forceinline__ void gemm_phase(PG8_LAS unsigned char* lds, const Gemm g, const Sched& S, const Epi& E) {
    const int tid = ltid(), wid = __builtin_amdgcn_readfirstlane(tid >> 6), lane = tid & 63, wr = wid >> 2, wc = wid & 3, fr = lane & 15, fq = lane >> 4;
    const int K = g.K, nt = K / BK;
    unsigned voffA[2], voffB[2];
#pragma unroll
    for (int i = 0; i < 2; ++i) { int R, C; stage_rc(tid * 16 + i * 8192, R, C); const int Rb = Epi::PERM ? ((R & ~31) + perm32(R & 31)) : R;
        voffA[i] = (unsigned)(R * K + C) * 2u; voffB[i] = (unsigned)(Rb * K + C) * 2u; }
    const size_t kstep = (size_t)(BK * 2);
    const size_t hstep = (size_t)HALF * K * 2;
        const unsigned ldsw = (unsigned)wid * 1024u;
    const int aoff = lds_byte(wr * 64 + fr, fq * 8), boff = lds_byte(wc * 32 + fr, fq * 8);
#define PG8_SA(b, h) (((b) * 2 + (h)) * HTB)
#define PG8_SB(b, h) ((4 + (b) * 2 + (h)) * HTB)
#define PG8_STAGE(bufoff, gbase, voff) do { _Pragma("unroll") for (int _i = 0; _i < 2; ++_i) \
        __builtin_amdgcn_global_load_lds((const unsigned*)((const char*)(gbase) + (voff)[_i]), (PG8_LAS unsigned*)(lds + (bufoff) + ldsw + _i * 8192), 16, 0, 0); } while (0)
#define PG8_LDA(dst, b, h) do { _Pragma("unroll") for (int m = 0; m < 4; ++m) _Pragma("unroll") for (int k = 0; k < 2; ++k) dst[m][k] = *(const PG8_LAS bf16x8*)(lds + PG8_SA(b, h) + aoff + m * 2048 + k * 1024); } while (0)
#define PG8_LDB(dst, b, h) do { _Pragma("unroll") for (int n = 0; n < 2; ++n) _Pragma("unroll") for (int k = 0; k < 2; ++k) dst[n][k] = *(const PG8_LAS bf16x8*)(lds + PG8_SB(b, h) + boff + n * 2048 + k * 1024); } while (0)
#define PG8_MMA(ai, bj, At, Bt) do { __builtin_amdgcn_s_setprio(1); _Pragma("unroll") for (int m = 0; m < 4; ++m) _Pragma("unroll") for (int n = 0; n < 2; ++n) _Pragma("unroll") for (int k = 0; k < 2; ++k) \
        acc[ai][bj][m][n] = __builtin_amdgcn_mfma_f32_16x16x32_bf16(Bt[n][k], At[m][k], acc[ai][bj][m][n], 0, 0, 0); __builtin_amdgcn_s_setprio(0); } while (0)
#define PG8_WAIT_V(n) asm volatile("s_waitcnt vmcnt(" #n ")" ::: "memory")
#define PG8_WAIT_L(n) asm volatile("s_waitcnt lgkmcnt(" #n ")" ::: "memory")
#define PG8_BAR __builtin_amdgcn_s_barrier()
#define PG8_SCHED __builtin_amdgcn_sched_barrier(0)
    Unit cur, nxt; int ui = 0;
    if (!S.next(0, cur)) return;
    f32x4 acc[2][2][4][2];
#pragma unroll
    for (int a = 0; a < 2; ++a)
#pragma unroll
        for (int b = 0; b < 2; ++b)
#pragma unroll
            for (int m = 0; m < 4; ++m)
#pragma unroll
                for (int n = 0; n < 2; ++n) acc[a][b][m][n] = (f32x4){0.f, 0.f, 0.f, 0.f};
    bf16x8 At[4][2], B0[2][2], B1[2][2];
    const char* cA = cur.a; const char* cB = cur.b;
    S.a_ready(cur);
    if constexpr (SP2) {
        PG8_STAGE(PG8_SB(0, 0), cB, voffB); PG8_STAGE(PG8_SB(0, 1), cB + hstep, voffB); PG8_STAGE(PG8_SA(0, 0), cA, voffA); PG8_STAGE(PG8_SA(0, 1), cA + hstep, voffA);
        if (wr == 1) PG8_BAR;
        PG8_WAIT_V(2); PG8_BAR;
        PG8_STAGE(PG8_SB(1, 0), cB + kstep, voffB); PG8_STAGE(PG8_SA(1, 0), cA + kstep, voffA); PG8_STAGE(PG8_SB(1, 1), cB + hstep + kstep, voffB);
        PG8_WAIT_V(6); PG8_BAR;
    } else {
        PG8_STAGE(PG8_SB(0, 0), cB, voffB); PG8_STAGE(PG8_SA(0, 0), cA, voffA); PG8_STAGE(PG8_SB(0, 1), cB + hstep, voffB); PG8_STAGE(PG8_SA(0, 1), cA + hstep, voffA);
        if (wr == 1) PG8_BAR;
        PG8_WAIT_V(4); PG8_BAR;
        PG8_STAGE(PG8_SB(1, 0), cB + kstep, voffB); PG8_STAGE(PG8_SA(1, 0), cA + kstep, voffA); PG8_STAGE(PG8_SB(1, 1), cB + hstep + kstep, voffB);
        PG8_WAIT_V(6); PG8_BAR;
    }
    for (;;) {
        const bool has_next = S.next(ui + 1, nxt);
        const char* nA = has_next ? nxt.a : cA; const char* nB = has_next ? nxt.b : cB;
        for (int t = 0; t < nt; t += 2) {
            const bool last = (t == nt - 2);
            const char* a1 = cA + (size_t)(t + 1) * kstep;
            const char* a2 = last ? nA : cA + (size_t)(t + 2) * kstep; const char* b2 = last ? nB : cB + (size_t)(t + 2) * kstep;
            const char* a3 = a2 + kstep; const char* b3 = b2 + kstep;
            if (last && has_next) S.a_ready(nxt);
            if constexpr (SP2) {
            PG8_LDB(B0, 0, 0); PG8_LDB(B1, 0, 1); PG8_SCHED; PG8_LDA(At, 0, 0); PG8_STAGE(PG8_SA(1, 1), a1 + hstep, voffA);
            PG8_WAIT_V(8); PG8_WAIT_L(0); PG8_BAR; PG8_MMA(0, 0, At, B0); PG8_MMA(0, 1, At, B1); PG8_BAR; PG8_SCHED;
            PG8_LDA(At, 0, 1); PG8_STAGE(PG8_SB(0, 0), b2, voffB); PG8_STAGE(PG8_SB(0, 1), b2 + hstep, voffB); PG8_STAGE(PG8_SA(0, 0), a2, voffA);
            PG8_WAIT_V(8); PG8_WAIT_L(0); PG8_BAR; PG8_MMA(1, 0, At, B0); PG8_MMA(1, 1, At, B1); PG8_BAR; PG8_SCHED;
            PG8_LDB(B0, 1, 0); PG8_LDB(B1, 1, 1); PG8_SCHED; PG8_LDA(At, 1, 0); PG8_STAGE(PG8_SA(0, 1), a2 + hstep, voffA);
            PG8_WAIT_V(8); PG8_WAIT_L(0); PG8_BAR; PG8_MMA(0, 0, At, B0); PG8_MMA(0, 1, At, B1); PG8_BAR; PG8_SCHED;
            PG8_LDA(At, 1, 1); PG8_STAGE(PG8_SB(1, 0), b3, voffB); PG8_STAGE(PG8_SB(1, 1), b3 + hstep, voffB); PG8_STAGE(PG8_SA(1, 0), a3, voffA);
            PG8_WAIT_V(8); PG8_WAIT_L(0); PG8_BAR; PG8_MMA(1, 0, At, B0); PG8_MMA(1, 1, At, B1); PG8_BAR; PG8_SCHED;
            } else {
            PG8_LDB(B0, 0, 0); PG8_SCHED; PG8_LDA(At, 0, 0); PG8_STAGE(PG8_SA(1, 1), a1 + hstep, voffA);
            PG8_WAIT_L(8); PG8_BAR; PG8_WAIT_L(0); PG8_MMA(0, 0, At, B0); PG8_BAR; PG8_SCHED;
            PG8_LDB(B1, 0, 1); PG8_STAGE(PG8_SB(0, 0), b2, voffB);
            PG8_BAR; PG8_WAIT_L(0); PG8_MMA(0, 1, At, B1); PG8_BAR;
            PG8_LDA(At, 0, 1); PG8_STAGE(PG8_SA(0, 0), a2, voffA);
            PG8_BAR; PG8_WAIT_L(0); PG8_MMA(1, 0, At, B0); PG8_BAR; PG8_SCHED;
            PG8_STAGE(PG8_SB(0, 1), b2 + hstep, voffB);
            PG8_WAIT_V(6); PG8_BAR; PG8_MMA(1, 1, At, B1); PG8_BAR;
            PG8_LDB(B0, 1, 0); PG8_SCHED; PG8_LDA(At, 1, 0); PG8_STAGE(PG8_SA(0, 1), a2 + hstep, voffA);
            PG8_WAIT_L(8); PG8_BAR; PG8_WAIT_L(0); PG8_MMA(0, 0, At, B0); PG8_BAR; PG8_SCHED;
            PG8_LDB(B1, 1, 1); PG8_STAGE(PG8_SB(1, 0), b3, voffB);
            PG8_BAR; PG8_WAIT_L(0); PG8_MMA(0, 1, At, B1); PG8_BAR;
            PG8_LDA(At, 1, 1); PG8_STAGE(PG8_SA(1, 0), a3, voffA);
            PG8_BAR; PG8_WAIT_L(0); PG8_MMA(1, 0, At, B0); PG8_BAR; PG8_SCHED;
            PG8_STAGE(PG8_SB(1, 1), b3 + hstep, voffB);
            PG8_WAIT_V(6); PG8_BAR; PG8_MMA(1, 1, At, B1); PG8_BAR;
            }
        }
        if constexpr (ALIGN_EPI) { if (wr == 0) PG8_BAR; }
        if constexpr (!Epi::AFTER_DRAIN) { E(acc, cur, wr, wc, fr, fq); S.done(cur); }
        if (!has_next) break;
#pragma unroll
        for (int a = 0; a < 2; ++a)
#pragma unroll
            for (int b = 0; b < 2; ++b)
#pragma unroll
                for (int m = 0; m < 4; ++m)
#pragma unroll
                    for (int n = 0; n < 2; ++n) acc[a][b][m][n] = (f32x4){0.f, 0.f, 0.f, 0.f};
        cur = nxt; cA = nA; cB = nB; ++ui;
        if constexpr (ALIGN_EPI) { if (wr == 1) PG8_BAR; }
    }
    PG8_WAIT_V(0);
    if constexpr (!ALIGN_EPI) { if (wr == 0) PG8_BAR; }
    PG8_BAR;
    if constexpr (Epi::AFTER_DRAIN) { E.fused(acc, cur, wr, wc, fr, fq, lds, wid, lane); S.done(cur); }
#undef PG8_SA
#undef PG8_SB
#undef PG8_STAGE
#undef PG8_LDA
#undef PG8_LDB
#undef PG8_MMA
#undef PG8_WAIT_V
#undef PG8_WAIT_L
#undef PG8_BAR
#undef PG8_SCHED
}
}
#include <hip/hip_bf16.h>
#include <cmath>
namespace attn_body {
using bf16=__hip_bfloat16;
using bf16x8=__attribute__((ext_vector_type(8)))short;
using s16x4=__attribute__((ext_vector_type(4)))short;
using f32x16=__attribute__((ext_vector_type(16)))float;
using u32x4=__attribute__((ext_vector_type(4)))unsigned;
constexpr int NHEAD=8,SEQ=2048,D=64,PQ=512,PK=512,PV=5376,PO=512;
constexpr int NW=8,QBLK=32,QB=QBLK*NW,KVBLK=64,NQB=SEQ/QB;
__device__ __forceinline__ int crow(int r,int hi){return (r&3)+8*(r>>2)+4*hi;}
#define SBAR() __builtin_amdgcn_sched_barrier(0)
__device__ __forceinline__ void cmask(f32x16&p0,f32x16&p1,int jb,int qrel,int hi){
  const float NEG=-INFINITY; int kb=64*jb+4*hi;
  #pragma unroll
  for(int r=0;r<16;++r){int kv=kb+(r&3)+8*(r>>2); if(kv>qrel)p0[r]=NEG; if(kv+32>qrel)p1[r]=NEG;}
}

constexpr int NSLOT=3, SLOTB=8192;
constexpr int LDS_K=0, LDS_V=NSLOT*SLOTB, LDS_WS=2*NSLOT*SLOTB, LDS_OST=LDS_WS+NW*64*4, LDS_BYTES=LDS_OST+NW*4096;
constexpr float C2=0.125f*1.4426950408889634f;
__device__ __forceinline__ void glds16(const void*gsrc,unsigned lds_dst){unsigned keep;
  asm volatile("s_mov_b32 %0, m0\n\ts_mov_b32 m0, %2\n\ts_nop 0\n\tglobal_load_lds_dwordx4 %1, off\n\ts_mov_b32 m0, %0":"=&s"(keep):"v"(gsrc),"s"(lds_dst):"memory");}
__device__ __forceinline__ float max3f(float a,float b,float c){float r;asm("v_max3_f32 %0, %1, %2, %3":"=v"(r):"v"(a),"v"(b),"v"(c));return r;}
__device__ __forceinline__ float max2f(float a,float b){float r;asm("v_max_f32_e32 %0, %1, %2":"=v"(r):"v"(a),"v"(b));return r;}
__device__ __forceinline__ float fadd_s(float a,float b){float r;asm("v_add_f32_e32 %0, %1, %2":"=v"(r):"v"(a),"v"(b));return r;}
__device__ __forceinline__ float fsub_s(float a,float b){float r;asm("v_sub_f32_e32 %0, %1, %2":"=v"(r):"v"(a),"v"(b));return r;}
typedef float f32x2_t __attribute__((ext_vector_type(2))); typedef __bf16 bf16x2_t __attribute__((ext_vector_type(2)));
__device__ __forceinline__ unsigned cvtpk_s(float lo,float hi){f32x2_t v={lo,hi};bf16x2_t b=__builtin_convertvector(v,bf16x2_t);return __builtin_bit_cast(unsigned,b);}
#define WAIT_BAR(N) asm volatile("s_waitcnt vmcnt(" #N ") lgkmcnt(0)\n\ts_barrier":::"memory")

__device__ __forceinline__ void qkt(f32x16&p0,f32x16&p1,const char*Kslot,const bf16x8*qr,const f32x16&negm,int r32,int hi){
  const char*kb=Kslot+hi*1024+r32*16;
  #pragma unroll
  for(int d0=0;d0<4;++d0){
    const bf16x8 b0=*reinterpret_cast<const bf16x8*>(kb+d0*2048);
    const bf16x8 b1=*reinterpret_cast<const bf16x8*>(kb+d0*2048+512);
    if(d0==0){p0=__builtin_amdgcn_mfma_f32_32x32x16_bf16(b0,qr[0],negm,0,0,0);p1=__builtin_amdgcn_mfma_f32_32x32x16_bf16(b1,qr[0],negm,0,0,0);}
    else{p0=__builtin_amdgcn_mfma_f32_32x32x16_bf16(b0,qr[d0],p0,0,0,0);p1=__builtin_amdgcn_mfma_f32_32x32x16_bf16(b1,qr[d0],p1,0,0,0);}}
}
typedef __attribute__((address_space(3))) const char* lds_cptr;
typedef short v4i16_t __attribute__((ext_vector_type(4)));
__device__ __forceinline__ void kload8(bf16x8*kf,lds_cptr kp){
  kf[0]=*(const __attribute__((address_space(3))) bf16x8*)(kp);      kf[1]=*(const __attribute__((address_space(3))) bf16x8*)(kp+512);
  kf[2]=*(const __attribute__((address_space(3))) bf16x8*)(kp+2048); kf[3]=*(const __attribute__((address_space(3))) bf16x8*)(kp+2560);
  kf[4]=*(const __attribute__((address_space(3))) bf16x8*)(kp+4096); kf[5]=*(const __attribute__((address_space(3))) bf16x8*)(kp+4608);
  kf[6]=*(const __attribute__((address_space(3))) bf16x8*)(kp+6144); kf[7]=*(const __attribute__((address_space(3))) bf16x8*)(kp+6656);
}
__device__ __forceinline__ void kload2(bf16x8*kf,lds_cptr kp,int j){ kf[2*j]=*(const __attribute__((address_space(3))) bf16x8*)(kp+j*2048); kf[2*j+1]=*(const __attribute__((address_space(3))) bf16x8*)(kp+j*2048+512); }
__device__ __forceinline__ s16x4 vtr(lds_cptr p){ return __builtin_bit_cast(s16x4,__builtin_amdgcn_ds_read_tr16_b64_v4i16((__attribute__((address_space(3))) v4i16_t*)p)); }
__device__ __forceinline__ float rowmax(const f32x16&p0,const f32x16&p1){
  float a=max3f(p0[0],p0[1],p1[0]),b=max3f(p0[2],p0[3],p1[1]);a=max3f(a,p1[2],p1[3]);
  #pragma unroll
  for(int r=4;r<16;r+=4){a=max3f(a,p0[r],p0[r+1]);b=max3f(b,p0[r+2],p0[r+3]);a=max3f(a,p1[r],p1[r+1]);b=max3f(b,p1[r+2],p1[r+3]);}
  const float m=max2f(a,b);
  auto rr=__builtin_amdgcn_permlane32_swap(__float_as_uint(m),__float_as_uint(m),false,false);
  return max2f(__uint_as_float(rr[0]),__uint_as_float(rr[1]));
}
__device__ __forceinline__ void pv(f32x16*o,int vb,bf16x8 pa0,bf16x8 pa1,bf16x8 pa2,bf16x8 pa3){
  #pragma unroll
  for(int d0=0;d0<2;++d0){s16x4 lo[4],hi[4];
    #pragma unroll
    for(int ks=0;ks<4;++ks){
      asm volatile("ds_read_b64_tr_b16 %0,%1 offset:%c2":"=&v"(lo[ks]):"v"(vb),"i"(d0*4096+ks*1024):"memory");
      asm volatile("ds_read_b64_tr_b16 %0,%1 offset:%c2":"=&v"(hi[ks]):"v"(vb),"i"(d0*4096+ks*1024+512):"memory");}
    asm volatile("s_waitcnt lgkmcnt(0)":::"memory");SBAR();
    #define PK(k) (bf16x8){lo[k][0],lo[k][1],lo[k][2],lo[k][3],hi[k][0],hi[k][1],hi[k][2],hi[k][3]}
    o[d0]=__builtin_amdgcn_mfma_f32_32x32x16_bf16(pa0,PK(0),o[d0],0,0,0);
    o[d0]=__builtin_amdgcn_mfma_f32_32x32x16_bf16(pa1,PK(1),o[d0],0,0,0);
    o[d0]=__builtin_amdgcn_mfma_f32_32x32x16_bf16(pa2,PK(2),o[d0],0,0,0);
    o[d0]=__builtin_amdgcn_mfma_f32_32x32x16_bf16(pa3,PK(3),o[d0],0,0,0);
    #undef PK
  }
}

#ifndef ATTN_STORE16
#define ATTN_STORE16(p,v) (*(u32x4*)(p)=(v))
#endif
template<int THRL> __device__ __forceinline__ void attn_unit(int b,int h,int qb,const bf16*Q,const bf16*__restrict__ K,const bf16*__restrict__ V,bf16*O,const unsigned char*__restrict__ SEL,char*shm){
  int tid_=threadIdx.x; asm volatile("":"+v"(tid_)); const int tid=tid_,lane=tid&63,r32=lane&31,hi=lane>>5;     const int wid=__builtin_amdgcn_readfirstlane(tid>>6);
  const long rowbase=(long)b*SEQ; const int q0=qb*QB;
  const bf16*Qw=Q+(rowbase+q0+wid*QBLK)*PQ+h*D;
  const bf16*Kh=K+rowbase*PK+h*D,*Vh=V+rowbase*PV+h*D;
  const unsigned lds0=(unsigned)(uintptr_t)shm;
  float*wsf=(float*)(shm+LDS_WS)+wid*64;
  const bf16*ksrc=Kh+(long)lane*PK+wid*8;
  const bf16*vsrc=Vh+(long)(16*(wid&3)+(lane>>2))*PV+(wid>>2)*32+(lane&3)*8;
  const unsigned kdst=lds0+LDS_K+wid*1024, vdst=lds0+LDS_V+wid*1024;
  #define TROW(t) ((long)(((t)<4)?(q0+(t)*KVBLK):(((t)-4)*KVBLK)))
  #define DMA_K(t,slot) glds16(ksrc+TROW(t)*PK,(unsigned)__builtin_amdgcn_readfirstlane(kdst+(slot)))
  #define DMA_V(t,slot) glds16(vsrc+TROW(t)*PV,(unsigned)__builtin_amdgcn_readfirstlane(vdst+(slot)))
  const int vb0=(int)(lds0+LDS_V)+((lane>>4)&1)*32+(lane&3)*8+(4*hi+((lane&15)>>2))*64;
  const char*Kbase=shm+LDS_K; bf16x8 kf[8];
  const lds_cptr shm3=(lds_cptr)shm; const lds_cptr kp0=shm3+LDS_K+hi*1024+r32*16; const lds_cptr vp0=shm3+LDS_V+((lane>>4)&1)*32+(lane&3)*8+(4*hi+((lane&15)>>2))*64;
  const int NT=(q0+QB)/KVBLK;
  DMA_K(0,0);DMA_V(0,0);DMA_K(1,SLOTB);
  bf16x8 qr[4];
  #pragma unroll
  for(int d0=0;d0<4;++d0)qr[d0]=*reinterpret_cast<const bf16x8*>(&Qw[(long)r32*PQ+d0*16+hi*8]);
  float mhat=0.f,l_reg=0.f;f32x16 o[2];o[0]=f32x16{};o[1]=f32x16{};
  const int qrel=wid*QBLK+r32;
  const unsigned selb=(unsigned)SEL[((long)(b*NHEAD+h))*SEQ+q0+qrel];
  #define CMASK(P0,P1,t) cmask(P0,P1,(t),qrel,hi)
  #define SUBREF(C0,C1,t) do{ const float sb_=(((t)<4)||((selb>>(((t)-4)>>2))&1u))?mhat:INFINITY; _Pragma("unroll") for(int r_=0;r_<16;++r_){C0[r_]-=sb_;C1[r_]-=sb_;} }while(0)
  bool resc=false;
  #define START(P0,P1) do{ const float rm=rowmax(P0,P1); resc=false; \
    { const float dl=rm; mhat=fadd_s(mhat,dl); \
      _Pragma("unroll") for(int r=0;r<16;++r){P0[r]=fsub_s(P0[r],dl);P1[r]=fsub_s(P1[r],dl);} \
      } \
    _Pragma("unroll") for(int r=0;r<16;++r)P0[r]=__builtin_amdgcn_exp2f(P0[r]); }while(0)
  #define RESC() do{ if(resc){ asm volatile("s_waitcnt lgkmcnt(0)":::"memory"); \
      _Pragma("unroll") for(int d_=0;d_<2;++d_) _Pragma("unroll") for(int r=0;r<16;++r)o[d_][r]*=wsf[crow(r,hi)]; } }while(0)
  f32x16 pA0,pA1,pB0,pB1;
  int sl_prev=0,sl_cur=0,sl_next=SLOTB;
  #define ROT() do{sl_prev=sl_cur;sl_cur=sl_next;sl_next=(sl_next==(NSLOT-1)*SLOTB)?0:sl_next+SLOTB;}while(0)
  DMA_K(2,2*SLOTB);
  WAIT_BAR(3);
  qkt(pA0,pA1,Kbase,qr,f32x16{},r32,hi);asm volatile("s_nop 15\n\ts_nop 7":"+v"(pA0),"+v"(pA1));CMASK(pA0,pA1,0);
  START(pA0,pA1);
  _Pragma("unroll") for(int r=0;r<16;++r)pA1[r]=__builtin_amdgcn_exp2f(pA1[r]);
  WAIT_BAR(0);
  DMA_K(3,0);DMA_V(1,SLOTB);
  ROT();
  kload8(kf,kp0+sl_cur);
  WAIT_BAR(2);
  s16x4 vlo[8],vhi[8]; u32x4 pw0,pw1,pw2,pw3;
  #define PKW(P,B) cvtpk_s(P[B],P[B+1])
  #define PAF(k) __builtin_bit_cast(bf16x8,pw##k)
  #define VFR(i) (bf16x8){vlo[i][0],vlo[i][1],vlo[i][2],vlo[i][3],vhi[i][0],vhi[i][1],vhi[i][2],vhi[i][3]}
  #define PIN(x) asm volatile("":"+v"(x))
  #define MX3(a,b,c) __builtin_fmaxf(__builtin_fmaxf((a),(b)),(c))
  #define GAPA(MF,A0,A1,A2,A3,W0,W1,PW) do{ MF; sacc+=A0; sacc+=A1; sacc+=A2; sacc+=A3; PIN(sacc); W0; W1; PIN(PW); SBAR(); }while(0)
  #define EX(v) __builtin_amdgcn_exp2f(v)
  #define GAPB(MF,X,B) do{ MF; X[B]=EX(X[B]); X[B+1]=EX(X[B+1]); X[B+2]=EX(X[B+2]); X[B+3]=EX(X[B+3]); PIN(X); SBAR(); }while(0)
  #define VRD(i) do{ vlo[i]=vtr(vp_+(((i)>>2)*4096+((i)&3)*1024)); vhi[i]=vtr(vp_+(((i)>>2)*4096+((i)&3)*1024+512)); }while(0)
  #define KRD(G,j) do{ if(G){ kload2(kf,kp0+sl_next,j); SBAR(); } }while(0)
  #define STEP(C0,C1,P0,P1,t,GK,GV,GL,MB) do{ SBAR(); \
    const lds_cptr vp_=vp0+sl_prev; \
    VRD(0); SBAR(); float sacc=(P0[0]+P0[1]); \
    GAPA(C0=__builtin_amdgcn_mfma_f32_32x32x16_bf16(kf[0],qr[0],f32x16{},0,0,0), P0[2],P0[3],P0[4],P0[5],     pw0[0]=PKW(P0,0), pw0[1]=PKW(P0,2), pw0); \
    VRD(4); SBAR(); GAPA(C1=__builtin_amdgcn_mfma_f32_32x32x16_bf16(kf[1],qr[0],f32x16{},0,0,0), P0[6],P0[7],P0[8],P0[9],     pw0[2]=PKW(P0,4), pw0[3]=PKW(P0,6), pw0); \
    VRD(1); SBAR(); GAPA(C0=__builtin_amdgcn_mfma_f32_32x32x16_bf16(kf[2],qr[1],C0,0,0,0),   P0[10],P0[11],P0[12],P0[13], pw1[0]=PKW(P0,8), pw1[1]=PKW(P0,10), pw1); \
    VRD(5); SBAR(); GAPA(C1=__builtin_amdgcn_mfma_f32_32x32x16_bf16(kf[3],qr[1],C1,0,0,0),   P0[14],P0[15],P1[0],P1[1],   pw1[2]=PKW(P0,12),pw1[3]=PKW(P0,14), pw1); \
    VRD(2); SBAR(); GAPA(C0=__builtin_amdgcn_mfma_f32_32x32x16_bf16(kf[4],qr[2],C0,0,0,0),   P1[2],P1[3],P1[4],P1[5],     pw2[0]=PKW(P1,0), pw2[1]=PKW(P1,2), pw2); \
    VRD(6); SBAR(); GAPA(C1=__builtin_amdgcn_mfma_f32_32x32x16_bf16(kf[5],qr[2],C1,0,0,0),   P1[6],P1[7],P1[8],P1[9],     pw2[2]=PKW(P1,4), pw2[3]=PKW(P1,6), pw2); \
    VRD(3); SBAR(); GAPA(C0=__builtin_amdgcn_mfma_f32_32x32x16_bf16(kf[6],qr[3],C0,0,0,0),   P1[10],P1[11],P1[12],P1[13], pw3[0]=PKW(P1,8), pw3[1]=PKW(P1,10), pw3); \
    VRD(7); SBAR(); GAPA(C1=__builtin_amdgcn_mfma_f32_32x32x16_bf16(kf[7],qr[3],C1,0,0,0),   P1[14],P1[15],0.f,0.f,       pw3[2]=PKW(P1,12),pw3[3]=PKW(P1,14), pw3); \
    l_reg+=sacc; \
    if(GK){DMA_K((t)+3,sl_cur);} if(GV){DMA_V((t)+1,sl_next);} \
    SUBREF(C0,C1,t); if(MB){CMASK(C0,C1,t);} \
    { float a=MX3(C0[0],C0[1],C1[0]),b=MX3(C0[2],C0[3],C1[1]); a=MX3(a,C1[2],C1[3]); \
      _Pragma("unroll") for(int r=4;r<16;r+=4){a=MX3(a,C0[r],C0[r+1]);b=MX3(b,C0[r+2],C0[r+3]);a=MX3(a,C1[r],C1[r+1]);b=MX3(b,C1[r+2],C1[r+3]);} \
      float rm=__builtin_fmaxf(a,b); { auto rr=__builtin_amdgcn_permlane32_swap(__float_as_uint(rm),__float_as_uint(rm),false,false); rm=__builtin_fmaxf(__uint_as_float(rr[0]),__uint_as_float(rr[1])); } \
      resc=false; \
      if(__builtin_expect(__any(rm>(float)THRL),0)){ const float dl=__builtin_fmaxf(rm,0.f); mhat+=dl; \
        _Pragma("unroll") for(int r=0;r<16;++r){C0[r]-=dl;C1[r]-=dl;} \
        const float f=__builtin_amdgcn_exp2f(-dl); l_reg*=f; if(hi==0)wsf[r32]=f; resc=true; } } \
    SBAR(); \
    GAPB(o[0]=__builtin_amdgcn_mfma_f32_32x32x16_bf16(PAF(0),VFR(0),o[0],0,0,0), C0,0); \
    GAPB(o[1]=__builtin_amdgcn_mfma_f32_32x32x16_bf16(PAF(0),VFR(4),o[1],0,0,0), C0,4); \
    KRD(GL,0); GAPB(o[0]=__builtin_amdgcn_mfma_f32_32x32x16_bf16(PAF(1),VFR(1),o[0],0,0,0), C0,8); \
    KRD(GL,1); GAPB(o[1]=__builtin_amdgcn_mfma_f32_32x32x16_bf16(PAF(1),VFR(5),o[1],0,0,0), C0,12); \
    KRD(GL,2); GAPB(o[0]=__builtin_amdgcn_mfma_f32_32x32x16_bf16(PAF(2),VFR(2),o[0],0,0,0), C1,0); \
    KRD(GL,3); GAPB(o[1]=__builtin_amdgcn_mfma_f32_32x32x16_bf16(PAF(2),VFR(6),o[1],0,0,0), C1,4); \
    GAPB(o[0]=__builtin_amdgcn_mfma_f32_32x32x16_bf16(PAF(3),VFR(3),o[0],0,0,0), C1,8); \
    GAPB(o[1]=__builtin_amdgcn_mfma_f32_32x32x16_bf16(PAF(3),VFR(7),o[1],0,0,0), C1,12); \
    }while(0)
  #define ENDW(tt) do{ if((tt)+3<NT){WAIT_BAR(2);} else if((tt)+2<NT){WAIT_BAR(1);} else {WAIT_BAR(0);} }while(0)
  { int t=1;
    for(;t+1<NT;t+=2){
      STEP(pB0,pB1,pA0,pA1,t,(t+3<NT),(t+1<NT),(t+1<NT),(t<4));       ENDW(t);   RESC(); ROT();
      STEP(pA0,pA1,pB0,pB1,t+1,(t+4<NT),(t+2<NT),(t+2<NT),(t+1<4));     ENDW(t+1); RESC(); ROT();
    }
    STEP(pB0,pB1,pA0,pA1,NT-1,false,false,false,(NT==4)); RESC();
  }
  { float sacc=pB0[0]+pB0[1]; _Pragma("unroll") for(int r=2;r<16;++r)sacc+=pB0[r]; _Pragma("unroll") for(int r=0;r<16;++r)sacc+=pB1[r]; l_reg+=sacc;
    pw0=(u32x4){PKW(pB0,0),PKW(pB0,2),PKW(pB0,4),PKW(pB0,6)};pw1=(u32x4){PKW(pB0,8),PKW(pB0,10),PKW(pB0,12),PKW(pB0,14)};pw2=(u32x4){PKW(pB1,0),PKW(pB1,2),PKW(pB1,4),PKW(pB1,6)};pw3=(u32x4){PKW(pB1,8),PKW(pB1,10),PKW(pB1,12),PKW(pB1,14)};
    SBAR(); pv(o,vb0+sl_cur,PAF(0),PAF(1),PAF(2),PAF(3)); }
  #undef PKW
  #undef PAF
  #undef VFR
  #undef PIN
  #undef MX3
  #undef GAPA
  #undef GAPB
  #undef EX
  #undef VRD
  #undef KRD
  #undef STEP
  #undef ENDW
  {auto rr=__builtin_amdgcn_permlane32_swap(__float_as_uint(l_reg),__float_as_uint(l_reg),false,false);l_reg=__uint_as_float(rr[0])+__uint_as_float(rr[1]);}
  if(hi==0)wsf[32+r32]=l_reg;asm volatile("s_waitcnt lgkmcnt(0)":::"memory");
  float rli[16];
  #pragma unroll
  for(int r=0;r<16;++r)rli[r]=__builtin_amdgcn_rcpf(wsf[32+crow(r,hi)]);
  bf16*Ow=O+(rowbase+q0+wid*QBLK)*PO+h*D;
  { bf16*stg=(bf16*)(shm+LDS_OST)+wid*2048;
    #pragma unroll
    for(int r=0;r<16;++r){const int orow=crow(r,hi);
      #pragma unroll
      for(int d0=0;d0<2;++d0)stg[orow*64+d0*32+r32]=__float2bfloat16(o[d0][r]*rli[r]);}
    asm volatile("s_waitcnt lgkmcnt(0)":::"memory");
    #pragma unroll
    for(int i=0;i<4;++i){const int row=i*8+(lane>>3),ch=lane&7; const u32x4 v=*(const u32x4*)(stg+row*64+ch*8); ATTN_STORE16(Ow+(long)row*PO+ch*8,v);} }
  asm volatile("s_waitcnt lgkmcnt(0)\n\ts_barrier":::"memory");
  #undef DMA_K
  #undef TROW
  #undef SUBREF
  #undef DMA_V
  #undef CMASK
  #undef START
  #undef RESC
  #undef ROT
}
constexpr int ATTN_LDS_BYTES=LDS_BYTES;
#undef SBAR
#undef WAIT_BAR
}
constexpr int DM = 1024, NB = 16, SEQ = 2048, NT = NB * SEQ;
constexpr int RWW = 512, INC = 5376, ZA = 1792, ZG = 3328;
constexpr int NEXP = 32, DEXP = 512;
constexpr int XS_ROWS = 2 * NT + NEXP * 256;
constexpr float C2 = 0.125f * 1.4426950408889634f;

#define LAS __attribute__((address_space(3)))
#define GAS __attribute__((address_space(1)))
typedef unsigned short bf16;
typedef unsigned v4u __attribute__((ext_vector_type(4)));
typedef unsigned v2u __attribute__((ext_vector_type(2)));
typedef float f32x4 __attribute__((ext_vector_type(4)));

__device__ __forceinline__ unsigned f2bf(float f) { unsigned u = __builtin_bit_cast(unsigned, f); return (u + 0x7fffu + ((u >> 16) & 1u)) >> 16; }
__device__ __forceinline__ unsigned pk2(float lo, float hi) { return f2bf(lo) | (f2bf(hi) << 16); }
__device__ __forceinline__ float bflo(unsigned w) { return __builtin_bit_cast(float, w << 16); }
__device__ __forceinline__ float bfhi(unsigned w) { return __builtin_bit_cast(float, w & 0xffff0000u); }
__device__ __forceinline__ float sigm(float x) { return 1.0f / (1.0f + __expf(-x)); }
__device__ __forceinline__ float wave_sum(float v) {
#pragma unroll
    for (int o = 1; o < 64; o <<= 1) v += __shfl_xor(v, o);
    return v;
}

constexpr size_t MiB = 1u << 20;
constexpr size_t WS_CTL = 0;
constexpr size_t WS_MOD = 1 * MiB;
constexpr size_t WS_COS = 2 * MiB;
constexpr size_t WS_SIN = 2 * MiB + 512 * 1024;
constexpr size_t WS_KMEAN = 3 * MiB;
constexpr size_t WS_WRT = 3 * MiB + 512 * 1024;
constexpr size_t WS_SEL = 4 * MiB;
constexpr size_t WS_RTE = 5 * MiB;
constexpr size_t WS_RTW = 5 * MiB + 256 * 1024;
constexpr size_t WS_RNK = 5 * MiB + 512 * 1024;
constexpr size_t WS_POS = 5 * MiB + 768 * 1024;
constexpr size_t WS_WLT = 6 * MiB;
constexpr size_t WS_WAT = 6 * MiB + 64 * 1024;
constexpr size_t WS_WGT = 6 * MiB + 128 * 1024;
constexpr size_t WS_WIN = 16 * MiB;
constexpr size_t WS_WBA = 27 * MiB;
constexpr size_t WS_WBB = 28 * MiB;
constexpr size_t WS_WOUT = 29 * MiB;
constexpr size_t WS_Z = 32 * MiB;
constexpr size_t WS_H = 368 * MiB;
constexpr size_t WS_Q = 368 * MiB, WS_K = 400 * MiB, WS_MRG = 368 * MiB;
constexpr size_t WS_YA = 432 * MiB, WS_YB = 464 * MiB;
constexpr size_t WS_WUP = 32 * MiB;
constexpr size_t WS_W2T = 96 * MiB;
constexpr size_t WS_H2 = 128 * MiB;
constexpr size_t WS_XS = 192 * MiB;
constexpr size_t WS_HID = 336 * MiB;
constexpr size_t WS_END = 496 * MiB;
constexpr int CW_CNT = 64;
constexpr int CW_NT = 128;
constexpr int CW_TEXP = 256;

__device__ __forceinline__ void tr_item(const float* W, int K, int N, bf16* WT, int kb, int nb, int dst_row0, LAS float* scr, int lane) {
    const int k0 = 64 * kb, n0 = 32 * nb;
#pragma unroll 8
    for (int i = 0; i < 32; ++i) { const int kk = 2 * i + (lane >> 5); scr[kk * 33 + (lane & 31)] = W[(size_t)(k0 + kk) * N + n0 + (lane & 31)]; }
    asm volatile("s_waitcnt lgkmcnt(0)" ::: "memory");
    const int c = lane & 7;
#pragma unroll
    for (int j = 0; j < 4; ++j) { const int n = (lane >> 3) + 8 * j; const LAS float* s = scr + (8 * c) * 33 + n;
        v4u o; o.x = pk2(s[0 * 33], s[1 * 33]); o.y = pk2(s[2 * 33], s[3 * 33]); o.z = pk2(s[4 * 33], s[5 * 33]); o.w = pk2(s[6 * 33], s[7 * 33]);
        *(v4u*)(WT + (size_t)(dst_row0 + n) * K + k0 + 8 * c) = o; }
    asm volatile("s_waitcnt lgkmcnt(0)" ::: "memory");
}

struct PArgs { const float* in[30]; float* out; unsigned char* ws; };

__device__ __forceinline__ void p_prep_weights(const PArgs& a, unsigned char* lds) {
    const int tid = ltid(), lane = tid & 63, wave = tid >> 6;
    LAS float* scr = (LAS float*)lds + wave * (64 * 33);
    const int gw = blockIdx.x * 8 + wave, NGW = gridDim.x * 8;
    unsigned char* ws = a.ws;
    constexpr int I_IN = 16 * 168, I_BR = 8 * 32, I_OUT = 16 * 32;
    for (int it = gw; it < I_IN + 2 * I_BR + I_OUT; it += NGW) {
        int r = it;
        if (r < I_IN) { const int kb = r / 168, nb = r % 168; tr_item(a.in[6], 1024, INC, (bf16*)(ws + WS_WIN), kb, nb, 32 * nb, scr, lane); continue; } r -= I_IN;
        if (r < I_BR) { const int kb = r / 32, nb = r % 32; tr_item(a.in[20], 512, 1024, (bf16*)(ws + WS_WBA), kb, nb, 32 * nb, scr, lane); continue; } r -= I_BR;
        if (r < I_BR) { const int kb = r / 32, nb = r % 32; tr_item(a.in[21], 512, 1024, (bf16*)(ws + WS_WBB), kb, nb, 32 * nb, scr, lane); continue; } r -= I_BR;
        { const int kb = r / 32, nb = r % 32; tr_item(a.in[22], 1024, 1024, (bf16*)(ws + WS_WOUT), kb, nb, 32 * nb, scr, lane); }
    }
    const int gt = blockIdx.x * 512 + tid, NGT = gridDim.x * 512;
    float* cosT = (float*)(ws + WS_COS); float* sinT = (float*)(ws + WS_SIN);
    for (int i = gt; i < SEQ * 32; i += NGT) { const int s = i >> 5, f = i & 31; const float inv = powf(10000.0f, -(float)f / 32.0f); const float ang = (float)s * inv; cosT[i] = cosf(ang); sinT[i] = sinf(ang); }
    { bf16* wlt = (bf16*)(ws + WS_WLT); bf16* wat = (bf16*)(ws + WS_WAT); bf16* wgt = (bf16*)(ws + WS_WGT);
      for (int i = gt; i < 8 * 64 * 64; i += NGT) { const int hh = i >> 12, j = (i >> 6) & 63, m = i & 63; wlt[i] = (bf16)f2bf(a.in[9][m * 512 + hh * 64 + j]); wat[i] = (bf16)f2bf(a.in[11][m * 512 + hh * 64 + j]); }
      for (int i = gt; i < 8 * 64 * 128; i += NGT) { const int hh = i >> 13, j = (i >> 7) & 63, m = i & 127; wgt[i] = (bf16)f2bf(a.in[12][m * 512 + hh * 64 + j]); } }
    float* wrt = (float*)(ws + WS_WRT);
    for (int i = gt; i < 36 * 1024; i += NGT) { const int e = i >> 10, k = i & 1023; wrt[i] = e < 4 ? a.in[23][k * 4 + e] : a.in[25][k * 32 + (e - 4)]; }
}

__device__ __forceinline__ void p_prep_experts(const PArgs& a, unsigned char* lds) {
    const int tid = ltid(), lane = tid & 63, wave = tid >> 6;
    LAS float* scr = (LAS float*)lds + wave * (64 * 33);
    const int gw = blockIdx.x * 8 + wave, NGW = gridDim.x * 8;
    unsigned char* ws = a.ws;
    for (int it = gw; it < NEXP * 768; it += NGW) {
        const int e = it / 768; int r = it % 768;
        bf16* wup = (bf16*)(ws + WS_WUP) + (size_t)e * 1024 * 1024;
        if (r < 256) { const int kb = r / 16, nb = r % 16, n0 = 32 * nb; tr_item(a.in[27] + (size_t)e * 1024 * 512, 1024, 512, wup, kb, nb, (n0 >> 7) * 256 + (n0 & 127), scr, lane); continue; } r -= 256;
        if (r < 256) { const int kb = r / 16, nb = r % 16, n0 = 32 * nb; tr_item(a.in[28] + (size_t)e * 1024 * 512, 1024, 512, wup, kb, nb, (n0 >> 7) * 256 + 128 + (n0 & 127), scr, lane); continue; } r -= 256;
        { const int kb = r / 32, nb = r % 32; tr_item(a.in[29] + (size_t)e * 512 * 1024, 512, 1024, (bf16*)(ws + WS_W2T) + (size_t)e * 1024 * 512, kb, nb, 32 * nb, scr, lane); }
    }
}

__device__ __forceinline__ void p_ada(const PArgs& a, unsigned char* lds) {
    float* sc = (float*)lds; float* red = sc + 16 * 1024;
    const float* c = a.in[1]; const float* w = a.in[2]; const float* bias = a.in[3];
    float* mod = (float*)(a.ws + WS_MOD);
    const int tid = ltid();
    for (int i = tid; i < 16 * 1024; i += 512) { const float v = c[i]; sc[i] = v / (1.0f + __expf(-v)); }
    __syncthreads();
    const int col = tid & 31, kg = tid >> 5;
    for (int tile = blockIdx.x; tile < 192; tile += gridDim.x) {
        const int e = tile * 32 + col;
        float acc[16];
#pragma unroll
        for (int b = 0; b < 16; ++b) acc[b] = 0.f;
        for (int d = kg * 64; d < kg * 64 + 64; ++d) { const float wv = w[(size_t)d * 6144 + e];
#pragma unroll
            for (int b = 0; b < 16; ++b) acc[b] += sc[b * 1024 + d] * wv; }
#pragma unroll
        for (int b = 0; b < 16; ++b) red[(kg * 16 + b) * 32 + col] = acc[b];
        __syncthreads();
        { const int b = tid >> 5, cc = tid & 31; float sm = 0.f;
#pragma unroll
            for (int k = 0; k < 16; ++k) sm += red[(k * 16 + b) * 32 + cc];
            mod[b * 6144 + tile * 32 + cc] = sm + bias[tile * 32 + cc]; }
        __syncthreads();
    }
}

__device__ __forceinline__ void p_norm1(const PArgs& a, unsigned char* lds) {
    const int tid = ltid(), lane = tid & 63, gw = blockIdx.x * 8 + (tid >> 6), NGW = gridDim.x * 8;
    const float* x = a.in[0]; const float* g = a.in[4]; const float* mod = (const float*)(a.ws + WS_MOD);
    bf16* h = (bf16*)(a.ws + WS_H);
    for (int m = gw; m < NT; m += NGW) {
        const int b = m >> 11; const f32x4* xr = (const f32x4*)(x + (size_t)m * DM) + lane; f32x4 v[4]; float s = 0.f;
#pragma unroll
        for (int j = 0; j < 4; ++j) { v[j] = xr[64 * j]; s += (v[j].x * v[j].x + v[j].y * v[j].y) + (v[j].z * v[j].z + v[j].w * v[j].w); }
        const float rstd = rsqrtf(wave_sum(s) * (1.0f / DM) + 1e-6f);
        v2u* o = (v2u*)(h + (size_t)m * DM) + lane;
#pragma unroll
        for (int j = 0; j < 4; ++j) { const int col = 4 * (lane + 64 * j);
            const f32x4 gg = *(const f32x4*)(g + col), sh = *(const f32x4*)(mod + b * 6144 + col), scl = *(const f32x4*)(mod + b * 6144 + 1024 + col);
            const f32x4 r = v[j] * rstd * gg * (scl + 1.0f) + sh; v2u w; w.x = pk2(r.x, r.y); w.y = pk2(r.z, r.w); o[64 * j] = w; }
    }
}

using pg8::Unit; using pg8::HALF; using pg8::BM; using pg8::cvt_pk_bf16;
typedef pg8::f32x4 pf4; typedef pg8::u32x4 pu4;

struct EpiStoreBf16 {
    static constexpr bool PERM = true, AFTER_DRAIN = false;
    bf16* O; int ldc;
    __device__ __forceinline__ void operator()(const pf4 (&acc)[2][2][4][2], const Unit& u, int wr, int wc, int fr, int fq) const {
        const int row0 = u.pm * BM + wr * 64 + fr, col0 = u.pn * BM + wc * 32 + 8 * fq;
#pragma unroll
        for (int ai = 0; ai < 2; ++ai)
#pragma unroll
            for (int m = 0; m < 4; ++m) { bf16* rowp = O + (size_t)(row0 + ai * HALF + m * 16) * ldc + col0;
#pragma unroll
                for (int bj = 0; bj < 2; ++bj) { const pf4 v0 = acc[ai][bj][m][0], v1 = acc[ai][bj][m][1]; pu4 w;
                    w.x = cvt_pk_bf16(v0[0], v0[1]); w.y = cvt_pk_bf16(v0[2], v0[3]); w.z = cvt_pk_bf16(v1[0], v1[1]); w.w = cvt_pk_bf16(v1[2], v1[3]);
                    *(pu4*)(rowp + bj * HALF) = w; } }
    }
};
struct EpiBranchA {
    static constexpr bool PERM = false, AFTER_DRAIN = false;
    float* tmp; const bf16* z;
    __device__ __forceinline__ void operator()(const pf4 (&acc)[2][2][4][2], const Unit& u, int wr, int wc, int fr, int fq) const {
        const int row0 = u.pm * BM + wr * 64 + fr, col0 = u.pn * BM + wc * 32 + 4 * fq;
#pragma unroll
        for (int ai = 0; ai < 2; ++ai)
#pragma unroll
            for (int m = 0; m < 4; ++m) { const size_t row = (size_t)(row0 + ai * HALF + m * 16);
#pragma unroll
                for (int bj = 0; bj < 2; ++bj)
#pragma unroll
                    for (int n = 0; n < 2; ++n) { const int col = col0 + bj * HALF + n * 16; const v2u gz = *(const v2u*)(z + row * INC + ZG + col); const pf4 v = acc[ai][bj][m][n];
                        pf4 o; o[0] = sigm(bflo(gz.x)) * v[0]; o[1] = sigm(bfhi(gz.x)) * v[1]; o[2] = sigm(bflo(gz.y)) * v[2]; o[3] = sigm(bfhi(gz.y)) * v[3];
                        *(pf4*)(tmp + row * DM + col) = o; } }
    }
};
struct EpiBranchB {
    static constexpr bool PERM = true, AFTER_DRAIN = false;
    const float* tmp; const bf16* z; bf16* mrg;
    __device__ __forceinline__ void operator()(const pf4 (&acc)[2][2][4][2], const Unit& u, int wr, int wc, int fr, int fq) const {
        const int row0 = u.pm * BM + wr * 64 + fr, col0 = u.pn * BM + wc * 32 + 8 * fq;
#pragma unroll
        for (int ai = 0; ai < 2; ++ai)
#pragma unroll
            for (int m = 0; m < 4; ++m) { const size_t row = (size_t)(row0 + ai * HALF + m * 16);
#pragma unroll
                for (int bj = 0; bj < 2; ++bj) { const int col = col0 + bj * HALF; const pu4 gz = *(const pu4*)(z + row * INC + ZG + 1024 + col);
                    const pf4 t0 = *(const pf4*)(tmp + row * DM + col), t1 = *(const pf4*)(tmp + row * DM + col + 4); const pf4 v0 = acc[ai][bj][m][0], v1 = acc[ai][bj][m][1];
                    pu4 w;
                    w.x = cvt_pk_bf16(t0[0] + sigm(bflo(gz.x)) * v0[0], t0[1] + sigm(bfhi(gz.x)) * v0[1]);
                    w.y = cvt_pk_bf16(t0[2] + sigm(bflo(gz.y)) * v0[2], t0[3] + sigm(bfhi(gz.y)) * v0[3]);
                    w.z = cvt_pk_bf16(t1[0] + sigm(bflo(gz.z)) * v1[0], t1[1] + sigm(bfhi(gz.z)) * v1[1]);
                    w.w = cvt_pk_bf16(t1[2] + sigm(bflo(gz.w)) * v1[2], t1[3] + sigm(bfhi(gz.w)) * v1[3]);
                    *(pu4*)(mrg + row * DM + col) = w; } }
    }
};
struct EpiOut {
    static constexpr bool PERM = false, AFTER_DRAIN = false;
    const float* x; const float* mod; float* out;
    __device__ __forceinline__ void operator()(const pf4 (&acc)[2][2][4][2], const Unit& u, int wr, int wc, int fr, int fq) const {
        const int row0 = u.pm * BM + wr * 64 + fr, col0 = u.pn * BM + wc * 32 + 4 * fq; const int b = u.pm >> 3;
        pf4 gt[2][2];
#pragma unroll
        for (int bj = 0; bj < 2; ++bj)
#pragma unroll
            for (int n = 0; n < 2; ++n) gt[bj][n] = *(const pf4*)(mod + b * 6144 + 2048 + col0 + bj * HALF + n * 16);
#pragma unroll
        for (int ai = 0; ai < 2; ++ai)
#pragma unroll
            for (int m = 0; m < 4; ++m) { const size_t off = (size_t)(row0 + ai * HALF + m * 16) * DM + col0;
#pragma unroll
                for (int bj = 0; bj < 2; ++bj)
#pragma unroll
                    for (int n = 0; n < 2; ++n) { const pf4 xv = *(const pf4*)(x + off + bj * HALF + n * 16); *(pf4*)(out + off + bj * HALF + n * 16) = xv + gt[bj][n] * acc[ai][bj][m][n]; } }
    }
};
struct EpiUp {
    static constexpr bool PERM = true, AFTER_DRAIN = false;
    bf16* hid;
    __device__ __forceinline__ void operator()(const pf4 (&acc)[2][2][4][2], const Unit& u, int wr, int wc, int fr, int fq) const {
        const int row0 = u.pm * BM + wr * 64 + fr, col0 = u.pn * 128 + wc * 32 + 8 * fq;
#pragma unroll
        for (int ai = 0; ai < 2; ++ai)
#pragma unroll
            for (int m = 0; m < 4; ++m) { const size_t row = (size_t)(row0 + ai * HALF + m * 16); float o[8];
#pragma unroll
                for (int n = 0; n < 2; ++n)
#pragma unroll
                    for (int e = 0; e < 4; ++e) { const float g = acc[ai][0][m][n][e], l = acc[ai][1][m][n][e]; o[4 * n + e] = g * sigm(g) * l; }
                pu4 w; w.x = cvt_pk_bf16(o[0], o[1]); w.y = cvt_pk_bf16(o[2], o[3]); w.z = cvt_pk_bf16(o[4], o[5]); w.w = cvt_pk_bf16(o[6], o[7]);
                *(pu4*)(hid + row * DEXP + col0) = w; }
    }
};

struct GemmArgs { unsigned char* ws; const float* x; float* out; };
template <class Epi> __device__ __forceinline__ void run_dense(const void* A, const void* Bt, int M, int N, int K, const Epi& E, unsigned char* lds) {
    pg8::Gemm g{K}; pg8::StaticOrder S; S.init(A, Bt, M, N, K, (int)gridDim.x, (int)blockIdx.x);
    pg8::gemm_phase<Epi, pg8::StaticOrder, true, true>((PG8_LAS unsigned char*)lds, g, S, E);
}
__device__ __forceinline__ void p_gemm_in(const GemmArgs& a, unsigned char* lds) {
    EpiStoreBf16 E{(bf16*)(a.ws + WS_Z), INC};
    run_dense(a.ws + WS_H, a.ws + WS_WIN, NT, INC, 1024, E, lds);
}
__device__ __forceinline__ void p_gemm_bra(const GemmArgs& a, unsigned char* lds) {
    EpiBranchA E{a.out, (const bf16*)(a.ws + WS_Z)};
    run_dense(a.ws + WS_YA, a.ws + WS_WBA, NT, 1024, 512, E, lds);
}
__device__ __forceinline__ void p_gemm_brb(const GemmArgs& a, unsigned char* lds) {
    EpiBranchB E{a.out, (const bf16*)(a.ws + WS_Z), (bf16*)(a.ws + WS_MRG)};
    run_dense(a.ws + WS_YB, a.ws + WS_WBB, NT, 1024, 512, E, lds);
}
__device__ __forceinline__ void p_gemm_out(const GemmArgs& a, unsigned char* lds) {
    EpiOut E{a.x, (const float*)(a.ws + WS_MOD), a.out};
    run_dense(a.ws + WS_MRG, a.ws + WS_WOUT, NT, 1024, 1024, E, lds);
}
struct GroupedOrder {
    const int* texp; int nT, nN, G, c; const char* A; size_t a_tile; const char* B; size_t b_exp, b_tile;
    __device__ bool next(int i, Unit& u) const {
        const long L = (long)i * G + c; if (L >= (long)nT * nN) return false;
        const int tile = (int)(L / nN), pn = (int)(L % nN); u.pm = tile; u.pn = pn; u.a = A + (size_t)tile * a_tile; u.b = B + (size_t)texp[tile] * b_exp + (size_t)pn * b_tile; return true;
    }
    __device__ __forceinline__ void a_ready(const Unit&) const {}
    __device__ __forceinline__ void done(const Unit&) const {}
};
__device__ __forceinline__ void p_gemm_up(const GemmArgs& a, unsigned char* lds) {
    const int* ctl = (const int*)(a.ws + WS_CTL);
    GroupedOrder S{ctl + CW_TEXP, ctl[CW_NT], 4, (int)gridDim.x, (int)blockIdx.x, (const char*)(a.ws + WS_XS), (size_t)256 * 1024 * 2, (const char*)(a.ws + WS_WUP), (size_t)1024 * 1024 * 2, (size_t)256 * 1024 * 2};
    EpiUp E{(bf16*)(a.ws + WS_HID)}; pg8::Gemm g{1024};
    pg8::gemm_phase<EpiUp, GroupedOrder, true, true>((PG8_LAS unsigned char*)lds, g, S, E);
}
__device__ __forceinline__ void p_gemm_down(const GemmArgs& a, unsigned char* lds) {
    const int* ctl = (const int*)(a.ws + WS_CTL);
    GroupedOrder S{ctl + CW_TEXP, ctl[CW_NT], 4, (int)gridDim.x, (int)blockIdx.x, (const char*)(a.ws + WS_HID), (size_t)256 * 512 * 2, (const char*)(a.ws + WS_W2T), (size_t)1024 * 512 * 2, (size_t)256 * 512 * 2};
    EpiStoreBf16 E{(bf16*)(a.ws + WS_XS), 1024}; pg8::Gemm g{512};
    pg8::gemm_phase<EpiStoreBf16, GroupedOrder, true, true>((PG8_LAS unsigned char*)lds, g, S, E);
}

__device__ __forceinline__ void load64bf(const bf16* p, float (&v)[64]) {
#pragma unroll
    for (int i = 0; i < 8; ++i) { const v4u w = *(const v4u*)(p + 8 * i);
        v[8 * i + 0] = bflo(w.x); v[8 * i + 1] = bfhi(w.x); v[8 * i + 2] = bflo(w.y); v[8 * i + 3] = bfhi(w.y);
        v[8 * i + 4] = bflo(w.z); v[8 * i + 5] = bfhi(w.z); v[8 * i + 6] = bflo(w.w); v[8 * i + 7] = bfhi(w.w); }
}
__device__ __forceinline__ void store64bf(bf16* p, const float (&v)[64], float sc) {
#pragma unroll
    for (int i = 0; i < 8; ++i) { v4u w; w.x = pk2(v[8 * i] * sc, v[8 * i + 1] * sc); w.y = pk2(v[8 * i + 2] * sc, v[8 * i + 3] * sc); w.z = pk2(v[8 * i + 4] * sc, v[8 * i + 5] * sc); w.w = pk2(v[8 * i + 6] * sc, v[8 * i + 7] * sc);
        *(v4u*)(p + 8 * i) = w; }
}
__device__ __forceinline__ void norm_rope(float (&v)[64], const float* g, const float* cosT, const float* sinT, int s) {
    float ss = 0.f;
#pragma unroll
    for (int d = 0; d < 64; ++d) ss += v[d] * v[d];
    const float rstd = rsqrtf(ss * (1.0f / 64.0f) + 1e-6f);
#pragma unroll
    for (int d = 0; d < 64; ++d) v[d] = v[d] * rstd * g[d];
#pragma unroll
    for (int i = 0; i < 32; ++i) { const float c = cosT[s * 32 + i], sn = sinT[s * 32 + i]; const float x1 = v[i], x2 = v[i + 32]; v[i] = x1 * c - x2 * sn; v[i + 32] = x2 * c + x1 * sn; }
}
__device__ __forceinline__ void p_kprep(const PArgs& a, unsigned char* lds) {
    float* tile = (float*)lds + (ltid() >> 8) * (256 * 65); float* red = (float*)lds + 2 * 256 * 65;
    const int tid = ltid(), half = tid >> 8, t256 = tid & 255;
    const bf16* z = (const bf16*)(a.ws + WS_Z);
    for (int base = blockIdx.x * 2; base < 1024; base += gridDim.x * 2) {
        const int blk = base + half; const bool ok = blk < 1024; const int h = blk & 7, n = (blk >> 3) & 7, b = (blk >> 6) & 15;
        const int s = n * 256 + t256; const size_t t = (size_t)b * SEQ + s;
        float v[64]; load64bf(z + t * INC + ZA + 512 + h * 64, v);
        norm_rope(v, a.in[19], (const float*)(a.ws + WS_COS), (const float*)(a.ws + WS_SIN), s);
        if (ok) store64bf((bf16*)(a.ws + WS_K) + t * 512 + h * 64, v, 1.0f);
#pragma unroll
        for (int d = 0; d < 64; ++d) tile[t256 * 65 + d] = v[d];
        __syncthreads();
        { const int d = t256 & 63, part = t256 >> 6; float sm = 0.f;
#pragma unroll 8
            for (int r = 0; r < 64; ++r) sm += tile[(part * 64 + r) * 65 + d];
            red[(half * 4 + part) * 64 + d] = sm; }
        __syncthreads();
        if (t256 < 64 && ok) { const float* r = red + half * 256; ((float*)(a.ws + WS_KMEAN))[(size_t)((b * 8 + h) * 8 + n) * 64 + t256] = ((r[t256] + r[64 + t256]) + (r[128 + t256] + r[192 + t256])) * (1.0f / 256.0f); }
        __syncthreads();
    }
}
__device__ __forceinline__ void p_qprep(const PArgs& a, unsigned char* lds) {
    const int tid = ltid(), half = tid >> 8, t256 = tid & 255;
    const bf16* z = (const bf16*)(a.ws + WS_Z);
    for (int base = blockIdx.x * 2; base < 1024; base += gridDim.x * 2) {
        const int blk = base + half; if (blk >= 1024) continue;
        const int h = blk & 7, n = (blk >> 3) & 7, b = blk >> 6;
        const int s = n * 256 + t256; const size_t t = (size_t)b * SEQ + s;
        float v[64]; load64bf(z + t * INC + ZA + h * 64, v);
        norm_rope(v, a.in[18], (const float*)(a.ws + WS_COS), (const float*)(a.ws + WS_SIN), s);
        const float* km = (const float*)(a.ws + WS_KMEAN) + (size_t)((b * 8 + h) * 8) * 64;
        float gate[7];
#pragma unroll
        for (int j = 0; j < 7; ++j) { float g = 0.f; if (j < n) {
#pragma unroll
                for (int d = 0; d < 64; ++d) g += v[d] * km[j * 64 + d]; }
            gate[j] = g; }
        unsigned sel = 0;
        if (n <= 3) sel = (1u << n) - 1u;
        else {
#pragma unroll
            for (int rep = 0; rep < 3; ++rep) { float best = -INFINITY; int bi = 0;
#pragma unroll
                for (int j = 0; j < 7; ++j) if (j < n && !((sel >> j) & 1u) && gate[j] > best) { best = gate[j]; bi = j; }
                sel |= 1u << bi; }
        }
        ((unsigned char*)(a.ws + WS_SEL))[(size_t)(b * 8 + h) * SEQ + s] = (unsigned char)sel;
        store64bf((bf16*)(a.ws + WS_Q) + t * 512 + h * 64, v, C2);
    }
}

__device__ __forceinline__ void p_attn(const PArgs& a, unsigned char* lds, int vb, int nvb) {
    const attn_body::bf16* Q = (const attn_body::bf16*)(a.ws + WS_Q); const attn_body::bf16* K = (const attn_body::bf16*)(a.ws + WS_K);
    const attn_body::bf16* V = (const attn_body::bf16*)(a.ws + WS_Z) + (ZA + 1024); attn_body::bf16* O = (attn_body::bf16*)(a.ws + WS_YB);
    const unsigned char* SEL = (const unsigned char*)(a.ws + WS_SEL);
    for (int p = vb; p < 512; p += nvb)
        for (int which = 0; which < 2; ++which) { const int bh = p >> 2, s = p & 3, qb = which ? 7 - s : s;
            attn_body::attn_unit<8>(bh >> 3, bh & 7, qb, Q, K, V, O, SEL, (char*)lds); }
}

namespace rw {
typedef short bf16x8 __attribute__((ext_vector_type(8)));
constexpr int RS = 72, RSB = RS * 2, MB = 64 * RSB;
constexpr int FS = 68;
enum { I_AT = 0, I_BT, I_AJ, I_BHJ, I_KHJ, I_X5, I_ABRT, I_L, I_LT, I_R0, I_R1, I_KT, I_RT, I_VJ, I_X14, I_GATE, I_VT, NBUF };
constexpr int OFF_F32 = NBUF * MB;
constexpr int LDS_NEED = OFF_F32 + (64 * 3 + 512) * 4;

__device__ __forceinline__ bf16x8 ldfrag(const unsigned char* M, int row, int k) { return *(const bf16x8*)(M + row * RSB + k * 2); }
__device__ __forceinline__ void mm(f32x4 (&acc)[2], const unsigned char* X, const unsigned char* Y, int mt, int nh, int fr, int fq) {
    const bf16x8 a0 = ldfrag(X, 16 * mt + fr, 8 * fq), a1 = ldfrag(X, 16 * mt + fr, 8 * fq + 32);
#pragma unroll
    for (int nt = 0; nt < 2; ++nt) { const bf16x8 b0 = ldfrag(Y, 16 * (2 * nh + nt) + fr, 8 * fq), b1 = ldfrag(Y, 16 * (2 * nh + nt) + fr, 8 * fq + 32);
        acc[nt] = __builtin_amdgcn_mfma_f32_16x16x32_bf16(a0, b0, acc[nt], 0, 0, 0); acc[nt] = __builtin_amdgcn_mfma_f32_16x16x32_bf16(a1, b1, acc[nt], 0, 0, 0); }
}
__device__ __forceinline__ void storeT(unsigned char* Z, const f32x4 (&acc)[2], int mt, int nh, int fr, int fq) {
#pragma unroll
    for (int nt = 0; nt < 2; ++nt) { v2u w; w.x = pk2(acc[nt][0], acc[nt][1]); w.y = pk2(acc[nt][2], acc[nt][3]); *(v2u*)(Z + (16 * (2 * nh + nt) + fr) * RSB + (16 * mt + 4 * fq) * 2) = w; }
}
__device__ __forceinline__ void storeN(unsigned char* Z, const f32x4 (&acc)[2], int mt, int nh, int fr, int fq) {
#pragma unroll
    for (int nt = 0; nt < 2; ++nt)
#pragma unroll
        for (int r = 0; r < 4; ++r) *(unsigned short*)(Z + (16 * mt + 4 * fq + r) * RSB + (16 * (2 * nh + nt) + fr) * 2) = (unsigned short)f2bf(acc[nt][r]);
}
__device__ __forceinline__ void ld8bf(const unsigned char* p, float (&v)[8]) { const v4u w = *(const v4u*)p; v[0] = bflo(w.x); v[1] = bfhi(w.x); v[2] = bflo(w.y); v[3] = bfhi(w.y); v[4] = bflo(w.z); v[5] = bfhi(w.z); v[6] = bflo(w.w); v[7] = bfhi(w.w); }
__device__ __forceinline__ void st8bf(unsigned char* p, const float (&v)[8]) { v4u w; w.x = pk2(v[0], v[1]); w.y = pk2(v[2], v[3]); w.z = pk2(v[4], v[5]); w.w = pk2(v[6], v[7]); *(v4u*)p = w; }
__device__ __forceinline__ void ld8f(const float* p, float (&v)[8]) { const f32x4 a = *(const f32x4*)p, b = *(const f32x4*)(p + 4); v[0] = a.x; v[1] = a.y; v[2] = a.z; v[3] = a.w; v[4] = b.x; v[5] = b.y; v[6] = b.z; v[7] = b.w; }
__device__ __forceinline__ void shift8(const bf16* zp, int off, bool hasp, const float* mu, float (&v)[8]) {
    float c[8], p[8], m[8]; ld8bf((const unsigned char*)(zp + off), c);
    if (hasp) ld8bf((const unsigned char*)(zp - INC + off), p); else {
#pragma unroll
        for (int e = 0; e < 8; ++e) p[e] = 0.f; }
    ld8f(mu + off, m);
#pragma unroll
    for (int e = 0; e < 8; ++e) v[e] = c[e] + (p[e] - c[e]) * m[e];
}
__device__ __forceinline__ float red8(float v) { v += __shfl_xor(v, 1); v += __shfl_xor(v, 2); v += __shfl_xor(v, 4); return v; }

__device__ __forceinline__ void scan_unit(const PArgs& a, unsigned char* lds, int bh) {
    const int tid = ltid(), lane = tid & 63, wid = __builtin_amdgcn_readfirstlane(tid >> 6);
    const int mt = wid >> 1, nh = wid & 1, fr = lane & 15, fq = lane >> 4;
    const int b = bh >> 3, h = bh & 7;
#define BUF(i) (lds + (i) * MB)
    float* GC = (float*)(lds + OFF_F32); float* BON = GC + 64; float* LEND = BON + 64; float* SEGT = LEND + 64;
    float* LWR = (float*)BUF(I_AT); float* LAR = (float*)BUF(I_AJ); float* LGR = (float*)BUF(I_L); float* LW = (float*)BUF(I_R0); float* YTF = (float*)BUF(I_L);
    unsigned char* ACTW = BUF(I_L); unsigned char* ACTA = BUF(I_LT); unsigned char* ACTG = BUF(I_R0);
    const bf16* z = (const bf16*)(a.ws + WS_Z); bf16* ya = (bf16*)(a.ws + WS_YA);
    const float* mu = a.in[7];
    bf16x8 fw[2], fa[2], fg[4];
    { const bf16* wlt = (const bf16*)(a.ws + WS_WLT) + (size_t)h * 4096 + (16 * mt + fr) * 64 + 8 * fq; const bf16* wat = (const bf16*)(a.ws + WS_WAT) + (size_t)h * 4096 + (16 * mt + fr) * 64 + 8 * fq;
      const bf16* wgt = (const bf16*)(a.ws + WS_WGT) + (size_t)h * 8192 + (16 * mt + fr) * 128 + 8 * fq;
      fw[0] = *(const bf16x8*)wlt; fw[1] = *(const bf16x8*)(wlt + 32); fa[0] = *(const bf16x8*)wat; fa[1] = *(const bf16x8*)(wat + 32);
#pragma unroll
      for (int ks = 0; ks < 4; ++ks) fg[ks] = *(const bf16x8*)(wgt + 32 * ks); }
    int s0i = I_X14, aki = I_X5;
    for (int i = tid; i < MB / 4; i += 512) ((unsigned*)BUF(I_X14))[i] = 0u;
    __syncthreads();
    const int pt = tid >> 3, pg = tid & 7, j0 = 8 * pg;
    const int colh = h * 64 + j0;
    for (int c = 0; c < SEQ / 64; ++c) {
        const int s = c * 64 + pt; const size_t t = (size_t)b * SEQ + s; const bf16* zp = z + t * INC; const bool hasp = s > 0;
        { float v[8];
          shift8(zp, colh, hasp, mu, v); st8bf(BUF(I_RT) + pt * RSB + j0 * 2, v);
          shift8(zp, 512 + colh, hasp, mu, v); st8bf(BUF(I_KT) + pt * RSB + j0 * 2, v);
          shift8(zp, 1024 + colh, hasp, mu, v); st8bf(BUF(I_VT) + pt * RSB + j0 * 2, v);
#pragma unroll
          for (int e = 0; e < 8; ++e) *(unsigned short*)(BUF(I_VJ) + (j0 + e) * RSB + pt * 2) = (unsigned short)f2bf(v[e]);
          shift8(zp, 1536 + j0, hasp, mu, v);
#pragma unroll
          for (int e = 0; e < 8; ++e) v[e] = tanhf(v[e]);
          st8bf(ACTW + pt * RSB + j0 * 2, v);
          shift8(zp, 1600 + j0, hasp, mu, v); st8bf(ACTA + pt * RSB + j0 * 2, v);
          shift8(zp, 1664 + j0, hasp, mu, v);
#pragma unroll
          for (int e = 0; e < 8; ++e) v[e] = sigm(v[e]);
          st8bf(ACTG + pt * 272 + j0 * 2, v);
          shift8(zp, 1728 + j0, hasp, mu, v);
#pragma unroll
          for (int e = 0; e < 8; ++e) v[e] = sigm(v[e]);
          st8bf(ACTG + pt * 272 + (64 + j0) * 2, v); }
        __syncthreads();
        f32x4 aw[2], aa[2], ag[2];
#pragma unroll
        for (int nt = 0; nt < 2; ++nt) { const int tr = 16 * (2 * nh + nt) + fr; const f32x4 zero = {0.f, 0.f, 0.f, 0.f};
            aw[nt] = __builtin_amdgcn_mfma_f32_16x16x32_bf16(fw[0], ldfrag(ACTW, tr, 8 * fq), zero, 0, 0, 0); aw[nt] = __builtin_amdgcn_mfma_f32_16x16x32_bf16(fw[1], ldfrag(ACTW, tr, 8 * fq + 32), aw[nt], 0, 0, 0);
            aa[nt] = __builtin_amdgcn_mfma_f32_16x16x32_bf16(fa[0], ldfrag(ACTA, tr, 8 * fq), zero, 0, 0, 0); aa[nt] = __builtin_amdgcn_mfma_f32_16x16x32_bf16(fa[1], ldfrag(ACTA, tr, 8 * fq + 32), aa[nt], 0, 0, 0);
            ag[nt] = zero;
#pragma unroll
            for (int ks = 0; ks < 4; ++ks) ag[nt] = __builtin_amdgcn_mfma_f32_16x16x32_bf16(fg[ks], *(const bf16x8*)(ACTG + tr * 272 + (8 * fq + 32 * ks) * 2), ag[nt], 0, 0, 0); }
        __syncthreads();
#pragma unroll
        for (int nt = 0; nt < 2; ++nt) { const int tr = 16 * (2 * nh + nt) + fr, jc = 16 * mt + 4 * fq;
            *(f32x4*)(LWR + tr * FS + jc) = aw[nt]; *(f32x4*)(LAR + tr * FS + jc) = aa[nt]; *(f32x4*)(LGR + tr * FS + jc) = ag[nt]; }
        __syncthreads();
        float lwv[8], an[8], bb[8], k2[8], rr[8], gg[8];
        { float lw8[8], la8[8], kx[8], w0v[8], a0v[8], kkc[8], kac[8], rkc[8];
          ld8f(LWR + pt * FS + j0, lw8); ld8f(LAR + pt * FS + j0, la8); ld8f(LGR + pt * FS + j0, gg);
          ld8bf(BUF(I_RT) + pt * RSB + j0 * 2, rr); ld8bf(BUF(I_KT) + pt * RSB + j0 * 2, kx);
          ld8f(a.in[8] + colh, w0v); ld8f(a.in[10] + colh, a0v); ld8f(a.in[13] + colh, kkc); ld8f(a.in[14] + colh, kac); ld8f(a.in[15] + colh, rkc);
          float ss = 0.f, bon = 0.f, av[8];
#pragma unroll
          for (int e = 0; e < 8; ++e) { lwv[e] = -0.606531f * sigm(w0v[e] + lw8[e]); av[e] = sigm(a0v[e] + la8[e]); an[e] = kx[e] * kkc[e]; ss += an[e] * an[e];
              k2[e] = kx[e] * (1.0f + (av[e] - 1.0f) * kac[e]); bon += rr[e] * k2[e] * rkc[e]; }
          ss = red8(ss); bon = red8(bon);
          const float inv = 1.0f / fmaxf(sqrtf(ss), 1e-12f);
#pragma unroll
          for (int e = 0; e < 8; ++e) { const float kn = an[e] * inv; an[e] = -kn; bb[e] = kn * av[e]; }
          *(f32x4*)(LW + pt * FS + j0) = (f32x4){lwv[0], lwv[1], lwv[2], lwv[3]}; *(f32x4*)(LW + pt * FS + j0 + 4) = (f32x4){lwv[4], lwv[5], lwv[6], lwv[7]};
          if (pg == 0) BON[pt] = bon; }
        __syncthreads();
        { const int j = tid & 63, sg = tid >> 6; float run = 0.f;
#pragma unroll
          for (int u = 0; u < 8; ++u) { run += LW[(8 * sg + u) * FS + j]; LW[(8 * sg + u) * FS + j] = run; }
          SEGT[sg * 64 + j] = run; }
        __syncthreads();
        if (tid < 64) { float run = 0.f;
#pragma unroll
            for (int sg = 0; sg < 8; ++sg) { const float tmp = SEGT[sg * 64 + tid]; SEGT[sg * 64 + tid] = run; run += tmp; }
            LEND[tid] = run; GC[tid] = __expf(run); }
        __syncthreads();
        { float Lc[8], sgp[8], le[8], o0[8], o1[8], o2[8], o3[8];
          ld8f(LW + pt * FS + j0, Lc); ld8f(SEGT + (pt >> 3) * 64 + j0, sgp); ld8f(LEND + j0, le);
#pragma unroll
          for (int e = 0; e < 8; ++e) { const float L = Lc[e] + sgp[e]; const float e1 = __expf(L), ie1 = __expf(-L), ep = __expf(L - lwv[e]), eh = __expf(le[e] - L);
              o0[e] = an[e] * ep; o1[e] = bb[e] * ie1; o2[e] = k2[e] * ie1; o3[e] = rr[e] * e1; Lc[e] = bb[e] * eh; sgp[e] = k2[e] * eh; }
          st8bf(BUF(I_AT) + pt * RSB + j0 * 2, o0); st8bf(BUF(I_BT) + pt * RSB + j0 * 2, o1); st8bf(BUF(I_KT) + pt * RSB + j0 * 2, o2); st8bf(BUF(I_RT) + pt * RSB + j0 * 2, o3);
          st8bf(BUF(I_GATE) + pt * RSB + j0 * 2, gg);
#pragma unroll
          for (int e = 0; e < 8; ++e) { *(unsigned short*)(BUF(I_AJ) + (j0 + e) * RSB + pt * 2) = (unsigned short)f2bf(o0[e]); *(unsigned short*)(BUF(I_BHJ) + (j0 + e) * RSB + pt * 2) = (unsigned short)f2bf(Lc[e]);
              *(unsigned short*)(BUF(I_KHJ) + (j0 + e) * RSB + pt * 2) = (unsigned short)f2bf(sgp[e]); } }
        __syncthreads();
        { const f32x4 zero = {0.f, 0.f, 0.f, 0.f}; f32x4 acc[2] = {zero, zero};
          mm(acc, BUF(I_AT), BUF(I_BT), mt, nh, fr, fq);
#pragma unroll
          for (int nt = 0; nt < 2; ++nt)
#pragma unroll
              for (int r = 0; r < 4; ++r) { const int m = 16 * mt + 4 * fq + r, n = 16 * (2 * nh + nt) + fr; if (!(m > n)) acc[nt][r] = 0.f; }
          storeN(BUF(I_L), acc, mt, nh, fr, fq); storeT(BUF(I_LT), acc, mt, nh, fr, fq);
#pragma unroll
          for (int nt = 0; nt < 2; ++nt)
#pragma unroll
              for (int r = 0; r < 4; ++r) { const int m = 16 * mt + 4 * fq + r, n = 16 * (2 * nh + nt) + fr; if (m == n) acc[nt][r] = 1.0f; }
          storeN(BUF(I_R0), acc, mt, nh, fr, fq);
          acc[0] = zero; acc[1] = zero; mm(acc, BUF(I_AT), BUF(I_KT), mt, nh, fr, fq);
#pragma unroll
          for (int nt = 0; nt < 2; ++nt)
#pragma unroll
              for (int r = 0; r < 4; ++r) { const int m = 16 * mt + 4 * fq + r, n = 16 * (2 * nh + nt) + fr; if (!(n < m)) acc[nt][r] = 0.f; }
          storeT(BUF(aki), acc, mt, nh, fr, fq);
          acc[0] = zero; acc[1] = zero; mm(acc, BUF(I_BT), BUF(I_RT), mt, nh, fr, fq);
#pragma unroll
          for (int nt = 0; nt < 2; ++nt)
#pragma unroll
              for (int r = 0; r < 4; ++r) { const int m = 16 * mt + 4 * fq + r, n = 16 * (2 * nh + nt) + fr; if (!(m <= n)) acc[nt][r] = 0.f; }
          storeT(BUF(I_ABRT), acc, mt, nh, fr, fq); }
        __syncthreads();
#pragma unroll
        for (int k = 1; k <= 6; ++k) {
            unsigned char* Pc = (k & 1) ? BUF(I_L) : BUF(I_AT); unsigned char* PTc = (k & 1) ? BUF(I_LT) : BUF(I_BT);
            unsigned char* Pn = (k & 1) ? BUF(I_AT) : BUF(I_L); unsigned char* PTn = (k & 1) ? BUF(I_BT) : BUF(I_LT);
            unsigned char* Rc = (k & 1) ? BUF(I_R1) : BUF(I_R0); unsigned char* Rn = (k & 1) ? BUF(I_R0) : BUF(I_R1);
            const f32x4 zero = {0.f, 0.f, 0.f, 0.f};
            if (k <= 5) { f32x4 acc[2] = {zero, zero}; mm(acc, Pc, PTc, mt, nh, fr, fq); storeN(Pn, acc, mt, nh, fr, fq); storeT(PTn, acc, mt, nh, fr, fq); }
            if (k >= 2) { f32x4 acc[2];
#pragma unroll
                for (int nt = 0; nt < 2; ++nt) { const v2u w = *(const v2u*)(Rc + (16 * (2 * nh + nt) + fr) * RSB + (16 * mt + 4 * fq) * 2); acc[nt] = (f32x4){bflo(w.x), bfhi(w.x), bflo(w.y), bfhi(w.y)}; }
                mm(acc, PTc, Rc, mt, nh, fr, fq); storeT(Rn, acc, mt, nh, fr, fq); }
            __syncthreads();
        }
        { const f32x4 zero = {0.f, 0.f, 0.f, 0.f}; f32x4 acc[2] = {zero, zero};
          mm(acc, BUF(I_R1), BUF(I_AJ), mt, nh, fr, fq); storeT(BUF(I_L), acc, mt, nh, fr, fq);
          acc[0] = zero; acc[1] = zero; mm(acc, BUF(I_R1), BUF(aki), mt, nh, fr, fq); storeT(BUF(I_LT), acc, mt, nh, fr, fq); }
        __syncthreads();
        { const f32x4 zero = {0.f, 0.f, 0.f, 0.f}; f32x4 acc[2];
#pragma unroll
          for (int nt = 0; nt < 2; ++nt) { const v2u w = *(const v2u*)(BUF(I_RT) + (16 * (2 * nh + nt) + fr) * RSB + (16 * mt + 4 * fq) * 2); acc[nt] = (f32x4){bflo(w.x), bfhi(w.x), bflo(w.y), bfhi(w.y)}; }
          mm(acc, BUF(I_L), BUF(I_ABRT), mt, nh, fr, fq); storeT(BUF(I_AT), acc, mt, nh, fr, fq);
          acc[0] = zero; acc[1] = zero; mm(acc, BUF(I_KT), BUF(I_RT), mt, nh, fr, fq);
#pragma unroll
          for (int nt = 0; nt < 2; ++nt)
#pragma unroll
              for (int r = 0; r < 4; ++r) { const int m = 16 * mt + 4 * fq + r, n = 16 * (2 * nh + nt) + fr; if (!(m <= n)) acc[nt][r] = 0.f; }
          mm(acc, BUF(I_LT), BUF(I_ABRT), mt, nh, fr, fq); storeT(BUF(I_BT), acc, mt, nh, fr, fq);
          acc[0] = zero; acc[1] = zero; mm(acc, BUF(I_L), BUF(I_BHJ), mt, nh, fr, fq);
#pragma unroll
          for (int nt = 0; nt < 2; ++nt)
#pragma unroll
              for (int r = 0; r < 4; ++r) { const int m = 16 * mt + 4 * fq + r, n = 16 * (2 * nh + nt) + fr; if (m == n) acc[nt][r] += GC[m]; }
          storeT(BUF(I_AJ), acc, mt, nh, fr, fq);
#pragma unroll
          for (int nt = 0; nt < 2; ++nt) { const v2u w = *(const v2u*)(BUF(I_KHJ) + (16 * (2 * nh + nt) + fr) * RSB + (16 * mt + 4 * fq) * 2); acc[nt] = (f32x4){bflo(w.x), bfhi(w.x), bflo(w.y), bfhi(w.y)}; }
          mm(acc, BUF(I_LT), BUF(I_BHJ), mt, nh, fr, fq); storeT(BUF(I_R0), acc, mt, nh, fr, fq); }
        __syncthreads();
        { const f32x4 zero = {0.f, 0.f, 0.f, 0.f}; f32x4 acc[2] = {zero, zero};
          mm(acc, BUF(s0i), BUF(I_AT), mt, nh, fr, fq); mm(acc, BUF(I_VJ), BUF(I_BT), mt, nh, fr, fq);
#pragma unroll
          for (int nt = 0; nt < 2; ++nt) *(f32x4*)(YTF + (16 * (2 * nh + nt) + fr) * FS + 16 * mt + 4 * fq) = acc[nt];
          acc[0] = zero; acc[1] = zero; mm(acc, BUF(I_AJ), BUF(s0i), mt, nh, fr, fq); mm(acc, BUF(I_R0), BUF(I_VJ), mt, nh, fr, fq);
          storeT(BUF(aki), acc, mt, nh, fr, fq); }
        __syncthreads();
        { float y[8], vv[8], g8[8], lg[8], lb[8]; ld8f(YTF + pt * FS + j0, y); ld8bf(BUF(I_VT) + pt * RSB + j0 * 2, vv); ld8bf(BUF(I_GATE) + pt * RSB + j0 * 2, g8);
          ld8f(a.in[16] + colh, lg); ld8f(a.in[17] + colh, lb);
          float sm = 0.f;
#pragma unroll
          for (int e = 0; e < 8; ++e) sm += y[e];
          const float mean = red8(sm) * (1.0f / 64.0f); float sq = 0.f;
#pragma unroll
          for (int e = 0; e < 8; ++e) { y[e] -= mean; sq += y[e] * y[e]; }
          const float rstd = rsqrtf(red8(sq) * (1.0f / 64.0f) + 64e-5f), bon = BON[pt];
#pragma unroll
          for (int e = 0; e < 8; ++e) y[e] = (y[e] * rstd * lg[e] + lb[e] + bon * vv[e]) * g8[e];
          st8bf((unsigned char*)(ya + t * RWW + colh), y); }
        { const int tmp = s0i; s0i = aki; aki = tmp; }
        __syncthreads();
    }
#undef BUF
}
}

__device__ __forceinline__ void p_norm2_route(const PArgs& a, unsigned char* lds) {
    const int tid = ltid(), lane = tid & 63, gw = blockIdx.x * 8 + (tid >> 6), NGW = gridDim.x * 8;
    const float* x1 = a.out; const float* g = a.in[5]; const float* mod = (const float*)(a.ws + WS_MOD);
    const float* wrt = (const float*)(a.ws + WS_WRT); const float* brg = a.in[24]; const float* bre = a.in[26];
    bf16* h2 = (bf16*)(a.ws + WS_H2);
    int* rte = (int*)(a.ws + WS_RTE); float* rtw = (float*)(a.ws + WS_RTW); int* rnk = (int*)(a.ws + WS_RNK); unsigned* cnt = (unsigned*)(a.ws + WS_CTL) + CW_CNT;
    for (int rg = gw; rg < NT / 4; rg += NGW) {
        f32x4 hv[4][4];
#pragma unroll
        for (int rr = 0; rr < 4; ++rr) { const int m = rg * 4 + rr, b = m >> 11; const f32x4* xr = (const f32x4*)(x1 + (size_t)m * DM) + lane; float s = 0.f;
#pragma unroll
            for (int j = 0; j < 4; ++j) { hv[rr][j] = xr[64 * j]; const f32x4 v = hv[rr][j]; s += (v.x * v.x + v.y * v.y) + (v.z * v.z + v.w * v.w); }
            const float rstd = rsqrtf(wave_sum(s) * (1.0f / DM) + 1e-6f);
            v2u* o = (v2u*)(h2 + (size_t)m * DM) + lane;
#pragma unroll
            for (int j = 0; j < 4; ++j) { const int col = 4 * (lane + 64 * j);
                const f32x4 gg = *(const f32x4*)(g + col), sh = *(const f32x4*)(mod + b * 6144 + 3072 + col), scl = *(const f32x4*)(mod + b * 6144 + 4096 + col);
                const f32x4 r = hv[rr][j] * rstd * gg * (scl + 1.0f) + sh; hv[rr][j] = r; v2u w; w.x = pk2(r.x, r.y); w.y = pk2(r.z, r.w); o[64 * j] = w; } }
        float mylog[4] = {0.f, 0.f, 0.f, 0.f};
        for (int e = 0; e < 36; ++e) { float p[4] = {0.f, 0.f, 0.f, 0.f};
#pragma unroll
            for (int j = 0; j < 4; ++j) { const f32x4 w4 = *(const f32x4*)(wrt + e * 1024 + 4 * (lane + 64 * j));
#pragma unroll
                for (int rr = 0; rr < 4; ++rr) { const f32x4 v = hv[rr][j]; p[rr] += (v.x * w4.x + v.y * w4.y) + (v.z * w4.z + v.w * w4.w); } }
#pragma unroll
            for (int rr = 0; rr < 4; ++rr) { const float sm = wave_sum(p[rr]); if (lane == e) mylog[rr] = sm; } }
#pragma unroll
        for (int rr = 0; rr < 4; ++rr) { const int m = rg * 4 + rr;
            float gl4[4];
#pragma unroll
            for (int i = 0; i < 4; ++i) gl4[i] = __shfl(mylog[rr], i) + brg[i];
            int gi = 0; float gm = gl4[0];
#pragma unroll
            for (int i = 1; i < 4; ++i) if (gl4[i] > gm) { gm = gl4[i]; gi = i; }
            float gs = 0.f;
#pragma unroll
            for (int i = 0; i < 4; ++i) gs += __expf(gl4[i] - gm);
            const float pg = 1.0f / gs;
            float el[8];
#pragma unroll
            for (int k = 0; k < 8; ++k) el[k] = __shfl(mylog[rr], 4 + gi * 8 + k) + bre[gi * 8 + k];
            int e1 = 0; float m1 = el[0];
#pragma unroll
            for (int k = 1; k < 8; ++k) if (el[k] > m1) { m1 = el[k]; e1 = k; }
            int e2 = -1; float m2 = -INFINITY;
#pragma unroll
            for (int k = 0; k < 8; ++k) if (k != e1 && el[k] > m2) { m2 = el[k]; e2 = k; }
            const float q2 = __expf(m2 - m1); const float w1 = pg / (1.0f + q2), w2 = pg * q2 / (1.0f + q2);
            if (lane == 0) { const int ea = gi * 8 + e1, eb = gi * 8 + e2; rte[2 * m] = ea; rte[2 * m + 1] = eb; rtw[2 * m] = w1; rtw[2 * m + 1] = w2;
                rnk[2 * m] = (int)atomicAdd(cnt + ea, 1u); rnk[2 * m + 1] = (int)atomicAdd(cnt + eb, 1u); } }
    }
}
__device__ __forceinline__ void p_moe_gather(const PArgs& a, unsigned char* lds) {
    int* off = (int*)lds;
    const int tid = ltid(), lane = tid & 63, gw = blockIdx.x * 8 + (tid >> 6), NGW = gridDim.x * 8;
    int* ctl = (int*)(a.ws + WS_CTL); const unsigned* cnt = (const unsigned*)ctl + CW_CNT;
    if (tid == 0) { int o = 0, nt = 0;
        for (int e = 0; e < NEXP; ++e) { off[e] = o; const int tiles = ((int)cnt[e] + 255) >> 8;
            if (blockIdx.x == 0) for (int i = 0; i < tiles; ++i) ctl[CW_TEXP + nt + i] = e;
            nt += tiles; o += tiles * 256; }
        if (blockIdx.x == 0) ctl[CW_NT] = nt; }
    __syncthreads();
    const int* rte = (const int*)(a.ws + WS_RTE); const int* rnk = (const int*)(a.ws + WS_RNK); int* pos = (int*)(a.ws + WS_POS);
    const bf16* h2 = (const bf16*)(a.ws + WS_H2); bf16* xs = (bf16*)(a.ws + WS_XS);
    for (int i = gw; i < 2 * NT; i += NGW) { const int p = off[rte[i]] + rnk[i]; if (lane == 0) pos[i] = p;
        const v4u* src = (const v4u*)(h2 + (size_t)(i >> 1) * DM) + lane; v4u* dst = (v4u*)(xs + (size_t)p * DM) + lane;
        dst[0] = src[0]; dst[64] = src[64]; }
}
__device__ __forceinline__ void p_combine(const PArgs& a, unsigned char* lds) {
    const int tid = ltid(), lane = tid & 63, gw = blockIdx.x * 8 + (tid >> 6), NGW = gridDim.x * 8;
    const float* mod = (const float*)(a.ws + WS_MOD); const int* pos = (const int*)(a.ws + WS_POS); const float* rtw = (const float*)(a.ws + WS_RTW);
    const bf16* ys = (const bf16*)(a.ws + WS_XS); float* out = a.out;
    for (int m = gw; m < NT; m += NGW) { const int b = m >> 11; const int p0 = pos[2 * m], p1 = pos[2 * m + 1]; const float w0 = rtw[2 * m], w1 = rtw[2 * m + 1];
        f32x4* o = (f32x4*)(out + (size_t)m * DM) + lane; const v2u* y0 = (const v2u*)(ys + (size_t)p0 * DM) + lane; const v2u* y1 = (const v2u*)(ys + (size_t)p1 * DM) + lane;
#pragma unroll
        for (int j = 0; j < 4; ++j) { const int col = 4 * (lane + 64 * j); const f32x4 g2 = *(const f32x4*)(mod + b * 6144 + 5120 + col); const v2u a0 = y0[64 * j], a1 = y1[64 * j];
            const f32x4 e0 = {bflo(a0.x), bfhi(a0.x), bflo(a0.y), bfhi(a0.y)}, e1 = {bflo(a1.x), bfhi(a1.x), bflo(a1.y), bfhi(a1.y)};
            o[64 * j] = o[64 * j] + g2 * (e0 * w0 + e1 * w1); } }
}

#define XB_TMO      128
#define XB_XCNT(j)  (256  + 64 * (j))
#define XB_XSUB(j)  (1280 + 64 * (j))
#define XB_XGEN(j)  (2304 + 64 * (j))
#define XB_TOP      3328
#define XB_TOPGEN   3392
#define XCD_BAR_WORDS 3456
#define XB_SPIN_CAP (1u << 22)

__device__ __forceinline__ unsigned xb_ld(unsigned* p)              { return __hip_atomic_load(p, __ATOMIC_RELAXED, __HIP_MEMORY_SCOPE_AGENT); }
__device__ __forceinline__ unsigned xb_add(unsigned* p, unsigned v) { return __hip_atomic_fetch_add(p, v, __ATOMIC_RELAXED, __HIP_MEMORY_SCOPE_AGENT); }
__device__ __forceinline__ unsigned xb_xcc_id() { return (unsigned)__builtin_amdgcn_s_getreg((3 << 11) | 20) & 0xFu; }
#define XB_SPIN(cond, bar) do { unsigned _sp = 0; while (cond) { __builtin_amdgcn_s_sleep(1); \
    if ((++_sp & 255u) == 0u) { if (xb_ld(&(bar)[XB_TMO])) break; if (_sp > XB_SPIN_CAP) { atomicAdd(&(bar)[XB_TMO], 1u); break; } } } } while (0)

struct XcdBarrier {
    unsigned* bar; unsigned x;
    volatile LAS unsigned* st;
};

__device__ __forceinline__ XcdBarrier xcd_barrier_post(unsigned* bar, volatile LAS unsigned* st) {
    XcdBarrier b; b.bar = bar; b.x = xb_xcc_id(); b.st = st;
    if (threadIdx.x == 0) (void)xb_add(&bar[XB_XCNT(b.x)], 1u);
    return b;
}
__device__ __forceinline__ void xcd_barrier_complete(unsigned* bar, unsigned x, unsigned& nloc, unsigned& nx) {
    const unsigned G = gridDim.x * gridDim.y * gridDim.z;
    unsigned sum, cnt, mine, sp = 0u;
    for (;;) {
        sum = 0u; cnt = 0u; mine = 0u;
#pragma unroll
        for (unsigned j = 0; j < 16; ++j) { const unsigned c = xb_ld(&bar[XB_XCNT(j)]); sum += c; cnt += (c > 0u) ? 1u : 0u; mine = (j == x) ? c : mine; }
        if (sum == G) break;
        __builtin_amdgcn_s_sleep(1);
        if ((++sp & 255u) == 0u) { if (xb_ld(&bar[XB_TMO])) break; if (sp > XB_SPIN_CAP) { atomicAdd(&bar[XB_TMO], 1u); break; } }
    }
    nloc = mine > 0u ? mine : 1u; nx = cnt > 0u ? cnt : 1u;
}

__device__ __forceinline__ void xcd_barrier(const XcdBarrier& b) {
    asm volatile("s_waitcnt vmcnt(0)" ::: "memory");
    __syncthreads();
    if (threadIdx.x == 0) {
        unsigned* bar = b.bar;
        __builtin_amdgcn_s_waitcnt(0);
        unsigned nloc = b.st[0], nx = b.st[1];
        if (nloc == 0u) { xcd_barrier_complete(bar, b.x, nloc, nx); b.st[0] = nloc; b.st[1] = nx; }
        const unsigned old = xb_add(&bar[XB_XSUB(b.x)], 1u);
        const unsigned gen = old / nloc;
        if (old + 1u == (gen + 1u) * nloc) {
            __builtin_amdgcn_fence(__ATOMIC_RELEASE, "agent");
            asm volatile("s_waitcnt vmcnt(0)" ::: "memory");
            const unsigned og = xb_add(&bar[XB_TOP], 1u);
            const unsigned tg = og / nx;
            if (og + 1u == (tg + 1u) * nx) xb_add(&bar[XB_TOPGEN], 1u);
            else XB_SPIN(xb_ld(&bar[XB_TOPGEN]) == tg, bar);
            __builtin_amdgcn_fence(__ATOMIC_ACQUIRE, "agent");
            xb_add(&bar[XB_XGEN(b.x)], 1u);
            asm volatile("s_waitcnt vmcnt(0)" ::: "memory");
        } else {
            XB_SPIN(xb_ld(&bar[XB_XGEN(b.x)]) == gen, bar);
            __builtin_amdgcn_fence(__ATOMIC_ACQUIRE, "agent");
            asm volatile("s_waitcnt vmcnt(0)" ::: "memory");
        }
    }
    __syncthreads();
}

constexpr int LDS_BYTES = 160 * 1024, MISC_OFF = LDS_BYTES - 256;
static_assert(rw::LDS_NEED <= MISC_OFF, "scan LDS");
constexpr int CW_BAR = 4096;

__global__ void __launch_bounds__(512, 2) mega_fwd(PArgs a) {
    extern __shared__ __attribute__((aligned(16))) unsigned char lds[];
    volatile LAS unsigned* MISC = (volatile LAS unsigned*)((LAS unsigned char*)lds + MISC_OFF);
    if (threadIdx.x < 64) MISC[threadIdx.x] = 0u;
    __syncthreads();
    XcdBarrier bar = xcd_barrier_post((unsigned*)(a.ws + WS_CTL) + CW_BAR, MISC + 8);
    GemmArgs g; g.ws = a.ws; g.x = a.in[0]; g.out = a.out;
    const int G = (int)gridDim.x, bx = (int)blockIdx.x;

    p_prep_weights(a, lds); __syncthreads(); p_ada(a, lds);
    xcd_barrier(bar);
    p_norm1(a, lds);
    xcd_barrier(bar);
    p_gemm_in(g, lds);
    xcd_barrier(bar);
    p_kprep(a, lds);
    xcd_barrier(bar);
    p_qprep(a, lds);
    xcd_barrier(bar);
    { const int nscan = G / 2;
      if (bx < nscan) { for (int bh = bx; bh < 128; bh += nscan) rw::scan_unit(a, lds, bh); }
      else p_attn(a, lds, bx - nscan, G - nscan); }
    xcd_barrier(bar);
    p_gemm_bra(g, lds);
    xcd_barrier(bar);
    p_gemm_brb(g, lds);
    xcd_barrier(bar);
    p_gemm_out(g, lds); __syncthreads(); p_prep_experts(a, lds);
    xcd_barrier(bar);
    p_norm2_route(a, lds);
    xcd_barrier(bar);
    p_moe_gather(a, lds);
    xcd_barrier(bar);
    p_gemm_up(g, lds);
    xcd_barrier(bar);
    p_gemm_down(g, lds);
    xcd_barrier(bar);
    p_combine(a, lds);
}

extern "C" void kernel_launch(void* const* d_in, const int* in_sizes, int n_in, void* d_out, int out_size, void* d_ws, size_t ws_size, hipStream_t stream) {
    static int grid = 0;
    if (grid == 0) {
        if (n_in != 30 || out_size != NT * DM || ws_size < WS_END) { fprintf(stderr, "kernel_launch: unexpected shapes (n_in %d, out %d, ws %zu)\n", n_in, out_size, ws_size); grid = -1; return; }
        int dev = 0, cus = 0, per_cu = 0;
        if (hipGetDevice(&dev) != hipSuccess || hipDeviceGetAttribute(&cus, hipDeviceAttributeMultiprocessorCount, dev) != hipSuccess) { grid = -1; return; }
        if (hipFuncSetAttribute((const void*)mega_fwd, hipFuncAttributeMaxDynamicSharedMemorySize, LDS_BYTES) != hipSuccess) { fprintf(stderr, "kernel_launch: hipFuncSetAttribute failed\n"); grid = -1; return; }
        if (hipOccupancyMaxActiveBlocksPerMultiprocessor(&per_cu, (const void*)mega_fwd, 512, LDS_BYTES) != hipSuccess || per_cu < 1) { fprintf(stderr, "kernel_launch: occupancy query says %d blocks per CU\n", per_cu); (void)hipGetLastError(); grid = -1; return; }
        grid = cus;
    }
    if (grid < 0) return;
    (void)hipMemsetAsync((char*)d_ws + WS_CTL, 0, 65536, stream);
    PArgs p{}; for (int i = 0; i < 30; ++i) p.in[i] = (const float*)d_in[i]; p.out = (float*)d_out; p.ws = (unsigned char*)d_ws;
    hipLaunchKernelGGL(mega_fwd, dim3(grid), dim3(512), LDS_BYTES, stream, p);
}
```

```cpp
#include <hip/hip_runtime.h>
#include <cstdio>
#include <cstdint>
__device__ __forceinline__ int mktid(int wv) { int l; asm volatile("v_mbcnt_lo_u32_b32 %0, -1, 0\n\tv_mbcnt_hi_u32_b32 %0, -1, %0" : "=v"(l)); return (wv << 6) | l; }
template <int CTRL> __device__ __forceinline__ float dppf(float v) { return __builtin_bit_cast(float, __builtin_amdgcn_update_dpp(0, __builtin_bit_cast(int, v), CTRL, 0xF, 0xF, true)); }
__device__ __forceinline__ float red4(float v) { v += dppf<0xB1>(v); v += dppf<0x4E>(v); return v; }
__device__ __forceinline__ float red8(float v) { v = red4(v); v += dppf<0x141>(v); return v; }
__device__ __forceinline__ float red16(float v) { v = red8(v); v += dppf<0x140>(v); return v; }
__device__ __forceinline__ float wave_sum(float v) { v = red16(v);
    v += __builtin_bit_cast(float, __builtin_amdgcn_ds_swizzle(__builtin_bit_cast(int, v), 0x401F));
    const unsigned u = __builtin_bit_cast(unsigned, v); auto rr = __builtin_amdgcn_permlane32_swap(u, u, false, false);
    return __builtin_bit_cast(float, (unsigned)rr[0]) + __builtin_bit_cast(float, (unsigned)rr[1]); }
__device__ __forceinline__ float lane_get(float v, int src) { return __builtin_bit_cast(float, __builtin_amdgcn_ds_bpermute(src << 2, __builtin_bit_cast(int, v))); }
namespace pg8 {
#define PG8_LAS __attribute__((address_space(3)))
typedef unsigned short bf16_t;
typedef short bf16x8 __attribute__((ext_vector_type(8)));
typedef float f32x4 __attribute__((ext_vector_type(4)));
typedef unsigned u32x4 __attribute__((ext_vector_type(4)));
constexpr int BM = 256, BK = 64, HALF = 128, HTB = HALF * BK * 2  , STAGE_BYTES = 8 * HTB, NXCD = 8, WGM = 8;

__host__ __device__ __forceinline__ int lds_byte(int r, int c) { const int st = (r >> 4) * 2 + (c >> 5), rr = r & 15, cc = c & 31, ob = rr * 64 + cc * 2; return st * 1024 + (ob ^ (((ob >> 9) & 1) << 5)); }
__host__ __device__ __forceinline__ void stage_rc(int b, int& R, int& C) { const int st = b / 1024, sb = b % 1024, swz = sb ^ (((sb >> 9) & 1) << 5); R = (st >> 1) * 16 + swz / 64; C = (st & 1) * 32 + (swz % 64) / 2; }
__host__ __device__ __forceinline__ int perm32(int rho) { const int n = rho >> 4, i = rho & 15; return 8 * (i >> 2) + 4 * n + (i & 3); }
struct Unit { int pm, pn; const char* a; const char* b; };
struct Gemm { int K; };

struct StaticOrder {
    int nM, nN, nwg, G, c; const char* A; const char* Bt; size_t tstep;
    __device__ void init(const void* A_, const void* Bt_, int M, int N, int K, int G_, int c_) { nM = M / BM; nN = N / BM; nwg = nM * nN; G = G_; c = c_; A = (const char*)A_; Bt = (const char*)Bt_; tstep = (size_t)BM * K * 2; }
    __device__ bool next(int i, Unit& u) const {
        const long L = (long)i * G + c; if (L >= nwg) return false;
        int wgid = (int)L; { const int q = nwg / NXCD, r = nwg % NXCD, xcd = wgid % NXCD, off = wgid / NXCD; wgid = (xcd < r ? xcd * (q + 1) : r * (q + 1) + (xcd - r) * q) + off; }
        const int nig = WGM * nN, gid = wgid / nig, fm = gid * WGM, gsz = (nM - fm) < WGM ? (nM - fm) : WGM;
        u.pm = fm + ((wgid % nig) % gsz); u.pn = (wgid % nig) / gsz; u.a = A + (size_t)u.pm * tstep; u.b = Bt + (size_t)u.pn * tstep; return true;
    }
    __device__ __forceinline__ void a_ready(const Unit&) const {}
    __device__ __forceinline__ void done(const Unit&) const {}
};
__device__ __forceinline__ unsigned cvt_pk_bf16(float lo, float hi) { unsigned r; asm volatile("v_cvt_pk_bf16_f32 %0, %1, %2" : "=v"(r) : "v"(lo), "v"(hi)); return r; }
template <class Epi, class Sched, bool ALIGN_EPI = false, bool SP2 = false>
__device__ __forceinline__ void gemm_phase(PG8_LAS unsigned char* lds, const Gemm g, const Sched& S, const Epi& E, int wv) {
    const int tid = mktid(wv), wid = __builtin_amdgcn_readfirstlane(tid >> 6), lane = tid & 63, wr = wid >> 2, wc = wid & 3, fr = lane & 15, fq = lane >> 4;
    const int K = g.K, nt = K / BK;
    unsigned voffA[2], voffB[2];
#pragma unroll
    for (int i = 0; i < 2; ++i) { int R, C; stage_rc(tid * 16 + i * 8192, R, C); const int Rb = Epi::PERM ? ((R & ~31) + perm32(R & 31)) : R;
        voffA[i] = (unsigned)(R * K + C) * 2u; voffB[i] = (unsigned)(Rb * K + C) * 2u; }
    const size_t kstep = (size_t)(BK * 2);
    const size_t hstep = (size_t)HALF * K * 2;
        const unsigned ldsw = (unsigned)wid * 1024u;
    const int aoff = lds_byte(wr * 64 + fr, fq * 8), boff = lds_byte(wc * 32 + fr, fq * 8);
#define PG8_SA(b, h) (((b) * 2 + (h)) * HTB)
#define PG8_SB(b, h) ((4 + (b) * 2 + (h)) * HTB)
#define PG8_STAGE(bufoff, gbase, voff) do { _Pragma("unroll") for (int _i = 0; _i < 2; ++_i) \
        __builtin_amdgcn_global_load_lds((const unsigned*)((const char*)(gbase) + (voff)[_i]), (PG8_LAS unsigned*)(lds + (bufoff) + ldsw + _i * 8192), 16, 0, 0); } while (0)
#define PG8_LDA(dst, b, h) do { _Pragma("unroll") for (int m = 0; m < 4; ++m) _Pragma("unroll") for (int k = 0; k < 2; ++k) dst[m][k] = *(const PG8_LAS bf16x8*)(lds + PG8_SA(b, h) + aoff + m * 2048 + k * 1024); } while (0)
#define PG8_LDB(dst, b, h) do { _Pragma("unroll") for (int n = 0; n < 2; ++n) _Pragma("unroll") for (int k = 0; k < 2; ++k) dst[n][k] = *(const PG8_LAS bf16x8*)(lds + PG8_SB(b, h) + boff + n * 2048 + k * 1024); } while (0)
#define PG8_MMA(ai, bj, At, Bt) do { __builtin_amdgcn_s_setprio(1); _Pragma("unroll") for (int m = 0; m < 4; ++m) _Pragma("unroll") for (int n = 0; n < 2; ++n) _Pragma("unroll") for (int k = 0; k < 2; ++k) \
        acc[ai][bj][m][n] = __builtin_amdgcn_mfma_f32_16x16x32_bf16(Bt[n][k], At[m][k], acc[ai][bj][m][n], 0, 0, 0); __builtin_amdgcn_s_setprio(0); } while (0)
#define PG8_WAIT_V(n) asm volatile("s_waitcnt vmcnt(" #n ")" ::: "memory")
#define PG8_WAIT_L(n) asm volatile("s_waitcnt lgkmcnt(" #n ")" ::: "memory")
#define PG8_BAR __builtin_amdgcn_s_barrier()
#define PG8_SCHED __builtin_amdgcn_sched_barrier(0)
    Unit cur, nxt; int ui = 0;
    if (!S.next(0, cur)) return;
    f32x4 acc[2][2][4][2];
#pragma unroll
    for (int a = 0; a < 2; ++a)
#pragma unroll
        for (int b = 0; b < 2; ++b)
#pragma unroll
            for (int m = 0; m < 4; ++m)
#pragma unroll
                for (int n = 0; n < 2; ++n) acc[a][b][m][n] = (f32x4){0.f, 0.f, 0.f, 0.f};
    bf16x8 At[4][2], B0[2][2], B1[2][2];
    const char* cA = cur.a; const char* cB = cur.b;
    S.a_ready(cur);
    if constexpr (SP2) {
        PG8_STAGE(PG8_SB(0, 0), cB, voffB); PG8_STAGE(PG8_SB(0, 1), cB + hstep, voffB); PG8_STAGE(PG8_SA(0, 0), cA, voffA); PG8_STAGE(PG8_SA(0, 1), cA + hstep, voffA);
        if (wr == 1) PG8_BAR;
        PG8_WAIT_V(2); PG8_BAR;
        PG8_STAGE(PG8_SB(1, 0), cB + kstep, voffB); PG8_STAGE(PG8_SA(1, 0), cA + kstep, voffA); PG8_STAGE(PG8_SB(1, 1), cB + hstep + kstep, voffB);
        PG8_WAIT_V(6); PG8_BAR;
    } else {
        PG8_STAGE(PG8_SB(0, 0), cB, voffB); PG8_STAGE(PG8_SA(0, 0), cA, voffA); PG8_STAGE(PG8_SB(0, 1), cB + hstep, voffB); PG8_STAGE(PG8_SA(0, 1), cA + hstep, voffA);
        if (wr == 1) PG8_BAR;
        PG8_WAIT_V(4); PG8_BAR;
        PG8_STAGE(PG8_SB(1, 0), cB + kstep, voffB); PG8_STAGE(PG8_SA(1, 0), cA + kstep, voffA); PG8_STAGE(PG8_SB(1, 1), cB + hstep + kstep, voffB);
        PG8_WAIT_V(6); PG8_BAR;
    }
    for (;;) {
        const bool has_next = S.next(ui + 1, nxt);
        const char* nA = has_next ? nxt.a : cA; const char* nB = has_next ? nxt.b : cB;
        for (int t = 0; t < nt; t += 2) {
            const bool last = (t == nt - 2);
            const char* a1 = cA + (size_t)(t + 1) * kstep;
            const char* a2 = last ? nA : cA + (size_t)(t + 2) * kstep; const char* b2 = last ? nB : cB + (size_t)(t + 2) * kstep;
            const char* a3 = a2 + kstep; const char* b3 = b2 + kstep;
            if (last && has_next) S.a_ready(nxt);
            if constexpr (SP2) {
            PG8_LDB(B0, 0, 0); PG8_LDB(B1, 0, 1); PG8_SCHED; PG8_LDA(At, 0, 0); PG8_STAGE(PG8_SA(1, 1), a1 + hstep, voffA);
            PG8_WAIT_V(8); PG8_WAIT_L(0); PG8_BAR; PG8_MMA(0, 0, At, B0); PG8_MMA(0, 1, At, B1); PG8_BAR; PG8_SCHED;
            PG8_LDA(At, 0, 1); PG8_STAGE(PG8_SB(0, 0), b2, voffB); PG8_STAGE(PG8_SB(0, 1), b2 + hstep, voffB); PG8_STAGE(PG8_SA(0, 0), a2, voffA);
            PG8_WAIT_V(8); PG8_WAIT_L(0); PG8_BAR; PG8_MMA(1, 0, At, B0); PG8_MMA(1, 1, At, B1); PG8_BAR; PG8_SCHED;
            PG8_LDB(B0, 1, 0); PG8_LDB(B1, 1, 1); PG8_SCHED; PG8_LDA(At, 1, 0); PG8_STAGE(PG8_SA(0, 1), a2 + hstep, voffA);
            PG8_WAIT_V(8); PG8_WAIT_L(0); PG8_BAR; PG8_MMA(0, 0, At, B0); PG8_MMA(0, 1, At, B1); PG8_BAR; PG8_SCHED;
            PG8_LDA(At, 1, 1); PG8_STAGE(PG8_SB(1, 0), b3, voffB); PG8_STAGE(PG8_SB(1, 1), b3 + hstep, voffB); PG8_STAGE(PG8_SA(1, 0), a3, voffA);
            PG8_WAIT_V(8); PG8_WAIT_L(0); PG8_BAR; PG8_MMA(1, 0, At, B0); PG8_MMA(1, 1, At, B1); PG8_BAR; PG8_SCHED;
            } else {
            PG8_LDB(B0, 0, 0); PG8_SCHED; PG8_LDA(At, 0, 0); PG8_STAGE(PG8_SA(1, 1), a1 + hstep, voffA);
            PG8_WAIT_L(8); PG8_BAR; PG8_WAIT_L(0); PG8_MMA(0, 0, At, B0); PG8_BAR; PG8_SCHED;
            PG8_LDB(B1, 0, 1); PG8_STAGE(PG8_SB(0, 0), b2, voffB);
            PG8_BAR; PG8_WAIT_L(0); PG8_MMA(0, 1, At, B1); PG8_BAR;
            PG8_LDA(At, 0, 1); PG8_STAGE(PG8_SA(0, 0), a2, voffA);
            PG8_BAR; PG8_WAIT_L(0); PG8_MMA(1, 0, At, B0); PG8_BAR; PG8_SCHED;
            PG8_STAGE(PG8_SB(0, 1), b2 + hstep, voffB);
            PG8_WAIT_V(6); PG8_BAR; PG8_MMA(1, 1, At, B1); PG8_BAR;
            PG8_LDB(B0, 1, 0); PG8_SCHED; PG8_LDA(At, 1, 0); PG8_STAGE(PG8_SA(0, 1), a2 + hstep, voffA);
            PG8_WAIT_L(8); PG8_BAR; PG8_WAIT_L(0); PG8_MMA(0, 0, At, B0); PG8_BAR; PG8_SCHED;
            PG8_LDB(B1, 1, 1); PG8_STAGE(PG8_SB(1, 0), b3, voffB);
            PG8_BAR; PG8_WAIT_L(0); PG8_MMA(0, 1, At, B1); PG8_BAR;
            PG8_LDA(At, 1, 1); PG8_STAGE(PG8_SA(1, 0), a3, voffA);
            PG8_BAR; PG8_WAIT_L(0); PG8_MMA(1, 0, At, B0); PG8_BAR; PG8_SCHED;
            PG8_STAGE(PG8_SB(1, 1), b3 + hstep, voffB);
            PG8_WAIT_V(6); PG8_BAR; PG8_MMA(1, 1, At, B1); PG8_BAR;
            }
        }
        if constexpr (ALIGN_EPI) { if (wr == 0) PG8_BAR; }
        if constexpr (!Epi::AFTER_DRAIN) { E(acc, cur, wr, wc, fr, fq); S.done(cur); }
        if (!has_next) break;
#pragma unroll
        for (int a = 0; a < 2; ++a)
#pragma unroll
            for (int b = 0; b < 2; ++b)
#pragma unroll
                for (int m = 0; m < 4; ++m)
#pragma unroll
                    for (int n = 0; n < 2; ++n) acc[a][b][m][n] = (f32x4){0.f, 0.f, 0.f, 0.f};
        cur = nxt; cA = nA; cB = nB; ++ui;
        if constexpr (ALIGN_EPI) { if (wr == 1) PG8_BAR; }
    }
    PG8_WAIT_V(0);
    if constexpr (!ALIGN_EPI) { if (wr == 0) PG8_BAR; }
    PG8_BAR;
    if constexpr (Epi::AFTER_DRAIN) { E.fused(acc, cur, wr, wc, fr, fq, lds, wid, lane); S.done(cur); }
#undef PG8_SA
#undef PG8_SB
#undef PG8_STAGE
#undef PG8_LDA
#undef PG8_LDB
#undef PG8_MMA
#undef PG8_WAIT_V
#undef PG8_WAIT_L
#undef PG8_BAR
#undef PG8_SCHED
}
}
#include <hip/hip_bf16.h>
#include <cmath>
namespace attn_body {
using bf16=__hip_bfloat16;
using bf16x8=__attribute__((ext_vector_type(8)))short;
using s16x4=__attribute__((ext_vector_type(4)))short;
using f32x16=__attribute__((ext_vector_type(16)))float;
using u32x4=__attribute__((ext_vector_type(4)))unsigned;
constexpr int NHEAD=8,SEQ=2048,D=64,PQ=512,PK=512,PV=5376,PO=512;
constexpr int NW=8,QBLK=32,QB=QBLK*NW,KVBLK=64,NQB=SEQ/QB;
__device__ __forceinline__ int crow(int r,int hi){return (r&3)+8*(r>>2)+4*hi;}
#define SBAR() __builtin_amdgcn_sched_barrier(0)
__device__ __forceinline__ void cmask(f32x16&p0,f32x16&p1,int jb,int qrel,int hi){
  const float NEG=-INFINITY; int kb=64*jb+4*hi;
  #pragma unroll
  for(int r=0;r<16;++r){int kv=kb+(r&3)+8*(r>>2); if(kv>qrel)p0[r]=NEG; if(kv+32>qrel)p1[r]=NEG;}
}

constexpr int NSLOT=3, SLOTB=8192;
constexpr int LDS_K=0, LDS_V=NSLOT*SLOTB, LDS_WS=2*NSLOT*SLOTB, LDS_OST=LDS_WS+NW*64*4, LDS_BYTES=LDS_OST+NW*4096;
constexpr float C2=0.125f*1.4426950408889634f;
__device__ __forceinline__ void glds16(const void*gsrc,unsigned lds_dst){unsigned keep;
  asm volatile("s_mov_b32 %0, m0\n\ts_mov_b32 m0, %2\n\ts_nop 0\n\tglobal_load_lds_dwordx4 %1, off\n\ts_mov_b32 m0, %0":"=&s"(keep):"v"(gsrc),"s"(lds_dst):"memory");}
__device__ __forceinline__ float max3f(float a,float b,float c){float r;asm("v_max3_f32 %0, %1, %2, %3":"=v"(r):"v"(a),"v"(b),"v"(c));return r;}
__device__ __forceinline__ float max2f(float a,float b){float r;asm("v_max_f32_e32 %0, %1, %2":"=v"(r):"v"(a),"v"(b));return r;}
__device__ __forceinline__ float fadd_s(float a,float b){float r;asm("v_add_f32_e32 %0, %1, %2":"=v"(r):"v"(a),"v"(b));return r;}
__device__ __forceinline__ float fsub_s(float a,float b){float r;asm("v_sub_f32_e32 %0, %1, %2":"=v"(r):"v"(a),"v"(b));return r;}
typedef float f32x2_t __attribute__((ext_vector_type(2))); typedef __bf16 bf16x2_t __attribute__((ext_vector_type(2)));
__device__ __forceinline__ unsigned cvtpk_s(float lo,float hi){f32x2_t v={lo,hi};bf16x2_t b=__builtin_convertvector(v,bf16x2_t);return __builtin_bit_cast(unsigned,b);}
#define WAIT_BAR(N) asm volatile("s_waitcnt vmcnt(" #N ") lgkmcnt(0)\n\ts_barrier":::"memory")

__device__ __forceinline__ void qkt(f32x16&p0,f32x16&p1,const char*Kslot,const bf16x8*qr,const f32x16&negm,int r32,int hi){
  const char*kb=Kslot+hi*1024+r32*16;
  #pragma unroll
  for(int d0=0;d0<4;++d0){
    const bf16x8 b0=*reinterpret_cast<const bf16x8*>(kb+d0*2048);
    const bf16x8 b1=*reinterpret_cast<const bf16x8*>(kb+d0*2048+512);
    if(d0==0){p0=__builtin_amdgcn_mfma_f32_32x32x16_bf16(b0,qr[0],negm,0,0,0);p1=__builtin_amdgcn_mfma_f32_32x32x16_bf16(b1,qr[0],negm,0,0,0);}
    else{p0=__builtin_amdgcn_mfma_f32_32x32x16_bf16(b0,qr[d0],p0,0,0,0);p1=__builtin_amdgcn_mfma_f32_32x32x16_bf16(b1,qr[d0],p1,0,0,0);}}
}
typedef __attribute__((address_space(3))) const char* lds_cptr;
typedef short v4i16_t __attribute__((ext_vector_type(4)));
__device__ __forceinline__ void kload8(bf16x8*kf,lds_cptr kp){
  kf[0]=*(const __attribute__((address_space(3))) bf16x8*)(kp);      kf[1]=*(const __attribute__((address_space(3))) bf16x8*)(kp+512);
  kf[2]=*(const __attribute__((address_space(3))) bf16x8*)(kp+2048); kf[3]=*(const __attribute__((address_space(3))) bf16x8*)(kp+2560);
  kf[4]=*(const __attribute__((address_space(3))) bf16x8*)(kp+4096); kf[5]=*(const __attribute__((address_space(3))) bf16x8*)(kp+4608);
  kf[6]=*(const __attribute__((address_space(3))) bf16x8*)(kp+6144); kf[7]=*(const __attribute__((address_space(3))) bf16x8*)(kp+6656);
}
__device__ __forceinline__ void kload2(bf16x8*kf,lds_cptr kp,int j){ kf[2*j]=*(const __attribute__((address_space(3))) bf16x8*)(kp+j*2048); kf[2*j+1]=*(const __attribute__((address_space(3))) bf16x8*)(kp+j*2048+512); }
__device__ __forceinline__ s16x4 vtr(lds_cptr p){ return __builtin_bit_cast(s16x4,__builtin_amdgcn_ds_read_tr16_b64_v4i16((__attribute__((address_space(3))) v4i16_t*)p)); }
__device__ __forceinline__ float rowmax(const f32x16&p0,const f32x16&p1){
  float a=max3f(p0[0],p0[1],p1[0]),b=max3f(p0[2],p0[3],p1[1]);a=max3f(a,p1[2],p1[3]);
  #pragma unroll
  for(int r=4;r<16;r+=4){a=max3f(a,p0[r],p0[r+1]);b=max3f(b,p0[r+2],p0[r+3]);a=max3f(a,p1[r],p1[r+1]);b=max3f(b,p1[r+2],p1[r+3]);}
  const float m=max2f(a,b);
  auto rr=__builtin_amdgcn_permlane32_swap(__float_as_uint(m),__float_as_uint(m),false,false);
  return max2f(__uint_as_float(rr[0]),__uint_as_float(rr[1]));
}
__device__ __forceinline__ void pv(f32x16*o,int vb,bf16x8 pa0,bf16x8 pa1,bf16x8 pa2,bf16x8 pa3){
  #pragma unroll
  for(int d0=0;d0<2;++d0){s16x4 lo[4],hi[4];
    #pragma unroll
    for(int ks=0;ks<4;++ks){
      asm volatile("ds_read_b64_tr_b16 %0,%1 offset:%c2":"=&v"(lo[ks]):"v"(vb),"i"(d0*4096+ks*1024):"memory");
      asm volatile("ds_read_b64_tr_b16 %0,%1 offset:%c2":"=&v"(hi[ks]):"v"(vb),"i"(d0*4096+ks*1024+512):"memory");}
    asm volatile("s_waitcnt lgkmcnt(0)":::"memory");SBAR();
    #define PK(k) (bf16x8){lo[k][0],lo[k][1],lo[k][2],lo[k][3],hi[k][0],hi[k][1],hi[k][2],hi[k][3]}
    o[d0]=__builtin_amdgcn_mfma_f32_32x32x16_bf16(pa0,PK(0),o[d0],0,0,0);
    o[d0]=__builtin_amdgcn_mfma_f32_32x32x16_bf16(pa1,PK(1),o[d0],0,0,0);
    o[d0]=__builtin_amdgcn_mfma_f32_32x32x16_bf16(pa2,PK(2),o[d0],0,0,0);
    o[d0]=__builtin_amdgcn_mfma_f32_32x32x16_bf16(pa3,PK(3),o[d0],0,0,0);
    #undef PK
  }
}

#ifndef ATTN_STORE16
#define ATTN_STORE16(p,v) (*(u32x4*)(p)=(v))
#endif
template<int THRL> __device__ __forceinline__ void attn_unit(int b,int h,int qb,const bf16*Q,const bf16*__restrict__ K,const bf16*__restrict__ V,bf16*O,const unsigned char*__restrict__ SEL,char*shm,int wv){
  const int tid=mktid(wv),lane=tid&63,r32=lane&31,hi=lane>>5;     const int wid=__builtin_amdgcn_readfirstlane(tid>>6);
  const long rowbase=(long)b*SEQ; const int q0=qb*QB;
  const bf16*Qw=Q+(rowbase+q0+wid*QBLK)*PQ+h*D;
  const bf16*Kh=K+rowbase*PK+h*D,*Vh=V+rowbase*PV+h*D;
  const unsigned lds0=(unsigned)(uintptr_t)shm;
  float*wsf=(float*)(shm+LDS_WS)+wid*64;
  const bf16*ksrc=Kh+(long)lane*PK+wid*8;
  const bf16*vsrc=Vh+(long)(16*(wid&3)+(lane>>2))*PV+(wid>>2)*32+(lane&3)*8;
  const unsigned kdst=lds0+LDS_K+wid*1024, vdst=lds0+LDS_V+wid*1024;
  #define TROW(t) ((long)(((t)<4)?(q0+(t)*KVBLK):(((t)-4)*KVBLK)))
  #define DMA_K(t,slot) glds16(ksrc+TROW(t)*PK,(unsigned)__builtin_amdgcn_readfirstlane(kdst+(slot)))
  #define DMA_V(t,slot) glds16(vsrc+TROW(t)*PV,(unsigned)__builtin_amdgcn_readfirstlane(vdst+(slot)))
  const int vb0=(int)(lds0+LDS_V)+((lane>>4)&1)*32+(lane&3)*8+(4*hi+((lane&15)>>2))*64;
  const char*Kbase=shm+LDS_K; bf16x8 kf[8];
  const lds_cptr shm3=(lds_cptr)shm; const lds_cptr kp0=shm3+LDS_K+hi*1024+r32*16; const lds_cptr vp0=shm3+LDS_V+((lane>>4)&1)*32+(lane&3)*8+(4*hi+((lane&15)>>2))*64;
  const int NT=(q0+QB)/KVBLK;
  DMA_K(0,0);DMA_V(0,0);DMA_K(1,SLOTB);
  bf16x8 qr[4];
  #pragma unroll
  for(int d0=0;d0<4;++d0)qr[d0]=*reinterpret_cast<const bf16x8*>(&Qw[(long)r32*PQ+d0*16+hi*8]);
  float mhat=0.f,l_reg=0.f;f32x16 o[2];o[0]=f32x16{};o[1]=f32x16{};
  const int qrel=wid*QBLK+r32;
  const unsigned selb=(unsigned)SEL[((long)(b*NHEAD+h))*SEQ+q0+qrel];
  #define CMASK(P0,P1,t) cmask(P0,P1,(t),qrel,hi)
  #define SUBREF(C0,C1,t) do{ const float sb_=(((t)<4)||((selb>>(((t)-4)>>2))&1u))?mhat:INFINITY; _Pragma("unroll") for(int r_=0;r_<16;++r_){C0[r_]-=sb_;C1[r_]-=sb_;} }while(0)
  bool resc=false;
  #define START(P0,P1) do{ const float rm=rowmax(P0,P1); resc=false; \
    { const float dl=rm; mhat=fadd_s(mhat,dl); \
      _Pragma("unroll") for(int r=0;r<16;++r){P0[r]=fsub_s(P0[r],dl);P1[r]=fsub_s(P1[r],dl);} \
      } \
    _Pragma("unroll") for(int r=0;r<16;++r)P0[r]=__builtin_amdgcn_exp2f(P0[r]); }while(0)
  #define RESC() do{ if(resc){ asm volatile("s_waitcnt lgkmcnt(0)":::"memory"); \
      _Pragma("unroll") for(int d_=0;d_<2;++d_) _Pragma("unroll") for(int r=0;r<16;++r)o[d_][r]*=wsf[crow(r,hi)]; } }while(0)
  f32x16 pA0,pA1,pB0,pB1;
  int sl_prev=0,sl_cur=0,sl_next=SLOTB;
  #define ROT() do{sl_prev=sl_cur;sl_cur=sl_next;sl_next=(sl_next==(NSLOT-1)*SLOTB)?0:sl_next+SLOTB;}while(0)
  DMA_K(2,2*SLOTB);
  WAIT_BAR(3);
  qkt(pA0,pA1,Kbase,qr,f32x16{},r32,hi);asm volatile("s_nop 15\n\ts_nop 7":"+v"(pA0),"+v"(pA1));CMASK(pA0,pA1,0);
  START(pA0,pA1);
  _Pragma("unroll") for(int r=0;r<16;++r)pA1[r]=__builtin_amdgcn_exp2f(pA1[r]);
  WAIT_BAR(0);
  DMA_K(3,0);DMA_V(1,SLOTB);
  ROT();
  kload8(kf,kp0+sl_cur);
  WAIT_BAR(2);
  s16x4 vlo[8],vhi[8]; u32x4 pw0,pw1,pw2,pw3;
  #define PKW(P,B) cvtpk_s(P[B],P[B+1])
  #define PAF(k) __builtin_bit_cast(bf16x8,pw##k)
  #define VFR(i) (bf16x8){vlo[i][0],vlo[i][1],vlo[i][2],vlo[i][3],vhi[i][0],vhi[i][1],vhi[i][2],vhi[i][3]}
  #define PIN(x) asm volatile("":"+v"(x))
  #define MX3(a,b,c) __builtin_fmaxf(__builtin_fmaxf((a),(b)),(c))
  #define GAPA(MF,A0,A1,A2,A3,W0,W1,PW) do{ MF; sacc+=A0; sacc+=A1; sacc+=A2; sacc+=A3; PIN(sacc); W0; W1; PIN(PW); SBAR(); }while(0)
  #define EX(v) __builtin_amdgcn_exp2f(v)
  #define GAPB(MF,X,B) do{ MF; X[B]=EX(X[B]); X[B+1]=EX(X[B+1]); X[B+2]=EX(X[B+2]); X[B+3]=EX(X[B+3]); PIN(X); SBAR(); }while(0)
  #define VRD(i) do{ vlo[i]=vtr(vp_+(((i)>>2)*4096+((i)&3)*1024)); vhi[i]=vtr(vp_+(((i)>>2)*4096+((i)&3)*1024+512)); }while(0)
  #define KRD(G,j) do{ if(G){ kload2(kf,kp0+sl_next,j); SBAR(); } }while(0)
  #define STEP(C0,C1,P0,P1,t,GK,GV,GL,MB) do{ SBAR(); \
    const lds_cptr vp_=vp0+sl_prev; \
    VRD(0); SBAR(); float sacc=(P0[0]+P0[1]); \
    GAPA(C0=__builtin_amdgcn_mfma_f32_32x32x16_bf16(kf[0],qr[0],f32x16{},0,0,0), P0[2],P0[3],P0[4],P0[5],     pw0[0]=PKW(P0,0), pw0[1]=PKW(P0,2), pw0); \
    VRD(4); SBAR(); GAPA(C1=__builtin_amdgcn_mfma_f32_32x32x16_bf16(kf[1],qr[0],f32x16{},0,0,0), P0[6],P0[7],P0[8],P0[9],     pw0[2]=PKW(P0,4), pw0[3]=PKW(P0,6), pw0); \
    VRD(1); SBAR(); GAPA(C0=__builtin_amdgcn_mfma_f32_32x32x16_bf16(kf[2],qr[1],C0,0,0,0),   P0[10],P0[11],P0[12],P0[13], pw1[0]=PKW(P0,8), pw1[1]=PKW(P0,10), pw1); \
    VRD(5); SBAR(); GAPA(C1=__builtin_amdgcn_mfma_f32_32x32x16_bf16(kf[3],qr[1],C1,0,0,0),   P0[14],P0[15],P1[0],P1[1],   pw1[2]=PKW(P0,12),pw1[3]=PKW(P0,14), pw1); \
    VRD(2); SBAR(); GAPA(C0=__builtin_amdgcn_mfma_f32_32x32x16_bf16(kf[4],qr[2],C0,0,0,0),   P1[2],P1[3],P1[4],P1[5],     pw2[0]=PKW(P1,0), pw2[1]=PKW(P1,2), pw2); \
    VRD(6); SBAR(); GAPA(C1=__builtin_amdgcn_mfma_f32_32x32x16_bf16(kf[5],qr[2],C1,0,0,0),   P1[6],P1[7],P1[8],P1[9],     pw2[2]=PKW(P1,4), pw2[3]=PKW(P1,6), pw2); \
    VRD(3); SBAR(); GAPA(C0=__builtin_amdgcn_mfma_f32_32x32x16_bf16(kf[6],qr[3],C0,0,0,0),   P1[10],P1[11],P1[12],P1[13], pw3[0]=PKW(P1,8), pw3[1]=PKW(P1,10), pw3); \
    VRD(7); SBAR(); GAPA(C1=__builtin_amdgcn_mfma_f32_32x32x16_bf16(kf[7],qr[3],C1,0,0,0),   P1[14],P1[15],0.f,0.f,       pw3[2]=PKW(P1,12),pw3[3]=PKW(P1,14), pw3); \
    l_reg+=sacc; \
    if(GK){DMA_K((t)+3,sl_cur);} if(GV){DMA_V((t)+1,sl_next);} \
    SUBREF(C0,C1,t); if(MB){CMASK(C0,C1,t);} \
    { float a=MX3(C0[0],C0[1],C1[0]),b=MX3(C0[2],C0[3],C1[1]); a=MX3(a,C1[2],C1[3]); \
      _Pragma("unroll") for(int r=4;r<16;r+=4){a=MX3(a,C0[r],C0[r+1]);b=MX3(b,C0[r+2],C0[r+3]);a=MX3(a,C1[r],C1[r+1]);b=MX3(b,C1[r+2],C1[r+3]);} \
      float rm=__builtin_fmaxf(a,b); { auto rr=__builtin_amdgcn_permlane32_swap(__float_as_uint(rm),__float_as_uint(rm),false,false); rm=__builtin_fmaxf(__uint_as_float(rr[0]),__uint_as_float(rr[1])); } \
      resc=false; \
      if(__builtin_expect(__any(rm>(float)THRL),0)){ const float dl=__builtin_fmaxf(rm,0.f); mhat+=dl; \
        _Pragma("unroll") for(int r=0;r<16;++r){C0[r]-=dl;C1[r]-=dl;} \
        const float f=__builtin_amdgcn_exp2f(-dl); l_reg*=f; if(hi==0)wsf[r32]=f; resc=true; } } \
    SBAR(); \
    GAPB(o[0]=__builtin_amdgcn_mfma_f32_32x32x16_bf16(PAF(0),VFR(0),o[0],0,0,0), C0,0); \
    GAPB(o[1]=__builtin_amdgcn_mfma_f32_32x32x16_bf16(PAF(0),VFR(4),o[1],0,0,0), C0,4); \
    KRD(GL,0); GAPB(o[0]=__builtin_amdgcn_mfma_f32_32x32x16_bf16(PAF(1),VFR(1),o[0],0,0,0), C0,8); \
    KRD(GL,1); GAPB(o[1]=__builtin_amdgcn_mfma_f32_32x32x16_bf16(PAF(1),VFR(5),o[1],0,0,0), C0,12); \
    KRD(GL,2); GAPB(o[0]=__builtin_amdgcn_mfma_f32_32x32x16_bf16(PAF(2),VFR(2),o[0],0,0,0), C1,0); \
    KRD(GL,3); GAPB(o[1]=__builtin_amdgcn_mfma_f32_32x32x16_bf16(PAF(2),VFR(6),o[1],0,0,0), C1,4); \
    GAPB(o[0]=__builtin_amdgcn_mfma_f32_32x32x16_bf16(PAF(3),VFR(3),o[0],0,0,0), C1,8); \
    GAPB(o[1]=__builtin_amdgcn_mfma_f32_32x32x16_bf16(PAF(3),VFR(7),o[1],0,0,0), C1,12); \
    }while(0)
  #define ENDW(tt) do{ if((tt)+3<NT){WAIT_BAR(2);} else if((tt)+2<NT){WAIT_BAR(1);} else {WAIT_BAR(0);} }while(0)
  { int t=1;
    for(;t+1<NT;t+=2){
      STEP(pB0,pB1,pA0,pA1,t,(t+3<NT),(t+1<NT),(t+1<NT),(t<4));       ENDW(t);   RESC(); ROT();
      STEP(pA0,pA1,pB0,pB1,t+1,(t+4<NT),(t+2<NT),(t+2<NT),(t+1<4));     ENDW(t+1); RESC(); ROT();
    }
    STEP(pB0,pB1,pA0,pA1,NT-1,false,false,false,(NT==4)); RESC();
  }
  { float sacc=pB0[0]+pB0[1]; _Pragma("unroll") for(int r=2;r<16;++r)sacc+=pB0[r]; _Pragma("unroll") for(int r=0;r<16;++r)sacc+=pB1[r]; l_reg+=sacc;
    pw0=(u32x4){PKW(pB0,0),PKW(pB0,2),PKW(pB0,4),PKW(pB0,6)};pw1=(u32x4){PKW(pB0,8),PKW(pB0,10),PKW(pB0,12),PKW(pB0,14)};pw2=(u32x4){PKW(pB1,0),PKW(pB1,2),PKW(pB1,4),PKW(pB1,6)};pw3=(u32x4){PKW(pB1,8),PKW(pB1,10),PKW(pB1,12),PKW(pB1,14)};
    SBAR(); pv(o,vb0+sl_cur,PAF(0),PAF(1),PAF(2),PAF(3)); }
  #undef PKW
  #undef PAF
  #undef VFR
  #undef PIN
  #undef MX3
  #undef GAPA
  #undef GAPB
  #undef EX
  #undef VRD
  #undef KRD
  #undef STEP
  #undef ENDW
  {auto rr=__builtin_amdgcn_permlane32_swap(__float_as_uint(l_reg),__float_as_uint(l_reg),false,false);l_reg=__uint_as_float(rr[0])+__uint_as_float(rr[1]);}
  if(hi==0)wsf[32+r32]=l_reg;asm volatile("s_waitcnt lgkmcnt(0)":::"memory");
  float rli[16];
  #pragma unroll
  for(int r=0;r<16;++r)rli[r]=__builtin_amdgcn_rcpf(wsf[32+crow(r,hi)]);
  bf16*Ow=O+(rowbase+q0+wid*QBLK)*PO+h*D;
  { bf16*stg=(bf16*)(shm+LDS_OST)+wid*2048;
    #pragma unroll
    for(int r=0;r<16;++r){const int orow=crow(r,hi);
      #pragma unroll
      for(int d0=0;d0<2;++d0)stg[orow*64+d0*32+r32]=__float2bfloat16(o[d0][r]*rli[r]);}
    asm volatile("s_waitcnt lgkmcnt(0)":::"memory");
    #pragma unroll
    for(int i=0;i<4;++i){const int row=i*8+(lane>>3),ch=lane&7; const u32x4 v=*(const u32x4*)(stg+row*64+ch*8); ATTN_STORE16(Ow+(long)row*PO+ch*8,v);} }
  asm volatile("s_waitcnt lgkmcnt(0)\n\ts_barrier":::"memory");
  #undef DMA_K
  #undef TROW
  #undef SUBREF
  #undef DMA_V
  #undef CMASK
  #undef START
  #undef RESC
  #undef ROT
}
constexpr int ATTN_LDS_BYTES=LDS_BYTES;
#undef SBAR
#undef WAIT_BAR
}
constexpr int DM = 1024, NB = 16, SEQ = 2048, NT = NB * SEQ;
constexpr int RWW = 512, INC = 5376, ZA = 1792, ZG = 3328;
constexpr int NEXP = 32, DEXP = 512;
constexpr int XS_ROWS = 2 * NT + NEXP * 256;
constexpr float C2 = 0.125f * 1.4426950408889634f;

#define LAS __attribute__((address_space(3)))
#define GAS __attribute__((address_space(1)))
typedef unsigned short bf16;
typedef unsigned v4u __attribute__((ext_vector_type(4)));
typedef unsigned v2u __attribute__((ext_vector_type(2)));
typedef float f32x4 __attribute__((ext_vector_type(4)));

__device__ __forceinline__ unsigned f2bf(float f) { unsigned u = __builtin_bit_cast(unsigned, f); return (u + 0x7fffu + ((u >> 16) & 1u)) >> 16; }
__device__ __forceinline__ unsigned pk2(float lo, float hi) { return f2bf(lo) | (f2bf(hi) << 16); }
__device__ __forceinline__ float bflo(unsigned w) { return __builtin_bit_cast(float, w << 16); }
__device__ __forceinline__ float bfhi(unsigned w) { return __builtin_bit_cast(float, w & 0xffff0000u); }
__device__ __forceinline__ float sigm(float x) { return __builtin_amdgcn_rcpf(1.0f + __expf(-x)); }

constexpr size_t MiB = 1u << 20;
constexpr size_t WS_CTL = 0;
constexpr size_t WS_MOD = 1 * MiB;
constexpr size_t WS_COS = 2 * MiB;
constexpr size_t WS_SIN = 2 * MiB + 512 * 1024;
constexpr size_t WS_KMEAN = 3 * MiB;
constexpr size_t WS_WRH = 3 * MiB + 512 * 1024;
constexpr size_t WS_WRL = 3 * MiB + 768 * 1024;
constexpr size_t WS_SEL = 4 * MiB;
constexpr size_t WS_RTE = 5 * MiB;
constexpr size_t WS_RTW = 5 * MiB + 256 * 1024;
constexpr size_t WS_RNK = 5 * MiB + 512 * 1024;
constexpr size_t WS_POS = 5 * MiB + 768 * 1024;
constexpr size_t WS_WLT = 6 * MiB;
constexpr size_t WS_WAT = 6 * MiB + 64 * 1024;
constexpr size_t WS_WGT = 6 * MiB + 128 * 1024;
constexpr size_t WS_WIN = 16 * MiB;
constexpr size_t WS_WBA = 27 * MiB;
constexpr size_t WS_WBB = 28 * MiB;
constexpr size_t WS_WOUT = 29 * MiB;
constexpr size_t WS_Z = 32 * MiB;
constexpr size_t WS_H = 368 * MiB;
constexpr size_t WS_Q = 368 * MiB, WS_K = 400 * MiB, WS_MRG = 368 * MiB;
constexpr size_t WS_YA = 432 * MiB, WS_YB = 464 * MiB;
constexpr size_t WS_WUP = 32 * MiB;
constexpr size_t WS_W2T = 96 * MiB;
constexpr size_t WS_H2 = 128 * MiB;
constexpr size_t WS_XS = 192 * MiB;
constexpr size_t WS_HID = 336 * MiB;
constexpr size_t WS_END = 496 * MiB;
constexpr int CW_CNT = 64;
constexpr int CW_NT = 128;
constexpr int CW_TEXP = 256;

__device__ __forceinline__ void tr_item(const float* W, int K, int N, bf16* WT, int kb, int nb, int dst_row0, LAS float* scr, int lane) {
    const int k0 = 64 * kb, n0 = 32 * nb;
#pragma unroll 8
    for (int i = 0; i < 32; ++i) { const int kk = 2 * i + (lane >> 5); scr[kk * 33 + (lane & 31)] = W[(size_t)(k0 + kk) * N + n0 + (lane & 31)]; }
    asm volatile("s_waitcnt lgkmcnt(0)" ::: "memory");
    const int c = lane & 7;
#pragma unroll
    for (int j = 0; j < 4; ++j) { const int n = (lane >> 3) + 8 * j; const LAS float* s = scr + (8 * c) * 33 + n;
        v4u o; o.x = pk2(s[0 * 33], s[1 * 33]); o.y = pk2(s[2 * 33], s[3 * 33]); o.z = pk2(s[4 * 33], s[5 * 33]); o.w = pk2(s[6 * 33], s[7 * 33]);
        *(v4u*)(WT + (size_t)(dst_row0 + n) * K + k0 + 8 * c) = o; }
    asm volatile("s_waitcnt lgkmcnt(0)" ::: "memory");
}

struct PArgs { const float* in[30]; float* out; unsigned char* ws; };

__device__ __forceinline__ void p_prep_weights(const PArgs& a, unsigned char* lds, int wv) {
    const int tid = mktid(wv), lane = tid & 63, wave = tid >> 6;
    LAS float* scr = (LAS float*)lds + wave * (64 * 33);
    const int gw = blockIdx.x * 8 + wave, NGW = gridDim.x * 8;
    unsigned char* ws = a.ws;
    constexpr int I_IN = 16 * 168, I_BR = 8 * 32, I_OUT = 16 * 32;
    for (int it = gw; it < I_IN + 2 * I_BR + I_OUT; it += NGW) {
        int r = it;
        if (r < I_IN) { const int kb = r / 168, nb = r % 168; tr_item(a.in[6], 1024, INC, (bf16*)(ws + WS_WIN), kb, nb, 32 * nb, scr, lane); continue; } r -= I_IN;
        if (r < I_BR) { const int kb = r / 32, nb = r % 32; tr_item(a.in[20], 512, 1024, (bf16*)(ws + WS_WBA), kb, nb, 32 * nb, scr, lane); continue; } r -= I_BR;
        if (r < I_BR) { const int kb = r / 32, nb = r % 32; tr_item(a.in[21], 512, 1024, (bf16*)(ws + WS_WBB), kb, nb, 32 * nb, scr, lane); continue; } r -= I_BR;
        { const int kb = r / 32, nb = r % 32; tr_item(a.in[22], 1024, 1024, (bf16*)(ws + WS_WOUT), kb, nb, 32 * nb, scr, lane); }
    }
    const int gt = blockIdx.x * 512 + tid, NGT = gridDim.x * 512;
    float* cosT = (float*)(ws + WS_COS); float* sinT = (float*)(ws + WS_SIN);
    for (int i = gt; i < SEQ * 32; i += NGT) { const int s = i >> 5, f = i & 31; const float inv = powf(10000.0f, -(float)f / 32.0f); const float ang = (float)s * inv; cosT[i] = cosf(ang); sinT[i] = sinf(ang); }
    { bf16* wlt = (bf16*)(ws + WS_WLT); bf16* wat = (bf16*)(ws + WS_WAT); bf16* wgt = (bf16*)(ws + WS_WGT);
      for (int i = gt; i < 8 * 64 * 64; i += NGT) { const int hh = i >> 12, j = (i >> 6) & 63, m = i & 63; wlt[i] = (bf16)f2bf(a.in[9][m * 512 + hh * 64 + j]); wat[i] = (bf16)f2bf(a.in[11][m * 512 + hh * 64 + j]); }
      for (int i = gt; i < 8 * 64 * 128; i += NGT) { const int hh = i >> 13, j = (i >> 7) & 63, m = i & 127; wgt[i] = (bf16)f2bf(a.in[12][m * 512 + hh * 64 + j]); } }
    { bf16* wrh = (bf16*)(ws + WS_WRH); bf16* wrl = (bf16*)(ws + WS_WRL);
      for (int i = gt; i < 48 * 1024; i += NGT) { const int e = i >> 10, k = i & 1023; const float w = e < 4 ? a.in[23][k * 4 + e] : e < 36 ? a.in[25][k * 32 + (e - 4)] : 0.f;
          const unsigned hi = f2bf(w); wrh[i] = (bf16)hi; wrl[i] = (bf16)f2bf(w - bflo(hi)); } }
}

__device__ __forceinline__ void p_prep_experts(const PArgs& a, unsigned char* lds, int wv) {
    const int tid = mktid(wv), lane = tid & 63, wave = tid >> 6;
    LAS float* scr = (LAS float*)lds + wave * (64 * 33);
    const int gw = blockIdx.x * 8 + wave, NGW = gridDim.x * 8;
    unsigned char* ws = a.ws;
    for (int it = gw; it < NEXP * 768; it += NGW) {
        const int e = it / 768; int r = it % 768;
        bf16* wup = (bf16*)(ws + WS_WUP) + (size_t)e * 1024 * 1024;
        if (r < 256) { const int kb = r / 16, nb = r % 16, n0 = 32 * nb; tr_item(a.in[27] + (size_t)e * 1024 * 512, 1024, 512, wup, kb, nb, (n0 >> 7) * 256 + (n0 & 127), scr, lane); continue; } r -= 256;
        if (r < 256) { const int kb = r / 16, nb = r % 16, n0 = 32 * nb; tr_item(a.in[28] + (size_t)e * 1024 * 512, 1024, 512, wup, kb, nb, (n0 >> 7) * 256 + 128 + (n0 & 127), scr, lane); continue; } r -= 256;
        { const int kb = r / 32, nb = r % 32; tr_item(a.in[29] + (size_t)e * 512 * 1024, 512, 1024, (bf16*)(ws + WS_W2T) + (size_t)e * 1024 * 512, kb, nb, 32 * nb, scr, lane); }
    }
}

__device__ __forceinline__ void p_ada(const PArgs& a, unsigned char* lds, int wv) {
    float* sc = (float*)lds; float* red = sc + 16 * 1024;
    const float* c = a.in[1]; const float* w = a.in[2]; const float* bias = a.in[3];
    float* mod = (float*)(a.ws + WS_MOD);
    const int tid = mktid(wv);
    for (int i = tid; i < 16 * 1024; i += 512) { const float v = c[i]; sc[i] = v / (1.0f + __expf(-v)); }
    __syncthreads();
    const int col = tid & 31, kg = tid >> 5;
    for (int tile = blockIdx.x; tile < 192; tile += gridDim.x) {
        const int e = tile * 32 + col;
        float acc[16];
#pragma unroll
        for (int b = 0; b < 16; ++b) acc[b] = 0.f;
        for (int d = kg * 64; d < kg * 64 + 64; ++d) { const float wv = w[(size_t)d * 6144 + e];
#pragma unroll
            for (int b = 0; b < 16; ++b) acc[b] += sc[b * 1024 + d] * wv; }
#pragma unroll
        for (int b = 0; b < 16; ++b) red[(kg * 16 + b) * 32 + col] = acc[b];
        __syncthreads();
        { const int b = tid >> 5, cc = tid & 31; float sm = 0.f;
#pragma unroll
            for (int k = 0; k < 16; ++k) sm += red[(k * 16 + b) * 32 + cc];
            mod[b * 6144 + tile * 32 + cc] = sm + bias[tile * 32 + cc]; }
        __syncthreads();
    }
}

__device__ __forceinline__ void p_norm1(const PArgs& a, unsigned char* lds, int wv) {
    const int tid = mktid(wv), lane = tid & 63, gw = blockIdx.x * 8 + (tid >> 6), NGW = gridDim.x * 8;
    const float* x = a.in[0]; const float* g = a.in[4]; const float* mod = (const float*)(a.ws + WS_MOD);
    bf16* h = (bf16*)(a.ws + WS_H);
    for (int m = gw; m < NT; m += NGW) {
        const int b = m >> 11; const f32x4* xr = (const f32x4*)(x + (size_t)m * DM) + lane; f32x4 v[4]; float s = 0.f;
#pragma unroll
        for (int j = 0; j < 4; ++j) { v[j] = xr[64 * j]; s += (v[j].x * v[j].x + v[j].y * v[j].y) + (v[j].z * v[j].z + v[j].w * v[j].w); }
        const float rstd = rsqrtf(wave_sum(s) * (1.0f / DM) + 1e-6f);
        v2u* o = (v2u*)(h + (size_t)m * DM) + lane;
#pragma unroll
        for (int j = 0; j < 4; ++j) { const int col = 4 * (lane + 64 * j);
            const f32x4 gg = *(const f32x4*)(g + col), sh = *(const f32x4*)(mod + b * 6144 + col), scl = *(const f32x4*)(mod + b * 6144 + 1024 + col);
            const f32x4 r = v[j] * rstd * gg * (scl + 1.0f) + sh; v2u w; w.x = pk2(r.x, r.y); w.y = pk2(r.z, r.w); o[64 * j] = w; }
    }
}

using pg8::Unit; using pg8::HALF; using pg8::BM; using pg8::cvt_pk_bf16;
typedef pg8::f32x4 pf4; typedef pg8::u32x4 pu4;

struct EpiStoreBf16 {
    static constexpr bool PERM = true, AFTER_DRAIN = false;
    bf16* O; int ldc;
    __device__ __forceinline__ void operator()(const pf4 (&acc)[2][2][4][2], const Unit& u, int wr, int wc, int fr, int fq) const {
        const int row0 = u.pm * BM + wr * 64 + fr, col0 = u.pn * BM + wc * 32 + 8 * fq;
#pragma unroll
        for (int ai = 0; ai < 2; ++ai)
#pragma unroll
            for (int m = 0; m < 4; ++m) { bf16* rowp = O + (size_t)(row0 + ai * HALF + m * 16) * ldc + col0;
#pragma unroll
                for (int bj = 0; bj < 2; ++bj) { const pf4 v0 = acc[ai][bj][m][0], v1 = acc[ai][bj][m][1]; pu4 w;
                    w.x = cvt_pk_bf16(v0[0], v0[1]); w.y = cvt_pk_bf16(v0[2], v0[3]); w.z = cvt_pk_bf16(v1[0], v1[1]); w.w = cvt_pk_bf16(v1[2], v1[3]);
                    *(pu4*)(rowp + bj * HALF) = w; } }
    }
};
struct EpiBranchA {
    static constexpr bool PERM = false, AFTER_DRAIN = false;
    float* tmp; const bf16* z;
    __device__ __forceinline__ void operator()(const pf4 (&acc)[2][2][4][2], const Unit& u, int wr, int wc, int fr, int fq) const {
        const int row0 = u.pm * BM + wr * 64 + fr, col0 = u.pn * BM + wc * 32 + 4 * fq;
#pragma unroll
        for (int ai = 0; ai < 2; ++ai)
#pragma unroll
            for (int m = 0; m < 4; ++m) { const size_t row = (size_t)(row0 + ai * HALF + m * 16);
#pragma unroll
                for (int bj = 0; bj < 2; ++bj)
#pragma unroll
                    for (int n = 0; n < 2; ++n) { const int col = col0 + bj * HALF + n * 16; const v2u gz = *(const v2u*)(z + row * INC + ZG + col); const pf4 v = acc[ai][bj][m][n];
                        pf4 o; o[0] = sigm(bflo(gz.x)) * v[0]; o[1] = sigm(bfhi(gz.x)) * v[1]; o[2] = sigm(bflo(gz.y)) * v[2]; o[3] = sigm(bfhi(gz.y)) * v[3];
                        *(pf4*)(tmp + row * DM + col) = o; } }
    }
};
struct EpiBranchB {
    static constexpr bool PERM = true, AFTER_DRAIN = false;
    const float* tmp; const bf16* z; bf16* mrg;
    __device__ __forceinline__ void operator()(const pf4 (&acc)[2][2][4][2], const Unit& u, int wr, int wc, int fr, int fq) const {
        const int row0 = u.pm * BM + wr * 64 + fr, col0 = u.pn * BM + wc * 32 + 8 * fq;
#pragma unroll
        for (int ai = 0; ai < 2; ++ai)
#pragma unroll
            for (int m = 0; m < 4; ++m) { const size_t row = (size_t)(row0 + ai * HALF + m * 16);
#pragma unroll
                for (int bj = 0; bj < 2; ++bj) { const int col = col0 + bj * HALF; const pu4 gz = *(const pu4*)(z + row * INC + ZG + 1024 + col);
                    const pf4 t0 = *(const pf4*)(tmp + row * DM + col), t1 = *(const pf4*)(tmp + row * DM + col + 4); const pf4 v0 = acc[ai][bj][m][0], v1 = acc[ai][bj][m][1];
                    pu4 w;
                    w.x = cvt_pk_bf16(t0[0] + sigm(bflo(gz.x)) * v0[0], t0[1] + sigm(bfhi(gz.x)) * v0[1]);
                    w.y = cvt_pk_bf16(t0[2] + sigm(bflo(gz.y)) * v0[2], t0[3] + sigm(bfhi(gz.y)) * v0[3]);
                    w.z = cvt_pk_bf16(t1[0] + sigm(bflo(gz.z)) * v1[0], t1[1] + sigm(bfhi(gz.z)) * v1[1]);
                    w.w = cvt_pk_bf16(t1[2] + sigm(bflo(gz.w)) * v1[2], t1[3] + sigm(bfhi(gz.w)) * v1[3]);
                    *(pu4*)(mrg + row * DM + col) = w; } }
    }
};
struct EpiOut {
    static constexpr bool PERM = false, AFTER_DRAIN = false;
    const float* x; const float* mod; float* out;
    __device__ __forceinline__ void operator()(const pf4 (&acc)[2][2][4][2], const Unit& u, int wr, int wc, int fr, int fq) const {
        const int row0 = u.pm * BM + wr * 64 + fr, col0 = u.pn * BM + wc * 32 + 4 * fq; const int b = u.pm >> 3;
        pf4 gt[2][2];
#pragma unroll
        for (int bj = 0; bj < 2; ++bj)
#pragma unroll
            for (int n = 0; n < 2; ++n) gt[bj][n] = *(const pf4*)(mod + b * 6144 + 2048 + col0 + bj * HALF + n * 16);
#pragma unroll
        for (int ai = 0; ai < 2; ++ai)
#pragma unroll
            for (int m = 0; m < 4; ++m) { const size_t off = (size_t)(row0 + ai * HALF + m * 16) * DM + col0;
#pragma unroll
                for (int bj = 0; bj < 2; ++bj)
#pragma unroll
                    for (int n = 0; n < 2; ++n) { const pf4 xv = *(const pf4*)(x + off + bj * HALF + n * 16); *(pf4*)(out + off + bj * HALF + n * 16) = xv + gt[bj][n] * acc[ai][bj][m][n]; } }
    }
};
struct EpiUp {
    static constexpr bool PERM = true, AFTER_DRAIN = false;
    bf16* hid;
    __device__ __forceinline__ void operator()(const pf4 (&acc)[2][2][4][2], const Unit& u, int wr, int wc, int fr, int fq) const {
        const int row0 = u.pm * BM + wr * 64 + fr, col0 = u.pn * 128 + wc * 32 + 8 * fq;
#pragma unroll
        for (int ai = 0; ai < 2; ++ai)
#pragma unroll
            for (int m = 0; m < 4; ++m) { const size_t row = (size_t)(row0 + ai * HALF + m * 16); float o[8];
#pragma unroll
                for (int n = 0; n < 2; ++n)
#pragma unroll
                    for (int e = 0; e < 4; ++e) { const float g = acc[ai][0][m][n][e], l = acc[ai][1][m][n][e]; o[4 * n + e] = g * sigm(g) * l; }
                pu4 w; w.x = cvt_pk_bf16(o[0], o[1]); w.y = cvt_pk_bf16(o[2], o[3]); w.z = cvt_pk_bf16(o[4], o[5]); w.w = cvt_pk_bf16(o[6], o[7]);
                *(pu4*)(hid + row * DEXP + col0) = w; }
    }
};

struct GemmArgs { unsigned char* ws; const float* x; float* out; };
template <class Epi> __device__ __forceinline__ void run_dense(const void* A, const void* Bt, int M, int N, int K, const Epi& E, unsigned char* lds, int wv) {
    pg8::Gemm g{K}; pg8::StaticOrder S; S.init(A, Bt, M, N, K, (int)gridDim.x, (int)blockIdx.x);
    pg8::gemm_phase<Epi, pg8::StaticOrder, true, true>((PG8_LAS unsigned char*)lds, g, S, E, wv);
}
__device__ __forceinline__ void p_gemm_in(const GemmArgs& a, unsigned char* lds, int wv) {
    EpiStoreBf16 E{(bf16*)(a.ws + WS_Z), INC};
    run_dense(a.ws + WS_H, a.ws + WS_WIN, NT, INC, 1024, E, lds, wv);
}
__device__ __forceinline__ void p_gemm_bra(const GemmArgs& a, unsigned char* lds, int wv) {
    EpiBranchA E{a.out, (const bf16*)(a.ws + WS_Z)};
    run_dense(a.ws + WS_YA, a.ws + WS_WBA, NT, 1024, 512, E, lds, wv);
}
__device__ __forceinline__ void p_gemm_brb(const GemmArgs& a, unsigned char* lds, int wv) {
    EpiBranchB E{a.out, (const bf16*)(a.ws + WS_Z), (bf16*)(a.ws + WS_MRG)};
    run_dense(a.ws + WS_YB, a.ws + WS_WBB, NT, 1024, 512, E, lds, wv);
}
__device__ __forceinline__ void p_gemm_out(const GemmArgs& a, unsigned char* lds, int wv) {
    EpiOut E{a.x, (const float*)(a.ws + WS_MOD), a.out};
    run_dense(a.ws + WS_MRG, a.ws + WS_WOUT, NT, 1024, 1024, E, lds, wv);
}
struct GroupedOrder {
    const int* texp; int nT, nN, G, c; const char* A; size_t a_tile; const char* B; size_t b_exp, b_tile;
    __device__ bool next(int i, Unit& u) const {
        const long L = (long)i * G + c; if (L >= (long)nT * nN) return false;
        const int tile = (int)(L / nN), pn = (int)(L % nN); u.pm = tile; u.pn = pn; u.a = A + (size_t)tile * a_tile; u.b = B + (size_t)texp[tile] * b_exp + (size_t)pn * b_tile; return true;
    }
    __device__ __forceinline__ void a_ready(const Unit&) const {}
    __device__ __forceinline__ void done(const Unit&) const {}
};
__device__ __forceinline__ void p_gemm_up(const GemmArgs& a, unsigned char* lds, int wv) {
    const int* ctl = (const int*)(a.ws + WS_CTL);
    GroupedOrder S{ctl + CW_TEXP, ctl[CW_NT], 4, (int)gridDim.x, (int)blockIdx.x, (const char*)(a.ws + WS_XS), (size_t)256 * 1024 * 2, (const char*)(a.ws + WS_WUP), (size_t)1024 * 1024 * 2, (size_t)256 * 1024 * 2};
    EpiUp E{(bf16*)(a.ws + WS_HID)}; pg8::Gemm g{1024};
    pg8::gemm_phase<EpiUp, GroupedOrder, true, true>((PG8_LAS unsigned char*)lds, g, S, E, wv);
}
__device__ __forceinline__ void p_gemm_down(const GemmArgs& a, unsigned char* lds, int wv) {
    const int* ctl = (const int*)(a.ws + WS_CTL);
    GroupedOrder S{ctl + CW_TEXP, ctl[CW_NT], 4, (int)gridDim.x, (int)blockIdx.x, (const char*)(a.ws + WS_HID), (size_t)256 * 512 * 2, (const char*)(a.ws + WS_W2T), (size_t)1024 * 512 * 2, (size_t)256 * 512 * 2};
    EpiStoreBf16 E{(bf16*)(a.ws + WS_XS), 1024}; pg8::Gemm g{512};
    pg8::gemm_phase<EpiStoreBf16, GroupedOrder, true, true>((PG8_LAS unsigned char*)lds, g, S, E, wv);
}

__device__ __forceinline__ void load64bf(const bf16* p, float (&v)[64]) {
#pragma unroll
    for (int i = 0; i < 8; ++i) { const v4u w = *(const v4u*)(p + 8 * i);
        v[8 * i + 0] = bflo(w.x); v[8 * i + 1] = bfhi(w.x); v[8 * i + 2] = bflo(w.y); v[8 * i + 3] = bfhi(w.y);
        v[8 * i + 4] = bflo(w.z); v[8 * i + 5] = bfhi(w.z); v[8 * i + 6] = bflo(w.w); v[8 * i + 7] = bfhi(w.w); }
}
__device__ __forceinline__ void store64bf(bf16* p, const float (&v)[64], float sc) {
#pragma unroll
    for (int i = 0; i < 8; ++i) { v4u w; w.x = pk2(v[8 * i] * sc, v[8 * i + 1] * sc); w.y = pk2(v[8 * i + 2] * sc, v[8 * i + 3] * sc); w.z = pk2(v[8 * i + 4] * sc, v[8 * i + 5] * sc); w.w = pk2(v[8 * i + 6] * sc, v[8 * i + 7] * sc);
        *(v4u*)(p + 8 * i) = w; }
}
__device__ __forceinline__ void norm_rope(float (&v)[64], const float* g, const float* cosT, const float* sinT, int s) {
    float ss = 0.f;
#pragma unroll
    for (int d = 0; d < 64; ++d) ss += v[d] * v[d];
    const float rstd = rsqrtf(ss * (1.0f / 64.0f) + 1e-6f);
#pragma unroll
    for (int d = 0; d < 64; ++d) v[d] = v[d] * rstd * g[d];
#pragma unroll
    for (int i = 0; i < 32; ++i) { const float c = cosT[s * 32 + i], sn = sinT[s * 32 + i]; const float x1 = v[i], x2 = v[i + 32]; v[i] = x1 * c - x2 * sn; v[i + 32] = x2 * c + x1 * sn; }
}
__device__ __forceinline__ void p_kprep(const PArgs& a, unsigned char* lds, int wv) {
    float* tile = (float*)lds + (mktid(wv) >> 8) * (256 * 65); float* red = (float*)lds + 2 * 256 * 65;
    const int tid = mktid(wv), half = tid >> 8, t256 = tid & 255;
    const bf16* z = (const bf16*)(a.ws + WS_Z);
    for (int base = blockIdx.x * 2; base < 1024; base += gridDim.x * 2) {
        const int blk = base + half; const bool ok = blk < 1024; const int h = blk & 7, n = (blk >> 3) & 7, b = (blk >> 6) & 15;
        const int s = n * 256 + t256; const size_t t = (size_t)b * SEQ + s;
        float v[64]; load64bf(z + t * INC + ZA + 512 + h * 64, v);
        norm_rope(v, a.in[19], (const float*)(a.ws + WS_COS), (const float*)(a.ws + WS_SIN), s);
        if (ok) store64bf((bf16*)(a.ws + WS_K) + t * 512 + h * 64, v, 1.0f);
#pragma unroll
        for (int d = 0; d < 64; ++d) tile[t256 * 65 + d] = v[d];
        __syncthreads();
        { const int d = t256 & 63, part = t256 >> 6; float sm = 0.f;
#pragma unroll 8
            for (int r = 0; r < 64; ++r) sm += tile[(part * 64 + r) * 65 + d];
            red[(half * 4 + part) * 64 + d] = sm; }
        __syncthreads();
        if (t256 < 64 && ok) { const float* r = red + half * 256; ((float*)(a.ws + WS_KMEAN))[(size_t)((b * 8 + h) * 8 + n) * 64 + t256] = ((r[t256] + r[64 + t256]) + (r[128 + t256] + r[192 + t256])) * (1.0f / 256.0f); }
        __syncthreads();
    }
}
__device__ __forceinline__ void p_qprep(const PArgs& a, unsigned char* lds, int wv) {
    const int tid = mktid(wv), half = tid >> 8, t256 = tid & 255;
    const bf16* z = (const bf16*)(a.ws + WS_Z);
    for (int base = blockIdx.x * 2; base < 1024; base += gridDim.x * 2) {
        const int blk = base + half; if (blk >= 1024) continue;
        const int h = blk & 7, n = (blk >> 3) & 7, b = blk >> 6;
        const int s = n * 256 + t256; const size_t t = (size_t)b * SEQ + s;
        float v[64]; load64bf(z + t * INC + ZA + h * 64, v);
        norm_rope(v, a.in[18], (const float*)(a.ws + WS_COS), (const float*)(a.ws + WS_SIN), s);
        const float* km = (const float*)(a.ws + WS_KMEAN) + (size_t)((b * 8 + h) * 8) * 64;
        float gate[7];
#pragma unroll
        for (int j = 0; j < 7; ++j) { float g = 0.f; if (j < n) {
#pragma unroll
                for (int d = 0; d < 64; ++d) g += v[d] * km[j * 64 + d]; }
            gate[j] = g; }
        unsigned sel = 0;
        if (n <= 3) sel = (1u << n) - 1u;
        else {
#pragma unroll
            for (int rep = 0; rep < 3; ++rep) { float best = -INFINITY; int bi = 0;
#pragma unroll
                for (int j = 0; j < 7; ++j) if (j < n && !((sel >> j) & 1u) && gate[j] > best) { best = gate[j]; bi = j; }
                sel |= 1u << bi; }
        }
        ((unsigned char*)(a.ws + WS_SEL))[(size_t)(b * 8 + h) * SEQ + s] = (unsigned char)sel;
        store64bf((bf16*)(a.ws + WS_Q) + t * 512 + h * 64, v, C2);
    }
}

__device__ __forceinline__ void p_attn(const PArgs& a, unsigned char* lds, int vb, int nvb, int wv) {
    const attn_body::bf16* Q = (const attn_body::bf16*)(a.ws + WS_Q); const attn_body::bf16* K = (const attn_body::bf16*)(a.ws + WS_K);
    const attn_body::bf16* V = (const attn_body::bf16*)(a.ws + WS_Z) + (ZA + 1024); attn_body::bf16* O = (attn_body::bf16*)(a.ws + WS_YB);
    const unsigned char* SEL = (const unsigned char*)(a.ws + WS_SEL);
    for (int p = vb; p < 512; p += nvb)
        for (int which = 0; which < 2; ++which) { const int bh = p >> 2, s = p & 3, qb = which ? 7 - s : s;
            attn_body::attn_unit<8>(bh >> 3, bh & 7, qb, Q, K, V, O, SEL, (char*)lds, wv); }
}

namespace rw {
typedef short bf16x8 __attribute__((ext_vector_type(8)));
constexpr int RS = 72, RSB = RS * 2, MB = 64 * RSB;
constexpr int FS = 68;
enum { I_AT = 0, I_BT, I_AJ, I_BHJ, I_KHJ, I_X5, I_ABRT, I_L, I_LT, I_R0, I_R1, I_KT, I_RT, I_VJ, I_X14, I_GATE, I_VT, NBUF };
constexpr int OFF_F32 = NBUF * MB;
constexpr int OFF_CST = OFF_F32 + (64 * 3 + 512) * 4;
constexpr int LDS_NEED = OFF_CST + 14 * 64 * 4;

__device__ __forceinline__ bf16x8 ldfrag(const unsigned char* M, int row, int k) { return *(const bf16x8*)(M + row * RSB + k * 2); }
__device__ __forceinline__ void mm(f32x4 (&acc)[2], const unsigned char* X, const unsigned char* Y, int mt, int nh, int fr, int fq) {
    const bf16x8 a0 = ldfrag(X, 16 * mt + fr, 8 * fq), a1 = ldfrag(X, 16 * mt + fr, 8 * fq + 32);
#pragma unroll
    for (int nt = 0; nt < 2; ++nt) { const bf16x8 b0 = ldfrag(Y, 16 * (2 * nh + nt) + fr, 8 * fq), b1 = ldfrag(Y, 16 * (2 * nh + nt) + fr, 8 * fq + 32);
        acc[nt] = __builtin_amdgcn_mfma_f32_16x16x32_bf16(a0, b0, acc[nt], 0, 0, 0); acc[nt] = __builtin_amdgcn_mfma_f32_16x16x32_bf16(a1, b1, acc[nt], 0, 0, 0); }
}
__device__ __forceinline__ void storeT(unsigned char* Z, const f32x4 (&acc)[2], int mt, int nh, int fr, int fq) {
#pragma unroll
    for (int nt = 0; nt < 2; ++nt) { v2u w; w.x = pk2(acc[nt][0], acc[nt][1]); w.y = pk2(acc[nt][2], acc[nt][3]); *(v2u*)(Z + (16 * (2 * nh + nt) + fr) * RSB + (16 * mt + 4 * fq) * 2) = w; }
}
__device__ __forceinline__ void storeN(unsigned char* Z, const f32x4 (&acc)[2], int mt, int nh, int fr, int fq) {
#pragma unroll
    for (int nt = 0; nt < 2; ++nt)
#pragma unroll
        for (int r = 0; r < 4; ++r) *(unsigned short*)(Z + (16 * mt + 4 * fq + r) * RSB + (16 * (2 * nh + nt) + fr) * 2) = (unsigned short)f2bf(acc[nt][r]);
}
__device__ __forceinline__ void ld8bf(const unsigned char* p, float (&v)[8]) { const v4u w = *(const v4u*)p; v[0] = bflo(w.x); v[1] = bfhi(w.x); v[2] = bflo(w.y); v[3] = bfhi(w.y); v[4] = bflo(w.z); v[5] = bfhi(w.z); v[6] = bflo(w.w); v[7] = bfhi(w.w); }
__device__ __forceinline__ void st8bf(unsigned char* p, const float (&v)[8]) { v4u w; w.x = pk2(v[0], v[1]); w.y = pk2(v[2], v[3]); w.z = pk2(v[4], v[5]); w.w = pk2(v[6], v[7]); *(v4u*)p = w; }
__device__ __forceinline__ void ld8f(const float* p, float (&v)[8]) { const f32x4 a = *(const f32x4*)p, b = *(const f32x4*)(p + 4); v[0] = a.x; v[1] = a.y; v[2] = a.z; v[3] = a.w; v[4] = b.x; v[5] = b.y; v[6] = b.z; v[7] = b.w; }
__device__ __forceinline__ void un8(const v4u w, float (&v)[8]) { v[0] = bflo(w.x); v[1] = bfhi(w.x); v[2] = bflo(w.y); v[3] = bfhi(w.y); v[4] = bflo(w.z); v[5] = bfhi(w.z); v[6] = bflo(w.w); v[7] = bfhi(w.w); }
__device__ __forceinline__ void shift8(const v4u cw, const v4u pw, bool hasp, const float* mu, float (&v)[8]) {
    float c[8], p[8], m[8]; un8(cw, c); un8(pw, p); ld8f(mu, m);
#pragma unroll
    for (int e = 0; e < 8; ++e) { const float pe = hasp ? p[e] : 0.f; v[e] = c[e] + (pe - c[e]) * m[e]; }
}
__device__ __forceinline__ float tanh_fast(float x) { return 1.0f - 2.0f * __builtin_amdgcn_rcpf(1.0f + __expf(2.0f * x)); }

__device__ __forceinline__ void scan_unit(const PArgs& a, unsigned char* lds, int bh, int wv) {
    const int tid = mktid(wv), lane = tid & 63, wid = __builtin_amdgcn_readfirstlane(tid >> 6);
    const int mt = wid >> 1, nh = wid & 1, fr = lane & 15, fq = lane >> 4;
    const int b = bh >> 3, h = bh & 7;
#define BUF(i) (lds + (i) * MB)
    float* GC = (float*)(lds + OFF_F32); float* BON = GC + 64; float* LEND = BON + 64; float* SEGT = LEND + 64;
    float* LWR = (float*)BUF(I_AT); float* LAR = (float*)BUF(I_AJ); float* LGR = (float*)BUF(I_L); float* LW = (float*)BUF(I_R0); float* YTF = (float*)BUF(I_L);
    unsigned char* ACTW = BUF(I_L); unsigned char* ACTA = BUF(I_LT); unsigned char* ACTG = BUF(I_R0);
    const bf16* z = (const bf16*)(a.ws + WS_Z); bf16* ya = (bf16*)(a.ws + WS_YA);
    const float* mu = a.in[7];
    bf16x8 fw[2], fa[2], fg[4];
    { const bf16* wlt = (const bf16*)(a.ws + WS_WLT) + (size_t)h * 4096 + (16 * mt + fr) * 64 + 8 * fq; const bf16* wat = (const bf16*)(a.ws + WS_WAT) + (size_t)h * 4096 + (16 * mt + fr) * 64 + 8 * fq;
      const bf16* wgt = (const bf16*)(a.ws + WS_WGT) + (size_t)h * 8192 + (16 * mt + fr) * 128 + 8 * fq;
      fw[0] = *(const bf16x8*)wlt; fw[1] = *(const bf16x8*)(wlt + 32); fa[0] = *(const bf16x8*)wat; fa[1] = *(const bf16x8*)(wat + 32);
#pragma unroll
      for (int ks = 0; ks < 4; ++ks) fg[ks] = *(const bf16x8*)(wgt + 32 * ks); }
    float* CST = (float*)(lds + OFF_CST);
    for (int i = tid; i < 14 * 64; i += 512) { const int blk = i >> 6, jj = i & 63; float v;
        if (blk < 3) v = mu[blk * 512 + h * 64 + jj]; else if (blk < 7) v = mu[1536 + (blk - 3) * 64 + jj]; else v = a.in[blk == 7 ? 8 : blk == 8 ? 10 : blk == 9 ? 13 : blk == 10 ? 14 : blk == 11 ? 15 : blk == 12 ? 16 : 17][h * 64 + jj];
        CST[i] = v; }
    int s0i = I_X14, aki = I_X5;
    for (int i = tid; i < MB / 4; i += 512) ((unsigned*)BUF(I_X14))[i] = 0u;
    __syncthreads();
    const int pt = tid >> 3, pg = tid & 7, j0 = 8 * pg;
    const int colh = h * 64 + j0;
    const int zoff0 = colh, zoff1 = 512 + colh, zoff2 = 1024 + colh, zoff3 = 1536 + j0, zoff4 = 1600 + j0, zoff5 = 1664 + j0, zoff6 = 1728 + j0;
    v4u zc[7], zq[7];
#define ZLOAD(cc) do { const bf16* zr_ = z + ((size_t)b * SEQ + (cc) * 64 + pt) * INC; const bf16* zs_ = ((cc) * 64 + pt) > 0 ? zr_ - INC : zr_; \
        zc[0] = *(const v4u*)(zr_ + zoff0); zc[1] = *(const v4u*)(zr_ + zoff1); zc[2] = *(const v4u*)(zr_ + zoff2); zc[3] = *(const v4u*)(zr_ + zoff3); zc[4] = *(const v4u*)(zr_ + zoff4); zc[5] = *(const v4u*)(zr_ + zoff5); zc[6] = *(const v4u*)(zr_ + zoff6); \
        zq[0] = *(const v4u*)(zs_ + zoff0); zq[1] = *(const v4u*)(zs_ + zoff1); zq[2] = *(const v4u*)(zs_ + zoff2); zq[3] = *(const v4u*)(zs_ + zoff3); zq[4] = *(const v4u*)(zs_ + zoff4); zq[5] = *(const v4u*)(zs_ + zoff5); zq[6] = *(const v4u*)(zs_ + zoff6); } while (0)
    ZLOAD(0);
    for (int c = 0; c < SEQ / 64; ++c) {
        const int s = c * 64 + pt; const size_t t = (size_t)b * SEQ + s; const bool hasp = s > 0;
        { float v[8];
          shift8(zc[0], zq[0], hasp, CST + 0 * 64 + j0, v); st8bf(BUF(I_RT) + pt * RSB + j0 * 2, v);
          shift8(zc[1], zq[1], hasp, CST + 1 * 64 + j0, v); st8bf(BUF(I_KT) + pt * RSB + j0 * 2, v);
          shift8(zc[2], zq[2], hasp, CST + 2 * 64 + j0, v); st8bf(BUF(I_VT) + pt * RSB + j0 * 2, v);
#pragma unroll
          for (int e = 0; e < 8; ++e) *(unsigned short*)(BUF(I_VJ) + (j0 + e) * RSB + pt * 2) = (unsigned short)f2bf(v[e]);
          shift8(zc[3], zq[3], hasp, CST + 3 * 64 + j0, v);
#pragma unroll
          for (int e = 0; e < 8; ++e) v[e] = tanh_fast(v[e]);
          st8bf(ACTW + pt * RSB + j0 * 2, v);
          shift8(zc[4], zq[4], hasp, CST + 4 * 64 + j0, v); st8bf(ACTA + pt * RSB + j0 * 2, v);
          shift8(zc[5], zq[5], hasp, CST + 5 * 64 + j0, v);
#pragma unroll
          for (int e = 0; e < 8; ++e) v[e] = sigm(v[e]);
          st8bf(ACTG + pt * 272 + j0 * 2, v);
          shift8(zc[6], zq[6], hasp, CST + 6 * 64 + j0, v);
#pragma unroll
          for (int e = 0; e < 8; ++e) v[e] = sigm(v[e]);
          st8bf(ACTG + pt * 272 + (64 + j0) * 2, v); }
        __syncthreads();
        f32x4 aw[2], aa[2], ag[2];
#pragma unroll
        for (int nt = 0; nt < 2; ++nt) { const int tr = 16 * (2 * nh + nt) + fr; const f32x4 zero = {0.f, 0.f, 0.f, 0.f};
            aw[nt] = __builtin_amdgcn_mfma_f32_16x16x32_bf16(fw[0], ldfrag(ACTW, tr, 8 * fq), zero, 0, 0, 0); aw[nt] = __builtin_amdgcn_mfma_f32_16x16x32_bf16(fw[1], ldfrag(ACTW, tr, 8 * fq + 32), aw[nt], 0, 0, 0);
            aa[nt] = __builtin_amdgcn_mfma_f32_16x16x32_bf16(fa[0], ldfrag(ACTA, tr, 8 * fq), zero, 0, 0, 0); aa[nt] = __builtin_amdgcn_mfma_f32_16x16x32_bf16(fa[1], ldfrag(ACTA, tr, 8 * fq + 32), aa[nt], 0, 0, 0);
            ag[nt] = zero;
#pragma unroll
            for (int ks = 0; ks < 4; ++ks) ag[nt] = __builtin_amdgcn_mfma_f32_16x16x32_bf16(fg[ks], *(const bf16x8*)(ACTG + tr * 272 + (8 * fq + 32 * ks) * 2), ag[nt], 0, 0, 0); }
        __syncthreads();
#pragma unroll
        for (int nt = 0; nt < 2; ++nt) { const int tr = 16 * (2 * nh + nt) + fr, jc = 16 * mt + 4 * fq;
            *(f32x4*)(LWR + tr * FS + jc) = aw[nt]; *(f32x4*)(LAR + tr * FS + jc) = aa[nt]; *(f32x4*)(LGR + tr * FS + jc) = ag[nt]; }
        __syncthreads();
        float lwv[8], an[8], bb[8], k2[8], rr[8], gg[8];
        { float lw8[8], la8[8], kx[8], w0v[8], a0v[8], kkc[8], kac[8], rkc[8];
          ld8f(LWR + pt * FS + j0, lw8); ld8f(LAR + pt * FS + j0, la8); ld8f(LGR + pt * FS + j0, gg);
          ld8bf(BUF(I_RT) + pt * RSB + j0 * 2, rr); ld8bf(BUF(I_KT) + pt * RSB + j0 * 2, kx);
          ld8f(CST + 7 * 64 + j0, w0v); ld8f(CST + 8 * 64 + j0, a0v); ld8f(CST + 9 * 64 + j0, kkc); ld8f(CST + 10 * 64 + j0, kac); ld8f(CST + 11 * 64 + j0, rkc);
          float ss = 0.f, bon = 0.f, av[8];
#pragma unroll
          for (int e = 0; e < 8; ++e) { lwv[e] = -0.606531f * sigm(w0v[e] + lw8[e]); av[e] = sigm(a0v[e] + la8[e]); an[e] = kx[e] * kkc[e]; ss += an[e] * an[e];
              k2[e] = kx[e] * (1.0f + (av[e] - 1.0f) * kac[e]); bon += rr[e] * k2[e] * rkc[e]; }
          ss = red8(ss); bon = red8(bon);
          const float inv = rsqrtf(fmaxf(ss, 1e-24f));
#pragma unroll
          for (int e = 0; e < 8; ++e) { const float kn = an[e] * inv; an[e] = -kn; bb[e] = kn * av[e]; }
          *(f32x4*)(LW + pt * FS + j0) = (f32x4){lwv[0], lwv[1], lwv[2], lwv[3]}; *(f32x4*)(LW + pt * FS + j0 + 4) = (f32x4){lwv[4], lwv[5], lwv[6], lwv[7]};
          if (pg == 0) BON[pt] = bon; }
        __syncthreads();
        { const int j = tid & 63, sg = tid >> 6; float run = 0.f;
#pragma unroll
          for (int u = 0; u < 8; ++u) { run += LW[(8 * sg + u) * FS + j]; LW[(8 * sg + u) * FS + j] = run; }
          SEGT[sg * 64 + j] = run; }
        __syncthreads();
        if (tid < 64) { float run = 0.f;
#pragma unroll
            for (int sg = 0; sg < 8; ++sg) { const float tmp = SEGT[sg * 64 + tid]; SEGT[sg * 64 + tid] = run; run += tmp; }
            LEND[tid] = run; GC[tid] = __expf(run); }
        __syncthreads();
        { float Lc[8], sgp[8], le[8], o0[8], o1[8], o2[8], o3[8];
          ld8f(LW + pt * FS + j0, Lc); ld8f(SEGT + (pt >> 3) * 64 + j0, sgp); ld8f(LEND + j0, le);
#pragma unroll
          for (int e = 0; e < 8; ++e) { const float L = Lc[e] + sgp[e]; const float e1 = __expf(L), ie1 = __expf(-L), ep = __expf(L - lwv[e]), eh = __expf(le[e] - L);
              o0[e] = an[e] * ep; o1[e] = bb[e] * ie1; o2[e] = k2[e] * ie1; o3[e] = rr[e] * e1; Lc[e] = bb[e] * eh; sgp[e] = k2[e] * eh; }
          st8bf(BUF(I_AT) + pt * RSB + j0 * 2, o0); st8bf(BUF(I_BT) + pt * RSB + j0 * 2, o1); st8bf(BUF(I_KT) + pt * RSB + j0 * 2, o2); st8bf(BUF(I_RT) + pt * RSB + j0 * 2, o3);
          st8bf(BUF(I_GATE) + pt * RSB + j0 * 2, gg);
#pragma unroll
          for (int e = 0; e < 8; ++e) { *(unsigned short*)(BUF(I_AJ) + (j0 + e) * RSB + pt * 2) = (unsigned short)f2bf(o0[e]); *(unsigned short*)(BUF(I_BHJ) + (j0 + e) * RSB + pt * 2) = (unsigned short)f2bf(Lc[e]);
              *(unsigned short*)(BUF(I_KHJ) + (j0 + e) * RSB + pt * 2) = (unsigned short)f2bf(sgp[e]); } }
        if (c + 1 < SEQ / 64) ZLOAD(c + 1);
        __syncthreads();
        { const f32x4 zero = {0.f, 0.f, 0.f, 0.f}; f32x4 acc[2] = {zero, zero};
          mm(acc, BUF(I_AT), BUF(I_BT), mt, nh, fr, fq);
#pragma unroll
          for (int nt = 0; nt < 2; ++nt)
#pragma unroll
              for (int r = 0; r < 4; ++r) { const int m = 16 * mt + 4 * fq + r, n = 16 * (2 * nh + nt) + fr; if (!(m > n)) acc[nt][r] = 0.f; }
          storeN(BUF(I_L), acc, mt, nh, fr, fq); storeT(BUF(I_LT), acc, mt, nh, fr, fq);
#pragma unroll
          for (int nt = 0; nt < 2; ++nt)
#pragma unroll
              for (int r = 0; r < 4; ++r) { const int m = 16 * mt + 4 * fq + r, n = 16 * (2 * nh + nt) + fr; if (m == n) acc[nt][r] = 1.0f; }
          storeN(BUF(I_R0), acc, mt, nh, fr, fq);
          acc[0] = zero; acc[1] = zero; mm(acc, BUF(I_AT), BUF(I_KT), mt, nh, fr, fq);
#pragma unroll
          for (int nt = 0; nt < 2; ++nt)
#pragma unroll
              for (int r = 0; r < 4; ++r) { const int m = 16 * mt + 4 * fq + r, n = 16 * (2 * nh + nt) + fr; if (!(n < m)) acc[nt][r] = 0.f; }
          storeT(BUF(aki), acc, mt, nh, fr, fq);
          acc[0] = zero; acc[1] = zero; mm(acc, BUF(I_BT), BUF(I_RT), mt, nh, fr, fq);
#pragma unroll
          for (int nt = 0; nt < 2; ++nt)
#pragma unroll
              for (int r = 0; r < 4; ++r) { const int m = 16 * mt + 4 * fq + r, n = 16 * (2 * nh + nt) + fr; if (!(m <= n)) acc[nt][r] = 0.f; }
          storeT(BUF(I_ABRT), acc, mt, nh, fr, fq); }
        __syncthreads();
#pragma unroll
        for (int k = 1; k <= 6; ++k) {
            unsigned char* Pc = (k & 1) ? BUF(I_L) : BUF(I_AT); unsigned char* PTc = (k & 1) ? BUF(I_LT) : BUF(I_BT);
            unsigned char* Pn = (k & 1) ? BUF(I_AT) : BUF(I_L); unsigned char* PTn = (k & 1) ? BUF(I_BT) : BUF(I_LT);
            unsigned char* Rc = (k & 1) ? BUF(I_R1) : BUF(I_R0); unsigned char* Rn = (k & 1) ? BUF(I_R0) : BUF(I_R1);
            const f32x4 zero = {0.f, 0.f, 0.f, 0.f};
            if (k <= 5) { f32x4 acc[2] = {zero, zero}; mm(acc, Pc, PTc, mt, nh, fr, fq); storeN(Pn, acc, mt, nh, fr, fq); storeT(PTn, acc, mt, nh, fr, fq); }
            if (k >= 2) { f32x4 acc[2];
#pragma unroll
                for (int nt = 0; nt < 2; ++nt) { const v2u w = *(const v2u*)(Rc + (16 * (2 * nh + nt) + fr) * RSB + (16 * mt + 4 * fq) * 2); acc[nt] = (f32x4){bflo(w.x), bfhi(w.x), bflo(w.y), bfhi(w.y)}; }
                mm(acc, PTc, Rc, mt, nh, fr, fq); storeT(Rn, acc, mt, nh, fr, fq); }
            __syncthreads();
        }
        { const f32x4 zero = {0.f, 0.f, 0.f, 0.f}; f32x4 acc[2] = {zero, zero};
          mm(acc, BUF(I_R1), BUF(I_AJ), mt, nh, fr, fq); storeT(BUF(I_L), acc, mt, nh, fr, fq);
          acc[0] = zero; acc[1] = zero; mm(acc, BUF(I_R1), BUF(aki), mt, nh, fr, fq); storeT(BUF(I_LT), acc, mt, nh, fr, fq); }
        __syncthreads();
        { const f32x4 zero = {0.f, 0.f, 0.f, 0.f}; f32x4 acc[2];
#pragma unroll
          for (int nt = 0; nt < 2; ++nt) { const v2u w = *(const v2u*)(BUF(I_RT) + (16 * (2 * nh + nt) + fr) * RSB + (16 * mt + 4 * fq) * 2); acc[nt] = (f32x4){bflo(w.x), bfhi(w.x), bflo(w.y), bfhi(w.y)}; }
          mm(acc, BUF(I_L), BUF(I_ABRT), mt, nh, fr, fq); storeT(BUF(I_AT), acc, mt, nh, fr, fq);
          acc[0] = zero; acc[1] = zero; mm(acc, BUF(I_KT), BUF(I_RT), mt, nh, fr, fq);
#pragma unroll
          for (int nt = 0; nt < 2; ++nt)
#pragma unroll
              for (int r = 0; r < 4; ++r) { const int m = 16 * mt + 4 * fq + r, n = 16 * (2 * nh + nt) + fr; if (!(m <= n)) acc[nt][r] = 0.f; }
          mm(acc, BUF(I_LT), BUF(I_ABRT), mt, nh, fr, fq); storeT(BUF(I_BT), acc, mt, nh, fr, fq);
          acc[0] = zero; acc[1] = zero; mm(acc, BUF(I_L), BUF(I_BHJ), mt, nh, fr, fq);
#pragma unroll
          for (int nt = 0; nt < 2; ++nt)
#pragma unroll
              for (int r = 0; r < 4; ++r) { const int m = 16 * mt + 4 * fq + r, n = 16 * (2 * nh + nt) + fr; if (m == n) acc[nt][r] += GC[m]; }
          storeT(BUF(I_AJ), acc, mt, nh, fr, fq);
#pragma unroll
          for (int nt = 0; nt < 2; ++nt) { const v2u w = *(const v2u*)(BUF(I_KHJ) + (16 * (2 * nh + nt) + fr) * RSB + (16 * mt + 4 * fq) * 2); acc[nt] = (f32x4){bflo(w.x), bfhi(w.x), bflo(w.y), bfhi(w.y)}; }
          mm(acc, BUF(I_LT), BUF(I_BHJ), mt, nh, fr, fq); storeT(BUF(I_R0), acc, mt, nh, fr, fq); }
        __syncthreads();
        { const f32x4 zero = {0.f, 0.f, 0.f, 0.f}; f32x4 acc[2] = {zero, zero};
          mm(acc, BUF(s0i), BUF(I_AT), mt, nh, fr, fq); mm(acc, BUF(I_VJ), BUF(I_BT), mt, nh, fr, fq);
#pragma unroll
          for (int nt = 0; nt < 2; ++nt) *(f32x4*)(YTF + (16 * (2 * nh + nt) + fr) * FS + 16 * mt + 4 * fq) = acc[nt];
          acc[0] = zero; acc[1] = zero; mm(acc, BUF(I_AJ), BUF(s0i), mt, nh, fr, fq); mm(acc, BUF(I_R0), BUF(I_VJ), mt, nh, fr, fq);
          storeT(BUF(aki), acc, mt, nh, fr, fq); }
        __syncthreads();
        { float y[8], vv[8], g8[8], lg[8], lb[8]; ld8f(YTF + pt * FS + j0, y); ld8bf(BUF(I_VT) + pt * RSB + j0 * 2, vv); ld8bf(BUF(I_GATE) + pt * RSB + j0 * 2, g8);
          ld8f(CST + 12 * 64 + j0, lg); ld8f(CST + 13 * 64 + j0, lb);
          float sm = 0.f;
#pragma unroll
          for (int e = 0; e < 8; ++e) sm += y[e];
          const float mean = red8(sm) * (1.0f / 64.0f); float sq = 0.f;
#pragma unroll
          for (int e = 0; e < 8; ++e) { y[e] -= mean; sq += y[e] * y[e]; }
          const float rstd = rsqrtf(red8(sq) * (1.0f / 64.0f) + 64e-5f), bon = BON[pt];
#pragma unroll
          for (int e = 0; e < 8; ++e) y[e] = (y[e] * rstd * lg[e] + lb[e] + bon * vv[e]) * g8[e];
          st8bf((unsigned char*)(ya + t * RWW + colh), y); }
        { const int tmp = s0i; s0i = aki; aki = tmp; }
        __syncthreads();
    }
#undef BUF
#undef ZLOAD
}
}

__device__ __forceinline__ void p_norm2_route(const PArgs& a, unsigned char* lds, int wv) {
    typedef short bf16x8 __attribute__((ext_vector_type(8)));
    const int tid = mktid(wv), lane = tid & 63, fr = lane & 15, fq = lane >> 4;
    const float* x1 = a.out; const float* g = a.in[5]; const float* mod = (const float*)(a.ws + WS_MOD);
    const bf16* wrh = (const bf16*)(a.ws + WS_WRH); const bf16* wrl = (const bf16*)(a.ws + WS_WRL); const float* brg = a.in[24]; const float* bre = a.in[26];
    bf16* h2 = (bf16*)(a.ws + WS_H2);
    int* rte = (int*)(a.ws + WS_RTE); float* rtw = (float*)(a.ws + WS_RTW); int* rnk = (int*)(a.ws + WS_RNK); unsigned* cnt = (unsigned*)(a.ws + WS_CTL) + CW_CNT;
    float* LG = (float*)lds + wv * (16 * 48);
    for (int grp = blockIdx.x * 8 + wv; grp < NT / 16; grp += gridDim.x * 8) {
        const int row = grp * 16 + fr, b = row >> 11;
        const float* xr = x1 + (size_t)row * DM + 8 * fq; const float* gp = g + 8 * fq; const float* scp = mod + b * 6144 + 4096 + 8 * fq; const float* shp = mod + b * 6144 + 3072 + 8 * fq;
        float ss = 0.f;
#pragma unroll 8
        for (int ks = 0; ks < 32; ++ks) { const f32x4 v0 = *(const f32x4*)(xr + 32 * ks), v1 = *(const f32x4*)(xr + 32 * ks + 4);
            ss += (v0.x * v0.x + v0.y * v0.y) + (v0.z * v0.z + v0.w * v0.w) + (v1.x * v1.x + v1.y * v1.y) + (v1.z * v1.z + v1.w * v1.w); }
        ss += __builtin_bit_cast(float, __builtin_amdgcn_ds_swizzle(__builtin_bit_cast(int, ss), 0x401F));
        { const unsigned u = __builtin_bit_cast(unsigned, ss); auto rr = __builtin_amdgcn_permlane32_swap(u, u, false, false); ss = __builtin_bit_cast(float, (unsigned)rr[0]) + __builtin_bit_cast(float, (unsigned)rr[1]); }
        const float rstd = rsqrtf(ss * (1.0f / DM) + 1e-6f);
        f32x4 acc[3]; acc[0] = (f32x4){0.f, 0.f, 0.f, 0.f}; acc[1] = acc[0]; acc[2] = acc[0];
        bf16* hrow = h2 + (size_t)row * DM + 8 * fq; const bf16* wh = wrh + fr * 1024 + 8 * fq; const bf16* wl = wrl + fr * 1024 + 8 * fq;
#pragma unroll 2
        for (int ks = 0; ks < 32; ++ks) {
            float v[8], gg[8], sc[8], sh[8]; rw::ld8f(xr + 32 * ks, v); rw::ld8f(gp + 32 * ks, gg); rw::ld8f(scp + 32 * ks, sc); rw::ld8f(shp + 32 * ks, sh);
            unsigned hw[4], lw[4];
#pragma unroll
            for (int e = 0; e < 4; ++e) { const float h0 = v[2 * e] * rstd * gg[2 * e] * (sc[2 * e] + 1.0f) + sh[2 * e], h1 = v[2 * e + 1] * rstd * gg[2 * e + 1] * (sc[2 * e + 1] + 1.0f) + sh[2 * e + 1];
                hw[e] = pk2(h0, h1); lw[e] = pk2(h0 - bflo(hw[e]), h1 - bfhi(hw[e])); }
            const v4u hv = {hw[0], hw[1], hw[2], hw[3]}, lv = {lw[0], lw[1], lw[2], lw[3]};
            *(v4u*)(hrow + 32 * ks) = hv;
            const bf16x8 ah = __builtin_bit_cast(bf16x8, hv), al = __builtin_bit_cast(bf16x8, lv);
#pragma unroll
            for (int nt = 0; nt < 3; ++nt) { const bf16x8 bh = *(const bf16x8*)(wh + nt * 16 * 1024 + 32 * ks), bl = *(const bf16x8*)(wl + nt * 16 * 1024 + 32 * ks);
                acc[nt] = __builtin_amdgcn_mfma_f32_16x16x32_bf16(ah, bh, acc[nt], 0, 0, 0); acc[nt] = __builtin_amdgcn_mfma_f32_16x16x32_bf16(ah, bl, acc[nt], 0, 0, 0); acc[nt] = __builtin_amdgcn_mfma_f32_16x16x32_bf16(al, bh, acc[nt], 0, 0, 0); }
        }
#pragma unroll
        for (int nt = 0; nt < 3; ++nt)
#pragma unroll
            for (int r = 0; r < 4; ++r) LG[(4 * fq + r) * 48 + 16 * nt + fr] = acc[nt][r];
        asm volatile("s_waitcnt lgkmcnt(0)" ::: "memory");
        if (lane < 16) { const int m = grp * 16 + lane; const float* lg = LG + lane * 48;
            float gl4[4];
#pragma unroll
            for (int i = 0; i < 4; ++i) gl4[i] = lg[i] + brg[i];
            int gi = 0; float gm = gl4[0];
#pragma unroll
            for (int i = 1; i < 4; ++i) if (gl4[i] > gm) { gm = gl4[i]; gi = i; }
            float gs = 0.f;
#pragma unroll
            for (int i = 0; i < 4; ++i) gs += __expf(gl4[i] - gm);
            const float pg = 1.0f / gs;
            float el[8];
#pragma unroll
            for (int k = 0; k < 8; ++k) el[k] = lg[4 + gi * 8 + k] + bre[gi * 8 + k];
            int e1 = 0; float m1 = el[0];
#pragma unroll
            for (int k = 1; k < 8; ++k) if (el[k] > m1) { m1 = el[k]; e1 = k; }
            int e2 = -1; float m2 = -INFINITY;
#pragma unroll
            for (int k = 0; k < 8; ++k) if (k != e1 && el[k] > m2) { m2 = el[k]; e2 = k; }
            const float q2 = __expf(m2 - m1); const float w1 = pg / (1.0f + q2), w2 = pg * q2 / (1.0f + q2);
            const int ea = gi * 8 + e1, eb = gi * 8 + e2; rte[2 * m] = ea; rte[2 * m + 1] = eb; rtw[2 * m] = w1; rtw[2 * m + 1] = w2;
            rnk[2 * m] = (int)atomicAdd(cnt + ea, 1u); rnk[2 * m + 1] = (int)atomicAdd(cnt + eb, 1u); }
        asm volatile("s_waitcnt lgkmcnt(0)" ::: "memory");
    }
}
__device__ __forceinline__ void p_moe_gather(const PArgs& a, unsigned char* lds, int wv) {
    int* off = (int*)lds;
    const int tid = mktid(wv), lane = tid & 63, gw = blockIdx.x * 8 + (tid >> 6), NGW = gridDim.x * 8;
    int* ctl = (int*)(a.ws + WS_CTL); const unsigned* cnt = (const unsigned*)ctl + CW_CNT;
    if (tid == 0) { int o = 0, nt = 0;
        for (int e = 0; e < NEXP; ++e) { off[e] = o; const int tiles = ((int)cnt[e] + 255) >> 8;
            if (blockIdx.x == 0) for (int i = 0; i < tiles; ++i) ctl[CW_TEXP + nt + i] = e;
            nt += tiles; o += tiles * 256; }
        if (blockIdx.x == 0) ctl[CW_NT] = nt; }
    __syncthreads();
    const int* rte = (const int*)(a.ws + WS_RTE); const int* rnk = (const int*)(a.ws + WS_RNK); int* pos = (int*)(a.ws + WS_POS);
    const bf16* h2 = (const bf16*)(a.ws + WS_H2); bf16* xs = (bf16*)(a.ws + WS_XS);
    for (int i = gw; i < 2 * NT; i += NGW) { const int p = off[rte[i]] + rnk[i]; if (lane == 0) pos[i] = p;
        const v4u* src = (const v4u*)(h2 + (size_t)(i >> 1) * DM) + lane; v4u* dst = (v4u*)(xs + (size_t)p * DM) + lane;
        dst[0] = src[0]; dst[64] = src[64]; }
}
__device__ __forceinline__ void p_combine(const PArgs& a, unsigned char* lds, int wv) {
    const int tid = mktid(wv), lane = tid & 63, gw = blockIdx.x * 8 + (tid >> 6), NGW = gridDim.x * 8;
    const float* mod = (const float*)(a.ws + WS_MOD); const int* pos = (const int*)(a.ws + WS_POS); const float* rtw = (const float*)(a.ws + WS_RTW);
    const bf16* ys = (const bf16*)(a.ws + WS_XS); float* out = a.out;
    for (int m = gw; m < NT; m += NGW) { const int b = m >> 11; const int p0 = pos[2 * m], p1 = pos[2 * m + 1]; const float w0 = rtw[2 * m], w1 = rtw[2 * m + 1];
        f32x4* o = (f32x4*)(out + (size_t)m * DM) + lane; const v2u* y0 = (const v2u*)(ys + (size_t)p0 * DM) + lane; const v2u* y1 = (const v2u*)(ys + (size_t)p1 * DM) + lane;
#pragma unroll
        for (int j = 0; j < 4; ++j) { const int col = 4 * (lane + 64 * j); const f32x4 g2 = *(const f32x4*)(mod + b * 6144 + 5120 + col); const v2u a0 = y0[64 * j], a1 = y1[64 * j];
            const f32x4 e0 = {bflo(a0.x), bfhi(a0.x), bflo(a0.y), bfhi(a0.y)}, e1 = {bflo(a1.x), bfhi(a1.x), bflo(a1.y), bfhi(a1.y)};
            o[64 * j] = o[64 * j] + g2 * (e0 * w0 + e1 * w1); } }
}

#define XB_TMO      128
#define XB_XCNT(j)  (256  + 64 * (j))
#define XB_XSUB(j)  (1280 + 64 * (j))
#define XB_XGEN(j)  (2304 + 64 * (j))
#define XB_TOP      3328
#define XB_TOPGEN   3392
#define XCD_BAR_WORDS 3456
#define XB_SPIN_CAP (1u << 22)

__device__ __forceinline__ unsigned xb_ld(unsigned* p)              { return __hip_atomic_load(p, __ATOMIC_RELAXED, __HIP_MEMORY_SCOPE_AGENT); }
__device__ __forceinline__ unsigned xb_add(unsigned* p, unsigned v) { return __hip_atomic_fetch_add(p, v, __ATOMIC_RELAXED, __HIP_MEMORY_SCOPE_AGENT); }
__device__ __forceinline__ unsigned xb_xcc_id() { return (unsigned)__builtin_amdgcn_s_getreg((3 << 11) | 20) & 0xFu; }
#define XB_SPIN(cond, bar) do { unsigned _sp = 0; while (cond) { __builtin_amdgcn_s_sleep(1); \
    if ((++_sp & 255u) == 0u) { if (xb_ld(&(bar)[XB_TMO])) break; if (_sp > XB_SPIN_CAP) { atomicAdd(&(bar)[XB_TMO], 1u); break; } } } } while (0)

struct XcdBarrier {
    unsigned* bar; unsigned x;
    volatile LAS unsigned* st;
};

__device__ __forceinline__ XcdBarrier xcd_barrier_post(unsigned* bar, volatile LAS unsigned* st, int wv) {
    XcdBarrier b; b.bar = bar; b.x = xb_xcc_id(); b.st = st;
    if (mktid(wv) == 0) (void)xb_add(&bar[XB_XCNT(b.x)], 1u);
    return b;
}
__device__ __forceinline__ void xcd_barrier_complete(unsigned* bar, unsigned x, unsigned& nloc, unsigned& nx) {
    const unsigned G = gridDim.x * gridDim.y * gridDim.z;
    unsigned sum, cnt, mine, sp = 0u;
    for (;;) {
        sum = 0u; cnt = 0u; mine = 0u;
#pragma unroll
        for (unsigned j = 0; j < 16; ++j) { const unsigned c = xb_ld(&bar[XB_XCNT(j)]); sum += c; cnt += (c > 0u) ? 1u : 0u; mine = (j == x) ? c : mine; }
        if (sum == G) break;
        __builtin_amdgcn_s_sleep(1);
        if ((++sp & 255u) == 0u) { if (xb_ld(&bar[XB_TMO])) break; if (sp > XB_SPIN_CAP) { atomicAdd(&bar[XB_TMO], 1u); break; } }
    }
    nloc = mine > 0u ? mine : 1u; nx = cnt > 0u ? cnt : 1u;
}

__device__ __forceinline__ void xcd_barrier(const XcdBarrier& b, int wv) {
    asm volatile("s_waitcnt vmcnt(0)" ::: "memory");
    __syncthreads();
    if (mktid(wv) == 0) {
        unsigned* bar = b.bar;
        __builtin_amdgcn_s_waitcnt(0);
        unsigned nloc = b.st[0], nx = b.st[1];
        if (nloc == 0u) { xcd_barrier_complete(bar, b.x, nloc, nx); b.st[0] = nloc; b.st[1] = nx; }
        const unsigned old = xb_add(&bar[XB_XSUB(b.x)], 1u);
        const unsigned gen = old / nloc;
        if (old + 1u == (gen + 1u) * nloc) {
            __builtin_amdgcn_fence(__ATOMIC_RELEASE, "agent");
            asm volatile("s_waitcnt vmcnt(0)" ::: "memory");
            const unsigned og = xb_add(&bar[XB_TOP], 1u);
            const unsigned tg = og / nx;
            if (og + 1u == (tg + 1u) * nx) xb_add(&bar[XB_TOPGEN], 1u);
            else XB_SPIN(xb_ld(&bar[XB_TOPGEN]) == tg, bar);
            __builtin_amdgcn_fence(__ATOMIC_ACQUIRE, "agent");
            xb_add(&bar[XB_XGEN(b.x)], 1u);
            asm volatile("s_waitcnt vmcnt(0)" ::: "memory");
        } else {
            XB_SPIN(xb_ld(&bar[XB_XGEN(b.x)]) == gen, bar);
            __builtin_amdgcn_fence(__ATOMIC_ACQUIRE, "agent");
            asm volatile("s_waitcnt vmcnt(0)" ::: "memory");
        }
    }
    __syncthreads();
}

constexpr int LDS_BYTES = 160 * 1024, MISC_OFF = LDS_BYTES - 256;
static_assert(rw::LDS_NEED <= MISC_OFF, "scan LDS");
constexpr int CW_BAR = 4096;

__global__ void __launch_bounds__(512, 2) mega_fwd(PArgs a) {
    extern __shared__ __attribute__((aligned(16))) unsigned char lds[];
    volatile LAS unsigned* MISC = (volatile LAS unsigned*)((LAS unsigned char*)lds + MISC_OFF);
    const int wv = __builtin_amdgcn_readfirstlane((int)threadIdx.x >> 6);
    { const int t0 = mktid(wv); if (t0 < 64) MISC[t0] = 0u; }
    __syncthreads();
    XcdBarrier bar = xcd_barrier_post((unsigned*)(a.ws + WS_CTL) + CW_BAR, MISC + 8, wv);
    GemmArgs g; g.ws = a.ws; g.x = a.in[0]; g.out = a.out;
    const int G = (int)gridDim.x, bx = (int)blockIdx.x;

    p_prep_weights(a, lds, wv); __syncthreads(); p_ada(a, lds, wv);
    xcd_barrier(bar, wv);
    p_norm1(a, lds, wv);
    xcd_barrier(bar, wv);
    p_gemm_in(g, lds, wv);
    xcd_barrier(bar, wv);
    p_kprep(a, lds, wv);
    xcd_barrier(bar, wv);
    p_qprep(a, lds, wv);
    xcd_barrier(bar, wv);
    { const int nscan = G / 2;
      if (bx < nscan) { for (int bh = bx; bh < 128; bh += nscan) rw::scan_unit(a, lds, bh, wv); }
      else p_attn(a, lds, bx - nscan, G - nscan, wv); }
    xcd_barrier(bar, wv);
    p_gemm_bra(g, lds, wv);
    xcd_barrier(bar, wv);
    p_gemm_brb(g, lds, wv);
    xcd_barrier(bar, wv);
    p_gemm_out(g, lds, wv); __syncthreads(); p_prep_experts(a, lds, wv);
    xcd_barrier(bar, wv);
    p_norm2_route(a, lds, wv);
    xcd_barrier(bar, wv);
    p_moe_gather(a, lds, wv);
    xcd_barrier(bar, wv);
    p_gemm_up(g, lds, wv);
    xcd_barrier(bar, wv);
    p_gemm_down(g, lds, wv);
    xcd_barrier(bar, wv);
    p_combine(a, lds, wv);
}

extern "C" void kernel_launch(void* const* d_in, const int* in_sizes, int n_in, void* d_out, int out_size, void* d_ws, size_t ws_size, hipStream_t stream) {
    static int grid = 0;
    if (grid == 0) {
        if (n_in != 30 || out_size != NT * DM || ws_size < WS_END) { fprintf(stderr, "kernel_launch: unexpected shapes (n_in %d, out %d, ws %zu)\n", n_in, out_size, ws_size); grid = -1; return; }
        int dev = 0, cus = 0, per_cu = 0;
        if (hipGetDevice(&dev) != hipSuccess || hipDeviceGetAttribute(&cus, hipDeviceAttributeMultiprocessorCount, dev) != hipSuccess) { grid = -1; return; }
        if (hipFuncSetAttribute((const void*)mega_fwd, hipFuncAttributeMaxDynamicSharedMemorySize, LDS_BYTES) != hipSuccess) { fprintf(stderr, "kernel_launch: hipFuncSetAttribute failed\n"); grid = -1; return; }
        if (hipOccupancyMaxActiveBlocksPerMultiprocessor(&per_cu, (const void*)mega_fwd, 512, LDS_BYTES) != hipSuccess || per_cu < 1) { fprintf(stderr, "kernel_launch: occupancy query says %d blocks per CU\n", per_cu); (void)hipGetLastError(); grid = -1; return; }
        grid = cus;
    }
    if (grid < 0) return;
    (void)hipMemsetAsync((char*)d_ws + WS_CTL, 0, 65536, stream);
    PArgs p{}; for (int i = 0; i < 30; ++i) p.in[i] = (const float*)d_in[i]; p.out = (float*)d_out; p.ws = (unsigned char*)d_ws;
    hipLaunchKernelGGL(mega_fwd, dim3(grid), dim3(512), LDS_BYTES, stream, p);
}
```

```cpp
#include <hip/hip_runtime.h>
#include <cstdio>
#include <cstdint>
__device__ __forceinline__ int mktid(int wv) { int l; asm volatile("v_mbcnt_lo_u32_b32 %0, -1, 0\n\tv_mbcnt_hi_u32_b32 %0, -1, %0" : "=v"(l)); return (wv << 6) | l; }
template <int CTRL> __device__ __forceinline__ float dppf(float v) { return __builtin_bit_cast(float, __builtin_amdgcn_update_dpp(0, __builtin_bit_cast(int, v), CTRL, 0xF, 0xF, true)); }
__device__ __forceinline__ float red4(float v) { v += dppf<0xB1>(v); v += dppf<0x4E>(v); return v; }
__device__ __forceinline__ float red8(float v) { v = red4(v); v += dppf<0x141>(v); return v; }
__device__ __forceinline__ float red16(float v) { v = red8(v); v += dppf<0x140>(v); return v; }
__device__ __forceinline__ float wave_sum(float v) { v = red16(v);
    v += __builtin_bit_cast(float, __builtin_amdgcn_ds_swizzle(__builtin_bit_cast(int, v), 0x401F));
    const unsigned u = __builtin_bit_cast(unsigned, v); auto rr = __builtin_amdgcn_permlane32_swap(u, u, false, false);
    return __builtin_bit_cast(float, (unsigned)rr[0]) + __builtin_bit_cast(float, (unsigned)rr[1]); }
__device__ __forceinline__ float lane_get(float v, int src) { return __builtin_bit_cast(float, __builtin_amdgcn_ds_bpermute(src << 2, __builtin_bit_cast(int, v))); }
namespace pg8 {
#define PG8_LAS __attribute__((address_space(3)))
typedef unsigned short bf16_t;
typedef short bf16x8 __attribute__((ext_vector_type(8)));
typedef float f32x4 __attribute__((ext_vector_type(4)));
typedef unsigned u32x4 __attribute__((ext_vector_type(4)));
constexpr int BM = 256, BK = 64, HALF = 128, HTB = HALF * BK * 2  , STAGE_BYTES = 8 * HTB, NXCD = 8, WGM = 8;

__host__ __device__ __forceinline__ int lds_byte(int r, int c) { const int st = (r >> 4) * 2 + (c >> 5), rr = r & 15, cc = c & 31, ob = rr * 64 + cc * 2; return st * 1024 + (ob ^ (((ob >> 9) & 1) << 5)); }
__host__ __device__ __forceinline__ void stage_rc(int b, int& R, int& C) { const int st = b / 1024, sb = b % 1024, swz = sb ^ (((sb >> 9) & 1) << 5); R = (st >> 1) * 16 + swz / 64; C = (st & 1) * 32 + (swz % 64) / 2; }
__host__ __device__ __forceinline__ int perm32(int rho) { const int n = rho >> 4, i = rho & 15; return 8 * (i >> 2) + 4 * n + (i & 3); }
struct Unit { int pm, pn, aux; const char* a; const char* b; };
struct Gemm { int K; };

struct StaticOrder {
    int nM, nN, nwg, G, c; const char* A; const char* Bt; size_t tstep;
    __device__ void init(const void* A_, const void* Bt_, int M, int N, int K, int G_, int c_) { nM = M / BM; nN = N / BM; nwg = nM * nN; G = G_; c = c_; A = (const char*)A_; Bt = (const char*)Bt_; tstep = (size_t)BM * K * 2; }
    __device__ bool next(int i, Unit& u) const {
        const long L = (long)i * G + c; if (L >= nwg) return false;
        int wgid = (int)L; { const int q = nwg / NXCD, r = nwg % NXCD, xcd = wgid % NXCD, off = wgid / NXCD; wgid = (xcd < r ? xcd * (q + 1) : r * (q + 1) + (xcd - r) * q) + off; }
        const int nig = WGM * nN, gid = wgid / nig, fm = gid * WGM, gsz = (nM - fm) < WGM ? (nM - fm) : WGM;
        u.aux = 0; u.pm = fm + ((wgid % nig) % gsz); u.pn = (wgid % nig) / gsz; u.a = A + (size_t)u.pm * tstep; u.b = Bt + (size_t)u.pn * tstep; return true;
    }
    __device__ __forceinline__ void a_ready(const Unit&) const {}
    __device__ __forceinline__ void done(const Unit&) const {}
};
__device__ __forceinline__ unsigned cvt_pk_bf16(float lo, float hi) { unsigned r; asm volatile("v_cvt_pk_bf16_f32 %0, %1, %2" : "=v"(r) : "v"(lo), "v"(hi)); return r; }
template <class Epi, class Sched, bool ALIGN_EPI = false, bool SP2 = false>
__device__ __forceinline__ void gemm_phase(PG8_LAS unsigned char* lds, const Gemm g, const Sched& S, const Epi& E, int wv) {
    const int tid = mktid(wv), wid = __builtin_amdgcn_readfirstlane(tid >> 6), lane = tid & 63, wr = wid >> 2, wc = wid & 3, fr = lane & 15, fq = lane >> 4;
    const int K = g.K, nt = K / BK;
    unsigned voffA[2], voffB[2];
#pragma unroll
    for (int i = 0; i < 2; ++i) { int R, C; stage_rc(tid * 16 + i * 8192, R, C); const int Rb = Epi::PERM ? ((R & ~31) + perm32(R & 31)) : R;
        voffA[i] = (unsigned)(R * K + C) * 2u; voffB[i] = (unsigned)(Rb * K + C) * 2u; }
    const size_t kstep = (size_t)(BK * 2);
    const size_t hstep = (size_t)HALF * K * 2;
        const unsigned ldsw = (unsigned)wid * 1024u;
    const int aoff = lds_byte(wr * 64 + fr, fq * 8), boff = lds_byte(wc * 32 + fr, fq * 8);
#define PG8_SA(b, h) (((b) * 2 + (h)) * HTB)
#define PG8_SB(b, h) ((4 + (b) * 2 + (h)) * HTB)
#define PG8_STAGE(bufoff, gbase, voff) do { _Pragma("unroll") for (int _i = 0; _i < 2; ++_i) \
        __builtin_amdgcn_global_load_lds((const unsigned*)((const char*)(gbase) + (voff)[_i]), (PG8_LAS unsigned*)(lds + (bufoff) + ldsw + _i * 8192), 16, 0, 0); } while (0)
#define PG8_LDA(dst, b, h) do { _Pragma("unroll") for (int m = 0; m < 4; ++m) _Pragma("unroll") for (int k = 0; k < 2; ++k) dst[m][k] = *(const PG8_LAS bf16x8*)(lds + PG8_SA(b, h) + aoff + m * 2048 + k * 1024); } while (0)
#define PG8_LDB(dst, b, h) do { _Pragma("unroll") for (int n = 0; n < 2; ++n) _Pragma("unroll") for (int k = 0; k < 2; ++k) dst[n][k] = *(const PG8_LAS bf16x8*)(lds + PG8_SB(b, h) + boff + n * 2048 + k * 1024); } while (0)
#define PG8_MMA(ai, bj, At, Bt) do { __builtin_amdgcn_s_setprio(1); _Pragma("unroll") for (int m = 0; m < 4; ++m) _Pragma("unroll") for (int n = 0; n < 2; ++n) _Pragma("unroll") for (int k = 0; k < 2; ++k) \
        acc[ai][bj][m][n] = __builtin_amdgcn_mfma_f32_16x16x32_bf16(Bt[n][k], At[m][k], acc[ai][bj][m][n], 0, 0, 0); __builtin_amdgcn_s_setprio(0); } while (0)
#define PG8_WAIT_V(n) asm volatile("s_waitcnt vmcnt(" #n ")" ::: "memory")
#define PG8_WAIT_L(n) asm volatile("s_waitcnt lgkmcnt(" #n ")" ::: "memory")
#define PG8_BAR __builtin_amdgcn_s_barrier()
#define PG8_SCHED __builtin_amdgcn_sched_barrier(0)
    Unit cur, nxt; int ui = 0;
    if (!S.next(0, cur)) return;
    f32x4 acc[2][2][4][2];
#pragma unroll
    for (int a = 0; a < 2; ++a)
#pragma unroll
        for (int b = 0; b < 2; ++b)
#pragma unroll
            for (int m = 0; m < 4; ++m)
#pragma unroll
                for (int n = 0; n < 2; ++n) acc[a][b][m][n] = (f32x4){0.f, 0.f, 0.f, 0.f};
    bf16x8 At[4][2], B0[2][2], B1[2][2];
    const char* cA = cur.a; const char* cB = cur.b;
    S.a_ready(cur);
    if constexpr (SP2) {
        PG8_STAGE(PG8_SB(0, 0), cB, voffB); PG8_STAGE(PG8_SB(0, 1), cB + hstep, voffB); PG8_STAGE(PG8_SA(0, 0), cA, voffA); PG8_STAGE(PG8_SA(0, 1), cA + hstep, voffA);
        if (wr == 1) PG8_BAR;
        PG8_WAIT_V(2); PG8_BAR;
        PG8_STAGE(PG8_SB(1, 0), cB + kstep, voffB); PG8_STAGE(PG8_SA(1, 0), cA + kstep, voffA); PG8_STAGE(PG8_SB(1, 1), cB + hstep + kstep, voffB);
        PG8_WAIT_V(6); PG8_BAR;
    } else {
        PG8_STAGE(PG8_SB(0, 0), cB, voffB); PG8_STAGE(PG8_SA(0, 0), cA, voffA); PG8_STAGE(PG8_SB(0, 1), cB + hstep, voffB); PG8_STAGE(PG8_SA(0, 1), cA + hstep, voffA);
        if (wr == 1) PG8_BAR;
        PG8_WAIT_V(4); PG8_BAR;
        PG8_STAGE(PG8_SB(1, 0), cB + kstep, voffB); PG8_STAGE(PG8_SA(1, 0), cA + kstep, voffA); PG8_STAGE(PG8_SB(1, 1), cB + hstep + kstep, voffB);
        PG8_WAIT_V(6); PG8_BAR;
    }
    for (;;) {
        const bool has_next = S.next(ui + 1, nxt);
        const char* nA = has_next ? nxt.a : cA; const char* nB = has_next ? nxt.b : cB;
        for (int t = 0; t < nt; t += 2) {
            const bool last = (t == nt - 2);
            const char* a1 = cA + (size_t)(t + 1) * kstep;
            const char* a2 = last ? nA : cA + (size_t)(t + 2) * kstep; const char* b2 = last ? nB : cB + (size_t)(t + 2) * kstep;
            const char* a3 = a2 + kstep; const char* b3 = b2 + kstep;
            if (last && has_next) S.a_ready(nxt);
            if constexpr (SP2) {
            PG8_LDB(B0, 0, 0); PG8_LDB(B1, 0, 1); PG8_SCHED; PG8_LDA(At, 0, 0); PG8_STAGE(PG8_SA(1, 1), a1 + hstep, voffA);
            PG8_WAIT_V(8); PG8_WAIT_L(0); PG8_BAR; PG8_MMA(0, 0, At, B0); PG8_MMA(0, 1, At, B1); PG8_BAR; PG8_SCHED;
            PG8_LDA(At, 0, 1); PG8_STAGE(PG8_SB(0, 0), b2, voffB); PG8_STAGE(PG8_SB(0, 1), b2 + hstep, voffB); PG8_STAGE(PG8_SA(0, 0), a2, voffA);
            PG8_WAIT_V(8); PG8_WAIT_L(0); PG8_BAR; PG8_MMA(1, 0, At, B0); PG8_MMA(1, 1, At, B1); PG8_BAR; PG8_SCHED;
            PG8_LDB(B0, 1, 0); PG8_LDB(B1, 1, 1); PG8_SCHED; PG8_LDA(At, 1, 0); PG8_STAGE(PG8_SA(0, 1), a2 + hstep, voffA);
            PG8_WAIT_V(8); PG8_WAIT_L(0); PG8_BAR; PG8_MMA(0, 0, At, B0); PG8_MMA(0, 1, At, B1); PG8_BAR; PG8_SCHED;
            PG8_LDA(At, 1, 1); PG8_STAGE(PG8_SB(1, 0), b3, voffB); PG8_STAGE(PG8_SB(1, 1), b3 + hstep, voffB); PG8_STAGE(PG8_SA(1, 0), a3, voffA);
            PG8_WAIT_V(8); PG8_WAIT_L(0); PG8_BAR; PG8_MMA(1, 0, At, B0); PG8_MMA(1, 1, At, B1); PG8_BAR; PG8_SCHED;
            } else {
            PG8_LDB(B0, 0, 0); PG8_SCHED; PG8_LDA(At, 0, 0); PG8_STAGE(PG8_SA(1, 1), a1 + hstep, voffA);
            PG8_WAIT_L(8); PG8_BAR; PG8_WAIT_L(0); PG8_MMA(0, 0, At, B0); PG8_BAR; PG8_SCHED;
            PG8_LDB(B1, 0, 1); PG8_STAGE(PG8_SB(0, 0), b2, voffB);
            PG8_BAR; PG8_WAIT_L(0); PG8_MMA(0, 1, At, B1); PG8_BAR;
            PG8_LDA(At, 0, 1); PG8_STAGE(PG8_SA(0, 0), a2, voffA);
            PG8_BAR; PG8_WAIT_L(0); PG8_MMA(1, 0, At, B0); PG8_BAR; PG8_SCHED;
            PG8_STAGE(PG8_SB(0, 1), b2 + hstep, voffB);
            PG8_WAIT_V(6); PG8_BAR; PG8_MMA(1, 1, At, B1); PG8_BAR;
            PG8_LDB(B0, 1, 0); PG8_SCHED; PG8_LDA(At, 1, 0); PG8_STAGE(PG8_SA(0, 1), a2 + hstep, voffA);
            PG8_WAIT_L(8); PG8_BAR; PG8_WAIT_L(0); PG8_MMA(0, 0, At, B0); PG8_BAR; PG8_SCHED;
            PG8_LDB(B1, 1, 1); PG8_STAGE(PG8_SB(1, 0), b3, voffB);
            PG8_BAR; PG8_WAIT_L(0); PG8_MMA(0, 1, At, B1); PG8_BAR;
            PG8_LDA(At, 1, 1); PG8_STAGE(PG8_SA(1, 0), a3, voffA);
            PG8_BAR; PG8_WAIT_L(0); PG8_MMA(1, 0, At, B0); PG8_BAR; PG8_SCHED;
            PG8_STAGE(PG8_SB(1, 1), b3 + hstep, voffB);
            PG8_WAIT_V(6); PG8_BAR; PG8_MMA(1, 1, At, B1); PG8_BAR;
            }
        }
        if constexpr (ALIGN_EPI) { if (wr == 0) PG8_BAR; }
        bool keep = false;
        if constexpr (!Epi::AFTER_DRAIN) { if constexpr (Epi::CHAIN) keep = E.chain(acc, cur, wr, wc, fr, fq); else E(acc, cur, wr, wc, fr, fq); S.done(cur); }
        if (!has_next) break;
        if (!keep) {
#pragma unroll
        for (int a = 0; a < 2; ++a)
#pragma unroll
            for (int b = 0; b < 2; ++b)
#pragma unroll
                for (int m = 0; m < 4; ++m)
#pragma unroll
                    for (int n = 0; n < 2; ++n) acc[a][b][m][n] = (f32x4){0.f, 0.f, 0.f, 0.f};
        }
        cur = nxt; cA = nA; cB = nB; ++ui;
        if constexpr (ALIGN_EPI) { if (wr == 1) PG8_BAR; }
    }
    PG8_WAIT_V(0);
    if constexpr (!ALIGN_EPI) { if (wr == 0) PG8_BAR; }
    PG8_BAR;
    if constexpr (Epi::AFTER_DRAIN) { E.fused(acc, cur, wr, wc, fr, fq, lds, wid, lane); S.done(cur); }
#undef PG8_SA
#undef PG8_SB
#undef PG8_STAGE
#undef PG8_LDA
#undef PG8_LDB
#undef PG8_MMA
#undef PG8_WAIT_V
#undef PG8_WAIT_L
#undef PG8_BAR
#undef PG8_SCHED
}
}
#include <hip/hip_bf16.h>
#include <cmath>
namespace attn_body {
using bf16=__hip_bfloat16;
using bf16x8=__attribute__((ext_vector_type(8)))short;
using s16x4=__attribute__((ext_vector_type(4)))short;
using f32x16=__attribute__((ext_vector_type(16)))float;
using u32x4=__attribute__((ext_vector_type(4)))unsigned;
constexpr int NHEAD=8,SEQ=2048,D=64,PQ=512,PK=512,PV=5376,PO=512;
constexpr int NW=8,QBLK=32,QB=QBLK*NW,KVBLK=64,NQB=SEQ/QB;
__device__ __forceinline__ int crow(int r,int hi){return (r&3)+8*(r>>2)+4*hi;}
#define SBAR() __builtin_amdgcn_sched_barrier(0)
__device__ __forceinline__ void cmask(f32x16&p0,f32x16&p1,int jb,int qrel,int hi){
  const float NEG=-INFINITY; int kb=64*jb+4*hi;
  #pragma unroll
  for(int r=0;r<16;++r){int kv=kb+(r&3)+8*(r>>2); if(kv>qrel)p0[r]=NEG; if(kv+32>qrel)p1[r]=NEG;}
}

constexpr int NSLOT=3, SLOTB=8192;
constexpr int LDS_K=0, LDS_V=NSLOT*SLOTB, LDS_WS=2*NSLOT*SLOTB, LDS_OST=LDS_WS+NW*64*4, LDS_BYTES=LDS_OST+NW*4096;
constexpr float C2=0.125f*1.4426950408889634f;
__device__ __forceinline__ void glds16(const void*gsrc,unsigned lds_dst){unsigned keep;
  asm volatile("s_mov_b32 %0, m0\n\ts_mov_b32 m0, %2\n\ts_nop 0\n\tglobal_load_lds_dwordx4 %1, off\n\ts_mov_b32 m0, %0":"=&s"(keep):"v"(gsrc),"s"(lds_dst):"memory");}
__device__ __forceinline__ float max3f(float a,float b,float c){float r;asm("v_max3_f32 %0, %1, %2, %3":"=v"(r):"v"(a),"v"(b),"v"(c));return r;}
__device__ __forceinline__ float max2f(float a,float b){float r;asm("v_max_f32_e32 %0, %1, %2":"=v"(r):"v"(a),"v"(b));return r;}
__device__ __forceinline__ float fadd_s(float a,float b){float r;asm("v_add_f32_e32 %0, %1, %2":"=v"(r):"v"(a),"v"(b));return r;}
__device__ __forceinline__ float fsub_s(float a,float b){float r;asm("v_sub_f32_e32 %0, %1, %2":"=v"(r):"v"(a),"v"(b));return r;}
typedef float f32x2_t __attribute__((ext_vector_type(2))); typedef __bf16 bf16x2_t __attribute__((ext_vector_type(2)));
__device__ __forceinline__ unsigned cvtpk_s(float lo,float hi){f32x2_t v={lo,hi};bf16x2_t b=__builtin_convertvector(v,bf16x2_t);return __builtin_bit_cast(unsigned,b);}
#define WAIT_BAR(N) asm volatile("s_waitcnt vmcnt(" #N ") lgkmcnt(0)\n\ts_barrier":::"memory")

__device__ __forceinline__ void qkt(f32x16&p0,f32x16&p1,const char*Kslot,const bf16x8*qr,const f32x16&negm,int r32,int hi){
  const char*kb=Kslot+hi*1024+r32*16;
  #pragma unroll
  for(int d0=0;d0<4;++d0){
    const bf16x8 b0=*reinterpret_cast<const bf16x8*>(kb+d0*2048);
    const bf16x8 b1=*reinterpret_cast<const bf16x8*>(kb+d0*2048+512);
    if(d0==0){p0=__builtin_amdgcn_mfma_f32_32x32x16_bf16(b0,qr[0],negm,0,0,0);p1=__builtin_amdgcn_mfma_f32_32x32x16_bf16(b1,qr[0],negm,0,0,0);}
    else{p0=__builtin_amdgcn_mfma_f32_32x32x16_bf16(b0,qr[d0],p0,0,0,0);p1=__builtin_amdgcn_mfma_f32_32x32x16_bf16(b1,qr[d0],p1,0,0,0);}}
}
typedef __attribute__((address_space(3))) const char* lds_cptr;
typedef short v4i16_t __attribute__((ext_vector_type(4)));
__device__ __forceinline__ void kload8(bf16x8*kf,lds_cptr kp){
  kf[0]=*(const __attribute__((address_space(3))) bf16x8*)(kp);      kf[1]=*(const __attribute__((address_space(3))) bf16x8*)(kp+512);
  kf[2]=*(const __attribute__((address_space(3))) bf16x8*)(kp+2048); kf[3]=*(const __attribute__((address_space(3))) bf16x8*)(kp+2560);
  kf[4]=*(const __attribute__((address_space(3))) bf16x8*)(kp+4096); kf[5]=*(const __attribute__((address_space(3))) bf16x8*)(kp+4608);
  kf[6]=*(const __attribute__((address_space(3))) bf16x8*)(kp+6144); kf[7]=*(const __attribute__((address_space(3))) bf16x8*)(kp+6656);
}
__device__ __forceinline__ void kload2(bf16x8*kf,lds_cptr kp,int j){ kf[2*j]=*(const __attribute__((address_space(3))) bf16x8*)(kp+j*2048); kf[2*j+1]=*(const __attribute__((address_space(3))) bf16x8*)(kp+j*2048+512); }
__device__ __forceinline__ s16x4 vtr(lds_cptr p){ return __builtin_bit_cast(s16x4,__builtin_amdgcn_ds_read_tr16_b64_v4i16((__attribute__((address_space(3))) v4i16_t*)p)); }
__device__ __forceinline__ float rowmax(const f32x16&p0,const f32x16&p1){
  float a=max3f(p0[0],p0[1],p1[0]),b=max3f(p0[2],p0[3],p1[1]);a=max3f(a,p1[2],p1[3]);
  #pragma unroll
  for(int r=4;r<16;r+=4){a=max3f(a,p0[r],p0[r+1]);b=max3f(b,p0[r+2],p0[r+3]);a=max3f(a,p1[r],p1[r+1]);b=max3f(b,p1[r+2],p1[r+3]);}
  const float m=max2f(a,b);
  auto rr=__builtin_amdgcn_permlane32_swap(__float_as_uint(m),__float_as_uint(m),false,false);
  return max2f(__uint_as_float(rr[0]),__uint_as_float(rr[1]));
}
__device__ __forceinline__ void pv(f32x16*o,int vb,bf16x8 pa0,bf16x8 pa1,bf16x8 pa2,bf16x8 pa3){
  #pragma unroll
  for(int d0=0;d0<2;++d0){s16x4 lo[4],hi[4];
    #pragma unroll
    for(int ks=0;ks<4;++ks){
      asm volatile("ds_read_b64_tr_b16 %0,%1 offset:%c2":"=&v"(lo[ks]):"v"(vb),"i"(d0*4096+ks*1024):"memory");
      asm volatile("ds_read_b64_tr_b16 %0,%1 offset:%c2":"=&v"(hi[ks]):"v"(vb),"i"(d0*4096+ks*1024+512):"memory");}
    asm volatile("s_waitcnt lgkmcnt(0)":::"memory");SBAR();
    #define PK(k) (bf16x8){lo[k][0],lo[k][1],lo[k][2],lo[k][3],hi[k][0],hi[k][1],hi[k][2],hi[k][3]}
    o[d0]=__builtin_amdgcn_mfma_f32_32x32x16_bf16(pa0,PK(0),o[d0],0,0,0);
    o[d0]=__builtin_amdgcn_mfma_f32_32x32x16_bf16(pa1,PK(1),o[d0],0,0,0);
    o[d0]=__builtin_amdgcn_mfma_f32_32x32x16_bf16(pa2,PK(2),o[d0],0,0,0);
    o[d0]=__builtin_amdgcn_mfma_f32_32x32x16_bf16(pa3,PK(3),o[d0],0,0,0);
    #undef PK
  }
}

#ifndef ATTN_STORE16
#define ATTN_STORE16(p,v) (*(u32x4*)(p)=(v))
#endif
template<int THRL> __device__ __forceinline__ void attn_unit(int b,int h,int qb,const bf16*Q,const bf16*__restrict__ K,const bf16*__restrict__ V,bf16*O,const unsigned char*__restrict__ SEL,char*shm,int wv){
  const int tid=mktid(wv),lane=tid&63,r32=lane&31,hi=lane>>5;     const int wid=__builtin_amdgcn_readfirstlane(tid>>6);
  const long rowbase=(long)b*SEQ; const int q0=qb*QB;
  const bf16*Qw=Q+(rowbase+q0+wid*QBLK)*PQ+h*D;
  const bf16*Kh=K+rowbase*PK+h*D,*Vh=V+rowbase*PV+h*D;
  const unsigned lds0=(unsigned)(uintptr_t)shm;
  float*wsf=(float*)(shm+LDS_WS)+wid*64;
  const bf16*ksrc=Kh+(long)lane*PK+wid*8;
  const bf16*vsrc=Vh+(long)(16*(wid&3)+(lane>>2))*PV+(wid>>2)*32+(lane&3)*8;
  const unsigned kdst=lds0+LDS_K+wid*1024, vdst=lds0+LDS_V+wid*1024;
  #define TROW(t) ((long)(((t)<4)?(q0+(t)*KVBLK):(((t)-4)*KVBLK)))
  #define DMA_K(t,slot) glds16(ksrc+TROW(t)*PK,(unsigned)__builtin_amdgcn_readfirstlane(kdst+(slot)))
  #define DMA_V(t,slot) glds16(vsrc+TROW(t)*PV,(unsigned)__builtin_amdgcn_readfirstlane(vdst+(slot)))
  const int vb0=(int)(lds0+LDS_V)+((lane>>4)&1)*32+(lane&3)*8+(4*hi+((lane&15)>>2))*64;
  const char*Kbase=shm+LDS_K; bf16x8 kf[8];
  const lds_cptr shm3=(lds_cptr)shm; const lds_cptr kp0=shm3+LDS_K+hi*1024+r32*16; const lds_cptr vp0=shm3+LDS_V+((lane>>4)&1)*32+(lane&3)*8+(4*hi+((lane&15)>>2))*64;
  const int NT=(q0+QB)/KVBLK;
  DMA_K(0,0);DMA_V(0,0);DMA_K(1,SLOTB);
  bf16x8 qr[4];
  #pragma unroll
  for(int d0=0;d0<4;++d0)qr[d0]=*reinterpret_cast<const bf16x8*>(&Qw[(long)r32*PQ+d0*16+hi*8]);
  float mhat=0.f,l_reg=0.f;f32x16 o[2];o[0]=f32x16{};o[1]=f32x16{};
  const int qrel=wid*QBLK+r32;
  const unsigned selb=(unsigned)SEL[((long)(b*NHEAD+h))*SEQ+q0+qrel];
  #define CMASK(P0,P1,t) cmask(P0,P1,(t),qrel,hi)
  #define SUBREF(C0,C1,t) do{ const float sb_=(((t)<4)||((selb>>(((t)-4)>>2))&1u))?mhat:INFINITY; _Pragma("unroll") for(int r_=0;r_<16;++r_){C0[r_]-=sb_;C1[r_]-=sb_;} }while(0)
  bool resc=false;
  #define START(P0,P1) do{ const float rm=rowmax(P0,P1); resc=false; \
    { const float dl=rm; mhat=fadd_s(mhat,dl); \
      _Pragma("unroll") for(int r=0;r<16;++r){P0[r]=fsub_s(P0[r],dl);P1[r]=fsub_s(P1[r],dl);} \
      } \
    _Pragma("unroll") for(int r=0;r<16;++r)P0[r]=__builtin_amdgcn_exp2f(P0[r]); }while(0)
  #define RESC() do{ if(resc){ asm volatile("s_waitcnt lgkmcnt(0)":::"memory"); \
      _Pragma("unroll") for(int d_=0;d_<2;++d_) _Pragma("unroll") for(int r=0;r<16;++r)o[d_][r]*=wsf[crow(r,hi)]; } }while(0)
  f32x16 pA0,pA1,pB0,pB1;
  int sl_prev=0,sl_cur=0,sl_next=SLOTB;
  #define ROT() do{sl_prev=sl_cur;sl_cur=sl_next;sl_next=(sl_next==(NSLOT-1)*SLOTB)?0:sl_next+SLOTB;}while(0)
  DMA_K(2,2*SLOTB);
  WAIT_BAR(3);
  qkt(pA0,pA1,Kbase,qr,f32x16{},r32,hi);asm volatile("s_nop 15\n\ts_nop 7":"+v"(pA0),"+v"(pA1));CMASK(pA0,pA1,0);
  START(pA0,pA1);
  _Pragma("unroll") for(int r=0;r<16;++r)pA1[r]=__builtin_amdgcn_exp2f(pA1[r]);
  WAIT_BAR(0);
  DMA_K(3,0);DMA_V(1,SLOTB);
  ROT();
  kload8(kf,kp0+sl_cur);
  WAIT_BAR(2);
  s16x4 vlo[8],vhi[8]; u32x4 pw0,pw1,pw2,pw3;
  #define PKW(P,B) cvtpk_s(P[B],P[B+1])
  #define PAF(k) __builtin_bit_cast(bf16x8,pw##k)
  #define VFR(i) (bf16x8){vlo[i][0],vlo[i][1],vlo[i][2],vlo[i][3],vhi[i][0],vhi[i][1],vhi[i][2],vhi[i][3]}
  #define PIN(x) asm volatile("":"+v"(x))
  #define MX3(a,b,c) __builtin_fmaxf(__builtin_fmaxf((a),(b)),(c))
  #define GAPA(MF,A0,A1,A2,A3,W0,W1,PW) do{ MF; sacc+=A0; sacc+=A1; sacc+=A2; sacc+=A3; PIN(sacc); W0; W1; PIN(PW); SBAR(); }while(0)
  #define EX(v) __builtin_amdgcn_exp2f(v)
  #define GAPB(MF,X,B) do{ MF; X[B]=EX(X[B]); X[B+1]=EX(X[B+1]); X[B+2]=EX(X[B+2]); X[B+3]=EX(X[B+3]); PIN(X); SBAR(); }while(0)
  #define VRD(i) do{ vlo[i]=vtr(vp_+(((i)>>2)*4096+((i)&3)*1024)); vhi[i]=vtr(vp_+(((i)>>2)*4096+((i)&3)*1024+512)); }while(0)
  #define KRD(G,j) do{ if(G){ kload2(kf,kp0+sl_next,j); SBAR(); } }while(0)
  #define STEP(C0,C1,P0,P1,t,GK,GV,GL,MB) do{ SBAR(); \
    const lds_cptr vp_=vp0+sl_prev; \
    VRD(0); SBAR(); float sacc=(P0[0]+P0[1]); \
    GAPA(C0=__builtin_amdgcn_mfma_f32_32x32x16_bf16(kf[0],qr[0],f32x16{},0,0,0), P0[2],P0[3],P0[4],P0[5],     pw0[0]=PKW(P0,0), pw0[1]=PKW(P0,2), pw0); \
    VRD(4); SBAR(); GAPA(C1=__builtin_amdgcn_mfma_f32_32x32x16_bf16(kf[1],qr[0],f32x16{},0,0,0), P0[6],P0[7],P0[8],P0[9],     pw0[2]=PKW(P0,4), pw0[3]=PKW(P0,6), pw0); \
    VRD(1); SBAR(); GAPA(C0=__builtin_amdgcn_mfma_f32_32x32x16_bf16(kf[2],qr[1],C0,0,0,0),   P0[10],P0[11],P0[12],P0[13], pw1[0]=PKW(P0,8), pw1[1]=PKW(P0,10), pw1); \
    VRD(5); SBAR(); GAPA(C1=__builtin_amdgcn_mfma_f32_32x32x16_bf16(kf[3],qr[1],C1,0,0,0),   P0[14],P0[15],P1[0],P1[1],   pw1[2]=PKW(P0,12),pw1[3]=PKW(P0,14), pw1); \
    VRD(2); SBAR(); GAPA(C0=__builtin_amdgcn_mfma_f32_32x32x16_bf16(kf[4],qr[2],C0,0,0,0),   P1[2],P1[3],P1[4],P1[5],     pw2[0]=PKW(P1,0), pw2[1]=PKW(P1,2), pw2); \
    VRD(6); SBAR(); GAPA(C1=__builtin_amdgcn_mfma_f32_32x32x16_bf16(kf[5],qr[2],C1,0,0,0),   P1[6],P1[7],P1[8],P1[9],     pw2[2]=PKW(P1,4), pw2[3]=PKW(P1,6), pw2); \
    VRD(3); SBAR(); GAPA(C0=__builtin_amdgcn_mfma_f32_32x32x16_bf16(kf[6],qr[3],C0,0,0,0),   P1[10],P1[11],P1[12],P1[13], pw3[0]=PKW(P1,8), pw3[1]=PKW(P1,10), pw3); \
    VRD(7); SBAR(); GAPA(C1=__builtin_amdgcn_mfma_f32_32x32x16_bf16(kf[7],qr[3],C1,0,0,0),   P1[14],P1[15],0.f,0.f,       pw3[2]=PKW(P1,12),pw3[3]=PKW(P1,14), pw3); \
    l_reg+=sacc; \
    if(GK){DMA_K((t)+3,sl_cur);} if(GV){DMA_V((t)+1,sl_next);} \
    SUBREF(C0,C1,t); if(MB){CMASK(C0,C1,t);} \
    { float a=MX3(C0[0],C0[1],C1[0]),b=MX3(C0[2],C0[3],C1[1]); a=MX3(a,C1[2],C1[3]); \
      _Pragma("unroll") for(int r=4;r<16;r+=4){a=MX3(a,C0[r],C0[r+1]);b=MX3(b,C0[r+2],C0[r+3]);a=MX3(a,C1[r],C1[r+1]);b=MX3(b,C1[r+2],C1[r+3]);} \
      float rm=__builtin_fmaxf(a,b); { auto rr=__builtin_amdgcn_permlane32_swap(__float_as_uint(rm),__float_as_uint(rm),false,false); rm=__builtin_fmaxf(__uint_as_float(rr[0]),__uint_as_float(rr[1])); } \
      resc=false; \
      if(__builtin_expect(__any(rm>(float)THRL),0)){ const float dl=__builtin_fmaxf(rm,0.f); mhat+=dl; \
        _Pragma("unroll") for(int r=0;r<16;++r){C0[r]-=dl;C1[r]-=dl;} \
        const float f=__builtin_amdgcn_exp2f(-dl); l_reg*=f; if(hi==0)wsf[r32]=f; resc=true; } } \
    SBAR(); \
    GAPB(o[0]=__builtin_amdgcn_mfma_f32_32x32x16_bf16(PAF(0),VFR(0),o[0],0,0,0), C0,0); \
    GAPB(o[1]=__builtin_amdgcn_mfma_f32_32x32x16_bf16(PAF(0),VFR(4),o[1],0,0,0), C0,4); \
    KRD(GL,0); GAPB(o[0]=__builtin_amdgcn_mfma_f32_32x32x16_bf16(PAF(1),VFR(1),o[0],0,0,0), C0,8); \
    KRD(GL,1); GAPB(o[1]=__builtin_amdgcn_mfma_f32_32x32x16_bf16(PAF(1),VFR(5),o[1],0,0,0), C0,12); \
    KRD(GL,2); GAPB(o[0]=__builtin_amdgcn_mfma_f32_32x32x16_bf16(PAF(2),VFR(2),o[0],0,0,0), C1,0); \
    KRD(GL,3); GAPB(o[1]=__builtin_amdgcn_mfma_f32_32x32x16_bf16(PAF(2),VFR(6),o[1],0,0,0), C1,4); \
    GAPB(o[0]=__builtin_amdgcn_mfma_f32_32x32x16_bf16(PAF(3),VFR(3),o[0],0,0,0), C1,8); \
    GAPB(o[1]=__builtin_amdgcn_mfma_f32_32x32x16_bf16(PAF(3),VFR(7),o[1],0,0,0), C1,12); \
    }while(0)
  #define ENDW(tt) do{ if((tt)+3<NT){WAIT_BAR(2);} else if((tt)+2<NT){WAIT_BAR(1);} else {WAIT_BAR(0);} }while(0)
  { int t=1;
    for(;t+1<NT;t+=2){
      STEP(pB0,pB1,pA0,pA1,t,(t+3<NT),(t+1<NT),(t+1<NT),(t<4));       ENDW(t);   RESC(); ROT();
      STEP(pA0,pA1,pB0,pB1,t+1,(t+4<NT),(t+2<NT),(t+2<NT),(t+1<4));     ENDW(t+1); RESC(); ROT();
    }
    STEP(pB0,pB1,pA0,pA1,NT-1,false,false,false,(NT==4)); RESC();
  }
  { float sacc=pB0[0]+pB0[1]; _Pragma("unroll") for(int r=2;r<16;++r)sacc+=pB0[r]; _Pragma("unroll") for(int r=0;r<16;++r)sacc+=pB1[r]; l_reg+=sacc;
    pw0=(u32x4){PKW(pB0,0),PKW(pB0,2),PKW(pB0,4),PKW(pB0,6)};pw1=(u32x4){PKW(pB0,8),PKW(pB0,10),PKW(pB0,12),PKW(pB0,14)};pw2=(u32x4){PKW(pB1,0),PKW(pB1,2),PKW(pB1,4),PKW(pB1,6)};pw3=(u32x4){PKW(pB1,8),PKW(pB1,10),PKW(pB1,12),PKW(pB1,14)};
    SBAR(); pv(o,vb0+sl_cur,PAF(0),PAF(1),PAF(2),PAF(3)); }
  #undef PKW
  #undef PAF
  #undef VFR
  #undef PIN
  #undef MX3
  #undef GAPA
  #undef GAPB
  #undef EX
  #undef VRD
  #undef KRD
  #undef STEP
  #undef ENDW
  {auto rr=__builtin_amdgcn_permlane32_swap(__float_as_uint(l_reg),__float_as_uint(l_reg),false,false);l_reg=__uint_as_float(rr[0])+__uint_as_float(rr[1]);}
  if(hi==0)wsf[32+r32]=l_reg;asm volatile("s_waitcnt lgkmcnt(0)":::"memory");
  float rli[16];
  #pragma unroll
  for(int r=0;r<16;++r)rli[r]=__builtin_amdgcn_rcpf(wsf[32+crow(r,hi)]);
  bf16*Ow=O+(rowbase+q0+wid*QBLK)*PO+h*D;
  { bf16*stg=(bf16*)(shm+LDS_OST)+wid*2048;
    #pragma unroll
    for(int r=0;r<16;++r){const int orow=crow(r,hi);
      #pragma unroll
      for(int d0=0;d0<2;++d0)stg[orow*64+d0*32+r32]=__float2bfloat16(o[d0][r]*rli[r]);}
    asm volatile("s_waitcnt lgkmcnt(0)":::"memory");
    #pragma unroll
    for(int i=0;i<4;++i){const int row=i*8+(lane>>3),ch=lane&7; const u32x4 v=*(const u32x4*)(stg+row*64+ch*8); ATTN_STORE16(Ow+(long)row*PO+ch*8,v);} }
  asm volatile("s_waitcnt lgkmcnt(0)\n\ts_barrier":::"memory");
  #undef DMA_K
  #undef TROW
  #undef SUBREF
  #undef DMA_V
  #undef CMASK
  #undef START
  #undef RESC
  #undef ROT
}
constexpr int ATTN_LDS_BYTES=LDS_BYTES;
#undef SBAR
#undef WAIT_BAR
}
constexpr int DM = 1024, NB = 16, SEQ = 2048, NT = NB * SEQ;
constexpr int RWW = 512, INC = 5376, ZA = 1792, ZG = 3328;
constexpr int NEXP = 32, DEXP = 512;
constexpr int XS_ROWS = 2 * NT + NEXP * 256;
constexpr float C2 = 0.125f * 1.4426950408889634f;

#define LAS __attribute__((address_space(3)))
#define GAS __attribute__((address_space(1)))
typedef unsigned short bf16;
typedef unsigned v4u __attribute__((ext_vector_type(4)));
typedef unsigned v2u __attribute__((ext_vector_type(2)));
typedef float f32x4 __attribute__((ext_vector_type(4)));

typedef float f32x2_c __attribute__((ext_vector_type(2))); typedef __bf16 bf16x2_c __attribute__((ext_vector_type(2)));
__device__ __forceinline__ unsigned pk2(float lo, float hi) { const f32x2_c v = {lo, hi}; return __builtin_bit_cast(unsigned, __builtin_convertvector(v, bf16x2_c)); }
__device__ __forceinline__ unsigned f2bf(float f) { return pk2(f, f) & 0xffffu; }
__device__ __forceinline__ float bflo(unsigned w) { return __builtin_bit_cast(float, w << 16); }
__device__ __forceinline__ float bfhi(unsigned w) { return __builtin_bit_cast(float, w & 0xffff0000u); }
__device__ __forceinline__ float sigm(float x) { return __builtin_amdgcn_rcpf(1.0f + __expf(-x)); }

constexpr size_t MiB = 1u << 20;
constexpr size_t WS_CTL = 0;
constexpr size_t WS_MOD = 1 * MiB;
constexpr size_t WS_COS = 2 * MiB;
constexpr size_t WS_SIN = 2 * MiB + 512 * 1024;
constexpr size_t WS_KMEAN = 3 * MiB;
constexpr size_t WS_WRH = 3 * MiB + 512 * 1024;
constexpr size_t WS_WRL = 3 * MiB + 768 * 1024;
constexpr size_t WS_SEL = 4 * MiB;
constexpr size_t WS_RTE = 5 * MiB;
constexpr size_t WS_RTW = 5 * MiB + 256 * 1024;
constexpr size_t WS_RNK = 5 * MiB + 512 * 1024;
constexpr size_t WS_POS = 5 * MiB + 768 * 1024;
constexpr size_t WS_WLT = 6 * MiB;
constexpr size_t WS_WAT = 6 * MiB + 64 * 1024;
constexpr size_t WS_WGT = 6 * MiB + 128 * 1024;
constexpr size_t WS_WIN = 16 * MiB;
constexpr size_t WS_WBA = 27 * MiB;
constexpr size_t WS_WBB = 28 * MiB;
constexpr size_t WS_WOUT = 29 * MiB;
constexpr size_t WS_Z = 32 * MiB;
constexpr size_t WS_H = 368 * MiB;
constexpr size_t WS_Q = 368 * MiB, WS_K = 400 * MiB, WS_MRG = 368 * MiB;
constexpr size_t WS_YA = 432 * MiB, WS_YB = 464 * MiB;
constexpr size_t WS_WUP = 32 * MiB;
constexpr size_t WS_W2T = 96 * MiB;
constexpr size_t WS_H2 = 128 * MiB;
constexpr size_t WS_XS = 192 * MiB;
constexpr size_t WS_HID = 336 * MiB;
constexpr size_t WS_X1B = 432 * MiB;
constexpr size_t WS_END = 496 * MiB;
constexpr int CW_CNT = 64;
constexpr int CW_NT = 128;
constexpr int CW_TEXP = 256;

__device__ __forceinline__ void tr_item(const float* W, int K, int N, bf16* WT, int kb, int nb, int dst_row0, LAS float* scr, int lane) {
    const int k0 = 64 * kb, n0 = 32 * nb;
#pragma unroll 8
    for (int i = 0; i < 32; ++i) { const int kk = 2 * i + (lane >> 5); scr[kk * 33 + (lane & 31)] = W[(size_t)(k0 + kk) * N + n0 + (lane & 31)]; }
    asm volatile("s_waitcnt lgkmcnt(0)" ::: "memory");
    const int c = lane & 7;
#pragma unroll
    for (int j = 0; j < 4; ++j) { const int n = (lane >> 3) + 8 * j; const LAS float* s = scr + (8 * c) * 33 + n;
        v4u o; o.x = pk2(s[0 * 33], s[1 * 33]); o.y = pk2(s[2 * 33], s[3 * 33]); o.z = pk2(s[4 * 33], s[5 * 33]); o.w = pk2(s[6 * 33], s[7 * 33]);
        *(v4u*)(WT + (size_t)(dst_row0 + n) * K + k0 + 8 * c) = o; }
    asm volatile("s_waitcnt lgkmcnt(0)" ::: "memory");
}

struct PArgs { const float* in[30]; float* out; unsigned char* ws; };

__device__ __forceinline__ void p_prep_weights(const PArgs& a, unsigned char* lds, int wv) {
    const int tid = mktid(wv), lane = tid & 63, wave = tid >> 6;
    LAS float* scr = (LAS float*)lds + wave * (64 * 33);
    const int gw = blockIdx.x * 8 + wave, NGW = gridDim.x * 8;
    unsigned char* ws = a.ws;
    constexpr int I_IN = 16 * 168, I_BR = 8 * 32, I_OUT = 16 * 32;
    for (int it = gw; it < I_IN + 2 * I_BR + I_OUT; it += NGW) {
        int r = it;
        if (r < I_IN) { const int kb = r / 168, nb = r % 168; tr_item(a.in[6], 1024, INC, (bf16*)(ws + WS_WIN), kb, nb, 32 * nb, scr, lane); continue; } r -= I_IN;
        if (r < I_BR) { const int kb = r / 32, nb = r % 32; tr_item(a.in[20], 512, 1024, (bf16*)(ws + WS_WBA), kb, nb, 32 * nb, scr, lane); continue; } r -= I_BR;
        if (r < I_BR) { const int kb = r / 32, nb = r % 32; tr_item(a.in[21], 512, 1024, (bf16*)(ws + WS_WBB), kb, nb, 32 * nb, scr, lane); continue; } r -= I_BR;
        { const int kb = r / 32, nb = r % 32; tr_item(a.in[22], 1024, 1024, (bf16*)(ws + WS_WOUT), kb, nb, 32 * nb, scr, lane); }
    }
    const int gt = blockIdx.x * 512 + tid, NGT = gridDim.x * 512;
    float* cosT = (float*)(ws + WS_COS); float* sinT = (float*)(ws + WS_SIN);
    for (int i = gt; i < SEQ * 32; i += NGT) { const int s = i >> 5, f = i & 31; const float inv = powf(10000.0f, -(float)f / 32.0f); const float ang = (float)s * inv; cosT[i] = cosf(ang); sinT[i] = sinf(ang); }
    { bf16* wlt = (bf16*)(ws + WS_WLT); bf16* wat = (bf16*)(ws + WS_WAT); bf16* wgt = (bf16*)(ws + WS_WGT);
      for (int i = gt; i < 8 * 64 * 64; i += NGT) { const int hh = i >> 12, j = (i >> 6) & 63, m = i & 63; wlt[i] = (bf16)f2bf(a.in[9][m * 512 + hh * 64 + j]); wat[i] = (bf16)f2bf(a.in[11][m * 512 + hh * 64 + j]); }
      for (int i = gt; i < 8 * 64 * 128; i += NGT) { const int hh = i >> 13, j = (i >> 7) & 63, m = i & 127; wgt[i] = (bf16)f2bf(a.in[12][m * 512 + hh * 64 + j]); } }
    { bf16* wrh = (bf16*)(ws + WS_WRH); bf16* wrl = (bf16*)(ws + WS_WRL);
      for (int i = gt; i < 48 * 1024; i += NGT) { const int e = i >> 10, k = i & 1023; const float w = e < 4 ? a.in[23][k * 4 + e] : e < 36 ? a.in[25][k * 32 + (e - 4)] : 0.f;
          const unsigned hi = f2bf(w); wrh[i] = (bf16)hi; wrl[i] = (bf16)f2bf(w - bflo(hi)); } }
}

__device__ __forceinline__ void p_prep_experts(const PArgs& a, unsigned char* lds, int wv) {
    const int tid = mktid(wv), lane = tid & 63, wave = tid >> 6;
    LAS float* scr = (LAS float*)lds + wave * (64 * 33);
    const int gw = blockIdx.x * 8 + wave, NGW = gridDim.x * 8;
    unsigned char* ws = a.ws;
    for (int it = gw; it < NEXP * 768; it += NGW) {
        const int e = it / 768; int r = it % 768;
        bf16* wup = (bf16*)(ws + WS_WUP) + (size_t)e * 1024 * 1024;
        if (r < 256) { const int kb = r / 16, nb = r % 16, n0 = 32 * nb; tr_item(a.in[27] + (size_t)e * 1024 * 512, 1024, 512, wup, kb, nb, (n0 >> 7) * 256 + (n0 & 127), scr, lane); continue; } r -= 256;
        if (r < 256) { const int kb = r / 16, nb = r % 16, n0 = 32 * nb; tr_item(a.in[28] + (size_t)e * 1024 * 512, 1024, 512, wup, kb, nb, (n0 >> 7) * 256 + 128 + (n0 & 127), scr, lane); continue; } r -= 256;
        { const int kb = r / 32, nb = r % 32; tr_item(a.in[29] + (size_t)e * 512 * 1024, 512, 1024, (bf16*)(ws + WS_W2T) + (size_t)e * 1024 * 512, kb, nb, 32 * nb, scr, lane); }
    }
}

__device__ __forceinline__ void p_ada(const PArgs& a, unsigned char* lds, int wv) {
    float* sc = (float*)lds; float* red = sc + 16 * 1024;
    const float* c = a.in[1]; const float* w = a.in[2]; const float* bias = a.in[3];
    float* mod = (float*)(a.ws + WS_MOD);
    const int tid = mktid(wv);
    for (int i = tid; i < 16 * 1024; i += 512) { const float v = c[i]; sc[i] = v / (1.0f + __expf(-v)); }
    __syncthreads();
    const int col = tid & 31, kg = tid >> 5;
    for (int tile = blockIdx.x; tile < 192; tile += gridDim.x) {
        const int e = tile * 32 + col;
        float acc[16];
#pragma unroll
        for (int b = 0; b < 16; ++b) acc[b] = 0.f;
        for (int d = kg * 64; d < kg * 64 + 64; ++d) { const float wv = w[(size_t)d * 6144 + e];
#pragma unroll
            for (int b = 0; b < 16; ++b) acc[b] += sc[b * 1024 + d] * wv; }
#pragma unroll
        for (int b = 0; b < 16; ++b) red[(kg * 16 + b) * 32 + col] = acc[b];
        __syncthreads();
        { const int b = tid >> 5, cc = tid & 31; float sm = 0.f;
#pragma unroll
            for (int k = 0; k < 16; ++k) sm += red[(k * 16 + b) * 32 + cc];
            mod[b * 6144 + tile * 32 + cc] = sm + bias[tile * 32 + cc]; }
        __syncthreads();
    }
}

__device__ __forceinline__ void p_norm1(const PArgs& a, unsigned char* lds, int wv) {
    const int tid = mktid(wv), lane = tid & 63, gw = blockIdx.x * 8 + (tid >> 6), NGW = gridDim.x * 8;
    const float* x = a.in[0]; const float* g = a.in[4]; const float* mod = (const float*)(a.ws + WS_MOD);
    bf16* h = (bf16*)(a.ws + WS_H);
    for (int m = gw; m < NT; m += NGW) {
        const int b = m >> 11; const f32x4* xr = (const f32x4*)(x + (size_t)m * DM) + lane; f32x4 v[4]; float s = 0.f;
#pragma unroll
        for (int j = 0; j < 4; ++j) { v[j] = xr[64 * j]; s += (v[j].x * v[j].x + v[j].y * v[j].y) + (v[j].z * v[j].z + v[j].w * v[j].w); }
        const float rstd = rsqrtf(wave_sum(s) * (1.0f / DM) + 1e-6f);
        v2u* o = (v2u*)(h + (size_t)m * DM) + lane;
#pragma unroll
        for (int j = 0; j < 4; ++j) { const int col = 4 * (lane + 64 * j);
            const f32x4 gg = *(const f32x4*)(g + col), sh = *(const f32x4*)(mod + b * 6144 + col), scl = *(const f32x4*)(mod + b * 6144 + 1024 + col);
            const f32x4 r = v[j] * rstd * gg * (scl + 1.0f) + sh; v2u w; w.x = pk2(r.x, r.y); w.y = pk2(r.z, r.w); o[64 * j] = w; }
    }
}

using pg8::Unit; using pg8::HALF; using pg8::BM; using pg8::cvt_pk_bf16;
typedef pg8::f32x4 pf4; typedef pg8::u32x4 pu4;

struct EpiStoreBf16 {
    static constexpr bool PERM = true, AFTER_DRAIN = false, CHAIN = false;
    bf16* O; int ldc;
    __device__ __forceinline__ void operator()(const pf4 (&acc)[2][2][4][2], const Unit& u, int wr, int wc, int fr, int fq) const {
        const int row0 = u.pm * BM + wr * 64 + fr, col0 = u.pn * BM + wc * 32 + 8 * fq;
#pragma unroll
        for (int ai = 0; ai < 2; ++ai)
#pragma unroll
            for (int m = 0; m < 4; ++m) { bf16* rowp = O + (size_t)(row0 + ai * HALF + m * 16) * ldc + col0;
#pragma unroll
                for (int bj = 0; bj < 2; ++bj) { const pf4 v0 = acc[ai][bj][m][0], v1 = acc[ai][bj][m][1]; pu4 w;
                    w.x = cvt_pk_bf16(v0[0], v0[1]); w.y = cvt_pk_bf16(v0[2], v0[3]); w.z = cvt_pk_bf16(v1[0], v1[1]); w.w = cvt_pk_bf16(v1[2], v1[3]);
                    *(pu4*)(rowp + bj * HALF) = w; } }
    }
};
struct EpiMerge {
    static constexpr bool PERM = true, AFTER_DRAIN = false, CHAIN = true;
    const bf16* z; bf16* mrg;
    __device__ __forceinline__ bool chain(pf4 (&acc)[2][2][4][2], const Unit& u, int wr, int wc, int fr, int fq) const {
        const int row0 = u.pm * BM + wr * 64 + fr, col0 = u.pn * BM + wc * 32 + 8 * fq;
        if (u.aux == 0) {
#pragma unroll
            for (int ai = 0; ai < 2; ++ai)
#pragma unroll
                for (int m = 0; m < 4; ++m) { const size_t row = (size_t)(row0 + ai * HALF + m * 16);
#pragma unroll
                    for (int bj = 0; bj < 2; ++bj) { const int col = col0 + bj * HALF; const pu4 za = *(const pu4*)(z + row * INC + ZG + col), zb = *(const pu4*)(z + row * INC + ZG + 1024 + col);
                        const float a8[8] = {bflo(za.x), bfhi(za.x), bflo(za.y), bfhi(za.y), bflo(za.z), bfhi(za.z), bflo(za.w), bfhi(za.w)};
                        const float b8[8] = {bflo(zb.x), bfhi(zb.x), bflo(zb.y), bfhi(zb.y), bflo(zb.z), bfhi(zb.z), bflo(zb.w), bfhi(zb.w)};
#pragma unroll
                        for (int e = 0; e < 8; ++e) acc[ai][bj][m][e >> 2][e & 3] *= (1.0f + __expf(-b8[e])) * __builtin_amdgcn_rcpf(1.0f + __expf(-a8[e])); } }
            return true;
        }
#pragma unroll
        for (int ai = 0; ai < 2; ++ai)
#pragma unroll
            for (int m = 0; m < 4; ++m) { const size_t row = (size_t)(row0 + ai * HALF + m * 16);
#pragma unroll
                for (int bj = 0; bj < 2; ++bj) { const int col = col0 + bj * HALF; const pu4 gz = *(const pu4*)(z + row * INC + ZG + 1024 + col); const pf4 v0 = acc[ai][bj][m][0], v1 = acc[ai][bj][m][1];
                    pu4 w;
                    w.x = cvt_pk_bf16(sigm(bflo(gz.x)) * v0[0], sigm(bfhi(gz.x)) * v0[1]); w.y = cvt_pk_bf16(sigm(bflo(gz.y)) * v0[2], sigm(bfhi(gz.y)) * v0[3]);
                    w.z = cvt_pk_bf16(sigm(bflo(gz.z)) * v1[0], sigm(bfhi(gz.z)) * v1[1]); w.w = cvt_pk_bf16(sigm(bflo(gz.w)) * v1[2], sigm(bfhi(gz.w)) * v1[3]);
                    *(pu4*)(mrg + row * DM + col) = w; } }
        return false;
    }
};
struct EpiOut {
    static constexpr bool PERM = true, AFTER_DRAIN = false, CHAIN = false;
    const float* x; const float* mod; bf16* x1;
    __device__ __forceinline__ void operator()(const pf4 (&acc)[2][2][4][2], const Unit& u, int wr, int wc, int fr, int fq) const {
        const int row0 = u.pm * BM + wr * 64 + fr, col0 = u.pn * BM + wc * 32 + 8 * fq; const int b = u.pm >> 3;
        pf4 gt[2][2];
#pragma unroll
        for (int bj = 0; bj < 2; ++bj)
#pragma unroll
            for (int n = 0; n < 2; ++n) gt[bj][n] = *(const pf4*)(mod + b * 6144 + 2048 + col0 + bj * HALF + n * 4);
#pragma unroll
        for (int ai = 0; ai < 2; ++ai)
#pragma unroll
            for (int m = 0; m < 4; ++m) { const size_t off = (size_t)(row0 + ai * HALF + m * 16) * DM + col0;
#pragma unroll
                for (int bj = 0; bj < 2; ++bj) { const pf4 x0 = *(const pf4*)(x + off + bj * HALF), x1v = *(const pf4*)(x + off + bj * HALF + 4);
                    const pf4 o0 = x0 + gt[bj][0] * acc[ai][bj][m][0], o1 = x1v + gt[bj][1] * acc[ai][bj][m][1]; pu4 w;
                    w.x = cvt_pk_bf16(o0[0], o0[1]); w.y = cvt_pk_bf16(o0[2], o0[3]); w.z = cvt_pk_bf16(o1[0], o1[1]); w.w = cvt_pk_bf16(o1[2], o1[3]);
                    *(pu4*)(x1 + off + bj * HALF) = w; } }
    }
};
struct EpiUp {
    static constexpr bool PERM = true, AFTER_DRAIN = false, CHAIN = false;
    bf16* hid;
    __device__ __forceinline__ void operator()(const pf4 (&acc)[2][2][4][2], const Unit& u, int wr, int wc, int fr, int fq) const {
        const int row0 = u.pm * BM + wr * 64 + fr, col0 = u.pn * 128 + wc * 32 + 8 * fq;
#pragma unroll
        for (int ai = 0; ai < 2; ++ai)
#pragma unroll
            for (int m = 0; m < 4; ++m) { const size_t row = (size_t)(row0 + ai * HALF + m * 16); float o[8];
#pragma unroll
                for (int n = 0; n < 2; ++n)
#pragma unroll
                    for (int e = 0; e < 4; ++e) { const float g = acc[ai][0][m][n][e], l = acc[ai][1][m][n][e]; o[4 * n + e] = g * sigm(g) * l; }
                pu4 w; w.x = cvt_pk_bf16(o[0], o[1]); w.y = cvt_pk_bf16(o[2], o[3]); w.z = cvt_pk_bf16(o[4], o[5]); w.w = cvt_pk_bf16(o[6], o[7]);
                *(pu4*)(hid + row * DEXP + col0) = w; }
    }
};

struct GemmArgs { unsigned char* ws; const float* x; float* out; };
template <class Epi> __device__ __forceinline__ void run_dense(const void* A, const void* Bt, int M, int N, int K, const Epi& E, unsigned char* lds, int wv) {
    pg8::Gemm g{K}; pg8::StaticOrder S; S.init(A, Bt, M, N, K, (int)gridDim.x, (int)blockIdx.x);
    pg8::gemm_phase<Epi, pg8::StaticOrder, true, true>((PG8_LAS unsigned char*)lds, g, S, E, wv);
}
__device__ __forceinline__ void p_gemm_in(const GemmArgs& a, unsigned char* lds, int wv) {
    EpiStoreBf16 E{(bf16*)(a.ws + WS_Z), INC};
    run_dense(a.ws + WS_H, a.ws + WS_WIN, NT, INC, 1024, E, lds, wv);
}
struct PairOrder {
    int nM, nN, nwg, G, c; const char *A0, *A1, *B0, *B1; size_t tstep;
    __device__ bool next(int i, Unit& u) const {
        const long L = (long)(i >> 1) * G + c; if (L >= nwg) return false;
        int wgid = (int)L; { const int q = nwg / pg8::NXCD, r = nwg % pg8::NXCD, xcd = wgid % pg8::NXCD, off = wgid / pg8::NXCD; wgid = (xcd < r ? xcd * (q + 1) : r * (q + 1) + (xcd - r) * q) + off; }
        const int nig = pg8::WGM * nN, gid = wgid / nig, fm = gid * pg8::WGM, gsz = (nM - fm) < pg8::WGM ? (nM - fm) : pg8::WGM;
        u.pm = fm + ((wgid % nig) % gsz); u.pn = (wgid % nig) / gsz; u.aux = i & 1;
        u.a = ((i & 1) ? A1 : A0) + (size_t)u.pm * tstep; u.b = ((i & 1) ? B1 : B0) + (size_t)u.pn * tstep; return true;
    }
    __device__ __forceinline__ void a_ready(const Unit&) const {}
    __device__ __forceinline__ void done(const Unit&) const {}
};
__device__ __forceinline__ void p_gemm_merge(const GemmArgs& a, unsigned char* lds, int wv) {
    PairOrder S{NT / 256, 4, (NT / 256) * 4, (int)gridDim.x, (int)blockIdx.x, (const char*)(a.ws + WS_YA), (const char*)(a.ws + WS_YB), (const char*)(a.ws + WS_WBA), (const char*)(a.ws + WS_WBB), (size_t)256 * 512 * 2};
    EpiMerge E{(const bf16*)(a.ws + WS_Z), (bf16*)(a.ws + WS_MRG)}; pg8::Gemm g{512};
    pg8::gemm_phase<EpiMerge, PairOrder, true, true>((PG8_LAS unsigned char*)lds, g, S, E, wv);
}
__device__ __forceinline__ void p_gemm_out(const GemmArgs& a, unsigned char* lds, int wv) {
    EpiOut E{a.x, (const float*)(a.ws + WS_MOD), (bf16*)(a.ws + WS_X1B)};
    run_dense(a.ws + WS_MRG, a.ws + WS_WOUT, NT, 1024, 1024, E, lds, wv);
}
struct GroupedOrder {
    const int* texp; int nT, nN, G, c; const char* A; size_t a_tile; const char* B; size_t b_exp, b_tile;
    __device__ bool next(int i, Unit& u) const {
        const long L = (long)i * G + c; if (L >= (long)nT * nN) return false;
        const int tile = (int)(L / nN), pn = (int)(L % nN); u.aux = 0; u.pm = tile; u.pn = pn; u.a = A + (size_t)tile * a_tile; u.b = B + (size_t)texp[tile] * b_exp + (size_t)pn * b_tile; return true;
    }
    __device__ __forceinline__ void a_ready(const Unit&) const {}
    __device__ __forceinline__ void done(const Unit&) const {}
};
__device__ __forceinline__ void p_gemm_up(const GemmArgs& a, unsigned char* lds, int wv) {
    const int* ctl = (const int*)(a.ws + WS_CTL);
    GroupedOrder S{ctl + CW_TEXP, ctl[CW_NT], 4, (int)gridDim.x, (int)blockIdx.x, (const char*)(a.ws + WS_XS), (size_t)256 * 1024 * 2, (const char*)(a.ws + WS_WUP), (size_t)1024 * 1024 * 2, (size_t)256 * 1024 * 2};
    EpiUp E{(bf16*)(a.ws + WS_HID)}; pg8::Gemm g{1024};
    pg8::gemm_phase<EpiUp, GroupedOrder, true, true>((PG8_LAS unsigned char*)lds, g, S, E, wv);
}
__device__ __forceinline__ void p_gemm_down(const GemmArgs& a, unsigned char* lds, int wv) {
    const int* ctl = (const int*)(a.ws + WS_CTL);
    GroupedOrder S{ctl + CW_TEXP, ctl[CW_NT], 4, (int)gridDim.x, (int)blockIdx.x, (const char*)(a.ws + WS_HID), (size_t)256 * 512 * 2, (const char*)(a.ws + WS_W2T), (size_t)1024 * 512 * 2, (size_t)256 * 512 * 2};
    EpiStoreBf16 E{(bf16*)(a.ws + WS_XS), 1024}; pg8::Gemm g{512};
    pg8::gemm_phase<EpiStoreBf16, GroupedOrder, true, true>((PG8_LAS unsigned char*)lds, g, S, E, wv);
}

__device__ __forceinline__ void load64bf(const bf16* p, float (&v)[64]) {
#pragma unroll
    for (int i = 0; i < 8; ++i) { const v4u w = *(const v4u*)(p + 8 * i);
        v[8 * i + 0] = bflo(w.x); v[8 * i + 1] = bfhi(w.x); v[8 * i + 2] = bflo(w.y); v[8 * i + 3] = bfhi(w.y);
        v[8 * i + 4] = bflo(w.z); v[8 * i + 5] = bfhi(w.z); v[8 * i + 6] = bflo(w.w); v[8 * i + 7] = bfhi(w.w); }
}
__device__ __forceinline__ void store64bf(bf16* p, const float (&v)[64], float sc) {
#pragma unroll
    for (int i = 0; i < 8; ++i) { v4u w; w.x = pk2(v[8 * i] * sc, v[8 * i + 1] * sc); w.y = pk2(v[8 * i + 2] * sc, v[8 * i + 3] * sc); w.z = pk2(v[8 * i + 4] * sc, v[8 * i + 5] * sc); w.w = pk2(v[8 * i + 6] * sc, v[8 * i + 7] * sc);
        *(v4u*)(p + 8 * i) = w; }
}
__device__ __forceinline__ void norm_rope(float (&v)[64], const float* g, const float* cosT, const float* sinT, int s) {
    float ss = 0.f;
#pragma unroll
    for (int d = 0; d < 64; ++d) ss += v[d] * v[d];
    const float rstd = rsqrtf(ss * (1.0f / 64.0f) + 1e-6f);
#pragma unroll
    for (int d = 0; d < 64; ++d) v[d] = v[d] * rstd * g[d];
#pragma unroll
    for (int i = 0; i < 32; ++i) { const float c = cosT[s * 32 + i], sn = sinT[s * 32 + i]; const float x1 = v[i], x2 = v[i + 32]; v[i] = x1 * c - x2 * sn; v[i + 32] = x2 * c + x1 * sn; }
}
__device__ __forceinline__ void p_kprep(const PArgs& a, unsigned char* lds, int wv) {
    float* tile = (float*)lds + (mktid(wv) >> 8) * (256 * 65); float* red = (float*)lds + 2 * 256 * 65;
    const int tid = mktid(wv), half = tid >> 8, t256 = tid & 255;
    const bf16* z = (const bf16*)(a.ws + WS_Z);
    for (int base = blockIdx.x * 2; base < 1024; base += gridDim.x * 2) {
        const int blk = base + half; const bool ok = blk < 1024; const int h = blk & 7, n = (blk >> 3) & 7, b = (blk >> 6) & 15;
        const int s = n * 256 + t256; const size_t t = (size_t)b * SEQ + s;
        float v[64]; load64bf(z + t * INC + ZA + 512 + h * 64, v);
        norm_rope(v, a.in[19], (const float*)(a.ws + WS_COS), (const float*)(a.ws + WS_SIN), s);
        if (ok) store64bf((bf16*)(a.ws + WS_K) + t * 512 + h * 64, v, 1.0f);
#pragma unroll
        for (int d = 0; d < 64; ++d) tile[t256 * 65 + d] = v[d];
        __syncthreads();
        { const int d = t256 & 63, part = t256 >> 6; float sm = 0.f;
#pragma unroll 8
            for (int r = 0; r < 64; ++r) sm += tile[(part * 64 + r) * 65 + d];
            red[(half * 4 + part) * 64 + d] = sm; }
        __syncthreads();
        if (t256 < 64 && ok) { const float* r = red + half * 256; ((float*)(a.ws + WS_KMEAN))[(size_t)((b * 8 + h) * 8 + n) * 64 + t256] = ((r[t256] + r[64 + t256]) + (r[128 + t256] + r[192 + t256])) * (1.0f / 256.0f); }
        __syncthreads();
    }
}
__device__ __forceinline__ void p_qprep(const PArgs& a, unsigned char* lds, int wv) {
    const int tid = mktid(wv), half = tid >> 8, t256 = tid & 255;
    const bf16* z = (const bf16*)(a.ws + WS_Z);
    for (int base = blockIdx.x * 2; base < 1024; base += gridDim.x * 2) {
        const int blk = base + half; if (blk >= 1024) continue;
        const int h = blk & 7, n = (blk >> 3) & 7, b = blk >> 6;
        const int s = n * 256 + t256; const size_t t = (size_t)b * SEQ + s;
        float v[64]; load64bf(z + t * INC + ZA + h * 64, v);
        norm_rope(v, a.in[18], (const float*)(a.ws + WS_COS), (const float*)(a.ws + WS_SIN), s);
        const float* km = (const float*)(a.ws + WS_KMEAN) + (size_t)((b * 8 + h) * 8) * 64;
        float gate[7];
#pragma unroll
        for (int j = 0; j < 7; ++j) { float g = 0.f; if (j < n) {
#pragma unroll
                for (int d = 0; d < 64; ++d) g += v[d] * km[j * 64 + d]; }
            gate[j] = g; }
        unsigned sel = 0;
        if (n <= 3) sel = (1u << n) - 1u;
        else {
#pragma unroll
            for (int rep = 0; rep < 3; ++rep) { float best = -INFINITY; int bi = 0;
#pragma unroll
                for (int j = 0; j < 7; ++j) if (j < n && !((sel >> j) & 1u) && gate[j] > best) { best = gate[j]; bi = j; }
                sel |= 1u << bi; }
        }
        ((unsigned char*)(a.ws + WS_SEL))[(size_t)(b * 8 + h) * SEQ + s] = (unsigned char)sel;
        store64bf((bf16*)(a.ws + WS_Q) + t * 512 + h * 64, v, C2);
    }
}

__device__ __forceinline__ void p_attn(const PArgs& a, unsigned char* lds, int vb, int nvb, int wv) {
    const attn_body::bf16* Q = (const attn_body::bf16*)(a.ws + WS_Q); const attn_body::bf16* K = (const attn_body::bf16*)(a.ws + WS_K);
    const attn_body::bf16* V = (const attn_body::bf16*)(a.ws + WS_Z) + (ZA + 1024); attn_body::bf16* O = (attn_body::bf16*)(a.ws + WS_YB);
    const unsigned char* SEL = (const unsigned char*)(a.ws + WS_SEL);
    for (int p = vb; p < 512; p += nvb)
        for (int which = 0; which < 2; ++which) { const int bh = p >> 2, s = p & 3, qb = which ? 7 - s : s;
            attn_body::attn_unit<8>(bh >> 3, bh & 7, qb, Q, K, V, O, SEL, (char*)lds, wv); }
}

namespace rw {
typedef short bf16x8 __attribute__((ext_vector_type(8)));
constexpr int RS = 72, RSB = RS * 2, MB = 64 * RSB;
constexpr int FS = 68;
enum { I_AT = 0, I_BT, I_AJ, I_BHJ, I_KHJ, I_X5, I_ABRT, I_L, I_LT, I_R0, I_R1, I_KT, I_RT, I_VJ, I_X14, I_GATE, I_VT, NBUF };
constexpr int OFF_F32 = NBUF * MB;
constexpr int OFF_CST = OFF_F32 + (64 * 3 + 512) * 4;
constexpr int LDS_NEED = OFF_CST + 14 * 64 * 4;

__device__ __forceinline__ bf16x8 ldfrag(const unsigned char* M, int row, int k) { return *(const bf16x8*)(M + row * RSB + k * 2); }
__device__ __forceinline__ void mm(f32x4 (&acc)[2], const unsigned char* X, const unsigned char* Y, int mt, int nh, int fr, int fq) {
    const bf16x8 a0 = ldfrag(X, 16 * mt + fr, 8 * fq), a1 = ldfrag(X, 16 * mt + fr, 8 * fq + 32);
#pragma unroll
    for (int nt = 0; nt < 2; ++nt) { const bf16x8 b0 = ldfrag(Y, 16 * (2 * nh + nt) + fr, 8 * fq), b1 = ldfrag(Y, 16 * (2 * nh + nt) + fr, 8 * fq + 32);
        acc[nt] = __builtin_amdgcn_mfma_f32_16x16x32_bf16(a0, b0, acc[nt], 0, 0, 0); acc[nt] = __builtin_amdgcn_mfma_f32_16x16x32_bf16(a1, b1, acc[nt], 0, 0, 0); }
}
__device__ __forceinline__ void storeT(unsigned char* Z, const f32x4 (&acc)[2], int mt, int nh, int fr, int fq) {
#pragma unroll
    for (int nt = 0; nt < 2; ++nt) { v2u w; w.x = pk2(acc[nt][0], acc[nt][1]); w.y = pk2(acc[nt][2], acc[nt][3]); *(v2u*)(Z + (16 * (2 * nh + nt) + fr) * RSB + (16 * mt + 4 * fq) * 2) = w; }
}
__device__ __forceinline__ void storeN(unsigned char* Z, const f32x4 (&acc)[2], int mt, int nh, int fr, int fq) {
#pragma unroll
    for (int nt = 0; nt < 2; ++nt)
#pragma unroll
        for (int r = 0; r < 4; ++r) *(unsigned short*)(Z + (16 * mt + 4 * fq + r) * RSB + (16 * (2 * nh + nt) + fr) * 2) = (unsigned short)f2bf(acc[nt][r]);
}
__device__ __forceinline__ void ld8bf(const unsigned char* p, float (&v)[8]) { const v4u w = *(const v4u*)p; v[0] = bflo(w.x); v[1] = bfhi(w.x); v[2] = bflo(w.y); v[3] = bfhi(w.y); v[4] = bflo(w.z); v[5] = bfhi(w.z); v[6] = bflo(w.w); v[7] = bfhi(w.w); }
__device__ __forceinline__ void st8bf(unsigned char* p, const float (&v)[8]) { v4u w; w.x = pk2(v[0], v[1]); w.y = pk2(v[2], v[3]); w.z = pk2(v[4], v[5]); w.w = pk2(v[6], v[7]); *(v4u*)p = w; }
__device__ __forceinline__ void ld8f(const float* p, float (&v)[8]) { const f32x4 a = *(const f32x4*)p, b = *(const f32x4*)(p + 4); v[0] = a.x; v[1] = a.y; v[2] = a.z; v[3] = a.w; v[4] = b.x; v[5] = b.y; v[6] = b.z; v[7] = b.w; }
__device__ __forceinline__ void un8(const v4u w, float (&v)[8]) { v[0] = bflo(w.x); v[1] = bfhi(w.x); v[2] = bflo(w.y); v[3] = bfhi(w.y); v[4] = bflo(w.z); v[5] = bfhi(w.z); v[6] = bflo(w.w); v[7] = bfhi(w.w); }
__device__ __forceinline__ void shift8(const v4u cw, const v4u pw, bool hasp, const float* mu, float (&v)[8]) {
    float c[8], p[8], m[8]; un8(cw, c); un8(pw, p); ld8f(mu, m);
#pragma unroll
    for (int e = 0; e < 8; ++e) { const float pe = hasp ? p[e] : 0.f; v[e] = c[e] + (pe - c[e]) * m[e]; }
}
__device__ __forceinline__ float tanh_fast(float x) { return 1.0f - 2.0f * __builtin_amdgcn_rcpf(1.0f + __expf(2.0f * x)); }

#define LBAR() do { asm volatile("s_waitcnt lgkmcnt(0)" ::: "memory"); __builtin_amdgcn_s_barrier(); asm volatile("" ::: "memory"); } while (0)
__device__ __forceinline__ void scan_unit(const PArgs& a, unsigned char* lds, int bh, int wv) {
    const int tid = mktid(wv), lane = tid & 63, wid = __builtin_amdgcn_readfirstlane(tid >> 6);
    const int mt = wid >> 1, nh = wid & 1, fr = lane & 15, fq = lane >> 4;
    const int b = bh >> 3, h = bh & 7;
#define BUF(i) (lds + (i) * MB)
    float* GC = (float*)(lds + OFF_F32); float* BON = GC + 64; float* LEND = BON + 64; float* SEGT = LEND + 64;
    float* LWR = (float*)BUF(I_AT); float* LAR = (float*)BUF(I_AJ); float* LGR = (float*)BUF(I_L); float* LW = (float*)BUF(I_R0); float* YTF = (float*)BUF(I_L);
    unsigned char* ACTW = BUF(I_L); unsigned char* ACTA = BUF(I_LT); unsigned char* ACTG = BUF(I_R0);
    const bf16* z = (const bf16*)(a.ws + WS_Z); bf16* ya = (bf16*)(a.ws + WS_YA);
    const float* mu = a.in[7];
    bf16x8 fw[2], fa[2], fg[4];
    { const bf16* wlt = (const bf16*)(a.ws + WS_WLT) + (size_t)h * 4096 + (16 * mt + fr) * 64 + 8 * fq; const bf16* wat = (const bf16*)(a.ws + WS_WAT) + (size_t)h * 4096 + (16 * mt + fr) * 64 + 8 * fq;
      const bf16* wgt = (const bf16*)(a.ws + WS_WGT) + (size_t)h * 8192 + (16 * mt + fr) * 128 + 8 * fq;
      fw[0] = *(const bf16x8*)wlt; fw[1] = *(const bf16x8*)(wlt + 32); fa[0] = *(const bf16x8*)wat; fa[1] = *(const bf16x8*)(wat + 32);
#pragma unroll
      for (int ks = 0; ks < 4; ++ks) fg[ks] = *(const bf16x8*)(wgt + 32 * ks); }
    float* CST = (float*)(lds + OFF_CST);
    for (int i = tid; i < 14 * 64; i += 512) { const int blk = i >> 6, jj = i & 63; float v;
        if (blk < 3) v = mu[blk * 512 + h * 64 + jj]; else if (blk < 7) v = mu[1536 + (blk - 3) * 64 + jj]; else v = a.in[blk == 7 ? 8 : blk == 8 ? 10 : blk == 9 ? 13 : blk == 10 ? 14 : blk == 11 ? 15 : blk == 12 ? 16 : 17][h * 64 + jj];
        CST[i] = v; }
    int s0i = I_X14, aki = I_X5;
    for (int i = tid; i < MB / 4; i += 512) ((unsigned*)BUF(I_X14))[i] = 0u;
    LBAR();
    const int pt = tid >> 3, pg = tid & 7, j0 = 8 * pg;
    const int colh = h * 64 + j0;
    const int zoff0 = colh, zoff1 = 512 + colh, zoff2 = 1024 + colh, zoff3 = 1536 + j0, zoff4 = 1600 + j0, zoff5 = 1664 + j0, zoff6 = 1728 + j0;
    v4u zc[7], zq[7];
#define ZLOAD(cc) do { const bf16* zr_ = z + ((size_t)b * SEQ + (cc) * 64 + pt) * INC; const bf16* zs_ = ((cc) * 64 + pt) > 0 ? zr_ - INC : zr_; \
        zc[0] = *(const v4u*)(zr_ + zoff0); zc[1] = *(const v4u*)(zr_ + zoff1); zc[2] = *(const v4u*)(zr_ + zoff2); zc[3] = *(const v4u*)(zr_ + zoff3); zc[4] = *(const v4u*)(zr_ + zoff4); zc[5] = *(const v4u*)(zr_ + zoff5); zc[6] = *(const v4u*)(zr_ + zoff6); \
        zq[0] = *(const v4u*)(zs_ + zoff0); zq[1] = *(const v4u*)(zs_ + zoff1); zq[2] = *(const v4u*)(zs_ + zoff2); zq[3] = *(const v4u*)(zs_ + zoff3); zq[4] = *(const v4u*)(zs_ + zoff4); zq[5] = *(const v4u*)(zs_ + zoff5); zq[6] = *(const v4u*)(zs_ + zoff6); } while (0)
    ZLOAD(0);
    for (int c = 0; c < SEQ / 64; ++c) {
        const int s = c * 64 + pt; const size_t t = (size_t)b * SEQ + s; const bool hasp = s > 0;
        { float v[8];
          shift8(zc[0], zq[0], hasp, CST + 0 * 64 + j0, v); st8bf(BUF(I_RT) + pt * RSB + j0 * 2, v);
          shift8(zc[1], zq[1], hasp, CST + 1 * 64 + j0, v); st8bf(BUF(I_KT) + pt * RSB + j0 * 2, v);
          shift8(zc[2], zq[2], hasp, CST + 2 * 64 + j0, v); st8bf(BUF(I_VT) + pt * RSB + j0 * 2, v);
#pragma unroll
          for (int e = 0; e < 8; ++e) *(unsigned short*)(BUF(I_VJ) + (j0 + e) * RSB + pt * 2) = (unsigned short)f2bf(v[e]);
          shift8(zc[3], zq[3], hasp, CST + 3 * 64 + j0, v);
#pragma unroll
          for (int e = 0; e < 8; ++e) v[e] = tanh_fast(v[e]);
          st8bf(ACTW + pt * RSB + j0 * 2, v);
          shift8(zc[4], zq[4], hasp, CST + 4 * 64 + j0, v); st8bf(ACTA + pt * RSB + j0 * 2, v);
          shift8(zc[5], zq[5], hasp, CST + 5 * 64 + j0, v);
#pragma unroll
          for (int e = 0; e < 8; ++e) v[e] = sigm(v[e]);
          st8bf(ACTG + pt * 272 + j0 * 2, v);
          shift8(zc[6], zq[6], hasp, CST + 6 * 64 + j0, v);
#pragma unroll
          for (int e = 0; e < 8; ++e) v[e] = sigm(v[e]);
          st8bf(ACTG + pt * 272 + (64 + j0) * 2, v); }
        LBAR();
        f32x4 aw[2], aa[2], ag[2];
#pragma unroll
        for (int nt = 0; nt < 2; ++nt) { const int tr = 16 * (2 * nh + nt) + fr; const f32x4 zero = {0.f, 0.f, 0.f, 0.f};
            aw[nt] = __builtin_amdgcn_mfma_f32_16x16x32_bf16(fw[0], ldfrag(ACTW, tr, 8 * fq), zero, 0, 0, 0); aw[nt] = __builtin_amdgcn_mfma_f32_16x16x32_bf16(fw[1], ldfrag(ACTW, tr, 8 * fq + 32), aw[nt], 0, 0, 0);
            aa[nt] = __builtin_amdgcn_mfma_f32_16x16x32_bf16(fa[0], ldfrag(ACTA, tr, 8 * fq), zero, 0, 0, 0); aa[nt] = __builtin_amdgcn_mfma_f32_16x16x32_bf16(fa[1], ldfrag(ACTA, tr, 8 * fq + 32), aa[nt], 0, 0, 0);
            ag[nt] = zero;
#pragma unroll
            for (int ks = 0; ks < 4; ++ks) ag[nt] = __builtin_amdgcn_mfma_f32_16x16x32_bf16(fg[ks], *(const bf16x8*)(ACTG + tr * 272 + (8 * fq + 32 * ks) * 2), ag[nt], 0, 0, 0); }
        LBAR();
#pragma unroll
        for (int nt = 0; nt < 2; ++nt) { const int tr = 16 * (2 * nh + nt) + fr, jc = 16 * mt + 4 * fq;
            *(f32x4*)(LWR + tr * FS + jc) = aw[nt]; *(f32x4*)(LAR + tr * FS + jc) = aa[nt]; *(f32x4*)(LGR + tr * FS + jc) = ag[nt]; }
        LBAR();
        float lwv[8], an[8], bb[8], k2[8], rr[8], gg[8];
        { float lw8[8], la8[8], kx[8], w0v[8], a0v[8], kkc[8], kac[8], rkc[8];
          ld8f(LWR + pt * FS + j0, lw8); ld8f(LAR + pt * FS + j0, la8); ld8f(LGR + pt * FS + j0, gg);
          ld8bf(BUF(I_RT) + pt * RSB + j0 * 2, rr); ld8bf(BUF(I_KT) + pt * RSB + j0 * 2, kx);
          ld8f(CST + 7 * 64 + j0, w0v); ld8f(CST + 8 * 64 + j0, a0v); ld8f(CST + 9 * 64 + j0, kkc); ld8f(CST + 10 * 64 + j0, kac); ld8f(CST + 11 * 64 + j0, rkc);
          float ss = 0.f, bon = 0.f, av[8];
#pragma unroll
          for (int e = 0; e < 8; ++e) { lwv[e] = -0.606531f * sigm(w0v[e] + lw8[e]); av[e] = sigm(a0v[e] + la8[e]); an[e] = kx[e] * kkc[e]; ss += an[e] * an[e];
              k2[e] = kx[e] * (1.0f + (av[e] - 1.0f) * kac[e]); bon += rr[e] * k2[e] * rkc[e]; }
          ss = red8(ss); bon = red8(bon);
          const float inv = rsqrtf(fmaxf(ss, 1e-24f));
#pragma unroll
          for (int e = 0; e < 8; ++e) { const float kn = an[e] * inv; an[e] = -kn; bb[e] = kn * av[e]; }
          *(f32x4*)(LW + pt * FS + j0) = (f32x4){lwv[0], lwv[1], lwv[2], lwv[3]}; *(f32x4*)(LW + pt * FS + j0 + 4) = (f32x4){lwv[4], lwv[5], lwv[6], lwv[7]};
          if (pg == 0) BON[pt] = bon; }
        LBAR();
        { const int j = tid & 63, sg = tid >> 6; float run = 0.f;
#pragma unroll
          for (int u = 0; u < 8; ++u) { run += LW[(8 * sg + u) * FS + j]; LW[(8 * sg + u) * FS + j] = run; }
          SEGT[sg * 64 + j] = run; }
        LBAR();
        if (tid < 64) { float run = 0.f;
#pragma unroll
            for (int sg = 0; sg < 8; ++sg) { const float tmp = SEGT[sg * 64 + tid]; SEGT[sg * 64 + tid] = run; run += tmp; }
            LEND[tid] = run; GC[tid] = __expf(run); }
        LBAR();
        { float Lc[8], sgp[8], le[8], o0[8], o1[8], o2[8], o3[8];
          ld8f(LW + pt * FS + j0, Lc); ld8f(SEGT + (pt >> 3) * 64 + j0, sgp); ld8f(LEND + j0, le);
#pragma unroll
          for (int e = 0; e < 8; ++e) { const float L = Lc[e] + sgp[e]; const float e1 = __expf(L), ie1 = __expf(-L), ep = __expf(L - lwv[e]), eh = __expf(le[e] - L);
              o0[e] = an[e] * ep; o1[e] = bb[e] * ie1; o2[e] = k2[e] * ie1; o3[e] = rr[e] * e1; Lc[e] = bb[e] * eh; sgp[e] = k2[e] * eh; }
          st8bf(BUF(I_AT) + pt * RSB + j0 * 2, o0); st8bf(BUF(I_BT) + pt * RSB + j0 * 2, o1); st8bf(BUF(I_KT) + pt * RSB + j0 * 2, o2); st8bf(BUF(I_RT) + pt * RSB + j0 * 2, o3);
          st8bf(BUF(I_GATE) + pt * RSB + j0 * 2, gg);
#pragma unroll
          for (int e = 0; e < 8; ++e) { *(unsigned short*)(BUF(I_AJ) + (j0 + e) * RSB + pt * 2) = (unsigned short)f2bf(o0[e]); *(unsigned short*)(BUF(I_BHJ) + (j0 + e) * RSB + pt * 2) = (unsigned short)f2bf(Lc[e]);
              *(unsigned short*)(BUF(I_KHJ) + (j0 + e) * RSB + pt * 2) = (unsigned short)f2bf(sgp[e]); } }
        if (c + 1 < SEQ / 64) ZLOAD(c + 1);
        LBAR();
        { const f32x4 zero = {0.f, 0.f, 0.f, 0.f}; f32x4 acc[2] = {zero, zero};
          mm(acc, BUF(I_AT), BUF(I_BT), mt, nh, fr, fq);
#pragma unroll
          for (int nt = 0; nt < 2; ++nt)
#pragma unroll
              for (int r = 0; r < 4; ++r) { const int m = 16 * mt + 4 * fq + r, n = 16 * (2 * nh + nt) + fr; if (!(m > n)) acc[nt][r] = 0.f; }
          storeN(BUF(I_L), acc, mt, nh, fr, fq); storeT(BUF(I_LT), acc, mt, nh, fr, fq);
#pragma unroll
          for (int nt = 0; nt < 2; ++nt)
#pragma unroll
              for (int r = 0; r < 4; ++r) { const int m = 16 * mt + 4 * fq + r, n = 16 * (2 * nh + nt) + fr; if (m == n) acc[nt][r] = 1.0f; }
          storeN(BUF(I_R0), acc, mt, nh, fr, fq);
          acc[0] = zero; acc[1] = zero; mm(acc, BUF(I_AT), BUF(I_KT), mt, nh, fr, fq);
#pragma unroll
          for (int nt = 0; nt < 2; ++nt)
#pragma unroll
              for (int r = 0; r < 4; ++r) { const int m = 16 * mt + 4 * fq + r, n = 16 * (2 * nh + nt) + fr; if (!(n < m)) acc[nt][r] = 0.f; }
          storeT(BUF(aki), acc, mt, nh, fr, fq);
          acc[0] = zero; acc[1] = zero; mm(acc, BUF(I_BT), BUF(I_RT), mt, nh, fr, fq);
#pragma unroll
          for (int nt = 0; nt < 2; ++nt)
#pragma unroll
              for (int r = 0; r < 4; ++r) { const int m = 16 * mt + 4 * fq + r, n = 16 * (2 * nh + nt) + fr; if (!(m <= n)) acc[nt][r] = 0.f; }
          storeT(BUF(I_ABRT), acc, mt, nh, fr, fq); }
        LBAR();
#pragma unroll
        for (int k = 1; k <= 6; ++k) {
            unsigned char* Pc = (k & 1) ? BUF(I_L) : BUF(I_AT); unsigned char* PTc = (k & 1) ? BUF(I_LT) : BUF(I_BT);
            unsigned char* Pn = (k & 1) ? BUF(I_AT) : BUF(I_L); unsigned char* PTn = (k & 1) ? BUF(I_BT) : BUF(I_LT);
            unsigned char* Rc = (k & 1) ? BUF(I_R1) : BUF(I_R0); unsigned char* Rn = (k & 1) ? BUF(I_R0) : BUF(I_R1);
            const f32x4 zero = {0.f, 0.f, 0.f, 0.f};
            if (k <= 5) { f32x4 acc[2] = {zero, zero}; mm(acc, Pc, PTc, mt, nh, fr, fq); storeN(Pn, acc, mt, nh, fr, fq); storeT(PTn, acc, mt, nh, fr, fq); }
            if (k >= 2) { f32x4 acc[2];
#pragma unroll
                for (int nt = 0; nt < 2; ++nt) { const v2u w = *(const v2u*)(Rc + (16 * (2 * nh + nt) + fr) * RSB + (16 * mt + 4 * fq) * 2); acc[nt] = (f32x4){bflo(w.x), bfhi(w.x), bflo(w.y), bfhi(w.y)}; }
                mm(acc, PTc, Rc, mt, nh, fr, fq); storeT(Rn, acc, mt, nh, fr, fq); }
            LBAR();
        }
        { const f32x4 zero = {0.f, 0.f, 0.f, 0.f}; f32x4 acc[2] = {zero, zero};
          mm(acc, BUF(I_R1), BUF(I_AJ), mt, nh, fr, fq); storeT(BUF(I_L), acc, mt, nh, fr, fq);
          acc[0] = zero; acc[1] = zero; mm(acc, BUF(I_R1), BUF(aki), mt, nh, fr, fq); storeT(BUF(I_LT), acc, mt, nh, fr, fq); }
        LBAR();
        { const f32x4 zero = {0.f, 0.f, 0.f, 0.f}; f32x4 acc[2];
#pragma unroll
          for (int nt = 0; nt < 2; ++nt) { const v2u w = *(const v2u*)(BUF(I_RT) + (16 * (2 * nh + nt) + fr) * RSB + (16 * mt + 4 * fq) * 2); acc[nt] = (f32x4){bflo(w.x), bfhi(w.x), bflo(w.y), bfhi(w.y)}; }
          mm(acc, BUF(I_L), BUF(I_ABRT), mt, nh, fr, fq); storeT(BUF(I_AT), acc, mt, nh, fr, fq);
          acc[0] = zero; acc[1] = zero; mm(acc, BUF(I_KT), BUF(I_RT), mt, nh, fr, fq);
#pragma unroll
          for (int nt = 0; nt < 2; ++nt)
#pragma unroll
              for (int r = 0; r < 4; ++r) { const int m = 16 * mt + 4 * fq + r, n = 16 * (2 * nh + nt) + fr; if (!(m <= n)) acc[nt][r] = 0.f; }
          mm(acc, BUF(I_LT), BUF(I_ABRT), mt, nh, fr, fq); storeT(BUF(I_BT), acc, mt, nh, fr, fq);
          acc[0] = zero; acc[1] = zero; mm(acc, BUF(I_L), BUF(I_BHJ), mt, nh, fr, fq);
#pragma unroll
          for (int nt = 0; nt < 2; ++nt)
#pragma unroll
              for (int r = 0; r < 4; ++r) { const int m = 16 * mt + 4 * fq + r, n = 16 * (2 * nh + nt) + fr; if (m == n) acc[nt][r] += GC[m]; }
          storeT(BUF(I_AJ), acc, mt, nh, fr, fq);
#pragma unroll
          for (int nt = 0; nt < 2; ++nt) { const v2u w = *(const v2u*)(BUF(I_KHJ) + (16 * (2 * nh + nt) + fr) * RSB + (16 * mt + 4 * fq) * 2); acc[nt] = (f32x4){bflo(w.x), bfhi(w.x), bflo(w.y), bfhi(w.y)}; }
          mm(acc, BUF(I_LT), BUF(I_BHJ), mt, nh, fr, fq); storeT(BUF(I_R0), acc, mt, nh, fr, fq); }
        LBAR();
        { const f32x4 zero = {0.f, 0.f, 0.f, 0.f}; f32x4 acc[2] = {zero, zero};
          mm(acc, BUF(s0i), BUF(I_AT), mt, nh, fr, fq); mm(acc, BUF(I_VJ), BUF(I_BT), mt, nh, fr, fq);
#pragma unroll
          for (int nt = 0; nt < 2; ++nt) *(f32x4*)(YTF + (16 * (2 * nh + nt) + fr) * FS + 16 * mt + 4 * fq) = acc[nt];
          acc[0] = zero; acc[1] = zero; mm(acc, BUF(I_AJ), BUF(s0i), mt, nh, fr, fq); mm(acc, BUF(I_R0), BUF(I_VJ), mt, nh, fr, fq);
          storeT(BUF(aki), acc, mt, nh, fr, fq); }
        LBAR();
        { float y[8], vv[8], g8[8], lg[8], lb[8]; ld8f(YTF + pt * FS + j0, y); ld8bf(BUF(I_VT) + pt * RSB + j0 * 2, vv); ld8bf(BUF(I_GATE) + pt * RSB + j0 * 2, g8);
          ld8f(CST + 12 * 64 + j0, lg); ld8f(CST + 13 * 64 + j0, lb);
          float sm = 0.f;
#pragma unroll
          for (int e = 0; e < 8; ++e) sm += y[e];
          const float mean = red8(sm) * (1.0f / 64.0f); float sq = 0.f;
#pragma unroll
          for (int e = 0; e < 8; ++e) { y[e] -= mean; sq += y[e] * y[e]; }
          const float rstd = rsqrtf(red8(sq) * (1.0f / 64.0f) + 64e-5f), bon = BON[pt];
#pragma unroll
          for (int e = 0; e < 8; ++e) y[e] = (y[e] * rstd * lg[e] + lb[e] + bon * vv[e]) * g8[e];
          st8bf((unsigned char*)(ya + t * RWW + colh), y); }
        { const int tmp = s0i; s0i = aki; aki = tmp; }
        LBAR();
    }
#undef BUF
#undef ZLOAD
}
#undef LBAR
}

__device__ __forceinline__ void p_norm2_route(const PArgs& a, unsigned char* lds, int wv) {
    typedef short bf16x8 __attribute__((ext_vector_type(8)));
    const int tid = mktid(wv), lane = tid & 63, fr = lane & 15, fq = lane >> 4;
    const bf16* x1 = (const bf16*)(a.ws + WS_X1B); const float* g = a.in[5]; const float* mod = (const float*)(a.ws + WS_MOD);
    const bf16* wrh = (const bf16*)(a.ws + WS_WRH); const bf16* wrl = (const bf16*)(a.ws + WS_WRL); const float* brg = a.in[24]; const float* bre = a.in[26];
    bf16* h2 = (bf16*)(a.ws + WS_H2);
    int* rte = (int*)(a.ws + WS_RTE); float* rtw = (float*)(a.ws + WS_RTW); int* rnk = (int*)(a.ws + WS_RNK); unsigned* cnt = (unsigned*)(a.ws + WS_CTL) + CW_CNT;
    float* LG = (float*)lds + wv * (16 * 48);
    for (int grp = blockIdx.x * 8 + wv; grp < NT / 16; grp += gridDim.x * 8) {
        const int row = grp * 16 + fr, b = row >> 11;
        const bf16* xr = x1 + (size_t)row * DM + 8 * fq; const float* gp = g + 8 * fq; const float* scp = mod + b * 6144 + 4096 + 8 * fq; const float* shp = mod + b * 6144 + 3072 + 8 * fq;
        float ss = 0.f;
#pragma unroll 8
        for (int ks = 0; ks < 32; ++ks) { float v[8]; rw::ld8bf((const unsigned char*)(xr + 32 * ks), v);
            ss += (v[0] * v[0] + v[1] * v[1]) + (v[2] * v[2] + v[3] * v[3]) + (v[4] * v[4] + v[5] * v[5]) + (v[6] * v[6] + v[7] * v[7]); }
        ss += __builtin_bit_cast(float, __builtin_amdgcn_ds_swizzle(__builtin_bit_cast(int, ss), 0x401F));
        { const unsigned u = __builtin_bit_cast(unsigned, ss); auto rr = __builtin_amdgcn_permlane32_swap(u, u, false, false); ss = __builtin_bit_cast(float, (unsigned)rr[0]) + __builtin_bit_cast(float, (unsigned)rr[1]); }
        const float rstd = rsqrtf(ss * (1.0f / DM) + 1e-6f);
        f32x4 acc[3]; acc[0] = (f32x4){0.f, 0.f, 0.f, 0.f}; acc[1] = acc[0]; acc[2] = acc[0];
        bf16* hrow = h2 + (size_t)row * DM + 8 * fq; const bf16* wh = wrh + fr * 1024 + 8 * fq; const bf16* wl = wrl + fr * 1024 + 8 * fq;
#pragma unroll 2
        for (int ks = 0; ks < 32; ++ks) {
            float v[8], gg[8], sc[8], sh[8]; rw::ld8bf((const unsigned char*)(xr + 32 * ks), v); rw::ld8f(gp + 32 * ks, gg); rw::ld8f(scp + 32 * ks, sc); rw::ld8f(shp + 32 * ks, sh);
            unsigned hw[4], lw[4];
#pragma unroll
            for (int e = 0; e < 4; ++e) { const float h0 = v[2 * e] * rstd * gg[2 * e] * (sc[2 * e] + 1.0f) + sh[2 * e], h1 = v[2 * e + 1] * rstd * gg[2 * e + 1] * (sc[2 * e + 1] + 1.0f) + sh[2 * e + 1];
                hw[e] = pk2(h0, h1); lw[e] = pk2(h0 - bflo(hw[e]), h1 - bfhi(hw[e])); }
            const v4u hv = {hw[0], hw[1], hw[2], hw[3]}, lv = {lw[0], lw[1], lw[2], lw[3]};
            *(v4u*)(hrow + 32 * ks) = hv;
            const bf16x8 ah = __builtin_bit_cast(bf16x8, hv), al = __builtin_bit_cast(bf16x8, lv);
#pragma unroll
            for (int nt = 0; nt < 3; ++nt) { const bf16x8 bh = *(const bf16x8*)(wh + nt * 16 * 1024 + 32 * ks), bl = *(const bf16x8*)(wl + nt * 16 * 1024 + 32 * ks);
                acc[nt] = __builtin_amdgcn_mfma_f32_16x16x32_bf16(ah, bh, acc[nt], 0, 0, 0); acc[nt] = __builtin_amdgcn_mfma_f32_16x16x32_bf16(ah, bl, acc[nt], 0, 0, 0); acc[nt] = __builtin_amdgcn_mfma_f32_16x16x32_bf16(al, bh, acc[nt], 0, 0, 0); }
        }
#pragma unroll
        for (int nt = 0; nt < 3; ++nt)
#pragma unroll
            for (int r = 0; r < 4; ++r) LG[(4 * fq + r) * 48 + 16 * nt + fr] = acc[nt][r];
        asm volatile("s_waitcnt lgkmcnt(0)" ::: "memory");
        if (lane < 16) { const int m = grp * 16 + lane; const float* lg = LG + lane * 48;
            float gl4[4];
#pragma unroll
            for (int i = 0; i < 4; ++i) gl4[i] = lg[i] + brg[i];
            int gi = 0; float gm = gl4[0];
#pragma unroll
            for (int i = 1; i < 4; ++i) if (gl4[i] > gm) { gm = gl4[i]; gi = i; }
            float gs = 0.f;
#pragma unroll
            for (int i = 0; i < 4; ++i) gs += __expf(gl4[i] - gm);
            const float pg = 1.0f / gs;
            float el[8];
#pragma unroll
            for (int k = 0; k < 8; ++k) el[k] = lg[4 + gi * 8 + k] + bre[gi * 8 + k];
            int e1 = 0; float m1 = el[0];
#pragma unroll
            for (int k = 1; k < 8; ++k) if (el[k] > m1) { m1 = el[k]; e1 = k; }
            int e2 = -1; float m2 = -INFINITY;
#pragma unroll
            for (int k = 0; k < 8; ++k) if (k != e1 && el[k] > m2) { m2 = el[k]; e2 = k; }
            const float q2 = __expf(m2 - m1); const float w1 = pg / (1.0f + q2), w2 = pg * q2 / (1.0f + q2);
            const int ea = gi * 8 + e1, eb = gi * 8 + e2; rte[2 * m] = ea; rte[2 * m + 1] = eb; rtw[2 * m] = w1; rtw[2 * m + 1] = w2;
            rnk[2 * m] = (int)atomicAdd(cnt + ea, 1u); rnk[2 * m + 1] = (int)atomicAdd(cnt + eb, 1u); }
        asm volatile("s_waitcnt lgkmcnt(0)" ::: "memory");
    }
}
__device__ __forceinline__ void p_moe_gather(const PArgs& a, unsigned char* lds, int wv) {
    int* off = (int*)lds;
    const int tid = mktid(wv), lane = tid & 63, gw = blockIdx.x * 8 + (tid >> 6), NGW = gridDim.x * 8;
    int* ctl = (int*)(a.ws + WS_CTL); const unsigned* cnt = (const unsigned*)ctl + CW_CNT;
    if (tid == 0) { int o = 0, nt = 0;
        for (int e = 0; e < NEXP; ++e) { off[e] = o; const int tiles = ((int)cnt[e] + 255) >> 8;
            if (blockIdx.x == 0) for (int i = 0; i < tiles; ++i) ctl[CW_TEXP + nt + i] = e;
            nt += tiles; o += tiles * 256; }
        if (blockIdx.x == 0) ctl[CW_NT] = nt; }
    __syncthreads();
    const int* rte = (const int*)(a.ws + WS_RTE); const int* rnk = (const int*)(a.ws + WS_RNK); int* pos = (int*)(a.ws + WS_POS);
    const bf16* h2 = (const bf16*)(a.ws + WS_H2); bf16* xs = (bf16*)(a.ws + WS_XS);
    for (int i = gw; i < 2 * NT; i += NGW) { const int p = off[rte[i]] + rnk[i]; if (lane == 0) pos[i] = p;
        const v4u* src = (const v4u*)(h2 + (size_t)(i >> 1) * DM) + lane; v4u* dst = (v4u*)(xs + (size_t)p * DM) + lane;
        dst[0] = src[0]; dst[64] = src[64]; }
}
__device__ __forceinline__ void p_combine(const PArgs& a, unsigned char* lds, int wv) {
    const int tid = mktid(wv), lane = tid & 63, gw = blockIdx.x * 8 + (tid >> 6), NGW = gridDim.x * 8;
    const float* mod = (const float*)(a.ws + WS_MOD); const int* pos = (const int*)(a.ws + WS_POS); const float* rtw = (const float*)(a.ws + WS_RTW);
    const bf16* ys = (const bf16*)(a.ws + WS_XS); float* out = a.out;
    for (int m = gw; m < NT; m += NGW) { const int b = m >> 11; const int p0 = pos[2 * m], p1 = pos[2 * m + 1]; const float w0 = rtw[2 * m], w1 = rtw[2 * m + 1];
        f32x4* o = (f32x4*)(out + (size_t)m * DM) + lane; const v2u* xb = (const v2u*)((const bf16*)(a.ws + WS_X1B) + (size_t)m * DM) + lane; const v2u* y0 = (const v2u*)(ys + (size_t)p0 * DM) + lane; const v2u* y1 = (const v2u*)(ys + (size_t)p1 * DM) + lane;
#pragma unroll
        for (int j = 0; j < 4; ++j) { const int col = 4 * (lane + 64 * j); const f32x4 g2 = *(const f32x4*)(mod + b * 6144 + 5120 + col); const v2u a0 = y0[64 * j], a1 = y1[64 * j];
            const f32x4 e0 = {bflo(a0.x), bfhi(a0.x), bflo(a0.y), bfhi(a0.y)}, e1 = {bflo(a1.x), bfhi(a1.x), bflo(a1.y), bfhi(a1.y)};
            const v2u xw = xb[64 * j]; const f32x4 xv = {bflo(xw.x), bfhi(xw.x), bflo(xw.y), bfhi(xw.y)};
            o[64 * j] = xv + g2 * (e0 * w0 + e1 * w1); } }
}

#define XB_TMO      128
#define XB_XCNT(j)  (256  + 64 * (j))
#define XB_XSUB(j)  (1280 + 64 * (j))
#define XB_XGEN(j)  (2304 + 64 * (j))
#define XB_TOP      3328
#define XB_TOPGEN   3392
#define XCD_BAR_WORDS 3456
#define XB_SPIN_CAP (1u << 22)

__device__ __forceinline__ unsigned xb_ld(unsigned* p)              { return __hip_atomic_load(p, __ATOMIC_RELAXED, __HIP_MEMORY_SCOPE_AGENT); }
__device__ __forceinline__ unsigned xb_add(unsigned* p, unsigned v) { return __hip_atomic_fetch_add(p, v, __ATOMIC_RELAXED, __HIP_MEMORY_SCOPE_AGENT); }
__device__ __forceinline__ unsigned xb_xcc_id() { return (unsigned)__builtin_amdgcn_s_getreg((3 << 11) | 20) & 0xFu; }
#define XB_SPIN(cond, bar) do { unsigned _sp = 0; while (cond) { __builtin_amdgcn_s_sleep(1); \
    if ((++_sp & 255u) == 0u) { if (xb_ld(&(bar)[XB_TMO])) break; if (_sp > XB_SPIN_CAP) { atomicAdd(&(bar)[XB_TMO], 1u); break; } } } } while (0)

struct XcdBarrier {
    unsigned* bar; unsigned x;
    volatile LAS unsigned* st;
};

__device__ __forceinline__ XcdBarrier xcd_barrier_post(unsigned* bar, volatile LAS unsigned* st, int wv) {
    XcdBarrier b; b.bar = bar; b.x = xb_xcc_id(); b.st = st;
    if (mktid(wv) == 0) (void)xb_add(&bar[XB_XCNT(b.x)], 1u);
    return b;
}
__device__ __forceinline__ void xcd_barrier_complete(unsigned* bar, unsigned x, unsigned& nloc, unsigned& nx) {
    const unsigned G = gridDim.x * gridDim.y * gridDim.z;
    unsigned sum, cnt, mine, sp = 0u;
    for (;;) {
        sum = 0u; cnt = 0u; mine = 0u;
#pragma unroll
        for (unsigned j = 0; j < 16; ++j) { const unsigned c = xb_ld(&bar[XB_XCNT(j)]); sum += c; cnt += (c > 0u) ? 1u : 0u; mine = (j == x) ? c : mine; }
        if (sum == G) break;
        __builtin_amdgcn_s_sleep(1);
        if ((++sp & 255u) == 0u) { if (xb_ld(&bar[XB_TMO])) break; if (sp > XB_SPIN_CAP) { atomicAdd(&bar[XB_TMO], 1u); break; } }
    }
    nloc = mine > 0u ? mine : 1u; nx = cnt > 0u ? cnt : 1u;
}

__device__ __forceinline__ void xcd_barrier(const XcdBarrier& b, int wv) {
    asm volatile("s_waitcnt vmcnt(0)" ::: "memory");
    __syncthreads();
    if (mktid(wv) == 0) {
        unsigned* bar = b.bar;
        __builtin_amdgcn_s_waitcnt(0);
        unsigned nloc = b.st[0], nx = b.st[1];
        if (nloc == 0u) { xcd_barrier_complete(bar, b.x, nloc, nx); b.st[0] = nloc; b.st[1] = nx; }
        const unsigned old = xb_add(&bar[XB_XSUB(b.x)], 1u);
        const unsigned gen = old / nloc;
        if (old + 1u == (gen + 1u) * nloc) {
            __builtin_amdgcn_fence(__ATOMIC_RELEASE, "agent");
            asm volatile("s_waitcnt vmcnt(0)" ::: "memory");
            const unsigned og = xb_add(&bar[XB_TOP], 1u);
            const unsigned tg = og / nx;
            if (og + 1u == (tg + 1u) * nx) xb_add(&bar[XB_TOPGEN], 1u);
            else XB_SPIN(xb_ld(&bar[XB_TOPGEN]) == tg, bar);
            __builtin_amdgcn_fence(__ATOMIC_ACQUIRE, "agent");
            xb_add(&bar[XB_XGEN(b.x)], 1u);
            asm volatile("s_waitcnt vmcnt(0)" ::: "memory");
        } else {
            XB_SPIN(xb_ld(&bar[XB_XGEN(b.x)]) == gen, bar);
            __builtin_amdgcn_fence(__ATOMIC_ACQUIRE, "agent");
            asm volatile("s_waitcnt vmcnt(0)" ::: "memory");
        }
    }
    __syncthreads();
}

constexpr int LDS_BYTES = 160 * 1024, MISC_OFF = LDS_BYTES - 256;
static_assert(rw::LDS_NEED <= MISC_OFF, "scan LDS");
constexpr int CW_BAR = 4096;

__global__ void __launch_bounds__(512, 2) mega_fwd(PArgs a) {
    extern __shared__ __attribute__((aligned(16))) unsigned char lds[];
    volatile LAS unsigned* MISC = (volatile LAS unsigned*)((LAS unsigned char*)lds + MISC_OFF);
    const int wv = __builtin_amdgcn_readfirstlane((int)threadIdx.x >> 6);
    { const int t0 = mktid(wv); if (t0 < 64) MISC[t0] = 0u; }
    __syncthreads();
    XcdBarrier bar = xcd_barrier_post((unsigned*)(a.ws + WS_CTL) + CW_BAR, MISC + 8, wv);
    GemmArgs g; g.ws = a.ws; g.x = a.in[0]; g.out = a.out;
    const int G = (int)gridDim.x, bx = (int)blockIdx.x;

    p_prep_weights(a, lds, wv); __syncthreads(); p_ada(a, lds, wv);
    xcd_barrier(bar, wv);
    p_norm1(a, lds, wv);
    xcd_barrier(bar, wv);
    p_gemm_in(g, lds, wv);
    xcd_barrier(bar, wv);
    p_kprep(a, lds, wv);
    xcd_barrier(bar, wv);
    p_qprep(a, lds, wv);
    xcd_barrier(bar, wv);
    { const int nscan = G / 2;
      if (bx < nscan) { for (int bh = bx; bh < 128; bh += nscan) rw::scan_unit(a, lds, bh, wv); }
      else p_attn(a, lds, bx - nscan, G - nscan, wv); }
    xcd_barrier(bar, wv);
    p_gemm_merge(g, lds, wv);
    xcd_barrier(bar, wv);
    p_gemm_out(g, lds, wv); __syncthreads(); p_prep_experts(a, lds, wv);
    xcd_barrier(bar, wv);
    p_norm2_route(a, lds, wv);
    xcd_barrier(bar, wv);
    p_moe_gather(a, lds, wv);
    xcd_barrier(bar, wv);
    p_gemm_up(g, lds, wv);
    xcd_barrier(bar, wv);
    p_gemm_down(g, lds, wv);
    xcd_barrier(bar, wv);
    p_combine(a, lds, wv);
}

extern "C" void kernel_launch(void* const* d_in, const int* in_sizes, int n_in, void* d_out, int out_size, void* d_ws, size_t ws_size, hipStream_t stream) {
    static int grid = 0;
    if (grid == 0) {
        if (n_in != 30 || out_size != NT * DM || ws_size < WS_END) { fprintf(stderr, "kernel_launch: unexpected shapes (n_in %d, out %d, ws %zu)\n", n_in, out_size, ws_size); grid = -1; return; }
        int dev = 0, cus = 0, per_cu = 0;
        if (hipGetDevice(&dev) != hipSuccess || hipDeviceGetAttribute(&cus, hipDeviceAttributeMultiprocessorCount, dev) != hipSuccess) { grid = -1; return; }
        if (hipFuncSetAttribute((const void*)mega_fwd, hipFuncAttributeMaxDynamicSharedMemorySize, LDS_BYTES) != hipSuccess) { fprintf(stderr, "kernel_launch: hipFuncSetAttribute failed\n"); grid = -1; return; }
        if (hipOccupancyMaxActiveBlocksPerMultiprocessor(&per_cu, (const void*)mega_fwd, 512, LDS_BYTES) != hipSuccess || per_cu < 1) { fprintf(stderr, "kernel_launch: occupancy query says %d blocks per CU\n", per_cu); (void)hipGetLastError(); grid = -1; return; }
        grid = cus;
    }
    if (grid < 0) return;
    (void)hipMemsetAsync((char*)d_ws + WS_CTL, 0, 65536, stream);
    PArgs p{}; for (int i = 0; i < 30; ++i) p.in[i] = (const float*)d_in[i]; p.out = (float*)d_out; p.ws = (unsigned char*)d_ws;
    hipLaunchKernelGGL(mega_fwd, dim3(grid), dim3(512), LDS_BYTES, stream, p);
}
```

```cpp
#include <hip/hip_runtime.h>
#include <cstdio>
#include <cstdint>
__device__ __forceinline__ int mktid(int wv) { int l; asm volatile("v_mbcnt_lo_u32_b32 %0, -1, 0\n\tv_mbcnt_hi_u32_b32 %0, -1, %0" : "=v"(l)); return (wv << 6) | l; }
template <int CTRL> __device__ __forceinline__ float dppf(float v) { return __builtin_bit_cast(float, __builtin_amdgcn_update_dpp(0, __builtin_bit_cast(int, v), CTRL, 0xF, 0xF, true)); }
__device__ __forceinline__ float red4(float v) { v += dppf<0xB1>(v); v += dppf<0x4E>(v); return v; }
__device__ __forceinline__ float red8(float v) { v = red4(v); v += dppf<0x141>(v); return v; }
__device__ __forceinline__ float red16(float v) { v = red8(v); v += dppf<0x140>(v); return v; }
__device__ __forceinline__ float wave_sum(float v) { v = red16(v);
    v += __builtin_bit_cast(float, __builtin_amdgcn_ds_swizzle(__builtin_bit_cast(int, v), 0x401F));
    const unsigned u = __builtin_bit_cast(unsigned, v); auto rr = __builtin_amdgcn_permlane32_swap(u, u, false, false);
    return __builtin_bit_cast(float, (unsigned)rr[0]) + __builtin_bit_cast(float, (unsigned)rr[1]); }
__device__ __forceinline__ float lane_get(float v, int src) { return __builtin_bit_cast(float, __builtin_amdgcn_ds_bpermute(src << 2, __builtin_bit_cast(int, v))); }
namespace pg8 {
#define PG8_LAS __attribute__((address_space(3)))
typedef unsigned short bf16_t;
typedef short bf16x8 __attribute__((ext_vector_type(8)));
typedef float f32x4 __attribute__((ext_vector_type(4)));
typedef unsigned u32x4 __attribute__((ext_vector_type(4)));
constexpr int BM = 256, BK = 64, HALF = 128, HTB = HALF * BK * 2  , STAGE_BYTES = 8 * HTB, NXCD = 8, WGM = 8;

__host__ __device__ __forceinline__ int lds_byte(int r, int c) { const int st = (r >> 4) * 2 + (c >> 5), rr = r & 15, cc = c & 31, ob = rr * 64 + cc * 2; return st * 1024 + (ob ^ (((ob >> 9) & 1) << 5)); }
__host__ __device__ __forceinline__ void stage_rc(int b, int& R, int& C) { const int st = b / 1024, sb = b % 1024, swz = sb ^ (((sb >> 9) & 1) << 5); R = (st >> 1) * 16 + swz / 64; C = (st & 1) * 32 + (swz % 64) / 2; }
__host__ __device__ __forceinline__ int perm32(int rho) { const int n = rho >> 4, i = rho & 15; return 8 * (i >> 2) + 4 * n + (i & 3); }
struct Unit { int pm, pn, aux; const char* a; const char* b; };
struct Gemm { int K; };

struct StaticOrder {
    int nM, nN, nwg, G, c; const char* A; const char* Bt; size_t tstep;
    __device__ void init(const void* A_, const void* Bt_, int M, int N, int K, int G_, int c_) { nM = M / BM; nN = N / BM; nwg = nM * nN; G = G_; c = c_; A = (const char*)A_; Bt = (const char*)Bt_; tstep = (size_t)BM * K * 2; }
    __device__ bool next(int i, Unit& u) const {
        const long L = (long)i * G + c; if (L >= nwg) return false;
        int wgid = (int)L; { const int q = nwg / NXCD, r = nwg % NXCD, xcd = wgid % NXCD, off = wgid / NXCD; wgid = (xcd < r ? xcd * (q + 1) : r * (q + 1) + (xcd - r) * q) + off; }
        const int nig = WGM * nN, gid = wgid / nig, fm = gid * WGM, gsz = (nM - fm) < WGM ? (nM - fm) : WGM;
        u.aux = 0; u.pm = fm + ((wgid % nig) % gsz); u.pn = (wgid % nig) / gsz; u.a = A + (size_t)u.pm * tstep; u.b = Bt + (size_t)u.pn * tstep; return true;
    }
    __device__ __forceinline__ void a_ready(const Unit&) const {}
    __device__ __forceinline__ void done(const Unit&) const {}
};
__device__ __forceinline__ unsigned cvt_pk_bf16(float lo, float hi) { unsigned r; asm volatile("v_cvt_pk_bf16_f32 %0, %1, %2" : "=v"(r) : "v"(lo), "v"(hi)); return r; }
template <class Epi, class Sched, bool ALIGN_EPI = false, bool SP2 = false>
__device__ __forceinline__ void gemm_phase(PG8_LAS unsigned char* lds, const Gemm g, const Sched& S, const Epi& E, int wv) {
    const int tid = mktid(wv), wid = __builtin_amdgcn_readfirstlane(tid >> 6), lane = tid & 63, wr = wid >> 2, wc = wid & 3, fr = lane & 15, fq = lane >> 4;
    const int K = g.K, nt = K / BK;
    unsigned voffA[2], voffB[2];
#pragma unroll
    for (int i = 0; i < 2; ++i) { int R, C; stage_rc(tid * 16 + i * 8192, R, C); const int Rb = Epi::PERM ? ((R & ~31) + perm32(R & 31)) : R;
        voffA[i] = (unsigned)(R * K + C) * 2u; voffB[i] = (unsigned)(Rb * K + C) * 2u; }
    const size_t kstep = (size_t)(BK * 2);
    const size_t hstep = (size_t)HALF * K * 2;
        const unsigned ldsw = (unsigned)wid * 1024u;
    const int aoff = lds_byte(wr * 64 + fr, fq * 8), boff = lds_byte(wc * 32 + fr, fq * 8);
#define PG8_SA(b, h) (((b) * 2 + (h)) * HTB)
#define PG8_SB(b, h) ((4 + (b) * 2 + (h)) * HTB)
#define PG8_STAGE(bufoff, gbase, voff) do { _Pragma("unroll") for (int _i = 0; _i < 2; ++_i) \
        __builtin_amdgcn_global_load_lds((const unsigned*)((const char*)(gbase) + (voff)[_i]), (PG8_LAS unsigned*)(lds + (bufoff) + ldsw + _i * 8192), 16, 0, 0); } while (0)
#define PG8_LDA(dst, b, h) do { _Pragma("unroll") for (int m = 0; m < 4; ++m) _Pragma("unroll") for (int k = 0; k < 2; ++k) dst[m][k] = *(const PG8_LAS bf16x8*)(lds + PG8_SA(b, h) + aoff + m * 2048 + k * 1024); } while (0)
#define PG8_LDB(dst, b, h) do { _Pragma("unroll") for (int n = 0; n < 2; ++n) _Pragma("unroll") for (int k = 0; k < 2; ++k) dst[n][k] = *(const PG8_LAS bf16x8*)(lds + PG8_SB(b, h) + boff + n * 2048 + k * 1024); } while (0)
#define PG8_MMA(ai, bj, At, Bt) do { __builtin_amdgcn_s_setprio(1); _Pragma("unroll") for (int m = 0; m < 4; ++m) _Pragma("unroll") for (int n = 0; n < 2; ++n) _Pragma("unroll") for (int k = 0; k < 2; ++k) \
        acc[ai][bj][m][n] = __builtin_amdgcn_mfma_f32_16x16x32_bf16(Bt[n][k], At[m][k], acc[ai][bj][m][n], 0, 0, 0); __builtin_amdgcn_s_setprio(0); } while (0)
#define PG8_WAIT_V(n) asm volatile("s_waitcnt vmcnt(" #n ")" ::: "memory")
#define PG8_WAIT_L(n) asm volatile("s_waitcnt lgkmcnt(" #n ")" ::: "memory")
#define PG8_BAR __builtin_amdgcn_s_barrier()
#define PG8_SCHED __builtin_amdgcn_sched_barrier(0)
    Unit cur, nxt; int ui = 0;
    if (!S.next(0, cur)) return;
    f32x4 acc[2][2][4][2];
#pragma unroll
    for (int a = 0; a < 2; ++a)
#pragma unroll
        for (int b = 0; b < 2; ++b)
#pragma unroll
            for (int m = 0; m < 4; ++m)
#pragma unroll
                for (int n = 0; n < 2; ++n) acc[a][b][m][n] = (f32x4){0.f, 0.f, 0.f, 0.f};
    bf16x8 At[4][2], B0[2][2], B1[2][2];
    const char* cA = cur.a; const char* cB = cur.b;
    S.a_ready(cur);
    if constexpr (SP2) {
        PG8_STAGE(PG8_SB(0, 0), cB, voffB); PG8_STAGE(PG8_SB(0, 1), cB + hstep, voffB); PG8_STAGE(PG8_SA(0, 0), cA, voffA); PG8_STAGE(PG8_SA(0, 1), cA + hstep, voffA);
        if (wr == 1) PG8_BAR;
        PG8_WAIT_V(2); PG8_BAR;
        PG8_STAGE(PG8_SB(1, 0), cB + kstep, voffB); PG8_STAGE(PG8_SA(1, 0), cA + kstep, voffA); PG8_STAGE(PG8_SB(1, 1), cB + hstep + kstep, voffB);
        PG8_WAIT_V(6); PG8_BAR;
    } else {
        PG8_STAGE(PG8_SB(0, 0), cB, voffB); PG8_STAGE(PG8_SA(0, 0), cA, voffA); PG8_STAGE(PG8_SB(0, 1), cB + hstep, voffB); PG8_STAGE(PG8_SA(0, 1), cA + hstep, voffA);
        if (wr == 1) PG8_BAR;
        PG8_WAIT_V(4); PG8_BAR;
        PG8_STAGE(PG8_SB(1, 0), cB + kstep, voffB); PG8_STAGE(PG8_SA(1, 0), cA + kstep, voffA); PG8_STAGE(PG8_SB(1, 1), cB + hstep + kstep, voffB);
        PG8_WAIT_V(6); PG8_BAR;
    }
    for (;;) {
        const bool has_next = S.next(ui + 1, nxt);
        const char* nA = has_next ? nxt.a : cA; const char* nB = has_next ? nxt.b : cB;
        for (int t = 0; t < nt; t += 2) {
            const bool last = (t == nt - 2);
            const char* a1 = cA + (size_t)(t + 1) * kstep;
            const char* a2 = last ? nA : cA + (size_t)(t + 2) * kstep; const char* b2 = last ? nB : cB + (size_t)(t + 2) * kstep;
            const char* a3 = a2 + kstep; const char* b3 = b2 + kstep;
            if (last && has_next) S.a_ready(nxt);
            if constexpr (SP2) {
            PG8_LDB(B0, 0, 0); PG8_LDB(B1, 0, 1); PG8_SCHED; PG8_LDA(At, 0, 0); PG8_STAGE(PG8_SA(1, 1), a1 + hstep, voffA);
            PG8_WAIT_V(8); PG8_WAIT_L(0); PG8_BAR; PG8_MMA(0, 0, At, B0); PG8_MMA(0, 1, At, B1); PG8_BAR; PG8_SCHED;
            PG8_LDA(At, 0, 1); PG8_STAGE(PG8_SB(0, 0), b2, voffB); PG8_STAGE(PG8_SB(0, 1), b2 + hstep, voffB); PG8_STAGE(PG8_SA(0, 0), a2, voffA);
            PG8_WAIT_V(8); PG8_WAIT_L(0); PG8_BAR; PG8_MMA(1, 0, At, B0); PG8_MMA(1, 1, At, B1); PG8_BAR; PG8_SCHED;
            PG8_LDB(B0, 1, 0); PG8_LDB(B1, 1, 1); PG8_SCHED; PG8_LDA(At, 1, 0); PG8_STAGE(PG8_SA(0, 1), a2 + hstep, voffA);
            PG8_WAIT_V(8); PG8_WAIT_L(0); PG8_BAR; PG8_MMA(0, 0, At, B0); PG8_MMA(0, 1, At, B1); PG8_BAR; PG8_SCHED;
            PG8_LDA(At, 1, 1); PG8_STAGE(PG8_SB(1, 0), b3, voffB); PG8_STAGE(PG8_SB(1, 1), b3 + hstep, voffB); PG8_STAGE(PG8_SA(1, 0), a3, voffA);
            PG8_WAIT_V(8); PG8_WAIT_L(0); PG8_BAR; PG8_MMA(1, 0, At, B0); PG8_MMA(1, 1, At, B1); PG8_BAR; PG8_SCHED;
            } else {
            PG8_LDB(B0, 0, 0); PG8_SCHED; PG8_LDA(At, 0, 0); PG8_STAGE(PG8_SA(1, 1), a1 + hstep, voffA);
            PG8_WAIT_L(8); PG8_BAR; PG8_WAIT_L(0); PG8_MMA(0, 0, At, B0); PG8_BAR; PG8_SCHED;
            PG8_LDB(B1, 0, 1); PG8_STAGE(PG8_SB(0, 0), b2, voffB);
            PG8_BAR; PG8_WAIT_L(0); PG8_MMA(0, 1, At, B1); PG8_BAR;
            PG8_LDA(At, 0, 1); PG8_STAGE(PG8_SA(0, 0), a2, voffA);
            PG8_BAR; PG8_WAIT_L(0); PG8_MMA(1, 0, At, B0); PG8_BAR; PG8_SCHED;
            PG8_STAGE(PG8_SB(0, 1), b2 + hstep, voffB);
            PG8_WAIT_V(6); PG8_BAR; PG8_MMA(1, 1, At, B1); PG8_BAR;
            PG8_LDB(B0, 1, 0); PG8_SCHED; PG8_LDA(At, 1, 0); PG8_STAGE(PG8_SA(0, 1), a2 + hstep, voffA);
            PG8_WAIT_L(8); PG8_BAR; PG8_WAIT_L(0); PG8_MMA(0, 0, At, B0); PG8_BAR; PG8_SCHED;
            PG8_LDB(B1, 1, 1); PG8_STAGE(PG8_SB(1, 0), b3, voffB);
            PG8_BAR; PG8_WAIT_L(0); PG8_MMA(0, 1, At, B1); PG8_BAR;
            PG8_LDA(At, 1, 1); PG8_STAGE(PG8_SA(1, 0), a3, voffA);
            PG8_BAR; PG8_WAIT_L(0); PG8_MMA(1, 0, At, B0); PG8_BAR; PG8_SCHED;
            PG8_STAGE(PG8_SB(1, 1), b3 + hstep, voffB);
            PG8_WAIT_V(6); PG8_BAR; PG8_MMA(1, 1, At, B1); PG8_BAR;
            }
        }
        if constexpr (ALIGN_EPI) { if (wr == 0) PG8_BAR; }
        bool keep = false;
        if constexpr (!Epi::AFTER_DRAIN) { if constexpr (Epi::CHAIN) keep = E.chain(acc, cur, wr, wc, fr, fq); else E(acc, cur, wr, wc, fr, fq); S.done(cur); }
        if (!has_next) break;
        if (!keep) {
#pragma unroll
        for (int a = 0; a < 2; ++a)
#pragma unroll
            for (int b = 0; b < 2; ++b)
#pragma unroll
                for (int m = 0; m < 4; ++m)
#pragma unroll
                    for (int n = 0; n < 2; ++n) acc[a][b][m][n] = (f32x4){0.f, 0.f, 0.f, 0.f};
        }
        cur = nxt; cA = nA; cB = nB; ++ui;
        if constexpr (ALIGN_EPI) { if (wr == 1) PG8_BAR; }
    }
    PG8_WAIT_V(0);
    if constexpr (!ALIGN_EPI) { if (wr == 0) PG8_BAR; }
    PG8_BAR;
    if constexpr (Epi::AFTER_DRAIN) { E.fused(acc, cur, wr, wc, fr, fq, lds, wid, lane); S.done(cur); }
#undef PG8_SA
#undef PG8_SB
#undef PG8_STAGE
#undef PG8_LDA
#undef PG8_LDB
#undef PG8_MMA
#undef PG8_WAIT_V
#undef PG8_WAIT_L
#undef PG8_BAR
#undef PG8_SCHED
}
}
#include <hip/hip_bf16.h>
#include <cmath>
namespace attn_body {
using bf16=__hip_bfloat16;
using bf16x8=__attribute__((ext_vector_type(8)))short;
using s16x4=__attribute__((ext_vector_type(4)))short;
using f32x16=__attribute__((ext_vector_type(16)))float;
using u32x4=__attribute__((ext_vector_type(4)))unsigned;
constexpr int NHEAD=8,SEQ=2048,D=64,PQ=512,PK=512,PV=5376,PO=512;
constexpr int NW=8,QBLK=32,QB=QBLK*NW,KVBLK=64,NQB=SEQ/QB;
__device__ __forceinline__ int crow(int r,int hi){return (r&3)+8*(r>>2)+4*hi;}
#define SBAR() __builtin_amdgcn_sched_barrier(0)
__device__ __forceinline__ void cmask(f32x16&p0,f32x16&p1,int jb,int qrel,int hi){
  const float NEG=-INFINITY; int kb=64*jb+4*hi;
  #pragma unroll
  for(int r=0;r<16;++r){int kv=kb+(r&3)+8*(r>>2); if(kv>qrel)p0[r]=NEG; if(kv+32>qrel)p1[r]=NEG;}
}

constexpr int NSLOT=3, SLOTB=8192;
constexpr int LDS_K=0, LDS_V=NSLOT*SLOTB, LDS_WS=2*NSLOT*SLOTB, LDS_OST=LDS_WS+NW*64*4, LDS_BYTES=LDS_OST+NW*4096;
constexpr float C2=0.125f*1.4426950408889634f;
__device__ __forceinline__ void glds16(const void*gsrc,unsigned lds_dst){unsigned keep;
  asm volatile("s_mov_b32 %0, m0\n\ts_mov_b32 m0, %2\n\ts_nop 0\n\tglobal_load_lds_dwordx4 %1, off\n\ts_mov_b32 m0, %0":"=&s"(keep):"v"(gsrc),"s"(lds_dst):"memory");}
__device__ __forceinline__ float max3f(float a,float b,float c){float r;asm("v_max3_f32 %0, %1, %2, %3":"=v"(r):"v"(a),"v"(b),"v"(c));return r;}
__device__ __forceinline__ float max2f(float a,float b){float r;asm("v_max_f32_e32 %0, %1, %2":"=v"(r):"v"(a),"v"(b));return r;}
__device__ __forceinline__ float fadd_s(float a,float b){float r;asm("v_add_f32_e32 %0, %1, %2":"=v"(r):"v"(a),"v"(b));return r;}
__device__ __forceinline__ float fsub_s(float a,float b){float r;asm("v_sub_f32_e32 %0, %1, %2":"=v"(r):"v"(a),"v"(b));return r;}
typedef float f32x2_t __attribute__((ext_vector_type(2))); typedef __bf16 bf16x2_t __attribute__((ext_vector_type(2)));
__device__ __forceinline__ unsigned cvtpk_s(float lo,float hi){f32x2_t v={lo,hi};bf16x2_t b=__builtin_convertvector(v,bf16x2_t);return __builtin_bit_cast(unsigned,b);}
#define WAIT_BAR(N) asm volatile("s_waitcnt vmcnt(" #N ") lgkmcnt(0)\n\ts_barrier":::"memory")

__device__ __forceinline__ void qkt(f32x16&p0,f32x16&p1,const char*Kslot,const bf16x8*qr,const f32x16&negm,int r32,int hi){
  const char*kb=Kslot+hi*1024+r32*16;
  #pragma unroll
  for(int d0=0;d0<4;++d0){
    const bf16x8 b0=*reinterpret_cast<const bf16x8*>(kb+d0*2048);
    const bf16x8 b1=*reinterpret_cast<const bf16x8*>(kb+d0*2048+512);
    if(d0==0){p0=__builtin_amdgcn_mfma_f32_32x32x16_bf16(b0,qr[0],negm,0,0,0);p1=__builtin_amdgcn_mfma_f32_32x32x16_bf16(b1,qr[0],negm,0,0,0);}
    else{p0=__builtin_amdgcn_mfma_f32_32x32x16_bf16(b0,qr[d0],p0,0,0,0);p1=__builtin_amdgcn_mfma_f32_32x32x16_bf16(b1,qr[d0],p1,0,0,0);}}
}
typedef __attribute__((address_space(3))) const char* lds_cptr;
typedef short v4i16_t __attribute__((ext_vector_type(4)));
__device__ __forceinline__ void kload8(bf16x8*kf,lds_cptr kp){
  kf[0]=*(const __attribute__((address_space(3))) bf16x8*)(kp);      kf[1]=*(const __attribute__((address_space(3))) bf16x8*)(kp+512);
  kf[2]=*(const __attribute__((address_space(3))) bf16x8*)(kp+2048); kf[3]=*(const __attribute__((address_space(3))) bf16x8*)(kp+2560);
  kf[4]=*(const __attribute__((address_space(3))) bf16x8*)(kp+4096); kf[5]=*(const __attribute__((address_space(3))) bf16x8*)(kp+4608);
  kf[6]=*(const __attribute__((address_space(3))) bf16x8*)(kp+6144); kf[7]=*(const __attribute__((address_space(3))) bf16x8*)(kp+6656);
}
__device__ __forceinline__ void kload2(bf16x8*kf,lds_cptr kp,int j){ kf[2*j]=*(const __attribute__((address_space(3))) bf16x8*)(kp+j*2048); kf[2*j+1]=*(const __attribute__((address_space(3))) bf16x8*)(kp+j*2048+512); }
__device__ __forceinline__ s16x4 vtr(lds_cptr p){ return __builtin_bit_cast(s16x4,__builtin_amdgcn_ds_read_tr16_b64_v4i16((__attribute__((address_space(3))) v4i16_t*)p)); }
__device__ __forceinline__ float rowmax(const f32x16&p0,const f32x16&p1){
  float a=max3f(p0[0],p0[1],p1[0]),b=max3f(p0[2],p0[3],p1[1]);a=max3f(a,p1[2],p1[3]);
  #pragma unroll
  for(int r=4;r<16;r+=4){a=max3f(a,p0[r],p0[r+1]);b=max3f(b,p0[r+2],p0[r+3]);a=max3f(a,p1[r],p1[r+1]);b=max3f(b,p1[r+2],p1[r+3]);}
  const float m=max2f(a,b);
  auto rr=__builtin_amdgcn_permlane32_swap(__float_as_uint(m),__float_as_uint(m),false,false);
  return max2f(__uint_as_float(rr[0]),__uint_as_float(rr[1]));
}
__device__ __forceinline__ void pv(f32x16*o,int vb,bf16x8 pa0,bf16x8 pa1,bf16x8 pa2,bf16x8 pa3){
  #pragma unroll
  for(int d0=0;d0<2;++d0){s16x4 lo[4],hi[4];
    #pragma unroll
    for(int ks=0;ks<4;++ks){
      asm volatile("ds_read_b64_tr_b16 %0,%1 offset:%c2":"=&v"(lo[ks]):"v"(vb),"i"(d0*4096+ks*1024):"memory");
      asm volatile("ds_read_b64_tr_b16 %0,%1 offset:%c2":"=&v"(hi[ks]):"v"(vb),"i"(d0*4096+ks*1024+512):"memory");}
    asm volatile("s_waitcnt lgkmcnt(0)":::"memory");SBAR();
    #define PK(k) (bf16x8){lo[k][0],lo[k][1],lo[k][2],lo[k][3],hi[k][0],hi[k][1],hi[k][2],hi[k][3]}
    o[d0]=__builtin_amdgcn_mfma_f32_32x32x16_bf16(pa0,PK(0),o[d0],0,0,0);
    o[d0]=__builtin_amdgcn_mfma_f32_32x32x16_bf16(pa1,PK(1),o[d0],0,0,0);
    o[d0]=__builtin_amdgcn_mfma_f32_32x32x16_bf16(pa2,PK(2),o[d0],0,0,0);
    o[d0]=__builtin_amdgcn_mfma_f32_32x32x16_bf16(pa3,PK(3),o[d0],0,0,0);
    #undef PK
  }
}

#ifndef ATTN_STORE16
#define ATTN_STORE16(p,v) (*(u32x4*)(p)=(v))
#endif
template<int THRL> __device__ __forceinline__ void attn_unit(int b,int h,int qb,const bf16*Q,const bf16*__restrict__ K,const bf16*__restrict__ V,bf16*O,const unsigned char*__restrict__ SEL,char*shm,int wv){
  const int tid=mktid(wv),lane=tid&63,r32=lane&31,hi=lane>>5;     const int wid=__builtin_amdgcn_readfirstlane(tid>>6);
  const long rowbase=(long)b*SEQ; const int q0=qb*QB;
  const bf16*Qw=Q+(rowbase+q0+wid*QBLK)*PQ+h*D;
  const bf16*Kh=K+rowbase*PK+h*D,*Vh=V+rowbase*PV+h*D;
  const unsigned lds0=(unsigned)(uintptr_t)shm;
  float*wsf=(float*)(shm+LDS_WS)+wid*64;
  const bf16*ksrc=Kh+(long)lane*PK+wid*8;
  const bf16*vsrc=Vh+(long)(16*(wid&3)+(lane>>2))*PV+(wid>>2)*32+(lane&3)*8;
  const unsigned kdst=lds0+LDS_K+wid*1024, vdst=lds0+LDS_V+wid*1024;
  #define TROW(t) ((long)(((t)<4)?(q0+(t)*KVBLK):(((t)-4)*KVBLK)))
  #define DMA_K(t,slot) glds16(ksrc+TROW(t)*PK,(unsigned)__builtin_amdgcn_readfirstlane(kdst+(slot)))
  #define DMA_V(t,slot) glds16(vsrc+TROW(t)*PV,(unsigned)__builtin_amdgcn_readfirstlane(vdst+(slot)))
  const int vb0=(int)(lds0+LDS_V)+((lane>>4)&1)*32+(lane&3)*8+(4*hi+((lane&15)>>2))*64;
  const char*Kbase=shm+LDS_K; bf16x8 kf[8];
  const lds_cptr shm3=(lds_cptr)shm; const lds_cptr kp0=shm3+LDS_K+hi*1024+r32*16; const lds_cptr vp0=shm3+LDS_V+((lane>>4)&1)*32+(lane&3)*8+(4*hi+((lane&15)>>2))*64;
  const int NT=(q0+QB)/KVBLK;
  DMA_K(0,0);DMA_V(0,0);DMA_K(1,SLOTB);
  bf16x8 qr[4];
  #pragma unroll
  for(int d0=0;d0<4;++d0)qr[d0]=*reinterpret_cast<const bf16x8*>(&Qw[(long)r32*PQ+d0*16+hi*8]);
  float mhat=0.f,l_reg=0.f;f32x16 o[2];o[0]=f32x16{};o[1]=f32x16{};
  const int qrel=wid*QBLK+r32;
  const unsigned selb=(unsigned)SEL[((long)(b*NHEAD+h))*SEQ+q0+qrel];
  #define CMASK(P0,P1,t) cmask(P0,P1,(t),qrel,hi)
  #define SUBREF(C0,C1,t) do{ const float sb_=(((t)<4)||((selb>>(((t)-4)>>2))&1u))?mhat:INFINITY; _Pragma("unroll") for(int r_=0;r_<16;++r_){C0[r_]-=sb_;C1[r_]-=sb_;} }while(0)
  bool resc=false;
  #define START(P0,P1) do{ const float rm=rowmax(P0,P1); resc=false; \
    { const float dl=rm; mhat=fadd_s(mhat,dl); \
      _Pragma("unroll") for(int r=0;r<16;++r){P0[r]=fsub_s(P0[r],dl);P1[r]=fsub_s(P1[r],dl);} \
      } \
    _Pragma("unroll") for(int r=0;r<16;++r)P0[r]=__builtin_amdgcn_exp2f(P0[r]); }while(0)
  #define RESC() do{ if(resc){ asm volatile("s_waitcnt lgkmcnt(0)":::"memory"); \
      _Pragma("unroll") for(int d_=0;d_<2;++d_) _Pragma("unroll") for(int r=0;r<16;++r)o[d_][r]*=wsf[crow(r,hi)]; } }while(0)
  f32x16 pA0,pA1,pB0,pB1;
  int sl_prev=0,sl_cur=0,sl_next=SLOTB;
  #define ROT() do{sl_prev=sl_cur;sl_cur=sl_next;sl_next=(sl_next==(NSLOT-1)*SLOTB)?0:sl_next+SLOTB;}while(0)
  DMA_K(2,2*SLOTB);
  WAIT_BAR(3);
  qkt(pA0,pA1,Kbase,qr,f32x16{},r32,hi);asm volatile("s_nop 15\n\ts_nop 7":"+v"(pA0),"+v"(pA1));CMASK(pA0,pA1,0);
  START(pA0,pA1);
  _Pragma("unroll") for(int r=0;r<16;++r)pA1[r]=__builtin_amdgcn_exp2f(pA1[r]);
  WAIT_BAR(0);
  DMA_K(3,0);DMA_V(1,SLOTB);
  ROT();
  kload8(kf,kp0+sl_cur);
  WAIT_BAR(2);
  s16x4 vlo[8],vhi[8]; u32x4 pw0,pw1,pw2,pw3;
  #define PKW(P,B) cvtpk_s(P[B],P[B+1])
  #define PAF(k) __builtin_bit_cast(bf16x8,pw##k)
  #define VFR(i) (bf16x8){vlo[i][0],vlo[i][1],vlo[i][2],vlo[i][3],vhi[i][0],vhi[i][1],vhi[i][2],vhi[i][3]}
  #define PIN(x) asm volatile("":"+v"(x))
  #define MX3(a,b,c) __builtin_fmaxf(__builtin_fmaxf((a),(b)),(c))
  #define GAPA(MF,A0,A1,A2,A3,W0,W1,PW) do{ MF; sacc+=A0; sacc+=A1; sacc+=A2; sacc+=A3; PIN(sacc); W0; W1; PIN(PW); SBAR(); }while(0)
  #define EX(v) __builtin_amdgcn_exp2f(v)
  #define GAPB(MF,X,B) do{ MF; X[B]=EX(X[B]); X[B+1]=EX(X[B+1]); X[B+2]=EX(X[B+2]); X[B+3]=EX(X[B+3]); PIN(X); SBAR(); }while(0)
  #define VRD(i) do{ vlo[i]=vtr(vp_+(((i)>>2)*4096+((i)&3)*1024)); vhi[i]=vtr(vp_+(((i)>>2)*4096+((i)&3)*1024+512)); }while(0)
  #define KRD(G,j) do{ if(G){ kload2(kf,kp0+sl_next,j); SBAR(); } }while(0)
  #define STEP(C0,C1,P0,P1,t,GK,GV,GL,MB) do{ SBAR(); \
    const lds_cptr vp_=vp0+sl_prev; \
    VRD(0); SBAR(); float sacc=(P0[0]+P0[1]); \
    GAPA(C0=__builtin_amdgcn_mfma_f32_32x32x16_bf16(kf[0],qr[0],f32x16{},0,0,0), P0[2],P0[3],P0[4],P0[5],     pw0[0]=PKW(P0,0), pw0[1]=PKW(P0,2), pw0); \
    VRD(4); SBAR(); GAPA(C1=__builtin_amdgcn_mfma_f32_32x32x16_bf16(kf[1],qr[0],f32x16{},0,0,0), P0[6],P0[7],P0[8],P0[9],     pw0[2]=PKW(P0,4), pw0[3]=PKW(P0,6), pw0); \
    VRD(1); SBAR(); GAPA(C0=__builtin_amdgcn_mfma_f32_32x32x16_bf16(kf[2],qr[1],C0,0,0,0),   P0[10],P0[11],P0[12],P0[13], pw1[0]=PKW(P0,8), pw1[1]=PKW(P0,10), pw1); \
    VRD(5); SBAR(); GAPA(C1=__builtin_amdgcn_mfma_f32_32x32x16_bf16(kf[3],qr[1],C1,0,0,0),   P0[14],P0[15],P1[0],P1[1],   pw1[2]=PKW(P0,12),pw1[3]=PKW(P0,14), pw1); \
    VRD(2); SBAR(); GAPA(C0=__builtin_amdgcn_mfma_f32_32x32x16_bf16(kf[4],qr[2],C0,0,0,0),   P1[2],P1[3],P1[4],P1[5],     pw2[0]=PKW(P1,0), pw2[1]=PKW(P1,2), pw2); \
    VRD(6); SBAR(); GAPA(C1=__builtin_amdgcn_mfma_f32_32x32x16_bf16(kf[5],qr[2],C1,0,0,0),   P1[6],P1[7],P1[8],P1[9],     pw2[2]=PKW(P1,4), pw2[3]=PKW(P1,6), pw2); \
    VRD(3); SBAR(); GAPA(C0=__builtin_amdgcn_mfma_f32_32x32x16_bf16(kf[6],qr[3],C0,0,0,0),   P1[10],P1[11],P1[12],P1[13], pw3[0]=PKW(P1,8), pw3[1]=PKW(P1,10), pw3); \
    VRD(7); SBAR(); GAPA(C1=__builtin_amdgcn_mfma_f32_32x32x16_bf16(kf[7],qr[3],C1,0,0,0),   P1[14],P1[15],0.f,0.f,       pw3[2]=PKW(P1,12),pw3[3]=PKW(P1,14), pw3); \
    l_reg+=sacc; \
    if(GK){DMA_K((t)+3,sl_cur);} if(GV){DMA_V((t)+1,sl_next);} \
    SUBREF(C0,C1,t); if(MB){CMASK(C0,C1,t);} \
    { float a=MX3(C0[0],C0[1],C1[0]),b=MX3(C0[2],C0[3],C1[1]); a=MX3(a,C1[2],C1[3]); \
      _Pragma("unroll") for(int r=4;r<16;r+=4){a=MX3(a,C0[r],C0[r+1]);b=MX3(b,C0[r+2],C0[r+3]);a=MX3(a,C1[r],C1[r+1]);b=MX3(b,C1[r+2],C1[r+3]);} \
      float rm=__builtin_fmaxf(a,b); { auto rr=__builtin_amdgcn_permlane32_swap(__float_as_uint(rm),__float_as_uint(rm),false,false); rm=__builtin_fmaxf(__uint_as_float(rr[0]),__uint_as_float(rr[1])); } \
      resc=false; \
      if(__builtin_expect(__any(rm>(float)THRL),0)){ const float dl=__builtin_fmaxf(rm,0.f); mhat+=dl; \
        _Pragma("unroll") for(int r=0;r<16;++r){C0[r]-=dl;C1[r]-=dl;} \
        const float f=__builtin_amdgcn_exp2f(-dl); l_reg*=f; if(hi==0)wsf[r32]=f; resc=true; } } \
    SBAR(); \
    GAPB(o[0]=__builtin_amdgcn_mfma_f32_32x32x16_bf16(PAF(0),VFR(0),o[0],0,0,0), C0,0); \
    GAPB(o[1]=__builtin_amdgcn_mfma_f32_32x32x16_bf16(PAF(0),VFR(4),o[1],0,0,0), C0,4); \
    KRD(GL,0); GAPB(o[0]=__builtin_amdgcn_mfma_f32_32x32x16_bf16(PAF(1),VFR(1),o[0],0,0,0), C0,8); \
    KRD(GL,1); GAPB(o[1]=__builtin_amdgcn_mfma_f32_32x32x16_bf16(PAF(1),VFR(5),o[1],0,0,0), C0,12); \
    KRD(GL,2); GAPB(o[0]=__builtin_amdgcn_mfma_f32_32x32x16_bf16(PAF(2),VFR(2),o[0],0,0,0), C1,0); \
    KRD(GL,3); GAPB(o[1]=__builtin_amdgcn_mfma_f32_32x32x16_bf16(PAF(2),VFR(6),o[1],0,0,0), C1,4); \
    GAPB(o[0]=__builtin_amdgcn_mfma_f32_32x32x16_bf16(PAF(3),VFR(3),o[0],0,0,0), C1,8); \
    GAPB(o[1]=__builtin_amdgcn_mfma_f32_32x32x16_bf16(PAF(3),VFR(7),o[1],0,0,0), C1,12); \
    }while(0)
  #define ENDW(tt) do{ if((tt)+3<NT){WAIT_BAR(2);} else if((tt)+2<NT){WAIT_BAR(1);} else {WAIT_BAR(0);} }while(0)
  { int t=1;
    for(;t+1<NT;t+=2){
      STEP(pB0,pB1,pA0,pA1,t,(t+3<NT),(t+1<NT),(t+1<NT),(t<4));       ENDW(t);   RESC(); ROT();
      STEP(pA0,pA1,pB0,pB1,t+1,(t+4<NT),(t+2<NT),(t+2<NT),(t+1<4));     ENDW(t+1); RESC(); ROT();
    }
    STEP(pB0,pB1,pA0,pA1,NT-1,false,false,false,(NT==4)); RESC();
  }
  { float sacc=pB0[0]+pB0[1]; _Pragma("unroll") for(int r=2;r<16;++r)sacc+=pB0[r]; _Pragma("unroll") for(int r=0;r<16;++r)sacc+=pB1[r]; l_reg+=sacc;
    pw0=(u32x4){PKW(pB0,0),PKW(pB0,2),PKW(pB0,4),PKW(pB0,6)};pw1=(u32x4){PKW(pB0,8),PKW(pB0,10),PKW(pB0,12),PKW(pB0,14)};pw2=(u32x4){PKW(pB1,0),PKW(pB1,2),PKW(pB1,4),PKW(pB1,6)};pw3=(u32x4){PKW(pB1,8),PKW(pB1,10),PKW(pB1,12),PKW(pB1,14)};
    SBAR(); pv(o,vb0+sl_cur,PAF(0),PAF(1),PAF(2),PAF(3)); }
  #undef PKW
  #undef PAF
  #undef VFR
  #undef PIN
  #undef MX3
  #undef GAPA
  #undef GAPB
  #undef EX
  #undef VRD
  #undef KRD
  #undef STEP
  #undef ENDW
  {auto rr=__builtin_amdgcn_permlane32_swap(__float_as_uint(l_reg),__float_as_uint(l_reg),false,false);l_reg=__uint_as_float(rr[0])+__uint_as_float(rr[1]);}
  if(hi==0)wsf[32+r32]=l_reg;asm volatile("s_waitcnt lgkmcnt(0)":::"memory");
  float rli[16];
  #pragma unroll
  for(int r=0;r<16;++r)rli[r]=__builtin_amdgcn_rcpf(wsf[32+crow(r,hi)]);
  bf16*Ow=O+(rowbase+q0+wid*QBLK)*PO+h*D;
  { bf16*stg=(bf16*)(shm+LDS_OST)+wid*2048;
    #pragma unroll
    for(int r=0;r<16;++r){const int orow=crow(r,hi);
      #pragma unroll
      for(int d0=0;d0<2;++d0)stg[orow*64+d0*32+r32]=__float2bfloat16(o[d0][r]*rli[r]);}
    asm volatile("s_waitcnt lgkmcnt(0)":::"memory");
    #pragma unroll
    for(int i=0;i<4;++i){const int row=i*8+(lane>>3),ch=lane&7; const u32x4 v=*(const u32x4*)(stg+row*64+ch*8); ATTN_STORE16(Ow+(long)row*PO+ch*8,v);} }
  asm volatile("s_waitcnt lgkmcnt(0)\n\ts_barrier":::"memory");
  #undef DMA_K
  #undef TROW
  #undef SUBREF
  #undef DMA_V
  #undef CMASK
  #undef START
  #undef RESC
  #undef ROT
}
constexpr int ATTN_LDS_BYTES=LDS_BYTES;
#undef SBAR
#undef WAIT_BAR
}
constexpr int DM = 1024, NB = 16, SEQ = 2048, NT = NB * SEQ;
constexpr int RWW = 512, INC = 5376, ZA = 1792, ZG = 3328;
constexpr int NEXP = 32, DEXP = 512;
constexpr int XS_ROWS = 2 * NT + NEXP * 256;
constexpr float C2 = 0.125f * 1.4426950408889634f;

#define LAS __attribute__((address_space(3)))
#define GAS __attribute__((address_space(1)))
typedef unsigned short bf16;
typedef unsigned v4u __attribute__((ext_vector_type(4)));
typedef unsigned v2u __attribute__((ext_vector_type(2)));
typedef float f32x4 __attribute__((ext_vector_type(4)));

typedef float f32x2_c __attribute__((ext_vector_type(2))); typedef __bf16 bf16x2_c __attribute__((ext_vector_type(2)));
__device__ __forceinline__ unsigned pk2(float lo, float hi) { const f32x2_c v = {lo, hi}; return __builtin_bit_cast(unsigned, __builtin_convertvector(v, bf16x2_c)); }
__device__ __forceinline__ unsigned f2bf(float f) { return pk2(f, f) & 0xffffu; }
__device__ __forceinline__ float bflo(unsigned w) { return __builtin_bit_cast(float, w << 16); }
__device__ __forceinline__ float bfhi(unsigned w) { return __builtin_bit_cast(float, w & 0xffff0000u); }
__device__ __forceinline__ float sigm(float x) { return __builtin_amdgcn_rcpf(1.0f + __expf(-x)); }

constexpr size_t MiB = 1u << 20;
constexpr size_t WS_CTL = 0;
constexpr size_t WS_MOD = 1 * MiB;
constexpr size_t WS_GM2 = 1 * MiB + 512 * 1024;
constexpr size_t WS_CB = 1 * MiB + 640 * 1024;
constexpr size_t WS_COS = 2 * MiB;
constexpr size_t WS_SIN = 2 * MiB + 512 * 1024;
constexpr size_t WS_KMEAN = 3 * MiB;
constexpr size_t WS_WRH = 3 * MiB + 512 * 1024;
constexpr size_t WS_WRL = 3 * MiB + 768 * 1024;
constexpr size_t WS_SEL = 4 * MiB;
constexpr size_t WS_RTE = 5 * MiB;
constexpr size_t WS_RTW = 5 * MiB + 256 * 1024;
constexpr size_t WS_RNK = 5 * MiB + 512 * 1024;
constexpr size_t WS_POS = 5 * MiB + 768 * 1024;
constexpr size_t WS_WLT = 6 * MiB;
constexpr size_t WS_WAT = 6 * MiB + 64 * 1024;
constexpr size_t WS_WGT = 6 * MiB + 128 * 1024;
constexpr size_t WS_WIN = 16 * MiB;
constexpr size_t WS_WBA = 27 * MiB;
constexpr size_t WS_WBB = 28 * MiB;
constexpr size_t WS_WOUT = 29 * MiB;
constexpr size_t WS_Z = 32 * MiB;
constexpr size_t WS_H = 368 * MiB;
constexpr size_t WS_Q = 368 * MiB, WS_K = 400 * MiB, WS_MRG = 368 * MiB;
constexpr size_t WS_YA = 432 * MiB, WS_YB = 464 * MiB;
constexpr size_t WS_WUP = 32 * MiB;
constexpr size_t WS_W2T = 96 * MiB;
constexpr size_t WS_H2 = 128 * MiB;
constexpr size_t WS_XS = 192 * MiB;
constexpr size_t WS_HID = 336 * MiB;
constexpr size_t WS_X1B = 432 * MiB;
constexpr size_t WS_END = 496 * MiB;
constexpr int CW_CNT = 64, CNT_PAD = 64;
constexpr int CW_NT = 2304;
constexpr int CW_TEXP = 2368;
static_assert(CW_CNT + NEXP * CNT_PAD <= CW_NT, "control words");

__device__ __forceinline__ void tr_item(const float* W, int K, int N, bf16* WT, int kb, int nb, int dst_row0, LAS float* scr, int lane) {
    const int k0 = 64 * kb, n0 = 32 * nb;
#pragma unroll 8
    for (int i = 0; i < 32; ++i) { const int kk = 2 * i + (lane >> 5); scr[kk * 33 + (lane & 31)] = W[(size_t)(k0 + kk) * N + n0 + (lane & 31)]; }
    asm volatile("s_waitcnt lgkmcnt(0)" ::: "memory");
    const int c = lane & 7;
#pragma unroll
    for (int j = 0; j < 4; ++j) { const int n = (lane >> 3) + 8 * j; const LAS float* s = scr + (8 * c) * 33 + n;
        v4u o; o.x = pk2(s[0 * 33], s[1 * 33]); o.y = pk2(s[2 * 33], s[3 * 33]); o.z = pk2(s[4 * 33], s[5 * 33]); o.w = pk2(s[6 * 33], s[7 * 33]);
        *(v4u*)(WT + (size_t)(dst_row0 + n) * K + k0 + 8 * c) = o; }
    asm volatile("s_waitcnt lgkmcnt(0)" ::: "memory");
}

struct PArgs { const float* in[30]; float* out; unsigned char* ws; };

__device__ __forceinline__ void p_prep_weights(const PArgs& a, unsigned char* lds, int wv) {
    const int tid = mktid(wv), lane = tid & 63, wave = tid >> 6;
    LAS float* scr = (LAS float*)lds + wave * (64 * 33);
    const int gw = blockIdx.x * 8 + wave, NGW = gridDim.x * 8;
    unsigned char* ws = a.ws;
    constexpr int I_IN = 16 * 168, I_BR = 8 * 32, I_OUT = 16 * 32;
    for (int it = gw; it < I_IN + 2 * I_BR + I_OUT; it += NGW) {
        int r = it;
        if (r < I_IN) { const int kb = r / 168, nb = r % 168; tr_item(a.in[6], 1024, INC, (bf16*)(ws + WS_WIN), kb, nb, 32 * nb, scr, lane); continue; } r -= I_IN;
        if (r < I_BR) { const int kb = r / 32, nb = r % 32; tr_item(a.in[20], 512, 1024, (bf16*)(ws + WS_WBA), kb, nb, 32 * nb, scr, lane); continue; } r -= I_BR;
        if (r < I_BR) { const int kb = r / 32, nb = r % 32; tr_item(a.in[21], 512, 1024, (bf16*)(ws + WS_WBB), kb, nb, 32 * nb, scr, lane); continue; } r -= I_BR;
        { const int kb = r / 32, nb = r % 32; tr_item(a.in[22], 1024, 1024, (bf16*)(ws + WS_WOUT), kb, nb, 32 * nb, scr, lane); }
    }
    const int gt = blockIdx.x * 512 + tid, NGT = gridDim.x * 512;
    float* cosT = (float*)(ws + WS_COS); float* sinT = (float*)(ws + WS_SIN);
    for (int i = gt; i < SEQ * 32; i += NGT) { const int s = i >> 5, f = i & 31; const float inv = powf(10000.0f, -(float)f / 32.0f); const float ang = (float)s * inv; cosT[i] = cosf(ang); sinT[i] = sinf(ang); }
    { bf16* wlt = (bf16*)(ws + WS_WLT); bf16* wat = (bf16*)(ws + WS_WAT); bf16* wgt = (bf16*)(ws + WS_WGT);
      for (int i = gt; i < 8 * 64 * 64; i += NGT) { const int hh = i >> 12, j = (i >> 6) & 63, m = i & 63; wlt[i] = (bf16)f2bf(a.in[9][m * 512 + hh * 64 + j]); wat[i] = (bf16)f2bf(a.in[11][m * 512 + hh * 64 + j]); }
      for (int i = gt; i < 8 * 64 * 128; i += NGT) { const int hh = i >> 13, j = (i >> 7) & 63, m = i & 127; wgt[i] = (bf16)f2bf(a.in[12][m * 512 + hh * 64 + j]); } }
    { bf16* wrh = (bf16*)(ws + WS_WRH); bf16* wrl = (bf16*)(ws + WS_WRL);
      for (int i = gt; i < 48 * 1024; i += NGT) { const int e = i >> 10, k = i & 1023; const float w = e < 4 ? a.in[23][k * 4 + e] : e < 36 ? a.in[25][k * 32 + (e - 4)] : 0.f;
          const unsigned hi = f2bf(w); wrh[i] = (bf16)hi; wrl[i] = (bf16)f2bf(w - bflo(hi)); } }
}

__device__ __forceinline__ void p_prep_experts(const PArgs& a, unsigned char* lds, int wv) {
    const int tid = mktid(wv), lane = tid & 63, wave = tid >> 6;
    LAS float* scr = (LAS float*)lds + wave * (64 * 33);
    const int gw = blockIdx.x * 8 + wave, NGW = gridDim.x * 8;
    unsigned char* ws = a.ws;
    for (int it = gw; it < NEXP * 768; it += NGW) {
        const int e = it / 768; int r = it % 768;
        bf16* wup = (bf16*)(ws + WS_WUP) + (size_t)e * 1024 * 1024;
        if (r < 256) { const int kb = r / 16, nb = r % 16, n0 = 32 * nb; tr_item(a.in[27] + (size_t)e * 1024 * 512, 1024, 512, wup, kb, nb, (n0 >> 7) * 256 + (n0 & 127), scr, lane); continue; } r -= 256;
        if (r < 256) { const int kb = r / 16, nb = r % 16, n0 = 32 * nb; tr_item(a.in[28] + (size_t)e * 1024 * 512, 1024, 512, wup, kb, nb, (n0 >> 7) * 256 + 128 + (n0 & 127), scr, lane); continue; } r -= 256;
        { const int kb = r / 32, nb = r % 32; tr_item(a.in[29] + (size_t)e * 512 * 1024, 512, 1024, (bf16*)(ws + WS_W2T) + (size_t)e * 1024 * 512, kb, nb, 32 * nb, scr, lane); }
    }
}

__device__ __forceinline__ void p_ada(const PArgs& a, unsigned char* lds, int wv) {
    float* sc = (float*)lds; float* red = sc + 16 * 1024;
    const float* c = a.in[1]; const float* w = a.in[2]; const float* bias = a.in[3];
    float* mod = (float*)(a.ws + WS_MOD);
    const int tid = mktid(wv);
    for (int i = tid; i < 16 * 1024; i += 512) { const float v = c[i]; sc[i] = v / (1.0f + __expf(-v)); }
    __syncthreads();
    const int col = tid & 31, kg = tid >> 5;
    for (int tile = blockIdx.x; tile < 192; tile += gridDim.x) {
        const int e = tile * 32 + col;
        float acc[16];
#pragma unroll
        for (int b = 0; b < 16; ++b) acc[b] = 0.f;
        for (int d = kg * 64; d < kg * 64 + 64; ++d) { const float wv = w[(size_t)d * 6144 + e];
#pragma unroll
            for (int b = 0; b < 16; ++b) acc[b] += sc[b * 1024 + d] * wv; }
#pragma unroll
        for (int b = 0; b < 16; ++b) red[(kg * 16 + b) * 32 + col] = acc[b];
        __syncthreads();
        { const int b = tid >> 5, cc = tid & 31; float sm = 0.f;
#pragma unroll
            for (int k = 0; k < 16; ++k) sm += red[(k * 16 + b) * 32 + cc];
            mod[b * 6144 + tile * 32 + cc] = sm + bias[tile * 32 + cc]; }
        __syncthreads();
    }
}

__device__ __forceinline__ void p_norm1(const PArgs& a, unsigned char* lds, int wv) {
    const int tid = mktid(wv), lane = tid & 63, gw = blockIdx.x * 8 + (tid >> 6), NGW = gridDim.x * 8;
    const float* x = a.in[0]; const float* g = a.in[4]; const float* mod = (const float*)(a.ws + WS_MOD);
    bf16* h = (bf16*)(a.ws + WS_H);
    for (int m = gw; m < NT; m += NGW) {
        const int b = m >> 11; const f32x4* xr = (const f32x4*)(x + (size_t)m * DM) + lane; f32x4 v[4]; float s = 0.f;
#pragma unroll
        for (int j = 0; j < 4; ++j) { v[j] = xr[64 * j]; s += (v[j].x * v[j].x + v[j].y * v[j].y) + (v[j].z * v[j].z + v[j].w * v[j].w); }
        const float rstd = rsqrtf(wave_sum(s) * (1.0f / DM) + 1e-6f);
        v2u* o = (v2u*)(h + (size_t)m * DM) + lane;
#pragma unroll
        for (int j = 0; j < 4; ++j) { const int col = 4 * (lane + 64 * j);
            const f32x4 gg = *(const f32x4*)(g + col), sh = *(const f32x4*)(mod + b * 6144 + col), scl = *(const f32x4*)(mod + b * 6144 + 1024 + col);
            const f32x4 r = v[j] * rstd * gg * (scl + 1.0f) + sh; v2u w; w.x = pk2(r.x, r.y); w.y = pk2(r.z, r.w); o[64 * j] = w; }
    }
    { float* gm2 = (float*)(a.ws + WS_GM2); float* cb = (float*)(a.ws + WS_CB); const float* g2 = a.in[5];
      for (int i = blockIdx.x * 512 + tid; i < 16 * 1024; i += gridDim.x * 512) { const int b = i >> 10, k = i & 1023; gm2[i] = g2[k] * (1.0f + mod[b * 6144 + 4096 + k]); }
      for (int p = gw; p < 16 * 48; p += NGW) { const int b = p / 48, n = p % 48; float s = 0.f;
          if (n < 36) { for (int k = lane; k < 1024; k += 64) { const float w = n < 4 ? a.in[23][k * 4 + n] : a.in[25][k * 32 + (n - 4)]; s += mod[b * 6144 + 3072 + k] * w; } }
          s = wave_sum(s); if (lane == 0) cb[p] = n < 4 ? s + a.in[24][n] : n < 36 ? s + a.in[26][n - 4] : 0.f; } }
}

using pg8::Unit; using pg8::HALF; using pg8::BM; using pg8::cvt_pk_bf16;
typedef pg8::f32x4 pf4; typedef pg8::u32x4 pu4;

struct EpiStoreBf16 {
    static constexpr bool PERM = true, AFTER_DRAIN = false, CHAIN = false;
    bf16* O; int ldc;
    __device__ __forceinline__ void operator()(const pf4 (&acc)[2][2][4][2], const Unit& u, int wr, int wc, int fr, int fq) const {
        const int row0 = u.pm * BM + wr * 64 + fr, col0 = u.pn * BM + wc * 32 + 8 * fq;
#pragma unroll
        for (int ai = 0; ai < 2; ++ai)
#pragma unroll
            for (int m = 0; m < 4; ++m) { bf16* rowp = O + (size_t)(row0 + ai * HALF + m * 16) * ldc + col0;
#pragma unroll
                for (int bj = 0; bj < 2; ++bj) { const pf4 v0 = acc[ai][bj][m][0], v1 = acc[ai][bj][m][1]; pu4 w;
                    w.x = cvt_pk_bf16(v0[0], v0[1]); w.y = cvt_pk_bf16(v0[2], v0[3]); w.z = cvt_pk_bf16(v1[0], v1[1]); w.w = cvt_pk_bf16(v1[2], v1[3]);
                    *(pu4*)(rowp + bj * HALF) = w; } }
    }
};
struct EpiMerge {
    static constexpr bool PERM = true, AFTER_DRAIN = false, CHAIN = true;
    const bf16* z; bf16* mrg;
    __device__ __forceinline__ bool chain(pf4 (&acc)[2][2][4][2], const Unit& u, int wr, int wc, int fr, int fq) const {
        const int row0 = u.pm * BM + wr * 64 + fr, col0 = u.pn * BM + wc * 32 + 8 * fq;
        if (u.aux == 0) {
#pragma unroll
            for (int ai = 0; ai < 2; ++ai)
#pragma unroll
                for (int m = 0; m < 4; ++m) { const size_t row = (size_t)(row0 + ai * HALF + m * 16);
#pragma unroll
                    for (int bj = 0; bj < 2; ++bj) { const int col = col0 + bj * HALF; const pu4 za = *(const pu4*)(z + row * INC + ZG + col), zb = *(const pu4*)(z + row * INC + ZG + 1024 + col);
                        const float a8[8] = {bflo(za.x), bfhi(za.x), bflo(za.y), bfhi(za.y), bflo(za.z), bfhi(za.z), bflo(za.w), bfhi(za.w)};
                        const float b8[8] = {bflo(zb.x), bfhi(zb.x), bflo(zb.y), bfhi(zb.y), bflo(zb.z), bfhi(zb.z), bflo(zb.w), bfhi(zb.w)};
#pragma unroll
                        for (int e = 0; e < 8; ++e) acc[ai][bj][m][e >> 2][e & 3] *= (1.0f + __expf(-b8[e])) * __builtin_amdgcn_rcpf(1.0f + __expf(-a8[e])); } }
            return true;
        }
#pragma unroll
        for (int ai = 0; ai < 2; ++ai)
#pragma unroll
            for (int m = 0; m < 4; ++m) { const size_t row = (size_t)(row0 + ai * HALF + m * 16);
#pragma unroll
                for (int bj = 0; bj < 2; ++bj) { const int col = col0 + bj * HALF; const pu4 gz = *(const pu4*)(z + row * INC + ZG + 1024 + col); const pf4 v0 = acc[ai][bj][m][0], v1 = acc[ai][bj][m][1];
                    pu4 w;
                    w.x = cvt_pk_bf16(sigm(bflo(gz.x)) * v0[0], sigm(bfhi(gz.x)) * v0[1]); w.y = cvt_pk_bf16(sigm(bflo(gz.y)) * v0[2], sigm(bfhi(gz.y)) * v0[3]);
                    w.z = cvt_pk_bf16(sigm(bflo(gz.z)) * v1[0], sigm(bfhi(gz.z)) * v1[1]); w.w = cvt_pk_bf16(sigm(bflo(gz.w)) * v1[2], sigm(bfhi(gz.w)) * v1[3]);
                    *(pu4*)(mrg + row * DM + col) = w; } }
        return false;
    }
};
struct EpiOut {
    static constexpr bool PERM = true, AFTER_DRAIN = false, CHAIN = false;
    const float* x; const float* mod; bf16* x1;
    __device__ __forceinline__ void operator()(const pf4 (&acc)[2][2][4][2], const Unit& u, int wr, int wc, int fr, int fq) const {
        const int row0 = u.pm * BM + wr * 64 + fr, col0 = u.pn * BM + wc * 32 + 8 * fq; const int b = u.pm >> 3;
        pf4 gt[2][2];
#pragma unroll
        for (int bj = 0; bj < 2; ++bj)
#pragma unroll
            for (int n = 0; n < 2; ++n) gt[bj][n] = *(const pf4*)(mod + b * 6144 + 2048 + col0 + bj * HALF + n * 4);
#pragma unroll
        for (int ai = 0; ai < 2; ++ai)
#pragma unroll
            for (int m = 0; m < 4; ++m) { const size_t off = (size_t)(row0 + ai * HALF + m * 16) * DM + col0;
#pragma unroll
                for (int bj = 0; bj < 2; ++bj) { const pf4 x0 = *(const pf4*)(x + off + bj * HALF), x1v = *(const pf4*)(x + off + bj * HALF + 4);
                    const pf4 o0 = x0 + gt[bj][0] * acc[ai][bj][m][0], o1 = x1v + gt[bj][1] * acc[ai][bj][m][1]; pu4 w;
                    w.x = cvt_pk_bf16(o0[0], o0[1]); w.y = cvt_pk_bf16(o0[2], o0[3]); w.z = cvt_pk_bf16(o1[0], o1[1]); w.w = cvt_pk_bf16(o1[2], o1[3]);
                    *(pu4*)(x1 + off + bj * HALF) = w; } }
    }
};
struct EpiUp {
    static constexpr bool PERM = true, AFTER_DRAIN = false, CHAIN = false;
    bf16* hid;
    __device__ __forceinline__ void operator()(const pf4 (&acc)[2][2][4][2], const Unit& u, int wr, int wc, int fr, int fq) const {
        const int row0 = u.pm * BM + wr * 64 + fr, col0 = u.pn * 128 + wc * 32 + 8 * fq;
#pragma unroll
        for (int ai = 0; ai < 2; ++ai)
#pragma unroll
            for (int m = 0; m < 4; ++m) { const size_t row = (size_t)(row0 + ai * HALF + m * 16); float o[8];
#pragma unroll
                for (int n = 0; n < 2; ++n)
#pragma unroll
                    for (int e = 0; e < 4; ++e) { const float g = acc[ai][0][m][n][e], l = acc[ai][1][m][n][e]; o[4 * n + e] = g * sigm(g) * l; }
                pu4 w; w.x = cvt_pk_bf16(o[0], o[1]); w.y = cvt_pk_bf16(o[2], o[3]); w.z = cvt_pk_bf16(o[4], o[5]); w.w = cvt_pk_bf16(o[6], o[7]);
                *(pu4*)(hid + row * DEXP + col0) = w; }
    }
};

struct GemmArgs { unsigned char* ws; const float* x; float* out; };
template <class Epi> __device__ __forceinline__ void run_dense(const void* A, const void* Bt, int M, int N, int K, const Epi& E, unsigned char* lds, int wv) {
    pg8::Gemm g{K}; pg8::StaticOrder S; S.init(A, Bt, M, N, K, (int)gridDim.x, (int)blockIdx.x);
    pg8::gemm_phase<Epi, pg8::StaticOrder, true, true>((PG8_LAS unsigned char*)lds, g, S, E, wv);
}
__device__ __forceinline__ void p_gemm_in(const GemmArgs& a, unsigned char* lds, int wv) {
    EpiStoreBf16 E{(bf16*)(a.ws + WS_Z), INC};
    run_dense(a.ws + WS_H, a.ws + WS_WIN, NT, INC, 1024, E, lds, wv);
}
struct PairOrder {
    int nM, nN, nwg, G, c; const char *A0, *A1, *B0, *B1; size_t tstep;
    __device__ bool next(int i, Unit& u) const {
        const long L = (long)(i >> 1) * G + c; if (L >= nwg) return false;
        int wgid = (int)L; { const int q = nwg / pg8::NXCD, r = nwg % pg8::NXCD, xcd = wgid % pg8::NXCD, off = wgid / pg8::NXCD; wgid = (xcd < r ? xcd * (q + 1) : r * (q + 1) + (xcd - r) * q) + off; }
        const int nig = pg8::WGM * nN, gid = wgid / nig, fm = gid * pg8::WGM, gsz = (nM - fm) < pg8::WGM ? (nM - fm) : pg8::WGM;
        u.pm = fm + ((wgid % nig) % gsz); u.pn = (wgid % nig) / gsz; u.aux = i & 1;
        u.a = ((i & 1) ? A1 : A0) + (size_t)u.pm * tstep; u.b = ((i & 1) ? B1 : B0) + (size_t)u.pn * tstep; return true;
    }
    __device__ __forceinline__ void a_ready(const Unit&) const {}
    __device__ __forceinline__ void done(const Unit&) const {}
};
__device__ __forceinline__ void p_gemm_merge(const GemmArgs& a, unsigned char* lds, int wv) {
    PairOrder S{NT / 256, 4, (NT / 256) * 4, (int)gridDim.x, (int)blockIdx.x, (const char*)(a.ws + WS_YA), (const char*)(a.ws + WS_YB), (const char*)(a.ws + WS_WBA), (const char*)(a.ws + WS_WBB), (size_t)256 * 512 * 2};
    EpiMerge E{(const bf16*)(a.ws + WS_Z), (bf16*)(a.ws + WS_MRG)}; pg8::Gemm g{512};
    pg8::gemm_phase<EpiMerge, PairOrder, true, true>((PG8_LAS unsigned char*)lds, g, S, E, wv);
}
__device__ __forceinline__ void p_gemm_out(const GemmArgs& a, unsigned char* lds, int wv) {
    EpiOut E{a.x, (const float*)(a.ws + WS_MOD), (bf16*)(a.ws + WS_X1B)};
    run_dense(a.ws + WS_MRG, a.ws + WS_WOUT, NT, 1024, 1024, E, lds, wv);
}
struct GroupedOrder {
    const int* texp; int nT, nN, G, c; const char* A; size_t a_tile; const char* B; size_t b_exp, b_tile;
    __device__ bool next(int i, Unit& u) const {
        const long L = (long)i * G + c; if (L >= (long)nT * nN) return false;
        const int tile = (int)(L / nN), pn = (int)(L % nN); u.aux = 0; u.pm = tile; u.pn = pn; u.a = A + (size_t)tile * a_tile; u.b = B + (size_t)texp[tile] * b_exp + (size_t)pn * b_tile; return true;
    }
    __device__ __forceinline__ void a_ready(const Unit&) const {}
    __device__ __forceinline__ void done(const Unit&) const {}
};
__device__ __forceinline__ void p_gemm_up(const GemmArgs& a, unsigned char* lds, int wv) {
    const int* ctl = (const int*)(a.ws + WS_CTL);
    GroupedOrder S{ctl + CW_TEXP, ctl[CW_NT], 4, (int)gridDim.x, (int)blockIdx.x, (const char*)(a.ws + WS_XS), (size_t)256 * 1024 * 2, (const char*)(a.ws + WS_WUP), (size_t)1024 * 1024 * 2, (size_t)256 * 1024 * 2};
    EpiUp E{(bf16*)(a.ws + WS_HID)}; pg8::Gemm g{1024};
    pg8::gemm_phase<EpiUp, GroupedOrder, true, true>((PG8_LAS unsigned char*)lds, g, S, E, wv);
}
__device__ __forceinline__ void p_gemm_down(const GemmArgs& a, unsigned char* lds, int wv) {
    const int* ctl = (const int*)(a.ws + WS_CTL);
    GroupedOrder S{ctl + CW_TEXP, ctl[CW_NT], 4, (int)gridDim.x, (int)blockIdx.x, (const char*)(a.ws + WS_HID), (size_t)256 * 512 * 2, (const char*)(a.ws + WS_W2T), (size_t)1024 * 512 * 2, (size_t)256 * 512 * 2};
    EpiStoreBf16 E{(bf16*)(a.ws + WS_XS), 1024}; pg8::Gemm g{512};
    pg8::gemm_phase<EpiStoreBf16, GroupedOrder, true, true>((PG8_LAS unsigned char*)lds, g, S, E, wv);
}

__device__ __forceinline__ void load64bf(const bf16* p, float (&v)[64]) {
#pragma unroll
    for (int i = 0; i < 8; ++i) { const v4u w = *(const v4u*)(p + 8 * i);
        v[8 * i + 0] = bflo(w.x); v[8 * i + 1] = bfhi(w.x); v[8 * i + 2] = bflo(w.y); v[8 * i + 3] = bfhi(w.y);
        v[8 * i + 4] = bflo(w.z); v[8 * i + 5] = bfhi(w.z); v[8 * i + 6] = bflo(w.w); v[8 * i + 7] = bfhi(w.w); }
}
__device__ __forceinline__ void store64bf(bf16* p, const float (&v)[64], float sc) {
#pragma unroll
    for (int i = 0; i < 8; ++i) { v4u w; w.x = pk2(v[8 * i] * sc, v[8 * i + 1] * sc); w.y = pk2(v[8 * i + 2] * sc, v[8 * i + 3] * sc); w.z = pk2(v[8 * i + 4] * sc, v[8 * i + 5] * sc); w.w = pk2(v[8 * i + 6] * sc, v[8 * i + 7] * sc);
        *(v4u*)(p + 8 * i) = w; }
}
__device__ __forceinline__ void norm_rope(float (&v)[64], const float* g, const float* cosT, const float* sinT, int s) {
    float ss = 0.f;
#pragma unroll
    for (int d = 0; d < 64; ++d) ss += v[d] * v[d];
    const float rstd = rsqrtf(ss * (1.0f / 64.0f) + 1e-6f);
#pragma unroll
    for (int d = 0; d < 64; ++d) v[d] = v[d] * rstd * g[d];
#pragma unroll
    for (int i = 0; i < 32; ++i) { const float c = cosT[s * 32 + i], sn = sinT[s * 32 + i]; const float x1 = v[i], x2 = v[i + 32]; v[i] = x1 * c - x2 * sn; v[i + 32] = x2 * c + x1 * sn; }
}
__device__ __forceinline__ void p_kprep(const PArgs& a, unsigned char* lds, int wv) {
    float* tile = (float*)lds + (mktid(wv) >> 8) * (256 * 65); float* red = (float*)lds + 2 * 256 * 65;
    const int tid = mktid(wv), half = tid >> 8, t256 = tid & 255;
    const bf16* z = (const bf16*)(a.ws + WS_Z);
    for (int base = blockIdx.x * 2; base < 1024; base += gridDim.x * 2) {
        const int blk = base + half; const bool ok = blk < 1024; const int h = blk & 7, n = (blk >> 3) & 7, b = (blk >> 6) & 15;
        const int s = n * 256 + t256; const size_t t = (size_t)b * SEQ + s;
        float v[64]; load64bf(z + t * INC + ZA + 512 + h * 64, v);
        norm_rope(v, a.in[19], (const float*)(a.ws + WS_COS), (const float*)(a.ws + WS_SIN), s);
        if (ok) store64bf((bf16*)(a.ws + WS_K) + t * 512 + h * 64, v, 1.0f);
#pragma unroll
        for (int d = 0; d < 64; ++d) tile[t256 * 65 + d] = v[d];
        __syncthreads();
        { const int d = t256 & 63, part = t256 >> 6; float sm = 0.f;
#pragma unroll 8
            for (int r = 0; r < 64; ++r) sm += tile[(part * 64 + r) * 65 + d];
            red[(half * 4 + part) * 64 + d] = sm; }
        __syncthreads();
        if (t256 < 64 && ok) { const float* r = red + half * 256; ((float*)(a.ws + WS_KMEAN))[(size_t)((b * 8 + h) * 8 + n) * 64 + t256] = ((r[t256] + r[64 + t256]) + (r[128 + t256] + r[192 + t256])) * (1.0f / 256.0f); }
        __syncthreads();
    }
}
__device__ __forceinline__ void p_qprep(const PArgs& a, unsigned char* lds, int wv) {
    const int tid = mktid(wv), half = tid >> 8, t256 = tid & 255;
    const bf16* z = (const bf16*)(a.ws + WS_Z);
    for (int base = blockIdx.x * 2; base < 1024; base += gridDim.x * 2) {
        const int blk = base + half; if (blk >= 1024) continue;
        const int h = blk & 7, n = (blk >> 3) & 7, b = blk >> 6;
        const int s = n * 256 + t256; const size_t t = (size_t)b * SEQ + s;
        float v[64]; load64bf(z + t * INC + ZA + h * 64, v);
        norm_rope(v, a.in[18], (const float*)(a.ws + WS_COS), (const float*)(a.ws + WS_SIN), s);
        const float* km = (const float*)(a.ws + WS_KMEAN) + (size_t)((b * 8 + h) * 8) * 64;
        float gate[7];
#pragma unroll
        for (int j = 0; j < 7; ++j) { float g = 0.f; if (j < n) {
#pragma unroll
                for (int d = 0; d < 64; ++d) g += v[d] * km[j * 64 + d]; }
            gate[j] = g; }
        unsigned sel = 0;
        if (n <= 3) sel = (1u << n) - 1u;
        else {
#pragma unroll
            for (int rep = 0; rep < 3; ++rep) { float best = -INFINITY; int bi = 0;
#pragma unroll
                for (int j = 0; j < 7; ++j) if (j < n && !((sel >> j) & 1u) && gate[j] > best) { best = gate[j]; bi = j; }
                sel |= 1u << bi; }
        }
        ((unsigned char*)(a.ws + WS_SEL))[(size_t)(b * 8 + h) * SEQ + s] = (unsigned char)sel;
        store64bf((bf16*)(a.ws + WS_Q) + t * 512 + h * 64, v, C2);
    }
}

__device__ __forceinline__ void p_attn(const PArgs& a, unsigned char* lds, int vb, int nvb, int wv) {
    const attn_body::bf16* Q = (const attn_body::bf16*)(a.ws + WS_Q); const attn_body::bf16* K = (const attn_body::bf16*)(a.ws + WS_K);
    const attn_body::bf16* V = (const attn_body::bf16*)(a.ws + WS_Z) + (ZA + 1024); attn_body::bf16* O = (attn_body::bf16*)(a.ws + WS_YB);
    const unsigned char* SEL = (const unsigned char*)(a.ws + WS_SEL);
    for (int p = vb; p < 512; p += nvb)
        for (int which = 0; which < 2; ++which) { const int bh = p >> 2, s = p & 3, qb = which ? 7 - s : s;
            attn_body::attn_unit<8>(bh >> 3, bh & 7, qb, Q, K, V, O, SEL, (char*)lds, wv); }
}

namespace rw {
typedef short bf16x8 __attribute__((ext_vector_type(8)));
constexpr int RS = 72, RSB = RS * 2, MB = 64 * RSB;
constexpr int FS = 68;
enum { I_AT = 0, I_BT, I_AJ, I_BHJ, I_KHJ, I_X5, I_ABRT, I_L, I_LT, I_R0, I_R1, I_KT, I_RT, I_VJ, I_X14, I_GATE, I_VT, NBUF };
constexpr int OFF_F32 = NBUF * MB;
constexpr int OFF_CST = OFF_F32 + (64 * 3 + 512) * 4;
constexpr int LDS_NEED = OFF_CST + 14 * 64 * 4;

__device__ __forceinline__ bf16x8 ldfrag(const unsigned char* M, int row, int k) { return *(const bf16x8*)(M + row * RSB + k * 2); }
__device__ __forceinline__ void mm(f32x4 (&acc)[2], const unsigned char* X, const unsigned char* Y, int mt, int nh, int fr, int fq) {
    const bf16x8 a0 = ldfrag(X, 16 * mt + fr, 8 * fq), a1 = ldfrag(X, 16 * mt + fr, 8 * fq + 32);
#pragma unroll
    for (int nt = 0; nt < 2; ++nt) { const bf16x8 b0 = ldfrag(Y, 16 * (2 * nh + nt) + fr, 8 * fq), b1 = ldfrag(Y, 16 * (2 * nh + nt) + fr, 8 * fq + 32);
        acc[nt] = __builtin_amdgcn_mfma_f32_16x16x32_bf16(a0, b0, acc[nt], 0, 0, 0); acc[nt] = __builtin_amdgcn_mfma_f32_16x16x32_bf16(a1, b1, acc[nt], 0, 0, 0); }
}
__device__ __forceinline__ void storeT(unsigned char* Z, const f32x4 (&acc)[2], int mt, int nh, int fr, int fq) {
#pragma unroll
    for (int nt = 0; nt < 2; ++nt) { v2u w; w.x = pk2(acc[nt][0], acc[nt][1]); w.y = pk2(acc[nt][2], acc[nt][3]); *(v2u*)(Z + (16 * (2 * nh + nt) + fr) * RSB + (16 * mt + 4 * fq) * 2) = w; }
}
__device__ __forceinline__ void storeN(unsigned char* Z, const f32x4 (&acc)[2], int mt, int nh, int fr, int fq) {
#pragma unroll
    for (int nt = 0; nt < 2; ++nt)
#pragma unroll
        for (int r = 0; r < 4; ++r) *(unsigned short*)(Z + (16 * mt + 4 * fq + r) * RSB + (16 * (2 * nh + nt) + fr) * 2) = (unsigned short)f2bf(acc[nt][r]);
}
__device__ __forceinline__ void ld8bf(const unsigned char* p, float (&v)[8]) { const v4u w = *(const v4u*)p; v[0] = bflo(w.x); v[1] = bfhi(w.x); v[2] = bflo(w.y); v[3] = bfhi(w.y); v[4] = bflo(w.z); v[5] = bfhi(w.z); v[6] = bflo(w.w); v[7] = bfhi(w.w); }
__device__ __forceinline__ void st8bf(unsigned char* p, const float (&v)[8]) { v4u w; w.x = pk2(v[0], v[1]); w.y = pk2(v[2], v[3]); w.z = pk2(v[4], v[5]); w.w = pk2(v[6], v[7]); *(v4u*)p = w; }
__device__ __forceinline__ void ld8f(const float* p, float (&v)[8]) { const f32x4 a = *(const f32x4*)p, b = *(const f32x4*)(p + 4); v[0] = a.x; v[1] = a.y; v[2] = a.z; v[3] = a.w; v[4] = b.x; v[5] = b.y; v[6] = b.z; v[7] = b.w; }
__device__ __forceinline__ void un8(const v4u w, float (&v)[8]) { v[0] = bflo(w.x); v[1] = bfhi(w.x); v[2] = bflo(w.y); v[3] = bfhi(w.y); v[4] = bflo(w.z); v[5] = bfhi(w.z); v[6] = bflo(w.w); v[7] = bfhi(w.w); }
__device__ __forceinline__ void shift8(const v4u cw, const v4u pw, bool hasp, const float* mu, float (&v)[8]) {
    float c[8], p[8], m[8]; un8(cw, c); un8(pw, p); ld8f(mu, m);
#pragma unroll
    for (int e = 0; e < 8; ++e) { const float pe = hasp ? p[e] : 0.f; v[e] = c[e] + (pe - c[e]) * m[e]; }
}
__device__ __forceinline__ float tanh_fast(float x) { return 1.0f - 2.0f * __builtin_amdgcn_rcpf(1.0f + __expf(2.0f * x)); }

#define LBAR() do { asm volatile("s_waitcnt lgkmcnt(0)" ::: "memory"); __builtin_amdgcn_s_barrier(); asm volatile("" ::: "memory"); } while (0)
__device__ __forceinline__ void scan_unit(const PArgs& a, unsigned char* lds, int bh, int wv) {
    const int tid = mktid(wv), lane = tid & 63, wid = __builtin_amdgcn_readfirstlane(tid >> 6);
    const int mt = wid >> 1, nh = wid & 1, fr = lane & 15, fq = lane >> 4;
    const int b = bh >> 3, h = bh & 7;
#define BUF(i) (lds + (i) * MB)
    float* GC = (float*)(lds + OFF_F32); float* BON = GC + 64; float* LEND = BON + 64; float* SEGT = LEND + 64;
    float* LWR = (float*)BUF(I_AT); float* LAR = (float*)BUF(I_AJ); float* LGR = (float*)BUF(I_L); float* LW = (float*)BUF(I_R0); float* YTF = (float*)BUF(I_L);
    unsigned char* ACTW = BUF(I_L); unsigned char* ACTA = BUF(I_LT); unsigned char* ACTG = BUF(I_R0);
    const bf16* z = (const bf16*)(a.ws + WS_Z); bf16* ya = (bf16*)(a.ws + WS_YA);
    const float* mu = a.in[7];
    bf16x8 fw[2], fa[2], fg[4];
    { const bf16* wlt = (const bf16*)(a.ws + WS_WLT) + (size_t)h * 4096 + (16 * mt + fr) * 64 + 8 * fq; const bf16* wat = (const bf16*)(a.ws + WS_WAT) + (size_t)h * 4096 + (16 * mt + fr) * 64 + 8 * fq;
      const bf16* wgt = (const bf16*)(a.ws + WS_WGT) + (size_t)h * 8192 + (16 * mt + fr) * 128 + 8 * fq;
      fw[0] = *(const bf16x8*)wlt; fw[1] = *(const bf16x8*)(wlt + 32); fa[0] = *(const bf16x8*)wat; fa[1] = *(const bf16x8*)(wat + 32);
#pragma unroll
      for (int ks = 0; ks < 4; ++ks) fg[ks] = *(const bf16x8*)(wgt + 32 * ks); }
    float* CST = (float*)(lds + OFF_CST);
    for (int i = tid; i < 14 * 64; i += 512) { const int blk = i >> 6, jj = i & 63; float v;
        if (blk < 3) v = mu[blk * 512 + h * 64 + jj]; else if (blk < 7) v = mu[1536 + (blk - 3) * 64 + jj]; else v = a.in[blk == 7 ? 8 : blk == 8 ? 10 : blk == 9 ? 13 : blk == 10 ? 14 : blk == 11 ? 15 : blk == 12 ? 16 : 17][h * 64 + jj];
        CST[i] = v; }
    int s0i = I_X14, aki = I_X5;
    for (int i = tid; i < MB / 4; i += 512) ((unsigned*)BUF(I_X14))[i] = 0u;
    LBAR();
    const int pt = tid >> 3, pg = tid & 7, j0 = 8 * pg;
    const int colh = h * 64 + j0;
    const int zoff0 = colh, zoff1 = 512 + colh, zoff2 = 1024 + colh, zoff3 = 1536 + j0, zoff4 = 1600 + j0, zoff5 = 1664 + j0, zoff6 = 1728 + j0;
    v4u zc[7], zq[7];
#define ZLOAD(cc) do { const bf16* zr_ = z + ((size_t)b * SEQ + (cc) * 64 + pt) * INC; const bf16* zs_ = ((cc) * 64 + pt) > 0 ? zr_ - INC : zr_; \
        zc[0] = *(const v4u*)(zr_ + zoff0); zc[1] = *(const v4u*)(zr_ + zoff1); zc[2] = *(const v4u*)(zr_ + zoff2); zc[3] = *(const v4u*)(zr_ + zoff3); zc[4] = *(const v4u*)(zr_ + zoff4); zc[5] = *(const v4u*)(zr_ + zoff5); zc[6] = *(const v4u*)(zr_ + zoff6); \
        zq[0] = *(const v4u*)(zs_ + zoff0); zq[1] = *(const v4u*)(zs_ + zoff1); zq[2] = *(const v4u*)(zs_ + zoff2); zq[3] = *(const v4u*)(zs_ + zoff3); zq[4] = *(const v4u*)(zs_ + zoff4); zq[5] = *(const v4u*)(zs_ + zoff5); zq[6] = *(const v4u*)(zs_ + zoff6); } while (0)
    ZLOAD(0);
    for (int c = 0; c < SEQ / 64; ++c) {
        const int s = c * 64 + pt; const size_t t = (size_t)b * SEQ + s; const bool hasp = s > 0;
        { float v[8];
          shift8(zc[0], zq[0], hasp, CST + 0 * 64 + j0, v); st8bf(BUF(I_RT) + pt * RSB + j0 * 2, v);
          shift8(zc[1], zq[1], hasp, CST + 1 * 64 + j0, v); st8bf(BUF(I_KT) + pt * RSB + j0 * 2, v);
          shift8(zc[2], zq[2], hasp, CST + 2 * 64 + j0, v); st8bf(BUF(I_VT) + pt * RSB + j0 * 2, v);
#pragma unroll
          for (int e = 0; e < 8; ++e) *(unsigned short*)(BUF(I_VJ) + (j0 + e) * RSB + pt * 2) = (unsigned short)f2bf(v[e]);
          shift8(zc[3], zq[3], hasp, CST + 3 * 64 + j0, v);
#pragma unroll
          for (int e = 0; e < 8; ++e) v[e] = tanh_fast(v[e]);
          st8bf(ACTW + pt * RSB + j0 * 2, v);
          shift8(zc[4], zq[4], hasp, CST + 4 * 64 + j0, v); st8bf(ACTA + pt * RSB + j0 * 2, v);
          shift8(zc[5], zq[5], hasp, CST + 5 * 64 + j0, v);
#pragma unroll
          for (int e = 0; e < 8; ++e) v[e] = sigm(v[e]);
          st8bf(ACTG + pt * 272 + j0 * 2, v);
          shift8(zc[6], zq[6], hasp, CST + 6 * 64 + j0, v);
#pragma unroll
          for (int e = 0; e < 8; ++e) v[e] = sigm(v[e]);
          st8bf(ACTG + pt * 272 + (64 + j0) * 2, v); }
        LBAR();
        f32x4 aw[2], aa[2], ag[2];
#pragma unroll
        for (int nt = 0; nt < 2; ++nt) { const int tr = 16 * (2 * nh + nt) + fr; const f32x4 zero = {0.f, 0.f, 0.f, 0.f};
            aw[nt] = __builtin_amdgcn_mfma_f32_16x16x32_bf16(fw[0], ldfrag(ACTW, tr, 8 * fq), zero, 0, 0, 0); aw[nt] = __builtin_amdgcn_mfma_f32_16x16x32_bf16(fw[1], ldfrag(ACTW, tr, 8 * fq + 32), aw[nt], 0, 0, 0);
            aa[nt] = __builtin_amdgcn_mfma_f32_16x16x32_bf16(fa[0], ldfrag(ACTA, tr, 8 * fq), zero, 0, 0, 0); aa[nt] = __builtin_amdgcn_mfma_f32_16x16x32_bf16(fa[1], ldfrag(ACTA, tr, 8 * fq + 32), aa[nt], 0, 0, 0);
            ag[nt] = zero;
#pragma unroll
            for (int ks = 0; ks < 4; ++ks) ag[nt] = __builtin_amdgcn_mfma_f32_16x16x32_bf16(fg[ks], *(const bf16x8*)(ACTG + tr * 272 + (8 * fq + 32 * ks) * 2), ag[nt], 0, 0, 0); }
        LBAR();
#pragma unroll
        for (int nt = 0; nt < 2; ++nt) { const int tr = 16 * (2 * nh + nt) + fr, jc = 16 * mt + 4 * fq;
            *(f32x4*)(LWR + tr * FS + jc) = aw[nt]; *(f32x4*)(LAR + tr * FS + jc) = aa[nt]; *(f32x4*)(LGR + tr * FS + jc) = ag[nt]; }
        LBAR();
        float lwv[8], an[8], bb[8], k2[8], rr[8], gg[8];
        { float lw8[8], la8[8], kx[8], w0v[8], a0v[8], kkc[8], kac[8], rkc[8];
          ld8f(LWR + pt * FS + j0, lw8); ld8f(LAR + pt * FS + j0, la8); ld8f(LGR + pt * FS + j0, gg);
          ld8bf(BUF(I_RT) + pt * RSB + j0 * 2, rr); ld8bf(BUF(I_KT) + pt * RSB + j0 * 2, kx);
          ld8f(CST + 7 * 64 + j0, w0v); ld8f(CST + 8 * 64 + j0, a0v); ld8f(CST + 9 * 64 + j0, kkc); ld8f(CST + 10 * 64 + j0, kac); ld8f(CST + 11 * 64 + j0, rkc);
          float ss = 0.f, bon = 0.f, av[8];
#pragma unroll
          for (int e = 0; e < 8; ++e) { lwv[e] = -0.606531f * sigm(w0v[e] + lw8[e]); av[e] = sigm(a0v[e] + la8[e]); an[e] = kx[e] * kkc[e]; ss += an[e] * an[e];
              k2[e] = kx[e] * (1.0f + (av[e] - 1.0f) * kac[e]); bon += rr[e] * k2[e] * rkc[e]; }
          ss = red8(ss); bon = red8(bon);
          const float inv = rsqrtf(fmaxf(ss, 1e-24f));
#pragma unroll
          for (int e = 0; e < 8; ++e) { const float kn = an[e] * inv; an[e] = -kn; bb[e] = kn * av[e]; }
          *(f32x4*)(LW + pt * FS + j0) = (f32x4){lwv[0], lwv[1], lwv[2], lwv[3]}; *(f32x4*)(LW + pt * FS + j0 + 4) = (f32x4){lwv[4], lwv[5], lwv[6], lwv[7]};
          if (pg == 0) BON[pt] = bon; }
        LBAR();
        { const int j = tid & 63, sg = tid >> 6; float run = 0.f;
#pragma unroll
          for (int u = 0; u < 8; ++u) { run += LW[(8 * sg + u) * FS + j]; LW[(8 * sg + u) * FS + j] = run; }
          SEGT[sg * 64 + j] = run; }
        LBAR();
        if (tid < 64) { float run = 0.f;
#pragma unroll
            for (int sg = 0; sg < 8; ++sg) { const float tmp = SEGT[sg * 64 + tid]; SEGT[sg * 64 + tid] = run; run += tmp; }
            LEND[tid] = run; GC[tid] = __expf(run); }
        LBAR();
        { float Lc[8], sgp[8], le[8], o0[8], o1[8], o2[8], o3[8];
          ld8f(LW + pt * FS + j0, Lc); ld8f(SEGT + (pt >> 3) * 64 + j0, sgp); ld8f(LEND + j0, le);
#pragma unroll
          for (int e = 0; e < 8; ++e) { const float L = Lc[e] + sgp[e]; const float e1 = __expf(L), ie1 = __expf(-L), ep = __expf(L - lwv[e]), eh = __expf(le[e] - L);
              o0[e] = an[e] * ep; o1[e] = bb[e] * ie1; o2[e] = k2[e] * ie1; o3[e] = rr[e] * e1; Lc[e] = bb[e] * eh; sgp[e] = k2[e] * eh; }
          st8bf(BUF(I_AT) + pt * RSB + j0 * 2, o0); st8bf(BUF(I_BT) + pt * RSB + j0 * 2, o1); st8bf(BUF(I_KT) + pt * RSB + j0 * 2, o2); st8bf(BUF(I_RT) + pt * RSB + j0 * 2, o3);
          st8bf(BUF(I_GATE) + pt * RSB + j0 * 2, gg);
#pragma unroll
          for (int e = 0; e < 8; ++e) { *(unsigned short*)(BUF(I_AJ) + (j0 + e) * RSB + pt * 2) = (unsigned short)f2bf(o0[e]); *(unsigned short*)(BUF(I_BHJ) + (j0 + e) * RSB + pt * 2) = (unsigned short)f2bf(Lc[e]);
              *(unsigned short*)(BUF(I_KHJ) + (j0 + e) * RSB + pt * 2) = (unsigned short)f2bf(sgp[e]); } }
        if (c + 1 < SEQ / 64) ZLOAD(c + 1);
        LBAR();
        { const f32x4 zero = {0.f, 0.f, 0.f, 0.f}; f32x4 acc[2] = {zero, zero};
          mm(acc, BUF(I_AT), BUF(I_BT), mt, nh, fr, fq);
#pragma unroll
          for (int nt = 0; nt < 2; ++nt)
#pragma unroll
              for (int r = 0; r < 4; ++r) { const int m = 16 * mt + 4 * fq + r, n = 16 * (2 * nh + nt) + fr; if (!(m > n)) acc[nt][r] = 0.f; }
          storeN(BUF(I_L), acc, mt, nh, fr, fq); storeT(BUF(I_LT), acc, mt, nh, fr, fq);
#pragma unroll
          for (int nt = 0; nt < 2; ++nt)
#pragma unroll
              for (int r = 0; r < 4; ++r) { const int m = 16 * mt + 4 * fq + r, n = 16 * (2 * nh + nt) + fr; if (m == n) acc[nt][r] = 1.0f; }
          storeN(BUF(I_R0), acc, mt, nh, fr, fq);
          acc[0] = zero; acc[1] = zero; mm(acc, BUF(I_AT), BUF(I_KT), mt, nh, fr, fq);
#pragma unroll
          for (int nt = 0; nt < 2; ++nt)
#pragma unroll
              for (int r = 0; r < 4; ++r) { const int m = 16 * mt + 4 * fq + r, n = 16 * (2 * nh + nt) + fr; if (!(n < m)) acc[nt][r] = 0.f; }
          storeT(BUF(aki), acc, mt, nh, fr, fq);
          acc[0] = zero; acc[1] = zero; mm(acc, BUF(I_BT), BUF(I_RT), mt, nh, fr, fq);
#pragma unroll
          for (int nt = 0; nt < 2; ++nt)
#pragma unroll
              for (int r = 0; r < 4; ++r) { const int m = 16 * mt + 4 * fq + r, n = 16 * (2 * nh + nt) + fr; if (!(m <= n)) acc[nt][r] = 0.f; }
          storeT(BUF(I_ABRT), acc, mt, nh, fr, fq); }
        LBAR();
#pragma unroll
        for (int k = 1; k <= 6; ++k) {
            unsigned char* Pc = (k & 1) ? BUF(I_L) : BUF(I_AT); unsigned char* PTc = (k & 1) ? BUF(I_LT) : BUF(I_BT);
            unsigned char* Pn = (k & 1) ? BUF(I_AT) : BUF(I_L); unsigned char* PTn = (k & 1) ? BUF(I_BT) : BUF(I_LT);
            unsigned char* Rc = (k & 1) ? BUF(I_R1) : BUF(I_R0); unsigned char* Rn = (k & 1) ? BUF(I_R0) : BUF(I_R1);
            const f32x4 zero = {0.f, 0.f, 0.f, 0.f};
            if (k <= 5) { f32x4 acc[2] = {zero, zero}; mm(acc, Pc, PTc, mt, nh, fr, fq); storeN(Pn, acc, mt, nh, fr, fq); storeT(PTn, acc, mt, nh, fr, fq); }
            if (k >= 2) { f32x4 acc[2];
#pragma unroll
                for (int nt = 0; nt < 2; ++nt) { const v2u w = *(const v2u*)(Rc + (16 * (2 * nh + nt) + fr) * RSB + (16 * mt + 4 * fq) * 2); acc[nt] = (f32x4){bflo(w.x), bfhi(w.x), bflo(w.y), bfhi(w.y)}; }
                mm(acc, PTc, Rc, mt, nh, fr, fq); storeT(Rn, acc, mt, nh, fr, fq); }
            LBAR();
        }
        { const f32x4 zero = {0.f, 0.f, 0.f, 0.f}; f32x4 acc[2] = {zero, zero};
          mm(acc, BUF(I_R1), BUF(I_AJ), mt, nh, fr, fq); storeT(BUF(I_L), acc, mt, nh, fr, fq);
          acc[0] = zero; acc[1] = zero; mm(acc, BUF(I_R1), BUF(aki), mt, nh, fr, fq); storeT(BUF(I_LT), acc, mt, nh, fr, fq); }
        LBAR();
        { const f32x4 zero = {0.f, 0.f, 0.f, 0.f}; f32x4 acc[2];
#pragma unroll
          for (int nt = 0; nt < 2; ++nt) { const v2u w = *(const v2u*)(BUF(I_RT) + (16 * (2 * nh + nt) + fr) * RSB + (16 * mt + 4 * fq) * 2); acc[nt] = (f32x4){bflo(w.x), bfhi(w.x), bflo(w.y), bfhi(w.y)}; }
          mm(acc, BUF(I_L), BUF(I_ABRT), mt, nh, fr, fq); storeT(BUF(I_AT), acc, mt, nh, fr, fq);
          acc[0] = zero; acc[1] = zero; mm(acc, BUF(I_KT), BUF(I_RT), mt, nh, fr, fq);
#pragma unroll
          for (int nt = 0; nt < 2; ++nt)
#pragma unroll
              for (int r = 0; r < 4; ++r) { const int m = 16 * mt + 4 * fq + r, n = 16 * (2 * nh + nt) + fr; if (!(m <= n)) acc[nt][r] = 0.f; }
          mm(acc, BUF(I_LT), BUF(I_ABRT), mt, nh, fr, fq); storeT(BUF(I_BT), acc, mt, nh, fr, fq);
          acc[0] = zero; acc[1] = zero; mm(acc, BUF(I_L), BUF(I_BHJ), mt, nh, fr, fq);
#pragma unroll
          for (int nt = 0; nt < 2; ++nt)
#pragma unroll
              for (int r = 0; r < 4; ++r) { const int m = 16 * mt + 4 * fq + r, n = 16 * (2 * nh + nt) + fr; if (m == n) acc[nt][r] += GC[m]; }
          storeT(BUF(I_AJ), acc, mt, nh, fr, fq);
#pragma unroll
          for (int nt = 0; nt < 2; ++nt) { const v2u w = *(const v2u*)(BUF(I_KHJ) + (16 * (2 * nh + nt) + fr) * RSB + (16 * mt + 4 * fq) * 2); acc[nt] = (f32x4){bflo(w.x), bfhi(w.x), bflo(w.y), bfhi(w.y)}; }
          mm(acc, BUF(I_LT), BUF(I_BHJ), mt, nh, fr, fq); storeT(BUF(I_R0), acc, mt, nh, fr, fq); }
        LBAR();
        { const f32x4 zero = {0.f, 0.f, 0.f, 0.f}; f32x4 acc[2] = {zero, zero};
          mm(acc, BUF(s0i), BUF(I_AT), mt, nh, fr, fq); mm(acc, BUF(I_VJ), BUF(I_BT), mt, nh, fr, fq);
#pragma unroll
          for (int nt = 0; nt < 2; ++nt) *(f32x4*)(YTF + (16 * (2 * nh + nt) + fr) * FS + 16 * mt + 4 * fq) = acc[nt];
          acc[0] = zero; acc[1] = zero; mm(acc, BUF(I_AJ), BUF(s0i), mt, nh, fr, fq); mm(acc, BUF(I_R0), BUF(I_VJ), mt, nh, fr, fq);
          storeT(BUF(aki), acc, mt, nh, fr, fq); }
        LBAR();
        { float y[8], vv[8], g8[8], lg[8], lb[8]; ld8f(YTF + pt * FS + j0, y); ld8bf(BUF(I_VT) + pt * RSB + j0 * 2, vv); ld8bf(BUF(I_GATE) + pt * RSB + j0 * 2, g8);
          ld8f(CST + 12 * 64 + j0, lg); ld8f(CST + 13 * 64 + j0, lb);
          float sm = 0.f;
#pragma unroll
          for (int e = 0; e < 8; ++e) sm += y[e];
          const float mean = red8(sm) * (1.0f / 64.0f); float sq = 0.f;
#pragma unroll
          for (int e = 0; e < 8; ++e) { y[e] -= mean; sq += y[e] * y[e]; }
          const float rstd = rsqrtf(red8(sq) * (1.0f / 64.0f) + 64e-5f), bon = BON[pt];
#pragma unroll
          for (int e = 0; e < 8; ++e) y[e] = (y[e] * rstd * lg[e] + lb[e] + bon * vv[e]) * g8[e];
          st8bf((unsigned char*)(ya + t * RWW + colh), y); }
        { const int tmp = s0i; s0i = aki; aki = tmp; }
        LBAR();
    }
#undef BUF
#undef ZLOAD
}
#undef LBAR
}

__device__ __forceinline__ void p_norm2_route(const PArgs& a, unsigned char* lds, int wv) {
    typedef short bf16x8 __attribute__((ext_vector_type(8)));
    const int tid = mktid(wv), lane = tid & 63, fr = lane & 15, fq = lane >> 4;
    const bf16* x1 = (const bf16*)(a.ws + WS_X1B); const float* mod = (const float*)(a.ws + WS_MOD); const float* gm2 = (const float*)(a.ws + WS_GM2); const float* cbt = (const float*)(a.ws + WS_CB);
    bf16* h2 = (bf16*)(a.ws + WS_H2);
    int* rte = (int*)(a.ws + WS_RTE); float* rtw = (float*)(a.ws + WS_RTW); int* rnk = (int*)(a.ws + WS_RNK); unsigned* cnt = (unsigned*)(a.ws + WS_CTL) + CW_CNT;
    float* PL = (float*)lds;
    float* PS = PL + 8 * 32 * 48;
    float* RS_ = PS + 8 * 32;
    float* FL = RS_ + 32;
    unsigned* HIST = (unsigned*)(FL + 32 * 48);
    unsigned* LRK = HIST + 32;
    if (tid < 32) HIST[tid] = 0u;
    __syncthreads();
    int gcount = 0;
    bf16x8 wh[4][3], wl[4][3];
    { const bf16* wrh = (const bf16*)(a.ws + WS_WRH) + fr * 1024 + 128 * wv + 8 * fq; const bf16* wrl = (const bf16*)(a.ws + WS_WRL) + fr * 1024 + 128 * wv + 8 * fq;
#pragma unroll
      for (int ks = 0; ks < 4; ++ks)
#pragma unroll
          for (int nt = 0; nt < 3; ++nt) { wh[ks][nt] = *(const bf16x8*)(wrh + nt * 16 * 1024 + 32 * ks); wl[ks][nt] = *(const bf16x8*)(wrl + nt * 16 * 1024 + 32 * ks); } }
    for (int grp = blockIdx.x; grp < NT / 32; grp += gridDim.x) {
        const int row0 = grp * 32, b = row0 >> 11;
        f32x4 acc[3][2];
#pragma unroll
        for (int nt = 0; nt < 3; ++nt) { acc[nt][0] = (f32x4){0.f, 0.f, 0.f, 0.f}; acc[nt][1] = acc[nt][0]; }
        float ssq[2] = {0.f, 0.f};
#pragma unroll
        for (int rt = 0; rt < 2; ++rt) {
            float xs[4][8];
#pragma unroll
            for (int ks = 0; ks < 4; ++ks) rw::ld8bf((const unsigned char*)(x1 + (size_t)(row0 + 16 * rt + fr) * DM + 128 * wv + 32 * ks + 8 * fq), xs[ks]);
#pragma unroll
            for (int ks = 0; ks < 4; ++ks) { float gm[8]; rw::ld8f(gm2 + b * 1024 + 128 * wv + 32 * ks + 8 * fq, gm); unsigned hw[4], lw[4];
#pragma unroll
                for (int e = 0; e < 4; ++e) { const float x0 = xs[ks][2 * e], x1v = xs[ks][2 * e + 1]; ssq[rt] += x0 * x0 + x1v * x1v; const float g0 = x0 * gm[2 * e], g1 = x1v * gm[2 * e + 1];
                    hw[e] = pk2(g0, g1); lw[e] = pk2(g0 - bflo(hw[e]), g1 - bfhi(hw[e])); }
                const v4u hv = {hw[0], hw[1], hw[2], hw[3]}, lv = {lw[0], lw[1], lw[2], lw[3]}; const bf16x8 bh = __builtin_bit_cast(bf16x8, hv), bl = __builtin_bit_cast(bf16x8, lv);
#pragma unroll
                for (int nt = 0; nt < 3; ++nt) { acc[nt][rt] = __builtin_amdgcn_mfma_f32_16x16x32_bf16(wh[ks][nt], bh, acc[nt][rt], 0, 0, 0); acc[nt][rt] = __builtin_amdgcn_mfma_f32_16x16x32_bf16(wl[ks][nt], bh, acc[nt][rt], 0, 0, 0);
                    acc[nt][rt] = __builtin_amdgcn_mfma_f32_16x16x32_bf16(wh[ks][nt], bl, acc[nt][rt], 0, 0, 0); } } }
#pragma unroll
        for (int rt = 0; rt < 2; ++rt) {
#pragma unroll
            for (int nt = 0; nt < 3; ++nt) *(f32x4*)(PL + (wv * 32 + 16 * rt + fr) * 48 + 16 * nt + 4 * fq) = acc[nt][rt];
            float s = ssq[rt]; s += __builtin_bit_cast(float, __builtin_amdgcn_ds_swizzle(__builtin_bit_cast(int, s), 0x401F));
            { const unsigned u = __builtin_bit_cast(unsigned, s); auto rr = __builtin_amdgcn_permlane32_swap(u, u, false, false); s = __builtin_bit_cast(float, (unsigned)rr[0]) + __builtin_bit_cast(float, (unsigned)rr[1]); }
            if (fq == 0) PS[wv * 32 + 16 * rt + fr] = s; }
        __syncthreads();
        { const int r = tid >> 4, c = tid & 15; float s0 = 0.f, s1 = 0.f, s2 = 0.f, sq = 0.f;
#pragma unroll
          for (int w = 0; w < 8; ++w) { const float* p = PL + (w * 32 + r) * 48; s0 += p[c]; s1 += p[c + 16]; s2 += p[c + 32]; sq += PS[w * 32 + r]; }
          const float rstd = rsqrtf(sq * (1.0f / DM) + 1e-6f); const float* cb = cbt + b * 48;
          FL[r * 48 + c] = rstd * s0 + cb[c]; FL[r * 48 + c + 16] = rstd * s1 + cb[c + 16]; FL[r * 48 + c + 32] = rstd * s2 + cb[c + 32];
          if (c == 0) RS_[r] = rstd; }
        __syncthreads();
#pragma unroll
        for (int rt = 0; rt < 2; ++rt) { const float rstd = RS_[16 * rt + fr];
#pragma unroll
            for (int ks = 0; ks < 4; ++ks) { float sh[8], gm[8], xv[8], o[8]; rw::ld8f(mod + b * 6144 + 3072 + 128 * wv + 32 * ks + 8 * fq, sh); rw::ld8f(gm2 + b * 1024 + 128 * wv + 32 * ks + 8 * fq, gm);
                rw::ld8bf((const unsigned char*)(x1 + (size_t)(row0 + 16 * rt + fr) * DM + 128 * wv + 32 * ks + 8 * fq), xv);
#pragma unroll
                for (int e = 0; e < 8; ++e) o[e] = xv[e] * gm[e] * rstd + sh[e];
                rw::st8bf((unsigned char*)(h2 + (size_t)(row0 + 16 * rt + fr) * DM + 128 * wv + 32 * ks + 8 * fq), o); } }
        if (tid < 32) { const int m = row0 + tid; const float* lg = FL + tid * 48;
            int gi = 0; float gm = lg[0];
#pragma unroll
            for (int i = 1; i < 4; ++i) if (lg[i] > gm) { gm = lg[i]; gi = i; }
            float gs = 0.f;
#pragma unroll
            for (int i = 0; i < 4; ++i) gs += __expf(lg[i] - gm);
            const float pg = 1.0f / gs;
            float el[8];
#pragma unroll
            for (int k = 0; k < 8; ++k) el[k] = lg[4 + gi * 8 + k];
            int e1 = 0; float m1 = el[0];
#pragma unroll
            for (int k = 1; k < 8; ++k) if (el[k] > m1) { m1 = el[k]; e1 = k; }
            int e2 = -1; float m2 = -INFINITY;
#pragma unroll
            for (int k = 0; k < 8; ++k) if (k != e1 && el[k] > m2) { m2 = el[k]; e2 = k; }
            const float q2 = __expf(m2 - m1); const float w1 = pg / (1.0f + q2), w2 = pg * q2 / (1.0f + q2);
            const int ea = gi * 8 + e1, eb = gi * 8 + e2; rte[2 * m] = ea; rte[2 * m + 1] = eb; rtw[2 * m] = w1; rtw[2 * m + 1] = w2;
            LRK[gcount * 64 + 2 * tid] = atomicAdd(HIST + ea, 1u) | ((unsigned)ea << 24); LRK[gcount * 64 + 2 * tid + 1] = atomicAdd(HIST + eb, 1u) | ((unsigned)eb << 24); }
        ++gcount;
        __syncthreads();
    }
    if (tid < 32) { const unsigned n = HIST[tid]; HIST[tid] = n ? atomicAdd(cnt + tid * CNT_PAD, n) : 0u; }
    __syncthreads();
    for (int i = tid; i < gcount * 64; i += 512) { const int gi_ = i >> 6, e = i & 63; const int m2 = 2 * ((blockIdx.x + gi_ * gridDim.x) * 32) + e; const unsigned lr = LRK[i]; rnk[m2] = (int)(HIST[lr >> 24] + (lr & 0xffffffu)); }
    __syncthreads();
}
__device__ __forceinline__ void p_moe_gather(const PArgs& a, unsigned char* lds, int wv) {
    int* off = (int*)lds;
    const int tid = mktid(wv), lane = tid & 63, gw = blockIdx.x * 8 + (tid >> 6), NGW = gridDim.x * 8;
    int* ctl = (int*)(a.ws + WS_CTL); const unsigned* cnt = (const unsigned*)ctl + CW_CNT;
    if (tid == 0) { int o = 0, nt = 0;
        for (int e = 0; e < NEXP; ++e) { off[e] = o; const int tiles = ((int)cnt[e * CNT_PAD] + 255) >> 8;
            if (blockIdx.x == 0) for (int i = 0; i < tiles; ++i) ctl[CW_TEXP + nt + i] = e;
            nt += tiles; o += tiles * 256; }
        if (blockIdx.x == 0) ctl[CW_NT] = nt; }
    __syncthreads();
    const int* rte = (const int*)(a.ws + WS_RTE); const int* rnk = (const int*)(a.ws + WS_RNK); int* pos = (int*)(a.ws + WS_POS);
    const bf16* h2 = (const bf16*)(a.ws + WS_H2); bf16* xs = (bf16*)(a.ws + WS_XS);
    for (int i = gw; i < 2 * NT; i += NGW) { const int p = off[rte[i]] + rnk[i]; if (lane == 0) pos[i] = p;
        const v4u* src = (const v4u*)(h2 + (size_t)(i >> 1) * DM) + lane; v4u* dst = (v4u*)(xs + (size_t)p * DM) + lane;
        dst[0] = src[0]; dst[64] = src[64]; }
}
__device__ __forceinline__ void p_combine(const PArgs& a, unsigned char* lds, int wv) {
    const int tid = mktid(wv), lane = tid & 63, gw = blockIdx.x * 8 + (tid >> 6), NGW = gridDim.x * 8;
    const float* mod = (const float*)(a.ws + WS_MOD); const int* pos = (const int*)(a.ws + WS_POS); const float* rtw = (const float*)(a.ws + WS_RTW);
    const bf16* ys = (const bf16*)(a.ws + WS_XS); float* out = a.out;
    for (int m = gw; m < NT; m += NGW) { const int b = m >> 11; const int p0 = pos[2 * m], p1 = pos[2 * m + 1]; const float w0 = rtw[2 * m], w1 = rtw[2 * m + 1];
        f32x4* o = (f32x4*)(out + (size_t)m * DM) + lane; const v2u* xb = (const v2u*)((const bf16*)(a.ws + WS_X1B) + (size_t)m * DM) + lane; const v2u* y0 = (const v2u*)(ys + (size_t)p0 * DM) + lane; const v2u* y1 = (const v2u*)(ys + (size_t)p1 * DM) + lane;
#pragma unroll
        for (int j = 0; j < 4; ++j) { const int col = 4 * (lane + 64 * j); const f32x4 g2 = *(const f32x4*)(mod + b * 6144 + 5120 + col); const v2u a0 = y0[64 * j], a1 = y1[64 * j];
            const f32x4 e0 = {bflo(a0.x), bfhi(a0.x), bflo(a0.y), bfhi(a0.y)}, e1 = {bflo(a1.x), bfhi(a1.x), bflo(a1.y), bfhi(a1.y)};
            const v2u xw = xb[64 * j]; const f32x4 xv = {bflo(xw.x), bfhi(xw.x), bflo(xw.y), bfhi(xw.y)};
            o[64 * j] = xv + g2 * (e0 * w0 + e1 * w1); } }
}

#define XB_TMO      128
#define XB_XCNT(j)  (256  + 64 * (j))
#define XB_XSUB(j)  (1280 + 64 * (j))
#define XB_XGEN(j)  (2304 + 64 * (j))
#define XB_TOP      3328
#define XB_TOPGEN   3392
#define XCD_BAR_WORDS 3456
#define XB_SPIN_CAP (1u << 22)

__device__ __forceinline__ unsigned xb_ld(unsigned* p)              { return __hip_atomic_load(p, __ATOMIC_RELAXED, __HIP_MEMORY_SCOPE_AGENT); }
__device__ __forceinline__ unsigned xb_add(unsigned* p, unsigned v) { return __hip_atomic_fetch_add(p, v, __ATOMIC_RELAXED, __HIP_MEMORY_SCOPE_AGENT); }
__device__ __forceinline__ unsigned xb_xcc_id() { return (unsigned)__builtin_amdgcn_s_getreg((3 << 11) | 20) & 0xFu; }
#define XB_SPIN(cond, bar) do { unsigned _sp = 0; while (cond) { __builtin_amdgcn_s_sleep(1); \
    if ((++_sp & 255u) == 0u) { if (xb_ld(&(bar)[XB_TMO])) break; if (_sp > XB_SPIN_CAP) { atomicAdd(&(bar)[XB_TMO], 1u); break; } } } } while (0)

struct XcdBarrier {
    unsigned* bar; unsigned x;
    volatile LAS unsigned* st;
};

__device__ __forceinline__ XcdBarrier xcd_barrier_post(unsigned* bar, volatile LAS unsigned* st, int wv) {
    XcdBarrier b; b.bar = bar; b.x = xb_xcc_id(); b.st = st;
    if (mktid(wv) == 0) (void)xb_add(&bar[XB_XCNT(b.x)], 1u);
    return b;
}
__device__ __forceinline__ void xcd_barrier_complete(unsigned* bar, unsigned x, unsigned& nloc, unsigned& nx) {
    const unsigned G = gridDim.x * gridDim.y * gridDim.z;
    unsigned sum, cnt, mine, sp = 0u;
    for (;;) {
        sum = 0u; cnt = 0u; mine = 0u;
#pragma unroll
        for (unsigned j = 0; j < 16; ++j) { const unsigned c = xb_ld(&bar[XB_XCNT(j)]); sum += c; cnt += (c > 0u) ? 1u : 0u; mine = (j == x) ? c : mine; }
        if (sum == G) break;
        __builtin_amdgcn_s_sleep(1);
        if ((++sp & 255u) == 0u) { if (xb_ld(&bar[XB_TMO])) break; if (sp > XB_SPIN_CAP) { atomicAdd(&bar[XB_TMO], 1u); break; } }
    }
    nloc = mine > 0u ? mine : 1u; nx = cnt > 0u ? cnt : 1u;
}

__device__ __forceinline__ void xcd_barrier(const XcdBarrier& b, int wv) {
    asm volatile("s_waitcnt vmcnt(0)" ::: "memory");
    __syncthreads();
    if (mktid(wv) == 0) {
        unsigned* bar = b.bar;
        __builtin_amdgcn_s_waitcnt(0);
        unsigned nloc = b.st[0], nx = b.st[1];
        if (nloc == 0u) { xcd_barrier_complete(bar, b.x, nloc, nx); b.st[0] = nloc; b.st[1] = nx; }
        const unsigned old = xb_add(&bar[XB_XSUB(b.x)], 1u);
        const unsigned gen = old / nloc;
        if (old + 1u == (gen + 1u) * nloc) {
            __builtin_amdgcn_fence(__ATOMIC_RELEASE, "agent");
            asm volatile("s_waitcnt vmcnt(0)" ::: "memory");
            const unsigned og = xb_add(&bar[XB_TOP], 1u);
            const unsigned tg = og / nx;
            if (og + 1u == (tg + 1u) * nx) xb_add(&bar[XB_TOPGEN], 1u);
            else XB_SPIN(xb_ld(&bar[XB_TOPGEN]) == tg, bar);
            __builtin_amdgcn_fence(__ATOMIC_ACQUIRE, "agent");
            xb_add(&bar[XB_XGEN(b.x)], 1u);
            asm volatile("s_waitcnt vmcnt(0)" ::: "memory");
        } else {
            XB_SPIN(xb_ld(&bar[XB_XGEN(b.x)]) == gen, bar);
            __builtin_amdgcn_fence(__ATOMIC_ACQUIRE, "agent");
            asm volatile("s_waitcnt vmcnt(0)" ::: "memory");
        }
    }
    __syncthreads();
}

constexpr int LDS_BYTES = 160 * 1024, MISC_OFF = LDS_BYTES - 256;
static_assert(rw::LDS_NEED <= MISC_OFF, "scan LDS");
constexpr int CW_BAR = 4096;

__global__ void __launch_bounds__(512, 2) mega_fwd(PArgs a) {
    extern __shared__ __attribute__((aligned(16))) unsigned char lds[];
    volatile LAS unsigned* MISC = (volatile LAS unsigned*)((LAS unsigned char*)lds + MISC_OFF);
    const int wv = __builtin_amdgcn_readfirstlane((int)threadIdx.x >> 6);
    { const int t0 = mktid(wv); if (t0 < 64) MISC[t0] = 0u; }
    __syncthreads();
    XcdBarrier bar = xcd_barrier_post((unsigned*)(a.ws + WS_CTL) + CW_BAR, MISC + 8, wv);
    GemmArgs g; g.ws = a.ws; g.x = a.in[0]; g.out = a.out;
    const int G = (int)gridDim.x, bx = (int)blockIdx.x;

    p_prep_weights(a, lds, wv); __syncthreads(); p_ada(a, lds, wv);
    xcd_barrier(bar, wv);
    p_norm1(a, lds, wv);
    xcd_barrier(bar, wv);
    p_gemm_in(g, lds, wv);
    xcd_barrier(bar, wv);
    p_kprep(a, lds, wv);
    xcd_barrier(bar, wv);
    p_qprep(a, lds, wv);
    xcd_barrier(bar, wv);
    { const int nscan = G / 2;
      if (bx < nscan) { for (int bh = bx; bh < 128; bh += nscan) rw::scan_unit(a, lds, bh, wv); }
      else p_attn(a, lds, bx - nscan, G - nscan, wv); }
    xcd_barrier(bar, wv);
    p_gemm_merge(g, lds, wv);
    xcd_barrier(bar, wv);
    p_gemm_out(g, lds, wv); __syncthreads(); p_prep_experts(a, lds, wv);
    xcd_barrier(bar, wv);
    p_norm2_route(a, lds, wv);
    xcd_barrier(bar, wv);
    p_moe_gather(a, lds, wv);
    xcd_barrier(bar, wv);
    p_gemm_up(g, lds, wv);
    xcd_barrier(bar, wv);
    p_gemm_down(g, lds, wv);
    xcd_barrier(bar, wv);
    p_combine(a, lds, wv);
}

extern "C" void kernel_launch(void* const* d_in, const int* in_sizes, int n_in, void* d_out, int out_size, void* d_ws, size_t ws_size, hipStream_t stream) {
    static int grid = 0;
    if (grid == 0) {
        if (n_in != 30 || out_size != NT * DM || ws_size < WS_END) { fprintf(stderr, "kernel_launch: unexpected shapes (n_in %d, out %d, ws %zu)\n", n_in, out_size, ws_size); grid = -1; return; }
        int dev = 0, cus = 0, per_cu = 0;
        if (hipGetDevice(&dev) != hipSuccess || hipDeviceGetAttribute(&cus, hipDeviceAttributeMultiprocessorCount, dev) != hipSuccess) { grid = -1; return; }
        if (hipFuncSetAttribute((const void*)mega_fwd, hipFuncAttributeMaxDynamicSharedMemorySize, LDS_BYTES) != hipSuccess) { fprintf(stderr, "kernel_launch: hipFuncSetAttribute failed\n"); grid = -1; return; }
        if (hipOccupancyMaxActiveBlocksPerMultiprocessor(&per_cu, (const void*)mega_fwd, 512, LDS_BYTES) != hipSuccess || per_cu < 1) { fprintf(stderr, "kernel_launch: occupancy query says %d blocks per CU\n", per_cu); (void)hipGetLastError(); grid = -1; return; }
        grid = cus;
    }
    if (grid < 0) return;
    (void)hipMemsetAsync((char*)d_ws + WS_CTL, 0, 65536, stream);
    PArgs p{}; for (int i = 0; i < 30; ++i) p.in[i] = (const float*)d_in[i]; p.out = (float*)d_out; p.ws = (unsigned char*)d_ws;
    hipLaunchKernelGGL(mega_fwd, dim3(grid), dim3(512), LDS_BYTES, stream, p);
}
```

```cpp
#include <hip/hip_runtime.h>
#include <cstdio>
#include <cstdint>
__device__ __forceinline__ int mktid(int wv) { int l; asm volatile("v_mbcnt_lo_u32_b32 %0, -1, 0\n\tv_mbcnt_hi_u32_b32 %0, -1, %0" : "=v"(l)); return (wv << 6) | l; }
template <int CTRL> __device__ __forceinline__ float dppf(float v) { return __builtin_bit_cast(float, __builtin_amdgcn_update_dpp(0, __builtin_bit_cast(int, v), CTRL, 0xF, 0xF, true)); }
__device__ __forceinline__ float red4(float v) { v += dppf<0xB1>(v); v += dppf<0x4E>(v); return v; }
__device__ __forceinline__ float red8(float v) { v = red4(v); v += dppf<0x141>(v); return v; }
__device__ __forceinline__ float red16(float v) { v = red8(v); v += dppf<0x140>(v); return v; }
__device__ __forceinline__ float wave_sum(float v) { v = red16(v);
    v += __builtin_bit_cast(float, __builtin_amdgcn_ds_swizzle(__builtin_bit_cast(int, v), 0x401F));
    const unsigned u = __builtin_bit_cast(unsigned, v); auto rr = __builtin_amdgcn_permlane32_swap(u, u, false, false);
    return __builtin_bit_cast(float, (unsigned)rr[0]) + __builtin_bit_cast(float, (unsigned)rr[1]); }
__device__ __forceinline__ float lane_get(float v, int src) { return __builtin_bit_cast(float, __builtin_amdgcn_ds_bpermute(src << 2, __builtin_bit_cast(int, v))); }
namespace pg8 {
#define PG8_LAS __attribute__((address_space(3)))
typedef unsigned short bf16_t;
typedef short bf16x8 __attribute__((ext_vector_type(8)));
typedef float f32x4 __attribute__((ext_vector_type(4)));
typedef unsigned u32x4 __attribute__((ext_vector_type(4)));
constexpr int BM = 256, BK = 64, HALF = 128, HTB = HALF * BK * 2  , STAGE_BYTES = 8 * HTB, NXCD = 8, WGM = 8;

__host__ __device__ __forceinline__ int lds_byte(int r, int c) { const int st = (r >> 4) * 2 + (c >> 5), rr = r & 15, cc = c & 31, ob = rr * 64 + cc * 2; return st * 1024 + (ob ^ (((ob >> 9) & 1) << 5)); }
__host__ __device__ __forceinline__ void stage_rc(int b, int& R, int& C) { const int st = b / 1024, sb = b % 1024, swz = sb ^ (((sb >> 9) & 1) << 5); R = (st >> 1) * 16 + swz / 64; C = (st & 1) * 32 + (swz % 64) / 2; }
__host__ __device__ __forceinline__ int perm32(int rho) { const int n = rho >> 4, i = rho & 15; return 8 * (i >> 2) + 4 * n + (i & 3); }
struct Unit { int pm, pn, aux; const char* a; const char* b; };
struct Gemm { int K; };

struct StaticOrder {
    int nM, nN, nwg, G, c; const char* A; const char* Bt; size_t tstep;
    __device__ void init(const void* A_, const void* Bt_, int M, int N, int K, int G_, int c_) { nM = M / BM; nN = N / BM; nwg = nM * nN; G = G_; c = c_; A = (const char*)A_; Bt = (const char*)Bt_; tstep = (size_t)BM * K * 2; }
    __device__ bool next(int i, Unit& u) const {
        const long L = (long)i * G + c; if (L >= nwg) return false;
        int wgid = (int)L; { const int q = nwg / NXCD, r = nwg % NXCD, xcd = wgid % NXCD, off = wgid / NXCD; wgid = (xcd < r ? xcd * (q + 1) : r * (q + 1) + (xcd - r) * q) + off; }
        const int nig = WGM * nN, gid = wgid / nig, fm = gid * WGM, gsz = (nM - fm) < WGM ? (nM - fm) : WGM;
        u.aux = 0; u.pm = fm + ((wgid % nig) % gsz); u.pn = (wgid % nig) / gsz; u.a = A + (size_t)u.pm * tstep; u.b = Bt + (size_t)u.pn * tstep; return true;
    }
    __device__ __forceinline__ void a_ready(const Unit&) const {}
    __device__ __forceinline__ void done(const Unit&) const {}
};
__device__ __forceinline__ unsigned cvt_pk_bf16(float lo, float hi) { unsigned r; asm volatile("v_cvt_pk_bf16_f32 %0, %1, %2" : "=v"(r) : "v"(lo), "v"(hi)); return r; }
template <class Epi, class Sched, bool ALIGN_EPI = false, bool SP2 = false>
__device__ __forceinline__ void gemm_phase(PG8_LAS unsigned char* lds, const Gemm g, const Sched& S, const Epi& E, int wv) {
    const int tid = mktid(wv), wid = __builtin_amdgcn_readfirstlane(tid >> 6), lane = tid & 63, wr = wid >> 2, wc = wid & 3, fr = lane & 15, fq = lane >> 4;
    const int K = g.K, nt = K / BK;
    unsigned voffA[2], voffB[2];
#pragma unroll
    for (int i = 0; i < 2; ++i) { int R, C; stage_rc(tid * 16 + i * 8192, R, C); const int Rb = Epi::PERM ? ((R & ~31) + perm32(R & 31)) : R;
        voffA[i] = (unsigned)(R * K + C) * 2u; voffB[i] = (unsigned)(Rb * K + C) * 2u; }
    const size_t kstep = (size_t)(BK * 2);
    const size_t hstep = (size_t)HALF * K * 2;
        const unsigned ldsw = (unsigned)wid * 1024u;
    const int aoff = lds_byte(wr * 64 + fr, fq * 8), boff = lds_byte(wc * 32 + fr, fq * 8);
#define PG8_SA(b, h) (((b) * 2 + (h)) * HTB)
#define PG8_SB(b, h) ((4 + (b) * 2 + (h)) * HTB)
#define PG8_STAGE(bufoff, gbase, voff) do { _Pragma("unroll") for (int _i = 0; _i < 2; ++_i) \
        __builtin_amdgcn_global_load_lds((const unsigned*)((const char*)(gbase) + (voff)[_i]), (PG8_LAS unsigned*)(lds + (bufoff) + ldsw + _i * 8192), 16, 0, 0); } while (0)
#define PG8_LDA(dst, b, h) do { _Pragma("unroll") for (int m = 0; m < 4; ++m) _Pragma("unroll") for (int k = 0; k < 2; ++k) dst[m][k] = *(const PG8_LAS bf16x8*)(lds + PG8_SA(b, h) + aoff + m * 2048 + k * 1024); } while (0)
#define PG8_LDB(dst, b, h) do { _Pragma("unroll") for (int n = 0; n < 2; ++n) _Pragma("unroll") for (int k = 0; k < 2; ++k) dst[n][k] = *(const PG8_LAS bf16x8*)(lds + PG8_SB(b, h) + boff + n * 2048 + k * 1024); } while (0)
#define PG8_MMA(ai, bj, At, Bt) do { __builtin_amdgcn_s_setprio(1); _Pragma("unroll") for (int m = 0; m < 4; ++m) _Pragma("unroll") for (int n = 0; n < 2; ++n) _Pragma("unroll") for (int k = 0; k < 2; ++k) \
        acc[ai][bj][m][n] = __builtin_amdgcn_mfma_f32_16x16x32_bf16(Bt[n][k], At[m][k], acc[ai][bj][m][n], 0, 0, 0); __builtin_amdgcn_s_setprio(0); } while (0)
#define PG8_WAIT_V(n) asm volatile("s_waitcnt vmcnt(" #n ")" ::: "memory")
#define PG8_WAIT_L(n) asm volatile("s_waitcnt lgkmcnt(" #n ")" ::: "memory")
#define PG8_BAR __builtin_amdgcn_s_barrier()
#define PG8_SCHED __builtin_amdgcn_sched_barrier(0)
    Unit cur, nxt; int ui = 0;
    if (!S.next(0, cur)) return;
    f32x4 acc[2][2][4][2];
#pragma unroll
    for (int a = 0; a < 2; ++a)
#pragma unroll
        for (int b = 0; b < 2; ++b)
#pragma unroll
            for (int m = 0; m < 4; ++m)
#pragma unroll
                for (int n = 0; n < 2; ++n) acc[a][b][m][n] = (f32x4){0.f, 0.f, 0.f, 0.f};
    bf16x8 At[4][2], B0[2][2], B1[2][2];
    const char* cA = cur.a; const char* cB = cur.b;
    S.a_ready(cur);
    if constexpr (SP2) {
        PG8_STAGE(PG8_SB(0, 0), cB, voffB); PG8_STAGE(PG8_SB(0, 1), cB + hstep, voffB); PG8_STAGE(PG8_SA(0, 0), cA, voffA); PG8_STAGE(PG8_SA(0, 1), cA + hstep, voffA);
        if (wr == 1) PG8_BAR;
        PG8_WAIT_V(2); PG8_BAR;
        PG8_STAGE(PG8_SB(1, 0), cB + kstep, voffB); PG8_STAGE(PG8_SA(1, 0), cA + kstep, voffA); PG8_STAGE(PG8_SB(1, 1), cB + hstep + kstep, voffB);
        PG8_WAIT_V(6); PG8_BAR;
    } else {
        PG8_STAGE(PG8_SB(0, 0), cB, voffB); PG8_STAGE(PG8_SA(0, 0), cA, voffA); PG8_STAGE(PG8_SB(0, 1), cB + hstep, voffB); PG8_STAGE(PG8_SA(0, 1), cA + hstep, voffA);
        if (wr == 1) PG8_BAR;
        PG8_WAIT_V(4); PG8_BAR;
        PG8_STAGE(PG8_SB(1, 0), cB + kstep, voffB); PG8_STAGE(PG8_SA(1, 0), cA + kstep, voffA); PG8_STAGE(PG8_SB(1, 1), cB + hstep + kstep, voffB);
        PG8_WAIT_V(6); PG8_BAR;
    }
    for (;;) {
        const bool has_next = S.next(ui + 1, nxt);
        const char* nA = has_next ? nxt.a : cA; const char* nB = has_next ? nxt.b : cB;
        for (int t = 0; t < nt; t += 2) {
            const bool last = (t == nt - 2);
            const char* a1 = cA + (size_t)(t + 1) * kstep;
            const char* a2 = last ? nA : cA + (size_t)(t + 2) * kstep; const char* b2 = last ? nB : cB + (size_t)(t + 2) * kstep;
            const char* a3 = a2 + kstep; const char* b3 = b2 + kstep;
            if (last && has_next) S.a_ready(nxt);
            if constexpr (SP2) {
            PG8_LDB(B0, 0, 0); PG8_LDB(B1, 0, 1); PG8_SCHED; PG8_LDA(At, 0, 0); PG8_STAGE(PG8_SA(1, 1), a1 + hstep, voffA);
            PG8_WAIT_V(8); PG8_WAIT_L(0); PG8_BAR; PG8_MMA(0, 0, At, B0); PG8_MMA(0, 1, At, B1); PG8_BAR; PG8_SCHED;
            PG8_LDA(At, 0, 1); PG8_STAGE(PG8_SB(0, 0), b2, voffB); PG8_STAGE(PG8_SB(0, 1), b2 + hstep, voffB); PG8_STAGE(PG8_SA(0, 0), a2, voffA);
            PG8_WAIT_V(8); PG8_WAIT_L(0); PG8_BAR; PG8_MMA(1, 0, At, B0); PG8_MMA(1, 1, At, B1); PG8_BAR; PG8_SCHED;
            PG8_LDB(B0, 1, 0); PG8_LDB(B1, 1, 1); PG8_SCHED; PG8_LDA(At, 1, 0); PG8_STAGE(PG8_SA(0, 1), a2 + hstep, voffA);
            PG8_WAIT_V(8); PG8_WAIT_L(0); PG8_BAR; PG8_MMA(0, 0, At, B0); PG8_MMA(0, 1, At, B1); PG8_BAR; PG8_SCHED;
            PG8_LDA(At, 1, 1); PG8_STAGE(PG8_SB(1, 0), b3, voffB); PG8_STAGE(PG8_SB(1, 1), b3 + hstep, voffB); PG8_STAGE(PG8_SA(1, 0), a3, voffA);
            PG8_WAIT_V(8); PG8_WAIT_L(0); PG8_BAR; PG8_MMA(1, 0, At, B0); PG8_MMA(1, 1, At, B1); PG8_BAR; PG8_SCHED;
            } else {
            PG8_LDB(B0, 0, 0); PG8_SCHED; PG8_LDA(At, 0, 0); PG8_STAGE(PG8_SA(1, 1), a1 + hstep, voffA);
            PG8_WAIT_L(8); PG8_BAR; PG8_WAIT_L(0); PG8_MMA(0, 0, At, B0); PG8_BAR; PG8_SCHED;
            PG8_LDB(B1, 0, 1); PG8_STAGE(PG8_SB(0, 0), b2, voffB);
            PG8_BAR; PG8_WAIT_L(0); PG8_MMA(0, 1, At, B1); PG8_BAR;
            PG8_LDA(At, 0, 1); PG8_STAGE(PG8_SA(0, 0), a2, voffA);
            PG8_BAR; PG8_WAIT_L(0); PG8_MMA(1, 0, At, B0); PG8_BAR; PG8_SCHED;
            PG8_STAGE(PG8_SB(0, 1), b2 + hstep, voffB);
            PG8_WAIT_V(6); PG8_BAR; PG8_MMA(1, 1, At, B1); PG8_BAR;
            PG8_LDB(B0, 1, 0); PG8_SCHED; PG8_LDA(At, 1, 0); PG8_STAGE(PG8_SA(0, 1), a2 + hstep, voffA);
            PG8_WAIT_L(8); PG8_BAR; PG8_WAIT_L(0); PG8_MMA(0, 0, At, B0); PG8_BAR; PG8_SCHED;
            PG8_LDB(B1, 1, 1); PG8_STAGE(PG8_SB(1, 0), b3, voffB);
            PG8_BAR; PG8_WAIT_L(0); PG8_MMA(0, 1, At, B1); PG8_BAR;
            PG8_LDA(At, 1, 1); PG8_STAGE(PG8_SA(1, 0), a3, voffA);
            PG8_BAR; PG8_WAIT_L(0); PG8_MMA(1, 0, At, B0); PG8_BAR; PG8_SCHED;
            PG8_STAGE(PG8_SB(1, 1), b3 + hstep, voffB);
            PG8_WAIT_V(6); PG8_BAR; PG8_MMA(1, 1, At, B1); PG8_BAR;
            }
        }
        if constexpr (ALIGN_EPI) { if (wr == 0) PG8_BAR; }
        bool keep = false;
        if constexpr (!Epi::AFTER_DRAIN) { if constexpr (Epi::CHAIN) keep = E.chain(acc, cur, wr, wc, fr, fq); else E(acc, cur, wr, wc, fr, fq); S.done(cur); }
        if (!has_next) break;
        if (!keep) {
#pragma unroll
        for (int a = 0; a < 2; ++a)
#pragma unroll
            for (int b = 0; b < 2; ++b)
#pragma unroll
                for (int m = 0; m < 4; ++m)
#pragma unroll
                    for (int n = 0; n < 2; ++n) acc[a][b][m][n] = (f32x4){0.f, 0.f, 0.f, 0.f};
        }
        cur = nxt; cA = nA; cB = nB; ++ui;
        if constexpr (ALIGN_EPI) { if (wr == 1) PG8_BAR; }
    }
    PG8_WAIT_V(0);
    if constexpr (!ALIGN_EPI) { if (wr == 0) PG8_BAR; }
    PG8_BAR;
    if constexpr (Epi::AFTER_DRAIN) { E.fused(acc, cur, wr, wc, fr, fq, lds, wid, lane); S.done(cur); }
#undef PG8_SA
#undef PG8_SB
#undef PG8_STAGE
#undef PG8_LDA
#undef PG8_LDB
#undef PG8_MMA
#undef PG8_WAIT_V
#undef PG8_WAIT_L
#undef PG8_BAR
#undef PG8_SCHED
}
}
#include <hip/hip_bf16.h>
#include <cmath>
namespace attn_body {
using bf16=__hip_bfloat16;
using bf16x8=__attribute__((ext_vector_type(8)))short;
using s16x4=__attribute__((ext_vector_type(4)))short;
using f32x16=__attribute__((ext_vector_type(16)))float;
using u32x4=__attribute__((ext_vector_type(4)))unsigned;
constexpr int NHEAD=8,SEQ=2048,D=64,PQ=512,PK=512,PV=4352,PO=512;
constexpr int NW=8,QBLK=32,QB=QBLK*NW,KVBLK=64,NQB=SEQ/QB;
__device__ __forceinline__ int crow(int r,int hi){return (r&3)+8*(r>>2)+4*hi;}
#define SBAR() __builtin_amdgcn_sched_barrier(0)
__device__ __forceinline__ void cmask(f32x16&p0,f32x16&p1,int jb,int qrel,int hi){
  const float NEG=-INFINITY; int kb=64*jb+4*hi;
  #pragma unroll
  for(int r=0;r<16;++r){int kv=kb+(r&3)+8*(r>>2); if(kv>qrel)p0[r]=NEG; if(kv+32>qrel)p1[r]=NEG;}
}

constexpr int NSLOT=3, SLOTB=8192;
constexpr int LDS_K=0, LDS_V=NSLOT*SLOTB, LDS_WS=2*NSLOT*SLOTB, LDS_OST=LDS_WS+NW*64*4, LDS_SEL=LDS_OST+NW*4096, LDS_KM=LDS_SEL+256, LDS_KP=LDS_KM+7*64*4, LDS_BYTES=LDS_KP+8*64*4;
constexpr float C2=0.125f*1.4426950408889634f;
__device__ __forceinline__ void glds16(const void*gsrc,unsigned lds_dst){unsigned keep;
  asm volatile("s_mov_b32 %0, m0\n\ts_mov_b32 m0, %2\n\ts_nop 0\n\tglobal_load_lds_dwordx4 %1, off\n\ts_mov_b32 m0, %0":"=&s"(keep):"v"(gsrc),"s"(lds_dst):"memory");}
__device__ __forceinline__ float max3f(float a,float b,float c){float r;asm("v_max3_f32 %0, %1, %2, %3":"=v"(r):"v"(a),"v"(b),"v"(c));return r;}
__device__ __forceinline__ float max2f(float a,float b){float r;asm("v_max_f32_e32 %0, %1, %2":"=v"(r):"v"(a),"v"(b));return r;}
__device__ __forceinline__ float fadd_s(float a,float b){float r;asm("v_add_f32_e32 %0, %1, %2":"=v"(r):"v"(a),"v"(b));return r;}
__device__ __forceinline__ float fsub_s(float a,float b){float r;asm("v_sub_f32_e32 %0, %1, %2":"=v"(r):"v"(a),"v"(b));return r;}
typedef float f32x2_t __attribute__((ext_vector_type(2))); typedef __bf16 bf16x2_t __attribute__((ext_vector_type(2)));
__device__ __forceinline__ unsigned cvtpk_s(float lo,float hi){f32x2_t v={lo,hi};bf16x2_t b=__builtin_convertvector(v,bf16x2_t);return __builtin_bit_cast(unsigned,b);}
#define WAIT_BAR(N) asm volatile("s_waitcnt vmcnt(" #N ") lgkmcnt(0)\n\ts_barrier":::"memory")

__device__ __forceinline__ void qkt(f32x16&p0,f32x16&p1,const char*Kslot,const bf16x8*qr,const f32x16&negm,int r32,int hi){
  const char*kb=Kslot+hi*1024+r32*16;
  #pragma unroll
  for(int d0=0;d0<4;++d0){
    const bf16x8 b0=*reinterpret_cast<const bf16x8*>(kb+d0*2048);
    const bf16x8 b1=*reinterpret_cast<const bf16x8*>(kb+d0*2048+512);
    if(d0==0){p0=__builtin_amdgcn_mfma_f32_32x32x16_bf16(b0,qr[0],negm,0,0,0);p1=__builtin_amdgcn_mfma_f32_32x32x16_bf16(b1,qr[0],negm,0,0,0);}
    else{p0=__builtin_amdgcn_mfma_f32_32x32x16_bf16(b0,qr[d0],p0,0,0,0);p1=__builtin_amdgcn_mfma_f32_32x32x16_bf16(b1,qr[d0],p1,0,0,0);}}
}
typedef __attribute__((address_space(3))) const char* lds_cptr;
typedef short v4i16_t __attribute__((ext_vector_type(4)));
__device__ __forceinline__ void kload8(bf16x8*kf,lds_cptr kp){
  kf[0]=*(const __attribute__((address_space(3))) bf16x8*)(kp);      kf[1]=*(const __attribute__((address_space(3))) bf16x8*)(kp+512);
  kf[2]=*(const __attribute__((address_space(3))) bf16x8*)(kp+2048); kf[3]=*(const __attribute__((address_space(3))) bf16x8*)(kp+2560);
  kf[4]=*(const __attribute__((address_space(3))) bf16x8*)(kp+4096); kf[5]=*(const __attribute__((address_space(3))) bf16x8*)(kp+4608);
  kf[6]=*(const __attribute__((address_space(3))) bf16x8*)(kp+6144); kf[7]=*(const __attribute__((address_space(3))) bf16x8*)(kp+6656);
}
__device__ __forceinline__ void kload2(bf16x8*kf,lds_cptr kp,int j){ kf[2*j]=*(const __attribute__((address_space(3))) bf16x8*)(kp+j*2048); kf[2*j+1]=*(const __attribute__((address_space(3))) bf16x8*)(kp+j*2048+512); }
__device__ __forceinline__ s16x4 vtr(lds_cptr p){ return __builtin_bit_cast(s16x4,__builtin_amdgcn_ds_read_tr16_b64_v4i16((__attribute__((address_space(3))) v4i16_t*)p)); }
__device__ __forceinline__ float rowmax(const f32x16&p0,const f32x16&p1){
  float a=max3f(p0[0],p0[1],p1[0]),b=max3f(p0[2],p0[3],p1[1]);a=max3f(a,p1[2],p1[3]);
  #pragma unroll
  for(int r=4;r<16;r+=4){a=max3f(a,p0[r],p0[r+1]);b=max3f(b,p0[r+2],p0[r+3]);a=max3f(a,p1[r],p1[r+1]);b=max3f(b,p1[r+2],p1[r+3]);}
  const float m=max2f(a,b);
  auto rr=__builtin_amdgcn_permlane32_swap(__float_as_uint(m),__float_as_uint(m),false,false);
  return max2f(__uint_as_float(rr[0]),__uint_as_float(rr[1]));
}
__device__ __forceinline__ void pv(f32x16*o,int vb,bf16x8 pa0,bf16x8 pa1,bf16x8 pa2,bf16x8 pa3){
  #pragma unroll
  for(int d0=0;d0<2;++d0){s16x4 lo[4],hi[4];
    #pragma unroll
    for(int ks=0;ks<4;++ks){
      asm volatile("ds_read_b64_tr_b16 %0,%1 offset:%c2":"=&v"(lo[ks]):"v"(vb),"i"(d0*4096+ks*1024):"memory");
      asm volatile("ds_read_b64_tr_b16 %0,%1 offset:%c2":"=&v"(hi[ks]):"v"(vb),"i"(d0*4096+ks*1024+512):"memory");}
    asm volatile("s_waitcnt lgkmcnt(0)":::"memory");SBAR();
    #define PK(k) (bf16x8){lo[k][0],lo[k][1],lo[k][2],lo[k][3],hi[k][0],hi[k][1],hi[k][2],hi[k][3]}
    o[d0]=__builtin_amdgcn_mfma_f32_32x32x16_bf16(pa0,PK(0),o[d0],0,0,0);
    o[d0]=__builtin_amdgcn_mfma_f32_32x32x16_bf16(pa1,PK(1),o[d0],0,0,0);
    o[d0]=__builtin_amdgcn_mfma_f32_32x32x16_bf16(pa2,PK(2),o[d0],0,0,0);
    o[d0]=__builtin_amdgcn_mfma_f32_32x32x16_bf16(pa3,PK(3),o[d0],0,0,0);
    #undef PK
  }
}

#ifndef ATTN_STORE16
#define ATTN_STORE16(p,v) (*(u32x4*)(p)=(v))
#endif
template<int THRL> __device__ __forceinline__ void attn_unit(int b,int h,int qb,const bf16*Q,const bf16*__restrict__ K,const bf16*__restrict__ V,bf16*O,char*shm,int wv){
  const int tid=mktid(wv),lane=tid&63,r32=lane&31,hi=lane>>5;     const int wid=__builtin_amdgcn_readfirstlane(tid>>6);
  const long rowbase=(long)b*SEQ; const int q0=qb*QB;
  if(qb>3){ float*KMl=(float*)(shm+LDS_KM); float*KPl=(float*)(shm+LDS_KP); const int c8=tid&7, rl=tid>>3;
    for(int n=0;n<qb;++n){ float sm[8];
      #pragma unroll
      for(int d=0;d<8;++d)sm[d]=0.f;
      #pragma unroll
      for(int rr=0;rr<4;++rr){ const u32x4 w=*reinterpret_cast<const u32x4*>(K+(rowbase+n*256+rl+64*rr)*PK+h*D+8*c8);
        sm[0]+=__uint_as_float(w[0]<<16);sm[1]+=__uint_as_float(w[0]&0xffff0000u);sm[2]+=__uint_as_float(w[1]<<16);sm[3]+=__uint_as_float(w[1]&0xffff0000u);
        sm[4]+=__uint_as_float(w[2]<<16);sm[5]+=__uint_as_float(w[2]&0xffff0000u);sm[6]+=__uint_as_float(w[3]<<16);sm[7]+=__uint_as_float(w[3]&0xffff0000u); }
      #pragma unroll
      for(int d=0;d<8;++d){ float v=sm[d];
        v+=__builtin_bit_cast(float,__builtin_amdgcn_ds_swizzle(__builtin_bit_cast(int,v),0x201F));
        v+=__builtin_bit_cast(float,__builtin_amdgcn_ds_swizzle(__builtin_bit_cast(int,v),0x401F));
        { const unsigned u=__builtin_bit_cast(unsigned,v); auto rr2=__builtin_amdgcn_permlane32_swap(u,u,false,false); v=__uint_as_float((unsigned)rr2[0])+__uint_as_float((unsigned)rr2[1]); }
        sm[d]=v; }
      if(lane<8){
        #pragma unroll
        for(int d=0;d<8;++d)KPl[wid*64+8*lane+d]=sm[d]; }
      asm volatile("s_waitcnt vmcnt(0) lgkmcnt(0)\n\ts_barrier":::"memory");
      if(tid<64){ float s8=0.f;
        #pragma unroll
        for(int w8=0;w8<8;++w8)s8+=KPl[w8*64+tid];
        KMl[n*64+tid]=s8*(1.0f/256.0f); }
      asm volatile("s_waitcnt lgkmcnt(0)\n\ts_barrier":::"memory"); } }
  if(tid<QB){ unsigned sel=(qb<=3)?((1u<<qb)-1u):0u;
    if(qb>3){ const bf16*qp=Q+(rowbase+q0+tid)*PQ+h*D; const float*km=(const float*)(shm+LDS_KM); float gate[7];
      #pragma unroll
      for(int j=0;j<7;++j)gate[j]=0.f;
      #pragma unroll 1
      for(int i=0;i<8;++i){ const u32x4 w=*reinterpret_cast<const u32x4*>(qp+8*i); float qv[8];
        qv[0]=__uint_as_float(w[0]<<16);qv[1]=__uint_as_float(w[0]&0xffff0000u);qv[2]=__uint_as_float(w[1]<<16);qv[3]=__uint_as_float(w[1]&0xffff0000u);
        qv[4]=__uint_as_float(w[2]<<16);qv[5]=__uint_as_float(w[2]&0xffff0000u);qv[6]=__uint_as_float(w[3]<<16);qv[7]=__uint_as_float(w[3]&0xffff0000u);
        #pragma unroll
        for(int j=0;j<7;++j) if(j<qb){ const float*kp=km+j*64+8*i;
          #pragma unroll
          for(int d=0;d<8;++d)gate[j]+=qv[d]*kp[d]; } }
      #pragma unroll
      for(int rep=0;rep<3;++rep){ float best=-INFINITY; int bi=0;
        #pragma unroll
        for(int j=0;j<7;++j) if(j<qb&&!((sel>>j)&1u)&&gate[j]>best){best=gate[j];bi=j;}
        sel|=1u<<bi; } }
    ((unsigned char*)(shm+LDS_SEL))[tid]=(unsigned char)sel; }
  asm volatile("s_waitcnt vmcnt(0) lgkmcnt(0)\n\ts_barrier":::"memory");
  const bf16*Qw=Q+(rowbase+q0+wid*QBLK)*PQ+h*D;
  const bf16*Kh=K+rowbase*PK+h*D,*Vh=V+rowbase*PV+h*D;
  const unsigned lds0=(unsigned)(uintptr_t)shm;
  float*wsf=(float*)(shm+LDS_WS)+wid*64;
  const bf16*ksrc=Kh+(long)lane*PK+wid*8;
  const bf16*vsrc=Vh+(long)(16*(wid&3)+(lane>>2))*PV+(wid>>2)*32+(lane&3)*8;
  const unsigned kdst=lds0+LDS_K+wid*1024, vdst=lds0+LDS_V+wid*1024;
  #define TROW(t) ((long)(((t)<4)?(q0+(t)*KVBLK):(((t)-4)*KVBLK)))
  #define DMA_K(t,slot) glds16(ksrc+TROW(t)*PK,(unsigned)__builtin_amdgcn_readfirstlane(kdst+(slot)))
  #define DMA_V(t,slot) glds16(vsrc+TROW(t)*PV,(unsigned)__builtin_amdgcn_readfirstlane(vdst+(slot)))
  const int vb0=(int)(lds0+LDS_V)+((lane>>4)&1)*32+(lane&3)*8+(4*hi+((lane&15)>>2))*64;
  const char*Kbase=shm+LDS_K; bf16x8 kf[8];
  const lds_cptr shm3=(lds_cptr)shm; const lds_cptr kp0=shm3+LDS_K+hi*1024+r32*16; const lds_cptr vp0=shm3+LDS_V+((lane>>4)&1)*32+(lane&3)*8+(4*hi+((lane&15)>>2))*64;
  const int NT=(q0+QB)/KVBLK;
  DMA_K(0,0);DMA_V(0,0);DMA_K(1,SLOTB);
  bf16x8 qr[4];
  #pragma unroll
  for(int d0=0;d0<4;++d0)qr[d0]=*reinterpret_cast<const bf16x8*>(&Qw[(long)r32*PQ+d0*16+hi*8]);
  float mhat=0.f,l_reg=0.f;f32x16 o[2];o[0]=f32x16{};o[1]=f32x16{};
  const int qrel=wid*QBLK+r32;
  const unsigned selb=((const unsigned char*)(shm+LDS_SEL))[qrel];
  #define CMASK(P0,P1,t) cmask(P0,P1,(t),qrel,hi)
  #define SUBREF(C0,C1,t) do{ const float sb_=(((t)<4)||((selb>>(((t)-4)>>2))&1u))?mhat:INFINITY; _Pragma("unroll") for(int r_=0;r_<16;++r_){C0[r_]-=sb_;C1[r_]-=sb_;} }while(0)
  bool resc=false;
  #define START(P0,P1) do{ const float rm=rowmax(P0,P1); resc=false; \
    { const float dl=rm; mhat=fadd_s(mhat,dl); \
      _Pragma("unroll") for(int r=0;r<16;++r){P0[r]=fsub_s(P0[r],dl);P1[r]=fsub_s(P1[r],dl);} \
      } \
    _Pragma("unroll") for(int r=0;r<16;++r)P0[r]=__builtin_amdgcn_exp2f(P0[r]); }while(0)
  #define RESC() do{ if(resc){ asm volatile("s_waitcnt lgkmcnt(0)":::"memory"); \
      _Pragma("unroll") for(int d_=0;d_<2;++d_) _Pragma("unroll") for(int r=0;r<16;++r)o[d_][r]*=wsf[crow(r,hi)]; } }while(0)
  f32x16 pA0,pA1,pB0,pB1;
  int sl_prev=0,sl_cur=0,sl_next=SLOTB;
  #define ROT() do{sl_prev=sl_cur;sl_cur=sl_next;sl_next=(sl_next==(NSLOT-1)*SLOTB)?0:sl_next+SLOTB;}while(0)
  DMA_K(2,2*SLOTB);
  WAIT_BAR(3);
  qkt(pA0,pA1,Kbase,qr,f32x16{},r32,hi);asm volatile("s_nop 15\n\ts_nop 7":"+v"(pA0),"+v"(pA1));CMASK(pA0,pA1,0);
  START(pA0,pA1);
  _Pragma("unroll") for(int r=0;r<16;++r)pA1[r]=__builtin_amdgcn_exp2f(pA1[r]);
  WAIT_BAR(0);
  DMA_K(3,0);DMA_V(1,SLOTB);
  ROT();
  kload8(kf,kp0+sl_cur);
  WAIT_BAR(2);
  s16x4 vlo[8],vhi[8]; u32x4 pw0,pw1,pw2,pw3;
  #define PKW(P,B) cvtpk_s(P[B],P[B+1])
  #define PAF(k) __builtin_bit_cast(bf16x8,pw##k)
  #define VFR(i) (bf16x8){vlo[i][0],vlo[i][1],vlo[i][2],vlo[i][3],vhi[i][0],vhi[i][1],vhi[i][2],vhi[i][3]}
  #define PIN(x) asm volatile("":"+v"(x))
  #define MX3(a,b,c) __builtin_fmaxf(__builtin_fmaxf((a),(b)),(c))
  #define GAPA(MF,A0,A1,A2,A3,W0,W1,PW) do{ MF; sacc+=A0; sacc+=A1; sacc+=A2; sacc+=A3; PIN(sacc); W0; W1; PIN(PW); SBAR(); }while(0)
  #define EX(v) __builtin_amdgcn_exp2f(v)
  #define GAPB(MF,X,B) do{ MF; X[B]=EX(X[B]); X[B+1]=EX(X[B+1]); X[B+2]=EX(X[B+2]); X[B+3]=EX(X[B+3]); PIN(X); SBAR(); }while(0)
  #define VRD(i) do{ vlo[i]=vtr(vp_+(((i)>>2)*4096+((i)&3)*1024)); vhi[i]=vtr(vp_+(((i)>>2)*4096+((i)&3)*1024+512)); }while(0)
  #define KRD(G,j) do{ if(G){ kload2(kf,kp0+sl_next,j); SBAR(); } }while(0)
  #define STEP(C0,C1,P0,P1,t,GK,GV,GL,MB) do{ SBAR(); \
    const lds_cptr vp_=vp0+sl_prev; \
    VRD(0); SBAR(); float sacc=(P0[0]+P0[1]); \
    GAPA(C0=__builtin_amdgcn_mfma_f32_32x32x16_bf16(kf[0],qr[0],f32x16{},0,0,0), P0[2],P0[3],P0[4],P0[5],     pw0[0]=PKW(P0,0), pw0[1]=PKW(P0,2), pw0); \
    VRD(4); SBAR(); GAPA(C1=__builtin_amdgcn_mfma_f32_32x32x16_bf16(kf[1],qr[0],f32x16{},0,0,0), P0[6],P0[7],P0[8],P0[9],     pw0[2]=PKW(P0,4), pw0[3]=PKW(P0,6), pw0); \
    VRD(1); SBAR(); GAPA(C0=__builtin_amdgcn_mfma_f32_32x32x16_bf16(kf[2],qr[1],C0,0,0,0),   P0[10],P0[11],P0[12],P0[13], pw1[0]=PKW(P0,8), pw1[1]=PKW(P0,10), pw1); \
    VRD(5); SBAR(); GAPA(C1=__builtin_amdgcn_mfma_f32_32x32x16_bf16(kf[3],qr[1],C1,0,0,0),   P0[14],P0[15],P1[0],P1[1],   pw1[2]=PKW(P0,12),pw1[3]=PKW(P0,14), pw1); \
    VRD(2); SBAR(); GAPA(C0=__builtin_amdgcn_mfma_f32_32x32x16_bf16(kf[4],qr[2],C0,0,0,0),   P1[2],P1[3],P1[4],P1[5],     pw2[0]=PKW(P1,0), pw2[1]=PKW(P1,2), pw2); \
    VRD(6); SBAR(); GAPA(C1=__builtin_amdgcn_mfma_f32_32x32x16_bf16(kf[5],qr[2],C1,0,0,0),   P1[6],P1[7],P1[8],P1[9],     pw2[2]=PKW(P1,4), pw2[3]=PKW(P1,6), pw2); \
    VRD(3); SBAR(); GAPA(C0=__builtin_amdgcn_mfma_f32_32x32x16_bf16(kf[6],qr[3],C0,0,0,0),   P1[10],P1[11],P1[12],P1[13], pw3[0]=PKW(P1,8), pw3[1]=PKW(P1,10), pw3); \
    VRD(7); SBAR(); GAPA(C1=__builtin_amdgcn_mfma_f32_32x32x16_bf16(kf[7],qr[3],C1,0,0,0),   P1[14],P1[15],0.f,0.f,       pw3[2]=PKW(P1,12),pw3[3]=PKW(P1,14), pw3); \
    l_reg+=sacc; \
    if(GK){DMA_K((t)+3,sl_cur);} if(GV){DMA_V((t)+1,sl_next);} \
    SUBREF(C0,C1,t); if(MB){CMASK(C0,C1,t);} \
    { float a=MX3(C0[0],C0[1],C1[0]),b=MX3(C0[2],C0[3],C1[1]); a=MX3(a,C1[2],C1[3]); \
      _Pragma("unroll") for(int r=4;r<16;r+=4){a=MX3(a,C0[r],C0[r+1]);b=MX3(b,C0[r+2],C0[r+3]);a=MX3(a,C1[r],C1[r+1]);b=MX3(b,C1[r+2],C1[r+3]);} \
      float rm=__builtin_fmaxf(a,b); { auto rr=__builtin_amdgcn_permlane32_swap(__float_as_uint(rm),__float_as_uint(rm),false,false); rm=__builtin_fmaxf(__uint_as_float(rr[0]),__uint_as_float(rr[1])); } \
      resc=false; \
      if(__builtin_expect(__any(rm>(float)THRL),0)){ const float dl=__builtin_fmaxf(rm,0.f); mhat+=dl; \
        _Pragma("unroll") for(int r=0;r<16;++r){C0[r]-=dl;C1[r]-=dl;} \
        const float f=__builtin_amdgcn_exp2f(-dl); l_reg*=f; if(hi==0)wsf[r32]=f; resc=true; } } \
    SBAR(); \
    GAPB(o[0]=__builtin_amdgcn_mfma_f32_32x32x16_bf16(PAF(0),VFR(0),o[0],0,0,0), C0,0); \
    GAPB(o[1]=__builtin_amdgcn_mfma_f32_32x32x16_bf16(PAF(0),VFR(4),o[1],0,0,0), C0,4); \
    KRD(GL,0); GAPB(o[0]=__builtin_amdgcn_mfma_f32_32x32x16_bf16(PAF(1),VFR(1),o[0],0,0,0), C0,8); \
    KRD(GL,1); GAPB(o[1]=__builtin_amdgcn_mfma_f32_32x32x16_bf16(PAF(1),VFR(5),o[1],0,0,0), C0,12); \
    KRD(GL,2); GAPB(o[0]=__builtin_amdgcn_mfma_f32_32x32x16_bf16(PAF(2),VFR(2),o[0],0,0,0), C1,0); \
    KRD(GL,3); GAPB(o[1]=__builtin_amdgcn_mfma_f32_32x32x16_bf16(PAF(2),VFR(6),o[1],0,0,0), C1,4); \
    GAPB(o[0]=__builtin_amdgcn_mfma_f32_32x32x16_bf16(PAF(3),VFR(3),o[0],0,0,0), C1,8); \
    GAPB(o[1]=__builtin_amdgcn_mfma_f32_32x32x16_bf16(PAF(3),VFR(7),o[1],0,0,0), C1,12); \
    }while(0)
  #define ENDW(tt) do{ if((tt)+3<NT){WAIT_BAR(2);} else if((tt)+2<NT){WAIT_BAR(1);} else {WAIT_BAR(0);} }while(0)
  { int t=1;
    for(;t+1<NT;t+=2){
      STEP(pB0,pB1,pA0,pA1,t,(t+3<NT),(t+1<NT),(t+1<NT),(t<4));       ENDW(t);   RESC(); ROT();
      STEP(pA0,pA1,pB0,pB1,t+1,(t+4<NT),(t+2<NT),(t+2<NT),(t+1<4));     ENDW(t+1); RESC(); ROT();
    }
    STEP(pB0,pB1,pA0,pA1,NT-1,false,false,false,(NT==4)); RESC();
  }
  { float sacc=pB0[0]+pB0[1]; _Pragma("unroll") for(int r=2;r<16;++r)sacc+=pB0[r]; _Pragma("unroll") for(int r=0;r<16;++r)sacc+=pB1[r]; l_reg+=sacc;
    pw0=(u32x4){PKW(pB0,0),PKW(pB0,2),PKW(pB0,4),PKW(pB0,6)};pw1=(u32x4){PKW(pB0,8),PKW(pB0,10),PKW(pB0,12),PKW(pB0,14)};pw2=(u32x4){PKW(pB1,0),PKW(pB1,2),PKW(pB1,4),PKW(pB1,6)};pw3=(u32x4){PKW(pB1,8),PKW(pB1,10),PKW(pB1,12),PKW(pB1,14)};
    SBAR(); pv(o,vb0+sl_cur,PAF(0),PAF(1),PAF(2),PAF(3)); }
  #undef PKW
  #undef PAF
  #undef VFR
  #undef PIN
  #undef MX3
  #undef GAPA
  #undef GAPB
  #undef EX
  #undef VRD
  #undef KRD
  #undef STEP
  #undef ENDW
  {auto rr=__builtin_amdgcn_permlane32_swap(__float_as_uint(l_reg),__float_as_uint(l_reg),false,false);l_reg=__uint_as_float(rr[0])+__uint_as_float(rr[1]);}
  if(hi==0)wsf[32+r32]=l_reg;asm volatile("s_waitcnt lgkmcnt(0)":::"memory");
  float rli[16];
  #pragma unroll
  for(int r=0;r<16;++r)rli[r]=__builtin_amdgcn_rcpf(wsf[32+crow(r,hi)]);
  bf16*Ow=O+(rowbase+q0+wid*QBLK)*PO+h*D;
  { bf16*stg=(bf16*)(shm+LDS_OST)+wid*2048;
    #pragma unroll
    for(int r=0;r<16;++r){const int orow=crow(r,hi);
      #pragma unroll
      for(int d0=0;d0<2;++d0)stg[orow*64+d0*32+r32]=__float2bfloat16(o[d0][r]*rli[r]);}
    asm volatile("s_waitcnt lgkmcnt(0)":::"memory");
    #pragma unroll
    for(int i=0;i<4;++i){const int row=i*8+(lane>>3),ch=lane&7; const u32x4 v=*(const u32x4*)(stg+row*64+ch*8); ATTN_STORE16(Ow+(long)row*PO+ch*8,v);} }
  asm volatile("s_waitcnt lgkmcnt(0)\n\ts_barrier":::"memory");
  #undef DMA_K
  #undef TROW
  #undef SUBREF
  #undef DMA_V
  #undef CMASK
  #undef START
  #undef RESC
  #undef ROT
}
constexpr int ATTN_LDS_BYTES=LDS_BYTES;
#undef SBAR
#undef WAIT_BAR
}
constexpr int DM = 1024, NB = 16, SEQ = 2048, NT = NB * SEQ;
constexpr int RWW = 512, WIN_N = 5376, INC = 4352, ZV = 1792, ZG = 2304;
constexpr int NEXP = 32, DEXP = 512;
constexpr int XS_ROWS = 2 * NT + NEXP * 256;
constexpr float C2 = 0.125f * 1.4426950408889634f;

#define LAS __attribute__((address_space(3)))
#define GAS __attribute__((address_space(1)))
typedef unsigned short bf16;
typedef unsigned v4u __attribute__((ext_vector_type(4)));
typedef unsigned v2u __attribute__((ext_vector_type(2)));
typedef float f32x4 __attribute__((ext_vector_type(4)));

typedef float f32x2_c __attribute__((ext_vector_type(2))); typedef __bf16 bf16x2_c __attribute__((ext_vector_type(2)));
__device__ __forceinline__ unsigned pk2(float lo, float hi) { const f32x2_c v = {lo, hi}; return __builtin_bit_cast(unsigned, __builtin_convertvector(v, bf16x2_c)); }
__device__ __forceinline__ unsigned f2bf(float f) { return pk2(f, f) & 0xffffu; }
__device__ __forceinline__ float bflo(unsigned w) { return __builtin_bit_cast(float, w << 16); }
__device__ __forceinline__ float bfhi(unsigned w) { return __builtin_bit_cast(float, w & 0xffff0000u); }
__device__ __forceinline__ float sigm(float x) { return __builtin_amdgcn_rcpf(1.0f + __expf(-x)); }

constexpr size_t MiB = 1u << 20;
constexpr size_t WS_CTL = 0;
constexpr size_t WS_MOD = 1 * MiB;
constexpr size_t WS_GM2 = 1 * MiB + 512 * 1024;
constexpr size_t WS_CB = 1 * MiB + 640 * 1024;
constexpr size_t WS_COS = 2 * MiB;
constexpr size_t WS_SIN = 2 * MiB + 512 * 1024;
constexpr size_t WS_KMEAN = 3 * MiB;
constexpr size_t WS_WRH = 3 * MiB + 512 * 1024;
constexpr size_t WS_WRL = 3 * MiB + 768 * 1024;
constexpr size_t WS_SEL = 4 * MiB;
constexpr size_t WS_RTE = 5 * MiB;
constexpr size_t WS_RTW = 5 * MiB + 256 * 1024;
constexpr size_t WS_RNK = 5 * MiB + 512 * 1024;
constexpr size_t WS_POS = 5 * MiB + 768 * 1024;
constexpr size_t WS_RSTD = 7 * MiB;
constexpr size_t WS_WLT = 6 * MiB;
constexpr size_t WS_WAT = 6 * MiB + 64 * 1024;
constexpr size_t WS_WGT = 6 * MiB + 128 * 1024;
constexpr size_t WS_WIN = 16 * MiB;
constexpr size_t WS_WBA = 27 * MiB;
constexpr size_t WS_WBB = 28 * MiB;
constexpr size_t WS_WOUT = 29 * MiB;
constexpr size_t WS_Z = 32 * MiB;
constexpr size_t WS_H = 368 * MiB;
constexpr size_t WS_Q = 304 * MiB, WS_K = 336 * MiB, WS_MRG = 368 * MiB;
constexpr size_t WS_YA = 432 * MiB, WS_YB = 464 * MiB;
constexpr size_t WS_WUP = 32 * MiB;
constexpr size_t WS_W2T = 96 * MiB;
constexpr size_t WS_H2 = 128 * MiB;
constexpr size_t WS_XS = 192 * MiB;
constexpr size_t WS_HID = 336 * MiB;
constexpr size_t WS_X1B = 432 * MiB;
constexpr size_t WS_END = 496 * MiB;
constexpr int CW_CNT = 64, CNT_PAD = 64;
constexpr int CW_NT = 2304;
constexpr int CW_TEXP = 2368;
static_assert(CW_CNT + NEXP * CNT_PAD <= CW_NT, "control words");

__device__ __forceinline__ void tr_item(const float* W, int K, int N, bf16* WT, int kb, int nb, int dst_row0, LAS float* scr, int lane) {
    const int k0 = 64 * kb, n0 = 32 * nb;
#pragma unroll 8
    for (int i = 0; i < 32; ++i) { const int kk = 2 * i + (lane >> 5); scr[kk * 33 + (lane & 31)] = W[(size_t)(k0 + kk) * N + n0 + (lane & 31)]; }
    asm volatile("s_waitcnt lgkmcnt(0)" ::: "memory");
    const int c = lane & 7;
#pragma unroll
    for (int j = 0; j < 4; ++j) { const int n = (lane >> 3) + 8 * j; const LAS float* s = scr + (8 * c) * 33 + n;
        v4u o; o.x = pk2(s[0 * 33], s[1 * 33]); o.y = pk2(s[2 * 33], s[3 * 33]); o.z = pk2(s[4 * 33], s[5 * 33]); o.w = pk2(s[6 * 33], s[7 * 33]);
        *(v4u*)(WT + (size_t)(dst_row0 + n) * K + k0 + 8 * c) = o; }
    asm volatile("s_waitcnt lgkmcnt(0)" ::: "memory");
}

struct PArgs { const float* in[30]; float* out; unsigned char* ws; };

__device__ __forceinline__ void p_prep_weights(const PArgs& a, unsigned char* lds, int wv) {
    const int tid = mktid(wv), lane = tid & 63, wave = tid >> 6;
    LAS float* scr = (LAS float*)lds + wave * (64 * 33);
    const int gw = blockIdx.x * 8 + wave, NGW = gridDim.x * 8;
    unsigned char* ws = a.ws;
    constexpr int I_IN = 16 * 168, I_BR = 8 * 32, I_OUT = 16 * 32;
    for (int it = gw; it < I_IN + 2 * I_BR + I_OUT; it += NGW) {
        int r = it;
        if (r < I_IN) { const int kb = r / 168, nb = r % 168; int dst = 32 * nb;
            if (dst >= 1792 && dst < 2816) { const int rel = dst - 1792, u = rel >> 8, hl = (rel & 255) >> 6, half = (rel & 63) >> 5; dst = 1792 + u * 256 + half * 128 + hl * 32; }
            tr_item(a.in[6], 1024, WIN_N, (bf16*)(ws + WS_WIN), kb, nb, dst, scr, lane); continue; } r -= I_IN;
        if (r < I_BR) { const int kb = r / 32, nb = r % 32; tr_item(a.in[20], 512, 1024, (bf16*)(ws + WS_WBA), kb, nb, 32 * nb, scr, lane); continue; } r -= I_BR;
        if (r < I_BR) { const int kb = r / 32, nb = r % 32; tr_item(a.in[21], 512, 1024, (bf16*)(ws + WS_WBB), kb, nb, 32 * nb, scr, lane); continue; } r -= I_BR;
        { const int kb = r / 32, nb = r % 32; tr_item(a.in[22], 1024, 1024, (bf16*)(ws + WS_WOUT), kb, nb, 32 * nb, scr, lane); }
    }
    const int gt = blockIdx.x * 512 + tid, NGT = gridDim.x * 512;
    float* cosT = (float*)(ws + WS_COS); float* sinT = (float*)(ws + WS_SIN);
    for (int i = gt; i < SEQ * 32; i += NGT) { const int s = i >> 5, f = i & 31; const float inv = powf(10000.0f, -(float)f / 32.0f); const float ang = (float)s * inv; cosT[i] = cosf(ang); sinT[i] = sinf(ang); }
    { bf16* wlt = (bf16*)(ws + WS_WLT); bf16* wat = (bf16*)(ws + WS_WAT); bf16* wgt = (bf16*)(ws + WS_WGT);
      for (int i = gt; i < 8 * 64 * 64; i += NGT) { const int hh = i >> 12, j = (i >> 6) & 63, m = i & 63; wlt[i] = (bf16)f2bf(a.in[9][m * 512 + hh * 64 + j]); wat[i] = (bf16)f2bf(a.in[11][m * 512 + hh * 64 + j]); }
      for (int i = gt; i < 8 * 64 * 128; i += NGT) { const int hh = i >> 13, j = (i >> 7) & 63, m = i & 127; wgt[i] = (bf16)f2bf(a.in[12][m * 512 + hh * 64 + j]); } }
    { bf16* wrh = (bf16*)(ws + WS_WRH); bf16* wrl = (bf16*)(ws + WS_WRL);
      for (int i = gt; i < 48 * 1024; i += NGT) { const int e = i >> 10, k = i & 1023; const float w = e < 4 ? a.in[23][k * 4 + e] : e < 36 ? a.in[25][k * 32 + (e - 4)] : 0.f;
          const unsigned hi = f2bf(w); wrh[i] = (bf16)hi; wrl[i] = (bf16)f2bf(w - bflo(hi)); } }
}

__device__ __forceinline__ void p_prep_experts(const PArgs& a, unsigned char* lds, int wv) {
    const int tid = mktid(wv), lane = tid & 63, wave = tid >> 6;
    LAS float* scr = (LAS float*)lds + wave * (64 * 33);
    const int gw = blockIdx.x * 8 + wave, NGW = gridDim.x * 8;
    unsigned char* ws = a.ws;
    for (int it = gw; it < NEXP * 768; it += NGW) {
        const int e = it / 768; int r = it % 768;
        bf16* wup = (bf16*)(ws + WS_WUP) + (size_t)e * 1024 * 1024;
        if (r < 256) { const int kb = r / 16, nb = r % 16, n0 = 32 * nb; tr_item(a.in[27] + (size_t)e * 1024 * 512, 1024, 512, wup, kb, nb, (n0 >> 7) * 256 + (n0 & 127), scr, lane); continue; } r -= 256;
        if (r < 256) { const int kb = r / 16, nb = r % 16, n0 = 32 * nb; tr_item(a.in[28] + (size_t)e * 1024 * 512, 1024, 512, wup, kb, nb, (n0 >> 7) * 256 + 128 + (n0 & 127), scr, lane); continue; } r -= 256;
        { const int kb = r / 32, nb = r % 32; tr_item(a.in[29] + (size_t)e * 512 * 1024, 512, 1024, (bf16*)(ws + WS_W2T) + (size_t)e * 1024 * 512, kb, nb, 32 * nb, scr, lane); }
    }
}

__device__ __forceinline__ void p_ada(const PArgs& a, unsigned char* lds, int wv) {
    float* sc = (float*)lds; float* red = sc + 16 * 1024;
    const float* c = a.in[1]; const float* w = a.in[2]; const float* bias = a.in[3];
    float* mod = (float*)(a.ws + WS_MOD);
    const int tid = mktid(wv);
    for (int i = tid; i < 16 * 1024; i += 512) { const float v = c[i]; sc[i] = v / (1.0f + __expf(-v)); }
    __syncthreads();
    const int col = tid & 31, kg = tid >> 5;
    for (int tile = blockIdx.x; tile < 192; tile += gridDim.x) {
        const int e = tile * 32 + col;
        float acc[16];
#pragma unroll
        for (int b = 0; b < 16; ++b) acc[b] = 0.f;
        for (int d = kg * 64; d < kg * 64 + 64; ++d) { const float wv = w[(size_t)d * 6144 + e];
#pragma unroll
            for (int b = 0; b < 16; ++b) acc[b] += sc[b * 1024 + d] * wv; }
#pragma unroll
        for (int b = 0; b < 16; ++b) red[(kg * 16 + b) * 32 + col] = acc[b];
        __syncthreads();
        { const int b = tid >> 5, cc = tid & 31; float sm = 0.f;
#pragma unroll
            for (int k = 0; k < 16; ++k) sm += red[(k * 16 + b) * 32 + cc];
            mod[b * 6144 + tile * 32 + cc] = sm + bias[tile * 32 + cc]; }
        __syncthreads();
    }
}

__device__ __forceinline__ void p_norm1(const PArgs& a, unsigned char* lds, int wv) {
    const int tid = mktid(wv), lane = tid & 63, gw = blockIdx.x * 8 + (tid >> 6), NGW = gridDim.x * 8;
    const float* x = a.in[0]; const float* g = a.in[4]; const float* mod = (const float*)(a.ws + WS_MOD);
    bf16* h = (bf16*)(a.ws + WS_H);
    for (int m = gw; m < NT; m += NGW) {
        const int b = m >> 11; const f32x4* xr = (const f32x4*)(x + (size_t)m * DM) + lane; f32x4 v[4]; float s = 0.f;
#pragma unroll
        for (int j = 0; j < 4; ++j) { v[j] = xr[64 * j]; s += (v[j].x * v[j].x + v[j].y * v[j].y) + (v[j].z * v[j].z + v[j].w * v[j].w); }
        const float rstd = rsqrtf(wave_sum(s) * (1.0f / DM) + 1e-6f);
        v2u* o = (v2u*)(h + (size_t)m * DM) + lane;
#pragma unroll
        for (int j = 0; j < 4; ++j) { const int col = 4 * (lane + 64 * j);
            const f32x4 gg = *(const f32x4*)(g + col), sh = *(const f32x4*)(mod + b * 6144 + col), scl = *(const f32x4*)(mod + b * 6144 + 1024 + col);
            const f32x4 r = v[j] * rstd * gg * (scl + 1.0f) + sh; v2u w; w.x = pk2(r.x, r.y); w.y = pk2(r.z, r.w); o[64 * j] = w; }
    }
    { float* gm2 = (float*)(a.ws + WS_GM2); float* cb = (float*)(a.ws + WS_CB); const float* g2 = a.in[5];
      for (int i = blockIdx.x * 512 + tid; i < 16 * 1024; i += gridDim.x * 512) { const int b = i >> 10, k = i & 1023; gm2[i] = g2[k] * (1.0f + mod[b * 6144 + 4096 + k]); }
      for (int p = gw; p < 16 * 48; p += NGW) { const int b = p / 48, n = p % 48; float s = 0.f;
          if (n < 36) { for (int k = lane; k < 1024; k += 64) { const float w = n < 4 ? a.in[23][k * 4 + n] : a.in[25][k * 32 + (n - 4)]; s += mod[b * 6144 + 3072 + k] * w; } }
          s = wave_sum(s); if (lane == 0) cb[p] = n < 4 ? s + a.in[24][n] : n < 36 ? s + a.in[26][n - 4] : 0.f; } }
}

using pg8::Unit; using pg8::HALF; using pg8::BM; using pg8::cvt_pk_bf16;
typedef pg8::f32x4 pf4; typedef pg8::u32x4 pu4;

struct EpiStoreBf16 {
    static constexpr bool PERM = true, AFTER_DRAIN = false, CHAIN = false;
    bf16* O; int ldc;
    __device__ __forceinline__ void operator()(const pf4 (&acc)[2][2][4][2], const Unit& u, int wr, int wc, int fr, int fq) const {
        const int row0 = u.pm * BM + wr * 64 + fr, col0 = u.pn * BM + wc * 32 + 8 * fq;
#pragma unroll
        for (int ai = 0; ai < 2; ++ai)
#pragma unroll
            for (int m = 0; m < 4; ++m) { bf16* rowp = O + (size_t)(row0 + ai * HALF + m * 16) * ldc + col0;
#pragma unroll
                for (int bj = 0; bj < 2; ++bj) { const pf4 v0 = acc[ai][bj][m][0], v1 = acc[ai][bj][m][1]; pu4 w;
                    w.x = cvt_pk_bf16(v0[0], v0[1]); w.y = cvt_pk_bf16(v0[2], v0[3]); w.z = cvt_pk_bf16(v1[0], v1[1]); w.w = cvt_pk_bf16(v1[2], v1[3]);
                    *(pu4*)(rowp + bj * HALF) = w; } }
    }
};
struct EpiZ {
    static constexpr bool PERM = true, AFTER_DRAIN = false, CHAIN = false;
    bf16* z; bf16* Q; bf16* K; const float* qg; const float* kg; const float* cosT; const float* sinT;
    __device__ __forceinline__ void operator()(const pf4 (&acc)[2][2][4][2], const Unit& u, int wr, int wc, int fr, int fq) const {
        const int row0 = u.pm * BM + wr * 64 + fr;
        if (u.pn < 7 || u.pn >= 11) {
            const int zc = (u.pn < 7 ? u.pn * 256 : (u.pn - 11) * 256 + 1792) + wc * 32 + 8 * fq;
#pragma unroll
            for (int ai = 0; ai < 2; ++ai)
#pragma unroll
                for (int m = 0; m < 4; ++m) { bf16* rowp = z + (size_t)(row0 + ai * HALF + m * 16) * INC + zc;
#pragma unroll
                    for (int bj = 0; bj < 2; ++bj) { const pf4 v0 = acc[ai][bj][m][0], v1 = acc[ai][bj][m][1]; pu4 w;
                        w.x = cvt_pk_bf16(v0[0], v0[1]); w.y = cvt_pk_bf16(v0[2], v0[3]); w.z = cvt_pk_bf16(v1[0], v1[1]); w.w = cvt_pk_bf16(v1[2], v1[3]);
                        *(pu4*)(rowp + bj * HALF) = w; } }
            return;
        }
        const bool isk = u.pn >= 9; const int head = 4 * ((u.pn - 7) & 1) + wc; const float* g = isk ? kg : qg; bf16* O = (isk ? K : Q) + head * 64 + 8 * fq;
        const float osc = isk ? 1.0f : C2;
#pragma unroll
        for (int ai = 0; ai < 2; ++ai)
#pragma unroll
            for (int m = 0; m < 4; ++m) { int rb = row0, fqv = fq; asm volatile("" : "+v"(rb), "+v"(fqv));
                const int row = rb + ai * HALF + m * 16, s = row & (SEQ - 1);
                float ss = 0.f;
#pragma unroll
                for (int bj = 0; bj < 2; ++bj)
#pragma unroll
                    for (int n = 0; n < 2; ++n) { const pf4 v = acc[ai][bj][m][n]; ss += (v[0] * v[0] + v[1] * v[1]) + (v[2] * v[2] + v[3] * v[3]); }
                ss += __builtin_bit_cast(float, __builtin_amdgcn_ds_swizzle(__builtin_bit_cast(int, ss), 0x401F));
                { const unsigned uu = __builtin_bit_cast(unsigned, ss); auto rr = __builtin_amdgcn_permlane32_swap(uu, uu, false, false); ss = __builtin_bit_cast(float, (unsigned)rr[0]) + __builtin_bit_cast(float, (unsigned)rr[1]); }
                const float rstd = rsqrtf(ss * (1.0f / 64.0f) + 1e-6f) ;
#pragma unroll
                for (int n = 0; n < 2; ++n) { const pf4 c = *(const pf4*)(cosT + s * 32 + 8 * fqv + 4 * n), sn = *(const pf4*)(sinT + s * 32 + 8 * fqv + 4 * n);
                    const pf4 x1 = acc[ai][0][m][n] * rstd * *(const pf4*)(g + 8 * fqv + 4 * n), x2 = acc[ai][1][m][n] * rstd * *(const pf4*)(g + 32 + 8 * fqv + 4 * n);
                    const pf4 o1 = x1 * c - x2 * sn, o2 = x2 * c + x1 * sn;
                    v2u wa, wb; wa.x = cvt_pk_bf16(o1[0] * osc, o1[1] * osc); wa.y = cvt_pk_bf16(o1[2] * osc, o1[3] * osc); wb.x = cvt_pk_bf16(o2[0] * osc, o2[1] * osc); wb.y = cvt_pk_bf16(o2[2] * osc, o2[3] * osc);
                    bf16* op = (isk ? K : Q) + (size_t)row * 512 + head * 64 + 8 * fqv + 4 * n; *(v2u*)op = wa; *(v2u*)(op + 32) = wb;
                    asm volatile("" ::: "memory"); } }
    }
};
struct EpiMerge {
    static constexpr bool PERM = true, AFTER_DRAIN = false, CHAIN = true;
    const bf16* z; bf16* mrg;
    __device__ __forceinline__ bool chain(pf4 (&acc)[2][2][4][2], const Unit& u, int wr, int wc, int fr, int fq) const {
        const int row0 = u.pm * BM + wr * 64 + fr, col0 = u.pn * BM + wc * 32 + 8 * fq;
        if (u.aux == 0) {
#pragma unroll
            for (int ai = 0; ai < 2; ++ai)
#pragma unroll
                for (int m = 0; m < 4; ++m) { const size_t row = (size_t)(row0 + ai * HALF + m * 16);
#pragma unroll
                    for (int bj = 0; bj < 2; ++bj) { const int col = col0 + bj * HALF; const pu4 za = *(const pu4*)(z + row * INC + ZG + col), zb = *(const pu4*)(z + row * INC + ZG + 1024 + col);
                        const float a8[8] = {bflo(za.x), bfhi(za.x), bflo(za.y), bfhi(za.y), bflo(za.z), bfhi(za.z), bflo(za.w), bfhi(za.w)};
                        const float b8[8] = {bflo(zb.x), bfhi(zb.x), bflo(zb.y), bfhi(zb.y), bflo(zb.z), bfhi(zb.z), bflo(zb.w), bfhi(zb.w)};
#pragma unroll
                        for (int e = 0; e < 8; ++e) acc[ai][bj][m][e >> 2][e & 3] *= (1.0f + __expf(-b8[e])) * __builtin_amdgcn_rcpf(1.0f + __expf(-a8[e])); } }
            return true;
        }
#pragma unroll
        for (int ai = 0; ai < 2; ++ai)
#pragma unroll
            for (int m = 0; m < 4; ++m) { const size_t row = (size_t)(row0 + ai * HALF + m * 16);
#pragma unroll
                for (int bj = 0; bj < 2; ++bj) { const int col = col0 + bj * HALF; const pu4 gz = *(const pu4*)(z + row * INC + ZG + 1024 + col); const pf4 v0 = acc[ai][bj][m][0], v1 = acc[ai][bj][m][1];
                    pu4 w;
                    w.x = cvt_pk_bf16(sigm(bflo(gz.x)) * v0[0], sigm(bfhi(gz.x)) * v0[1]); w.y = cvt_pk_bf16(sigm(bflo(gz.y)) * v0[2], sigm(bfhi(gz.y)) * v0[3]);
                    w.z = cvt_pk_bf16(sigm(bflo(gz.z)) * v1[0], sigm(bfhi(gz.z)) * v1[1]); w.w = cvt_pk_bf16(sigm(bflo(gz.w)) * v1[2], sigm(bfhi(gz.w)) * v1[3]);
                    *(pu4*)(mrg + row * DM + col) = w; } }
        return false;
    }
};
struct EpiOut {
    static constexpr bool PERM = true, AFTER_DRAIN = false, CHAIN = false;
    const float* x; const float* mod; bf16* x1;
    __device__ __forceinline__ void operator()(const pf4 (&acc)[2][2][4][2], const Unit& u, int wr, int wc, int fr, int fq) const {
        const int row0 = u.pm * BM + wr * 64 + fr, col0 = u.pn * BM + wc * 32 + 8 * fq; const int b = u.pm >> 3;
        pf4 gt[2][2];
#pragma unroll
        for (int bj = 0; bj < 2; ++bj)
#pragma unroll
            for (int n = 0; n < 2; ++n) gt[bj][n] = *(const pf4*)(mod + b * 6144 + 2048 + col0 + bj * HALF + n * 4);
#pragma unroll
        for (int ai = 0; ai < 2; ++ai)
#pragma unroll
            for (int m = 0; m < 4; ++m) { const size_t off = (size_t)(row0 + ai * HALF + m * 16) * DM + col0;
#pragma unroll
                for (int bj = 0; bj < 2; ++bj) { const pf4 x0 = *(const pf4*)(x + off + bj * HALF), x1v = *(const pf4*)(x + off + bj * HALF + 4);
                    const pf4 o0 = x0 + gt[bj][0] * acc[ai][bj][m][0], o1 = x1v + gt[bj][1] * acc[ai][bj][m][1]; pu4 w;
                    w.x = cvt_pk_bf16(o0[0], o0[1]); w.y = cvt_pk_bf16(o0[2], o0[3]); w.z = cvt_pk_bf16(o1[0], o1[1]); w.w = cvt_pk_bf16(o1[2], o1[3]);
                    *(pu4*)(x1 + off + bj * HALF) = w; } }
    }
};
struct EpiUp {
    static constexpr bool PERM = true, AFTER_DRAIN = false, CHAIN = false;
    bf16* hid;
    __device__ __forceinline__ void operator()(const pf4 (&acc)[2][2][4][2], const Unit& u, int wr, int wc, int fr, int fq) const {
        const int row0 = u.pm * BM + wr * 64 + fr, col0 = u.pn * 128 + wc * 32 + 8 * fq;
#pragma unroll
        for (int ai = 0; ai < 2; ++ai)
#pragma unroll
            for (int m = 0; m < 4; ++m) { const size_t row = (size_t)(row0 + ai * HALF + m * 16); float o[8];
#pragma unroll
                for (int n = 0; n < 2; ++n)
#pragma unroll
                    for (int e = 0; e < 4; ++e) { const float g = acc[ai][0][m][n][e], l = acc[ai][1][m][n][e]; o[4 * n + e] = g * sigm(g) * l; }
                pu4 w; w.x = cvt_pk_bf16(o[0], o[1]); w.y = cvt_pk_bf16(o[2], o[3]); w.z = cvt_pk_bf16(o[4], o[5]); w.w = cvt_pk_bf16(o[6], o[7]);
                *(pu4*)(hid + row * DEXP + col0) = w; }
    }
};

struct GemmArgs { unsigned char* ws; const float* x; float* out; const float* qg; const float* kg; };
template <class Epi> __device__ __forceinline__ void run_dense(const void* A, const void* Bt, int M, int N, int K, const Epi& E, unsigned char* lds, int wv) {
    pg8::Gemm g{K}; pg8::StaticOrder S; S.init(A, Bt, M, N, K, (int)gridDim.x, (int)blockIdx.x);
    pg8::gemm_phase<Epi, pg8::StaticOrder, true, true>((PG8_LAS unsigned char*)lds, g, S, E, wv);
}
__device__ __forceinline__ void p_gemm_in(const GemmArgs& a, unsigned char* lds, int wv) {
    EpiZ E{(bf16*)(a.ws + WS_Z), (bf16*)(a.ws + WS_Q), (bf16*)(a.ws + WS_K), a.qg, a.kg, (const float*)(a.ws + WS_COS), (const float*)(a.ws + WS_SIN)};
    run_dense(a.ws + WS_H, a.ws + WS_WIN, NT, WIN_N, 1024, E, lds, wv);
}
struct PairOrder {
    int nM, nN, nwg, G, c; const char *A0, *A1, *B0, *B1; size_t tstep;
    __device__ bool next(int i, Unit& u) const {
        const long L = (long)(i >> 1) * G + c; if (L >= nwg) return false;
        int wgid = (int)L; { const int q = nwg / pg8::NXCD, r = nwg % pg8::NXCD, xcd = wgid % pg8::NXCD, off = wgid / pg8::NXCD; wgid = (xcd < r ? xcd * (q + 1) : r * (q + 1) + (xcd - r) * q) + off; }
        const int nig = pg8::WGM * nN, gid = wgid / nig, fm = gid * pg8::WGM, gsz = (nM - fm) < pg8::WGM ? (nM - fm) : pg8::WGM;
        u.pm = fm + ((wgid % nig) % gsz); u.pn = (wgid % nig) / gsz; u.aux = i & 1;
        u.a = ((i & 1) ? A1 : A0) + (size_t)u.pm * tstep; u.b = ((i & 1) ? B1 : B0) + (size_t)u.pn * tstep; return true;
    }
    __device__ __forceinline__ void a_ready(const Unit&) const {}
    __device__ __forceinline__ void done(const Unit&) const {}
};
__device__ __forceinline__ void p_gemm_merge(const GemmArgs& a, unsigned char* lds, int wv) {
    PairOrder S{NT / 256, 4, (NT / 256) * 4, (int)gridDim.x, (int)blockIdx.x, (const char*)(a.ws + WS_YA), (const char*)(a.ws + WS_YB), (const char*)(a.ws + WS_WBA), (const char*)(a.ws + WS_WBB), (size_t)256 * 512 * 2};
    EpiMerge E{(const bf16*)(a.ws + WS_Z), (bf16*)(a.ws + WS_MRG)}; pg8::Gemm g{512};
    pg8::gemm_phase<EpiMerge, PairOrder, true, true>((PG8_LAS unsigned char*)lds, g, S, E, wv);
}
__device__ __forceinline__ void p_gemm_out(const GemmArgs& a, unsigned char* lds, int wv) {
    EpiOut E{a.x, (const float*)(a.ws + WS_MOD), (bf16*)(a.ws + WS_X1B)};
    run_dense(a.ws + WS_MRG, a.ws + WS_WOUT, NT, 1024, 1024, E, lds, wv);
}
struct GroupedOrder {
    const int* texp; int nT, nN, G, c; const char* A; size_t a_tile; const char* B; size_t b_exp, b_tile;
    __device__ bool next(int i, Unit& u) const {
        const long L = (long)i * G + c; if (L >= (long)nT * nN) return false;
        const int tile = (int)(L / nN), pn = (int)(L % nN); u.aux = 0; u.pm = tile; u.pn = pn; u.a = A + (size_t)tile * a_tile; u.b = B + (size_t)texp[tile] * b_exp + (size_t)pn * b_tile; return true;
    }
    __device__ __forceinline__ void a_ready(const Unit&) const {}
    __device__ __forceinline__ void done(const Unit&) const {}
};
__device__ __forceinline__ void p_gemm_up(const GemmArgs& a, unsigned char* lds, int wv) {
    const int* ctl = (const int*)(a.ws + WS_CTL);
    GroupedOrder S{ctl + CW_TEXP, ctl[CW_NT], 4, (int)gridDim.x, (int)blockIdx.x, (const char*)(a.ws + WS_XS), (size_t)256 * 1024 * 2, (const char*)(a.ws + WS_WUP), (size_t)1024 * 1024 * 2, (size_t)256 * 1024 * 2};
    EpiUp E{(bf16*)(a.ws + WS_HID)}; pg8::Gemm g{1024};
    pg8::gemm_phase<EpiUp, GroupedOrder, true, true>((PG8_LAS unsigned char*)lds, g, S, E, wv);
}
__device__ __forceinline__ void p_gemm_down(const GemmArgs& a, unsigned char* lds, int wv) {
    const int* ctl = (const int*)(a.ws + WS_CTL);
    GroupedOrder S{ctl + CW_TEXP, ctl[CW_NT], 4, (int)gridDim.x, (int)blockIdx.x, (const char*)(a.ws + WS_HID), (size_t)256 * 512 * 2, (const char*)(a.ws + WS_W2T), (size_t)1024 * 512 * 2, (size_t)256 * 512 * 2};
    EpiStoreBf16 E{(bf16*)(a.ws + WS_XS), 1024}; pg8::Gemm g{512};
    pg8::gemm_phase<EpiStoreBf16, GroupedOrder, true, true>((PG8_LAS unsigned char*)lds, g, S, E, wv);
}

__device__ __forceinline__ void p_attn(const PArgs& a, unsigned char* lds, int vb, int nvb, int wv) {
    const attn_body::bf16* Q = (const attn_body::bf16*)(a.ws + WS_Q); const attn_body::bf16* K = (const attn_body::bf16*)(a.ws + WS_K);
    const attn_body::bf16* V = (const attn_body::bf16*)(a.ws + WS_Z) + ZV; attn_body::bf16* O = (attn_body::bf16*)(a.ws + WS_YB);
    for (int p = vb; p < 512; p += nvb)
        for (int which = 0; which < 2; ++which) { const int bh = p >> 2, s = p & 3, qb = which ? 7 - s : s;
            attn_body::attn_unit<8>(bh >> 3, bh & 7, qb, Q, K, V, O, (char*)lds, wv); }
}

namespace rw {
typedef short bf16x8 __attribute__((ext_vector_type(8)));
constexpr int MB = 8192;
__device__ __forceinline__ int SW(int r, int c) { return r * 128 + ((((c >> 3) ^ (r >> 1)) & 7) << 4) + (c & 7) * 2; }
__device__ __forceinline__ int SWG(int r, int c) { return r * 256 + ((((c >> 3) ^ r) & 15) << 4) + (c & 7) * 2; }
__device__ __forceinline__ int SWF(int r, int c) { return r * 256 + ((((c >> 2) ^ r) & 15) << 4) + (c & 3) * 4; }
enum { I_AT = 0, I_BT, I_AJ, I_BHJ, I_KHJ, I_ABRT, I_X5, I_L, I_LT, I_R0, I_R1, I_KT, I_RT, I_VJ, I_X14, I_GATE, I_VT, NBUF };
constexpr int OFF_F32 = NBUF * MB;
constexpr int OFF_CST = OFF_F32 + (64 * 3 + 512) * 4;
constexpr int LDS_NEED = OFF_CST + 14 * 64 * 4;

__device__ __forceinline__ bf16x8 ldfrag(const unsigned char* M, int row, int k) { return *(const bf16x8*)(M + SW(row, k)); }
__device__ __forceinline__ void mm(f32x4 (&acc)[2], const unsigned char* X, const unsigned char* Y, int mt, int nh, int fr, int fq) {
    const bf16x8 a0 = ldfrag(X, 16 * mt + fr, 8 * fq), a1 = ldfrag(X, 16 * mt + fr, 8 * fq + 32);
#pragma unroll
    for (int nt = 0; nt < 2; ++nt) { const bf16x8 b0 = ldfrag(Y, 16 * (2 * nh + nt) + fr, 8 * fq), b1 = ldfrag(Y, 16 * (2 * nh + nt) + fr, 8 * fq + 32);
        acc[nt] = __builtin_amdgcn_mfma_f32_16x16x32_bf16(a0, b0, acc[nt], 0, 0, 0); acc[nt] = __builtin_amdgcn_mfma_f32_16x16x32_bf16(a1, b1, acc[nt], 0, 0, 0); }
}
struct FA { bf16x8 k0, k1; };
struct FB { bf16x8 k0[2], k1[2]; };
__device__ __forceinline__ FA ldA(const unsigned char* X, int mt, int fr, int fq) { FA f; f.k0 = ldfrag(X, 16 * mt + fr, 8 * fq); f.k1 = ldfrag(X, 16 * mt + fr, 8 * fq + 32); return f; }
__device__ __forceinline__ FB ldB(const unsigned char* Y, int nh, int fr, int fq) { FB f;
#pragma unroll
    for (int nt = 0; nt < 2; ++nt) { f.k0[nt] = ldfrag(Y, 16 * (2 * nh + nt) + fr, 8 * fq); f.k1[nt] = ldfrag(Y, 16 * (2 * nh + nt) + fr, 8 * fq + 32); }
    return f; }
__device__ __forceinline__ void mma(f32x4 (&acc)[2], const FA& a, const FB& b) {
    acc[0] = __builtin_amdgcn_mfma_f32_16x16x32_bf16(a.k0, b.k0[0], acc[0], 0, 0, 0); acc[1] = __builtin_amdgcn_mfma_f32_16x16x32_bf16(a.k0, b.k0[1], acc[1], 0, 0, 0);
    acc[0] = __builtin_amdgcn_mfma_f32_16x16x32_bf16(a.k1, b.k1[0], acc[0], 0, 0, 0); acc[1] = __builtin_amdgcn_mfma_f32_16x16x32_bf16(a.k1, b.k1[1], acc[1], 0, 0, 0);
}
__device__ __forceinline__ void ldC(f32x4 (&acc)[2], const unsigned char* Z, int mt, int nh, int fr, int fq) {
#pragma unroll
    for (int nt = 0; nt < 2; ++nt) { const v2u w = *(const v2u*)(Z + SW(16 * (2 * nh + nt) + fr, 16 * mt + 4 * fq)); acc[nt] = (f32x4){bflo(w.x), bfhi(w.x), bflo(w.y), bfhi(w.y)}; }
}
__device__ __forceinline__ void storeT(unsigned char* Z, const f32x4 (&acc)[2], int mt, int nh, int fr, int fq) {
#pragma unroll
    for (int nt = 0; nt < 2; ++nt) { v2u w; w.x = pk2(acc[nt][0], acc[nt][1]); w.y = pk2(acc[nt][2], acc[nt][3]); *(v2u*)(Z + SW(16 * (2 * nh + nt) + fr, 16 * mt + 4 * fq)) = w; }
}
__device__ __forceinline__ void storeN(unsigned char* Z, const f32x4 (&acc)[2], int mt, int nh, int fr, int fq) {
#pragma unroll
    for (int nt = 0; nt < 2; ++nt)
#pragma unroll
        for (int r = 0; r < 4; ++r) *(unsigned short*)(Z + SW(16 * mt + 4 * fq + r, 16 * (2 * nh + nt) + fr)) = (unsigned short)f2bf(acc[nt][r]);
}
__device__ __forceinline__ void ld8bf(const unsigned char* p, float (&v)[8]) { const v4u w = *(const v4u*)p; v[0] = bflo(w.x); v[1] = bfhi(w.x); v[2] = bflo(w.y); v[3] = bfhi(w.y); v[4] = bflo(w.z); v[5] = bfhi(w.z); v[6] = bflo(w.w); v[7] = bfhi(w.w); }
__device__ __forceinline__ void st8bf(unsigned char* p, const float (&v)[8]) { v4u w; w.x = pk2(v[0], v[1]); w.y = pk2(v[2], v[3]); w.z = pk2(v[4], v[5]); w.w = pk2(v[6], v[7]); *(v4u*)p = w; }
__device__ __forceinline__ void ld8f(const float* p, float (&v)[8]) { const f32x4 a = *(const f32x4*)p, b = *(const f32x4*)(p + 4); v[0] = a.x; v[1] = a.y; v[2] = a.z; v[3] = a.w; v[4] = b.x; v[5] = b.y; v[6] = b.z; v[7] = b.w; }
__device__ __forceinline__ void ld8fs(const unsigned char* M, int r, int c, float (&v)[8]) { const f32x4 a = *(const f32x4*)(M + SWF(r, c)), b = *(const f32x4*)(M + SWF(r, c + 4)); v[0] = a.x; v[1] = a.y; v[2] = a.z; v[3] = a.w; v[4] = b.x; v[5] = b.y; v[6] = b.z; v[7] = b.w; }
__device__ __forceinline__ void un8(const v4u w, float (&v)[8]) { v[0] = bflo(w.x); v[1] = bfhi(w.x); v[2] = bflo(w.y); v[3] = bfhi(w.y); v[4] = bflo(w.z); v[5] = bfhi(w.z); v[6] = bflo(w.w); v[7] = bfhi(w.w); }
__device__ __forceinline__ void shift8(const v4u cw, const v4u pw, bool hasp, const float* mu, float (&v)[8]) {
    float c[8], p[8], m[8]; un8(cw, c); un8(pw, p); ld8f(mu, m);
#pragma unroll
    for (int e = 0; e < 8; ++e) { const float pe = hasp ? p[e] : 0.f; v[e] = c[e] + (pe - c[e]) * m[e]; }
}
__device__ __forceinline__ float tanh_fast(float x) { return 1.0f - 2.0f * __builtin_amdgcn_rcpf(1.0f + __expf(2.0f * x)); }

#define LBAR() do { asm volatile("s_waitcnt lgkmcnt(0)" ::: "memory"); __builtin_amdgcn_s_barrier(); asm volatile("" ::: "memory"); } while (0)
__device__ __forceinline__ void scan_unit(const PArgs& a, unsigned char* lds, int bh, int wv) {
    const int tid = mktid(wv), lane = tid & 63, wid = __builtin_amdgcn_readfirstlane(tid >> 6);
    const int mt = wid >> 1, nh = wid & 1; int fr = lane & 15, fq = lane >> 4;
    const int b = bh >> 3, h = bh & 7;
#define BUF(i) (lds + (i) * MB)
    float* GC = (float*)(lds + OFF_F32); float* BON = GC + 64; float* LEND = BON + 64; float* SEGT = LEND + 64;
    unsigned char* LWR = BUF(I_AT); unsigned char* LAR = BUF(I_AJ); unsigned char* LGR = BUF(I_KHJ); unsigned char* LW = BUF(I_R0); unsigned char* LC = BUF(I_L); unsigned char* YTF = BUF(I_L);
    unsigned char* ACTW = BUF(I_L); unsigned char* ACTA = BUF(I_LT); unsigned char* ACTG = BUF(I_R0);
    const bf16* z = (const bf16*)(a.ws + WS_Z); bf16* ya = (bf16*)(a.ws + WS_YA);
    const float* mu = a.in[7];
    bf16x8 fw[2], fa[2], fg[4];
    { const bf16* wlt = (const bf16*)(a.ws + WS_WLT) + (size_t)h * 4096 + (16 * mt + fr) * 64 + 8 * fq; const bf16* wat = (const bf16*)(a.ws + WS_WAT) + (size_t)h * 4096 + (16 * mt + fr) * 64 + 8 * fq;
      const bf16* wgt = (const bf16*)(a.ws + WS_WGT) + (size_t)h * 8192 + (16 * mt + fr) * 128 + 8 * fq;
      fw[0] = *(const bf16x8*)wlt; fw[1] = *(const bf16x8*)(wlt + 32); fa[0] = *(const bf16x8*)wat; fa[1] = *(const bf16x8*)(wat + 32);
#pragma unroll
      for (int ks = 0; ks < 4; ++ks) fg[ks] = *(const bf16x8*)(wgt + 32 * ks); }
    float* CST = (float*)(lds + OFF_CST);
    for (int i = tid; i < 14 * 64; i += 512) { const int blk = i >> 6, jj = i & 63; float v;
        if (blk < 3) v = mu[blk * 512 + h * 64 + jj]; else if (blk < 7) v = mu[1536 + (blk - 3) * 64 + jj]; else v = a.in[blk == 7 ? 8 : blk == 8 ? 10 : blk == 9 ? 13 : blk == 10 ? 14 : blk == 11 ? 15 : blk == 12 ? 16 : 17][h * 64 + jj];
        CST[i] = v; }
    int s0i = I_X14, aki = I_X5;
    for (int i = tid; i < MB / 4; i += 512) ((unsigned*)BUF(I_X14))[i] = 0u;
    LBAR();
    int pt = tid >> 3, j0 = 8 * (tid & 7);
    const int colh = h * 64 + j0;
    const int zoff0 = colh, zoff1 = 512 + colh, zoff2 = 1024 + colh, zoff3 = 1536 + j0, zoff4 = 1600 + j0, zoff5 = 1664 + j0, zoff6 = 1728 + j0;
    v4u zc[7], zq[7];
#define ZLOAD(cc) do { const bf16* zr_ = z + ((size_t)b * SEQ + (cc) * 64 + pt) * INC; const bf16* zs_ = ((cc) * 64 + pt) > 0 ? zr_ - INC : zr_; \
        zc[0] = *(const v4u*)(zr_ + zoff0); zc[1] = *(const v4u*)(zr_ + zoff1); zc[2] = *(const v4u*)(zr_ + zoff2); zc[3] = *(const v4u*)(zr_ + zoff3); zc[4] = *(const v4u*)(zr_ + zoff4); zc[5] = *(const v4u*)(zr_ + zoff5); zc[6] = *(const v4u*)(zr_ + zoff6); \
        zq[0] = *(const v4u*)(zs_ + zoff0); zq[1] = *(const v4u*)(zs_ + zoff1); zq[2] = *(const v4u*)(zs_ + zoff2); zq[3] = *(const v4u*)(zs_ + zoff3); zq[4] = *(const v4u*)(zs_ + zoff4); zq[5] = *(const v4u*)(zs_ + zoff5); zq[6] = *(const v4u*)(zs_ + zoff6); } while (0)
    ZLOAD(0);
    v4u ypend = {0u, 0u, 0u, 0u}; size_t ypoff = 0;
    for (int c = 0; c < SEQ / 64; ++c) {
        asm volatile("" : "+v"(fr), "+v"(fq), "+v"(pt), "+v"(j0));
        const int s = c * 64 + pt; const size_t t = (size_t)b * SEQ + s; const bool hasp = s > 0;
        { float v[8];
          shift8(zc[0], zq[0], hasp, CST + 0 * 64 + j0, v); st8bf(BUF(I_RT) + SW(pt, j0), v);
          shift8(zc[1], zq[1], hasp, CST + 1 * 64 + j0, v); st8bf(BUF(I_KT) + SW(pt, j0), v);
          shift8(zc[2], zq[2], hasp, CST + 2 * 64 + j0, v); st8bf(BUF(I_VT) + SW(pt, j0), v);
#pragma unroll
          for (int e = 0; e < 8; ++e) *(unsigned short*)(BUF(I_VJ) + SW(j0 + e, pt)) = (unsigned short)f2bf(v[e]);
          shift8(zc[3], zq[3], hasp, CST + 3 * 64 + j0, v);
#pragma unroll
          for (int e = 0; e < 8; ++e) v[e] = tanh_fast(v[e]);
          st8bf(ACTW + SW(pt, j0), v);
          shift8(zc[4], zq[4], hasp, CST + 4 * 64 + j0, v); st8bf(ACTA + SW(pt, j0), v);
          shift8(zc[5], zq[5], hasp, CST + 5 * 64 + j0, v);
#pragma unroll
          for (int e = 0; e < 8; ++e) v[e] = sigm(v[e]);
          st8bf(ACTG + SWG(pt, j0), v);
          shift8(zc[6], zq[6], hasp, CST + 6 * 64 + j0, v);
#pragma unroll
          for (int e = 0; e < 8; ++e) v[e] = sigm(v[e]);
          st8bf(ACTG + SWG(pt, 64 + j0), v); }
        LBAR();
        f32x4 aw[2], aa[2], ag[2];
#pragma unroll
        for (int nt = 0; nt < 2; ++nt) { const int tr = 16 * (2 * nh + nt) + fr; const f32x4 zero = {0.f, 0.f, 0.f, 0.f};
            aw[nt] = __builtin_amdgcn_mfma_f32_16x16x32_bf16(fw[0], ldfrag(ACTW, tr, 8 * fq), zero, 0, 0, 0); aw[nt] = __builtin_amdgcn_mfma_f32_16x16x32_bf16(fw[1], ldfrag(ACTW, tr, 8 * fq + 32), aw[nt], 0, 0, 0);
            aa[nt] = __builtin_amdgcn_mfma_f32_16x16x32_bf16(fa[0], ldfrag(ACTA, tr, 8 * fq), zero, 0, 0, 0); aa[nt] = __builtin_amdgcn_mfma_f32_16x16x32_bf16(fa[1], ldfrag(ACTA, tr, 8 * fq + 32), aa[nt], 0, 0, 0);
            ag[nt] = zero;
#pragma unroll
            for (int ks = 0; ks < 4; ++ks) ag[nt] = __builtin_amdgcn_mfma_f32_16x16x32_bf16(fg[ks], *(const bf16x8*)(ACTG + SWG(tr, 8 * fq + 32 * ks)), ag[nt], 0, 0, 0); }
#pragma unroll
        for (int nt = 0; nt < 2; ++nt) { const int tr = 16 * (2 * nh + nt) + fr, jc = 16 * mt + 4 * fq;
            *(f32x4*)(LWR + SWF(tr, jc)) = aw[nt]; *(f32x4*)(LAR + SWF(tr, jc)) = aa[nt]; *(f32x4*)(LGR + SWF(tr, jc)) = ag[nt]; }
        LBAR();
        float lwv[8], an[8], bb[8], k2[8], rr[8], gg[8];
        { float lw8[8], la8[8], kx[8], w0v[8], a0v[8], kkc[8], kac[8], rkc[8];
          ld8fs(LWR, pt, j0, lw8); ld8fs(LAR, pt, j0, la8); ld8fs(LGR, pt, j0, gg);
          ld8bf(BUF(I_RT) + SW(pt, j0), rr); ld8bf(BUF(I_KT) + SW(pt, j0), kx);
          ld8f(CST + 7 * 64 + j0, w0v); ld8f(CST + 8 * 64 + j0, a0v); ld8f(CST + 9 * 64 + j0, kkc); ld8f(CST + 10 * 64 + j0, kac); ld8f(CST + 11 * 64 + j0, rkc);
          float ss = 0.f, bon = 0.f, av[8];
#pragma unroll
          for (int e = 0; e < 8; ++e) { lwv[e] = -0.606531f * sigm(w0v[e] + lw8[e]); av[e] = sigm(a0v[e] + la8[e]); an[e] = kx[e] * kkc[e]; ss += an[e] * an[e];
              k2[e] = kx[e] * (1.0f + (av[e] - 1.0f) * kac[e]); bon += rr[e] * k2[e] * rkc[e]; }
          ss = red8(ss); bon = red8(bon);
          const float inv = rsqrtf(fmaxf(ss, 1e-24f));
#pragma unroll
          for (int e = 0; e < 8; ++e) { const float kn = an[e] * inv; an[e] = -kn; bb[e] = kn * av[e]; }
          *(f32x4*)(LW + SWF(pt, j0)) = (f32x4){lwv[0], lwv[1], lwv[2], lwv[3]}; *(f32x4*)(LW + SWF(pt, j0 + 4)) = (f32x4){lwv[4], lwv[5], lwv[6], lwv[7]};
          if (j0 == 0) BON[pt] = bon; }
        LBAR();
        { const int j = tid & 63, sg = wid; float r0 = 0.f, r1 = 0.f, r2 = 0.f, r3 = 0.f;
          for (int u = 0; u < 8 * sg; u += 4) { r0 += *(const float*)(LW + SWF(u, j)); r1 += *(const float*)(LW + SWF(u + 1, j)); r2 += *(const float*)(LW + SWF(u + 2, j)); r3 += *(const float*)(LW + SWF(u + 3, j)); }
          float v8[8];
#pragma unroll
          for (int u = 0; u < 8; ++u) v8[u] = *(const float*)(LW + SWF(8 * sg + u, j));
          float run = (r0 + r1) + (r2 + r3);
#pragma unroll
          for (int u = 0; u < 8; ++u) { run += v8[u]; *(float*)(LC + SWF(8 * sg + u, j)) = run; }
          if (sg == 7) { LEND[j] = run; GC[j] = __expf(run); } }
        LBAR();
        { float Lc[8], sgp[8], le[8], o0[8], o1[8], o2[8], o3[8];
          ld8fs(LC, pt, j0, Lc); ld8f(LEND + j0, le);
#pragma unroll
          for (int e = 0; e < 8; ++e) { const float L = Lc[e]; const float e1 = __expf(L), ie1 = __expf(-L), ep = __expf(L - lwv[e]), eh = __expf(le[e] - L);
              o0[e] = an[e] * ep; o1[e] = bb[e] * ie1; o2[e] = k2[e] * ie1; o3[e] = rr[e] * e1; Lc[e] = bb[e] * eh; sgp[e] = k2[e] * eh; }
          st8bf(BUF(I_AT) + SW(pt, j0), o0); st8bf(BUF(I_BT) + SW(pt, j0), o1); st8bf(BUF(I_KT) + SW(pt, j0), o2); st8bf(BUF(I_RT) + SW(pt, j0), o3);
          st8bf(BUF(I_GATE) + SW(pt, j0), gg);
#pragma unroll
          for (int e = 0; e < 8; ++e) { *(unsigned short*)(BUF(I_AJ) + SW(j0 + e, pt)) = (unsigned short)f2bf(o0[e]); *(unsigned short*)(BUF(I_BHJ) + SW(j0 + e, pt)) = (unsigned short)f2bf(Lc[e]);
              *(unsigned short*)(BUF(I_KHJ) + SW(j0 + e, pt)) = (unsigned short)f2bf(sgp[e]); } }
        if (c > 0) *(v4u*)(ya + ypoff) = ypend;
        if (c + 1 < SEQ / 64) ZLOAD(c + 1);
        LBAR();
#define MASK(acc, cond) _Pragma("unroll") for (int nt = 0; nt < 2; ++nt) _Pragma("unroll") for (int r = 0; r < 4; ++r) { const int m_ = 16 * mt + 4 * fq + r, n_ = 16 * (2 * nh + nt) + fr; if (!(cond)) acc[nt][r] = 0.f; }
        { const f32x4 zero = {0.f, 0.f, 0.f, 0.f}; f32x4 aL[2] = {zero, zero}, aK[2] = {zero, zero}, aR[2] = {zero, zero};
          const FA fAT = ldA(BUF(I_AT), mt, fr, fq), fBTa = ldA(BUF(I_BT), mt, fr, fq); const FB fBT = ldB(BUF(I_BT), nh, fr, fq), fKT = ldB(BUF(I_KT), nh, fr, fq), fRT = ldB(BUF(I_RT), nh, fr, fq);
          mma(aL, fAT, fBT);
          mma(aK, fAT, fKT);
          mma(aR, fBTa, fRT);
          MASK(aL, m_ > n_) MASK(aK, n_ < m_) MASK(aR, m_ <= n_)
          storeN(BUF(I_L), aL, mt, nh, fr, fq); storeT(BUF(I_LT), aL, mt, nh, fr, fq);
#pragma unroll
          for (int nt = 0; nt < 2; ++nt)
#pragma unroll
              for (int r = 0; r < 4; ++r) { const int m_ = 16 * mt + 4 * fq + r, n_ = 16 * (2 * nh + nt) + fr; if (m_ == n_) aL[nt][r] = 1.0f; }
          storeN(BUF(I_R0), aL, mt, nh, fr, fq);
          storeT(BUF(aki), aK, mt, nh, fr, fq);
          storeT(BUF(I_ABRT), aR, mt, nh, fr, fq); }
        LBAR();
#pragma unroll
        for (int k = 1; k <= 6; ++k) {
            unsigned char* Pc = (k & 1) ? BUF(I_L) : BUF(I_AT); unsigned char* PTc = (k & 1) ? BUF(I_LT) : BUF(I_BT);
            unsigned char* Pn = (k & 1) ? BUF(I_AT) : BUF(I_L); unsigned char* PTn = (k & 1) ? BUF(I_BT) : BUF(I_LT);
            unsigned char* Rc = (k & 1) ? BUF(I_R1) : BUF(I_R0); unsigned char* Rn = (k & 1) ? BUF(I_R0) : BUF(I_R1);
            const f32x4 zero = {0.f, 0.f, 0.f, 0.f}; f32x4 aP[2] = {zero, zero}, aRr[2] = {zero, zero};
            FA fP, fPTa; FB fPT, fR;
            if (k <= 5) { fP = ldA(Pc, mt, fr, fq); fPT = ldB(PTc, nh, fr, fq); }
            if (k >= 2) { fPTa = ldA(PTc, mt, fr, fq); fR = ldB(Rc, nh, fr, fq); ldC(aRr, Rc, mt, nh, fr, fq); }
            if (k <= 5) mma(aP, fP, fPT);
            if (k >= 2) mma(aRr, fPTa, fR);
            if (k <= 5) { storeN(Pn, aP, mt, nh, fr, fq); storeT(PTn, aP, mt, nh, fr, fq); }
            if (k >= 2) storeT(Rn, aRr, mt, nh, fr, fq);
            LBAR();
        }
        { const f32x4 zero = {0.f, 0.f, 0.f, 0.f}; f32x4 a1[2] = {zero, zero}, a2[2] = {zero, zero};
          const FA fTT = ldA(BUF(I_R1), mt, fr, fq); const FB fAJ = ldB(BUF(I_AJ), nh, fr, fq), fAK = ldB(BUF(aki), nh, fr, fq);
          mma(a1, fTT, fAJ); mma(a2, fTT, fAK);
          storeT(BUF(I_L), a1, mt, nh, fr, fq);
          storeT(BUF(I_LT), a2, mt, nh, fr, fq); }
        LBAR();
        { const f32x4 zero = {0.f, 0.f, 0.f, 0.f}; f32x4 aMY[2], aNY[2] = {zero, zero}, aMS[2] = {zero, zero}, aNS[2];
          const FA fG1 = ldA(BUF(I_L), mt, fr, fq), fG2 = ldA(BUF(I_LT), mt, fr, fq), fKTa = ldA(BUF(I_KT), mt, fr, fq);
          const FB fAB = ldB(BUF(I_ABRT), nh, fr, fq), fRT = ldB(BUF(I_RT), nh, fr, fq), fBH = ldB(BUF(I_BHJ), nh, fr, fq);
          ldC(aMY, BUF(I_RT), mt, nh, fr, fq); ldC(aNS, BUF(I_KHJ), mt, nh, fr, fq);
          mma(aNY, fKTa, fRT);
          mma(aMY, fG1, fAB);
          mma(aMS, fG1, fBH);
          mma(aNS, fG2, fBH);
          MASK(aNY, m_ <= n_)
          mma(aNY, fG2, fAB);
#pragma unroll
          for (int nt = 0; nt < 2; ++nt)
#pragma unroll
              for (int r = 0; r < 4; ++r) { const int m_ = 16 * mt + 4 * fq + r, n_ = 16 * (2 * nh + nt) + fr; if (m_ == n_) aMS[nt][r] += GC[m_]; }
          storeT(BUF(I_AT), aMY, mt, nh, fr, fq); storeT(BUF(I_BT), aNY, mt, nh, fr, fq); storeT(BUF(I_AJ), aMS, mt, nh, fr, fq); storeT(BUF(I_R0), aNS, mt, nh, fr, fq); }
        LBAR();
        { const f32x4 zero = {0.f, 0.f, 0.f, 0.f}; f32x4 aY[2] = {zero, zero}, aS[2] = {zero, zero};
          const FA fS0a = ldA(BUF(s0i), mt, fr, fq), fVJa = ldA(BUF(I_VJ), mt, fr, fq), fMS = ldA(BUF(I_AJ), mt, fr, fq), fNS = ldA(BUF(I_R0), mt, fr, fq);
          const FB fMY = ldB(BUF(I_AT), nh, fr, fq), fNY = ldB(BUF(I_BT), nh, fr, fq), fS0 = ldB(BUF(s0i), nh, fr, fq), fVJ = ldB(BUF(I_VJ), nh, fr, fq);
          mma(aY, fS0a, fMY); mma(aS, fMS, fS0); mma(aY, fVJa, fNY); mma(aS, fNS, fVJ);
#pragma unroll
          for (int nt = 0; nt < 2; ++nt) *(f32x4*)(YTF + SWF(16 * (2 * nh + nt) + fr, 16 * mt + 4 * fq)) = aY[nt];
          storeT(BUF(aki), aS, mt, nh, fr, fq); }
        LBAR();
#undef MASK
        { float y[8], vv[8], g8[8], lg[8], lb[8]; ld8fs(YTF, pt, j0, y); ld8bf(BUF(I_VT) + SW(pt, j0), vv); ld8bf(BUF(I_GATE) + SW(pt, j0), g8);
          ld8f(CST + 12 * 64 + j0, lg); ld8f(CST + 13 * 64 + j0, lb);
          float sm = 0.f;
#pragma unroll
          for (int e = 0; e < 8; ++e) sm += y[e];
          const float mean = red8(sm) * (1.0f / 64.0f); float sq = 0.f;
#pragma unroll
          for (int e = 0; e < 8; ++e) { y[e] -= mean; sq += y[e] * y[e]; }
          const float rstd = rsqrtf(red8(sq) * (1.0f / 64.0f) + 64e-5f), bon = BON[pt];
#pragma unroll
          for (int e = 0; e < 8; ++e) y[e] = (y[e] * rstd * lg[e] + lb[e] + bon * vv[e]) * g8[e];
          ypend.x = pk2(y[0], y[1]); ypend.y = pk2(y[2], y[3]); ypend.z = pk2(y[4], y[5]); ypend.w = pk2(y[6], y[7]); ypoff = t * RWW + colh; }
        { const int tmp = s0i; s0i = aki; aki = tmp; }
        LBAR();
    }
    *(v4u*)(ya + ypoff) = ypend;
    LBAR();
#undef BUF
#undef ZLOAD
}
#undef LBAR
}

__device__ __forceinline__ void p_norm2_route(const PArgs& a, unsigned char* lds, int wv) {
    typedef short bf16x8 __attribute__((ext_vector_type(8)));
    const int tid = mktid(wv), lane = tid & 63, fr = lane & 15, fq = lane >> 4;
    const bf16* x1 = (const bf16*)(a.ws + WS_X1B); const float* mod = (const float*)(a.ws + WS_MOD); const float* gm2 = (const float*)(a.ws + WS_GM2); const float* cbt = (const float*)(a.ws + WS_CB);
    int* rte = (int*)(a.ws + WS_RTE); float* rtw = (float*)(a.ws + WS_RTW); int* rnk = (int*)(a.ws + WS_RNK); unsigned* cnt = (unsigned*)(a.ws + WS_CTL) + CW_CNT;
    float* PL = (float*)lds;
    float* PS = PL + 8 * 32 * 48;
    float* RS_ = PS + 8 * 32;
    float* FL = RS_ + 32;
    unsigned* HIST = (unsigned*)(FL + 32 * 48);
    unsigned* LRK = HIST + 32;
    if (tid < 32) HIST[tid] = 0u;
    __syncthreads();
    int gcount = 0;
    bf16x8 wh[4][3], wl[4][3];
    { const bf16* wrh = (const bf16*)(a.ws + WS_WRH) + fr * 1024 + 128 * wv + 8 * fq; const bf16* wrl = (const bf16*)(a.ws + WS_WRL) + fr * 1024 + 128 * wv + 8 * fq;
#pragma unroll
      for (int ks = 0; ks < 4; ++ks)
#pragma unroll
          for (int nt = 0; nt < 3; ++nt) { wh[ks][nt] = *(const bf16x8*)(wrh + nt * 16 * 1024 + 32 * ks); wl[ks][nt] = *(const bf16x8*)(wrl + nt * 16 * 1024 + 32 * ks); } }
    for (int grp = blockIdx.x; grp < NT / 32; grp += gridDim.x) {
        const int row0 = grp * 32, b = row0 >> 11;
        f32x4 acc[3][2];
#pragma unroll
        for (int nt = 0; nt < 3; ++nt) { acc[nt][0] = (f32x4){0.f, 0.f, 0.f, 0.f}; acc[nt][1] = acc[nt][0]; }
        float ssq[2] = {0.f, 0.f};
#pragma unroll
        for (int rt = 0; rt < 2; ++rt) {
            float xs[4][8];
#pragma unroll
            for (int ks = 0; ks < 4; ++ks) rw::ld8bf((const unsigned char*)(x1 + (size_t)(row0 + 16 * rt + fr) * DM + 128 * wv + 32 * ks + 8 * fq), xs[ks]);
#pragma unroll
            for (int ks = 0; ks < 4; ++ks) { float gm[8]; rw::ld8f(gm2 + b * 1024 + 128 * wv + 32 * ks + 8 * fq, gm); unsigned hw[4], lw[4];
#pragma unroll
                for (int e = 0; e < 4; ++e) { const float x0 = xs[ks][2 * e], x1v = xs[ks][2 * e + 1]; ssq[rt] += x0 * x0 + x1v * x1v; const float g0 = x0 * gm[2 * e], g1 = x1v * gm[2 * e + 1];
                    hw[e] = pk2(g0, g1); lw[e] = pk2(g0 - bflo(hw[e]), g1 - bfhi(hw[e])); }
                const v4u hv = {hw[0], hw[1], hw[2], hw[3]}, lv = {lw[0], lw[1], lw[2], lw[3]}; const bf16x8 bh = __builtin_bit_cast(bf16x8, hv), bl = __builtin_bit_cast(bf16x8, lv);
#pragma unroll
                for (int nt = 0; nt < 3; ++nt) { acc[nt][rt] = __builtin_amdgcn_mfma_f32_16x16x32_bf16(wh[ks][nt], bh, acc[nt][rt], 0, 0, 0); acc[nt][rt] = __builtin_amdgcn_mfma_f32_16x16x32_bf16(wl[ks][nt], bh, acc[nt][rt], 0, 0, 0);
                    acc[nt][rt] = __builtin_amdgcn_mfma_f32_16x16x32_bf16(wh[ks][nt], bl, acc[nt][rt], 0, 0, 0); } } }
#pragma unroll
        for (int rt = 0; rt < 2; ++rt) {
#pragma unroll
            for (int nt = 0; nt < 3; ++nt) *(f32x4*)(PL + (wv * 32 + 16 * rt + fr) * 48 + 16 * nt + 4 * fq) = acc[nt][rt];
            float s = ssq[rt]; s += __builtin_bit_cast(float, __builtin_amdgcn_ds_swizzle(__builtin_bit_cast(int, s), 0x401F));
            { const unsigned u = __builtin_bit_cast(unsigned, s); auto rr = __builtin_amdgcn_permlane32_swap(u, u, false, false); s = __builtin_bit_cast(float, (unsigned)rr[0]) + __builtin_bit_cast(float, (unsigned)rr[1]); }
            if (fq == 0) PS[wv * 32 + 16 * rt + fr] = s; }
        __syncthreads();
        { const int r = tid >> 4, c = tid & 15; float s0 = 0.f, s1 = 0.f, s2 = 0.f, sq = 0.f;
#pragma unroll
          for (int w = 0; w < 8; ++w) { const float* p = PL + (w * 32 + r) * 48; s0 += p[c]; s1 += p[c + 16]; s2 += p[c + 32]; sq += PS[w * 32 + r]; }
          const float rstd = rsqrtf(sq * (1.0f / DM) + 1e-6f); const float* cb = cbt + b * 48;
          FL[r * 48 + c] = rstd * s0 + cb[c]; FL[r * 48 + c + 16] = rstd * s1 + cb[c + 16]; FL[r * 48 + c + 32] = rstd * s2 + cb[c + 32];
          if (c == 0) ((float*)(a.ws + WS_RSTD))[row0 + r] = rstd; }
        __syncthreads();
        if (tid < 32) { const int m = row0 + tid; const float* lg = FL + tid * 48;
            int gi = 0; float gm = lg[0];
#pragma unroll
            for (int i = 1; i < 4; ++i) if (lg[i] > gm) { gm = lg[i]; gi = i; }
            float gs = 0.f;
#pragma unroll
            for (int i = 0; i < 4; ++i) gs += __expf(lg[i] - gm);
            const float pg = 1.0f / gs;
            float el[8];
#pragma unroll
            for (int k = 0; k < 8; ++k) el[k] = lg[4 + gi * 8 + k];
            int e1 = 0; float m1 = el[0];
#pragma unroll
            for (int k = 1; k < 8; ++k) if (el[k] > m1) { m1 = el[k]; e1 = k; }
            int e2 = -1; float m2 = -INFINITY;
#pragma unroll
            for (int k = 0; k < 8; ++k) if (k != e1 && el[k] > m2) { m2 = el[k]; e2 = k; }
            const float q2 = __expf(m2 - m1); const float w1 = pg / (1.0f + q2), w2 = pg * q2 / (1.0f + q2);
            const int ea = gi * 8 + e1, eb = gi * 8 + e2; rte[2 * m] = ea; rte[2 * m + 1] = eb; rtw[2 * m] = w1; rtw[2 * m + 1] = w2;
            LRK[gcount * 64 + 2 * tid] = atomicAdd(HIST + ea, 1u) | ((unsigned)ea << 24); LRK[gcount * 64 + 2 * tid + 1] = atomicAdd(HIST + eb, 1u) | ((unsigned)eb << 24); }
        ++gcount;
        __syncthreads();
    }
    if (tid < 32) { const unsigned n = HIST[tid]; HIST[tid] = n ? atomicAdd(cnt + tid * CNT_PAD, n) : 0u; }
    __syncthreads();
    for (int i = tid; i < gcount * 64; i += 512) { const int gi_ = i >> 6, e = i & 63; const int m2 = 2 * ((blockIdx.x + gi_ * gridDim.x) * 32) + e; const unsigned lr = LRK[i]; rnk[m2] = (int)(HIST[lr >> 24] + (lr & 0xffffffu)); }
    __syncthreads();
}
__device__ __forceinline__ void p_moe_gather(const PArgs& a, unsigned char* lds, int wv) {
    int* off = (int*)lds;
    const int tid = mktid(wv), lane = tid & 63, gw = blockIdx.x * 8 + (tid >> 6), NGW = gridDim.x * 8;
    int* ctl = (int*)(a.ws + WS_CTL); const unsigned* cnt = (const unsigned*)ctl + CW_CNT;
    if (tid == 0) { int o = 0, nt = 0;
        for (int e = 0; e < NEXP; ++e) { off[e] = o; const int tiles = ((int)cnt[e * CNT_PAD] + 255) >> 8;
            if (blockIdx.x == 0) for (int i = 0; i < tiles; ++i) ctl[CW_TEXP + nt + i] = e;
            nt += tiles; o += tiles * 256; }
        if (blockIdx.x == 0) ctl[CW_NT] = nt; }
    __syncthreads();
    const int* rte = (const int*)(a.ws + WS_RTE); const int* rnk = (const int*)(a.ws + WS_RNK); int* pos = (int*)(a.ws + WS_POS);
    const bf16* x1 = (const bf16*)(a.ws + WS_X1B); bf16* xs = (bf16*)(a.ws + WS_XS); const float* rstdv = (const float*)(a.ws + WS_RSTD);
    const float* mod = (const float*)(a.ws + WS_MOD); const float* gm2 = (const float*)(a.ws + WS_GM2);
    for (int t = gw; t < NT; t += NGW) { const int b = t >> 11; const int p0 = off[rte[2 * t]] + rnk[2 * t], p1 = off[rte[2 * t + 1]] + rnk[2 * t + 1]; if (lane == 0) { pos[2 * t] = p0; pos[2 * t + 1] = p1; }
        const float rstd = rstdv[t];
#pragma unroll
        for (int hf = 0; hf < 2; ++hf) { const int col = 8 * lane + 512 * hf; float xv[8], gm[8], sh[8], o[8];
            rw::ld8bf((const unsigned char*)(x1 + (size_t)t * DM + col), xv); rw::ld8f(gm2 + b * 1024 + col, gm); rw::ld8f(mod + b * 6144 + 3072 + col, sh);
#pragma unroll
            for (int e = 0; e < 8; ++e) o[e] = xv[e] * gm[e] * rstd + sh[e];
            v4u w; w.x = pk2(o[0], o[1]); w.y = pk2(o[2], o[3]); w.z = pk2(o[4], o[5]); w.w = pk2(o[6], o[7]);
            *(v4u*)(xs + (size_t)p0 * DM + col) = w; *(v4u*)(xs + (size_t)p1 * DM + col) = w; } }
}
__device__ __forceinline__ void p_combine(const PArgs& a, unsigned char* lds, int wv) {
    const int tid = mktid(wv), lane = tid & 63, gw = blockIdx.x * 8 + (tid >> 6), NGW = gridDim.x * 8;
    const float* mod = (const float*)(a.ws + WS_MOD); const int* pos = (const int*)(a.ws + WS_POS); const float* rtw = (const float*)(a.ws + WS_RTW);
    const bf16* ys = (const bf16*)(a.ws + WS_XS); float* out = a.out;
    for (int m = gw; m < NT; m += NGW) { const int b = m >> 11; const int p0 = pos[2 * m], p1 = pos[2 * m + 1]; const float w0 = rtw[2 * m], w1 = rtw[2 * m + 1];
        f32x4* o = (f32x4*)(out + (size_t)m * DM) + lane; const v2u* xb = (const v2u*)((const bf16*)(a.ws + WS_X1B) + (size_t)m * DM) + lane; const v2u* y0 = (const v2u*)(ys + (size_t)p0 * DM) + lane; const v2u* y1 = (const v2u*)(ys + (size_t)p1 * DM) + lane;
#pragma unroll
        for (int j = 0; j < 4; ++j) { const int col = 4 * (lane + 64 * j); const f32x4 g2 = *(const f32x4*)(mod + b * 6144 + 5120 + col); const v2u a0 = y0[64 * j], a1 = y1[64 * j];
            const f32x4 e0 = {bflo(a0.x), bfhi(a0.x), bflo(a0.y), bfhi(a0.y)}, e1 = {bflo(a1.x), bfhi(a1.x), bflo(a1.y), bfhi(a1.y)};
            const v2u xw = xb[64 * j]; const f32x4 xv = {bflo(xw.x), bfhi(xw.x), bflo(xw.y), bfhi(xw.y)};
            o[64 * j] = xv + g2 * (e0 * w0 + e1 * w1); } }
}

#define XB_TMO      128
#define XB_XCNT(j)  (256  + 64 * (j))
#define XB_XSUB(j)  (1280 + 64 * (j))
#define XB_XGEN(j)  (2304 + 64 * (j))
#define XB_TOP      3328
#define XB_TOPGEN   3392
#define XCD_BAR_WORDS 3456
#define XB_SPIN_CAP (1u << 22)

__device__ __forceinline__ unsigned xb_ld(unsigned* p)              { return __hip_atomic_load(p, __ATOMIC_RELAXED, __HIP_MEMORY_SCOPE_AGENT); }
__device__ __forceinline__ unsigned xb_add(unsigned* p, unsigned v) { return __hip_atomic_fetch_add(p, v, __ATOMIC_RELAXED, __HIP_MEMORY_SCOPE_AGENT); }
__device__ __forceinline__ unsigned xb_xcc_id() { return (unsigned)__builtin_amdgcn_s_getreg((3 << 11) | 20) & 0xFu; }
#define XB_SPIN(cond, bar) do { unsigned _sp = 0; while (cond) { __builtin_amdgcn_s_sleep(1); \
    if ((++_sp & 255u) == 0u) { if (xb_ld(&(bar)[XB_TMO])) break; if (_sp > XB_SPIN_CAP) { atomicAdd(&(bar)[XB_TMO], 1u); break; } } } } while (0)

struct XcdBarrier {
    unsigned* bar; unsigned x;
    volatile LAS unsigned* st;
};

__device__ __forceinline__ XcdBarrier xcd_barrier_post(unsigned* bar, volatile LAS unsigned* st, int wv) {
    XcdBarrier b; b.bar = bar; b.x = xb_xcc_id(); b.st = st;
    if (mktid(wv) == 0) (void)xb_add(&bar[XB_XCNT(b.x)], 1u);
    return b;
}
__device__ __forceinline__ void xcd_barrier_complete(unsigned* bar, unsigned x, unsigned& nloc, unsigned& nx) {
    const unsigned G = gridDim.x * gridDim.y * gridDim.z;
    unsigned sum, cnt, mine, sp = 0u;
    for (;;) {
        sum = 0u; cnt = 0u; mine = 0u;
#pragma unroll
        for (unsigned j = 0; j < 16; ++j) { const unsigned c = xb_ld(&bar[XB_XCNT(j)]); sum += c; cnt += (c > 0u) ? 1u : 0u; mine = (j == x) ? c : mine; }
        if (sum == G) break;
        __builtin_amdgcn_s_sleep(1);
        if ((++sp & 255u) == 0u) { if (xb_ld(&bar[XB_TMO])) break; if (sp > XB_SPIN_CAP) { atomicAdd(&bar[XB_TMO], 1u); break; } }
    }
    nloc = mine > 0u ? mine : 1u; nx = cnt > 0u ? cnt : 1u;
}

__device__ __forceinline__ void xcd_barrier(const XcdBarrier& b, int wv) {
    asm volatile("s_waitcnt vmcnt(0)" ::: "memory");
    __syncthreads();
    if (mktid(wv) == 0) {
        unsigned* bar = b.bar;
        __builtin_amdgcn_s_waitcnt(0);
        unsigned nloc = b.st[0], nx = b.st[1];
        if (nloc == 0u) { xcd_barrier_complete(bar, b.x, nloc, nx); b.st[0] = nloc; b.st[1] = nx; }
        const unsigned old = xb_add(&bar[XB_XSUB(b.x)], 1u);
        const unsigned gen = old / nloc;
        if (old + 1u == (gen + 1u) * nloc) {
            __builtin_amdgcn_fence(__ATOMIC_RELEASE, "agent");
            asm volatile("s_waitcnt vmcnt(0)" ::: "memory");
            const unsigned og = xb_add(&bar[XB_TOP], 1u);
            const unsigned tg = og / nx;
            if (og + 1u == (tg + 1u) * nx) xb_add(&bar[XB_TOPGEN], 1u);
            else XB_SPIN(xb_ld(&bar[XB_TOPGEN]) == tg, bar);
            __builtin_amdgcn_fence(__ATOMIC_ACQUIRE, "agent");
            xb_add(&bar[XB_XGEN(b.x)], 1u);
            asm volatile("s_waitcnt vmcnt(0)" ::: "memory");
        } else {
            XB_SPIN(xb_ld(&bar[XB_XGEN(b.x)]) == gen, bar);
            __builtin_amdgcn_fence(__ATOMIC_ACQUIRE, "agent");
            asm volatile("s_waitcnt vmcnt(0)" ::: "memory");
        }
    }
    __syncthreads();
}

constexpr int LDS_BYTES = 160 * 1024, MISC_OFF = LDS_BYTES - 256;
static_assert(rw::LDS_NEED <= MISC_OFF, "scan LDS");
constexpr int CW_BAR = 4096;

__global__ void __launch_bounds__(512, 2) mega_fwd(PArgs a) {
    extern __shared__ __attribute__((aligned(16))) unsigned char lds[];
    volatile LAS unsigned* MISC = (volatile LAS unsigned*)((LAS unsigned char*)lds + MISC_OFF);
    const int wv = __builtin_amdgcn_readfirstlane((int)threadIdx.x >> 6);
    { const int t0 = mktid(wv); if (t0 < 64) MISC[t0] = 0u; }
    __syncthreads();
    XcdBarrier bar = xcd_barrier_post((unsigned*)(a.ws + WS_CTL) + CW_BAR, MISC + 8, wv);
    GemmArgs g; g.ws = a.ws; g.x = a.in[0]; g.out = a.out; g.qg = a.in[18]; g.kg = a.in[19];
    const int G = (int)gridDim.x, bx = (int)blockIdx.x;

    p_prep_weights(a, lds, wv); __syncthreads(); p_ada(a, lds, wv);
    xcd_barrier(bar, wv);
    p_norm1(a, lds, wv);
    xcd_barrier(bar, wv);
    p_gemm_in(g, lds, wv);
    xcd_barrier(bar, wv);
    { const int nscan = G / 2;
      if (bx < nscan) { for (int bh = bx; bh < 128; bh += nscan) rw::scan_unit(a, lds, bh, wv); }
      else p_attn(a, lds, bx - nscan, G - nscan, wv); }
    xcd_barrier(bar, wv);
    p_gemm_merge(g, lds, wv);
    xcd_barrier(bar, wv);
    p_gemm_out(g, lds, wv); __syncthreads(); p_prep_experts(a, lds, wv);
    xcd_barrier(bar, wv);
    p_norm2_route(a, lds, wv);
    xcd_barrier(bar, wv);
    p_moe_gather(a, lds, wv);
    xcd_barrier(bar, wv);
    p_gemm_up(g, lds, wv);
    xcd_barrier(bar, wv);
    p_gemm_down(g, lds, wv);
    xcd_barrier(bar, wv);
    p_combine(a, lds, wv);
}

extern "C" void kernel_launch(void* const* d_in, const int* in_sizes, int n_in, void* d_out, int out_size, void* d_ws, size_t ws_size, hipStream_t stream) {
    static int grid = 0;
    if (grid == 0) {
        if (n_in != 30 || out_size != NT * DM || ws_size < WS_END) { fprintf(stderr, "kernel_launch: unexpected shapes (n_in %d, out %d, ws %zu)\n", n_in, out_size, ws_size); grid = -1; return; }
        int dev = 0, cus = 0, per_cu = 0;
        if (hipGetDevice(&dev) != hipSuccess || hipDeviceGetAttribute(&cus, hipDeviceAttributeMultiprocessorCount, dev) != hipSuccess) { grid = -1; return; }
        if (hipFuncSetAttribute((const void*)mega_fwd, hipFuncAttributeMaxDynamicSharedMemorySize, LDS_BYTES) != hipSuccess) { fprintf(stderr, "kernel_launch: hipFuncSetAttribute failed\n"); grid = -1; return; }
        if (hipOccupancyMaxActiveBlocksPerMultiprocessor(&per_cu, (const void*)mega_fwd, 512, LDS_BYTES) != hipSuccess || per_cu < 1) { fprintf(stderr, "kernel_launch: occupancy query says %d blocks per CU\n", per_cu); (void)hipGetLastError(); grid = -1; return; }
        grid = cus;
    }
    if (grid < 0) return;
    (void)hipMemsetAsync((char*)d_ws + WS_CTL, 0, 65536, stream);
    PArgs p{}; for (int i = 0; i < 30; ++i) p.in[i] = (const float*)d_in[i]; p.out = (float*)d_out; p.ws = (unsigned char*)d_ws;
    hipLaunchKernelGGL(mega_fwd, dim3(grid), dim3(512), LDS_BYTES, stream, p);
}
```

```cpp
#include <hip/hip_runtime.h>
#include <cstdio>
#include <cstdint>
__device__ __forceinline__ int mktid(int wv) { int l; asm volatile("v_mbcnt_lo_u32_b32 %0, -1, 0\n\tv_mbcnt_hi_u32_b32 %0, -1, %0" : "=v"(l)); return (wv << 6) | l; }
template <int CTRL> __device__ __forceinline__ float dppf(float v) { return __builtin_bit_cast(float, __builtin_amdgcn_update_dpp(0, __builtin_bit_cast(int, v), CTRL, 0xF, 0xF, true)); }
__device__ __forceinline__ float red4(float v) { v += dppf<0xB1>(v); v += dppf<0x4E>(v); return v; }
__device__ __forceinline__ float red8(float v) { v = red4(v); v += dppf<0x141>(v); return v; }
__device__ __forceinline__ float red16(float v) { v = red8(v); v += dppf<0x140>(v); return v; }
__device__ __forceinline__ float wave_sum(float v) { v = red16(v);
    v += __builtin_bit_cast(float, __builtin_amdgcn_ds_swizzle(__builtin_bit_cast(int, v), 0x401F));
    const unsigned u = __builtin_bit_cast(unsigned, v); auto rr = __builtin_amdgcn_permlane32_swap(u, u, false, false);
    return __builtin_bit_cast(float, (unsigned)rr[0]) + __builtin_bit_cast(float, (unsigned)rr[1]); }
__device__ __forceinline__ float lane_get(float v, int src) { return __builtin_bit_cast(float, __builtin_amdgcn_ds_bpermute(src << 2, __builtin_bit_cast(int, v))); }
namespace pg8 {
#define PG8_LAS __attribute__((address_space(3)))
typedef unsigned short bf16_t;
typedef short bf16x8 __attribute__((ext_vector_type(8)));
typedef float f32x4 __attribute__((ext_vector_type(4)));
typedef unsigned u32x4 __attribute__((ext_vector_type(4)));
constexpr int BM = 256, BK = 64, HALF = 128, HTB = HALF * BK * 2  , STAGE_BYTES = 8 * HTB, NXCD = 8, WGM = 8;

__host__ __device__ __forceinline__ int lds_byte(int r, int c) { const int st = (r >> 4) * 2 + (c >> 5), rr = r & 15, cc = c & 31, ob = rr * 64 + cc * 2; return st * 1024 + (ob ^ (((ob >> 9) & 1) << 5)); }
__host__ __device__ __forceinline__ void stage_rc(int b, int& R, int& C) { const int st = b / 1024, sb = b % 1024, swz = sb ^ (((sb >> 9) & 1) << 5); R = (st >> 1) * 16 + swz / 64; C = (st & 1) * 32 + (swz % 64) / 2; }
__host__ __device__ __forceinline__ int perm32(int rho) { const int n = rho >> 4, i = rho & 15; return 8 * (i >> 2) + 4 * n + (i & 3); }
struct Unit { int pm, pn, aux; const char* a; const char* b; };
struct Gemm { int K; };

struct StaticOrder {
    int nM, nN, nwg, G, c; const char* A; const char* Bt; size_t tstep;
    __device__ void init(const void* A_, const void* Bt_, int M, int N, int K, int G_, int c_) { nM = M / BM; nN = N / BM; nwg = nM * nN; G = G_; c = c_; A = (const char*)A_; Bt = (const char*)Bt_; tstep = (size_t)BM * K * 2; }
    __device__ bool next(int i, Unit& u) const {
        const long L = (long)i * G + c; if (L >= nwg) return false;
        int wgid = (int)L; { const int q = nwg / NXCD, r = nwg % NXCD, xcd = wgid % NXCD, off = wgid / NXCD; wgid = (xcd < r ? xcd * (q + 1) : r * (q + 1) + (xcd - r) * q) + off; }
        const int nig = WGM * nN, gid = wgid / nig, fm = gid * WGM, gsz = (nM - fm) < WGM ? (nM - fm) : WGM;
        u.aux = 0; u.pm = fm + ((wgid % nig) % gsz); u.pn = (wgid % nig) / gsz; u.a = A + (size_t)u.pm * tstep; u.b = Bt + (size_t)u.pn * tstep; return true;
    }
    __device__ __forceinline__ void a_ready(const Unit&) const {}
    __device__ __forceinline__ void done(const Unit&) const {}
};
__device__ __forceinline__ unsigned cvt_pk_bf16(float lo, float hi) { unsigned r; asm volatile("v_cvt_pk_bf16_f32 %0, %1, %2" : "=v"(r) : "v"(lo), "v"(hi)); return r; }
template <class Epi, class Sched, bool ALIGN_EPI = false, bool SP2 = false>
__device__ __forceinline__ void gemm_phase(PG8_LAS unsigned char* lds, const Gemm g, const Sched& S, const Epi& E, int wv) {
    const int tid = mktid(wv), wid = __builtin_amdgcn_readfirstlane(tid >> 6), lane = tid & 63, wr = wid >> 2, wc = wid & 3, fr = lane & 15, fq = lane >> 4;
    const int K = g.K, nt = K / BK;
    unsigned voffA[2], voffB[2];
#pragma unroll
    for (int i = 0; i < 2; ++i) { int R, C; stage_rc(tid * 16 + i * 8192, R, C); const int Rb = Epi::PERM ? ((R & ~31) + perm32(R & 31)) : R;
        voffA[i] = (unsigned)(R * K + C) * 2u; voffB[i] = (unsigned)(Rb * K + C) * 2u; }
    const size_t kstep = (size_t)(BK * 2);
    const size_t hstep = (size_t)HALF * K * 2;
        const unsigned ldsw = (unsigned)wid * 1024u;
    const int aoff = lds_byte(wr * 64 + fr, fq * 8), boff = lds_byte(wc * 32 + fr, fq * 8);
#define PG8_SA(b, h) (((b) * 2 + (h)) * HTB)
#define PG8_SB(b, h) ((4 + (b) * 2 + (h)) * HTB)
#define PG8_STAGE(bufoff, gbase, voff) do { _Pragma("unroll") for (int _i = 0; _i < 2; ++_i) \
        __builtin_amdgcn_global_load_lds((const unsigned*)((const char*)(gbase) + (voff)[_i]), (PG8_LAS unsigned*)(lds + (bufoff) + ldsw + _i * 8192), 16, 0, 0); } while (0)
#define PG8_LDA(dst, b, h) do { _Pragma("unroll") for (int m = 0; m < 4; ++m) _Pragma("unroll") for (int k = 0; k < 2; ++k) dst[m][k] = *(const PG8_LAS bf16x8*)(lds + PG8_SA(b, h) + aoff + m * 2048 + k * 1024); } while (0)
#define PG8_LDB(dst, b, h) do { _Pragma("unroll") for (int n = 0; n < 2; ++n) _Pragma("unroll") for (int k = 0; k < 2; ++k) dst[n][k] = *(const PG8_LAS bf16x8*)(lds + PG8_SB(b, h) + boff + n * 2048 + k * 1024); } while (0)
#define PG8_MMA(ai, bj, At, Bt) do { __builtin_amdgcn_s_setprio(1); _Pragma("unroll") for (int m = 0; m < 4; ++m) _Pragma("unroll") for (int n = 0; n < 2; ++n) _Pragma("unroll") for (int k = 0; k < 2; ++k) \
        acc[ai][bj][m][n] = __builtin_amdgcn_mfma_f32_16x16x32_bf16(Bt[n][k], At[m][k], acc[ai][bj][m][n], 0, 0, 0); __builtin_amdgcn_s_setprio(0); } while (0)
#define PG8_WAIT_V(n) asm volatile("s_waitcnt vmcnt(" #n ")" ::: "memory")
#define PG8_WAIT_L(n) asm volatile("s_waitcnt lgkmcnt(" #n ")" ::: "memory")
#define PG8_BAR __builtin_amdgcn_s_barrier()
#define PG8_SCHED __builtin_amdgcn_sched_barrier(0)
    Unit cur, nxt; int ui = 0;
    if (!S.next(0, cur)) return;
    f32x4 acc[2][2][4][2];
#pragma unroll
    for (int a = 0; a < 2; ++a)
#pragma unroll
        for (int b = 0; b < 2; ++b)
#pragma unroll
            for (int m = 0; m < 4; ++m)
#pragma unroll
                for (int n = 0; n < 2; ++n) acc[a][b][m][n] = (f32x4){0.f, 0.f, 0.f, 0.f};
    bf16x8 At[4][2], B0[2][2], B1[2][2];
    const char* cA = cur.a; const char* cB = cur.b;
    S.a_ready(cur);
    if constexpr (SP2) {
        PG8_STAGE(PG8_SB(0, 0), cB, voffB); PG8_STAGE(PG8_SB(0, 1), cB + hstep, voffB); PG8_STAGE(PG8_SA(0, 0), cA, voffA); PG8_STAGE(PG8_SA(0, 1), cA + hstep, voffA);
        if (wr == 1) PG8_BAR;
        PG8_WAIT_V(2); PG8_BAR;
        PG8_STAGE(PG8_SB(1, 0), cB + kstep, voffB); PG8_STAGE(PG8_SA(1, 0), cA + kstep, voffA); PG8_STAGE(PG8_SB(1, 1), cB + hstep + kstep, voffB);
        PG8_WAIT_V(6); PG8_BAR;
    } else {
        PG8_STAGE(PG8_SB(0, 0), cB, voffB); PG8_STAGE(PG8_SA(0, 0), cA, voffA); PG8_STAGE(PG8_SB(0, 1), cB + hstep, voffB); PG8_STAGE(PG8_SA(0, 1), cA + hstep, voffA);
        if (wr == 1) PG8_BAR;
        PG8_WAIT_V(4); PG8_BAR;
        PG8_STAGE(PG8_SB(1, 0), cB + kstep, voffB); PG8_STAGE(PG8_SA(1, 0), cA + kstep, voffA); PG8_STAGE(PG8_SB(1, 1), cB + hstep + kstep, voffB);
        PG8_WAIT_V(6); PG8_BAR;
    }
    for (;;) {
        const bool has_next = S.next(ui + 1, nxt);
        const char* nA = has_next ? nxt.a : cA; const char* nB = has_next ? nxt.b : cB;
        for (int t = 0; t < nt; t += 2) {
            const bool last = (t == nt - 2);
            const char* a1 = cA + (size_t)(t + 1) * kstep;
            const char* a2 = last ? nA : cA + (size_t)(t + 2) * kstep; const char* b2 = last ? nB : cB + (size_t)(t + 2) * kstep;
            const char* a3 = a2 + kstep; const char* b3 = b2 + kstep;
            if (last && has_next) S.a_ready(nxt);
            if constexpr (SP2) {
            PG8_LDB(B0, 0, 0); PG8_LDB(B1, 0, 1); PG8_SCHED; PG8_LDA(At, 0, 0); PG8_STAGE(PG8_SA(1, 1), a1 + hstep, voffA);
            PG8_WAIT_V(8); PG8_WAIT_L(0); PG8_BAR; PG8_MMA(0, 0, At, B0); PG8_MMA(0, 1, At, B1); PG8_BAR; PG8_SCHED;
            PG8_LDA(At, 0, 1); PG8_STAGE(PG8_SB(0, 0), b2, voffB); PG8_STAGE(PG8_SB(0, 1), b2 + hstep, voffB); PG8_STAGE(PG8_SA(0, 0), a2, voffA);
            PG8_WAIT_V(8); PG8_WAIT_L(0); PG8_BAR; PG8_MMA(1, 0, At, B0); PG8_MMA(1, 1, At, B1); PG8_BAR; PG8_SCHED;
            PG8_LDB(B0, 1, 0); PG8_LDB(B1, 1, 1); PG8_SCHED; PG8_LDA(At, 1, 0); PG8_STAGE(PG8_SA(0, 1), a2 + hstep, voffA);
            PG8_WAIT_V(8); PG8_WAIT_L(0); PG8_BAR; PG8_MMA(0, 0, At, B0); PG8_MMA(0, 1, At, B1); PG8_BAR; PG8_SCHED;
            PG8_LDA(At, 1, 1); PG8_STAGE(PG8_SB(1, 0), b3, voffB); PG8_STAGE(PG8_SB(1, 1), b3 + hstep, voffB); PG8_STAGE(PG8_SA(1, 0), a3, voffA);
            PG8_WAIT_V(8); PG8_WAIT_L(0); PG8_BAR; PG8_MMA(1, 0, At, B0); PG8_MMA(1, 1, At, B1); PG8_BAR; PG8_SCHED;
            } else {
            PG8_LDB(B0, 0, 0); PG8_SCHED; PG8_LDA(At, 0, 0); PG8_STAGE(PG8_SA(1, 1), a1 + hstep, voffA);
            PG8_WAIT_L(8); PG8_BAR; PG8_WAIT_L(0); PG8_MMA(0, 0, At, B0); PG8_BAR; PG8_SCHED;
            PG8_LDB(B1, 0, 1); PG8_STAGE(PG8_SB(0, 0), b2, voffB);
            PG8_BAR; PG8_WAIT_L(0); PG8_MMA(0, 1, At, B1); PG8_BAR;
            PG8_LDA(At, 0, 1); PG8_STAGE(PG8_SA(0, 0), a2, voffA);
            PG8_BAR; PG8_WAIT_L(0); PG8_MMA(1, 0, At, B0); PG8_BAR; PG8_SCHED;
            PG8_STAGE(PG8_SB(0, 1), b2 + hstep, voffB);
            PG8_WAIT_V(6); PG8_BAR; PG8_MMA(1, 1, At, B1); PG8_BAR;
            PG8_LDB(B0, 1, 0); PG8_SCHED; PG8_LDA(At, 1, 0); PG8_STAGE(PG8_SA(0, 1), a2 + hstep, voffA);
            PG8_WAIT_L(8); PG8_BAR; PG8_WAIT_L(0); PG8_MMA(0, 0, At, B0); PG8_BAR; PG8_SCHED;
            PG8_LDB(B1, 1, 1); PG8_STAGE(PG8_SB(1, 0), b3, voffB);
            PG8_BAR; PG8_WAIT_L(0); PG8_MMA(0, 1, At, B1); PG8_BAR;
            PG8_LDA(At, 1, 1); PG8_STAGE(PG8_SA(1, 0), a3, voffA);
            PG8_BAR; PG8_WAIT_L(0); PG8_MMA(1, 0, At, B0); PG8_BAR; PG8_SCHED;
            PG8_STAGE(PG8_SB(1, 1), b3 + hstep, voffB);
            PG8_WAIT_V(6); PG8_BAR; PG8_MMA(1, 1, At, B1); PG8_BAR;
            }
        }
        if constexpr (ALIGN_EPI) { if (wr == 0) PG8_BAR; }
        bool keep = false;
        if constexpr (!Epi::AFTER_DRAIN) { if constexpr (Epi::CHAIN) keep = E.chain(acc, cur, wr, wc, fr, fq); else E(acc, cur, wr, wc, fr, fq); S.done(cur); }
        if (!has_next) break;
        if (!keep) {
#pragma unroll
        for (int a = 0; a < 2; ++a)
#pragma unroll
            for (int b = 0; b < 2; ++b)
#pragma unroll
                for (int m = 0; m < 4; ++m)
#pragma unroll
                    for (int n = 0; n < 2; ++n) acc[a][b][m][n] = (f32x4){0.f, 0.f, 0.f, 0.f};
        }
        cur = nxt; cA = nA; cB = nB; ++ui;
        if constexpr (ALIGN_EPI) { if (wr == 1) PG8_BAR; }
    }
    PG8_WAIT_V(0);
    if constexpr (!ALIGN_EPI) { if (wr == 0) PG8_BAR; }
    PG8_BAR;
    if constexpr (Epi::AFTER_DRAIN) { E.fused(acc, cur, wr, wc, fr, fq, lds, wid, lane); S.done(cur); }
#undef PG8_SA
#undef PG8_SB
#undef PG8_STAGE
#undef PG8_LDA
#undef PG8_LDB
#undef PG8_MMA
#undef PG8_WAIT_V
#undef PG8_WAIT_L
#undef PG8_BAR
#undef PG8_SCHED
}
}
#include <hip/hip_bf16.h>
#include <cmath>
namespace attn_body {
using bf16=__hip_bfloat16;
using bf16x8=__attribute__((ext_vector_type(8)))short;
using s16x4=__attribute__((ext_vector_type(4)))short;
using f32x16=__attribute__((ext_vector_type(16)))float;
using u32x4=__attribute__((ext_vector_type(4)))unsigned;
constexpr int NHEAD=8,SEQ=2048,D=64,PQ=512,PK=512,PV=4352,PO=512;
constexpr int NW=8,QBLK=32,QB=QBLK*NW,KVBLK=64,NQB=SEQ/QB;
__device__ __forceinline__ int crow(int r,int hi){return (r&3)+8*(r>>2)+4*hi;}
#define SBAR() __builtin_amdgcn_sched_barrier(0)
__device__ __forceinline__ void cmask(f32x16&p0,f32x16&p1,int jb,int qrel,int hi){
  const float NEG=-INFINITY; int kb=64*jb+4*hi;
  #pragma unroll
  for(int r=0;r<16;++r){int kv=kb+(r&3)+8*(r>>2); if(kv>qrel)p0[r]=NEG; if(kv+32>qrel)p1[r]=NEG;}
}

constexpr int NSLOT=3, SLOTB=8192;
constexpr int LDS_K=0, LDS_V=NSLOT*SLOTB, LDS_WS=2*NSLOT*SLOTB, LDS_OST=LDS_WS+NW*64*4, LDS_SEL=LDS_OST+NW*4096, LDS_KM=LDS_SEL+256, LDS_KP=LDS_KM+7*64*4, LDS_BYTES=LDS_KP+8*64*4;
constexpr float C2=0.125f*1.4426950408889634f;
__device__ __forceinline__ void glds16(const void*gsrc,unsigned lds_dst){unsigned keep;
  asm volatile("s_mov_b32 %0, m0\n\ts_mov_b32 m0, %2\n\ts_nop 0\n\tglobal_load_lds_dwordx4 %1, off\n\ts_mov_b32 m0, %0":"=&s"(keep):"v"(gsrc),"s"(lds_dst):"memory");}
__device__ __forceinline__ float max3f(float a,float b,float c){float r;asm("v_max3_f32 %0, %1, %2, %3":"=v"(r):"v"(a),"v"(b),"v"(c));return r;}
__device__ __forceinline__ float max2f(float a,float b){float r;asm("v_max_f32_e32 %0, %1, %2":"=v"(r):"v"(a),"v"(b));return r;}
__device__ __forceinline__ float fadd_s(float a,float b){float r;asm("v_add_f32_e32 %0, %1, %2":"=v"(r):"v"(a),"v"(b));return r;}
__device__ __forceinline__ float fsub_s(float a,float b){float r;asm("v_sub_f32_e32 %0, %1, %2":"=v"(r):"v"(a),"v"(b));return r;}
typedef float f32x2_t __attribute__((ext_vector_type(2))); typedef __bf16 bf16x2_t __attribute__((ext_vector_type(2)));
__device__ __forceinline__ unsigned cvtpk_s(float lo,float hi){f32x2_t v={lo,hi};bf16x2_t b=__builtin_convertvector(v,bf16x2_t);return __builtin_bit_cast(unsigned,b);}
#define WAIT_BAR(N) asm volatile("s_waitcnt vmcnt(" #N ") lgkmcnt(0)\n\ts_barrier":::"memory")

__device__ __forceinline__ void qkt(f32x16&p0,f32x16&p1,const char*Kslot,const bf16x8*qr,const f32x16&negm,int r32,int hi){
  const char*kb=Kslot+hi*1024+r32*16;
  #pragma unroll
  for(int d0=0;d0<4;++d0){
    const bf16x8 b0=*reinterpret_cast<const bf16x8*>(kb+d0*2048);
    const bf16x8 b1=*reinterpret_cast<const bf16x8*>(kb+d0*2048+512);
    if(d0==0){p0=__builtin_amdgcn_mfma_f32_32x32x16_bf16(b0,qr[0],negm,0,0,0);p1=__builtin_amdgcn_mfma_f32_32x32x16_bf16(b1,qr[0],negm,0,0,0);}
    else{p0=__builtin_amdgcn_mfma_f32_32x32x16_bf16(b0,qr[d0],p0,0,0,0);p1=__builtin_amdgcn_mfma_f32_32x32x16_bf16(b1,qr[d0],p1,0,0,0);}}
}
typedef __attribute__((address_space(3))) const char* lds_cptr;
typedef short v4i16_t __attribute__((ext_vector_type(4)));
__device__ __forceinline__ void kload8(bf16x8*kf,lds_cptr kp){
  kf[0]=*(const __attribute__((address_space(3))) bf16x8*)(kp);      kf[1]=*(const __attribute__((address_space(3))) bf16x8*)(kp+512);
  kf[2]=*(const __attribute__((address_space(3))) bf16x8*)(kp+2048); kf[3]=*(const __attribute__((address_space(3))) bf16x8*)(kp+2560);
  kf[4]=*(const __attribute__((address_space(3))) bf16x8*)(kp+4096); kf[5]=*(const __attribute__((address_space(3))) bf16x8*)(kp+4608);
  kf[6]=*(const __attribute__((address_space(3))) bf16x8*)(kp+6144); kf[7]=*(const __attribute__((address_space(3))) bf16x8*)(kp+6656);
}
__device__ __forceinline__ void kload2(bf16x8*kf,lds_cptr kp,int j){ kf[2*j]=*(const __attribute__((address_space(3))) bf16x8*)(kp+j*2048); kf[2*j+1]=*(const __attribute__((address_space(3))) bf16x8*)(kp+j*2048+512); }
__device__ __forceinline__ s16x4 vtr(lds_cptr p){ return __builtin_bit_cast(s16x4,__builtin_amdgcn_ds_read_tr16_b64_v4i16((__attribute__((address_space(3))) v4i16_t*)p)); }
__device__ __forceinline__ float rowmax(const f32x16&p0,const f32x16&p1){
  float a=max3f(p0[0],p0[1],p1[0]),b=max3f(p0[2],p0[3],p1[1]);a=max3f(a,p1[2],p1[3]);
  #pragma unroll
  for(int r=4;r<16;r+=4){a=max3f(a,p0[r],p0[r+1]);b=max3f(b,p0[r+2],p0[r+3]);a=max3f(a,p1[r],p1[r+1]);b=max3f(b,p1[r+2],p1[r+3]);}
  const float m=max2f(a,b);
  auto rr=__builtin_amdgcn_permlane32_swap(__float_as_uint(m),__float_as_uint(m),false,false);
  return max2f(__uint_as_float(rr[0]),__uint_as_float(rr[1]));
}
__device__ __forceinline__ void pv(f32x16*o,int vb,bf16x8 pa0,bf16x8 pa1,bf16x8 pa2,bf16x8 pa3){
  #pragma unroll
  for(int d0=0;d0<2;++d0){s16x4 lo[4],hi[4];
    #pragma unroll
    for(int ks=0;ks<4;++ks){
      asm volatile("ds_read_b64_tr_b16 %0,%1 offset:%c2":"=&v"(lo[ks]):"v"(vb),"i"(d0*4096+ks*1024):"memory");
      asm volatile("ds_read_b64_tr_b16 %0,%1 offset:%c2":"=&v"(hi[ks]):"v"(vb),"i"(d0*4096+ks*1024+512):"memory");}
    asm volatile("s_waitcnt lgkmcnt(0)":::"memory");SBAR();
    #define PK(k) (bf16x8){lo[k][0],lo[k][1],lo[k][2],lo[k][3],hi[k][0],hi[k][1],hi[k][2],hi[k][3]}
    o[d0]=__builtin_amdgcn_mfma_f32_32x32x16_bf16(pa0,PK(0),o[d0],0,0,0);
    o[d0]=__builtin_amdgcn_mfma_f32_32x32x16_bf16(pa1,PK(1),o[d0],0,0,0);
    o[d0]=__builtin_amdgcn_mfma_f32_32x32x16_bf16(pa2,PK(2),o[d0],0,0,0);
    o[d0]=__builtin_amdgcn_mfma_f32_32x32x16_bf16(pa3,PK(3),o[d0],0,0,0);
    #undef PK
  }
}

#ifndef ATTN_STORE16
#define ATTN_STORE16(p,v) (*(u32x4*)(p)=(v))
#endif
template<int THRL> __device__ __forceinline__ void attn_unit(int b,int h,int qb,const bf16*Q,const bf16*__restrict__ K,const bf16*__restrict__ V,bf16*O,char*shm,int wv){
  const int tid=mktid(wv),lane=tid&63,r32=lane&31,hi=lane>>5;     const int wid=__builtin_amdgcn_readfirstlane(tid>>6);
  const long rowbase=(long)b*SEQ; const int q0=qb*QB;
  if(qb>3){ float*KMl=(float*)(shm+LDS_KM); float*KPl=(float*)(shm+LDS_KP); const int c8=tid&7, rl=tid>>3;
    for(int n=0;n<qb;++n){ float sm[8];
      #pragma unroll
      for(int d=0;d<8;++d)sm[d]=0.f;
      #pragma unroll
      for(int rr=0;rr<4;++rr){ const u32x4 w=*reinterpret_cast<const u32x4*>(K+(rowbase+n*256+rl+64*rr)*PK+h*D+8*c8);
        sm[0]+=__uint_as_float(w[0]<<16);sm[1]+=__uint_as_float(w[0]&0xffff0000u);sm[2]+=__uint_as_float(w[1]<<16);sm[3]+=__uint_as_float(w[1]&0xffff0000u);
        sm[4]+=__uint_as_float(w[2]<<16);sm[5]+=__uint_as_float(w[2]&0xffff0000u);sm[6]+=__uint_as_float(w[3]<<16);sm[7]+=__uint_as_float(w[3]&0xffff0000u); }
      #pragma unroll
      for(int d=0;d<8;++d){ float v=sm[d];
        v+=__builtin_bit_cast(float,__builtin_amdgcn_ds_swizzle(__builtin_bit_cast(int,v),0x201F));
        v+=__builtin_bit_cast(float,__builtin_amdgcn_ds_swizzle(__builtin_bit_cast(int,v),0x401F));
        { const unsigned u=__builtin_bit_cast(unsigned,v); auto rr2=__builtin_amdgcn_permlane32_swap(u,u,false,false); v=__uint_as_float((unsigned)rr2[0])+__uint_as_float((unsigned)rr2[1]); }
        sm[d]=v; }
      if(lane<8){
        #pragma unroll
        for(int d=0;d<8;++d)KPl[wid*64+8*lane+d]=sm[d]; }
      asm volatile("s_waitcnt vmcnt(0) lgkmcnt(0)\n\ts_barrier":::"memory");
      if(tid<64){ float s8=0.f;
        #pragma unroll
        for(int w8=0;w8<8;++w8)s8+=KPl[w8*64+tid];
        KMl[n*64+tid]=s8*(1.0f/256.0f); }
      asm volatile("s_waitcnt lgkmcnt(0)\n\ts_barrier":::"memory"); } }
  if(tid<QB){ unsigned sel=(qb<=3)?((1u<<qb)-1u):0u;
    if(qb>3){ const bf16*qp=Q+(rowbase+q0+tid)*PQ+h*D; const float*km=(const float*)(shm+LDS_KM); float gate[7];
      #pragma unroll
      for(int j=0;j<7;++j)gate[j]=0.f;
      #pragma unroll 1
      for(int i=0;i<8;++i){ const u32x4 w=*reinterpret_cast<const u32x4*>(qp+8*i); float qv[8];
        qv[0]=__uint_as_float(w[0]<<16);qv[1]=__uint_as_float(w[0]&0xffff0000u);qv[2]=__uint_as_float(w[1]<<16);qv[3]=__uint_as_float(w[1]&0xffff0000u);
        qv[4]=__uint_as_float(w[2]<<16);qv[5]=__uint_as_float(w[2]&0xffff0000u);qv[6]=__uint_as_float(w[3]<<16);qv[7]=__uint_as_float(w[3]&0xffff0000u);
        #pragma unroll
        for(int j=0;j<7;++j) if(j<qb){ const float*kp=km+j*64+8*i;
          #pragma unroll
          for(int d=0;d<8;++d)gate[j]+=qv[d]*kp[d]; } }
      #pragma unroll
      for(int rep=0;rep<3;++rep){ float best=-INFINITY; int bi=0;
        #pragma unroll
        for(int j=0;j<7;++j) if(j<qb&&!((sel>>j)&1u)&&gate[j]>best){best=gate[j];bi=j;}
        sel|=1u<<bi; } }
    ((unsigned char*)(shm+LDS_SEL))[tid]=(unsigned char)sel; }
  asm volatile("s_waitcnt vmcnt(0) lgkmcnt(0)\n\ts_barrier":::"memory");
  const bf16*Qw=Q+(rowbase+q0+wid*QBLK)*PQ+h*D;
  const bf16*Kh=K+rowbase*PK+h*D,*Vh=V+rowbase*PV+h*D;
  const unsigned lds0=(unsigned)(uintptr_t)shm;
  float*wsf=(float*)(shm+LDS_WS)+wid*64;
  const bf16*ksrc=Kh+(long)lane*PK+wid*8;
  const bf16*vsrc=Vh+(long)(16*(wid&3)+(lane>>2))*PV+(wid>>2)*32+(lane&3)*8;
  const unsigned kdst=lds0+LDS_K+wid*1024, vdst=lds0+LDS_V+wid*1024;
  #define TROW(t) ((long)(((t)<4)?(q0+(t)*KVBLK):(((t)-4)*KVBLK)))
  #define DMA_K(t,slot) glds16(ksrc+TROW(t)*PK,(unsigned)__builtin_amdgcn_readfirstlane(kdst+(slot)))
  #define DMA_V(t,slot) glds16(vsrc+TROW(t)*PV,(unsigned)__builtin_amdgcn_readfirstlane(vdst+(slot)))
  const int vb0=(int)(lds0+LDS_V)+((lane>>4)&1)*32+(lane&3)*8+(4*hi+((lane&15)>>2))*64;
  const char*Kbase=shm+LDS_K; bf16x8 kf[8];
  const lds_cptr shm3=(lds_cptr)shm; const lds_cptr kp0=shm3+LDS_K+hi*1024+r32*16; const lds_cptr vp0=shm3+LDS_V+((lane>>4)&1)*32+(lane&3)*8+(4*hi+((lane&15)>>2))*64;
  const int NT=(q0+QB)/KVBLK;
  DMA_K(0,0);DMA_V(0,0);DMA_K(1,SLOTB);
  bf16x8 qr[4];
  #pragma unroll
  for(int d0=0;d0<4;++d0)qr[d0]=*reinterpret_cast<const bf16x8*>(&Qw[(long)r32*PQ+d0*16+hi*8]);
  float mhat=0.f,l_reg=0.f;f32x16 o[2];o[0]=f32x16{};o[1]=f32x16{};
  const int qrel=wid*QBLK+r32;
  const unsigned selb=((const unsigned char*)(shm+LDS_SEL))[qrel];
  #define CMASK(P0,P1,t) cmask(P0,P1,(t),qrel,hi)
  #define SUBREF(C0,C1,t) do{ const float sb_=(((t)<4)||((selb>>(((t)-4)>>2))&1u))?mhat:INFINITY; _Pragma("unroll") for(int r_=0;r_<16;++r_){C0[r_]-=sb_;C1[r_]-=sb_;} }while(0)
  bool resc=false;
  #define START(P0,P1) do{ const float rm=rowmax(P0,P1); resc=false; \
    { const float dl=rm; mhat=fadd_s(mhat,dl); \
      _Pragma("unroll") for(int r=0;r<16;++r){P0[r]=fsub_s(P0[r],dl);P1[r]=fsub_s(P1[r],dl);} \
      } \
    _Pragma("unroll") for(int r=0;r<16;++r)P0[r]=__builtin_amdgcn_exp2f(P0[r]); }while(0)
  #define RESC() do{ if(resc){ asm volatile("s_waitcnt lgkmcnt(0)":::"memory"); \
      _Pragma("unroll") for(int d_=0;d_<2;++d_) _Pragma("unroll") for(int r=0;r<16;++r)o[d_][r]*=wsf[crow(r,hi)]; } }while(0)
  f32x16 pA0,pA1,pB0,pB1;
  int sl_prev=0,sl_cur=0,sl_next=SLOTB;
  #define ROT() do{sl_prev=sl_cur;sl_cur=sl_next;sl_next=(sl_next==(NSLOT-1)*SLOTB)?0:sl_next+SLOTB;}while(0)
  DMA_K(2,2*SLOTB);
  WAIT_BAR(3);
  qkt(pA0,pA1,Kbase,qr,f32x16{},r32,hi);asm volatile("s_nop 15\n\ts_nop 7":"+v"(pA0),"+v"(pA1));CMASK(pA0,pA1,0);
  START(pA0,pA1);
  _Pragma("unroll") for(int r=0;r<16;++r)pA1[r]=__builtin_amdgcn_exp2f(pA1[r]);
  WAIT_BAR(0);
  DMA_K(3,0);DMA_V(1,SLOTB);
  ROT();
  kload8(kf,kp0+sl_cur);
  WAIT_BAR(2);
  s16x4 vlo[8],vhi[8]; u32x4 pw0,pw1,pw2,pw3;
  #define PKW(P,B) cvtpk_s(P[B],P[B+1])
  #define PAF(k) __builtin_bit_cast(bf16x8,pw##k)
  #define VFR(i) (bf16x8){vlo[i][0],vlo[i][1],vlo[i][2],vlo[i][3],vhi[i][0],vhi[i][1],vhi[i][2],vhi[i][3]}
  #define PIN(x) asm volatile("":"+v"(x))
  #define MX3(a,b,c) __builtin_fmaxf(__builtin_fmaxf((a),(b)),(c))
  #define GAPA(MF,A0,A1,A2,A3,W0,W1,PW) do{ MF; sacc+=A0; sacc+=A1; sacc+=A2; sacc+=A3; PIN(sacc); W0; W1; PIN(PW); SBAR(); }while(0)
  #define EX(v) __builtin_amdgcn_exp2f(v)
  #define GAPB(MF,X,B) do{ MF; X[B]=EX(X[B]); X[B+1]=EX(X[B+1]); X[B+2]=EX(X[B+2]); X[B+3]=EX(X[B+3]); PIN(X); SBAR(); }while(0)
  #define VRD(i) do{ vlo[i]=vtr(vp_+(((i)>>2)*4096+((i)&3)*1024)); vhi[i]=vtr(vp_+(((i)>>2)*4096+((i)&3)*1024+512)); }while(0)
  #define KRD(G,j) do{ if(G){ kload2(kf,kp0+sl_next,j); SBAR(); } }while(0)
  #define STEP(C0,C1,P0,P1,t,GK,GV,GL,MB) do{ SBAR(); \
    const lds_cptr vp_=vp0+sl_prev; \
    VRD(0); SBAR(); float sacc=(P0[0]+P0[1]); \
    GAPA(C0=__builtin_amdgcn_mfma_f32_32x32x16_bf16(kf[0],qr[0],f32x16{},0,0,0), P0[2],P0[3],P0[4],P0[5],     pw0[0]=PKW(P0,0), pw0[1]=PKW(P0,2), pw0); \
    VRD(4); SBAR(); GAPA(C1=__builtin_amdgcn_mfma_f32_32x32x16_bf16(kf[1],qr[0],f32x16{},0,0,0), P0[6],P0[7],P0[8],P0[9],     pw0[2]=PKW(P0,4), pw0[3]=PKW(P0,6), pw0); \
    VRD(1); SBAR(); GAPA(C0=__builtin_amdgcn_mfma_f32_32x32x16_bf16(kf[2],qr[1],C0,0,0,0),   P0[10],P0[11],P0[12],P0[13], pw1[0]=PKW(P0,8), pw1[1]=PKW(P0,10), pw1); \
    VRD(5); SBAR(); GAPA(C1=__builtin_amdgcn_mfma_f32_32x32x16_bf16(kf[3],qr[1],C1,0,0,0),   P0[14],P0[15],P1[0],P1[1],   pw1[2]=PKW(P0,12),pw1[3]=PKW(P0,14), pw1); \
    VRD(2); SBAR(); GAPA(C0=__builtin_amdgcn_mfma_f32_32x32x16_bf16(kf[4],qr[2],C0,0,0,0),   P1[2],P1[3],P1[4],P1[5],     pw2[0]=PKW(P1,0), pw2[1]=PKW(P1,2), pw2); \
    VRD(6); SBAR(); GAPA(C1=__builtin_amdgcn_mfma_f32_32x32x16_bf16(kf[5],qr[2],C1,0,0,0),   P1[6],P1[7],P1[8],P1[9],     pw2[2]=PKW(P1,4), pw2[3]=PKW(P1,6), pw2); \
    VRD(3); SBAR(); GAPA(C0=__builtin_amdgcn_mfma_f32_32x32x16_bf16(kf[6],qr[3],C0,0,0,0),   P1[10],P1[11],P1[12],P1[13], pw3[0]=PKW(P1,8), pw3[1]=PKW(P1,10), pw3); \
    VRD(7); SBAR(); GAPA(C1=__builtin_amdgcn_mfma_f32_32x32x16_bf16(kf[7],qr[3],C1,0,0,0),   P1[14],P1[15],0.f,0.f,       pw3[2]=PKW(P1,12),pw3[3]=PKW(P1,14), pw3); \
    l_reg+=sacc; \
    if(GK){DMA_K((t)+3,sl_cur);} if(GV){DMA_V((t)+1,sl_next);} \
    SUBREF(C0,C1,t); if(MB){CMASK(C0,C1,t);} \
    { float a=MX3(C0[0],C0[1],C1[0]),b=MX3(C0[2],C0[3],C1[1]); a=MX3(a,C1[2],C1[3]); \
      _Pragma("unroll") for(int r=4;r<16;r+=4){a=MX3(a,C0[r],C0[r+1]);b=MX3(b,C0[r+2],C0[r+3]);a=MX3(a,C1[r],C1[r+1]);b=MX3(b,C1[r+2],C1[r+3]);} \
      float rm=__builtin_fmaxf(a,b); { auto rr=__builtin_amdgcn_permlane32_swap(__float_as_uint(rm),__float_as_uint(rm),false,false); rm=__builtin_fmaxf(__uint_as_float(rr[0]),__uint_as_float(rr[1])); } \
      resc=false; \
      if(__builtin_expect(__any(rm>(float)THRL),0)){ const float dl=__builtin_fmaxf(rm,0.f); mhat+=dl; \
        _Pragma("unroll") for(int r=0;r<16;++r){C0[r]-=dl;C1[r]-=dl;} \
        const float f=__builtin_amdgcn_exp2f(-dl); l_reg*=f; if(hi==0)wsf[r32]=f; resc=true; } } \
    SBAR(); \
    GAPB(o[0]=__builtin_amdgcn_mfma_f32_32x32x16_bf16(PAF(0),VFR(0),o[0],0,0,0), C0,0); \
    GAPB(o[1]=__builtin_amdgcn_mfma_f32_32x32x16_bf16(PAF(0),VFR(4),o[1],0,0,0), C0,4); \
    KRD(GL,0); GAPB(o[0]=__builtin_amdgcn_mfma_f32_32x32x16_bf16(PAF(1),VFR(1),o[0],0,0,0), C0,8); \
    KRD(GL,1); GAPB(o[1]=__builtin_amdgcn_mfma_f32_32x32x16_bf16(PAF(1),VFR(5),o[1],0,0,0), C0,12); \
    KRD(GL,2); GAPB(o[0]=__builtin_amdgcn_mfma_f32_32x32x16_bf16(PAF(2),VFR(2),o[0],0,0,0), C1,0); \
    KRD(GL,3); GAPB(o[1]=__builtin_amdgcn_mfma_f32_32x32x16_bf16(PAF(2),VFR(6),o[1],0,0,0), C1,4); \
    GAPB(o[0]=__builtin_amdgcn_mfma_f32_32x32x16_bf16(PAF(3),VFR(3),o[0],0,0,0), C1,8); \
    GAPB(o[1]=__builtin_amdgcn_mfma_f32_32x32x16_bf16(PAF(3),VFR(7),o[1],0,0,0), C1,12); \
    }while(0)
  #define ENDW(tt) do{ if((tt)+3<NT){WAIT_BAR(2);} else if((tt)+2<NT){WAIT_BAR(1);} else {WAIT_BAR(0);} }while(0)
  { int t=1;
    for(;t+1<NT;t+=2){
      STEP(pB0,pB1,pA0,pA1,t,(t+3<NT),(t+1<NT),(t+1<NT),(t<4));       ENDW(t);   RESC(); ROT();
      STEP(pA0,pA1,pB0,pB1,t+1,(t+4<NT),(t+2<NT),(t+2<NT),(t+1<4));     ENDW(t+1); RESC(); ROT();
    }
    STEP(pB0,pB1,pA0,pA1,NT-1,false,false,false,(NT==4)); RESC();
  }
  { float sacc=pB0[0]+pB0[1]; _Pragma("unroll") for(int r=2;r<16;++r)sacc+=pB0[r]; _Pragma("unroll") for(int r=0;r<16;++r)sacc+=pB1[r]; l_reg+=sacc;
    pw0=(u32x4){PKW(pB0,0),PKW(pB0,2),PKW(pB0,4),PKW(pB0,6)};pw1=(u32x4){PKW(pB0,8),PKW(pB0,10),PKW(pB0,12),PKW(pB0,14)};pw2=(u32x4){PKW(pB1,0),PKW(pB1,2),PKW(pB1,4),PKW(pB1,6)};pw3=(u32x4){PKW(pB1,8),PKW(pB1,10),PKW(pB1,12),PKW(pB1,14)};
    SBAR(); pv(o,vb0+sl_cur,PAF(0),PAF(1),PAF(2),PAF(3)); }
  #undef PKW
  #undef PAF
  #undef VFR
  #undef PIN
  #undef MX3
  #undef GAPA
  #undef GAPB
  #undef EX
  #undef VRD
  #undef KRD
  #undef STEP
  #undef ENDW
  {auto rr=__builtin_amdgcn_permlane32_swap(__float_as_uint(l_reg),__float_as_uint(l_reg),false,false);l_reg=__uint_as_float(rr[0])+__uint_as_float(rr[1]);}
  if(hi==0)wsf[32+r32]=l_reg;asm volatile("s_waitcnt lgkmcnt(0)":::"memory");
  float rli[16];
  #pragma unroll
  for(int r=0;r<16;++r)rli[r]=__builtin_amdgcn_rcpf(wsf[32+crow(r,hi)]);
  bf16*Ow=O+(rowbase+q0+wid*QBLK)*PO+h*D;
  { bf16*stg=(bf16*)(shm+LDS_OST)+wid*2048;
    #pragma unroll
    for(int r=0;r<16;++r){const int orow=crow(r,hi);
      #pragma unroll
      for(int d0=0;d0<2;++d0)stg[orow*64+d0*32+r32]=__float2bfloat16(o[d0][r]*rli[r]);}
    asm volatile("s_waitcnt lgkmcnt(0)":::"memory");
    #pragma unroll
    for(int i=0;i<4;++i){const int row=i*8+(lane>>3),ch=lane&7; const u32x4 v=*(const u32x4*)(stg+row*64+ch*8); ATTN_STORE16(Ow+(long)row*PO+ch*8,v);} }
  asm volatile("s_waitcnt lgkmcnt(0)\n\ts_barrier":::"memory");
  #undef DMA_K
  #undef TROW
  #undef SUBREF
  #undef DMA_V
  #undef CMASK
  #undef START
  #undef RESC
  #undef ROT
}
constexpr int ATTN_LDS_BYTES=LDS_BYTES;
#undef SBAR
#undef WAIT_BAR
}
constexpr int DM = 1024, NB = 16, SEQ = 2048, NT = NB * SEQ;
constexpr int RWW = 512, WIN_N = 5376, INC = 4352, ZV = 1792, ZG = 2304;
constexpr int NEXP = 32, DEXP = 512;
constexpr int XS_ROWS = 2 * NT + NEXP * 256;
constexpr float C2 = 0.125f * 1.4426950408889634f;

#define LAS __attribute__((address_space(3)))
#define GAS __attribute__((address_space(1)))
typedef unsigned short bf16;
typedef unsigned v4u __attribute__((ext_vector_type(4)));
typedef unsigned v2u __attribute__((ext_vector_type(2)));
typedef float f32x4 __attribute__((ext_vector_type(4)));

typedef float f32x2_c __attribute__((ext_vector_type(2))); typedef __bf16 bf16x2_c __attribute__((ext_vector_type(2)));
__device__ __forceinline__ unsigned pk2(float lo, float hi) { const f32x2_c v = {lo, hi}; return __builtin_bit_cast(unsigned, __builtin_convertvector(v, bf16x2_c)); }
__device__ __forceinline__ unsigned f2bf(float f) { return pk2(f, f) & 0xffffu; }
__device__ __forceinline__ float bflo(unsigned w) { return __builtin_bit_cast(float, w << 16); }
__device__ __forceinline__ float bfhi(unsigned w) { return __builtin_bit_cast(float, w & 0xffff0000u); }
__device__ __forceinline__ float sigm(float x) { return __builtin_amdgcn_rcpf(1.0f + __expf(-x)); }

constexpr size_t MiB = 1u << 20;
constexpr size_t WS_CTL = 0;
constexpr size_t WS_MOD = 1 * MiB;
constexpr size_t WS_GM2 = 1 * MiB + 512 * 1024;
constexpr size_t WS_CB = 1 * MiB + 640 * 1024;
constexpr size_t WS_COS = 2 * MiB;
constexpr size_t WS_SIN = 2 * MiB + 512 * 1024;
constexpr size_t WS_KMEAN = 3 * MiB;
constexpr size_t WS_WRH = 3 * MiB + 512 * 1024;
constexpr size_t WS_WRL = 3 * MiB + 768 * 1024;
constexpr size_t WS_SEL = 4 * MiB;
constexpr size_t WS_RTE = 5 * MiB;
constexpr size_t WS_RTW = 5 * MiB + 256 * 1024;
constexpr size_t WS_RNK = 5 * MiB + 512 * 1024;
constexpr size_t WS_POS = 5 * MiB + 768 * 1024;
constexpr size_t WS_RSTD = 7 * MiB;
constexpr size_t WS_WLT = 6 * MiB;
constexpr size_t WS_WAT = 6 * MiB + 64 * 1024;
constexpr size_t WS_WGT = 6 * MiB + 128 * 1024;
constexpr size_t WS_WIN = 16 * MiB;
constexpr size_t WS_WBA = 27 * MiB;
constexpr size_t WS_WBB = 28 * MiB;
constexpr size_t WS_WOUT = 29 * MiB;
constexpr size_t WS_Z = 32 * MiB;
constexpr size_t WS_H = 368 * MiB;
constexpr size_t WS_Q = 304 * MiB, WS_K = 336 * MiB, WS_MRG = 304 * MiB;
constexpr size_t WS_YA = 432 * MiB, WS_YB = 464 * MiB;
constexpr size_t WS_WUP = 368 * MiB;
constexpr size_t WS_H2 = 128 * MiB;
constexpr size_t WS_XS = 64 * MiB;
constexpr size_t WS_HID = 208 * MiB;
constexpr size_t WS_X1B = 432 * MiB;
constexpr size_t WS_END = 496 * MiB;
constexpr int CW_CNT = 64, CNT_PAD = 64;
constexpr int CW_NT = 2304;
constexpr int CW_TEXP = 2368;
static_assert(CW_CNT + NEXP * CNT_PAD <= CW_NT, "control words");

__device__ __forceinline__ void tr_item(const float* W, int K, int N, bf16* WT, int kb, int nb, int dst_row0, LAS float* scr, int lane) {
    const int k0 = 64 * kb, n0 = 32 * nb;
#pragma unroll 8
    for (int i = 0; i < 32; ++i) { const int kk = 2 * i + (lane >> 5); scr[kk * 33 + (lane & 31)] = W[(size_t)(k0 + kk) * N + n0 + (lane & 31)]; }
    asm volatile("s_waitcnt lgkmcnt(0)" ::: "memory");
    const int c = lane & 7;
#pragma unroll
    for (int j = 0; j < 4; ++j) { const int n = (lane >> 3) + 8 * j; const LAS float* s = scr + (8 * c) * 33 + n;
        v4u o; o.x = pk2(s[0 * 33], s[1 * 33]); o.y = pk2(s[2 * 33], s[3 * 33]); o.z = pk2(s[4 * 33], s[5 * 33]); o.w = pk2(s[6 * 33], s[7 * 33]);
        *(v4u*)(WT + (size_t)(dst_row0 + n) * K + k0 + 8 * c) = o; }
    asm volatile("s_waitcnt lgkmcnt(0)" ::: "memory");
}

struct PArgs { const float* in[30]; float* out; unsigned char* ws; };

__device__ __forceinline__ void p_prep_weights(const PArgs& a, unsigned char* lds, int wv) {
    const int tid = mktid(wv), lane = tid & 63, wave = tid >> 6;
    LAS float* scr = (LAS float*)lds + wave * (64 * 33);
    const int gw = blockIdx.x * 8 + wave, NGW = gridDim.x * 8;
    unsigned char* ws = a.ws;
    constexpr int I_IN = 16 * 168, I_BR = 8 * 32, I_OUT = 16 * 32;
    for (int it = gw; it < I_IN + 2 * I_BR + I_OUT; it += NGW) {
        int r = it;
        if (r < I_IN) { const int kb = r / 168, nb = r % 168; int dst = 32 * nb;
            if (dst >= 1792 && dst < 2816) { const int rel = dst - 1792, u = rel >> 8, hl = (rel & 255) >> 6, half = (rel & 63) >> 5; dst = 1792 + u * 256 + half * 128 + hl * 32; }
            tr_item(a.in[6], 1024, WIN_N, (bf16*)(ws + WS_WIN), kb, nb, dst, scr, lane); continue; } r -= I_IN;
        if (r < I_BR) { const int kb = r / 32, nb = r % 32; tr_item(a.in[20], 512, 1024, (bf16*)(ws + WS_WBA), kb, nb, 32 * nb, scr, lane); continue; } r -= I_BR;
        if (r < I_BR) { const int kb = r / 32, nb = r % 32; tr_item(a.in[21], 512, 1024, (bf16*)(ws + WS_WBB), kb, nb, 32 * nb, scr, lane); continue; } r -= I_BR;
        { const int kb = r / 32, nb = r % 32; tr_item(a.in[22], 1024, 1024, (bf16*)(ws + WS_WOUT), kb, nb, 32 * nb, scr, lane); }
    }
    const int gt = blockIdx.x * 512 + tid, NGT = gridDim.x * 512;
    float* cosT = (float*)(ws + WS_COS); float* sinT = (float*)(ws + WS_SIN);
    for (int i = gt; i < SEQ * 32; i += NGT) { const int s = i >> 5, f = i & 31; const float inv = powf(10000.0f, -(float)f / 32.0f); const float ang = (float)s * inv; cosT[i] = cosf(ang); sinT[i] = sinf(ang); }
    { bf16* wlt = (bf16*)(ws + WS_WLT); bf16* wat = (bf16*)(ws + WS_WAT); bf16* wgt = (bf16*)(ws + WS_WGT);
      for (int i = gt; i < 8 * 64 * 64; i += NGT) { const int hh = i >> 12, j = (i >> 6) & 63, m = i & 63; wlt[i] = (bf16)f2bf(a.in[9][m * 512 + hh * 64 + j]); wat[i] = (bf16)f2bf(a.in[11][m * 512 + hh * 64 + j]); }
      for (int i = gt; i < 8 * 64 * 128; i += NGT) { const int hh = i >> 13, j = (i >> 7) & 63, m = i & 127; wgt[i] = (bf16)f2bf(a.in[12][m * 512 + hh * 64 + j]); } }
    { bf16* wrh = (bf16*)(ws + WS_WRH); bf16* wrl = (bf16*)(ws + WS_WRL);
      for (int i = gt; i < 48 * 1024; i += NGT) { const int e = i >> 10, k = i & 1023; const float w = e < 4 ? a.in[23][k * 4 + e] : e < 36 ? a.in[25][k * 32 + (e - 4)] : 0.f;
          const unsigned hi = f2bf(w); wrh[i] = (bf16)hi; wrl[i] = (bf16)f2bf(w - bflo(hi)); } }
}

__device__ __forceinline__ void p_prep_experts_up(const PArgs& a, unsigned char* lds, int wv, int vb, int nvb) {
    const int tid = mktid(wv), lane = tid & 63, wave = tid >> 6;
    LAS float* scr = (LAS float*)lds + wave * (64 * 33);
    unsigned char* ws = a.ws;
    for (int it = vb * 8 + wave; it < NEXP * 512; it += nvb * 8) {
        const int e = it >> 9; int r = it & 511;
        bf16* wup = (bf16*)(ws + WS_WUP) + (size_t)e * 1024 * 1024;
        if (r < 256) { const int kb = r / 16, nb = r % 16, n0 = 32 * nb; tr_item(a.in[27] + (size_t)e * 1024 * 512, 1024, 512, wup, kb, nb, (n0 >> 7) * 256 + (n0 & 127), scr, lane); continue; } r -= 256;
        { const int kb = r / 16, nb = r % 16, n0 = 32 * nb; tr_item(a.in[28] + (size_t)e * 1024 * 512, 1024, 512, wup, kb, nb, (n0 >> 7) * 256 + 128 + (n0 & 127), scr, lane); }
    }
    for (int it = vb * 8 + wave; it < NEXP * 256; it += nvb * 8) { const int e = it >> 8, r = it & 255; const int kb = r / 32, nb = r % 32;
        tr_item(a.in[29] + (size_t)e * 512 * 1024, 512, 1024, (bf16*)a.out + (size_t)e * 1024 * 512, kb, nb, 32 * nb, scr, lane); }
}

__device__ __forceinline__ void p_ada(const PArgs& a, unsigned char* lds, int wv) {
    float* sc = (float*)lds; float* red = sc + 16 * 1024;
    const float* c = a.in[1]; const float* w = a.in[2]; const float* bias = a.in[3];
    float* mod = (float*)(a.ws + WS_MOD);
    const int tid = mktid(wv);
    for (int i = tid; i < 16 * 1024; i += 512) { const float v = c[i]; sc[i] = v / (1.0f + __expf(-v)); }
    __syncthreads();
    const int col = tid & 31, kg = tid >> 5;
    for (int tile = blockIdx.x; tile < 192; tile += gridDim.x) {
        const int e = tile * 32 + col;
        float acc[16];
#pragma unroll
        for (int b = 0; b < 16; ++b) acc[b] = 0.f;
        for (int d = kg * 64; d < kg * 64 + 64; ++d) { const float wv = w[(size_t)d * 6144 + e];
#pragma unroll
            for (int b = 0; b < 16; ++b) acc[b] += sc[b * 1024 + d] * wv; }
#pragma unroll
        for (int b = 0; b < 16; ++b) red[(kg * 16 + b) * 32 + col] = acc[b];
        __syncthreads();
        { const int b = tid >> 5, cc = tid & 31; float sm = 0.f;
#pragma unroll
            for (int k = 0; k < 16; ++k) sm += red[(k * 16 + b) * 32 + cc];
            mod[b * 6144 + tile * 32 + cc] = sm + bias[tile * 32 + cc]; }
        __syncthreads();
    }
}

__device__ __forceinline__ void p_norm1(const PArgs& a, unsigned char* lds, int wv) {
    const int tid = mktid(wv), lane = tid & 63, gw = blockIdx.x * 8 + (tid >> 6), NGW = gridDim.x * 8;
    const float* x = a.in[0]; const float* g = a.in[4]; const float* mod = (const float*)(a.ws + WS_MOD);
    bf16* h = (bf16*)(a.ws + WS_H);
    for (int m = gw; m < NT; m += NGW) {
        const int b = m >> 11; const f32x4* xr = (const f32x4*)(x + (size_t)m * DM) + lane; f32x4 v[4]; float s = 0.f;
#pragma unroll
        for (int j = 0; j < 4; ++j) { v[j] = xr[64 * j]; s += (v[j].x * v[j].x + v[j].y * v[j].y) + (v[j].z * v[j].z + v[j].w * v[j].w); }
        const float rstd = rsqrtf(wave_sum(s) * (1.0f / DM) + 1e-6f);
        v2u* o = (v2u*)(h + (size_t)m * DM) + lane;
#pragma unroll
        for (int j = 0; j < 4; ++j) { const int col = 4 * (lane + 64 * j);
            const f32x4 gg = *(const f32x4*)(g + col), sh = *(const f32x4*)(mod + b * 6144 + col), scl = *(const f32x4*)(mod + b * 6144 + 1024 + col);
            const f32x4 r = v[j] * rstd * gg * (scl + 1.0f) + sh; v2u w; w.x = pk2(r.x, r.y); w.y = pk2(r.z, r.w); o[64 * j] = w; }
    }
    { float* gm2 = (float*)(a.ws + WS_GM2); float* cb = (float*)(a.ws + WS_CB); const float* g2 = a.in[5];
      for (int i = blockIdx.x * 512 + tid; i < 16 * 1024; i += gridDim.x * 512) { const int b = i >> 10, k = i & 1023; gm2[i] = g2[k] * (1.0f + mod[b * 6144 + 4096 + k]); }
      for (int p = gw; p < 16 * 48; p += NGW) { const int b = p / 48, n = p % 48; float s = 0.f;
          if (n < 36) { for (int k = lane; k < 1024; k += 64) { const float w = n < 4 ? a.in[23][k * 4 + n] : a.in[25][k * 32 + (n - 4)]; s += mod[b * 6144 + 3072 + k] * w; } }
          s = wave_sum(s); if (lane == 0) cb[p] = n < 4 ? s + a.in[24][n] : n < 36 ? s + a.in[26][n - 4] : 0.f; } }
}

using pg8::Unit; using pg8::HALF; using pg8::BM; using pg8::cvt_pk_bf16;
typedef pg8::f32x4 pf4; typedef pg8::u32x4 pu4;

struct EpiStoreBf16 {
    static constexpr bool PERM = true, AFTER_DRAIN = false, CHAIN = false;
    bf16* O; int ldc;
    __device__ __forceinline__ void operator()(const pf4 (&acc)[2][2][4][2], const Unit& u, int wr, int wc, int fr, int fq) const {
        const int row0 = u.pm * BM + wr * 64 + fr, col0 = u.pn * BM + wc * 32 + 8 * fq;
#pragma unroll
        for (int ai = 0; ai < 2; ++ai)
#pragma unroll
            for (int m = 0; m < 4; ++m) { bf16* rowp = O + (size_t)(row0 + ai * HALF + m * 16) * ldc + col0;
#pragma unroll
                for (int bj = 0; bj < 2; ++bj) { const pf4 v0 = acc[ai][bj][m][0], v1 = acc[ai][bj][m][1]; pu4 w;
                    w.x = cvt_pk_bf16(v0[0], v0[1]); w.y = cvt_pk_bf16(v0[2], v0[3]); w.z = cvt_pk_bf16(v1[0], v1[1]); w.w = cvt_pk_bf16(v1[2], v1[3]);
                    *(pu4*)(rowp + bj * HALF) = w; } }
    }
};
struct EpiZ {
    static constexpr bool PERM = true, AFTER_DRAIN = false, CHAIN = false;
    bf16* z; bf16* Q; bf16* K; const float* qg; const float* kg; const float* cosT; const float* sinT;
    __device__ __forceinline__ void operator()(const pf4 (&acc)[2][2][4][2], const Unit& u, int wr, int wc, int fr, int fq) const {
        const int row0 = u.pm * BM + wr * 64 + fr;
        if (u.pn < 7 || u.pn >= 11) {
            const int zc = (u.pn < 7 ? u.pn * 256 : (u.pn - 11) * 256 + 1792) + wc * 32 + 8 * fq;
#pragma unroll
            for (int ai = 0; ai < 2; ++ai)
#pragma unroll
                for (int m = 0; m < 4; ++m) { bf16* rowp = z + (size_t)(row0 + ai * HALF + m * 16) * INC + zc;
#pragma unroll
                    for (int bj = 0; bj < 2; ++bj) { const pf4 v0 = acc[ai][bj][m][0], v1 = acc[ai][bj][m][1]; pu4 w;
                        w.x = cvt_pk_bf16(v0[0], v0[1]); w.y = cvt_pk_bf16(v0[2], v0[3]); w.z = cvt_pk_bf16(v1[0], v1[1]); w.w = cvt_pk_bf16(v1[2], v1[3]);
                        *(pu4*)(rowp + bj * HALF) = w; } }
            return;
        }
        const bool isk = u.pn >= 9; const int head = 4 * ((u.pn - 7) & 1) + wc; const float* g = isk ? kg : qg; bf16* O = (isk ? K : Q) + head * 64 + 8 * fq;
        const float osc = isk ? 1.0f : C2;
#pragma unroll
        for (int ai = 0; ai < 2; ++ai)
#pragma unroll
            for (int m = 0; m < 4; ++m) { int rb = row0, fqv = fq; asm volatile("" : "+v"(rb), "+v"(fqv));
                const int row = rb + ai * HALF + m * 16, s = row & (SEQ - 1);
                float ss = 0.f;
#pragma unroll
                for (int bj = 0; bj < 2; ++bj)
#pragma unroll
                    for (int n = 0; n < 2; ++n) { const pf4 v = acc[ai][bj][m][n]; ss += (v[0] * v[0] + v[1] * v[1]) + (v[2] * v[2] + v[3] * v[3]); }
                ss += __builtin_bit_cast(float, __builtin_amdgcn_ds_swizzle(__builtin_bit_cast(int, ss), 0x401F));
                { const unsigned uu = __builtin_bit_cast(unsigned, ss); auto rr = __builtin_amdgcn_permlane32_swap(uu, uu, false, false); ss = __builtin_bit_cast(float, (unsigned)rr[0]) + __builtin_bit_cast(float, (unsigned)rr[1]); }
                const float rstd = rsqrtf(ss * (1.0f / 64.0f) + 1e-6f) ;
#pragma unroll
                for (int n = 0; n < 2; ++n) { const pf4 c = *(const pf4*)(cosT + s * 32 + 8 * fqv + 4 * n), sn = *(const pf4*)(sinT + s * 32 + 8 * fqv + 4 * n);
                    const pf4 x1 = acc[ai][0][m][n] * rstd * *(const pf4*)(g + 8 * fqv + 4 * n), x2 = acc[ai][1][m][n] * rstd * *(const pf4*)(g + 32 + 8 * fqv + 4 * n);
                    const pf4 o1 = x1 * c - x2 * sn, o2 = x2 * c + x1 * sn;
                    v2u wa, wb; wa.x = cvt_pk_bf16(o1[0] * osc, o1[1] * osc); wa.y = cvt_pk_bf16(o1[2] * osc, o1[3] * osc); wb.x = cvt_pk_bf16(o2[0] * osc, o2[1] * osc); wb.y = cvt_pk_bf16(o2[2] * osc, o2[3] * osc);
                    bf16* op = (isk ? K : Q) + (size_t)row * 512 + head * 64 + 8 * fqv + 4 * n; *(v2u*)op = wa; *(v2u*)(op + 32) = wb;
                    asm volatile("" ::: "memory"); } }
    }
};
struct EpiMerge {
    static constexpr bool PERM = true, AFTER_DRAIN = false, CHAIN = true;
    const bf16* z; bf16* mrg;
    __device__ __forceinline__ bool chain(pf4 (&acc)[2][2][4][2], const Unit& u, int wr, int wc, int fr, int fq) const {
        const int row0 = u.pm * BM + wr * 64 + fr, col0 = u.pn * BM + wc * 32 + 8 * fq;
        if (u.aux == 0) {
#pragma unroll
            for (int ai = 0; ai < 2; ++ai)
#pragma unroll
                for (int m = 0; m < 4; ++m) { const size_t row = (size_t)(row0 + ai * HALF + m * 16);
#pragma unroll
                    for (int bj = 0; bj < 2; ++bj) { const int col = col0 + bj * HALF; const pu4 za = *(const pu4*)(z + row * INC + ZG + col), zb = *(const pu4*)(z + row * INC + ZG + 1024 + col);
                        const float a8[8] = {bflo(za.x), bfhi(za.x), bflo(za.y), bfhi(za.y), bflo(za.z), bfhi(za.z), bflo(za.w), bfhi(za.w)};
                        const float b8[8] = {bflo(zb.x), bfhi(zb.x), bflo(zb.y), bfhi(zb.y), bflo(zb.z), bfhi(zb.z), bflo(zb.w), bfhi(zb.w)};
#pragma unroll
                        for (int e = 0; e < 8; ++e) acc[ai][bj][m][e >> 2][e & 3] *= (1.0f + __expf(-b8[e])) * __builtin_amdgcn_rcpf(1.0f + __expf(-a8[e])); } }
            return true;
        }
#pragma unroll
        for (int ai = 0; ai < 2; ++ai)
#pragma unroll
            for (int m = 0; m < 4; ++m) { const size_t row = (size_t)(row0 + ai * HALF + m * 16);
#pragma unroll
                for (int bj = 0; bj < 2; ++bj) { const int col = col0 + bj * HALF; const pu4 gz = *(const pu4*)(z + row * INC + ZG + 1024 + col); const pf4 v0 = acc[ai][bj][m][0], v1 = acc[ai][bj][m][1];
                    pu4 w;
                    w.x = cvt_pk_bf16(sigm(bflo(gz.x)) * v0[0], sigm(bfhi(gz.x)) * v0[1]); w.y = cvt_pk_bf16(sigm(bflo(gz.y)) * v0[2], sigm(bfhi(gz.y)) * v0[3]);
                    w.z = cvt_pk_bf16(sigm(bflo(gz.z)) * v1[0], sigm(bfhi(gz.z)) * v1[1]); w.w = cvt_pk_bf16(sigm(bflo(gz.w)) * v1[2], sigm(bfhi(gz.w)) * v1[3]);
                    *(pu4*)(mrg + row * DM + col) = w; } }
        return false;
    }
};
struct EpiOut {
    static constexpr bool PERM = true, AFTER_DRAIN = false, CHAIN = false;
    const float* x; const float* mod; bf16* x1;
    __device__ __forceinline__ void operator()(const pf4 (&acc)[2][2][4][2], const Unit& u, int wr, int wc, int fr, int fq) const {
        const int row0 = u.pm * BM + wr * 64 + fr, col0 = u.pn * BM + wc * 32 + 8 * fq; const int b = u.pm >> 3;
        pf4 gt[2][2];
#pragma unroll
        for (int bj = 0; bj < 2; ++bj)
#pragma unroll
            for (int n = 0; n < 2; ++n) gt[bj][n] = *(const pf4*)(mod + b * 6144 + 2048 + col0 + bj * HALF + n * 4);
#pragma unroll
        for (int ai = 0; ai < 2; ++ai)
#pragma unroll
            for (int m = 0; m < 4; ++m) { const size_t off = (size_t)(row0 + ai * HALF + m * 16) * DM + col0;
#pragma unroll
                for (int bj = 0; bj < 2; ++bj) { const pf4 x0 = *(const pf4*)(x + off + bj * HALF), x1v = *(const pf4*)(x + off + bj * HALF + 4);
                    const pf4 o0 = x0 + gt[bj][0] * acc[ai][bj][m][0], o1 = x1v + gt[bj][1] * acc[ai][bj][m][1]; pu4 w;
                    w.x = cvt_pk_bf16(o0[0], o0[1]); w.y = cvt_pk_bf16(o0[2], o0[3]); w.z = cvt_pk_bf16(o1[0], o1[1]); w.w = cvt_pk_bf16(o1[2], o1[3]);
                    *(pu4*)(x1 + off + bj * HALF) = w; } }
    }
};
struct EpiUp {
    static constexpr bool PERM = true, AFTER_DRAIN = false, CHAIN = false;
    bf16* hid;
    __device__ __forceinline__ void operator()(const pf4 (&acc)[2][2][4][2], const Unit& u, int wr, int wc, int fr, int fq) const {
        const int row0 = u.pm * BM + wr * 64 + fr, col0 = u.pn * 128 + wc * 32 + 8 * fq;
#pragma unroll
        for (int ai = 0; ai < 2; ++ai)
#pragma unroll
            for (int m = 0; m < 4; ++m) { const size_t row = (size_t)(row0 + ai * HALF + m * 16); float o[8];
#pragma unroll
                for (int n = 0; n < 2; ++n)
#pragma unroll
                    for (int e = 0; e < 4; ++e) { const float g = acc[ai][0][m][n][e], l = acc[ai][1][m][n][e]; o[4 * n + e] = g * sigm(g) * l; }
                pu4 w; w.x = cvt_pk_bf16(o[0], o[1]); w.y = cvt_pk_bf16(o[2], o[3]); w.z = cvt_pk_bf16(o[4], o[5]); w.w = cvt_pk_bf16(o[6], o[7]);
                *(pu4*)(hid + row * DEXP + col0) = w; }
    }
};

struct GemmArgs { unsigned char* ws; const float* x; float* out; const float* qg; const float* kg; };
template <class Epi> __device__ __forceinline__ void run_dense(const void* A, const void* Bt, int M, int N, int K, const Epi& E, unsigned char* lds, int wv) {
    pg8::Gemm g{K}; pg8::StaticOrder S; S.init(A, Bt, M, N, K, (int)gridDim.x, (int)blockIdx.x);
    pg8::gemm_phase<Epi, pg8::StaticOrder, true, true>((PG8_LAS unsigned char*)lds, g, S, E, wv);
}
__device__ __forceinline__ void p_gemm_in(const GemmArgs& a, unsigned char* lds, int wv) {
    EpiZ E{(bf16*)(a.ws + WS_Z), (bf16*)(a.ws + WS_Q), (bf16*)(a.ws + WS_K), a.qg, a.kg, (const float*)(a.ws + WS_COS), (const float*)(a.ws + WS_SIN)};
    run_dense(a.ws + WS_H, a.ws + WS_WIN, NT, WIN_N, 1024, E, lds, wv);
}
struct PairOrder {
    int nM, nN, nwg, G, c; const char *A0, *A1, *B0, *B1; size_t tstep;
    __device__ bool next(int i, Unit& u) const {
        const long L = (long)(i >> 1) * G + c; if (L >= nwg) return false;
        int wgid = (int)L; { const int q = nwg / pg8::NXCD, r = nwg % pg8::NXCD, xcd = wgid % pg8::NXCD, off = wgid / pg8::NXCD; wgid = (xcd < r ? xcd * (q + 1) : r * (q + 1) + (xcd - r) * q) + off; }
        const int nig = pg8::WGM * nN, gid = wgid / nig, fm = gid * pg8::WGM, gsz = (nM - fm) < pg8::WGM ? (nM - fm) : pg8::WGM;
        u.pm = fm + ((wgid % nig) % gsz); u.pn = (wgid % nig) / gsz; u.aux = i & 1;
        u.a = ((i & 1) ? A1 : A0) + (size_t)u.pm * tstep; u.b = ((i & 1) ? B1 : B0) + (size_t)u.pn * tstep; return true;
    }
    __device__ __forceinline__ void a_ready(const Unit&) const {}
    __device__ __forceinline__ void done(const Unit&) const {}
};
__device__ __forceinline__ void p_gemm_merge(const GemmArgs& a, unsigned char* lds, int wv) {
    PairOrder S{NT / 256, 4, (NT / 256) * 4, (int)gridDim.x, (int)blockIdx.x, (const char*)(a.ws + WS_YA), (const char*)(a.ws + WS_YB), (const char*)(a.ws + WS_WBA), (const char*)(a.ws + WS_WBB), (size_t)256 * 512 * 2};
    EpiMerge E{(const bf16*)(a.ws + WS_Z), (bf16*)(a.ws + WS_MRG)}; pg8::Gemm g{512};
    pg8::gemm_phase<EpiMerge, PairOrder, true, true>((PG8_LAS unsigned char*)lds, g, S, E, wv);
}
__device__ __forceinline__ void p_gemm_out(const GemmArgs& a, unsigned char* lds, int wv) {
    EpiOut E{a.x, (const float*)(a.ws + WS_MOD), (bf16*)(a.ws + WS_X1B)};
    run_dense(a.ws + WS_MRG, a.ws + WS_WOUT, NT, 1024, 1024, E, lds, wv);
}
struct GroupedOrder {
    const int* texp; int nT, nN, G, c; const char* A; size_t a_tile; const char* B; size_t b_exp, b_tile;
    __device__ bool next(int i, Unit& u) const {
        const long L = (long)i * G + c; if (L >= (long)nT * nN) return false;
        const int tile = (int)(L / nN), pn = (int)(L % nN); u.aux = 0; u.pm = tile; u.pn = pn; u.a = A + (size_t)tile * a_tile; u.b = B + (size_t)texp[tile] * b_exp + (size_t)pn * b_tile; return true;
    }
    __device__ __forceinline__ void a_ready(const Unit&) const {}
    __device__ __forceinline__ void done(const Unit&) const {}
};
__device__ __forceinline__ void p_gemm_up(const GemmArgs& a, unsigned char* lds, int wv) {
    const int* ctl = (const int*)(a.ws + WS_CTL);
    GroupedOrder S{ctl + CW_TEXP, ctl[CW_NT], 4, (int)gridDim.x, (int)blockIdx.x, (const char*)(a.ws + WS_XS), (size_t)256 * 1024 * 2, (const char*)(a.ws + WS_WUP), (size_t)1024 * 1024 * 2, (size_t)256 * 1024 * 2};
    EpiUp E{(bf16*)(a.ws + WS_HID)}; pg8::Gemm g{1024};
    pg8::gemm_phase<EpiUp, GroupedOrder, true, true>((PG8_LAS unsigned char*)lds, g, S, E, wv);
}
__device__ __forceinline__ void p_gemm_down(const GemmArgs& a, unsigned char* lds, int wv) {
    const int* ctl = (const int*)(a.ws + WS_CTL);
    GroupedOrder S{ctl + CW_TEXP, ctl[CW_NT], 4, (int)gridDim.x, (int)blockIdx.x, (const char*)(a.ws + WS_HID), (size_t)256 * 512 * 2, (const char*)a.out, (size_t)1024 * 512 * 2, (size_t)256 * 512 * 2};
    EpiStoreBf16 E{(bf16*)(a.ws + WS_XS), 1024}; pg8::Gemm g{512};
    pg8::gemm_phase<EpiStoreBf16, GroupedOrder, true, true>((PG8_LAS unsigned char*)lds, g, S, E, wv);
}

__device__ __forceinline__ void p_attn(const PArgs& a, unsigned char* lds, int vb, int nvb, int wv) {
    const attn_body::bf16* Q = (const attn_body::bf16*)(a.ws + WS_Q); const attn_body::bf16* K = (const attn_body::bf16*)(a.ws + WS_K);
    const attn_body::bf16* V = (const attn_body::bf16*)(a.ws + WS_Z) + ZV; attn_body::bf16* O = (attn_body::bf16*)(a.ws + WS_YB);
    for (int p = vb; p < 512; p += nvb)
        for (int which = 0; which < 2; ++which) { const int bh = p >> 2, s = p & 3, qb = which ? 7 - s : s;
            attn_body::attn_unit<8>(bh >> 3, bh & 7, qb, Q, K, V, O, (char*)lds, wv); }
}

namespace rw {
typedef short bf16x8 __attribute__((ext_vector_type(8)));
constexpr int MB = 8192;
__device__ __forceinline__ int SW(int r, int c) { return r * 128 + ((((c >> 3) ^ (r >> 1)) & 7) << 4) + (c & 7) * 2; }
__device__ __forceinline__ int SWG(int r, int c) { return r * 256 + ((((c >> 3) ^ r) & 15) << 4) + (c & 7) * 2; }
__device__ __forceinline__ int SWF(int r, int c) { return r * 256 + ((((c >> 2) ^ r) & 15) << 4) + (c & 3) * 4; }
enum { I_AT = 0, I_BT, I_AJ, I_BHJ, I_KHJ, I_ABRT, I_X5, I_L, I_LT, I_R0, I_R1, I_KT, I_RT, I_VJ, I_X14, I_GATE, I_VT, NBUF };
constexpr int OFF_F32 = NBUF * MB;
constexpr int OFF_CST = OFF_F32 + (64 * 3 + 512) * 4;
constexpr int LDS_NEED = OFF_CST + 14 * 64 * 4;

__device__ __forceinline__ bf16x8 ldfrag(const unsigned char* M, int row, int k) { return *(const bf16x8*)(M + SW(row, k)); }
__device__ __forceinline__ void mm(f32x4 (&acc)[2], const unsigned char* X, const unsigned char* Y, int mt, int nh, int fr, int fq) {
    const bf16x8 a0 = ldfrag(X, 16 * mt + fr, 8 * fq), a1 = ldfrag(X, 16 * mt + fr, 8 * fq + 32);
#pragma unroll
    for (int nt = 0; nt < 2; ++nt) { const bf16x8 b0 = ldfrag(Y, 16 * (2 * nh + nt) + fr, 8 * fq), b1 = ldfrag(Y, 16 * (2 * nh + nt) + fr, 8 * fq + 32);
        acc[nt] = __builtin_amdgcn_mfma_f32_16x16x32_bf16(a0, b0, acc[nt], 0, 0, 0); acc[nt] = __builtin_amdgcn_mfma_f32_16x16x32_bf16(a1, b1, acc[nt], 0, 0, 0); }
}
struct FA { bf16x8 k0, k1; };
struct FB { bf16x8 k0[2], k1[2]; };
__device__ __forceinline__ FA ldA(const unsigned char* X, int mt, int fr, int fq) { FA f; f.k0 = ldfrag(X, 16 * mt + fr, 8 * fq); f.k1 = ldfrag(X, 16 * mt + fr, 8 * fq + 32); return f; }
__device__ __forceinline__ FB ldB(const unsigned char* Y, int nh, int fr, int fq) { FB f;
#pragma unroll
    for (int nt = 0; nt < 2; ++nt) { f.k0[nt] = ldfrag(Y, 16 * (2 * nh + nt) + fr, 8 * fq); f.k1[nt] = ldfrag(Y, 16 * (2 * nh + nt) + fr, 8 * fq + 32); }
    return f; }
__device__ __forceinline__ void mma(f32x4 (&acc)[2], const FA& a, const FB& b) {
    acc[0] = __builtin_amdgcn_mfma_f32_16x16x32_bf16(a.k0, b.k0[0], acc[0], 0, 0, 0); acc[1] = __builtin_amdgcn_mfma_f32_16x16x32_bf16(a.k0, b.k0[1], acc[1], 0, 0, 0);
    acc[0] = __builtin_amdgcn_mfma_f32_16x16x32_bf16(a.k1, b.k1[0], acc[0], 0, 0, 0); acc[1] = __builtin_amdgcn_mfma_f32_16x16x32_bf16(a.k1, b.k1[1], acc[1], 0, 0, 0);
}
__device__ __forceinline__ void ldC(f32x4 (&acc)[2], const unsigned char* Z, int mt, int nh, int fr, int fq) {
#pragma unroll
    for (int nt = 0; nt < 2; ++nt) { const v2u w = *(const v2u*)(Z + SW(16 * (2 * nh + nt) + fr, 16 * mt + 4 * fq)); acc[nt] = (f32x4){bflo(w.x), bfhi(w.x), bflo(w.y), bfhi(w.y)}; }
}
__device__ __forceinline__ void storeT(unsigned char* Z, const f32x4 (&acc)[2], int mt, int nh, int fr, int fq) {
#pragma unroll
    for (int nt = 0; nt < 2; ++nt) { v2u w; w.x = pk2(acc[nt][0], acc[nt][1]); w.y = pk2(acc[nt][2], acc[nt][3]); *(v2u*)(Z + SW(16 * (2 * nh + nt) + fr, 16 * mt + 4 * fq)) = w; }
}
__device__ __forceinline__ void storeN(unsigned char* Z, const f32x4 (&acc)[2], int mt, int nh, int fr, int fq) {
#pragma unroll
    for (int nt = 0; nt < 2; ++nt)
#pragma unroll
        for (int r = 0; r < 4; ++r) *(unsigned short*)(Z + SW(16 * mt + 4 * fq + r, 16 * (2 * nh + nt) + fr)) = (unsigned short)f2bf(acc[nt][r]);
}
__device__ __forceinline__ void ld8bf(const unsigned char* p, float (&v)[8]) { const v4u w = *(const v4u*)p; v[0] = bflo(w.x); v[1] = bfhi(w.x); v[2] = bflo(w.y); v[3] = bfhi(w.y); v[4] = bflo(w.z); v[5] = bfhi(w.z); v[6] = bflo(w.w); v[7] = bfhi(w.w); }
__device__ __forceinline__ void st8bf(unsigned char* p, const float (&v)[8]) { v4u w; w.x = pk2(v[0], v[1]); w.y = pk2(v[2], v[3]); w.z = pk2(v[4], v[5]); w.w = pk2(v[6], v[7]); *(v4u*)p = w; }
__device__ __forceinline__ void ld8f(const float* p, float (&v)[8]) { const f32x4 a = *(const f32x4*)p, b = *(const f32x4*)(p + 4); v[0] = a.x; v[1] = a.y; v[2] = a.z; v[3] = a.w; v[4] = b.x; v[5] = b.y; v[6] = b.z; v[7] = b.w; }
__device__ __forceinline__ void ld8fs(const unsigned char* M, int r, int c, float (&v)[8]) { const f32x4 a = *(const f32x4*)(M + SWF(r, c)), b = *(const f32x4*)(M + SWF(r, c + 4)); v[0] = a.x; v[1] = a.y; v[2] = a.z; v[3] = a.w; v[4] = b.x; v[5] = b.y; v[6] = b.z; v[7] = b.w; }
__device__ __forceinline__ void un8(const v4u w, float (&v)[8]) { v[0] = bflo(w.x); v[1] = bfhi(w.x); v[2] = bflo(w.y); v[3] = bfhi(w.y); v[4] = bflo(w.z); v[5] = bfhi(w.z); v[6] = bflo(w.w); v[7] = bfhi(w.w); }
__device__ __forceinline__ void shift8(const v4u cw, const v4u pw, bool hasp, const float* mu, float (&v)[8]) {
    float c[8], p[8], m[8]; un8(cw, c); un8(pw, p); ld8f(mu, m);
#pragma unroll
    for (int e = 0; e < 8; ++e) { const float pe = hasp ? p[e] : 0.f; v[e] = c[e] + (pe - c[e]) * m[e]; }
}
__device__ __forceinline__ float tanh_fast(float x) { return 1.0f - 2.0f * __builtin_amdgcn_rcpf(1.0f + __expf(2.0f * x)); }

#define LBAR() do { asm volatile("s_waitcnt lgkmcnt(0)" ::: "memory"); __builtin_amdgcn_s_barrier(); asm volatile("" ::: "memory"); } while (0)
__device__ __forceinline__ void scan_unit(const PArgs& a, unsigned char* lds, int bh, int wv) {
    const int tid = mktid(wv), lane = tid & 63, wid = __builtin_amdgcn_readfirstlane(tid >> 6);
    const int mt = wid >> 1, nh = wid & 1; int fr = lane & 15, fq = lane >> 4;
    const int b = bh >> 3, h = bh & 7;
#define BUF(i) (lds + (i) * MB)
    float* GC = (float*)(lds + OFF_F32); float* BON = GC + 64; float* LEND = BON + 64; float* SEGT = LEND + 64;
    unsigned char* LWR = BUF(I_AT); unsigned char* LAR = BUF(I_AJ); unsigned char* LGR = BUF(I_KHJ); unsigned char* LW = BUF(I_R0); unsigned char* LC = BUF(I_L); unsigned char* YTF = BUF(I_L);
    unsigned char* ACTW = BUF(I_L); unsigned char* ACTA = BUF(I_LT); unsigned char* ACTG = BUF(I_R0);
    const bf16* z = (const bf16*)(a.ws + WS_Z); bf16* ya = (bf16*)(a.ws + WS_YA);
    const float* mu = a.in[7];
    bf16x8 fw[2], fa[2], fg[4];
    { const bf16* wlt = (const bf16*)(a.ws + WS_WLT) + (size_t)h * 4096 + (16 * mt + fr) * 64 + 8 * fq; const bf16* wat = (const bf16*)(a.ws + WS_WAT) + (size_t)h * 4096 + (16 * mt + fr) * 64 + 8 * fq;
      const bf16* wgt = (const bf16*)(a.ws + WS_WGT) + (size_t)h * 8192 + (16 * mt + fr) * 128 + 8 * fq;
      fw[0] = *(const bf16x8*)wlt; fw[1] = *(const bf16x8*)(wlt + 32); fa[0] = *(const bf16x8*)wat; fa[1] = *(const bf16x8*)(wat + 32);
#pragma unroll
      for (int ks = 0; ks < 4; ++ks) fg[ks] = *(const bf16x8*)(wgt + 32 * ks); }
    float* CST = (float*)(lds + OFF_CST);
    for (int i = tid; i < 14 * 64; i += 512) { const int blk = i >> 6, jj = i & 63; float v;
        if (blk < 3) v = mu[blk * 512 + h * 64 + jj]; else if (blk < 7) v = mu[1536 + (blk - 3) * 64 + jj]; else v = a.in[blk == 7 ? 8 : blk == 8 ? 10 : blk == 9 ? 13 : blk == 10 ? 14 : blk == 11 ? 15 : blk == 12 ? 16 : 17][h * 64 + jj];
        CST[i] = v; }
    int s0i = I_X14, aki = I_X5;
    for (int i = tid; i < MB / 4; i += 512) ((unsigned*)BUF(I_X14))[i] = 0u;
    LBAR();
    int pt = tid >> 3, j0 = 8 * (tid & 7);
    const int colh = h * 64 + j0;
    const int zoff0 = colh, zoff1 = 512 + colh, zoff2 = 1024 + colh, zoff3 = 1536 + j0, zoff4 = 1600 + j0, zoff5 = 1664 + j0, zoff6 = 1728 + j0;
    v4u zc[7], zq[7];
#define ZLOAD(cc) do { const bf16* zr_ = z + ((size_t)b * SEQ + (cc) * 64 + pt) * INC; const bf16* zs_ = ((cc) * 64 + pt) > 0 ? zr_ - INC : zr_; \
        zc[0] = *(const v4u*)(zr_ + zoff0); zc[1] = *(const v4u*)(zr_ + zoff1); zc[2] = *(const v4u*)(zr_ + zoff2); zc[3] = *(const v4u*)(zr_ + zoff3); zc[4] = *(const v4u*)(zr_ + zoff4); zc[5] = *(const v4u*)(zr_ + zoff5); zc[6] = *(const v4u*)(zr_ + zoff6); \
        zq[0] = *(const v4u*)(zs_ + zoff0); zq[1] = *(const v4u*)(zs_ + zoff1); zq[2] = *(const v4u*)(zs_ + zoff2); zq[3] = *(const v4u*)(zs_ + zoff3); zq[4] = *(const v4u*)(zs_ + zoff4); zq[5] = *(const v4u*)(zs_ + zoff5); zq[6] = *(const v4u*)(zs_ + zoff6); } while (0)
    ZLOAD(0);
    v4u ypend = {0u, 0u, 0u, 0u}; size_t ypoff = 0;
    for (int c = 0; c < SEQ / 64; ++c) {
        asm volatile("" : "+v"(fr), "+v"(fq), "+v"(pt), "+v"(j0));
        const int s = c * 64 + pt; const size_t t = (size_t)b * SEQ + s; const bool hasp = s > 0;
        { float v[8];
          shift8(zc[0], zq[0], hasp, CST + 0 * 64 + j0, v); st8bf(BUF(I_RT) + SW(pt, j0), v);
          shift8(zc[1], zq[1], hasp, CST + 1 * 64 + j0, v); st8bf(BUF(I_KT) + SW(pt, j0), v);
          shift8(zc[2], zq[2], hasp, CST + 2 * 64 + j0, v); st8bf(BUF(I_VT) + SW(pt, j0), v);
#pragma unroll
          for (int e = 0; e < 8; ++e) *(unsigned short*)(BUF(I_VJ) + SW(j0 + e, pt)) = (unsigned short)f2bf(v[e]);
          shift8(zc[3], zq[3], hasp, CST + 3 * 64 + j0, v);
#pragma unroll
          for (int e = 0; e < 8; ++e) v[e] = tanh_fast(v[e]);
          st8bf(ACTW + SW(pt, j0), v);
          shift8(zc[4], zq[4], hasp, CST + 4 * 64 + j0, v); st8bf(ACTA + SW(pt, j0), v);
          shift8(zc[5], zq[5], hasp, CST + 5 * 64 + j0, v);
#pragma unroll
          for (int e = 0; e < 8; ++e) v[e] = sigm(v[e]);
          st8bf(ACTG + SWG(pt, j0), v);
          shift8(zc[6], zq[6], hasp, CST + 6 * 64 + j0, v);
#pragma unroll
          for (int e = 0; e < 8; ++e) v[e] = sigm(v[e]);
          st8bf(ACTG + SWG(pt, 64 + j0), v); }
        LBAR();
        f32x4 aw[2], aa[2], ag[2];
#pragma unroll
        for (int nt = 0; nt < 2; ++nt) { const int tr = 16 * (2 * nh + nt) + fr; const f32x4 zero = {0.f, 0.f, 0.f, 0.f};
            aw[nt] = __builtin_amdgcn_mfma_f32_16x16x32_bf16(fw[0], ldfrag(ACTW, tr, 8 * fq), zero, 0, 0, 0); aw[nt] = __builtin_amdgcn_mfma_f32_16x16x32_bf16(fw[1], ldfrag(ACTW, tr, 8 * fq + 32), aw[nt], 0, 0, 0);
            aa[nt] = __builtin_amdgcn_mfma_f32_16x16x32_bf16(fa[0], ldfrag(ACTA, tr, 8 * fq), zero, 0, 0, 0); aa[nt] = __builtin_amdgcn_mfma_f32_16x16x32_bf16(fa[1], ldfrag(ACTA, tr, 8 * fq + 32), aa[nt], 0, 0, 0);
            ag[nt] = zero;
#pragma unroll
            for (int ks = 0; ks < 4; ++ks) ag[nt] = __builtin_amdgcn_mfma_f32_16x16x32_bf16(fg[ks], *(const bf16x8*)(ACTG + SWG(tr, 8 * fq + 32 * ks)), ag[nt], 0, 0, 0); }
#pragma unroll
        for (int nt = 0; nt < 2; ++nt) { const int tr = 16 * (2 * nh + nt) + fr, jc = 16 * mt + 4 * fq;
            *(f32x4*)(LWR + SWF(tr, jc)) = aw[nt]; *(f32x4*)(LAR + SWF(tr, jc)) = aa[nt]; *(f32x4*)(LGR + SWF(tr, jc)) = ag[nt]; }
        LBAR();
        float lwv[8], an[8], bb[8], k2[8], rr[8], gg[8];
        { float lw8[8], la8[8], kx[8], w0v[8], a0v[8], kkc[8], kac[8], rkc[8];
          ld8fs(LWR, pt, j0, lw8); ld8fs(LAR, pt, j0, la8); ld8fs(LGR, pt, j0, gg);
          ld8bf(BUF(I_RT) + SW(pt, j0), rr); ld8bf(BUF(I_KT) + SW(pt, j0), kx);
          ld8f(CST + 7 * 64 + j0, w0v); ld8f(CST + 8 * 64 + j0, a0v); ld8f(CST + 9 * 64 + j0, kkc); ld8f(CST + 10 * 64 + j0, kac); ld8f(CST + 11 * 64 + j0, rkc);
          float ss = 0.f, bon = 0.f, av[8];
#pragma unroll
          for (int e = 0; e < 8; ++e) { lwv[e] = -0.606531f * sigm(w0v[e] + lw8[e]); av[e] = sigm(a0v[e] + la8[e]); an[e] = kx[e] * kkc[e]; ss += an[e] * an[e];
              k2[e] = kx[e] * (1.0f + (av[e] - 1.0f) * kac[e]); bon += rr[e] * k2[e] * rkc[e]; }
          ss = red8(ss); bon = red8(bon);
          const float inv = rsqrtf(fmaxf(ss, 1e-24f));
#pragma unroll
          for (int e = 0; e < 8; ++e) { const float kn = an[e] * inv; an[e] = -kn; bb[e] = kn * av[e]; }
          *(f32x4*)(LW + SWF(pt, j0)) = (f32x4){lwv[0], lwv[1], lwv[2], lwv[3]}; *(f32x4*)(LW + SWF(pt, j0 + 4)) = (f32x4){lwv[4], lwv[5], lwv[6], lwv[7]};
          if (j0 == 0) BON[pt] = bon; }
        LBAR();
        { const int j = tid & 63, sg = wid; float r0 = 0.f, r1 = 0.f, r2 = 0.f, r3 = 0.f;
          for (int u = 0; u < 8 * sg; u += 4) { r0 += *(const float*)(LW + SWF(u, j)); r1 += *(const float*)(LW + SWF(u + 1, j)); r2 += *(const float*)(LW + SWF(u + 2, j)); r3 += *(const float*)(LW + SWF(u + 3, j)); }
          float v8[8];
#pragma unroll
          for (int u = 0; u < 8; ++u) v8[u] = *(const float*)(LW + SWF(8 * sg + u, j));
          float run = (r0 + r1) + (r2 + r3);
#pragma unroll
          for (int u = 0; u < 8; ++u) { run += v8[u]; *(float*)(LC + SWF(8 * sg + u, j)) = run; }
          if (sg == 7) { LEND[j] = run; GC[j] = __expf(run); } }
        LBAR();
        { float Lc[8], sgp[8], le[8], o0[8], o1[8], o2[8], o3[8];
          ld8fs(LC, pt, j0, Lc); ld8f(LEND + j0, le);
#pragma unroll
          for (int e = 0; e < 8; ++e) { const float L = Lc[e]; const float e1 = __expf(L), ie1 = __expf(-L), ep = __expf(L - lwv[e]), eh = __expf(le[e] - L);
              o0[e] = an[e] * ep; o1[e] = bb[e] * ie1; o2[e] = k2[e] * ie1; o3[e] = rr[e] * e1; Lc[e] = bb[e] * eh; sgp[e] = k2[e] * eh; }
          st8bf(BUF(I_AT) + SW(pt, j0), o0); st8bf(BUF(I_BT) + SW(pt, j0), o1); st8bf(BUF(I_KT) + SW(pt, j0), o2); st8bf(BUF(I_RT) + SW(pt, j0), o3);
          st8bf(BUF(I_GATE) + SW(pt, j0), gg);
#pragma unroll
          for (int e = 0; e < 8; ++e) { *(unsigned short*)(BUF(I_AJ) + SW(j0 + e, pt)) = (unsigned short)f2bf(o0[e]); *(unsigned short*)(BUF(I_BHJ) + SW(j0 + e, pt)) = (unsigned short)f2bf(Lc[e]);
              *(unsigned short*)(BUF(I_KHJ) + SW(j0 + e, pt)) = (unsigned short)f2bf(sgp[e]); } }
        if (c > 0) *(v4u*)(ya + ypoff) = ypend;
        if (c + 1 < SEQ / 64) ZLOAD(c + 1);
        LBAR();
#define MASK(acc, cond) _Pragma("unroll") for (int nt = 0; nt < 2; ++nt) _Pragma("unroll") for (int r = 0; r < 4; ++r) { const int m_ = 16 * mt + 4 * fq + r, n_ = 16 * (2 * nh + nt) + fr; if (!(cond)) acc[nt][r] = 0.f; }
        { const f32x4 zero = {0.f, 0.f, 0.f, 0.f}; f32x4 aL[2] = {zero, zero}, aK[2] = {zero, zero}, aR[2] = {zero, zero};
          const FA fAT = ldA(BUF(I_AT), mt, fr, fq), fBTa = ldA(BUF(I_BT), mt, fr, fq); const FB fBT = ldB(BUF(I_BT), nh, fr, fq), fKT = ldB(BUF(I_KT), nh, fr, fq), fRT = ldB(BUF(I_RT), nh, fr, fq);
          mma(aL, fAT, fBT);
          mma(aK, fAT, fKT);
          mma(aR, fBTa, fRT);
          MASK(aL, m_ > n_) MASK(aK, n_ < m_) MASK(aR, m_ <= n_)
          storeN(BUF(I_L), aL, mt, nh, fr, fq); storeT(BUF(I_LT), aL, mt, nh, fr, fq);
#pragma unroll
          for (int nt = 0; nt < 2; ++nt)
#pragma unroll
              for (int r = 0; r < 4; ++r) { const int m_ = 16 * mt + 4 * fq + r, n_ = 16 * (2 * nh + nt) + fr; if (m_ == n_) aL[nt][r] = 1.0f; }
          storeN(BUF(I_R0), aL, mt, nh, fr, fq);
          storeT(BUF(aki), aK, mt, nh, fr, fq);
          storeT(BUF(I_ABRT), aR, mt, nh, fr, fq); }
        LBAR();
#pragma unroll
        for (int k = 1; k <= 6; ++k) {
            unsigned char* Pc = (k & 1) ? BUF(I_L) : BUF(I_AT); unsigned char* PTc = (k & 1) ? BUF(I_LT) : BUF(I_BT);
            unsigned char* Pn = (k & 1) ? BUF(I_AT) : BUF(I_L); unsigned char* PTn = (k & 1) ? BUF(I_BT) : BUF(I_LT);
            unsigned char* Rc = (k & 1) ? BUF(I_R1) : BUF(I_R0); unsigned char* Rn = (k & 1) ? BUF(I_R0) : BUF(I_R1);
            const f32x4 zero = {0.f, 0.f, 0.f, 0.f}; f32x4 aP[2] = {zero, zero}, aRr[2] = {zero, zero};
            FA fP, fPTa; FB fPT, fR;
            if (k <= 5) { fP = ldA(Pc, mt, fr, fq); fPT = ldB(PTc, nh, fr, fq); }
            if (k >= 2) { fPTa = ldA(PTc, mt, fr, fq); fR = ldB(Rc, nh, fr, fq); ldC(aRr, Rc, mt, nh, fr, fq); }
            if (k <= 5) mma(aP, fP, fPT);
            if (k >= 2) mma(aRr, fPTa, fR);
            if (k <= 5) { storeN(Pn, aP, mt, nh, fr, fq); storeT(PTn, aP, mt, nh, fr, fq); }
            if (k >= 2) storeT(Rn, aRr, mt, nh, fr, fq);
            LBAR();
        }
        { const f32x4 zero = {0.f, 0.f, 0.f, 0.f}; f32x4 a1[2] = {zero, zero}, a2[2] = {zero, zero};
          const FA fTT = ldA(BUF(I_R1), mt, fr, fq); const FB fAJ = ldB(BUF(I_AJ), nh, fr, fq), fAK = ldB(BUF(aki), nh, fr, fq);
          mma(a1, fTT, fAJ); mma(a2, fTT, fAK);
          storeT(BUF(I_L), a1, mt, nh, fr, fq);
          storeT(BUF(I_LT), a2, mt, nh, fr, fq); }
        LBAR();
        { const f32x4 zero = {0.f, 0.f, 0.f, 0.f}; f32x4 aMY[2], aNY[2] = {zero, zero}, aMS[2] = {zero, zero}, aNS[2];
          const FA fG1 = ldA(BUF(I_L), mt, fr, fq), fG2 = ldA(BUF(I_LT), mt, fr, fq), fKTa = ldA(BUF(I_KT), mt, fr, fq);
          const FB fAB = ldB(BUF(I_ABRT), nh, fr, fq), fRT = ldB(BUF(I_RT), nh, fr, fq), fBH = ldB(BUF(I_BHJ), nh, fr, fq);
          ldC(aMY, BUF(I_RT), mt, nh, fr, fq); ldC(aNS, BUF(I_KHJ), mt, nh, fr, fq);
          mma(aNY, fKTa, fRT);
          mma(aMY, fG1, fAB);
          mma(aMS, fG1, fBH);
          mma(aNS, fG2, fBH);
          MASK(aNY, m_ <= n_)
          mma(aNY, fG2, fAB);
#pragma unroll
          for (int nt = 0; nt < 2; ++nt)
#pragma unroll
              for (int r = 0; r < 4; ++r) { const int m_ = 16 * mt + 4 * fq + r, n_ = 16 * (2 * nh + nt) + fr; if (m_ == n_) aMS[nt][r] += GC[m_]; }
          storeT(BUF(I_AT), aMY, mt, nh, fr, fq); storeT(BUF(I_BT), aNY, mt, nh, fr, fq); storeT(BUF(I_AJ), aMS, mt, nh, fr, fq); storeT(BUF(I_R0), aNS, mt, nh, fr, fq); }
        LBAR();
        { const f32x4 zero = {0.f, 0.f, 0.f, 0.f}; f32x4 aY[2] = {zero, zero}, aS[2] = {zero, zero};
          const FA fS0a = ldA(BUF(s0i), mt, fr, fq), fVJa = ldA(BUF(I_VJ), mt, fr, fq), fMS = ldA(BUF(I_AJ), mt, fr, fq), fNS = ldA(BUF(I_R0), mt, fr, fq);
          const FB fMY = ldB(BUF(I_AT), nh, fr, fq), fNY = ldB(BUF(I_BT), nh, fr, fq), fS0 = ldB(BUF(s0i), nh, fr, fq), fVJ = ldB(BUF(I_VJ), nh, fr, fq);
          mma(aY, fS0a, fMY); mma(aS, fMS, fS0); mma(aY, fVJa, fNY); mma(aS, fNS, fVJ);
#pragma unroll
          for (int nt = 0; nt < 2; ++nt) *(f32x4*)(YTF + SWF(16 * (2 * nh + nt) + fr, 16 * mt + 4 * fq)) = aY[nt];
          storeT(BUF(aki), aS, mt, nh, fr, fq); }
        LBAR();
#undef MASK
        { float y[8], vv[8], g8[8], lg[8], lb[8]; ld8fs(YTF, pt, j0, y); ld8bf(BUF(I_VT) + SW(pt, j0), vv); ld8bf(BUF(I_GATE) + SW(pt, j0), g8);
          ld8f(CST + 12 * 64 + j0, lg); ld8f(CST + 13 * 64 + j0, lb);
          float sm = 0.f;
#pragma unroll
          for (int e = 0; e < 8; ++e) sm += y[e];
          const float mean = red8(sm) * (1.0f / 64.0f); float sq = 0.f;
#pragma unroll
          for (int e = 0; e < 8; ++e) { y[e] -= mean; sq += y[e] * y[e]; }
          const float rstd = rsqrtf(red8(sq) * (1.0f / 64.0f) + 64e-5f), bon = BON[pt];
#pragma unroll
          for (int e = 0; e < 8; ++e) y[e] = (y[e] * rstd * lg[e] + lb[e] + bon * vv[e]) * g8[e];
          ypend.x = pk2(y[0], y[1]); ypend.y = pk2(y[2], y[3]); ypend.z = pk2(y[4], y[5]); ypend.w = pk2(y[6], y[7]); ypoff = t * RWW + colh; }
        { const int tmp = s0i; s0i = aki; aki = tmp; }
        LBAR();
    }
    *(v4u*)(ya + ypoff) = ypend;
    LBAR();
#undef BUF
#undef ZLOAD
}
#undef LBAR
}

__device__ __forceinline__ void p_norm2_route(const PArgs& a, unsigned char* lds, int wv) {
    typedef short bf16x8 __attribute__((ext_vector_type(8)));
    const int tid = mktid(wv), lane = tid & 63, fr = lane & 15, fq = lane >> 4;
    const bf16* x1 = (const bf16*)(a.ws + WS_X1B); const float* mod = (const float*)(a.ws + WS_MOD); const float* gm2 = (const float*)(a.ws + WS_GM2); const float* cbt = (const float*)(a.ws + WS_CB);
    int* rte = (int*)(a.ws + WS_RTE); float* rtw = (float*)(a.ws + WS_RTW); int* rnk = (int*)(a.ws + WS_RNK); unsigned* cnt = (unsigned*)(a.ws + WS_CTL) + CW_CNT;
    float* PL = (float*)lds;
    float* PS = PL + 8 * 32 * 48;
    float* RS_ = PS + 8 * 32;
    float* FL = RS_ + 32;
    unsigned* HIST = (unsigned*)(FL + 32 * 48);
    unsigned* LRK = HIST + 32;
    if (tid < 32) HIST[tid] = 0u;
    __syncthreads();
    int gcount = 0;
    bf16x8 wh[4][3], wl[4][3];
    { const bf16* wrh = (const bf16*)(a.ws + WS_WRH) + fr * 1024 + 128 * wv + 8 * fq; const bf16* wrl = (const bf16*)(a.ws + WS_WRL) + fr * 1024 + 128 * wv + 8 * fq;
#pragma unroll
      for (int ks = 0; ks < 4; ++ks)
#pragma unroll
          for (int nt = 0; nt < 3; ++nt) { wh[ks][nt] = *(const bf16x8*)(wrh + nt * 16 * 1024 + 32 * ks); wl[ks][nt] = *(const bf16x8*)(wrl + nt * 16 * 1024 + 32 * ks); } }
    for (int grp = blockIdx.x; grp < NT / 32; grp += gridDim.x) {
        const int row0 = grp * 32, b = row0 >> 11;
        f32x4 acc[3][2];
#pragma unroll
        for (int nt = 0; nt < 3; ++nt) { acc[nt][0] = (f32x4){0.f, 0.f, 0.f, 0.f}; acc[nt][1] = acc[nt][0]; }
        float ssq[2] = {0.f, 0.f};
#pragma unroll
        for (int rt = 0; rt < 2; ++rt) {
            float xs[4][8];
#pragma unroll
            for (int ks = 0; ks < 4; ++ks) rw::ld8bf((const unsigned char*)(x1 + (size_t)(row0 + 16 * rt + fr) * DM + 128 * wv + 32 * ks + 8 * fq), xs[ks]);
#pragma unroll
            for (int ks = 0; ks < 4; ++ks) { float gm[8]; rw::ld8f(gm2 + b * 1024 + 128 * wv + 32 * ks + 8 * fq, gm); unsigned hw[4], lw[4];
#pragma unroll
                for (int e = 0; e < 4; ++e) { const float x0 = xs[ks][2 * e], x1v = xs[ks][2 * e + 1]; ssq[rt] += x0 * x0 + x1v * x1v; const float g0 = x0 * gm[2 * e], g1 = x1v * gm[2 * e + 1];
                    hw[e] = pk2(g0, g1); lw[e] = pk2(g0 - bflo(hw[e]), g1 - bfhi(hw[e])); }
                const v4u hv = {hw[0], hw[1], hw[2], hw[3]}, lv = {lw[0], lw[1], lw[2], lw[3]}; const bf16x8 bh = __builtin_bit_cast(bf16x8, hv), bl = __builtin_bit_cast(bf16x8, lv);
#pragma unroll
                for (int nt = 0; nt < 3; ++nt) { acc[nt][rt] = __builtin_amdgcn_mfma_f32_16x16x32_bf16(wh[ks][nt], bh, acc[nt][rt], 0, 0, 0); acc[nt][rt] = __builtin_amdgcn_mfma_f32_16x16x32_bf16(wl[ks][nt], bh, acc[nt][rt], 0, 0, 0);
                    acc[nt][rt] = __builtin_amdgcn_mfma_f32_16x16x32_bf16(wh[ks][nt], bl, acc[nt][rt], 0, 0, 0); } } }
#pragma unroll
        for (int rt = 0; rt < 2; ++rt) {
#pragma unroll
            for (int nt = 0; nt < 3; ++nt) *(f32x4*)(PL + (wv * 32 + 16 * rt + fr) * 48 + 16 * nt + 4 * fq) = acc[nt][rt];
            float s = ssq[rt]; s += __builtin_bit_cast(float, __builtin_amdgcn_ds_swizzle(__builtin_bit_cast(int, s), 0x401F));
            { const unsigned u = __builtin_bit_cast(unsigned, s); auto rr = __builtin_amdgcn_permlane32_swap(u, u, false, false); s = __builtin_bit_cast(float, (unsigned)rr[0]) + __builtin_bit_cast(float, (unsigned)rr[1]); }
            if (fq == 0) PS[wv * 32 + 16 * rt + fr] = s; }
        __syncthreads();
        { const int r = tid >> 4, c = tid & 15; float s0 = 0.f, s1 = 0.f, s2 = 0.f, sq = 0.f;
#pragma unroll
          for (int w = 0; w < 8; ++w) { const float* p = PL + (w * 32 + r) * 48; s0 += p[c]; s1 += p[c + 16]; s2 += p[c + 32]; sq += PS[w * 32 + r]; }
          const float rstd = rsqrtf(sq * (1.0f / DM) + 1e-6f); const float* cb = cbt + b * 48;
          FL[r * 48 + c] = rstd * s0 + cb[c]; FL[r * 48 + c + 16] = rstd * s1 + cb[c + 16]; FL[r * 48 + c + 32] = rstd * s2 + cb[c + 32];
          if (c == 0) ((float*)(a.ws + WS_RSTD))[row0 + r] = rstd; }
        __syncthreads();
        if (tid < 32) { const int m = row0 + tid; const float* lg = FL + tid * 48;
            int gi = 0; float gm = lg[0];
#pragma unroll
            for (int i = 1; i < 4; ++i) if (lg[i] > gm) { gm = lg[i]; gi = i; }
            float gs = 0.f;
#pragma unroll
            for (int i = 0; i < 4; ++i) gs += __expf(lg[i] - gm);
            const float pg = 1.0f / gs;
            float el[8];
#pragma unroll
            for (int k = 0; k < 8; ++k) el[k] = lg[4 + gi * 8 + k];
            int e1 = 0; float m1 = el[0];
#pragma unroll
            for (int k = 1; k < 8; ++k) if (el[k] > m1) { m1 = el[k]; e1 = k; }
            int e2 = -1; float m2 = -INFINITY;
#pragma unroll
            for (int k = 0; k < 8; ++k) if (k != e1 && el[k] > m2) { m2 = el[k]; e2 = k; }
            const float q2 = __expf(m2 - m1); const float w1 = pg / (1.0f + q2), w2 = pg * q2 / (1.0f + q2);
            const int ea = gi * 8 + e1, eb = gi * 8 + e2; rte[2 * m] = ea; rte[2 * m + 1] = eb; rtw[2 * m] = w1; rtw[2 * m + 1] = w2;
            LRK[gcount * 64 + 2 * tid] = atomicAdd(HIST + ea, 1u) | ((unsigned)ea << 24); LRK[gcount * 64 + 2 * tid + 1] = atomicAdd(HIST + eb, 1u) | ((unsigned)eb << 24); }
        ++gcount;
        __syncthreads();
    }
    if (tid < 32) { const unsigned n = HIST[tid]; HIST[tid] = n ? atomicAdd(cnt + tid * CNT_PAD, n) : 0u; }
    __syncthreads();
    for (int i = tid; i < gcount * 64; i += 512) { const int gi_ = i >> 6, e = i & 63; const int m2 = 2 * ((blockIdx.x + gi_ * gridDim.x) * 32) + e; const unsigned lr = LRK[i]; rnk[m2] = (int)(HIST[lr >> 24] + (lr & 0xffffffu)); }
    __syncthreads();
}
__device__ __forceinline__ void p_moe_gather(const PArgs& a, unsigned char* lds, int wv) {
    int* off = (int*)lds;
    const int tid = mktid(wv), lane = tid & 63, gw = blockIdx.x * 8 + (tid >> 6), NGW = gridDim.x * 8;
    int* ctl = (int*)(a.ws + WS_CTL); const unsigned* cnt = (const unsigned*)ctl + CW_CNT;
    if (tid == 0) { int o = 0, nt = 0;
        for (int e = 0; e < NEXP; ++e) { off[e] = o; const int tiles = ((int)cnt[e * CNT_PAD] + 255) >> 8;
            if (blockIdx.x == 0) for (int i = 0; i < tiles; ++i) ctl[CW_TEXP + nt + i] = e;
            nt += tiles; o += tiles * 256; }
        if (blockIdx.x == 0) ctl[CW_NT] = nt; }
    __syncthreads();
    const int* rte = (const int*)(a.ws + WS_RTE); const int* rnk = (const int*)(a.ws + WS_RNK); int* pos = (int*)(a.ws + WS_POS);
    const bf16* x1 = (const bf16*)(a.ws + WS_X1B); bf16* xs = (bf16*)(a.ws + WS_XS); const float* rstdv = (const float*)(a.ws + WS_RSTD);
    const float* mod = (const float*)(a.ws + WS_MOD); const float* gm2 = (const float*)(a.ws + WS_GM2);
    for (int t = gw; t < NT; t += NGW) { const int b = t >> 11; const int p0 = off[rte[2 * t]] + rnk[2 * t], p1 = off[rte[2 * t + 1]] + rnk[2 * t + 1]; if (lane == 0) { pos[2 * t] = p0; pos[2 * t + 1] = p1; }
        const float rstd = rstdv[t];
#pragma unroll
        for (int hf = 0; hf < 2; ++hf) { const int col = 8 * lane + 512 * hf; float xv[8], gm[8], sh[8], o[8];
            rw::ld8bf((const unsigned char*)(x1 + (size_t)t * DM + col), xv); rw::ld8f(gm2 + b * 1024 + col, gm); rw::ld8f(mod + b * 6144 + 3072 + col, sh);
#pragma unroll
            for (int e = 0; e < 8; ++e) o[e] = xv[e] * gm[e] * rstd + sh[e];
            v4u w; w.x = pk2(o[0], o[1]); w.y = pk2(o[2], o[3]); w.z = pk2(o[4], o[5]); w.w = pk2(o[6], o[7]);
            *(v4u*)(xs + (size_t)p0 * DM + col) = w; *(v4u*)(xs + (size_t)p1 * DM + col) = w; } }
}
__device__ __forceinline__ void p_combine(const PArgs& a, unsigned char* lds, int wv) {
    const int tid = mktid(wv), lane = tid & 63, gw = blockIdx.x * 8 + (tid >> 6), NGW = gridDim.x * 8;
    const float* mod = (const float*)(a.ws + WS_MOD); const int* pos = (const int*)(a.ws + WS_POS); const float* rtw = (const float*)(a.ws + WS_RTW);
    const bf16* ys = (const bf16*)(a.ws + WS_XS); float* out = a.out;
    for (int m = gw; m < NT; m += NGW) { const int b = m >> 11; const int p0 = pos[2 * m], p1 = pos[2 * m + 1]; const float w0 = rtw[2 * m], w1 = rtw[2 * m + 1];
        f32x4* o = (f32x4*)(out + (size_t)m * DM) + lane; const v2u* xb = (const v2u*)((const bf16*)(a.ws + WS_X1B) + (size_t)m * DM) + lane; const v2u* y0 = (const v2u*)(ys + (size_t)p0 * DM) + lane; const v2u* y1 = (const v2u*)(ys + (size_t)p1 * DM) + lane;
#pragma unroll
        for (int j = 0; j < 4; ++j) { const int col = 4 * (lane + 64 * j); const f32x4 g2 = *(const f32x4*)(mod + b * 6144 + 5120 + col); const v2u a0 = y0[64 * j], a1 = y1[64 * j];
            const f32x4 e0 = {bflo(a0.x), bfhi(a0.x), bflo(a0.y), bfhi(a0.y)}, e1 = {bflo(a1.x), bfhi(a1.x), bflo(a1.y), bfhi(a1.y)};
            const v2u xw = xb[64 * j]; const f32x4 xv = {bflo(xw.x), bfhi(xw.x), bflo(xw.y), bfhi(xw.y)};
            o[64 * j] = xv + g2 * (e0 * w0 + e1 * w1); } }
}

#define XB_TMO      128
#define XB_XCNT(j)  (256  + 64 * (j))
#define XB_XSUB(j)  (1280 + 64 * (j))
#define XB_XGEN(j)  (2304 + 64 * (j))
#define XB_TOP      3328
#define XB_TOPGEN   3392
#define XCD_BAR_WORDS 3456
#define XB_SPIN_CAP (1u << 22)

__device__ __forceinline__ unsigned xb_ld(unsigned* p)              { return __hip_atomic_load(p, __ATOMIC_RELAXED, __HIP_MEMORY_SCOPE_AGENT); }
__device__ __forceinline__ unsigned xb_add(unsigned* p, unsigned v) { return __hip_atomic_fetch_add(p, v, __ATOMIC_RELAXED, __HIP_MEMORY_SCOPE_AGENT); }
__device__ __forceinline__ unsigned xb_xcc_id() { return (unsigned)__builtin_amdgcn_s_getreg((3 << 11) | 20) & 0xFu; }
#define XB_SPIN(cond, bar) do { unsigned _sp = 0; while (cond) { __builtin_amdgcn_s_sleep(1); \
    if ((++_sp & 255u) == 0u) { if (xb_ld(&(bar)[XB_TMO])) break; if (_sp > XB_SPIN_CAP) { atomicAdd(&(bar)[XB_TMO], 1u); break; } } } } while (0)

struct XcdBarrier {
    unsigned* bar; unsigned x;
    volatile LAS unsigned* st;
};

__device__ __forceinline__ XcdBarrier xcd_barrier_post(unsigned* bar, volatile LAS unsigned* st, int wv) {
    XcdBarrier b; b.bar = bar; b.x = xb_xcc_id(); b.st = st;
    if (mktid(wv) == 0) (void)xb_add(&bar[XB_XCNT(b.x)], 1u);
    return b;
}
__device__ __forceinline__ void xcd_barrier_complete(unsigned* bar, unsigned x, unsigned& nloc, unsigned& nx) {
    const unsigned G = gridDim.x * gridDim.y * gridDim.z;
    unsigned sum, cnt, mine, sp = 0u;
    for (;;) {
        sum = 0u; cnt = 0u; mine = 0u;
#pragma unroll
        for (unsigned j = 0; j < 16; ++j) { const unsigned c = xb_ld(&bar[XB_XCNT(j)]); sum += c; cnt += (c > 0u) ? 1u : 0u; mine = (j == x) ? c : mine; }
        if (sum == G) break;
        __builtin_amdgcn_s_sleep(1);
        if ((++sp & 255u) == 0u) { if (xb_ld(&bar[XB_TMO])) break; if (sp > XB_SPIN_CAP) { atomicAdd(&bar[XB_TMO], 1u); break; } }
    }
    nloc = mine > 0u ? mine : 1u; nx = cnt > 0u ? cnt : 1u;
}

__device__ __forceinline__ void xcd_barrier(const XcdBarrier& b, int wv) {
    asm volatile("s_waitcnt vmcnt(0)" ::: "memory");
    __syncthreads();
    if (mktid(wv) == 0) {
        unsigned* bar = b.bar;
        __builtin_amdgcn_s_waitcnt(0);
        unsigned nloc = b.st[0], nx = b.st[1];
        if (nloc == 0u) { xcd_barrier_complete(bar, b.x, nloc, nx); b.st[0] = nloc; b.st[1] = nx; }
        const unsigned old = xb_add(&bar[XB_XSUB(b.x)], 1u);
        const unsigned gen = old / nloc;
        if (old + 1u == (gen + 1u) * nloc) {
            __builtin_amdgcn_fence(__ATOMIC_RELEASE, "agent");
            asm volatile("s_waitcnt vmcnt(0)" ::: "memory");
            const unsigned og = xb_add(&bar[XB_TOP], 1u);
            const unsigned tg = og / nx;
            if (og + 1u == (tg + 1u) * nx) xb_add(&bar[XB_TOPGEN], 1u);
            else XB_SPIN(xb_ld(&bar[XB_TOPGEN]) == tg, bar);
            __builtin_amdgcn_fence(__ATOMIC_ACQUIRE, "agent");
            xb_add(&bar[XB_XGEN(b.x)], 1u);
            asm volatile("s_waitcnt vmcnt(0)" ::: "memory");
        } else {
            XB_SPIN(xb_ld(&bar[XB_XGEN(b.x)]) == gen, bar);
            __builtin_amdgcn_fence(__ATOMIC_ACQUIRE, "agent");
            asm volatile("s_waitcnt vmcnt(0)" ::: "memory");
        }
    }
    __syncthreads();
}

constexpr int LDS_BYTES = 160 * 1024, MISC_OFF = LDS_BYTES - 256;
static_assert(rw::LDS_NEED <= MISC_OFF, "scan LDS");
constexpr int CW_BAR = 4096;

__global__ void __launch_bounds__(512, 2) mega_fwd(PArgs a) {
    extern __shared__ __attribute__((aligned(16))) unsigned char lds[];
    volatile LAS unsigned* MISC = (volatile LAS unsigned*)((LAS unsigned char*)lds + MISC_OFF);
    const int wv = __builtin_amdgcn_readfirstlane((int)threadIdx.x >> 6);
    { const int t0 = mktid(wv); if (t0 < 64) MISC[t0] = 0u; }
    __syncthreads();
    XcdBarrier bar = xcd_barrier_post((unsigned*)(a.ws + WS_CTL) + CW_BAR, MISC + 8, wv);
    GemmArgs g; g.ws = a.ws; g.x = a.in[0]; g.out = a.out; g.qg = a.in[18]; g.kg = a.in[19];
    const int G = (int)gridDim.x, bx = (int)blockIdx.x;

    p_prep_weights(a, lds, wv); __syncthreads(); p_ada(a, lds, wv);
    xcd_barrier(bar, wv);
    p_norm1(a, lds, wv);
    xcd_barrier(bar, wv);
    p_gemm_in(g, lds, wv);
    xcd_barrier(bar, wv);
    { const int nscan = G / 2;
      if (bx < nscan) { for (int bh = bx; bh < 128; bh += nscan) rw::scan_unit(a, lds, bh, wv); }
      else { p_attn(a, lds, bx - nscan, G - nscan, wv); __syncthreads(); p_prep_experts_up(a, lds, wv, bx - nscan, G - nscan); } }
    xcd_barrier(bar, wv);
    p_gemm_merge(g, lds, wv);
    xcd_barrier(bar, wv);
    p_gemm_out(g, lds, wv);
    xcd_barrier(bar, wv);
    p_norm2_route(a, lds, wv);
    xcd_barrier(bar, wv);
    p_moe_gather(a, lds, wv);
    xcd_barrier(bar, wv);
    p_gemm_up(g, lds, wv);
    xcd_barrier(bar, wv);
    p_gemm_down(g, lds, wv);
    xcd_barrier(bar, wv);
    p_combine(a, lds, wv);
}

extern "C" void kernel_launch(void* const* d_in, const int* in_sizes, int n_in, void* d_out, int out_size, void* d_ws, size_t ws_size, hipStream_t stream) {
    static int grid = 0;
    if (grid == 0) {
        if (n_in != 30 || out_size != NT * DM || ws_size < WS_END) { fprintf(stderr, "kernel_launch: unexpected shapes (n_in %d, out %d, ws %zu)\n", n_in, out_size, ws_size); grid = -1; return; }
        int dev = 0, cus = 0, per_cu = 0;
        if (hipGetDevice(&dev) != hipSuccess || hipDeviceGetAttribute(&cus, hipDeviceAttributeMultiprocessorCount, dev) != hipSuccess) { grid = -1; return; }
        if (hipFuncSetAttribute((const void*)mega_fwd, hipFuncAttributeMaxDynamicSharedMemorySize, LDS_BYTES) != hipSuccess) { fprintf(stderr, "kernel_launch: hipFuncSetAttribute failed\n"); grid = -1; return; }
        if (hipOccupancyMaxActiveBlocksPerMultiprocessor(&per_cu, (const void*)mega_fwd, 512, LDS_BYTES) != hipSuccess || per_cu < 1) { fprintf(stderr, "kernel_launch: occupancy query says %d blocks per CU\n", per_cu); (void)hipGetLastError(); grid = -1; return; }
        grid = cus;
    }
    if (grid < 0) return;
    (void)hipMemsetAsync((char*)d_ws + WS_CTL, 0, 65536, stream);
    PArgs p{}; for (int i = 0; i < 30; ++i) p.in[i] = (const float*)d_in[i]; p.out = (float*)d_out; p.ws = (unsigned char*)d_ws;
    hipLaunchKernelGGL(mega_fwd, dim3(grid), dim3(512), LDS_BYTES, stream, p);
}
```

```cpp
#include <hip/hip_runtime.h>
#include <cstdio>
#include <cstdint>
__device__ __forceinline__ int mktid(int wv) { int l; asm volatile("v_mbcnt_lo_u32_b32 %0, -1, 0\n\tv_mbcnt_hi_u32_b32 %0, -1, %0" : "=v"(l)); return (wv << 6) | l; }
template <int CTRL> __device__ __forceinline__ float dppf(float v) { return __builtin_bit_cast(float, __builtin_amdgcn_update_dpp(0, __builtin_bit_cast(int, v), CTRL, 0xF, 0xF, true)); }
__device__ __forceinline__ float red4(float v) { v += dppf<0xB1>(v); v += dppf<0x4E>(v); return v; }
__device__ __forceinline__ float red8(float v) { v = red4(v); v += dppf<0x141>(v); return v; }
__device__ __forceinline__ float red16(float v) { v = red8(v); v += dppf<0x140>(v); return v; }
__device__ __forceinline__ float wave_sum(float v) { v = red16(v);
    v += __builtin_bit_cast(float, __builtin_amdgcn_ds_swizzle(__builtin_bit_cast(int, v), 0x401F));
    const unsigned u = __builtin_bit_cast(unsigned, v); auto rr = __builtin_amdgcn_permlane32_swap(u, u, false, false);
    return __builtin_bit_cast(float, (unsigned)rr[0]) + __builtin_bit_cast(float, (unsigned)rr[1]); }
__device__ __forceinline__ void wave_sum8(float (&v)[8]) {
#pragma unroll
    for (int i = 0; i < 8; ++i) v[i] += dppf<0xB1>(v[i]);
#pragma unroll
    for (int i = 0; i < 8; ++i) v[i] += dppf<0x4E>(v[i]);
#pragma unroll
    for (int i = 0; i < 8; ++i) v[i] += dppf<0x141>(v[i]);
#pragma unroll
    for (int i = 0; i < 8; ++i) v[i] += dppf<0x140>(v[i]);
#pragma unroll
    for (int i = 0; i < 8; ++i) v[i] += __builtin_bit_cast(float, __builtin_amdgcn_ds_swizzle(__builtin_bit_cast(int, v[i]), 0x401F));
#pragma unroll
    for (int i = 0; i < 8; ++i) { const unsigned u = __builtin_bit_cast(unsigned, v[i]); auto rr = __builtin_amdgcn_permlane32_swap(u, u, false, false); v[i] = __builtin_bit_cast(float, (unsigned)rr[0]) + __builtin_bit_cast(float, (unsigned)rr[1]); }
}
__device__ __forceinline__ float lane_get(float v, int src) { return __builtin_bit_cast(float, __builtin_amdgcn_ds_bpermute(src << 2, __builtin_bit_cast(int, v))); }
namespace pg8 {
#define PG8_LAS __attribute__((address_space(3)))
typedef unsigned short bf16_t;
typedef short bf16x8 __attribute__((ext_vector_type(8)));
typedef float f32x4 __attribute__((ext_vector_type(4)));
typedef unsigned u32x4 __attribute__((ext_vector_type(4)));
constexpr int BM = 256, BK = 64, HALF = 128, HTB = HALF * BK * 2  , STAGE_BYTES = 8 * HTB, NXCD = 8, WGM = 8;

__host__ __device__ __forceinline__ int lds_byte(int r, int c) { const int st = (r >> 4) * 2 + (c >> 5), rr = r & 15, cc = c & 31, ob = rr * 64 + cc * 2; return st * 1024 + (ob ^ (((ob >> 9) & 1) << 5)); }
__host__ __device__ __forceinline__ void stage_rc(int b, int& R, int& C) { const int st = b / 1024, sb = b % 1024, swz = sb ^ (((sb >> 9) & 1) << 5); R = (st >> 1) * 16 + swz / 64; C = (st & 1) * 32 + (swz % 64) / 2; }
__host__ __device__ __forceinline__ int perm32(int rho) { const int n = rho >> 4, i = rho & 15; return 8 * (i >> 2) + 4 * n + (i & 3); }
struct Unit { int pm, pn, aux; const char* a; const char* b; };
struct Gemm { int K; };

struct StaticOrder {
    int nM, nN, nwg, G, c; const char* A; const char* Bt; size_t tstep;
    __device__ void init(const void* A_, const void* Bt_, int M, int N, int K, int G_, int c_) { nM = M / BM; nN = N / BM; nwg = nM * nN; G = G_; c = c_; A = (const char*)A_; Bt = (const char*)Bt_; tstep = (size_t)BM * K * 2; }
    __device__ bool next(int i, Unit& u) const {
        const long L = (long)i * G + c; if (L >= nwg) return false;
        int wgid = (int)L; { const int q = nwg / NXCD, r = nwg % NXCD, xcd = wgid % NXCD, off = wgid / NXCD; wgid = (xcd < r ? xcd * (q + 1) : r * (q + 1) + (xcd - r) * q) + off; }
        const int nig = WGM * nN, gid = wgid / nig, fm = gid * WGM, gsz = (nM - fm) < WGM ? (nM - fm) : WGM;
        u.aux = 0; u.pm = fm + ((wgid % nig) % gsz); u.pn = (wgid % nig) / gsz; u.a = A + (size_t)u.pm * tstep; u.b = Bt + (size_t)u.pn * tstep; return true;
    }
    __device__ __forceinline__ void a_ready(const Unit&) const {}
    __device__ __forceinline__ void done(const Unit&) const {}
};
__device__ __forceinline__ unsigned cvt_pk_bf16(float lo, float hi) { unsigned r; asm volatile("v_cvt_pk_bf16_f32 %0, %1, %2" : "=v"(r) : "v"(lo), "v"(hi)); return r; }
template <class Epi, class Sched, bool ALIGN_EPI = false, bool SP2 = false>
__device__ __forceinline__ void gemm_phase(PG8_LAS unsigned char* lds, const Gemm g, const Sched& S, const Epi& E, int wv) {
    const int tid = mktid(wv), wid = __builtin_amdgcn_readfirstlane(tid >> 6), lane = tid & 63, wr = wid >> 2, wc = wid & 3, fr = lane & 15, fq = lane >> 4;
    const int K = g.K, nt = K / BK;
    unsigned voffA[2], voffB[2];
#pragma unroll
    for (int i = 0; i < 2; ++i) { int R, C; stage_rc(tid * 16 + i * 8192, R, C); const int Rb = Epi::PERM ? ((R & ~31) + perm32(R & 31)) : R;
        voffA[i] = (unsigned)(R * K + C) * 2u; voffB[i] = (unsigned)(Rb * K + C) * 2u; }
    const size_t kstep = (size_t)(BK * 2);
    const size_t hstep = (size_t)HALF * K * 2;
        const unsigned ldsw = (unsigned)wid * 1024u;
    const int aoff = lds_byte(wr * 64 + fr, fq * 8), boff = lds_byte(wc * 32 + fr, fq * 8);
#define PG8_SA(b, h) (((b) * 2 + (h)) * HTB)
#define PG8_SB(b, h) ((4 + (b) * 2 + (h)) * HTB)
#define PG8_STAGE(bufoff, gbase, voff) do { _Pragma("unroll") for (int _i = 0; _i < 2; ++_i) \
        __builtin_amdgcn_global_load_lds((const unsigned*)((const char*)(gbase) + (voff)[_i]), (PG8_LAS unsigned*)(lds + (bufoff) + ldsw + _i * 8192), 16, 0, 0); } while (0)
#define PG8_LDA(dst, b, h) do { _Pragma("unroll") for (int m = 0; m < 4; ++m) _Pragma("unroll") for (int k = 0; k < 2; ++k) dst[m][k] = *(const PG8_LAS bf16x8*)(lds + PG8_SA(b, h) + aoff + m * 2048 + k * 1024); } while (0)
#define PG8_LDB(dst, b, h) do { _Pragma("unroll") for (int n = 0; n < 2; ++n) _Pragma("unroll") for (int k = 0; k < 2; ++k) dst[n][k] = *(const PG8_LAS bf16x8*)(lds + PG8_SB(b, h) + boff + n * 2048 + k * 1024); } while (0)
#define PG8_MMA(ai, bj, At, Bt) do { __builtin_amdgcn_s_setprio(1); _Pragma("unroll") for (int m = 0; m < 4; ++m) _Pragma("unroll") for (int n = 0; n < 2; ++n) _Pragma("unroll") for (int k = 0; k < 2; ++k) \
        acc[ai][bj][m][n] = __builtin_amdgcn_mfma_f32_16x16x32_bf16(Bt[n][k], At[m][k], acc[ai][bj][m][n], 0, 0, 0); __builtin_amdgcn_s_setprio(0); } while (0)
#define PG8_WAIT_V(n) asm volatile("s_waitcnt vmcnt(" #n ")" ::: "memory")
#define PG8_WAIT_L(n) asm volatile("s_waitcnt lgkmcnt(" #n ")" ::: "memory")
#define PG8_BAR __builtin_amdgcn_s_barrier()
#define PG8_SCHED __builtin_amdgcn_sched_barrier(0)
    Unit cur, nxt; int ui = 0;
    if (!S.next(0, cur)) return;
    f32x4 acc[2][2][4][2];
#pragma unroll
    for (int a = 0; a < 2; ++a)
#pragma unroll
        for (int b = 0; b < 2; ++b)
#pragma unroll
            for (int m = 0; m < 4; ++m)
#pragma unroll
                for (int n = 0; n < 2; ++n) acc[a][b][m][n] = (f32x4){0.f, 0.f, 0.f, 0.f};
    bf16x8 At[4][2], B0[2][2], B1[2][2];
    const char* cA = cur.a; const char* cB = cur.b;
    S.a_ready(cur);
    if constexpr (SP2) {
        PG8_STAGE(PG8_SB(0, 0), cB, voffB); PG8_STAGE(PG8_SB(0, 1), cB + hstep, voffB); PG8_STAGE(PG8_SA(0, 0), cA, voffA); PG8_STAGE(PG8_SA(0, 1), cA + hstep, voffA);
        if (wr == 1) PG8_BAR;
        PG8_WAIT_V(2); PG8_BAR;
        PG8_STAGE(PG8_SB(1, 0), cB + kstep, voffB); PG8_STAGE(PG8_SA(1, 0), cA + kstep, voffA); PG8_STAGE(PG8_SB(1, 1), cB + hstep + kstep, voffB);
        PG8_WAIT_V(6); PG8_BAR;
    } else {
        PG8_STAGE(PG8_SB(0, 0), cB, voffB); PG8_STAGE(PG8_SA(0, 0), cA, voffA); PG8_STAGE(PG8_SB(0, 1), cB + hstep, voffB); PG8_STAGE(PG8_SA(0, 1), cA + hstep, voffA);
        if (wr == 1) PG8_BAR;
        PG8_WAIT_V(4); PG8_BAR;
        PG8_STAGE(PG8_SB(1, 0), cB + kstep, voffB); PG8_STAGE(PG8_SA(1, 0), cA + kstep, voffA); PG8_STAGE(PG8_SB(1, 1), cB + hstep + kstep, voffB);
        PG8_WAIT_V(6); PG8_BAR;
    }
    for (;;) {
        const bool has_next = S.next(ui + 1, nxt);
        const char* nA = has_next ? nxt.a : cA; const char* nB = has_next ? nxt.b : cB;
        for (int t = 0; t < nt; t += 2) {
            const bool last = (t == nt - 2);
            const char* a1 = cA + (size_t)(t + 1) * kstep;
            const char* a2 = last ? nA : cA + (size_t)(t + 2) * kstep; const char* b2 = last ? nB : cB + (size_t)(t + 2) * kstep;
            const char* a3 = a2 + kstep; const char* b3 = b2 + kstep;
            if (last && has_next) S.a_ready(nxt);
            if constexpr (SP2) {
            PG8_LDB(B0, 0, 0); PG8_LDB(B1, 0, 1); PG8_SCHED; PG8_LDA(At, 0, 0); PG8_STAGE(PG8_SA(1, 1), a1 + hstep, voffA);
            PG8_WAIT_V(8); PG8_WAIT_L(0); PG8_BAR; PG8_MMA(0, 0, At, B0); PG8_MMA(0, 1, At, B1); PG8_BAR; PG8_SCHED;
            PG8_LDA(At, 0, 1); PG8_STAGE(PG8_SB(0, 0), b2, voffB); PG8_STAGE(PG8_SB(0, 1), b2 + hstep, voffB); PG8_STAGE(PG8_SA(0, 0), a2, voffA);
            PG8_WAIT_V(8); PG8_WAIT_L(0); PG8_BAR; PG8_MMA(1, 0, At, B0); PG8_MMA(1, 1, At, B1); PG8_BAR; PG8_SCHED;
            PG8_LDB(B0, 1, 0); PG8_LDB(B1, 1, 1); PG8_SCHED; PG8_LDA(At, 1, 0); PG8_STAGE(PG8_SA(0, 1), a2 + hstep, voffA);
            PG8_WAIT_V(8); PG8_WAIT_L(0); PG8_BAR; PG8_MMA(0, 0, At, B0); PG8_MMA(0, 1, At, B1); PG8_BAR; PG8_SCHED;
            PG8_LDA(At, 1, 1); PG8_STAGE(PG8_SB(1, 0), b3, voffB); PG8_STAGE(PG8_SB(1, 1), b3 + hstep, voffB); PG8_STAGE(PG8_SA(1, 0), a3, voffA);
            PG8_WAIT_V(8); PG8_WAIT_L(0); PG8_BAR; PG8_MMA(1, 0, At, B0); PG8_MMA(1, 1, At, B1); PG8_BAR; PG8_SCHED;
            } else {
            PG8_LDB(B0, 0, 0); PG8_SCHED; PG8_LDA(At, 0, 0); PG8_STAGE(PG8_SA(1, 1), a1 + hstep, voffA);
            PG8_WAIT_L(8); PG8_BAR; PG8_WAIT_L(0); PG8_MMA(0, 0, At, B0); PG8_BAR; PG8_SCHED;
            PG8_LDB(B1, 0, 1); PG8_STAGE(PG8_SB(0, 0), b2, voffB);
            PG8_BAR; PG8_WAIT_L(0); PG8_MMA(0, 1, At, B1); PG8_BAR;
            PG8_LDA(At, 0, 1); PG8_STAGE(PG8_SA(0, 0), a2, voffA);
            PG8_BAR; PG8_WAIT_L(0); PG8_MMA(1, 0, At, B0); PG8_BAR; PG8_SCHED;
            PG8_STAGE(PG8_SB(0, 1), b2 + hstep, voffB);
            PG8_WAIT_V(6); PG8_BAR; PG8_MMA(1, 1, At, B1); PG8_BAR;
            PG8_LDB(B0, 1, 0); PG8_SCHED; PG8_LDA(At, 1, 0); PG8_STAGE(PG8_SA(0, 1), a2 + hstep, voffA);
            PG8_WAIT_L(8); PG8_BAR; PG8_WAIT_L(0); PG8_MMA(0, 0, At, B0); PG8_BAR; PG8_SCHED;
            PG8_LDB(B1, 1, 1); PG8_STAGE(PG8_SB(1, 0), b3, voffB);
            PG8_BAR; PG8_WAIT_L(0); PG8_MMA(0, 1, At, B1); PG8_BAR;
            PG8_LDA(At, 1, 1); PG8_STAGE(PG8_SA(1, 0), a3, voffA);
            PG8_BAR; PG8_WAIT_L(0); PG8_MMA(1, 0, At, B0); PG8_BAR; PG8_SCHED;
            PG8_STAGE(PG8_SB(1, 1), b3 + hstep, voffB);
            PG8_WAIT_V(6); PG8_BAR; PG8_MMA(1, 1, At, B1); PG8_BAR;
            }
        }
        if constexpr (ALIGN_EPI) { if (wr == 0) PG8_BAR; }
        bool keep = false;
        if constexpr (!Epi::AFTER_DRAIN) { if constexpr (Epi::CHAIN) keep = E.chain(acc, cur, wr, wc, fr, fq); else E(acc, cur, wr, wc, fr, fq); S.done(cur); }
        if (!has_next) break;
        if (!keep) {
#pragma unroll
        for (int a = 0; a < 2; ++a)
#pragma unroll
            for (int b = 0; b < 2; ++b)
#pragma unroll
                for (int m = 0; m < 4; ++m)
#pragma unroll
                    for (int n = 0; n < 2; ++n) acc[a][b][m][n] = (f32x4){0.f, 0.f, 0.f, 0.f};
        }
        cur = nxt; cA = nA; cB = nB; ++ui;
        if constexpr (ALIGN_EPI) { if (wr == 1) PG8_BAR; }
    }
    PG8_WAIT_V(0);
    if constexpr (!ALIGN_EPI) { if (wr == 0) PG8_BAR; }
    PG8_BAR;
    if constexpr (Epi::AFTER_DRAIN) { E.fused(acc, cur, wr, wc, fr, fq, lds, wid, lane); S.done(cur); }
#undef PG8_SA
#undef PG8_SB
#undef PG8_STAGE
#undef PG8_LDA
#undef PG8_LDB
#undef PG8_MMA
#undef PG8_WAIT_V
#undef PG8_WAIT_L
#undef PG8_BAR
#undef PG8_SCHED
}
}
#include <hip/hip_bf16.h>
#include <cmath>
namespace attn_body {
using bf16=__hip_bfloat16;
using bf16x8=__attribute__((ext_vector_type(8)))short;
using s16x4=__attribute__((ext_vector_type(4)))short;
using f32x16=__attribute__((ext_vector_type(16)))float;
using u32x4=__attribute__((ext_vector_type(4)))unsigned;
constexpr int NHEAD=8,SEQ=2048,D=64,PQ=512,PK=512,PV=4352,PO=512;
constexpr int NW=8,QBLK=32,QB=QBLK*NW,KVBLK=64,NQB=SEQ/QB;
__device__ __forceinline__ int crow(int r,int hi){return (r&3)+8*(r>>2)+4*hi;}
#define SBAR() __builtin_amdgcn_sched_barrier(0)
__device__ __forceinline__ void cmask(f32x16&p0,f32x16&p1,int jb,int qrel,int hi){
  const float NEG=-INFINITY; int kb=64*jb+4*hi;
  #pragma unroll
  for(int r=0;r<16;++r){int kv=kb+(r&3)+8*(r>>2); if(kv>qrel)p0[r]=NEG; if(kv+32>qrel)p1[r]=NEG;}
}

constexpr int NSLOT=3, SLOTB=8192;
constexpr int LDS_K=0, LDS_V=NSLOT*SLOTB, LDS_WS=2*NSLOT*SLOTB, LDS_OST=LDS_WS+NW*64*4, LDS_SEL=LDS_OST+NW*4096, LDS_KM=LDS_SEL+256, LDS_KP=LDS_KM+7*64*4, LDS_BYTES=LDS_KP+8*64*4;
constexpr float C2=0.125f*1.4426950408889634f;
__device__ __forceinline__ void glds16(const void*gsrc,unsigned lds_dst){unsigned keep;
  asm volatile("s_mov_b32 %0, m0\n\ts_mov_b32 m0, %2\n\ts_nop 0\n\tglobal_load_lds_dwordx4 %1, off\n\ts_mov_b32 m0, %0":"=&s"(keep):"v"(gsrc),"s"(lds_dst):"memory");}
__device__ __forceinline__ float max3f(float a,float b,float c){float r;asm("v_max3_f32 %0, %1, %2, %3":"=v"(r):"v"(a),"v"(b),"v"(c));return r;}
__device__ __forceinline__ float max2f(float a,float b){float r;asm("v_max_f32_e32 %0, %1, %2":"=v"(r):"v"(a),"v"(b));return r;}
__device__ __forceinline__ float fadd_s(float a,float b){float r;asm("v_add_f32_e32 %0, %1, %2":"=v"(r):"v"(a),"v"(b));return r;}
__device__ __forceinline__ float fsub_s(float a,float b){float r;asm("v_sub_f32_e32 %0, %1, %2":"=v"(r):"v"(a),"v"(b));return r;}
typedef float f32x2_t __attribute__((ext_vector_type(2))); typedef __bf16 bf16x2_t __attribute__((ext_vector_type(2)));
__device__ __forceinline__ unsigned cvtpk_s(float lo,float hi){f32x2_t v={lo,hi};bf16x2_t b=__builtin_convertvector(v,bf16x2_t);return __builtin_bit_cast(unsigned,b);}
#define WAIT_BAR(N) asm volatile("s_waitcnt vmcnt(" #N ") lgkmcnt(0)\n\ts_barrier":::"memory")

__device__ __forceinline__ void qkt(f32x16&p0,f32x16&p1,const char*Kslot,const bf16x8*qr,const f32x16&negm,int r32,int hi){
  const char*kb=Kslot+hi*1024+r32*16;
  #pragma unroll
  for(int d0=0;d0<4;++d0){
    const bf16x8 b0=*reinterpret_cast<const bf16x8*>(kb+d0*2048);
    const bf16x8 b1=*reinterpret_cast<const bf16x8*>(kb+d0*2048+512);
    if(d0==0){p0=__builtin_amdgcn_mfma_f32_32x32x16_bf16(b0,qr[0],negm,0,0,0);p1=__builtin_amdgcn_mfma_f32_32x32x16_bf16(b1,qr[0],negm,0,0,0);}
    else{p0=__builtin_amdgcn_mfma_f32_32x32x16_bf16(b0,qr[d0],p0,0,0,0);p1=__builtin_amdgcn_mfma_f32_32x32x16_bf16(b1,qr[d0],p1,0,0,0);}}
}
typedef __attribute__((address_space(3))) const char* lds_cptr;
typedef short v4i16_t __attribute__((ext_vector_type(4)));
__device__ __forceinline__ void kload8(bf16x8*kf,lds_cptr kp){
  kf[0]=*(const __attribute__((address_space(3))) bf16x8*)(kp);      kf[1]=*(const __attribute__((address_space(3))) bf16x8*)(kp+512);
  kf[2]=*(const __attribute__((address_space(3))) bf16x8*)(kp+2048); kf[3]=*(const __attribute__((address_space(3))) bf16x8*)(kp+2560);
  kf[4]=*(const __attribute__((address_space(3))) bf16x8*)(kp+4096); kf[5]=*(const __attribute__((address_space(3))) bf16x8*)(kp+4608);
  kf[6]=*(const __attribute__((address_space(3))) bf16x8*)(kp+6144); kf[7]=*(const __attribute__((address_space(3))) bf16x8*)(kp+6656);
}
__device__ __forceinline__ void kload2(bf16x8*kf,lds_cptr kp,int j){ kf[2*j]=*(const __attribute__((address_space(3))) bf16x8*)(kp+j*2048); kf[2*j+1]=*(const __attribute__((address_space(3))) bf16x8*)(kp+j*2048+512); }
__device__ __forceinline__ s16x4 vtr(lds_cptr p){ return __builtin_bit_cast(s16x4,__builtin_amdgcn_ds_read_tr16_b64_v4i16((__attribute__((address_space(3))) v4i16_t*)p)); }
__device__ __forceinline__ float rowmax(const f32x16&p0,const f32x16&p1){
  float a=max3f(p0[0],p0[1],p1[0]),b=max3f(p0[2],p0[3],p1[1]);a=max3f(a,p1[2],p1[3]);
  #pragma unroll
  for(int r=4;r<16;r+=4){a=max3f(a,p0[r],p0[r+1]);b=max3f(b,p0[r+2],p0[r+3]);a=max3f(a,p1[r],p1[r+1]);b=max3f(b,p1[r+2],p1[r+3]);}
  const float m=max2f(a,b);
  auto rr=__builtin_amdgcn_permlane32_swap(__float_as_uint(m),__float_as_uint(m),false,false);
  return max2f(__uint_as_float(rr[0]),__uint_as_float(rr[1]));
}
__device__ __forceinline__ void pv(f32x16*o,int vb,bf16x8 pa0,bf16x8 pa1,bf16x8 pa2,bf16x8 pa3){
  #pragma unroll
  for(int d0=0;d0<2;++d0){s16x4 lo[4],hi[4];
    #pragma unroll
    for(int ks=0;ks<4;++ks){
      asm volatile("ds_read_b64_tr_b16 %0,%1 offset:%c2":"=&v"(lo[ks]):"v"(vb),"i"(d0*4096+ks*1024):"memory");
      asm volatile("ds_read_b64_tr_b16 %0,%1 offset:%c2":"=&v"(hi[ks]):"v"(vb),"i"(d0*4096+ks*1024+512):"memory");}
    asm volatile("s_waitcnt lgkmcnt(0)":::"memory");SBAR();
    #define PK(k) (bf16x8){lo[k][0],lo[k][1],lo[k][2],lo[k][3],hi[k][0],hi[k][1],hi[k][2],hi[k][3]}
    o[d0]=__builtin_amdgcn_mfma_f32_32x32x16_bf16(pa0,PK(0),o[d0],0,0,0);
    o[d0]=__builtin_amdgcn_mfma_f32_32x32x16_bf16(pa1,PK(1),o[d0],0,0,0);
    o[d0]=__builtin_amdgcn_mfma_f32_32x32x16_bf16(pa2,PK(2),o[d0],0,0,0);
    o[d0]=__builtin_amdgcn_mfma_f32_32x32x16_bf16(pa3,PK(3),o[d0],0,0,0);
    #undef PK
  }
}

#ifndef ATTN_STORE16
#define ATTN_STORE16(p,v) (*(u32x4*)(p)=(v))
#endif
template<int THRL> __device__ __forceinline__ void attn_unit(int b,int h,int qb,const bf16*Q,const bf16*__restrict__ K,const bf16*__restrict__ V,bf16*O,char*shm,int wv){
  const int tid=mktid(wv),lane=tid&63,r32=lane&31,hi=lane>>5;     const int wid=__builtin_amdgcn_readfirstlane(tid>>6);
  const long rowbase=(long)b*SEQ; const int q0=qb*QB;
  if(qb>3){ float*KMl=(float*)(shm+LDS_KM); float*KPl=(float*)(shm+LDS_KP); const int c8=tid&7, rl=tid>>3;
    for(int n=0;n<qb;++n){ float sm[8];
      #pragma unroll
      for(int d=0;d<8;++d)sm[d]=0.f;
      #pragma unroll
      for(int rr=0;rr<4;++rr){ const u32x4 w=*reinterpret_cast<const u32x4*>(K+(rowbase+n*256+rl+64*rr)*PK+h*D+8*c8);
        sm[0]+=__uint_as_float(w[0]<<16);sm[1]+=__uint_as_float(w[0]&0xffff0000u);sm[2]+=__uint_as_float(w[1]<<16);sm[3]+=__uint_as_float(w[1]&0xffff0000u);
        sm[4]+=__uint_as_float(w[2]<<16);sm[5]+=__uint_as_float(w[2]&0xffff0000u);sm[6]+=__uint_as_float(w[3]<<16);sm[7]+=__uint_as_float(w[3]&0xffff0000u); }
      #pragma unroll
      for(int d=0;d<8;++d){ float v=sm[d];
        v+=__builtin_bit_cast(float,__builtin_amdgcn_ds_swizzle(__builtin_bit_cast(int,v),0x201F));
        v+=__builtin_bit_cast(float,__builtin_amdgcn_ds_swizzle(__builtin_bit_cast(int,v),0x401F));
        { const unsigned u=__builtin_bit_cast(unsigned,v); auto rr2=__builtin_amdgcn_permlane32_swap(u,u,false,false); v=__uint_as_float((unsigned)rr2[0])+__uint_as_float((unsigned)rr2[1]); }
        sm[d]=v; }
      if(lane<8){
        #pragma unroll
        for(int d=0;d<8;++d)KPl[wid*64+8*lane+d]=sm[d]; }
      asm volatile("s_waitcnt vmcnt(0) lgkmcnt(0)\n\ts_barrier":::"memory");
      if(tid<64){ float s8=0.f;
        #pragma unroll
        for(int w8=0;w8<8;++w8)s8+=KPl[w8*64+tid];
        KMl[n*64+tid]=s8*(1.0f/256.0f); }
      asm volatile("s_waitcnt lgkmcnt(0)\n\ts_barrier":::"memory"); } }
  if(tid<QB){ unsigned sel=(qb<=3)?((1u<<qb)-1u):0u;
    if(qb>3){ const bf16*qp=Q+(rowbase+q0+tid)*PQ+h*D; const float*km=(const float*)(shm+LDS_KM); float gate[7];
      #pragma unroll
      for(int j=0;j<7;++j)gate[j]=0.f;
      #pragma unroll 1
      for(int i=0;i<8;++i){ const u32x4 w=*reinterpret_cast<const u32x4*>(qp+8*i); float qv[8];
        qv[0]=__uint_as_float(w[0]<<16);qv[1]=__uint_as_float(w[0]&0xffff0000u);qv[2]=__uint_as_float(w[1]<<16);qv[3]=__uint_as_float(w[1]&0xffff0000u);
        qv[4]=__uint_as_float(w[2]<<16);qv[5]=__uint_as_float(w[2]&0xffff0000u);qv[6]=__uint_as_float(w[3]<<16);qv[7]=__uint_as_float(w[3]&0xffff0000u);
        #pragma unroll
        for(int j=0;j<7;++j) if(j<qb){ const float*kp=km+j*64+8*i;
          #pragma unroll
          for(int d=0;d<8;++d)gate[j]+=qv[d]*kp[d]; } }
      #pragma unroll
      for(int rep=0;rep<3;++rep){ float best=-INFINITY; int bi=0;
        #pragma unroll
        for(int j=0;j<7;++j) if(j<qb&&!((sel>>j)&1u)&&gate[j]>best){best=gate[j];bi=j;}
        sel|=1u<<bi; } }
    ((unsigned char*)(shm+LDS_SEL))[tid]=(unsigned char)sel; }
  asm volatile("s_waitcnt vmcnt(0) lgkmcnt(0)\n\ts_barrier":::"memory");
  const bf16*Qw=Q+(rowbase+q0+wid*QBLK)*PQ+h*D;
  const bf16*Kh=K+rowbase*PK+h*D,*Vh=V+rowbase*PV+h*D;
  const unsigned lds0=(unsigned)(uintptr_t)shm;
  float*wsf=(float*)(shm+LDS_WS)+wid*64;
  const bf16*ksrc=Kh+(long)lane*PK+wid*8;
  const bf16*vsrc=Vh+(long)(16*(wid&3)+(lane>>2))*PV+(wid>>2)*32+(lane&3)*8;
  const unsigned kdst=lds0+LDS_K+wid*1024, vdst=lds0+LDS_V+wid*1024;
  #define TROW(t) ((long)(((t)<4)?(q0+(t)*KVBLK):(((t)-4)*KVBLK)))
  #define DMA_K(t,slot) glds16(ksrc+TROW(t)*PK,(unsigned)__builtin_amdgcn_readfirstlane(kdst+(slot)))
  #define DMA_V(t,slot) glds16(vsrc+TROW(t)*PV,(unsigned)__builtin_amdgcn_readfirstlane(vdst+(slot)))
  const int vb0=(int)(lds0+LDS_V)+((lane>>4)&1)*32+(lane&3)*8+(4*hi+((lane&15)>>2))*64;
  const char*Kbase=shm+LDS_K; bf16x8 kf[8];
  const lds_cptr shm3=(lds_cptr)shm; const lds_cptr kp0=shm3+LDS_K+hi*1024+r32*16; const lds_cptr vp0=shm3+LDS_V+((lane>>4)&1)*32+(lane&3)*8+(4*hi+((lane&15)>>2))*64;
  const int NT=(q0+QB)/KVBLK;
  DMA_K(0,0);DMA_V(0,0);DMA_K(1,SLOTB);
  bf16x8 qr[4];
  #pragma unroll
  for(int d0=0;d0<4;++d0)qr[d0]=*reinterpret_cast<const bf16x8*>(&Qw[(long)r32*PQ+d0*16+hi*8]);
  float mhat=0.f,l_reg=0.f;f32x16 o[2];o[0]=f32x16{};o[1]=f32x16{};
  const int qrel=wid*QBLK+r32;
  const unsigned selb=((const unsigned char*)(shm+LDS_SEL))[qrel];
  #define CMASK(P0,P1,t) cmask(P0,P1,(t),qrel,hi)
  #define SUBREF(C0,C1,t) do{ const float sb_=(((t)<4)||((selb>>(((t)-4)>>2))&1u))?mhat:INFINITY; _Pragma("unroll") for(int r_=0;r_<16;++r_){C0[r_]-=sb_;C1[r_]-=sb_;} }while(0)
  bool resc=false;
  #define START(P0,P1) do{ const float rm=rowmax(P0,P1); resc=false; \
    { const float dl=rm; mhat=fadd_s(mhat,dl); \
      _Pragma("unroll") for(int r=0;r<16;++r){P0[r]=fsub_s(P0[r],dl);P1[r]=fsub_s(P1[r],dl);} \
      } \
    _Pragma("unroll") for(int r=0;r<16;++r)P0[r]=__builtin_amdgcn_exp2f(P0[r]); }while(0)
  #define RESC() do{ if(resc){ asm volatile("s_waitcnt lgkmcnt(0)":::"memory"); \
      _Pragma("unroll") for(int d_=0;d_<2;++d_) _Pragma("unroll") for(int r=0;r<16;++r)o[d_][r]*=wsf[crow(r,hi)]; } }while(0)
  f32x16 pA0,pA1,pB0,pB1;
  int sl_prev=0,sl_cur=0,sl_next=SLOTB;
  #define ROT() do{sl_prev=sl_cur;sl_cur=sl_next;sl_next=(sl_next==(NSLOT-1)*SLOTB)?0:sl_next+SLOTB;}while(0)
  DMA_K(2,2*SLOTB);
  WAIT_BAR(3);
  qkt(pA0,pA1,Kbase,qr,f32x16{},r32,hi);asm volatile("s_nop 15\n\ts_nop 7":"+v"(pA0),"+v"(pA1));CMASK(pA0,pA1,0);
  START(pA0,pA1);
  _Pragma("unroll") for(int r=0;r<16;++r)pA1[r]=__builtin_amdgcn_exp2f(pA1[r]);
  WAIT_BAR(0);
  DMA_K(3,0);DMA_V(1,SLOTB);
  ROT();
  kload8(kf,kp0+sl_cur);
  WAIT_BAR(2);
  s16x4 vlo[8],vhi[8]; u32x4 pw0,pw1,pw2,pw3;
  #define PKW(P,B) cvtpk_s(P[B],P[B+1])
  #define PAF(k) __builtin_bit_cast(bf16x8,pw##k)
  #define VFR(i) (bf16x8){vlo[i][0],vlo[i][1],vlo[i][2],vlo[i][3],vhi[i][0],vhi[i][1],vhi[i][2],vhi[i][3]}
  #define PIN(x) asm volatile("":"+v"(x))
  #define MX3(a,b,c) __builtin_fmaxf(__builtin_fmaxf((a),(b)),(c))
  #define GAPA(MF,A0,A1,A2,A3,W0,W1,PW) do{ MF; sacc+=A0; sacc+=A1; sacc+=A2; sacc+=A3; PIN(sacc); W0; W1; PIN(PW); SBAR(); }while(0)
  #define EX(v) __builtin_amdgcn_exp2f(v)
  #define GAPB(MF,X,B) do{ MF; X[B]=EX(X[B]); X[B+1]=EX(X[B+1]); X[B+2]=EX(X[B+2]); X[B+3]=EX(X[B+3]); PIN(X); SBAR(); }while(0)
  #define VRD(i) do{ vlo[i]=vtr(vp_+(((i)>>2)*4096+((i)&3)*1024)); vhi[i]=vtr(vp_+(((i)>>2)*4096+((i)&3)*1024+512)); }while(0)
  #define KRD(G,j) do{ if(G){ kload2(kf,kp0+sl_next,j); SBAR(); } }while(0)
  #define STEP(C0,C1,P0,P1,t,GK,GV,GL,MB) do{ SBAR(); \
    const lds_cptr vp_=vp0+sl_prev; \
    VRD(0); SBAR(); float sacc=(P0[0]+P0[1]); \
    GAPA(C0=__builtin_amdgcn_mfma_f32_32x32x16_bf16(kf[0],qr[0],f32x16{},0,0,0), P0[2],P0[3],P0[4],P0[5],     pw0[0]=PKW(P0,0), pw0[1]=PKW(P0,2), pw0); \
    VRD(4); SBAR(); GAPA(C1=__builtin_amdgcn_mfma_f32_32x32x16_bf16(kf[1],qr[0],f32x16{},0,0,0), P0[6],P0[7],P0[8],P0[9],     pw0[2]=PKW(P0,4), pw0[3]=PKW(P0,6), pw0); \
    VRD(1); SBAR(); GAPA(C0=__builtin_amdgcn_mfma_f32_32x32x16_bf16(kf[2],qr[1],C0,0,0,0),   P0[10],P0[11],P0[12],P0[13], pw1[0]=PKW(P0,8), pw1[1]=PKW(P0,10), pw1); \
    VRD(5); SBAR(); GAPA(C1=__builtin_amdgcn_mfma_f32_32x32x16_bf16(kf[3],qr[1],C1,0,0,0),   P0[14],P0[15],P1[0],P1[1],   pw1[2]=PKW(P0,12),pw1[3]=PKW(P0,14), pw1); \
    VRD(2); SBAR(); GAPA(C0=__builtin_amdgcn_mfma_f32_32x32x16_bf16(kf[4],qr[2],C0,0,0,0),   P1[2],P1[3],P1[4],P1[5],     pw2[0]=PKW(P1,0), pw2[1]=PKW(P1,2), pw2); \
    VRD(6); SBAR(); GAPA(C1=__builtin_amdgcn_mfma_f32_32x32x16_bf16(kf[5],qr[2],C1,0,0,0),   P1[6],P1[7],P1[8],P1[9],     pw2[2]=PKW(P1,4), pw2[3]=PKW(P1,6), pw2); \
    VRD(3); SBAR(); GAPA(C0=__builtin_amdgcn_mfma_f32_32x32x16_bf16(kf[6],qr[3],C0,0,0,0),   P1[10],P1[11],P1[12],P1[13], pw3[0]=PKW(P1,8), pw3[1]=PKW(P1,10), pw3); \
    VRD(7); SBAR(); GAPA(C1=__builtin_amdgcn_mfma_f32_32x32x16_bf16(kf[7],qr[3],C1,0,0,0),   P1[14],P1[15],0.f,0.f,       pw3[2]=PKW(P1,12),pw3[3]=PKW(P1,14), pw3); \
    l_reg+=sacc; \
    if(GK){DMA_K((t)+3,sl_cur);} if(GV){DMA_V((t)+1,sl_next);} \
    SUBREF(C0,C1,t); if(MB){CMASK(C0,C1,t);} \
    { float a=MX3(C0[0],C0[1],C1[0]),b=MX3(C0[2],C0[3],C1[1]); a=MX3(a,C1[2],C1[3]); \
      _Pragma("unroll") for(int r=4;r<16;r+=4){a=MX3(a,C0[r],C0[r+1]);b=MX3(b,C0[r+2],C0[r+3]);a=MX3(a,C1[r],C1[r+1]);b=MX3(b,C1[r+2],C1[r+3]);} \
      float rm=__builtin_fmaxf(a,b); { auto rr=__builtin_amdgcn_permlane32_swap(__float_as_uint(rm),__float_as_uint(rm),false,false); rm=__builtin_fmaxf(__uint_as_float(rr[0]),__uint_as_float(rr[1])); } \
      resc=false; \
      if(__builtin_expect(__any(rm>(float)THRL),0)){ const float dl=__builtin_fmaxf(rm,0.f); mhat+=dl; \
        _Pragma("unroll") for(int r=0;r<16;++r){C0[r]-=dl;C1[r]-=dl;} \
        const float f=__builtin_amdgcn_exp2f(-dl); l_reg*=f; if(hi==0)wsf[r32]=f; resc=true; } } \
    SBAR(); \
    GAPB(o[0]=__builtin_amdgcn_mfma_f32_32x32x16_bf16(PAF(0),VFR(0),o[0],0,0,0), C0,0); \
    GAPB(o[1]=__builtin_amdgcn_mfma_f32_32x32x16_bf16(PAF(0),VFR(4),o[1],0,0,0), C0,4); \
    KRD(GL,0); GAPB(o[0]=__builtin_amdgcn_mfma_f32_32x32x16_bf16(PAF(1),VFR(1),o[0],0,0,0), C0,8); \
    KRD(GL,1); GAPB(o[1]=__builtin_amdgcn_mfma_f32_32x32x16_bf16(PAF(1),VFR(5),o[1],0,0,0), C0,12); \
    KRD(GL,2); GAPB(o[0]=__builtin_amdgcn_mfma_f32_32x32x16_bf16(PAF(2),VFR(2),o[0],0,0,0), C1,0); \
    KRD(GL,3); GAPB(o[1]=__builtin_amdgcn_mfma_f32_32x32x16_bf16(PAF(2),VFR(6),o[1],0,0,0), C1,4); \
    GAPB(o[0]=__builtin_amdgcn_mfma_f32_32x32x16_bf16(PAF(3),VFR(3),o[0],0,0,0), C1,8); \
    GAPB(o[1]=__builtin_amdgcn_mfma_f32_32x32x16_bf16(PAF(3),VFR(7),o[1],0,0,0), C1,12); \
    }while(0)
  #define ENDW(tt) do{ if((tt)+3<NT){WAIT_BAR(2);} else if((tt)+2<NT){WAIT_BAR(1);} else {WAIT_BAR(0);} }while(0)
  { int t=1;
    for(;t+1<NT;t+=2){
      STEP(pB0,pB1,pA0,pA1,t,(t+3<NT),(t+1<NT),(t+1<NT),(t<4));       ENDW(t);   RESC(); ROT();
      STEP(pA0,pA1,pB0,pB1,t+1,(t+4<NT),(t+2<NT),(t+2<NT),(t+1<4));     ENDW(t+1); RESC(); ROT();
    }
    STEP(pB0,pB1,pA0,pA1,NT-1,false,false,false,(NT==4)); RESC();
  }
  { float sacc=pB0[0]+pB0[1]; _Pragma("unroll") for(int r=2;r<16;++r)sacc+=pB0[r]; _Pragma("unroll") for(int r=0;r<16;++r)sacc+=pB1[r]; l_reg+=sacc;
    pw0=(u32x4){PKW(pB0,0),PKW(pB0,2),PKW(pB0,4),PKW(pB0,6)};pw1=(u32x4){PKW(pB0,8),PKW(pB0,10),PKW(pB0,12),PKW(pB0,14)};pw2=(u32x4){PKW(pB1,0),PKW(pB1,2),PKW(pB1,4),PKW(pB1,6)};pw3=(u32x4){PKW(pB1,8),PKW(pB1,10),PKW(pB1,12),PKW(pB1,14)};
    SBAR(); pv(o,vb0+sl_cur,PAF(0),PAF(1),PAF(2),PAF(3)); }
  #undef PKW
  #undef PAF
  #undef VFR
  #undef PIN
  #undef MX3
  #undef GAPA
  #undef GAPB
  #undef EX
  #undef VRD
  #undef KRD
  #undef STEP
  #undef ENDW
  {auto rr=__builtin_amdgcn_permlane32_swap(__float_as_uint(l_reg),__float_as_uint(l_reg),false,false);l_reg=__uint_as_float(rr[0])+__uint_as_float(rr[1]);}
  if(hi==0)wsf[32+r32]=l_reg;asm volatile("s_waitcnt lgkmcnt(0)":::"memory");
  float rli[16];
  #pragma unroll
  for(int r=0;r<16;++r)rli[r]=__builtin_amdgcn_rcpf(wsf[32+crow(r,hi)]);
  bf16*Ow=O+(rowbase+q0+wid*QBLK)*PO+h*D;
  { bf16*stg=(bf16*)(shm+LDS_OST)+wid*2048;
    #pragma unroll
    for(int r=0;r<16;++r){const int orow=crow(r,hi);
      #pragma unroll
      for(int d0=0;d0<2;++d0)stg[orow*64+d0*32+r32]=__float2bfloat16(o[d0][r]*rli[r]);}
    asm volatile("s_waitcnt lgkmcnt(0)":::"memory");
    #pragma unroll
    for(int i=0;i<4;++i){const int row=i*8+(lane>>3),ch=lane&7; const u32x4 v=*(const u32x4*)(stg+row*64+ch*8); ATTN_STORE16(Ow+(long)row*PO+ch*8,v);} }
  asm volatile("s_waitcnt lgkmcnt(0)\n\ts_barrier":::"memory");
  #undef DMA_K
  #undef TROW
  #undef SUBREF
  #undef DMA_V
  #undef CMASK
  #undef START
  #undef RESC
  #undef ROT
}
constexpr int ATTN_LDS_BYTES=LDS_BYTES;
#undef SBAR
#undef WAIT_BAR
}
constexpr int DM = 1024, NB = 16, SEQ = 2048, NT = NB * SEQ;
constexpr int RWW = 512, WIN_N = 5376, INC = 4352, ZV = 1792, ZG = 2304;
constexpr int NEXP = 32, DEXP = 512;
constexpr int XS_ROWS = 2 * NT + NEXP * 256;
constexpr float C2 = 0.125f * 1.4426950408889634f;

#define LAS __attribute__((address_space(3)))
#define GAS __attribute__((address_space(1)))
typedef unsigned short bf16;
typedef unsigned v4u __attribute__((ext_vector_type(4)));
typedef unsigned v2u __attribute__((ext_vector_type(2)));
typedef float f32x4 __attribute__((ext_vector_type(4)));

typedef float f32x2_c __attribute__((ext_vector_type(2))); typedef __bf16 bf16x2_c __attribute__((ext_vector_type(2)));
__device__ __forceinline__ unsigned pk2(float lo, float hi) { const f32x2_c v = {lo, hi}; return __builtin_bit_cast(unsigned, __builtin_convertvector(v, bf16x2_c)); }
__device__ __forceinline__ unsigned f2bf(float f) { return pk2(f, f) & 0xffffu; }
__device__ __forceinline__ float bflo(unsigned w) { return __builtin_bit_cast(float, w << 16); }
__device__ __forceinline__ float bfhi(unsigned w) { return __builtin_bit_cast(float, w & 0xffff0000u); }
__device__ __forceinline__ float sigm(float x) { return __builtin_amdgcn_rcpf(1.0f + __expf(-x)); }

constexpr size_t MiB = 1u << 20;
constexpr size_t WS_CTL = 0;
constexpr size_t WS_MOD = 1 * MiB;
constexpr size_t WS_GM2 = 1 * MiB + 512 * 1024;
constexpr size_t WS_CB = 1 * MiB + 640 * 1024;
constexpr size_t WS_COS = 2 * MiB;
constexpr size_t WS_SIN = 2 * MiB + 512 * 1024;
constexpr size_t WS_KMEAN = 3 * MiB;
constexpr size_t WS_WRH = 3 * MiB + 512 * 1024;
constexpr size_t WS_WRL = 3 * MiB + 768 * 1024;
constexpr size_t WS_SEL = 4 * MiB;
constexpr size_t WS_RTE = 5 * MiB;
constexpr size_t WS_RTW = 5 * MiB + 256 * 1024;
constexpr size_t WS_RNK = 5 * MiB + 512 * 1024;
constexpr size_t WS_POS = 5 * MiB + 768 * 1024;
constexpr size_t WS_RSTD = 7 * MiB;
constexpr size_t WS_WLT = 6 * MiB;
constexpr size_t WS_WAT = 6 * MiB + 64 * 1024;
constexpr size_t WS_WGT = 6 * MiB + 128 * 1024;
constexpr size_t WS_WIN = 16 * MiB;
constexpr size_t WS_WBA = 27 * MiB;
constexpr size_t WS_WBB = 28 * MiB;
constexpr size_t WS_WOUT = 29 * MiB;
constexpr size_t WS_Z = 32 * MiB;
constexpr size_t WS_H = 368 * MiB;
constexpr size_t WS_Q = 304 * MiB, WS_K = 336 * MiB, WS_MRG = 304 * MiB;
constexpr size_t WS_YA = 432 * MiB, WS_YB = 464 * MiB;
constexpr size_t WS_WUP = 368 * MiB;
constexpr size_t WS_H2 = 128 * MiB;
constexpr size_t WS_XS = 64 * MiB;
constexpr size_t WS_HID = 208 * MiB;
constexpr size_t WS_X1B = 432 * MiB;
constexpr size_t WS_ACT = 496 * MiB;
constexpr size_t WS_END = 512 * MiB;
constexpr int CW_CNT = 64, CNT_PAD = 64;
constexpr int CW_NT = 2304;
constexpr int CW_TEXP = 2368;
static_assert(CW_CNT + NEXP * CNT_PAD <= CW_NT, "control words");

__device__ __forceinline__ void tr_item(const float* W, int K, int N, bf16* WT, int kb, int nb, int dst_row0, LAS float* scr, int lane) {
    const int k0 = 64 * kb, n0 = 32 * nb;
#pragma unroll 8
    for (int i = 0; i < 32; ++i) { const int kk = 2 * i + (lane >> 5); scr[kk * 33 + (lane & 31)] = W[(size_t)(k0 + kk) * N + n0 + (lane & 31)]; }
    asm volatile("s_waitcnt lgkmcnt(0)" ::: "memory");
    const int c = lane & 7;
#pragma unroll
    for (int j = 0; j < 4; ++j) { const int n = (lane >> 3) + 8 * j; const LAS float* s = scr + (8 * c) * 33 + n;
        v4u o; o.x = pk2(s[0 * 33], s[1 * 33]); o.y = pk2(s[2 * 33], s[3 * 33]); o.z = pk2(s[4 * 33], s[5 * 33]); o.w = pk2(s[6 * 33], s[7 * 33]);
        *(v4u*)(WT + (size_t)(dst_row0 + n) * K + k0 + 8 * c) = o; }
    asm volatile("s_waitcnt lgkmcnt(0)" ::: "memory");
}

struct PArgs { const float* in[30]; float* out; unsigned char* ws; };

__device__ __forceinline__ void p_prep_weights(const PArgs& a, unsigned char* lds, int wv) {
    const int tid = mktid(wv), lane = tid & 63, wave = tid >> 6;
    LAS float* scr = (LAS float*)lds + wave * (64 * 33);
    const int gw = blockIdx.x * 8 + wave, NGW = gridDim.x * 8;
    unsigned char* ws = a.ws;
    constexpr int I_IN = 16 * 168, I_BR = 8 * 32, I_OUT = 16 * 32;
    for (int it = gw; it < I_IN + 2 * I_BR + I_OUT; it += NGW) {
        int r = it;
        if (r < I_IN) { const int kb = r / 168, nb = r % 168; int dst = 32 * nb;
            if (dst >= 1792 && dst < 2816) { const int rel = dst - 1792, u = rel >> 8, hl = (rel & 255) >> 6, half = (rel & 63) >> 5; dst = 1792 + u * 256 + half * 128 + hl * 32; }
            tr_item(a.in[6], 1024, WIN_N, (bf16*)(ws + WS_WIN), kb, nb, dst, scr, lane); continue; } r -= I_IN;
        if (r < I_BR) { const int kb = r / 32, nb = r % 32; tr_item(a.in[20], 512, 1024, (bf16*)(ws + WS_WBA), kb, nb, 32 * nb, scr, lane); continue; } r -= I_BR;
        if (r < I_BR) { const int kb = r / 32, nb = r % 32; tr_item(a.in[21], 512, 1024, (bf16*)(ws + WS_WBB), kb, nb, 32 * nb, scr, lane); continue; } r -= I_BR;
        { const int kb = r / 32, nb = r % 32; tr_item(a.in[22], 1024, 1024, (bf16*)(ws + WS_WOUT), kb, nb, 32 * nb, scr, lane); }
    }
    const int gt = blockIdx.x * 512 + tid, NGT = gridDim.x * 512;
    float* cosT = (float*)(ws + WS_COS); float* sinT = (float*)(ws + WS_SIN);
    for (int i = gt; i < SEQ * 32; i += NGT) { const int s = i >> 5, f = i & 31; const float inv = powf(10000.0f, -(float)f / 32.0f); const float ang = (float)s * inv; cosT[i] = cosf(ang); sinT[i] = sinf(ang); }
    { bf16* wlt = (bf16*)(ws + WS_WLT); bf16* wat = (bf16*)(ws + WS_WAT); bf16* wgt = (bf16*)(ws + WS_WGT);
      for (int i = gt; i < 8 * 64 * 64; i += NGT) { const int hh = i >> 12, j = (i >> 6) & 63, m = i & 63; wlt[i] = (bf16)f2bf(a.in[9][m * 512 + hh * 64 + j]); wat[i] = (bf16)f2bf(a.in[11][m * 512 + hh * 64 + j]); }
      for (int i = gt; i < 8 * 64 * 128; i += NGT) { const int hh = i >> 13, j = (i >> 7) & 63, m = i & 127; wgt[i] = (bf16)f2bf(a.in[12][m * 512 + hh * 64 + j]); } }
    { bf16* wrh = (bf16*)(ws + WS_WRH); bf16* wrl = (bf16*)(ws + WS_WRL);
      for (int i = gt; i < 48 * 1024; i += NGT) { const int e = i >> 10, k = i & 1023; const float w = e < 4 ? a.in[23][k * 4 + e] : e < 36 ? a.in[25][k * 32 + (e - 4)] : 0.f;
          const unsigned hi = f2bf(w); wrh[i] = (bf16)hi; wrl[i] = (bf16)f2bf(w - bflo(hi)); } }
}

constexpr int CW_PEXP = 2816;
__device__ __forceinline__ void p_prep_experts_dyn(const PArgs& a, unsigned char* lds, int wv) {
    const int tid = mktid(wv), lane = tid & 63, wave = tid >> 6;
    LAS float* scr = (LAS float*)lds + wave * (64 * 33);
    unsigned* ctr = (unsigned*)(a.ws + WS_CTL) + CW_PEXP;
    constexpr int NITEM = NEXP * 768;
    for (;;) {
        unsigned base = 0; if (lane == 0) base = atomicAdd(ctr, 16u);
        base = (unsigned)__builtin_amdgcn_readfirstlane((int)base);
        if (base >= (unsigned)NITEM) break;
        for (int it = (int)base; it < (int)base + 16 && it < NITEM; ++it) {
            const int e = it / 768; int r = it % 768;
            bf16* wup = (bf16*)(a.ws + WS_WUP) + (size_t)e * 1024 * 1024;
            if (r < 256) { const int kb = r / 16, nb = r % 16, n0 = 32 * nb; tr_item(a.in[27] + (size_t)e * 1024 * 512, 1024, 512, wup, kb, nb, (n0 >> 7) * 256 + (n0 & 127), scr, lane); continue; } r -= 256;
            if (r < 256) { const int kb = r / 16, nb = r % 16, n0 = 32 * nb; tr_item(a.in[28] + (size_t)e * 1024 * 512, 1024, 512, wup, kb, nb, (n0 >> 7) * 256 + 128 + (n0 & 127), scr, lane); continue; } r -= 256;
            { const int kb = r / 32, nb = r % 32; tr_item(a.in[29] + (size_t)e * 512 * 1024, 512, 1024, (bf16*)a.out + (size_t)e * 1024 * 512, kb, nb, 32 * nb, scr, lane); }
        }
    }
}

__device__ __forceinline__ void p_ada(const PArgs& a, unsigned char* lds, int wv) {
    float* sc = (float*)lds; float* red = sc + 16 * 1024;
    const float* c = a.in[1]; const float* w = a.in[2]; const float* bias = a.in[3];
    float* mod = (float*)(a.ws + WS_MOD);
    const int tid = mktid(wv);
    for (int i = tid; i < 16 * 1024; i += 512) { const float v = c[i]; sc[i] = v / (1.0f + __expf(-v)); }
    __syncthreads();
    const int col = tid & 31, kg = tid >> 5;
    for (int tile = blockIdx.x; tile < 192; tile += gridDim.x) {
        const int e = tile * 32 + col;
        float acc[16];
#pragma unroll
        for (int b = 0; b < 16; ++b) acc[b] = 0.f;
        for (int d = kg * 64; d < kg * 64 + 64; ++d) { const float wv = w[(size_t)d * 6144 + e];
#pragma unroll
            for (int b = 0; b < 16; ++b) acc[b] += sc[b * 1024 + d] * wv; }
#pragma unroll
        for (int b = 0; b < 16; ++b) red[(kg * 16 + b) * 32 + col] = acc[b];
        __syncthreads();
        { const int b = tid >> 5, cc = tid & 31; float sm = 0.f;
#pragma unroll
            for (int k = 0; k < 16; ++k) sm += red[(k * 16 + b) * 32 + cc];
            mod[b * 6144 + tile * 32 + cc] = sm + bias[tile * 32 + cc]; }
        __syncthreads();
    }
}

__device__ __forceinline__ void p_norm1(const PArgs& a, unsigned char* lds, int wv) {
    const int tid = mktid(wv), lane = tid & 63, gw = blockIdx.x * 8 + (tid >> 6), NGW = gridDim.x * 8;
    const float* x = a.in[0]; const float* g = a.in[4]; const float* mod = (const float*)(a.ws + WS_MOD);
    bf16* h = (bf16*)(a.ws + WS_H);
    for (int m = gw; m < NT; m += NGW) {
        const int b = m >> 11; const f32x4* xr = (const f32x4*)(x + (size_t)m * DM) + lane; f32x4 v[4]; float s = 0.f;
#pragma unroll
        for (int j = 0; j < 4; ++j) { v[j] = xr[64 * j]; s += (v[j].x * v[j].x + v[j].y * v[j].y) + (v[j].z * v[j].z + v[j].w * v[j].w); }
        const float rstd = rsqrtf(wave_sum(s) * (1.0f / DM) + 1e-6f);
        v2u* o = (v2u*)(h + (size_t)m * DM) + lane;
#pragma unroll
        for (int j = 0; j < 4; ++j) { const int col = 4 * (lane + 64 * j);
            const f32x4 gg = *(const f32x4*)(g + col), sh = *(const f32x4*)(mod + b * 6144 + col), scl = *(const f32x4*)(mod + b * 6144 + 1024 + col);
            const f32x4 r = v[j] * rstd * gg * (scl + 1.0f) + sh; v2u w; w.x = pk2(r.x, r.y); w.y = pk2(r.z, r.w); o[64 * j] = w; }
    }
    { float* gm2 = (float*)(a.ws + WS_GM2); float* cb = (float*)(a.ws + WS_CB); const float* g2 = a.in[5];
      for (int i = blockIdx.x * 512 + tid; i < 16 * 1024; i += gridDim.x * 512) { const int b = i >> 10, k = i & 1023; gm2[i] = g2[k] * (1.0f + mod[b * 6144 + 4096 + k]); }
      for (int p = gw; p < 16 * 48; p += NGW) { const int b = p / 48, n = p % 48; float s = 0.f;
          if (n < 36) { for (int k = lane; k < 1024; k += 64) { const float w = n < 4 ? a.in[23][k * 4 + n] : a.in[25][k * 32 + (n - 4)]; s += mod[b * 6144 + 3072 + k] * w; } }
          s = wave_sum(s); if (lane == 0) cb[p] = n < 4 ? s + a.in[24][n] : n < 36 ? s + a.in[26][n - 4] : 0.f; } }
}

using pg8::Unit; using pg8::HALF; using pg8::BM; using pg8::cvt_pk_bf16;
typedef pg8::f32x4 pf4; typedef pg8::u32x4 pu4;

struct EpiStoreBf16 {
    static constexpr bool PERM = true, AFTER_DRAIN = false, CHAIN = false;
    bf16* O; int ldc;
    __device__ __forceinline__ void operator()(const pf4 (&acc)[2][2][4][2], const Unit& u, int wr, int wc, int fr, int fq) const {
        const int row0 = u.pm * BM + wr * 64 + fr, col0 = u.pn * BM + wc * 32 + 8 * fq;
#pragma unroll
        for (int ai = 0; ai < 2; ++ai)
#pragma unroll
            for (int m = 0; m < 4; ++m) { bf16* rowp = O + (size_t)(row0 + ai * HALF + m * 16) * ldc + col0;
#pragma unroll
                for (int bj = 0; bj < 2; ++bj) { const pf4 v0 = acc[ai][bj][m][0], v1 = acc[ai][bj][m][1]; pu4 w;
                    w.x = cvt_pk_bf16(v0[0], v0[1]); w.y = cvt_pk_bf16(v0[2], v0[3]); w.z = cvt_pk_bf16(v1[0], v1[1]); w.w = cvt_pk_bf16(v1[2], v1[3]);
                    *(pu4*)(rowp + bj * HALF) = w; } }
    }
};
struct EpiZ {
    static constexpr bool PERM = true, AFTER_DRAIN = false, CHAIN = false;
    bf16* z; bf16* Q; bf16* K; const float* qg; const float* kg; const float* cosT; const float* sinT;
    __device__ __forceinline__ void operator()(const pf4 (&acc)[2][2][4][2], const Unit& u, int wr, int wc, int fr, int fq) const {
        const int row0 = u.pm * BM + wr * 64 + fr;
        if (u.pn < 7 || u.pn >= 11) {
            const int zc = (u.pn < 7 ? u.pn * 256 : (u.pn - 11) * 256 + 1792) + wc * 32 + 8 * fq;
#pragma unroll
            for (int ai = 0; ai < 2; ++ai)
#pragma unroll
                for (int m = 0; m < 4; ++m) { bf16* rowp = z + (size_t)(row0 + ai * HALF + m * 16) * INC + zc;
#pragma unroll
                    for (int bj = 0; bj < 2; ++bj) { const pf4 v0 = acc[ai][bj][m][0], v1 = acc[ai][bj][m][1]; pu4 w;
                        w.x = cvt_pk_bf16(v0[0], v0[1]); w.y = cvt_pk_bf16(v0[2], v0[3]); w.z = cvt_pk_bf16(v1[0], v1[1]); w.w = cvt_pk_bf16(v1[2], v1[3]);
                        *(pu4*)(rowp + bj * HALF) = w; } }
            return;
        }
        const bool isk = u.pn >= 9; const int head = 4 * ((u.pn - 7) & 1) + wc; const float* g = isk ? kg : qg; bf16* O = (isk ? K : Q) + head * 64 + 8 * fq;
        const float osc = isk ? 1.0f : C2;
#pragma unroll
        for (int ai = 0; ai < 2; ++ai)
#pragma unroll
            for (int m = 0; m < 4; ++m) { int rb = row0, fqv = fq; asm volatile("" : "+v"(rb), "+v"(fqv));
                const int row = rb + ai * HALF + m * 16, s = row & (SEQ - 1);
                float ss = 0.f;
#pragma unroll
                for (int bj = 0; bj < 2; ++bj)
#pragma unroll
                    for (int n = 0; n < 2; ++n) { const pf4 v = acc[ai][bj][m][n]; ss += (v[0] * v[0] + v[1] * v[1]) + (v[2] * v[2] + v[3] * v[3]); }
                ss += __builtin_bit_cast(float, __builtin_amdgcn_ds_swizzle(__builtin_bit_cast(int, ss), 0x401F));
                { const unsigned uu = __builtin_bit_cast(unsigned, ss); auto rr = __builtin_amdgcn_permlane32_swap(uu, uu, false, false); ss = __builtin_bit_cast(float, (unsigned)rr[0]) + __builtin_bit_cast(float, (unsigned)rr[1]); }
                const float rstd = rsqrtf(ss * (1.0f / 64.0f) + 1e-6f) ;
#pragma unroll
                for (int n = 0; n < 2; ++n) { const pf4 c = *(const pf4*)(cosT + s * 32 + 8 * fqv + 4 * n), sn = *(const pf4*)(sinT + s * 32 + 8 * fqv + 4 * n);
                    const pf4 x1 = acc[ai][0][m][n] * rstd * *(const pf4*)(g + 8 * fqv + 4 * n), x2 = acc[ai][1][m][n] * rstd * *(const pf4*)(g + 32 + 8 * fqv + 4 * n);
                    const pf4 o1 = x1 * c - x2 * sn, o2 = x2 * c + x1 * sn;
                    v2u wa, wb; wa.x = cvt_pk_bf16(o1[0] * osc, o1[1] * osc); wa.y = cvt_pk_bf16(o1[2] * osc, o1[3] * osc); wb.x = cvt_pk_bf16(o2[0] * osc, o2[1] * osc); wb.y = cvt_pk_bf16(o2[2] * osc, o2[3] * osc);
                    bf16* op = (isk ? K : Q) + (size_t)row * 512 + head * 64 + 8 * fqv + 4 * n; *(v2u*)op = wa; *(v2u*)(op + 32) = wb;
                    asm volatile("" ::: "memory"); } }
    }
};
struct EpiMerge {
    static constexpr bool PERM = true, AFTER_DRAIN = false, CHAIN = true;
    const bf16* z; bf16* mrg;
    __device__ __forceinline__ bool chain(pf4 (&acc)[2][2][4][2], const Unit& u, int wr, int wc, int fr, int fq) const {
        const int row0 = u.pm * BM + wr * 64 + fr, col0 = u.pn * BM + wc * 32 + 8 * fq;
        if (u.aux == 0) {
#pragma unroll
            for (int ai = 0; ai < 2; ++ai)
#pragma unroll
                for (int m = 0; m < 4; ++m) { const size_t row = (size_t)(row0 + ai * HALF + m * 16);
#pragma unroll
                    for (int bj = 0; bj < 2; ++bj) { const int col = col0 + bj * HALF; const pu4 za = *(const pu4*)(z + row * INC + ZG + col), zb = *(const pu4*)(z + row * INC + ZG + 1024 + col);
                        const float a8[8] = {bflo(za.x), bfhi(za.x), bflo(za.y), bfhi(za.y), bflo(za.z), bfhi(za.z), bflo(za.w), bfhi(za.w)};
                        const float b8[8] = {bflo(zb.x), bfhi(zb.x), bflo(zb.y), bfhi(zb.y), bflo(zb.z), bfhi(zb.z), bflo(zb.w), bfhi(zb.w)};
#pragma unroll
                        for (int e = 0; e < 8; ++e) acc[ai][bj][m][e >> 2][e & 3] *= (1.0f + __expf(-b8[e])) * __builtin_amdgcn_rcpf(1.0f + __expf(-a8[e])); } }
            return true;
        }
#pragma unroll
        for (int ai = 0; ai < 2; ++ai)
#pragma unroll
            for (int m = 0; m < 4; ++m) { const size_t row = (size_t)(row0 + ai * HALF + m * 16);
#pragma unroll
                for (int bj = 0; bj < 2; ++bj) { const int col = col0 + bj * HALF; const pu4 gz = *(const pu4*)(z + row * INC + ZG + 1024 + col); const pf4 v0 = acc[ai][bj][m][0], v1 = acc[ai][bj][m][1];
                    pu4 w;
                    w.x = cvt_pk_bf16(sigm(bflo(gz.x)) * v0[0], sigm(bfhi(gz.x)) * v0[1]); w.y = cvt_pk_bf16(sigm(bflo(gz.y)) * v0[2], sigm(bfhi(gz.y)) * v0[3]);
                    w.z = cvt_pk_bf16(sigm(bflo(gz.z)) * v1[0], sigm(bfhi(gz.z)) * v1[1]); w.w = cvt_pk_bf16(sigm(bflo(gz.w)) * v1[2], sigm(bfhi(gz.w)) * v1[3]);
                    *(pu4*)(mrg + row * DM + col) = w; } }
        return false;
    }
};
struct EpiOut {
    static constexpr bool PERM = true, AFTER_DRAIN = false, CHAIN = false;
    const float* x; const float* mod; bf16* x1;
    __device__ __forceinline__ void operator()(const pf4 (&acc)[2][2][4][2], const Unit& u, int wr, int wc, int fr, int fq) const {
        const int row0 = u.pm * BM + wr * 64 + fr, col0 = u.pn * BM + wc * 32 + 8 * fq; const int b = u.pm >> 3;
        pf4 gt[2][2];
#pragma unroll
        for (int bj = 0; bj < 2; ++bj)
#pragma unroll
            for (int n = 0; n < 2; ++n) gt[bj][n] = *(const pf4*)(mod + b * 6144 + 2048 + col0 + bj * HALF + n * 4);
#pragma unroll
        for (int ai = 0; ai < 2; ++ai)
#pragma unroll
            for (int m = 0; m < 4; ++m) { const size_t off = (size_t)(row0 + ai * HALF + m * 16) * DM + col0;
#pragma unroll
                for (int bj = 0; bj < 2; ++bj) { const pf4 x0 = *(const pf4*)(x + off + bj * HALF), x1v = *(const pf4*)(x + off + bj * HALF + 4);
                    const pf4 o0 = x0 + gt[bj][0] * acc[ai][bj][m][0], o1 = x1v + gt[bj][1] * acc[ai][bj][m][1]; pu4 w;
                    w.x = cvt_pk_bf16(o0[0], o0[1]); w.y = cvt_pk_bf16(o0[2], o0[3]); w.z = cvt_pk_bf16(o1[0], o1[1]); w.w = cvt_pk_bf16(o1[2], o1[3]);
                    *(pu4*)(x1 + off + bj * HALF) = w; } }
    }
};
struct EpiUp {
    static constexpr bool PERM = true, AFTER_DRAIN = false, CHAIN = false;
    bf16* hid;
    __device__ __forceinline__ void operator()(const pf4 (&acc)[2][2][4][2], const Unit& u, int wr, int wc, int fr, int fq) const {
        const int row0 = u.pm * BM + wr * 64 + fr, col0 = u.pn * 128 + wc * 32 + 8 * fq;
#pragma unroll
        for (int ai = 0; ai < 2; ++ai)
#pragma unroll
            for (int m = 0; m < 4; ++m) { const size_t row = (size_t)(row0 + ai * HALF + m * 16); float o[8];
#pragma unroll
                for (int n = 0; n < 2; ++n)
#pragma unroll
                    for (int e = 0; e < 4; ++e) { const float g = acc[ai][0][m][n][e], l = acc[ai][1][m][n][e]; o[4 * n + e] = g * sigm(g) * l; }
                pu4 w; w.x = cvt_pk_bf16(o[0], o[1]); w.y = cvt_pk_bf16(o[2], o[3]); w.z = cvt_pk_bf16(o[4], o[5]); w.w = cvt_pk_bf16(o[6], o[7]);
                *(pu4*)(hid + row * DEXP + col0) = w; }
    }
};

struct GemmArgs { unsigned char* ws; const float* x; float* out; const float* qg; const float* kg; };
template <class Epi> __device__ __forceinline__ void run_dense(const void* A, const void* Bt, int M, int N, int K, const Epi& E, unsigned char* lds, int wv) {
    pg8::Gemm g{K}; pg8::StaticOrder S; S.init(A, Bt, M, N, K, (int)gridDim.x, (int)blockIdx.x);
    pg8::gemm_phase<Epi, pg8::StaticOrder, true, true>((PG8_LAS unsigned char*)lds, g, S, E, wv);
}
__device__ __forceinline__ void p_gemm_in(const GemmArgs& a, unsigned char* lds, int wv) {
    EpiZ E{(bf16*)(a.ws + WS_Z), (bf16*)(a.ws + WS_Q), (bf16*)(a.ws + WS_K), a.qg, a.kg, (const float*)(a.ws + WS_COS), (const float*)(a.ws + WS_SIN)};
    run_dense(a.ws + WS_H, a.ws + WS_WIN, NT, WIN_N, 1024, E, lds, wv);
}
struct PairOrder {
    int nM, nN, nwg, G, c; const char *A0, *A1, *B0, *B1; size_t tstep;
    __device__ bool next(int i, Unit& u) const {
        const long L = (long)(i >> 1) * G + c; if (L >= nwg) return false;
        int wgid = (int)L; { const int q = nwg / pg8::NXCD, r = nwg % pg8::NXCD, xcd = wgid % pg8::NXCD, off = wgid / pg8::NXCD; wgid = (xcd < r ? xcd * (q + 1) : r * (q + 1) + (xcd - r) * q) + off; }
        const int nig = pg8::WGM * nN, gid = wgid / nig, fm = gid * pg8::WGM, gsz = (nM - fm) < pg8::WGM ? (nM - fm) : pg8::WGM;
        u.pm = fm + ((wgid % nig) % gsz); u.pn = (wgid % nig) / gsz; u.aux = i & 1;
        u.a = ((i & 1) ? A1 : A0) + (size_t)u.pm * tstep; u.b = ((i & 1) ? B1 : B0) + (size_t)u.pn * tstep; return true;
    }
    __device__ __forceinline__ void a_ready(const Unit&) const {}
    __device__ __forceinline__ void done(const Unit&) const {}
};
__device__ __forceinline__ void p_gemm_merge(const GemmArgs& a, unsigned char* lds, int wv) {
    PairOrder S{NT / 256, 4, (NT / 256) * 4, (int)gridDim.x, (int)blockIdx.x, (const char*)(a.ws + WS_YA), (const char*)(a.ws + WS_YB), (const char*)(a.ws + WS_WBA), (const char*)(a.ws + WS_WBB), (size_t)256 * 512 * 2};
    EpiMerge E{(const bf16*)(a.ws + WS_Z), (bf16*)(a.ws + WS_MRG)}; pg8::Gemm g{512};
    pg8::gemm_phase<EpiMerge, PairOrder, true, true>((PG8_LAS unsigned char*)lds, g, S, E, wv);
}
__device__ __forceinline__ void p_gemm_out(const GemmArgs& a, unsigned char* lds, int wv) {
    EpiOut E{a.x, (const float*)(a.ws + WS_MOD), (bf16*)(a.ws + WS_X1B)};
    run_dense(a.ws + WS_MRG, a.ws + WS_WOUT, NT, 1024, 1024, E, lds, wv);
}
struct GroupedOrder {
    const int* texp; int nT, nN, G, c; const char* A; size_t a_tile; const char* B; size_t b_exp, b_tile;
    __device__ bool next(int i, Unit& u) const {
        const long L = (long)i * G + c; if (L >= (long)nT * nN) return false;
        const int tile = (int)(L / nN), pn = (int)(L % nN); u.aux = 0; u.pm = tile; u.pn = pn; u.a = A + (size_t)tile * a_tile; u.b = B + (size_t)texp[tile] * b_exp + (size_t)pn * b_tile; return true;
    }
    __device__ __forceinline__ void a_ready(const Unit&) const {}
    __device__ __forceinline__ void done(const Unit&) const {}
};
__device__ __forceinline__ void p_gemm_up(const GemmArgs& a, unsigned char* lds, int wv) {
    const int* ctl = (const int*)(a.ws + WS_CTL);
    GroupedOrder S{ctl + CW_TEXP, ctl[CW_NT], 4, (int)gridDim.x, (int)blockIdx.x, (const char*)(a.ws + WS_XS), (size_t)256 * 1024 * 2, (const char*)(a.ws + WS_WUP), (size_t)1024 * 1024 * 2, (size_t)256 * 1024 * 2};
    EpiUp E{(bf16*)(a.ws + WS_HID)}; pg8::Gemm g{1024};
    pg8::gemm_phase<EpiUp, GroupedOrder, true, true>((PG8_LAS unsigned char*)lds, g, S, E, wv);
}
__device__ __forceinline__ void p_gemm_down(const GemmArgs& a, unsigned char* lds, int wv) {
    const int* ctl = (const int*)(a.ws + WS_CTL);
    GroupedOrder S{ctl + CW_TEXP, ctl[CW_NT], 4, (int)gridDim.x, (int)blockIdx.x, (const char*)(a.ws + WS_HID), (size_t)256 * 512 * 2, (const char*)a.out, (size_t)1024 * 512 * 2, (size_t)256 * 512 * 2};
    EpiStoreBf16 E{(bf16*)(a.ws + WS_XS), 1024}; pg8::Gemm g{512};
    pg8::gemm_phase<EpiStoreBf16, GroupedOrder, true, true>((PG8_LAS unsigned char*)lds, g, S, E, wv);
}

__device__ __forceinline__ void p_attn(const PArgs& a, unsigned char* lds, int vb, int nvb, int wv) {
    const attn_body::bf16* Q = (const attn_body::bf16*)(a.ws + WS_Q); const attn_body::bf16* K = (const attn_body::bf16*)(a.ws + WS_K);
    const attn_body::bf16* V = (const attn_body::bf16*)(a.ws + WS_Z) + ZV; attn_body::bf16* O = (attn_body::bf16*)(a.ws + WS_YB);
    for (int p = vb; p < 512; p += nvb)
        for (int which = 0; which < 2; ++which) { const int bh = p >> 2, s = p & 3, qb = which ? 7 - s : s;
            attn_body::attn_unit<8>(bh >> 3, bh & 7, qb, Q, K, V, O, (char*)lds, wv); }
}

__device__ __forceinline__ void p_actprep(const PArgs& a, unsigned char* lds, int wv) {
    const int tid = mktid(wv); const bf16* z = (const bf16*)(a.ws + WS_Z); bf16* act = (bf16*)(a.ws + WS_ACT); const float* mu = a.in[7];
    for (int i = blockIdx.x * 512 + tid; i < NT * 32; i += gridDim.x * 512) { const int t = i >> 5, cg = i & 31, col = 1536 + 8 * cg; const bool hasp = (t & (SEQ - 1)) > 0;
        const v4u cw = *(const v4u*)(z + (size_t)t * INC + col); v4u pw = {0u, 0u, 0u, 0u}; if (hasp) pw = *(const v4u*)(z + (size_t)(t - 1) * INC + col);
        const float c8[8] = {bflo(cw.x), bfhi(cw.x), bflo(cw.y), bfhi(cw.y), bflo(cw.z), bfhi(cw.z), bflo(cw.w), bfhi(cw.w)}, p8[8] = {bflo(pw.x), bfhi(pw.x), bflo(pw.y), bfhi(pw.y), bflo(pw.z), bfhi(pw.z), bflo(pw.w), bfhi(pw.w)};
        const f32x4 m0 = *(const f32x4*)(mu + col), m1 = *(const f32x4*)(mu + col + 4); const float m8[8] = {m0.x, m0.y, m0.z, m0.w, m1.x, m1.y, m1.z, m1.w}; float v[8];
#pragma unroll
        for (int e = 0; e < 8; ++e) { const float x = c8[e] + (p8[e] - c8[e]) * m8[e]; v[e] = cg < 8 ? 1.0f - 2.0f * __builtin_amdgcn_rcpf(1.0f + __expf(2.0f * x)) : cg < 16 ? x : sigm(x); }
        v4u w; w.x = pk2(v[0], v[1]); w.y = pk2(v[2], v[3]); w.z = pk2(v[4], v[5]); w.w = pk2(v[6], v[7]);
        *(v4u*)(act + (size_t)t * 256 + 8 * cg) = w; }
}

namespace rw {
typedef short bf16x8 __attribute__((ext_vector_type(8)));
constexpr int MB = 8192;
__device__ __forceinline__ int SW(int r, int c) { return r * 128 + ((((c >> 3) ^ (r >> 1)) & 7) << 4) + (c & 7) * 2; }
__device__ __forceinline__ int SWG(int r, int c) { return r * 256 + ((((c >> 3) ^ r) & 15) << 4) + (c & 7) * 2; }
__device__ __forceinline__ int SWF(int r, int c) { return r * 256 + ((((c >> 2) ^ r) & 15) << 4) + (c & 3) * 4; }
enum { I_AT = 0, I_BT, I_AJ, I_BHJ, I_KHJ, I_ABRT, I_X5, I_L, I_LT, I_R0, I_R1, I_KT, I_RT, I_VJ, I_X14, I_GATE, I_VT, I_VT2, NBUF };
constexpr int OFF_F32 = NBUF * MB;
constexpr int OFF_CST = OFF_F32 + (64 * 3 + 512) * 4;
constexpr int LDS_NEED = OFF_CST + 14 * 64 * 4;

__device__ __forceinline__ bf16x8 ldfrag(const unsigned char* M, int row, int k) { return *(const bf16x8*)(M + SW(row, k)); }
__device__ __forceinline__ void mm(f32x4 (&acc)[2], const unsigned char* X, const unsigned char* Y, int mt, int nh, int fr, int fq) {
    const bf16x8 a0 = ldfrag(X, 16 * mt + fr, 8 * fq), a1 = ldfrag(X, 16 * mt + fr, 8 * fq + 32);
#pragma unroll
    for (int nt = 0; nt < 2; ++nt) { const bf16x8 b0 = ldfrag(Y, 16 * (2 * nh + nt) + fr, 8 * fq), b1 = ldfrag(Y, 16 * (2 * nh + nt) + fr, 8 * fq + 32);
        acc[nt] = __builtin_amdgcn_mfma_f32_16x16x32_bf16(a0, b0, acc[nt], 0, 0, 0); acc[nt] = __builtin_amdgcn_mfma_f32_16x16x32_bf16(a1, b1, acc[nt], 0, 0, 0); }
}
struct FA { bf16x8 k0, k1; };
struct FB { bf16x8 k0[2], k1[2]; };
__device__ __forceinline__ FA ldA(const unsigned char* X, int mt, int fr, int fq) { FA f; f.k0 = ldfrag(X, 16 * mt + fr, 8 * fq); f.k1 = ldfrag(X, 16 * mt + fr, 8 * fq + 32); return f; }
__device__ __forceinline__ FB ldB(const unsigned char* Y, int nh, int fr, int fq) { FB f;
#pragma unroll
    for (int nt = 0; nt < 2; ++nt) { f.k0[nt] = ldfrag(Y, 16 * (2 * nh + nt) + fr, 8 * fq); f.k1[nt] = ldfrag(Y, 16 * (2 * nh + nt) + fr, 8 * fq + 32); }
    return f; }
__device__ __forceinline__ void mma(f32x4 (&acc)[2], const FA& a, const FB& b) {
    acc[0] = __builtin_amdgcn_mfma_f32_16x16x32_bf16(a.k0, b.k0[0], acc[0], 0, 0, 0); acc[1] = __builtin_amdgcn_mfma_f32_16x16x32_bf16(a.k0, b.k0[1], acc[1], 0, 0, 0);
    acc[0] = __builtin_amdgcn_mfma_f32_16x16x32_bf16(a.k1, b.k1[0], acc[0], 0, 0, 0); acc[1] = __builtin_amdgcn_mfma_f32_16x16x32_bf16(a.k1, b.k1[1], acc[1], 0, 0, 0);
}
__device__ __forceinline__ void ldC(f32x4 (&acc)[2], const unsigned char* Z, int mt, int nh, int fr, int fq) {
#pragma unroll
    for (int nt = 0; nt < 2; ++nt) { const v2u w = *(const v2u*)(Z + SW(16 * (2 * nh + nt) + fr, 16 * mt + 4 * fq)); acc[nt] = (f32x4){bflo(w.x), bfhi(w.x), bflo(w.y), bfhi(w.y)}; }
}
__device__ __forceinline__ void storeT(unsigned char* Z, const f32x4 (&acc)[2], int mt, int nh, int fr, int fq) {
#pragma unroll
    for (int nt = 0; nt < 2; ++nt) { v2u w; w.x = pk2(acc[nt][0], acc[nt][1]); w.y = pk2(acc[nt][2], acc[nt][3]); *(v2u*)(Z + SW(16 * (2 * nh + nt) + fr, 16 * mt + 4 * fq)) = w; }
}
__device__ __forceinline__ void storeN(unsigned char* Z, const f32x4 (&acc)[2], int mt, int nh, int fr, int fq) {
#pragma unroll
    for (int nt = 0; nt < 2; ++nt)
#pragma unroll
        for (int r = 0; r < 4; ++r) *(unsigned short*)(Z + SW(16 * mt + 4 * fq + r, 16 * (2 * nh + nt) + fr)) = (unsigned short)f2bf(acc[nt][r]);
}
__device__ __forceinline__ void ld8bf(const unsigned char* p, float (&v)[8]) { const v4u w = *(const v4u*)p; v[0] = bflo(w.x); v[1] = bfhi(w.x); v[2] = bflo(w.y); v[3] = bfhi(w.y); v[4] = bflo(w.z); v[5] = bfhi(w.z); v[6] = bflo(w.w); v[7] = bfhi(w.w); }
__device__ __forceinline__ void st8bf(unsigned char* p, const float (&v)[8]) { v4u w; w.x = pk2(v[0], v[1]); w.y = pk2(v[2], v[3]); w.z = pk2(v[4], v[5]); w.w = pk2(v[6], v[7]); *(v4u*)p = w; }
__device__ __forceinline__ void ld8f(const float* p, float (&v)[8]) { const f32x4 a = *(const f32x4*)p, b = *(const f32x4*)(p + 4); v[0] = a.x; v[1] = a.y; v[2] = a.z; v[3] = a.w; v[4] = b.x; v[5] = b.y; v[6] = b.z; v[7] = b.w; }
__device__ __forceinline__ void ld8fs(const unsigned char* M, int r, int c, float (&v)[8]) { const f32x4 a = *(const f32x4*)(M + SWF(r, c)), b = *(const f32x4*)(M + SWF(r, c + 4)); v[0] = a.x; v[1] = a.y; v[2] = a.z; v[3] = a.w; v[4] = b.x; v[5] = b.y; v[6] = b.z; v[7] = b.w; }
__device__ __forceinline__ void un8(const v4u w, float (&v)[8]) { v[0] = bflo(w.x); v[1] = bfhi(w.x); v[2] = bflo(w.y); v[3] = bfhi(w.y); v[4] = bflo(w.z); v[5] = bfhi(w.z); v[6] = bflo(w.w); v[7] = bfhi(w.w); }
__device__ __forceinline__ void shift8(const v4u cw, const v4u pw, bool hasp, const float* mu, float (&v)[8]) {
    float c[8], p[8], m[8]; un8(cw, c); un8(pw, p); ld8f(mu, m);
#pragma unroll
    for (int e = 0; e < 8; ++e) { const float pe = hasp ? p[e] : 0.f; v[e] = c[e] + (pe - c[e]) * m[e]; }
}
__device__ __forceinline__ float tanh_fast(float x) { return 1.0f - 2.0f * __builtin_amdgcn_rcpf(1.0f + __expf(2.0f * x)); }

#define LBAR() do { asm volatile("s_waitcnt lgkmcnt(0)" ::: "memory"); __builtin_amdgcn_s_barrier(); asm volatile("" ::: "memory"); } while (0)
__device__ __forceinline__ void scan_unit(const PArgs& a, unsigned char* lds, int bh, int wv) {
    const int tid = mktid(wv), lane = tid & 63, wid = __builtin_amdgcn_readfirstlane(tid >> 6);
    const int mt = wid >> 1, nh = wid & 1; int fr = lane & 15, fq = lane >> 4;
    const int b = bh >> 3, h = bh & 7;
#define BUF(i) (lds + (i) * MB)
    float* GC = (float*)(lds + OFF_F32); float* BON = GC + 64; float* SSQ = BON + 64; float* SEGT = SSQ + 64;
    unsigned char* LWR = BUF(I_AT); unsigned char* LAR = BUF(I_AJ); unsigned char* LGR = BUF(I_KHJ); unsigned char* YTF = BUF(I_KHJ);
    unsigned char* ACTW = BUF(I_L); unsigned char* ACTA = BUF(I_LT); unsigned char* ACTG = BUF(I_R0);
    const bf16* z = (const bf16*)(a.ws + WS_Z); bf16* ya = (bf16*)(a.ws + WS_YA);
    const float* mu = a.in[7];
    bf16x8 fw[2], fa[2], fg[4];
    { const bf16* wlt = (const bf16*)(a.ws + WS_WLT) + (size_t)h * 4096 + (16 * mt + fr) * 64 + 8 * fq; const bf16* wat = (const bf16*)(a.ws + WS_WAT) + (size_t)h * 4096 + (16 * mt + fr) * 64 + 8 * fq;
      const bf16* wgt = (const bf16*)(a.ws + WS_WGT) + (size_t)h * 8192 + (16 * mt + fr) * 128 + 8 * fq;
      fw[0] = *(const bf16x8*)wlt; fw[1] = *(const bf16x8*)(wlt + 32); fa[0] = *(const bf16x8*)wat; fa[1] = *(const bf16x8*)(wat + 32);
#pragma unroll
      for (int ks = 0; ks < 4; ++ks) fg[ks] = *(const bf16x8*)(wgt + 32 * ks); }
    float* CST = (float*)(lds + OFF_CST);
    for (int i = tid; i < 14 * 64; i += 512) { const int blk = i >> 6, jj = i & 63; float v;
        if (blk < 3) v = mu[blk * 512 + h * 64 + jj]; else if (blk < 7) v = mu[1536 + (blk - 3) * 64 + jj]; else v = a.in[blk == 7 ? 8 : blk == 8 ? 10 : blk == 9 ? 13 : blk == 10 ? 14 : blk == 11 ? 15 : blk == 12 ? 16 : 17][h * 64 + jj];
        CST[i] = v; }
    int s0i = I_X14, aki = I_X5;
    for (int i = tid; i < MB / 4; i += 512) ((unsigned*)BUF(I_X14))[i] = 0u;
    LBAR();
    int pt = tid >> 3, j0 = 8 * (tid & 7);
    const int colh = h * 64 + j0;
    const int zoff0 = colh, zoff1 = 512 + colh, zoff2 = 1024 + colh;
    const bf16* actb = (const bf16*)(a.ws + WS_ACT);
    v4u zc[3], zq[3], za[4];
#define ZLOAD(cc) do { const size_t tr_ = (size_t)b * SEQ + (cc) * 64 + pt; const bf16* zr_ = z + tr_ * INC; const bf16* zs_ = ((cc) * 64 + pt) > 0 ? zr_ - INC : zr_; const bf16* ar_ = actb + tr_ * 256 + j0; \
        zc[0] = *(const v4u*)(zr_ + zoff0); zc[1] = *(const v4u*)(zr_ + zoff1); zc[2] = *(const v4u*)(zr_ + zoff2); \
        zq[0] = *(const v4u*)(zs_ + zoff0); zq[1] = *(const v4u*)(zs_ + zoff1); zq[2] = *(const v4u*)(zs_ + zoff2); \
        za[0] = *(const v4u*)(ar_); za[1] = *(const v4u*)(ar_ + 64); za[2] = *(const v4u*)(ar_ + 128); za[3] = *(const v4u*)(ar_ + 192); } while (0)
#define ESTAGE(VTB, TT_) \
        { float y[8], vv[8], g8[8], lg[8], lb[8]; ld8fs(YTF, pt, j0, y); ld8bf((VTB) + SW(pt, j0), vv); ld8bf(BUF(I_GATE) + SW(pt, j0), g8); \
          ld8f(CST + 12 * 64 + j0, lg); ld8f(CST + 13 * 64 + j0, lb); \
          float sm = 0.f; \
_Pragma("unroll") \
          for (int e = 0; e < 8; ++e) sm += y[e]; \
          const float mean = red8(sm) * (1.0f / 64.0f); float sq = 0.f; \
_Pragma("unroll") \
          for (int e = 0; e < 8; ++e) { y[e] -= mean; sq += y[e] * y[e]; } \
          const float rstd = rsqrtf(red8(sq) * (1.0f / 64.0f) + 64e-5f), bon = BON[pt]; \
_Pragma("unroll") \
          for (int e = 0; e < 8; ++e) y[e] = (y[e] * rstd * lg[e] + lb[e] + bon * vv[e]) * g8[e]; \
          ypend.x = pk2(y[0], y[1]); ypend.y = pk2(y[2], y[3]); ypend.z = pk2(y[4], y[5]); ypend.w = pk2(y[6], y[7]); ypoff = (TT_) * RWW + colh; }
    ZLOAD(0);
    v4u ypend = {0u, 0u, 0u, 0u}; size_t ypoff = 0;
    for (int c = 0; c < SEQ / 64; ++c) {
        asm volatile("" : "+v"(fr), "+v"(fq), "+v"(pt), "+v"(j0));
        const int s = c * 64 + pt; const size_t t = (size_t)b * SEQ + s; const bool hasp = s > 0;
        if (c > 0) { ESTAGE(((c - 1) & 1) ? BUF(I_VT2) : BUF(I_VT), t - 64) }
        { float v[8];
          shift8(zc[0], zq[0], hasp, CST + 0 * 64 + j0, v); st8bf(BUF(I_RT) + SW(pt, j0), v);
          shift8(zc[1], zq[1], hasp, CST + 1 * 64 + j0, v); st8bf(BUF(I_KT) + SW(pt, j0), v);
          { float kkc[8], ss = 0.f; ld8f(CST + 9 * 64 + j0, kkc);
#pragma unroll
            for (int e = 0; e < 8; ++e) { const float q = v[e] * kkc[e]; ss += q * q; }
            ss = red8(ss); if (j0 == 0) SSQ[pt] = ss; }
          shift8(zc[2], zq[2], hasp, CST + 2 * 64 + j0, v); st8bf(((c & 1) ? BUF(I_VT2) : BUF(I_VT)) + SW(pt, j0), v);
          *(v4u*)(ACTW + SW(pt, j0)) = za[0]; *(v4u*)(ACTA + SW(pt, j0)) = za[1]; *(v4u*)(ACTG + SWG(pt, j0)) = za[2]; *(v4u*)(ACTG + SWG(pt, 64 + j0)) = za[3]; }
        LBAR();
        f32x4 aw[2], aa[2], ag[2];
#pragma unroll
        for (int nt = 0; nt < 2; ++nt) { const int tr = 16 * (2 * nh + nt) + fr; const f32x4 zero = {0.f, 0.f, 0.f, 0.f};
            aw[nt] = __builtin_amdgcn_mfma_f32_16x16x32_bf16(fw[0], ldfrag(ACTW, tr, 8 * fq), zero, 0, 0, 0); aw[nt] = __builtin_amdgcn_mfma_f32_16x16x32_bf16(fw[1], ldfrag(ACTW, tr, 8 * fq + 32), aw[nt], 0, 0, 0);
            aa[nt] = __builtin_amdgcn_mfma_f32_16x16x32_bf16(fa[0], ldfrag(ACTA, tr, 8 * fq), zero, 0, 0, 0); aa[nt] = __builtin_amdgcn_mfma_f32_16x16x32_bf16(fa[1], ldfrag(ACTA, tr, 8 * fq + 32), aa[nt], 0, 0, 0);
            ag[nt] = zero;
#pragma unroll
            for (int ks = 0; ks < 4; ++ks) ag[nt] = __builtin_amdgcn_mfma_f32_16x16x32_bf16(fg[ks], *(const bf16x8*)(ACTG + SWG(tr, 8 * fq + 32 * ks)), ag[nt], 0, 0, 0); }
#pragma unroll
        for (int nt = 0; nt < 2; ++nt) { const int tr = 16 * (2 * nh + nt) + fr, jc = 16 * mt + 4 * fq;
            *(f32x4*)(LWR + SWF(tr, jc)) = aw[nt]; *(f32x4*)(LAR + SWF(tr, jc)) = aa[nt]; *(f32x4*)(LGR + SWF(tr, jc)) = ag[nt]; }
        LBAR();
        float lwv[8], an[8], bb[8], k2[8], rr[8], gg[8], vv8[8], p8[8];
        { const int j = lane, tw = wid;
          const float w0c = CST[7 * 64 + j], a0c = CST[8 * 64 + j], kkc = CST[9 * 64 + j], kac = CST[10 * 64 + j], rkc = CST[11 * 64 + j];
          const unsigned char* vtb = (c & 1) ? BUF(I_VT2) : BUF(I_VT);
          float bo[8], av[8];
#pragma unroll
          for (int u = 0; u < 8; ++u) { const int t8 = 8 * tw + u;
              const float lw = *(const float*)(LWR + SWF(t8, j)), la = *(const float*)(LAR + SWF(t8, j)); gg[u] = *(const float*)(LGR + SWF(t8, j));
              rr[u] = bflo(*(const unsigned short*)(BUF(I_RT) + SW(t8, j))); const float kx = bflo(*(const unsigned short*)(BUF(I_KT) + SW(t8, j))); vv8[u] = bflo(*(const unsigned short*)(vtb + SW(t8, j)));
              lwv[u] = -0.606531f * sigm(w0c + lw); av[u] = sigm(a0c + la);
              const float kn = kx * kkc * rsqrtf(fmaxf(SSQ[t8], 1e-24f)); an[u] = -kn; bb[u] = kn * av[u];
              k2[u] = kx * (1.0f + (av[u] - 1.0f) * kac); bo[u] = rr[u] * k2[u] * rkc; }
          wave_sum8(bo);
          if (j == 0) {
#pragma unroll
              for (int u = 0; u < 8; ++u) BON[8 * tw + u] = bo[u]; }
          p8[0] = lwv[0];
#pragma unroll
          for (int u = 1; u < 8; ++u) p8[u] = p8[u - 1] + lwv[u];
          SEGT[tw * 64 + j] = p8[7]; }
        LBAR();
        { const int j = lane, tw = wid; float sg8[8];
#pragma unroll
          for (int s2 = 0; s2 < 8; ++s2) sg8[s2] = SEGT[s2 * 64 + j];
          float base = 0.f, tot = 0.f;
#pragma unroll
          for (int s2 = 0; s2 < 8; ++s2) { tot += sg8[s2]; base += (s2 < tw) ? sg8[s2] : 0.f; }
          const float gcj = __expf(tot); if (tw == 7) GC[j] = gcj;
          float eprev = __expf(base);
          float o0[8], ob[8], ok[8];
#pragma unroll
          for (int u = 0; u < 8; ++u) { const int t8 = 8 * tw + u; const float L = p8[u] + base; const float e1 = __expf(L), ie1 = __builtin_amdgcn_rcpf(e1), ep = eprev, eh = gcj * ie1; eprev = e1;
              o0[u] = an[u] * ep; ob[u] = bb[u] * eh; ok[u] = k2[u] * eh;
              *(unsigned short*)(BUF(I_AT) + SW(t8, j)) = (unsigned short)f2bf(o0[u]); *(unsigned short*)(BUF(I_BT) + SW(t8, j)) = (unsigned short)f2bf(bb[u] * ie1);
              *(unsigned short*)(BUF(I_KT) + SW(t8, j)) = (unsigned short)f2bf(k2[u] * ie1); *(unsigned short*)(BUF(I_RT) + SW(t8, j)) = (unsigned short)f2bf(rr[u] * e1);
              *(unsigned short*)(BUF(I_GATE) + SW(t8, j)) = (unsigned short)f2bf(gg[u]); }
          st8bf(BUF(I_AJ) + SW(j, 8 * tw), o0); st8bf(BUF(I_BHJ) + SW(j, 8 * tw), ob); st8bf(BUF(I_KHJ) + SW(j, 8 * tw), ok); st8bf(BUF(I_VJ) + SW(j, 8 * tw), vv8); }
        if (c > 0) *(v4u*)(ya + ypoff) = ypend;
        if (c + 1 < SEQ / 64) ZLOAD(c + 1);
        LBAR();
#define MASK(acc, cond) _Pragma("unroll") for (int nt = 0; nt < 2; ++nt) _Pragma("unroll") for (int r = 0; r < 4; ++r) { const int m_ = 16 * mt + 4 * fq + r, n_ = 16 * (2 * nh + nt) + fr; if (!(cond)) acc[nt][r] = 0.f; }
        { const f32x4 zero = {0.f, 0.f, 0.f, 0.f}; f32x4 aL[2] = {zero, zero}, aK[2] = {zero, zero}, aR[2] = {zero, zero};
          const FA fAT = ldA(BUF(I_AT), mt, fr, fq), fBTa = ldA(BUF(I_BT), mt, fr, fq); const FB fBT = ldB(BUF(I_BT), nh, fr, fq), fKT = ldB(BUF(I_KT), nh, fr, fq), fRT = ldB(BUF(I_RT), nh, fr, fq);
          mma(aL, fAT, fBT);
          mma(aK, fAT, fKT);
          mma(aR, fBTa, fRT);
          MASK(aL, m_ > n_) MASK(aK, n_ < m_) MASK(aR, m_ <= n_)
          storeN(BUF(I_L), aL, mt, nh, fr, fq); storeT(BUF(I_LT), aL, mt, nh, fr, fq);
#pragma unroll
          for (int nt = 0; nt < 2; ++nt)
#pragma unroll
              for (int r = 0; r < 4; ++r) { const int m_ = 16 * mt + 4 * fq + r, n_ = 16 * (2 * nh + nt) + fr; if (m_ == n_) aL[nt][r] = 1.0f; }
          storeN(BUF(I_R0), aL, mt, nh, fr, fq);
          storeT(BUF(aki), aK, mt, nh, fr, fq);
          storeT(BUF(I_ABRT), aR, mt, nh, fr, fq); }
        LBAR();
#pragma unroll
        for (int k = 1; k <= 6; ++k) {
            unsigned char* Pc = (k & 1) ? BUF(I_L) : BUF(I_AT); unsigned char* PTc = (k & 1) ? BUF(I_LT) : BUF(I_BT);
            unsigned char* Pn = (k & 1) ? BUF(I_AT) : BUF(I_L); unsigned char* PTn = (k & 1) ? BUF(I_BT) : BUF(I_LT);
            unsigned char* Rc = (k & 1) ? BUF(I_R1) : BUF(I_R0); unsigned char* Rn = (k & 1) ? BUF(I_R0) : BUF(I_R1);
            const f32x4 zero = {0.f, 0.f, 0.f, 0.f}; f32x4 aP[2] = {zero, zero}, aRr[2] = {zero, zero};
            FA fP, fPTa; FB fPT, fR;
            if (k <= 5) { fP = ldA(Pc, mt, fr, fq); fPT = ldB(PTc, nh, fr, fq); }
            if (k >= 2) { fPTa = ldA(PTc, mt, fr, fq); fR = ldB(Rc, nh, fr, fq); ldC(aRr, Rc, mt, nh, fr, fq); }
            if (k <= 5) mma(aP, fP, fPT);
            if (k >= 2) mma(aRr, fPTa, fR);
            if (k <= 5) { storeN(Pn, aP, mt, nh, fr, fq); storeT(PTn, aP, mt, nh, fr, fq); }
            if (k >= 2) storeT(Rn, aRr, mt, nh, fr, fq);
            LBAR();
        }
        { const f32x4 zero = {0.f, 0.f, 0.f, 0.f}; f32x4 a1[2] = {zero, zero}, a2[2] = {zero, zero};
          const FA fTT = ldA(BUF(I_R1), mt, fr, fq); const FB fAJ = ldB(BUF(I_AJ), nh, fr, fq), fAK = ldB(BUF(aki), nh, fr, fq);
          mma(a1, fTT, fAJ); mma(a2, fTT, fAK);
          storeT(BUF(I_L), a1, mt, nh, fr, fq);
          storeT(BUF(I_LT), a2, mt, nh, fr, fq); }
        LBAR();
        { const f32x4 zero = {0.f, 0.f, 0.f, 0.f}; f32x4 aMY[2], aNY[2] = {zero, zero}, aMS[2] = {zero, zero}, aNS[2];
          const FA fG1 = ldA(BUF(I_L), mt, fr, fq), fG2 = ldA(BUF(I_LT), mt, fr, fq), fKTa = ldA(BUF(I_KT), mt, fr, fq);
          const FB fAB = ldB(BUF(I_ABRT), nh, fr, fq), fRT = ldB(BUF(I_RT), nh, fr, fq), fBH = ldB(BUF(I_BHJ), nh, fr, fq);
          ldC(aMY, BUF(I_RT), mt, nh, fr, fq); ldC(aNS, BUF(I_KHJ), mt, nh, fr, fq);
          mma(aNY, fKTa, fRT);
          mma(aMY, fG1, fAB);
          mma(aMS, fG1, fBH);
          mma(aNS, fG2, fBH);
          MASK(aNY, m_ <= n_)
          mma(aNY, fG2, fAB);
#pragma unroll
          for (int nt = 0; nt < 2; ++nt)
#pragma unroll
              for (int r = 0; r < 4; ++r) { const int m_ = 16 * mt + 4 * fq + r, n_ = 16 * (2 * nh + nt) + fr; if (m_ == n_) aMS[nt][r] += GC[m_]; }
          storeT(BUF(I_AT), aMY, mt, nh, fr, fq); storeT(BUF(I_BT), aNY, mt, nh, fr, fq); storeT(BUF(I_AJ), aMS, mt, nh, fr, fq); storeT(BUF(I_R0), aNS, mt, nh, fr, fq); }
        LBAR();
        { const f32x4 zero = {0.f, 0.f, 0.f, 0.f}; f32x4 aY[2] = {zero, zero}, aS[2] = {zero, zero};
          const FA fS0a = ldA(BUF(s0i), mt, fr, fq), fVJa = ldA(BUF(I_VJ), mt, fr, fq), fMS = ldA(BUF(I_AJ), mt, fr, fq), fNS = ldA(BUF(I_R0), mt, fr, fq);
          const FB fMY = ldB(BUF(I_AT), nh, fr, fq), fNY = ldB(BUF(I_BT), nh, fr, fq), fS0 = ldB(BUF(s0i), nh, fr, fq), fVJ = ldB(BUF(I_VJ), nh, fr, fq);
          mma(aY, fS0a, fMY); mma(aS, fMS, fS0); mma(aY, fVJa, fNY); mma(aS, fNS, fVJ);
#pragma unroll
          for (int nt = 0; nt < 2; ++nt) *(f32x4*)(YTF + SWF(16 * (2 * nh + nt) + fr, 16 * mt + 4 * fq)) = aY[nt];
          storeT(BUF(aki), aS, mt, nh, fr, fq); }
        LBAR();
#undef MASK
        { const int tmp = s0i; s0i = aki; aki = tmp; }
    }
    { const int c = SEQ / 64; const size_t tprev = (size_t)b * SEQ + (c - 1) * 64 + pt; ESTAGE(((c - 1) & 1) ? BUF(I_VT2) : BUF(I_VT), tprev) }
    *(v4u*)(ya + ypoff) = ypend;
    LBAR();
#undef ESTAGE
#undef BUF
#undef ZLOAD
}
#undef LBAR
}

__device__ __forceinline__ void p_norm2_route(const PArgs& a, unsigned char* lds, int wv) {
    typedef short bf16x8 __attribute__((ext_vector_type(8)));
    const int tid = mktid(wv), lane = tid & 63, fr = lane & 15, fq = lane >> 4;
    const bf16* x1 = (const bf16*)(a.ws + WS_X1B); const float* mod = (const float*)(a.ws + WS_MOD); const float* gm2 = (const float*)(a.ws + WS_GM2); const float* cbt = (const float*)(a.ws + WS_CB);
    int* rte = (int*)(a.ws + WS_RTE); float* rtw = (float*)(a.ws + WS_RTW); int* rnk = (int*)(a.ws + WS_RNK); unsigned* cnt = (unsigned*)(a.ws + WS_CTL) + CW_CNT;
    float* PL = (float*)lds;
    float* PS = PL + 8 * 32 * 48;
    float* RS_ = PS + 8 * 32;
    float* FL = RS_ + 32;
    unsigned* HIST = (unsigned*)(FL + 32 * 48);
    unsigned* LRK = HIST + 32;
    if (tid < 32) HIST[tid] = 0u;
    __syncthreads();
    int gcount = 0;
    bf16x8 wh[4][3], wl[4][3];
    { const bf16* wrh = (const bf16*)(a.ws + WS_WRH) + fr * 1024 + 128 * wv + 8 * fq; const bf16* wrl = (const bf16*)(a.ws + WS_WRL) + fr * 1024 + 128 * wv + 8 * fq;
#pragma unroll
      for (int ks = 0; ks < 4; ++ks)
#pragma unroll
          for (int nt = 0; nt < 3; ++nt) { wh[ks][nt] = *(const bf16x8*)(wrh + nt * 16 * 1024 + 32 * ks); wl[ks][nt] = *(const bf16x8*)(wrl + nt * 16 * 1024 + 32 * ks); } }
    for (int grp = blockIdx.x; grp < NT / 32; grp += gridDim.x) {
        const int row0 = grp * 32, b = row0 >> 11;
        f32x4 acc[3][2];
#pragma unroll
        for (int nt = 0; nt < 3; ++nt) { acc[nt][0] = (f32x4){0.f, 0.f, 0.f, 0.f}; acc[nt][1] = acc[nt][0]; }
        float ssq[2] = {0.f, 0.f};
#pragma unroll
        for (int rt = 0; rt < 2; ++rt) {
            float xs[4][8];
#pragma unroll
            for (int ks = 0; ks < 4; ++ks) rw::ld8bf((const unsigned char*)(x1 + (size_t)(row0 + 16 * rt + fr) * DM + 128 * wv + 32 * ks + 8 * fq), xs[ks]);
#pragma unroll
            for (int ks = 0; ks < 4; ++ks) { float gm[8]; rw::ld8f(gm2 + b * 1024 + 128 * wv + 32 * ks + 8 * fq, gm); unsigned hw[4], lw[4];
#pragma unroll
                for (int e = 0; e < 4; ++e) { const float x0 = xs[ks][2 * e], x1v = xs[ks][2 * e + 1]; ssq[rt] += x0 * x0 + x1v * x1v; const float g0 = x0 * gm[2 * e], g1 = x1v * gm[2 * e + 1];
                    hw[e] = pk2(g0, g1); lw[e] = pk2(g0 - bflo(hw[e]), g1 - bfhi(hw[e])); }
                const v4u hv = {hw[0], hw[1], hw[2], hw[3]}, lv = {lw[0], lw[1], lw[2], lw[3]}; const bf16x8 bh = __builtin_bit_cast(bf16x8, hv), bl = __builtin_bit_cast(bf16x8, lv);
#pragma unroll
                for (int nt = 0; nt < 3; ++nt) { acc[nt][rt] = __builtin_amdgcn_mfma_f32_16x16x32_bf16(wh[ks][nt], bh, acc[nt][rt], 0, 0, 0); acc[nt][rt] = __builtin_amdgcn_mfma_f32_16x16x32_bf16(wl[ks][nt], bh, acc[nt][rt], 0, 0, 0);
                    acc[nt][rt] = __builtin_amdgcn_mfma_f32_16x16x32_bf16(wh[ks][nt], bl, acc[nt][rt], 0, 0, 0); } } }
#pragma unroll
        for (int rt = 0; rt < 2; ++rt) {
#pragma unroll
            for (int nt = 0; nt < 3; ++nt) *(f32x4*)(PL + (wv * 32 + 16 * rt + fr) * 48 + 16 * nt + 4 * fq) = acc[nt][rt];
            float s = ssq[rt]; s += __builtin_bit_cast(float, __builtin_amdgcn_ds_swizzle(__builtin_bit_cast(int, s), 0x401F));
            { const unsigned u = __builtin_bit_cast(unsigned, s); auto rr = __builtin_amdgcn_permlane32_swap(u, u, false, false); s = __builtin_bit_cast(float, (unsigned)rr[0]) + __builtin_bit_cast(float, (unsigned)rr[1]); }
            if (fq == 0) PS[wv * 32 + 16 * rt + fr] = s; }
        __syncthreads();
        { const int r = tid >> 4, c = tid & 15; float s0 = 0.f, s1 = 0.f, s2 = 0.f, sq = 0.f;
#pragma unroll
          for (int w = 0; w < 8; ++w) { const float* p = PL + (w * 32 + r) * 48; s0 += p[c]; s1 += p[c + 16]; s2 += p[c + 32]; sq += PS[w * 32 + r]; }
          const float rstd = rsqrtf(sq * (1.0f / DM) + 1e-6f); const float* cb = cbt + b * 48;
          FL[r * 48 + c] = rstd * s0 + cb[c]; FL[r * 48 + c + 16] = rstd * s1 + cb[c + 16]; FL[r * 48 + c + 32] = rstd * s2 + cb[c + 32];
          if (c == 0) ((float*)(a.ws + WS_RSTD))[row0 + r] = rstd; }
        __syncthreads();
        if (tid < 32) { const int m = row0 + tid; const float* lg = FL + tid * 48;
            int gi = 0; float gm = lg[0];
#pragma unroll
            for (int i = 1; i < 4; ++i) if (lg[i] > gm) { gm = lg[i]; gi = i; }
            float gs = 0.f;
#pragma unroll
            for (int i = 0; i < 4; ++i) gs += __expf(lg[i] - gm);
            const float pg = 1.0f / gs;
            float el[8];
#pragma unroll
            for (int k = 0; k < 8; ++k) el[k] = lg[4 + gi * 8 + k];
            int e1 = 0; float m1 = el[0];
#pragma unroll
            for (int k = 1; k < 8; ++k) if (el[k] > m1) { m1 = el[k]; e1 = k; }
            int e2 = -1; float m2 = -INFINITY;
#pragma unroll
            for (int k = 0; k < 8; ++k) if (k != e1 && el[k] > m2) { m2 = el[k]; e2 = k; }
            const float q2 = __expf(m2 - m1); const float w1 = pg / (1.0f + q2), w2 = pg * q2 / (1.0f + q2);
            const int ea = gi * 8 + e1, eb = gi * 8 + e2; rte[2 * m] = ea; rte[2 * m + 1] = eb; rtw[2 * m] = w1; rtw[2 * m + 1] = w2;
            LRK[gcount * 64 + 2 * tid] = atomicAdd(HIST + ea, 1u) | ((unsigned)ea << 24); LRK[gcount * 64 + 2 * tid + 1] = atomicAdd(HIST + eb, 1u) | ((unsigned)eb << 24); }
        ++gcount;
        __syncthreads();
    }
    if (tid < 32) { const unsigned n = HIST[tid]; HIST[tid] = n ? atomicAdd(cnt + tid * CNT_PAD, n) : 0u; }
    __syncthreads();
    for (int i = tid; i < gcount * 64; i += 512) { const int gi_ = i >> 6, e = i & 63; const int m2 = 2 * ((blockIdx.x + gi_ * gridDim.x) * 32) + e; const unsigned lr = LRK[i]; rnk[m2] = (int)(HIST[lr >> 24] + (lr & 0xffffffu)); }
    __syncthreads();
}
__device__ __forceinline__ void p_moe_gather(const PArgs& a, unsigned char* lds, int wv) {
    int* off = (int*)lds;
    const int tid = mktid(wv), lane = tid & 63, gw = blockIdx.x * 8 + (tid >> 6), NGW = gridDim.x * 8;
    int* ctl = (int*)(a.ws + WS_CTL); const unsigned* cnt = (const unsigned*)ctl + CW_CNT;
    if (tid == 0) { int o = 0, nt = 0;
        for (int e = 0; e < NEXP; ++e) { off[e] = o; const int tiles = ((int)cnt[e * CNT_PAD] + 255) >> 8;
            if (blockIdx.x == 0) for (int i = 0; i < tiles; ++i) ctl[CW_TEXP + nt + i] = e;
            nt += tiles; o += tiles * 256; }
        if (blockIdx.x == 0) ctl[CW_NT] = nt; }
    __syncthreads();
    const int* rte = (const int*)(a.ws + WS_RTE); const int* rnk = (const int*)(a.ws + WS_RNK); int* pos = (int*)(a.ws + WS_POS);
    const bf16* x1 = (const bf16*)(a.ws + WS_X1B); bf16* xs = (bf16*)(a.ws + WS_XS); const float* rstdv = (const float*)(a.ws + WS_RSTD);
    const float* mod = (const float*)(a.ws + WS_MOD); const float* gm2 = (const float*)(a.ws + WS_GM2);
    for (int t = gw; t < NT; t += NGW) { const int b = t >> 11; const int p0 = off[rte[2 * t]] + rnk[2 * t], p1 = off[rte[2 * t + 1]] + rnk[2 * t + 1]; if (lane == 0) { pos[2 * t] = p0; pos[2 * t + 1] = p1; }
        const float rstd = rstdv[t];
#pragma unroll
        for (int hf = 0; hf < 2; ++hf) { const int col = 8 * lane + 512 * hf; float xv[8], gm[8], sh[8], o[8];
            rw::ld8bf((const unsigned char*)(x1 + (size_t)t * DM + col), xv); rw::ld8f(gm2 + b * 1024 + col, gm); rw::ld8f(mod + b * 6144 + 3072 + col, sh);
#pragma unroll
            for (int e = 0; e < 8; ++e) o[e] = xv[e] * gm[e] * rstd + sh[e];
            v4u w; w.x = pk2(o[0], o[1]); w.y = pk2(o[2], o[3]); w.z = pk2(o[4], o[5]); w.w = pk2(o[6], o[7]);
            *(v4u*)(xs + (size_t)p0 * DM + col) = w; *(v4u*)(xs + (size_t)p1 * DM + col) = w; } }
}
__device__ __forceinline__ void p_combine(const PArgs& a, unsigned char* lds, int wv) {
    const int tid = mktid(wv), lane = tid & 63, gw = blockIdx.x * 8 + (tid >> 6), NGW = gridDim.x * 8;
    const float* mod = (const float*)(a.ws + WS_MOD); const int* pos = (const int*)(a.ws + WS_POS); const float* rtw = (const float*)(a.ws + WS_RTW);
    const bf16* ys = (const bf16*)(a.ws + WS_XS); float* out = a.out;
    for (int m = gw; m < NT; m += NGW) { const int b = m >> 11; const int p0 = pos[2 * m], p1 = pos[2 * m + 1]; const float w0 = rtw[2 * m], w1 = rtw[2 * m + 1];
        f32x4* o = (f32x4*)(out + (size_t)m * DM) + lane; const v2u* xb = (const v2u*)((const bf16*)(a.ws + WS_X1B) + (size_t)m * DM) + lane; const v2u* y0 = (const v2u*)(ys + (size_t)p0 * DM) + lane; const v2u* y1 = (const v2u*)(ys + (size_t)p1 * DM) + lane;
#pragma unroll
        for (int j = 0; j < 4; ++j) { const int col = 4 * (lane + 64 * j); const f32x4 g2 = *(const f32x4*)(mod + b * 6144 + 5120 + col); const v2u a0 = y0[64 * j], a1 = y1[64 * j];
            const f32x4 e0 = {bflo(a0.x), bfhi(a0.x), bflo(a0.y), bfhi(a0.y)}, e1 = {bflo(a1.x), bfhi(a1.x), bflo(a1.y), bfhi(a1.y)};
            const v2u xw = xb[64 * j]; const f32x4 xv = {bflo(xw.x), bfhi(xw.x), bflo(xw.y), bfhi(xw.y)};
            o[64 * j] = xv + g2 * (e0 * w0 + e1 * w1); } }
}

#define XB_TMO      128
#define XB_XCNT(j)  (256  + 64 * (j))
#define XB_XSUB(j)  (1280 + 64 * (j))
#define XB_XGEN(j)  (2304 + 64 * (j))
#define XB_TOP      3328
#define XB_TOPGEN   3392
#define XCD_BAR_WORDS 3456
#define XB_SPIN_CAP (1u << 22)

__device__ __forceinline__ unsigned xb_ld(unsigned* p)              { return __hip_atomic_load(p, __ATOMIC_RELAXED, __HIP_MEMORY_SCOPE_AGENT); }
__device__ __forceinline__ unsigned xb_add(unsigned* p, unsigned v) { return __hip_atomic_fetch_add(p, v, __ATOMIC_RELAXED, __HIP_MEMORY_SCOPE_AGENT); }
__device__ __forceinline__ unsigned xb_xcc_id() { return (unsigned)__builtin_amdgcn_s_getreg((3 << 11) | 20) & 0xFu; }
#define XB_SPIN(cond, bar) do { unsigned _sp = 0; while (cond) { __builtin_amdgcn_s_sleep(1); \
    if ((++_sp & 255u) == 0u) { if (xb_ld(&(bar)[XB_TMO])) break; if (_sp > XB_SPIN_CAP) { atomicAdd(&(bar)[XB_TMO], 1u); break; } } } } while (0)

struct XcdBarrier {
    unsigned* bar; unsigned x;
    volatile LAS unsigned* st;
};

__device__ __forceinline__ XcdBarrier xcd_barrier_post(unsigned* bar, volatile LAS unsigned* st, int wv) {
    XcdBarrier b; b.bar = bar; b.x = xb_xcc_id(); b.st = st;
    if (mktid(wv) == 0) (void)xb_add(&bar[XB_XCNT(b.x)], 1u);
    return b;
}
__device__ __forceinline__ void xcd_barrier_complete(unsigned* bar, unsigned x, unsigned& nloc, unsigned& nx) {
    const unsigned G = gridDim.x * gridDim.y * gridDim.z;
    unsigned sum, cnt, mine, sp = 0u;
    for (;;) {
        sum = 0u; cnt = 0u; mine = 0u;
#pragma unroll
        for (unsigned j = 0; j < 16; ++j) { const unsigned c = xb_ld(&bar[XB_XCNT(j)]); sum += c; cnt += (c > 0u) ? 1u : 0u; mine = (j == x) ? c : mine; }
        if (sum == G) break;
        __builtin_amdgcn_s_sleep(1);
        if ((++sp & 255u) == 0u) { if (xb_ld(&bar[XB_TMO])) break; if (sp > XB_SPIN_CAP) { atomicAdd(&bar[XB_TMO], 1u); break; } }
    }
    nloc = mine > 0u ? mine : 1u; nx = cnt > 0u ? cnt : 1u;
}

__device__ __forceinline__ void xcd_barrier(const XcdBarrier& b, int wv) {
    asm volatile("s_waitcnt vmcnt(0)" ::: "memory");
    __syncthreads();
    if (mktid(wv) == 0) {
        unsigned* bar = b.bar;
        __builtin_amdgcn_s_waitcnt(0);
        unsigned nloc = b.st[0], nx = b.st[1];
        if (nloc == 0u) { xcd_barrier_complete(bar, b.x, nloc, nx); b.st[0] = nloc; b.st[1] = nx; }
        const unsigned old = xb_add(&bar[XB_XSUB(b.x)], 1u);
        const unsigned gen = old / nloc;
        if (old + 1u == (gen + 1u) * nloc) {
            __builtin_amdgcn_fence(__ATOMIC_RELEASE, "agent");
            asm volatile("s_waitcnt vmcnt(0)" ::: "memory");
            const unsigned og = xb_add(&bar[XB_TOP], 1u);
            const unsigned tg = og / nx;
            if (og + 1u == (tg + 1u) * nx) xb_add(&bar[XB_TOPGEN], 1u);
            else XB_SPIN(xb_ld(&bar[XB_TOPGEN]) == tg, bar);
            __builtin_amdgcn_fence(__ATOMIC_ACQUIRE, "agent");
            xb_add(&bar[XB_XGEN(b.x)], 1u);
            asm volatile("s_waitcnt vmcnt(0)" ::: "memory");
        } else {
            XB_SPIN(xb_ld(&bar[XB_XGEN(b.x)]) == gen, bar);
            __builtin_amdgcn_fence(__ATOMIC_ACQUIRE, "agent");
            asm volatile("s_waitcnt vmcnt(0)" ::: "memory");
        }
    }
    __syncthreads();
}

constexpr int LDS_BYTES = 160 * 1024, MISC_OFF = LDS_BYTES - 256;
static_assert(rw::LDS_NEED <= MISC_OFF, "scan LDS");
constexpr int CW_BAR = 4096;

__global__ void __launch_bounds__(512, 2) mega_fwd(PArgs a) {
    extern __shared__ __attribute__((aligned(16))) unsigned char lds[];
    volatile LAS unsigned* MISC = (volatile LAS unsigned*)((LAS unsigned char*)lds + MISC_OFF);
    const int wv = __builtin_amdgcn_readfirstlane((int)threadIdx.x >> 6);
    { const int t0 = mktid(wv); if (t0 < 64) MISC[t0] = 0u; }
    __syncthreads();
    XcdBarrier bar = xcd_barrier_post((unsigned*)(a.ws + WS_CTL) + CW_BAR, MISC + 8, wv);
    GemmArgs g; g.ws = a.ws; g.x = a.in[0]; g.out = a.out; g.qg = a.in[18]; g.kg = a.in[19];
    const int G = (int)gridDim.x, bx = (int)blockIdx.x;

    p_prep_weights(a, lds, wv); __syncthreads(); p_ada(a, lds, wv);
    xcd_barrier(bar, wv);
    p_norm1(a, lds, wv);
    xcd_barrier(bar, wv);
    p_gemm_in(g, lds, wv);
    xcd_barrier(bar, wv);
    p_actprep(a, lds, wv);
    xcd_barrier(bar, wv);
    { const int nscan = G / 2;
      if (bx < nscan) { for (int bh = bx; bh < 128; bh += nscan) rw::scan_unit(a, lds, bh, wv); }
      else p_attn(a, lds, bx - nscan, G - nscan, wv); }
    __syncthreads(); p_prep_experts_dyn(a, lds, wv);
    xcd_barrier(bar, wv);
    p_gemm_merge(g, lds, wv);
    xcd_barrier(bar, wv);
    p_gemm_out(g, lds, wv);
    xcd_barrier(bar, wv);
    p_norm2_route(a, lds, wv);
    xcd_barrier(bar, wv);
    p_moe_gather(a, lds, wv);
    xcd_barrier(bar, wv);
    p_gemm_up(g, lds, wv);
    xcd_barrier(bar, wv);
    p_gemm_down(g, lds, wv);
    xcd_barrier(bar, wv);
    p_combine(a, lds, wv);
}

extern "C" void kernel_launch(void* const* d_in, const int* in_sizes, int n_in, void* d_out, int out_size, void* d_ws, size_t ws_size, hipStream_t stream) {
    static int grid = 0;
    if (grid == 0) {
        if (n_in != 30 || out_size != NT * DM || ws_size < WS_END) { fprintf(stderr, "kernel_launch: unexpected shapes (n_in %d, out %d, ws %zu)\n", n_in, out_size, ws_size); grid = -1; return; }
        int dev = 0, cus = 0, per_cu = 0;
        if (hipGetDevice(&dev) != hipSuccess || hipDeviceGetAttribute(&cus, hipDeviceAttributeMultiprocessorCount, dev) != hipSuccess) { grid = -1; return; }
        if (hipFuncSetAttribute((const void*)mega_fwd, hipFuncAttributeMaxDynamicSharedMemorySize, LDS_BYTES) != hipSuccess) { fprintf(stderr, "kernel_launch: hipFuncSetAttribute failed\n"); grid = -1; return; }
        if (hipOccupancyMaxActiveBlocksPerMultiprocessor(&per_cu, (const void*)mega_fwd, 512, LDS_BYTES) != hipSuccess || per_cu < 1) { fprintf(stderr, "kernel_launch: occupancy query says %d blocks per CU\n", per_cu); (void)hipGetLastError(); grid = -1; return; }
        grid = cus;
    }
    if (grid < 0) return;
    (void)hipMemsetAsync((char*)d_ws + WS_CTL, 0, 65536, stream);
    PArgs p{}; for (int i = 0; i < 30; ++i) p.in[i] = (const float*)d_in[i]; p.out = (float*)d_out; p.ws = (unsigned char*)d_ws;
    hipLaunchKernelGGL(mega_fwd, dim3(grid), dim3(512), LDS_BYTES, stream, p);
}
```

```cpp
#include <hip/hip_runtime.h>
#include <cstdio>
#include <cstdint>
__device__ __forceinline__ int mktid(int wv) { int l; asm volatile("v_mbcnt_lo_u32_b32 %0, -1, 0\n\tv_mbcnt_hi_u32_b32 %0, -1, %0" : "=v"(l)); return (wv << 6) | l; }
template <int CTRL> __device__ __forceinline__ float dppf(float v) { return __builtin_bit_cast(float, __builtin_amdgcn_update_dpp(0, __builtin_bit_cast(int, v), CTRL, 0xF, 0xF, true)); }
__device__ __forceinline__ float red4(float v) { v += dppf<0xB1>(v); v += dppf<0x4E>(v); return v; }
__device__ __forceinline__ float red8(float v) { v = red4(v); v += dppf<0x141>(v); return v; }
__device__ __forceinline__ float red16(float v) { v = red8(v); v += dppf<0x140>(v); return v; }
__device__ __forceinline__ float wave_sum(float v) { v = red16(v);
    v += __builtin_bit_cast(float, __builtin_amdgcn_ds_swizzle(__builtin_bit_cast(int, v), 0x401F));
    const unsigned u = __builtin_bit_cast(unsigned, v); auto rr = __builtin_amdgcn_permlane32_swap(u, u, false, false);
    return __builtin_bit_cast(float, (unsigned)rr[0]) + __builtin_bit_cast(float, (unsigned)rr[1]); }
__device__ __forceinline__ void wave_sum8(float (&v)[8]) {
#pragma unroll
    for (int i = 0; i < 8; ++i) v[i] += dppf<0xB1>(v[i]);
#pragma unroll
    for (int i = 0; i < 8; ++i) v[i] += dppf<0x4E>(v[i]);
#pragma unroll
    for (int i = 0; i < 8; ++i) v[i] += dppf<0x141>(v[i]);
#pragma unroll
    for (int i = 0; i < 8; ++i) v[i] += dppf<0x140>(v[i]);
#pragma unroll
    for (int i = 0; i < 8; ++i) v[i] += __builtin_bit_cast(float, __builtin_amdgcn_ds_swizzle(__builtin_bit_cast(int, v[i]), 0x401F));
#pragma unroll
    for (int i = 0; i < 8; ++i) { const unsigned u = __builtin_bit_cast(unsigned, v[i]); auto rr = __builtin_amdgcn_permlane32_swap(u, u, false, false); v[i] = __builtin_bit_cast(float, (unsigned)rr[0]) + __builtin_bit_cast(float, (unsigned)rr[1]); }
}
__device__ __forceinline__ float lane_get(float v, int src) { return __builtin_bit_cast(float, __builtin_amdgcn_ds_bpermute(src << 2, __builtin_bit_cast(int, v))); }
namespace pg8 {
#define PG8_LAS __attribute__((address_space(3)))
typedef unsigned short bf16_t;
typedef short bf16x8 __attribute__((ext_vector_type(8)));
typedef float f32x4 __attribute__((ext_vector_type(4)));
typedef unsigned u32x4 __attribute__((ext_vector_type(4)));
constexpr int BM = 256, BK = 64, HALF = 128, HTB = HALF * BK * 2  , STAGE_BYTES = 8 * HTB, NXCD = 8, WGM = 8;

__host__ __device__ __forceinline__ int lds_byte(int r, int c) { const int st = (r >> 4) * 2 + (c >> 5), rr = r & 15, cc = c & 31, ob = rr * 64 + cc * 2; return st * 1024 + (ob ^ (((ob >> 9) & 1) << 5)); }
__host__ __device__ __forceinline__ void stage_rc(int b, int& R, int& C) { const int st = b / 1024, sb = b % 1024, swz = sb ^ (((sb >> 9) & 1) << 5); R = (st >> 1) * 16 + swz / 64; C = (st & 1) * 32 + (swz % 64) / 2; }
__host__ __device__ __forceinline__ int perm32(int rho) { const int n = rho >> 4, i = rho & 15; return 8 * (i >> 2) + 4 * n + (i & 3); }
struct Unit { int pm, pn, aux; const char* a; const char* b; };
struct Gemm { int K; };

struct StaticOrder {
    int nM, nN, nwg, G, c; const char* A; const char* Bt; size_t tstep;
    __device__ void init(const void* A_, const void* Bt_, int M, int N, int K, int G_, int c_) { nM = M / BM; nN = N / BM; nwg = nM * nN; G = G_; c = c_; A = (const char*)A_; Bt = (const char*)Bt_; tstep = (size_t)BM * K * 2; }
    __device__ bool next(int i, Unit& u) const {
        const long L = (long)i * G + c; if (L >= nwg) return false;
        int wgid = (int)L; { const int q = nwg / NXCD, r = nwg % NXCD, xcd = wgid % NXCD, off = wgid / NXCD; wgid = (xcd < r ? xcd * (q + 1) : r * (q + 1) + (xcd - r) * q) + off; }
        const int nig = WGM * nN, gid = wgid / nig, fm = gid * WGM, gsz = (nM - fm) < WGM ? (nM - fm) : WGM;
        u.aux = 0; u.pm = fm + ((wgid % nig) % gsz); u.pn = (wgid % nig) / gsz; u.a = A + (size_t)u.pm * tstep; u.b = Bt + (size_t)u.pn * tstep; return true;
    }
    __device__ __forceinline__ void a_ready(const Unit&) const {}
    __device__ __forceinline__ void done(const Unit&) const {}
};
__device__ __forceinline__ unsigned cvt_pk_bf16(float lo, float hi) { unsigned r; asm volatile("v_cvt_pk_bf16_f32 %0, %1, %2" : "=v"(r) : "v"(lo), "v"(hi)); return r; }
template <class Epi, class Sched, bool ALIGN_EPI = false, bool SP2 = false>
__device__ __forceinline__ void gemm_phase(PG8_LAS unsigned char* lds, const Gemm g, const Sched& S, const Epi& E, int wv) {
    const int tid = mktid(wv), wid = __builtin_amdgcn_readfirstlane(tid >> 6), lane = tid & 63, wr = wid >> 2, wc = wid & 3, fr = lane & 15, fq = lane >> 4;
    const int K = g.K, nt = K / BK;
    unsigned voffA[2], voffB[2];
#pragma unroll
    for (int i = 0; i < 2; ++i) { int R, C; stage_rc(tid * 16 + i * 8192, R, C); const int Rb = Epi::PERM ? ((R & ~31) + perm32(R & 31)) : R;
        voffA[i] = (unsigned)(R * K + C) * 2u; voffB[i] = (unsigned)(Rb * K + C) * 2u; }
    const size_t kstep = (size_t)(BK * 2);
    const size_t hstep = (size_t)HALF * K * 2;
        const unsigned ldsw = (unsigned)wid * 1024u;
    const int aoff = lds_byte(wr * 64 + fr, fq * 8), boff = lds_byte(wc * 32 + fr, fq * 8);
#define PG8_SA(b, h) (((b) * 2 + (h)) * HTB)
#define PG8_SB(b, h) ((4 + (b) * 2 + (h)) * HTB)
#define PG8_STAGE(bufoff, gbase, voff) do { _Pragma("unroll") for (int _i = 0; _i < 2; ++_i) \
        __builtin_amdgcn_global_load_lds((const unsigned*)((const char*)(gbase) + (voff)[_i]), (PG8_LAS unsigned*)(lds + (bufoff) + ldsw + _i * 8192), 16, 0, 0); } while (0)
#define PG8_LDA(dst, b, h) do { _Pragma("unroll") for (int m = 0; m < 4; ++m) _Pragma("unroll") for (int k = 0; k < 2; ++k) dst[m][k] = *(const PG8_LAS bf16x8*)(lds + PG8_SA(b, h) + aoff + m * 2048 + k * 1024); } while (0)
#define PG8_LDB(dst, b, h) do { _Pragma("unroll") for (int n = 0; n < 2; ++n) _Pragma("unroll") for (int k = 0; k < 2; ++k) dst[n][k] = *(const PG8_LAS bf16x8*)(lds + PG8_SB(b, h) + boff + n * 2048 + k * 1024); } while (0)
#define PG8_MMA(ai, bj, At, Bt) do { __builtin_amdgcn_s_setprio(1); _Pragma("unroll") for (int m = 0; m < 4; ++m) _Pragma("unroll") for (int n = 0; n < 2; ++n) _Pragma("unroll") for (int k = 0; k < 2; ++k) \
        acc[ai][bj][m][n] = __builtin_amdgcn_mfma_f32_16x16x32_bf16(Bt[n][k], At[m][k], acc[ai][bj][m][n], 0, 0, 0); __builtin_amdgcn_s_setprio(0); } while (0)
#define PG8_WAIT_V(n) asm volatile("s_waitcnt vmcnt(" #n ")" ::: "memory")
#define PG8_WAIT_L(n) asm volatile("s_waitcnt lgkmcnt(" #n ")" ::: "memory")
#define PG8_BAR __builtin_amdgcn_s_barrier()
#define PG8_SCHED __builtin_amdgcn_sched_barrier(0)
    Unit cur, nxt; int ui = 0;
    if (!S.next(0, cur)) return;
    f32x4 acc[2][2][4][2];
#pragma unroll
    for (int a = 0; a < 2; ++a)
#pragma unroll
        for (int b = 0; b < 2; ++b)
#pragma unroll
            for (int m = 0; m < 4; ++m)
#pragma unroll
                for (int n = 0; n < 2; ++n) acc[a][b][m][n] = (f32x4){0.f, 0.f, 0.f, 0.f};
    bf16x8 At[4][2], B0[2][2], B1[2][2];
    const char* cA = cur.a; const char* cB = cur.b;
    S.a_ready(cur);
    if constexpr (SP2) {
        PG8_STAGE(PG8_SB(0, 0), cB, voffB); PG8_STAGE(PG8_SB(0, 1), cB + hstep, voffB); PG8_STAGE(PG8_SA(0, 0), cA, voffA); PG8_STAGE(PG8_SA(0, 1), cA + hstep, voffA);
        if (wr == 1) PG8_BAR;
        PG8_WAIT_V(2); PG8_BAR;
        PG8_STAGE(PG8_SB(1, 0), cB + kstep, voffB); PG8_STAGE(PG8_SA(1, 0), cA + kstep, voffA); PG8_STAGE(PG8_SB(1, 1), cB + hstep + kstep, voffB);
        PG8_WAIT_V(6); PG8_BAR;
    } else {
        PG8_STAGE(PG8_SB(0, 0), cB, voffB); PG8_STAGE(PG8_SA(0, 0), cA, voffA); PG8_STAGE(PG8_SB(0, 1), cB + hstep, voffB); PG8_STAGE(PG8_SA(0, 1), cA + hstep, voffA);
        if (wr == 1) PG8_BAR;
        PG8_WAIT_V(4); PG8_BAR;
        PG8_STAGE(PG8_SB(1, 0), cB + kstep, voffB); PG8_STAGE(PG8_SA(1, 0), cA + kstep, voffA); PG8_STAGE(PG8_SB(1, 1), cB + hstep + kstep, voffB);
        PG8_WAIT_V(6); PG8_BAR;
    }
    for (;;) {
        const bool has_next = S.next(ui + 1, nxt);
        const char* nA = has_next ? nxt.a : cA; const char* nB = has_next ? nxt.b : cB;
        for (int t = 0; t < nt; t += 2) {
            const bool last = (t == nt - 2);
            const char* a1 = cA + (size_t)(t + 1) * kstep;
            const char* a2 = last ? nA : cA + (size_t)(t + 2) * kstep; const char* b2 = last ? nB : cB + (size_t)(t + 2) * kstep;
            const char* a3 = a2 + kstep; const char* b3 = b2 + kstep;
            if (last && has_next) S.a_ready(nxt);
            if constexpr (SP2) {
            PG8_LDB(B0, 0, 0); PG8_LDB(B1, 0, 1); PG8_SCHED; PG8_LDA(At, 0, 0); PG8_STAGE(PG8_SA(1, 1), a1 + hstep, voffA);
            PG8_WAIT_V(8); PG8_WAIT_L(0); PG8_BAR; PG8_MMA(0, 0, At, B0); PG8_MMA(0, 1, At, B1); PG8_BAR; PG8_SCHED;
            PG8_LDA(At, 0, 1); PG8_STAGE(PG8_SB(0, 0), b2, voffB); PG8_STAGE(PG8_SB(0, 1), b2 + hstep, voffB); PG8_STAGE(PG8_SA(0, 0), a2, voffA);
            PG8_WAIT_V(8); PG8_WAIT_L(0); PG8_BAR; PG8_MMA(1, 0, At, B0); PG8_MMA(1, 1, At, B1); PG8_BAR; PG8_SCHED;
            PG8_LDB(B0, 1, 0); PG8_LDB(B1, 1, 1); PG8_SCHED; PG8_LDA(At, 1, 0); PG8_STAGE(PG8_SA(0, 1), a2 + hstep, voffA);
            PG8_WAIT_V(8); PG8_WAIT_L(0); PG8_BAR; PG8_MMA(0, 0, At, B0); PG8_MMA(0, 1, At, B1); PG8_BAR; PG8_SCHED;
            PG8_LDA(At, 1, 1); PG8_STAGE(PG8_SB(1, 0), b3, voffB); PG8_STAGE(PG8_SB(1, 1), b3 + hstep, voffB); PG8_STAGE(PG8_SA(1, 0), a3, voffA);
            PG8_WAIT_V(8); PG8_WAIT_L(0); PG8_BAR; PG8_MMA(1, 0, At, B0); PG8_MMA(1, 1, At, B1); PG8_BAR; PG8_SCHED;
            } else {
            PG8_LDB(B0, 0, 0); PG8_SCHED; PG8_LDA(At, 0, 0); PG8_STAGE(PG8_SA(1, 1), a1 + hstep, voffA);
            PG8_WAIT_L(8); PG8_BAR; PG8_WAIT_L(0); PG8_MMA(0, 0, At, B0); PG8_BAR; PG8_SCHED;
            PG8_LDB(B1, 0, 1); PG8_STAGE(PG8_SB(0, 0), b2, voffB);
            PG8_BAR; PG8_WAIT_L(0); PG8_MMA(0, 1, At, B1); PG8_BAR;
            PG8_LDA(At, 0, 1); PG8_STAGE(PG8_SA(0, 0), a2, voffA);
            PG8_BAR; PG8_WAIT_L(0); PG8_MMA(1, 0, At, B0); PG8_BAR; PG8_SCHED;
            PG8_STAGE(PG8_SB(0, 1), b2 + hstep, voffB);
            PG8_WAIT_V(6); PG8_BAR; PG8_MMA(1, 1, At, B1); PG8_BAR;
            PG8_LDB(B0, 1, 0); PG8_SCHED; PG8_LDA(At, 1, 0); PG8_STAGE(PG8_SA(0, 1), a2 + hstep, voffA);
            PG8_WAIT_L(8); PG8_BAR; PG8_WAIT_L(0); PG8_MMA(0, 0, At, B0); PG8_BAR; PG8_SCHED;
            PG8_LDB(B1, 1, 1); PG8_STAGE(PG8_SB(1, 0), b3, voffB);
            PG8_BAR; PG8_WAIT_L(0); PG8_MMA(0, 1, At, B1); PG8_BAR;
            PG8_LDA(At, 1, 1); PG8_STAGE(PG8_SA(1, 0), a3, voffA);
            PG8_BAR; PG8_WAIT_L(0); PG8_MMA(1, 0, At, B0); PG8_BAR; PG8_SCHED;
            PG8_STAGE(PG8_SB(1, 1), b3 + hstep, voffB);
            PG8_WAIT_V(6); PG8_BAR; PG8_MMA(1, 1, At, B1); PG8_BAR;
            }
        }
        if constexpr (ALIGN_EPI) { if (wr == 0) PG8_BAR; }
        bool keep = false;
        if constexpr (!Epi::AFTER_DRAIN) { if constexpr (Epi::CHAIN) keep = E.chain(acc, cur, wr, wc, fr, fq); else E(acc, cur, wr, wc, fr, fq); S.done(cur); }
        if (!has_next) break;
        if (!keep) {
#pragma unroll
        for (int a = 0; a < 2; ++a)
#pragma unroll
            for (int b = 0; b < 2; ++b)
#pragma unroll
                for (int m = 0; m < 4; ++m)
#pragma unroll
                    for (int n = 0; n < 2; ++n) acc[a][b][m][n] = (f32x4){0.f, 0.f, 0.f, 0.f};
        }
        cur = nxt; cA = nA; cB = nB; ++ui;
        if constexpr (ALIGN_EPI) { if (wr == 1) PG8_BAR; }
    }
    PG8_WAIT_V(0);
    if constexpr (!ALIGN_EPI) { if (wr == 0) PG8_BAR; }
    PG8_BAR;
    if constexpr (Epi::AFTER_DRAIN) { E.fused(acc, cur, wr, wc, fr, fq, lds, wid, lane); S.done(cur); }
#undef PG8_SA
#undef PG8_SB
#undef PG8_STAGE
#undef PG8_LDA
#undef PG8_LDB
#undef PG8_MMA
#undef PG8_WAIT_V
#undef PG8_WAIT_L
#undef PG8_BAR
#undef PG8_SCHED
}
}
#include <hip/hip_bf16.h>
#include <cmath>
namespace attn_body {
using bf16=__hip_bfloat16;
using bf16x8=__attribute__((ext_vector_type(8)))short;
using s16x4=__attribute__((ext_vector_type(4)))short;
using f32x16=__attribute__((ext_vector_type(16)))float;
using u32x4=__attribute__((ext_vector_type(4)))unsigned;
constexpr int NHEAD=8,SEQ=2048,D=64,PQ=512,PK=512,PV=4352,PO=512;
constexpr int NW=8,QBLK=32,QB=QBLK*NW,KVBLK=64,NQB=SEQ/QB;
__device__ __forceinline__ int crow(int r,int hi){return (r&3)+8*(r>>2)+4*hi;}
#define SBAR() __builtin_amdgcn_sched_barrier(0)
__device__ __forceinline__ void cmask(f32x16&p0,f32x16&p1,int jb,int qrel,int hi){
  const float NEG=-INFINITY; int kb=64*jb+4*hi;
  #pragma unroll
  for(int r=0;r<16;++r){int kv=kb+(r&3)+8*(r>>2); if(kv>qrel)p0[r]=NEG; if(kv+32>qrel)p1[r]=NEG;}
}

constexpr int NSLOT=3, SLOTB=8192;
constexpr int LDS_K=0, LDS_V=NSLOT*SLOTB, LDS_WS=2*NSLOT*SLOTB, LDS_OST=LDS_WS+NW*64*4, LDS_SEL=LDS_OST+NW*4096, LDS_KM=LDS_SEL+256, LDS_KP=LDS_KM+7*64*4, LDS_BYTES=LDS_KP+8*64*4;
constexpr float C2=0.125f*1.4426950408889634f;
__device__ __forceinline__ void glds16(const void*gsrc,unsigned lds_dst){unsigned keep;
  asm volatile("s_mov_b32 %0, m0\n\ts_mov_b32 m0, %2\n\ts_nop 0\n\tglobal_load_lds_dwordx4 %1, off\n\ts_mov_b32 m0, %0":"=&s"(keep):"v"(gsrc),"s"(lds_dst):"memory");}
__device__ __forceinline__ float max3f(float a,float b,float c){float r;asm("v_max3_f32 %0, %1, %2, %3":"=v"(r):"v"(a),"v"(b),"v"(c));return r;}
__device__ __forceinline__ float max2f(float a,float b){float r;asm("v_max_f32_e32 %0, %1, %2":"=v"(r):"v"(a),"v"(b));return r;}
__device__ __forceinline__ float fadd_s(float a,float b){float r;asm("v_add_f32_e32 %0, %1, %2":"=v"(r):"v"(a),"v"(b));return r;}
__device__ __forceinline__ float fsub_s(float a,float b){float r;asm("v_sub_f32_e32 %0, %1, %2":"=v"(r):"v"(a),"v"(b));return r;}
typedef float f32x2_t __attribute__((ext_vector_type(2))); typedef __bf16 bf16x2_t __attribute__((ext_vector_type(2)));
__device__ __forceinline__ unsigned cvtpk_s(float lo,float hi){f32x2_t v={lo,hi};bf16x2_t b=__builtin_convertvector(v,bf16x2_t);return __builtin_bit_cast(unsigned,b);}
#define WAIT_BAR(N) asm volatile("s_waitcnt vmcnt(" #N ") lgkmcnt(0)\n\ts_barrier":::"memory")

__device__ __forceinline__ void qkt(f32x16&p0,f32x16&p1,const char*Kslot,const bf16x8*qr,const f32x16&negm,int r32,int hi){
  const char*kb=Kslot+hi*1024+r32*16;
  #pragma unroll
  for(int d0=0;d0<4;++d0){
    const bf16x8 b0=*reinterpret_cast<const bf16x8*>(kb+d0*2048);
    const bf16x8 b1=*reinterpret_cast<const bf16x8*>(kb+d0*2048+512);
    if(d0==0){p0=__builtin_amdgcn_mfma_f32_32x32x16_bf16(b0,qr[0],negm,0,0,0);p1=__builtin_amdgcn_mfma_f32_32x32x16_bf16(b1,qr[0],negm,0,0,0);}
    else{p0=__builtin_amdgcn_mfma_f32_32x32x16_bf16(b0,qr[d0],p0,0,0,0);p1=__builtin_amdgcn_mfma_f32_32x32x16_bf16(b1,qr[d0],p1,0,0,0);}}
}
typedef __attribute__((address_space(3))) const char* lds_cptr;
typedef short v4i16_t __attribute__((ext_vector_type(4)));
__device__ __forceinline__ void kload8(bf16x8*kf,lds_cptr kp){
  kf[0]=*(const __attribute__((address_space(3))) bf16x8*)(kp);      kf[1]=*(const __attribute__((address_space(3))) bf16x8*)(kp+512);
  kf[2]=*(const __attribute__((address_space(3))) bf16x8*)(kp+2048); kf[3]=*(const __attribute__((address_space(3))) bf16x8*)(kp+2560);
  kf[4]=*(const __attribute__((address_space(3))) bf16x8*)(kp+4096); kf[5]=*(const __attribute__((address_space(3))) bf16x8*)(kp+4608);
  kf[6]=*(const __attribute__((address_space(3))) bf16x8*)(kp+6144); kf[7]=*(const __attribute__((address_space(3))) bf16x8*)(kp+6656);
}
__device__ __forceinline__ void kload2(bf16x8*kf,lds_cptr kp,int j){ kf[2*j]=*(const __attribute__((address_space(3))) bf16x8*)(kp+j*2048); kf[2*j+1]=*(const __attribute__((address_space(3))) bf16x8*)(kp+j*2048+512); }
__device__ __forceinline__ s16x4 vtr(lds_cptr p){ return __builtin_bit_cast(s16x4,__builtin_amdgcn_ds_read_tr16_b64_v4i16((__attribute__((address_space(3))) v4i16_t*)p)); }
__device__ __forceinline__ float rowmax(const f32x16&p0,const f32x16&p1){
  float a=max3f(p0[0],p0[1],p1[0]),b=max3f(p0[2],p0[3],p1[1]);a=max3f(a,p1[2],p1[3]);
  #pragma unroll
  for(int r=4;r<16;r+=4){a=max3f(a,p0[r],p0[r+1]);b=max3f(b,p0[r+2],p0[r+3]);a=max3f(a,p1[r],p1[r+1]);b=max3f(b,p1[r+2],p1[r+3]);}
  const float m=max2f(a,b);
  auto rr=__builtin_amdgcn_permlane32_swap(__float_as_uint(m),__float_as_uint(m),false,false);
  return max2f(__uint_as_float(rr[0]),__uint_as_float(rr[1]));
}
__device__ __forceinline__ void pv(f32x16*o,int vb,bf16x8 pa0,bf16x8 pa1,bf16x8 pa2,bf16x8 pa3){
  #pragma unroll
  for(int d0=0;d0<2;++d0){s16x4 lo[4],hi[4];
    #pragma unroll
    for(int ks=0;ks<4;++ks){
      asm volatile("ds_read_b64_tr_b16 %0,%1 offset:%c2":"=&v"(lo[ks]):"v"(vb),"i"(d0*4096+ks*1024):"memory");
      asm volatile("ds_read_b64_tr_b16 %0,%1 offset:%c2":"=&v"(hi[ks]):"v"(vb),"i"(d0*4096+ks*1024+512):"memory");}
    asm volatile("s_waitcnt lgkmcnt(0)":::"memory");SBAR();
    #define PK(k) (bf16x8){lo[k][0],lo[k][1],lo[k][2],lo[k][3],hi[k][0],hi[k][1],hi[k][2],hi[k][3]}
    o[d0]=__builtin_amdgcn_mfma_f32_32x32x16_bf16(pa0,PK(0),o[d0],0,0,0);
    o[d0]=__builtin_amdgcn_mfma_f32_32x32x16_bf16(pa1,PK(1),o[d0],0,0,0);
    o[d0]=__builtin_amdgcn_mfma_f32_32x32x16_bf16(pa2,PK(2),o[d0],0,0,0);
    o[d0]=__builtin_amdgcn_mfma_f32_32x32x16_bf16(pa3,PK(3),o[d0],0,0,0);
    #undef PK
  }
}

#ifndef ATTN_STORE16
#define ATTN_STORE16(p,v) (*(u32x4*)(p)=(v))
#endif
template<int THRL> __device__ __forceinline__ void attn_unit(int b,int h,int qb,const bf16*Q,const bf16*__restrict__ K,const bf16*__restrict__ V,bf16*O,char*shm,int wv){
  const int tid=mktid(wv),lane=tid&63,r32=lane&31,hi=lane>>5;     const int wid=__builtin_amdgcn_readfirstlane(tid>>6);
  const long rowbase=(long)b*SEQ; const int q0=qb*QB;
  if(qb>3){ float*KMl=(float*)(shm+LDS_KM); float*KPl=(float*)(shm+LDS_KP); const int c8=tid&7, rl=tid>>3;
    for(int n=0;n<qb;++n){ float sm[8];
      #pragma unroll
      for(int d=0;d<8;++d)sm[d]=0.f;
      #pragma unroll
      for(int rr=0;rr<4;++rr){ const u32x4 w=*reinterpret_cast<const u32x4*>(K+(rowbase+n*256+rl+64*rr)*PK+h*D+8*c8);
        sm[0]+=__uint_as_float(w[0]<<16);sm[1]+=__uint_as_float(w[0]&0xffff0000u);sm[2]+=__uint_as_float(w[1]<<16);sm[3]+=__uint_as_float(w[1]&0xffff0000u);
        sm[4]+=__uint_as_float(w[2]<<16);sm[5]+=__uint_as_float(w[2]&0xffff0000u);sm[6]+=__uint_as_float(w[3]<<16);sm[7]+=__uint_as_float(w[3]&0xffff0000u); }
      #pragma unroll
      for(int d=0;d<8;++d){ float v=sm[d];
        v+=__builtin_bit_cast(float,__builtin_amdgcn_ds_swizzle(__builtin_bit_cast(int,v),0x201F));
        v+=__builtin_bit_cast(float,__builtin_amdgcn_ds_swizzle(__builtin_bit_cast(int,v),0x401F));
        { const unsigned u=__builtin_bit_cast(unsigned,v); auto rr2=__builtin_amdgcn_permlane32_swap(u,u,false,false); v=__uint_as_float((unsigned)rr2[0])+__uint_as_float((unsigned)rr2[1]); }
        sm[d]=v; }
      if(lane<8){
        #pragma unroll
        for(int d=0;d<8;++d)KPl[wid*64+8*lane+d]=sm[d]; }
      asm volatile("s_waitcnt vmcnt(0) lgkmcnt(0)\n\ts_barrier":::"memory");
      if(tid<64){ float s8=0.f;
        #pragma unroll
        for(int w8=0;w8<8;++w8)s8+=KPl[w8*64+tid];
        KMl[n*64+tid]=s8*(1.0f/256.0f); }
      asm volatile("s_waitcnt lgkmcnt(0)\n\ts_barrier":::"memory"); } }
  if(tid<QB){ unsigned sel=(qb<=3)?((1u<<qb)-1u):0u;
    if(qb>3){ const bf16*qp=Q+(rowbase+q0+tid)*PQ+h*D; const float*km=(const float*)(shm+LDS_KM); float gate[7];
      #pragma unroll
      for(int j=0;j<7;++j)gate[j]=0.f;
      #pragma unroll 1
      for(int i=0;i<8;++i){ const u32x4 w=*reinterpret_cast<const u32x4*>(qp+8*i); float qv[8];
        qv[0]=__uint_as_float(w[0]<<16);qv[1]=__uint_as_float(w[0]&0xffff0000u);qv[2]=__uint_as_float(w[1]<<16);qv[3]=__uint_as_float(w[1]&0xffff0000u);
        qv[4]=__uint_as_float(w[2]<<16);qv[5]=__uint_as_float(w[2]&0xffff0000u);qv[6]=__uint_as_float(w[3]<<16);qv[7]=__uint_as_float(w[3]&0xffff0000u);
        #pragma unroll
        for(int j=0;j<7;++j) if(j<qb){ const float*kp=km+j*64+8*i;
          #pragma unroll
          for(int d=0;d<8;++d)gate[j]+=qv[d]*kp[d]; } }
      #pragma unroll
      for(int rep=0;rep<3;++rep){ float best=-INFINITY; int bi=0;
        #pragma unroll
        for(int j=0;j<7;++j) if(j<qb&&!((sel>>j)&1u)&&gate[j]>best){best=gate[j];bi=j;}
        sel|=1u<<bi; } }
    ((unsigned char*)(shm+LDS_SEL))[tid]=(unsigned char)sel; }
  asm volatile("s_waitcnt vmcnt(0) lgkmcnt(0)\n\ts_barrier":::"memory");
  const bf16*Qw=Q+(rowbase+q0+wid*QBLK)*PQ+h*D;
  const bf16*Kh=K+rowbase*PK+h*D,*Vh=V+rowbase*PV+h*D;
  const unsigned lds0=(unsigned)(uintptr_t)shm;
  float*wsf=(float*)(shm+LDS_WS)+wid*64;
  const bf16*ksrc=Kh+(long)lane*PK+wid*8;
  const bf16*vsrc=Vh+(long)(16*(wid&3)+(lane>>2))*PV+(wid>>2)*32+(lane&3)*8;
  const unsigned kdst=lds0+LDS_K+wid*1024, vdst=lds0+LDS_V+wid*1024;
  #define TROW(t) ((long)(((t)<4)?(q0+(t)*KVBLK):(((t)-4)*KVBLK)))
  #define DMA_K(t,slot) glds16(ksrc+TROW(t)*PK,(unsigned)__builtin_amdgcn_readfirstlane(kdst+(slot)))
  #define DMA_V(t,slot) glds16(vsrc+TROW(t)*PV,(unsigned)__builtin_amdgcn_readfirstlane(vdst+(slot)))
  const int vb0=(int)(lds0+LDS_V)+((lane>>4)&1)*32+(lane&3)*8+(4*hi+((lane&15)>>2))*64;
  const char*Kbase=shm+LDS_K; bf16x8 kf[8];
  const lds_cptr shm3=(lds_cptr)shm; const lds_cptr kp0=shm3+LDS_K+hi*1024+r32*16; const lds_cptr vp0=shm3+LDS_V+((lane>>4)&1)*32+(lane&3)*8+(4*hi+((lane&15)>>2))*64;
  const int NT=(q0+QB)/KVBLK;
  DMA_K(0,0);DMA_V(0,0);DMA_K(1,SLOTB);
  bf16x8 qr[4];
  #pragma unroll
  for(int d0=0;d0<4;++d0)qr[d0]=*reinterpret_cast<const bf16x8*>(&Qw[(long)r32*PQ+d0*16+hi*8]);
  float mhat=0.f,l_reg=0.f;f32x16 o[2];o[0]=f32x16{};o[1]=f32x16{};
  const int qrel=wid*QBLK+r32;
  const unsigned selb=((const unsigned char*)(shm+LDS_SEL))[qrel];
  #define CMASK(P0,P1,t) cmask(P0,P1,(t),qrel,hi)
  #define SUBREF(C0,C1,t) do{ const float sb_=(((t)<4)||((selb>>(((t)-4)>>2))&1u))?mhat:INFINITY; _Pragma("unroll") for(int r_=0;r_<16;++r_){C0[r_]-=sb_;C1[r_]-=sb_;} }while(0)
  bool resc=false;
  #define START(P0,P1) do{ const float rm=rowmax(P0,P1); resc=false; \
    { const float dl=rm; mhat=fadd_s(mhat,dl); \
      _Pragma("unroll") for(int r=0;r<16;++r){P0[r]=fsub_s(P0[r],dl);P1[r]=fsub_s(P1[r],dl);} \
      } \
    _Pragma("unroll") for(int r=0;r<16;++r)P0[r]=__builtin_amdgcn_exp2f(P0[r]); }while(0)
  #define RESC() do{ if(resc){ asm volatile("s_waitcnt lgkmcnt(0)":::"memory"); \
      _Pragma("unroll") for(int d_=0;d_<2;++d_) _Pragma("unroll") for(int r=0;r<16;++r)o[d_][r]*=wsf[crow(r,hi)]; } }while(0)
  f32x16 pA0,pA1,pB0,pB1;
  int sl_prev=0,sl_cur=0,sl_next=SLOTB;
  #define ROT() do{sl_prev=sl_cur;sl_cur=sl_next;sl_next=(sl_next==(NSLOT-1)*SLOTB)?0:sl_next+SLOTB;}while(0)
  DMA_K(2,2*SLOTB);
  WAIT_BAR(3);
  qkt(pA0,pA1,Kbase,qr,f32x16{},r32,hi);asm volatile("s_nop 15\n\ts_nop 7":"+v"(pA0),"+v"(pA1));CMASK(pA0,pA1,0);
  START(pA0,pA1);
  _Pragma("unroll") for(int r=0;r<16;++r)pA1[r]=__builtin_amdgcn_exp2f(pA1[r]);
  WAIT_BAR(0);
  DMA_K(3,0);DMA_V(1,SLOTB);
  ROT();
  kload8(kf,kp0+sl_cur);
  WAIT_BAR(2);
  s16x4 vlo[8],vhi[8]; u32x4 pw0,pw1,pw2,pw3;
  #define PKW(P,B) cvtpk_s(P[B],P[B+1])
  #define PAF(k) __builtin_bit_cast(bf16x8,pw##k)
  #define VFR(i) (bf16x8){vlo[i][0],vlo[i][1],vlo[i][2],vlo[i][3],vhi[i][0],vhi[i][1],vhi[i][2],vhi[i][3]}
  #define PIN(x) asm volatile("":"+v"(x))
  #define MX3(a,b,c) __builtin_fmaxf(__builtin_fmaxf((a),(b)),(c))
  #define GAPA(MF,A0,A1,A2,A3,W0,W1,PW) do{ MF; sacc+=A0; sacc+=A1; sacc+=A2; sacc+=A3; PIN(sacc); W0; W1; PIN(PW); SBAR(); }while(0)
  #define EX(v) __builtin_amdgcn_exp2f(v)
  #define GAPB(MF,X,B) do{ MF; X[B]=EX(X[B]); X[B+1]=EX(X[B+1]); X[B+2]=EX(X[B+2]); X[B+3]=EX(X[B+3]); PIN(X); SBAR(); }while(0)
  #define VRD(i) do{ vlo[i]=vtr(vp_+(((i)>>2)*4096+((i)&3)*1024)); vhi[i]=vtr(vp_+(((i)>>2)*4096+((i)&3)*1024+512)); }while(0)
  #define KRD(G,j) do{ if(G){ kload2(kf,kp0+sl_next,j); SBAR(); } }while(0)
  #define STEP(C0,C1,P0,P1,t,GK,GV,GL,MB) do{ SBAR(); \
    const lds_cptr vp_=vp0+sl_prev; \
    VRD(0); SBAR(); float sacc=(P0[0]+P0[1]); \
    GAPA(C0=__builtin_amdgcn_mfma_f32_32x32x16_bf16(kf[0],qr[0],f32x16{},0,0,0), P0[2],P0[3],P0[4],P0[5],     pw0[0]=PKW(P0,0), pw0[1]=PKW(P0,2), pw0); \
    VRD(4); SBAR(); GAPA(C1=__builtin_amdgcn_mfma_f32_32x32x16_bf16(kf[1],qr[0],f32x16{},0,0,0), P0[6],P0[7],P0[8],P0[9],     pw0[2]=PKW(P0,4), pw0[3]=PKW(P0,6), pw0); \
    VRD(1); SBAR(); GAPA(C0=__builtin_amdgcn_mfma_f32_32x32x16_bf16(kf[2],qr[1],C0,0,0,0),   P0[10],P0[11],P0[12],P0[13], pw1[0]=PKW(P0,8), pw1[1]=PKW(P0,10), pw1); \
    VRD(5); SBAR(); GAPA(C1=__builtin_amdgcn_mfma_f32_32x32x16_bf16(kf[3],qr[1],C1,0,0,0),   P0[14],P0[15],P1[0],P1[1],   pw1[2]=PKW(P0,12),pw1[3]=PKW(P0,14), pw1); \
    VRD(2); SBAR(); GAPA(C0=__builtin_amdgcn_mfma_f32_32x32x16_bf16(kf[4],qr[2],C0,0,0,0),   P1[2],P1[3],P1[4],P1[5],     pw2[0]=PKW(P1,0), pw2[1]=PKW(P1,2), pw2); \
    VRD(6); SBAR(); GAPA(C1=__builtin_amdgcn_mfma_f32_32x32x16_bf16(kf[5],qr[2],C1,0,0,0),   P1[6],P1[7],P1[8],P1[9],     pw2[2]=PKW(P1,4), pw2[3]=PKW(P1,6), pw2); \
    VRD(3); SBAR(); GAPA(C0=__builtin_amdgcn_mfma_f32_32x32x16_bf16(kf[6],qr[3],C0,0,0,0),   P1[10],P1[11],P1[12],P1[13], pw3[0]=PKW(P1,8), pw3[1]=PKW(P1,10), pw3); \
    VRD(7); SBAR(); GAPA(C1=__builtin_amdgcn_mfma_f32_32x32x16_bf16(kf[7],qr[3],C1,0,0,0),   P1[14],P1[15],0.f,0.f,       pw3[2]=PKW(P1,12),pw3[3]=PKW(P1,14), pw3); \
    l_reg+=sacc; \
    if(GK){DMA_K((t)+3,sl_cur);} if(GV){DMA_V((t)+1,sl_next);} \
    SUBREF(C0,C1,t); if(MB){CMASK(C0,C1,t);} \
    { float a=MX3(C0[0],C0[1],C1[0]),b=MX3(C0[2],C0[3],C1[1]); a=MX3(a,C1[2],C1[3]); \
      _Pragma("unroll") for(int r=4;r<16;r+=4){a=MX3(a,C0[r],C0[r+1]);b=MX3(b,C0[r+2],C0[r+3]);a=MX3(a,C1[r],C1[r+1]);b=MX3(b,C1[r+2],C1[r+3]);} \
      float rm=__builtin_fmaxf(a,b); { auto rr=__builtin_amdgcn_permlane32_swap(__float_as_uint(rm),__float_as_uint(rm),false,false); rm=__builtin_fmaxf(__uint_as_float(rr[0]),__uint_as_float(rr[1])); } \
      resc=false; \
      if(__builtin_expect(__any(rm>(float)THRL),0)){ const float dl=__builtin_fmaxf(rm,0.f); mhat+=dl; \
        _Pragma("unroll") for(int r=0;r<16;++r){C0[r]-=dl;C1[r]-=dl;} \
        const float f=__builtin_amdgcn_exp2f(-dl); l_reg*=f; if(hi==0)wsf[r32]=f; resc=true; } } \
    SBAR(); \
    GAPB(o[0]=__builtin_amdgcn_mfma_f32_32x32x16_bf16(PAF(0),VFR(0),o[0],0,0,0), C0,0); \
    GAPB(o[1]=__builtin_amdgcn_mfma_f32_32x32x16_bf16(PAF(0),VFR(4),o[1],0,0,0), C0,4); \
    KRD(GL,0); GAPB(o[0]=__builtin_amdgcn_mfma_f32_32x32x16_bf16(PAF(1),VFR(1),o[0],0,0,0), C0,8); \
    KRD(GL,1); GAPB(o[1]=__builtin_amdgcn_mfma_f32_32x32x16_bf16(PAF(1),VFR(5),o[1],0,0,0), C0,12); \
    KRD(GL,2); GAPB(o[0]=__builtin_amdgcn_mfma_f32_32x32x16_bf16(PAF(2),VFR(2),o[0],0,0,0), C1,0); \
    KRD(GL,3); GAPB(o[1]=__builtin_amdgcn_mfma_f32_32x32x16_bf16(PAF(2),VFR(6),o[1],0,0,0), C1,4); \
    GAPB(o[0]=__builtin_amdgcn_mfma_f32_32x32x16_bf16(PAF(3),VFR(3),o[0],0,0,0), C1,8); \
    GAPB(o[1]=__builtin_amdgcn_mfma_f32_32x32x16_bf16(PAF(3),VFR(7),o[1],0,0,0), C1,12); \
    }while(0)
  #define ENDW(tt) do{ if((tt)+3<NT){WAIT_BAR(2);} else if((tt)+2<NT){WAIT_BAR(1);} else {WAIT_BAR(0);} }while(0)
  { int t=1;
    for(;t+1<NT;t+=2){
      STEP(pB0,pB1,pA0,pA1,t,(t+3<NT),(t+1<NT),(t+1<NT),(t<4));       ENDW(t);   RESC(); ROT();
      STEP(pA0,pA1,pB0,pB1,t+1,(t+4<NT),(t+2<NT),(t+2<NT),(t+1<4));     ENDW(t+1); RESC(); ROT();
    }
    STEP(pB0,pB1,pA0,pA1,NT-1,false,false,false,(NT==4)); RESC();
  }
  { float sacc=pB0[0]+pB0[1]; _Pragma("unroll") for(int r=2;r<16;++r)sacc+=pB0[r]; _Pragma("unroll") for(int r=0;r<16;++r)sacc+=pB1[r]; l_reg+=sacc;
    pw0=(u32x4){PKW(pB0,0),PKW(pB0,2),PKW(pB0,4),PKW(pB0,6)};pw1=(u32x4){PKW(pB0,8),PKW(pB0,10),PKW(pB0,12),PKW(pB0,14)};pw2=(u32x4){PKW(pB1,0),PKW(pB1,2),PKW(pB1,4),PKW(pB1,6)};pw3=(u32x4){PKW(pB1,8),PKW(pB1,10),PKW(pB1,12),PKW(pB1,14)};
    SBAR(); pv(o,vb0+sl_cur,PAF(0),PAF(1),PAF(2),PAF(3)); }
  #undef PKW
  #undef PAF
  #undef VFR
  #undef PIN
  #undef MX3
  #undef GAPA
  #undef GAPB
  #undef EX
  #undef VRD
  #undef KRD
  #undef STEP
  #undef ENDW
  {auto rr=__builtin_amdgcn_permlane32_swap(__float_as_uint(l_reg),__float_as_uint(l_reg),false,false);l_reg=__uint_as_float(rr[0])+__uint_as_float(rr[1]);}
  if(hi==0)wsf[32+r32]=l_reg;asm volatile("s_waitcnt lgkmcnt(0)":::"memory");
  float rli[16];
  #pragma unroll
  for(int r=0;r<16;++r)rli[r]=__builtin_amdgcn_rcpf(wsf[32+crow(r,hi)]);
  bf16*Ow=O+(rowbase+q0+wid*QBLK)*PO+h*D;
  { bf16*stg=(bf16*)(shm+LDS_OST)+wid*2048;
    #pragma unroll
    for(int r=0;r<16;++r){const int orow=crow(r,hi);
      #pragma unroll
      for(int d0=0;d0<2;++d0)stg[orow*64+d0*32+r32]=__float2bfloat16(o[d0][r]*rli[r]);}
    asm volatile("s_waitcnt lgkmcnt(0)":::"memory");
    #pragma unroll
    for(int i=0;i<4;++i){const int row=i*8+(lane>>3),ch=lane&7; const u32x4 v=*(const u32x4*)(stg+row*64+ch*8); ATTN_STORE16(Ow+(long)row*PO+ch*8,v);} }
  asm volatile("s_waitcnt lgkmcnt(0)\n\ts_barrier":::"memory");
  #undef DMA_K
  #undef TROW
  #undef SUBREF
  #undef DMA_V
  #undef CMASK
  #undef START
  #undef RESC
  #undef ROT
}
constexpr int ATTN_LDS_BYTES=LDS_BYTES;
#undef SBAR
#undef WAIT_BAR
}
constexpr int DM = 1024, NB = 16, SEQ = 2048, NT = NB * SEQ;
constexpr int RWW = 512, WIN_N = 5376, INC = 4352, ZV = 1792, ZG = 2304;
constexpr int NEXP = 32, DEXP = 512;
constexpr int XS_ROWS = 2 * NT + NEXP * 256;
constexpr float C2 = 0.125f * 1.4426950408889634f;

#define LAS __attribute__((address_space(3)))
#define GAS __attribute__((address_space(1)))
typedef unsigned short bf16;
typedef unsigned v4u __attribute__((ext_vector_type(4)));
typedef unsigned v2u __attribute__((ext_vector_type(2)));
typedef float f32x4 __attribute__((ext_vector_type(4)));

typedef float f32x2_c __attribute__((ext_vector_type(2))); typedef __bf16 bf16x2_c __attribute__((ext_vector_type(2)));
__device__ __forceinline__ unsigned pk2(float lo, float hi) { const f32x2_c v = {lo, hi}; return __builtin_bit_cast(unsigned, __builtin_convertvector(v, bf16x2_c)); }
__device__ __forceinline__ unsigned f2bf(float f) { return pk2(f, f) & 0xffffu; }
__device__ __forceinline__ float bflo(unsigned w) { return __builtin_bit_cast(float, w << 16); }
__device__ __forceinline__ float bfhi(unsigned w) { return __builtin_bit_cast(float, w & 0xffff0000u); }
__device__ __forceinline__ float sigm(float x) { return __builtin_amdgcn_rcpf(1.0f + __expf(-x)); }

constexpr size_t MiB = 1u << 20;
constexpr size_t WS_CTL = 0;
constexpr size_t WS_MOD = 1 * MiB;
constexpr size_t WS_GM2 = 1 * MiB + 512 * 1024;
constexpr size_t WS_CB = 1 * MiB + 640 * 1024;
constexpr size_t WS_COS = 2 * MiB;
constexpr size_t WS_SIN = 2 * MiB + 512 * 1024;
constexpr size_t WS_KMEAN = 3 * MiB;
constexpr size_t WS_WRH = 3 * MiB + 512 * 1024;
constexpr size_t WS_WRL = 3 * MiB + 768 * 1024;
constexpr size_t WS_SEL = 4 * MiB;
constexpr size_t WS_RTE = 5 * MiB;
constexpr size_t WS_RTW = 5 * MiB + 256 * 1024;
constexpr size_t WS_RNK = 5 * MiB + 512 * 1024;
constexpr size_t WS_POS = 5 * MiB + 768 * 1024;
constexpr size_t WS_RSTD = 7 * MiB;
constexpr size_t WS_WLT = 6 * MiB;
constexpr size_t WS_WAT = 6 * MiB + 64 * 1024;
constexpr size_t WS_WGT = 6 * MiB + 128 * 1024;
constexpr size_t WS_WIN = 16 * MiB;
constexpr size_t WS_WBA = 27 * MiB;
constexpr size_t WS_WBB = 28 * MiB;
constexpr size_t WS_WOUT = 29 * MiB;
constexpr size_t WS_Z = 32 * MiB;
constexpr size_t WS_H = 368 * MiB;
constexpr size_t WS_Q = 304 * MiB, WS_K = 336 * MiB, WS_MRG = 304 * MiB;
constexpr size_t WS_YA = 432 * MiB, WS_YB = 464 * MiB;
constexpr size_t WS_WUP = 368 * MiB;
constexpr size_t WS_H2 = 128 * MiB;
constexpr size_t WS_XS = 64 * MiB;
constexpr size_t WS_HID = 208 * MiB;
constexpr size_t WS_X1B = 432 * MiB;
constexpr size_t WS_ACT = 496 * MiB;
constexpr size_t WS_END = 512 * MiB;
constexpr int CW_CNT = 64, CNT_PAD = 64;
constexpr int CW_NT = 2304;
constexpr int CW_TEXP = 2368;
static_assert(CW_CNT + NEXP * CNT_PAD <= CW_NT, "control words");

__device__ __forceinline__ void tr_item(const float* W, int K, int N, bf16* WT, int kb, int nb, int dst_row0, LAS float* scr, int lane) {
    const int k0 = 64 * kb, n0 = 32 * nb;
#pragma unroll 8
    for (int i = 0; i < 32; ++i) { const int kk = 2 * i + (lane >> 5); scr[kk * 33 + (lane & 31)] = W[(size_t)(k0 + kk) * N + n0 + (lane & 31)]; }
    asm volatile("s_waitcnt lgkmcnt(0)" ::: "memory");
    const int c = lane & 7;
#pragma unroll
    for (int j = 0; j < 4; ++j) { const int n = (lane >> 3) + 8 * j; const LAS float* s = scr + (8 * c) * 33 + n;
        v4u o; o.x = pk2(s[0 * 33], s[1 * 33]); o.y = pk2(s[2 * 33], s[3 * 33]); o.z = pk2(s[4 * 33], s[5 * 33]); o.w = pk2(s[6 * 33], s[7 * 33]);
        *(v4u*)(WT + (size_t)(dst_row0 + n) * K + k0 + 8 * c) = o; }
    asm volatile("s_waitcnt lgkmcnt(0)" ::: "memory");
}

struct PArgs { const float* in[30]; float* out; unsigned char* ws; };

__device__ __forceinline__ void p_prep_weights(const PArgs& a, unsigned char* lds, int wv) {
    const int tid = mktid(wv), lane = tid & 63, wave = tid >> 6;
    LAS float* scr = (LAS float*)lds + wave * (64 * 33);
    const int gw = blockIdx.x * 8 + wave, NGW = gridDim.x * 8;
    unsigned char* ws = a.ws;
    constexpr int I_IN = 16 * 168, I_BR = 8 * 32, I_OUT = 16 * 32;
    for (int it = gw; it < I_IN + 2 * I_BR + I_OUT; it += NGW) {
        int r = it;
        if (r < I_IN) { const int kb = r / 168, nb = r % 168; int dst = 32 * nb;
            if (dst >= 1792 && dst < 2816) { const int rel = dst - 1792, u = rel >> 8, hl = (rel & 255) >> 6, half = (rel & 63) >> 5; dst = 1792 + u * 256 + half * 128 + hl * 32; }
            tr_item(a.in[6], 1024, WIN_N, (bf16*)(ws + WS_WIN), kb, nb, dst, scr, lane); continue; } r -= I_IN;
        if (r < I_BR) { const int kb = r / 32, nb = r % 32; tr_item(a.in[20], 512, 1024, (bf16*)(ws + WS_WBA), kb, nb, 32 * nb, scr, lane); continue; } r -= I_BR;
        if (r < I_BR) { const int kb = r / 32, nb = r % 32; tr_item(a.in[21], 512, 1024, (bf16*)(ws + WS_WBB), kb, nb, 32 * nb, scr, lane); continue; } r -= I_BR;
        { const int kb = r / 32, nb = r % 32; tr_item(a.in[22], 1024, 1024, (bf16*)(ws + WS_WOUT), kb, nb, 32 * nb, scr, lane); }
    }
    const int gt = blockIdx.x * 512 + tid, NGT = gridDim.x * 512;
    float* cosT = (float*)(ws + WS_COS); float* sinT = (float*)(ws + WS_SIN);
    for (int i = gt; i < SEQ * 32; i += NGT) { const int s = i >> 5, f = i & 31; const float inv = powf(10000.0f, -(float)f / 32.0f); const float ang = (float)s * inv; cosT[i] = cosf(ang); sinT[i] = sinf(ang); }
    { bf16* wlt = (bf16*)(ws + WS_WLT); bf16* wat = (bf16*)(ws + WS_WAT); bf16* wgt = (bf16*)(ws + WS_WGT);
      for (int i = gt; i < 8 * 64 * 64; i += NGT) { const int hh = i >> 12, j = (i >> 6) & 63, m = i & 63; wlt[i] = (bf16)f2bf(a.in[9][m * 512 + hh * 64 + j]); wat[i] = (bf16)f2bf(a.in[11][m * 512 + hh * 64 + j]); }
      for (int i = gt; i < 8 * 64 * 128; i += NGT) { const int hh = i >> 13, j = (i >> 7) & 63, m = i & 127; wgt[i] = (bf16)f2bf(a.in[12][m * 512 + hh * 64 + j]); } }
    { bf16* wrh = (bf16*)(ws + WS_WRH); bf16* wrl = (bf16*)(ws + WS_WRL);
      for (int i = gt; i < 48 * 1024; i += NGT) { const int e = i >> 10, k = i & 1023; const float w = e < 4 ? a.in[23][k * 4 + e] : e < 36 ? a.in[25][k * 32 + (e - 4)] : 0.f;
          const unsigned hi = f2bf(w); wrh[i] = (bf16)hi; wrl[i] = (bf16)f2bf(w - bflo(hi)); } }
}

constexpr int CW_PEXP = 2816;
__device__ __forceinline__ void p_prep_experts_dyn(const PArgs& a, unsigned char* lds, int wv) {
    const int tid = mktid(wv), lane = tid & 63, wave = tid >> 6;
    LAS float* scr = (LAS float*)lds + wave * (64 * 33);
    unsigned* ctr = (unsigned*)(a.ws + WS_CTL) + CW_PEXP;
    constexpr int NITEM = NEXP * 768;
    for (;;) {
        unsigned base = 0; if (lane == 0) base = atomicAdd(ctr, 16u);
        base = (unsigned)__builtin_amdgcn_readfirstlane((int)base);
        if (base >= (unsigned)NITEM) break;
        for (int it = (int)base; it < (int)base + 16 && it < NITEM; ++it) {
            const int e = it / 768; int r = it % 768;
            bf16* wup = (bf16*)(a.ws + WS_WUP) + (size_t)e * 1024 * 1024;
            if (r < 256) { const int kb = r / 16, nb = r % 16, n0 = 32 * nb; tr_item(a.in[27] + (size_t)e * 1024 * 512, 1024, 512, wup, kb, nb, (n0 >> 7) * 256 + (n0 & 127), scr, lane); continue; } r -= 256;
            if (r < 256) { const int kb = r / 16, nb = r % 16, n0 = 32 * nb; tr_item(a.in[28] + (size_t)e * 1024 * 512, 1024, 512, wup, kb, nb, (n0 >> 7) * 256 + 128 + (n0 & 127), scr, lane); continue; } r -= 256;
            { const int kb = r / 32, nb = r % 32; tr_item(a.in[29] + (size_t)e * 512 * 1024, 512, 1024, (bf16*)a.out + (size_t)e * 1024 * 512, kb, nb, 32 * nb, scr, lane); }
        }
    }
}

__device__ __forceinline__ void p_ada(const PArgs& a, unsigned char* lds, int wv) {
    float* sc = (float*)lds; float* red = sc + 16 * 1024;
    const float* c = a.in[1]; const float* w = a.in[2]; const float* bias = a.in[3];
    float* mod = (float*)(a.ws + WS_MOD);
    const int tid = mktid(wv);
    for (int i = tid; i < 16 * 1024; i += 512) { const float v = c[i]; sc[i] = v / (1.0f + __expf(-v)); }
    __syncthreads();
    const int col = tid & 31, kg = tid >> 5;
    for (int tile = blockIdx.x; tile < 192; tile += gridDim.x) {
        const int e = tile * 32 + col;
        float acc[16];
#pragma unroll
        for (int b = 0; b < 16; ++b) acc[b] = 0.f;
        for (int d = kg * 64; d < kg * 64 + 64; ++d) { const float wv = w[(size_t)d * 6144 + e];
#pragma unroll
            for (int b = 0; b < 16; ++b) acc[b] += sc[b * 1024 + d] * wv; }
#pragma unroll
        for (int b = 0; b < 16; ++b) red[(kg * 16 + b) * 32 + col] = acc[b];
        __syncthreads();
        { const int b = tid >> 5, cc = tid & 31; float sm = 0.f;
#pragma unroll
            for (int k = 0; k < 16; ++k) sm += red[(k * 16 + b) * 32 + cc];
            mod[b * 6144 + tile * 32 + cc] = sm + bias[tile * 32 + cc]; }
        __syncthreads();
    }
}

__device__ __forceinline__ void p_norm1(const PArgs& a, unsigned char* lds, int wv) {
    const int tid = mktid(wv), lane = tid & 63, gw = blockIdx.x * 8 + (tid >> 6), NGW = gridDim.x * 8;
    const float* x = a.in[0]; const float* g = a.in[4]; const float* mod = (const float*)(a.ws + WS_MOD);
    bf16* h = (bf16*)(a.ws + WS_H);
    for (int m = gw; m < NT; m += NGW) {
        const int b = m >> 11; const f32x4* xr = (const f32x4*)(x + (size_t)m * DM) + lane; f32x4 v[4]; float s = 0.f;
#pragma unroll
        for (int j = 0; j < 4; ++j) { v[j] = xr[64 * j]; s += (v[j].x * v[j].x + v[j].y * v[j].y) + (v[j].z * v[j].z + v[j].w * v[j].w); }
        const float rstd = rsqrtf(wave_sum(s) * (1.0f / DM) + 1e-6f);
        v2u* o = (v2u*)(h + (size_t)m * DM) + lane;
#pragma unroll
        for (int j = 0; j < 4; ++j) { const int col = 4 * (lane + 64 * j);
            const f32x4 gg = *(const f32x4*)(g + col), sh = *(const f32x4*)(mod + b * 6144 + col), scl = *(const f32x4*)(mod + b * 6144 + 1024 + col);
            const f32x4 r = v[j] * rstd * gg * (scl + 1.0f) + sh; v2u w; w.x = pk2(r.x, r.y); w.y = pk2(r.z, r.w); o[64 * j] = w; }
    }
    { float* gm2 = (float*)(a.ws + WS_GM2); float* cb = (float*)(a.ws + WS_CB); const float* g2 = a.in[5];
      for (int i = blockIdx.x * 512 + tid; i < 16 * 1024; i += gridDim.x * 512) { const int b = i >> 10, k = i & 1023; gm2[i] = g2[k] * (1.0f + mod[b * 6144 + 4096 + k]); }
      for (int p = gw; p < 16 * 48; p += NGW) { const int b = p / 48, n = p % 48; float s = 0.f;
          if (n < 36) { for (int k = lane; k < 1024; k += 64) { const float w = n < 4 ? a.in[23][k * 4 + n] : a.in[25][k * 32 + (n - 4)]; s += mod[b * 6144 + 3072 + k] * w; } }
          s = wave_sum(s); if (lane == 0) cb[p] = n < 4 ? s + a.in[24][n] : n < 36 ? s + a.in[26][n - 4] : 0.f; } }
}

using pg8::Unit; using pg8::HALF; using pg8::BM; using pg8::cvt_pk_bf16;
typedef pg8::f32x4 pf4; typedef pg8::u32x4 pu4;

struct EpiStoreBf16 {
    static constexpr bool PERM = true, AFTER_DRAIN = false, CHAIN = false;
    bf16* O; int ldc;
    __device__ __forceinline__ void operator()(const pf4 (&acc)[2][2][4][2], const Unit& u, int wr, int wc, int fr, int fq) const {
        const int row0 = u.pm * BM + wr * 64 + fr, col0 = u.pn * BM + wc * 32 + 8 * fq;
#pragma unroll
        for (int ai = 0; ai < 2; ++ai)
#pragma unroll
            for (int m = 0; m < 4; ++m) { bf16* rowp = O + (size_t)(row0 + ai * HALF + m * 16) * ldc + col0;
#pragma unroll
                for (int bj = 0; bj < 2; ++bj) { const pf4 v0 = acc[ai][bj][m][0], v1 = acc[ai][bj][m][1]; pu4 w;
                    w.x = cvt_pk_bf16(v0[0], v0[1]); w.y = cvt_pk_bf16(v0[2], v0[3]); w.z = cvt_pk_bf16(v1[0], v1[1]); w.w = cvt_pk_bf16(v1[2], v1[3]);
                    *(pu4*)(rowp + bj * HALF) = w; } }
    }
};
struct EpiZ {
    static constexpr bool PERM = true, AFTER_DRAIN = false, CHAIN = false;
    bf16* z; bf16* Q; bf16* K; const float* qg; const float* kg; const float* cosT; const float* sinT;
    __device__ __forceinline__ void operator()(const pf4 (&acc)[2][2][4][2], const Unit& u, int wr, int wc, int fr, int fq) const {
        const int row0 = u.pm * BM + wr * 64 + fr;
        if (u.pn < 7 || u.pn >= 11) {
            const int zc = (u.pn < 7 ? u.pn * 256 : (u.pn - 11) * 256 + 1792) + wc * 32 + 8 * fq;
#pragma unroll
            for (int ai = 0; ai < 2; ++ai)
#pragma unroll
                for (int m = 0; m < 4; ++m) { bf16* rowp = z + (size_t)(row0 + ai * HALF + m * 16) * INC + zc;
#pragma unroll
                    for (int bj = 0; bj < 2; ++bj) { const pf4 v0 = acc[ai][bj][m][0], v1 = acc[ai][bj][m][1]; pu4 w;
                        w.x = cvt_pk_bf16(v0[0], v0[1]); w.y = cvt_pk_bf16(v0[2], v0[3]); w.z = cvt_pk_bf16(v1[0], v1[1]); w.w = cvt_pk_bf16(v1[2], v1[3]);
                        *(pu4*)(rowp + bj * HALF) = w; } }
            return;
        }
        const bool isk = u.pn >= 9; const int head = 4 * ((u.pn - 7) & 1) + wc; const float* g = isk ? kg : qg; bf16* O = (isk ? K : Q) + head * 64 + 8 * fq;
        const float osc = isk ? 1.0f : C2;
#pragma unroll
        for (int ai = 0; ai < 2; ++ai)
#pragma unroll
            for (int m = 0; m < 4; ++m) { int rb = row0, fqv = fq; asm volatile("" : "+v"(rb), "+v"(fqv));
                const int row = rb + ai * HALF + m * 16, s = row & (SEQ - 1);
                float ss = 0.f;
#pragma unroll
                for (int bj = 0; bj < 2; ++bj)
#pragma unroll
                    for (int n = 0; n < 2; ++n) { const pf4 v = acc[ai][bj][m][n]; ss += (v[0] * v[0] + v[1] * v[1]) + (v[2] * v[2] + v[3] * v[3]); }
                ss += __builtin_bit_cast(float, __builtin_amdgcn_ds_swizzle(__builtin_bit_cast(int, ss), 0x401F));
                { const unsigned uu = __builtin_bit_cast(unsigned, ss); auto rr = __builtin_amdgcn_permlane32_swap(uu, uu, false, false); ss = __builtin_bit_cast(float, (unsigned)rr[0]) + __builtin_bit_cast(float, (unsigned)rr[1]); }
                const float rstd = rsqrtf(ss * (1.0f / 64.0f) + 1e-6f) ;
#pragma unroll
                for (int n = 0; n < 2; ++n) { const pf4 c = *(const pf4*)(cosT + s * 32 + 8 * fqv + 4 * n), sn = *(const pf4*)(sinT + s * 32 + 8 * fqv + 4 * n);
                    const pf4 x1 = acc[ai][0][m][n] * rstd * *(const pf4*)(g + 8 * fqv + 4 * n), x2 = acc[ai][1][m][n] * rstd * *(const pf4*)(g + 32 + 8 * fqv + 4 * n);
                    const pf4 o1 = x1 * c - x2 * sn, o2 = x2 * c + x1 * sn;
                    v2u wa, wb; wa.x = cvt_pk_bf16(o1[0] * osc, o1[1] * osc); wa.y = cvt_pk_bf16(o1[2] * osc, o1[3] * osc); wb.x = cvt_pk_bf16(o2[0] * osc, o2[1] * osc); wb.y = cvt_pk_bf16(o2[2] * osc, o2[3] * osc);
                    bf16* op = (isk ? K : Q) + (size_t)row * 512 + head * 64 + 8 * fqv + 4 * n; *(v2u*)op = wa; *(v2u*)(op + 32) = wb;
                    asm volatile("" ::: "memory"); } }
    }
};
struct EpiMerge {
    static constexpr bool PERM = true, AFTER_DRAIN = false, CHAIN = true;
    const bf16* z; bf16* mrg;
    __device__ __forceinline__ bool chain(pf4 (&acc)[2][2][4][2], const Unit& u, int wr, int wc, int fr, int fq) const {
        const int row0 = u.pm * BM + wr * 64 + fr, col0 = u.pn * BM + wc * 32 + 8 * fq;
        if (u.aux == 0) {
#pragma unroll
            for (int ai = 0; ai < 2; ++ai)
#pragma unroll
                for (int m = 0; m < 4; ++m) { const size_t row = (size_t)(row0 + ai * HALF + m * 16);
#pragma unroll
                    for (int bj = 0; bj < 2; ++bj) { const int col = col0 + bj * HALF; const pu4 za = *(const pu4*)(z + row * INC + ZG + col), zb = *(const pu4*)(z + row * INC + ZG + 1024 + col);
                        const float a8[8] = {bflo(za.x), bfhi(za.x), bflo(za.y), bfhi(za.y), bflo(za.z), bfhi(za.z), bflo(za.w), bfhi(za.w)};
                        const float b8[8] = {bflo(zb.x), bfhi(zb.x), bflo(zb.y), bfhi(zb.y), bflo(zb.z), bfhi(zb.z), bflo(zb.w), bfhi(zb.w)};
#pragma unroll
                        for (int e = 0; e < 8; ++e) acc[ai][bj][m][e >> 2][e & 3] *= (1.0f + __expf(-b8[e])) * __builtin_amdgcn_rcpf(1.0f + __expf(-a8[e])); } }
            return true;
        }
#pragma unroll
        for (int ai = 0; ai < 2; ++ai)
#pragma unroll
            for (int m = 0; m < 4; ++m) { const size_t row = (size_t)(row0 + ai * HALF + m * 16);
#pragma unroll
                for (int bj = 0; bj < 2; ++bj) { const int col = col0 + bj * HALF; const pu4 gz = *(const pu4*)(z + row * INC + ZG + 1024 + col); const pf4 v0 = acc[ai][bj][m][0], v1 = acc[ai][bj][m][1];
                    pu4 w;
                    w.x = cvt_pk_bf16(sigm(bflo(gz.x)) * v0[0], sigm(bfhi(gz.x)) * v0[1]); w.y = cvt_pk_bf16(sigm(bflo(gz.y)) * v0[2], sigm(bfhi(gz.y)) * v0[3]);
                    w.z = cvt_pk_bf16(sigm(bflo(gz.z)) * v1[0], sigm(bfhi(gz.z)) * v1[1]); w.w = cvt_pk_bf16(sigm(bflo(gz.w)) * v1[2], sigm(bfhi(gz.w)) * v1[3]);
                    *(pu4*)(mrg + row * DM + col) = w; } }
        return false;
    }
};
struct EpiOut {
    static constexpr bool PERM = true, AFTER_DRAIN = false, CHAIN = false;
    const float* x; const float* mod; bf16* x1;
    __device__ __forceinline__ void operator()(const pf4 (&acc)[2][2][4][2], const Unit& u, int wr, int wc, int fr, int fq) const {
        const int row0 = u.pm * BM + wr * 64 + fr, col0 = u.pn * BM + wc * 32 + 8 * fq; const int b = u.pm >> 3;
        pf4 gt[2][2];
#pragma unroll
        for (int bj = 0; bj < 2; ++bj)
#pragma unroll
            for (int n = 0; n < 2; ++n) gt[bj][n] = *(const pf4*)(mod + b * 6144 + 2048 + col0 + bj * HALF + n * 4);
#pragma unroll
        for (int ai = 0; ai < 2; ++ai)
#pragma unroll
            for (int m = 0; m < 4; ++m) { const size_t off = (size_t)(row0 + ai * HALF + m * 16) * DM + col0;
#pragma unroll
                for (int bj = 0; bj < 2; ++bj) { const pf4 x0 = *(const pf4*)(x + off + bj * HALF), x1v = *(const pf4*)(x + off + bj * HALF + 4);
                    const pf4 o0 = x0 + gt[bj][0] * acc[ai][bj][m][0], o1 = x1v + gt[bj][1] * acc[ai][bj][m][1]; pu4 w;
                    w.x = cvt_pk_bf16(o0[0], o0[1]); w.y = cvt_pk_bf16(o0[2], o0[3]); w.z = cvt_pk_bf16(o1[0], o1[1]); w.w = cvt_pk_bf16(o1[2], o1[3]);
                    *(pu4*)(x1 + off + bj * HALF) = w; } }
    }
};
struct EpiUp {
    static constexpr bool PERM = true, AFTER_DRAIN = false, CHAIN = false;
    bf16* hid;
    __device__ __forceinline__ void operator()(const pf4 (&acc)[2][2][4][2], const Unit& u, int wr, int wc, int fr, int fq) const {
        const int row0 = u.pm * BM + wr * 64 + fr, col0 = u.pn * 128 + wc * 32 + 8 * fq;
#pragma unroll
        for (int ai = 0; ai < 2; ++ai)
#pragma unroll
            for (int m = 0; m < 4; ++m) { const size_t row = (size_t)(row0 + ai * HALF + m * 16); float o[8];
#pragma unroll
                for (int n = 0; n < 2; ++n)
#pragma unroll
                    for (int e = 0; e < 4; ++e) { const float g = acc[ai][0][m][n][e], l = acc[ai][1][m][n][e]; o[4 * n + e] = g * sigm(g) * l; }
                pu4 w; w.x = cvt_pk_bf16(o[0], o[1]); w.y = cvt_pk_bf16(o[2], o[3]); w.z = cvt_pk_bf16(o[4], o[5]); w.w = cvt_pk_bf16(o[6], o[7]);
                *(pu4*)(hid + row * DEXP + col0) = w; }
    }
};

struct GemmArgs { unsigned char* ws; const float* x; float* out; const float* qg; const float* kg; };
template <class Epi> __device__ __forceinline__ void run_dense(const void* A, const void* Bt, int M, int N, int K, const Epi& E, unsigned char* lds, int wv) {
    pg8::Gemm g{K}; pg8::StaticOrder S; S.init(A, Bt, M, N, K, (int)gridDim.x, (int)blockIdx.x);
    pg8::gemm_phase<Epi, pg8::StaticOrder, true, true>((PG8_LAS unsigned char*)lds, g, S, E, wv);
}
__device__ __forceinline__ void p_gemm_in(const GemmArgs& a, unsigned char* lds, int wv) {
    EpiZ E{(bf16*)(a.ws + WS_Z), (bf16*)(a.ws + WS_Q), (bf16*)(a.ws + WS_K), a.qg, a.kg, (const float*)(a.ws + WS_COS), (const float*)(a.ws + WS_SIN)};
    run_dense(a.ws + WS_H, a.ws + WS_WIN, NT, WIN_N, 1024, E, lds, wv);
}
struct PairOrder {
    int nM, nN, nwg, G, c; const char *A0, *A1, *B0, *B1; size_t tstep;
    __device__ bool next(int i, Unit& u) const {
        const long L = (long)(i >> 1) * G + c; if (L >= nwg) return false;
        int wgid = (int)L; { const int q = nwg / pg8::NXCD, r = nwg % pg8::NXCD, xcd = wgid % pg8::NXCD, off = wgid / pg8::NXCD; wgid = (xcd < r ? xcd * (q + 1) : r * (q + 1) + (xcd - r) * q) + off; }
        const int nig = pg8::WGM * nN, gid = wgid / nig, fm = gid * pg8::WGM, gsz = (nM - fm) < pg8::WGM ? (nM - fm) : pg8::WGM;
        u.pm = fm + ((wgid % nig) % gsz); u.pn = (wgid % nig) / gsz; u.aux = i & 1;
        u.a = ((i & 1) ? A1 : A0) + (size_t)u.pm * tstep; u.b = ((i & 1) ? B1 : B0) + (size_t)u.pn * tstep; return true;
    }
    __device__ __forceinline__ void a_ready(const Unit&) const {}
    __device__ __forceinline__ void done(const Unit&) const {}
};
__device__ __forceinline__ void p_gemm_merge(const GemmArgs& a, unsigned char* lds, int wv) {
    PairOrder S{NT / 256, 4, (NT / 256) * 4, (int)gridDim.x, (int)blockIdx.x, (const char*)(a.ws + WS_YA), (const char*)(a.ws + WS_YB), (const char*)(a.ws + WS_WBA), (const char*)(a.ws + WS_WBB), (size_t)256 * 512 * 2};
    EpiMerge E{(const bf16*)(a.ws + WS_Z), (bf16*)(a.ws + WS_MRG)}; pg8::Gemm g{512};
    pg8::gemm_phase<EpiMerge, PairOrder, true, true>((PG8_LAS unsigned char*)lds, g, S, E, wv);
}
__device__ __forceinline__ void p_gemm_out(const GemmArgs& a, unsigned char* lds, int wv) {
    EpiOut E{a.x, (const float*)(a.ws + WS_MOD), (bf16*)(a.ws + WS_X1B)};
    run_dense(a.ws + WS_MRG, a.ws + WS_WOUT, NT, 1024, 1024, E, lds, wv);
}
struct GroupedOrder {
    const int* texp; int nT, nN, G, c; const char* A; size_t a_tile; const char* B; size_t b_exp, b_tile;
    __device__ bool next(int i, Unit& u) const {
        const long L = (long)i * G + c; if (L >= (long)nT * nN) return false;
        const int tile = (int)(L / nN), pn = (int)(L % nN); u.aux = 0; u.pm = tile; u.pn = pn; u.a = A + (size_t)tile * a_tile; u.b = B + (size_t)texp[tile] * b_exp + (size_t)pn * b_tile; return true;
    }
    __device__ __forceinline__ void a_ready(const Unit&) const {}
    __device__ __forceinline__ void done(const Unit&) const {}
};
__device__ __forceinline__ void p_gemm_up(const GemmArgs& a, unsigned char* lds, int wv) {
    const int* ctl = (const int*)(a.ws + WS_CTL);
    GroupedOrder S{ctl + CW_TEXP, ctl[CW_NT], 4, (int)gridDim.x, (int)blockIdx.x, (const char*)(a.ws + WS_XS), (size_t)256 * 1024 * 2, (const char*)(a.ws + WS_WUP), (size_t)1024 * 1024 * 2, (size_t)256 * 1024 * 2};
    EpiUp E{(bf16*)(a.ws + WS_HID)}; pg8::Gemm g{1024};
    pg8::gemm_phase<EpiUp, GroupedOrder, true, true>((PG8_LAS unsigned char*)lds, g, S, E, wv);
}
__device__ __forceinline__ void p_gemm_down(const GemmArgs& a, unsigned char* lds, int wv) {
    const int* ctl = (const int*)(a.ws + WS_CTL);
    GroupedOrder S{ctl + CW_TEXP, ctl[CW_NT], 4, (int)gridDim.x, (int)blockIdx.x, (const char*)(a.ws + WS_HID), (size_t)256 * 512 * 2, (const char*)a.out, (size_t)1024 * 512 * 2, (size_t)256 * 512 * 2};
    EpiStoreBf16 E{(bf16*)(a.ws + WS_XS), 1024}; pg8::Gemm g{512};
    pg8::gemm_phase<EpiStoreBf16, GroupedOrder, true, true>((PG8_LAS unsigned char*)lds, g, S, E, wv);
}

__device__ __forceinline__ void p_attn(const PArgs& a, unsigned char* lds, int vb, int nvb, int wv) {
    const attn_body::bf16* Q = (const attn_body::bf16*)(a.ws + WS_Q); const attn_body::bf16* K = (const attn_body::bf16*)(a.ws + WS_K);
    const attn_body::bf16* V = (const attn_body::bf16*)(a.ws + WS_Z) + ZV; attn_body::bf16* O = (attn_body::bf16*)(a.ws + WS_YB);
    for (int p = vb; p < 512; p += nvb)
        for (int which = 0; which < 2; ++which) { const int bh = p >> 2, s = p & 3, qb = which ? 7 - s : s;
            attn_body::attn_unit<8>(bh >> 3, bh & 7, qb, Q, K, V, O, (char*)lds, wv); }
}

__device__ __forceinline__ void p_actprep(const PArgs& a, unsigned char* lds, int wv) {
    const int tid = mktid(wv); const bf16* z = (const bf16*)(a.ws + WS_Z); bf16* act = (bf16*)(a.ws + WS_ACT); const float* mu = a.in[7];
    for (int i = blockIdx.x * 512 + tid; i < NT * 32; i += gridDim.x * 512) { const int t = i >> 5, cg = i & 31, col = 1536 + 8 * cg; const bool hasp = (t & (SEQ - 1)) > 0;
        const v4u cw = *(const v4u*)(z + (size_t)t * INC + col); v4u pw = {0u, 0u, 0u, 0u}; if (hasp) pw = *(const v4u*)(z + (size_t)(t - 1) * INC + col);
        const float c8[8] = {bflo(cw.x), bfhi(cw.x), bflo(cw.y), bfhi(cw.y), bflo(cw.z), bfhi(cw.z), bflo(cw.w), bfhi(cw.w)}, p8[8] = {bflo(pw.x), bfhi(pw.x), bflo(pw.y), bfhi(pw.y), bflo(pw.z), bfhi(pw.z), bflo(pw.w), bfhi(pw.w)};
        const f32x4 m0 = *(const f32x4*)(mu + col), m1 = *(const f32x4*)(mu + col + 4); const float m8[8] = {m0.x, m0.y, m0.z, m0.w, m1.x, m1.y, m1.z, m1.w}; float v[8];
#pragma unroll
        for (int e = 0; e < 8; ++e) { const float x = c8[e] + (p8[e] - c8[e]) * m8[e]; v[e] = cg < 8 ? 1.0f - 2.0f * __builtin_amdgcn_rcpf(1.0f + __expf(2.0f * x)) : cg < 16 ? x : sigm(x); }
        v4u w; w.x = pk2(v[0], v[1]); w.y = pk2(v[2], v[3]); w.z = pk2(v[4], v[5]); w.w = pk2(v[6], v[7]);
        *(v4u*)(act + (size_t)t * 256 + 8 * cg) = w; }
}

namespace rw {
typedef short bf16x8 __attribute__((ext_vector_type(8)));
constexpr int MB = 8192;
__device__ __forceinline__ int SW(int r, int c) { return r * 128 + ((((c >> 3) ^ (r >> 1)) & 7) << 4) + (c & 7) * 2; }
__device__ __forceinline__ int SWG(int r, int c) { return r * 256 + ((((c >> 3) ^ r) & 15) << 4) + (c & 7) * 2; }
__device__ __forceinline__ int SWF(int r, int c) { return r * 256 + ((((c >> 2) ^ r) & 15) << 4) + (c & 3) * 4; }
enum { I_AT = 0, I_BT, I_AJ, I_BHJ, I_KHJ, I_ABRT, I_X5, I_L, I_LT, I_R0, I_R1, I_KT, I_RT, I_VJ, I_X14, I_GATE, I_VT, I_VT2, NBUF };
constexpr int OFF_F32 = NBUF * MB;
constexpr int OFF_CST = OFF_F32 + (64 * 3 + 512) * 4;
constexpr int LDS_NEED = OFF_CST + 14 * 64 * 4;

__device__ __forceinline__ bf16x8 ldfrag(const unsigned char* M, int row, int k) { return *(const bf16x8*)(M + SW(row, k)); }
__device__ __forceinline__ void mm(f32x4 (&acc)[2], const unsigned char* X, const unsigned char* Y, int mt, int nh, int fr, int fq) {
    const bf16x8 a0 = ldfrag(X, 16 * mt + fr, 8 * fq), a1 = ldfrag(X, 16 * mt + fr, 8 * fq + 32);
#pragma unroll
    for (int nt = 0; nt < 2; ++nt) { const bf16x8 b0 = ldfrag(Y, 16 * (2 * nh + nt) + fr, 8 * fq), b1 = ldfrag(Y, 16 * (2 * nh + nt) + fr, 8 * fq + 32);
        acc[nt] = __builtin_amdgcn_mfma_f32_16x16x32_bf16(a0, b0, acc[nt], 0, 0, 0); acc[nt] = __builtin_amdgcn_mfma_f32_16x16x32_bf16(a1, b1, acc[nt], 0, 0, 0); }
}
typedef short s16x4 __attribute__((ext_vector_type(4)));
typedef __attribute__((address_space(3))) s16x4* lds_s16x4p;
__device__ __forceinline__ bf16x8 ldfragT(const unsigned char* M, int row0, int kb, int fr, int fq) {
    const int k0 = kb + 8 * fq + (fr >> 2), c0 = row0 + 4 * (fr & 3);
    const s16x4 lo = __builtin_amdgcn_ds_read_tr16_b64_v4i16((lds_s16x4p)(M + SW(k0, c0))), hi = __builtin_amdgcn_ds_read_tr16_b64_v4i16((lds_s16x4p)(M + SW(k0 + 4, c0)));
    return (bf16x8){lo[0], lo[1], lo[2], lo[3], hi[0], hi[1], hi[2], hi[3]};
}
struct FA { bf16x8 k0, k1; };
struct FB { bf16x8 k0[2], k1[2]; };
__device__ __forceinline__ FA ldA(const unsigned char* X, int mt, int fr, int fq) { FA f; f.k0 = ldfrag(X, 16 * mt + fr, 8 * fq); f.k1 = ldfrag(X, 16 * mt + fr, 8 * fq + 32); return f; }
__device__ __forceinline__ FB ldB(const unsigned char* Y, int nh, int fr, int fq) { FB f;
#pragma unroll
    for (int nt = 0; nt < 2; ++nt) { f.k0[nt] = ldfrag(Y, 16 * (2 * nh + nt) + fr, 8 * fq); f.k1[nt] = ldfrag(Y, 16 * (2 * nh + nt) + fr, 8 * fq + 32); }
    return f; }
__device__ __forceinline__ FA ldAT(const unsigned char* XT, int mt, int fr, int fq) { FA f; f.k0 = ldfragT(XT, 16 * mt, 0, fr, fq); f.k1 = ldfragT(XT, 16 * mt, 32, fr, fq); return f; }
__device__ __forceinline__ FB ldBT(const unsigned char* YT, int nh, int fr, int fq) { FB f;
#pragma unroll
    for (int nt = 0; nt < 2; ++nt) { f.k0[nt] = ldfragT(YT, 16 * (2 * nh + nt), 0, fr, fq); f.k1[nt] = ldfragT(YT, 16 * (2 * nh + nt), 32, fr, fq); }
    return f; }
__device__ __forceinline__ void mma(f32x4 (&acc)[2], const FA& a, const FB& b) {
    acc[0] = __builtin_amdgcn_mfma_f32_16x16x32_bf16(a.k0, b.k0[0], acc[0], 0, 0, 0); acc[1] = __builtin_amdgcn_mfma_f32_16x16x32_bf16(a.k0, b.k0[1], acc[1], 0, 0, 0);
    acc[0] = __builtin_amdgcn_mfma_f32_16x16x32_bf16(a.k1, b.k1[0], acc[0], 0, 0, 0); acc[1] = __builtin_amdgcn_mfma_f32_16x16x32_bf16(a.k1, b.k1[1], acc[1], 0, 0, 0);
}
__device__ __forceinline__ void ldC(f32x4 (&acc)[2], const unsigned char* Z, int mt, int nh, int fr, int fq) {
#pragma unroll
    for (int nt = 0; nt < 2; ++nt) { const v2u w = *(const v2u*)(Z + SW(16 * (2 * nh + nt) + fr, 16 * mt + 4 * fq)); acc[nt] = (f32x4){bflo(w.x), bfhi(w.x), bflo(w.y), bfhi(w.y)}; }
}
__device__ __forceinline__ void storeT(unsigned char* Z, const f32x4 (&acc)[2], int mt, int nh, int fr, int fq) {
#pragma unroll
    for (int nt = 0; nt < 2; ++nt) { v2u w; w.x = pk2(acc[nt][0], acc[nt][1]); w.y = pk2(acc[nt][2], acc[nt][3]); *(v2u*)(Z + SW(16 * (2 * nh + nt) + fr, 16 * mt + 4 * fq)) = w; }
}
__device__ __forceinline__ void storeN(unsigned char* Z, const f32x4 (&acc)[2], int mt, int nh, int fr, int fq) {
#pragma unroll
    for (int nt = 0; nt < 2; ++nt)
#pragma unroll
        for (int r = 0; r < 4; ++r) *(unsigned short*)(Z + SW(16 * mt + 4 * fq + r, 16 * (2 * nh + nt) + fr)) = (unsigned short)f2bf(acc[nt][r]);
}
__device__ __forceinline__ void ld8bf(const unsigned char* p, float (&v)[8]) { const v4u w = *(const v4u*)p; v[0] = bflo(w.x); v[1] = bfhi(w.x); v[2] = bflo(w.y); v[3] = bfhi(w.y); v[4] = bflo(w.z); v[5] = bfhi(w.z); v[6] = bflo(w.w); v[7] = bfhi(w.w); }
__device__ __forceinline__ void st8bf(unsigned char* p, const float (&v)[8]) { v4u w; w.x = pk2(v[0], v[1]); w.y = pk2(v[2], v[3]); w.z = pk2(v[4], v[5]); w.w = pk2(v[6], v[7]); *(v4u*)p = w; }
__device__ __forceinline__ void ld8f(const float* p, float (&v)[8]) { const f32x4 a = *(const f32x4*)p, b = *(const f32x4*)(p + 4); v[0] = a.x; v[1] = a.y; v[2] = a.z; v[3] = a.w; v[4] = b.x; v[5] = b.y; v[6] = b.z; v[7] = b.w; }
__device__ __forceinline__ void ld8fs(const unsigned char* M, int r, int c, float (&v)[8]) { const f32x4 a = *(const f32x4*)(M + SWF(r, c)), b = *(const f32x4*)(M + SWF(r, c + 4)); v[0] = a.x; v[1] = a.y; v[2] = a.z; v[3] = a.w; v[4] = b.x; v[5] = b.y; v[6] = b.z; v[7] = b.w; }
__device__ __forceinline__ void un8(const v4u w, float (&v)[8]) { v[0] = bflo(w.x); v[1] = bfhi(w.x); v[2] = bflo(w.y); v[3] = bfhi(w.y); v[4] = bflo(w.z); v[5] = bfhi(w.z); v[6] = bflo(w.w); v[7] = bfhi(w.w); }
__device__ __forceinline__ void shift8(const v4u cw, const v4u pw, bool hasp, const float* mu, float (&v)[8]) {
    float c[8], p[8], m[8]; un8(cw, c); un8(pw, p); ld8f(mu, m);
#pragma unroll
    for (int e = 0; e < 8; ++e) { const float pe = hasp ? p[e] : 0.f; v[e] = c[e] + (pe - c[e]) * m[e]; }
}
__device__ __forceinline__ float tanh_fast(float x) { return 1.0f - 2.0f * __builtin_amdgcn_rcpf(1.0f + __expf(2.0f * x)); }

#define LBAR() do { asm volatile("s_waitcnt lgkmcnt(0)" ::: "memory"); __builtin_amdgcn_s_barrier(); asm volatile("" ::: "memory"); } while (0)
__device__ __forceinline__ void scan_unit(const PArgs& a, unsigned char* lds, int bh, int wv) {
    const int tid = mktid(wv), lane = tid & 63, wid = __builtin_amdgcn_readfirstlane(tid >> 6);
    const int mt = wid >> 1, nh = wid & 1; int fr = lane & 15, fq = lane >> 4;
    const int b = bh >> 3, h = bh & 7;
#define BUF(i) (lds + (i) * MB)
    float* GC = (float*)(lds + OFF_F32); float* BON = GC + 64; float* SSQ = BON + 64; float* SEGT = SSQ + 64;
    unsigned char* LWR = BUF(I_AT); unsigned char* LAR = BUF(I_AJ); unsigned char* LGR = BUF(I_KHJ); unsigned char* YTF = BUF(I_KHJ);
    unsigned char* ACTW = BUF(I_L); unsigned char* ACTA = BUF(I_LT); unsigned char* ACTG = BUF(I_R0);
    const bf16* z = (const bf16*)(a.ws + WS_Z); bf16* ya = (bf16*)(a.ws + WS_YA);
    const float* mu = a.in[7];
    bf16x8 fw[2], fa[2], fg[4];
    { const bf16* wlt = (const bf16*)(a.ws + WS_WLT) + (size_t)h * 4096 + (16 * mt + fr) * 64 + 8 * fq; const bf16* wat = (const bf16*)(a.ws + WS_WAT) + (size_t)h * 4096 + (16 * mt + fr) * 64 + 8 * fq;
      const bf16* wgt = (const bf16*)(a.ws + WS_WGT) + (size_t)h * 8192 + (16 * mt + fr) * 128 + 8 * fq;
      fw[0] = *(const bf16x8*)wlt; fw[1] = *(const bf16x8*)(wlt + 32); fa[0] = *(const bf16x8*)wat; fa[1] = *(const bf16x8*)(wat + 32);
#pragma unroll
      for (int ks = 0; ks < 4; ++ks) fg[ks] = *(const bf16x8*)(wgt + 32 * ks); }
    float* CST = (float*)(lds + OFF_CST);
    for (int i = tid; i < 14 * 64; i += 512) { const int blk = i >> 6, jj = i & 63; float v;
        if (blk < 3) v = mu[blk * 512 + h * 64 + jj]; else if (blk < 7) v = mu[1536 + (blk - 3) * 64 + jj]; else v = a.in[blk == 7 ? 8 : blk == 8 ? 10 : blk == 9 ? 13 : blk == 10 ? 14 : blk == 11 ? 15 : blk == 12 ? 16 : 17][h * 64 + jj];
        CST[i] = v; }
    int s0i = I_X14, aki = I_X5;
    for (int i = tid; i < MB / 4; i += 512) ((unsigned*)BUF(I_X14))[i] = 0u;
    LBAR();
    int pt = tid >> 3, j0 = 8 * (tid & 7);
    const int colh = h * 64 + j0;
    const int zoff0 = colh, zoff1 = 512 + colh, zoff2 = 1024 + colh;
    const bf16* actb = (const bf16*)(a.ws + WS_ACT);
    v4u zc[3], zq[3], za[4];
#define ZLOAD(cc) do { const size_t tr_ = (size_t)b * SEQ + (cc) * 64 + pt; const bf16* zr_ = z + tr_ * INC; const bf16* zs_ = ((cc) * 64 + pt) > 0 ? zr_ - INC : zr_; const bf16* ar_ = actb + tr_ * 256 + j0; \
        zc[0] = *(const v4u*)(zr_ + zoff0); zc[1] = *(const v4u*)(zr_ + zoff1); zc[2] = *(const v4u*)(zr_ + zoff2); \
        zq[0] = *(const v4u*)(zs_ + zoff0); zq[1] = *(const v4u*)(zs_ + zoff1); zq[2] = *(const v4u*)(zs_ + zoff2); \
        za[0] = *(const v4u*)(ar_); za[1] = *(const v4u*)(ar_ + 64); za[2] = *(const v4u*)(ar_ + 128); za[3] = *(const v4u*)(ar_ + 192); } while (0)
#define ESTAGE(VTB, TT_) \
        { float y[8], vv[8], g8[8], lg[8], lb[8]; ld8fs(YTF, pt, j0, y); ld8bf((VTB) + SW(pt, j0), vv); ld8bf(BUF(I_GATE) + SW(pt, j0), g8); \
          ld8f(CST + 12 * 64 + j0, lg); ld8f(CST + 13 * 64 + j0, lb); \
          float sm = 0.f; \
_Pragma("unroll") \
          for (int e = 0; e < 8; ++e) sm += y[e]; \
          const float mean = red8(sm) * (1.0f / 64.0f); float sq = 0.f; \
_Pragma("unroll") \
          for (int e = 0; e < 8; ++e) { y[e] -= mean; sq += y[e] * y[e]; } \
          const float rstd = rsqrtf(red8(sq) * (1.0f / 64.0f) + 64e-5f), bon = BON[pt]; \
_Pragma("unroll") \
          for (int e = 0; e < 8; ++e) y[e] = (y[e] * rstd * lg[e] + lb[e] + bon * vv[e]) * g8[e]; \
          ypend.x = pk2(y[0], y[1]); ypend.y = pk2(y[2], y[3]); ypend.z = pk2(y[4], y[5]); ypend.w = pk2(y[6], y[7]); ypoff = (TT_) * RWW + colh; }
    ZLOAD(0);
    v4u ypend = {0u, 0u, 0u, 0u}; size_t ypoff = 0;
    for (int c = 0; c < SEQ / 64; ++c) {
        asm volatile("" : "+v"(fr), "+v"(fq), "+v"(pt), "+v"(j0));
        const int s = c * 64 + pt; const size_t t = (size_t)b * SEQ + s; const bool hasp = s > 0;
        if (c > 0) { ESTAGE(((c - 1) & 1) ? BUF(I_VT2) : BUF(I_VT), t - 64) }
        { float v[8];
          shift8(zc[0], zq[0], hasp, CST + 0 * 64 + j0, v); st8bf(BUF(I_RT) + SW(pt, j0), v);
          shift8(zc[1], zq[1], hasp, CST + 1 * 64 + j0, v); st8bf(BUF(I_KT) + SW(pt, j0), v);
          { float kkc[8], ss = 0.f; ld8f(CST + 9 * 64 + j0, kkc);
#pragma unroll
            for (int e = 0; e < 8; ++e) { const float q = v[e] * kkc[e]; ss += q * q; }
            ss = red8(ss); if (j0 == 0) SSQ[pt] = rsqrtf(fmaxf(ss, 1e-24f)); }
          shift8(zc[2], zq[2], hasp, CST + 2 * 64 + j0, v); st8bf(((c & 1) ? BUF(I_VT2) : BUF(I_VT)) + SW(pt, j0), v);
          *(v4u*)(ACTW + SW(pt, j0)) = za[0]; *(v4u*)(ACTA + SW(pt, j0)) = za[1]; *(v4u*)(ACTG + SWG(pt, j0)) = za[2]; *(v4u*)(ACTG + SWG(pt, 64 + j0)) = za[3]; }
        LBAR();
        f32x4 aw[2], aa[2], ag[2];
#pragma unroll
        for (int nt = 0; nt < 2; ++nt) { const int tr = 16 * (2 * nh + nt) + fr; const f32x4 zero = {0.f, 0.f, 0.f, 0.f};
            aw[nt] = __builtin_amdgcn_mfma_f32_16x16x32_bf16(fw[0], ldfrag(ACTW, tr, 8 * fq), zero, 0, 0, 0); aw[nt] = __builtin_amdgcn_mfma_f32_16x16x32_bf16(fw[1], ldfrag(ACTW, tr, 8 * fq + 32), aw[nt], 0, 0, 0);
            aa[nt] = __builtin_amdgcn_mfma_f32_16x16x32_bf16(fa[0], ldfrag(ACTA, tr, 8 * fq), zero, 0, 0, 0); aa[nt] = __builtin_amdgcn_mfma_f32_16x16x32_bf16(fa[1], ldfrag(ACTA, tr, 8 * fq + 32), aa[nt], 0, 0, 0);
            ag[nt] = zero;
#pragma unroll
            for (int ks = 0; ks < 4; ++ks) ag[nt] = __builtin_amdgcn_mfma_f32_16x16x32_bf16(fg[ks], *(const bf16x8*)(ACTG + SWG(tr, 8 * fq + 32 * ks)), ag[nt], 0, 0, 0); }
#pragma unroll
        for (int nt = 0; nt < 2; ++nt) { const int tr = 16 * (2 * nh + nt) + fr, jc = 16 * mt + 4 * fq;
            *(f32x4*)(LWR + SWF(tr, jc)) = aw[nt]; *(f32x4*)(LAR + SWF(tr, jc)) = aa[nt]; *(f32x4*)(LGR + SWF(tr, jc)) = ag[nt]; }
        LBAR();
        float lwv[8], an[8], bb[8], k2[8], rr[8], gg[8], vv8[8], p8[8];
        { const int j = lane, tw = wid;
          const float w0c = CST[7 * 64 + j], a0c = CST[8 * 64 + j], kkc = CST[9 * 64 + j], kac = CST[10 * 64 + j], rkc = CST[11 * 64 + j];
          const unsigned char* vtb = (c & 1) ? BUF(I_VT2) : BUF(I_VT);
          float bo[8], av[8];
#pragma unroll
          for (int u = 0; u < 8; ++u) { const int t8 = 8 * tw + u;
              const float lw = *(const float*)(LWR + SWF(t8, j)), la = *(const float*)(LAR + SWF(t8, j)); gg[u] = *(const float*)(LGR + SWF(t8, j));
              rr[u] = bflo(*(const unsigned short*)(BUF(I_RT) + SW(t8, j))); const float kx = bflo(*(const unsigned short*)(BUF(I_KT) + SW(t8, j))); vv8[u] = bflo(*(const unsigned short*)(vtb + SW(t8, j)));
              lwv[u] = -0.606531f * sigm(w0c + lw); av[u] = sigm(a0c + la);
              const float kn = kx * kkc * SSQ[t8]; an[u] = -kn; bb[u] = kn * av[u];
              k2[u] = kx * (1.0f + (av[u] - 1.0f) * kac); bo[u] = rr[u] * k2[u] * rkc; }
          wave_sum8(bo);
          if (j == 0) {
#pragma unroll
              for (int u = 0; u < 8; ++u) BON[8 * tw + u] = bo[u]; }
          p8[0] = lwv[0];
#pragma unroll
          for (int u = 1; u < 8; ++u) p8[u] = p8[u - 1] + lwv[u];
          SEGT[tw * 64 + j] = p8[7]; }
        LBAR();
        { const int j = lane, tw = wid; float sg8[8];
#pragma unroll
          for (int s2 = 0; s2 < 8; ++s2) sg8[s2] = SEGT[s2 * 64 + j];
          float base = 0.f, tot = 0.f;
#pragma unroll
          for (int s2 = 0; s2 < 8; ++s2) { tot += sg8[s2]; base += (s2 < tw) ? sg8[s2] : 0.f; }
          const float gcj = __expf(tot); if (tw == 7) GC[j] = gcj;
          float eprev = __expf(base);
          float o0[8], o1[8], o2[8], o3[8], ob[8], ok[8];
#pragma unroll
          for (int u = 0; u < 8; ++u) { const float L = p8[u] + base; const float e1 = __expf(L), ie1 = __builtin_amdgcn_rcpf(e1), ep = eprev, eh = gcj * ie1; eprev = e1;
              o0[u] = an[u] * ep; o1[u] = bb[u] * ie1; o2[u] = k2[u] * ie1; o3[u] = rr[u] * e1; ob[u] = bb[u] * eh; ok[u] = k2[u] * eh;
              *(unsigned short*)(BUF(I_GATE) + SW(8 * tw + u, j)) = (unsigned short)f2bf(gg[u]); }
          st8bf(BUF(I_AJ) + SW(j, 8 * tw), o0); st8bf(BUF(I_BT) + SW(j, 8 * tw), o1); st8bf(BUF(I_KT) + SW(j, 8 * tw), o2); st8bf(BUF(I_RT) + SW(j, 8 * tw), o3);
          st8bf(BUF(I_BHJ) + SW(j, 8 * tw), ob); st8bf(BUF(I_KHJ) + SW(j, 8 * tw), ok); st8bf(BUF(I_VJ) + SW(j, 8 * tw), vv8); }
        if (c > 0) *(v4u*)(ya + ypoff) = ypend;
        if (c + 1 < SEQ / 64) ZLOAD(c + 1);
        LBAR();
#define MASK(acc, cond) _Pragma("unroll") for (int nt = 0; nt < 2; ++nt) _Pragma("unroll") for (int r = 0; r < 4; ++r) { const int m_ = 16 * mt + 4 * fq + r, n_ = 16 * (2 * nh + nt) + fr; if (!(cond)) acc[nt][r] = 0.f; }
        { const f32x4 zero = {0.f, 0.f, 0.f, 0.f}; f32x4 aL[2] = {zero, zero}, aL2[2] = {zero, zero}, aK[2] = {zero, zero}, aR[2] = {zero, zero};
          const FA fAT = ldAT(BUF(I_AJ), mt, fr, fq), fBTa = ldAT(BUF(I_BT), mt, fr, fq); const FB fBT = ldBT(BUF(I_BT), nh, fr, fq), fKT = ldBT(BUF(I_KT), nh, fr, fq), fRT = ldBT(BUF(I_RT), nh, fr, fq), fATb = ldBT(BUF(I_AJ), nh, fr, fq);
          mma(aL, fAT, fBT);
          mma(aL2, fBTa, fATb);
          mma(aK, fAT, fKT);
          mma(aR, fBTa, fRT);
          MASK(aL, m_ > n_) MASK(aL2, n_ > m_) MASK(aK, n_ < m_) MASK(aR, m_ <= n_)
#pragma unroll
          for (int nt = 0; nt < 2; ++nt)
#pragma unroll
              for (int r = 0; r < 4; ++r) { const int m_ = 16 * mt + 4 * fq + r, n_ = 16 * (2 * nh + nt) + fr; if (m_ == n_) aL2[nt][r] = 1.0f; }
          storeT(BUF(I_L), aL, mt, nh, fr, fq); storeT(BUF(I_R0), aL2, mt, nh, fr, fq);
          storeT(BUF(aki), aK, mt, nh, fr, fq);
          storeT(BUF(I_ABRT), aR, mt, nh, fr, fq); }
        LBAR();
#pragma unroll
        for (int k = 1; k <= 6; ++k) {
            unsigned char* Pc = (k & 1) ? BUF(I_L) : BUF(I_AT); unsigned char* Pn = (k & 1) ? BUF(I_AT) : BUF(I_L);
            unsigned char* Rc = (k & 1) ? BUF(I_R1) : BUF(I_R0); unsigned char* Rn = (k & 1) ? BUF(I_R0) : BUF(I_R1);
            const f32x4 zero = {0.f, 0.f, 0.f, 0.f}; f32x4 aP[2] = {zero, zero}, aRr[2] = {zero, zero};
            FA fP, fPTa; FB fPT, fR;
            if (k <= 5) { fP = ldAT(Pc, mt, fr, fq); fPT = ldB(Pc, nh, fr, fq); }
            if (k >= 2) { fPTa = ldA(Pc, mt, fr, fq); fR = ldB(Rc, nh, fr, fq); ldC(aRr, Rc, mt, nh, fr, fq); }
            if (k <= 5) mma(aP, fP, fPT);
            if (k >= 2) mma(aRr, fPTa, fR);
            if (k <= 5) storeT(Pn, aP, mt, nh, fr, fq);
            if (k >= 2) storeT(Rn, aRr, mt, nh, fr, fq);
            LBAR();
        }
        { const f32x4 zero = {0.f, 0.f, 0.f, 0.f}; f32x4 a1[2] = {zero, zero}, a2[2] = {zero, zero};
          const FA fTT = ldA(BUF(I_R1), mt, fr, fq); const FB fAJ = ldB(BUF(I_AJ), nh, fr, fq), fAK = ldB(BUF(aki), nh, fr, fq);
          mma(a1, fTT, fAJ); mma(a2, fTT, fAK);
          storeT(BUF(I_L), a1, mt, nh, fr, fq);
          storeT(BUF(I_LT), a2, mt, nh, fr, fq); }
        LBAR();
        { const f32x4 zero = {0.f, 0.f, 0.f, 0.f}; f32x4 aMY[2], aNY[2] = {zero, zero}, aMS[2] = {zero, zero}, aNS[2];
          const FA fG1 = ldA(BUF(I_L), mt, fr, fq), fG2 = ldA(BUF(I_LT), mt, fr, fq), fKTa = ldAT(BUF(I_KT), mt, fr, fq);
          const FB fAB = ldB(BUF(I_ABRT), nh, fr, fq), fRT = ldBT(BUF(I_RT), nh, fr, fq), fBH = ldB(BUF(I_BHJ), nh, fr, fq);
#pragma unroll
          for (int nt = 0; nt < 2; ++nt)
#pragma unroll
              for (int r = 0; r < 4; ++r) aMY[nt][r] = bflo(*(const unsigned short*)(BUF(I_RT) + SW(16 * mt + 4 * fq + r, 16 * (2 * nh + nt) + fr)));
          ldC(aNS, BUF(I_KHJ), mt, nh, fr, fq);
          mma(aNY, fKTa, fRT);
          mma(aMY, fG1, fAB);
          mma(aMS, fG1, fBH);
          mma(aNS, fG2, fBH);
          MASK(aNY, m_ <= n_)
          mma(aNY, fG2, fAB);
#pragma unroll
          for (int nt = 0; nt < 2; ++nt)
#pragma unroll
              for (int r = 0; r < 4; ++r) { const int m_ = 16 * mt + 4 * fq + r, n_ = 16 * (2 * nh + nt) + fr; if (m_ == n_) aMS[nt][r] += GC[m_]; }
          storeT(BUF(I_AT), aMY, mt, nh, fr, fq); storeT(BUF(I_BT), aNY, mt, nh, fr, fq); storeT(BUF(I_AJ), aMS, mt, nh, fr, fq); storeT(BUF(I_R0), aNS, mt, nh, fr, fq); }
        LBAR();
        { const f32x4 zero = {0.f, 0.f, 0.f, 0.f}; f32x4 aY[2] = {zero, zero}, aS[2] = {zero, zero};
          const FA fS0a = ldA(BUF(s0i), mt, fr, fq), fVJa = ldA(BUF(I_VJ), mt, fr, fq), fMS = ldA(BUF(I_AJ), mt, fr, fq), fNS = ldA(BUF(I_R0), mt, fr, fq);
          const FB fMY = ldB(BUF(I_AT), nh, fr, fq), fNY = ldB(BUF(I_BT), nh, fr, fq), fS0 = ldB(BUF(s0i), nh, fr, fq), fVJ = ldB(BUF(I_VJ), nh, fr, fq);
          mma(aY, fS0a, fMY); mma(aS, fMS, fS0); mma(aY, fVJa, fNY); mma(aS, fNS, fVJ);
#pragma unroll
          for (int nt = 0; nt < 2; ++nt) *(f32x4*)(YTF + SWF(16 * (2 * nh + nt) + fr, 16 * mt + 4 * fq)) = aY[nt];
          storeT(BUF(aki), aS, mt, nh, fr, fq); }
        LBAR();
#undef MASK
        { const int tmp = s0i; s0i = aki; aki = tmp; }
    }
    { const int c = SEQ / 64; const size_t tprev = (size_t)b * SEQ + (c - 1) * 64 + pt; ESTAGE(((c - 1) & 1) ? BUF(I_VT2) : BUF(I_VT), tprev) }
    *(v4u*)(ya + ypoff) = ypend;
    LBAR();
#undef ESTAGE
#undef BUF
#undef ZLOAD
}
#undef LBAR
}

__device__ __forceinline__ void p_norm2_route(const PArgs& a, unsigned char* lds, int wv) {
    typedef short bf16x8 __attribute__((ext_vector_type(8)));
    const int tid = mktid(wv), lane = tid & 63, fr = lane & 15, fq = lane >> 4;
    const bf16* x1 = (const bf16*)(a.ws + WS_X1B); const float* mod = (const float*)(a.ws + WS_MOD); const float* gm2 = (const float*)(a.ws + WS_GM2); const float* cbt = (const float*)(a.ws + WS_CB);
    int* rte = (int*)(a.ws + WS_RTE); float* rtw = (float*)(a.ws + WS_RTW); int* rnk = (int*)(a.ws + WS_RNK); unsigned* cnt = (unsigned*)(a.ws + WS_CTL) + CW_CNT;
    float* PL = (float*)lds;
    float* PS = PL + 8 * 32 * 48;
    float* RS_ = PS + 8 * 32;
    float* FL = RS_ + 32;
    unsigned* HIST = (unsigned*)(FL + 32 * 48);
    unsigned* LRK = HIST + 32;
    if (tid < 32) HIST[tid] = 0u;
    __syncthreads();
    int gcount = 0;
    bf16x8 wh[4][3], wl[4][3];
    { const bf16* wrh = (const bf16*)(a.ws + WS_WRH) + fr * 1024 + 128 * wv + 8 * fq; const bf16* wrl = (const bf16*)(a.ws + WS_WRL) + fr * 1024 + 128 * wv + 8 * fq;
#pragma unroll
      for (int ks = 0; ks < 4; ++ks)
#pragma unroll
          for (int nt = 0; nt < 3; ++nt) { wh[ks][nt] = *(const bf16x8*)(wrh + nt * 16 * 1024 + 32 * ks); wl[ks][nt] = *(const bf16x8*)(wrl + nt * 16 * 1024 + 32 * ks); } }
    for (int grp = blockIdx.x; grp < NT / 32; grp += gridDim.x) {
        const int row0 = grp * 32, b = row0 >> 11;
        f32x4 acc[3][2];
#pragma unroll
        for (int nt = 0; nt < 3; ++nt) { acc[nt][0] = (f32x4){0.f, 0.f, 0.f, 0.f}; acc[nt][1] = acc[nt][0]; }
        float ssq[2] = {0.f, 0.f};
#pragma unroll
        for (int rt = 0; rt < 2; ++rt) {
            float xs[4][8];
#pragma unroll
            for (int ks = 0; ks < 4; ++ks) rw::ld8bf((const unsigned char*)(x1 + (size_t)(row0 + 16 * rt + fr) * DM + 128 * wv + 32 * ks + 8 * fq), xs[ks]);
#pragma unroll
            for (int ks = 0; ks < 4; ++ks) { float gm[8]; rw::ld8f(gm2 + b * 1024 + 128 * wv + 32 * ks + 8 * fq, gm); unsigned hw[4], lw[4];
#pragma unroll
                for (int e = 0; e < 4; ++e) { const float x0 = xs[ks][2 * e], x1v = xs[ks][2 * e + 1]; ssq[rt] += x0 * x0 + x1v * x1v; const float g0 = x0 * gm[2 * e], g1 = x1v * gm[2 * e + 1];
                    hw[e] = pk2(g0, g1); lw[e] = pk2(g0 - bflo(hw[e]), g1 - bfhi(hw[e])); }
                const v4u hv = {hw[0], hw[1], hw[2], hw[3]}, lv = {lw[0], lw[1], lw[2], lw[3]}; const bf16x8 bh = __builtin_bit_cast(bf16x8, hv), bl = __builtin_bit_cast(bf16x8, lv);
#pragma unroll
                for (int nt = 0; nt < 3; ++nt) { acc[nt][rt] = __builtin_amdgcn_mfma_f32_16x16x32_bf16(wh[ks][nt], bh, acc[nt][rt], 0, 0, 0); acc[nt][rt] = __builtin_amdgcn_mfma_f32_16x16x32_bf16(wl[ks][nt], bh, acc[nt][rt], 0, 0, 0);
                    acc[nt][rt] = __builtin_amdgcn_mfma_f32_16x16x32_bf16(wh[ks][nt], bl, acc[nt][rt], 0, 0, 0); } } }
#pragma unroll
        for (int rt = 0; rt < 2; ++rt) {
#pragma unroll
            for (int nt = 0; nt < 3; ++nt) *(f32x4*)(PL + (wv * 32 + 16 * rt + fr) * 48 + 16 * nt + 4 * fq) = acc[nt][rt];
            float s = ssq[rt]; s += __builtin_bit_cast(float, __builtin_amdgcn_ds_swizzle(__builtin_bit_cast(int, s), 0x401F));
            { const unsigned u = __builtin_bit_cast(unsigned, s); auto rr = __builtin_amdgcn_permlane32_swap(u, u, false, false); s = __builtin_bit_cast(float, (unsigned)rr[0]) + __builtin_bit_cast(float, (unsigned)rr[1]); }
            if (fq == 0) PS[wv * 32 + 16 * rt + fr] = s; }
        __syncthreads();
        { const int r = tid >> 4, c = tid & 15; float s0 = 0.f, s1 = 0.f, s2 = 0.f, sq = 0.f;
#pragma unroll
          for (int w = 0; w < 8; ++w) { const float* p = PL + (w * 32 + r) * 48; s0 += p[c]; s1 += p[c + 16]; s2 += p[c + 32]; sq += PS[w * 32 + r]; }
          const float rstd = rsqrtf(sq * (1.0f / DM) + 1e-6f); const float* cb = cbt + b * 48;
          FL[r * 48 + c] = rstd * s0 + cb[c]; FL[r * 48 + c + 16] = rstd * s1 + cb[c + 16]; FL[r * 48 + c + 32] = rstd * s2 + cb[c + 32];
          if (c == 0) ((float*)(a.ws + WS_RSTD))[row0 + r] = rstd; }
        __syncthreads();
        if (tid < 32) { const int m = row0 + tid; const float* lg = FL + tid * 48;
            int gi = 0; float gm = lg[0];
#pragma unroll
            for (int i = 1; i < 4; ++i) if (lg[i] > gm) { gm = lg[i]; gi = i; }
            float gs = 0.f;
#pragma unroll
            for (int i = 0; i < 4; ++i) gs += __expf(lg[i] - gm);
            const float pg = 1.0f / gs;
            float el[8];
#pragma unroll
            for (int k = 0; k < 8; ++k) el[k] = lg[4 + gi * 8 + k];
            int e1 = 0; float m1 = el[0];
#pragma unroll
            for (int k = 1; k < 8; ++k) if (el[k] > m1) { m1 = el[k]; e1 = k; }
            int e2 = -1; float m2 = -INFINITY;
#pragma unroll
            for (int k = 0; k < 8; ++k) if (k != e1 && el[k] > m2) { m2 = el[k]; e2 = k; }
            const float q2 = __expf(m2 - m1); const float w1 = pg / (1.0f + q2), w2 = pg * q2 / (1.0f + q2);
            const int ea = gi * 8 + e1, eb = gi * 8 + e2; rte[2 * m] = ea; rte[2 * m + 1] = eb; rtw[2 * m] = w1; rtw[2 * m + 1] = w2;
            LRK[gcount * 64 + 2 * tid] = atomicAdd(HIST + ea, 1u) | ((unsigned)ea << 24); LRK[gcount * 64 + 2 * tid + 1] = atomicAdd(HIST + eb, 1u) | ((unsigned)eb << 24); }
        ++gcount;
        __syncthreads();
    }
    if (tid < 32) { const unsigned n = HIST[tid]; HIST[tid] = n ? atomicAdd(cnt + tid * CNT_PAD, n) : 0u; }
    __syncthreads();
    for (int i = tid; i < gcount * 64; i += 512) { const int gi_ = i >> 6, e = i & 63; const int m2 = 2 * ((blockIdx.x + gi_ * gridDim.x) * 32) + e; const unsigned lr = LRK[i]; rnk[m2] = (int)(HIST[lr >> 24] + (lr & 0xffffffu)); }
    __syncthreads();
}
__device__ __forceinline__ void p_moe_gather(const PArgs& a, unsigned char* lds, int wv) {
    int* off = (int*)lds;
    const int tid = mktid(wv), lane = tid & 63, gw = blockIdx.x * 8 + (tid >> 6), NGW = gridDim.x * 8;
    int* ctl = (int*)(a.ws + WS_CTL); const unsigned* cnt = (const unsigned*)ctl + CW_CNT;
    if (tid == 0) { int o = 0, nt = 0;
        for (int e = 0; e < NEXP; ++e) { off[e] = o; const int tiles = ((int)cnt[e * CNT_PAD] + 255) >> 8;
            if (blockIdx.x == 0) for (int i = 0; i < tiles; ++i) ctl[CW_TEXP + nt + i] = e;
            nt += tiles; o += tiles * 256; }
        if (blockIdx.x == 0) ctl[CW_NT] = nt; }
    __syncthreads();
    const int* rte = (const int*)(a.ws + WS_RTE); const int* rnk = (const int*)(a.ws + WS_RNK); int* pos = (int*)(a.ws + WS_POS);
    const bf16* x1 = (const bf16*)(a.ws + WS_X1B); bf16* xs = (bf16*)(a.ws + WS_XS); const float* rstdv = (const float*)(a.ws + WS_RSTD);
    const float* mod = (const float*)(a.ws + WS_MOD); const float* gm2 = (const float*)(a.ws + WS_GM2);
    for (int t = gw; t < NT; t += NGW) { const int b = t >> 11; const int p0 = off[rte[2 * t]] + rnk[2 * t], p1 = off[rte[2 * t + 1]] + rnk[2 * t + 1]; if (lane == 0) { pos[2 * t] = p0; pos[2 * t + 1] = p1; }
        const float rstd = rstdv[t];
#pragma unroll
        for (int hf = 0; hf < 2; ++hf) { const int col = 8 * lane + 512 * hf; float xv[8], gm[8], sh[8], o[8];
            rw::ld8bf((const unsigned char*)(x1 + (size_t)t * DM + col), xv); rw::ld8f(gm2 + b * 1024 + col, gm); rw::ld8f(mod + b * 6144 + 3072 + col, sh);
#pragma unroll
            for (int e = 0; e < 8; ++e) o[e] = xv[e] * gm[e] * rstd + sh[e];
            v4u w; w.x = pk2(o[0], o[1]); w.y = pk2(o[2], o[3]); w.z = pk2(o[4], o[5]); w.w = pk2(o[6], o[7]);
            *(v4u*)(xs + (size_t)p0 * DM + col) = w; *(v4u*)(xs + (size_t)p1 * DM + col) = w; } }
}
__device__ __forceinline__ void p_combine(const PArgs& a, unsigned char* lds, int wv) {
    const int tid = mktid(wv), lane = tid & 63, gw = blockIdx.x * 8 + (tid >> 6), NGW = gridDim.x * 8;
    const float* mod = (const float*)(a.ws + WS_MOD); const int* pos = (const int*)(a.ws + WS_POS); const float* rtw = (const float*)(a.ws + WS_RTW);
    const bf16* ys = (const bf16*)(a.ws + WS_XS); float* out = a.out;
    for (int m = gw; m < NT; m += NGW) { const int b = m >> 11; const int p0 = pos[2 * m], p1 = pos[2 * m + 1]; const float w0 = rtw[2 * m], w1 = rtw[2 * m + 1];
        f32x4* o = (f32x4*)(out + (size_t)m * DM) + lane; const v2u* xb = (const v2u*)((const bf16*)(a.ws + WS_X1B) + (size_t)m * DM) + lane; const v2u* y0 = (const v2u*)(ys + (size_t)p0 * DM) + lane; const v2u* y1 = (const v2u*)(ys + (size_t)p1 * DM) + lane;
#pragma unroll
        for (int j = 0; j < 4; ++j) { const int col = 4 * (lane + 64 * j); const f32x4 g2 = *(const f32x4*)(mod + b * 6144 + 5120 + col); const v2u a0 = y0[64 * j], a1 = y1[64 * j];
            const f32x4 e0 = {bflo(a0.x), bfhi(a0.x), bflo(a0.y), bfhi(a0.y)}, e1 = {bflo(a1.x), bfhi(a1.x), bflo(a1.y), bfhi(a1.y)};
            const v2u xw = xb[64 * j]; const f32x4 xv = {bflo(xw.x), bfhi(xw.x), bflo(xw.y), bfhi(xw.y)};
            o[64 * j] = xv + g2 * (e0 * w0 + e1 * w1); } }
}

#define XB_TMO      128
#define XB_XCNT(j)  (256  + 64 * (j))
#define XB_XSUB(j)  (1280 + 64 * (j))
#define XB_XGEN(j)  (2304 + 64 * (j))
#define XB_TOP      3328
#define XB_TOPGEN   3392
#define XCD_BAR_WORDS 3456
#define XB_SPIN_CAP (1u << 22)

__device__ __forceinline__ unsigned xb_ld(unsigned* p)              { return __hip_atomic_load(p, __ATOMIC_RELAXED, __HIP_MEMORY_SCOPE_AGENT); }
__device__ __forceinline__ unsigned xb_add(unsigned* p, unsigned v) { return __hip_atomic_fetch_add(p, v, __ATOMIC_RELAXED, __HIP_MEMORY_SCOPE_AGENT); }
__device__ __forceinline__ unsigned xb_xcc_id() { return (unsigned)__builtin_amdgcn_s_getreg((3 << 11) | 20) & 0xFu; }
#define XB_SPIN(cond, bar) do { unsigned _sp = 0; while (cond) { __builtin_amdgcn_s_sleep(1); \
    if ((++_sp & 255u) == 0u) { if (xb_ld(&(bar)[XB_TMO])) break; if (_sp > XB_SPIN_CAP) { atomicAdd(&(bar)[XB_TMO], 1u); break; } } } } while (0)

struct XcdBarrier {
    unsigned* bar; unsigned x;
    volatile LAS unsigned* st;
};

__device__ __forceinline__ XcdBarrier xcd_barrier_post(unsigned* bar, volatile LAS unsigned* st, int wv) {
    XcdBarrier b; b.bar = bar; b.x = xb_xcc_id(); b.st = st;
    if (mktid(wv) == 0) (void)xb_add(&bar[XB_XCNT(b.x)], 1u);
    return b;
}
__device__ __forceinline__ void xcd_barrier_complete(unsigned* bar, unsigned x, unsigned& nloc, unsigned& nx) {
    const unsigned G = gridDim.x * gridDim.y * gridDim.z;
    unsigned sum, cnt, mine, sp = 0u;
    for (;;) {
        sum = 0u; cnt = 0u; mine = 0u;
#pragma unroll
        for (unsigned j = 0; j < 16; ++j) { const unsigned c = xb_ld(&bar[XB_XCNT(j)]); sum += c; cnt += (c > 0u) ? 1u : 0u; mine = (j == x) ? c : mine; }
        if (sum == G) break;
        __builtin_amdgcn_s_sleep(1);
        if ((++sp & 255u) == 0u) { if (xb_ld(&bar[XB_TMO])) break; if (sp > XB_SPIN_CAP) { atomicAdd(&bar[XB_TMO], 1u); break; } }
    }
    nloc = mine > 0u ? mine : 1u; nx = cnt > 0u ? cnt : 1u;
}

__device__ __forceinline__ void xcd_barrier(const XcdBarrier& b, int wv) {
    asm volatile("s_waitcnt vmcnt(0)" ::: "memory");
    __syncthreads();
    if (mktid(wv) == 0) {
        unsigned* bar = b.bar;
        __builtin_amdgcn_s_waitcnt(0);
        unsigned nloc = b.st[0], nx = b.st[1];
        if (nloc == 0u) { xcd_barrier_complete(bar, b.x, nloc, nx); b.st[0] = nloc; b.st[1] = nx; }
        const unsigned old = xb_add(&bar[XB_XSUB(b.x)], 1u);
        const unsigned gen = old / nloc;
        if (old + 1u == (gen + 1u) * nloc) {
            __builtin_amdgcn_fence(__ATOMIC_RELEASE, "agent");
            asm volatile("s_waitcnt vmcnt(0)" ::: "memory");
            const unsigned og = xb_add(&bar[XB_TOP], 1u);
            const unsigned tg = og / nx;
            if (og + 1u == (tg + 1u) * nx) xb_add(&bar[XB_TOPGEN], 1u);
            else XB_SPIN(xb_ld(&bar[XB_TOPGEN]) == tg, bar);
            __builtin_amdgcn_fence(__ATOMIC_ACQUIRE, "agent");
            xb_add(&bar[XB_XGEN(b.x)], 1u);
            asm volatile("s_waitcnt vmcnt(0)" ::: "memory");
        } else {
            XB_SPIN(xb_ld(&bar[XB_XGEN(b.x)]) == gen, bar);
            __builtin_amdgcn_fence(__ATOMIC_ACQUIRE, "agent");
            asm volatile("s_waitcnt vmcnt(0)" ::: "memory");
        }
    }
    __syncthreads();
}

constexpr int LDS_BYTES = 160 * 1024, MISC_OFF = LDS_BYTES - 256;
static_assert(rw::LDS_NEED <= MISC_OFF, "scan LDS");
constexpr int CW_BAR = 4096;

__global__ void __launch_bounds__(512, 2) mega_fwd(PArgs a) {
    extern __shared__ __attribute__((aligned(16))) unsigned char lds[];
    volatile LAS unsigned* MISC = (volatile LAS unsigned*)((LAS unsigned char*)lds + MISC_OFF);
    const int wv = __builtin_amdgcn_readfirstlane((int)threadIdx.x >> 6);
    { const int t0 = mktid(wv); if (t0 < 64) MISC[t0] = 0u; }
    __syncthreads();
    XcdBarrier bar = xcd_barrier_post((unsigned*)(a.ws + WS_CTL) + CW_BAR, MISC + 8, wv);
    GemmArgs g; g.ws = a.ws; g.x = a.in[0]; g.out = a.out; g.qg = a.in[18]; g.kg = a.in[19];
    const int G = (int)gridDim.x, bx = (int)blockIdx.x;

    p_prep_weights(a, lds, wv); __syncthreads(); p_ada(a, lds, wv);
    xcd_barrier(bar, wv);
    p_norm1(a, lds, wv);
    xcd_barrier(bar, wv);
    p_gemm_in(g, lds, wv);
    xcd_barrier(bar, wv);
    p_actprep(a, lds, wv);
    xcd_barrier(bar, wv);
    { const int nscan = G / 2;
      if (bx < nscan) { for (int bh = bx; bh < 128; bh += nscan) rw::scan_unit(a, lds, bh, wv); }
      else p_attn(a, lds, bx - nscan, G - nscan, wv); }
    __syncthreads(); p_prep_experts_dyn(a, lds, wv);
    xcd_barrier(bar, wv);
    p_gemm_merge(g, lds, wv);
    xcd_barrier(bar, wv);
    p_gemm_out(g, lds, wv);
    xcd_barrier(bar, wv);
    p_norm2_route(a, lds, wv);
    xcd_barrier(bar, wv);
    p_moe_gather(a, lds, wv);
    xcd_barrier(bar, wv);
    p_gemm_up(g, lds, wv);
    xcd_barrier(bar, wv);
    p_gemm_down(g, lds, wv);
    xcd_barrier(bar, wv);
    p_combine(a, lds, wv);
}

extern "C" void kernel_launch(void* const* d_in, const int* in_sizes, int n_in, void* d_out, int out_size, void* d_ws, size_t ws_size, hipStream_t stream) {
    static int grid = 0;
    if (grid == 0) {
        if (n_in != 30 || out_size != NT * DM || ws_size < WS_END) { fprintf(stderr, "kernel_launch: unexpected shapes (n_in %d, out %d, ws %zu)\n", n_in, out_size, ws_size); grid = -1; return; }
        int dev = 0, cus = 0, per_cu = 0;
        if (hipGetDevice(&dev) != hipSuccess || hipDeviceGetAttribute(&cus, hipDeviceAttributeMultiprocessorCount, dev) != hipSuccess) { grid = -1; return; }
        if (hipFuncSetAttribute((const void*)mega_fwd, hipFuncAttributeMaxDynamicSharedMemorySize, LDS_BYTES) != hipSuccess) { fprintf(stderr, "kernel_launch: hipFuncSetAttribute failed\n"); grid = -1; return; }
        if (hipOccupancyMaxActiveBlocksPerMultiprocessor(&per_cu, (const void*)mega_fwd, 512, LDS_BYTES) != hipSuccess || per_cu < 1) { fprintf(stderr, "kernel_launch: occupancy query says %d blocks per CU\n", per_cu); (void)hipGetLastError(); grid = -1; return; }
        grid = cus;
    }
    if (grid < 0) return;
    (void)hipMemsetAsync((char*)d_ws + WS_CTL, 0, 65536, stream);
    PArgs p{}; for (int i = 0; i < 30; ++i) p.in[i] = (const float*)d_in[i]; p.out = (float*)d_out; p.ws = (unsigned char*)d_ws;
    hipLaunchKernelGGL(mega_fwd, dim3(grid), dim3(512), LDS_BYTES, stream, p);
}
```

```cpp
#include <hip/hip_runtime.h>
#include <cstdio>
#include <cstdint>
__device__ __forceinline__ int mktid(int wv) { int l; asm volatile("v_mbcnt_lo_u32_b32 %0, -1, 0\n\tv_mbcnt_hi_u32_b32 %0, -1, %0" : "=v"(l)); return (wv << 6) | l; }
template <int CTRL> __device__ __forceinline__ float dppf(float v) { return __builtin_bit_cast(float, __builtin_amdgcn_update_dpp(0, __builtin_bit_cast(int, v), CTRL, 0xF, 0xF, true)); }
__device__ __forceinline__ float red4(float v) { v += dppf<0xB1>(v); v += dppf<0x4E>(v); return v; }
__device__ __forceinline__ float red8(float v) { v = red4(v); v += dppf<0x141>(v); return v; }
__device__ __forceinline__ float red16(float v) { v = red8(v); v += dppf<0x140>(v); return v; }
__device__ __forceinline__ float wave_sum(float v) { v = red16(v);
    v += __builtin_bit_cast(float, __builtin_amdgcn_ds_swizzle(__builtin_bit_cast(int, v), 0x401F));
    const unsigned u = __builtin_bit_cast(unsigned, v); auto rr = __builtin_amdgcn_permlane32_swap(u, u, false, false);
    return __builtin_bit_cast(float, (unsigned)rr[0]) + __builtin_bit_cast(float, (unsigned)rr[1]); }
__device__ __forceinline__ void wave_sum8(float (&v)[8]) {
#pragma unroll
    for (int i = 0; i < 8; ++i) v[i] += dppf<0xB1>(v[i]);
#pragma unroll
    for (int i = 0; i < 8; ++i) v[i] += dppf<0x4E>(v[i]);
#pragma unroll
    for (int i = 0; i < 8; ++i) v[i] += dppf<0x141>(v[i]);
#pragma unroll
    for (int i = 0; i < 8; ++i) v[i] += dppf<0x140>(v[i]);
#pragma unroll
    for (int i = 0; i < 8; ++i) v[i] += __builtin_bit_cast(float, __builtin_amdgcn_ds_swizzle(__builtin_bit_cast(int, v[i]), 0x401F));
#pragma unroll
    for (int i = 0; i < 8; ++i) { const unsigned u = __builtin_bit_cast(unsigned, v[i]); auto rr = __builtin_amdgcn_permlane32_swap(u, u, false, false); v[i] = __builtin_bit_cast(float, (unsigned)rr[0]) + __builtin_bit_cast(float, (unsigned)rr[1]); }
}
__device__ __forceinline__ float lane_get(float v, int src) { return __builtin_bit_cast(float, __builtin_amdgcn_ds_bpermute(src << 2, __builtin_bit_cast(int, v))); }
namespace pg8 {
#define PG8_LAS __attribute__((address_space(3)))
typedef unsigned short bf16_t;
typedef short bf16x8 __attribute__((ext_vector_type(8)));
typedef float f32x4 __attribute__((ext_vector_type(4)));
typedef unsigned u32x4 __attribute__((ext_vector_type(4)));
constexpr int BM = 256, BK = 64, HALF = 128, HTB = HALF * BK * 2  , STAGE_BYTES = 8 * HTB, NXCD = 8, WGM = 8;

__host__ __device__ __forceinline__ int lds_byte(int r, int c) { const int st = (r >> 4) * 2 + (c >> 5), rr = r & 15, cc = c & 31, ob = rr * 64 + cc * 2; return st * 1024 + (ob ^ (((ob >> 9) & 1) << 5)); }
__host__ __device__ __forceinline__ void stage_rc(int b, int& R, int& C) { const int st = b / 1024, sb = b % 1024, swz = sb ^ (((sb >> 9) & 1) << 5); R = (st >> 1) * 16 + swz / 64; C = (st & 1) * 32 + (swz % 64) / 2; }
__host__ __device__ __forceinline__ int perm32(int rho) { const int n = rho >> 4, i = rho & 15; return 8 * (i >> 2) + 4 * n + (i & 3); }
struct Unit { int pm, pn, aux; const char* a; const char* b; };
struct Gemm { int K; };

struct StaticOrder {
    int nM, nN, nwg, G, c; const char* A; const char* Bt; size_t tstep;
    __device__ void init(const void* A_, const void* Bt_, int M, int N, int K, int G_, int c_) { nM = M / BM; nN = N / BM; nwg = nM * nN; G = G_; c = c_; A = (const char*)A_; Bt = (const char*)Bt_; tstep = (size_t)BM * K * 2; }
    __device__ bool next(int i, Unit& u) const {
        const long L = (long)i * G + c; if (L >= nwg) return false;
        int wgid = (int)L; { const int q = nwg / NXCD, r = nwg % NXCD, xcd = wgid % NXCD, off = wgid / NXCD; wgid = (xcd < r ? xcd * (q + 1) : r * (q + 1) + (xcd - r) * q) + off; }
        const int nig = WGM * nN, gid = wgid / nig, fm = gid * WGM, gsz = (nM - fm) < WGM ? (nM - fm) : WGM;
        u.aux = 0; u.pm = fm + ((wgid % nig) % gsz); u.pn = (wgid % nig) / gsz; u.a = A + (size_t)u.pm * tstep; u.b = Bt + (size_t)u.pn * tstep; return true;
    }
    __device__ __forceinline__ void a_ready(const Unit&) const {}
    __device__ __forceinline__ void done(const Unit&) const {}
};
__device__ __forceinline__ unsigned cvt_pk_bf16(float lo, float hi) { unsigned r; asm volatile("v_cvt_pk_bf16_f32 %0, %1, %2" : "=v"(r) : "v"(lo), "v"(hi)); return r; }
template <class Epi, class Sched, bool ALIGN_EPI = false, bool SP2 = false>
__device__ __forceinline__ void gemm_phase(PG8_LAS unsigned char* lds, const Gemm g, const Sched& S, const Epi& E, int wv) {
    const int tid = mktid(wv), wid = __builtin_amdgcn_readfirstlane(tid >> 6), lane = tid & 63, wr = wid >> 2, wc = wid & 3, fr = lane & 15, fq = lane >> 4;
    const int K = g.K, nt = K / BK;
    unsigned voffA[2], voffB[2];
#pragma unroll
    for (int i = 0; i < 2; ++i) { int R, C; stage_rc(tid * 16 + i * 8192, R, C); const int Rb = Epi::PERM ? ((R & ~31) + perm32(R & 31)) : R;
        voffA[i] = (unsigned)(R * K + C) * 2u; voffB[i] = (unsigned)(Rb * K + C) * 2u; }
    const size_t kstep = (size_t)(BK * 2);
    const size_t hstep = (size_t)HALF * K * 2;
        const unsigned ldsw = (unsigned)wid * 1024u;
    const int aoff = lds_byte(wr * 64 + fr, fq * 8), boff = lds_byte(wc * 32 + fr, fq * 8);
#define PG8_SA(b, h) (((b) * 2 + (h)) * HTB)
#define PG8_SB(b, h) ((4 + (b) * 2 + (h)) * HTB)
#define PG8_STAGE(bufoff, gbase, voff) do { _Pragma("unroll") for (int _i = 0; _i < 2; ++_i) \
        __builtin_amdgcn_global_load_lds((const unsigned*)((const char*)(gbase) + (voff)[_i]), (PG8_LAS unsigned*)(lds + (bufoff) + ldsw + _i * 8192), 16, 0, 0); } while (0)
#define PG8_LDA(dst, b, h) do { _Pragma("unroll") for (int m = 0; m < 4; ++m) _Pragma("unroll") for (int k = 0; k < 2; ++k) dst[m][k] = *(const PG8_LAS bf16x8*)(lds + PG8_SA(b, h) + aoff + m * 2048 + k * 1024); } while (0)
#define PG8_LDB(dst, b, h) do { _Pragma("unroll") for (int n = 0; n < 2; ++n) _Pragma("unroll") for (int k = 0; k < 2; ++k) dst[n][k] = *(const PG8_LAS bf16x8*)(lds + PG8_SB(b, h) + boff + n * 2048 + k * 1024); } while (0)
#define PG8_MMA(ai, bj, At, Bt) do { __builtin_amdgcn_s_setprio(1); _Pragma("unroll") for (int m = 0; m < 4; ++m) _Pragma("unroll") for (int n = 0; n < 2; ++n) _Pragma("unroll") for (int k = 0; k < 2; ++k) \
        acc[ai][bj][m][n] = __builtin_amdgcn_mfma_f32_16x16x32_bf16(Bt[n][k], At[m][k], acc[ai][bj][m][n], 0, 0, 0); __builtin_amdgcn_s_setprio(0); } while (0)
#define PG8_WAIT_V(n) asm volatile("s_waitcnt vmcnt(" #n ")" ::: "memory")
#define PG8_WAIT_L(n) asm volatile("s_waitcnt lgkmcnt(" #n ")" ::: "memory")
#define PG8_BAR __builtin_amdgcn_s_barrier()
#define PG8_SCHED __builtin_amdgcn_sched_barrier(0)
    Unit cur, nxt; int ui = 0;
    if (!S.next(0, cur)) return;
    f32x4 acc[2][2][4][2];
#pragma unroll
    for (int a = 0; a < 2; ++a)
#pragma unroll
        for (int b = 0; b < 2; ++b)
#pragma unroll
            for (int m = 0; m < 4; ++m)
#pragma unroll
                for (int n = 0; n < 2; ++n) acc[a][b][m][n] = (f32x4){0.f, 0.f, 0.f, 0.f};
    bf16x8 At[4][2], B0[2][2], B1[2][2];
    const char* cA = cur.a; const char* cB = cur.b;
    S.a_ready(cur);
    if constexpr (SP2) {
        PG8_STAGE(PG8_SB(0, 0), cB, voffB); PG8_STAGE(PG8_SB(0, 1), cB + hstep, voffB); PG8_STAGE(PG8_SA(0, 0), cA, voffA); PG8_STAGE(PG8_SA(0, 1), cA + hstep, voffA);
        if (wr == 1) PG8_BAR;
        PG8_WAIT_V(2); PG8_BAR;
        PG8_STAGE(PG8_SB(1, 0), cB + kstep, voffB); PG8_STAGE(PG8_SA(1, 0), cA + kstep, voffA); PG8_STAGE(PG8_SB(1, 1), cB + hstep + kstep, voffB);
        PG8_WAIT_V(6); PG8_BAR;
    } else {
        PG8_STAGE(PG8_SB(0, 0), cB, voffB); PG8_STAGE(PG8_SA(0, 0), cA, voffA); PG8_STAGE(PG8_SB(0, 1), cB + hstep, voffB); PG8_STAGE(PG8_SA(0, 1), cA + hstep, voffA);
        if (wr == 1) PG8_BAR;
        PG8_WAIT_V(4); PG8_BAR;
        PG8_STAGE(PG8_SB(1, 0), cB + kstep, voffB); PG8_STAGE(PG8_SA(1, 0), cA + kstep, voffA); PG8_STAGE(PG8_SB(1, 1), cB + hstep + kstep, voffB);
        PG8_WAIT_V(6); PG8_BAR;
    }
    for (;;) {
        const bool has_next = S.next(ui + 1, nxt);
        const char* nA = has_next ? nxt.a : cA; const char* nB = has_next ? nxt.b : cB;
        for (int t = 0; t < nt; t += 2) {
            const bool last = (t == nt - 2);
            const char* a1 = cA + (size_t)(t + 1) * kstep;
            const char* a2 = last ? nA : cA + (size_t)(t + 2) * kstep; const char* b2 = last ? nB : cB + (size_t)(t + 2) * kstep;
            const char* a3 = a2 + kstep; const char* b3 = b2 + kstep;
            if (last && has_next) S.a_ready(nxt);
            if constexpr (SP2) {
            PG8_LDB(B0, 0, 0); PG8_LDB(B1, 0, 1); PG8_SCHED; PG8_LDA(At, 0, 0); PG8_STAGE(PG8_SA(1, 1), a1 + hstep, voffA);
            PG8_WAIT_V(8); PG8_WAIT_L(0); PG8_BAR; PG8_MMA(0, 0, At, B0); PG8_MMA(0, 1, At, B1); PG8_BAR; PG8_SCHED;
            PG8_LDA(At, 0, 1); PG8_STAGE(PG8_SB(0, 0), b2, voffB); PG8_STAGE(PG8_SB(0, 1), b2 + hstep, voffB); PG8_STAGE(PG8_SA(0, 0), a2, voffA);
            PG8_WAIT_V(8); PG8_WAIT_L(0); PG8_BAR; PG8_MMA(1, 0, At, B0); PG8_MMA(1, 1, At, B1); PG8_BAR; PG8_SCHED;
            PG8_LDB(B0, 1, 0); PG8_LDB(B1, 1, 1); PG8_SCHED; PG8_LDA(At, 1, 0); PG8_STAGE(PG8_SA(0, 1), a2 + hstep, voffA);
            PG8_WAIT_V(8); PG8_WAIT_L(0); PG8_BAR; PG8_MMA(0, 0, At, B0); PG8_MMA(0, 1, At, B1); PG8_BAR; PG8_SCHED;
            PG8_LDA(At, 1, 1); PG8_STAGE(PG8_SB(1, 0), b3, voffB); PG8_STAGE(PG8_SB(1, 1), b3 + hstep, voffB); PG8_STAGE(PG8_SA(1, 0), a3, voffA);
            PG8_WAIT_V(8); PG8_WAIT_L(0); PG8_BAR; PG8_MMA(1, 0, At, B0); PG8_MMA(1, 1, At, B1); PG8_BAR; PG8_SCHED;
            } else {
            PG8_LDB(B0, 0, 0); PG8_SCHED; PG8_LDA(At, 0, 0); PG8_STAGE(PG8_SA(1, 1), a1 + hstep, voffA);
            PG8_WAIT_L(8); PG8_BAR; PG8_WAIT_L(0); PG8_MMA(0, 0, At, B0); PG8_BAR; PG8_SCHED;
            PG8_LDB(B1, 0, 1); PG8_STAGE(PG8_SB(0, 0), b2, voffB);
            PG8_BAR; PG8_WAIT_L(0); PG8_MMA(0, 1, At, B1); PG8_BAR;
            PG8_LDA(At, 0, 1); PG8_STAGE(PG8_SA(0, 0), a2, voffA);
            PG8_BAR; PG8_WAIT_L(0); PG8_MMA(1, 0, At, B0); PG8_BAR; PG8_SCHED;
            PG8_STAGE(PG8_SB(0, 1), b2 + hstep, voffB);
            PG8_WAIT_V(6); PG8_BAR; PG8_MMA(1, 1, At, B1); PG8_BAR;
            PG8_LDB(B0, 1, 0); PG8_SCHED; PG8_LDA(At, 1, 0); PG8_STAGE(PG8_SA(0, 1), a2 + hstep, voffA);
            PG8_WAIT_L(8); PG8_BAR; PG8_WAIT_L(0); PG8_MMA(0, 0, At, B0); PG8_BAR; PG8_SCHED;
            PG8_LDB(B1, 1, 1); PG8_STAGE(PG8_SB(1, 0), b3, voffB);
            PG8_BAR; PG8_WAIT_L(0); PG8_MMA(0, 1, At, B1); PG8_BAR;
            PG8_LDA(At, 1, 1); PG8_STAGE(PG8_SA(1, 0), a3, voffA);
            PG8_BAR; PG8_WAIT_L(0); PG8_MMA(1, 0, At, B0); PG8_BAR; PG8_SCHED;
            PG8_STAGE(PG8_SB(1, 1), b3 + hstep, voffB);
            PG8_WAIT_V(6); PG8_BAR; PG8_MMA(1, 1, At, B1); PG8_BAR;
            }
        }
        if constexpr (ALIGN_EPI) { if (wr == 0) PG8_BAR; }
        bool keep = false;
        if constexpr (!Epi::AFTER_DRAIN) { if constexpr (Epi::CHAIN) keep = E.chain(acc, cur, wr, wc, fr, fq); else E(acc, cur, wr, wc, fr, fq); S.done(cur); }
        if (!has_next) break;
        if (!keep) {
#pragma unroll
        for (int a = 0; a < 2; ++a)
#pragma unroll
            for (int b = 0; b < 2; ++b)
#pragma unroll
                for (int m = 0; m < 4; ++m)
#pragma unroll
                    for (int n = 0; n < 2; ++n) acc[a][b][m][n] = (f32x4){0.f, 0.f, 0.f, 0.f};
        }
        cur = nxt; cA = nA; cB = nB; ++ui;
        if constexpr (ALIGN_EPI) { if (wr == 1) PG8_BAR; }
    }
    PG8_WAIT_V(0);
    if constexpr (!ALIGN_EPI) { if (wr == 0) PG8_BAR; }
    PG8_BAR;
    if constexpr (Epi::AFTER_DRAIN) { E.fused(acc, cur, wr, wc, fr, fq, lds, wid, lane); S.done(cur); }
#undef PG8_SA
#undef PG8_SB
#undef PG8_STAGE
#undef PG8_LDA
#undef PG8_LDB
#undef PG8_MMA
#undef PG8_WAIT_V
#undef PG8_WAIT_L
#undef PG8_BAR
#undef PG8_SCHED
}
}
#include <hip/hip_bf16.h>
#include <cmath>
namespace attn_body {
using bf16=__hip_bfloat16;
using bf16x8=__attribute__((ext_vector_type(8)))short;
using s16x4=__attribute__((ext_vector_type(4)))short;
using f32x16=__attribute__((ext_vector_type(16)))float;
using u32x4=__attribute__((ext_vector_type(4)))unsigned;
constexpr int NHEAD=8,SEQ=2048,D=64,PQ=512,PK=512,PV=4352,PO=512;
constexpr int NW=8,QBLK=32,QB=QBLK*NW,KVBLK=64,NQB=SEQ/QB;
__device__ __forceinline__ int crow(int r,int hi){return (r&3)+8*(r>>2)+4*hi;}
#define SBAR() __builtin_amdgcn_sched_barrier(0)
__device__ __forceinline__ void cmask(f32x16&p0,f32x16&p1,int jb,int qrel,int hi){
  const float NEG=-INFINITY; int kb=64*jb+4*hi;
  #pragma unroll
  for(int r=0;r<16;++r){int kv=kb+(r&3)+8*(r>>2); if(kv>qrel)p0[r]=NEG; if(kv+32>qrel)p1[r]=NEG;}
}

constexpr int NSLOT=3, SLOTB=8192;
constexpr int LDS_K=0, LDS_V=NSLOT*SLOTB, LDS_WS=2*NSLOT*SLOTB, LDS_OST=LDS_WS+NW*64*4, LDS_SEL=LDS_OST+NW*4096, LDS_KM=LDS_SEL+256, LDS_KP=LDS_KM+7*64*4, LDS_BYTES=LDS_KP+8*64*4;
constexpr float C2=0.125f*1.4426950408889634f;
__device__ __forceinline__ void glds16(const void*gsrc,unsigned lds_dst){unsigned keep;
  asm volatile("s_mov_b32 %0, m0\n\ts_mov_b32 m0, %2\n\ts_nop 0\n\tglobal_load_lds_dwordx4 %1, off\n\ts_mov_b32 m0, %0":"=&s"(keep):"v"(gsrc),"s"(lds_dst):"memory");}
__device__ __forceinline__ float max3f(float a,float b,float c){float r;asm("v_max3_f32 %0, %1, %2, %3":"=v"(r):"v"(a),"v"(b),"v"(c));return r;}
__device__ __forceinline__ float max2f(float a,float b){float r;asm("v_max_f32_e32 %0, %1, %2":"=v"(r):"v"(a),"v"(b));return r;}
__device__ __forceinline__ float fadd_s(float a,float b){float r;asm("v_add_f32_e32 %0, %1, %2":"=v"(r):"v"(a),"v"(b));return r;}
__device__ __forceinline__ float fsub_s(float a,float b){float r;asm("v_sub_f32_e32 %0, %1, %2":"=v"(r):"v"(a),"v"(b));return r;}
typedef float f32x2_t __attribute__((ext_vector_type(2))); typedef __bf16 bf16x2_t __attribute__((ext_vector_type(2)));
__device__ __forceinline__ unsigned cvtpk_s(float lo,float hi){f32x2_t v={lo,hi};bf16x2_t b=__builtin_convertvector(v,bf16x2_t);return __builtin_bit_cast(unsigned,b);}
#define WAIT_BAR(N) asm volatile("s_waitcnt vmcnt(" #N ") lgkmcnt(0)\n\ts_barrier":::"memory")

__device__ __forceinline__ void qkt(f32x16&p0,f32x16&p1,const char*Kslot,const bf16x8*qr,const f32x16&negm,int r32,int hi){
  const char*kb=Kslot+hi*1024+r32*16;
  #pragma unroll
  for(int d0=0;d0<4;++d0){
    const bf16x8 b0=*reinterpret_cast<const bf16x8*>(kb+d0*2048);
    const bf16x8 b1=*reinterpret_cast<const bf16x8*>(kb+d0*2048+512);
    if(d0==0){p0=__builtin_amdgcn_mfma_f32_32x32x16_bf16(b0,qr[0],negm,0,0,0);p1=__builtin_amdgcn_mfma_f32_32x32x16_bf16(b1,qr[0],negm,0,0,0);}
    else{p0=__builtin_amdgcn_mfma_f32_32x32x16_bf16(b0,qr[d0],p0,0,0,0);p1=__builtin_amdgcn_mfma_f32_32x32x16_bf16(b1,qr[d0],p1,0,0,0);}}
}
typedef __attribute__((address_space(3))) const char* lds_cptr;
typedef short v4i16_t __attribute__((ext_vector_type(4)));
__device__ __forceinline__ void kload8(bf16x8*kf,lds_cptr kp){
  kf[0]=*(const __attribute__((address_space(3))) bf16x8*)(kp);      kf[1]=*(const __attribute__((address_space(3))) bf16x8*)(kp+512);
  kf[2]=*(const __attribute__((address_space(3))) bf16x8*)(kp+2048); kf[3]=*(const __attribute__((address_space(3))) bf16x8*)(kp+2560);
  kf[4]=*(const __attribute__((address_space(3))) bf16x8*)(kp+4096); kf[5]=*(const __attribute__((address_space(3))) bf16x8*)(kp+4608);
  kf[6]=*(const __attribute__((address_space(3))) bf16x8*)(kp+6144); kf[7]=*(const __attribute__((address_space(3))) bf16x8*)(kp+6656);
}
__device__ __forceinline__ void kload2(bf16x8*kf,lds_cptr kp,int j){ kf[2*j]=*(const __attribute__((address_space(3))) bf16x8*)(kp+j*2048); kf[2*j+1]=*(const __attribute__((address_space(3))) bf16x8*)(kp+j*2048+512); }
__device__ __forceinline__ s16x4 vtr(lds_cptr p){ return __builtin_bit_cast(s16x4,__builtin_amdgcn_ds_read_tr16_b64_v4i16((__attribute__((address_space(3))) v4i16_t*)p)); }
__device__ __forceinline__ float rowmax(const f32x16&p0,const f32x16&p1){
  float a=max3f(p0[0],p0[1],p1[0]),b=max3f(p0[2],p0[3],p1[1]);a=max3f(a,p1[2],p1[3]);
  #pragma unroll
  for(int r=4;r<16;r+=4){a=max3f(a,p0[r],p0[r+1]);b=max3f(b,p0[r+2],p0[r+3]);a=max3f(a,p1[r],p1[r+1]);b=max3f(b,p1[r+2],p1[r+3]);}
  const float m=max2f(a,b);
  auto rr=__builtin_amdgcn_permlane32_swap(__float_as_uint(m),__float_as_uint(m),false,false);
  return max2f(__uint_as_float(rr[0]),__uint_as_float(rr[1]));
}
__device__ __forceinline__ void pv(f32x16*o,int vb,bf16x8 pa0,bf16x8 pa1,bf16x8 pa2,bf16x8 pa3){
  #pragma unroll
  for(int d0=0;d0<2;++d0){s16x4 lo[4],hi[4];
    #pragma unroll
    for(int ks=0;ks<4;++ks){
      asm volatile("ds_read_b64_tr_b16 %0,%1 offset:%c2":"=&v"(lo[ks]):"v"(vb),"i"(d0*4096+ks*1024):"memory");
      asm volatile("ds_read_b64_tr_b16 %0,%1 offset:%c2":"=&v"(hi[ks]):"v"(vb),"i"(d0*4096+ks*1024+512):"memory");}
    asm volatile("s_waitcnt lgkmcnt(0)":::"memory");SBAR();
    #define PK(k) (bf16x8){lo[k][0],lo[k][1],lo[k][2],lo[k][3],hi[k][0],hi[k][1],hi[k][2],hi[k][3]}
    o[d0]=__builtin_amdgcn_mfma_f32_32x32x16_bf16(pa0,PK(0),o[d0],0,0,0);
    o[d0]=__builtin_amdgcn_mfma_f32_32x32x16_bf16(pa1,PK(1),o[d0],0,0,0);
    o[d0]=__builtin_amdgcn_mfma_f32_32x32x16_bf16(pa2,PK(2),o[d0],0,0,0);
    o[d0]=__builtin_amdgcn_mfma_f32_32x32x16_bf16(pa3,PK(3),o[d0],0,0,0);
    #undef PK
  }
}

#ifndef ATTN_STORE16
#define ATTN_STORE16(p,v) (*(u32x4*)(p)=(v))
#endif
template<int THRL> __device__ __forceinline__ void attn_unit(int b,int h,int qb,const bf16*Q,const bf16*__restrict__ K,const bf16*__restrict__ V,bf16*O,char*shm,int wv){
  const int tid=mktid(wv),lane=tid&63,r32=lane&31,hi=lane>>5;     const int wid=__builtin_amdgcn_readfirstlane(tid>>6);
  const long rowbase=(long)b*SEQ; const int q0=qb*QB;
  if(qb>3){ float*KMl=(float*)(shm+LDS_KM); float*KPl=(float*)(shm+LDS_KP); const int c8=tid&7, rl=tid>>3;
    for(int n=0;n<qb;++n){ float sm[8];
      #pragma unroll
      for(int d=0;d<8;++d)sm[d]=0.f;
      #pragma unroll
      for(int rr=0;rr<4;++rr){ const u32x4 w=*reinterpret_cast<const u32x4*>(K+(rowbase+n*256+rl+64*rr)*PK+h*D+8*c8);
        sm[0]+=__uint_as_float(w[0]<<16);sm[1]+=__uint_as_float(w[0]&0xffff0000u);sm[2]+=__uint_as_float(w[1]<<16);sm[3]+=__uint_as_float(w[1]&0xffff0000u);
        sm[4]+=__uint_as_float(w[2]<<16);sm[5]+=__uint_as_float(w[2]&0xffff0000u);sm[6]+=__uint_as_float(w[3]<<16);sm[7]+=__uint_as_float(w[3]&0xffff0000u); }
      #pragma unroll
      for(int d=0;d<8;++d){ float v=sm[d];
        v+=__builtin_bit_cast(float,__builtin_amdgcn_ds_swizzle(__builtin_bit_cast(int,v),0x201F));
        v+=__builtin_bit_cast(float,__builtin_amdgcn_ds_swizzle(__builtin_bit_cast(int,v),0x401F));
        { const unsigned u=__builtin_bit_cast(unsigned,v); auto rr2=__builtin_amdgcn_permlane32_swap(u,u,false,false); v=__uint_as_float((unsigned)rr2[0])+__uint_as_float((unsigned)rr2[1]); }
        sm[d]=v; }
      if(lane<8){
        #pragma unroll
        for(int d=0;d<8;++d)KPl[wid*64+8*lane+d]=sm[d]; }
      asm volatile("s_waitcnt vmcnt(0) lgkmcnt(0)\n\ts_barrier":::"memory");
      if(tid<64){ float s8=0.f;
        #pragma unroll
        for(int w8=0;w8<8;++w8)s8+=KPl[w8*64+tid];
        KMl[n*64+tid]=s8*(1.0f/256.0f); }
      asm volatile("s_waitcnt lgkmcnt(0)\n\ts_barrier":::"memory"); } }
  if(tid<QB){ unsigned sel=(qb<=3)?((1u<<qb)-1u):0u;
    if(qb>3){ const bf16*qp=Q+(rowbase+q0+tid)*PQ+h*D; const float*km=(const float*)(shm+LDS_KM); float gate[7];
      #pragma unroll
      for(int j=0;j<7;++j)gate[j]=0.f;
      #pragma unroll 1
      for(int i=0;i<8;++i){ const u32x4 w=*reinterpret_cast<const u32x4*>(qp+8*i); float qv[8];
        qv[0]=__uint_as_float(w[0]<<16);qv[1]=__uint_as_float(w[0]&0xffff0000u);qv[2]=__uint_as_float(w[1]<<16);qv[3]=__uint_as_float(w[1]&0xffff0000u);
        qv[4]=__uint_as_float(w[2]<<16);qv[5]=__uint_as_float(w[2]&0xffff0000u);qv[6]=__uint_as_float(w[3]<<16);qv[7]=__uint_as_float(w[3]&0xffff0000u);
        #pragma unroll
        for(int j=0;j<7;++j) if(j<qb){ const float*kp=km+j*64+8*i;
          #pragma unroll
          for(int d=0;d<8;++d)gate[j]+=qv[d]*kp[d]; } }
      #pragma unroll
      for(int rep=0;rep<3;++rep){ float best=-INFINITY; int bi=0;
        #pragma unroll
        for(int j=0;j<7;++j) if(j<qb&&!((sel>>j)&1u)&&gate[j]>best){best=gate[j];bi=j;}
        sel|=1u<<bi; } }
    ((unsigned char*)(shm+LDS_SEL))[tid]=(unsigned char)sel; }
  asm volatile("s_waitcnt vmcnt(0) lgkmcnt(0)\n\ts_barrier":::"memory");
  const bf16*Qw=Q+(rowbase+q0+wid*QBLK)*PQ+h*D;
  const bf16*Kh=K+rowbase*PK+h*D,*Vh=V+rowbase*PV+h*D;
  const unsigned lds0=(unsigned)(uintptr_t)shm;
  float*wsf=(float*)(shm+LDS_WS)+wid*64;
  const bf16*ksrc=Kh+(long)lane*PK+wid*8;
  const bf16*vsrc=Vh+(long)(16*(wid&3)+(lane>>2))*PV+(wid>>2)*32+(lane&3)*8;
  const unsigned kdst=lds0+LDS_K+wid*1024, vdst=lds0+LDS_V+wid*1024;
  #define TROW(t) ((long)(((t)<4)?(q0+(t)*KVBLK):(((t)-4)*KVBLK)))
  #define DMA_K(t,slot) glds16(ksrc+TROW(t)*PK,(unsigned)__builtin_amdgcn_readfirstlane(kdst+(slot)))
  #define DMA_V(t,slot) glds16(vsrc+TROW(t)*PV,(unsigned)__builtin_amdgcn_readfirstlane(vdst+(slot)))
  const int vb0=(int)(lds0+LDS_V)+((lane>>4)&1)*32+(lane&3)*8+(4*hi+((lane&15)>>2))*64;
  const char*Kbase=shm+LDS_K; bf16x8 kf[8];
  const lds_cptr shm3=(lds_cptr)shm; const lds_cptr kp0=shm3+LDS_K+hi*1024+r32*16; const lds_cptr vp0=shm3+LDS_V+((lane>>4)&1)*32+(lane&3)*8+(4*hi+((lane&15)>>2))*64;
  const int NT=(q0+QB)/KVBLK;
  DMA_K(0,0);DMA_V(0,0);DMA_K(1,SLOTB);
  bf16x8 qr[4];
  #pragma unroll
  for(int d0=0;d0<4;++d0)qr[d0]=*reinterpret_cast<const bf16x8*>(&Qw[(long)r32*PQ+d0*16+hi*8]);
  float mhat=0.f,l_reg=0.f;f32x16 o[2];o[0]=f32x16{};o[1]=f32x16{};
  const int qrel=wid*QBLK+r32;
  const unsigned selb=((const unsigned char*)(shm+LDS_SEL))[qrel];
  #define CMASK(P0,P1,t) cmask(P0,P1,(t),qrel,hi)
  #define SUBREF(C0,C1,t) do{ const float sb_=(((t)<4)||((selb>>(((t)-4)>>2))&1u))?mhat:INFINITY; _Pragma("unroll") for(int r_=0;r_<16;++r_){C0[r_]-=sb_;C1[r_]-=sb_;} }while(0)
  bool resc=false;
  #define START(P0,P1) do{ const float rm=rowmax(P0,P1); resc=false; \
    { const float dl=rm; mhat=fadd_s(mhat,dl); \
      _Pragma("unroll") for(int r=0;r<16;++r){P0[r]=fsub_s(P0[r],dl);P1[r]=fsub_s(P1[r],dl);} \
      } \
    _Pragma("unroll") for(int r=0;r<16;++r)P0[r]=__builtin_amdgcn_exp2f(P0[r]); }while(0)
  #define RESC() do{ if(resc){ asm volatile("s_waitcnt lgkmcnt(0)":::"memory"); \
      _Pragma("unroll") for(int d_=0;d_<2;++d_) _Pragma("unroll") for(int r=0;r<16;++r)o[d_][r]*=wsf[crow(r,hi)]; } }while(0)
  f32x16 pA0,pA1,pB0,pB1;
  int sl_prev=0,sl_cur=0,sl_next=SLOTB;
  #define ROT() do{sl_prev=sl_cur;sl_cur=sl_next;sl_next=(sl_next==(NSLOT-1)*SLOTB)?0:sl_next+SLOTB;}while(0)
  DMA_K(2,2*SLOTB);
  WAIT_BAR(3);
  qkt(pA0,pA1,Kbase,qr,f32x16{},r32,hi);asm volatile("s_nop 15\n\ts_nop 7":"+v"(pA0),"+v"(pA1));CMASK(pA0,pA1,0);
  START(pA0,pA1);
  _Pragma("unroll") for(int r=0;r<16;++r)pA1[r]=__builtin_amdgcn_exp2f(pA1[r]);
  WAIT_BAR(0);
  DMA_K(3,0);DMA_V(1,SLOTB);
  ROT();
  kload8(kf,kp0+sl_cur);
  WAIT_BAR(2);
  s16x4 vlo[8],vhi[8]; u32x4 pw0,pw1,pw2,pw3;
  #define PKW(P,B) cvtpk_s(P[B],P[B+1])
  #define PAF(k) __builtin_bit_cast(bf16x8,pw##k)
  #define VFR(i) (bf16x8){vlo[i][0],vlo[i][1],vlo[i][2],vlo[i][3],vhi[i][0],vhi[i][1],vhi[i][2],vhi[i][3]}
  #define PIN(x) asm volatile("":"+v"(x))
  #define MX3(a,b,c) __builtin_fmaxf(__builtin_fmaxf((a),(b)),(c))
  #define GAPA(MF,A0,A1,A2,A3,W0,W1,PW) do{ MF; sacc+=A0; sacc+=A1; sacc+=A2; sacc+=A3; PIN(sacc); W0; W1; PIN(PW); SBAR(); }while(0)
  #define EX(v) __builtin_amdgcn_exp2f(v)
  #define GAPB(MF,X,B) do{ MF; X[B]=EX(X[B]); X[B+1]=EX(X[B+1]); X[B+2]=EX(X[B+2]); X[B+3]=EX(X[B+3]); PIN(X); SBAR(); }while(0)
  #define VRD(i) do{ vlo[i]=vtr(vp_+(((i)>>2)*4096+((i)&3)*1024)); vhi[i]=vtr(vp_+(((i)>>2)*4096+((i)&3)*1024+512)); }while(0)
  #define KRD(G,j) do{ if(G){ kload2(kf,kp0+sl_next,j); SBAR(); } }while(0)
  #define STEP(C0,C1,P0,P1,t,GK,GV,GL,MB) do{ SBAR(); \
    const lds_cptr vp_=vp0+sl_prev; \
    VRD(0); SBAR(); float sacc=(P0[0]+P0[1]); \
    GAPA(C0=__builtin_amdgcn_mfma_f32_32x32x16_bf16(kf[0],qr[0],f32x16{},0,0,0), P0[2],P0[3],P0[4],P0[5],     pw0[0]=PKW(P0,0), pw0[1]=PKW(P0,2), pw0); \
    VRD(4); SBAR(); GAPA(C1=__builtin_amdgcn_mfma_f32_32x32x16_bf16(kf[1],qr[0],f32x16{},0,0,0), P0[6],P0[7],P0[8],P0[9],     pw0[2]=PKW(P0,4), pw0[3]=PKW(P0,6), pw0); \
    VRD(1); SBAR(); GAPA(C0=__builtin_amdgcn_mfma_f32_32x32x16_bf16(kf[2],qr[1],C0,0,0,0),   P0[10],P0[11],P0[12],P0[13], pw1[0]=PKW(P0,8), pw1[1]=PKW(P0,10), pw1); \
    VRD(5); SBAR(); GAPA(C1=__builtin_amdgcn_mfma_f32_32x32x16_bf16(kf[3],qr[1],C1,0,0,0),   P0[14],P0[15],P1[0],P1[1],   pw1[2]=PKW(P0,12),pw1[3]=PKW(P0,14), pw1); \
    VRD(2); SBAR(); GAPA(C0=__builtin_amdgcn_mfma_f32_32x32x16_bf16(kf[4],qr[2],C0,0,0,0),   P1[2],P1[3],P1[4],P1[5],     pw2[0]=PKW(P1,0), pw2[1]=PKW(P1,2), pw2); \
    VRD(6); SBAR(); GAPA(C1=__builtin_amdgcn_mfma_f32_32x32x16_bf16(kf[5],qr[2],C1,0,0,0),   P1[6],P1[7],P1[8],P1[9],     pw2[2]=PKW(P1,4), pw2[3]=PKW(P1,6), pw2); \
    VRD(3); SBAR(); GAPA(C0=__builtin_amdgcn_mfma_f32_32x32x16_bf16(kf[6],qr[3],C0,0,0,0),   P1[10],P1[11],P1[12],P1[13], pw3[0]=PKW(P1,8), pw3[1]=PKW(P1,10), pw3); \
    VRD(7); SBAR(); GAPA(C1=__builtin_amdgcn_mfma_f32_32x32x16_bf16(kf[7],qr[3],C1,0,0,0),   P1[14],P1[15],0.f,0.f,       pw3[2]=PKW(P1,12),pw3[3]=PKW(P1,14), pw3); \
    l_reg+=sacc; \
    if(GK){DMA_K((t)+3,sl_cur);} if(GV){DMA_V((t)+1,sl_next);} \
    SUBREF(C0,C1,t); if(MB){CMASK(C0,C1,t);} \
    { float a=MX3(C0[0],C0[1],C1[0]),b=MX3(C0[2],C0[3],C1[1]); a=MX3(a,C1[2],C1[3]); \
      _Pragma("unroll") for(int r=4;r<16;r+=4){a=MX3(a,C0[r],C0[r+1]);b=MX3(b,C0[r+2],C0[r+3]);a=MX3(a,C1[r],C1[r+1]);b=MX3(b,C1[r+2],C1[r+3]);} \
      float rm=__builtin_fmaxf(a,b); { auto rr=__builtin_amdgcn_permlane32_swap(__float_as_uint(rm),__float_as_uint(rm),false,false); rm=__builtin_fmaxf(__uint_as_float(rr[0]),__uint_as_float(rr[1])); } \
      resc=false; \
      if(__builtin_expect(__any(rm>(float)THRL),0)){ const float dl=__builtin_fmaxf(rm,0.f); mhat+=dl; \
        _Pragma("unroll") for(int r=0;r<16;++r){C0[r]-=dl;C1[r]-=dl;} \
        const float f=__builtin_amdgcn_exp2f(-dl); l_reg*=f; if(hi==0)wsf[r32]=f; resc=true; } } \
    SBAR(); \
    GAPB(o[0]=__builtin_amdgcn_mfma_f32_32x32x16_bf16(PAF(0),VFR(0),o[0],0,0,0), C0,0); \
    GAPB(o[1]=__builtin_amdgcn_mfma_f32_32x32x16_bf16(PAF(0),VFR(4),o[1],0,0,0), C0,4); \
    KRD(GL,0); GAPB(o[0]=__builtin_amdgcn_mfma_f32_32x32x16_bf16(PAF(1),VFR(1),o[0],0,0,0), C0,8); \
    KRD(GL,1); GAPB(o[1]=__builtin_amdgcn_mfma_f32_32x32x16_bf16(PAF(1),VFR(5),o[1],0,0,0), C0,12); \
    KRD(GL,2); GAPB(o[0]=__builtin_amdgcn_mfma_f32_32x32x16_bf16(PAF(2),VFR(2),o[0],0,0,0), C1,0); \
    KRD(GL,3); GAPB(o[1]=__builtin_amdgcn_mfma_f32_32x32x16_bf16(PAF(2),VFR(6),o[1],0,0,0), C1,4); \
    GAPB(o[0]=__builtin_amdgcn_mfma_f32_32x32x16_bf16(PAF(3),VFR(3),o[0],0,0,0), C1,8); \
    GAPB(o[1]=__builtin_amdgcn_mfma_f32_32x32x16_bf16(PAF(3),VFR(7),o[1],0,0,0), C1,12); \
    }while(0)
  #define ENDW(tt) do{ if((tt)+3<NT){WAIT_BAR(2);} else if((tt)+2<NT){WAIT_BAR(1);} else {WAIT_BAR(0);} }while(0)
  { int t=1;
    for(;t+1<NT;t+=2){
      STEP(pB0,pB1,pA0,pA1,t,(t+3<NT),(t+1<NT),(t+1<NT),(t<4));       ENDW(t);   RESC(); ROT();
      STEP(pA0,pA1,pB0,pB1,t+1,(t+4<NT),(t+2<NT),(t+2<NT),(t+1<4));     ENDW(t+1); RESC(); ROT();
    }
    STEP(pB0,pB1,pA0,pA1,NT-1,false,false,false,(NT==4)); RESC();
  }
  { float sacc=pB0[0]+pB0[1]; _Pragma("unroll") for(int r=2;r<16;++r)sacc+=pB0[r]; _Pragma("unroll") for(int r=0;r<16;++r)sacc+=pB1[r]; l_reg+=sacc;
    pw0=(u32x4){PKW(pB0,0),PKW(pB0,2),PKW(pB0,4),PKW(pB0,6)};pw1=(u32x4){PKW(pB0,8),PKW(pB0,10),PKW(pB0,12),PKW(pB0,14)};pw2=(u32x4){PKW(pB1,0),PKW(pB1,2),PKW(pB1,4),PKW(pB1,6)};pw3=(u32x4){PKW(pB1,8),PKW(pB1,10),PKW(pB1,12),PKW(pB1,14)};
    SBAR(); pv(o,vb0+sl_cur,PAF(0),PAF(1),PAF(2),PAF(3)); }
  #undef PKW
  #undef PAF
  #undef VFR
  #undef PIN
  #undef MX3
  #undef GAPA
  #undef GAPB
  #undef EX
  #undef VRD
  #undef KRD
  #undef STEP
  #undef ENDW
  {auto rr=__builtin_amdgcn_permlane32_swap(__float_as_uint(l_reg),__float_as_uint(l_reg),false,false);l_reg=__uint_as_float(rr[0])+__uint_as_float(rr[1]);}
  if(hi==0)wsf[32+r32]=l_reg;asm volatile("s_waitcnt lgkmcnt(0)":::"memory");
  float rli[16];
  #pragma unroll
  for(int r=0;r<16;++r)rli[r]=__builtin_amdgcn_rcpf(wsf[32+crow(r,hi)]);
  bf16*Ow=O+(rowbase+q0+wid*QBLK)*PO+h*D;
  { bf16*stg=(bf16*)(shm+LDS_OST)+wid*2048;
    #pragma unroll
    for(int r=0;r<16;++r){const int orow=crow(r,hi);
      #pragma unroll
      for(int d0=0;d0<2;++d0)stg[orow*64+d0*32+r32]=__float2bfloat16(o[d0][r]*rli[r]);}
    asm volatile("s_waitcnt lgkmcnt(0)":::"memory");
    #pragma unroll
    for(int i=0;i<4;++i){const int row=i*8+(lane>>3),ch=lane&7; const u32x4 v=*(const u32x4*)(stg+row*64+ch*8); ATTN_STORE16(Ow+(long)row*PO+ch*8,v);} }
  asm volatile("s_waitcnt lgkmcnt(0)\n\ts_barrier":::"memory");
  #undef DMA_K
  #undef TROW
  #undef SUBREF
  #undef DMA_V
  #undef CMASK
  #undef START
  #undef RESC
  #undef ROT
}
constexpr int ATTN_LDS_BYTES=LDS_BYTES;
#undef SBAR
#undef WAIT_BAR
}
constexpr int DM = 1024, NB = 16, SEQ = 2048, NT = NB * SEQ;
constexpr int RWW = 512, WIN_N = 5376, INC = 4352, ZV = 1792, ZG = 2304;
constexpr int NEXP = 32, DEXP = 512;
constexpr int XS_ROWS = 2 * NT + NEXP * 256;
constexpr float C2 = 0.125f * 1.4426950408889634f;

#define LAS __attribute__((address_space(3)))
#define GAS __attribute__((address_space(1)))
typedef unsigned short bf16;
typedef unsigned v4u __attribute__((ext_vector_type(4)));
typedef unsigned v2u __attribute__((ext_vector_type(2)));
typedef float f32x4 __attribute__((ext_vector_type(4)));

typedef float f32x2_c __attribute__((ext_vector_type(2))); typedef __bf16 bf16x2_c __attribute__((ext_vector_type(2)));
__device__ __forceinline__ unsigned pk2(float lo, float hi) { const f32x2_c v = {lo, hi}; return __builtin_bit_cast(unsigned, __builtin_convertvector(v, bf16x2_c)); }
__device__ __forceinline__ unsigned f2bf(float f) { return pk2(f, f) & 0xffffu; }
__device__ __forceinline__ float bflo(unsigned w) { return __builtin_bit_cast(float, w << 16); }
__device__ __forceinline__ float bfhi(unsigned w) { return __builtin_bit_cast(float, w & 0xffff0000u); }
__device__ __forceinline__ float sigm(float x) { return __builtin_amdgcn_rcpf(1.0f + __expf(-x)); }

constexpr size_t MiB = 1u << 20;
constexpr size_t WS_CTL = 0;
constexpr size_t WS_MOD = 1 * MiB;
constexpr size_t WS_GM2 = 1 * MiB + 512 * 1024;
constexpr size_t WS_CB = 1 * MiB + 640 * 1024;
constexpr size_t WS_COS = 2 * MiB;
constexpr size_t WS_SIN = 2 * MiB + 512 * 1024;
constexpr size_t WS_KMEAN = 3 * MiB;
constexpr size_t WS_WRH = 3 * MiB + 512 * 1024;
constexpr size_t WS_WRL = 3 * MiB + 768 * 1024;
constexpr size_t WS_SEL = 4 * MiB;
constexpr size_t WS_RTE = 5 * MiB;
constexpr size_t WS_RTW = 5 * MiB + 256 * 1024;
constexpr size_t WS_RNK = 5 * MiB + 512 * 1024;
constexpr size_t WS_POS = 5 * MiB + 768 * 1024;
constexpr size_t WS_RSTD = 7 * MiB;
constexpr size_t WS_WLT = 6 * MiB;
constexpr size_t WS_WAT = 6 * MiB + 64 * 1024;
constexpr size_t WS_WGT = 6 * MiB + 128 * 1024;
constexpr size_t WS_WIN = 16 * MiB;
constexpr size_t WS_WBA = 27 * MiB;
constexpr size_t WS_WBB = 28 * MiB;
constexpr size_t WS_WOUT = 29 * MiB;
constexpr size_t WS_Z = 32 * MiB;
constexpr size_t WS_H = 368 * MiB;
constexpr size_t WS_Q = 304 * MiB, WS_K = 336 * MiB, WS_MRG = 304 * MiB;
constexpr size_t WS_YA = 432 * MiB, WS_YB = 464 * MiB;
constexpr size_t WS_WUP = 368 * MiB;
constexpr size_t WS_H2 = 128 * MiB;
constexpr size_t WS_XS = 64 * MiB;
constexpr size_t WS_HID = 208 * MiB;
constexpr size_t WS_X1B = 432 * MiB;
constexpr size_t WS_ACT = 496 * MiB;
constexpr size_t WS_END = 512 * MiB;
constexpr int CW_CNT = 64, CNT_PAD = 64;
constexpr int CW_NT = 2304;
constexpr int CW_TEXP = 2368;
static_assert(CW_CNT + NEXP * CNT_PAD <= CW_NT, "control words");

__device__ __forceinline__ void tr_item(const float* W, int K, int N, bf16* WT, int kb, int nb, int dst_row0, LAS float* scr, int lane) {
    const int k0 = 64 * kb, n0 = 32 * nb;
#pragma unroll 8
    for (int i = 0; i < 32; ++i) { const int kk = 2 * i + (lane >> 5); scr[kk * 33 + (lane & 31)] = W[(size_t)(k0 + kk) * N + n0 + (lane & 31)]; }
    asm volatile("s_waitcnt lgkmcnt(0)" ::: "memory");
    const int c = lane & 7;
#pragma unroll
    for (int j = 0; j < 4; ++j) { const int n = (lane >> 3) + 8 * j; const LAS float* s = scr + (8 * c) * 33 + n;
        v4u o; o.x = pk2(s[0 * 33], s[1 * 33]); o.y = pk2(s[2 * 33], s[3 * 33]); o.z = pk2(s[4 * 33], s[5 * 33]); o.w = pk2(s[6 * 33], s[7 * 33]);
        *(v4u*)(WT + (size_t)(dst_row0 + n) * K + k0 + 8 * c) = o; }
    asm volatile("s_waitcnt lgkmcnt(0)" ::: "memory");
}

struct PArgs { const float* in[30]; float* out; unsigned char* ws; };

__device__ __forceinline__ void p_prep_weights(const PArgs& a, unsigned char* lds, int wv) {
    const int tid = mktid(wv), lane = tid & 63, wave = tid >> 6;
    LAS float* scr = (LAS float*)lds + wave * (64 * 33);
    const int gw = blockIdx.x * 8 + wave, NGW = gridDim.x * 8;
    unsigned char* ws = a.ws;
    constexpr int I_IN = 16 * 168, I_BR = 8 * 32, I_OUT = 16 * 32;
    for (int it = gw; it < I_IN + 2 * I_BR + I_OUT; it += NGW) {
        int r = it;
        if (r < I_IN) { const int kb = r / 168, nb = r % 168; int dst = 32 * nb;
            if (dst >= 1792 && dst < 2816) { const int rel = dst - 1792, u = rel >> 8, hl = (rel & 255) >> 6, half = (rel & 63) >> 5; dst = 1792 + u * 256 + half * 128 + hl * 32; }
            tr_item(a.in[6], 1024, WIN_N, (bf16*)(ws + WS_WIN), kb, nb, dst, scr, lane); continue; } r -= I_IN;
        if (r < I_BR) { const int kb = r / 32, nb = r % 32; tr_item(a.in[20], 512, 1024, (bf16*)(ws + WS_WBA), kb, nb, 32 * nb, scr, lane); continue; } r -= I_BR;
        if (r < I_BR) { const int kb = r / 32, nb = r % 32; tr_item(a.in[21], 512, 1024, (bf16*)(ws + WS_WBB), kb, nb, 32 * nb, scr, lane); continue; } r -= I_BR;
        { const int kb = r / 32, nb = r % 32; tr_item(a.in[22], 1024, 1024, (bf16*)(ws + WS_WOUT), kb, nb, 32 * nb, scr, lane); }
    }
    const int gt = blockIdx.x * 512 + tid, NGT = gridDim.x * 512;
    float* cosT = (float*)(ws + WS_COS); float* sinT = (float*)(ws + WS_SIN);
    for (int i = gt; i < SEQ * 32; i += NGT) { const int s = i >> 5, f = i & 31; const float inv = powf(10000.0f, -(float)f / 32.0f); const float ang = (float)s * inv; cosT[i] = cosf(ang); sinT[i] = sinf(ang); }
    { bf16* wlt = (bf16*)(ws + WS_WLT); bf16* wat = (bf16*)(ws + WS_WAT); bf16* wgt = (bf16*)(ws + WS_WGT);
      for (int i = gt; i < 8 * 64 * 64; i += NGT) { const int hh = i >> 12, j = (i >> 6) & 63, m = i & 63; wlt[i] = (bf16)f2bf(a.in[9][m * 512 + hh * 64 + j]); wat[i] = (bf16)f2bf(a.in[11][m * 512 + hh * 64 + j]); }
      for (int i = gt; i < 8 * 64 * 128; i += NGT) { const int hh = i >> 13, j = (i >> 7) & 63, m = i & 127; wgt[i] = (bf16)f2bf(a.in[12][m * 512 + hh * 64 + j]); } }
    { bf16* wrh = (bf16*)(ws + WS_WRH); bf16* wrl = (bf16*)(ws + WS_WRL);
      for (int i = gt; i < 48 * 1024; i += NGT) { const int e = i >> 10, k = i & 1023; const float w = e < 4 ? a.in[23][k * 4 + e] : e < 36 ? a.in[25][k * 32 + (e - 4)] : 0.f;
          const unsigned hi = f2bf(w); wrh[i] = (bf16)hi; wrl[i] = (bf16)f2bf(w - bflo(hi)); } }
}

constexpr int CW_PEXP = 2816;
__device__ __forceinline__ void p_prep_experts_dyn(const PArgs& a, unsigned char* lds, int wv) {
    const int tid = mktid(wv), lane = tid & 63, wave = tid >> 6;
    LAS float* scr = (LAS float*)lds + wave * (64 * 33);
    unsigned* ctr = (unsigned*)(a.ws + WS_CTL) + CW_PEXP;
    constexpr int NITEM = NEXP * 768;
    for (;;) {
        unsigned base = 0; if (lane == 0) base = atomicAdd(ctr, 16u);
        base = (unsigned)__builtin_amdgcn_readfirstlane((int)base);
        if (base >= (unsigned)NITEM) break;
        for (int it = (int)base; it < (int)base + 16 && it < NITEM; ++it) {
            const int e = it / 768; int r = it % 768;
            bf16* wup = (bf16*)(a.ws + WS_WUP) + (size_t)e * 1024 * 1024;
            if (r < 256) { const int kb = r / 16, nb = r % 16, n0 = 32 * nb; tr_item(a.in[27] + (size_t)e * 1024 * 512, 1024, 512, wup, kb, nb, (n0 >> 7) * 256 + (n0 & 127), scr, lane); continue; } r -= 256;
            if (r < 256) { const int kb = r / 16, nb = r % 16, n0 = 32 * nb; tr_item(a.in[28] + (size_t)e * 1024 * 512, 1024, 512, wup, kb, nb, (n0 >> 7) * 256 + 128 + (n0 & 127), scr, lane); continue; } r -= 256;
            { const int kb = r / 32, nb = r % 32; tr_item(a.in[29] + (size_t)e * 512 * 1024, 512, 1024, (bf16*)a.out + (size_t)e * 1024 * 512, kb, nb, 32 * nb, scr, lane); }
        }
    }
}

__device__ __forceinline__ void p_ada(const PArgs& a, unsigned char* lds, int wv) {
    float* sc = (float*)lds; float* red = sc + 16 * 1024;
    const float* c = a.in[1]; const float* w = a.in[2]; const float* bias = a.in[3];
    float* mod = (float*)(a.ws + WS_MOD);
    const int tid = mktid(wv);
    for (int i = tid; i < 16 * 1024; i += 512) { const float v = c[i]; sc[i] = v / (1.0f + __expf(-v)); }
    __syncthreads();
    const int col = tid & 31, kg = tid >> 5;
    for (int tile = blockIdx.x; tile < 192; tile += gridDim.x) {
        const int e = tile * 32 + col;
        float acc[16];
#pragma unroll
        for (int b = 0; b < 16; ++b) acc[b] = 0.f;
        for (int d = kg * 64; d < kg * 64 + 64; ++d) { const float wv = w[(size_t)d * 6144 + e];
#pragma unroll
            for (int b = 0; b < 16; ++b) acc[b] += sc[b * 1024 + d] * wv; }
#pragma unroll
        for (int b = 0; b < 16; ++b) red[(kg * 16 + b) * 32 + col] = acc[b];
        __syncthreads();
        { const int b = tid >> 5, cc = tid & 31; float sm = 0.f;
#pragma unroll
            for (int k = 0; k < 16; ++k) sm += red[(k * 16 + b) * 32 + cc];
            mod[b * 6144 + tile * 32 + cc] = sm + bias[tile * 32 + cc]; }
        __syncthreads();
    }
}

__device__ __forceinline__ void p_norm1(const PArgs& a, unsigned char* lds, int wv) {
    const int tid = mktid(wv), lane = tid & 63, gw = blockIdx.x * 8 + (tid >> 6), NGW = gridDim.x * 8;
    const float* x = a.in[0]; const float* g = a.in[4]; const float* mod = (const float*)(a.ws + WS_MOD);
    bf16* h = (bf16*)(a.ws + WS_H);
    for (int m = gw; m < NT; m += NGW) {
        const int b = m >> 11; const f32x4* xr = (const f32x4*)(x + (size_t)m * DM) + lane; f32x4 v[4]; float s = 0.f;
#pragma unroll
        for (int j = 0; j < 4; ++j) { v[j] = xr[64 * j]; s += (v[j].x * v[j].x + v[j].y * v[j].y) + (v[j].z * v[j].z + v[j].w * v[j].w); }
        const float rstd = rsqrtf(wave_sum(s) * (1.0f / DM) + 1e-6f);
        v2u* o = (v2u*)(h + (size_t)m * DM) + lane;
#pragma unroll
        for (int j = 0; j < 4; ++j) { const int col = 4 * (lane + 64 * j);
            const f32x4 gg = *(const f32x4*)(g + col), sh = *(const f32x4*)(mod + b * 6144 + col), scl = *(const f32x4*)(mod + b * 6144 + 1024 + col);
            const f32x4 r = v[j] * rstd * gg * (scl + 1.0f) + sh; v2u w; w.x = pk2(r.x, r.y); w.y = pk2(r.z, r.w); o[64 * j] = w; }
    }
    { float* gm2 = (float*)(a.ws + WS_GM2); float* cb = (float*)(a.ws + WS_CB); const float* g2 = a.in[5];
      for (int i = blockIdx.x * 512 + tid; i < 16 * 1024; i += gridDim.x * 512) { const int b = i >> 10, k = i & 1023; gm2[i] = g2[k] * (1.0f + mod[b * 6144 + 4096 + k]); }
      for (int p = gw; p < 16 * 48; p += NGW) { const int b = p / 48, n = p % 48; float s = 0.f;
          if (n < 36) { for (int k = lane; k < 1024; k += 64) { const float w = n < 4 ? a.in[23][k * 4 + n] : a.in[25][k * 32 + (n - 4)]; s += mod[b * 6144 + 3072 + k] * w; } }
          s = wave_sum(s); if (lane == 0) cb[p] = n < 4 ? s + a.in[24][n] : n < 36 ? s + a.in[26][n - 4] : 0.f; } }
}

using pg8::Unit; using pg8::HALF; using pg8::BM; using pg8::cvt_pk_bf16;
typedef pg8::f32x4 pf4; typedef pg8::u32x4 pu4;

struct EpiStoreBf16 {
    static constexpr bool PERM = true, AFTER_DRAIN = false, CHAIN = false;
    bf16* O; int ldc;
    __device__ __forceinline__ void operator()(const pf4 (&acc)[2][2][4][2], const Unit& u, int wr, int wc, int fr, int fq) const {
        const int row0 = u.pm * BM + wr * 64 + fr, col0 = u.pn * BM + wc * 32 + 8 * fq;
#pragma unroll
        for (int ai = 0; ai < 2; ++ai)
#pragma unroll
            for (int m = 0; m < 4; ++m) { bf16* rowp = O + (size_t)(row0 + ai * HALF + m * 16) * ldc + col0;
#pragma unroll
                for (int bj = 0; bj < 2; ++bj) { const pf4 v0 = acc[ai][bj][m][0], v1 = acc[ai][bj][m][1]; pu4 w;
                    w.x = cvt_pk_bf16(v0[0], v0[1]); w.y = cvt_pk_bf16(v0[2], v0[3]); w.z = cvt_pk_bf16(v1[0], v1[1]); w.w = cvt_pk_bf16(v1[2], v1[3]);
                    *(pu4*)(rowp + bj * HALF) = w; } }
    }
};
struct EpiZ {
    static constexpr bool PERM = true, AFTER_DRAIN = false, CHAIN = false;
    bf16* z; bf16* Q; bf16* K; const float* qg; const float* kg; const float* cosT; const float* sinT;
    __device__ __forceinline__ void operator()(const pf4 (&acc)[2][2][4][2], const Unit& u, int wr, int wc, int fr, int fq) const {
        const int row0 = u.pm * BM + wr * 64 + fr;
        if (u.pn < 7 || u.pn >= 11) {
            const int zc = (u.pn < 7 ? u.pn * 256 : (u.pn - 11) * 256 + 1792) + wc * 32 + 8 * fq;
#pragma unroll
            for (int ai = 0; ai < 2; ++ai)
#pragma unroll
                for (int m = 0; m < 4; ++m) { bf16* rowp = z + (size_t)(row0 + ai * HALF + m * 16) * INC + zc;
#pragma unroll
                    for (int bj = 0; bj < 2; ++bj) { const pf4 v0 = acc[ai][bj][m][0], v1 = acc[ai][bj][m][1]; pu4 w;
                        w.x = cvt_pk_bf16(v0[0], v0[1]); w.y = cvt_pk_bf16(v0[2], v0[3]); w.z = cvt_pk_bf16(v1[0], v1[1]); w.w = cvt_pk_bf16(v1[2], v1[3]);
                        *(pu4*)(rowp + bj * HALF) = w; } }
            return;
        }
        const bool isk = u.pn >= 9; const int head = 4 * ((u.pn - 7) & 1) + wc; const float* g = isk ? kg : qg; bf16* O = (isk ? K : Q) + head * 64 + 8 * fq;
        const float osc = isk ? 1.0f : C2;
        pf4 gl[2][2];
#pragma unroll
        for (int bj = 0; bj < 2; ++bj)
#pragma unroll
            for (int n = 0; n < 2; ++n) gl[bj][n] = *(const pf4*)(g + 32 * bj + 8 * fq + 4 * n);
#pragma unroll
        for (int aim = 0; aim < 4; ++aim) { const int ai = aim >> 1, m0 = 2 * (aim & 1);
            pf4 ct[2][2], st[2][2];
#pragma unroll
            for (int mm = 0; mm < 2; ++mm) { const int s = (row0 + ai * HALF + (m0 + mm) * 16) & (SEQ - 1);
#pragma unroll
                for (int n = 0; n < 2; ++n) { ct[mm][n] = *(const pf4*)(cosT + s * 32 + 8 * fq + 4 * n); st[mm][n] = *(const pf4*)(sinT + s * 32 + 8 * fq + 4 * n); } }
#pragma unroll
            for (int mm = 0; mm < 2; ++mm) { const int m = m0 + mm; const int row = row0 + ai * HALF + m * 16;
                float ss = 0.f;
#pragma unroll
                for (int bj = 0; bj < 2; ++bj)
#pragma unroll
                    for (int n = 0; n < 2; ++n) { const pf4 v = acc[ai][bj][m][n]; ss += (v[0] * v[0] + v[1] * v[1]) + (v[2] * v[2] + v[3] * v[3]); }
                ss += __builtin_bit_cast(float, __builtin_amdgcn_ds_swizzle(__builtin_bit_cast(int, ss), 0x401F));
                { const unsigned uu = __builtin_bit_cast(unsigned, ss); auto rr = __builtin_amdgcn_permlane32_swap(uu, uu, false, false); ss = __builtin_bit_cast(float, (unsigned)rr[0]) + __builtin_bit_cast(float, (unsigned)rr[1]); }
                const float rstd = rsqrtf(ss * (1.0f / 64.0f) + 1e-6f);
#pragma unroll
                for (int n = 0; n < 2; ++n) { const pf4 x1 = acc[ai][0][m][n] * rstd * gl[0][n], x2 = acc[ai][1][m][n] * rstd * gl[1][n];
                    const pf4 o1 = x1 * ct[mm][n] - x2 * st[mm][n], o2 = x2 * ct[mm][n] + x1 * st[mm][n];
                    v2u wa, wb; wa.x = cvt_pk_bf16(o1[0] * osc, o1[1] * osc); wa.y = cvt_pk_bf16(o1[2] * osc, o1[3] * osc); wb.x = cvt_pk_bf16(o2[0] * osc, o2[1] * osc); wb.y = cvt_pk_bf16(o2[2] * osc, o2[3] * osc);
                    bf16* op = O + (size_t)row * 512 + 4 * n; *(v2u*)op = wa; *(v2u*)(op + 32) = wb; } }
            asm volatile("" ::: "memory");
        }
    }
};
struct EpiMerge {
    static constexpr bool PERM = true, AFTER_DRAIN = false, CHAIN = true;
    const bf16* z; bf16* mrg;
    __device__ __forceinline__ bool chain(pf4 (&acc)[2][2][4][2], const Unit& u, int wr, int wc, int fr, int fq) const {
        const int row0 = u.pm * BM + wr * 64 + fr, col0 = u.pn * BM + wc * 32 + 8 * fq;
        if (u.aux == 0) {
#pragma unroll
            for (int ai = 0; ai < 2; ++ai) {
                pu4 za[4][2], zb[4][2];
#pragma unroll
                for (int m = 0; m < 4; ++m) { const size_t row = (size_t)(row0 + ai * HALF + m * 16);
#pragma unroll
                    for (int bj = 0; bj < 2; ++bj) { const int col = col0 + bj * HALF; za[m][bj] = *(const pu4*)(z + row * INC + ZG + col); zb[m][bj] = *(const pu4*)(z + row * INC + ZG + 1024 + col); } }
#pragma unroll
                for (int m = 0; m < 4; ++m)
#pragma unroll
                    for (int bj = 0; bj < 2; ++bj) { const pu4 a4 = za[m][bj], b4 = zb[m][bj];
                        const float a8[8] = {bflo(a4.x), bfhi(a4.x), bflo(a4.y), bfhi(a4.y), bflo(a4.z), bfhi(a4.z), bflo(a4.w), bfhi(a4.w)};
                        const float b8[8] = {bflo(b4.x), bfhi(b4.x), bflo(b4.y), bfhi(b4.y), bflo(b4.z), bfhi(b4.z), bflo(b4.w), bfhi(b4.w)};
#pragma unroll
                        for (int e = 0; e < 8; ++e) acc[ai][bj][m][e >> 2][e & 3] *= (1.0f + __expf(-b8[e])) * __builtin_amdgcn_rcpf(1.0f + __expf(-a8[e])); }
                asm volatile("" ::: "memory");
            }
            return true;
        }
        pu4 gz[2][4][2];
#pragma unroll
        for (int ai = 0; ai < 2; ++ai)
#pragma unroll
            for (int m = 0; m < 4; ++m) { const size_t row = (size_t)(row0 + ai * HALF + m * 16);
#pragma unroll
                for (int bj = 0; bj < 2; ++bj) gz[ai][m][bj] = *(const pu4*)(z + row * INC + ZG + 1024 + col0 + bj * HALF); }
#pragma unroll
        for (int ai = 0; ai < 2; ++ai)
#pragma unroll
            for (int m = 0; m < 4; ++m) { const size_t row = (size_t)(row0 + ai * HALF + m * 16);
#pragma unroll
                for (int bj = 0; bj < 2; ++bj) { const int col = col0 + bj * HALF; const pu4 g4 = gz[ai][m][bj]; const pf4 v0 = acc[ai][bj][m][0], v1 = acc[ai][bj][m][1];
                    pu4 w;
                    w.x = cvt_pk_bf16(sigm(bflo(g4.x)) * v0[0], sigm(bfhi(g4.x)) * v0[1]); w.y = cvt_pk_bf16(sigm(bflo(g4.y)) * v0[2], sigm(bfhi(g4.y)) * v0[3]);
                    w.z = cvt_pk_bf16(sigm(bflo(g4.z)) * v1[0], sigm(bfhi(g4.z)) * v1[1]); w.w = cvt_pk_bf16(sigm(bflo(g4.w)) * v1[2], sigm(bfhi(g4.w)) * v1[3]);
                    *(pu4*)(mrg + row * DM + col) = w; } }
        return false;
    }
};
struct EpiOut {
    static constexpr bool PERM = true, AFTER_DRAIN = false, CHAIN = false;
    const float* x; const float* mod; bf16* x1;
    __device__ __forceinline__ void operator()(const pf4 (&acc)[2][2][4][2], const Unit& u, int wr, int wc, int fr, int fq) const {
        const int row0 = u.pm * BM + wr * 64 + fr, col0 = u.pn * BM + wc * 32 + 8 * fq; const int b = u.pm >> 3;
        pf4 gt[2][2];
#pragma unroll
        for (int bj = 0; bj < 2; ++bj)
#pragma unroll
            for (int n = 0; n < 2; ++n) gt[bj][n] = *(const pf4*)(mod + b * 6144 + 2048 + col0 + bj * HALF + n * 4);
#pragma unroll
        for (int ai = 0; ai < 2; ++ai) {
            pf4 xv[4][2][2];
#pragma unroll
            for (int m = 0; m < 4; ++m) { const size_t off = (size_t)(row0 + ai * HALF + m * 16) * DM + col0;
#pragma unroll
                for (int bj = 0; bj < 2; ++bj) { xv[m][bj][0] = *(const pf4*)(x + off + bj * HALF); xv[m][bj][1] = *(const pf4*)(x + off + bj * HALF + 4); } }
#pragma unroll
            for (int m = 0; m < 4; ++m) { const size_t off = (size_t)(row0 + ai * HALF + m * 16) * DM + col0;
#pragma unroll
                for (int bj = 0; bj < 2; ++bj) { const pf4 o0 = xv[m][bj][0] + gt[bj][0] * acc[ai][bj][m][0], o1 = xv[m][bj][1] + gt[bj][1] * acc[ai][bj][m][1]; pu4 w;
                    w.x = cvt_pk_bf16(o0[0], o0[1]); w.y = cvt_pk_bf16(o0[2], o0[3]); w.z = cvt_pk_bf16(o1[0], o1[1]); w.w = cvt_pk_bf16(o1[2], o1[3]);
                    *(pu4*)(x1 + off + bj * HALF) = w; } }
            asm volatile("" ::: "memory");
        }
    }
};
struct EpiUp {
    static constexpr bool PERM = true, AFTER_DRAIN = false, CHAIN = false;
    bf16* hid;
    __device__ __forceinline__ void operator()(const pf4 (&acc)[2][2][4][2], const Unit& u, int wr, int wc, int fr, int fq) const {
        const int row0 = u.pm * BM + wr * 64 + fr, col0 = u.pn * 128 + wc * 32 + 8 * fq;
#pragma unroll
        for (int ai = 0; ai < 2; ++ai)
#pragma unroll
            for (int m = 0; m < 4; ++m) { const size_t row = (size_t)(row0 + ai * HALF + m * 16); float o[8];
#pragma unroll
                for (int n = 0; n < 2; ++n)
#pragma unroll
                    for (int e = 0; e < 4; ++e) { const float g = acc[ai][0][m][n][e], l = acc[ai][1][m][n][e]; o[4 * n + e] = g * sigm(g) * l; }
                pu4 w; w.x = cvt_pk_bf16(o[0], o[1]); w.y = cvt_pk_bf16(o[2], o[3]); w.z = cvt_pk_bf16(o[4], o[5]); w.w = cvt_pk_bf16(o[6], o[7]);
                *(pu4*)(hid + row * DEXP + col0) = w; }
    }
};

struct GemmArgs { unsigned char* ws; const float* x; float* out; const float* qg; const float* kg; };
template <class Epi> __device__ __forceinline__ void run_dense(const void* A, const void* Bt, int M, int N, int K, const Epi& E, unsigned char* lds, int wv) {
    pg8::Gemm g{K}; pg8::StaticOrder S; S.init(A, Bt, M, N, K, (int)gridDim.x, (int)blockIdx.x);
    pg8::gemm_phase<Epi, pg8::StaticOrder, true, true>((PG8_LAS unsigned char*)lds, g, S, E, wv);
}
__device__ __forceinline__ void p_gemm_in(const GemmArgs& a, unsigned char* lds, int wv) {
    EpiZ E{(bf16*)(a.ws + WS_Z), (bf16*)(a.ws + WS_Q), (bf16*)(a.ws + WS_K), a.qg, a.kg, (const float*)(a.ws + WS_COS), (const float*)(a.ws + WS_SIN)};
    run_dense(a.ws + WS_H, a.ws + WS_WIN, NT, WIN_N, 1024, E, lds, wv);
}
struct PairOrder {
    int nM, nN, nwg, G, c; const char *A0, *A1, *B0, *B1; size_t tstep;
    __device__ bool next(int i, Unit& u) const {
        const long L = (long)(i >> 1) * G + c; if (L >= nwg) return false;
        int wgid = (int)L; { const int q = nwg / pg8::NXCD, r = nwg % pg8::NXCD, xcd = wgid % pg8::NXCD, off = wgid / pg8::NXCD; wgid = (xcd < r ? xcd * (q + 1) : r * (q + 1) + (xcd - r) * q) + off; }
        const int nig = pg8::WGM * nN, gid = wgid / nig, fm = gid * pg8::WGM, gsz = (nM - fm) < pg8::WGM ? (nM - fm) : pg8::WGM;
        u.pm = fm + ((wgid % nig) % gsz); u.pn = (wgid % nig) / gsz; u.aux = i & 1;
        u.a = ((i & 1) ? A1 : A0) + (size_t)u.pm * tstep; u.b = ((i & 1) ? B1 : B0) + (size_t)u.pn * tstep; return true;
    }
    __device__ __forceinline__ void a_ready(const Unit&) const {}
    __device__ __forceinline__ void done(const Unit&) const {}
};
__device__ __forceinline__ void p_gemm_merge(const GemmArgs& a, unsigned char* lds, int wv) {
    PairOrder S{NT / 256, 4, (NT / 256) * 4, (int)gridDim.x, (int)blockIdx.x, (const char*)(a.ws + WS_YA), (const char*)(a.ws + WS_YB), (const char*)(a.ws + WS_WBA), (const char*)(a.ws + WS_WBB), (size_t)256 * 512 * 2};
    EpiMerge E{(const bf16*)(a.ws + WS_Z), (bf16*)(a.ws + WS_MRG)}; pg8::Gemm g{512};
    pg8::gemm_phase<EpiMerge, PairOrder, true, true>((PG8_LAS unsigned char*)lds, g, S, E, wv);
}
__device__ __forceinline__ void p_gemm_out(const GemmArgs& a, unsigned char* lds, int wv) {
    EpiOut E{a.x, (const float*)(a.ws + WS_MOD), (bf16*)(a.ws + WS_X1B)};
    run_dense(a.ws + WS_MRG, a.ws + WS_WOUT, NT, 1024, 1024, E, lds, wv);
}
struct GroupedOrder {
    const int* texp; int nT, nN, G, c; const char* A; size_t a_tile; const char* B; size_t b_exp, b_tile;
    __device__ bool next(int i, Unit& u) const {
        const long L = (long)i * G + c; if (L >= (long)nT * nN) return false;
        const int tile = (int)(L / nN), pn = (int)(L % nN); u.aux = 0; u.pm = tile; u.pn = pn; u.a = A + (size_t)tile * a_tile; u.b = B + (size_t)texp[tile] * b_exp + (size_t)pn * b_tile; return true;
    }
    __device__ __forceinline__ void a_ready(const Unit&) const {}
    __device__ __forceinline__ void done(const Unit&) const {}
};
__device__ __forceinline__ void p_gemm_up(const GemmArgs& a, unsigned char* lds, int wv) {
    const int* ctl = (const int*)(a.ws + WS_CTL);
    GroupedOrder S{ctl + CW_TEXP, ctl[CW_NT], 4, (int)gridDim.x, (int)blockIdx.x, (const char*)(a.ws + WS_XS), (size_t)256 * 1024 * 2, (const char*)(a.ws + WS_WUP), (size_t)1024 * 1024 * 2, (size_t)256 * 1024 * 2};
    EpiUp E{(bf16*)(a.ws + WS_HID)}; pg8::Gemm g{1024};
    pg8::gemm_phase<EpiUp, GroupedOrder, true, true>((PG8_LAS unsigned char*)lds, g, S, E, wv);
}
__device__ __forceinline__ void p_gemm_down(const GemmArgs& a, unsigned char* lds, int wv) {
    const int* ctl = (const int*)(a.ws + WS_CTL);
    GroupedOrder S{ctl + CW_TEXP, ctl[CW_NT], 4, (int)gridDim.x, (int)blockIdx.x, (const char*)(a.ws + WS_HID), (size_t)256 * 512 * 2, (const char*)a.out, (size_t)1024 * 512 * 2, (size_t)256 * 512 * 2};
    EpiStoreBf16 E{(bf16*)(a.ws + WS_XS), 1024}; pg8::Gemm g{512};
    pg8::gemm_phase<EpiStoreBf16, GroupedOrder, true, true>((PG8_LAS unsigned char*)lds, g, S, E, wv);
}

__device__ __forceinline__ void p_attn(const PArgs& a, unsigned char* lds, int vb, int nvb, int wv) {
    const attn_body::bf16* Q = (const attn_body::bf16*)(a.ws + WS_Q); const attn_body::bf16* K = (const attn_body::bf16*)(a.ws + WS_K);
    const attn_body::bf16* V = (const attn_body::bf16*)(a.ws + WS_Z) + ZV; attn_body::bf16* O = (attn_body::bf16*)(a.ws + WS_YB);
    for (int p = vb; p < 512; p += nvb)
        for (int which = 0; which < 2; ++which) { const int bh = p >> 2, s = p & 3, qb = which ? 7 - s : s;
            attn_body::attn_unit<8>(bh >> 3, bh & 7, qb, Q, K, V, O, (char*)lds, wv); }
}

__device__ __forceinline__ void p_actprep(const PArgs& a, unsigned char* lds, int wv) {
    const int tid = mktid(wv); const bf16* z = (const bf16*)(a.ws + WS_Z); bf16* act = (bf16*)(a.ws + WS_ACT); const float* mu = a.in[7];
    for (int i = blockIdx.x * 512 + tid; i < NT * 32; i += gridDim.x * 512) { const int t = i >> 5, cg = i & 31, col = 1536 + 8 * cg; const bool hasp = (t & (SEQ - 1)) > 0;
        const v4u cw = *(const v4u*)(z + (size_t)t * INC + col); v4u pw = {0u, 0u, 0u, 0u}; if (hasp) pw = *(const v4u*)(z + (size_t)(t - 1) * INC + col);
        const float c8[8] = {bflo(cw.x), bfhi(cw.x), bflo(cw.y), bfhi(cw.y), bflo(cw.z), bfhi(cw.z), bflo(cw.w), bfhi(cw.w)}, p8[8] = {bflo(pw.x), bfhi(pw.x), bflo(pw.y), bfhi(pw.y), bflo(pw.z), bfhi(pw.z), bflo(pw.w), bfhi(pw.w)};
        const f32x4 m0 = *(const f32x4*)(mu + col), m1 = *(const f32x4*)(mu + col + 4); const float m8[8] = {m0.x, m0.y, m0.z, m0.w, m1.x, m1.y, m1.z, m1.w}; float v[8];
#pragma unroll
        for (int e = 0; e < 8; ++e) { const float x = c8[e] + (p8[e] - c8[e]) * m8[e]; v[e] = cg < 8 ? 1.0f - 2.0f * __builtin_amdgcn_rcpf(1.0f + __expf(2.0f * x)) : cg < 16 ? x : sigm(x); }
        v4u w; w.x = pk2(v[0], v[1]); w.y = pk2(v[2], v[3]); w.z = pk2(v[4], v[5]); w.w = pk2(v[6], v[7]);
        *(v4u*)(act + (size_t)t * 256 + 8 * cg) = w; }
}

namespace rw {
typedef short bf16x8 __attribute__((ext_vector_type(8)));
constexpr int MB = 8192;
__device__ __forceinline__ int SW(int r, int c) { return r * 128 + ((((c >> 3) ^ (r >> 1)) & 7) << 4) + (c & 7) * 2; }
__device__ __forceinline__ int SWG(int r, int c) { return r * 256 + ((((c >> 3) ^ r) & 15) << 4) + (c & 7) * 2; }
__device__ __forceinline__ int SWF(int r, int c) { return r * 256 + ((((c >> 2) ^ r) & 15) << 4) + (c & 3) * 4; }
enum { I_AT = 0, I_BT, I_AJ, I_BHJ, I_KHJ, I_ABRT, I_X5, I_L, I_LT, I_R0, I_R1, I_KT, I_RT, I_VJ, I_X14, I_GATE, I_VT, I_VT2, NBUF };
constexpr int OFF_F32 = NBUF * MB;
constexpr int OFF_CST = OFF_F32 + (64 * 3 + 512) * 4;
constexpr int LDS_NEED = OFF_CST + 14 * 64 * 4;

__device__ __forceinline__ bf16x8 ldfrag(const unsigned char* M, int row, int k) { return *(const bf16x8*)(M + SW(row, k)); }
__device__ __forceinline__ void mm(f32x4 (&acc)[2], const unsigned char* X, const unsigned char* Y, int mt, int nh, int fr, int fq) {
    const bf16x8 a0 = ldfrag(X, 16 * mt + fr, 8 * fq), a1 = ldfrag(X, 16 * mt + fr, 8 * fq + 32);
#pragma unroll
    for (int nt = 0; nt < 2; ++nt) { const bf16x8 b0 = ldfrag(Y, 16 * (2 * nh + nt) + fr, 8 * fq), b1 = ldfrag(Y, 16 * (2 * nh + nt) + fr, 8 * fq + 32);
        acc[nt] = __builtin_amdgcn_mfma_f32_16x16x32_bf16(a0, b0, acc[nt], 0, 0, 0); acc[nt] = __builtin_amdgcn_mfma_f32_16x16x32_bf16(a1, b1, acc[nt], 0, 0, 0); }
}
typedef short s16x4 __attribute__((ext_vector_type(4)));
typedef __attribute__((address_space(3))) s16x4* lds_s16x4p;
__device__ __forceinline__ bf16x8 ldfragT(const unsigned char* M, int row0, int kb, int fr, int fq) {
    const int k0 = kb + 8 * fq + (fr >> 2), c0 = row0 + 4 * (fr & 3);
    const s16x4 lo = __builtin_amdgcn_ds_read_tr16_b64_v4i16((lds_s16x4p)(M + SW(k0, c0))), hi = __builtin_amdgcn_ds_read_tr16_b64_v4i16((lds_s16x4p)(M + SW(k0 + 4, c0)));
    return (bf16x8){lo[0], lo[1], lo[2], lo[3], hi[0], hi[1], hi[2], hi[3]};
}
struct FA { bf16x8 k0, k1; };
struct FB { bf16x8 k0[2], k1[2]; };
__device__ __forceinline__ FA ldA(const unsigned char* X, int mt, int fr, int fq) { FA f; f.k0 = ldfrag(X, 16 * mt + fr, 8 * fq); f.k1 = ldfrag(X, 16 * mt + fr, 8 * fq + 32); return f; }
__device__ __forceinline__ FB ldB(const unsigned char* Y, int nh, int fr, int fq) { FB f;
#pragma unroll
    for (int nt = 0; nt < 2; ++nt) { f.k0[nt] = ldfrag(Y, 16 * (2 * nh + nt) + fr, 8 * fq); f.k1[nt] = ldfrag(Y, 16 * (2 * nh + nt) + fr, 8 * fq + 32); }
    return f; }
__device__ __forceinline__ FA ldAT(const unsigned char* XT, int mt, int fr, int fq) { FA f; f.k0 = ldfragT(XT, 16 * mt, 0, fr, fq); f.k1 = ldfragT(XT, 16 * mt, 32, fr, fq); return f; }
__device__ __forceinline__ FB ldBT(const unsigned char* YT, int nh, int fr, int fq) { FB f;
#pragma unroll
    for (int nt = 0; nt < 2; ++nt) { f.k0[nt] = ldfragT(YT, 16 * (2 * nh + nt), 0, fr, fq); f.k1[nt] = ldfragT(YT, 16 * (2 * nh + nt), 32, fr, fq); }
    return f; }
__device__ __forceinline__ void mma(f32x4 (&acc)[2], const FA& a, const FB& b) {
    acc[0] = __builtin_amdgcn_mfma_f32_16x16x32_bf16(a.k0, b.k0[0], acc[0], 0, 0, 0); acc[1] = __builtin_amdgcn_mfma_f32_16x16x32_bf16(a.k0, b.k0[1], acc[1], 0, 0, 0);
    acc[0] = __builtin_amdgcn_mfma_f32_16x16x32_bf16(a.k1, b.k1[0], acc[0], 0, 0, 0); acc[1] = __builtin_amdgcn_mfma_f32_16x16x32_bf16(a.k1, b.k1[1], acc[1], 0, 0, 0);
}
__device__ __forceinline__ void ldC(f32x4 (&acc)[2], const unsigned char* Z, int mt, int nh, int fr, int fq) {
#pragma unroll
    for (int nt = 0; nt < 2; ++nt) { const v2u w = *(const v2u*)(Z + SW(16 * (2 * nh + nt) + fr, 16 * mt + 4 * fq)); acc[nt] = (f32x4){bflo(w.x), bfhi(w.x), bflo(w.y), bfhi(w.y)}; }
}
__device__ __forceinline__ void storeT(unsigned char* Z, const f32x4 (&acc)[2], int mt, int nh, int fr, int fq) {
#pragma unroll
    for (int nt = 0; nt < 2; ++nt) { v2u w; w.x = pk2(acc[nt][0], acc[nt][1]); w.y = pk2(acc[nt][2], acc[nt][3]); *(v2u*)(Z + SW(16 * (2 * nh + nt) + fr, 16 * mt + 4 * fq)) = w; }
}
__device__ __forceinline__ void storeN(unsigned char* Z, const f32x4 (&acc)[2], int mt, int nh, int fr, int fq) {
#pragma unroll
    for (int nt = 0; nt < 2; ++nt)
#pragma unroll
        for (int r = 0; r < 4; ++r) *(unsigned short*)(Z + SW(16 * mt + 4 * fq + r, 16 * (2 * nh + nt) + fr)) = (unsigned short)f2bf(acc[nt][r]);
}
__device__ __forceinline__ void ld8bf(const unsigned char* p, float (&v)[8]) { const v4u w = *(const v4u*)p; v[0] = bflo(w.x); v[1] = bfhi(w.x); v[2] = bflo(w.y); v[3] = bfhi(w.y); v[4] = bflo(w.z); v[5] = bfhi(w.z); v[6] = bflo(w.w); v[7] = bfhi(w.w); }
__device__ __forceinline__ void st8bf(unsigned char* p, const float (&v)[8]) { v4u w; w.x = pk2(v[0], v[1]); w.y = pk2(v[2], v[3]); w.z = pk2(v[4], v[5]); w.w = pk2(v[6], v[7]); *(v4u*)p = w; }
__device__ __forceinline__ void ld8f(const float* p, float (&v)[8]) { const f32x4 a = *(const f32x4*)p, b = *(const f32x4*)(p + 4); v[0] = a.x; v[1] = a.y; v[2] = a.z; v[3] = a.w; v[4] = b.x; v[5] = b.y; v[6] = b.z; v[7] = b.w; }
__device__ __forceinline__ void ld8fs(const unsigned char* M, int r, int c, float (&v)[8]) { const f32x4 a = *(const f32x4*)(M + SWF(r, c)), b = *(const f32x4*)(M + SWF(r, c + 4)); v[0] = a.x; v[1] = a.y; v[2] = a.z; v[3] = a.w; v[4] = b.x; v[5] = b.y; v[6] = b.z; v[7] = b.w; }
__device__ __forceinline__ void un8(const v4u w, float (&v)[8]) { v[0] = bflo(w.x); v[1] = bfhi(w.x); v[2] = bflo(w.y); v[3] = bfhi(w.y); v[4] = bflo(w.z); v[5] = bfhi(w.z); v[6] = bflo(w.w); v[7] = bfhi(w.w); }
__device__ __forceinline__ void shift8(const v4u cw, const v4u pw, bool hasp, const float* mu, float (&v)[8]) {
    float c[8], p[8], m[8]; un8(cw, c); un8(pw, p); ld8f(mu, m);
#pragma unroll
    for (int e = 0; e < 8; ++e) { const float pe = hasp ? p[e] : 0.f; v[e] = c[e] + (pe - c[e]) * m[e]; }
}
__device__ __forceinline__ float tanh_fast(float x) { return 1.0f - 2.0f * __builtin_amdgcn_rcpf(1.0f + __expf(2.0f * x)); }

#define LBAR() do { asm volatile("s_waitcnt lgkmcnt(0)" ::: "memory"); __builtin_amdgcn_s_barrier(); asm volatile("" ::: "memory"); } while (0)
__device__ __forceinline__ void scan_unit(const PArgs& a, unsigned char* lds, int bh, int wv) {
    const int tid = mktid(wv), lane = tid & 63, wid = __builtin_amdgcn_readfirstlane(tid >> 6);
    const int mt = wid >> 1, nh = wid & 1; int fr = lane & 15, fq = lane >> 4;
    const int b = bh >> 3, h = bh & 7;
#define BUF(i) (lds + (i) * MB)
    float* GC = (float*)(lds + OFF_F32); float* BON = GC + 64; float* SSQ = BON + 64; float* SEGT = SSQ + 64;
    unsigned char* LWR = BUF(I_AT); unsigned char* LAR = BUF(I_AJ); unsigned char* LGR = BUF(I_KHJ); unsigned char* YTF = BUF(I_KHJ);
    unsigned char* ACTW = BUF(I_L); unsigned char* ACTA = BUF(I_LT); unsigned char* ACTG = BUF(I_R0);
    const bf16* z = (const bf16*)(a.ws + WS_Z); bf16* ya = (bf16*)(a.ws + WS_YA);
    const float* mu = a.in[7];
    bf16x8 fw[2], fa[2], fg[4];
    { const bf16* wlt = (const bf16*)(a.ws + WS_WLT) + (size_t)h * 4096 + (16 * mt + fr) * 64 + 8 * fq; const bf16* wat = (const bf16*)(a.ws + WS_WAT) + (size_t)h * 4096 + (16 * mt + fr) * 64 + 8 * fq;
      const bf16* wgt = (const bf16*)(a.ws + WS_WGT) + (size_t)h * 8192 + (16 * mt + fr) * 128 + 8 * fq;
      fw[0] = *(const bf16x8*)wlt; fw[1] = *(const bf16x8*)(wlt + 32); fa[0] = *(const bf16x8*)wat; fa[1] = *(const bf16x8*)(wat + 32);
#pragma unroll
      for (int ks = 0; ks < 4; ++ks) fg[ks] = *(const bf16x8*)(wgt + 32 * ks); }
    float* CST = (float*)(lds + OFF_CST);
    for (int i = tid; i < 14 * 64; i += 512) { const int blk = i >> 6, jj = i & 63; float v;
        if (blk < 3) v = mu[blk * 512 + h * 64 + jj]; else if (blk < 7) v = mu[1536 + (blk - 3) * 64 + jj]; else v = a.in[blk == 7 ? 8 : blk == 8 ? 10 : blk == 9 ? 13 : blk == 10 ? 14 : blk == 11 ? 15 : blk == 12 ? 16 : 17][h * 64 + jj];
        CST[i] = v; }
    int s0i = I_X14, aki = I_X5;
    for (int i = tid; i < MB / 4; i += 512) ((unsigned*)BUF(I_X14))[i] = 0u;
    LBAR();
    int pt = tid >> 3, j0 = 8 * (tid & 7);
    const int colh = h * 64 + j0;
    const int zoff0 = colh, zoff1 = 512 + colh, zoff2 = 1024 + colh;
    const bf16* actb = (const bf16*)(a.ws + WS_ACT);
    v4u zc[3], zq[3], za[4];
#define ZLOAD(cc) do { const size_t tr_ = (size_t)b * SEQ + (cc) * 64 + pt; const bf16* zr_ = z + tr_ * INC; const bf16* zs_ = ((cc) * 64 + pt) > 0 ? zr_ - INC : zr_; const bf16* ar_ = actb + tr_ * 256 + j0; \
        zc[0] = *(const v4u*)(zr_ + zoff0); zc[1] = *(const v4u*)(zr_ + zoff1); zc[2] = *(const v4u*)(zr_ + zoff2); \
        zq[0] = *(const v4u*)(zs_ + zoff0); zq[1] = *(const v4u*)(zs_ + zoff1); zq[2] = *(const v4u*)(zs_ + zoff2); \
        za[0] = *(const v4u*)(ar_); za[1] = *(const v4u*)(ar_ + 64); za[2] = *(const v4u*)(ar_ + 128); za[3] = *(const v4u*)(ar_ + 192); } while (0)
#define ESTAGE(VTB, TT_) \
        { float y[8], vv[8], g8[8], lg[8], lb[8]; ld8fs(YTF, pt, j0, y); ld8bf((VTB) + SW(pt, j0), vv); ld8bf(BUF(I_GATE) + SW(pt, j0), g8); \
          ld8f(CST + 12 * 64 + j0, lg); ld8f(CST + 13 * 64 + j0, lb); \
          float sm = 0.f; \
_Pragma("unroll") \
          for (int e = 0; e < 8; ++e) sm += y[e]; \
          const float mean = red8(sm) * (1.0f / 64.0f); float sq = 0.f; \
_Pragma("unroll") \
          for (int e = 0; e < 8; ++e) { y[e] -= mean; sq += y[e] * y[e]; } \
          const float rstd = rsqrtf(red8(sq) * (1.0f / 64.0f) + 64e-5f), bon = BON[pt]; \
_Pragma("unroll") \
          for (int e = 0; e < 8; ++e) y[e] = (y[e] * rstd * lg[e] + lb[e] + bon * vv[e]) * g8[e]; \
          ypend.x = pk2(y[0], y[1]); ypend.y = pk2(y[2], y[3]); ypend.z = pk2(y[4], y[5]); ypend.w = pk2(y[6], y[7]); ypoff = (TT_) * RWW + colh; }
    ZLOAD(0);
    v4u ypend = {0u, 0u, 0u, 0u}; size_t ypoff = 0;
    for (int c = 0; c < SEQ / 64; ++c) {
        asm volatile("" : "+v"(fr), "+v"(fq), "+v"(pt), "+v"(j0));
        const int s = c * 64 + pt; const size_t t = (size_t)b * SEQ + s; const bool hasp = s > 0;
        if (c > 0) { ESTAGE(((c - 1) & 1) ? BUF(I_VT2) : BUF(I_VT), t - 64) }
        { float v[8];
          shift8(zc[0], zq[0], hasp, CST + 0 * 64 + j0, v); st8bf(BUF(I_RT) + SW(pt, j0), v);
          shift8(zc[1], zq[1], hasp, CST + 1 * 64 + j0, v); st8bf(BUF(I_KT) + SW(pt, j0), v);
          { float kkc[8], ss = 0.f; ld8f(CST + 9 * 64 + j0, kkc);
#pragma unroll
            for (int e = 0; e < 8; ++e) { const float q = v[e] * kkc[e]; ss += q * q; }
            ss = red8(ss); if (j0 == 0) SSQ[pt] = rsqrtf(fmaxf(ss, 1e-24f)); }
          shift8(zc[2], zq[2], hasp, CST + 2 * 64 + j0, v); st8bf(((c & 1) ? BUF(I_VT2) : BUF(I_VT)) + SW(pt, j0), v);
          *(v4u*)(ACTW + SW(pt, j0)) = za[0]; *(v4u*)(ACTA + SW(pt, j0)) = za[1]; *(v4u*)(ACTG + SWG(pt, j0)) = za[2]; *(v4u*)(ACTG + SWG(pt, 64 + j0)) = za[3]; }
        LBAR();
        f32x4 aw[2], aa[2], ag[2];
#pragma unroll
        for (int nt = 0; nt < 2; ++nt) { const int tr = 16 * (2 * nh + nt) + fr; const f32x4 zero = {0.f, 0.f, 0.f, 0.f};
            aw[nt] = __builtin_amdgcn_mfma_f32_16x16x32_bf16(fw[0], ldfrag(ACTW, tr, 8 * fq), zero, 0, 0, 0); aw[nt] = __builtin_amdgcn_mfma_f32_16x16x32_bf16(fw[1], ldfrag(ACTW, tr, 8 * fq + 32), aw[nt], 0, 0, 0);
            aa[nt] = __builtin_amdgcn_mfma_f32_16x16x32_bf16(fa[0], ldfrag(ACTA, tr, 8 * fq), zero, 0, 0, 0); aa[nt] = __builtin_amdgcn_mfma_f32_16x16x32_bf16(fa[1], ldfrag(ACTA, tr, 8 * fq + 32), aa[nt], 0, 0, 0);
            ag[nt] = zero;
#pragma unroll
            for (int ks = 0; ks < 4; ++ks) ag[nt] = __builtin_amdgcn_mfma_f32_16x16x32_bf16(fg[ks], *(const bf16x8*)(ACTG + SWG(tr, 8 * fq + 32 * ks)), ag[nt], 0, 0, 0); }
#pragma unroll
        for (int nt = 0; nt < 2; ++nt) { const int tr = 16 * (2 * nh + nt) + fr, jc = 16 * mt + 4 * fq;
            *(f32x4*)(LWR + SWF(tr, jc)) = aw[nt]; *(f32x4*)(LAR + SWF(tr, jc)) = aa[nt]; *(f32x4*)(LGR + SWF(tr, jc)) = ag[nt]; }
        LBAR();
        float lwv[8], an[8], bb[8], k2[8], rr[8], gg[8], vv8[8], p8[8];
        { const int j = lane, tw = wid;
          const float w0c = CST[7 * 64 + j], a0c = CST[8 * 64 + j], kkc = CST[9 * 64 + j], kac = CST[10 * 64 + j], rkc = CST[11 * 64 + j];
          const unsigned char* vtb = (c & 1) ? BUF(I_VT2) : BUF(I_VT);
          float bo[8], av[8];
#pragma unroll
          for (int u = 0; u < 8; ++u) { const int t8 = 8 * tw + u;
              const float lw = *(const float*)(LWR + SWF(t8, j)), la = *(const float*)(LAR + SWF(t8, j)); gg[u] = *(const float*)(LGR + SWF(t8, j));
              rr[u] = bflo(*(const unsigned short*)(BUF(I_RT) + SW(t8, j))); const float kx = bflo(*(const unsigned short*)(BUF(I_KT) + SW(t8, j))); vv8[u] = bflo(*(const unsigned short*)(vtb + SW(t8, j)));
              lwv[u] = -0.606531f * sigm(w0c + lw); av[u] = sigm(a0c + la);
              const float kn = kx * kkc * SSQ[t8]; an[u] = -kn; bb[u] = kn * av[u];
              k2[u] = kx * (1.0f + (av[u] - 1.0f) * kac); bo[u] = rr[u] * k2[u] * rkc; }
          wave_sum8(bo);
          if (j == 0) {
#pragma unroll
              for (int u = 0; u < 8; ++u) BON[8 * tw + u] = bo[u]; }
          p8[0] = lwv[0];
#pragma unroll
          for (int u = 1; u < 8; ++u) p8[u] = p8[u - 1] + lwv[u];
          SEGT[tw * 64 + j] = p8[7]; }
        LBAR();
        { const int j = lane, tw = wid; float sg8[8];
#pragma unroll
          for (int s2 = 0; s2 < 8; ++s2) sg8[s2] = SEGT[s2 * 64 + j];
          float base = 0.f, tot = 0.f;
#pragma unroll
          for (int s2 = 0; s2 < 8; ++s2) { tot += sg8[s2]; base += (s2 < tw) ? sg8[s2] : 0.f; }
          const float gcj = __expf(tot); if (tw == 7) GC[j] = gcj;
          float eprev = __expf(base);
          float o0[8], o1[8], o2[8], o3[8], ob[8], ok[8];
#pragma unroll
          for (int u = 0; u < 8; ++u) { const float L = p8[u] + base; const float e1 = __expf(L), ie1 = __builtin_amdgcn_rcpf(e1), ep = eprev, eh = gcj * ie1; eprev = e1;
              o0[u] = an[u] * ep; o1[u] = bb[u] * ie1; o2[u] = k2[u] * ie1; o3[u] = rr[u] * e1; ob[u] = bb[u] * eh; ok[u] = k2[u] * eh;
              *(unsigned short*)(BUF(I_GATE) + SW(8 * tw + u, j)) = (unsigned short)f2bf(gg[u]); }
          st8bf(BUF(I_AJ) + SW(j, 8 * tw), o0); st8bf(BUF(I_BT) + SW(j, 8 * tw), o1); st8bf(BUF(I_KT) + SW(j, 8 * tw), o2); st8bf(BUF(I_RT) + SW(j, 8 * tw), o3);
          st8bf(BUF(I_BHJ) + SW(j, 8 * tw), ob); st8bf(BUF(I_KHJ) + SW(j, 8 * tw), ok); st8bf(BUF(I_VJ) + SW(j, 8 * tw), vv8); }
        if (c > 0) *(v4u*)(ya + ypoff) = ypend;
        if (c + 1 < SEQ / 64) ZLOAD(c + 1);
        LBAR();
#define MASK(acc, cond) _Pragma("unroll") for (int nt = 0; nt < 2; ++nt) _Pragma("unroll") for (int r = 0; r < 4; ++r) { const int m_ = 16 * mt + 4 * fq + r, n_ = 16 * (2 * nh + nt) + fr; if (!(cond)) acc[nt][r] = 0.f; }
        { const f32x4 zero = {0.f, 0.f, 0.f, 0.f}; f32x4 aL[2] = {zero, zero}, aL2[2] = {zero, zero}, aK[2] = {zero, zero}, aR[2] = {zero, zero};
          const FA fAT = ldAT(BUF(I_AJ), mt, fr, fq), fBTa = ldAT(BUF(I_BT), mt, fr, fq); const FB fBT = ldBT(BUF(I_BT), nh, fr, fq), fKT = ldBT(BUF(I_KT), nh, fr, fq), fRT = ldBT(BUF(I_RT), nh, fr, fq), fATb = ldBT(BUF(I_AJ), nh, fr, fq);
          mma(aL, fAT, fBT);
          mma(aL2, fBTa, fATb);
          mma(aK, fAT, fKT);
          mma(aR, fBTa, fRT);
          MASK(aL, m_ > n_) MASK(aL2, n_ > m_) MASK(aK, n_ < m_) MASK(aR, m_ <= n_)
#pragma unroll
          for (int nt = 0; nt < 2; ++nt)
#pragma unroll
              for (int r = 0; r < 4; ++r) { const int m_ = 16 * mt + 4 * fq + r, n_ = 16 * (2 * nh + nt) + fr; if (m_ == n_) aL2[nt][r] = 1.0f; }
          storeT(BUF(I_L), aL, mt, nh, fr, fq); storeT(BUF(I_R0), aL2, mt, nh, fr, fq);
          storeT(BUF(aki), aK, mt, nh, fr, fq);
          storeT(BUF(I_ABRT), aR, mt, nh, fr, fq); }
        LBAR();
#pragma unroll
        for (int k = 1; k <= 6; ++k) {
            unsigned char* Pc = (k & 1) ? BUF(I_L) : BUF(I_AT); unsigned char* Pn = (k & 1) ? BUF(I_AT) : BUF(I_L);
            unsigned char* Rc = (k & 1) ? BUF(I_R1) : BUF(I_R0); unsigned char* Rn = (k & 1) ? BUF(I_R0) : BUF(I_R1);
            const f32x4 zero = {0.f, 0.f, 0.f, 0.f}; f32x4 aP[2] = {zero, zero}, aRr[2] = {zero, zero};
            FA fP, fPTa; FB fPT, fR;
            if (k <= 5) { fP = ldAT(Pc, mt, fr, fq); fPT = ldB(Pc, nh, fr, fq); }
            if (k >= 2) { fPTa = ldA(Pc, mt, fr, fq); fR = ldB(Rc, nh, fr, fq); ldC(aRr, Rc, mt, nh, fr, fq); }
            if (k <= 5) mma(aP, fP, fPT);
            if (k >= 2) mma(aRr, fPTa, fR);
            if (k <= 5) storeT(Pn, aP, mt, nh, fr, fq);
            if (k >= 2) storeT(Rn, aRr, mt, nh, fr, fq);
            LBAR();
        }
        { const f32x4 zero = {0.f, 0.f, 0.f, 0.f}; f32x4 a1[2] = {zero, zero}, a2[2] = {zero, zero};
          const FA fTT = ldA(BUF(I_R1), mt, fr, fq); const FB fAJ = ldB(BUF(I_AJ), nh, fr, fq), fAK = ldB(BUF(aki), nh, fr, fq);
          mma(a1, fTT, fAJ); mma(a2, fTT, fAK);
          storeT(BUF(I_L), a1, mt, nh, fr, fq);
          storeT(BUF(I_LT), a2, mt, nh, fr, fq); }
        LBAR();
        { const f32x4 zero = {0.f, 0.f, 0.f, 0.f}; f32x4 aMY[2], aNY[2] = {zero, zero}, aMS[2] = {zero, zero}, aNS[2];
          const FA fG1 = ldA(BUF(I_L), mt, fr, fq), fG2 = ldA(BUF(I_LT), mt, fr, fq), fKTa = ldAT(BUF(I_KT), mt, fr, fq);
          const FB fAB = ldB(BUF(I_ABRT), nh, fr, fq), fRT = ldBT(BUF(I_RT), nh, fr, fq), fBH = ldB(BUF(I_BHJ), nh, fr, fq);
#pragma unroll
          for (int nt = 0; nt < 2; ++nt)
#pragma unroll
              for (int r = 0; r < 4; ++r) aMY[nt][r] = bflo(*(const unsigned short*)(BUF(I_RT) + SW(16 * mt + 4 * fq + r, 16 * (2 * nh + nt) + fr)));
          ldC(aNS, BUF(I_KHJ), mt, nh, fr, fq);
          mma(aNY, fKTa, fRT);
          mma(aMY, fG1, fAB);
          mma(aMS, fG1, fBH);
          mma(aNS, fG2, fBH);
          MASK(aNY, m_ <= n_)
          mma(aNY, fG2, fAB);
#pragma unroll
          for (int nt = 0; nt < 2; ++nt)
#pragma unroll
              for (int r = 0; r < 4; ++r) { const int m_ = 16 * mt + 4 * fq + r, n_ = 16 * (2 * nh + nt) + fr; if (m_ == n_) aMS[nt][r] += GC[m_]; }
          storeT(BUF(I_AT), aMY, mt, nh, fr, fq); storeT(BUF(I_BT), aNY, mt, nh, fr, fq); storeT(BUF(I_AJ), aMS, mt, nh, fr, fq); storeT(BUF(I_R0), aNS, mt, nh, fr, fq); }
        LBAR();
        { const f32x4 zero = {0.f, 0.f, 0.f, 0.f}; f32x4 aY[2] = {zero, zero}, aS[2] = {zero, zero};
          const FA fS0a = ldA(BUF(s0i), mt, fr, fq), fVJa = ldA(BUF(I_VJ), mt, fr, fq), fMS = ldA(BUF(I_AJ), mt, fr, fq), fNS = ldA(BUF(I_R0), mt, fr, fq);
          const FB fMY = ldB(BUF(I_AT), nh, fr, fq), fNY = ldB(BUF(I_BT), nh, fr, fq), fS0 = ldB(BUF(s0i), nh, fr, fq), fVJ = ldB(BUF(I_VJ), nh, fr, fq);
          mma(aY, fS0a, fMY); mma(aS, fMS, fS0); mma(aY, fVJa, fNY); mma(aS, fNS, fVJ);
#pragma unroll
          for (int nt = 0; nt < 2; ++nt) *(f32x4*)(YTF + SWF(16 * (2 * nh + nt) + fr, 16 * mt + 4 * fq)) = aY[nt];
          storeT(BUF(aki), aS, mt, nh, fr, fq); }
        LBAR();
#undef MASK
        { const int tmp = s0i; s0i = aki; aki = tmp; }
    }
    { const int c = SEQ / 64; const size_t tprev = (size_t)b * SEQ + (c - 1) * 64 + pt; ESTAGE(((c - 1) & 1) ? BUF(I_VT2) : BUF(I_VT), tprev) }
    *(v4u*)(ya + ypoff) = ypend;
    LBAR();
#undef ESTAGE
#undef BUF
#undef ZLOAD
}
#undef LBAR
}

__device__ __forceinline__ void p_norm2_route(const PArgs& a, unsigned char* lds, int wv) {
    typedef short bf16x8 __attribute__((ext_vector_type(8)));
    const int tid = mktid(wv), lane = tid & 63, fr = lane & 15, fq = lane >> 4;
    const bf16* x1 = (const bf16*)(a.ws + WS_X1B); const float* mod = (const float*)(a.ws + WS_MOD); const float* gm2 = (const float*)(a.ws + WS_GM2); const float* cbt = (const float*)(a.ws + WS_CB);
    int* rte = (int*)(a.ws + WS_RTE); float* rtw = (float*)(a.ws + WS_RTW); int* rnk = (int*)(a.ws + WS_RNK); unsigned* cnt = (unsigned*)(a.ws + WS_CTL) + CW_CNT;
    float* PL = (float*)lds;
    float* PS = PL + 8 * 32 * 48;
    float* RS_ = PS + 8 * 32;
    float* FL = RS_ + 32;
    unsigned* HIST = (unsigned*)(FL + 32 * 48);
    unsigned* LRK = HIST + 32;
    if (tid < 32) HIST[tid] = 0u;
    __syncthreads();
    int gcount = 0;
    bf16x8 wh[4][3], wl[4][3];
    { const bf16* wrh = (const bf16*)(a.ws + WS_WRH) + fr * 1024 + 128 * wv + 8 * fq; const bf16* wrl = (const bf16*)(a.ws + WS_WRL) + fr * 1024 + 128 * wv + 8 * fq;
#pragma unroll
      for (int ks = 0; ks < 4; ++ks)
#pragma unroll
          for (int nt = 0; nt < 3; ++nt) { wh[ks][nt] = *(const bf16x8*)(wrh + nt * 16 * 1024 + 32 * ks); wl[ks][nt] = *(const bf16x8*)(wrl + nt * 16 * 1024 + 32 * ks); } }
    for (int grp = blockIdx.x; grp < NT / 32; grp += gridDim.x) {
        const int row0 = grp * 32, b = row0 >> 11;
        f32x4 acc[3][2];
#pragma unroll
        for (int nt = 0; nt < 3; ++nt) { acc[nt][0] = (f32x4){0.f, 0.f, 0.f, 0.f}; acc[nt][1] = acc[nt][0]; }
        float ssq[2] = {0.f, 0.f};
#pragma unroll
        for (int rt = 0; rt < 2; ++rt) {
            float xs[4][8];
#pragma unroll
            for (int ks = 0; ks < 4; ++ks) rw::ld8bf((const unsigned char*)(x1 + (size_t)(row0 + 16 * rt + fr) * DM + 128 * wv + 32 * ks + 8 * fq), xs[ks]);
#pragma unroll
            for (int ks = 0; ks < 4; ++ks) { float gm[8]; rw::ld8f(gm2 + b * 1024 + 128 * wv + 32 * ks + 8 * fq, gm); unsigned hw[4], lw[4];
#pragma unroll
                for (int e = 0; e < 4; ++e) { const float x0 = xs[ks][2 * e], x1v = xs[ks][2 * e + 1]; ssq[rt] += x0 * x0 + x1v * x1v; const float g0 = x0 * gm[2 * e], g1 = x1v * gm[2 * e + 1];
                    hw[e] = pk2(g0, g1); lw[e] = pk2(g0 - bflo(hw[e]), g1 - bfhi(hw[e])); }
                const v4u hv = {hw[0], hw[1], hw[2], hw[3]}, lv = {lw[0], lw[1], lw[2], lw[3]}; const bf16x8 bh = __builtin_bit_cast(bf16x8, hv), bl = __builtin_bit_cast(bf16x8, lv);
#pragma unroll
                for (int nt = 0; nt < 3; ++nt) { acc[nt][rt] = __builtin_amdgcn_mfma_f32_16x16x32_bf16(wh[ks][nt], bh, acc[nt][rt], 0, 0, 0); acc[nt][rt] = __builtin_amdgcn_mfma_f32_16x16x32_bf16(wl[ks][nt], bh, acc[nt][rt], 0, 0, 0);
                    acc[nt][rt] = __builtin_amdgcn_mfma_f32_16x16x32_bf16(wh[ks][nt], bl, acc[nt][rt], 0, 0, 0); } } }
#pragma unroll
        for (int rt = 0; rt < 2; ++rt) {
#pragma unroll
            for (int nt = 0; nt < 3; ++nt) *(f32x4*)(PL + (wv * 32 + 16 * rt + fr) * 48 + 16 * nt + 4 * fq) = acc[nt][rt];
            float s = ssq[rt]; s += __builtin_bit_cast(float, __builtin_amdgcn_ds_swizzle(__builtin_bit_cast(int, s), 0x401F));
            { const unsigned u = __builtin_bit_cast(unsigned, s); auto rr = __builtin_amdgcn_permlane32_swap(u, u, false, false); s = __builtin_bit_cast(float, (unsigned)rr[0]) + __builtin_bit_cast(float, (unsigned)rr[1]); }
            if (fq == 0) PS[wv * 32 + 16 * rt + fr] = s; }
        __syncthreads();
        { const int r = tid >> 4, c = tid & 15; float s0 = 0.f, s1 = 0.f, s2 = 0.f, sq = 0.f;
#pragma unroll
          for (int w = 0; w < 8; ++w) { const float* p = PL + (w * 32 + r) * 48; s0 += p[c]; s1 += p[c + 16]; s2 += p[c + 32]; sq += PS[w * 32 + r]; }
          const float rstd = rsqrtf(sq * (1.0f / DM) + 1e-6f); const float* cb = cbt + b * 48;
          FL[r * 48 + c] = rstd * s0 + cb[c]; FL[r * 48 + c + 16] = rstd * s1 + cb[c + 16]; FL[r * 48 + c + 32] = rstd * s2 + cb[c + 32];
          if (c == 0) ((float*)(a.ws + WS_RSTD))[row0 + r] = rstd; }
        __syncthreads();
        if (tid < 32) { const int m = row0 + tid; const float* lg = FL + tid * 48;
            int gi = 0; float gm = lg[0];
#pragma unroll
            for (int i = 1; i < 4; ++i) if (lg[i] > gm) { gm = lg[i]; gi = i; }
            float gs = 0.f;
#pragma unroll
            for (int i = 0; i < 4; ++i) gs += __expf(lg[i] - gm);
            const float pg = 1.0f / gs;
            float el[8];
#pragma unroll
            for (int k = 0; k < 8; ++k) el[k] = lg[4 + gi * 8 + k];
            int e1 = 0; float m1 = el[0];
#pragma unroll
            for (int k = 1; k < 8; ++k) if (el[k] > m1) { m1 = el[k]; e1 = k; }
            int e2 = -1; float m2 = -INFINITY;
#pragma unroll
            for (int k = 0; k < 8; ++k) if (k != e1 && el[k] > m2) { m2 = el[k]; e2 = k; }
            const float q2 = __expf(m2 - m1); const float w1 = pg / (1.0f + q2), w2 = pg * q2 / (1.0f + q2);
            const int ea = gi * 8 + e1, eb = gi * 8 + e2; rte[2 * m] = ea; rte[2 * m + 1] = eb; rtw[2 * m] = w1; rtw[2 * m + 1] = w2;
            LRK[gcount * 64 + 2 * tid] = atomicAdd(HIST + ea, 1u) | ((unsigned)ea << 24); LRK[gcount * 64 + 2 * tid + 1] = atomicAdd(HIST + eb, 1u) | ((unsigned)eb << 24); }
        ++gcount;
        __syncthreads();
    }
    if (tid < 32) { const unsigned n = HIST[tid]; HIST[tid] = n ? atomicAdd(cnt + tid * CNT_PAD, n) : 0u; }
    __syncthreads();
    for (int i = tid; i < gcount * 64; i += 512) { const int gi_ = i >> 6, e = i & 63; const int m2 = 2 * ((blockIdx.x + gi_ * gridDim.x) * 32) + e; const unsigned lr = LRK[i]; rnk[m2] = (int)(HIST[lr >> 24] + (lr & 0xffffffu)); }
    __syncthreads();
}
__device__ __forceinline__ void p_moe_gather(const PArgs& a, unsigned char* lds, int wv) {
    int* off = (int*)lds;
    const int tid = mktid(wv), lane = tid & 63, gw = blockIdx.x * 8 + (tid >> 6), NGW = gridDim.x * 8;
    int* ctl = (int*)(a.ws + WS_CTL); const unsigned* cnt = (const unsigned*)ctl + CW_CNT;
    if (tid == 0) { int o = 0, nt = 0;
        for (int e = 0; e < NEXP; ++e) { off[e] = o; const int tiles = ((int)cnt[e * CNT_PAD] + 255) >> 8;
            if (blockIdx.x == 0) for (int i = 0; i < tiles; ++i) ctl[CW_TEXP + nt + i] = e;
            nt += tiles; o += tiles * 256; }
        if (blockIdx.x == 0) ctl[CW_NT] = nt; }
    __syncthreads();
    const int* rte = (const int*)(a.ws + WS_RTE); const int* rnk = (const int*)(a.ws + WS_RNK); int* pos = (int*)(a.ws + WS_POS);
    const bf16* x1 = (const bf16*)(a.ws + WS_X1B); bf16* xs = (bf16*)(a.ws + WS_XS); const float* rstdv = (const float*)(a.ws + WS_RSTD);
    const float* mod = (const float*)(a.ws + WS_MOD); const float* gm2 = (const float*)(a.ws + WS_GM2);
    for (int t = gw; t < NT; t += NGW) { const int b = t >> 11; const int p0 = off[rte[2 * t]] + rnk[2 * t], p1 = off[rte[2 * t + 1]] + rnk[2 * t + 1]; if (lane == 0) { pos[2 * t] = p0; pos[2 * t + 1] = p1; }
        const float rstd = rstdv[t];
#pragma unroll
        for (int hf = 0; hf < 2; ++hf) { const int col = 8 * lane + 512 * hf; float xv[8], gm[8], sh[8], o[8];
            rw::ld8bf((const unsigned char*)(x1 + (size_t)t * DM + col), xv); rw::ld8f(gm2 + b * 1024 + col, gm); rw::ld8f(mod + b * 6144 + 3072 + col, sh);
#pragma unroll
            for (int e = 0; e < 8; ++e) o[e] = xv[e] * gm[e] * rstd + sh[e];
            v4u w; w.x = pk2(o[0], o[1]); w.y = pk2(o[2], o[3]); w.z = pk2(o[4], o[5]); w.w = pk2(o[6], o[7]);
            *(v4u*)(xs + (size_t)p0 * DM + col) = w; *(v4u*)(xs + (size_t)p1 * DM + col) = w; } }
}
__device__ __forceinline__ void p_combine(const PArgs& a, unsigned char* lds, int wv) {
    const int tid = mktid(wv), lane = tid & 63, gw = blockIdx.x * 8 + (tid >> 6), NGW = gridDim.x * 8;
    const float* mod = (const float*)(a.ws + WS_MOD); const int* pos = (const int*)(a.ws + WS_POS); const float* rtw = (const float*)(a.ws + WS_RTW);
    const bf16* ys = (const bf16*)(a.ws + WS_XS); float* out = a.out;
    for (int m = gw; m < NT; m += NGW) { const int b = m >> 11; const int p0 = pos[2 * m], p1 = pos[2 * m + 1]; const float w0 = rtw[2 * m], w1 = rtw[2 * m + 1];
        f32x4* o = (f32x4*)(out + (size_t)m * DM) + lane; const v2u* xb = (const v2u*)((const bf16*)(a.ws + WS_X1B) + (size_t)m * DM) + lane; const v2u* y0 = (const v2u*)(ys + (size_t)p0 * DM) + lane; const v2u* y1 = (const v2u*)(ys + (size_t)p1 * DM) + lane;
#pragma unroll
        for (int j = 0; j < 4; ++j) { const int col = 4 * (lane + 64 * j); const f32x4 g2 = *(const f32x4*)(mod + b * 6144 + 5120 + col); const v2u a0 = y0[64 * j], a1 = y1[64 * j];
            const f32x4 e0 = {bflo(a0.x), bfhi(a0.x), bflo(a0.y), bfhi(a0.y)}, e1 = {bflo(a1.x), bfhi(a1.x), bflo(a1.y), bfhi(a1.y)};
            const v2u xw = xb[64 * j]; const f32x4 xv = {bflo(xw.x), bfhi(xw.x), bflo(xw.y), bfhi(xw.y)};
            o[64 * j] = xv + g2 * (e0 * w0 + e1 * w1); } }
}

#define XB_TMO      128
#define XB_XCNT(j)  (256  + 64 * (j))
#define XB_XSUB(j)  (1280 + 64 * (j))
#define XB_XGEN(j)  (2304 + 64 * (j))
#define XB_TOP      3328
#define XB_TOPGEN   3392
#define XCD_BAR_WORDS 3456
#define XB_SPIN_CAP (1u << 22)

__device__ __forceinline__ unsigned xb_ld(unsigned* p)              { return __hip_atomic_load(p, __ATOMIC_RELAXED, __HIP_MEMORY_SCOPE_AGENT); }
__device__ __forceinline__ unsigned xb_add(unsigned* p, unsigned v) { return __hip_atomic_fetch_add(p, v, __ATOMIC_RELAXED, __HIP_MEMORY_SCOPE_AGENT); }
__device__ __forceinline__ unsigned xb_xcc_id() { return (unsigned)__builtin_amdgcn_s_getreg((3 << 11) | 20) & 0xFu; }
#define XB_SPIN(cond, bar) do { unsigned _sp = 0; while (cond) { __builtin_amdgcn_s_sleep(1); \
    if ((++_sp & 255u) == 0u) { if (xb_ld(&(bar)[XB_TMO])) break; if (_sp > XB_SPIN_CAP) { atomicAdd(&(bar)[XB_TMO], 1u); break; } } } } while (0)

struct XcdBarrier {
    unsigned* bar; unsigned x;
    volatile LAS unsigned* st;
};

__device__ __forceinline__ XcdBarrier xcd_barrier_post(unsigned* bar, volatile LAS unsigned* st, int wv) {
    XcdBarrier b; b.bar = bar; b.x = xb_xcc_id(); b.st = st;
    if (mktid(wv) == 0) (void)xb_add(&bar[XB_XCNT(b.x)], 1u);
    return b;
}
__device__ __forceinline__ void xcd_barrier_complete(unsigned* bar, unsigned x, unsigned& nloc, unsigned& nx) {
    const unsigned G = gridDim.x * gridDim.y * gridDim.z;
    unsigned sum, cnt, mine, sp = 0u;
    for (;;) {
        sum = 0u; cnt = 0u; mine = 0u;
#pragma unroll
        for (unsigned j = 0; j < 16; ++j) { const unsigned c = xb_ld(&bar[XB_XCNT(j)]); sum += c; cnt += (c > 0u) ? 1u : 0u; mine = (j == x) ? c : mine; }
        if (sum == G) break;
        __builtin_amdgcn_s_sleep(1);
        if ((++sp & 255u) == 0u) { if (xb_ld(&bar[XB_TMO])) break; if (sp > XB_SPIN_CAP) { atomicAdd(&bar[XB_TMO], 1u); break; } }
    }
    nloc = mine > 0u ? mine : 1u; nx = cnt > 0u ? cnt : 1u;
}

__device__ __forceinline__ void xcd_barrier(const XcdBarrier& b, int wv) {
    asm volatile("s_waitcnt vmcnt(0)" ::: "memory");
    __syncthreads();
    if (mktid(wv) == 0) {
        unsigned* bar = b.bar;
        __builtin_amdgcn_s_waitcnt(0);
        unsigned nloc = b.st[0], nx = b.st[1];
        if (nloc == 0u) { xcd_barrier_complete(bar, b.x, nloc, nx); b.st[0] = nloc; b.st[1] = nx; }
        const unsigned old = xb_add(&bar[XB_XSUB(b.x)], 1u);
        const unsigned gen = old / nloc;
        if (old + 1u == (gen + 1u) * nloc) {
            __builtin_amdgcn_fence(__ATOMIC_RELEASE, "agent");
            asm volatile("s_waitcnt vmcnt(0)" ::: "memory");
            const unsigned og = xb_add(&bar[XB_TOP], 1u);
            const unsigned tg = og / nx;
            if (og + 1u == (tg + 1u) * nx) xb_add(&bar[XB_TOPGEN], 1u);
            else XB_SPIN(xb_ld(&bar[XB_TOPGEN]) == tg, bar);
            __builtin_amdgcn_fence(__ATOMIC_ACQUIRE, "agent");
            xb_add(&bar[XB_XGEN(b.x)], 1u);
            asm volatile("s_waitcnt vmcnt(0)" ::: "memory");
        } else {
            XB_SPIN(xb_ld(&bar[XB_XGEN(b.x)]) == gen, bar);
            __builtin_amdgcn_fence(__ATOMIC_ACQUIRE, "agent");
            asm volatile("s_waitcnt vmcnt(0)" ::: "memory");
        }
    }
    __syncthreads();
}

constexpr int LDS_BYTES = 160 * 1024, MISC_OFF = LDS_BYTES - 256;
static_assert(rw::LDS_NEED <= MISC_OFF, "scan LDS");
constexpr int CW_BAR = 4096;

__global__ void __launch_bounds__(512, 2) mega_fwd(PArgs a) {
    extern __shared__ __attribute__((aligned(16))) unsigned char lds[];
    volatile LAS unsigned* MISC = (volatile LAS unsigned*)((LAS unsigned char*)lds + MISC_OFF);
    const int wv = __builtin_amdgcn_readfirstlane((int)threadIdx.x >> 6);
    { const int t0 = mktid(wv); if (t0 < 64) MISC[t0] = 0u; }
    __syncthreads();
    XcdBarrier bar = xcd_barrier_post((unsigned*)(a.ws + WS_CTL) + CW_BAR, MISC + 8, wv);
    GemmArgs g; g.ws = a.ws; g.x = a.in[0]; g.out = a.out; g.qg = a.in[18]; g.kg = a.in[19];
    const int G = (int)gridDim.x, bx = (int)blockIdx.x;

    p_prep_weights(a, lds, wv); __syncthreads(); p_ada(a, lds, wv);
    xcd_barrier(bar, wv);
    p_norm1(a, lds, wv);
    xcd_barrier(bar, wv);
    p_gemm_in(g, lds, wv);
    xcd_barrier(bar, wv);
    p_actprep(a, lds, wv);
    xcd_barrier(bar, wv);
    { const int nscan = G / 2;
      if (bx < nscan) { for (int bh = bx; bh < 128; bh += nscan) rw::scan_unit(a, lds, bh, wv); }
      else p_attn(a, lds, bx - nscan, G - nscan, wv); }
    __syncthreads(); p_prep_experts_dyn(a, lds, wv);
    xcd_barrier(bar, wv);
    p_gemm_merge(g, lds, wv);
    xcd_barrier(bar, wv);
    p_gemm_out(g, lds, wv);
    xcd_barrier(bar, wv);
    p_norm2_route(a, lds, wv);
    xcd_barrier(bar, wv);
    p_moe_gather(a, lds, wv);
    xcd_barrier(bar, wv);
    p_gemm_up(g, lds, wv);
    xcd_barrier(bar, wv);
    p_gemm_down(g, lds, wv);
    xcd_barrier(bar, wv);
    p_combine(a, lds, wv);
}

extern "C" void kernel_launch(void* const* d_in, const int* in_sizes, int n_in, void* d_out, int out_size, void* d_ws, size_t ws_size, hipStream_t stream) {
    static int grid = 0;
    if (grid == 0) {
        if (n_in != 30 || out_size != NT * DM || ws_size < WS_END) { fprintf(stderr, "kernel_launch: unexpected shapes (n_in %d, out %d, ws %zu)\n", n_in, out_size, ws_size); grid = -1; return; }
        int dev = 0, cus = 0, per_cu = 0;
        if (hipGetDevice(&dev) != hipSuccess || hipDeviceGetAttribute(&cus, hipDeviceAttributeMultiprocessorCount, dev) != hipSuccess) { grid = -1; return; }
        if (hipFuncSetAttribute((const void*)mega_fwd, hipFuncAttributeMaxDynamicSharedMemorySize, LDS_BYTES) != hipSuccess) { fprintf(stderr, "kernel_launch: hipFuncSetAttribute failed\n"); grid = -1; return; }
        if (hipOccupancyMaxActiveBlocksPerMultiprocessor(&per_cu, (const void*)mega_fwd, 512, LDS_BYTES) != hipSuccess || per_cu < 1) { fprintf(stderr, "kernel_launch: occupancy query says %d blocks per CU\n", per_cu); (void)hipGetLastError(); grid = -1; return; }
        grid = cus;
    }
    if (grid < 0) return;
    (void)hipMemsetAsync((char*)d_ws + WS_CTL, 0, 65536, stream);
    PArgs p{}; for (int i = 0; i < 30; ++i) p.in[i] = (const float*)d_in[i]; p.out = (float*)d_out; p.ws = (unsigned char*)d_ws;
    hipLaunchKernelGGL(mega_fwd, dim3(grid), dim3(512), LDS_BYTES, stream, p);
}
```

```cpp
#include <hip/hip_runtime.h>
#include <cstdio>
#include <cstdint>
__device__ __forceinline__ int mktid(int wv) { int l; asm volatile("v_mbcnt_lo_u32_b32 %0, -1, 0\n\tv_mbcnt_hi_u32_b32 %0, -1, %0" : "=v"(l)); return (wv << 6) | l; }
template <int CTRL> __device__ __forceinline__ float dppf(float v) { return __builtin_bit_cast(float, __builtin_amdgcn_update_dpp(0, __builtin_bit_cast(int, v), CTRL, 0xF, 0xF, true)); }
__device__ __forceinline__ float red4(float v) { v += dppf<0xB1>(v); v += dppf<0x4E>(v); return v; }
__device__ __forceinline__ float red8(float v) { v = red4(v); v += dppf<0x141>(v); return v; }
__device__ __forceinline__ float red16(float v) { v = red8(v); v += dppf<0x140>(v); return v; }
__device__ __forceinline__ float wave_sum(float v) { v = red16(v);
    v += __builtin_bit_cast(float, __builtin_amdgcn_ds_swizzle(__builtin_bit_cast(int, v), 0x401F));
    const unsigned u = __builtin_bit_cast(unsigned, v); auto rr = __builtin_amdgcn_permlane32_swap(u, u, false, false);
    return __builtin_bit_cast(float, (unsigned)rr[0]) + __builtin_bit_cast(float, (unsigned)rr[1]); }
__device__ __forceinline__ void wave_sum8(float (&v)[8]) {
#pragma unroll
    for (int i = 0; i < 8; ++i) v[i] += dppf<0xB1>(v[i]);
#pragma unroll
    for (int i = 0; i < 8; ++i) v[i] += dppf<0x4E>(v[i]);
#pragma unroll
    for (int i = 0; i < 8; ++i) v[i] += dppf<0x141>(v[i]);
#pragma unroll
    for (int i = 0; i < 8; ++i) v[i] += dppf<0x140>(v[i]);
#pragma unroll
    for (int i = 0; i < 8; ++i) v[i] += __builtin_bit_cast(float, __builtin_amdgcn_ds_swizzle(__builtin_bit_cast(int, v[i]), 0x401F));
#pragma unroll
    for (int i = 0; i < 8; ++i) { const unsigned u = __builtin_bit_cast(unsigned, v[i]); auto rr = __builtin_amdgcn_permlane32_swap(u, u, false, false); v[i] = __builtin_bit_cast(float, (unsigned)rr[0]) + __builtin_bit_cast(float, (unsigned)rr[1]); }
}
__device__ __forceinline__ float lane_get(float v, int src) { return __builtin_bit_cast(float, __builtin_amdgcn_ds_bpermute(src << 2, __builtin_bit_cast(int, v))); }
namespace pg8 {
#define PG8_LAS __attribute__((address_space(3)))
typedef unsigned short bf16_t;
typedef short bf16x8 __attribute__((ext_vector_type(8)));
typedef float f32x4 __attribute__((ext_vector_type(4)));
typedef unsigned u32x4 __attribute__((ext_vector_type(4)));
constexpr int BM = 256, BK = 64, HALF = 128, HTB = HALF * BK * 2  , STAGE_BYTES = 8 * HTB, NXCD = 8, WGM = 4;

__host__ __device__ __forceinline__ int lds_byte(int r, int c) { const int st = (r >> 4) * 2 + (c >> 5), rr = r & 15, cc = c & 31, ob = rr * 64 + cc * 2; return st * 1024 + (ob ^ (((ob >> 9) & 1) << 5)); }
__host__ __device__ __forceinline__ void stage_rc(int b, int& R, int& C) { const int st = b / 1024, sb = b % 1024, swz = sb ^ (((sb >> 9) & 1) << 5); R = (st >> 1) * 16 + swz / 64; C = (st & 1) * 32 + (swz % 64) / 2; }
__host__ __device__ __forceinline__ int perm32(int rho) { const int n = rho >> 4, i = rho & 15; return 8 * (i >> 2) + 4 * n + (i & 3); }
struct Unit { int pm, pn, aux; const char* a; const char* b; };
struct Gemm { int K; };

struct StaticOrder {
    int nM, nN, nwg, G, c; const char* A; const char* Bt; size_t tstep;
    __device__ void init(const void* A_, const void* Bt_, int M, int N, int K, int G_, int c_) { nM = M / BM; nN = N / BM; nwg = nM * nN; G = G_; c = c_; A = (const char*)A_; Bt = (const char*)Bt_; tstep = (size_t)BM * K * 2; }
    __device__ bool next(int i, Unit& u) const {
        const long L = (long)i * G + c; if (L >= nwg) return false;
        int wgid = (int)L; { const int q = nwg / NXCD, r = nwg % NXCD, xcd = wgid % NXCD, off = wgid / NXCD; wgid = (xcd < r ? xcd * (q + 1) : r * (q + 1) + (xcd - r) * q) + off; }
        const int nig = WGM * nN, gid = wgid / nig, fm = gid * WGM, gsz = (nM - fm) < WGM ? (nM - fm) : WGM;
        u.aux = 0; u.pm = fm + ((wgid % nig) % gsz); u.pn = (wgid % nig) / gsz; u.a = A + (size_t)u.pm * tstep; u.b = Bt + (size_t)u.pn * tstep; return true;
    }
    __device__ __forceinline__ void a_ready(const Unit&) const {}
    __device__ __forceinline__ void done(const Unit&) const {}
};
__device__ __forceinline__ unsigned cvt_pk_bf16(float lo, float hi) { unsigned r; asm volatile("v_cvt_pk_bf16_f32 %0, %1, %2" : "=v"(r) : "v"(lo), "v"(hi)); return r; }
template <class Epi, class Sched, bool ALIGN_EPI = false, bool SP2 = false>
__device__ __forceinline__ void gemm_phase(PG8_LAS unsigned char* lds, const Gemm g, const Sched& S, const Epi& E, int wv) {
    const int tid = mktid(wv), wid = __builtin_amdgcn_readfirstlane(tid >> 6), lane = tid & 63, wr = wid >> 2, wc = wid & 3, fr = lane & 15, fq = lane >> 4;
    const int K = g.K, nt = K / BK;
    unsigned voffA[2], voffB[2];
#pragma unroll
    for (int i = 0; i < 2; ++i) { int R, C; stage_rc(tid * 16 + i * 8192, R, C); const int Rb = Epi::PERM ? ((R & ~31) + perm32(R & 31)) : R;
        voffA[i] = (unsigned)(R * K + C) * 2u; voffB[i] = (unsigned)(Rb * K + C) * 2u; }
    const size_t kstep = (size_t)(BK * 2);
    const size_t hstep = (size_t)HALF * K * 2;
        const unsigned ldsw = (unsigned)wid * 1024u;
    const int aoff = lds_byte(wr * 64 + fr, fq * 8), boff = lds_byte(wc * 32 + fr, fq * 8);
#define PG8_SA(b, h) (((b) * 2 + (h)) * HTB)
#define PG8_SB(b, h) ((4 + (b) * 2 + (h)) * HTB)
#define PG8_STAGE(bufoff, gbase, voff) do { _Pragma("unroll") for (int _i = 0; _i < 2; ++_i) \
        __builtin_amdgcn_global_load_lds((const unsigned*)((const char*)(gbase) + (voff)[_i]), (PG8_LAS unsigned*)(lds + (bufoff) + ldsw + _i * 8192), 16, 0, 0); } while (0)
#define PG8_LDA(dst, b, h) do { _Pragma("unroll") for (int m = 0; m < 4; ++m) _Pragma("unroll") for (int k = 0; k < 2; ++k) dst[m][k] = *(const PG8_LAS bf16x8*)(lds + PG8_SA(b, h) + aoff + m * 2048 + k * 1024); } while (0)
#define PG8_LDB(dst, b, h) do { _Pragma("unroll") for (int n = 0; n < 2; ++n) _Pragma("unroll") for (int k = 0; k < 2; ++k) dst[n][k] = *(const PG8_LAS bf16x8*)(lds + PG8_SB(b, h) + boff + n * 2048 + k * 1024); } while (0)
#define PG8_MMA(ai, bj, At, Bt) do { __builtin_amdgcn_s_setprio(1); _Pragma("unroll") for (int m = 0; m < 4; ++m) _Pragma("unroll") for (int n = 0; n < 2; ++n) _Pragma("unroll") for (int k = 0; k < 2; ++k) \
        acc[ai][bj][m][n] = __builtin_amdgcn_mfma_f32_16x16x32_bf16(Bt[n][k], At[m][k], acc[ai][bj][m][n], 0, 0, 0); __builtin_amdgcn_s_setprio(0); } while (0)
#define PG8_WAIT_V(n) asm volatile("s_waitcnt vmcnt(" #n ")" ::: "memory")
#define PG8_WAIT_L(n) asm volatile("s_waitcnt lgkmcnt(" #n ")" ::: "memory")
#define PG8_BAR __builtin_amdgcn_s_barrier()
#define PG8_SCHED __builtin_amdgcn_sched_barrier(0)
    Unit cur, nxt; int ui = 0;
    if (!S.next(0, cur)) return;
    f32x4 acc[2][2][4][2];
#pragma unroll
    for (int a = 0; a < 2; ++a)
#pragma unroll
        for (int b = 0; b < 2; ++b)
#pragma unroll
            for (int m = 0; m < 4; ++m)
#pragma unroll
                for (int n = 0; n < 2; ++n) acc[a][b][m][n] = (f32x4){0.f, 0.f, 0.f, 0.f};
    bf16x8 At[4][2], B0[2][2], B1[2][2];
    const char* cA = cur.a; const char* cB = cur.b;
    S.a_ready(cur);
    if constexpr (SP2) {
        PG8_STAGE(PG8_SB(0, 0), cB, voffB); PG8_STAGE(PG8_SB(0, 1), cB + hstep, voffB); PG8_STAGE(PG8_SA(0, 0), cA, voffA); PG8_STAGE(PG8_SA(0, 1), cA + hstep, voffA);
        if (wr == 1) PG8_BAR;
        PG8_WAIT_V(2); PG8_BAR;
        PG8_STAGE(PG8_SB(1, 0), cB + kstep, voffB); PG8_STAGE(PG8_SA(1, 0), cA + kstep, voffA); PG8_STAGE(PG8_SB(1, 1), cB + hstep + kstep, voffB);
        PG8_WAIT_V(6); PG8_BAR;
    } else {
        PG8_STAGE(PG8_SB(0, 0), cB, voffB); PG8_STAGE(PG8_SA(0, 0), cA, voffA); PG8_STAGE(PG8_SB(0, 1), cB + hstep, voffB); PG8_STAGE(PG8_SA(0, 1), cA + hstep, voffA);
        if (wr == 1) PG8_BAR;
        PG8_WAIT_V(4); PG8_BAR;
        PG8_STAGE(PG8_SB(1, 0), cB + kstep, voffB); PG8_STAGE(PG8_SA(1, 0), cA + kstep, voffA); PG8_STAGE(PG8_SB(1, 1), cB + hstep + kstep, voffB);
        PG8_WAIT_V(6); PG8_BAR;
    }
    for (;;) {
        const bool has_next = S.next(ui + 1, nxt);
        const char* nA = has_next ? nxt.a : cA; const char* nB = has_next ? nxt.b : cB;
        for (int t = 0; t < nt; t += 2) {
            const bool last = (t == nt - 2);
            const char* a1 = cA + (size_t)(t + 1) * kstep;
            const char* a2 = last ? nA : cA + (size_t)(t + 2) * kstep; const char* b2 = last ? nB : cB + (size_t)(t + 2) * kstep;
            const char* a3 = a2 + kstep; const char* b3 = b2 + kstep;
            if (last && has_next) S.a_ready(nxt);
            if constexpr (SP2) {
            PG8_LDB(B0, 0, 0); PG8_LDB(B1, 0, 1); PG8_SCHED; PG8_LDA(At, 0, 0); PG8_STAGE(PG8_SA(1, 1), a1 + hstep, voffA);
            PG8_WAIT_V(8); PG8_WAIT_L(0); PG8_BAR; PG8_MMA(0, 0, At, B0); PG8_MMA(0, 1, At, B1); PG8_BAR; PG8_SCHED;
            PG8_LDA(At, 0, 1); PG8_STAGE(PG8_SB(0, 0), b2, voffB); PG8_STAGE(PG8_SB(0, 1), b2 + hstep, voffB); PG8_STAGE(PG8_SA(0, 0), a2, voffA);
            PG8_WAIT_V(8); PG8_WAIT_L(0); PG8_BAR; PG8_MMA(1, 0, At, B0); PG8_MMA(1, 1, At, B1); PG8_BAR; PG8_SCHED;
            PG8_LDB(B0, 1, 0); PG8_LDB(B1, 1, 1); PG8_SCHED; PG8_LDA(At, 1, 0); PG8_STAGE(PG8_SA(0, 1), a2 + hstep, voffA);
            PG8_WAIT_V(8); PG8_WAIT_L(0); PG8_BAR; PG8_MMA(0, 0, At, B0); PG8_MMA(0, 1, At, B1); PG8_BAR; PG8_SCHED;
            PG8_LDA(At, 1, 1); PG8_STAGE(PG8_SB(1, 0), b3, voffB); PG8_STAGE(PG8_SB(1, 1), b3 + hstep, voffB); PG8_STAGE(PG8_SA(1, 0), a3, voffA);
            PG8_WAIT_V(8); PG8_WAIT_L(0); PG8_BAR; PG8_MMA(1, 0, At, B0); PG8_MMA(1, 1, At, B1); PG8_BAR; PG8_SCHED;
            } else {
            PG8_LDB(B0, 0, 0); PG8_SCHED; PG8_LDA(At, 0, 0); PG8_STAGE(PG8_SA(1, 1), a1 + hstep, voffA);
            PG8_WAIT_L(8); PG8_BAR; PG8_WAIT_L(0); PG8_MMA(0, 0, At, B0); PG8_BAR; PG8_SCHED;
            PG8_LDB(B1, 0, 1); PG8_STAGE(PG8_SB(0, 0), b2, voffB);
            PG8_BAR; PG8_WAIT_L(0); PG8_MMA(0, 1, At, B1); PG8_BAR;
            PG8_LDA(At, 0, 1); PG8_STAGE(PG8_SA(0, 0), a2, voffA);
            PG8_BAR; PG8_WAIT_L(0); PG8_MMA(1, 0, At, B0); PG8_BAR; PG8_SCHED;
            PG8_STAGE(PG8_SB(0, 1), b2 + hstep, voffB);
            PG8_WAIT_V(6); PG8_BAR; PG8_MMA(1, 1, At, B1); PG8_BAR;
            PG8_LDB(B0, 1, 0); PG8_SCHED; PG8_LDA(At, 1, 0); PG8_STAGE(PG8_SA(0, 1), a2 + hstep, voffA);
            PG8_WAIT_L(8); PG8_BAR; PG8_WAIT_L(0); PG8_MMA(0, 0, At, B0); PG8_BAR; PG8_SCHED;
            PG8_LDB(B1, 1, 1); PG8_STAGE(PG8_SB(1, 0), b3, voffB);
            PG8_BAR; PG8_WAIT_L(0); PG8_MMA(0, 1, At, B1); PG8_BAR;
            PG8_LDA(At, 1, 1); PG8_STAGE(PG8_SA(1, 0), a3, voffA);
            PG8_BAR; PG8_WAIT_L(0); PG8_MMA(1, 0, At, B0); PG8_BAR; PG8_SCHED;
            PG8_STAGE(PG8_SB(1, 1), b3 + hstep, voffB);
            PG8_WAIT_V(6); PG8_BAR; PG8_MMA(1, 1, At, B1); PG8_BAR;
            }
        }
        if constexpr (ALIGN_EPI) { if (wr == 0) PG8_BAR; }
        bool keep = false;
        if constexpr (!Epi::AFTER_DRAIN) { if constexpr (Epi::CHAIN) keep = E.chain(acc, cur, wr, wc, fr, fq); else E(acc, cur, wr, wc, fr, fq); S.done(cur); }
        if (!has_next) break;
        if (!keep) {
#pragma unroll
        for (int a = 0; a < 2; ++a)
#pragma unroll
            for (int b = 0; b < 2; ++b)
#pragma unroll
                for (int m = 0; m < 4; ++m)
#pragma unroll
                    for (int n = 0; n < 2; ++n) acc[a][b][m][n] = (f32x4){0.f, 0.f, 0.f, 0.f};
        }
        cur = nxt; cA = nA; cB = nB; ++ui;
        if constexpr (ALIGN_EPI) { if (wr == 1) PG8_BAR; }
    }
    PG8_WAIT_V(0);
    if constexpr (!ALIGN_EPI) { if (wr == 0) PG8_BAR; }
    PG8_BAR;
    if constexpr (Epi::AFTER_DRAIN) { E.fused(acc, cur, wr, wc, fr, fq, lds, wid, lane); S.done(cur); }
#undef PG8_SA
#undef PG8_SB
#undef PG8_STAGE
#undef PG8_LDA
#undef PG8_LDB
#undef PG8_MMA
#undef PG8_WAIT_V
#undef PG8_WAIT_L
#undef PG8_BAR
#undef PG8_SCHED
}
}
#include <hip/hip_bf16.h>
#include <cmath>
namespace attn_body {
using bf16=__hip_bfloat16;
using bf16x8=__attribute__((ext_vector_type(8)))short;
using s16x4=__attribute__((ext_vector_type(4)))short;
using f32x16=__attribute__((ext_vector_type(16)))float;
using u32x4=__attribute__((ext_vector_type(4)))unsigned;
constexpr int NHEAD=8,SEQ=2048,D=64,PQ=512,PK=512,PV=4352,PO=512;
constexpr int NW=8,QBLK=32,QB=QBLK*NW,KVBLK=64,NQB=SEQ/QB;
__device__ __forceinline__ int crow(int r,int hi){return (r&3)+8*(r>>2)+4*hi;}
#define SBAR() __builtin_amdgcn_sched_barrier(0)
__device__ __forceinline__ void cmask(f32x16&p0,f32x16&p1,int jb,int qrel,int hi){
  const float NEG=-INFINITY; int kb=64*jb+4*hi;
  #pragma unroll
  for(int r=0;r<16;++r){int kv=kb+(r&3)+8*(r>>2); if(kv>qrel)p0[r]=NEG; if(kv+32>qrel)p1[r]=NEG;}
}

constexpr int NSLOT=3, SLOTB=8192;
constexpr int LDS_K=0, LDS_V=NSLOT*SLOTB, LDS_WS=2*NSLOT*SLOTB, LDS_OST=LDS_WS+NW*64*4, LDS_SEL=LDS_OST+NW*4096, LDS_KM=LDS_SEL+256, LDS_KP=LDS_KM+7*64*4, LDS_BYTES=LDS_KP+8*64*4;
constexpr float C2=0.125f*1.4426950408889634f;
__device__ __forceinline__ void glds16(const void*gsrc,unsigned lds_dst){unsigned keep;
  asm volatile("s_mov_b32 %0, m0\n\ts_mov_b32 m0, %2\n\ts_nop 0\n\tglobal_load_lds_dwordx4 %1, off\n\ts_mov_b32 m0, %0":"=&s"(keep):"v"(gsrc),"s"(lds_dst):"memory");}
__device__ __forceinline__ float max3f(float a,float b,float c){float r;asm("v_max3_f32 %0, %1, %2, %3":"=v"(r):"v"(a),"v"(b),"v"(c));return r;}
__device__ __forceinline__ float max2f(float a,float b){float r;asm("v_max_f32_e32 %0, %1, %2":"=v"(r):"v"(a),"v"(b));return r;}
__device__ __forceinline__ float fadd_s(float a,float b){float r;asm("v_add_f32_e32 %0, %1, %2":"=v"(r):"v"(a),"v"(b));return r;}
__device__ __forceinline__ float fsub_s(float a,float b){float r;asm("v_sub_f32_e32 %0, %1, %2":"=v"(r):"v"(a),"v"(b));return r;}
typedef float f32x2_t __attribute__((ext_vector_type(2))); typedef __bf16 bf16x2_t __attribute__((ext_vector_type(2)));
__device__ __forceinline__ unsigned cvtpk_s(float lo,float hi){f32x2_t v={lo,hi};bf16x2_t b=__builtin_convertvector(v,bf16x2_t);return __builtin_bit_cast(unsigned,b);}
#define WAIT_BAR(N) asm volatile("s_waitcnt vmcnt(" #N ") lgkmcnt(0)\n\ts_barrier":::"memory")

__device__ __forceinline__ void qkt(f32x16&p0,f32x16&p1,const char*Kslot,const bf16x8*qr,const f32x16&negm,int r32,int hi){
  const char*kb=Kslot+hi*1024+r32*16;
  #pragma unroll
  for(int d0=0;d0<4;++d0){
    const bf16x8 b0=*reinterpret_cast<const bf16x8*>(kb+d0*2048);
    const bf16x8 b1=*reinterpret_cast<const bf16x8*>(kb+d0*2048+512);
    if(d0==0){p0=__builtin_amdgcn_mfma_f32_32x32x16_bf16(b0,qr[0],negm,0,0,0);p1=__builtin_amdgcn_mfma_f32_32x32x16_bf16(b1,qr[0],negm,0,0,0);}
    else{p0=__builtin_amdgcn_mfma_f32_32x32x16_bf16(b0,qr[d0],p0,0,0,0);p1=__builtin_amdgcn_mfma_f32_32x32x16_bf16(b1,qr[d0],p1,0,0,0);}}
}
typedef __attribute__((address_space(3))) const char* lds_cptr;
typedef short v4i16_t __attribute__((ext_vector_type(4)));
__device__ __forceinline__ void kload8(bf16x8*kf,lds_cptr kp){
  kf[0]=*(const __attribute__((address_space(3))) bf16x8*)(kp);      kf[1]=*(const __attribute__((address_space(3))) bf16x8*)(kp+512);
  kf[2]=*(const __attribute__((address_space(3))) bf16x8*)(kp+2048); kf[3]=*(const __attribute__((address_space(3))) bf16x8*)(kp+2560);
  kf[4]=*(const __attribute__((address_space(3))) bf16x8*)(kp+4096); kf[5]=*(const __attribute__((address_space(3))) bf16x8*)(kp+4608);
  kf[6]=*(const __attribute__((address_space(3))) bf16x8*)(kp+6144); kf[7]=*(const __attribute__((address_space(3))) bf16x8*)(kp+6656);
}
__device__ __forceinline__ void kload2(bf16x8*kf,lds_cptr kp,int j){ kf[2*j]=*(const __attribute__((address_space(3))) bf16x8*)(kp+j*2048); kf[2*j+1]=*(const __attribute__((address_space(3))) bf16x8*)(kp+j*2048+512); }
__device__ __forceinline__ s16x4 vtr(lds_cptr p){ return __builtin_bit_cast(s16x4,__builtin_amdgcn_ds_read_tr16_b64_v4i16((__attribute__((address_space(3))) v4i16_t*)p)); }
__device__ __forceinline__ float rowmax(const f32x16&p0,const f32x16&p1){
  float a=max3f(p0[0],p0[1],p1[0]),b=max3f(p0[2],p0[3],p1[1]);a=max3f(a,p1[2],p1[3]);
  #pragma unroll
  for(int r=4;r<16;r+=4){a=max3f(a,p0[r],p0[r+1]);b=max3f(b,p0[r+2],p0[r+3]);a=max3f(a,p1[r],p1[r+1]);b=max3f(b,p1[r+2],p1[r+3]);}
  const float m=max2f(a,b);
  auto rr=__builtin_amdgcn_permlane32_swap(__float_as_uint(m),__float_as_uint(m),false,false);
  return max2f(__uint_as_float(rr[0]),__uint_as_float(rr[1]));
}
__device__ __forceinline__ void pv(f32x16*o,int vb,bf16x8 pa0,bf16x8 pa1,bf16x8 pa2,bf16x8 pa3){
  #pragma unroll
  for(int d0=0;d0<2;++d0){s16x4 lo[4],hi[4];
    #pragma unroll
    for(int ks=0;ks<4;++ks){
      asm volatile("ds_read_b64_tr_b16 %0,%1 offset:%c2":"=&v"(lo[ks]):"v"(vb),"i"(d0*4096+ks*1024):"memory");
      asm volatile("ds_read_b64_tr_b16 %0,%1 offset:%c2":"=&v"(hi[ks]):"v"(vb),"i"(d0*4096+ks*1024+512):"memory");}
    asm volatile("s_waitcnt lgkmcnt(0)":::"memory");SBAR();
    #define PK(k) (bf16x8){lo[k][0],lo[k][1],lo[k][2],lo[k][3],hi[k][0],hi[k][1],hi[k][2],hi[k][3]}
    o[d0]=__builtin_amdgcn_mfma_f32_32x32x16_bf16(pa0,PK(0),o[d0],0,0,0);
    o[d0]=__builtin_amdgcn_mfma_f32_32x32x16_bf16(pa1,PK(1),o[d0],0,0,0);
    o[d0]=__builtin_amdgcn_mfma_f32_32x32x16_bf16(pa2,PK(2),o[d0],0,0,0);
    o[d0]=__builtin_amdgcn_mfma_f32_32x32x16_bf16(pa3,PK(3),o[d0],0,0,0);
    #undef PK
  }
}

#ifndef ATTN_STORE16
#define ATTN_STORE16(p,v) (*(u32x4*)(p)=(v))
#endif
template<int THRL> __device__ __forceinline__ void attn_unit(int b,int h,int qb,const bf16*Q,const bf16*__restrict__ K,const bf16*__restrict__ V,bf16*O,char*shm,int wv){
  const int tid=mktid(wv),lane=tid&63,r32=lane&31,hi=lane>>5;     const int wid=__builtin_amdgcn_readfirstlane(tid>>6);
  const long rowbase=(long)b*SEQ; const int q0=qb*QB;
  if(qb>3){ float*KMl=(float*)(shm+LDS_KM); float*KPl=(float*)(shm+LDS_KP); const int c8=tid&7, rl=tid>>3;
    for(int n=0;n<qb;++n){ float sm[8];
      #pragma unroll
      for(int d=0;d<8;++d)sm[d]=0.f;
      #pragma unroll
      for(int rr=0;rr<4;++rr){ const u32x4 w=*reinterpret_cast<const u32x4*>(K+(rowbase+n*256+rl+64*rr)*PK+h*D+8*c8);
        sm[0]+=__uint_as_float(w[0]<<16);sm[1]+=__uint_as_float(w[0]&0xffff0000u);sm[2]+=__uint_as_float(w[1]<<16);sm[3]+=__uint_as_float(w[1]&0xffff0000u);
        sm[4]+=__uint_as_float(w[2]<<16);sm[5]+=__uint_as_float(w[2]&0xffff0000u);sm[6]+=__uint_as_float(w[3]<<16);sm[7]+=__uint_as_float(w[3]&0xffff0000u); }
      #pragma unroll
      for(int d=0;d<8;++d){ float v=sm[d];
        v+=__builtin_bit_cast(float,__builtin_amdgcn_ds_swizzle(__builtin_bit_cast(int,v),0x201F));
        v+=__builtin_bit_cast(float,__builtin_amdgcn_ds_swizzle(__builtin_bit_cast(int,v),0x401F));
        { const unsigned u=__builtin_bit_cast(unsigned,v); auto rr2=__builtin_amdgcn_permlane32_swap(u,u,false,false); v=__uint_as_float((unsigned)rr2[0])+__uint_as_float((unsigned)rr2[1]); }
        sm[d]=v; }
      if(lane<8){
        #pragma unroll
        for(int d=0;d<8;++d)KPl[wid*64+8*lane+d]=sm[d]; }
      asm volatile("s_waitcnt vmcnt(0) lgkmcnt(0)\n\ts_barrier":::"memory");
      if(tid<64){ float s8=0.f;
        #pragma unroll
        for(int w8=0;w8<8;++w8)s8+=KPl[w8*64+tid];
        KMl[n*64+tid]=s8*(1.0f/256.0f); }
      asm volatile("s_waitcnt lgkmcnt(0)\n\ts_barrier":::"memory"); } }
  if(tid<QB){ unsigned sel=(qb<=3)?((1u<<qb)-1u):0u;
    if(qb>3){ const bf16*qp=Q+(rowbase+q0+tid)*PQ+h*D; const float*km=(const float*)(shm+LDS_KM); float gate[7];
      #pragma unroll
      for(int j=0;j<7;++j)gate[j]=0.f;
      #pragma unroll 1
      for(int i=0;i<8;++i){ const u32x4 w=*reinterpret_cast<const u32x4*>(qp+8*i); float qv[8];
        qv[0]=__uint_as_float(w[0]<<16);qv[1]=__uint_as_float(w[0]&0xffff0000u);qv[2]=__uint_as_float(w[1]<<16);qv[3]=__uint_as_float(w[1]&0xffff0000u);
        qv[4]=__uint_as_float(w[2]<<16);qv[5]=__uint_as_float(w[2]&0xffff0000u);qv[6]=__uint_as_float(w[3]<<16);qv[7]=__uint_as_float(w[3]&0xffff0000u);
        #pragma unroll
        for(int j=0;j<7;++j) if(j<qb){ const float*kp=km+j*64+8*i;
          #pragma unroll
          for(int d=0;d<8;++d)gate[j]+=qv[d]*kp[d]; } }
      #pragma unroll
      for(int rep=0;rep<3;++rep){ float best=-INFINITY; int bi=0;
        #pragma unroll
        for(int j=0;j<7;++j) if(j<qb&&!((sel>>j)&1u)&&gate[j]>best){best=gate[j];bi=j;}
        sel|=1u<<bi; } }
    ((unsigned char*)(shm+LDS_SEL))[tid]=(unsigned char)sel; }
  asm volatile("s_waitcnt vmcnt(0) lgkmcnt(0)\n\ts_barrier":::"memory");
  const bf16*Qw=Q+(rowbase+q0+wid*QBLK)*PQ+h*D;
  const bf16*Kh=K+rowbase*PK+h*D,*Vh=V+rowbase*PV+h*D;
  const unsigned lds0=(unsigned)(uintptr_t)shm;
  float*wsf=(float*)(shm+LDS_WS)+wid*64;
  const bf16*ksrc=Kh+(long)lane*PK+wid*8;
  const bf16*vsrc=Vh+(long)(16*(wid&3)+(lane>>2))*PV+(wid>>2)*32+(lane&3)*8;
  const unsigned kdst=lds0+LDS_K+wid*1024, vdst=lds0+LDS_V+wid*1024;
  #define TROW(t) ((long)(((t)<4)?(q0+(t)*KVBLK):(((t)-4)*KVBLK)))
  #define DMA_K(t,slot) glds16(ksrc+TROW(t)*PK,(unsigned)__builtin_amdgcn_readfirstlane(kdst+(slot)))
  #define DMA_V(t,slot) glds16(vsrc+TROW(t)*PV,(unsigned)__builtin_amdgcn_readfirstlane(vdst+(slot)))
  const int vb0=(int)(lds0+LDS_V)+((lane>>4)&1)*32+(lane&3)*8+(4*hi+((lane&15)>>2))*64;
  const char*Kbase=shm+LDS_K; bf16x8 kf[8];
  const lds_cptr shm3=(lds_cptr)shm; const lds_cptr kp0=shm3+LDS_K+hi*1024+r32*16; const lds_cptr vp0=shm3+LDS_V+((lane>>4)&1)*32+(lane&3)*8+(4*hi+((lane&15)>>2))*64;
  const int NT=(q0+QB)/KVBLK;
  DMA_K(0,0);DMA_V(0,0);DMA_K(1,SLOTB);
  bf16x8 qr[4];
  #pragma unroll
  for(int d0=0;d0<4;++d0)qr[d0]=*reinterpret_cast<const bf16x8*>(&Qw[(long)r32*PQ+d0*16+hi*8]);
  float mhat=0.f,l_reg=0.f;f32x16 o[2];o[0]=f32x16{};o[1]=f32x16{};
  const int qrel=wid*QBLK+r32;
  const unsigned selb=((const unsigned char*)(shm+LDS_SEL))[qrel];
  #define CMASK(P0,P1,t) cmask(P0,P1,(t),qrel,hi)
  #define SUBREF(C0,C1,t) do{ const float sb_=(((t)<4)||((selb>>(((t)-4)>>2))&1u))?mhat:INFINITY; _Pragma("unroll") for(int r_=0;r_<16;++r_){C0[r_]-=sb_;C1[r_]-=sb_;} }while(0)
  bool resc=false;
  #define START(P0,P1) do{ const float rm=rowmax(P0,P1); resc=false; \
    { const float dl=rm; mhat=fadd_s(mhat,dl); \
      _Pragma("unroll") for(int r=0;r<16;++r){P0[r]=fsub_s(P0[r],dl);P1[r]=fsub_s(P1[r],dl);} \
      } \
    _Pragma("unroll") for(int r=0;r<16;++r)P0[r]=__builtin_amdgcn_exp2f(P0[r]); }while(0)
  #define RESC() do{ if(resc){ asm volatile("s_waitcnt lgkmcnt(0)":::"memory"); \
      _Pragma("unroll") for(int d_=0;d_<2;++d_) _Pragma("unroll") for(int r=0;r<16;++r)o[d_][r]*=wsf[crow(r,hi)]; } }while(0)
  f32x16 pA0,pA1,pB0,pB1;
  int sl_prev=0,sl_cur=0,sl_next=SLOTB;
  #define ROT() do{sl_prev=sl_cur;sl_cur=sl_next;sl_next=(sl_next==(NSLOT-1)*SLOTB)?0:sl_next+SLOTB;}while(0)
  DMA_K(2,2*SLOTB);
  WAIT_BAR(3);
  qkt(pA0,pA1,Kbase,qr,f32x16{},r32,hi);asm volatile("s_nop 15\n\ts_nop 7":"+v"(pA0),"+v"(pA1));CMASK(pA0,pA1,0);
  START(pA0,pA1);
  _Pragma("unroll") for(int r=0;r<16;++r)pA1[r]=__builtin_amdgcn_exp2f(pA1[r]);
  WAIT_BAR(0);
  DMA_K(3,0);DMA_V(1,SLOTB);
  ROT();
  kload8(kf,kp0+sl_cur);
  WAIT_BAR(2);
  s16x4 vlo[8],vhi[8]; u32x4 pw0,pw1,pw2,pw3;
  #define PKW(P,B) cvtpk_s(P[B],P[B+1])
  #define PAF(k) __builtin_bit_cast(bf16x8,pw##k)
  #define VFR(i) (bf16x8){vlo[i][0],vlo[i][1],vlo[i][2],vlo[i][3],vhi[i][0],vhi[i][1],vhi[i][2],vhi[i][3]}
  #define PIN(x) asm volatile("":"+v"(x))
  #define MX3(a,b,c) __builtin_fmaxf(__builtin_fmaxf((a),(b)),(c))
  #define GAPA(MF,A0,A1,A2,A3,W0,W1,PW) do{ MF; sacc+=A0; sacc+=A1; sacc+=A2; sacc+=A3; PIN(sacc); W0; W1; PIN(PW); SBAR(); }while(0)
  #define EX(v) __builtin_amdgcn_exp2f(v)
  #define GAPB(MF,X,B) do{ MF; X[B]=EX(X[B]); X[B+1]=EX(X[B+1]); X[B+2]=EX(X[B+2]); X[B+3]=EX(X[B+3]); PIN(X); SBAR(); }while(0)
  #define VRD(i) do{ vlo[i]=vtr(vp_+(((i)>>2)*4096+((i)&3)*1024)); vhi[i]=vtr(vp_+(((i)>>2)*4096+((i)&3)*1024+512)); }while(0)
  #define KRD(G,j) do{ if(G){ kload2(kf,kp0+sl_next,j); SBAR(); } }while(0)
  #define STEP(C0,C1,P0,P1,t,GK,GV,GL,MB) do{ SBAR(); \
    const lds_cptr vp_=vp0+sl_prev; \
    VRD(0); SBAR(); float sacc=(P0[0]+P0[1]); \
    GAPA(C0=__builtin_amdgcn_mfma_f32_32x32x16_bf16(kf[0],qr[0],f32x16{},0,0,0), P0[2],P0[3],P0[4],P0[5],     pw0[0]=PKW(P0,0), pw0[1]=PKW(P0,2), pw0); \
    VRD(4); SBAR(); GAPA(C1=__builtin_amdgcn_mfma_f32_32x32x16_bf16(kf[1],qr[0],f32x16{},0,0,0), P0[6],P0[7],P0[8],P0[9],     pw0[2]=PKW(P0,4), pw0[3]=PKW(P0,6), pw0); \
    VRD(1); SBAR(); GAPA(C0=__builtin_amdgcn_mfma_f32_32x32x16_bf16(kf[2],qr[1],C0,0,0,0),   P0[10],P0[11],P0[12],P0[13], pw1[0]=PKW(P0,8), pw1[1]=PKW(P0,10), pw1); \
    VRD(5); SBAR(); GAPA(C1=__builtin_amdgcn_mfma_f32_32x32x16_bf16(kf[3],qr[1],C1,0,0,0),   P0[14],P0[15],P1[0],P1[1],   pw1[2]=PKW(P0,12),pw1[3]=PKW(P0,14), pw1); \
    VRD(2); SBAR(); GAPA(C0=__builtin_amdgcn_mfma_f32_32x32x16_bf16(kf[4],qr[2],C0,0,0,0),   P1[2],P1[3],P1[4],P1[5],     pw2[0]=PKW(P1,0), pw2[1]=PKW(P1,2), pw2); \
    VRD(6); SBAR(); GAPA(C1=__builtin_amdgcn_mfma_f32_32x32x16_bf16(kf[5],qr[2],C1,0,0,0),   P1[6],P1[7],P1[8],P1[9],     pw2[2]=PKW(P1,4), pw2[3]=PKW(P1,6), pw2); \
    VRD(3); SBAR(); GAPA(C0=__builtin_amdgcn_mfma_f32_32x32x16_bf16(kf[6],qr[3],C0,0,0,0),   P1[10],P1[11],P1[12],P1[13], pw3[0]=PKW(P1,8), pw3[1]=PKW(P1,10), pw3); \
    VRD(7); SBAR(); GAPA(C1=__builtin_amdgcn_mfma_f32_32x32x16_bf16(kf[7],qr[3],C1,0,0,0),   P1[14],P1[15],0.f,0.f,       pw3[2]=PKW(P1,12),pw3[3]=PKW(P1,14), pw3); \
    l_reg+=sacc; \
    if(GK){DMA_K((t)+3,sl_cur);} if(GV){DMA_V((t)+1,sl_next);} \
    SUBREF(C0,C1,t); if(MB){CMASK(C0,C1,t);} \
    { float a=MX3(C0[0],C0[1],C1[0]),b=MX3(C0[2],C0[3],C1[1]); a=MX3(a,C1[2],C1[3]); \
      _Pragma("unroll") for(int r=4;r<16;r+=4){a=MX3(a,C0[r],C0[r+1]);b=MX3(b,C0[r+2],C0[r+3]);a=MX3(a,C1[r],C1[r+1]);b=MX3(b,C1[r+2],C1[r+3]);} \
      float rm=__builtin_fmaxf(a,b); { auto rr=__builtin_amdgcn_permlane32_swap(__float_as_uint(rm),__float_as_uint(rm),false,false); rm=__builtin_fmaxf(__uint_as_float(rr[0]),__uint_as_float(rr[1])); } \
      resc=false; \
      if(__builtin_expect(__any(rm>(float)THRL),0)){ const float dl=__builtin_fmaxf(rm,0.f); mhat+=dl; \
        _Pragma("unroll") for(int r=0;r<16;++r){C0[r]-=dl;C1[r]-=dl;} \
        const float f=__builtin_amdgcn_exp2f(-dl); l_reg*=f; if(hi==0)wsf[r32]=f; resc=true; } } \
    SBAR(); \
    GAPB(o[0]=__builtin_amdgcn_mfma_f32_32x32x16_bf16(PAF(0),VFR(0),o[0],0,0,0), C0,0); \
    GAPB(o[1]=__builtin_amdgcn_mfma_f32_32x32x16_bf16(PAF(0),VFR(4),o[1],0,0,0), C0,4); \
    KRD(GL,0); GAPB(o[0]=__builtin_amdgcn_mfma_f32_32x32x16_bf16(PAF(1),VFR(1),o[0],0,0,0), C0,8); \
    KRD(GL,1); GAPB(o[1]=__builtin_amdgcn_mfma_f32_32x32x16_bf16(PAF(1),VFR(5),o[1],0,0,0), C0,12); \
    KRD(GL,2); GAPB(o[0]=__builtin_amdgcn_mfma_f32_32x32x16_bf16(PAF(2),VFR(2),o[0],0,0,0), C1,0); \
    KRD(GL,3); GAPB(o[1]=__builtin_amdgcn_mfma_f32_32x32x16_bf16(PAF(2),VFR(6),o[1],0,0,0), C1,4); \
    GAPB(o[0]=__builtin_amdgcn_mfma_f32_32x32x16_bf16(PAF(3),VFR(3),o[0],0,0,0), C1,8); \
    GAPB(o[1]=__builtin_amdgcn_mfma_f32_32x32x16_bf16(PAF(3),VFR(7),o[1],0,0,0), C1,12); \
    }while(0)
  #define ENDW(tt) do{ if((tt)+3<NT){WAIT_BAR(2);} else if((tt)+2<NT){WAIT_BAR(1);} else {WAIT_BAR(0);} }while(0)
  { int t=1;
    for(;t+1<NT;t+=2){
      STEP(pB0,pB1,pA0,pA1,t,(t+3<NT),(t+1<NT),(t+1<NT),(t<4));       ENDW(t);   RESC(); ROT();
      STEP(pA0,pA1,pB0,pB1,t+1,(t+4<NT),(t+2<NT),(t+2<NT),(t+1<4));     ENDW(t+1); RESC(); ROT();
    }
    STEP(pB0,pB1,pA0,pA1,NT-1,false,false,false,(NT==4)); RESC();
  }
  { float sacc=pB0[0]+pB0[1]; _Pragma("unroll") for(int r=2;r<16;++r)sacc+=pB0[r]; _Pragma("unroll") for(int r=0;r<16;++r)sacc+=pB1[r]; l_reg+=sacc;
    pw0=(u32x4){PKW(pB0,0),PKW(pB0,2),PKW(pB0,4),PKW(pB0,6)};pw1=(u32x4){PKW(pB0,8),PKW(pB0,10),PKW(pB0,12),PKW(pB0,14)};pw2=(u32x4){PKW(pB1,0),PKW(pB1,2),PKW(pB1,4),PKW(pB1,6)};pw3=(u32x4){PKW(pB1,8),PKW(pB1,10),PKW(pB1,12),PKW(pB1,14)};
    SBAR(); pv(o,vb0+sl_cur,PAF(0),PAF(1),PAF(2),PAF(3)); }
  #undef PKW
  #undef PAF
  #undef VFR
  #undef PIN
  #undef MX3
  #undef GAPA
  #undef GAPB
  #undef EX
  #undef VRD
  #undef KRD
  #undef STEP
  #undef ENDW
  {auto rr=__builtin_amdgcn_permlane32_swap(__float_as_uint(l_reg),__float_as_uint(l_reg),false,false);l_reg=__uint_as_float(rr[0])+__uint_as_float(rr[1]);}
  if(hi==0)wsf[32+r32]=l_reg;asm volatile("s_waitcnt lgkmcnt(0)":::"memory");
  float rli[16];
  #pragma unroll
  for(int r=0;r<16;++r)rli[r]=__builtin_amdgcn_rcpf(wsf[32+crow(r,hi)]);
  bf16*Ow=O+(rowbase+q0+wid*QBLK)*PO+h*D;
  { bf16*stg=(bf16*)(shm+LDS_OST)+wid*2048;
    #pragma unroll
    for(int r=0;r<16;++r){const int orow=crow(r,hi);
      #pragma unroll
      for(int d0=0;d0<2;++d0)stg[orow*64+d0*32+r32]=__float2bfloat16(o[d0][r]*rli[r]);}
    asm volatile("s_waitcnt lgkmcnt(0)":::"memory");
    #pragma unroll
    for(int i=0;i<4;++i){const int row=i*8+(lane>>3),ch=lane&7; const u32x4 v=*(const u32x4*)(stg+row*64+ch*8); ATTN_STORE16(Ow+(long)row*PO+ch*8,v);} }
  asm volatile("s_waitcnt lgkmcnt(0)\n\ts_barrier":::"memory");
  #undef DMA_K
  #undef TROW
  #undef SUBREF
  #undef DMA_V
  #undef CMASK
  #undef START
  #undef RESC
  #undef ROT
}
constexpr int ATTN_LDS_BYTES=LDS_BYTES;
#undef SBAR
#undef WAIT_BAR
}
constexpr int DM = 1024, NB = 16, SEQ = 2048, NT = NB * SEQ;
constexpr int RWW = 512, WIN_N = 5376, INC = 4352, ZV = 1792, ZG = 2304;
constexpr int NEXP = 32, DEXP = 512;
constexpr int XS_ROWS = 2 * NT + NEXP * 256;
constexpr float C2 = 0.125f * 1.4426950408889634f;

#define LAS __attribute__((address_space(3)))
#define GAS __attribute__((address_space(1)))
typedef unsigned short bf16;
typedef unsigned v4u __attribute__((ext_vector_type(4)));
typedef unsigned v2u __attribute__((ext_vector_type(2)));
typedef float f32x4 __attribute__((ext_vector_type(4)));

typedef float f32x2_c __attribute__((ext_vector_type(2))); typedef __bf16 bf16x2_c __attribute__((ext_vector_type(2)));
__device__ __forceinline__ unsigned pk2(float lo, float hi) { const f32x2_c v = {lo, hi}; return __builtin_bit_cast(unsigned, __builtin_convertvector(v, bf16x2_c)); }
__device__ __forceinline__ unsigned f2bf(float f) { return pk2(f, f) & 0xffffu; }
__device__ __forceinline__ float bflo(unsigned w) { return __builtin_bit_cast(float, w << 16); }
__device__ __forceinline__ float bfhi(unsigned w) { return __builtin_bit_cast(float, w & 0xffff0000u); }
__device__ __forceinline__ float sigm(float x) { return __builtin_amdgcn_rcpf(1.0f + __expf(-x)); }

constexpr size_t MiB = 1u << 20;
constexpr size_t WS_CTL = 0;
constexpr size_t WS_MOD = 1 * MiB;
constexpr size_t WS_GM2 = 1 * MiB + 512 * 1024;
constexpr size_t WS_CB = 1 * MiB + 640 * 1024;
constexpr size_t WS_COS = 2 * MiB;
constexpr size_t WS_SIN = 2 * MiB + 512 * 1024;
constexpr size_t WS_KMEAN = 3 * MiB;
constexpr size_t WS_WRH = 3 * MiB + 512 * 1024;
constexpr size_t WS_WRL = 3 * MiB + 768 * 1024;
constexpr size_t WS_SEL = 4 * MiB;
constexpr size_t WS_RTE = 5 * MiB;
constexpr size_t WS_RTW = 5 * MiB + 256 * 1024;
constexpr size_t WS_RNK = 5 * MiB + 512 * 1024;
constexpr size_t WS_POS = 5 * MiB + 768 * 1024;
constexpr size_t WS_RSTD = 7 * MiB;
constexpr size_t WS_WLT = 6 * MiB;
constexpr size_t WS_WAT = 6 * MiB + 64 * 1024;
constexpr size_t WS_WGT = 6 * MiB + 128 * 1024;
constexpr size_t WS_WIN = 16 * MiB;
constexpr size_t WS_WBA = 27 * MiB;
constexpr size_t WS_WBB = 28 * MiB;
constexpr size_t WS_WOUT = 29 * MiB;
constexpr size_t WS_Z = 32 * MiB;
constexpr size_t WS_H = 368 * MiB;
constexpr size_t WS_Q = 304 * MiB, WS_K = 336 * MiB, WS_MRG = 304 * MiB;
constexpr size_t WS_YA = 432 * MiB, WS_YB = 464 * MiB;
constexpr size_t WS_WUP = 368 * MiB;
constexpr size_t WS_H2 = 128 * MiB;
constexpr size_t WS_XS = 64 * MiB;
constexpr size_t WS_HID = 208 * MiB;
constexpr size_t WS_X1B = 432 * MiB;
constexpr size_t WS_ACT = 496 * MiB;
constexpr size_t WS_END = 512 * MiB;
constexpr int CW_CNT = 64, CNT_PAD = 64;
constexpr int CW_NT = 2304;
constexpr int CW_TEXP = 2368;
static_assert(CW_CNT + NEXP * CNT_PAD <= CW_NT, "control words");

__device__ __forceinline__ void tr_item(const float* W, int K, int N, bf16* WT, int kb, int nb, int dst_row0, LAS float* scr, int lane) {
    const int k0 = 64 * kb, n0 = 32 * nb;
#pragma unroll 8
    for (int i = 0; i < 32; ++i) { const int kk = 2 * i + (lane >> 5); scr[kk * 33 + (lane & 31)] = W[(size_t)(k0 + kk) * N + n0 + (lane & 31)]; }
    asm volatile("s_waitcnt lgkmcnt(0)" ::: "memory");
    const int c = lane & 7;
#pragma unroll
    for (int j = 0; j < 4; ++j) { const int n = (lane >> 3) + 8 * j; const LAS float* s = scr + (8 * c) * 33 + n;
        v4u o; o.x = pk2(s[0 * 33], s[1 * 33]); o.y = pk2(s[2 * 33], s[3 * 33]); o.z = pk2(s[4 * 33], s[5 * 33]); o.w = pk2(s[6 * 33], s[7 * 33]);
        *(v4u*)(WT + (size_t)(dst_row0 + n) * K + k0 + 8 * c) = o; }
    asm volatile("s_waitcnt lgkmcnt(0)" ::: "memory");
}

struct PArgs { const float* in[30]; float* out; unsigned char* ws; };

__device__ __forceinline__ void p_prep_weights(const PArgs& a, unsigned char* lds, int wv) {
    const int tid = mktid(wv), lane = tid & 63, wave = tid >> 6;
    LAS float* scr = (LAS float*)lds + wave * (64 * 33);
    const int gw = blockIdx.x * 8 + wave, NGW = gridDim.x * 8;
    unsigned char* ws = a.ws;
    constexpr int I_IN = 16 * 168, I_BR = 8 * 32, I_OUT = 16 * 32;
    for (int it = gw; it < I_IN + 2 * I_BR + I_OUT; it += NGW) {
        int r = it;
        if (r < I_IN) { const int kb = r / 168, nb = r % 168; int dst = 32 * nb;
            if (dst >= 1792 && dst < 2816) { const int rel = dst - 1792, u = rel >> 8, hl = (rel & 255) >> 6, half = (rel & 63) >> 5; dst = 1792 + u * 256 + half * 128 + hl * 32; }
            tr_item(a.in[6], 1024, WIN_N, (bf16*)(ws + WS_WIN), kb, nb, dst, scr, lane); continue; } r -= I_IN;
        if (r < I_BR) { const int kb = r / 32, nb = r % 32; tr_item(a.in[20], 512, 1024, (bf16*)(ws + WS_WBA), kb, nb, 32 * nb, scr, lane); continue; } r -= I_BR;
        if (r < I_BR) { const int kb = r / 32, nb = r % 32; tr_item(a.in[21], 512, 1024, (bf16*)(ws + WS_WBB), kb, nb, 32 * nb, scr, lane); continue; } r -= I_BR;
        { const int kb = r / 32, nb = r % 32; tr_item(a.in[22], 1024, 1024, (bf16*)(ws + WS_WOUT), kb, nb, 32 * nb, scr, lane); }
    }
    const int gt = blockIdx.x * 512 + tid, NGT = gridDim.x * 512;
    float* cosT = (float*)(ws + WS_COS); float* sinT = (float*)(ws + WS_SIN);
    for (int i = gt; i < SEQ * 32; i += NGT) { const int s = i >> 5, f = i & 31; const float inv = powf(10000.0f, -(float)f / 32.0f); const float ang = (float)s * inv; cosT[i] = cosf(ang); sinT[i] = sinf(ang); }
    { bf16* wlt = (bf16*)(ws + WS_WLT); bf16* wat = (bf16*)(ws + WS_WAT); bf16* wgt = (bf16*)(ws + WS_WGT);
      for (int i = gt; i < 8 * 64 * 64; i += NGT) { const int hh = i >> 12, j = (i >> 6) & 63, m = i & 63; wlt[i] = (bf16)f2bf(a.in[9][m * 512 + hh * 64 + j]); wat[i] = (bf16)f2bf(a.in[11][m * 512 + hh * 64 + j]); }
      for (int i = gt; i < 8 * 64 * 128; i += NGT) { const int hh = i >> 13, j = (i >> 7) & 63, m = i & 127; wgt[i] = (bf16)f2bf(a.in[12][m * 512 + hh * 64 + j]); } }
    { bf16* wrh = (bf16*)(ws + WS_WRH); bf16* wrl = (bf16*)(ws + WS_WRL);
      for (int i = gt; i < 48 * 1024; i += NGT) { const int e = i >> 10, k = i & 1023; const float w = e < 4 ? a.in[23][k * 4 + e] : e < 36 ? a.in[25][k * 32 + (e - 4)] : 0.f;
          const unsigned hi = f2bf(w); wrh[i] = (bf16)hi; wrl[i] = (bf16)f2bf(w - bflo(hi)); } }
}

constexpr int CW_PEXP = 2816;
__device__ __forceinline__ void p_prep_experts_dyn(const PArgs& a, unsigned char* lds, int wv) {
    const int tid = mktid(wv), lane = tid & 63, wave = tid >> 6;
    LAS float* scr = (LAS float*)lds + wave * (64 * 33);
    unsigned* ctr = (unsigned*)(a.ws + WS_CTL) + CW_PEXP;
    constexpr int NITEM = NEXP * 768;
    for (;;) {
        unsigned base = 0; if (lane == 0) base = atomicAdd(ctr, 16u);
        base = (unsigned)__builtin_amdgcn_readfirstlane((int)base);
        if (base >= (unsigned)NITEM) break;
        for (int it = (int)base; it < (int)base + 16 && it < NITEM; ++it) {
            const int e = it / 768; int r = it % 768;
            bf16* wup = (bf16*)(a.ws + WS_WUP) + (size_t)e * 1024 * 1024;
            if (r < 256) { const int kb = r / 16, nb = r % 16, n0 = 32 * nb; tr_item(a.in[27] + (size_t)e * 1024 * 512, 1024, 512, wup, kb, nb, (n0 >> 7) * 256 + (n0 & 127), scr, lane); continue; } r -= 256;
            if (r < 256) { const int kb = r / 16, nb = r % 16, n0 = 32 * nb; tr_item(a.in[28] + (size_t)e * 1024 * 512, 1024, 512, wup, kb, nb, (n0 >> 7) * 256 + 128 + (n0 & 127), scr, lane); continue; } r -= 256;
            { const int kb = r / 32, nb = r % 32; tr_item(a.in[29] + (size_t)e * 512 * 1024, 512, 1024, (bf16*)a.out + (size_t)e * 1024 * 512, kb, nb, 32 * nb, scr, lane); }
        }
    }
}

__device__ __forceinline__ void p_ada(const PArgs& a, unsigned char* lds, int wv) {
    float* sc = (float*)lds; float* red = sc + 16 * 1024;
    const float* c = a.in[1]; const float* w = a.in[2]; const float* bias = a.in[3];
    float* mod = (float*)(a.ws + WS_MOD);
    const int tid = mktid(wv);
    for (int i = tid; i < 16 * 1024; i += 512) { const float v = c[i]; sc[i] = v / (1.0f + __expf(-v)); }
    __syncthreads();
    const int col = tid & 31, kg = tid >> 5;
    for (int tile = blockIdx.x; tile < 192; tile += gridDim.x) {
        const int e = tile * 32 + col;
        float acc[16];
#pragma unroll
        for (int b = 0; b < 16; ++b) acc[b] = 0.f;
        for (int d = kg * 64; d < kg * 64 + 64; ++d) { const float wv = w[(size_t)d * 6144 + e];
#pragma unroll
            for (int b = 0; b < 16; ++b) acc[b] += sc[b * 1024 + d] * wv; }
#pragma unroll
        for (int b = 0; b < 16; ++b) red[(kg * 16 + b) * 32 + col] = acc[b];
        __syncthreads();
        { const int b = tid >> 5, cc = tid & 31; float sm = 0.f;
#pragma unroll
            for (int k = 0; k < 16; ++k) sm += red[(k * 16 + b) * 32 + cc];
            mod[b * 6144 + tile * 32 + cc] = sm + bias[tile * 32 + cc]; }
        __syncthreads();
    }
}

__device__ __forceinline__ void p_norm1(const PArgs& a, unsigned char* lds, int wv) {
    const int tid = mktid(wv), lane = tid & 63, gw = blockIdx.x * 8 + (tid >> 6), NGW = gridDim.x * 8;
    const float* x = a.in[0]; const float* g = a.in[4]; const float* mod = (const float*)(a.ws + WS_MOD);
    bf16* h = (bf16*)(a.ws + WS_H);
    for (int m = gw; m < NT; m += NGW) {
        const int b = m >> 11; const f32x4* xr = (const f32x4*)(x + (size_t)m * DM) + lane; f32x4 v[4]; float s = 0.f;
#pragma unroll
        for (int j = 0; j < 4; ++j) { v[j] = xr[64 * j]; s += (v[j].x * v[j].x + v[j].y * v[j].y) + (v[j].z * v[j].z + v[j].w * v[j].w); }
        const float rstd = rsqrtf(wave_sum(s) * (1.0f / DM) + 1e-6f);
        v2u* o = (v2u*)(h + (size_t)m * DM) + lane;
#pragma unroll
        for (int j = 0; j < 4; ++j) { const int col = 4 * (lane + 64 * j);
            const f32x4 gg = *(const f32x4*)(g + col), sh = *(const f32x4*)(mod + b * 6144 + col), scl = *(const f32x4*)(mod + b * 6144 + 1024 + col);
            const f32x4 r = v[j] * rstd * gg * (scl + 1.0f) + sh; v2u w; w.x = pk2(r.x, r.y); w.y = pk2(r.z, r.w); o[64 * j] = w; }
    }
    { float* gm2 = (float*)(a.ws + WS_GM2); float* cb = (float*)(a.ws + WS_CB); const float* g2 = a.in[5];
      for (int i = blockIdx.x * 512 + tid; i < 16 * 1024; i += gridDim.x * 512) { const int b = i >> 10, k = i & 1023; gm2[i] = g2[k] * (1.0f + mod[b * 6144 + 4096 + k]); }
      for (int p = gw; p < 16 * 48; p += NGW) { const int b = p / 48, n = p % 48; float s = 0.f;
          if (n < 36) { for (int k = lane; k < 1024; k += 64) { const float w = n < 4 ? a.in[23][k * 4 + n] : a.in[25][k * 32 + (n - 4)]; s += mod[b * 6144 + 3072 + k] * w; } }
          s = wave_sum(s); if (lane == 0) cb[p] = n < 4 ? s + a.in[24][n] : n < 36 ? s + a.in[26][n - 4] : 0.f; } }
}

using pg8::Unit; using pg8::HALF; using pg8::BM; using pg8::cvt_pk_bf16;
typedef pg8::f32x4 pf4; typedef pg8::u32x4 pu4;

struct EpiStoreBf16 {
    static constexpr bool PERM = true, AFTER_DRAIN = false, CHAIN = false;
    bf16* O; int ldc;
    __device__ __forceinline__ void operator()(const pf4 (&acc)[2][2][4][2], const Unit& u, int wr, int wc, int fr, int fq) const {
        const int row0 = u.pm * BM + wr * 64 + fr, col0 = u.pn * BM + wc * 32 + 8 * fq;
#pragma unroll
        for (int ai = 0; ai < 2; ++ai)
#pragma unroll
            for (int m = 0; m < 4; ++m) { bf16* rowp = O + (size_t)(row0 + ai * HALF + m * 16) * ldc + col0;
#pragma unroll
                for (int bj = 0; bj < 2; ++bj) { const pf4 v0 = acc[ai][bj][m][0], v1 = acc[ai][bj][m][1]; pu4 w;
                    w.x = cvt_pk_bf16(v0[0], v0[1]); w.y = cvt_pk_bf16(v0[2], v0[3]); w.z = cvt_pk_bf16(v1[0], v1[1]); w.w = cvt_pk_bf16(v1[2], v1[3]);
                    *(pu4*)(rowp + bj * HALF) = w; } }
    }
};
struct EpiZ {
    static constexpr bool PERM = true, AFTER_DRAIN = false, CHAIN = false;
    bf16* z; bf16* Q; bf16* K; const float* qg; const float* kg; const float* cosT; const float* sinT;
    __device__ __forceinline__ void operator()(const pf4 (&acc)[2][2][4][2], const Unit& u, int wr, int wc, int fr, int fq) const {
        const int row0 = u.pm * BM + wr * 64 + fr;
        if (u.pn < 7 || u.pn >= 11) {
            const int zc = (u.pn < 7 ? u.pn * 256 : (u.pn - 11) * 256 + 1792) + wc * 32 + 8 * fq;
#pragma unroll
            for (int ai = 0; ai < 2; ++ai)
#pragma unroll
                for (int m = 0; m < 4; ++m) { bf16* rowp = z + (size_t)(row0 + ai * HALF + m * 16) * INC + zc;
#pragma unroll
                    for (int bj = 0; bj < 2; ++bj) { const pf4 v0 = acc[ai][bj][m][0], v1 = acc[ai][bj][m][1]; pu4 w;
                        w.x = cvt_pk_bf16(v0[0], v0[1]); w.y = cvt_pk_bf16(v0[2], v0[3]); w.z = cvt_pk_bf16(v1[0], v1[1]); w.w = cvt_pk_bf16(v1[2], v1[3]);
                        *(pu4*)(rowp + bj * HALF) = w; } }
            return;
        }
        const bool isk = u.pn >= 9; const int head = 4 * ((u.pn - 7) & 1) + wc; const float* g = isk ? kg : qg; bf16* O = (isk ? K : Q) + head * 64 + 8 * fq;
        const float osc = isk ? 1.0f : C2;
        pf4 gl[2][2];
#pragma unroll
        for (int bj = 0; bj < 2; ++bj)
#pragma unroll
            for (int n = 0; n < 2; ++n) gl[bj][n] = *(const pf4*)(g + 32 * bj + 8 * fq + 4 * n);
#pragma unroll
        for (int aim = 0; aim < 4; ++aim) { const int ai = aim >> 1, m0 = 2 * (aim & 1);
            pf4 ct[2][2], st[2][2];
#pragma unroll
            for (int mm = 0; mm < 2; ++mm) { const int s = (row0 + ai * HALF + (m0 + mm) * 16) & (SEQ - 1);
#pragma unroll
                for (int n = 0; n < 2; ++n) { ct[mm][n] = *(const pf4*)(cosT + s * 32 + 8 * fq + 4 * n); st[mm][n] = *(const pf4*)(sinT + s * 32 + 8 * fq + 4 * n); } }
#pragma unroll
            for (int mm = 0; mm < 2; ++mm) { const int m = m0 + mm; const int row = row0 + ai * HALF + m * 16;
                float ss = 0.f;
#pragma unroll
                for (int bj = 0; bj < 2; ++bj)
#pragma unroll
                    for (int n = 0; n < 2; ++n) { const pf4 v = acc[ai][bj][m][n]; ss += (v[0] * v[0] + v[1] * v[1]) + (v[2] * v[2] + v[3] * v[3]); }
                ss += __builtin_bit_cast(float, __builtin_amdgcn_ds_swizzle(__builtin_bit_cast(int, ss), 0x401F));
                { const unsigned uu = __builtin_bit_cast(unsigned, ss); auto rr = __builtin_amdgcn_permlane32_swap(uu, uu, false, false); ss = __builtin_bit_cast(float, (unsigned)rr[0]) + __builtin_bit_cast(float, (unsigned)rr[1]); }
                const float rstd = rsqrtf(ss * (1.0f / 64.0f) + 1e-6f);
#pragma unroll
                for (int n = 0; n < 2; ++n) { const pf4 x1 = acc[ai][0][m][n] * rstd * gl[0][n], x2 = acc[ai][1][m][n] * rstd * gl[1][n];
                    const pf4 o1 = x1 * ct[mm][n] - x2 * st[mm][n], o2 = x2 * ct[mm][n] + x1 * st[mm][n];
                    v2u wa, wb; wa.x = cvt_pk_bf16(o1[0] * osc, o1[1] * osc); wa.y = cvt_pk_bf16(o1[2] * osc, o1[3] * osc); wb.x = cvt_pk_bf16(o2[0] * osc, o2[1] * osc); wb.y = cvt_pk_bf16(o2[2] * osc, o2[3] * osc);
                    bf16* op = O + (size_t)row * 512 + 4 * n; *(v2u*)op = wa; *(v2u*)(op + 32) = wb; } }
            asm volatile("" ::: "memory");
        }
    }
};
struct EpiMerge {
    static constexpr bool PERM = true, AFTER_DRAIN = false, CHAIN = true;
    const bf16* z; bf16* mrg;
    __device__ __forceinline__ bool chain(pf4 (&acc)[2][2][4][2], const Unit& u, int wr, int wc, int fr, int fq) const {
        const int row0 = u.pm * BM + wr * 64 + fr, col0 = u.pn * BM + wc * 32 + 8 * fq;
        if (u.aux == 0) {
#pragma unroll
            for (int ai = 0; ai < 2; ++ai) {
                pu4 za[4][2], zb[4][2];
#pragma unroll
                for (int m = 0; m < 4; ++m) { const size_t row = (size_t)(row0 + ai * HALF + m * 16);
#pragma unroll
                    for (int bj = 0; bj < 2; ++bj) { const int col = col0 + bj * HALF; za[m][bj] = *(const pu4*)(z + row * INC + ZG + col); zb[m][bj] = *(const pu4*)(z + row * INC + ZG + 1024 + col); } }
#pragma unroll
                for (int m = 0; m < 4; ++m)
#pragma unroll
                    for (int bj = 0; bj < 2; ++bj) { const pu4 a4 = za[m][bj], b4 = zb[m][bj];
                        const float a8[8] = {bflo(a4.x), bfhi(a4.x), bflo(a4.y), bfhi(a4.y), bflo(a4.z), bfhi(a4.z), bflo(a4.w), bfhi(a4.w)};
                        const float b8[8] = {bflo(b4.x), bfhi(b4.x), bflo(b4.y), bfhi(b4.y), bflo(b4.z), bfhi(b4.z), bflo(b4.w), bfhi(b4.w)};
#pragma unroll
                        for (int e = 0; e < 8; ++e) acc[ai][bj][m][e >> 2][e & 3] *= (1.0f + __expf(-b8[e])) * __builtin_amdgcn_rcpf(1.0f + __expf(-a8[e])); }
                asm volatile("" ::: "memory");
            }
            return true;
        }
        pu4 gz[2][4][2];
#pragma unroll
        for (int ai = 0; ai < 2; ++ai)
#pragma unroll
            for (int m = 0; m < 4; ++m) { const size_t row = (size_t)(row0 + ai * HALF + m * 16);
#pragma unroll
                for (int bj = 0; bj < 2; ++bj) gz[ai][m][bj] = *(const pu4*)(z + row * INC + ZG + 1024 + col0 + bj * HALF); }
#pragma unroll
        for (int ai = 0; ai < 2; ++ai)
#pragma unroll
            for (int m = 0; m < 4; ++m) { const size_t row = (size_t)(row0 + ai * HALF + m * 16);
#pragma unroll
                for (int bj = 0; bj < 2; ++bj) { const int col = col0 + bj * HALF; const pu4 g4 = gz[ai][m][bj]; const pf4 v0 = acc[ai][bj][m][0], v1 = acc[ai][bj][m][1];
                    pu4 w;
                    w.x = cvt_pk_bf16(sigm(bflo(g4.x)) * v0[0], sigm(bfhi(g4.x)) * v0[1]); w.y = cvt_pk_bf16(sigm(bflo(g4.y)) * v0[2], sigm(bfhi(g4.y)) * v0[3]);
                    w.z = cvt_pk_bf16(sigm(bflo(g4.z)) * v1[0], sigm(bfhi(g4.z)) * v1[1]); w.w = cvt_pk_bf16(sigm(bflo(g4.w)) * v1[2], sigm(bfhi(g4.w)) * v1[3]);
                    *(pu4*)(mrg + row * DM + col) = w; } }
        return false;
    }
};
struct EpiOut {
    static constexpr bool PERM = true, AFTER_DRAIN = false, CHAIN = false;
    const float* x; const float* mod; bf16* x1;
    __device__ __forceinline__ void operator()(const pf4 (&acc)[2][2][4][2], const Unit& u, int wr, int wc, int fr, int fq) const {
        const int row0 = u.pm * BM + wr * 64 + fr, col0 = u.pn * BM + wc * 32 + 8 * fq; const int b = u.pm >> 3;
        pf4 gt[2][2];
#pragma unroll
        for (int bj = 0; bj < 2; ++bj)
#pragma unroll
            for (int n = 0; n < 2; ++n) gt[bj][n] = *(const pf4*)(mod + b * 6144 + 2048 + col0 + bj * HALF + n * 4);
#pragma unroll
        for (int ai = 0; ai < 2; ++ai) {
            pf4 xv[4][2][2];
#pragma unroll
            for (int m = 0; m < 4; ++m) { const size_t off = (size_t)(row0 + ai * HALF + m * 16) * DM + col0;
#pragma unroll
                for (int bj = 0; bj < 2; ++bj) { xv[m][bj][0] = *(const pf4*)(x + off + bj * HALF); xv[m][bj][1] = *(const pf4*)(x + off + bj * HALF + 4); } }
#pragma unroll
            for (int m = 0; m < 4; ++m) { const size_t off = (size_t)(row0 + ai * HALF + m * 16) * DM + col0;
#pragma unroll
                for (int bj = 0; bj < 2; ++bj) { const pf4 o0 = xv[m][bj][0] + gt[bj][0] * acc[ai][bj][m][0], o1 = xv[m][bj][1] + gt[bj][1] * acc[ai][bj][m][1]; pu4 w;
                    w.x = cvt_pk_bf16(o0[0], o0[1]); w.y = cvt_pk_bf16(o0[2], o0[3]); w.z = cvt_pk_bf16(o1[0], o1[1]); w.w = cvt_pk_bf16(o1[2], o1[3]);
                    *(pu4*)(x1 + off + bj * HALF) = w; } }
            asm volatile("" ::: "memory");
        }
    }
};
struct EpiUp {
    static constexpr bool PERM = true, AFTER_DRAIN = false, CHAIN = false;
    bf16* hid;
    __device__ __forceinline__ void operator()(const pf4 (&acc)[2][2][4][2], const Unit& u, int wr, int wc, int fr, int fq) const {
        const int row0 = u.pm * BM + wr * 64 + fr, col0 = u.pn * 128 + wc * 32 + 8 * fq;
#pragma unroll
        for (int ai = 0; ai < 2; ++ai)
#pragma unroll
            for (int m = 0; m < 4; ++m) { const size_t row = (size_t)(row0 + ai * HALF + m * 16); float o[8];
#pragma unroll
                for (int n = 0; n < 2; ++n)
#pragma unroll
                    for (int e = 0; e < 4; ++e) { const float g = acc[ai][0][m][n][e], l = acc[ai][1][m][n][e]; o[4 * n + e] = g * sigm(g) * l; }
                pu4 w; w.x = cvt_pk_bf16(o[0], o[1]); w.y = cvt_pk_bf16(o[2], o[3]); w.z = cvt_pk_bf16(o[4], o[5]); w.w = cvt_pk_bf16(o[6], o[7]);
                *(pu4*)(hid + row * DEXP + col0) = w; }
    }
};

struct GemmArgs { unsigned char* ws; const float* x; float* out; const float* qg; const float* kg; };
template <class Epi> __device__ __forceinline__ void run_dense(const void* A, const void* Bt, int M, int N, int K, const Epi& E, unsigned char* lds, int wv) {
    pg8::Gemm g{K}; pg8::StaticOrder S; S.init(A, Bt, M, N, K, (int)gridDim.x, (int)blockIdx.x);
    pg8::gemm_phase<Epi, pg8::StaticOrder, true, true>((PG8_LAS unsigned char*)lds, g, S, E, wv);
}
__device__ __forceinline__ void p_gemm_in(const GemmArgs& a, unsigned char* lds, int wv) {
    EpiZ E{(bf16*)(a.ws + WS_Z), (bf16*)(a.ws + WS_Q), (bf16*)(a.ws + WS_K), a.qg, a.kg, (const float*)(a.ws + WS_COS), (const float*)(a.ws + WS_SIN)};
    run_dense(a.ws + WS_H, a.ws + WS_WIN, NT, WIN_N, 1024, E, lds, wv);
}
struct PairOrder {
    int nM, nN, nwg, G, c; const char *A0, *A1, *B0, *B1; size_t tstep;
    __device__ bool next(int i, Unit& u) const {
        const long L = (long)(i >> 1) * G + c; if (L >= nwg) return false;
        int wgid = (int)L; { const int q = nwg / pg8::NXCD, r = nwg % pg8::NXCD, xcd = wgid % pg8::NXCD, off = wgid / pg8::NXCD; wgid = (xcd < r ? xcd * (q + 1) : r * (q + 1) + (xcd - r) * q) + off; }
        const int nig = pg8::WGM * nN, gid = wgid / nig, fm = gid * pg8::WGM, gsz = (nM - fm) < pg8::WGM ? (nM - fm) : pg8::WGM;
        u.pm = fm + ((wgid % nig) % gsz); u.pn = (wgid % nig) / gsz; u.aux = i & 1;
        u.a = ((i & 1) ? A1 : A0) + (size_t)u.pm * tstep; u.b = ((i & 1) ? B1 : B0) + (size_t)u.pn * tstep; return true;
    }
    __device__ __forceinline__ void a_ready(const Unit&) const {}
    __device__ __forceinline__ void done(const Unit&) const {}
};
__device__ __forceinline__ void p_gemm_merge(const GemmArgs& a, unsigned char* lds, int wv) {
    PairOrder S{NT / 256, 4, (NT / 256) * 4, (int)gridDim.x, (int)blockIdx.x, (const char*)(a.ws + WS_YA), (const char*)(a.ws + WS_YB), (const char*)(a.ws + WS_WBA), (const char*)(a.ws + WS_WBB), (size_t)256 * 512 * 2};
    EpiMerge E{(const bf16*)(a.ws + WS_Z), (bf16*)(a.ws + WS_MRG)}; pg8::Gemm g{512};
    pg8::gemm_phase<EpiMerge, PairOrder, true, true>((PG8_LAS unsigned char*)lds, g, S, E, wv);
}
__device__ __forceinline__ void p_gemm_out(const GemmArgs& a, unsigned char* lds, int wv) {
    EpiOut E{a.x, (const float*)(a.ws + WS_MOD), (bf16*)(a.ws + WS_X1B)};
    run_dense(a.ws + WS_MRG, a.ws + WS_WOUT, NT, 1024, 1024, E, lds, wv);
}
struct GroupedOrder {
    const int* texp; int nT, nN, G, c; const char* A; size_t a_tile; const char* B; size_t b_exp, b_tile;
    __device__ bool next(int i, Unit& u) const {
        const long L = (long)i * G + c; if (L >= (long)nT * nN) return false;
        const int tile = (int)(L / nN), pn = (int)(L % nN); u.aux = 0; u.pm = tile; u.pn = pn; u.a = A + (size_t)tile * a_tile; u.b = B + (size_t)texp[tile] * b_exp + (size_t)pn * b_tile; return true;
    }
    __device__ __forceinline__ void a_ready(const Unit&) const {}
    __device__ __forceinline__ void done(const Unit&) const {}
};
__device__ __forceinline__ void p_gemm_up(const GemmArgs& a, unsigned char* lds, int wv) {
    const int* ctl = (const int*)(a.ws + WS_CTL);
    GroupedOrder S{ctl + CW_TEXP, ctl[CW_NT], 4, (int)gridDim.x, (int)blockIdx.x, (const char*)(a.ws + WS_XS), (size_t)256 * 1024 * 2, (const char*)(a.ws + WS_WUP), (size_t)1024 * 1024 * 2, (size_t)256 * 1024 * 2};
    EpiUp E{(bf16*)(a.ws + WS_HID)}; pg8::Gemm g{1024};
    pg8::gemm_phase<EpiUp, GroupedOrder, true, true>((PG8_LAS unsigned char*)lds, g, S, E, wv);
}
__device__ __forceinline__ void p_gemm_down(const GemmArgs& a, unsigned char* lds, int wv) {
    const int* ctl = (const int*)(a.ws + WS_CTL);
    GroupedOrder S{ctl + CW_TEXP, ctl[CW_NT], 4, (int)gridDim.x, (int)blockIdx.x, (const char*)(a.ws + WS_HID), (size_t)256 * 512 * 2, (const char*)a.out, (size_t)1024 * 512 * 2, (size_t)256 * 512 * 2};
    EpiStoreBf16 E{(bf16*)(a.ws + WS_XS), 1024}; pg8::Gemm g{512};
    pg8::gemm_phase<EpiStoreBf16, GroupedOrder, true, true>((PG8_LAS unsigned char*)lds, g, S, E, wv);
}

__device__ __forceinline__ void p_attn(const PArgs& a, unsigned char* lds, int vb, int nvb, int wv) {
    const attn_body::bf16* Q = (const attn_body::bf16*)(a.ws + WS_Q); const attn_body::bf16* K = (const attn_body::bf16*)(a.ws + WS_K);
    const attn_body::bf16* V = (const attn_body::bf16*)(a.ws + WS_Z) + ZV; attn_body::bf16* O = (attn_body::bf16*)(a.ws + WS_YB);
    for (int p = vb; p < 512; p += nvb)
        for (int which = 0; which < 2; ++which) { const int bh = p >> 2, s = p & 3, qb = which ? 7 - s : s;
            attn_body::attn_unit<8>(bh >> 3, bh & 7, qb, Q, K, V, O, (char*)lds, wv); }
}

__device__ __forceinline__ void p_actprep(const PArgs& a, unsigned char* lds, int wv) {
    const int tid = mktid(wv); const bf16* z = (const bf16*)(a.ws + WS_Z); bf16* act = (bf16*)(a.ws + WS_ACT); const float* mu = a.in[7];
    for (int i = blockIdx.x * 512 + tid; i < NT * 32; i += gridDim.x * 512) { const int t = i >> 5, cg = i & 31, col = 1536 + 8 * cg; const bool hasp = (t & (SEQ - 1)) > 0;
        const v4u cw = *(const v4u*)(z + (size_t)t * INC + col); v4u pw = {0u, 0u, 0u, 0u}; if (hasp) pw = *(const v4u*)(z + (size_t)(t - 1) * INC + col);
        const float c8[8] = {bflo(cw.x), bfhi(cw.x), bflo(cw.y), bfhi(cw.y), bflo(cw.z), bfhi(cw.z), bflo(cw.w), bfhi(cw.w)}, p8[8] = {bflo(pw.x), bfhi(pw.x), bflo(pw.y), bfhi(pw.y), bflo(pw.z), bfhi(pw.z), bflo(pw.w), bfhi(pw.w)};
        const f32x4 m0 = *(const f32x4*)(mu + col), m1 = *(const f32x4*)(mu + col + 4); const float m8[8] = {m0.x, m0.y, m0.z, m0.w, m1.x, m1.y, m1.z, m1.w}; float v[8];
#pragma unroll
        for (int e = 0; e < 8; ++e) { const float x = c8[e] + (p8[e] - c8[e]) * m8[e]; v[e] = cg < 8 ? 1.0f - 2.0f * __builtin_amdgcn_rcpf(1.0f + __expf(2.0f * x)) : cg < 16 ? x : sigm(x); }
        v4u w; w.x = pk2(v[0], v[1]); w.y = pk2(v[2], v[3]); w.z = pk2(v[4], v[5]); w.w = pk2(v[6], v[7]);
        *(v4u*)(act + (size_t)t * 256 + 8 * cg) = w; }
}

namespace rw {
typedef short bf16x8 __attribute__((ext_vector_type(8)));
constexpr int MB = 8192;
__device__ __forceinline__ int SW(int r, int c) { return r * 128 + ((((c >> 3) ^ (r >> 1)) & 7) << 4) + (c & 7) * 2; }
__device__ __forceinline__ int SWG(int r, int c) { return r * 256 + ((((c >> 3) ^ r) & 15) << 4) + (c & 7) * 2; }
__device__ __forceinline__ int SWF(int r, int c) { return r * 256 + ((((c >> 2) ^ r) & 15) << 4) + (c & 3) * 4; }
enum { I_AT = 0, I_BT, I_AJ, I_BHJ, I_KHJ, I_ABRT, I_X5, I_L, I_LT, I_R0, I_R1, I_KT, I_RT, I_VJ, I_X14, I_GATE, I_VT, I_VT2, NBUF };
constexpr int OFF_F32 = NBUF * MB;
constexpr int OFF_CST = OFF_F32 + (64 * 3 + 512) * 4;
constexpr int LDS_NEED = OFF_CST + 14 * 64 * 4;

__device__ __forceinline__ bf16x8 ldfrag(const unsigned char* M, int row, int k) { return *(const bf16x8*)(M + SW(row, k)); }
__device__ __forceinline__ void mm(f32x4 (&acc)[2], const unsigned char* X, const unsigned char* Y, int mt, int nh, int fr, int fq) {
    const bf16x8 a0 = ldfrag(X, 16 * mt + fr, 8 * fq), a1 = ldfrag(X, 16 * mt + fr, 8 * fq + 32);
#pragma unroll
    for (int nt = 0; nt < 2; ++nt) { const bf16x8 b0 = ldfrag(Y, 16 * (2 * nh + nt) + fr, 8 * fq), b1 = ldfrag(Y, 16 * (2 * nh + nt) + fr, 8 * fq + 32);
        acc[nt] = __builtin_amdgcn_mfma_f32_16x16x32_bf16(a0, b0, acc[nt], 0, 0, 0); acc[nt] = __builtin_amdgcn_mfma_f32_16x16x32_bf16(a1, b1, acc[nt], 0, 0, 0); }
}
typedef short s16x4 __attribute__((ext_vector_type(4)));
typedef __attribute__((address_space(3))) s16x4* lds_s16x4p;
__device__ __forceinline__ bf16x8 ldfragT(const unsigned char* M, int row0, int kb, int fr, int fq) {
    const int k0 = kb + 8 * fq + (fr >> 2), c0 = row0 + 4 * (fr & 3);
    const s16x4 lo = __builtin_amdgcn_ds_read_tr16_b64_v4i16((lds_s16x4p)(M + SW(k0, c0))), hi = __builtin_amdgcn_ds_read_tr16_b64_v4i16((lds_s16x4p)(M + SW(k0 + 4, c0)));
    return (bf16x8){lo[0], lo[1], lo[2], lo[3], hi[0], hi[1], hi[2], hi[3]};
}
struct FA { bf16x8 k0, k1; };
struct FB { bf16x8 k0[2], k1[2]; };
__device__ __forceinline__ FA ldA(const unsigned char* X, int mt, int fr, int fq) { FA f; f.k0 = ldfrag(X, 16 * mt + fr, 8 * fq); f.k1 = ldfrag(X, 16 * mt + fr, 8 * fq + 32); return f; }
__device__ __forceinline__ FB ldB(const unsigned char* Y, int nh, int fr, int fq) { FB f;
#pragma unroll
    for (int nt = 0; nt < 2; ++nt) { f.k0[nt] = ldfrag(Y, 16 * (2 * nh + nt) + fr, 8 * fq); f.k1[nt] = ldfrag(Y, 16 * (2 * nh + nt) + fr, 8 * fq + 32); }
    return f; }
__device__ __forceinline__ FA ldAT(const unsigned char* XT, int mt, int fr, int fq) { FA f; f.k0 = ldfragT(XT, 16 * mt, 0, fr, fq); f.k1 = ldfragT(XT, 16 * mt, 32, fr, fq); return f; }
__device__ __forceinline__ FB ldBT(const unsigned char* YT, int nh, int fr, int fq) { FB f;
#pragma unroll
    for (int nt = 0; nt < 2; ++nt) { f.k0[nt] = ldfragT(YT, 16 * (2 * nh + nt), 0, fr, fq); f.k1[nt] = ldfragT(YT, 16 * (2 * nh + nt), 32, fr, fq); }
    return f; }
__device__ __forceinline__ void mma(f32x4 (&acc)[2], const FA& a, const FB& b) {
    acc[0] = __builtin_amdgcn_mfma_f32_16x16x32_bf16(a.k0, b.k0[0], acc[0], 0, 0, 0); acc[1] = __builtin_amdgcn_mfma_f32_16x16x32_bf16(a.k0, b.k0[1], acc[1], 0, 0, 0);
    acc[0] = __builtin_amdgcn_mfma_f32_16x16x32_bf16(a.k1, b.k1[0], acc[0], 0, 0, 0); acc[1] = __builtin_amdgcn_mfma_f32_16x16x32_bf16(a.k1, b.k1[1], acc[1], 0, 0, 0);
}
__device__ __forceinline__ void ldC(f32x4 (&acc)[2], const unsigned char* Z, int mt, int nh, int fr, int fq) {
#pragma unroll
    for (int nt = 0; nt < 2; ++nt) { const v2u w = *(const v2u*)(Z + SW(16 * (2 * nh + nt) + fr, 16 * mt + 4 * fq)); acc[nt] = (f32x4){bflo(w.x), bfhi(w.x), bflo(w.y), bfhi(w.y)}; }
}
__device__ __forceinline__ void storeT(unsigned char* Z, const f32x4 (&acc)[2], int mt, int nh, int fr, int fq) {
#pragma unroll
    for (int nt = 0; nt < 2; ++nt) { v2u w; w.x = pk2(acc[nt][0], acc[nt][1]); w.y = pk2(acc[nt][2], acc[nt][3]); *(v2u*)(Z + SW(16 * (2 * nh + nt) + fr, 16 * mt + 4 * fq)) = w; }
}
__device__ __forceinline__ void storeN(unsigned char* Z, const f32x4 (&acc)[2], int mt, int nh, int fr, int fq) {
#pragma unroll
    for (int nt = 0; nt < 2; ++nt)
#pragma unroll
        for (int r = 0; r < 4; ++r) *(unsigned short*)(Z + SW(16 * mt + 4 * fq + r, 16 * (2 * nh + nt) + fr)) = (unsigned short)f2bf(acc[nt][r]);
}
__device__ __forceinline__ void ld8bf(const unsigned char* p, float (&v)[8]) { const v4u w = *(const v4u*)p; v[0] = bflo(w.x); v[1] = bfhi(w.x); v[2] = bflo(w.y); v[3] = bfhi(w.y); v[4] = bflo(w.z); v[5] = bfhi(w.z); v[6] = bflo(w.w); v[7] = bfhi(w.w); }
__device__ __forceinline__ void st8bf(unsigned char* p, const float (&v)[8]) { v4u w; w.x = pk2(v[0], v[1]); w.y = pk2(v[2], v[3]); w.z = pk2(v[4], v[5]); w.w = pk2(v[6], v[7]); *(v4u*)p = w; }
__device__ __forceinline__ void ld8f(const float* p, float (&v)[8]) { const f32x4 a = *(const f32x4*)p, b = *(const f32x4*)(p + 4); v[0] = a.x; v[1] = a.y; v[2] = a.z; v[3] = a.w; v[4] = b.x; v[5] = b.y; v[6] = b.z; v[7] = b.w; }
__device__ __forceinline__ void ld8fs(const unsigned char* M, int r, int c, float (&v)[8]) { const f32x4 a = *(const f32x4*)(M + SWF(r, c)), b = *(const f32x4*)(M + SWF(r, c + 4)); v[0] = a.x; v[1] = a.y; v[2] = a.z; v[3] = a.w; v[4] = b.x; v[5] = b.y; v[6] = b.z; v[7] = b.w; }
__device__ __forceinline__ void un8(const v4u w, float (&v)[8]) { v[0] = bflo(w.x); v[1] = bfhi(w.x); v[2] = bflo(w.y); v[3] = bfhi(w.y); v[4] = bflo(w.z); v[5] = bfhi(w.z); v[6] = bflo(w.w); v[7] = bfhi(w.w); }
__device__ __forceinline__ void shift8(const v4u cw, const v4u pw, bool hasp, const float* mu, float (&v)[8]) {
    float c[8], p[8], m[8]; un8(cw, c); un8(pw, p); ld8f(mu, m);
#pragma unroll
    for (int e = 0; e < 8; ++e) { const float pe = hasp ? p[e] : 0.f; v[e] = c[e] + (pe - c[e]) * m[e]; }
}
__device__ __forceinline__ float tanh_fast(float x) { return 1.0f - 2.0f * __builtin_amdgcn_rcpf(1.0f + __expf(2.0f * x)); }

#define LBAR() do { asm volatile("s_waitcnt lgkmcnt(0)" ::: "memory"); __builtin_amdgcn_s_barrier(); asm volatile("" ::: "memory"); } while (0)
__device__ __forceinline__ void scan_unit(const PArgs& a, unsigned char* lds, int bh, int wv) {
    const int tid = mktid(wv), lane = tid & 63, wid = __builtin_amdgcn_readfirstlane(tid >> 6);
    const int mt = wid >> 1, nh = wid & 1; int fr = lane & 15, fq = lane >> 4;
    const int b = bh >> 3, h = bh & 7;
#define BUF(i) (lds + (i) * MB)
    float* GC = (float*)(lds + OFF_F32); float* BON = GC + 64; float* SSQ = BON + 64; float* SEGT = SSQ + 64;
    unsigned char* LWR = BUF(I_AT); unsigned char* LAR = BUF(I_AJ); unsigned char* LGR = BUF(I_KHJ); unsigned char* YTF = BUF(I_KHJ);
    unsigned char* ACTW = BUF(I_L); unsigned char* ACTA = BUF(I_LT); unsigned char* ACTG = BUF(I_R0);
    const bf16* z = (const bf16*)(a.ws + WS_Z); bf16* ya = (bf16*)(a.ws + WS_YA);
    const float* mu = a.in[7];
    bf16x8 fw[2], fa[2], fg[4];
    { const bf16* wlt = (const bf16*)(a.ws + WS_WLT) + (size_t)h * 4096 + (16 * mt + fr) * 64 + 8 * fq; const bf16* wat = (const bf16*)(a.ws + WS_WAT) + (size_t)h * 4096 + (16 * mt + fr) * 64 + 8 * fq;
      const bf16* wgt = (const bf16*)(a.ws + WS_WGT) + (size_t)h * 8192 + (16 * mt + fr) * 128 + 8 * fq;
      fw[0] = *(const bf16x8*)wlt; fw[1] = *(const bf16x8*)(wlt + 32); fa[0] = *(const bf16x8*)wat; fa[1] = *(const bf16x8*)(wat + 32);
#pragma unroll
      for (int ks = 0; ks < 4; ++ks) fg[ks] = *(const bf16x8*)(wgt + 32 * ks); }
    float* CST = (float*)(lds + OFF_CST);
    for (int i = tid; i < 14 * 64; i += 512) { const int blk = i >> 6, jj = i & 63; float v;
        if (blk < 3) v = mu[blk * 512 + h * 64 + jj]; else if (blk < 7) v = mu[1536 + (blk - 3) * 64 + jj]; else v = a.in[blk == 7 ? 8 : blk == 8 ? 10 : blk == 9 ? 13 : blk == 10 ? 14 : blk == 11 ? 15 : blk == 12 ? 16 : 17][h * 64 + jj];
        CST[i] = v; }
    int s0i = I_X14, aki = I_X5;
    for (int i = tid; i < MB / 4; i += 512) ((unsigned*)BUF(I_X14))[i] = 0u;
    LBAR();
    int pt = tid >> 3, j0 = 8 * (tid & 7);
    const int colh = h * 64 + j0;
    const int zoff0 = colh, zoff1 = 512 + colh, zoff2 = 1024 + colh;
    const bf16* actb = (const bf16*)(a.ws + WS_ACT);
    v4u zc[3], zq[3], za[4];
#define ZLOAD(cc) do { const size_t tr_ = (size_t)b * SEQ + (cc) * 64 + pt; const bf16* zr_ = z + tr_ * INC; const bf16* zs_ = ((cc) * 64 + pt) > 0 ? zr_ - INC : zr_; const bf16* ar_ = actb + tr_ * 256 + j0; \
        zc[0] = *(const v4u*)(zr_ + zoff0); zc[1] = *(const v4u*)(zr_ + zoff1); zc[2] = *(const v4u*)(zr_ + zoff2); \
        zq[0] = *(const v4u*)(zs_ + zoff0); zq[1] = *(const v4u*)(zs_ + zoff1); zq[2] = *(const v4u*)(zs_ + zoff2); \
        za[0] = *(const v4u*)(ar_); za[1] = *(const v4u*)(ar_ + 64); za[2] = *(const v4u*)(ar_ + 128); za[3] = *(const v4u*)(ar_ + 192); } while (0)
#define ESTAGE(VTB, TT_) \
        { float y[8], vv[8], g8[8], lg[8], lb[8]; ld8fs(YTF, pt, j0, y); ld8bf((VTB) + SW(pt, j0), vv); ld8bf(BUF(I_GATE) + SW(pt, j0), g8); \
          ld8f(CST + 12 * 64 + j0, lg); ld8f(CST + 13 * 64 + j0, lb); \
          float sm = 0.f; \
_Pragma("unroll") \
          for (int e = 0; e < 8; ++e) sm += y[e]; \
          const float mean = red8(sm) * (1.0f / 64.0f); float sq = 0.f; \
_Pragma("unroll") \
          for (int e = 0; e < 8; ++e) { y[e] -= mean; sq += y[e] * y[e]; } \
          const float rstd = rsqrtf(red8(sq) * (1.0f / 64.0f) + 64e-5f), bon = BON[pt]; \
_Pragma("unroll") \
          for (int e = 0; e < 8; ++e) y[e] = (y[e] * rstd * lg[e] + lb[e] + bon * vv[e]) * g8[e]; \
          ypend.x = pk2(y[0], y[1]); ypend.y = pk2(y[2], y[3]); ypend.z = pk2(y[4], y[5]); ypend.w = pk2(y[6], y[7]); ypoff = (TT_) * RWW + colh; }
    ZLOAD(0);
    v4u ypend = {0u, 0u, 0u, 0u}; size_t ypoff = 0;
    for (int c = 0; c < SEQ / 64; ++c) {
        asm volatile("" : "+v"(fr), "+v"(fq), "+v"(pt), "+v"(j0));
        const int s = c * 64 + pt; const size_t t = (size_t)b * SEQ + s; const bool hasp = s > 0;
        if (c > 0) { ESTAGE(((c - 1) & 1) ? BUF(I_VT2) : BUF(I_VT), t - 64) }
        { float v[8];
          shift8(zc[0], zq[0], hasp, CST + 0 * 64 + j0, v); st8bf(BUF(I_RT) + SW(pt, j0), v);
          shift8(zc[1], zq[1], hasp, CST + 1 * 64 + j0, v); st8bf(BUF(I_KT) + SW(pt, j0), v);
          { float kkc[8], ss = 0.f; ld8f(CST + 9 * 64 + j0, kkc);
#pragma unroll
            for (int e = 0; e < 8; ++e) { const float q = v[e] * kkc[e]; ss += q * q; }
            ss = red8(ss); if (j0 == 0) SSQ[pt] = rsqrtf(fmaxf(ss, 1e-24f)); }
          shift8(zc[2], zq[2], hasp, CST + 2 * 64 + j0, v); st8bf(((c & 1) ? BUF(I_VT2) : BUF(I_VT)) + SW(pt, j0), v);
          *(v4u*)(ACTW + SW(pt, j0)) = za[0]; *(v4u*)(ACTA + SW(pt, j0)) = za[1]; *(v4u*)(ACTG + SWG(pt, j0)) = za[2]; *(v4u*)(ACTG + SWG(pt, 64 + j0)) = za[3]; }
        LBAR();
        f32x4 aw[2], aa[2], ag[2];
#pragma unroll
        for (int nt = 0; nt < 2; ++nt) { const int tr = 16 * (2 * nh + nt) + fr; const f32x4 zero = {0.f, 0.f, 0.f, 0.f};
            aw[nt] = __builtin_amdgcn_mfma_f32_16x16x32_bf16(fw[0], ldfrag(ACTW, tr, 8 * fq), zero, 0, 0, 0); aw[nt] = __builtin_amdgcn_mfma_f32_16x16x32_bf16(fw[1], ldfrag(ACTW, tr, 8 * fq + 32), aw[nt], 0, 0, 0);
            aa[nt] = __builtin_amdgcn_mfma_f32_16x16x32_bf16(fa[0], ldfrag(ACTA, tr, 8 * fq), zero, 0, 0, 0); aa[nt] = __builtin_amdgcn_mfma_f32_16x16x32_bf16(fa[1], ldfrag(ACTA, tr, 8 * fq + 32), aa[nt], 0, 0, 0);
            ag[nt] = zero;
#pragma unroll
            for (int ks = 0; ks < 4; ++ks) ag[nt] = __builtin_amdgcn_mfma_f32_16x16x32_bf16(fg[ks], *(const bf16x8*)(ACTG + SWG(tr, 8 * fq + 32 * ks)), ag[nt], 0, 0, 0); }
#pragma unroll
        for (int nt = 0; nt < 2; ++nt) { const int tr = 16 * (2 * nh + nt) + fr, jc = 16 * mt + 4 * fq;
            *(f32x4*)(LWR + SWF(tr, jc)) = aw[nt]; *(f32x4*)(LAR + SWF(tr, jc)) = aa[nt]; *(f32x4*)(LGR + SWF(tr, jc)) = ag[nt]; }
        LBAR();
        float lwv[8], an[8], bb[8], k2[8], rr[8], gg[8], vv8[8], p8[8];
        { const int j = lane, tw = wid;
          const float w0c = CST[7 * 64 + j], a0c = CST[8 * 64 + j], kkc = CST[9 * 64 + j], kac = CST[10 * 64 + j], rkc = CST[11 * 64 + j];
          const unsigned char* vtb = (c & 1) ? BUF(I_VT2) : BUF(I_VT);
          float bo[8], av[8];
#pragma unroll
          for (int u = 0; u < 8; ++u) { const int t8 = 8 * tw + u;
              const float lw = *(const float*)(LWR + SWF(t8, j)), la = *(const float*)(LAR + SWF(t8, j)); gg[u] = *(const float*)(LGR + SWF(t8, j));
              rr[u] = bflo(*(const unsigned short*)(BUF(I_RT) + SW(t8, j))); const float kx = bflo(*(const unsigned short*)(BUF(I_KT) + SW(t8, j))); vv8[u] = bflo(*(const unsigned short*)(vtb + SW(t8, j)));
              lwv[u] = -0.606531f * sigm(w0c + lw); av[u] = sigm(a0c + la);
              const float kn = kx * kkc * SSQ[t8]; an[u] = -kn; bb[u] = kn * av[u];
              k2[u] = kx * (1.0f + (av[u] - 1.0f) * kac); bo[u] = rr[u] * k2[u] * rkc; }
          wave_sum8(bo);
          if (j == 0) {
#pragma unroll
              for (int u = 0; u < 8; ++u) BON[8 * tw + u] = bo[u]; }
          p8[0] = lwv[0];
#pragma unroll
          for (int u = 1; u < 8; ++u) p8[u] = p8[u - 1] + lwv[u];
          SEGT[tw * 64 + j] = p8[7]; }
        LBAR();
        { const int j = lane, tw = wid; float sg8[8];
#pragma unroll
          for (int s2 = 0; s2 < 8; ++s2) sg8[s2] = SEGT[s2 * 64 + j];
          float base = 0.f, tot = 0.f;
#pragma unroll
          for (int s2 = 0; s2 < 8; ++s2) { tot += sg8[s2]; base += (s2 < tw) ? sg8[s2] : 0.f; }
          const float gcj = __expf(tot); if (tw == 7) GC[j] = gcj;
          float eprev = __expf(base);
          float o0[8], o1[8], o2[8], o3[8], ob[8], ok[8];
#pragma unroll
          for (int u = 0; u < 8; ++u) { const float L = p8[u] + base; const float e1 = __expf(L), ie1 = __builtin_amdgcn_rcpf(e1), ep = eprev, eh = gcj * ie1; eprev = e1;
              o0[u] = an[u] * ep; o1[u] = bb[u] * ie1; o2[u] = k2[u] * ie1; o3[u] = rr[u] * e1; ob[u] = bb[u] * eh; ok[u] = k2[u] * eh;
              *(unsigned short*)(BUF(I_GATE) + SW(8 * tw + u, j)) = (unsigned short)f2bf(gg[u]); }
          st8bf(BUF(I_AJ) + SW(j, 8 * tw), o0); st8bf(BUF(I_BT) + SW(j, 8 * tw), o1); st8bf(BUF(I_KT) + SW(j, 8 * tw), o2); st8bf(BUF(I_RT) + SW(j, 8 * tw), o3);
          st8bf(BUF(I_BHJ) + SW(j, 8 * tw), ob); st8bf(BUF(I_KHJ) + SW(j, 8 * tw), ok); st8bf(BUF(I_VJ) + SW(j, 8 * tw), vv8); }
        if (c > 0) *(v4u*)(ya + ypoff) = ypend;
        if (c + 1 < SEQ / 64) ZLOAD(c + 1);
        LBAR();
#define MASK(acc, cond) _Pragma("unroll") for (int nt = 0; nt < 2; ++nt) _Pragma("unroll") for (int r = 0; r < 4; ++r) { const int m_ = 16 * mt + 4 * fq + r, n_ = 16 * (2 * nh + nt) + fr; if (!(cond)) acc[nt][r] = 0.f; }
        { const f32x4 zero = {0.f, 0.f, 0.f, 0.f}; f32x4 aL[2] = {zero, zero}, aL2[2] = {zero, zero}, aK[2] = {zero, zero}, aR[2] = {zero, zero};
          const FA fAT = ldAT(BUF(I_AJ), mt, fr, fq), fBTa = ldAT(BUF(I_BT), mt, fr, fq); const FB fBT = ldBT(BUF(I_BT), nh, fr, fq), fKT = ldBT(BUF(I_KT), nh, fr, fq), fRT = ldBT(BUF(I_RT), nh, fr, fq), fATb = ldBT(BUF(I_AJ), nh, fr, fq);
          mma(aL, fAT, fBT);
          mma(aL2, fBTa, fATb);
          mma(aK, fAT, fKT);
          mma(aR, fBTa, fRT);
          MASK(aL, m_ > n_) MASK(aL2, n_ > m_) MASK(aK, n_ < m_) MASK(aR, m_ <= n_)
#pragma unroll
          for (int nt = 0; nt < 2; ++nt)
#pragma unroll
              for (int r = 0; r < 4; ++r) { const int m_ = 16 * mt + 4 * fq + r, n_ = 16 * (2 * nh + nt) + fr; if (m_ == n_) aL2[nt][r] = 1.0f; }
          storeT(BUF(I_L), aL, mt, nh, fr, fq); storeT(BUF(I_R0), aL2, mt, nh, fr, fq);
          storeT(BUF(aki), aK, mt, nh, fr, fq);
          storeT(BUF(I_ABRT), aR, mt, nh, fr, fq); }
        LBAR();
#pragma unroll
        for (int k = 1; k <= 6; ++k) {
            unsigned char* Pc = (k & 1) ? BUF(I_L) : BUF(I_AT); unsigned char* Pn = (k & 1) ? BUF(I_AT) : BUF(I_L);
            unsigned char* Rc = (k & 1) ? BUF(I_R1) : BUF(I_R0); unsigned char* Rn = (k & 1) ? BUF(I_R0) : BUF(I_R1);
            const f32x4 zero = {0.f, 0.f, 0.f, 0.f}; f32x4 aP[2] = {zero, zero}, aRr[2] = {zero, zero};
            FA fP, fPTa; FB fPT, fR;
            if (k <= 5) { fP = ldAT(Pc, mt, fr, fq); fPT = ldB(Pc, nh, fr, fq); }
            if (k >= 2) { fPTa = ldA(Pc, mt, fr, fq); fR = ldB(Rc, nh, fr, fq); ldC(aRr, Rc, mt, nh, fr, fq); }
            if (k <= 5) mma(aP, fP, fPT);
            if (k >= 2) mma(aRr, fPTa, fR);
            if (k <= 5) storeT(Pn, aP, mt, nh, fr, fq);
            if (k >= 2) storeT(Rn, aRr, mt, nh, fr, fq);
            LBAR();
        }
        { const f32x4 zero = {0.f, 0.f, 0.f, 0.f}; f32x4 a1[2] = {zero, zero}, a2[2] = {zero, zero};
          const FA fTT = ldA(BUF(I_R1), mt, fr, fq); const FB fAJ = ldB(BUF(I_AJ), nh, fr, fq), fAK = ldB(BUF(aki), nh, fr, fq);
          mma(a1, fTT, fAJ); mma(a2, fTT, fAK);
          storeT(BUF(I_L), a1, mt, nh, fr, fq);
          storeT(BUF(I_LT), a2, mt, nh, fr, fq); }
        LBAR();
        { const f32x4 zero = {0.f, 0.f, 0.f, 0.f}; f32x4 aMY[2], aNY[2] = {zero, zero}, aMS[2] = {zero, zero}, aNS[2];
          const FA fG1 = ldA(BUF(I_L), mt, fr, fq), fG2 = ldA(BUF(I_LT), mt, fr, fq), fKTa = ldAT(BUF(I_KT), mt, fr, fq);
          const FB fAB = ldB(BUF(I_ABRT), nh, fr, fq), fRT = ldBT(BUF(I_RT), nh, fr, fq), fBH = ldB(BUF(I_BHJ), nh, fr, fq);
#pragma unroll
          for (int nt = 0; nt < 2; ++nt)
#pragma unroll
              for (int r = 0; r < 4; ++r) aMY[nt][r] = bflo(*(const unsigned short*)(BUF(I_RT) + SW(16 * mt + 4 * fq + r, 16 * (2 * nh + nt) + fr)));
          ldC(aNS, BUF(I_KHJ), mt, nh, fr, fq);
          mma(aNY, fKTa, fRT);
          mma(aMY, fG1, fAB);
          mma(aMS, fG1, fBH);
          mma(aNS, fG2, fBH);
          MASK(aNY, m_ <= n_)
          mma(aNY, fG2, fAB);
#pragma unroll
          for (int nt = 0; nt < 2; ++nt)
#pragma unroll
              for (int r = 0; r < 4; ++r) { const int m_ = 16 * mt + 4 * fq + r, n_ = 16 * (2 * nh + nt) + fr; if (m_ == n_) aMS[nt][r] += GC[m_]; }
          storeT(BUF(I_AT), aMY, mt, nh, fr, fq); storeT(BUF(I_BT), aNY, mt, nh, fr, fq); storeT(BUF(I_AJ), aMS, mt, nh, fr, fq); storeT(BUF(I_R0), aNS, mt, nh, fr, fq); }
        LBAR();
        { const f32x4 zero = {0.f, 0.f, 0.f, 0.f}; f32x4 aY[2] = {zero, zero}, aS[2] = {zero, zero};
          const FA fS0a = ldA(BUF(s0i), mt, fr, fq), fVJa = ldA(BUF(I_VJ), mt, fr, fq), fMS = ldA(BUF(I_AJ), mt, fr, fq), fNS = ldA(BUF(I_R0), mt, fr, fq);
          const FB fMY = ldB(BUF(I_AT), nh, fr, fq), fNY = ldB(BUF(I_BT), nh, fr, fq), fS0 = ldB(BUF(s0i), nh, fr, fq), fVJ = ldB(BUF(I_VJ), nh, fr, fq);
          mma(aY, fS0a, fMY); mma(aS, fMS, fS0); mma(aY, fVJa, fNY); mma(aS, fNS, fVJ);
#pragma unroll
          for (int nt = 0; nt < 2; ++nt) *(f32x4*)(YTF + SWF(16 * (2 * nh + nt) + fr, 16 * mt + 4 * fq)) = aY[nt];
          storeT(BUF(aki), aS, mt, nh, fr, fq); }
        LBAR();
#undef MASK
        { const int tmp = s0i; s0i = aki; aki = tmp; }
    }
    { const int c = SEQ / 64; const size_t tprev = (size_t)b * SEQ + (c - 1) * 64 + pt; ESTAGE(((c - 1) & 1) ? BUF(I_VT2) : BUF(I_VT), tprev) }
    *(v4u*)(ya + ypoff) = ypend;
    LBAR();
#undef ESTAGE
#undef BUF
#undef ZLOAD
}
#undef LBAR
}

__device__ __forceinline__ void p_norm2_route(const PArgs& a, unsigned char* lds, int wv) {
    typedef short bf16x8 __attribute__((ext_vector_type(8)));
    const int tid = mktid(wv), lane = tid & 63, fr = lane & 15, fq = lane >> 4;
    const bf16* x1 = (const bf16*)(a.ws + WS_X1B); const float* mod = (const float*)(a.ws + WS_MOD); const float* gm2 = (const float*)(a.ws + WS_GM2); const float* cbt = (const float*)(a.ws + WS_CB);
    int* rte = (int*)(a.ws + WS_RTE); float* rtw = (float*)(a.ws + WS_RTW); int* rnk = (int*)(a.ws + WS_RNK); unsigned* cnt = (unsigned*)(a.ws + WS_CTL) + CW_CNT;
    float* PL = (float*)lds;
    float* PS = PL + 8 * 32 * 48;
    float* RS_ = PS + 8 * 32;
    float* FL = RS_ + 32;
    unsigned* HIST = (unsigned*)(FL + 32 * 48);
    unsigned* LRK = HIST + 32;
    if (tid < 32) HIST[tid] = 0u;
    __syncthreads();
    int gcount = 0;
    bf16x8 wh[4][3], wl[4][3];
    { const bf16* wrh = (const bf16*)(a.ws + WS_WRH) + fr * 1024 + 128 * wv + 8 * fq; const bf16* wrl = (const bf16*)(a.ws + WS_WRL) + fr * 1024 + 128 * wv + 8 * fq;
#pragma unroll
      for (int ks = 0; ks < 4; ++ks)
#pragma unroll
          for (int nt = 0; nt < 3; ++nt) { wh[ks][nt] = *(const bf16x8*)(wrh + nt * 16 * 1024 + 32 * ks); wl[ks][nt] = *(const bf16x8*)(wrl + nt * 16 * 1024 + 32 * ks); } }
    for (int grp = blockIdx.x; grp < NT / 32; grp += gridDim.x) {
        const int row0 = grp * 32, b = row0 >> 11;
        f32x4 acc[3][2];
#pragma unroll
        for (int nt = 0; nt < 3; ++nt) { acc[nt][0] = (f32x4){0.f, 0.f, 0.f, 0.f}; acc[nt][1] = acc[nt][0]; }
        float ssq[2] = {0.f, 0.f};
#pragma unroll
        for (int rt = 0; rt < 2; ++rt) {
            float xs[4][8];
#pragma unroll
            for (int ks = 0; ks < 4; ++ks) rw::ld8bf((const unsigned char*)(x1 + (size_t)(row0 + 16 * rt + fr) * DM + 128 * wv + 32 * ks + 8 * fq), xs[ks]);
#pragma unroll
            for (int ks = 0; ks < 4; ++ks) { float gm[8]; rw::ld8f(gm2 + b * 1024 + 128 * wv + 32 * ks + 8 * fq, gm); unsigned hw[4], lw[4];
#pragma unroll
                for (int e = 0; e < 4; ++e) { const float x0 = xs[ks][2 * e], x1v = xs[ks][2 * e + 1]; ssq[rt] += x0 * x0 + x1v * x1v; const float g0 = x0 * gm[2 * e], g1 = x1v * gm[2 * e + 1];
                    hw[e] = pk2(g0, g1); lw[e] = pk2(g0 - bflo(hw[e]), g1 - bfhi(hw[e])); }
                const v4u hv = {hw[0], hw[1], hw[2], hw[3]}, lv = {lw[0], lw[1], lw[2], lw[3]}; const bf16x8 bh = __builtin_bit_cast(bf16x8, hv), bl = __builtin_bit_cast(bf16x8, lv);
#pragma unroll
                for (int nt = 0; nt < 3; ++nt) { acc[nt][rt] = __builtin_amdgcn_mfma_f32_16x16x32_bf16(wh[ks][nt], bh, acc[nt][rt], 0, 0, 0); acc[nt][rt] = __builtin_amdgcn_mfma_f32_16x16x32_bf16(wl[ks][nt], bh, acc[nt][rt], 0, 0, 0);
                    acc[nt][rt] = __builtin_amdgcn_mfma_f32_16x16x32_bf16(wh[ks][nt], bl, acc[nt][rt], 0, 0, 0); } } }
#pragma unroll
        for (int rt = 0; rt < 2; ++rt) {
#pragma unroll
            for (int nt = 0; nt < 3; ++nt) *(f32x4*)(PL + (wv * 32 + 16 * rt + fr) * 48 + 16 * nt + 4 * fq) = acc[nt][rt];
            float s = ssq[rt]; s += __builtin_bit_cast(float, __builtin_amdgcn_ds_swizzle(__builtin_bit_cast(int, s), 0x401F));
            { const unsigned u = __builtin_bit_cast(unsigned, s); auto rr = __builtin_amdgcn_permlane32_swap(u, u, false, false); s = __builtin_bit_cast(float, (unsigned)rr[0]) + __builtin_bit_cast(float, (unsigned)rr[1]); }
            if (fq == 0) PS[wv * 32 + 16 * rt + fr] = s; }
        __syncthreads();
        { const int r = tid >> 4, c = tid & 15; float s0 = 0.f, s1 = 0.f, s2 = 0.f, sq = 0.f;
#pragma unroll
          for (int w = 0; w < 8; ++w) { const float* p = PL + (w * 32 + r) * 48; s0 += p[c]; s1 += p[c + 16]; s2 += p[c + 32]; sq += PS[w * 32 + r]; }
          const float rstd = rsqrtf(sq * (1.0f / DM) + 1e-6f); const float* cb = cbt + b * 48;
          FL[r * 48 + c] = rstd * s0 + cb[c]; FL[r * 48 + c + 16] = rstd * s1 + cb[c + 16]; FL[r * 48 + c + 32] = rstd * s2 + cb[c + 32];
          if (c == 0) ((float*)(a.ws + WS_RSTD))[row0 + r] = rstd; }
        __syncthreads();
        if (tid < 32) { const int m = row0 + tid; const float* lg = FL + tid * 48;
            int gi = 0; float gm = lg[0];
#pragma unroll
            for (int i = 1; i < 4; ++i) if (lg[i] > gm) { gm = lg[i]; gi = i; }
            float gs = 0.f;
#pragma unroll
            for (int i = 0; i < 4; ++i) gs += __expf(lg[i] - gm);
            const float pg = 1.0f / gs;
            float el[8];
#pragma unroll
            for (int k = 0; k < 8; ++k) el[k] = lg[4 + gi * 8 + k];
            int e1 = 0; float m1 = el[0];
#pragma unroll
            for (int k = 1; k < 8; ++k) if (el[k] > m1) { m1 = el[k]; e1 = k; }
            int e2 = -1; float m2 = -INFINITY;
#pragma unroll
            for (int k = 0; k < 8; ++k) if (k != e1 && el[k] > m2) { m2 = el[k]; e2 = k; }
            const float q2 = __expf(m2 - m1); const float w1 = pg / (1.0f + q2), w2 = pg * q2 / (1.0f + q2);
            const int ea = gi * 8 + e1, eb = gi * 8 + e2; rte[2 * m] = ea; rte[2 * m + 1] = eb; rtw[2 * m] = w1; rtw[2 * m + 1] = w2;
            LRK[gcount * 64 + 2 * tid] = atomicAdd(HIST + ea, 1u) | ((unsigned)ea << 24); LRK[gcount * 64 + 2 * tid + 1] = atomicAdd(HIST + eb, 1u) | ((unsigned)eb << 24); }
        ++gcount;
        __syncthreads();
    }
    if (tid < 32) { const unsigned n = HIST[tid]; HIST[tid] = n ? atomicAdd(cnt + tid * CNT_PAD, n) : 0u; }
    __syncthreads();
    for (int i = tid; i < gcount * 64; i += 512) { const int gi_ = i >> 6, e = i & 63; const int m2 = 2 * ((blockIdx.x + gi_ * gridDim.x) * 32) + e; const unsigned lr = LRK[i]; rnk[m2] = (int)(HIST[lr >> 24] + (lr & 0xffffffu)); }
    __syncthreads();
}
__device__ __forceinline__ void p_moe_gather(const PArgs& a, unsigned char* lds, int wv) {
    int* off = (int*)lds;
    const int tid = mktid(wv), lane = tid & 63, gw = blockIdx.x * 8 + (tid >> 6), NGW = gridDim.x * 8;
    int* ctl = (int*)(a.ws + WS_CTL); const unsigned* cnt = (const unsigned*)ctl + CW_CNT;
    if (tid == 0) { int o = 0, nt = 0;
        for (int e = 0; e < NEXP; ++e) { off[e] = o; const int tiles = ((int)cnt[e * CNT_PAD] + 255) >> 8;
            if (blockIdx.x == 0) for (int i = 0; i < tiles; ++i) ctl[CW_TEXP + nt + i] = e;
            nt += tiles; o += tiles * 256; }
        if (blockIdx.x == 0) ctl[CW_NT] = nt; }
    __syncthreads();
    const int* rte = (const int*)(a.ws + WS_RTE); const int* rnk = (const int*)(a.ws + WS_RNK); int* pos = (int*)(a.ws + WS_POS);
    const bf16* x1 = (const bf16*)(a.ws + WS_X1B); bf16* xs = (bf16*)(a.ws + WS_XS); const float* rstdv = (const float*)(a.ws + WS_RSTD);
    const float* mod = (const float*)(a.ws + WS_MOD); const float* gm2 = (const float*)(a.ws + WS_GM2);
    for (int t = gw; t < NT; t += NGW) { const int b = t >> 11; const int p0 = off[rte[2 * t]] + rnk[2 * t], p1 = off[rte[2 * t + 1]] + rnk[2 * t + 1]; if (lane == 0) { pos[2 * t] = p0; pos[2 * t + 1] = p1; }
        const float rstd = rstdv[t];
#pragma unroll
        for (int hf = 0; hf < 2; ++hf) { const int col = 8 * lane + 512 * hf; float xv[8], gm[8], sh[8], o[8];
            rw::ld8bf((const unsigned char*)(x1 + (size_t)t * DM + col), xv); rw::ld8f(gm2 + b * 1024 + col, gm); rw::ld8f(mod + b * 6144 + 3072 + col, sh);
#pragma unroll
            for (int e = 0; e < 8; ++e) o[e] = xv[e] * gm[e] * rstd + sh[e];
            v4u w; w.x = pk2(o[0], o[1]); w.y = pk2(o[2], o[3]); w.z = pk2(o[4], o[5]); w.w = pk2(o[6], o[7]);
            *(v4u*)(xs + (size_t)p0 * DM + col) = w; *(v4u*)(xs + (size_t)p1 * DM + col) = w; } }
}
__device__ __forceinline__ void p_combine(const PArgs& a, unsigned char* lds, int wv) {
    const int tid = mktid(wv), lane = tid & 63, gw = blockIdx.x * 8 + (tid >> 6), NGW = gridDim.x * 8;
    const float* mod = (const float*)(a.ws + WS_MOD); const int* pos = (const int*)(a.ws + WS_POS); const float* rtw = (const float*)(a.ws + WS_RTW);
    const bf16* ys = (const bf16*)(a.ws + WS_XS); float* out = a.out;
    for (int m = gw; m < NT; m += NGW) { const int b = m >> 11; const int p0 = pos[2 * m], p1 = pos[2 * m + 1]; const float w0 = rtw[2 * m], w1 = rtw[2 * m + 1];
        f32x4* o = (f32x4*)(out + (size_t)m * DM) + lane; const v2u* xb = (const v2u*)((const bf16*)(a.ws + WS_X1B) + (size_t)m * DM) + lane; const v2u* y0 = (const v2u*)(ys + (size_t)p0 * DM) + lane; const v2u* y1 = (const v2u*)(ys + (size_t)p1 * DM) + lane;
#pragma unroll
        for (int j = 0; j < 4; ++j) { const int col = 4 * (lane + 64 * j); const f32x4 g2 = *(const f32x4*)(mod + b * 6144 + 5120 + col); const v2u a0 = y0[64 * j], a1 = y1[64 * j];
            const f32x4 e0 = {bflo(a0.x), bfhi(a0.x), bflo(a0.y), bfhi(a0.y)}, e1 = {bflo(a1.x), bfhi(a1.x), bflo(a1.y), bfhi(a1.y)};
            const v2u xw = xb[64 * j]; const f32x4 xv = {bflo(xw.x), bfhi(xw.x), bflo(xw.y), bfhi(xw.y)};
            o[64 * j] = xv + g2 * (e0 * w0 + e1 * w1); } }
}

#define XB_TMO      128
#define XB_XCNT(j)  (256  + 64 * (j))
#define XB_XSUB(j)  (1280 + 64 * (j))
#define XB_XGEN(j)  (2304 + 64 * (j))
#define XB_TOP      3328
#define XB_TOPGEN   3392
#define XCD_BAR_WORDS 3456
#define XB_SPIN_CAP (1u << 22)

__device__ __forceinline__ unsigned xb_ld(unsigned* p)              { return __hip_atomic_load(p, __ATOMIC_RELAXED, __HIP_MEMORY_SCOPE_AGENT); }
__device__ __forceinline__ unsigned xb_add(unsigned* p, unsigned v) { return __hip_atomic_fetch_add(p, v, __ATOMIC_RELAXED, __HIP_MEMORY_SCOPE_AGENT); }
__device__ __forceinline__ unsigned xb_xcc_id() { return (unsigned)__builtin_amdgcn_s_getreg((3 << 11) | 20) & 0xFu; }
#define XB_SPIN(cond, bar) do { unsigned _sp = 0; while (cond) { __builtin_amdgcn_s_sleep(1); \
    if ((++_sp & 255u) == 0u) { if (xb_ld(&(bar)[XB_TMO])) break; if (_sp > XB_SPIN_CAP) { atomicAdd(&(bar)[XB_TMO], 1u); break; } } } } while (0)

struct XcdBarrier {
    unsigned* bar; unsigned x;
    volatile LAS unsigned* st;
};

__device__ __forceinline__ XcdBarrier xcd_barrier_post(unsigned* bar, volatile LAS unsigned* st, int wv) {
    XcdBarrier b; b.bar = bar; b.x = xb_xcc_id(); b.st = st;
    if (mktid(wv) == 0) (void)xb_add(&bar[XB_XCNT(b.x)], 1u);
    return b;
}
__device__ __forceinline__ void xcd_barrier_complete(unsigned* bar, unsigned x, unsigned& nloc, unsigned& nx) {
    const unsigned G = gridDim.x * gridDim.y * gridDim.z;
    unsigned sum, cnt, mine, sp = 0u;
    for (;;) {
        sum = 0u; cnt = 0u; mine = 0u;
#pragma unroll
        for (unsigned j = 0; j < 16; ++j) { const unsigned c = xb_ld(&bar[XB_XCNT(j)]); sum += c; cnt += (c > 0u) ? 1u : 0u; mine = (j == x) ? c : mine; }
        if (sum == G) break;
        __builtin_amdgcn_s_sleep(1);
        if ((++sp & 255u) == 0u) { if (xb_ld(&bar[XB_TMO])) break; if (sp > XB_SPIN_CAP) { atomicAdd(&bar[XB_TMO], 1u); break; } }
    }
    nloc = mine > 0u ? mine : 1u; nx = cnt > 0u ? cnt : 1u;
}

__device__ __forceinline__ void xcd_barrier(const XcdBarrier& b, int wv) {
    asm volatile("s_waitcnt vmcnt(0)" ::: "memory");
    __syncthreads();
    if (mktid(wv) == 0) {
        unsigned* bar = b.bar;
        __builtin_amdgcn_s_waitcnt(0);
        unsigned nloc = b.st[0], nx = b.st[1];
        if (nloc == 0u) { xcd_barrier_complete(bar, b.x, nloc, nx); b.st[0] = nloc; b.st[1] = nx; }
        const unsigned old = xb_add(&bar[XB_XSUB(b.x)], 1u);
        const unsigned gen = old / nloc;
        if (old + 1u == (gen + 1u) * nloc) {
            __builtin_amdgcn_fence(__ATOMIC_RELEASE, "agent");
            asm volatile("s_waitcnt vmcnt(0)" ::: "memory");
            const unsigned og = xb_add(&bar[XB_TOP], 1u);
            const unsigned tg = og / nx;
            if (og + 1u == (tg + 1u) * nx) xb_add(&bar[XB_TOPGEN], 1u);
            else XB_SPIN(xb_ld(&bar[XB_TOPGEN]) == tg, bar);
            __builtin_amdgcn_fence(__ATOMIC_ACQUIRE, "agent");
            xb_add(&bar[XB_XGEN(b.x)], 1u);
            asm volatile("s_waitcnt vmcnt(0)" ::: "memory");
        } else {
            XB_SPIN(xb_ld(&bar[XB_XGEN(b.x)]) == gen, bar);
            __builtin_amdgcn_fence(__ATOMIC_ACQUIRE, "agent");
            asm volatile("s_waitcnt vmcnt(0)" ::: "memory");
        }
    }
    __syncthreads();
}

constexpr int LDS_BYTES = 160 * 1024, MISC_OFF = LDS_BYTES - 256;
static_assert(rw::LDS_NEED <= MISC_OFF, "scan LDS");
constexpr int CW_BAR = 4096;

__global__ void __launch_bounds__(512, 2) mega_fwd(PArgs a) {
    extern __shared__ __attribute__((aligned(16))) unsigned char lds[];
    volatile LAS unsigned* MISC = (volatile LAS unsigned*)((LAS unsigned char*)lds + MISC_OFF);
    const int wv = __builtin_amdgcn_readfirstlane((int)threadIdx.x >> 6);
    { const int t0 = mktid(wv); if (t0 < 64) MISC[t0] = 0u; }
    __syncthreads();
    XcdBarrier bar = xcd_barrier_post((unsigned*)(a.ws + WS_CTL) + CW_BAR, MISC + 8, wv);
    GemmArgs g; g.ws = a.ws; g.x = a.in[0]; g.out = a.out; g.qg = a.in[18]; g.kg = a.in[19];
    const int G = (int)gridDim.x, bx = (int)blockIdx.x;

    p_prep_weights(a, lds, wv); __syncthreads(); p_ada(a, lds, wv);
    xcd_barrier(bar, wv);
    p_norm1(a, lds, wv);
    xcd_barrier(bar, wv);
    p_gemm_in(g, lds, wv);
    xcd_barrier(bar, wv);
    p_actprep(a, lds, wv);
    xcd_barrier(bar, wv);
    { const int nscan = G / 2;
      if (bx < nscan) { for (int bh = bx; bh < 128; bh += nscan) rw::scan_unit(a, lds, bh, wv); }
      else p_attn(a, lds, bx - nscan, G - nscan, wv); }
    __syncthreads(); p_prep_experts_dyn(a, lds, wv);
    xcd_barrier(bar, wv);
    p_gemm_merge(g, lds, wv);
    xcd_barrier(bar, wv);
    p_gemm_out(g, lds, wv);
    xcd_barrier(bar, wv);
    p_norm2_route(a, lds, wv);
    xcd_barrier(bar, wv);
    p_moe_gather(a, lds, wv);
    xcd_barrier(bar, wv);
    p_gemm_up(g, lds, wv);
    xcd_barrier(bar, wv);
    p_gemm_down(g, lds, wv);
    xcd_barrier(bar, wv);
    p_combine(a, lds, wv);
}

extern "C" void kernel_launch(void* const* d_in, const int* in_sizes, int n_in, void* d_out, int out_size, void* d_ws, size_t ws_size, hipStream_t stream) {
    static int grid = 0;
    if (grid == 0) {
        if (n_in != 30 || out_size != NT * DM || ws_size < WS_END) { fprintf(stderr, "kernel_launch: unexpected shapes (n_in %d, out %d, ws %zu)\n", n_in, out_size, ws_size); grid = -1; return; }
        int dev = 0, cus = 0, per_cu = 0;
        if (hipGetDevice(&dev) != hipSuccess || hipDeviceGetAttribute(&cus, hipDeviceAttributeMultiprocessorCount, dev) != hipSuccess) { grid = -1; return; }
        if (hipFuncSetAttribute((const void*)mega_fwd, hipFuncAttributeMaxDynamicSharedMemorySize, LDS_BYTES) != hipSuccess) { fprintf(stderr, "kernel_launch: hipFuncSetAttribute failed\n"); grid = -1; return; }
        if (hipOccupancyMaxActiveBlocksPerMultiprocessor(&per_cu, (const void*)mega_fwd, 512, LDS_BYTES) != hipSuccess || per_cu < 1) { fprintf(stderr, "kernel_launch: occupancy query says %d blocks per CU\n", per_cu); (void)hipGetLastError(); grid = -1; return; }
        grid = cus;
    }
    if (grid < 0) return;
    (void)hipMemsetAsync((char*)d_ws + WS_CTL, 0, 65536, stream);
    PArgs p{}; for (int i = 0; i < 30; ++i) p.in[i] = (const float*)d_in[i]; p.out = (float*)d_out; p.ws = (unsigned char*)d_ws;
    hipLaunchKernelGGL(mega_fwd, dim3(grid), dim3(512), LDS_BYTES, stream, p);
}
```

```cpp
#include <hip/hip_runtime.h>
#include <cstdio>
#include <cstdint>
__device__ __forceinline__ int mktid(int wv) { int l; asm volatile("v_mbcnt_lo_u32_b32 %0, -1, 0\n\tv_mbcnt_hi_u32_b32 %0, -1, %0" : "=v"(l)); return (wv << 6) | l; }
template <int CTRL> __device__ __forceinline__ float dppf(float v) { return __builtin_bit_cast(float, __builtin_amdgcn_update_dpp(0, __builtin_bit_cast(int, v), CTRL, 0xF, 0xF, true)); }
__device__ __forceinline__ float red4(float v) { v += dppf<0xB1>(v); v += dppf<0x4E>(v); return v; }
__device__ __forceinline__ float red8(float v) { v = red4(v); v += dppf<0x141>(v); return v; }
__device__ __forceinline__ float red16(float v) { v = red8(v); v += dppf<0x140>(v); return v; }
__device__ __forceinline__ float wave_sum(float v) { v = red16(v);
    v += __builtin_bit_cast(float, __builtin_amdgcn_ds_swizzle(__builtin_bit_cast(int, v), 0x401F));
    const unsigned u = __builtin_bit_cast(unsigned, v); auto rr = __builtin_amdgcn_permlane32_swap(u, u, false, false);
    return __builtin_bit_cast(float, (unsigned)rr[0]) + __builtin_bit_cast(float, (unsigned)rr[1]); }
__device__ __forceinline__ void wave_sum8(float (&v)[8]) {
#pragma unroll
    for (int i = 0; i < 8; ++i) v[i] += dppf<0xB1>(v[i]);
#pragma unroll
    for (int i = 0; i < 8; ++i) v[i] += dppf<0x4E>(v[i]);
#pragma unroll
    for (int i = 0; i < 8; ++i) v[i] += dppf<0x141>(v[i]);
#pragma unroll
    for (int i = 0; i < 8; ++i) v[i] += dppf<0x140>(v[i]);
#pragma unroll
    for (int i = 0; i < 8; ++i) v[i] += __builtin_bit_cast(float, __builtin_amdgcn_ds_swizzle(__builtin_bit_cast(int, v[i]), 0x401F));
#pragma unroll
    for (int i = 0; i < 8; ++i) { const unsigned u = __builtin_bit_cast(unsigned, v[i]); auto rr = __builtin_amdgcn_permlane32_swap(u, u, false, false); v[i] = __builtin_bit_cast(float, (unsigned)rr[0]) + __builtin_bit_cast(float, (unsigned)rr[1]); }
}
__device__ __forceinline__ float lane_get(float v, int src) { return __builtin_bit_cast(float, __builtin_amdgcn_ds_bpermute(src << 2, __builtin_bit_cast(int, v))); }
namespace pg8 {
#define PG8_LAS __attribute__((address_space(3)))
typedef unsigned short bf16_t;
typedef short bf16x8 __attribute__((ext_vector_type(8)));
typedef float f32x4 __attribute__((ext_vector_type(4)));
typedef unsigned u32x4 __attribute__((ext_vector_type(4)));
constexpr int BM = 256, BK = 64, HALF = 128, HTB = HALF * BK * 2  , STAGE_BYTES = 8 * HTB, NXCD = 8, WGM = 4;

__host__ __device__ __forceinline__ int lds_byte(int r, int c) { const int st = (r >> 4) * 2 + (c >> 5), rr = r & 15, cc = c & 31, ob = rr * 64 + cc * 2; return st * 1024 + (ob ^ (((ob >> 9) & 1) << 5)); }
__host__ __device__ __forceinline__ void stage_rc(int b, int& R, int& C) { const int st = b / 1024, sb = b % 1024, swz = sb ^ (((sb >> 9) & 1) << 5); R = (st >> 1) * 16 + swz / 64; C = (st & 1) * 32 + (swz % 64) / 2; }
__host__ __device__ __forceinline__ int perm32(int rho) { const int n = rho >> 4, i = rho & 15; return 8 * (i >> 2) + 4 * n + (i & 3); }
struct Unit { int pm, pn, aux; const char* a; const char* b; };
struct Gemm { int K; };

struct StaticOrder {
    int nM, nN, nwg, G, c; const char* A; const char* Bt; size_t tstep;
    __device__ void init(const void* A_, const void* Bt_, int M, int N, int K, int G_, int c_) { nM = M / BM; nN = N / BM; nwg = nM * nN; G = G_; c = c_; A = (const char*)A_; Bt = (const char*)Bt_; tstep = (size_t)BM * K * 2; }
    __device__ bool next(int i, Unit& u) const {
        const long L = (long)i * G + c; if (L >= nwg) return false;
        int wgid = (int)L; { const int q = nwg / NXCD, r = nwg % NXCD, xcd = wgid % NXCD, off = wgid / NXCD; wgid = (xcd < r ? xcd * (q + 1) : r * (q + 1) + (xcd - r) * q) + off; }
        const int nig = WGM * nN, gid = wgid / nig, fm = gid * WGM, gsz = (nM - fm) < WGM ? (nM - fm) : WGM;
        u.aux = 0; u.pm = fm + ((wgid % nig) % gsz); u.pn = (wgid % nig) / gsz; u.a = A + (size_t)u.pm * tstep; u.b = Bt + (size_t)u.pn * tstep; return true;
    }
    __device__ __forceinline__ void a_ready(const Unit&) const {}
    __device__ __forceinline__ void done(const Unit&) const {}
};
__device__ __forceinline__ unsigned cvt_pk_bf16(float lo, float hi) { unsigned r; asm volatile("v_cvt_pk_bf16_f32 %0, %1, %2" : "=v"(r) : "v"(lo), "v"(hi)); return r; }
template <class Epi, class Sched, bool ALIGN_EPI = false, bool SP2 = false>
__device__ __forceinline__ void gemm_phase(PG8_LAS unsigned char* lds, const Gemm g, const Sched& S, const Epi& E, int wv) {
    const int tid = mktid(wv), wid = __builtin_amdgcn_readfirstlane(tid >> 6), lane = tid & 63, wr = wid >> 2, wc = wid & 3, fr = lane & 15, fq = lane >> 4;
    const int K = g.K, nt = K / BK;
    unsigned voffA[2], voffB[2];
#pragma unroll
    for (int i = 0; i < 2; ++i) { int R, C; stage_rc(tid * 16 + i * 8192, R, C); const int Rb = Epi::PERM ? ((R & ~31) + perm32(R & 31)) : R;
        voffA[i] = (unsigned)(R * K + C) * 2u; voffB[i] = (unsigned)(Rb * K + C) * 2u; }
    const size_t kstep = (size_t)(BK * 2);
    const size_t hstep = (size_t)HALF * K * 2;
        const unsigned ldsw = (unsigned)wid * 1024u;
    const int aoff = lds_byte(wr * 64 + fr, fq * 8), boff = lds_byte(wc * 32 + fr, fq * 8);
#define PG8_SA(b, h) (((b) * 2 + (h)) * HTB)
#define PG8_SB(b, h) ((4 + (b) * 2 + (h)) * HTB)
#define PG8_STAGE(bufoff, gbase, voff) do { _Pragma("unroll") for (int _i = 0; _i < 2; ++_i) \
        __builtin_amdgcn_global_load_lds((const unsigned*)((const char*)(gbase) + (voff)[_i]), (PG8_LAS unsigned*)(lds + (bufoff) + ldsw + _i * 8192), 16, 0, 0); } while (0)
#define PG8_LDA(dst, b, h) do { _Pragma("unroll") for (int m = 0; m < 4; ++m) _Pragma("unroll") for (int k = 0; k < 2; ++k) dst[m][k] = *(const PG8_LAS bf16x8*)(lds + PG8_SA(b, h) + aoff + m * 2048 + k * 1024); } while (0)
#define PG8_LDB(dst, b, h) do { _Pragma("unroll") for (int n = 0; n < 2; ++n) _Pragma("unroll") for (int k = 0; k < 2; ++k) dst[n][k] = *(const PG8_LAS bf16x8*)(lds + PG8_SB(b, h) + boff + n * 2048 + k * 1024); } while (0)
#define PG8_MMA(ai, bj, At, Bt) do { __builtin_amdgcn_s_setprio(1); _Pragma("unroll") for (int m = 0; m < 4; ++m) _Pragma("unroll") for (int n = 0; n < 2; ++n) _Pragma("unroll") for (int k = 0; k < 2; ++k) \
        acc[ai][bj][m][n] = __builtin_amdgcn_mfma_f32_16x16x32_bf16(Bt[n][k], At[m][k], acc[ai][bj][m][n], 0, 0, 0); __builtin_amdgcn_s_setprio(0); } while (0)
#define PG8_WAIT_V(n) asm volatile("s_waitcnt vmcnt(" #n ")" ::: "memory")
#define PG8_WAIT_L(n) asm volatile("s_waitcnt lgkmcnt(" #n ")" ::: "memory")
#define PG8_BAR __builtin_amdgcn_s_barrier()
#define PG8_SCHED __builtin_amdgcn_sched_barrier(0)
    Unit cur, nxt; int ui = 0;
    if (!S.next(0, cur)) return;
    f32x4 acc[2][2][4][2];
#pragma unroll
    for (int a = 0; a < 2; ++a)
#pragma unroll
        for (int b = 0; b < 2; ++b)
#pragma unroll
            for (int m = 0; m < 4; ++m)
#pragma unroll
                for (int n = 0; n < 2; ++n) acc[a][b][m][n] = (f32x4){0.f, 0.f, 0.f, 0.f};
    bf16x8 At[4][2], B0[2][2], B1[2][2];
    const char* cA = cur.a; const char* cB = cur.b;
    S.a_ready(cur);
    if constexpr (SP2) {
        PG8_STAGE(PG8_SB(0, 0), cB, voffB); PG8_STAGE(PG8_SB(0, 1), cB + hstep, voffB); PG8_STAGE(PG8_SA(0, 0), cA, voffA); PG8_STAGE(PG8_SA(0, 1), cA + hstep, voffA);
        if (wr == 1) PG8_BAR;
        PG8_WAIT_V(2); PG8_BAR;
        PG8_STAGE(PG8_SB(1, 0), cB + kstep, voffB); PG8_STAGE(PG8_SA(1, 0), cA + kstep, voffA); PG8_STAGE(PG8_SB(1, 1), cB + hstep + kstep, voffB);
        PG8_WAIT_V(6); PG8_BAR;
    } else {
        PG8_STAGE(PG8_SB(0, 0), cB, voffB); PG8_STAGE(PG8_SA(0, 0), cA, voffA); PG8_STAGE(PG8_SB(0, 1), cB + hstep, voffB); PG8_STAGE(PG8_SA(0, 1), cA + hstep, voffA);
        if (wr == 1) PG8_BAR;
        PG8_WAIT_V(4); PG8_BAR;
        PG8_STAGE(PG8_SB(1, 0), cB + kstep, voffB); PG8_STAGE(PG8_SA(1, 0), cA + kstep, voffA); PG8_STAGE(PG8_SB(1, 1), cB + hstep + kstep, voffB);
        PG8_WAIT_V(6); PG8_BAR;
    }
    for (;;) {
        const bool has_next = S.next(ui + 1, nxt);
        const char* nA = has_next ? nxt.a : cA; const char* nB = has_next ? nxt.b : cB;
        for (int t = 0; t < nt; t += 2) {
            const bool last = (t == nt - 2);
            const char* a1 = cA + (size_t)(t + 1) * kstep;
            const char* a2 = last ? nA : cA + (size_t)(t + 2) * kstep; const char* b2 = last ? nB : cB + (size_t)(t + 2) * kstep;
            const char* a3 = a2 + kstep; const char* b3 = b2 + kstep;
            if (last && has_next) S.a_ready(nxt);
            if constexpr (SP2) {
            PG8_LDB(B0, 0, 0); PG8_LDB(B1, 0, 1); PG8_SCHED; PG8_LDA(At, 0, 0); PG8_STAGE(PG8_SA(1, 1), a1 + hstep, voffA);
            PG8_WAIT_V(8); PG8_WAIT_L(0); PG8_BAR; PG8_MMA(0, 0, At, B0); PG8_MMA(0, 1, At, B1); PG8_BAR; PG8_SCHED;
            PG8_LDA(At, 0, 1); PG8_STAGE(PG8_SB(0, 0), b2, voffB); PG8_STAGE(PG8_SB(0, 1), b2 + hstep, voffB); PG8_STAGE(PG8_SA(0, 0), a2, voffA);
            PG8_WAIT_V(8); PG8_WAIT_L(0); PG8_BAR; PG8_MMA(1, 0, At, B0); PG8_MMA(1, 1, At, B1); PG8_BAR; PG8_SCHED;
            PG8_LDB(B0, 1, 0); PG8_LDB(B1, 1, 1); PG8_SCHED; PG8_LDA(At, 1, 0); PG8_STAGE(PG8_SA(0, 1), a2 + hstep, voffA);
            PG8_WAIT_V(8); PG8_WAIT_L(0); PG8_BAR; PG8_MMA(0, 0, At, B0); PG8_MMA(0, 1, At, B1); PG8_BAR; PG8_SCHED;
            PG8_LDA(At, 1, 1); PG8_STAGE(PG8_SB(1, 0), b3, voffB); PG8_STAGE(PG8_SB(1, 1), b3 + hstep, voffB); PG8_STAGE(PG8_SA(1, 0), a3, voffA);
            PG8_WAIT_V(8); PG8_WAIT_L(0); PG8_BAR; PG8_MMA(1, 0, At, B0); PG8_MMA(1, 1, At, B1); PG8_BAR; PG8_SCHED;
            } else {
            PG8_LDB(B0, 0, 0); PG8_SCHED; PG8_LDA(At, 0, 0); PG8_STAGE(PG8_SA(1, 1), a1 + hstep, voffA);
            PG8_WAIT_L(8); PG8_BAR; PG8_WAIT_L(0); PG8_MMA(0, 0, At, B0); PG8_BAR; PG8_SCHED;
            PG8_LDB(B1, 0, 1); PG8_STAGE(PG8_SB(0, 0), b2, voffB);
            PG8_BAR; PG8_WAIT_L(0); PG8_MMA(0, 1, At, B1); PG8_BAR;
            PG8_LDA(At, 0, 1); PG8_STAGE(PG8_SA(0, 0), a2, voffA);
            PG8_BAR; PG8_WAIT_L(0); PG8_MMA(1, 0, At, B0); PG8_BAR; PG8_SCHED;
            PG8_STAGE(PG8_SB(0, 1), b2 + hstep, voffB);
            PG8_WAIT_V(6); PG8_BAR; PG8_MMA(1, 1, At, B1); PG8_BAR;
            PG8_LDB(B0, 1, 0); PG8_SCHED; PG8_LDA(At, 1, 0); PG8_STAGE(PG8_SA(0, 1), a2 + hstep, voffA);
            PG8_WAIT_L(8); PG8_BAR; PG8_WAIT_L(0); PG8_MMA(0, 0, At, B0); PG8_BAR; PG8_SCHED;
            PG8_LDB(B1, 1, 1); PG8_STAGE(PG8_SB(1, 0), b3, voffB);
            PG8_BAR; PG8_WAIT_L(0); PG8_MMA(0, 1, At, B1); PG8_BAR;
            PG8_LDA(At, 1, 1); PG8_STAGE(PG8_SA(1, 0), a3, voffA);
            PG8_BAR; PG8_WAIT_L(0); PG8_MMA(1, 0, At, B0); PG8_BAR; PG8_SCHED;
            PG8_STAGE(PG8_SB(1, 1), b3 + hstep, voffB);
            PG8_WAIT_V(6); PG8_BAR; PG8_MMA(1, 1, At, B1); PG8_BAR;
            }
        }
        if constexpr (ALIGN_EPI) { if (wr == 0) PG8_BAR; }
        bool keep = false;
        if constexpr (!Epi::AFTER_DRAIN) { if constexpr (Epi::CHAIN) keep = E.chain(acc, cur, wr, wc, fr, fq); else E(acc, cur, wr, wc, fr, fq); S.done(cur); }
        if (!has_next) break;
        if (!keep) {
#pragma unroll
        for (int a = 0; a < 2; ++a)
#pragma unroll
            for (int b = 0; b < 2; ++b)
#pragma unroll
                for (int m = 0; m < 4; ++m)
#pragma unroll
                    for (int n = 0; n < 2; ++n) acc[a][b][m][n] = (f32x4){0.f, 0.f, 0.f, 0.f};
        }
        cur = nxt; cA = nA; cB = nB; ++ui;
        if constexpr (ALIGN_EPI) { if (wr == 1) PG8_BAR; }
    }
    PG8_WAIT_V(0);
    if constexpr (!ALIGN_EPI) { if (wr == 0) PG8_BAR; }
    PG8_BAR;
    if constexpr (Epi::AFTER_DRAIN) { E.fused(acc, cur, wr, wc, fr, fq, lds, wid, lane); S.done(cur); }
#undef PG8_SA
#undef PG8_SB
#undef PG8_STAGE
#undef PG8_LDA
#undef PG8_LDB
#undef PG8_MMA
#undef PG8_WAIT_V
#undef PG8_WAIT_L
#undef PG8_BAR
#undef PG8_SCHED
}
}
#include <hip/hip_bf16.h>
#include <cmath>
namespace attn_body {
using bf16=__hip_bfloat16;
using bf16x8=__attribute__((ext_vector_type(8)))short;
using s16x4=__attribute__((ext_vector_type(4)))short;
using f32x16=__attribute__((ext_vector_type(16)))float;
using u32x4=__attribute__((ext_vector_type(4)))unsigned;
constexpr int NHEAD=8,SEQ=2048,D=64,PQ=512,PK=512,PV=4352,PO=512;
constexpr int NW=8,QBLK=32,QB=QBLK*NW,KVBLK=64,NQB=SEQ/QB;
__device__ __forceinline__ int crow(int r,int hi){return (r&3)+8*(r>>2)+4*hi;}
#define SBAR() __builtin_amdgcn_sched_barrier(0)
__device__ __forceinline__ void cmask(f32x16&p0,f32x16&p1,int jb,int qrel,int hi){
  const float NEG=-INFINITY; int kb=64*jb+4*hi;
  #pragma unroll
  for(int r=0;r<16;++r){int kv=kb+(r&3)+8*(r>>2); if(kv>qrel)p0[r]=NEG; if(kv+32>qrel)p1[r]=NEG;}
}

constexpr int NSLOT=3, SLOTB=8192;
constexpr int LDS_K=0, LDS_V=NSLOT*SLOTB, LDS_WS=2*NSLOT*SLOTB, LDS_OST=LDS_WS+NW*64*4, LDS_SEL=LDS_OST+NW*4096, LDS_KM=LDS_SEL+256, LDS_KP=LDS_KM+7*64*4, LDS_BYTES=LDS_KP+8*64*4;
constexpr float C2=0.125f*1.4426950408889634f;
__device__ __forceinline__ void glds16(const void*gsrc,unsigned lds_dst){unsigned keep;
  asm volatile("s_mov_b32 %0, m0\n\ts_mov_b32 m0, %2\n\ts_nop 0\n\tglobal_load_lds_dwordx4 %1, off\n\ts_mov_b32 m0, %0":"=&s"(keep):"v"(gsrc),"s"(lds_dst):"memory");}
__device__ __forceinline__ float max3f(float a,float b,float c){float r;asm("v_max3_f32 %0, %1, %2, %3":"=v"(r):"v"(a),"v"(b),"v"(c));return r;}
__device__ __forceinline__ float max2f(float a,float b){float r;asm("v_max_f32_e32 %0, %1, %2":"=v"(r):"v"(a),"v"(b));return r;}
__device__ __forceinline__ float fadd_s(float a,float b){float r;asm("v_add_f32_e32 %0, %1, %2":"=v"(r):"v"(a),"v"(b));return r;}
__device__ __forceinline__ float fsub_s(float a,float b){float r;asm("v_sub_f32_e32 %0, %1, %2":"=v"(r):"v"(a),"v"(b));return r;}
typedef float f32x2_t __attribute__((ext_vector_type(2))); typedef __bf16 bf16x2_t __attribute__((ext_vector_type(2)));
__device__ __forceinline__ unsigned cvtpk_s(float lo,float hi){f32x2_t v={lo,hi};bf16x2_t b=__builtin_convertvector(v,bf16x2_t);return __builtin_bit_cast(unsigned,b);}
#define WAIT_BAR(N) asm volatile("s_waitcnt vmcnt(" #N ") lgkmcnt(0)\n\ts_barrier":::"memory")

__device__ __forceinline__ void qkt(f32x16&p0,f32x16&p1,const char*Kslot,const bf16x8*qr,const f32x16&negm,int r32,int hi){
  const char*kb=Kslot+hi*1024+r32*16;
  #pragma unroll
  for(int d0=0;d0<4;++d0){
    const bf16x8 b0=*reinterpret_cast<const bf16x8*>(kb+d0*2048);
    const bf16x8 b1=*reinterpret_cast<const bf16x8*>(kb+d0*2048+512);
    if(d0==0){p0=__builtin_amdgcn_mfma_f32_32x32x16_bf16(b0,qr[0],negm,0,0,0);p1=__builtin_amdgcn_mfma_f32_32x32x16_bf16(b1,qr[0],negm,0,0,0);}
    else{p0=__builtin_amdgcn_mfma_f32_32x32x16_bf16(b0,qr[d0],p0,0,0,0);p1=__builtin_amdgcn_mfma_f32_32x32x16_bf16(b1,qr[d0],p1,0,0,0);}}
}
typedef __attribute__((address_space(3))) const char* lds_cptr;
typedef short v4i16_t __attribute__((ext_vector_type(4)));
__device__ __forceinline__ void kload8(bf16x8*kf,lds_cptr kp){
  kf[0]=*(const __attribute__((address_space(3))) bf16x8*)(kp);      kf[1]=*(const __attribute__((address_space(3))) bf16x8*)(kp+512);
  kf[2]=*(const __attribute__((address_space(3))) bf16x8*)(kp+2048); kf[3]=*(const __attribute__((address_space(3))) bf16x8*)(kp+2560);
  kf[4]=*(const __attribute__((address_space(3))) bf16x8*)(kp+4096); kf[5]=*(const __attribute__((address_space(3))) bf16x8*)(kp+4608);
  kf[6]=*(const __attribute__((address_space(3))) bf16x8*)(kp+6144); kf[7]=*(const __attribute__((address_space(3))) bf16x8*)(kp+6656);
}
__device__ __forceinline__ void kload2(bf16x8*kf,lds_cptr kp,int j){ kf[2*j]=*(const __attribute__((address_space(3))) bf16x8*)(kp+j*2048); kf[2*j+1]=*(const __attribute__((address_space(3))) bf16x8*)(kp+j*2048+512); }
__device__ __forceinline__ s16x4 vtr(lds_cptr p){ return __builtin_bit_cast(s16x4,__builtin_amdgcn_ds_read_tr16_b64_v4i16((__attribute__((address_space(3))) v4i16_t*)p)); }
__device__ __forceinline__ float rowmax(const f32x16&p0,const f32x16&p1){
  float a=max3f(p0[0],p0[1],p1[0]),b=max3f(p0[2],p0[3],p1[1]);a=max3f(a,p1[2],p1[3]);
  #pragma unroll
  for(int r=4;r<16;r+=4){a=max3f(a,p0[r],p0[r+1]);b=max3f(b,p0[r+2],p0[r+3]);a=max3f(a,p1[r],p1[r+1]);b=max3f(b,p1[r+2],p1[r+3]);}
  const float m=max2f(a,b);
  auto rr=__builtin_amdgcn_permlane32_swap(__float_as_uint(m),__float_as_uint(m),false,false);
  return max2f(__uint_as_float(rr[0]),__uint_as_float(rr[1]));
}
__device__ __forceinline__ void pv(f32x16*o,int vb,bf16x8 pa0,bf16x8 pa1,bf16x8 pa2,bf16x8 pa3){
  #pragma unroll
  for(int d0=0;d0<2;++d0){s16x4 lo[4],hi[4];
    #pragma unroll
    for(int ks=0;ks<4;++ks){
      asm volatile("ds_read_b64_tr_b16 %0,%1 offset:%c2":"=&v"(lo[ks]):"v"(vb),"i"(d0*4096+ks*1024):"memory");
      asm volatile("ds_read_b64_tr_b16 %0,%1 offset:%c2":"=&v"(hi[ks]):"v"(vb),"i"(d0*4096+ks*1024+512):"memory");}
    asm volatile("s_waitcnt lgkmcnt(0)":::"memory");SBAR();
    #define PK(k) (bf16x8){lo[k][0],lo[k][1],lo[k][2],lo[k][3],hi[k][0],hi[k][1],hi[k][2],hi[k][3]}
    o[d0]=__builtin_amdgcn_mfma_f32_32x32x16_bf16(pa0,PK(0),o[d0],0,0,0);
    o[d0]=__builtin_amdgcn_mfma_f32_32x32x16_bf16(pa1,PK(1),o[d0],0,0,0);
    o[d0]=__builtin_amdgcn_mfma_f32_32x32x16_bf16(pa2,PK(2),o[d0],0,0,0);
    o[d0]=__builtin_amdgcn_mfma_f32_32x32x16_bf16(pa3,PK(3),o[d0],0,0,0);
    #undef PK
  }
}

#ifndef ATTN_STORE16
#define ATTN_STORE16(p,v) (*(u32x4*)(p)=(v))
#endif
template<int THRL> __device__ __forceinline__ void attn_unit(int b,int h,int qb,const bf16*Q,const bf16*__restrict__ K,const bf16*__restrict__ V,bf16*O,char*shm,int wv){
  const int tid=mktid(wv),lane=tid&63,r32=lane&31,hi=lane>>5;     const int wid=__builtin_amdgcn_readfirstlane(tid>>6);
  const long rowbase=(long)b*SEQ; const int q0=qb*QB;
  if(qb>3){ float*KMl=(float*)(shm+LDS_KM); float*KPl=(float*)(shm+LDS_KP); const int c8=tid&7, rl=tid>>3;
    for(int n=0;n<qb;++n){ float sm[8];
      #pragma unroll
      for(int d=0;d<8;++d)sm[d]=0.f;
      #pragma unroll
      for(int rr=0;rr<4;++rr){ const u32x4 w=*reinterpret_cast<const u32x4*>(K+(rowbase+n*256+rl+64*rr)*PK+h*D+8*c8);
        sm[0]+=__uint_as_float(w[0]<<16);sm[1]+=__uint_as_float(w[0]&0xffff0000u);sm[2]+=__uint_as_float(w[1]<<16);sm[3]+=__uint_as_float(w[1]&0xffff0000u);
        sm[4]+=__uint_as_float(w[2]<<16);sm[5]+=__uint_as_float(w[2]&0xffff0000u);sm[6]+=__uint_as_float(w[3]<<16);sm[7]+=__uint_as_float(w[3]&0xffff0000u); }
      #pragma unroll
      for(int d=0;d<8;++d){ float v=sm[d];
        v+=__builtin_bit_cast(float,__builtin_amdgcn_ds_swizzle(__builtin_bit_cast(int,v),0x201F));
        v+=__builtin_bit_cast(float,__builtin_amdgcn_ds_swizzle(__builtin_bit_cast(int,v),0x401F));
        { const unsigned u=__builtin_bit_cast(unsigned,v); auto rr2=__builtin_amdgcn_permlane32_swap(u,u,false,false); v=__uint_as_float((unsigned)rr2[0])+__uint_as_float((unsigned)rr2[1]); }
        sm[d]=v; }
      if(lane<8){
        #pragma unroll
        for(int d=0;d<8;++d)KPl[wid*64+8*lane+d]=sm[d]; }
      asm volatile("s_waitcnt vmcnt(0) lgkmcnt(0)\n\ts_barrier":::"memory");
      if(tid<64){ float s8=0.f;
        #pragma unroll
        for(int w8=0;w8<8;++w8)s8+=KPl[w8*64+tid];
        KMl[n*64+tid]=s8*(1.0f/256.0f); }
      asm volatile("s_waitcnt lgkmcnt(0)\n\ts_barrier":::"memory"); } }
  if(tid<QB){ unsigned sel=(qb<=3)?((1u<<qb)-1u):0u;
    if(qb>3){ const bf16*qp=Q+(rowbase+q0+tid)*PQ+h*D; const float*km=(const float*)(shm+LDS_KM); float gate[7];
      #pragma unroll
      for(int j=0;j<7;++j)gate[j]=0.f;
      #pragma unroll 1
      for(int i=0;i<8;++i){ const u32x4 w=*reinterpret_cast<const u32x4*>(qp+8*i); float qv[8];
        qv[0]=__uint_as_float(w[0]<<16);qv[1]=__uint_as_float(w[0]&0xffff0000u);qv[2]=__uint_as_float(w[1]<<16);qv[3]=__uint_as_float(w[1]&0xffff0000u);
        qv[4]=__uint_as_float(w[2]<<16);qv[5]=__uint_as_float(w[2]&0xffff0000u);qv[6]=__uint_as_float(w[3]<<16);qv[7]=__uint_as_float(w[3]&0xffff0000u);
        #pragma unroll
        for(int j=0;j<7;++j) if(j<qb){ const float*kp=km+j*64+8*i;
          #pragma unroll
          for(int d=0;d<8;++d)gate[j]+=qv[d]*kp[d]; } }
      #pragma unroll
      for(int rep=0;rep<3;++rep){ float best=-INFINITY; int bi=0;
        #pragma unroll
        for(int j=0;j<7;++j) if(j<qb&&!((sel>>j)&1u)&&gate[j]>best){best=gate[j];bi=j;}
        sel|=1u<<bi; } }
    ((unsigned char*)(shm+LDS_SEL))[tid]=(unsigned char)sel; }
  asm volatile("s_waitcnt vmcnt(0) lgkmcnt(0)\n\ts_barrier":::"memory");
  const bf16*Qw=Q+(rowbase+q0+wid*QBLK)*PQ+h*D;
  const bf16*Kh=K+rowbase*PK+h*D,*Vh=V+rowbase*PV+h*D;
  const unsigned lds0=(unsigned)(uintptr_t)shm;
  float*wsf=(float*)(shm+LDS_WS)+wid*64;
  const bf16*ksrc=Kh+(long)lane*PK+wid*8;
  const bf16*vsrc=Vh+(long)(16*(wid&3)+(lane>>2))*PV+(wid>>2)*32+(lane&3)*8;
  const unsigned kdst=lds0+LDS_K+wid*1024, vdst=lds0+LDS_V+wid*1024;
  #define TROW(t) ((long)(((t)<4)?(q0+(t)*KVBLK):(((t)-4)*KVBLK)))
  #define DMA_K(t,slot) glds16(ksrc+TROW(t)*PK,(unsigned)__builtin_amdgcn_readfirstlane(kdst+(slot)))
  #define DMA_V(t,slot) glds16(vsrc+TROW(t)*PV,(unsigned)__builtin_amdgcn_readfirstlane(vdst+(slot)))
  const int vb0=(int)(lds0+LDS_V)+((lane>>4)&1)*32+(lane&3)*8+(4*hi+((lane&15)>>2))*64;
  const char*Kbase=shm+LDS_K; bf16x8 kf[8];
  const lds_cptr shm3=(lds_cptr)shm; const lds_cptr kp0=shm3+LDS_K+hi*1024+r32*16; const lds_cptr vp0=shm3+LDS_V+((lane>>4)&1)*32+(lane&3)*8+(4*hi+((lane&15)>>2))*64;
  const int NT=(q0+QB)/KVBLK;
  DMA_K(0,0);DMA_V(0,0);DMA_K(1,SLOTB);
  bf16x8 qr[4];
  #pragma unroll
  for(int d0=0;d0<4;++d0)qr[d0]=*reinterpret_cast<const bf16x8*>(&Qw[(long)r32*PQ+d0*16+hi*8]);
  float mhat=0.f,l_reg=0.f;f32x16 o[2];o[0]=f32x16{};o[1]=f32x16{};
  const int qrel=wid*QBLK+r32;
  const unsigned selb=((const unsigned char*)(shm+LDS_SEL))[qrel];
  #define CMASK(P0,P1,t) cmask(P0,P1,(t),qrel,hi)
  #define SUBREF(C0,C1,t) do{ const float sb_=(((t)<4)||((selb>>(((t)-4)>>2))&1u))?mhat:INFINITY; _Pragma("unroll") for(int r_=0;r_<16;++r_){C0[r_]-=sb_;C1[r_]-=sb_;} }while(0)
  bool resc=false;
  #define START(P0,P1) do{ const float rm=rowmax(P0,P1); resc=false; \
    { const float dl=rm; mhat=fadd_s(mhat,dl); \
      _Pragma("unroll") for(int r=0;r<16;++r){P0[r]=fsub_s(P0[r],dl);P1[r]=fsub_s(P1[r],dl);} \
      } \
    _Pragma("unroll") for(int r=0;r<16;++r)P0[r]=__builtin_amdgcn_exp2f(P0[r]); }while(0)
  #define RESC() do{ if(resc){ asm volatile("s_waitcnt lgkmcnt(0)":::"memory"); \
      _Pragma("unroll") for(int d_=0;d_<2;++d_) _Pragma("unroll") for(int r=0;r<16;++r)o[d_][r]*=wsf[crow(r,hi)]; } }while(0)
  f32x16 pA0,pA1,pB0,pB1;
  int sl_prev=0,sl_cur=0,sl_next=SLOTB;
  #define ROT() do{sl_prev=sl_cur;sl_cur=sl_next;sl_next=(sl_next==(NSLOT-1)*SLOTB)?0:sl_next+SLOTB;}while(0)
  DMA_K(2,2*SLOTB);
  WAIT_BAR(3);
  qkt(pA0,pA1,Kbase,qr,f32x16{},r32,hi);asm volatile("s_nop 15\n\ts_nop 7":"+v"(pA0),"+v"(pA1));CMASK(pA0,pA1,0);
  START(pA0,pA1);
  _Pragma("unroll") for(int r=0;r<16;++r)pA1[r]=__builtin_amdgcn_exp2f(pA1[r]);
  WAIT_BAR(0);
  DMA_K(3,0);DMA_V(1,SLOTB);
  ROT();
  kload8(kf,kp0+sl_cur);
  WAIT_BAR(2);
  s16x4 vlo[8],vhi[8]; u32x4 pw0,pw1,pw2,pw3;
  #define PKW(P,B) cvtpk_s(P[B],P[B+1])
  #define PAF(k) __builtin_bit_cast(bf16x8,pw##k)
  #define VFR(i) (bf16x8){vlo[i][0],vlo[i][1],vlo[i][2],vlo[i][3],vhi[i][0],vhi[i][1],vhi[i][2],vhi[i][3]}
  #define PIN(x) asm volatile("":"+v"(x))
  #define MX3(a,b,c) __builtin_fmaxf(__builtin_fmaxf((a),(b)),(c))
  #define GAPA(MF,A0,A1,A2,A3,W0,W1,PW) do{ MF; sacc+=A0; sacc+=A1; sacc+=A2; sacc+=A3; PIN(sacc); W0; W1; PIN(PW); SBAR(); }while(0)
  #define EX(v) __builtin_amdgcn_exp2f(v)
  #define GAPB(MF,X,B) do{ MF; X[B]=EX(X[B]); X[B+1]=EX(X[B+1]); X[B+2]=EX(X[B+2]); X[B+3]=EX(X[B+3]); PIN(X); SBAR(); }while(0)
  #define VRD(i) do{ vlo[i]=vtr(vp_+(((i)>>2)*4096+((i)&3)*1024)); vhi[i]=vtr(vp_+(((i)>>2)*4096+((i)&3)*1024+512)); }while(0)
  #define KRD(G,j) do{ if(G){ kload2(kf,kp0+sl_next,j); SBAR(); } }while(0)
  #define STEP(C0,C1,P0,P1,t,GK,GV,GL,MB) do{ SBAR(); \
    const lds_cptr vp_=vp0+sl_prev; \
    VRD(0); SBAR(); float sacc=(P0[0]+P0[1]); \
    GAPA(C0=__builtin_amdgcn_mfma_f32_32x32x16_bf16(kf[0],qr[0],f32x16{},0,0,0), P0[2],P0[3],P0[4],P0[5],     pw0[0]=PKW(P0,0), pw0[1]=PKW(P0,2), pw0); \
    VRD(4); SBAR(); GAPA(C1=__builtin_amdgcn_mfma_f32_32x32x16_bf16(kf[1],qr[0],f32x16{},0,0,0), P0[6],P0[7],P0[8],P0[9],     pw0[2]=PKW(P0,4), pw0[3]=PKW(P0,6), pw0); \
    VRD(1); SBAR(); GAPA(C0=__builtin_amdgcn_mfma_f32_32x32x16_bf16(kf[2],qr[1],C0,0,0,0),   P0[10],P0[11],P0[12],P0[13], pw1[0]=PKW(P0,8), pw1[1]=PKW(P0,10), pw1); \
    VRD(5); SBAR(); GAPA(C1=__builtin_amdgcn_mfma_f32_32x32x16_bf16(kf[3],qr[1],C1,0,0,0),   P0[14],P0[15],P1[0],P1[1],   pw1[2]=PKW(P0,12),pw1[3]=PKW(P0,14), pw1); \
    VRD(2); SBAR(); GAPA(C0=__builtin_amdgcn_mfma_f32_32x32x16_bf16(kf[4],qr[2],C0,0,0,0),   P1[2],P1[3],P1[4],P1[5],     pw2[0]=PKW(P1,0), pw2[1]=PKW(P1,2), pw2); \
    VRD(6); SBAR(); GAPA(C1=__builtin_amdgcn_mfma_f32_32x32x16_bf16(kf[5],qr[2],C1,0,0,0),   P1[6],P1[7],P1[8],P1[9],     pw2[2]=PKW(P1,4), pw2[3]=PKW(P1,6), pw2); \
    VRD(3); SBAR(); GAPA(C0=__builtin_amdgcn_mfma_f32_32x32x16_bf16(kf[6],qr[3],C0,0,0,0),   P1[10],P1[11],P1[12],P1[13], pw3[0]=PKW(P1,8), pw3[1]=PKW(P1,10), pw3); \
    VRD(7); SBAR(); GAPA(C1=__builtin_amdgcn_mfma_f32_32x32x16_bf16(kf[7],qr[3],C1,0,0,0),   P1[14],P1[15],0.f,0.f,       pw3[2]=PKW(P1,12),pw3[3]=PKW(P1,14), pw3); \
    l_reg+=sacc; \
    if(GK){DMA_K((t)+3,sl_cur);} if(GV){DMA_V((t)+1,sl_next);} \
    SUBREF(C0,C1,t); if(MB){CMASK(C0,C1,t);} \
    { float a=MX3(C0[0],C0[1],C1[0]),b=MX3(C0[2],C0[3],C1[1]); a=MX3(a,C1[2],C1[3]); \
      _Pragma("unroll") for(int r=4;r<16;r+=4){a=MX3(a,C0[r],C0[r+1]);b=MX3(b,C0[r+2],C0[r+3]);a=MX3(a,C1[r],C1[r+1]);b=MX3(b,C1[r+2],C1[r+3]);} \
      float rm=__builtin_fmaxf(a,b); { auto rr=__builtin_amdgcn_permlane32_swap(__float_as_uint(rm),__float_as_uint(rm),false,false); rm=__builtin_fmaxf(__uint_as_float(rr[0]),__uint_as_float(rr[1])); } \
      resc=false; \
      if(__builtin_expect(__any(rm>(float)THRL),0)){ const float dl=__builtin_fmaxf(rm,0.f); mhat+=dl; \
        _Pragma("unroll") for(int r=0;r<16;++r){C0[r]-=dl;C1[r]-=dl;} \
        const float f=__builtin_amdgcn_exp2f(-dl); l_reg*=f; if(hi==0)wsf[r32]=f; resc=true; } } \
    SBAR(); \
    GAPB(o[0]=__builtin_amdgcn_mfma_f32_32x32x16_bf16(PAF(0),VFR(0),o[0],0,0,0), C0,0); \
    GAPB(o[1]=__builtin_amdgcn_mfma_f32_32x32x16_bf16(PAF(0),VFR(4),o[1],0,0,0), C0,4); \
    KRD(GL,0); GAPB(o[0]=__builtin_amdgcn_mfma_f32_32x32x16_bf16(PAF(1),VFR(1),o[0],0,0,0), C0,8); \
    KRD(GL,1); GAPB(o[1]=__builtin_amdgcn_mfma_f32_32x32x16_bf16(PAF(1),VFR(5),o[1],0,0,0), C0,12); \
    KRD(GL,2); GAPB(o[0]=__builtin_amdgcn_mfma_f32_32x32x16_bf16(PAF(2),VFR(2),o[0],0,0,0), C1,0); \
    KRD(GL,3); GAPB(o[1]=__builtin_amdgcn_mfma_f32_32x32x16_bf16(PAF(2),VFR(6),o[1],0,0,0), C1,4); \
    GAPB(o[0]=__builtin_amdgcn_mfma_f32_32x32x16_bf16(PAF(3),VFR(3),o[0],0,0,0), C1,8); \
    GAPB(o[1]=__builtin_amdgcn_mfma_f32_32x32x16_bf16(PAF(3),VFR(7),o[1],0,0,0), C1,12); \
    }while(0)
  #define ENDW(tt) do{ if((tt)+3<NT){WAIT_BAR(2);} else if((tt)+2<NT){WAIT_BAR(1);} else {WAIT_BAR(0);} }while(0)
  { int t=1;
    for(;t+1<NT;t+=2){
      STEP(pB0,pB1,pA0,pA1,t,(t+3<NT),(t+1<NT),(t+1<NT),(t<4));       ENDW(t);   RESC(); ROT();
      STEP(pA0,pA1,pB0,pB1,t+1,(t+4<NT),(t+2<NT),(t+2<NT),(t+1<4));     ENDW(t+1); RESC(); ROT();
    }
    STEP(pB0,pB1,pA0,pA1,NT-1,false,false,false,(NT==4)); RESC();
  }
  { float sacc=pB0[0]+pB0[1]; _Pragma("unroll") for(int r=2;r<16;++r)sacc+=pB0[r]; _Pragma("unroll") for(int r=0;r<16;++r)sacc+=pB1[r]; l_reg+=sacc;
    pw0=(u32x4){PKW(pB0,0),PKW(pB0,2),PKW(pB0,4),PKW(pB0,6)};pw1=(u32x4){PKW(pB0,8),PKW(pB0,10),PKW(pB0,12),PKW(pB0,14)};pw2=(u32x4){PKW(pB1,0),PKW(pB1,2),PKW(pB1,4),PKW(pB1,6)};pw3=(u32x4){PKW(pB1,8),PKW(pB1,10),PKW(pB1,12),PKW(pB1,14)};
    SBAR(); pv(o,vb0+sl_cur,PAF(0),PAF(1),PAF(2),PAF(3)); }
  #undef PKW
  #undef PAF
  #undef VFR
  #undef PIN
  #undef MX3
  #undef GAPA
  #undef GAPB
  #undef EX
  #undef VRD
  #undef KRD
  #undef STEP
  #undef ENDW
  {auto rr=__builtin_amdgcn_permlane32_swap(__float_as_uint(l_reg),__float_as_uint(l_reg),false,false);l_reg=__uint_as_float(rr[0])+__uint_as_float(rr[1]);}
  if(hi==0)wsf[32+r32]=l_reg;asm volatile("s_waitcnt lgkmcnt(0)":::"memory");
  float rli[16];
  #pragma unroll
  for(int r=0;r<16;++r)rli[r]=__builtin_amdgcn_rcpf(wsf[32+crow(r,hi)]);
  bf16*Ow=O+(rowbase+q0+wid*QBLK)*PO+h*D;
  { bf16*stg=(bf16*)(shm+LDS_OST)+wid*2048;
    #pragma unroll
    for(int r=0;r<16;++r){const int orow=crow(r,hi);
      #pragma unroll
      for(int d0=0;d0<2;++d0)stg[orow*64+d0*32+r32]=__float2bfloat16(o[d0][r]*rli[r]);}
    asm volatile("s_waitcnt lgkmcnt(0)":::"memory");
    #pragma unroll
    for(int i=0;i<4;++i){const int row=i*8+(lane>>3),ch=lane&7; const u32x4 v=*(const u32x4*)(stg+row*64+ch*8); ATTN_STORE16(Ow+(long)row*PO+ch*8,v);} }
  asm volatile("s_waitcnt lgkmcnt(0)\n\ts_barrier":::"memory");
  #undef DMA_K
  #undef TROW
  #undef SUBREF
  #undef DMA_V
  #undef CMASK
  #undef START
  #undef RESC
  #undef ROT
}
constexpr int ATTN_LDS_BYTES=LDS_BYTES;
#undef SBAR
#undef WAIT_BAR
}
constexpr int DM = 1024, NB = 16, SEQ = 2048, NT = NB * SEQ;
constexpr int RWW = 512, WIN_N = 5376, INC = 4352, ZV = 1792, ZG = 2304;
constexpr int NEXP = 32, DEXP = 512;
constexpr int XS_ROWS = 2 * NT + NEXP * 256;
constexpr float C2 = 0.125f * 1.4426950408889634f;

#define LAS __attribute__((address_space(3)))
#define GAS __attribute__((address_space(1)))
typedef unsigned short bf16;
typedef unsigned v4u __attribute__((ext_vector_type(4)));
typedef unsigned v2u __attribute__((ext_vector_type(2)));
typedef float f32x4 __attribute__((ext_vector_type(4)));

typedef float f32x2_c __attribute__((ext_vector_type(2))); typedef __bf16 bf16x2_c __attribute__((ext_vector_type(2)));
__device__ __forceinline__ unsigned pk2(float lo, float hi) { const f32x2_c v = {lo, hi}; return __builtin_bit_cast(unsigned, __builtin_convertvector(v, bf16x2_c)); }
__device__ __forceinline__ unsigned f2bf(float f) { return pk2(f, f) & 0xffffu; }
__device__ __forceinline__ float bflo(unsigned w) { return __builtin_bit_cast(float, w << 16); }
__device__ __forceinline__ float bfhi(unsigned w) { return __builtin_bit_cast(float, w & 0xffff0000u); }
__device__ __forceinline__ float sigm(float x) { return __builtin_amdgcn_rcpf(1.0f + __expf(-x)); }

constexpr size_t MiB = 1u << 20;
constexpr size_t WS_CTL = 0;
constexpr size_t WS_MOD = 1 * MiB;
constexpr size_t WS_GM2 = 1 * MiB + 512 * 1024;
constexpr size_t WS_CB = 1 * MiB + 640 * 1024;
constexpr size_t WS_COS = 2 * MiB;
constexpr size_t WS_SIN = 2 * MiB + 512 * 1024;
constexpr size_t WS_KMEAN = 3 * MiB;
constexpr size_t WS_WRH = 3 * MiB + 512 * 1024;
constexpr size_t WS_WRL = 3 * MiB + 768 * 1024;
constexpr size_t WS_SEL = 4 * MiB;
constexpr size_t WS_RTE = 5 * MiB;
constexpr size_t WS_RTW = 5 * MiB + 256 * 1024;
constexpr size_t WS_RNK = 5 * MiB + 512 * 1024;
constexpr size_t WS_POS = 5 * MiB + 768 * 1024;
constexpr size_t WS_RSTD = 7 * MiB;
constexpr size_t WS_WLT = 6 * MiB;
constexpr size_t WS_WAT = 6 * MiB + 64 * 1024;
constexpr size_t WS_WGT = 6 * MiB + 128 * 1024;
constexpr size_t WS_WIN = 16 * MiB;
constexpr size_t WS_WBA = 27 * MiB;
constexpr size_t WS_WBB = 28 * MiB;
constexpr size_t WS_WOUT = 29 * MiB;
constexpr size_t WS_Z = 32 * MiB;
constexpr size_t WS_H = 368 * MiB;
constexpr size_t WS_Q = 304 * MiB, WS_K = 336 * MiB, WS_MRG = 304 * MiB;
constexpr size_t WS_YA = 432 * MiB, WS_YB = 464 * MiB;
constexpr size_t WS_WUP = 368 * MiB;
constexpr size_t WS_H2 = 128 * MiB;
constexpr size_t WS_XS = 64 * MiB;
constexpr size_t WS_HID = 208 * MiB;
constexpr size_t WS_X1B = 432 * MiB;
constexpr size_t WS_ACT = 496 * MiB;
constexpr size_t WS_END = 512 * MiB;
constexpr int CW_CNT = 64, CNT_PAD = 64;
constexpr int CW_NT = 2304;
constexpr int CW_TEXP = 2368;
static_assert(CW_CNT + NEXP * CNT_PAD <= CW_NT, "control words");

__device__ __forceinline__ void tr_item(const float* W, int K, int N, bf16* WT, int kb, int nb, int dst_row0, LAS float* scr, int lane) {
    const int k0 = 64 * kb, n0 = 32 * nb;
#pragma unroll 8
    for (int i = 0; i < 32; ++i) { const int kk = 2 * i + (lane >> 5); scr[kk * 33 + (lane & 31)] = W[(size_t)(k0 + kk) * N + n0 + (lane & 31)]; }
    asm volatile("s_waitcnt lgkmcnt(0)" ::: "memory");
    const int c = lane & 7;
#pragma unroll
    for (int j = 0; j < 4; ++j) { const int n = (lane >> 3) + 8 * j; const LAS float* s = scr + (8 * c) * 33 + n;
        v4u o; o.x = pk2(s[0 * 33], s[1 * 33]); o.y = pk2(s[2 * 33], s[3 * 33]); o.z = pk2(s[4 * 33], s[5 * 33]); o.w = pk2(s[6 * 33], s[7 * 33]);
        *(v4u*)(WT + (size_t)(dst_row0 + n) * K + k0 + 8 * c) = o; }
    asm volatile("s_waitcnt lgkmcnt(0)" ::: "memory");
}

struct PArgs { const float* in[30]; float* out; unsigned char* ws; };

__device__ __forceinline__ void p_prep_weights(const PArgs& a, unsigned char* lds, int wv) {
    const int tid = mktid(wv), lane = tid & 63, wave = tid >> 6;
    LAS float* scr = (LAS float*)lds + wave * (64 * 33);
    const int gw = blockIdx.x * 8 + wave, NGW = gridDim.x * 8;
    unsigned char* ws = a.ws;
    constexpr int I_IN = 16 * 168, I_BR = 8 * 32, I_OUT = 16 * 32;
    for (int it = gw; it < I_IN + 2 * I_BR + I_OUT; it += NGW) {
        int r = it;
        if (r < I_IN) { const int kb = r / 168, nb = r % 168; int dst = 32 * nb;
            if (dst >= 1792 && dst < 2816) { const int rel = dst - 1792, u = rel >> 8, hl = (rel & 255) >> 6, half = (rel & 63) >> 5; dst = 1792 + u * 256 + half * 128 + hl * 32; }
            tr_item(a.in[6], 1024, WIN_N, (bf16*)(ws + WS_WIN), kb, nb, dst, scr, lane); continue; } r -= I_IN;
        if (r < I_BR) { const int kb = r / 32, nb = r % 32; tr_item(a.in[20], 512, 1024, (bf16*)(ws + WS_WBA), kb, nb, 32 * nb, scr, lane); continue; } r -= I_BR;
        if (r < I_BR) { const int kb = r / 32, nb = r % 32; tr_item(a.in[21], 512, 1024, (bf16*)(ws + WS_WBB), kb, nb, 32 * nb, scr, lane); continue; } r -= I_BR;
        { const int kb = r / 32, nb = r % 32; tr_item(a.in[22], 1024, 1024, (bf16*)(ws + WS_WOUT), kb, nb, 32 * nb, scr, lane); }
    }
    const int gt = blockIdx.x * 512 + tid, NGT = gridDim.x * 512;
    float* cosT = (float*)(ws + WS_COS); float* sinT = (float*)(ws + WS_SIN);
    for (int i = gt; i < SEQ * 32; i += NGT) { const int s = i >> 5, f = i & 31; const float inv = powf(10000.0f, -(float)f / 32.0f); const float ang = (float)s * inv; cosT[i] = cosf(ang); sinT[i] = sinf(ang); }
    { bf16* wlt = (bf16*)(ws + WS_WLT); bf16* wat = (bf16*)(ws + WS_WAT); bf16* wgt = (bf16*)(ws + WS_WGT);
      for (int i = gt; i < 8 * 64 * 64; i += NGT) { const int hh = i >> 12, j = (i >> 6) & 63, m = i & 63; wlt[i] = (bf16)f2bf(a.in[9][m * 512 + hh * 64 + j]); wat[i] = (bf16)f2bf(a.in[11][m * 512 + hh * 64 + j]); }
      for (int i = gt; i < 8 * 64 * 128; i += NGT) { const int hh = i >> 13, j = (i >> 7) & 63, m = i & 127; wgt[i] = (bf16)f2bf(a.in[12][m * 512 + hh * 64 + j]); } }
    { bf16* wrh = (bf16*)(ws + WS_WRH); bf16* wrl = (bf16*)(ws + WS_WRL);
      for (int i = gt; i < 48 * 1024; i += NGT) { const int e = i >> 10, k = i & 1023; const float w = e < 4 ? a.in[23][k * 4 + e] : e < 36 ? a.in[25][k * 32 + (e - 4)] : 0.f;
          const unsigned hi = f2bf(w); wrh[i] = (bf16)hi; wrl[i] = (bf16)f2bf(w - bflo(hi)); } }
}

constexpr int CW_PEXP = 2816;
__device__ __forceinline__ void p_prep_experts_dyn(const PArgs& a, unsigned char* lds, int wv) {
    const int tid = mktid(wv), lane = tid & 63, wave = tid >> 6;
    LAS float* scr = (LAS float*)lds + wave * (64 * 33);
    unsigned* ctr = (unsigned*)(a.ws + WS_CTL) + CW_PEXP;
    constexpr int NITEM = NEXP * 768;
    for (;;) {
        unsigned base = 0; if (lane == 0) base = atomicAdd(ctr, 16u);
        base = (unsigned)__builtin_amdgcn_readfirstlane((int)base);
        if (base >= (unsigned)NITEM) break;
        for (int it = (int)base; it < (int)base + 16 && it < NITEM; ++it) {
            const int e = it / 768; int r = it % 768;
            bf16* wup = (bf16*)(a.ws + WS_WUP) + (size_t)e * 1024 * 1024;
            if (r < 256) { const int kb = r / 16, nb = r % 16, n0 = 32 * nb; tr_item(a.in[27] + (size_t)e * 1024 * 512, 1024, 512, wup, kb, nb, (n0 >> 7) * 256 + (n0 & 127), scr, lane); continue; } r -= 256;
            if (r < 256) { const int kb = r / 16, nb = r % 16, n0 = 32 * nb; tr_item(a.in[28] + (size_t)e * 1024 * 512, 1024, 512, wup, kb, nb, (n0 >> 7) * 256 + 128 + (n0 & 127), scr, lane); continue; } r -= 256;
            { const int kb = r / 32, nb = r % 32; tr_item(a.in[29] + (size_t)e * 512 * 1024, 512, 1024, (bf16*)a.out + (size_t)e * 1024 * 512, kb, nb, 32 * nb, scr, lane); }
        }
    }
}

__device__ __forceinline__ void p_ada(const PArgs& a, unsigned char* lds, int wv) {
    float* sc = (float*)lds; float* red = sc + 16 * 1024;
    const float* c = a.in[1]; const float* w = a.in[2]; const float* bias = a.in[3];
    float* mod = (float*)(a.ws + WS_MOD);
    const int tid = mktid(wv);
    for (int i = tid; i < 16 * 1024; i += 512) { const float v = c[i]; sc[i] = v / (1.0f + __expf(-v)); }
    __syncthreads();
    const int col = tid & 31, kg = tid >> 5;
    for (int tile = blockIdx.x; tile < 192; tile += gridDim.x) {
        const int e = tile * 32 + col;
        float acc[16];
#pragma unroll
        for (int b = 0; b < 16; ++b) acc[b] = 0.f;
        for (int d = kg * 64; d < kg * 64 + 64; ++d) { const float wv = w[(size_t)d * 6144 + e];
#pragma unroll
            for (int b = 0; b < 16; ++b) acc[b] += sc[b * 1024 + d] * wv; }
#pragma unroll
        for (int b = 0; b < 16; ++b) red[(kg * 16 + b) * 32 + col] = acc[b];
        __syncthreads();
        { const int b = tid >> 5, cc = tid & 31; float sm = 0.f;
#pragma unroll
            for (int k = 0; k < 16; ++k) sm += red[(k * 16 + b) * 32 + cc];
            mod[b * 6144 + tile * 32 + cc] = sm + bias[tile * 32 + cc]; }
        __syncthreads();
    }
}

__device__ __forceinline__ void p_norm1(const PArgs& a, unsigned char* lds, int wv) {
    const int tid = mktid(wv), lane = tid & 63, gw = blockIdx.x * 8 + (tid >> 6), NGW = gridDim.x * 8;
    const float* x = a.in[0]; const float* g = a.in[4]; const float* mod = (const float*)(a.ws + WS_MOD);
    bf16* h = (bf16*)(a.ws + WS_H);
    f32x4 v[4][4];
    { const f32x4* xr = (const f32x4*)(x + (size_t)(4 * gw < NT ? 4 * gw : 0) * DM) + lane;
#pragma unroll
      for (int r = 0; r < 4; ++r)
#pragma unroll
          for (int j = 0; j < 4; ++j) v[r][j] = xr[256 * r + 64 * j]; }
    for (int m0 = 4 * gw; m0 < NT; m0 += 4 * NGW) {
        const int mn = m0 + 4 * NGW < NT ? m0 + 4 * NGW : m0;
        f32x4 nv[4][4];
        { const f32x4* xr = (const f32x4*)(x + (size_t)mn * DM) + lane;
#pragma unroll
          for (int r = 0; r < 4; ++r)
#pragma unroll
              for (int j = 0; j < 4; ++j) nv[r][j] = xr[256 * r + 64 * j]; }
        const int b = m0 >> 11; float rstd[4];
#pragma unroll
        for (int r = 0; r < 4; ++r) { float s = 0.f;
#pragma unroll
            for (int j = 0; j < 4; ++j) s += (v[r][j].x * v[r][j].x + v[r][j].y * v[r][j].y) + (v[r][j].z * v[r][j].z + v[r][j].w * v[r][j].w);
            rstd[r] = rsqrtf(wave_sum(s) * (1.0f / DM) + 1e-6f); }
#pragma unroll
        for (int j = 0; j < 4; ++j) { const int col = 4 * (lane + 64 * j);
            const f32x4 gg = *(const f32x4*)(g + col), sh = *(const f32x4*)(mod + b * 6144 + col), scl = *(const f32x4*)(mod + b * 6144 + 1024 + col);
#pragma unroll
            for (int r = 0; r < 4; ++r) { const f32x4 q = v[r][j] * rstd[r] * gg * (scl + 1.0f) + sh; v2u w; w.x = pk2(q.x, q.y); w.y = pk2(q.z, q.w); ((v2u*)(h + (size_t)(m0 + r) * DM) + lane)[64 * j] = w; } }
#pragma unroll
        for (int r = 0; r < 4; ++r)
#pragma unroll
            for (int j = 0; j < 4; ++j) v[r][j] = nv[r][j];
    }
    { float* gm2 = (float*)(a.ws + WS_GM2); float* cb = (float*)(a.ws + WS_CB); const float* g2 = a.in[5];
      for (int i = blockIdx.x * 512 + tid; i < 16 * 1024; i += gridDim.x * 512) { const int b = i >> 10, k = i & 1023; gm2[i] = g2[k] * (1.0f + mod[b * 6144 + 4096 + k]); }
      for (int p = blockIdx.x + gridDim.x * (tid >> 6); p < 16 * 48; p += NGW) {    const int b = p / 48, n = p % 48; float s = 0.f;
          if (n < 36) { for (int k = lane; k < 1024; k += 64) { const float w = n < 4 ? a.in[23][k * 4 + n] : a.in[25][k * 32 + (n - 4)]; s += mod[b * 6144 + 3072 + k] * w; } }
          s = wave_sum(s); if (lane == 0) cb[p] = n < 4 ? s + a.in[24][n] : n < 36 ? s + a.in[26][n - 4] : 0.f; } }
}

using pg8::Unit; using pg8::HALF; using pg8::BM; using pg8::cvt_pk_bf16;
typedef pg8::f32x4 pf4; typedef pg8::u32x4 pu4;

struct EpiStoreBf16 {
    static constexpr bool PERM = true, AFTER_DRAIN = false, CHAIN = false;
    bf16* O; int ldc;
    __device__ __forceinline__ void operator()(const pf4 (&acc)[2][2][4][2], const Unit& u, int wr, int wc, int fr, int fq) const {
        const int row0 = u.pm * BM + wr * 64 + fr, col0 = u.pn * BM + wc * 32 + 8 * fq;
#pragma unroll
        for (int ai = 0; ai < 2; ++ai)
#pragma unroll
            for (int m = 0; m < 4; ++m) { bf16* rowp = O + (size_t)(row0 + ai * HALF + m * 16) * ldc + col0;
#pragma unroll
                for (int bj = 0; bj < 2; ++bj) { const pf4 v0 = acc[ai][bj][m][0], v1 = acc[ai][bj][m][1]; pu4 w;
                    w.x = cvt_pk_bf16(v0[0], v0[1]); w.y = cvt_pk_bf16(v0[2], v0[3]); w.z = cvt_pk_bf16(v1[0], v1[1]); w.w = cvt_pk_bf16(v1[2], v1[3]);
                    *(pu4*)(rowp + bj * HALF) = w; } }
    }
};
struct EpiZ {
    static constexpr bool PERM = true, AFTER_DRAIN = false, CHAIN = false;
    bf16* z; bf16* Q; bf16* K; const float* qg; const float* kg; const float* cosT; const float* sinT;
    __device__ __forceinline__ void operator()(const pf4 (&acc)[2][2][4][2], const Unit& u, int wr, int wc, int fr, int fq) const {
        const int row0 = u.pm * BM + wr * 64 + fr;
        if (u.pn < 7 || u.pn >= 11) {
            const int zc = (u.pn < 7 ? u.pn * 256 : (u.pn - 11) * 256 + 1792) + wc * 32 + 8 * fq;
#pragma unroll
            for (int ai = 0; ai < 2; ++ai)
#pragma unroll
                for (int m = 0; m < 4; ++m) { bf16* rowp = z + (size_t)(row0 + ai * HALF + m * 16) * INC + zc;
#pragma unroll
                    for (int bj = 0; bj < 2; ++bj) { const pf4 v0 = acc[ai][bj][m][0], v1 = acc[ai][bj][m][1]; pu4 w;
                        w.x = cvt_pk_bf16(v0[0], v0[1]); w.y = cvt_pk_bf16(v0[2], v0[3]); w.z = cvt_pk_bf16(v1[0], v1[1]); w.w = cvt_pk_bf16(v1[2], v1[3]);
                        *(pu4*)(rowp + bj * HALF) = w; } }
            return;
        }
        const bool isk = u.pn >= 9; const int head = 4 * ((u.pn - 7) & 1) + wc; const float* g = isk ? kg : qg; bf16* O = (isk ? K : Q) + head * 64 + 8 * fq;
        const float osc = isk ? 1.0f : C2;
        pf4 gl[2][2];
#pragma unroll
        for (int bj = 0; bj < 2; ++bj)
#pragma unroll
            for (int n = 0; n < 2; ++n) gl[bj][n] = *(const pf4*)(g + 32 * bj + 8 * fq + 4 * n);
#pragma unroll
        for (int aim = 0; aim < 4; ++aim) { const int ai = aim >> 1, m0 = 2 * (aim & 1);
            pf4 ct[2][2], st[2][2];
#pragma unroll
            for (int mm = 0; mm < 2; ++mm) { const int s = (row0 + ai * HALF + (m0 + mm) * 16) & (SEQ - 1);
#pragma unroll
                for (int n = 0; n < 2; ++n) { ct[mm][n] = *(const pf4*)(cosT + s * 32 + 8 * fq + 4 * n); st[mm][n] = *(const pf4*)(sinT + s * 32 + 8 * fq + 4 * n); } }
#pragma unroll
            for (int mm = 0; mm < 2; ++mm) { const int m = m0 + mm; const int row = row0 + ai * HALF + m * 16;
                float ss = 0.f;
#pragma unroll
                for (int bj = 0; bj < 2; ++bj)
#pragma unroll
                    for (int n = 0; n < 2; ++n) { const pf4 v = acc[ai][bj][m][n]; ss += (v[0] * v[0] + v[1] * v[1]) + (v[2] * v[2] + v[3] * v[3]); }
                ss += __builtin_bit_cast(float, __builtin_amdgcn_ds_swizzle(__builtin_bit_cast(int, ss), 0x401F));
                { const unsigned uu = __builtin_bit_cast(unsigned, ss); auto rr = __builtin_amdgcn_permlane32_swap(uu, uu, false, false); ss = __builtin_bit_cast(float, (unsigned)rr[0]) + __builtin_bit_cast(float, (unsigned)rr[1]); }
                const float rstd = rsqrtf(ss * (1.0f / 64.0f) + 1e-6f);
#pragma unroll
                for (int n = 0; n < 2; ++n) { const pf4 x1 = acc[ai][0][m][n] * rstd * gl[0][n], x2 = acc[ai][1][m][n] * rstd * gl[1][n];
                    const pf4 o1 = x1 * ct[mm][n] - x2 * st[mm][n], o2 = x2 * ct[mm][n] + x1 * st[mm][n];
                    v2u wa, wb; wa.x = cvt_pk_bf16(o1[0] * osc, o1[1] * osc); wa.y = cvt_pk_bf16(o1[2] * osc, o1[3] * osc); wb.x = cvt_pk_bf16(o2[0] * osc, o2[1] * osc); wb.y = cvt_pk_bf16(o2[2] * osc, o2[3] * osc);
                    bf16* op = O + (size_t)row * 512 + 4 * n; *(v2u*)op = wa; *(v2u*)(op + 32) = wb; } }
            asm volatile("" ::: "memory");
        }
    }
};
struct EpiMerge {
    static constexpr bool PERM = true, AFTER_DRAIN = false, CHAIN = true;
    const bf16* z; bf16* mrg;
    __device__ __forceinline__ bool chain(pf4 (&acc)[2][2][4][2], const Unit& u, int wr, int wc, int fr, int fq) const {
        const int row0 = u.pm * BM + wr * 64 + fr, col0 = u.pn * BM + wc * 32 + 8 * fq;
        if (u.aux == 0) {
#pragma unroll
            for (int ai = 0; ai < 2; ++ai) {
                pu4 za[4][2], zb[4][2];
#pragma unroll
                for (int m = 0; m < 4; ++m) { const size_t row = (size_t)(row0 + ai * HALF + m * 16);
#pragma unroll
                    for (int bj = 0; bj < 2; ++bj) { const int col = col0 + bj * HALF; za[m][bj] = *(const pu4*)(z + row * INC + ZG + col); zb[m][bj] = *(const pu4*)(z + row * INC + ZG + 1024 + col); } }
#pragma unroll
                for (int m = 0; m < 4; ++m)
#pragma unroll
                    for (int bj = 0; bj < 2; ++bj) { const pu4 a4 = za[m][bj], b4 = zb[m][bj];
                        const float a8[8] = {bflo(a4.x), bfhi(a4.x), bflo(a4.y), bfhi(a4.y), bflo(a4.z), bfhi(a4.z), bflo(a4.w), bfhi(a4.w)};
                        const float b8[8] = {bflo(b4.x), bfhi(b4.x), bflo(b4.y), bfhi(b4.y), bflo(b4.z), bfhi(b4.z), bflo(b4.w), bfhi(b4.w)};
#pragma unroll
                        for (int e = 0; e < 8; ++e) acc[ai][bj][m][e >> 2][e & 3] *= (1.0f + __expf(-b8[e])) * __builtin_amdgcn_rcpf(1.0f + __expf(-a8[e])); }
                asm volatile("" ::: "memory");
            }
            return true;
        }
        pu4 gz[2][4][2];
#pragma unroll
        for (int ai = 0; ai < 2; ++ai)
#pragma unroll
            for (int m = 0; m < 4; ++m) { const size_t row = (size_t)(row0 + ai * HALF + m * 16);
#pragma unroll
                for (int bj = 0; bj < 2; ++bj) gz[ai][m][bj] = *(const pu4*)(z + row * INC + ZG + 1024 + col0 + bj * HALF); }
#pragma unroll
        for (int ai = 0; ai < 2; ++ai)
#pragma unroll
            for (int m = 0; m < 4; ++m) { const size_t row = (size_t)(row0 + ai * HALF + m * 16);
#pragma unroll
                for (int bj = 0; bj < 2; ++bj) { const int col = col0 + bj * HALF; const pu4 g4 = gz[ai][m][bj]; const pf4 v0 = acc[ai][bj][m][0], v1 = acc[ai][bj][m][1];
                    pu4 w;
                    w.x = cvt_pk_bf16(sigm(bflo(g4.x)) * v0[0], sigm(bfhi(g4.x)) * v0[1]); w.y = cvt_pk_bf16(sigm(bflo(g4.y)) * v0[2], sigm(bfhi(g4.y)) * v0[3]);
                    w.z = cvt_pk_bf16(sigm(bflo(g4.z)) * v1[0], sigm(bfhi(g4.z)) * v1[1]); w.w = cvt_pk_bf16(sigm(bflo(g4.w)) * v1[2], sigm(bfhi(g4.w)) * v1[3]);
                    *(pu4*)(mrg + row * DM + col) = w; } }
        return false;
    }
};
struct EpiOut {
    static constexpr bool PERM = true, AFTER_DRAIN = false, CHAIN = false;
    const float* x; const float* mod; bf16* x1;
    __device__ __forceinline__ void operator()(const pf4 (&acc)[2][2][4][2], const Unit& u, int wr, int wc, int fr, int fq) const {
        const int row0 = u.pm * BM + wr * 64 + fr, col0 = u.pn * BM + wc * 32 + 8 * fq; const int b = u.pm >> 3;
        pf4 gt[2][2];
#pragma unroll
        for (int bj = 0; bj < 2; ++bj)
#pragma unroll
            for (int n = 0; n < 2; ++n) gt[bj][n] = *(const pf4*)(mod + b * 6144 + 2048 + col0 + bj * HALF + n * 4);
#pragma unroll
        for (int ai = 0; ai < 2; ++ai) {
            pf4 xv[4][2][2];
#pragma unroll
            for (int m = 0; m < 4; ++m) { const size_t off = (size_t)(row0 + ai * HALF + m * 16) * DM + col0;
#pragma unroll
                for (int bj = 0; bj < 2; ++bj) { xv[m][bj][0] = *(const pf4*)(x + off + bj * HALF); xv[m][bj][1] = *(const pf4*)(x + off + bj * HALF + 4); } }
#pragma unroll
            for (int m = 0; m < 4; ++m) { const size_t off = (size_t)(row0 + ai * HALF + m * 16) * DM + col0;
#pragma unroll
                for (int bj = 0; bj < 2; ++bj) { const pf4 o0 = xv[m][bj][0] + gt[bj][0] * acc[ai][bj][m][0], o1 = xv[m][bj][1] + gt[bj][1] * acc[ai][bj][m][1]; pu4 w;
                    w.x = cvt_pk_bf16(o0[0], o0[1]); w.y = cvt_pk_bf16(o0[2], o0[3]); w.z = cvt_pk_bf16(o1[0], o1[1]); w.w = cvt_pk_bf16(o1[2], o1[3]);
                    *(pu4*)(x1 + off + bj * HALF) = w; } }
            asm volatile("" ::: "memory");
        }
    }
};
struct EpiUp {
    static constexpr bool PERM = true, AFTER_DRAIN = false, CHAIN = false;
    bf16* hid;
    __device__ __forceinline__ void operator()(const pf4 (&acc)[2][2][4][2], const Unit& u, int wr, int wc, int fr, int fq) const {
        const int row0 = u.pm * BM + wr * 64 + fr, col0 = u.pn * 128 + wc * 32 + 8 * fq;
#pragma unroll
        for (int ai = 0; ai < 2; ++ai)
#pragma unroll
            for (int m = 0; m < 4; ++m) { const size_t row = (size_t)(row0 + ai * HALF + m * 16); float o[8];
#pragma unroll
                for (int n = 0; n < 2; ++n)
#pragma unroll
                    for (int e = 0; e < 4; ++e) { const float g = acc[ai][0][m][n][e], l = acc[ai][1][m][n][e]; o[4 * n + e] = g * sigm(g) * l; }
                pu4 w; w.x = cvt_pk_bf16(o[0], o[1]); w.y = cvt_pk_bf16(o[2], o[3]); w.z = cvt_pk_bf16(o[4], o[5]); w.w = cvt_pk_bf16(o[6], o[7]);
                *(pu4*)(hid + row * DEXP + col0) = w; }
    }
};

struct GemmArgs { unsigned char* ws; const float* x; float* out; const float* qg; const float* kg; };
template <class Epi> __device__ __forceinline__ void run_dense(const void* A, const void* Bt, int M, int N, int K, const Epi& E, unsigned char* lds, int wv) {
    pg8::Gemm g{K}; pg8::StaticOrder S; S.init(A, Bt, M, N, K, (int)gridDim.x, (int)blockIdx.x);
    pg8::gemm_phase<Epi, pg8::StaticOrder, true, true>((PG8_LAS unsigned char*)lds, g, S, E, wv);
}
__device__ __forceinline__ void p_gemm_in(const GemmArgs& a, unsigned char* lds, int wv) {
    EpiZ E{(bf16*)(a.ws + WS_Z), (bf16*)(a.ws + WS_Q), (bf16*)(a.ws + WS_K), a.qg, a.kg, (const float*)(a.ws + WS_COS), (const float*)(a.ws + WS_SIN)};
    run_dense(a.ws + WS_H, a.ws + WS_WIN, NT, WIN_N, 1024, E, lds, wv);
}
struct PairOrder {
    int nM, nN, nwg, G, c; const char *A0, *A1, *B0, *B1; size_t tstep;
    __device__ bool next(int i, Unit& u) const {
        const long L = (long)(i >> 1) * G + c; if (L >= nwg) return false;
        int wgid = (int)L; { const int q = nwg / pg8::NXCD, r = nwg % pg8::NXCD, xcd = wgid % pg8::NXCD, off = wgid / pg8::NXCD; wgid = (xcd < r ? xcd * (q + 1) : r * (q + 1) + (xcd - r) * q) + off; }
        const int nig = pg8::WGM * nN, gid = wgid / nig, fm = gid * pg8::WGM, gsz = (nM - fm) < pg8::WGM ? (nM - fm) : pg8::WGM;
        u.pm = fm + ((wgid % nig) % gsz); u.pn = (wgid % nig) / gsz; u.aux = i & 1;
        u.a = ((i & 1) ? A1 : A0) + (size_t)u.pm * tstep; u.b = ((i & 1) ? B1 : B0) + (size_t)u.pn * tstep; return true;
    }
    __device__ __forceinline__ void a_ready(const Unit&) const {}
    __device__ __forceinline__ void done(const Unit&) const {}
};
__device__ __forceinline__ void p_gemm_merge(const GemmArgs& a, unsigned char* lds, int wv) {
    PairOrder S{NT / 256, 4, (NT / 256) * 4, (int)gridDim.x, (int)blockIdx.x, (const char*)(a.ws + WS_YA), (const char*)(a.ws + WS_YB), (const char*)(a.ws + WS_WBA), (const char*)(a.ws + WS_WBB), (size_t)256 * 512 * 2};
    EpiMerge E{(const bf16*)(a.ws + WS_Z), (bf16*)(a.ws + WS_MRG)}; pg8::Gemm g{512};
    pg8::gemm_phase<EpiMerge, PairOrder, true, true>((PG8_LAS unsigned char*)lds, g, S, E, wv);
}
__device__ __forceinline__ void p_gemm_out(const GemmArgs& a, unsigned char* lds, int wv) {
    EpiOut E{a.x, (const float*)(a.ws + WS_MOD), (bf16*)(a.ws + WS_X1B)};
    run_dense(a.ws + WS_MRG, a.ws + WS_WOUT, NT, 1024, 1024, E, lds, wv);
}
struct GroupedOrder {
    const int* texp; int nT, nN, G, c; const char* A; size_t a_tile; const char* B; size_t b_exp, b_tile;
    __device__ bool next(int i, Unit& u) const {
        const long L = (long)i * G + c; if (L >= (long)nT * nN) return false;
        const int tile = (int)(L / nN), pn = (int)(L % nN); u.aux = 0; u.pm = tile; u.pn = pn; u.a = A + (size_t)tile * a_tile; u.b = B + (size_t)texp[tile] * b_exp + (size_t)pn * b_tile; return true;
    }
    __device__ __forceinline__ void a_ready(const Unit&) const {}
    __device__ __forceinline__ void done(const Unit&) const {}
};
__device__ __forceinline__ void p_gemm_up(const GemmArgs& a, unsigned char* lds, int wv) {
    const int* ctl = (const int*)(a.ws + WS_CTL);
    GroupedOrder S{ctl + CW_TEXP, ctl[CW_NT], 4, (int)gridDim.x, (int)blockIdx.x, (const char*)(a.ws + WS_XS), (size_t)256 * 1024 * 2, (const char*)(a.ws + WS_WUP), (size_t)1024 * 1024 * 2, (size_t)256 * 1024 * 2};
    EpiUp E{(bf16*)(a.ws + WS_HID)}; pg8::Gemm g{1024};
    pg8::gemm_phase<EpiUp, GroupedOrder, true, true>((PG8_LAS unsigned char*)lds, g, S, E, wv);
}
__device__ __forceinline__ void p_gemm_down(const GemmArgs& a, unsigned char* lds, int wv) {
    const int* ctl = (const int*)(a.ws + WS_CTL);
    GroupedOrder S{ctl + CW_TEXP, ctl[CW_NT], 4, (int)gridDim.x, (int)blockIdx.x, (const char*)(a.ws + WS_HID), (size_t)256 * 512 * 2, (const char*)a.out, (size_t)1024 * 512 * 2, (size_t)256 * 512 * 2};
    EpiStoreBf16 E{(bf16*)(a.ws + WS_XS), 1024}; pg8::Gemm g{512};
    pg8::gemm_phase<EpiStoreBf16, GroupedOrder, true, true>((PG8_LAS unsigned char*)lds, g, S, E, wv);
}

__device__ __forceinline__ void p_attn(const PArgs& a, unsigned char* lds, int vb, int nvb, int wv) {
    const attn_body::bf16* Q = (const attn_body::bf16*)(a.ws + WS_Q); const attn_body::bf16* K = (const attn_body::bf16*)(a.ws + WS_K);
    const attn_body::bf16* V = (const attn_body::bf16*)(a.ws + WS_Z) + ZV; attn_body::bf16* O = (attn_body::bf16*)(a.ws + WS_YB);
    for (int p = vb; p < 512; p += nvb)
        for (int which = 0; which < 2; ++which) { const int bh = p >> 2, s = p & 3, qb = which ? 7 - s : s;
            attn_body::attn_unit<8>(bh >> 3, bh & 7, qb, Q, K, V, O, (char*)lds, wv); }
}

__device__ __forceinline__ void p_actprep(const PArgs& a, unsigned char* lds, int wv) {
    const int tid = mktid(wv); const bf16* z = (const bf16*)(a.ws + WS_Z); bf16* act = (bf16*)(a.ws + WS_ACT); const float* mu = a.in[7];
    for (int i = blockIdx.x * 512 + tid; i < NT * 32; i += gridDim.x * 512) { const int t = i >> 5, cg = i & 31, col = 1536 + 8 * cg; const bool hasp = (t & (SEQ - 1)) > 0;
        const v4u cw = *(const v4u*)(z + (size_t)t * INC + col); v4u pw = {0u, 0u, 0u, 0u}; if (hasp) pw = *(const v4u*)(z + (size_t)(t - 1) * INC + col);
        const float c8[8] = {bflo(cw.x), bfhi(cw.x), bflo(cw.y), bfhi(cw.y), bflo(cw.z), bfhi(cw.z), bflo(cw.w), bfhi(cw.w)}, p8[8] = {bflo(pw.x), bfhi(pw.x), bflo(pw.y), bfhi(pw.y), bflo(pw.z), bfhi(pw.z), bflo(pw.w), bfhi(pw.w)};
        const f32x4 m0 = *(const f32x4*)(mu + col), m1 = *(const f32x4*)(mu + col + 4); const float m8[8] = {m0.x, m0.y, m0.z, m0.w, m1.x, m1.y, m1.z, m1.w}; float v[8];
#pragma unroll
        for (int e = 0; e < 8; ++e) { const float x = c8[e] + (p8[e] - c8[e]) * m8[e]; v[e] = cg < 8 ? 1.0f - 2.0f * __builtin_amdgcn_rcpf(1.0f + __expf(2.0f * x)) : cg < 16 ? x : sigm(x); }
        v4u w; w.x = pk2(v[0], v[1]); w.y = pk2(v[2], v[3]); w.z = pk2(v[4], v[5]); w.w = pk2(v[6], v[7]);
        *(v4u*)(act + (size_t)t * 256 + 8 * cg) = w; }
}

namespace rw {
typedef short bf16x8 __attribute__((ext_vector_type(8)));
constexpr int MB = 8192;
__device__ __forceinline__ int SW(int r, int c) { return r * 128 + ((((c >> 3) ^ (r >> 1)) & 7) << 4) + (c & 7) * 2; }
__device__ __forceinline__ int SWG(int r, int c) { return r * 256 + ((((c >> 3) ^ r) & 15) << 4) + (c & 7) * 2; }
__device__ __forceinline__ int SWF(int r, int c) { return r * 256 + ((((c >> 2) ^ r) & 15) << 4) + (c & 3) * 4; }
enum { I_AT = 0, I_BT, I_AJ, I_BHJ, I_KHJ, I_ABRT, I_X5, I_L, I_LT, I_R0, I_R1, I_KT, I_RT, I_VJ, I_X14, I_GATE, I_VT, I_VT2, NBUF };
constexpr int OFF_F32 = NBUF * MB;
constexpr int OFF_CST = OFF_F32 + (64 * 3 + 512) * 4;
constexpr int LDS_NEED = OFF_CST + 14 * 64 * 4;

__device__ __forceinline__ bf16x8 ldfrag(const unsigned char* M, int row, int k) { return *(const bf16x8*)(M + SW(row, k)); }
__device__ __forceinline__ void mm(f32x4 (&acc)[2], const unsigned char* X, const unsigned char* Y, int mt, int nh, int fr, int fq) {
    const bf16x8 a0 = ldfrag(X, 16 * mt + fr, 8 * fq), a1 = ldfrag(X, 16 * mt + fr, 8 * fq + 32);
#pragma unroll
    for (int nt = 0; nt < 2; ++nt) { const bf16x8 b0 = ldfrag(Y, 16 * (2 * nh + nt) + fr, 8 * fq), b1 = ldfrag(Y, 16 * (2 * nh + nt) + fr, 8 * fq + 32);
        acc[nt] = __builtin_amdgcn_mfma_f32_16x16x32_bf16(a0, b0, acc[nt], 0, 0, 0); acc[nt] = __builtin_amdgcn_mfma_f32_16x16x32_bf16(a1, b1, acc[nt], 0, 0, 0); }
}
typedef short s16x4 __attribute__((ext_vector_type(4)));
typedef __attribute__((address_space(3))) s16x4* lds_s16x4p;
__device__ __forceinline__ bf16x8 ldfragT(const unsigned char* M, int row0, int kb, int fr, int fq) {
    const int k0 = kb + 8 * fq + (fr >> 2), c0 = row0 + 4 * (fr & 3);
    const s16x4 lo = __builtin_amdgcn_ds_read_tr16_b64_v4i16((lds_s16x4p)(M + SW(k0, c0))), hi = __builtin_amdgcn_ds_read_tr16_b64_v4i16((lds_s16x4p)(M + SW(k0 + 4, c0)));
    return (bf16x8){lo[0], lo[1], lo[2], lo[3], hi[0], hi[1], hi[2], hi[3]};
}
struct FA { bf16x8 k0, k1; };
struct FB { bf16x8 k0[2], k1[2]; };
__device__ __forceinline__ FA ldA(const unsigned char* X, int mt, int fr, int fq) { FA f; f.k0 = ldfrag(X, 16 * mt + fr, 8 * fq); f.k1 = ldfrag(X, 16 * mt + fr, 8 * fq + 32); return f; }
__device__ __forceinline__ FB ldB(const unsigned char* Y, int nh, int fr, int fq) { FB f;
#pragma unroll
    for (int nt = 0; nt < 2; ++nt) { f.k0[nt] = ldfrag(Y, 16 * (2 * nh + nt) + fr, 8 * fq); f.k1[nt] = ldfrag(Y, 16 * (2 * nh + nt) + fr, 8 * fq + 32); }
    return f; }
__device__ __forceinline__ FA ldAT(const unsigned char* XT, int mt, int fr, int fq) { FA f; f.k0 = ldfragT(XT, 16 * mt, 0, fr, fq); f.k1 = ldfragT(XT, 16 * mt, 32, fr, fq); return f; }
__device__ __forceinline__ FB ldBT(const unsigned char* YT, int nh, int fr, int fq) { FB f;
#pragma unroll
    for (int nt = 0; nt < 2; ++nt) { f.k0[nt] = ldfragT(YT, 16 * (2 * nh + nt), 0, fr, fq); f.k1[nt] = ldfragT(YT, 16 * (2 * nh + nt), 32, fr, fq); }
    return f; }
__device__ __forceinline__ void mma(f32x4 (&acc)[2], const FA& a, const FB& b) {
    acc[0] = __builtin_amdgcn_mfma_f32_16x16x32_bf16(a.k0, b.k0[0], acc[0], 0, 0, 0); acc[1] = __builtin_amdgcn_mfma_f32_16x16x32_bf16(a.k0, b.k0[1], acc[1], 0, 0, 0);
    acc[0] = __builtin_amdgcn_mfma_f32_16x16x32_bf16(a.k1, b.k1[0], acc[0], 0, 0, 0); acc[1] = __builtin_amdgcn_mfma_f32_16x16x32_bf16(a.k1, b.k1[1], acc[1], 0, 0, 0);
}
__device__ __forceinline__ void ldC(f32x4 (&acc)[2], const unsigned char* Z, int mt, int nh, int fr, int fq) {
#pragma unroll
    for (int nt = 0; nt < 2; ++nt) { const v2u w = *(const v2u*)(Z + SW(16 * (2 * nh + nt) + fr, 16 * mt + 4 * fq)); acc[nt] = (f32x4){bflo(w.x), bfhi(w.x), bflo(w.y), bfhi(w.y)}; }
}
__device__ __forceinline__ void storeT(unsigned char* Z, const f32x4 (&acc)[2], int mt, int nh, int fr, int fq) {
#pragma unroll
    for (int nt = 0; nt < 2; ++nt) { v2u w; w.x = pk2(acc[nt][0], acc[nt][1]); w.y = pk2(acc[nt][2], acc[nt][3]); *(v2u*)(Z + SW(16 * (2 * nh + nt) + fr, 16 * mt + 4 * fq)) = w; }
}
__device__ __forceinline__ void storeN(unsigned char* Z, const f32x4 (&acc)[2], int mt, int nh, int fr, int fq) {
#pragma unroll
    for (int nt = 0; nt < 2; ++nt)
#pragma unroll
        for (int r = 0; r < 4; ++r) *(unsigned short*)(Z + SW(16 * mt + 4 * fq + r, 16 * (2 * nh + nt) + fr)) = (unsigned short)f2bf(acc[nt][r]);
}
__device__ __forceinline__ void ld8bf(const unsigned char* p, float (&v)[8]) { const v4u w = *(const v4u*)p; v[0] = bflo(w.x); v[1] = bfhi(w.x); v[2] = bflo(w.y); v[3] = bfhi(w.y); v[4] = bflo(w.z); v[5] = bfhi(w.z); v[6] = bflo(w.w); v[7] = bfhi(w.w); }
__device__ __forceinline__ void st8bf(unsigned char* p, const float (&v)[8]) { v4u w; w.x = pk2(v[0], v[1]); w.y = pk2(v[2], v[3]); w.z = pk2(v[4], v[5]); w.w = pk2(v[6], v[7]); *(v4u*)p = w; }
__device__ __forceinline__ void ld8f(const float* p, float (&v)[8]) { const f32x4 a = *(const f32x4*)p, b = *(const f32x4*)(p + 4); v[0] = a.x; v[1] = a.y; v[2] = a.z; v[3] = a.w; v[4] = b.x; v[5] = b.y; v[6] = b.z; v[7] = b.w; }
__device__ __forceinline__ void ld8fs(const unsigned char* M, int r, int c, float (&v)[8]) { const f32x4 a = *(const f32x4*)(M + SWF(r, c)), b = *(const f32x4*)(M + SWF(r, c + 4)); v[0] = a.x; v[1] = a.y; v[2] = a.z; v[3] = a.w; v[4] = b.x; v[5] = b.y; v[6] = b.z; v[7] = b.w; }
__device__ __forceinline__ void un8(const v4u w, float (&v)[8]) { v[0] = bflo(w.x); v[1] = bfhi(w.x); v[2] = bflo(w.y); v[3] = bfhi(w.y); v[4] = bflo(w.z); v[5] = bfhi(w.z); v[6] = bflo(w.w); v[7] = bfhi(w.w); }
__device__ __forceinline__ void shift8(const v4u cw, const v4u pw, bool hasp, const float* mu, float (&v)[8]) {
    float c[8], p[8], m[8]; un8(cw, c); un8(pw, p); ld8f(mu, m);
#pragma unroll
    for (int e = 0; e < 8; ++e) { const float pe = hasp ? p[e] : 0.f; v[e] = c[e] + (pe - c[e]) * m[e]; }
}
__device__ __forceinline__ float tanh_fast(float x) { return 1.0f - 2.0f * __builtin_amdgcn_rcpf(1.0f + __expf(2.0f * x)); }

#define LBAR() do { asm volatile("s_waitcnt lgkmcnt(0)" ::: "memory"); __builtin_amdgcn_s_barrier(); asm volatile("" ::: "memory"); } while (0)
__device__ __forceinline__ void scan_unit(const PArgs& a, unsigned char* lds, int bh, int wv) {
    const int tid = mktid(wv), lane = tid & 63, wid = __builtin_amdgcn_readfirstlane(tid >> 6);
    const int mt = wid >> 1, nh = wid & 1; int fr = lane & 15, fq = lane >> 4;
    const int b = bh >> 3, h = bh & 7;
#define BUF(i) (lds + (i) * MB)
    float* GC = (float*)(lds + OFF_F32); float* BON = GC + 64; float* SSQ = BON + 64; float* SEGT = SSQ + 64;
    unsigned char* LWR = BUF(I_AT); unsigned char* LAR = BUF(I_AJ); unsigned char* LGR = BUF(I_KHJ); unsigned char* YTF = BUF(I_KHJ);
    unsigned char* ACTW = BUF(I_L); unsigned char* ACTA = BUF(I_LT); unsigned char* ACTG = BUF(I_R0);
    const bf16* z = (const bf16*)(a.ws + WS_Z); bf16* ya = (bf16*)(a.ws + WS_YA);
    const float* mu = a.in[7];
    bf16x8 fw[2], fa[2], fg[4];
    { const bf16* wlt = (const bf16*)(a.ws + WS_WLT) + (size_t)h * 4096 + (16 * mt + fr) * 64 + 8 * fq; const bf16* wat = (const bf16*)(a.ws + WS_WAT) + (size_t)h * 4096 + (16 * mt + fr) * 64 + 8 * fq;
      const bf16* wgt = (const bf16*)(a.ws + WS_WGT) + (size_t)h * 8192 + (16 * mt + fr) * 128 + 8 * fq;
      fw[0] = *(const bf16x8*)wlt; fw[1] = *(const bf16x8*)(wlt + 32); fa[0] = *(const bf16x8*)wat; fa[1] = *(const bf16x8*)(wat + 32);
#pragma unroll
      for (int ks = 0; ks < 4; ++ks) fg[ks] = *(const bf16x8*)(wgt + 32 * ks); }
    float* CST = (float*)(lds + OFF_CST);
    for (int i = tid; i < 14 * 64; i += 512) { const int blk = i >> 6, jj = i & 63; float v;
        if (blk < 3) v = mu[blk * 512 + h * 64 + jj]; else if (blk < 7) v = mu[1536 + (blk - 3) * 64 + jj]; else v = a.in[blk == 7 ? 8 : blk == 8 ? 10 : blk == 9 ? 13 : blk == 10 ? 14 : blk == 11 ? 15 : blk == 12 ? 16 : 17][h * 64 + jj];
        CST[i] = v; }
    int s0i = I_X14, aki = I_X5;
    for (int i = tid; i < MB / 4; i += 512) ((unsigned*)BUF(I_X14))[i] = 0u;
    LBAR();
    int pt = tid >> 3, j0 = 8 * (tid & 7);
    const int colh = h * 64 + j0;
    const int zoff0 = colh, zoff1 = 512 + colh, zoff2 = 1024 + colh;
    const bf16* actb = (const bf16*)(a.ws + WS_ACT);
    v4u zc[3], zq[3], za[4];
#define ZLOAD(cc) do { const size_t tr_ = (size_t)b * SEQ + (cc) * 64 + pt; const bf16* zr_ = z + tr_ * INC; const bf16* zs_ = ((cc) * 64 + pt) > 0 ? zr_ - INC : zr_; const bf16* ar_ = actb + tr_ * 256 + j0; \
        zc[0] = *(const v4u*)(zr_ + zoff0); zc[1] = *(const v4u*)(zr_ + zoff1); zc[2] = *(const v4u*)(zr_ + zoff2); \
        zq[0] = *(const v4u*)(zs_ + zoff0); zq[1] = *(const v4u*)(zs_ + zoff1); zq[2] = *(const v4u*)(zs_ + zoff2); \
        za[0] = *(const v4u*)(ar_); za[1] = *(const v4u*)(ar_ + 64); za[2] = *(const v4u*)(ar_ + 128); za[3] = *(const v4u*)(ar_ + 192); } while (0)
#define ESTAGE(VTB, TT_) \
        { float y[8], vv[8], g8[8], lg[8], lb[8]; ld8fs(YTF, pt, j0, y); ld8bf((VTB) + SW(pt, j0), vv); ld8bf(BUF(I_GATE) + SW(pt, j0), g8); \
          ld8f(CST + 12 * 64 + j0, lg); ld8f(CST + 13 * 64 + j0, lb); \
          float sm = 0.f; \
_Pragma("unroll") \
          for (int e = 0; e < 8; ++e) sm += y[e]; \
          const float mean = red8(sm) * (1.0f / 64.0f); float sq = 0.f; \
_Pragma("unroll") \
          for (int e = 0; e < 8; ++e) { y[e] -= mean; sq += y[e] * y[e]; } \
          const float rstd = rsqrtf(red8(sq) * (1.0f / 64.0f) + 64e-5f), bon = BON[pt]; \
_Pragma("unroll") \
          for (int e = 0; e < 8; ++e) y[e] = (y[e] * rstd * lg[e] + lb[e] + bon * vv[e]) * g8[e]; \
          ypend.x = pk2(y[0], y[1]); ypend.y = pk2(y[2], y[3]); ypend.z = pk2(y[4], y[5]); ypend.w = pk2(y[6], y[7]); ypoff = (TT_) * RWW + colh; }
    ZLOAD(0);
    v4u ypend = {0u, 0u, 0u, 0u}; size_t ypoff = 0;
    for (int c = 0; c < SEQ / 64; ++c) {
        asm volatile("" : "+v"(fr), "+v"(fq), "+v"(pt), "+v"(j0));
        const int s = c * 64 + pt; const size_t t = (size_t)b * SEQ + s; const bool hasp = s > 0;
        if (c > 0) { ESTAGE(((c - 1) & 1) ? BUF(I_VT2) : BUF(I_VT), t - 64) }
        { float v[8];
          shift8(zc[0], zq[0], hasp, CST + 0 * 64 + j0, v); st8bf(BUF(I_RT) + SW(pt, j0), v);
          shift8(zc[1], zq[1], hasp, CST + 1 * 64 + j0, v); st8bf(BUF(I_KT) + SW(pt, j0), v);
          { float kkc[8], ss = 0.f; ld8f(CST + 9 * 64 + j0, kkc);
#pragma unroll
            for (int e = 0; e < 8; ++e) { const float q = v[e] * kkc[e]; ss += q * q; }
            ss = red8(ss); if (j0 == 0) SSQ[pt] = rsqrtf(fmaxf(ss, 1e-24f)); }
          shift8(zc[2], zq[2], hasp, CST + 2 * 64 + j0, v); st8bf(((c & 1) ? BUF(I_VT2) : BUF(I_VT)) + SW(pt, j0), v);
          *(v4u*)(ACTW + SW(pt, j0)) = za[0]; *(v4u*)(ACTA + SW(pt, j0)) = za[1]; *(v4u*)(ACTG + SWG(pt, j0)) = za[2]; *(v4u*)(ACTG + SWG(pt, 64 + j0)) = za[3]; }
        LBAR();
        f32x4 aw[2], aa[2], ag[2];
#pragma unroll
        for (int nt = 0; nt < 2; ++nt) { const int tr = 16 * (2 * nh + nt) + fr; const f32x4 zero = {0.f, 0.f, 0.f, 0.f};
            aw[nt] = __builtin_amdgcn_mfma_f32_16x16x32_bf16(fw[0], ldfrag(ACTW, tr, 8 * fq), zero, 0, 0, 0); aw[nt] = __builtin_amdgcn_mfma_f32_16x16x32_bf16(fw[1], ldfrag(ACTW, tr, 8 * fq + 32), aw[nt], 0, 0, 0);
            aa[nt] = __builtin_amdgcn_mfma_f32_16x16x32_bf16(fa[0], ldfrag(ACTA, tr, 8 * fq), zero, 0, 0, 0); aa[nt] = __builtin_amdgcn_mfma_f32_16x16x32_bf16(fa[1], ldfrag(ACTA, tr, 8 * fq + 32), aa[nt], 0, 0, 0);
            ag[nt] = zero;
#pragma unroll
            for (int ks = 0; ks < 4; ++ks) ag[nt] = __builtin_amdgcn_mfma_f32_16x16x32_bf16(fg[ks], *(const bf16x8*)(ACTG + SWG(tr, 8 * fq + 32 * ks)), ag[nt], 0, 0, 0); }
#pragma unroll
        for (int nt = 0; nt < 2; ++nt) { const int tr = 16 * (2 * nh + nt) + fr, jc = 16 * mt + 4 * fq;
            *(f32x4*)(LWR + SWF(tr, jc)) = aw[nt]; *(f32x4*)(LAR + SWF(tr, jc)) = aa[nt]; *(f32x4*)(LGR + SWF(tr, jc)) = ag[nt]; }
        LBAR();
        float lwv[8], an[8], bb[8], k2[8], rr[8], gg[8], vv8[8], p8[8];
        { const int j = lane, tw = wid;
          const float w0c = CST[7 * 64 + j], a0c = CST[8 * 64 + j], kkc = CST[9 * 64 + j], kac = CST[10 * 64 + j], rkc = CST[11 * 64 + j];
          const unsigned char* vtb = (c & 1) ? BUF(I_VT2) : BUF(I_VT);
          float bo[8], av[8];
#pragma unroll
          for (int u = 0; u < 8; ++u) { const int t8 = 8 * tw + u;
              const float lw = *(const float*)(LWR + SWF(t8, j)), la = *(const float*)(LAR + SWF(t8, j)); gg[u] = *(const float*)(LGR + SWF(t8, j));
              rr[u] = bflo(*(const unsigned short*)(BUF(I_RT) + SW(t8, j))); const float kx = bflo(*(const unsigned short*)(BUF(I_KT) + SW(t8, j))); vv8[u] = bflo(*(const unsigned short*)(vtb + SW(t8, j)));
              lwv[u] = -0.606531f * sigm(w0c + lw); av[u] = sigm(a0c + la);
              const float kn = kx * kkc * SSQ[t8]; an[u] = -kn; bb[u] = kn * av[u];
              k2[u] = kx * (1.0f + (av[u] - 1.0f) * kac); bo[u] = rr[u] * k2[u] * rkc; }
          wave_sum8(bo);
          if (j == 0) {
#pragma unroll
              for (int u = 0; u < 8; ++u) BON[8 * tw + u] = bo[u]; }
          p8[0] = lwv[0];
#pragma unroll
          for (int u = 1; u < 8; ++u) p8[u] = p8[u - 1] + lwv[u];
          SEGT[tw * 64 + j] = p8[7]; }
        LBAR();
        { const int j = lane, tw = wid; float sg8[8];
#pragma unroll
          for (int s2 = 0; s2 < 8; ++s2) sg8[s2] = SEGT[s2 * 64 + j];
          float base = 0.f, tot = 0.f;
#pragma unroll
          for (int s2 = 0; s2 < 8; ++s2) { tot += sg8[s2]; base += (s2 < tw) ? sg8[s2] : 0.f; }
          const float gcj = __expf(tot); if (tw == 7) GC[j] = gcj;
          float eprev = __expf(base);
          float o0[8], o1[8], o2[8], o3[8], ob[8], ok[8];
#pragma unroll
          for (int u = 0; u < 8; ++u) { const float L = p8[u] + base; const float e1 = __expf(L), ie1 = __builtin_amdgcn_rcpf(e1), ep = eprev, eh = gcj * ie1; eprev = e1;
              o0[u] = an[u] * ep; o1[u] = bb[u] * ie1; o2[u] = k2[u] * ie1; o3[u] = rr[u] * e1; ob[u] = bb[u] * eh; ok[u] = k2[u] * eh;
              *(unsigned short*)(BUF(I_GATE) + SW(8 * tw + u, j)) = (unsigned short)f2bf(gg[u]); }
          st8bf(BUF(I_AJ) + SW(j, 8 * tw), o0); st8bf(BUF(I_BT) + SW(j, 8 * tw), o1); st8bf(BUF(I_KT) + SW(j, 8 * tw), o2); st8bf(BUF(I_RT) + SW(j, 8 * tw), o3);
          st8bf(BUF(I_BHJ) + SW(j, 8 * tw), ob); st8bf(BUF(I_KHJ) + SW(j, 8 * tw), ok); st8bf(BUF(I_VJ) + SW(j, 8 * tw), vv8); }
        if (c > 0) *(v4u*)(ya + ypoff) = ypend;
        if (c + 1 < SEQ / 64) ZLOAD(c + 1);
        LBAR();
#define MASK(acc, cond) _Pragma("unroll") for (int nt = 0; nt < 2; ++nt) _Pragma("unroll") for (int r = 0; r < 4; ++r) { const int m_ = 16 * mt + 4 * fq + r, n_ = 16 * (2 * nh + nt) + fr; if (!(cond)) acc[nt][r] = 0.f; }
        { const f32x4 zero = {0.f, 0.f, 0.f, 0.f}; f32x4 aL[2] = {zero, zero}, aL2[2] = {zero, zero}, aK[2] = {zero, zero}, aR[2] = {zero, zero};
          const FA fAT = ldAT(BUF(I_AJ), mt, fr, fq), fBTa = ldAT(BUF(I_BT), mt, fr, fq); const FB fBT = ldBT(BUF(I_BT), nh, fr, fq), fKT = ldBT(BUF(I_KT), nh, fr, fq), fRT = ldBT(BUF(I_RT), nh, fr, fq), fATb = ldBT(BUF(I_AJ), nh, fr, fq);
          mma(aL, fAT, fBT);
          mma(aL2, fBTa, fATb);
          mma(aK, fAT, fKT);
          mma(aR, fBTa, fRT);
          MASK(aL, m_ > n_) MASK(aL2, n_ > m_) MASK(aK, n_ < m_) MASK(aR, m_ <= n_)
#pragma unroll
          for (int nt = 0; nt < 2; ++nt)
#pragma unroll
              for (int r = 0; r < 4; ++r) { const int m_ = 16 * mt + 4 * fq + r, n_ = 16 * (2 * nh + nt) + fr; if (m_ == n_) aL2[nt][r] = 1.0f; }
          storeT(BUF(I_L), aL, mt, nh, fr, fq); storeT(BUF(I_R0), aL2, mt, nh, fr, fq);
          storeT(BUF(aki), aK, mt, nh, fr, fq);
          storeT(BUF(I_ABRT), aR, mt, nh, fr, fq); }
        LBAR();
#pragma unroll
        for (int k = 1; k <= 6; ++k) {
            unsigned char* Pc = (k & 1) ? BUF(I_L) : BUF(I_AT); unsigned char* Pn = (k & 1) ? BUF(I_AT) : BUF(I_L);
            unsigned char* Rc = (k & 1) ? BUF(I_R1) : BUF(I_R0); unsigned char* Rn = (k & 1) ? BUF(I_R0) : BUF(I_R1);
            const f32x4 zero = {0.f, 0.f, 0.f, 0.f}; f32x4 aP[2] = {zero, zero}, aRr[2] = {zero, zero};
            FA fP, fPTa; FB fPT, fR;
            if (k <= 5) { fP = ldAT(Pc, mt, fr, fq); fPT = ldB(Pc, nh, fr, fq); }
            if (k >= 2) { fPTa = ldA(Pc, mt, fr, fq); fR = ldB(Rc, nh, fr, fq); ldC(aRr, Rc, mt, nh, fr, fq); }
            if (k <= 5) mma(aP, fP, fPT);
            if (k >= 2) mma(aRr, fPTa, fR);
            if (k <= 5) storeT(Pn, aP, mt, nh, fr, fq);
            if (k >= 2) storeT(Rn, aRr, mt, nh, fr, fq);
            LBAR();
        }
        { const f32x4 zero = {0.f, 0.f, 0.f, 0.f}; f32x4 a1[2] = {zero, zero}, a2[2] = {zero, zero};
          const FA fTT = ldA(BUF(I_R1), mt, fr, fq); const FB fAJ = ldB(BUF(I_AJ), nh, fr, fq), fAK = ldB(BUF(aki), nh, fr, fq);
          mma(a1, fTT, fAJ); mma(a2, fTT, fAK);
          storeT(BUF(I_L), a1, mt, nh, fr, fq);
          storeT(BUF(I_LT), a2, mt, nh, fr, fq); }
        LBAR();
        { const f32x4 zero = {0.f, 0.f, 0.f, 0.f}; f32x4 aMY[2], aNY[2] = {zero, zero}, aMS[2] = {zero, zero}, aNS[2];
          const FA fG1 = ldA(BUF(I_L), mt, fr, fq), fG2 = ldA(BUF(I_LT), mt, fr, fq), fKTa = ldAT(BUF(I_KT), mt, fr, fq);
          const FB fAB = ldB(BUF(I_ABRT), nh, fr, fq), fRT = ldBT(BUF(I_RT), nh, fr, fq), fBH = ldB(BUF(I_BHJ), nh, fr, fq);
#pragma unroll
          for (int nt = 0; nt < 2; ++nt)
#pragma unroll
              for (int r = 0; r < 4; ++r) aMY[nt][r] = bflo(*(const unsigned short*)(BUF(I_RT) + SW(16 * mt + 4 * fq + r, 16 * (2 * nh + nt) + fr)));
          ldC(aNS, BUF(I_KHJ), mt, nh, fr, fq);
          mma(aNY, fKTa, fRT);
          mma(aMY, fG1, fAB);
          mma(aMS, fG1, fBH);
          mma(aNS, fG2, fBH);
          MASK(aNY, m_ <= n_)
          mma(aNY, fG2, fAB);
#pragma unroll
          for (int nt = 0; nt < 2; ++nt)
#pragma unroll
              for (int r = 0; r < 4; ++r) { const int m_ = 16 * mt + 4 * fq + r, n_ = 16 * (2 * nh + nt) + fr; if (m_ == n_) aMS[nt][r] += GC[m_]; }
          storeT(BUF(I_AT), aMY, mt, nh, fr, fq); storeT(BUF(I_BT), aNY, mt, nh, fr, fq); storeT(BUF(I_AJ), aMS, mt, nh, fr, fq); storeT(BUF(I_R0), aNS, mt, nh, fr, fq); }
        LBAR();
        { const f32x4 zero = {0.f, 0.f, 0.f, 0.f}; f32x4 aY[2] = {zero, zero}, aS[2] = {zero, zero};
          const FA fS0a = ldA(BUF(s0i), mt, fr, fq), fVJa = ldA(BUF(I_VJ), mt, fr, fq), fMS = ldA(BUF(I_AJ), mt, fr, fq), fNS = ldA(BUF(I_R0), mt, fr, fq);
          const FB fMY = ldB(BUF(I_AT), nh, fr, fq), fNY = ldB(BUF(I_BT), nh, fr, fq), fS0 = ldB(BUF(s0i), nh, fr, fq), fVJ = ldB(BUF(I_VJ), nh, fr, fq);
          mma(aY, fS0a, fMY); mma(aS, fMS, fS0); mma(aY, fVJa, fNY); mma(aS, fNS, fVJ);
#pragma unroll
          for (int nt = 0; nt < 2; ++nt) *(f32x4*)(YTF + SWF(16 * (2 * nh + nt) + fr, 16 * mt + 4 * fq)) = aY[nt];
          storeT(BUF(aki), aS, mt, nh, fr, fq); }
        LBAR();
#undef MASK
        { const int tmp = s0i; s0i = aki; aki = tmp; }
    }
    { const int c = SEQ / 64; const size_t tprev = (size_t)b * SEQ + (c - 1) * 64 + pt; ESTAGE(((c - 1) & 1) ? BUF(I_VT2) : BUF(I_VT), tprev) }
    *(v4u*)(ya + ypoff) = ypend;
    LBAR();
#undef ESTAGE
#undef BUF
#undef ZLOAD
}
#undef LBAR
}

__device__ __forceinline__ void p_norm2_route(const PArgs& a, unsigned char* lds, int wv) {
    typedef short bf16x8 __attribute__((ext_vector_type(8)));
    const int tid = mktid(wv), lane = tid & 63, fr = lane & 15, fq = lane >> 4;
    const bf16* x1 = (const bf16*)(a.ws + WS_X1B); const float* mod = (const float*)(a.ws + WS_MOD); const float* gm2 = (const float*)(a.ws + WS_GM2); const float* cbt = (const float*)(a.ws + WS_CB);
    int* rte = (int*)(a.ws + WS_RTE); float* rtw = (float*)(a.ws + WS_RTW); int* rnk = (int*)(a.ws + WS_RNK); unsigned* cnt = (unsigned*)(a.ws + WS_CTL) + CW_CNT;
    float* PL = (float*)lds;
    float* PS = PL + 8 * 32 * 48;
    float* RS_ = PS + 8 * 32;
    float* FL = RS_ + 32;
    unsigned* HIST = (unsigned*)(FL + 32 * 48);
    unsigned* LRK = HIST + 32;
    if (tid < 32) HIST[tid] = 0u;
    __syncthreads();
    int gcount = 0;
    bf16x8 wh[4][3], wl[4][3];
    { const bf16* wrh = (const bf16*)(a.ws + WS_WRH) + fr * 1024 + 128 * wv + 8 * fq; const bf16* wrl = (const bf16*)(a.ws + WS_WRL) + fr * 1024 + 128 * wv + 8 * fq;
#pragma unroll
      for (int ks = 0; ks < 4; ++ks)
#pragma unroll
          for (int nt = 0; nt < 3; ++nt) { wh[ks][nt] = *(const bf16x8*)(wrh + nt * 16 * 1024 + 32 * ks); wl[ks][nt] = *(const bf16x8*)(wrl + nt * 16 * 1024 + 32 * ks); } }
    for (int grp = blockIdx.x; grp < NT / 32; grp += gridDim.x) {
        const int row0 = grp * 32, b = row0 >> 11;
        f32x4 acc[3][2];
#pragma unroll
        for (int nt = 0; nt < 3; ++nt) { acc[nt][0] = (f32x4){0.f, 0.f, 0.f, 0.f}; acc[nt][1] = acc[nt][0]; }
        float ssq[2] = {0.f, 0.f};
#pragma unroll
        for (int rt = 0; rt < 2; ++rt) {
            float xs[4][8];
#pragma unroll
            for (int ks = 0; ks < 4; ++ks) rw::ld8bf((const unsigned char*)(x1 + (size_t)(row0 + 16 * rt + fr) * DM + 128 * wv + 32 * ks + 8 * fq), xs[ks]);
#pragma unroll
            for (int ks = 0; ks < 4; ++ks) { float gm[8]; rw::ld8f(gm2 + b * 1024 + 128 * wv + 32 * ks + 8 * fq, gm); unsigned hw[4], lw[4];
#pragma unroll
                for (int e = 0; e < 4; ++e) { const float x0 = xs[ks][2 * e], x1v = xs[ks][2 * e + 1]; ssq[rt] += x0 * x0 + x1v * x1v; const float g0 = x0 * gm[2 * e], g1 = x1v * gm[2 * e + 1];
                    hw[e] = pk2(g0, g1); lw[e] = pk2(g0 - bflo(hw[e]), g1 - bfhi(hw[e])); }
                const v4u hv = {hw[0], hw[1], hw[2], hw[3]}, lv = {lw[0], lw[1], lw[2], lw[3]}; const bf16x8 bh = __builtin_bit_cast(bf16x8, hv), bl = __builtin_bit_cast(bf16x8, lv);
#pragma unroll
                for (int nt = 0; nt < 3; ++nt) { acc[nt][rt] = __builtin_amdgcn_mfma_f32_16x16x32_bf16(wh[ks][nt], bh, acc[nt][rt], 0, 0, 0); acc[nt][rt] = __builtin_amdgcn_mfma_f32_16x16x32_bf16(wl[ks][nt], bh, acc[nt][rt], 0, 0, 0);
                    acc[nt][rt] = __builtin_amdgcn_mfma_f32_16x16x32_bf16(wh[ks][nt], bl, acc[nt][rt], 0, 0, 0); } } }
#pragma unroll
        for (int rt = 0; rt < 2; ++rt) {
#pragma unroll
            for (int nt = 0; nt < 3; ++nt) *(f32x4*)(PL + (wv * 32 + 16 * rt + fr) * 48 + 16 * nt + 4 * fq) = acc[nt][rt];
            float s = ssq[rt]; s += __builtin_bit_cast(float, __builtin_amdgcn_ds_swizzle(__builtin_bit_cast(int, s), 0x401F));
            { const unsigned u = __builtin_bit_cast(unsigned, s); auto rr = __builtin_amdgcn_permlane32_swap(u, u, false, false); s = __builtin_bit_cast(float, (unsigned)rr[0]) + __builtin_bit_cast(float, (unsigned)rr[1]); }
            if (fq == 0) PS[wv * 32 + 16 * rt + fr] = s; }
        __syncthreads();
        { const int r = tid >> 4, c = tid & 15; float s0 = 0.f, s1 = 0.f, s2 = 0.f, sq = 0.f;
#pragma unroll
          for (int w = 0; w < 8; ++w) { const float* p = PL + (w * 32 + r) * 48; s0 += p[c]; s1 += p[c + 16]; s2 += p[c + 32]; sq += PS[w * 32 + r]; }
          const float rstd = rsqrtf(sq * (1.0f / DM) + 1e-6f); const float* cb = cbt + b * 48;
          FL[r * 48 + c] = rstd * s0 + cb[c]; FL[r * 48 + c + 16] = rstd * s1 + cb[c + 16]; FL[r * 48 + c + 32] = rstd * s2 + cb[c + 32];
          if (c == 0) ((float*)(a.ws + WS_RSTD))[row0 + r] = rstd; }
        __syncthreads();
        if (tid < 32) { const int m = row0 + tid; const float* lg = FL + tid * 48;
            int gi = 0; float gm = lg[0];
#pragma unroll
            for (int i = 1; i < 4; ++i) if (lg[i] > gm) { gm = lg[i]; gi = i; }
            float gs = 0.f;
#pragma unroll
            for (int i = 0; i < 4; ++i) gs += __expf(lg[i] - gm);
            const float pg = 1.0f / gs;
            float el[8];
#pragma unroll
            for (int k = 0; k < 8; ++k) el[k] = lg[4 + gi * 8 + k];
            int e1 = 0; float m1 = el[0];
#pragma unroll
            for (int k = 1; k < 8; ++k) if (el[k] > m1) { m1 = el[k]; e1 = k; }
            int e2 = -1; float m2 = -INFINITY;
#pragma unroll
            for (int k = 0; k < 8; ++k) if (k != e1 && el[k] > m2) { m2 = el[k]; e2 = k; }
            const float q2 = __expf(m2 - m1); const float w1 = pg / (1.0f + q2), w2 = pg * q2 / (1.0f + q2);
            const int ea = gi * 8 + e1, eb = gi * 8 + e2; rte[2 * m] = ea; rte[2 * m + 1] = eb; rtw[2 * m] = w1; rtw[2 * m + 1] = w2;
            LRK[gcount * 64 + 2 * tid] = atomicAdd(HIST + ea, 1u) | ((unsigned)ea << 24); LRK[gcount * 64 + 2 * tid + 1] = atomicAdd(HIST + eb, 1u) | ((unsigned)eb << 24); }
        ++gcount;
        __syncthreads();
    }
    if (tid < 32) { const unsigned n = HIST[tid]; HIST[tid] = n ? atomicAdd(cnt + tid * CNT_PAD, n) : 0u; }
    __syncthreads();
    for (int i = tid; i < gcount * 64; i += 512) { const int gi_ = i >> 6, e = i & 63; const int m2 = 2 * ((blockIdx.x + gi_ * gridDim.x) * 32) + e; const unsigned lr = LRK[i]; rnk[m2] = (int)(HIST[lr >> 24] + (lr & 0xffffffu)); }
    __syncthreads();
}
__device__ __forceinline__ void p_moe_gather(const PArgs& a, unsigned char* lds, int wv) {
    int* off = (int*)lds; int* tl = off + 64;
    const int tid = mktid(wv), lane = tid & 63, gw = blockIdx.x * 8 + (tid >> 6), NGW = gridDim.x * 8;
    int* ctl = (int*)(a.ws + WS_CTL); const unsigned* cnt = (const unsigned*)ctl + CW_CNT;
    if (tid < NEXP) tl[tid] = ((int)cnt[tid * CNT_PAD] + 255) >> 8;
    __syncthreads();
    if (tid < NEXP) { int o = 0; for (int e = 0; e < tid; ++e) o += tl[e];
        off[tid] = o * 256;
        if (blockIdx.x == 0) { const int n = tl[tid]; for (int i = 0; i < n; ++i) ctl[CW_TEXP + o + i] = tid; if (tid == NEXP - 1) ctl[CW_NT] = o + n; } }
    __syncthreads();
    const int* rte = (const int*)(a.ws + WS_RTE); const int* rnk = (const int*)(a.ws + WS_RNK); int* pos = (int*)(a.ws + WS_POS);
    const bf16* x1 = (const bf16*)(a.ws + WS_X1B); bf16* xs = (bf16*)(a.ws + WS_XS); const float* rstdv = (const float*)(a.ws + WS_RSTD);
    const float* mod = (const float*)(a.ws + WS_MOD); const float* gm2 = (const float*)(a.ws + WS_GM2);
    typedef int v4i_ __attribute__((ext_vector_type(4)));
    v4u xr[4][2]; v4i_ re[2], rk[2]; f32x4 rs;
    { const int t0 = 4 * gw < NT ? 4 * gw : 0;
#pragma unroll
      for (int r = 0; r < 4; ++r)
#pragma unroll
          for (int hf = 0; hf < 2; ++hf) xr[r][hf] = *(const v4u*)(x1 + (size_t)(t0 + r) * DM + 8 * lane + 512 * hf);
      re[0] = *(const v4i_*)(rte + 2 * t0); re[1] = *(const v4i_*)(rte + 2 * t0 + 4); rk[0] = *(const v4i_*)(rnk + 2 * t0); rk[1] = *(const v4i_*)(rnk + 2 * t0 + 4); rs = *(const f32x4*)(rstdv + t0); }
    for (int t0 = 4 * gw; t0 < NT; t0 += 4 * NGW) {
        const int tn = t0 + 4 * NGW < NT ? t0 + 4 * NGW : t0;
        v4u nx[4][2]; v4i_ ne[2], nk[2]; f32x4 ns;
#pragma unroll
        for (int r = 0; r < 4; ++r)
#pragma unroll
            for (int hf = 0; hf < 2; ++hf) nx[r][hf] = *(const v4u*)(x1 + (size_t)(tn + r) * DM + 8 * lane + 512 * hf);
        ne[0] = *(const v4i_*)(rte + 2 * tn); ne[1] = *(const v4i_*)(rte + 2 * tn + 4); nk[0] = *(const v4i_*)(rnk + 2 * tn); nk[1] = *(const v4i_*)(rnk + 2 * tn + 4); ns = *(const f32x4*)(rstdv + tn);
        const int b = t0 >> 11; int p0[4], p1[4];
#pragma unroll
        for (int r = 0; r < 4; ++r) { const int i0 = 2 * r, i1 = 2 * r + 1; p0[r] = off[re[i0 >> 2][i0 & 3]] + rk[i0 >> 2][i0 & 3]; p1[r] = off[re[i1 >> 2][i1 & 3]] + rk[i1 >> 2][i1 & 3]; }
        if (lane < 4) { const int r = lane; pos[2 * (t0 + r)] = r == 0 ? p0[0] : r == 1 ? p0[1] : r == 2 ? p0[2] : p0[3]; pos[2 * (t0 + r) + 1] = r == 0 ? p1[0] : r == 1 ? p1[1] : r == 2 ? p1[2] : p1[3]; }
#pragma unroll
        for (int hf = 0; hf < 2; ++hf) { const int col = 8 * lane + 512 * hf; float gm[8], sh[8];
            rw::ld8f(gm2 + b * 1024 + col, gm); rw::ld8f(mod + b * 6144 + 3072 + col, sh);
#pragma unroll
            for (int r = 0; r < 4; ++r) { const v4u xw = xr[r][hf]; const float rstd = rs[r];
                const float xv[8] = {bflo(xw.x), bfhi(xw.x), bflo(xw.y), bfhi(xw.y), bflo(xw.z), bfhi(xw.z), bflo(xw.w), bfhi(xw.w)}; float o[8];
#pragma unroll
                for (int e = 0; e < 8; ++e) o[e] = xv[e] * gm[e] * rstd + sh[e];
                v4u w; w.x = pk2(o[0], o[1]); w.y = pk2(o[2], o[3]); w.z = pk2(o[4], o[5]); w.w = pk2(o[6], o[7]);
                *(v4u*)(xs + (size_t)p0[r] * DM + col) = w; *(v4u*)(xs + (size_t)p1[r] * DM + col) = w; } }
#pragma unroll
        for (int r = 0; r < 4; ++r)
#pragma unroll
            for (int hf = 0; hf < 2; ++hf) xr[r][hf] = nx[r][hf];
        re[0] = ne[0]; re[1] = ne[1]; rk[0] = nk[0]; rk[1] = nk[1]; rs = ns;
    }
}
__device__ __forceinline__ void p_combine(const PArgs& a, unsigned char* lds, int wv) {
    const int tid = mktid(wv), lane = tid & 63, gw = blockIdx.x * 8 + (tid >> 6), NGW = gridDim.x * 8;
    const float* mod = (const float*)(a.ws + WS_MOD); const int* pos = (const int*)(a.ws + WS_POS); const float* rtw = (const float*)(a.ws + WS_RTW);
    const bf16* ys = (const bf16*)(a.ws + WS_XS); float* out = a.out; const bf16* x1 = (const bf16*)(a.ws + WS_X1B);
    typedef int v4i_ __attribute__((ext_vector_type(4)));
    v4i_ ps[2]; f32x4 wt[2];
    { const int m0 = 4 * gw < NT ? 4 * gw : 0; ps[0] = *(const v4i_*)(pos + 2 * m0); ps[1] = *(const v4i_*)(pos + 2 * m0 + 4); wt[0] = *(const f32x4*)(rtw + 2 * m0); wt[1] = *(const f32x4*)(rtw + 2 * m0 + 4); }
    for (int m0 = 4 * gw; m0 < NT; m0 += 4 * NGW) {
        const int mn = m0 + 4 * NGW < NT ? m0 + 4 * NGW : m0; const int b = m0 >> 11;
        v4u xw[4][2], y0[4][2], y1[4][2];
#pragma unroll
        for (int r = 0; r < 4; ++r) { const int i0 = 2 * r, i1 = 2 * r + 1; const int q0 = ps[i0 >> 2][i0 & 3], q1 = ps[i1 >> 2][i1 & 3];
#pragma unroll
            for (int hf = 0; hf < 2; ++hf) { const int col = 8 * lane + 512 * hf; xw[r][hf] = *(const v4u*)(x1 + (size_t)(m0 + r) * DM + col); y0[r][hf] = *(const v4u*)(ys + (size_t)q0 * DM + col); y1[r][hf] = *(const v4u*)(ys + (size_t)q1 * DM + col); } }
        v4i_ np[2]; f32x4 nw[2];
        np[0] = *(const v4i_*)(pos + 2 * mn); np[1] = *(const v4i_*)(pos + 2 * mn + 4); nw[0] = *(const f32x4*)(rtw + 2 * mn); nw[1] = *(const f32x4*)(rtw + 2 * mn + 4);
#pragma unroll
        for (int hf = 0; hf < 2; ++hf) { const int col = 8 * lane + 512 * hf; float g2[8]; rw::ld8f(mod + b * 6144 + 5120 + col, g2);
#pragma unroll
            for (int r = 0; r < 4; ++r) { const int i0 = 2 * r, i1 = 2 * r + 1; const float w0 = wt[i0 >> 2][i0 & 3], w1 = wt[i1 >> 2][i1 & 3];
                const v4u xa = xw[r][hf], a0 = y0[r][hf], a1 = y1[r][hf];
                const float xv[8] = {bflo(xa.x), bfhi(xa.x), bflo(xa.y), bfhi(xa.y), bflo(xa.z), bfhi(xa.z), bflo(xa.w), bfhi(xa.w)};
                const float e0[8] = {bflo(a0.x), bfhi(a0.x), bflo(a0.y), bfhi(a0.y), bflo(a0.z), bfhi(a0.z), bflo(a0.w), bfhi(a0.w)};
                const float e1[8] = {bflo(a1.x), bfhi(a1.x), bflo(a1.y), bfhi(a1.y), bflo(a1.z), bfhi(a1.z), bflo(a1.w), bfhi(a1.w)};
                float o[8];
#pragma unroll
                for (int e = 0; e < 8; ++e) o[e] = xv[e] + g2[e] * (e0[e] * w0 + e1[e] * w1);
                float* op = out + (size_t)(m0 + r) * DM + col; *(f32x4*)op = (f32x4){o[0], o[1], o[2], o[3]}; *(f32x4*)(op + 4) = (f32x4){o[4], o[5], o[6], o[7]}; } }
        ps[0] = np[0]; ps[1] = np[1]; wt[0] = nw[0]; wt[1] = nw[1];
    }
}

#define XB_TMO      128
#define XB_XCNT(j)  (256  + 64 * (j))
#define XB_XSUB(j)  (1280 + 64 * (j))
#define XB_XGEN(j)  (2304 + 64 * (j))
#define XB_TOP      3328
#define XB_TOPGEN   3392
#define XCD_BAR_WORDS 3456
#define XB_SPIN_CAP (1u << 22)

__device__ __forceinline__ unsigned xb_ld(unsigned* p)              { return __hip_atomic_load(p, __ATOMIC_RELAXED, __HIP_MEMORY_SCOPE_AGENT); }
__device__ __forceinline__ unsigned xb_add(unsigned* p, unsigned v) { return __hip_atomic_fetch_add(p, v, __ATOMIC_RELAXED, __HIP_MEMORY_SCOPE_AGENT); }
__device__ __forceinline__ unsigned xb_xcc_id() { return (unsigned)__builtin_amdgcn_s_getreg((3 << 11) | 20) & 0xFu; }
#define XB_SPIN(cond, bar) do { unsigned _sp = 0; while (cond) { __builtin_amdgcn_s_sleep(1); \
    if ((++_sp & 255u) == 0u) { if (xb_ld(&(bar)[XB_TMO])) break; if (_sp > XB_SPIN_CAP) { atomicAdd(&(bar)[XB_TMO], 1u); break; } } } } while (0)

struct XcdBarrier {
    unsigned* bar; unsigned x;
    volatile LAS unsigned* st;
};

__device__ __forceinline__ XcdBarrier xcd_barrier_post(unsigned* bar, volatile LAS unsigned* st, int wv) {
    XcdBarrier b; b.bar = bar; b.x = xb_xcc_id(); b.st = st;
    if (mktid(wv) == 0) (void)xb_add(&bar[XB_XCNT(b.x)], 1u);
    return b;
}
__device__ __forceinline__ void xcd_barrier_complete(unsigned* bar, unsigned x, unsigned& nloc, unsigned& nx) {
    const unsigned G = gridDim.x * gridDim.y * gridDim.z;
    unsigned sum, cnt, mine, sp = 0u;
    for (;;) {
        sum = 0u; cnt = 0u; mine = 0u;
#pragma unroll
        for (unsigned j = 0; j < 16; ++j) { const unsigned c = xb_ld(&bar[XB_XCNT(j)]); sum += c; cnt += (c > 0u) ? 1u : 0u; mine = (j == x) ? c : mine; }
        if (sum == G) break;
        __builtin_amdgcn_s_sleep(1);
        if ((++sp & 255u) == 0u) { if (xb_ld(&bar[XB_TMO])) break; if (sp > XB_SPIN_CAP) { atomicAdd(&bar[XB_TMO], 1u); break; } }
    }
    nloc = mine > 0u ? mine : 1u; nx = cnt > 0u ? cnt : 1u;
}

__device__ __forceinline__ void xcd_barrier(const XcdBarrier& b, int wv) {
    asm volatile("s_waitcnt vmcnt(0)" ::: "memory");
    __syncthreads();
    if (mktid(wv) == 0) {
        unsigned* bar = b.bar;
        __builtin_amdgcn_s_waitcnt(0);
        unsigned nloc = b.st[0], nx = b.st[1];
        if (nloc == 0u) { xcd_barrier_complete(bar, b.x, nloc, nx); b.st[0] = nloc; b.st[1] = nx; }
        const unsigned old = xb_add(&bar[XB_XSUB(b.x)], 1u);
        const unsigned gen = old / nloc;
        if (old + 1u == (gen + 1u) * nloc) {
            __builtin_amdgcn_fence(__ATOMIC_RELEASE, "agent");
            asm volatile("s_waitcnt vmcnt(0)" ::: "memory");
            const unsigned og = xb_add(&bar[XB_TOP], 1u);
            const unsigned tg = og / nx;
            if (og + 1u == (tg + 1u) * nx) xb_add(&bar[XB_TOPGEN], 1u);
            else XB_SPIN(xb_ld(&bar[XB_TOPGEN]) == tg, bar);
            __builtin_amdgcn_fence(__ATOMIC_ACQUIRE, "agent");
            xb_add(&bar[XB_XGEN(b.x)], 1u);
            asm volatile("s_waitcnt vmcnt(0)" ::: "memory");
        } else {
            XB_SPIN(xb_ld(&bar[XB_XGEN(b.x)]) == gen, bar);
            __builtin_amdgcn_fence(__ATOMIC_ACQUIRE, "agent");
            asm volatile("s_waitcnt vmcnt(0)" ::: "memory");
        }
    }
    __syncthreads();
}

constexpr int LDS_BYTES = 160 * 1024, MISC_OFF = LDS_BYTES - 256;
static_assert(rw::LDS_NEED <= MISC_OFF, "scan LDS");
constexpr int CW_BAR = 4096;

__global__ void __launch_bounds__(512, 2) mega_fwd(PArgs a) {
    extern __shared__ __attribute__((aligned(16))) unsigned char lds[];
    volatile LAS unsigned* MISC = (volatile LAS unsigned*)((LAS unsigned char*)lds + MISC_OFF);
    const int wv = __builtin_amdgcn_readfirstlane((int)threadIdx.x >> 6);
    { const int t0 = mktid(wv); if (t0 < 64) MISC[t0] = 0u; }
    __syncthreads();
    XcdBarrier bar = xcd_barrier_post((unsigned*)(a.ws + WS_CTL) + CW_BAR, MISC + 8, wv);
    GemmArgs g; g.ws = a.ws; g.x = a.in[0]; g.out = a.out; g.qg = a.in[18]; g.kg = a.in[19];
    const int G = (int)gridDim.x, bx = (int)blockIdx.x;

    p_prep_weights(a, lds, wv); __syncthreads(); p_ada(a, lds, wv);
    xcd_barrier(bar, wv);
    p_norm1(a, lds, wv);
    xcd_barrier(bar, wv);
    p_gemm_in(g, lds, wv);
    xcd_barrier(bar, wv);
    p_actprep(a, lds, wv);
    xcd_barrier(bar, wv);
    { const int nscan = G / 2;
      if (bx < nscan) { for (int bh = bx; bh < 128; bh += nscan) rw::scan_unit(a, lds, bh, wv); }
      else p_attn(a, lds, bx - nscan, G - nscan, wv); }
    __syncthreads(); p_prep_experts_dyn(a, lds, wv);
    xcd_barrier(bar, wv);
    p_gemm_merge(g, lds, wv);
    xcd_barrier(bar, wv);
    p_gemm_out(g, lds, wv);
    xcd_barrier(bar, wv);
    p_norm2_route(a, lds, wv);
    xcd_barrier(bar, wv);
    p_moe_gather(a, lds, wv);
    xcd_barrier(bar, wv);
    p_gemm_up(g, lds, wv);
    xcd_barrier(bar, wv);
    p_gemm_down(g, lds, wv);
    xcd_barrier(bar, wv);
    p_combine(a, lds, wv);
}

extern "C" void kernel_launch(void* const* d_in, const int* in_sizes, int n_in, void* d_out, int out_size, void* d_ws, size_t ws_size, hipStream_t stream) {
    static int grid = 0;
    if (grid == 0) {
        if (n_in != 30 || out_size != NT * DM || ws_size < WS_END) { fprintf(stderr, "kernel_launch: unexpected shapes (n_in %d, out %d, ws %zu)\n", n_in, out_size, ws_size); grid = -1; return; }
        int dev = 0, cus = 0, per_cu = 0;
        if (hipGetDevice(&dev) != hipSuccess || hipDeviceGetAttribute(&cus, hipDeviceAttributeMultiprocessorCount, dev) != hipSuccess) { grid = -1; return; }
        if (hipFuncSetAttribute((const void*)mega_fwd, hipFuncAttributeMaxDynamicSharedMemorySize, LDS_BYTES) != hipSuccess) { fprintf(stderr, "kernel_launch: hipFuncSetAttribute failed\n"); grid = -1; return; }
        if (hipOccupancyMaxActiveBlocksPerMultiprocessor(&per_cu, (const void*)mega_fwd, 512, LDS_BYTES) != hipSuccess || per_cu < 1) { fprintf(stderr, "kernel_launch: occupancy query says %d blocks per CU\n", per_cu); (void)hipGetLastError(); grid = -1; return; }
        grid = cus;
    }
    if (grid < 0) return;
    (void)hipMemsetAsync((char*)d_ws + WS_CTL, 0, 65536, stream);
    PArgs p{}; for (int i = 0; i < 30; ++i) p.in[i] = (const float*)d_in[i]; p.out = (float*)d_out; p.ws = (unsigned char*)d_ws;
    hipLaunchKernelGGL(mega_fwd, dim3(grid), dim3(512), LDS_BYTES, stream, p);
}
```

```cpp
#include <hip/hip_runtime.h>
#include <cstdio>
#include <cstdint>
__device__ __forceinline__ int mktid(int wv) { int l; asm volatile("v_mbcnt_lo_u32_b32 %0, -1, 0\n\tv_mbcnt_hi_u32_b32 %0, -1, %0" : "=v"(l)); return (wv << 6) | l; }
template <int CTRL> __device__ __forceinline__ float dppf(float v) { return __builtin_bit_cast(float, __builtin_amdgcn_update_dpp(0, __builtin_bit_cast(int, v), CTRL, 0xF, 0xF, true)); }
__device__ __forceinline__ float red4(float v) { v += dppf<0xB1>(v); v += dppf<0x4E>(v); return v; }
__device__ __forceinline__ float red8(float v) { v = red4(v); v += dppf<0x141>(v); return v; }
__device__ __forceinline__ float red16(float v) { v = red8(v); v += dppf<0x140>(v); return v; }
__device__ __forceinline__ float wave_sum(float v) { v = red16(v);
    v += __builtin_bit_cast(float, __builtin_amdgcn_ds_swizzle(__builtin_bit_cast(int, v), 0x401F));
    const unsigned u = __builtin_bit_cast(unsigned, v); auto rr = __builtin_amdgcn_permlane32_swap(u, u, false, false);
    return __builtin_bit_cast(float, (unsigned)rr[0]) + __builtin_bit_cast(float, (unsigned)rr[1]); }
__device__ __forceinline__ void wave_sum8(float (&v)[8]) {
#pragma unroll
    for (int i = 0; i < 8; ++i) v[i] += dppf<0xB1>(v[i]);
#pragma unroll
    for (int i = 0; i < 8; ++i) v[i] += dppf<0x4E>(v[i]);
#pragma unroll
    for (int i = 0; i < 8; ++i) v[i] += dppf<0x141>(v[i]);
#pragma unroll
    for (int i = 0; i < 8; ++i) v[i] += dppf<0x140>(v[i]);
#pragma unroll
    for (int i = 0; i < 8; ++i) v[i] += __builtin_bit_cast(float, __builtin_amdgcn_ds_swizzle(__builtin_bit_cast(int, v[i]), 0x401F));
#pragma unroll
    for (int i = 0; i < 8; ++i) { const unsigned u = __builtin_bit_cast(unsigned, v[i]); auto rr = __builtin_amdgcn_permlane32_swap(u, u, false, false); v[i] = __builtin_bit_cast(float, (unsigned)rr[0]) + __builtin_bit_cast(float, (unsigned)rr[1]); }
}
__device__ __forceinline__ float lane_get(float v, int src) { return __builtin_bit_cast(float, __builtin_amdgcn_ds_bpermute(src << 2, __builtin_bit_cast(int, v))); }
namespace pg8 {
#define PG8_LAS __attribute__((address_space(3)))
typedef unsigned short bf16_t;
typedef short bf16x8 __attribute__((ext_vector_type(8)));
typedef float f32x4 __attribute__((ext_vector_type(4)));
typedef unsigned u32x4 __attribute__((ext_vector_type(4)));
constexpr int BM = 256, BK = 64, HALF = 128, HTB = HALF * BK * 2  , STAGE_BYTES = 8 * HTB, NXCD = 8, WGM = 4;

__host__ __device__ __forceinline__ int lds_byte(int r, int c) { const int st = (r >> 4) * 2 + (c >> 5), rr = r & 15, cc = c & 31, ob = rr * 64 + cc * 2; return st * 1024 + (ob ^ (((ob >> 9) & 1) << 5)); }
__host__ __device__ __forceinline__ void stage_rc(int b, int& R, int& C) { const int st = b / 1024, sb = b % 1024, swz = sb ^ (((sb >> 9) & 1) << 5); R = (st >> 1) * 16 + swz / 64; C = (st & 1) * 32 + (swz % 64) / 2; }
__host__ __device__ __forceinline__ int perm32(int rho) { const int n = rho >> 4, i = rho & 15; return 8 * (i >> 2) + 4 * n + (i & 3); }
struct Unit { int pm, pn, aux; const char* a; const char* b; };
struct Gemm { int K; };

struct StaticOrder {
    int nM, nN, nwg, G, c; const char* A; const char* Bt; size_t tstep;
    __device__ void init(const void* A_, const void* Bt_, int M, int N, int K, int G_, int c_) { nM = M / BM; nN = N / BM; nwg = nM * nN; G = G_; c = c_; A = (const char*)A_; Bt = (const char*)Bt_; tstep = (size_t)BM * K * 2; }
    __device__ bool next(int i, Unit& u) const {
        const long L = (long)i * G + c; if (L >= nwg) return false;
        int wgid = (int)L; { const int q = nwg / NXCD, r = nwg % NXCD, xcd = wgid % NXCD, off = wgid / NXCD; wgid = (xcd < r ? xcd * (q + 1) : r * (q + 1) + (xcd - r) * q) + off; }
        const int nig = WGM * nN, gid = wgid / nig, fm = gid * WGM, gsz = (nM - fm) < WGM ? (nM - fm) : WGM;
        u.aux = 0; u.pm = fm + ((wgid % nig) % gsz); u.pn = (wgid % nig) / gsz; u.a = A + (size_t)u.pm * tstep; u.b = Bt + (size_t)u.pn * tstep; return true;
    }
    __device__ __forceinline__ void a_ready(const Unit&) const {}
    __device__ __forceinline__ void done(const Unit&) const {}
};
__device__ __forceinline__ unsigned cvt_pk_bf16(float lo, float hi) { unsigned r; asm volatile("v_cvt_pk_bf16_f32 %0, %1, %2" : "=v"(r) : "v"(lo), "v"(hi)); return r; }
template <class Epi, class Sched, bool ALIGN_EPI = false, bool SP2 = false>
__device__ __forceinline__ void gemm_phase(PG8_LAS unsigned char* lds, const Gemm g, const Sched& S, const Epi& E, int wv) {
    const int tid = mktid(wv), wid = __builtin_amdgcn_readfirstlane(tid >> 6), lane = tid & 63, wr = wid >> 2, wc = wid & 3, fr = lane & 15, fq = lane >> 4;
    const int K = g.K, nt = K / BK;
    unsigned voffA[2], voffB[2];
#pragma unroll
    for (int i = 0; i < 2; ++i) { int R, C; stage_rc(tid * 16 + i * 8192, R, C); const int Rb = Epi::PERM ? ((R & ~31) + perm32(R & 31)) : R;
        voffA[i] = (unsigned)(R * K + C) * 2u; voffB[i] = (unsigned)(Rb * K + C) * 2u; }
    const size_t kstep = (size_t)(BK * 2);
    const size_t hstep = (size_t)HALF * K * 2;
        const unsigned ldsw = (unsigned)wid * 1024u;
    const int aoff = lds_byte(wr * 64 + fr, fq * 8), boff = lds_byte(wc * 32 + fr, fq * 8);
#define PG8_SA(b, h) (((b) * 2 + (h)) * HTB)
#define PG8_SB(b, h) ((4 + (b) * 2 + (h)) * HTB)
#define PG8_STAGE(bufoff, gbase, voff) do { _Pragma("unroll") for (int _i = 0; _i < 2; ++_i) \
        __builtin_amdgcn_global_load_lds((const unsigned*)((const char*)(gbase) + (voff)[_i]), (PG8_LAS unsigned*)(lds + (bufoff) + ldsw + _i * 8192), 16, 0, 0); } while (0)
#define PG8_LDA(dst, b, h) do { _Pragma("unroll") for (int m = 0; m < 4; ++m) _Pragma("unroll") for (int k = 0; k < 2; ++k) dst[m][k] = *(const PG8_LAS bf16x8*)(lds + PG8_SA(b, h) + aoff + m * 2048 + k * 1024); } while (0)
#define PG8_LDB(dst, b, h) do { _Pragma("unroll") for (int n = 0; n < 2; ++n) _Pragma("unroll") for (int k = 0; k < 2; ++k) dst[n][k] = *(const PG8_LAS bf16x8*)(lds + PG8_SB(b, h) + boff + n * 2048 + k * 1024); } while (0)
#define PG8_MMA(ai, bj, At, Bt) do { __builtin_amdgcn_s_setprio(1); _Pragma("unroll") for (int m = 0; m < 4; ++m) _Pragma("unroll") for (int n = 0; n < 2; ++n) _Pragma("unroll") for (int k = 0; k < 2; ++k) \
        acc[ai][bj][m][n] = __builtin_amdgcn_mfma_f32_16x16x32_bf16(Bt[n][k], At[m][k], acc[ai][bj][m][n], 0, 0, 0); __builtin_amdgcn_s_setprio(0); } while (0)
#define PG8_WAIT_V(n) asm volatile("s_waitcnt vmcnt(" #n ")" ::: "memory")
#define PG8_WAIT_L(n) asm volatile("s_waitcnt lgkmcnt(" #n ")" ::: "memory")
#define PG8_BAR __builtin_amdgcn_s_barrier()
#define PG8_SCHED __builtin_amdgcn_sched_barrier(0)
    Unit cur, nxt; int ui = 0;
    if (!S.next(0, cur)) return;
    f32x4 acc[2][2][4][2];
#pragma unroll
    for (int a = 0; a < 2; ++a)
#pragma unroll
        for (int b = 0; b < 2; ++b)
#pragma unroll
            for (int m = 0; m < 4; ++m)
#pragma unroll
                for (int n = 0; n < 2; ++n) acc[a][b][m][n] = (f32x4){0.f, 0.f, 0.f, 0.f};
    bf16x8 At[4][2], B0[2][2], B1[2][2];
    const char* cA = cur.a; const char* cB = cur.b;
    S.a_ready(cur);
    if constexpr (SP2) {
        PG8_STAGE(PG8_SB(0, 0), cB, voffB); PG8_STAGE(PG8_SB(0, 1), cB + hstep, voffB); PG8_STAGE(PG8_SA(0, 0), cA, voffA); PG8_STAGE(PG8_SA(0, 1), cA + hstep, voffA);
        if (wr == 1) PG8_BAR;
        PG8_WAIT_V(2); PG8_BAR;
        PG8_STAGE(PG8_SB(1, 0), cB + kstep, voffB); PG8_STAGE(PG8_SA(1, 0), cA + kstep, voffA); PG8_STAGE(PG8_SB(1, 1), cB + hstep + kstep, voffB);
        PG8_WAIT_V(6); PG8_BAR;
    } else {
        PG8_STAGE(PG8_SB(0, 0), cB, voffB); PG8_STAGE(PG8_SA(0, 0), cA, voffA); PG8_STAGE(PG8_SB(0, 1), cB + hstep, voffB); PG8_STAGE(PG8_SA(0, 1), cA + hstep, voffA);
        if (wr == 1) PG8_BAR;
        PG8_WAIT_V(4); PG8_BAR;
        PG8_STAGE(PG8_SB(1, 0), cB + kstep, voffB); PG8_STAGE(PG8_SA(1, 0), cA + kstep, voffA); PG8_STAGE(PG8_SB(1, 1), cB + hstep + kstep, voffB);
        PG8_WAIT_V(6); PG8_BAR;
    }
    for (;;) {
        const bool has_next = S.next(ui + 1, nxt);
        const char* nA = has_next ? nxt.a : cA; const char* nB = has_next ? nxt.b : cB;
        for (int t = 0; t < nt; t += 2) {
            const bool last = (t == nt - 2);
            const char* a1 = cA + (size_t)(t + 1) * kstep;
            const char* a2 = last ? nA : cA + (size_t)(t + 2) * kstep; const char* b2 = last ? nB : cB + (size_t)(t + 2) * kstep;
            const char* a3 = a2 + kstep; const char* b3 = b2 + kstep;
            if (last && has_next) S.a_ready(nxt);
            if constexpr (SP2) {
            PG8_LDB(B0, 0, 0); PG8_LDB(B1, 0, 1); PG8_SCHED; PG8_LDA(At, 0, 0); PG8_STAGE(PG8_SA(1, 1), a1 + hstep, voffA);
            PG8_WAIT_V(8); PG8_WAIT_L(0); PG8_BAR; PG8_MMA(0, 0, At, B0); PG8_MMA(0, 1, At, B1); PG8_BAR; PG8_SCHED;
            PG8_LDA(At, 0, 1); PG8_STAGE(PG8_SB(0, 0), b2, voffB); PG8_STAGE(PG8_SB(0, 1), b2 + hstep, voffB); PG8_STAGE(PG8_SA(0, 0), a2, voffA);
            PG8_WAIT_V(8); PG8_WAIT_L(0); PG8_BAR; PG8_MMA(1, 0, At, B0); PG8_MMA(1, 1, At, B1); PG8_BAR; PG8_SCHED;
            PG8_LDB(B0, 1, 0); PG8_LDB(B1, 1, 1); PG8_SCHED; PG8_LDA(At, 1, 0); PG8_STAGE(PG8_SA(0, 1), a2 + hstep, voffA);
            PG8_WAIT_V(8); PG8_WAIT_L(0); PG8_BAR; PG8_MMA(0, 0, At, B0); PG8_MMA(0, 1, At, B1); PG8_BAR; PG8_SCHED;
            PG8_LDA(At, 1, 1); PG8_STAGE(PG8_SB(1, 0), b3, voffB); PG8_STAGE(PG8_SB(1, 1), b3 + hstep, voffB); PG8_STAGE(PG8_SA(1, 0), a3, voffA);
            PG8_WAIT_V(8); PG8_WAIT_L(0); PG8_BAR; PG8_MMA(1, 0, At, B0); PG8_MMA(1, 1, At, B1); PG8_BAR; PG8_SCHED;
            } else {
            PG8_LDB(B0, 0, 0); PG8_SCHED; PG8_LDA(At, 0, 0); PG8_STAGE(PG8_SA(1, 1), a1 + hstep, voffA);
            PG8_WAIT_L(8); PG8_BAR; PG8_WAIT_L(0); PG8_MMA(0, 0, At, B0); PG8_BAR; PG8_SCHED;
            PG8_LDB(B1, 0, 1); PG8_STAGE(PG8_SB(0, 0), b2, voffB);
            PG8_BAR; PG8_WAIT_L(0); PG8_MMA(0, 1, At, B1); PG8_BAR;
            PG8_LDA(At, 0, 1); PG8_STAGE(PG8_SA(0, 0), a2, voffA);
            PG8_BAR; PG8_WAIT_L(0); PG8_MMA(1, 0, At, B0); PG8_BAR; PG8_SCHED;
            PG8_STAGE(PG8_SB(0, 1), b2 + hstep, voffB);
            PG8_WAIT_V(6); PG8_BAR; PG8_MMA(1, 1, At, B1); PG8_BAR;
            PG8_LDB(B0, 1, 0); PG8_SCHED; PG8_LDA(At, 1, 0); PG8_STAGE(PG8_SA(0, 1), a2 + hstep, voffA);
            PG8_WAIT_L(8); PG8_BAR; PG8_WAIT_L(0); PG8_MMA(0, 0, At, B0); PG8_BAR; PG8_SCHED;
            PG8_LDB(B1, 1, 1); PG8_STAGE(PG8_SB(1, 0), b3, voffB);
            PG8_BAR; PG8_WAIT_L(0); PG8_MMA(0, 1, At, B1); PG8_BAR;
            PG8_LDA(At, 1, 1); PG8_STAGE(PG8_SA(1, 0), a3, voffA);
            PG8_BAR; PG8_WAIT_L(0); PG8_MMA(1, 0, At, B0); PG8_BAR; PG8_SCHED;
            PG8_STAGE(PG8_SB(1, 1), b3 + hstep, voffB);
            PG8_WAIT_V(6); PG8_BAR; PG8_MMA(1, 1, At, B1); PG8_BAR;
            }
        }
        if constexpr (ALIGN_EPI) { if (wr == 0) PG8_BAR; }
        bool keep = false;
        if constexpr (!Epi::AFTER_DRAIN) { if constexpr (Epi::CHAIN) keep = E.chain(acc, cur, wr, wc, fr, fq); else E(acc, cur, wr, wc, fr, fq); S.done(cur); }
        if (!has_next) break;
        if (!keep) {
#pragma unroll
        for (int a = 0; a < 2; ++a)
#pragma unroll
            for (int b = 0; b < 2; ++b)
#pragma unroll
                for (int m = 0; m < 4; ++m)
#pragma unroll
                    for (int n = 0; n < 2; ++n) acc[a][b][m][n] = (f32x4){0.f, 0.f, 0.f, 0.f};
        }
        cur = nxt; cA = nA; cB = nB; ++ui;
        if constexpr (ALIGN_EPI) { if (wr == 1) PG8_BAR; }
    }
    PG8_WAIT_V(0);
    if constexpr (!ALIGN_EPI) { if (wr == 0) PG8_BAR; }
    PG8_BAR;
    if constexpr (Epi::AFTER_DRAIN) { E.fused(acc, cur, wr, wc, fr, fq, lds, wid, lane); S.done(cur); }
#undef PG8_SA
#undef PG8_SB
#undef PG8_STAGE
#undef PG8_LDA
#undef PG8_LDB
#undef PG8_MMA
#undef PG8_WAIT_V
#undef PG8_WAIT_L
#undef PG8_BAR
#undef PG8_SCHED
}
}
#include <hip/hip_bf16.h>
#include <cmath>
namespace attn_body {
using bf16=__hip_bfloat16;
using bf16x8=__attribute__((ext_vector_type(8)))short;
using s16x4=__attribute__((ext_vector_type(4)))short;
using f32x16=__attribute__((ext_vector_type(16)))float;
using u32x4=__attribute__((ext_vector_type(4)))unsigned;
constexpr int NHEAD=8,SEQ=2048,D=64,PQ=512,PK=512,PV=4352,PO=512;
constexpr int NW=8,QBLK=32,QB=QBLK*NW,KVBLK=64,NQB=SEQ/QB;
__device__ __forceinline__ int crow(int r,int hi){return (r&3)+8*(r>>2)+4*hi;}
#define SBAR() __builtin_amdgcn_sched_barrier(0)
__device__ __forceinline__ void cmask(f32x16&p0,f32x16&p1,int jb,int qrel,int hi){
  const float NEG=-INFINITY; int kb=64*jb+4*hi;
  #pragma unroll
  for(int r=0;r<16;++r){int kv=kb+(r&3)+8*(r>>2); if(kv>qrel)p0[r]=NEG; if(kv+32>qrel)p1[r]=NEG;}
}

constexpr int NSLOT=3, SLOTB=8192;
constexpr int LDS_K=0, LDS_V=NSLOT*SLOTB, LDS_WS=2*NSLOT*SLOTB, LDS_OST=LDS_WS+NW*64*4, LDS_SEL=LDS_OST+NW*4096, LDS_KM=LDS_SEL+256, LDS_KP=LDS_KM+7*64*4, LDS_BYTES=LDS_KP+8*64*4;
constexpr float C2=0.125f*1.4426950408889634f;
__device__ __forceinline__ void glds16(const void*gsrc,unsigned lds_dst){unsigned keep;
  asm volatile("s_mov_b32 %0, m0\n\ts_mov_b32 m0, %2\n\ts_nop 0\n\tglobal_load_lds_dwordx4 %1, off\n\ts_mov_b32 m0, %0":"=&s"(keep):"v"(gsrc),"s"(lds_dst):"memory");}
__device__ __forceinline__ float max3f(float a,float b,float c){float r;asm("v_max3_f32 %0, %1, %2, %3":"=v"(r):"v"(a),"v"(b),"v"(c));return r;}
__device__ __forceinline__ float max2f(float a,float b){float r;asm("v_max_f32_e32 %0, %1, %2":"=v"(r):"v"(a),"v"(b));return r;}
__device__ __forceinline__ float fadd_s(float a,float b){float r;asm("v_add_f32_e32 %0, %1, %2":"=v"(r):"v"(a),"v"(b));return r;}
__device__ __forceinline__ float fsub_s(float a,float b){float r;asm("v_sub_f32_e32 %0, %1, %2":"=v"(r):"v"(a),"v"(b));return r;}
typedef float f32x2_t __attribute__((ext_vector_type(2))); typedef __bf16 bf16x2_t __attribute__((ext_vector_type(2)));
__device__ __forceinline__ unsigned cvtpk_s(float lo,float hi){f32x2_t v={lo,hi};bf16x2_t b=__builtin_convertvector(v,bf16x2_t);return __builtin_bit_cast(unsigned,b);}
#define WAIT_BAR(N) asm volatile("s_waitcnt vmcnt(" #N ") lgkmcnt(0)\n\ts_barrier":::"memory")

__device__ __forceinline__ void qkt(f32x16&p0,f32x16&p1,const char*Kslot,const bf16x8*qr,const f32x16&negm,int r32,int hi){
  const char*kb=Kslot+hi*1024+r32*16;
  #pragma unroll
  for(int d0=0;d0<4;++d0){
    const bf16x8 b0=*reinterpret_cast<const bf16x8*>(kb+d0*2048);
    const bf16x8 b1=*reinterpret_cast<const bf16x8*>(kb+d0*2048+512);
    if(d0==0){p0=__builtin_amdgcn_mfma_f32_32x32x16_bf16(b0,qr[0],negm,0,0,0);p1=__builtin_amdgcn_mfma_f32_32x32x16_bf16(b1,qr[0],negm,0,0,0);}
    else{p0=__builtin_amdgcn_mfma_f32_32x32x16_bf16(b0,qr[d0],p0,0,0,0);p1=__builtin_amdgcn_mfma_f32_32x32x16_bf16(b1,qr[d0],p1,0,0,0);}}
}
typedef __attribute__((address_space(3))) const char* lds_cptr;
typedef short v4i16_t __attribute__((ext_vector_type(4)));
__device__ __forceinline__ void kload8(bf16x8*kf,lds_cptr kp){
  kf[0]=*(const __attribute__((address_space(3))) bf16x8*)(kp);      kf[1]=*(const __attribute__((address_space(3))) bf16x8*)(kp+512);
  kf[2]=*(const __attribute__((address_space(3))) bf16x8*)(kp+2048); kf[3]=*(const __attribute__((address_space(3))) bf16x8*)(kp+2560);
  kf[4]=*(const __attribute__((address_space(3))) bf16x8*)(kp+4096); kf[5]=*(const __attribute__((address_space(3))) bf16x8*)(kp+4608);
  kf[6]=*(const __attribute__((address_space(3))) bf16x8*)(kp+6144); kf[7]=*(const __attribute__((address_space(3))) bf16x8*)(kp+6656);
}
__device__ __forceinline__ void kload2(bf16x8*kf,lds_cptr kp,int j){ kf[2*j]=*(const __attribute__((address_space(3))) bf16x8*)(kp+j*2048); kf[2*j+1]=*(const __attribute__((address_space(3))) bf16x8*)(kp+j*2048+512); }
__device__ __forceinline__ s16x4 vtr(lds_cptr p){ return __builtin_bit_cast(s16x4,__builtin_amdgcn_ds_read_tr16_b64_v4i16((__attribute__((address_space(3))) v4i16_t*)p)); }
__device__ __forceinline__ float rowmax(const f32x16&p0,const f32x16&p1){
  float a=max3f(p0[0],p0[1],p1[0]),b=max3f(p0[2],p0[3],p1[1]);a=max3f(a,p1[2],p1[3]);
  #pragma unroll
  for(int r=4;r<16;r+=4){a=max3f(a,p0[r],p0[r+1]);b=max3f(b,p0[r+2],p0[r+3]);a=max3f(a,p1[r],p1[r+1]);b=max3f(b,p1[r+2],p1[r+3]);}
  const float m=max2f(a,b);
  auto rr=__builtin_amdgcn_permlane32_swap(__float_as_uint(m),__float_as_uint(m),false,false);
  return max2f(__uint_as_float(rr[0]),__uint_as_float(rr[1]));
}
__device__ __forceinline__ void pv(f32x16*o,int vb,bf16x8 pa0,bf16x8 pa1,bf16x8 pa2,bf16x8 pa3){
  #pragma unroll
  for(int d0=0;d0<2;++d0){s16x4 lo[4],hi[4];
    #pragma unroll
    for(int ks=0;ks<4;++ks){
      asm volatile("ds_read_b64_tr_b16 %0,%1 offset:%c2":"=&v"(lo[ks]):"v"(vb),"i"(d0*4096+ks*1024):"memory");
      asm volatile("ds_read_b64_tr_b16 %0,%1 offset:%c2":"=&v"(hi[ks]):"v"(vb),"i"(d0*4096+ks*1024+512):"memory");}
    asm volatile("s_waitcnt lgkmcnt(0)":::"memory");SBAR();
    #define PK(k) (bf16x8){lo[k][0],lo[k][1],lo[k][2],lo[k][3],hi[k][0],hi[k][1],hi[k][2],hi[k][3]}
    o[d0]=__builtin_amdgcn_mfma_f32_32x32x16_bf16(pa0,PK(0),o[d0],0,0,0);
    o[d0]=__builtin_amdgcn_mfma_f32_32x32x16_bf16(pa1,PK(1),o[d0],0,0,0);
    o[d0]=__builtin_amdgcn_mfma_f32_32x32x16_bf16(pa2,PK(2),o[d0],0,0,0);
    o[d0]=__builtin_amdgcn_mfma_f32_32x32x16_bf16(pa3,PK(3),o[d0],0,0,0);
    #undef PK
  }
}

#ifndef ATTN_STORE16
#define ATTN_STORE16(p,v) (*(u32x4*)(p)=(v))
#endif
template<int THRL> __device__ __forceinline__ void attn_unit(int b,int h,int qb,const bf16*Q,const bf16*__restrict__ K,const bf16*__restrict__ V,bf16*O,char*shm,int wv){
  const int tid=mktid(wv),lane=tid&63,r32=lane&31,hi=lane>>5;     const int wid=__builtin_amdgcn_readfirstlane(tid>>6);
  const long rowbase=(long)b*SEQ; const int q0=qb*QB;
  if(qb>3){ float*KMl=(float*)(shm+LDS_KM); float*KPl=(float*)(shm+LDS_KP); const int c8=tid&7, rl=tid>>3;
    for(int n=0;n<qb;++n){ float sm[8];
      #pragma unroll
      for(int d=0;d<8;++d)sm[d]=0.f;
      #pragma unroll
      for(int rr=0;rr<4;++rr){ const u32x4 w=*reinterpret_cast<const u32x4*>(K+(rowbase+n*256+rl+64*rr)*PK+h*D+8*c8);
        sm[0]+=__uint_as_float(w[0]<<16);sm[1]+=__uint_as_float(w[0]&0xffff0000u);sm[2]+=__uint_as_float(w[1]<<16);sm[3]+=__uint_as_float(w[1]&0xffff0000u);
        sm[4]+=__uint_as_float(w[2]<<16);sm[5]+=__uint_as_float(w[2]&0xffff0000u);sm[6]+=__uint_as_float(w[3]<<16);sm[7]+=__uint_as_float(w[3]&0xffff0000u); }
      #pragma unroll
      for(int d=0;d<8;++d){ float v=sm[d];
        v+=__builtin_bit_cast(float,__builtin_amdgcn_ds_swizzle(__builtin_bit_cast(int,v),0x201F));
        v+=__builtin_bit_cast(float,__builtin_amdgcn_ds_swizzle(__builtin_bit_cast(int,v),0x401F));
        { const unsigned u=__builtin_bit_cast(unsigned,v); auto rr2=__builtin_amdgcn_permlane32_swap(u,u,false,false); v=__uint_as_float((unsigned)rr2[0])+__uint_as_float((unsigned)rr2[1]); }
        sm[d]=v; }
      if(lane<8){
        #pragma unroll
        for(int d=0;d<8;++d)KPl[wid*64+8*lane+d]=sm[d]; }
      asm volatile("s_waitcnt vmcnt(0) lgkmcnt(0)\n\ts_barrier":::"memory");
      if(tid<64){ float s8=0.f;
        #pragma unroll
        for(int w8=0;w8<8;++w8)s8+=KPl[w8*64+tid];
        KMl[n*64+tid]=s8*(1.0f/256.0f); }
      asm volatile("s_waitcnt lgkmcnt(0)\n\ts_barrier":::"memory"); } }
  if(tid<QB){ unsigned sel=(qb<=3)?((1u<<qb)-1u):0u;
    if(qb>3){ const bf16*qp=Q+(rowbase+q0+tid)*PQ+h*D; const float*km=(const float*)(shm+LDS_KM); float gate[7];
      #pragma unroll
      for(int j=0;j<7;++j)gate[j]=0.f;
      #pragma unroll 1
      for(int i=0;i<8;++i){ const u32x4 w=*reinterpret_cast<const u32x4*>(qp+8*i); float qv[8];
        qv[0]=__uint_as_float(w[0]<<16);qv[1]=__uint_as_float(w[0]&0xffff0000u);qv[2]=__uint_as_float(w[1]<<16);qv[3]=__uint_as_float(w[1]&0xffff0000u);
        qv[4]=__uint_as_float(w[2]<<16);qv[5]=__uint_as_float(w[2]&0xffff0000u);qv[6]=__uint_as_float(w[3]<<16);qv[7]=__uint_as_float(w[3]&0xffff0000u);
        #pragma unroll
        for(int j=0;j<7;++j) if(j<qb){ const float*kp=km+j*64+8*i;
          #pragma unroll
          for(int d=0;d<8;++d)gate[j]+=qv[d]*kp[d]; } }
      #pragma unroll
      for(int rep=0;rep<3;++rep){ float best=-INFINITY; int bi=0;
        #pragma unroll
        for(int j=0;j<7;++j) if(j<qb&&!((sel>>j)&1u)&&gate[j]>best){best=gate[j];bi=j;}
        sel|=1u<<bi; } }
    ((unsigned char*)(shm+LDS_SEL))[tid]=(unsigned char)sel; }
  asm volatile("s_waitcnt vmcnt(0) lgkmcnt(0)\n\ts_barrier":::"memory");
  const bf16*Qw=Q+(rowbase+q0+wid*QBLK)*PQ+h*D;
  const bf16*Kh=K+rowbase*PK+h*D,*Vh=V+rowbase*PV+h*D;
  const unsigned lds0=(unsigned)(uintptr_t)shm;
  float*wsf=(float*)(shm+LDS_WS)+wid*64;
  const bf16*ksrc=Kh+(long)lane*PK+wid*8;
  const bf16*vsrc=Vh+(long)(16*(wid&3)+(lane>>2))*PV+(wid>>2)*32+(lane&3)*8;
  const unsigned kdst=lds0+LDS_K+wid*1024, vdst=lds0+LDS_V+wid*1024;
  #define TROW(t) ((long)(((t)<4)?(q0+(t)*KVBLK):(((t)-4)*KVBLK)))
  #define DMA_K(t,slot) glds16(ksrc+TROW(t)*PK,(unsigned)__builtin_amdgcn_readfirstlane(kdst+(slot)))
  #define DMA_V(t,slot) glds16(vsrc+TROW(t)*PV,(unsigned)__builtin_amdgcn_readfirstlane(vdst+(slot)))
  const int vb0=(int)(lds0+LDS_V)+((lane>>4)&1)*32+(lane&3)*8+(4*hi+((lane&15)>>2))*64;
  const char*Kbase=shm+LDS_K; bf16x8 kf[8];
  const lds_cptr shm3=(lds_cptr)shm; const lds_cptr kp0=shm3+LDS_K+hi*1024+r32*16; const lds_cptr vp0=shm3+LDS_V+((lane>>4)&1)*32+(lane&3)*8+(4*hi+((lane&15)>>2))*64;
  const int NT=(q0+QB)/KVBLK;
  DMA_K(0,0);DMA_V(0,0);DMA_K(1,SLOTB);
  bf16x8 qr[4];
  #pragma unroll
  for(int d0=0;d0<4;++d0)qr[d0]=*reinterpret_cast<const bf16x8*>(&Qw[(long)r32*PQ+d0*16+hi*8]);
  float mhat=0.f,l_reg=0.f;f32x16 o[2];o[0]=f32x16{};o[1]=f32x16{};
  const int qrel=wid*QBLK+r32;
  const unsigned selb=((const unsigned char*)(shm+LDS_SEL))[qrel];
  #define CMASK(P0,P1,t) cmask(P0,P1,(t),qrel,hi)
  #define SUBREF(C0,C1,t) do{ const float sb_=(((t)<4)||((selb>>(((t)-4)>>2))&1u))?mhat:INFINITY; _Pragma("unroll") for(int r_=0;r_<16;++r_){C0[r_]-=sb_;C1[r_]-=sb_;} }while(0)
  bool resc=false;
  #define START(P0,P1) do{ const float rm=rowmax(P0,P1); resc=false; \
    { const float dl=rm; mhat=fadd_s(mhat,dl); \
      _Pragma("unroll") for(int r=0;r<16;++r){P0[r]=fsub_s(P0[r],dl);P1[r]=fsub_s(P1[r],dl);} \
      } \
    _Pragma("unroll") for(int r=0;r<16;++r)P0[r]=__builtin_amdgcn_exp2f(P0[r]); }while(0)
  #define RESC() do{ if(resc){ asm volatile("s_waitcnt lgkmcnt(0)":::"memory"); \
      _Pragma("unroll") for(int d_=0;d_<2;++d_) _Pragma("unroll") for(int r=0;r<16;++r)o[d_][r]*=wsf[crow(r,hi)]; } }while(0)
  f32x16 pA0,pA1,pB0,pB1;
  int sl_prev=0,sl_cur=0,sl_next=SLOTB;
  #define ROT() do{sl_prev=sl_cur;sl_cur=sl_next;sl_next=(sl_next==(NSLOT-1)*SLOTB)?0:sl_next+SLOTB;}while(0)
  DMA_K(2,2*SLOTB);
  WAIT_BAR(3);
  qkt(pA0,pA1,Kbase,qr,f32x16{},r32,hi);asm volatile("s_nop 15\n\ts_nop 7":"+v"(pA0),"+v"(pA1));CMASK(pA0,pA1,0);
  START(pA0,pA1);
  _Pragma("unroll") for(int r=0;r<16;++r)pA1[r]=__builtin_amdgcn_exp2f(pA1[r]);
  WAIT_BAR(0);
  DMA_K(3,0);DMA_V(1,SLOTB);
  ROT();
  kload8(kf,kp0+sl_cur);
  WAIT_BAR(2);
  s16x4 vlo[8],vhi[8]; u32x4 pw0,pw1,pw2,pw3;
  #define PKW(P,B) cvtpk_s(P[B],P[B+1])
  #define PAF(k) __builtin_bit_cast(bf16x8,pw##k)
  #define VFR(i) (bf16x8){vlo[i][0],vlo[i][1],vlo[i][2],vlo[i][3],vhi[i][0],vhi[i][1],vhi[i][2],vhi[i][3]}
  #define PIN(x) asm volatile("":"+v"(x))
  #define MX3(a,b,c) __builtin_fmaxf(__builtin_fmaxf((a),(b)),(c))
  #define GAPA(MF,A0,A1,A2,A3,W0,W1,PW) do{ MF; sacc+=A0; sacc+=A1; sacc+=A2; sacc+=A3; PIN(sacc); W0; W1; PIN(PW); SBAR(); }while(0)
  #define EX(v) __builtin_amdgcn_exp2f(v)
  #define GAPB(MF,X,B) do{ MF; X[B]=EX(X[B]); X[B+1]=EX(X[B+1]); X[B+2]=EX(X[B+2]); X[B+3]=EX(X[B+3]); PIN(X); SBAR(); }while(0)
  #define VRD(i) do{ vlo[i]=vtr(vp_+(((i)>>2)*4096+((i)&3)*1024)); vhi[i]=vtr(vp_+(((i)>>2)*4096+((i)&3)*1024+512)); }while(0)
  #define KRD(G,j) do{ if(G){ kload2(kf,kp0+sl_next,j); SBAR(); } }while(0)
  #define STEP(C0,C1,P0,P1,t,GK,GV,GL,MB) do{ SBAR(); \
    const lds_cptr vp_=vp0+sl_prev; \
    VRD(0); SBAR(); float sacc=(P0[0]+P0[1]); \
    GAPA(C0=__builtin_amdgcn_mfma_f32_32x32x16_bf16(kf[0],qr[0],f32x16{},0,0,0), P0[2],P0[3],P0[4],P0[5],     pw0[0]=PKW(P0,0), pw0[1]=PKW(P0,2), pw0); \
    VRD(4); SBAR(); GAPA(C1=__builtin_amdgcn_mfma_f32_32x32x16_bf16(kf[1],qr[0],f32x16{},0,0,0), P0[6],P0[7],P0[8],P0[9],     pw0[2]=PKW(P0,4), pw0[3]=PKW(P0,6), pw0); \
    VRD(1); SBAR(); GAPA(C0=__builtin_amdgcn_mfma_f32_32x32x16_bf16(kf[2],qr[1],C0,0,0,0),   P0[10],P0[11],P0[12],P0[13], pw1[0]=PKW(P0,8), pw1[1]=PKW(P0,10), pw1); \
    VRD(5); SBAR(); GAPA(C1=__builtin_amdgcn_mfma_f32_32x32x16_bf16(kf[3],qr[1],C1,0,0,0),   P0[14],P0[15],P1[0],P1[1],   pw1[2]=PKW(P0,12),pw1[3]=PKW(P0,14), pw1); \
    VRD(2); SBAR(); GAPA(C0=__builtin_amdgcn_mfma_f32_32x32x16_bf16(kf[4],qr[2],C0,0,0,0),   P1[2],P1[3],P1[4],P1[5],     pw2[0]=PKW(P1,0), pw2[1]=PKW(P1,2), pw2); \
    VRD(6); SBAR(); GAPA(C1=__builtin_amdgcn_mfma_f32_32x32x16_bf16(kf[5],qr[2],C1,0,0,0),   P1[6],P1[7],P1[8],P1[9],     pw2[2]=PKW(P1,4), pw2[3]=PKW(P1,6), pw2); \
    VRD(3); SBAR(); GAPA(C0=__builtin_amdgcn_mfma_f32_32x32x16_bf16(kf[6],qr[3],C0,0,0,0),   P1[10],P1[11],P1[12],P1[13], pw3[0]=PKW(P1,8), pw3[1]=PKW(P1,10), pw3); \
    VRD(7); SBAR(); GAPA(C1=__builtin_amdgcn_mfma_f32_32x32x16_bf16(kf[7],qr[3],C1,0,0,0),   P1[14],P1[15],0.f,0.f,       pw3[2]=PKW(P1,12),pw3[3]=PKW(P1,14), pw3); \
    l_reg+=sacc; \
    if(GK){DMA_K((t)+3,sl_cur);} if(GV){DMA_V((t)+1,sl_next);} \
    SUBREF(C0,C1,t); if(MB){CMASK(C0,C1,t);} \
    { float a=MX3(C0[0],C0[1],C1[0]),b=MX3(C0[2],C0[3],C1[1]); a=MX3(a,C1[2],C1[3]); \
      _Pragma("unroll") for(int r=4;r<16;r+=4){a=MX3(a,C0[r],C0[r+1]);b=MX3(b,C0[r+2],C0[r+3]);a=MX3(a,C1[r],C1[r+1]);b=MX3(b,C1[r+2],C1[r+3]);} \
      float rm=__builtin_fmaxf(a,b); { auto rr=__builtin_amdgcn_permlane32_swap(__float_as_uint(rm),__float_as_uint(rm),false,false); rm=__builtin_fmaxf(__uint_as_float(rr[0]),__uint_as_float(rr[1])); } \
      resc=false; \
      if(__builtin_expect(__any(rm>(float)THRL),0)){ const float dl=__builtin_fmaxf(rm,0.f); mhat+=dl; \
        _Pragma("unroll") for(int r=0;r<16;++r){C0[r]-=dl;C1[r]-=dl;} \
        const float f=__builtin_amdgcn_exp2f(-dl); l_reg*=f; if(hi==0)wsf[r32]=f; resc=true; } } \
    SBAR(); \
    GAPB(o[0]=__builtin_amdgcn_mfma_f32_32x32x16_bf16(PAF(0),VFR(0),o[0],0,0,0), C0,0); \
    GAPB(o[1]=__builtin_amdgcn_mfma_f32_32x32x16_bf16(PAF(0),VFR(4),o[1],0,0,0), C0,4); \
    KRD(GL,0); GAPB(o[0]=__builtin_amdgcn_mfma_f32_32x32x16_bf16(PAF(1),VFR(1),o[0],0,0,0), C0,8); \
    KRD(GL,1); GAPB(o[1]=__builtin_amdgcn_mfma_f32_32x32x16_bf16(PAF(1),VFR(5),o[1],0,0,0), C0,12); \
    KRD(GL,2); GAPB(o[0]=__builtin_amdgcn_mfma_f32_32x32x16_bf16(PAF(2),VFR(2),o[0],0,0,0), C1,0); \
    KRD(GL,3); GAPB(o[1]=__builtin_amdgcn_mfma_f32_32x32x16_bf16(PAF(2),VFR(6),o[1],0,0,0), C1,4); \
    GAPB(o[0]=__builtin_amdgcn_mfma_f32_32x32x16_bf16(PAF(3),VFR(3),o[0],0,0,0), C1,8); \
    GAPB(o[1]=__builtin_amdgcn_mfma_f32_32x32x16_bf16(PAF(3),VFR(7),o[1],0,0,0), C1,12); \
    }while(0)
  #define ENDW(tt) do{ if((tt)+3<NT){WAIT_BAR(2);} else if((tt)+2<NT){WAIT_BAR(1);} else {WAIT_BAR(0);} }while(0)
  { int t=1;
    for(;t+1<NT;t+=2){
      STEP(pB0,pB1,pA0,pA1,t,(t+3<NT),(t+1<NT),(t+1<NT),(t<4));       ENDW(t);   RESC(); ROT();
      STEP(pA0,pA1,pB0,pB1,t+1,(t+4<NT),(t+2<NT),(t+2<NT),(t+1<4));     ENDW(t+1); RESC(); ROT();
    }
    STEP(pB0,pB1,pA0,pA1,NT-1,false,false,false,(NT==4)); RESC();
  }
  { float sacc=pB0[0]+pB0[1]; _Pragma("unroll") for(int r=2;r<16;++r)sacc+=pB0[r]; _Pragma("unroll") for(int r=0;r<16;++r)sacc+=pB1[r]; l_reg+=sacc;
    pw0=(u32x4){PKW(pB0,0),PKW(pB0,2),PKW(pB0,4),PKW(pB0,6)};pw1=(u32x4){PKW(pB0,8),PKW(pB0,10),PKW(pB0,12),PKW(pB0,14)};pw2=(u32x4){PKW(pB1,0),PKW(pB1,2),PKW(pB1,4),PKW(pB1,6)};pw3=(u32x4){PKW(pB1,8),PKW(pB1,10),PKW(pB1,12),PKW(pB1,14)};
    SBAR(); pv(o,vb0+sl_cur,PAF(0),PAF(1),PAF(2),PAF(3)); }
  #undef PKW
  #undef PAF
  #undef VFR
  #undef PIN
  #undef MX3
  #undef GAPA
  #undef GAPB
  #undef EX
  #undef VRD
  #undef KRD
  #undef STEP
  #undef ENDW
  {auto rr=__builtin_amdgcn_permlane32_swap(__float_as_uint(l_reg),__float_as_uint(l_reg),false,false);l_reg=__uint_as_float(rr[0])+__uint_as_float(rr[1]);}
  if(hi==0)wsf[32+r32]=l_reg;asm volatile("s_waitcnt lgkmcnt(0)":::"memory");
  float rli[16];
  #pragma unroll
  for(int r=0;r<16;++r)rli[r]=__builtin_amdgcn_rcpf(wsf[32+crow(r,hi)]);
  bf16*Ow=O+(rowbase+q0+wid*QBLK)*PO+h*D;
  { bf16*stg=(bf16*)(shm+LDS_OST)+wid*2048;
    #pragma unroll
    for(int r=0;r<16;++r){const int orow=crow(r,hi);
      #pragma unroll
      for(int d0=0;d0<2;++d0)stg[orow*64+d0*32+r32]=__float2bfloat16(o[d0][r]*rli[r]);}
    asm volatile("s_waitcnt lgkmcnt(0)":::"memory");
    #pragma unroll
    for(int i=0;i<4;++i){const int row=i*8+(lane>>3),ch=lane&7; const u32x4 v=*(const u32x4*)(stg+row*64+ch*8); ATTN_STORE16(Ow+(long)row*PO+ch*8,v);} }
  asm volatile("s_waitcnt lgkmcnt(0)\n\ts_barrier":::"memory");
  #undef DMA_K
  #undef TROW
  #undef SUBREF
  #undef DMA_V
  #undef CMASK
  #undef START
  #undef RESC
  #undef ROT
}
constexpr int ATTN_LDS_BYTES=LDS_BYTES;
#undef SBAR
#undef WAIT_BAR
}
constexpr int DM = 1024, NB = 16, SEQ = 2048, NT = NB * SEQ;
constexpr int RWW = 512, WIN_N = 5376, INC = 4352, ZV = 1792, ZG = 2304;
constexpr int NEXP = 32, DEXP = 512;
constexpr int XS_ROWS = 2 * NT + NEXP * 256;
constexpr float C2 = 0.125f * 1.4426950408889634f;

#define LAS __attribute__((address_space(3)))
#define GAS __attribute__((address_space(1)))
typedef unsigned short bf16;
typedef unsigned v4u __attribute__((ext_vector_type(4)));
typedef unsigned v2u __attribute__((ext_vector_type(2)));
typedef float f32x4 __attribute__((ext_vector_type(4)));

typedef float f32x2_c __attribute__((ext_vector_type(2))); typedef __bf16 bf16x2_c __attribute__((ext_vector_type(2)));
__device__ __forceinline__ unsigned pk2(float lo, float hi) { const f32x2_c v = {lo, hi}; return __builtin_bit_cast(unsigned, __builtin_convertvector(v, bf16x2_c)); }
__device__ __forceinline__ unsigned f2bf(float f) { return pk2(f, f) & 0xffffu; }
__device__ __forceinline__ float bflo(unsigned w) { return __builtin_bit_cast(float, w << 16); }
__device__ __forceinline__ float bfhi(unsigned w) { return __builtin_bit_cast(float, w & 0xffff0000u); }
__device__ __forceinline__ float sigm(float x) { return __builtin_amdgcn_rcpf(1.0f + __expf(-x)); }

constexpr size_t MiB = 1u << 20;
constexpr size_t WS_CTL = 0;
constexpr size_t WS_MOD = 1 * MiB;
constexpr size_t WS_GM2 = 1 * MiB + 512 * 1024;
constexpr size_t WS_CB = 1 * MiB + 640 * 1024;
constexpr size_t WS_COS = 2 * MiB;
constexpr size_t WS_SIN = 2 * MiB + 512 * 1024;
constexpr size_t WS_KMEAN = 3 * MiB;
constexpr size_t WS_WRH = 3 * MiB + 512 * 1024;
constexpr size_t WS_WRL = 3 * MiB + 768 * 1024;
constexpr size_t WS_SEL = 4 * MiB;
constexpr size_t WS_RTE = 5 * MiB;
constexpr size_t WS_RTW = 5 * MiB + 256 * 1024;
constexpr size_t WS_RNK = 5 * MiB + 512 * 1024;
constexpr size_t WS_POS = 5 * MiB + 768 * 1024;
constexpr size_t WS_RSTD = 7 * MiB;
constexpr size_t WS_WLT = 6 * MiB;
constexpr size_t WS_WAT = 6 * MiB + 64 * 1024;
constexpr size_t WS_WGT = 6 * MiB + 128 * 1024;
constexpr size_t WS_WIN = 16 * MiB;
constexpr size_t WS_WBA = 27 * MiB;
constexpr size_t WS_WBB = 28 * MiB;
constexpr size_t WS_WOUT = 29 * MiB;
constexpr size_t WS_Z = 32 * MiB;
constexpr size_t WS_H = 368 * MiB;
constexpr size_t WS_Q = 304 * MiB, WS_K = 336 * MiB, WS_MRG = 304 * MiB;
constexpr size_t WS_YA = 432 * MiB, WS_YB = 464 * MiB;
constexpr size_t WS_WUP = 368 * MiB;
constexpr size_t WS_H2 = 128 * MiB;
constexpr size_t WS_XS = 64 * MiB;
constexpr size_t WS_HID = 208 * MiB;
constexpr size_t WS_X1B = 432 * MiB;
constexpr size_t WS_ACT = 496 * MiB;
constexpr size_t WS_END = 512 * MiB;
constexpr int CW_CNT = 64, CNT_PAD = 64;
constexpr int CW_NT = 2304;
constexpr int CW_TEXP = 2368;
static_assert(CW_CNT + NEXP * CNT_PAD <= CW_NT, "control words");

__device__ __forceinline__ void tr_item(const float* W, int K, int N, bf16* WT, int kb, int nb, int dst_row0, LAS float* scr, int lane) {
    const int k0 = 64 * kb, n0 = 32 * nb;
#pragma unroll
    for (int i = 0; i < 32; ++i) { const int kk = 2 * i + (lane >> 5); scr[kk * 33 + (lane & 31)] = W[(size_t)(k0 + kk) * N + n0 + (lane & 31)]; }
    asm volatile("s_waitcnt lgkmcnt(0)" ::: "memory");
    const int c = lane & 7;
#pragma unroll
    for (int j = 0; j < 4; ++j) { const int n = (lane >> 3) + 8 * j; const LAS float* s = scr + (8 * c) * 33 + n;
        v4u o; o.x = pk2(s[0 * 33], s[1 * 33]); o.y = pk2(s[2 * 33], s[3 * 33]); o.z = pk2(s[4 * 33], s[5 * 33]); o.w = pk2(s[6 * 33], s[7 * 33]);
        *(v4u*)(WT + (size_t)(dst_row0 + n) * K + k0 + 8 * c) = o; }
    asm volatile("s_waitcnt lgkmcnt(0)" ::: "memory");
}

struct PArgs { const float* in[30]; float* out; unsigned char* ws; };

__device__ __forceinline__ void p_prep_weights(const PArgs& a, unsigned char* lds, int wv) {
    const int tid = mktid(wv), lane = tid & 63, wave = tid >> 6;
    LAS float* scr = (LAS float*)lds + wave * (64 * 33);
    const int gw = blockIdx.x * 8 + wave, NGW = gridDim.x * 8;
    unsigned char* ws = a.ws;
    constexpr int I_IN = 16 * 168, I_BR = 8 * 32, I_OUT = 16 * 32;
    for (int it = gw; it < I_IN + 2 * I_BR + I_OUT; it += NGW) {
        int r = it;
        if (r < I_IN) { const int kb = r / 168, nb = r % 168; int dst = 32 * nb;
            if (dst >= 1792 && dst < 2816) { const int rel = dst - 1792, u = rel >> 8, hl = (rel & 255) >> 6, half = (rel & 63) >> 5; dst = 1792 + u * 256 + half * 128 + hl * 32; }
            tr_item(a.in[6], 1024, WIN_N, (bf16*)(ws + WS_WIN), kb, nb, dst, scr, lane); continue; } r -= I_IN;
        if (r < I_BR) { const int kb = r / 32, nb = r % 32; tr_item(a.in[20], 512, 1024, (bf16*)(ws + WS_WBA), kb, nb, 32 * nb, scr, lane); continue; } r -= I_BR;
        if (r < I_BR) { const int kb = r / 32, nb = r % 32; tr_item(a.in[21], 512, 1024, (bf16*)(ws + WS_WBB), kb, nb, 32 * nb, scr, lane); continue; } r -= I_BR;
        { const int kb = r / 32, nb = r % 32; tr_item(a.in[22], 1024, 1024, (bf16*)(ws + WS_WOUT), kb, nb, 32 * nb, scr, lane); }
    }
    const int gt = blockIdx.x * 512 + tid, NGT = gridDim.x * 512;
    float* cosT = (float*)(ws + WS_COS); float* sinT = (float*)(ws + WS_SIN);
    for (int i = gt; i < SEQ * 32; i += NGT) { const int s = i >> 5, f = i & 31; const float inv = powf(10000.0f, -(float)f / 32.0f); const float ang = (float)s * inv; cosT[i] = cosf(ang); sinT[i] = sinf(ang); }
    { bf16* wlt = (bf16*)(ws + WS_WLT); bf16* wat = (bf16*)(ws + WS_WAT); bf16* wgt = (bf16*)(ws + WS_WGT);
      for (int i = gt; i < 8 * 64 * 64; i += NGT) { const int hh = i >> 12, j = (i >> 6) & 63, m = i & 63; wlt[i] = (bf16)f2bf(a.in[9][m * 512 + hh * 64 + j]); wat[i] = (bf16)f2bf(a.in[11][m * 512 + hh * 64 + j]); }
      for (int i = gt; i < 8 * 64 * 128; i += NGT) { const int hh = i >> 13, j = (i >> 7) & 63, m = i & 127; wgt[i] = (bf16)f2bf(a.in[12][m * 512 + hh * 64 + j]); } }
    { bf16* wrh = (bf16*)(ws + WS_WRH); bf16* wrl = (bf16*)(ws + WS_WRL);
      for (int i = gt; i < 48 * 1024; i += NGT) { const int e = i >> 10, k = i & 1023; const float w = e < 4 ? a.in[23][k * 4 + e] : e < 36 ? a.in[25][k * 32 + (e - 4)] : 0.f;
          const unsigned hi = f2bf(w); wrh[i] = (bf16)hi; wrl[i] = (bf16)f2bf(w - bflo(hi)); } }
}

constexpr int CW_PEXP = 2816;
__device__ __forceinline__ void p_prep_experts_dyn(const PArgs& a, unsigned char* lds, int wv) {
    const int tid = mktid(wv), lane = tid & 63, wave = tid >> 6;
    LAS float* scr = (LAS float*)lds + wave * (64 * 33);
    unsigned* ctr = (unsigned*)(a.ws + WS_CTL) + CW_PEXP;
    constexpr int NITEM = NEXP * 768;
    for (;;) {
        unsigned base = 0; if (lane == 0) base = atomicAdd(ctr, 16u);
        base = (unsigned)__builtin_amdgcn_readfirstlane((int)base);
        if (base >= (unsigned)NITEM) break;
        for (int it = (int)base; it < (int)base + 16 && it < NITEM; ++it) {
            const int e = it / 768; int r = it % 768;
            bf16* wup = (bf16*)(a.ws + WS_WUP) + (size_t)e * 1024 * 1024;
            if (r < 256) { const int kb = r / 16, nb = r % 16, n0 = 32 * nb; tr_item(a.in[27] + (size_t)e * 1024 * 512, 1024, 512, wup, kb, nb, (n0 >> 7) * 256 + (n0 & 127), scr, lane); continue; } r -= 256;
            if (r < 256) { const int kb = r / 16, nb = r % 16, n0 = 32 * nb; tr_item(a.in[28] + (size_t)e * 1024 * 512, 1024, 512, wup, kb, nb, (n0 >> 7) * 256 + 128 + (n0 & 127), scr, lane); continue; } r -= 256;
            { const int kb = r / 32, nb = r % 32; tr_item(a.in[29] + (size_t)e * 512 * 1024, 512, 1024, (bf16*)a.out + (size_t)e * 1024 * 512, kb, nb, 32 * nb, scr, lane); }
        }
    }
}

__device__ __forceinline__ void p_ada_load(const PArgs& a, int tile, int tid, float (&wr)[64]) {
    const float* w = a.in[2] + (size_t)((tid >> 5) * 64) * 6144 + tile * 32 + (tid & 31);
#pragma unroll
    for (int i = 0; i < 64; ++i) wr[i] = w[(size_t)i * 6144];
}
__device__ __forceinline__ void p_ada_finish(const PArgs& a, const float* sc, float* red, int tile, int tid, const float (&wr)[64]) {
    const float* bias = a.in[3]; float* mod = (float*)(a.ws + WS_MOD);
    const int col = tid & 31, kg = tid >> 5;
    float acc[16];
#pragma unroll
    for (int b = 0; b < 16; ++b) acc[b] = 0.f;
#pragma unroll
    for (int i = 0; i < 64; ++i)
#pragma unroll
        for (int b = 0; b < 16; ++b) acc[b] += sc[b * 1024 + kg * 64 + i] * wr[i];
#pragma unroll
    for (int b = 0; b < 16; ++b) red[(kg * 16 + b) * 32 + col] = acc[b];
    __syncthreads();
    { const int b = tid >> 5, cc = tid & 31; float sm = 0.f;
#pragma unroll
        for (int k = 0; k < 16; ++k) sm += red[(k * 16 + b) * 32 + cc];
        mod[b * 6144 + tile * 32 + cc] = sm + bias[tile * 32 + cc]; }
    __syncthreads();
}

__device__ __forceinline__ void p_norm1(const PArgs& a, unsigned char* lds, int wv) {
    const int tid = mktid(wv), lane = tid & 63, gw = blockIdx.x * 8 + (tid >> 6), NGW = gridDim.x * 8;
    const float* x = a.in[0]; const float* g = a.in[4]; const float* mod = (const float*)(a.ws + WS_MOD);
    bf16* h = (bf16*)(a.ws + WS_H);
    f32x4 v[4][4];
    { const f32x4* xr = (const f32x4*)(x + (size_t)(4 * gw < NT ? 4 * gw : 0) * DM) + lane;
#pragma unroll
      for (int r = 0; r < 4; ++r)
#pragma unroll
          for (int j = 0; j < 4; ++j) v[r][j] = xr[256 * r + 64 * j]; }
    for (int m0 = 4 * gw; m0 < NT; m0 += 4 * NGW) {
        const int mn = m0 + 4 * NGW < NT ? m0 + 4 * NGW : m0;
        f32x4 nv[4][4];
        { const f32x4* xr = (const f32x4*)(x + (size_t)mn * DM) + lane;
#pragma unroll
          for (int r = 0; r < 4; ++r)
#pragma unroll
              for (int j = 0; j < 4; ++j) nv[r][j] = xr[256 * r + 64 * j]; }
        const int b = m0 >> 11; float rstd[4];
#pragma unroll
        for (int r = 0; r < 4; ++r) { float s = 0.f;
#pragma unroll
            for (int j = 0; j < 4; ++j) s += (v[r][j].x * v[r][j].x + v[r][j].y * v[r][j].y) + (v[r][j].z * v[r][j].z + v[r][j].w * v[r][j].w);
            rstd[r] = rsqrtf(wave_sum(s) * (1.0f / DM) + 1e-6f); }
#pragma unroll
        for (int j = 0; j < 4; ++j) { const int col = 4 * (lane + 64 * j);
            const f32x4 gg = *(const f32x4*)(g + col), sh = *(const f32x4*)(mod + b * 6144 + col), scl = *(const f32x4*)(mod + b * 6144 + 1024 + col);
#pragma unroll
            for (int r = 0; r < 4; ++r) { const f32x4 q = v[r][j] * rstd[r] * gg * (scl + 1.0f) + sh; v2u w; w.x = pk2(q.x, q.y); w.y = pk2(q.z, q.w); ((v2u*)(h + (size_t)(m0 + r) * DM) + lane)[64 * j] = w; } }
#pragma unroll
        for (int r = 0; r < 4; ++r)
#pragma unroll
            for (int j = 0; j < 4; ++j) v[r][j] = nv[r][j];
    }
    { float* gm2 = (float*)(a.ws + WS_GM2); float* cb = (float*)(a.ws + WS_CB); const float* g2 = a.in[5];
      for (int i = blockIdx.x * 512 + tid; i < 16 * 1024; i += gridDim.x * 512) { const int b = i >> 10, k = i & 1023; gm2[i] = g2[k] * (1.0f + mod[b * 6144 + 4096 + k]); }
      for (int p = blockIdx.x + gridDim.x * (tid >> 6); p < 16 * 48; p += NGW) {    const int b = p / 48, n = p % 48; float s = 0.f;
          if (n < 36) { for (int k = lane; k < 1024; k += 64) { const float w = n < 4 ? a.in[23][k * 4 + n] : a.in[25][k * 32 + (n - 4)]; s += mod[b * 6144 + 3072 + k] * w; } }
          s = wave_sum(s); if (lane == 0) cb[p] = n < 4 ? s + a.in[24][n] : n < 36 ? s + a.in[26][n - 4] : 0.f; } }
}

using pg8::Unit; using pg8::HALF; using pg8::BM; using pg8::cvt_pk_bf16;
typedef pg8::f32x4 pf4; typedef pg8::u32x4 pu4;

struct EpiStoreBf16 {
    static constexpr bool PERM = true, AFTER_DRAIN = false, CHAIN = false;
    bf16* O; int ldc;
    __device__ __forceinline__ void operator()(const pf4 (&acc)[2][2][4][2], const Unit& u, int wr, int wc, int fr, int fq) const {
        const int row0 = u.pm * BM + wr * 64 + fr, col0 = u.pn * BM + wc * 32 + 8 * fq;
#pragma unroll
        for (int ai = 0; ai < 2; ++ai)
#pragma unroll
            for (int m = 0; m < 4; ++m) { bf16* rowp = O + (size_t)(row0 + ai * HALF + m * 16) * ldc + col0;
#pragma unroll
                for (int bj = 0; bj < 2; ++bj) { const pf4 v0 = acc[ai][bj][m][0], v1 = acc[ai][bj][m][1]; pu4 w;
                    w.x = cvt_pk_bf16(v0[0], v0[1]); w.y = cvt_pk_bf16(v0[2], v0[3]); w.z = cvt_pk_bf16(v1[0], v1[1]); w.w = cvt_pk_bf16(v1[2], v1[3]);
                    *(pu4*)(rowp + bj * HALF) = w; } }
    }
};
struct EpiZ {
    static constexpr bool PERM = true, AFTER_DRAIN = false, CHAIN = false;
    bf16* z; bf16* Q; bf16* K; const float* qg; const float* kg; const float* cosT; const float* sinT;
    __device__ __forceinline__ void operator()(const pf4 (&acc)[2][2][4][2], const Unit& u, int wr, int wc, int fr, int fq) const {
        const int row0 = u.pm * BM + wr * 64 + fr;
        if (u.pn < 7 || u.pn >= 11) {
            const int zc = (u.pn < 7 ? u.pn * 256 : (u.pn - 11) * 256 + 1792) + wc * 32 + 8 * fq;
#pragma unroll
            for (int ai = 0; ai < 2; ++ai)
#pragma unroll
                for (int m = 0; m < 4; ++m) { bf16* rowp = z + (size_t)(row0 + ai * HALF + m * 16) * INC + zc;
#pragma unroll
                    for (int bj = 0; bj < 2; ++bj) { const pf4 v0 = acc[ai][bj][m][0], v1 = acc[ai][bj][m][1]; pu4 w;
                        w.x = cvt_pk_bf16(v0[0], v0[1]); w.y = cvt_pk_bf16(v0[2], v0[3]); w.z = cvt_pk_bf16(v1[0], v1[1]); w.w = cvt_pk_bf16(v1[2], v1[3]);
                        *(pu4*)(rowp + bj * HALF) = w; } }
            return;
        }
        const bool isk = u.pn >= 9; const int head = 4 * ((u.pn - 7) & 1) + wc; const float* g = isk ? kg : qg; bf16* O = (isk ? K : Q) + head * 64 + 8 * fq;
        const float osc = isk ? 1.0f : C2;
        pf4 gl[2][2];
#pragma unroll
        for (int bj = 0; bj < 2; ++bj)
#pragma unroll
            for (int n = 0; n < 2; ++n) gl[bj][n] = *(const pf4*)(g + 32 * bj + 8 * fq + 4 * n);
#pragma unroll
        for (int aim = 0; aim < 4; ++aim) { const int ai = aim >> 1, m0 = 2 * (aim & 1);
            pf4 ct[2][2], st[2][2];
#pragma unroll
            for (int mm = 0; mm < 2; ++mm) { const int s = (row0 + ai * HALF + (m0 + mm) * 16) & (SEQ - 1);
#pragma unroll
                for (int n = 0; n < 2; ++n) { ct[mm][n] = *(const pf4*)(cosT + s * 32 + 8 * fq + 4 * n); st[mm][n] = *(const pf4*)(sinT + s * 32 + 8 * fq + 4 * n); } }
#pragma unroll
            for (int mm = 0; mm < 2; ++mm) { const int m = m0 + mm; const int row = row0 + ai * HALF + m * 16;
                float ss = 0.f;
#pragma unroll
                for (int bj = 0; bj < 2; ++bj)
#pragma unroll
                    for (int n = 0; n < 2; ++n) { const pf4 v = acc[ai][bj][m][n]; ss += (v[0] * v[0] + v[1] * v[1]) + (v[2] * v[2] + v[3] * v[3]); }
                ss += __builtin_bit_cast(float, __builtin_amdgcn_ds_swizzle(__builtin_bit_cast(int, ss), 0x401F));
                { const unsigned uu = __builtin_bit_cast(unsigned, ss); auto rr = __builtin_amdgcn_permlane32_swap(uu, uu, false, false); ss = __builtin_bit_cast(float, (unsigned)rr[0]) + __builtin_bit_cast(float, (unsigned)rr[1]); }
                const float rstd = rsqrtf(ss * (1.0f / 64.0f) + 1e-6f);
#pragma unroll
                for (int n = 0; n < 2; ++n) { const pf4 x1 = acc[ai][0][m][n] * rstd * gl[0][n], x2 = acc[ai][1][m][n] * rstd * gl[1][n];
                    const pf4 o1 = x1 * ct[mm][n] - x2 * st[mm][n], o2 = x2 * ct[mm][n] + x1 * st[mm][n];
                    v2u wa, wb; wa.x = cvt_pk_bf16(o1[0] * osc, o1[1] * osc); wa.y = cvt_pk_bf16(o1[2] * osc, o1[3] * osc); wb.x = cvt_pk_bf16(o2[0] * osc, o2[1] * osc); wb.y = cvt_pk_bf16(o2[2] * osc, o2[3] * osc);
                    bf16* op = O + (size_t)row * 512 + 4 * n; *(v2u*)op = wa; *(v2u*)(op + 32) = wb; } }
            asm volatile("" ::: "memory");
        }
    }
};
struct EpiMerge {
    static constexpr bool PERM = true, AFTER_DRAIN = false, CHAIN = true;
    const bf16* z; bf16* mrg;
    __device__ __forceinline__ bool chain(pf4 (&acc)[2][2][4][2], const Unit& u, int wr, int wc, int fr, int fq) const {
        const int row0 = u.pm * BM + wr * 64 + fr, col0 = u.pn * BM + wc * 32 + 8 * fq;
        if (u.aux == 0) {
#pragma unroll
            for (int ai = 0; ai < 2; ++ai) {
                pu4 za[4][2], zb[4][2];
#pragma unroll
                for (int m = 0; m < 4; ++m) { const size_t row = (size_t)(row0 + ai * HALF + m * 16);
#pragma unroll
                    for (int bj = 0; bj < 2; ++bj) { const int col = col0 + bj * HALF; za[m][bj] = *(const pu4*)(z + row * INC + ZG + col); zb[m][bj] = *(const pu4*)(z + row * INC + ZG + 1024 + col); } }
#pragma unroll
                for (int m = 0; m < 4; ++m)
#pragma unroll
                    for (int bj = 0; bj < 2; ++bj) { const pu4 a4 = za[m][bj], b4 = zb[m][bj];
                        const float a8[8] = {bflo(a4.x), bfhi(a4.x), bflo(a4.y), bfhi(a4.y), bflo(a4.z), bfhi(a4.z), bflo(a4.w), bfhi(a4.w)};
                        const float b8[8] = {bflo(b4.x), bfhi(b4.x), bflo(b4.y), bfhi(b4.y), bflo(b4.z), bfhi(b4.z), bflo(b4.w), bfhi(b4.w)};
#pragma unroll
                        for (int e = 0; e < 8; ++e) acc[ai][bj][m][e >> 2][e & 3] *= (1.0f + __expf(-b8[e])) * __builtin_amdgcn_rcpf(1.0f + __expf(-a8[e])); }
                asm volatile("" ::: "memory");
            }
            return true;
        }
        pu4 gz[2][4][2];
#pragma unroll
        for (int ai = 0; ai < 2; ++ai)
#pragma unroll
            for (int m = 0; m < 4; ++m) { const size_t row = (size_t)(row0 + ai * HALF + m * 16);
#pragma unroll
                for (int bj = 0; bj < 2; ++bj) gz[ai][m][bj] = *(const pu4*)(z + row * INC + ZG + 1024 + col0 + bj * HALF); }
#pragma unroll
        for (int ai = 0; ai < 2; ++ai)
#pragma unroll
            for (int m = 0; m < 4; ++m) { const size_t row = (size_t)(row0 + ai * HALF + m * 16);
#pragma unroll
                for (int bj = 0; bj < 2; ++bj) { const int col = col0 + bj * HALF; const pu4 g4 = gz[ai][m][bj]; const pf4 v0 = acc[ai][bj][m][0], v1 = acc[ai][bj][m][1];
                    pu4 w;
                    w.x = cvt_pk_bf16(sigm(bflo(g4.x)) * v0[0], sigm(bfhi(g4.x)) * v0[1]); w.y = cvt_pk_bf16(sigm(bflo(g4.y)) * v0[2], sigm(bfhi(g4.y)) * v0[3]);
                    w.z = cvt_pk_bf16(sigm(bflo(g4.z)) * v1[0], sigm(bfhi(g4.z)) * v1[1]); w.w = cvt_pk_bf16(sigm(bflo(g4.w)) * v1[2], sigm(bfhi(g4.w)) * v1[3]);
                    *(pu4*)(mrg + row * DM + col) = w; } }
        return false;
    }
};
struct EpiOut {
    static constexpr bool PERM = true, AFTER_DRAIN = false, CHAIN = false;
    const float* x; const float* mod; bf16* x1;
    __device__ __forceinline__ void operator()(const pf4 (&acc)[2][2][4][2], const Unit& u, int wr, int wc, int fr, int fq) const {
        const int row0 = u.pm * BM + wr * 64 + fr, col0 = u.pn * BM + wc * 32 + 8 * fq; const int b = u.pm >> 3;
        pf4 gt[2][2];
#pragma unroll
        for (int bj = 0; bj < 2; ++bj)
#pragma unroll
            for (int n = 0; n < 2; ++n) gt[bj][n] = *(const pf4*)(mod + b * 6144 + 2048 + col0 + bj * HALF + n * 4);
#pragma unroll
        for (int ai = 0; ai < 2; ++ai) {
            pf4 xv[4][2][2];
#pragma unroll
            for (int m = 0; m < 4; ++m) { const size_t off = (size_t)(row0 + ai * HALF + m * 16) * DM + col0;
#pragma unroll
                for (int bj = 0; bj < 2; ++bj) { xv[m][bj][0] = *(const pf4*)(x + off + bj * HALF); xv[m][bj][1] = *(const pf4*)(x + off + bj * HALF + 4); } }
#pragma unroll
            for (int m = 0; m < 4; ++m) { const size_t off = (size_t)(row0 + ai * HALF + m * 16) * DM + col0;
#pragma unroll
                for (int bj = 0; bj < 2; ++bj) { const pf4 o0 = xv[m][bj][0] + gt[bj][0] * acc[ai][bj][m][0], o1 = xv[m][bj][1] + gt[bj][1] * acc[ai][bj][m][1]; pu4 w;
                    w.x = cvt_pk_bf16(o0[0], o0[1]); w.y = cvt_pk_bf16(o0[2], o0[3]); w.z = cvt_pk_bf16(o1[0], o1[1]); w.w = cvt_pk_bf16(o1[2], o1[3]);
                    *(pu4*)(x1 + off + bj * HALF) = w; } }
            asm volatile("" ::: "memory");
        }
    }
};
struct EpiUp {
    static constexpr bool PERM = true, AFTER_DRAIN = false, CHAIN = false;
    bf16* hid;
    __device__ __forceinline__ void operator()(const pf4 (&acc)[2][2][4][2], const Unit& u, int wr, int wc, int fr, int fq) const {
        const int row0 = u.pm * BM + wr * 64 + fr, col0 = u.pn * 128 + wc * 32 + 8 * fq;
#pragma unroll
        for (int ai = 0; ai < 2; ++ai)
#pragma unroll
            for (int m = 0; m < 4; ++m) { const size_t row = (size_t)(row0 + ai * HALF + m * 16); float o[8];
#pragma unroll
                for (int n = 0; n < 2; ++n)
#pragma unroll
                    for (int e = 0; e < 4; ++e) { const float g = acc[ai][0][m][n][e], l = acc[ai][1][m][n][e]; o[4 * n + e] = g * sigm(g) * l; }
                pu4 w; w.x = cvt_pk_bf16(o[0], o[1]); w.y = cvt_pk_bf16(o[2], o[3]); w.z = cvt_pk_bf16(o[4], o[5]); w.w = cvt_pk_bf16(o[6], o[7]);
                *(pu4*)(hid + row * DEXP + col0) = w; }
    }
};

struct GemmArgs { unsigned char* ws; const float* x; float* out; const float* qg; const float* kg; };
template <class Epi> __device__ __forceinline__ void run_dense(const void* A, const void* Bt, int M, int N, int K, const Epi& E, unsigned char* lds, int wv) {
    pg8::Gemm g{K}; pg8::StaticOrder S; S.init(A, Bt, M, N, K, (int)gridDim.x, (int)blockIdx.x);
    pg8::gemm_phase<Epi, pg8::StaticOrder, true, true>((PG8_LAS unsigned char*)lds, g, S, E, wv);
}
__device__ __forceinline__ void p_gemm_in(const GemmArgs& a, unsigned char* lds, int wv) {
    EpiZ E{(bf16*)(a.ws + WS_Z), (bf16*)(a.ws + WS_Q), (bf16*)(a.ws + WS_K), a.qg, a.kg, (const float*)(a.ws + WS_COS), (const float*)(a.ws + WS_SIN)};
    run_dense(a.ws + WS_H, a.ws + WS_WIN, NT, WIN_N, 1024, E, lds, wv);
}
struct PairOrder {
    int nM, nN, nwg, G, c; const char *A0, *A1, *B0, *B1; size_t tstep;
    __device__ bool next(int i, Unit& u) const {
        const long L = (long)(i >> 1) * G + c; if (L >= nwg) return false;
        int wgid = (int)L; { const int q = nwg / pg8::NXCD, r = nwg % pg8::NXCD, xcd = wgid % pg8::NXCD, off = wgid / pg8::NXCD; wgid = (xcd < r ? xcd * (q + 1) : r * (q + 1) + (xcd - r) * q) + off; }
        const int nig = pg8::WGM * nN, gid = wgid / nig, fm = gid * pg8::WGM, gsz = (nM - fm) < pg8::WGM ? (nM - fm) : pg8::WGM;
        u.pm = fm + ((wgid % nig) % gsz); u.pn = (wgid % nig) / gsz; u.aux = i & 1;
        u.a = ((i & 1) ? A1 : A0) + (size_t)u.pm * tstep; u.b = ((i & 1) ? B1 : B0) + (size_t)u.pn * tstep; return true;
    }
    __device__ __forceinline__ void a_ready(const Unit&) const {}
    __device__ __forceinline__ void done(const Unit&) const {}
};
__device__ __forceinline__ void p_gemm_merge(const GemmArgs& a, unsigned char* lds, int wv) {
    PairOrder S{NT / 256, 4, (NT / 256) * 4, (int)gridDim.x, (int)blockIdx.x, (const char*)(a.ws + WS_YA), (const char*)(a.ws + WS_YB), (const char*)(a.ws + WS_WBA), (const char*)(a.ws + WS_WBB), (size_t)256 * 512 * 2};
    EpiMerge E{(const bf16*)(a.ws + WS_Z), (bf16*)(a.ws + WS_MRG)}; pg8::Gemm g{512};
    pg8::gemm_phase<EpiMerge, PairOrder, true, true>((PG8_LAS unsigned char*)lds, g, S, E, wv);
}
__device__ __forceinline__ void p_gemm_out(const GemmArgs& a, unsigned char* lds, int wv) {
    EpiOut E{a.x, (const float*)(a.ws + WS_MOD), (bf16*)(a.ws + WS_X1B)};
    run_dense(a.ws + WS_MRG, a.ws + WS_WOUT, NT, 1024, 1024, E, lds, wv);
}
struct GroupedOrder {
    const int* texp; int nT, nN, G, c; const char* A; size_t a_tile; const char* B; size_t b_exp, b_tile;
    __device__ bool next(int i, Unit& u) const {
        const long L = (long)i * G + c; if (L >= (long)nT * nN) return false;
        const int tile = (int)(L / nN), pn = (int)(L % nN); u.aux = 0; u.pm = tile; u.pn = pn; u.a = A + (size_t)tile * a_tile; u.b = B + (size_t)texp[tile] * b_exp + (size_t)pn * b_tile; return true;
    }
    __device__ __forceinline__ void a_ready(const Unit&) const {}
    __device__ __forceinline__ void done(const Unit&) const {}
};
__device__ __forceinline__ void p_gemm_up(const GemmArgs& a, unsigned char* lds, int wv) {
    const int* ctl = (const int*)(a.ws + WS_CTL);
    GroupedOrder S{ctl + CW_TEXP, ctl[CW_NT], 4, (int)gridDim.x, (int)blockIdx.x, (const char*)(a.ws + WS_XS), (size_t)256 * 1024 * 2, (const char*)(a.ws + WS_WUP), (size_t)1024 * 1024 * 2, (size_t)256 * 1024 * 2};
    EpiUp E{(bf16*)(a.ws + WS_HID)}; pg8::Gemm g{1024};
    pg8::gemm_phase<EpiUp, GroupedOrder, true, true>((PG8_LAS unsigned char*)lds, g, S, E, wv);
}
__device__ __forceinline__ void p_gemm_down(const GemmArgs& a, unsigned char* lds, int wv) {
    const int* ctl = (const int*)(a.ws + WS_CTL);
    GroupedOrder S{ctl + CW_TEXP, ctl[CW_NT], 4, (int)gridDim.x, (int)blockIdx.x, (const char*)(a.ws + WS_HID), (size_t)256 * 512 * 2, (const char*)a.out, (size_t)1024 * 512 * 2, (size_t)256 * 512 * 2};
    EpiStoreBf16 E{(bf16*)(a.ws + WS_XS), 1024}; pg8::Gemm g{512};
    pg8::gemm_phase<EpiStoreBf16, GroupedOrder, true, true>((PG8_LAS unsigned char*)lds, g, S, E, wv);
}

__device__ __forceinline__ void p_attn(const PArgs& a, unsigned char* lds, int vb, int nvb, int wv) {
    const attn_body::bf16* Q = (const attn_body::bf16*)(a.ws + WS_Q); const attn_body::bf16* K = (const attn_body::bf16*)(a.ws + WS_K);
    const attn_body::bf16* V = (const attn_body::bf16*)(a.ws + WS_Z) + ZV; attn_body::bf16* O = (attn_body::bf16*)(a.ws + WS_YB);
    for (int p = vb; p < 512; p += nvb)
        for (int which = 0; which < 2; ++which) { const int bh = p >> 2, s = p & 3, qb = which ? 7 - s : s;
            attn_body::attn_unit<8>(bh >> 3, bh & 7, qb, Q, K, V, O, (char*)lds, wv); }
}

__device__ __forceinline__ void p_actprep(const PArgs& a, unsigned char* lds, int wv) {
    const int tid = mktid(wv); const bf16* z = (const bf16*)(a.ws + WS_Z); bf16* act = (bf16*)(a.ws + WS_ACT); const float* mu = a.in[7];
    for (int i = blockIdx.x * 512 + tid; i < NT * 32; i += gridDim.x * 512) { const int t = i >> 5, cg = i & 31, col = 1536 + 8 * cg; const bool hasp = (t & (SEQ - 1)) > 0;
        const v4u cw = *(const v4u*)(z + (size_t)t * INC + col); v4u pw = {0u, 0u, 0u, 0u}; if (hasp) pw = *(const v4u*)(z + (size_t)(t - 1) * INC + col);
        const float c8[8] = {bflo(cw.x), bfhi(cw.x), bflo(cw.y), bfhi(cw.y), bflo(cw.z), bfhi(cw.z), bflo(cw.w), bfhi(cw.w)}, p8[8] = {bflo(pw.x), bfhi(pw.x), bflo(pw.y), bfhi(pw.y), bflo(pw.z), bfhi(pw.z), bflo(pw.w), bfhi(pw.w)};
        const f32x4 m0 = *(const f32x4*)(mu + col), m1 = *(const f32x4*)(mu + col + 4); const float m8[8] = {m0.x, m0.y, m0.z, m0.w, m1.x, m1.y, m1.z, m1.w}; float v[8];
#pragma unroll
        for (int e = 0; e < 8; ++e) { const float x = c8[e] + (p8[e] - c8[e]) * m8[e]; v[e] = cg < 8 ? 1.0f - 2.0f * __builtin_amdgcn_rcpf(1.0f + __expf(2.0f * x)) : cg < 16 ? x : sigm(x); }
        v4u w; w.x = pk2(v[0], v[1]); w.y = pk2(v[2], v[3]); w.z = pk2(v[4], v[5]); w.w = pk2(v[6], v[7]);
        *(v4u*)(act + (size_t)t * 256 + 8 * cg) = w; }
}

namespace rw {
typedef short bf16x8 __attribute__((ext_vector_type(8)));
constexpr int MB = 8192;
__device__ __forceinline__ int SW(int r, int c) { return r * 128 + ((((c >> 3) ^ (r >> 1)) & 7) << 4) + (c & 7) * 2; }
__device__ __forceinline__ int SWG(int r, int c) { return r * 256 + ((((c >> 3) ^ r) & 15) << 4) + (c & 7) * 2; }
__device__ __forceinline__ int SWF(int r, int c) { return r * 256 + ((((c >> 2) ^ r) & 15) << 4) + (c & 3) * 4; }
enum { I_AT = 0, I_BT, I_AJ, I_BHJ, I_KHJ, I_ABRT, I_X5, I_L, I_LT, I_R0, I_R1, I_KT, I_RT, I_VJ, I_X14, I_GATE, I_VT, I_VT2, NBUF };
constexpr int OFF_F32 = NBUF * MB;
constexpr int OFF_CST = OFF_F32 + (64 * 3 + 512) * 4;
constexpr int LDS_NEED = OFF_CST + 14 * 64 * 4;

__device__ __forceinline__ bf16x8 ldfrag(const unsigned char* M, int row, int k) { return *(const bf16x8*)(M + SW(row, k)); }
__device__ __forceinline__ void mm(f32x4 (&acc)[2], const unsigned char* X, const unsigned char* Y, int mt, int nh, int fr, int fq) {
    const bf16x8 a0 = ldfrag(X, 16 * mt + fr, 8 * fq), a1 = ldfrag(X, 16 * mt + fr, 8 * fq + 32);
#pragma unroll
    for (int nt = 0; nt < 2; ++nt) { const bf16x8 b0 = ldfrag(Y, 16 * (2 * nh + nt) + fr, 8 * fq), b1 = ldfrag(Y, 16 * (2 * nh + nt) + fr, 8 * fq + 32);
        acc[nt] = __builtin_amdgcn_mfma_f32_16x16x32_bf16(a0, b0, acc[nt], 0, 0, 0); acc[nt] = __builtin_amdgcn_mfma_f32_16x16x32_bf16(a1, b1, acc[nt], 0, 0, 0); }
}
typedef short s16x4 __attribute__((ext_vector_type(4)));
typedef __attribute__((address_space(3))) s16x4* lds_s16x4p;
__device__ __forceinline__ bf16x8 ldfragT(const unsigned char* M, int row0, int kb, int fr, int fq) {
    const int k0 = kb + 8 * fq + (fr >> 2), c0 = row0 + 4 * (fr & 3);
    const s16x4 lo = __builtin_amdgcn_ds_read_tr16_b64_v4i16((lds_s16x4p)(M + SW(k0, c0))), hi = __builtin_amdgcn_ds_read_tr16_b64_v4i16((lds_s16x4p)(M + SW(k0 + 4, c0)));
    return (bf16x8){lo[0], lo[1], lo[2], lo[3], hi[0], hi[1], hi[2], hi[3]};
}
struct FA { bf16x8 k0, k1; };
struct FB { bf16x8 k0[2], k1[2]; };
__device__ __forceinline__ FA ldA(const unsigned char* X, int mt, int fr, int fq) { FA f; f.k0 = ldfrag(X, 16 * mt + fr, 8 * fq); f.k1 = ldfrag(X, 16 * mt + fr, 8 * fq + 32); return f; }
__device__ __forceinline__ FB ldB(const unsigned char* Y, int nh, int fr, int fq) { FB f;
#pragma unroll
    for (int nt = 0; nt < 2; ++nt) { f.k0[nt] = ldfrag(Y, 16 * (2 * nh + nt) + fr, 8 * fq); f.k1[nt] = ldfrag(Y, 16 * (2 * nh + nt) + fr, 8 * fq + 32); }
    return f; }
__device__ __forceinline__ FA ldAT(const unsigned char* XT, int mt, int fr, int fq) { FA f; f.k0 = ldfragT(XT, 16 * mt, 0, fr, fq); f.k1 = ldfragT(XT, 16 * mt, 32, fr, fq); return f; }
__device__ __forceinline__ FB ldBT(const unsigned char* YT, int nh, int fr, int fq) { FB f;
#pragma unroll
    for (int nt = 0; nt < 2; ++nt) { f.k0[nt] = ldfragT(YT, 16 * (2 * nh + nt), 0, fr, fq); f.k1[nt] = ldfragT(YT, 16 * (2 * nh + nt), 32, fr, fq); }
    return f; }
__device__ __forceinline__ void mma(f32x4 (&acc)[2], const FA& a, const FB& b) {
    acc[0] = __builtin_amdgcn_mfma_f32_16x16x32_bf16(a.k0, b.k0[0], acc[0], 0, 0, 0); acc[1] = __builtin_amdgcn_mfma_f32_16x16x32_bf16(a.k0, b.k0[1], acc[1], 0, 0, 0);
    acc[0] = __builtin_amdgcn_mfma_f32_16x16x32_bf16(a.k1, b.k1[0], acc[0], 0, 0, 0); acc[1] = __builtin_amdgcn_mfma_f32_16x16x32_bf16(a.k1, b.k1[1], acc[1], 0, 0, 0);
}
__device__ __forceinline__ void ldC(f32x4 (&acc)[2], const unsigned char* Z, int mt, int nh, int fr, int fq) {
#pragma unroll
    for (int nt = 0; nt < 2; ++nt) { const v2u w = *(const v2u*)(Z + SW(16 * (2 * nh + nt) + fr, 16 * mt + 4 * fq)); acc[nt] = (f32x4){bflo(w.x), bfhi(w.x), bflo(w.y), bfhi(w.y)}; }
}
__device__ __forceinline__ void storeT(unsigned char* Z, const f32x4 (&acc)[2], int mt, int nh, int fr, int fq) {
#pragma unroll
    for (int nt = 0; nt < 2; ++nt) { v2u w; w.x = pk2(acc[nt][0], acc[nt][1]); w.y = pk2(acc[nt][2], acc[nt][3]); *(v2u*)(Z + SW(16 * (2 * nh + nt) + fr, 16 * mt + 4 * fq)) = w; }
}
__device__ __forceinline__ void storeN(unsigned char* Z, const f32x4 (&acc)[2], int mt, int nh, int fr, int fq) {
#pragma unroll
    for (int nt = 0; nt < 2; ++nt)
#pragma unroll
        for (int r = 0; r < 4; ++r) *(unsigned short*)(Z + SW(16 * mt + 4 * fq + r, 16 * (2 * nh + nt) + fr)) = (unsigned short)f2bf(acc[nt][r]);
}
__device__ __forceinline__ void ld8bf(const unsigned char* p, float (&v)[8]) { const v4u w = *(const v4u*)p; v[0] = bflo(w.x); v[1] = bfhi(w.x); v[2] = bflo(w.y); v[3] = bfhi(w.y); v[4] = bflo(w.z); v[5] = bfhi(w.z); v[6] = bflo(w.w); v[7] = bfhi(w.w); }
__device__ __forceinline__ void st8bf(unsigned char* p, const float (&v)[8]) { v4u w; w.x = pk2(v[0], v[1]); w.y = pk2(v[2], v[3]); w.z = pk2(v[4], v[5]); w.w = pk2(v[6], v[7]); *(v4u*)p = w; }
__device__ __forceinline__ void ld8f(const float* p, float (&v)[8]) { const f32x4 a = *(const f32x4*)p, b = *(const f32x4*)(p + 4); v[0] = a.x; v[1] = a.y; v[2] = a.z; v[3] = a.w; v[4] = b.x; v[5] = b.y; v[6] = b.z; v[7] = b.w; }
__device__ __forceinline__ void ld8fs(const unsigned char* M, int r, int c, float (&v)[8]) { const f32x4 a = *(const f32x4*)(M + SWF(r, c)), b = *(const f32x4*)(M + SWF(r, c + 4)); v[0] = a.x; v[1] = a.y; v[2] = a.z; v[3] = a.w; v[4] = b.x; v[5] = b.y; v[6] = b.z; v[7] = b.w; }
__device__ __forceinline__ void un8(const v4u w, float (&v)[8]) { v[0] = bflo(w.x); v[1] = bfhi(w.x); v[2] = bflo(w.y); v[3] = bfhi(w.y); v[4] = bflo(w.z); v[5] = bfhi(w.z); v[6] = bflo(w.w); v[7] = bfhi(w.w); }
__device__ __forceinline__ void shift8(const v4u cw, const v4u pw, bool hasp, const float* mu, float (&v)[8]) {
    float c[8], p[8], m[8]; un8(cw, c); un8(pw, p); ld8f(mu, m);
#pragma unroll
    for (int e = 0; e < 8; ++e) { const float pe = hasp ? p[e] : 0.f; v[e] = c[e] + (pe - c[e]) * m[e]; }
}
__device__ __forceinline__ float tanh_fast(float x) { return 1.0f - 2.0f * __builtin_amdgcn_rcpf(1.0f + __expf(2.0f * x)); }

#define LBAR() do { asm volatile("s_waitcnt lgkmcnt(0)" ::: "memory"); __builtin_amdgcn_s_barrier(); asm volatile("" ::: "memory"); } while (0)
__device__ __forceinline__ void scan_unit(const PArgs& a, unsigned char* lds, int bh, int wv) {
    const int tid = mktid(wv), lane = tid & 63, wid = __builtin_amdgcn_readfirstlane(tid >> 6);
    const int mt = wid >> 1, nh = wid & 1; int fr = lane & 15, fq = lane >> 4;
    const int b = bh >> 3, h = bh & 7;
#define BUF(i) (lds + (i) * MB)
    float* GC = (float*)(lds + OFF_F32); float* BON = GC + 64; float* SSQ = BON + 64; float* SEGT = SSQ + 64;
    unsigned char* LWR = BUF(I_AT); unsigned char* LAR = BUF(I_AJ); unsigned char* LGR = BUF(I_KHJ); unsigned char* YTF = BUF(I_KHJ);
    unsigned char* ACTW = BUF(I_L); unsigned char* ACTA = BUF(I_LT); unsigned char* ACTG = BUF(I_R0);
    const bf16* z = (const bf16*)(a.ws + WS_Z); bf16* ya = (bf16*)(a.ws + WS_YA);
    const float* mu = a.in[7];
    bf16x8 fw[2], fa[2], fg[4];
    { const bf16* wlt = (const bf16*)(a.ws + WS_WLT) + (size_t)h * 4096 + (16 * mt + fr) * 64 + 8 * fq; const bf16* wat = (const bf16*)(a.ws + WS_WAT) + (size_t)h * 4096 + (16 * mt + fr) * 64 + 8 * fq;
      const bf16* wgt = (const bf16*)(a.ws + WS_WGT) + (size_t)h * 8192 + (16 * mt + fr) * 128 + 8 * fq;
      fw[0] = *(const bf16x8*)wlt; fw[1] = *(const bf16x8*)(wlt + 32); fa[0] = *(const bf16x8*)wat; fa[1] = *(const bf16x8*)(wat + 32);
#pragma unroll
      for (int ks = 0; ks < 4; ++ks) fg[ks] = *(const bf16x8*)(wgt + 32 * ks); }
    float* CST = (float*)(lds + OFF_CST);
    for (int i = tid; i < 14 * 64; i += 512) { const int blk = i >> 6, jj = i & 63; float v;
        if (blk < 3) v = mu[blk * 512 + h * 64 + jj]; else if (blk < 7) v = mu[1536 + (blk - 3) * 64 + jj]; else v = a.in[blk == 7 ? 8 : blk == 8 ? 10 : blk == 9 ? 13 : blk == 10 ? 14 : blk == 11 ? 15 : blk == 12 ? 16 : 17][h * 64 + jj];
        CST[i] = v; }
    int s0i = I_X14, aki = I_X5;
    for (int i = tid; i < MB / 4; i += 512) ((unsigned*)BUF(I_X14))[i] = 0u;
    LBAR();
    int pt = tid >> 3, j0 = 8 * (tid & 7);
    const int colh = h * 64 + j0;
    const int zoff0 = colh, zoff1 = 512 + colh, zoff2 = 1024 + colh;
    const bf16* actb = (const bf16*)(a.ws + WS_ACT);
    v4u zc[3], zq[3], za[4];
#define ZLOAD(cc) do { const size_t tr_ = (size_t)b * SEQ + (cc) * 64 + pt; const bf16* zr_ = z + tr_ * INC; const bf16* zs_ = ((cc) * 64 + pt) > 0 ? zr_ - INC : zr_; const bf16* ar_ = actb + tr_ * 256 + j0; \
        zc[0] = *(const v4u*)(zr_ + zoff0); zc[1] = *(const v4u*)(zr_ + zoff1); zc[2] = *(const v4u*)(zr_ + zoff2); \
        zq[0] = *(const v4u*)(zs_ + zoff0); zq[1] = *(const v4u*)(zs_ + zoff1); zq[2] = *(const v4u*)(zs_ + zoff2); \
        za[0] = *(const v4u*)(ar_); za[1] = *(const v4u*)(ar_ + 64); za[2] = *(const v4u*)(ar_ + 128); za[3] = *(const v4u*)(ar_ + 192); } while (0)
#define ESTAGE(VTB, TT_) \
        { float y[8], vv[8], g8[8], lg[8], lb[8]; ld8fs(YTF, pt, j0, y); ld8bf((VTB) + SW(pt, j0), vv); ld8bf(BUF(I_GATE) + SW(pt, j0), g8); \
          ld8f(CST + 12 * 64 + j0, lg); ld8f(CST + 13 * 64 + j0, lb); \
          float sm = 0.f; \
_Pragma("unroll") \
          for (int e = 0; e < 8; ++e) sm += y[e]; \
          const float mean = red8(sm) * (1.0f / 64.0f); float sq = 0.f; \
_Pragma("unroll") \
          for (int e = 0; e < 8; ++e) { y[e] -= mean; sq += y[e] * y[e]; } \
          const float rstd = rsqrtf(red8(sq) * (1.0f / 64.0f) + 64e-5f), bon = BON[pt]; \
_Pragma("unroll") \
          for (int e = 0; e < 8; ++e) y[e] = (y[e] * rstd * lg[e] + lb[e] + bon * vv[e]) * g8[e]; \
          ypend.x = pk2(y[0], y[1]); ypend.y = pk2(y[2], y[3]); ypend.z = pk2(y[4], y[5]); ypend.w = pk2(y[6], y[7]); ypoff = (TT_) * RWW + colh; }
    ZLOAD(0);
    v4u ypend = {0u, 0u, 0u, 0u}; size_t ypoff = 0;
    for (int c = 0; c < SEQ / 64; ++c) {
        asm volatile("" : "+v"(fr), "+v"(fq), "+v"(pt), "+v"(j0));
        const int s = c * 64 + pt; const size_t t = (size_t)b * SEQ + s; const bool hasp = s > 0;
        if (c > 0) { ESTAGE(((c - 1) & 1) ? BUF(I_VT2) : BUF(I_VT), t - 64) }
        { float v[8];
          shift8(zc[0], zq[0], hasp, CST + 0 * 64 + j0, v); st8bf(BUF(I_RT) + SW(pt, j0), v);
          shift8(zc[1], zq[1], hasp, CST + 1 * 64 + j0, v); st8bf(BUF(I_KT) + SW(pt, j0), v);
          { float kkc[8], ss = 0.f; ld8f(CST + 9 * 64 + j0, kkc);
#pragma unroll
            for (int e = 0; e < 8; ++e) { const float q = v[e] * kkc[e]; ss += q * q; }
            ss = red8(ss); if (j0 == 0) SSQ[pt] = rsqrtf(fmaxf(ss, 1e-24f)); }
          shift8(zc[2], zq[2], hasp, CST + 2 * 64 + j0, v); st8bf(((c & 1) ? BUF(I_VT2) : BUF(I_VT)) + SW(pt, j0), v);
          *(v4u*)(ACTW + SW(pt, j0)) = za[0]; *(v4u*)(ACTA + SW(pt, j0)) = za[1]; *(v4u*)(ACTG + SWG(pt, j0)) = za[2]; *(v4u*)(ACTG + SWG(pt, 64 + j0)) = za[3]; }
        LBAR();
        f32x4 aw[2], aa[2], ag[2];
#pragma unroll
        for (int nt = 0; nt < 2; ++nt) { const int tr = 16 * (2 * nh + nt) + fr; const f32x4 zero = {0.f, 0.f, 0.f, 0.f};
            aw[nt] = __builtin_amdgcn_mfma_f32_16x16x32_bf16(fw[0], ldfrag(ACTW, tr, 8 * fq), zero, 0, 0, 0); aw[nt] = __builtin_amdgcn_mfma_f32_16x16x32_bf16(fw[1], ldfrag(ACTW, tr, 8 * fq + 32), aw[nt], 0, 0, 0);
            aa[nt] = __builtin_amdgcn_mfma_f32_16x16x32_bf16(fa[0], ldfrag(ACTA, tr, 8 * fq), zero, 0, 0, 0); aa[nt] = __builtin_amdgcn_mfma_f32_16x16x32_bf16(fa[1], ldfrag(ACTA, tr, 8 * fq + 32), aa[nt], 0, 0, 0);
            ag[nt] = zero;
#pragma unroll
            for (int ks = 0; ks < 4; ++ks) ag[nt] = __builtin_amdgcn_mfma_f32_16x16x32_bf16(fg[ks], *(const bf16x8*)(ACTG + SWG(tr, 8 * fq + 32 * ks)), ag[nt], 0, 0, 0); }
#pragma unroll
        for (int nt = 0; nt < 2; ++nt) { const int tr = 16 * (2 * nh + nt) + fr, jc = 16 * mt + 4 * fq;
            *(f32x4*)(LWR + SWF(tr, jc)) = aw[nt]; *(f32x4*)(LAR + SWF(tr, jc)) = aa[nt]; *(f32x4*)(LGR + SWF(tr, jc)) = ag[nt]; }
        LBAR();
        float lwv[8], an[8], bb[8], k2[8], rr[8], gg[8], vv8[8], p8[8];
        { const int j = lane, tw = wid;
          const float w0c = CST[7 * 64 + j], a0c = CST[8 * 64 + j], kkc = CST[9 * 64 + j], kac = CST[10 * 64 + j], rkc = CST[11 * 64 + j];
          const unsigned char* vtb = (c & 1) ? BUF(I_VT2) : BUF(I_VT);
          float bo[8], av[8];
#pragma unroll
          for (int u = 0; u < 8; ++u) { const int t8 = 8 * tw + u;
              const float lw = *(const float*)(LWR + SWF(t8, j)), la = *(const float*)(LAR + SWF(t8, j)); gg[u] = *(const float*)(LGR + SWF(t8, j));
              rr[u] = bflo(*(const unsigned short*)(BUF(I_RT) + SW(t8, j))); const float kx = bflo(*(const unsigned short*)(BUF(I_KT) + SW(t8, j))); vv8[u] = bflo(*(const unsigned short*)(vtb + SW(t8, j)));
              lwv[u] = -0.606531f * sigm(w0c + lw); av[u] = sigm(a0c + la);
              const float kn = kx * kkc * SSQ[t8]; an[u] = -kn; bb[u] = kn * av[u];
              k2[u] = kx * (1.0f + (av[u] - 1.0f) * kac); bo[u] = rr[u] * k2[u] * rkc; }
          wave_sum8(bo);
          if (j == 0) {
#pragma unroll
              for (int u = 0; u < 8; ++u) BON[8 * tw + u] = bo[u]; }
          p8[0] = lwv[0];
#pragma unroll
          for (int u = 1; u < 8; ++u) p8[u] = p8[u - 1] + lwv[u];
          SEGT[tw * 64 + j] = p8[7]; }
        LBAR();
        { const int j = lane, tw = wid; float sg8[8];
#pragma unroll
          for (int s2 = 0; s2 < 8; ++s2) sg8[s2] = SEGT[s2 * 64 + j];
          float base = 0.f, tot = 0.f;
#pragma unroll
          for (int s2 = 0; s2 < 8; ++s2) { tot += sg8[s2]; base += (s2 < tw) ? sg8[s2] : 0.f; }
          const float gcj = __expf(tot); if (tw == 7) GC[j] = gcj;
          float eprev = __expf(base);
          float o0[8], o1[8], o2[8], o3[8], ob[8], ok[8];
#pragma unroll
          for (int u = 0; u < 8; ++u) { const float L = p8[u] + base; const float e1 = __expf(L), ie1 = __builtin_amdgcn_rcpf(e1), ep = eprev, eh = gcj * ie1; eprev = e1;
              o0[u] = an[u] * ep; o1[u] = bb[u] * ie1; o2[u] = k2[u] * ie1; o3[u] = rr[u] * e1; ob[u] = bb[u] * eh; ok[u] = k2[u] * eh;
              *(unsigned short*)(BUF(I_GATE) + SW(8 * tw + u, j)) = (unsigned short)f2bf(gg[u]); }
          st8bf(BUF(I_AJ) + SW(j, 8 * tw), o0); st8bf(BUF(I_BT) + SW(j, 8 * tw), o1); st8bf(BUF(I_KT) + SW(j, 8 * tw), o2); st8bf(BUF(I_RT) + SW(j, 8 * tw), o3);
          st8bf(BUF(I_BHJ) + SW(j, 8 * tw), ob); st8bf(BUF(I_KHJ) + SW(j, 8 * tw), ok); st8bf(BUF(I_VJ) + SW(j, 8 * tw), vv8); }
        if (c > 0) *(v4u*)(ya + ypoff) = ypend;
        if (c + 1 < SEQ / 64) ZLOAD(c + 1);
        LBAR();
#define MASK(acc, cond) _Pragma("unroll") for (int nt = 0; nt < 2; ++nt) _Pragma("unroll") for (int r = 0; r < 4; ++r) { const int m_ = 16 * mt + 4 * fq + r, n_ = 16 * (2 * nh + nt) + fr; if (!(cond)) acc[nt][r] = 0.f; }
        { const f32x4 zero = {0.f, 0.f, 0.f, 0.f}; f32x4 aL[2] = {zero, zero}, aL2[2] = {zero, zero}, aK[2] = {zero, zero}, aR[2] = {zero, zero};
          const FA fAT = ldAT(BUF(I_AJ), mt, fr, fq), fBTa = ldAT(BUF(I_BT), mt, fr, fq); const FB fBT = ldBT(BUF(I_BT), nh, fr, fq), fKT = ldBT(BUF(I_KT), nh, fr, fq), fRT = ldBT(BUF(I_RT), nh, fr, fq), fATb = ldBT(BUF(I_AJ), nh, fr, fq);
          mma(aL, fAT, fBT);
          mma(aL2, fBTa, fATb);
          mma(aK, fAT, fKT);
          mma(aR, fBTa, fRT);
          MASK(aL, m_ > n_) MASK(aL2, n_ > m_) MASK(aK, n_ < m_) MASK(aR, m_ <= n_)
#pragma unroll
          for (int nt = 0; nt < 2; ++nt)
#pragma unroll
              for (int r = 0; r < 4; ++r) { const int m_ = 16 * mt + 4 * fq + r, n_ = 16 * (2 * nh + nt) + fr; if (m_ == n_) aL2[nt][r] = 1.0f; }
          storeT(BUF(I_L), aL, mt, nh, fr, fq); storeT(BUF(I_R0), aL2, mt, nh, fr, fq);
          storeT(BUF(aki), aK, mt, nh, fr, fq);
          storeT(BUF(I_ABRT), aR, mt, nh, fr, fq); }
        LBAR();
#pragma unroll
        for (int k = 1; k <= 6; ++k) {
            unsigned char* Pc = (k & 1) ? BUF(I_L) : BUF(I_AT); unsigned char* Pn = (k & 1) ? BUF(I_AT) : BUF(I_L);
            unsigned char* Rc = (k & 1) ? BUF(I_R1) : BUF(I_R0); unsigned char* Rn = (k & 1) ? BUF(I_R0) : BUF(I_R1);
            const f32x4 zero = {0.f, 0.f, 0.f, 0.f}; f32x4 aP[2] = {zero, zero}, aRr[2] = {zero, zero};
            FA fP, fPTa; FB fPT, fR;
            if (k <= 5) { fP = ldAT(Pc, mt, fr, fq); fPT = ldB(Pc, nh, fr, fq); }
            if (k >= 2) { fPTa = ldA(Pc, mt, fr, fq); fR = ldB(Rc, nh, fr, fq); ldC(aRr, Rc, mt, nh, fr, fq); }
            if (k <= 5) mma(aP, fP, fPT);
            if (k >= 2) mma(aRr, fPTa, fR);
            if (k <= 5) storeT(Pn, aP, mt, nh, fr, fq);
            if (k >= 2) storeT(Rn, aRr, mt, nh, fr, fq);
            LBAR();
        }
        { const f32x4 zero = {0.f, 0.f, 0.f, 0.f}; f32x4 a1[2] = {zero, zero}, a2[2] = {zero, zero};
          const FA fTT = ldA(BUF(I_R1), mt, fr, fq); const FB fAJ = ldB(BUF(I_AJ), nh, fr, fq), fAK = ldB(BUF(aki), nh, fr, fq);
          mma(a1, fTT, fAJ); mma(a2, fTT, fAK);
          storeT(BUF(I_L), a1, mt, nh, fr, fq);
          storeT(BUF(I_LT), a2, mt, nh, fr, fq); }
        LBAR();
        { const f32x4 zero = {0.f, 0.f, 0.f, 0.f}; f32x4 aMY[2], aNY[2] = {zero, zero}, aMS[2] = {zero, zero}, aNS[2];
          const FA fG1 = ldA(BUF(I_L), mt, fr, fq), fG2 = ldA(BUF(I_LT), mt, fr, fq), fKTa = ldAT(BUF(I_KT), mt, fr, fq);
          const FB fAB = ldB(BUF(I_ABRT), nh, fr, fq), fRT = ldBT(BUF(I_RT), nh, fr, fq), fBH = ldB(BUF(I_BHJ), nh, fr, fq);
#pragma unroll
          for (int nt = 0; nt < 2; ++nt)
#pragma unroll
              for (int r = 0; r < 4; ++r) aMY[nt][r] = bflo(*(const unsigned short*)(BUF(I_RT) + SW(16 * mt + 4 * fq + r, 16 * (2 * nh + nt) + fr)));
          ldC(aNS, BUF(I_KHJ), mt, nh, fr, fq);
          mma(aNY, fKTa, fRT);
          mma(aMY, fG1, fAB);
          mma(aMS, fG1, fBH);
          mma(aNS, fG2, fBH);
          MASK(aNY, m_ <= n_)
          mma(aNY, fG2, fAB);
#pragma unroll
          for (int nt = 0; nt < 2; ++nt)
#pragma unroll
              for (int r = 0; r < 4; ++r) { const int m_ = 16 * mt + 4 * fq + r, n_ = 16 * (2 * nh + nt) + fr; if (m_ == n_) aMS[nt][r] += GC[m_]; }
          storeT(BUF(I_AT), aMY, mt, nh, fr, fq); storeT(BUF(I_BT), aNY, mt, nh, fr, fq); storeT(BUF(I_AJ), aMS, mt, nh, fr, fq); storeT(BUF(I_R0), aNS, mt, nh, fr, fq); }
        LBAR();
        { const f32x4 zero = {0.f, 0.f, 0.f, 0.f}; f32x4 aY[2] = {zero, zero}, aS[2] = {zero, zero};
          const FA fS0a = ldA(BUF(s0i), mt, fr, fq), fVJa = ldA(BUF(I_VJ), mt, fr, fq), fMS = ldA(BUF(I_AJ), mt, fr, fq), fNS = ldA(BUF(I_R0), mt, fr, fq);
          const FB fMY = ldB(BUF(I_AT), nh, fr, fq), fNY = ldB(BUF(I_BT), nh, fr, fq), fS0 = ldB(BUF(s0i), nh, fr, fq), fVJ = ldB(BUF(I_VJ), nh, fr, fq);
          mma(aY, fS0a, fMY); mma(aS, fMS, fS0); mma(aY, fVJa, fNY); mma(aS, fNS, fVJ);
#pragma unroll
          for (int nt = 0; nt < 2; ++nt) *(f32x4*)(YTF + SWF(16 * (2 * nh + nt) + fr, 16 * mt + 4 * fq)) = aY[nt];
          storeT(BUF(aki), aS, mt, nh, fr, fq); }
        LBAR();
#undef MASK
        { const int tmp = s0i; s0i = aki; aki = tmp; }
    }
    { const int c = SEQ / 64; const size_t tprev = (size_t)b * SEQ + (c - 1) * 64 + pt; ESTAGE(((c - 1) & 1) ? BUF(I_VT2) : BUF(I_VT), tprev) }
    *(v4u*)(ya + ypoff) = ypend;
    LBAR();
#undef ESTAGE
#undef BUF
#undef ZLOAD
}
#undef LBAR
}

__device__ __forceinline__ void p_norm2_route(const PArgs& a, unsigned char* lds, int wv) {
    typedef short bf16x8 __attribute__((ext_vector_type(8)));
    const int tid = mktid(wv), lane = tid & 63, fr = lane & 15, fq = lane >> 4;
    const bf16* x1 = (const bf16*)(a.ws + WS_X1B); const float* mod = (const float*)(a.ws + WS_MOD); const float* gm2 = (const float*)(a.ws + WS_GM2); const float* cbt = (const float*)(a.ws + WS_CB);
    int* rte = (int*)(a.ws + WS_RTE); float* rtw = (float*)(a.ws + WS_RTW); int* rnk = (int*)(a.ws + WS_RNK); unsigned* cnt = (unsigned*)(a.ws + WS_CTL) + CW_CNT;
    float* PL = (float*)lds;
    float* PS = PL + 8 * 32 * 48;
    float* RS_ = PS + 8 * 32;
    float* FL = RS_ + 32;
    unsigned* HIST = (unsigned*)(FL + 32 * 48);
    unsigned* LRK = HIST + 32;
    if (tid < 32) HIST[tid] = 0u;
    __syncthreads();
    int gcount = 0;
    bf16x8 wh[4][3], wl[4][3];
    { const bf16* wrh = (const bf16*)(a.ws + WS_WRH) + fr * 1024 + 128 * wv + 8 * fq; const bf16* wrl = (const bf16*)(a.ws + WS_WRL) + fr * 1024 + 128 * wv + 8 * fq;
#pragma unroll
      for (int ks = 0; ks < 4; ++ks)
#pragma unroll
          for (int nt = 0; nt < 3; ++nt) { wh[ks][nt] = *(const bf16x8*)(wrh + nt * 16 * 1024 + 32 * ks); wl[ks][nt] = *(const bf16x8*)(wrl + nt * 16 * 1024 + 32 * ks); } }
    for (int grp = blockIdx.x; grp < NT / 32; grp += gridDim.x) {
        const int row0 = grp * 32, b = row0 >> 11;
        f32x4 acc[3][2];
#pragma unroll
        for (int nt = 0; nt < 3; ++nt) { acc[nt][0] = (f32x4){0.f, 0.f, 0.f, 0.f}; acc[nt][1] = acc[nt][0]; }
        float ssq[2] = {0.f, 0.f};
#pragma unroll
        for (int rt = 0; rt < 2; ++rt) {
            float xs[4][8];
#pragma unroll
            for (int ks = 0; ks < 4; ++ks) rw::ld8bf((const unsigned char*)(x1 + (size_t)(row0 + 16 * rt + fr) * DM + 128 * wv + 32 * ks + 8 * fq), xs[ks]);
#pragma unroll
            for (int ks = 0; ks < 4; ++ks) { float gm[8]; rw::ld8f(gm2 + b * 1024 + 128 * wv + 32 * ks + 8 * fq, gm); unsigned hw[4], lw[4];
#pragma unroll
                for (int e = 0; e < 4; ++e) { const float x0 = xs[ks][2 * e], x1v = xs[ks][2 * e + 1]; ssq[rt] += x0 * x0 + x1v * x1v; const float g0 = x0 * gm[2 * e], g1 = x1v * gm[2 * e + 1];
                    hw[e] = pk2(g0, g1); lw[e] = pk2(g0 - bflo(hw[e]), g1 - bfhi(hw[e])); }
                const v4u hv = {hw[0], hw[1], hw[2], hw[3]}, lv = {lw[0], lw[1], lw[2], lw[3]}; const bf16x8 bh = __builtin_bit_cast(bf16x8, hv), bl = __builtin_bit_cast(bf16x8, lv);
#pragma unroll
                for (int nt = 0; nt < 3; ++nt) { acc[nt][rt] = __builtin_amdgcn_mfma_f32_16x16x32_bf16(wh[ks][nt], bh, acc[nt][rt], 0, 0, 0); acc[nt][rt] = __builtin_amdgcn_mfma_f32_16x16x32_bf16(wl[ks][nt], bh, acc[nt][rt], 0, 0, 0);
                    acc[nt][rt] = __builtin_amdgcn_mfma_f32_16x16x32_bf16(wh[ks][nt], bl, acc[nt][rt], 0, 0, 0); } } }
#pragma unroll
        for (int rt = 0; rt < 2; ++rt) {
#pragma unroll
            for (int nt = 0; nt < 3; ++nt) *(f32x4*)(PL + (wv * 32 + 16 * rt + fr) * 48 + 16 * nt + 4 * fq) = acc[nt][rt];
            float s = ssq[rt]; s += __builtin_bit_cast(float, __builtin_amdgcn_ds_swizzle(__builtin_bit_cast(int, s), 0x401F));
            { const unsigned u = __builtin_bit_cast(unsigned, s); auto rr = __builtin_amdgcn_permlane32_swap(u, u, false, false); s = __builtin_bit_cast(float, (unsigned)rr[0]) + __builtin_bit_cast(float, (unsigned)rr[1]); }
            if (fq == 0) PS[wv * 32 + 16 * rt + fr] = s; }
        __syncthreads();
        { const int r = tid >> 4, c = tid & 15; float s0 = 0.f, s1 = 0.f, s2 = 0.f, sq = 0.f;
#pragma unroll
          for (int w = 0; w < 8; ++w) { const float* p = PL + (w * 32 + r) * 48; s0 += p[c]; s1 += p[c + 16]; s2 += p[c + 32]; sq += PS[w * 32 + r]; }
          const float rstd = rsqrtf(sq * (1.0f / DM) + 1e-6f); const float* cb = cbt + b * 48;
          FL[r * 48 + c] = rstd * s0 + cb[c]; FL[r * 48 + c + 16] = rstd * s1 + cb[c + 16]; FL[r * 48 + c + 32] = rstd * s2 + cb[c + 32];
          if (c == 0) ((float*)(a.ws + WS_RSTD))[row0 + r] = rstd; }
        __syncthreads();
        if (tid < 32) { const int m = row0 + tid; const float* lg = FL + tid * 48;
            int gi = 0; float gm = lg[0];
#pragma unroll
            for (int i = 1; i < 4; ++i) if (lg[i] > gm) { gm = lg[i]; gi = i; }
            float gs = 0.f;
#pragma unroll
            for (int i = 0; i < 4; ++i) gs += __expf(lg[i] - gm);
            const float pg = 1.0f / gs;
            float el[8];
#pragma unroll
            for (int k = 0; k < 8; ++k) el[k] = lg[4 + gi * 8 + k];
            int e1 = 0; float m1 = el[0];
#pragma unroll
            for (int k = 1; k < 8; ++k) if (el[k] > m1) { m1 = el[k]; e1 = k; }
            int e2 = -1; float m2 = -INFINITY;
#pragma unroll
            for (int k = 0; k < 8; ++k) if (k != e1 && el[k] > m2) { m2 = el[k]; e2 = k; }
            const float q2 = __expf(m2 - m1); const float w1 = pg / (1.0f + q2), w2 = pg * q2 / (1.0f + q2);
            const int ea = gi * 8 + e1, eb = gi * 8 + e2; rte[2 * m] = ea; rte[2 * m + 1] = eb; rtw[2 * m] = w1; rtw[2 * m + 1] = w2;
            LRK[gcount * 64 + 2 * tid] = atomicAdd(HIST + ea, 1u) | ((unsigned)ea << 24); LRK[gcount * 64 + 2 * tid + 1] = atomicAdd(HIST + eb, 1u) | ((unsigned)eb << 24); }
        ++gcount;
        __syncthreads();
    }
    if (tid < 32) { const unsigned n = HIST[tid]; HIST[tid] = n ? atomicAdd(cnt + tid * CNT_PAD, n) : 0u; }
    __syncthreads();
    for (int i = tid; i < gcount * 64; i += 512) { const int gi_ = i >> 6, e = i & 63; const int m2 = 2 * ((blockIdx.x + gi_ * gridDim.x) * 32) + e; const unsigned lr = LRK[i]; rnk[m2] = (int)(HIST[lr >> 24] + (lr & 0xffffffu)); }
    __syncthreads();
}
__device__ __forceinline__ void p_moe_gather(const PArgs& a, unsigned char* lds, int wv) {
    int* off = (int*)lds; int* tl = off + 64;
    const int tid = mktid(wv), lane = tid & 63, gw = blockIdx.x * 8 + (tid >> 6), NGW = gridDim.x * 8;
    int* ctl = (int*)(a.ws + WS_CTL); const unsigned* cnt = (const unsigned*)ctl + CW_CNT;
    if (tid < NEXP) tl[tid] = ((int)cnt[tid * CNT_PAD] + 255) >> 8;
    __syncthreads();
    if (tid < NEXP) { int o = 0; for (int e = 0; e < tid; ++e) o += tl[e];
        off[tid] = o * 256;
        if (blockIdx.x == 0) { const int n = tl[tid]; for (int i = 0; i < n; ++i) ctl[CW_TEXP + o + i] = tid; if (tid == NEXP - 1) ctl[CW_NT] = o + n; } }
    __syncthreads();
    const int* rte = (const int*)(a.ws + WS_RTE); const int* rnk = (const int*)(a.ws + WS_RNK); int* pos = (int*)(a.ws + WS_POS);
    const bf16* x1 = (const bf16*)(a.ws + WS_X1B); bf16* xs = (bf16*)(a.ws + WS_XS); const float* rstdv = (const float*)(a.ws + WS_RSTD);
    const float* mod = (const float*)(a.ws + WS_MOD); const float* gm2 = (const float*)(a.ws + WS_GM2);
    typedef int v4i_ __attribute__((ext_vector_type(4)));
    v4u xr[4][2]; v4i_ re[2], rk[2]; f32x4 rs;
    { const int t0 = 4 * gw < NT ? 4 * gw : 0;
#pragma unroll
      for (int r = 0; r < 4; ++r)
#pragma unroll
          for (int hf = 0; hf < 2; ++hf) xr[r][hf] = *(const v4u*)(x1 + (size_t)(t0 + r) * DM + 8 * lane + 512 * hf);
      re[0] = *(const v4i_*)(rte + 2 * t0); re[1] = *(const v4i_*)(rte + 2 * t0 + 4); rk[0] = *(const v4i_*)(rnk + 2 * t0); rk[1] = *(const v4i_*)(rnk + 2 * t0 + 4); rs = *(const f32x4*)(rstdv + t0); }
    for (int t0 = 4 * gw; t0 < NT; t0 += 4 * NGW) {
        const int tn = t0 + 4 * NGW < NT ? t0 + 4 * NGW : t0;
        v4u nx[4][2]; v4i_ ne[2], nk[2]; f32x4 ns;
#pragma unroll
        for (int r = 0; r < 4; ++r)
#pragma unroll
            for (int hf = 0; hf < 2; ++hf) nx[r][hf] = *(const v4u*)(x1 + (size_t)(tn + r) * DM + 8 * lane + 512 * hf);
        ne[0] = *(const v4i_*)(rte + 2 * tn); ne[1] = *(const v4i_*)(rte + 2 * tn + 4); nk[0] = *(const v4i_*)(rnk + 2 * tn); nk[1] = *(const v4i_*)(rnk + 2 * tn + 4); ns = *(const f32x4*)(rstdv + tn);
        const int b = t0 >> 11; int p0[4], p1[4];
#pragma unroll
        for (int r = 0; r < 4; ++r) { const int i0 = 2 * r, i1 = 2 * r + 1; p0[r] = off[re[i0 >> 2][i0 & 3]] + rk[i0 >> 2][i0 & 3]; p1[r] = off[re[i1 >> 2][i1 & 3]] + rk[i1 >> 2][i1 & 3]; }
        if (lane < 4) { const int r = lane; pos[2 * (t0 + r)] = r == 0 ? p0[0] : r == 1 ? p0[1] : r == 2 ? p0[2] : p0[3]; pos[2 * (t0 + r) + 1] = r == 0 ? p1[0] : r == 1 ? p1[1] : r == 2 ? p1[2] : p1[3]; }
#pragma unroll
        for (int hf = 0; hf < 2; ++hf) { const int col = 8 * lane + 512 * hf; float gm[8], sh[8];
            rw::ld8f(gm2 + b * 1024 + col, gm); rw::ld8f(mod + b * 6144 + 3072 + col, sh);
#pragma unroll
            for (int r = 0; r < 4; ++r) { const v4u xw = xr[r][hf]; const float rstd = rs[r];
                const float xv[8] = {bflo(xw.x), bfhi(xw.x), bflo(xw.y), bfhi(xw.y), bflo(xw.z), bfhi(xw.z), bflo(xw.w), bfhi(xw.w)}; float o[8];
#pragma unroll
                for (int e = 0; e < 8; ++e) o[e] = xv[e] * gm[e] * rstd + sh[e];
                v4u w; w.x = pk2(o[0], o[1]); w.y = pk2(o[2], o[3]); w.z = pk2(o[4], o[5]); w.w = pk2(o[6], o[7]);
                *(v4u*)(xs + (size_t)p0[r] * DM + col) = w; *(v4u*)(xs + (size_t)p1[r] * DM + col) = w; } }
#pragma unroll
        for (int r = 0; r < 4; ++r)
#pragma unroll
            for (int hf = 0; hf < 2; ++hf) xr[r][hf] = nx[r][hf];
        re[0] = ne[0]; re[1] = ne[1]; rk[0] = nk[0]; rk[1] = nk[1]; rs = ns;
    }
}
__device__ __forceinline__ void p_combine(const PArgs& a, unsigned char* lds, int wv) {
    const int tid = mktid(wv), lane = tid & 63, gw = blockIdx.x * 8 + (tid >> 6), NGW = gridDim.x * 8;
    const float* mod = (const float*)(a.ws + WS_MOD); const int* pos = (const int*)(a.ws + WS_POS); const float* rtw = (const float*)(a.ws + WS_RTW);
    const bf16* ys = (const bf16*)(a.ws + WS_XS); float* out = a.out; const bf16* x1 = (const bf16*)(a.ws + WS_X1B);
    typedef int v4i_ __attribute__((ext_vector_type(4)));
    v4i_ ps[2]; f32x4 wt[2];
    { const int m0 = 4 * gw < NT ? 4 * gw : 0; ps[0] = *(const v4i_*)(pos + 2 * m0); ps[1] = *(const v4i_*)(pos + 2 * m0 + 4); wt[0] = *(const f32x4*)(rtw + 2 * m0); wt[1] = *(const f32x4*)(rtw + 2 * m0 + 4); }
    for (int m0 = 4 * gw; m0 < NT; m0 += 4 * NGW) {
        const int mn = m0 + 4 * NGW < NT ? m0 + 4 * NGW : m0; const int b = m0 >> 11;
        v4u xw[4][2], y0[4][2], y1[4][2];
#pragma unroll
        for (int r = 0; r < 4; ++r) { const int i0 = 2 * r, i1 = 2 * r + 1; const int q0 = ps[i0 >> 2][i0 & 3], q1 = ps[i1 >> 2][i1 & 3];
#pragma unroll
            for (int hf = 0; hf < 2; ++hf) { const int col = 8 * lane + 512 * hf; xw[r][hf] = *(const v4u*)(x1 + (size_t)(m0 + r) * DM + col); y0[r][hf] = *(const v4u*)(ys + (size_t)q0 * DM + col); y1[r][hf] = *(const v4u*)(ys + (size_t)q1 * DM + col); } }
        v4i_ np[2]; f32x4 nw[2];
        np[0] = *(const v4i_*)(pos + 2 * mn); np[1] = *(const v4i_*)(pos + 2 * mn + 4); nw[0] = *(const f32x4*)(rtw + 2 * mn); nw[1] = *(const f32x4*)(rtw + 2 * mn + 4);
#pragma unroll
        for (int hf = 0; hf < 2; ++hf) { const int col = 8 * lane + 512 * hf; float g2[8]; rw::ld8f(mod + b * 6144 + 5120 + col, g2);
#pragma unroll
            for (int r = 0; r < 4; ++r) { const int i0 = 2 * r, i1 = 2 * r + 1; const float w0 = wt[i0 >> 2][i0 & 3], w1 = wt[i1 >> 2][i1 & 3];
                const v4u xa = xw[r][hf], a0 = y0[r][hf], a1 = y1[r][hf];
                const float xv[8] = {bflo(xa.x), bfhi(xa.x), bflo(xa.y), bfhi(xa.y), bflo(xa.z), bfhi(xa.z), bflo(xa.w), bfhi(xa.w)};
                const float e0[8] = {bflo(a0.x), bfhi(a0.x), bflo(a0.y), bfhi(a0.y), bflo(a0.z), bfhi(a0.z), bflo(a0.w), bfhi(a0.w)};
                const float e1[8] = {bflo(a1.x), bfhi(a1.x), bflo(a1.y), bfhi(a1.y), bflo(a1.z), bfhi(a1.z), bflo(a1.w), bfhi(a1.w)};
                float o[8];
#pragma unroll
                for (int e = 0; e < 8; ++e) o[e] = xv[e] + g2[e] * (e0[e] * w0 + e1[e] * w1);
                float* op = out + (size_t)(m0 + r) * DM + col; *(f32x4*)op = (f32x4){o[0], o[1], o[2], o[3]}; *(f32x4*)(op + 4) = (f32x4){o[4], o[5], o[6], o[7]}; } }
        ps[0] = np[0]; ps[1] = np[1]; wt[0] = nw[0]; wt[1] = nw[1];
    }
}

#define XB_TMO      128
#define XB_XCNT(j)  (256  + 64 * (j))
#define XB_XSUB(j)  (1280 + 64 * (j))
#define XB_XGEN(j)  (2304 + 64 * (j))
#define XB_TOP      3328
#define XB_TOPGEN   3392
#define XCD_BAR_WORDS 3456
#define XB_SPIN_CAP (1u << 22)

__device__ __forceinline__ unsigned xb_ld(unsigned* p)              { return __hip_atomic_load(p, __ATOMIC_RELAXED, __HIP_MEMORY_SCOPE_AGENT); }
__device__ __forceinline__ unsigned xb_add(unsigned* p, unsigned v) { return __hip_atomic_fetch_add(p, v, __ATOMIC_RELAXED, __HIP_MEMORY_SCOPE_AGENT); }
__device__ __forceinline__ unsigned xb_xcc_id() { return (unsigned)__builtin_amdgcn_s_getreg((3 << 11) | 20) & 0xFu; }
#define XB_SPIN(cond, bar) do { unsigned _sp = 0; while (cond) { __builtin_amdgcn_s_sleep(1); \
    if ((++_sp & 255u) == 0u) { if (xb_ld(&(bar)[XB_TMO])) break; if (_sp > XB_SPIN_CAP) { atomicAdd(&(bar)[XB_TMO], 1u); break; } } } } while (0)

struct XcdBarrier {
    unsigned* bar; unsigned x;
    volatile LAS unsigned* st;
};

__device__ __forceinline__ XcdBarrier xcd_barrier_post(unsigned* bar, volatile LAS unsigned* st, int wv) {
    XcdBarrier b; b.bar = bar; b.x = xb_xcc_id(); b.st = st;
    if (mktid(wv) == 0) (void)xb_add(&bar[XB_XCNT(b.x)], 1u);
    return b;
}
__device__ __forceinline__ void xcd_barrier_complete(unsigned* bar, unsigned x, unsigned& nloc, unsigned& nx) {
    const unsigned G = gridDim.x * gridDim.y * gridDim.z;
    unsigned sum, cnt, mine, sp = 0u;
    for (;;) {
        sum = 0u; cnt = 0u; mine = 0u;
#pragma unroll
        for (unsigned j = 0; j < 16; ++j) { const unsigned c = xb_ld(&bar[XB_XCNT(j)]); sum += c; cnt += (c > 0u) ? 1u : 0u; mine = (j == x) ? c : mine; }
        if (sum == G) break;
        __builtin_amdgcn_s_sleep(1);
        if ((++sp & 255u) == 0u) { if (xb_ld(&bar[XB_TMO])) break; if (sp > XB_SPIN_CAP) { atomicAdd(&bar[XB_TMO], 1u); break; } }
    }
    nloc = mine > 0u ? mine : 1u; nx = cnt > 0u ? cnt : 1u;
}

__device__ __forceinline__ void xcd_barrier(const XcdBarrier& b, int wv) {
    asm volatile("s_waitcnt vmcnt(0)" ::: "memory");
    __syncthreads();
    if (mktid(wv) == 0) {
        unsigned* bar = b.bar;
        __builtin_amdgcn_s_waitcnt(0);
        unsigned nloc = b.st[0], nx = b.st[1];
        if (nloc == 0u) { xcd_barrier_complete(bar, b.x, nloc, nx); b.st[0] = nloc; b.st[1] = nx; }
        const unsigned old = xb_add(&bar[XB_XSUB(b.x)], 1u);
        const unsigned gen = old / nloc;
        if (old + 1u == (gen + 1u) * nloc) {
            __builtin_amdgcn_fence(__ATOMIC_RELEASE, "agent");
            asm volatile("s_waitcnt vmcnt(0)" ::: "memory");
            const unsigned og = xb_add(&bar[XB_TOP], 1u);
            const unsigned tg = og / nx;
            if (og + 1u == (tg + 1u) * nx) xb_add(&bar[XB_TOPGEN], 1u);
            else XB_SPIN(xb_ld(&bar[XB_TOPGEN]) == tg, bar);
            __builtin_amdgcn_fence(__ATOMIC_ACQUIRE, "agent");
            xb_add(&bar[XB_XGEN(b.x)], 1u);
            asm volatile("s_waitcnt vmcnt(0)" ::: "memory");
        } else {
            XB_SPIN(xb_ld(&bar[XB_XGEN(b.x)]) == gen, bar);
            __builtin_amdgcn_fence(__ATOMIC_ACQUIRE, "agent");
            asm volatile("s_waitcnt vmcnt(0)" ::: "memory");
        }
    }
    __syncthreads();
}

constexpr int LDS_BYTES = 160 * 1024, MISC_OFF = LDS_BYTES - 256;
static_assert(rw::LDS_NEED <= MISC_OFF, "scan LDS");
constexpr int CW_BAR = 4096;

__global__ void __launch_bounds__(512, 2) mega_fwd(PArgs a) {
    extern __shared__ __attribute__((aligned(16))) unsigned char lds[];
    volatile LAS unsigned* MISC = (volatile LAS unsigned*)((LAS unsigned char*)lds + MISC_OFF);
    const int wv = __builtin_amdgcn_readfirstlane((int)threadIdx.x >> 6);
    { const int t0 = mktid(wv); if (t0 < 64) MISC[t0] = 0u; }
    __syncthreads();
    XcdBarrier bar = xcd_barrier_post((unsigned*)(a.ws + WS_CTL) + CW_BAR, MISC + 8, wv);
    GemmArgs g; g.ws = a.ws; g.x = a.in[0]; g.out = a.out; g.qg = a.in[18]; g.kg = a.in[19];
    const int G = (int)gridDim.x, bx = (int)blockIdx.x;

    { const int t0 = mktid(wv); float wr[64]; float* sc = (float*)(lds + 68 * 1024); float* red = (float*)lds;
      const bool has = bx < 192;
      if (has) p_ada_load(a, bx, t0, wr);
      for (int i = t0; i < 16 * 1024; i += 512) { const float v = a.in[1][i]; sc[i] = v / (1.0f + __expf(-v)); }
      p_prep_weights(a, lds, wv);
      __syncthreads();
      if (has) p_ada_finish(a, sc, red, bx, t0, wr);
      for (int tile = bx + G; tile < 192; tile += G) { p_ada_load(a, tile, t0, wr); p_ada_finish(a, sc, red, tile, t0, wr); } }
    xcd_barrier(bar, wv);
    p_norm1(a, lds, wv);
    xcd_barrier(bar, wv);
    p_gemm_in(g, lds, wv);
    xcd_barrier(bar, wv);
    p_actprep(a, lds, wv);
    xcd_barrier(bar, wv);
    { const int nscan = G / 2;
      if (bx < nscan) { for (int bh = bx; bh < 128; bh += nscan) rw::scan_unit(a, lds, bh, wv); }
      else p_attn(a, lds, bx - nscan, G - nscan, wv); }
    __syncthreads(); p_prep_experts_dyn(a, lds, wv);
    xcd_barrier(bar, wv);
    p_gemm_merge(g, lds, wv);
    xcd_barrier(bar, wv);
    p_gemm_out(g, lds, wv);
    xcd_barrier(bar, wv);
    p_norm2_route(a, lds, wv);
    xcd_barrier(bar, wv);
    p_moe_gather(a, lds, wv);
    xcd_barrier(bar, wv);
    p_gemm_up(g, lds, wv);
    xcd_barrier(bar, wv);
    p_gemm_down(g, lds, wv);
    xcd_barrier(bar, wv);
    p_combine(a, lds, wv);
}

extern "C" void kernel_launch(void* const* d_in, const int* in_sizes, int n_in, void* d_out, int out_size, void* d_ws, size_t ws_size, hipStream_t stream) {
    static int grid = 0;
    if (grid == 0) {
        if (n_in != 30 || out_size != NT * DM || ws_size < WS_END) { fprintf(stderr, "kernel_launch: unexpected shapes (n_in %d, out %d, ws %zu)\n", n_in, out_size, ws_size); grid = -1; return; }
        int dev = 0, cus = 0, per_cu = 0;
        if (hipGetDevice(&dev) != hipSuccess || hipDeviceGetAttribute(&cus, hipDeviceAttributeMultiprocessorCount, dev) != hipSuccess) { grid = -1; return; }
        if (hipFuncSetAttribute((const void*)mega_fwd, hipFuncAttributeMaxDynamicSharedMemorySize, LDS_BYTES) != hipSuccess) { fprintf(stderr, "kernel_launch: hipFuncSetAttribute failed\n"); grid = -1; return; }
        if (hipOccupancyMaxActiveBlocksPerMultiprocessor(&per_cu, (const void*)mega_fwd, 512, LDS_BYTES) != hipSuccess || per_cu < 1) { fprintf(stderr, "kernel_launch: occupancy query says %d blocks per CU\n", per_cu); (void)hipGetLastError(); grid = -1; return; }
        grid = cus;
    }
    if (grid < 0) return;
    (void)hipMemsetAsync((char*)d_ws + WS_CTL, 0, 65536, stream);
    PArgs p{}; for (int i = 0; i < 30; ++i) p.in[i] = (const float*)d_in[i]; p.out = (float*)d_out; p.ws = (unsigned char*)d_ws;
    hipLaunchKernelGGL(mega_fwd, dim3(grid), dim3(512), LDS_BYTES, stream, p);
}
```

```cpp
#include <hip/hip_runtime.h>
#include <cstdio>
#include <cstdint>
__device__ __forceinline__ int mktid(int wv) { int l; asm volatile("v_mbcnt_lo_u32_b32 %0, -1, 0\n\tv_mbcnt_hi_u32_b32 %0, -1, %0" : "=v"(l)); return (wv << 6) | l; }
template <int CTRL> __device__ __forceinline__ float dppf(float v) { return __builtin_bit_cast(float, __builtin_amdgcn_update_dpp(0, __builtin_bit_cast(int, v), CTRL, 0xF, 0xF, true)); }
__device__ __forceinline__ float red4(float v) { v += dppf<0xB1>(v); v += dppf<0x4E>(v); return v; }
__device__ __forceinline__ float red8(float v) { v = red4(v); v += dppf<0x141>(v); return v; }
__device__ __forceinline__ float red16(float v) { v = red8(v); v += dppf<0x140>(v); return v; }
__device__ __forceinline__ float wave_sum(float v) { v = red16(v);
    v += __builtin_bit_cast(float, __builtin_amdgcn_ds_swizzle(__builtin_bit_cast(int, v), 0x401F));
    const unsigned u = __builtin_bit_cast(unsigned, v); auto rr = __builtin_amdgcn_permlane32_swap(u, u, false, false);
    return __builtin_bit_cast(float, (unsigned)rr[0]) + __builtin_bit_cast(float, (unsigned)rr[1]); }
__device__ __forceinline__ void wave_sum8(float (&v)[8]) {
#pragma unroll
    for (int i = 0; i < 8; ++i) v[i] += dppf<0xB1>(v[i]);
#pragma unroll
    for (int i = 0; i < 8; ++i) v[i] += dppf<0x4E>(v[i]);
#pragma unroll
    for (int i = 0; i < 8; ++i) v[i] += dppf<0x141>(v[i]);
#pragma unroll
    for (int i = 0; i < 8; ++i) v[i] += dppf<0x140>(v[i]);
#pragma unroll
    for (int i = 0; i < 8; ++i) v[i] += __builtin_bit_cast(float, __builtin_amdgcn_ds_swizzle(__builtin_bit_cast(int, v[i]), 0x401F));
#pragma unroll
    for (int i = 0; i < 8; ++i) { const unsigned u = __builtin_bit_cast(unsigned, v[i]); auto rr = __builtin_amdgcn_permlane32_swap(u, u, false, false); v[i] = __builtin_bit_cast(float, (unsigned)rr[0]) + __builtin_bit_cast(float, (unsigned)rr[1]); }
}
__device__ __forceinline__ float lane_get(float v, int src) { return __builtin_bit_cast(float, __builtin_amdgcn_ds_bpermute(src << 2, __builtin_bit_cast(int, v))); }
namespace pg8 {
#define PG8_LAS __attribute__((address_space(3)))
typedef unsigned short bf16_t;
typedef short bf16x8 __attribute__((ext_vector_type(8)));
typedef float f32x4 __attribute__((ext_vector_type(4)));
typedef unsigned u32x4 __attribute__((ext_vector_type(4)));
constexpr int BM = 256, BK = 64, HALF = 128, HTB = HALF * BK * 2  , STAGE_BYTES = 8 * HTB, NXCD = 8, WGM = 4;

__host__ __device__ __forceinline__ int lds_byte(int r, int c) { const int st = (r >> 4) * 2 + (c >> 5), rr = r & 15, cc = c & 31, ob = rr * 64 + cc * 2; return st * 1024 + (ob ^ (((ob >> 9) & 1) << 5)); }
__host__ __device__ __forceinline__ void stage_rc(int b, int& R, int& C) { const int st = b / 1024, sb = b % 1024, swz = sb ^ (((sb >> 9) & 1) << 5); R = (st >> 1) * 16 + swz / 64; C = (st & 1) * 32 + (swz % 64) / 2; }
__host__ __device__ __forceinline__ int perm32(int rho) { const int n = rho >> 4, i = rho & 15; return 8 * (i >> 2) + 4 * n + (i & 3); }
struct Unit { int pm, pn, aux; const char* a; const char* b; };
struct Gemm { int K; };

struct StaticOrder {
    int nM, nN, nwg, G, c; const char* A; const char* Bt; size_t tstep;
    __device__ void init(const void* A_, const void* Bt_, int M, int N, int K, int G_, int c_) { nM = M / BM; nN = N / BM; nwg = nM * nN; G = G_; c = c_; A = (const char*)A_; Bt = (const char*)Bt_; tstep = (size_t)BM * K * 2; }
    __device__ bool next(int i, Unit& u) const {
        const long L = (long)i * G + c; if (L >= nwg) return false;
        int wgid = (int)L; { const int q = nwg / NXCD, r = nwg % NXCD, xcd = wgid % NXCD, off = wgid / NXCD; wgid = (xcd < r ? xcd * (q + 1) : r * (q + 1) + (xcd - r) * q) + off; }
        const int nig = WGM * nN, gid = wgid / nig, fm = gid * WGM, gsz = (nM - fm) < WGM ? (nM - fm) : WGM;
        u.aux = 0; u.pm = fm + ((wgid % nig) % gsz); u.pn = (wgid % nig) / gsz; u.a = A + (size_t)u.pm * tstep; u.b = Bt + (size_t)u.pn * tstep; return true;
    }
    __device__ __forceinline__ void a_ready(const Unit&) const {}
    __device__ __forceinline__ void done(const Unit&) const {}
};
__device__ __forceinline__ unsigned cvt_pk_bf16(float lo, float hi) { unsigned r; asm volatile("v_cvt_pk_bf16_f32 %0, %1, %2" : "=v"(r) : "v"(lo), "v"(hi)); return r; }
template <class Epi, class Sched, bool ALIGN_EPI = false, bool SP2 = false>
__device__ __forceinline__ void gemm_phase(PG8_LAS unsigned char* lds, const Gemm g, const Sched& S, const Epi& E, int wv) {
    const int tid = mktid(wv), wid = __builtin_amdgcn_readfirstlane(tid >> 6), lane = tid & 63, wr = wid >> 2, wc = wid & 3, fr = lane & 15, fq = lane >> 4;
    const int K = g.K, nt = K / BK;
    unsigned voffA[2], voffB[2];
#pragma unroll
    for (int i = 0; i < 2; ++i) { int R, C; stage_rc(tid * 16 + i * 8192, R, C); const int Rb = Epi::PERM ? ((R & ~31) + perm32(R & 31)) : R;
        voffA[i] = (unsigned)(R * K + C) * 2u; voffB[i] = (unsigned)(Rb * K + C) * 2u; }
    const size_t kstep = (size_t)(BK * 2);
    const size_t hstep = (size_t)HALF * K * 2;
        const unsigned ldsw = (unsigned)wid * 1024u;
    const int aoff = lds_byte(wr * 64 + fr, fq * 8), boff = lds_byte(wc * 32 + fr, fq * 8);
#define PG8_SA(b, h) (((b) * 2 + (h)) * HTB)
#define PG8_SB(b, h) ((4 + (b) * 2 + (h)) * HTB)
#define PG8_STAGE(bufoff, gbase, voff) do { _Pragma("unroll") for (int _i = 0; _i < 2; ++_i) \
        __builtin_amdgcn_global_load_lds((const unsigned*)((const char*)(gbase) + (voff)[_i]), (PG8_LAS unsigned*)(lds + (bufoff) + ldsw + _i * 8192), 16, 0, 0); } while (0)
#define PG8_LDA(dst, b, h) do { _Pragma("unroll") for (int m = 0; m < 4; ++m) _Pragma("unroll") for (int k = 0; k < 2; ++k) dst[m][k] = *(const PG8_LAS bf16x8*)(lds + PG8_SA(b, h) + aoff + m * 2048 + k * 1024); } while (0)
#define PG8_LDB(dst, b, h) do { _Pragma("unroll") for (int n = 0; n < 2; ++n) _Pragma("unroll") for (int k = 0; k < 2; ++k) dst[n][k] = *(const PG8_LAS bf16x8*)(lds + PG8_SB(b, h) + boff + n * 2048 + k * 1024); } while (0)
#define PG8_MMA(ai, bj, At, Bt) do { __builtin_amdgcn_s_setprio(1); _Pragma("unroll") for (int m = 0; m < 4; ++m) _Pragma("unroll") for (int n = 0; n < 2; ++n) _Pragma("unroll") for (int k = 0; k < 2; ++k) \
        acc[ai][bj][m][n] = __builtin_amdgcn_mfma_f32_16x16x32_bf16(Bt[n][k], At[m][k], acc[ai][bj][m][n], 0, 0, 0); __builtin_amdgcn_s_setprio(0); } while (0)
#define PG8_WAIT_V(n) asm volatile("s_waitcnt vmcnt(" #n ")" ::: "memory")
#define PG8_WAIT_L(n) asm volatile("s_waitcnt lgkmcnt(" #n ")" ::: "memory")
#define PG8_BAR __builtin_amdgcn_s_barrier()
#define PG8_SCHED __builtin_amdgcn_sched_barrier(0)
    Unit cur, nxt; int ui = 0;
    if (!S.next(0, cur)) return;
    f32x4 acc[2][2][4][2];
#pragma unroll
    for (int a = 0; a < 2; ++a)
#pragma unroll
        for (int b = 0; b < 2; ++b)
#pragma unroll
            for (int m = 0; m < 4; ++m)
#pragma unroll
                for (int n = 0; n < 2; ++n) acc[a][b][m][n] = (f32x4){0.f, 0.f, 0.f, 0.f};
    bf16x8 At[4][2], B0[2][2], B1[2][2];
    const char* cA = cur.a; const char* cB = cur.b;
    S.a_ready(cur);
    if constexpr (SP2) {
        PG8_STAGE(PG8_SB(0, 0), cB, voffB); PG8_STAGE(PG8_SB(0, 1), cB + hstep, voffB); PG8_STAGE(PG8_SA(0, 0), cA, voffA); PG8_STAGE(PG8_SA(0, 1), cA + hstep, voffA);
        if (wr == 1) PG8_BAR;
        PG8_WAIT_V(2); PG8_BAR;
        PG8_STAGE(PG8_SB(1, 0), cB + kstep, voffB); PG8_STAGE(PG8_SA(1, 0), cA + kstep, voffA); PG8_STAGE(PG8_SB(1, 1), cB + hstep + kstep, voffB);
        PG8_WAIT_V(6); PG8_BAR;
    } else {
        PG8_STAGE(PG8_SB(0, 0), cB, voffB); PG8_STAGE(PG8_SA(0, 0), cA, voffA); PG8_STAGE(PG8_SB(0, 1), cB + hstep, voffB); PG8_STAGE(PG8_SA(0, 1), cA + hstep, voffA);
        if (wr == 1) PG8_BAR;
        PG8_WAIT_V(4); PG8_BAR;
        PG8_STAGE(PG8_SB(1, 0), cB + kstep, voffB); PG8_STAGE(PG8_SA(1, 0), cA + kstep, voffA); PG8_STAGE(PG8_SB(1, 1), cB + hstep + kstep, voffB);
        PG8_WAIT_V(6); PG8_BAR;
    }
    for (;;) {
        const bool has_next = S.next(ui + 1, nxt);
        const char* nA = has_next ? nxt.a : cA; const char* nB = has_next ? nxt.b : cB;
        for (int t = 0; t < nt; t += 2) {
            const bool last = (t == nt - 2);
            const char* a1 = cA + (size_t)(t + 1) * kstep;
            const char* a2 = last ? nA : cA + (size_t)(t + 2) * kstep; const char* b2 = last ? nB : cB + (size_t)(t + 2) * kstep;
            const char* a3 = a2 + kstep; const char* b3 = b2 + kstep;
            if (last && has_next) S.a_ready(nxt);
            if constexpr (SP2) {
            PG8_LDB(B0, 0, 0); PG8_LDB(B1, 0, 1); PG8_SCHED; PG8_LDA(At, 0, 0); PG8_STAGE(PG8_SA(1, 1), a1 + hstep, voffA);
            PG8_WAIT_V(8); PG8_WAIT_L(0); PG8_BAR; PG8_MMA(0, 0, At, B0); PG8_MMA(0, 1, At, B1); PG8_BAR; PG8_SCHED;
            PG8_LDA(At, 0, 1); PG8_STAGE(PG8_SB(0, 0), b2, voffB); PG8_STAGE(PG8_SB(0, 1), b2 + hstep, voffB); PG8_STAGE(PG8_SA(0, 0), a2, voffA);
            PG8_WAIT_V(8); PG8_WAIT_L(0); PG8_BAR; PG8_MMA(1, 0, At, B0); PG8_MMA(1, 1, At, B1); PG8_BAR; PG8_SCHED;
            PG8_LDB(B0, 1, 0); PG8_LDB(B1, 1, 1); PG8_SCHED; PG8_LDA(At, 1, 0); PG8_STAGE(PG8_SA(0, 1), a2 + hstep, voffA);
            PG8_WAIT_V(8); PG8_WAIT_L(0); PG8_BAR; PG8_MMA(0, 0, At, B0); PG8_MMA(0, 1, At, B1); PG8_BAR; PG8_SCHED;
            PG8_LDA(At, 1, 1); PG8_STAGE(PG8_SB(1, 0), b3, voffB); PG8_STAGE(PG8_SB(1, 1), b3 + hstep, voffB); PG8_STAGE(PG8_SA(1, 0), a3, voffA);
            PG8_WAIT_V(8); PG8_WAIT_L(0); PG8_BAR; PG8_MMA(1, 0, At, B0); PG8_MMA(1, 1, At, B1); PG8_BAR; PG8_SCHED;
            } else {
            PG8_LDB(B0, 0, 0); PG8_SCHED; PG8_LDA(At, 0, 0); PG8_STAGE(PG8_SA(1, 1), a1 + hstep, voffA);
            PG8_WAIT_L(8); PG8_BAR; PG8_WAIT_L(0); PG8_MMA(0, 0, At, B0); PG8_BAR; PG8_SCHED;
            PG8_LDB(B1, 0, 1); PG8_STAGE(PG8_SB(0, 0), b2, voffB);
            PG8_BAR; PG8_WAIT_L(0); PG8_MMA(0, 1, At, B1); PG8_BAR;
            PG8_LDA(At, 0, 1); PG8_STAGE(PG8_SA(0, 0), a2, voffA);
            PG8_BAR; PG8_WAIT_L(0); PG8_MMA(1, 0, At, B0); PG8_BAR; PG8_SCHED;
            PG8_STAGE(PG8_SB(0, 1), b2 + hstep, voffB);
            PG8_WAIT_V(6); PG8_BAR; PG8_MMA(1, 1, At, B1); PG8_BAR;
            PG8_LDB(B0, 1, 0); PG8_SCHED; PG8_LDA(At, 1, 0); PG8_STAGE(PG8_SA(0, 1), a2 + hstep, voffA);
            PG8_WAIT_L(8); PG8_BAR; PG8_WAIT_L(0); PG8_MMA(0, 0, At, B0); PG8_BAR; PG8_SCHED;
            PG8_LDB(B1, 1, 1); PG8_STAGE(PG8_SB(1, 0), b3, voffB);
            PG8_BAR; PG8_WAIT_L(0); PG8_MMA(0, 1, At, B1); PG8_BAR;
            PG8_LDA(At, 1, 1); PG8_STAGE(PG8_SA(1, 0), a3, voffA);
            PG8_BAR; PG8_WAIT_L(0); PG8_MMA(1, 0, At, B0); PG8_BAR; PG8_SCHED;
            PG8_STAGE(PG8_SB(1, 1), b3 + hstep, voffB);
            PG8_WAIT_V(6); PG8_BAR; PG8_MMA(1, 1, At, B1); PG8_BAR;
            }
        }
        if constexpr (ALIGN_EPI) { if (wr == 0) PG8_BAR; }
        bool keep = false;
        if constexpr (!Epi::AFTER_DRAIN) { if constexpr (Epi::CHAIN) keep = E.chain(acc, cur, wr, wc, fr, fq); else E(acc, cur, wr, wc, fr, fq); S.done(cur); }
        if (!has_next) break;
        if (!keep) {
#pragma unroll
        for (int a = 0; a < 2; ++a)
#pragma unroll
            for (int b = 0; b < 2; ++b)
#pragma unroll
                for (int m = 0; m < 4; ++m)
#pragma unroll
                    for (int n = 0; n < 2; ++n) acc[a][b][m][n] = (f32x4){0.f, 0.f, 0.f, 0.f};
        }
        cur = nxt; cA = nA; cB = nB; ++ui;
        if constexpr (ALIGN_EPI) { if (wr == 1) PG8_BAR; }
    }
    PG8_WAIT_V(0);
    if constexpr (!ALIGN_EPI) { if (wr == 0) PG8_BAR; }
    PG8_BAR;
    if constexpr (Epi::AFTER_DRAIN) { E.fused(acc, cur, wr, wc, fr, fq, lds, wid, lane); S.done(cur); }
#undef PG8_SA
#undef PG8_SB
#undef PG8_STAGE
#undef PG8_LDA
#undef PG8_LDB
#undef PG8_MMA
#undef PG8_WAIT_V
#undef PG8_WAIT_L
#undef PG8_BAR
#undef PG8_SCHED
}
}
#include <hip/hip_bf16.h>
#include <cmath>
namespace attn_body {
using bf16=__hip_bfloat16;
using bf16x8=__attribute__((ext_vector_type(8)))short;
using s16x4=__attribute__((ext_vector_type(4)))short;
using f32x16=__attribute__((ext_vector_type(16)))float;
using u32x4=__attribute__((ext_vector_type(4)))unsigned;
constexpr int NHEAD=8,SEQ=2048,D=64,PQ=512,PK=512,PV=4352,PO=512;
constexpr int NW=8,QBLK=32,QB=QBLK*NW,KVBLK=64,NQB=SEQ/QB;
__device__ __forceinline__ int crow(int r,int hi){return (r&3)+8*(r>>2)+4*hi;}
#define SBAR() __builtin_amdgcn_sched_barrier(0)
__device__ __forceinline__ void cmask(f32x16&p0,f32x16&p1,int jb,int qrel,int hi){
  const float NEG=-INFINITY; int kb=64*jb+4*hi;
  #pragma unroll
  for(int r=0;r<16;++r){int kv=kb+(r&3)+8*(r>>2); if(kv>qrel)p0[r]=NEG; if(kv+32>qrel)p1[r]=NEG;}
}

constexpr int NSLOT=3, SLOTB=8192;
constexpr int LDS_K=0, LDS_V=NSLOT*SLOTB, LDS_WS=2*NSLOT*SLOTB, LDS_OST=LDS_WS+NW*64*4, LDS_SEL=LDS_OST+NW*4096, LDS_KM=LDS_SEL+256, LDS_KP=LDS_KM+7*64*4, LDS_BYTES=LDS_KP+8*64*4;
constexpr float C2=0.125f*1.4426950408889634f;
__device__ __forceinline__ void glds16(const void*gsrc,unsigned lds_dst){unsigned keep;
  asm volatile("s_mov_b32 %0, m0\n\ts_mov_b32 m0, %2\n\ts_nop 0\n\tglobal_load_lds_dwordx4 %1, off\n\ts_mov_b32 m0, %0":"=&s"(keep):"v"(gsrc),"s"(lds_dst):"memory");}
__device__ __forceinline__ float max3f(float a,float b,float c){float r;asm("v_max3_f32 %0, %1, %2, %3":"=v"(r):"v"(a),"v"(b),"v"(c));return r;}
__device__ __forceinline__ float max2f(float a,float b){float r;asm("v_max_f32_e32 %0, %1, %2":"=v"(r):"v"(a),"v"(b));return r;}
__device__ __forceinline__ float fadd_s(float a,float b){float r;asm("v_add_f32_e32 %0, %1, %2":"=v"(r):"v"(a),"v"(b));return r;}
__device__ __forceinline__ float fsub_s(float a,float b){float r;asm("v_sub_f32_e32 %0, %1, %2":"=v"(r):"v"(a),"v"(b));return r;}
typedef float f32x2_t __attribute__((ext_vector_type(2))); typedef __bf16 bf16x2_t __attribute__((ext_vector_type(2)));
__device__ __forceinline__ unsigned cvtpk_s(float lo,float hi){f32x2_t v={lo,hi};bf16x2_t b=__builtin_convertvector(v,bf16x2_t);return __builtin_bit_cast(unsigned,b);}
#define WAIT_BAR(N) asm volatile("s_waitcnt vmcnt(" #N ") lgkmcnt(0)\n\ts_barrier":::"memory")

__device__ __forceinline__ void qkt(f32x16&p0,f32x16&p1,const char*Kslot,const bf16x8*qr,const f32x16&negm,int r32,int hi){
  const char*kb=Kslot+hi*1024+r32*16;
  #pragma unroll
  for(int d0=0;d0<4;++d0){
    const bf16x8 b0=*reinterpret_cast<const bf16x8*>(kb+d0*2048);
    const bf16x8 b1=*reinterpret_cast<const bf16x8*>(kb+d0*2048+512);
    if(d0==0){p0=__builtin_amdgcn_mfma_f32_32x32x16_bf16(b0,qr[0],negm,0,0,0);p1=__builtin_amdgcn_mfma_f32_32x32x16_bf16(b1,qr[0],negm,0,0,0);}
    else{p0=__builtin_amdgcn_mfma_f32_32x32x16_bf16(b0,qr[d0],p0,0,0,0);p1=__builtin_amdgcn_mfma_f32_32x32x16_bf16(b1,qr[d0],p1,0,0,0);}}
}
typedef __attribute__((address_space(3))) const char* lds_cptr;
typedef short v4i16_t __attribute__((ext_vector_type(4)));
__device__ __forceinline__ void kload8(bf16x8*kf,lds_cptr kp){
  kf[0]=*(const __attribute__((address_space(3))) bf16x8*)(kp);      kf[1]=*(const __attribute__((address_space(3))) bf16x8*)(kp+512);
  kf[2]=*(const __attribute__((address_space(3))) bf16x8*)(kp+2048); kf[3]=*(const __attribute__((address_space(3))) bf16x8*)(kp+2560);
  kf[4]=*(const __attribute__((address_space(3))) bf16x8*)(kp+4096); kf[5]=*(const __attribute__((address_space(3))) bf16x8*)(kp+4608);
  kf[6]=*(const __attribute__((address_space(3))) bf16x8*)(kp+6144); kf[7]=*(const __attribute__((address_space(3))) bf16x8*)(kp+6656);
}
__device__ __forceinline__ void kload2(bf16x8*kf,lds_cptr kp,int j){ kf[2*j]=*(const __attribute__((address_space(3))) bf16x8*)(kp+j*2048); kf[2*j+1]=*(const __attribute__((address_space(3))) bf16x8*)(kp+j*2048+512); }
__device__ __forceinline__ s16x4 vtr(lds_cptr p){ return __builtin_bit_cast(s16x4,__builtin_amdgcn_ds_read_tr16_b64_v4i16((__attribute__((address_space(3))) v4i16_t*)p)); }
__device__ __forceinline__ float rowmax(const f32x16&p0,const f32x16&p1){
  float a=max3f(p0[0],p0[1],p1[0]),b=max3f(p0[2],p0[3],p1[1]);a=max3f(a,p1[2],p1[3]);
  #pragma unroll
  for(int r=4;r<16;r+=4){a=max3f(a,p0[r],p0[r+1]);b=max3f(b,p0[r+2],p0[r+3]);a=max3f(a,p1[r],p1[r+1]);b=max3f(b,p1[r+2],p1[r+3]);}
  const float m=max2f(a,b);
  auto rr=__builtin_amdgcn_permlane32_swap(__float_as_uint(m),__float_as_uint(m),false,false);
  return max2f(__uint_as_float(rr[0]),__uint_as_float(rr[1]));
}
__device__ __forceinline__ void pv(f32x16*o,int vb,bf16x8 pa0,bf16x8 pa1,bf16x8 pa2,bf16x8 pa3){
  #pragma unroll
  for(int d0=0;d0<2;++d0){s16x4 lo[4],hi[4];
    #pragma unroll
    for(int ks=0;ks<4;++ks){
      asm volatile("ds_read_b64_tr_b16 %0,%1 offset:%c2":"=&v"(lo[ks]):"v"(vb),"i"(d0*4096+ks*1024):"memory");
      asm volatile("ds_read_b64_tr_b16 %0,%1 offset:%c2":"=&v"(hi[ks]):"v"(vb),"i"(d0*4096+ks*1024+512):"memory");}
    asm volatile("s_waitcnt lgkmcnt(0)":::"memory");SBAR();
    #define PK(k) (bf16x8){lo[k][0],lo[k][1],lo[k][2],lo[k][3],hi[k][0],hi[k][1],hi[k][2],hi[k][3]}
    o[d0]=__builtin_amdgcn_mfma_f32_32x32x16_bf16(pa0,PK(0),o[d0],0,0,0);
    o[d0]=__builtin_amdgcn_mfma_f32_32x32x16_bf16(pa1,PK(1),o[d0],0,0,0);
    o[d0]=__builtin_amdgcn_mfma_f32_32x32x16_bf16(pa2,PK(2),o[d0],0,0,0);
    o[d0]=__builtin_amdgcn_mfma_f32_32x32x16_bf16(pa3,PK(3),o[d0],0,0,0);
    #undef PK
  }
}

#ifndef ATTN_STORE16
#define ATTN_STORE16(p,v) (*(u32x4*)(p)=(v))
#endif
template<int THRL> __device__ __forceinline__ void attn_unit(int b,int h,int qb,const bf16*Q,const bf16*__restrict__ K,const bf16*__restrict__ V,bf16*O,char*shm,int wv){
  const int tid=mktid(wv),lane=tid&63,r32=lane&31,hi=lane>>5;     const int wid=__builtin_amdgcn_readfirstlane(tid>>6);
  const long rowbase=(long)b*SEQ; const int q0=qb*QB;
  if(qb>3){ float*KMl=(float*)(shm+LDS_KM); float*KPl=(float*)(shm+LDS_KP); const int c8=tid&7, rl=tid>>3;
    for(int n=0;n<qb;++n){ float sm[8];
      #pragma unroll
      for(int d=0;d<8;++d)sm[d]=0.f;
      #pragma unroll
      for(int rr=0;rr<4;++rr){ const u32x4 w=*reinterpret_cast<const u32x4*>(K+(rowbase+n*256+rl+64*rr)*PK+h*D+8*c8);
        sm[0]+=__uint_as_float(w[0]<<16);sm[1]+=__uint_as_float(w[0]&0xffff0000u);sm[2]+=__uint_as_float(w[1]<<16);sm[3]+=__uint_as_float(w[1]&0xffff0000u);
        sm[4]+=__uint_as_float(w[2]<<16);sm[5]+=__uint_as_float(w[2]&0xffff0000u);sm[6]+=__uint_as_float(w[3]<<16);sm[7]+=__uint_as_float(w[3]&0xffff0000u); }
      #pragma unroll
      for(int d=0;d<8;++d){ float v=sm[d];
        v+=__builtin_bit_cast(float,__builtin_amdgcn_ds_swizzle(__builtin_bit_cast(int,v),0x201F));
        v+=__builtin_bit_cast(float,__builtin_amdgcn_ds_swizzle(__builtin_bit_cast(int,v),0x401F));
        { const unsigned u=__builtin_bit_cast(unsigned,v); auto rr2=__builtin_amdgcn_permlane32_swap(u,u,false,false); v=__uint_as_float((unsigned)rr2[0])+__uint_as_float((unsigned)rr2[1]); }
        sm[d]=v; }
      if(lane<8){
        #pragma unroll
        for(int d=0;d<8;++d)KPl[wid*64+8*lane+d]=sm[d]; }
      asm volatile("s_waitcnt vmcnt(0) lgkmcnt(0)\n\ts_barrier":::"memory");
      if(tid<64){ float s8=0.f;
        #pragma unroll
        for(int w8=0;w8<8;++w8)s8+=KPl[w8*64+tid];
        KMl[n*64+tid]=s8*(1.0f/256.0f); }
      asm volatile("s_waitcnt lgkmcnt(0)\n\ts_barrier":::"memory"); } }
  if(tid<QB){ unsigned sel=(qb<=3)?((1u<<qb)-1u):0u;
    if(qb>3){ const bf16*qp=Q+(rowbase+q0+tid)*PQ+h*D; const float*km=(const float*)(shm+LDS_KM); float gate[7];
      #pragma unroll
      for(int j=0;j<7;++j)gate[j]=0.f;
      #pragma unroll 1
      for(int i=0;i<8;++i){ const u32x4 w=*reinterpret_cast<const u32x4*>(qp+8*i); float qv[8];
        qv[0]=__uint_as_float(w[0]<<16);qv[1]=__uint_as_float(w[0]&0xffff0000u);qv[2]=__uint_as_float(w[1]<<16);qv[3]=__uint_as_float(w[1]&0xffff0000u);
        qv[4]=__uint_as_float(w[2]<<16);qv[5]=__uint_as_float(w[2]&0xffff0000u);qv[6]=__uint_as_float(w[3]<<16);qv[7]=__uint_as_float(w[3]&0xffff0000u);
        #pragma unroll
        for(int j=0;j<7;++j) if(j<qb){ const float*kp=km+j*64+8*i;
          #pragma unroll
          for(int d=0;d<8;++d)gate[j]+=qv[d]*kp[d]; } }
      #pragma unroll
      for(int rep=0;rep<3;++rep){ float best=-INFINITY; int bi=0;
        #pragma unroll
        for(int j=0;j<7;++j) if(j<qb&&!((sel>>j)&1u)&&gate[j]>best){best=gate[j];bi=j;}
        sel|=1u<<bi; } }
    ((unsigned char*)(shm+LDS_SEL))[tid]=(unsigned char)sel; }
  asm volatile("s_waitcnt vmcnt(0) lgkmcnt(0)\n\ts_barrier":::"memory");
  const bf16*Qw=Q+(rowbase+q0+wid*QBLK)*PQ+h*D;
  const bf16*Kh=K+rowbase*PK+h*D,*Vh=V+rowbase*PV+h*D;
  const unsigned lds0=(unsigned)(uintptr_t)shm;
  float*wsf=(float*)(shm+LDS_WS)+wid*64;
  const bf16*ksrc=Kh+(long)lane*PK+wid*8;
  const bf16*vsrc=Vh+(long)(16*(wid&3)+(lane>>2))*PV+(wid>>2)*32+(lane&3)*8;
  const unsigned kdst=lds0+LDS_K+wid*1024, vdst=lds0+LDS_V+wid*1024;
  #define TROW(t) ((long)(((t)<4)?(q0+(t)*KVBLK):(((t)-4)*KVBLK)))
  #define DMA_K(t,slot) glds16(ksrc+TROW(t)*PK,(unsigned)__builtin_amdgcn_readfirstlane(kdst+(slot)))
  #define DMA_V(t,slot) glds16(vsrc+TROW(t)*PV,(unsigned)__builtin_amdgcn_readfirstlane(vdst+(slot)))
  const int vb0=(int)(lds0+LDS_V)+((lane>>4)&1)*32+(lane&3)*8+(4*hi+((lane&15)>>2))*64;
  const char*Kbase=shm+LDS_K; bf16x8 kf[8];
  const lds_cptr shm3=(lds_cptr)shm; const lds_cptr kp0=shm3+LDS_K+hi*1024+r32*16; const lds_cptr vp0=shm3+LDS_V+((lane>>4)&1)*32+(lane&3)*8+(4*hi+((lane&15)>>2))*64;
  const int NT=(q0+QB)/KVBLK;
  DMA_K(0,0);DMA_V(0,0);DMA_K(1,SLOTB);
  bf16x8 qr[4];
  #pragma unroll
  for(int d0=0;d0<4;++d0)qr[d0]=*reinterpret_cast<const bf16x8*>(&Qw[(long)r32*PQ+d0*16+hi*8]);
  float mhat=0.f,l_reg=0.f;f32x16 o[2];o[0]=f32x16{};o[1]=f32x16{};
  const int qrel=wid*QBLK+r32;
  const unsigned selb=((const unsigned char*)(shm+LDS_SEL))[qrel];
  #define CMASK(P0,P1,t) cmask(P0,P1,(t),qrel,hi)
  #define SUBREF(C0,C1,t) do{ const float sb_=(((t)<4)||((selb>>(((t)-4)>>2))&1u))?mhat:INFINITY; _Pragma("unroll") for(int r_=0;r_<16;++r_){C0[r_]-=sb_;C1[r_]-=sb_;} }while(0)
  bool resc=false;
  #define START(P0,P1) do{ const float rm=rowmax(P0,P1); resc=false; \
    { const float dl=rm; mhat=fadd_s(mhat,dl); \
      _Pragma("unroll") for(int r=0;r<16;++r){P0[r]=fsub_s(P0[r],dl);P1[r]=fsub_s(P1[r],dl);} \
      } \
    _Pragma("unroll") for(int r=0;r<16;++r)P0[r]=__builtin_amdgcn_exp2f(P0[r]); }while(0)
  #define RESC() do{ if(resc){ asm volatile("s_waitcnt lgkmcnt(0)":::"memory"); \
      _Pragma("unroll") for(int d_=0;d_<2;++d_) _Pragma("unroll") for(int r=0;r<16;++r)o[d_][r]*=wsf[crow(r,hi)]; } }while(0)
  f32x16 pA0,pA1,pB0,pB1;
  int sl_prev=0,sl_cur=0,sl_next=SLOTB;
  #define ROT() do{sl_prev=sl_cur;sl_cur=sl_next;sl_next=(sl_next==(NSLOT-1)*SLOTB)?0:sl_next+SLOTB;}while(0)
  DMA_K(2,2*SLOTB);
  WAIT_BAR(3);
  qkt(pA0,pA1,Kbase,qr,f32x16{},r32,hi);asm volatile("s_nop 15\n\ts_nop 7":"+v"(pA0),"+v"(pA1));CMASK(pA0,pA1,0);
  START(pA0,pA1);
  _Pragma("unroll") for(int r=0;r<16;++r)pA1[r]=__builtin_amdgcn_exp2f(pA1[r]);
  WAIT_BAR(0);
  DMA_K(3,0);DMA_V(1,SLOTB);
  ROT();
  kload8(kf,kp0+sl_cur);
  WAIT_BAR(2);
  s16x4 vlo[8],vhi[8]; u32x4 pw0,pw1,pw2,pw3;
  #define PKW(P,B) cvtpk_s(P[B],P[B+1])
  #define PAF(k) __builtin_bit_cast(bf16x8,pw##k)
  #define VFR(i) (bf16x8){vlo[i][0],vlo[i][1],vlo[i][2],vlo[i][3],vhi[i][0],vhi[i][1],vhi[i][2],vhi[i][3]}
  #define PIN(x) asm volatile("":"+v"(x))
  #define MX3(a,b,c) __builtin_fmaxf(__builtin_fmaxf((a),(b)),(c))
  #define GAPA(MF,A0,A1,A2,A3,W0,W1,PW) do{ MF; sacc+=A0; sacc+=A1; sacc+=A2; sacc+=A3; PIN(sacc); W0; W1; PIN(PW); SBAR(); }while(0)
  #define EX(v) __builtin_amdgcn_exp2f(v)
  #define GAPB(MF,X,B) do{ MF; X[B]=EX(X[B]); X[B+1]=EX(X[B+1]); X[B+2]=EX(X[B+2]); X[B+3]=EX(X[B+3]); PIN(X); SBAR(); }while(0)
  #define VRD(i) do{ vlo[i]=vtr(vp_+(((i)>>2)*4096+((i)&3)*1024)); vhi[i]=vtr(vp_+(((i)>>2)*4096+((i)&3)*1024+512)); }while(0)
  #define KRD(G,j) do{ if(G){ kload2(kf,kp0+sl_next,j); SBAR(); } }while(0)
  #define STEP(C0,C1,P0,P1,t,GK,GV,GL,MB) do{ SBAR(); \
    const lds_cptr vp_=vp0+sl_prev; \
    VRD(0); SBAR(); float sacc=(P0[0]+P0[1]); \
    GAPA(C0=__builtin_amdgcn_mfma_f32_32x32x16_bf16(kf[0],qr[0],f32x16{},0,0,0), P0[2],P0[3],P0[4],P0[5],     pw0[0]=PKW(P0,0), pw0[1]=PKW(P0,2), pw0); \
    VRD(4); SBAR(); GAPA(C1=__builtin_amdgcn_mfma_f32_32x32x16_bf16(kf[1],qr[0],f32x16{},0,0,0), P0[6],P0[7],P0[8],P0[9],     pw0[2]=PKW(P0,4), pw0[3]=PKW(P0,6), pw0); \
    VRD(1); SBAR(); GAPA(C0=__builtin_amdgcn_mfma_f32_32x32x16_bf16(kf[2],qr[1],C0,0,0,0),   P0[10],P0[11],P0[12],P0[13], pw1[0]=PKW(P0,8), pw1[1]=PKW(P0,10), pw1); \
    VRD(5); SBAR(); GAPA(C1=__builtin_amdgcn_mfma_f32_32x32x16_bf16(kf[3],qr[1],C1,0,0,0),   P0[14],P0[15],P1[0],P1[1],   pw1[2]=PKW(P0,12),pw1[3]=PKW(P0,14), pw1); \
    VRD(2); SBAR(); GAPA(C0=__builtin_amdgcn_mfma_f32_32x32x16_bf16(kf[4],qr[2],C0,0,0,0),   P1[2],P1[3],P1[4],P1[5],     pw2[0]=PKW(P1,0), pw2[1]=PKW(P1,2), pw2); \
    VRD(6); SBAR(); GAPA(C1=__builtin_amdgcn_mfma_f32_32x32x16_bf16(kf[5],qr[2],C1,0,0,0),   P1[6],P1[7],P1[8],P1[9],     pw2[2]=PKW(P1,4), pw2[3]=PKW(P1,6), pw2); \
    VRD(3); SBAR(); GAPA(C0=__builtin_amdgcn_mfma_f32_32x32x16_bf16(kf[6],qr[3],C0,0,0,0),   P1[10],P1[11],P1[12],P1[13], pw3[0]=PKW(P1,8), pw3[1]=PKW(P1,10), pw3); \
    VRD(7); SBAR(); GAPA(C1=__builtin_amdgcn_mfma_f32_32x32x16_bf16(kf[7],qr[3],C1,0,0,0),   P1[14],P1[15],0.f,0.f,       pw3[2]=PKW(P1,12),pw3[3]=PKW(P1,14), pw3); \
    l_reg+=sacc; \
    if(GK){DMA_K((t)+3,sl_cur);} if(GV){DMA_V((t)+1,sl_next);} \
    SUBREF(C0,C1,t); if(MB){CMASK(C0,C1,t);} \
    { float a=MX3(C0[0],C0[1],C1[0]),b=MX3(C0[2],C0[3],C1[1]); a=MX3(a,C1[2],C1[3]); \
      _Pragma("unroll") for(int r=4;r<16;r+=4){a=MX3(a,C0[r],C0[r+1]);b=MX3(b,C0[r+2],C0[r+3]);a=MX3(a,C1[r],C1[r+1]);b=MX3(b,C1[r+2],C1[r+3]);} \
      float rm=__builtin_fmaxf(a,b); { auto rr=__builtin_amdgcn_permlane32_swap(__float_as_uint(rm),__float_as_uint(rm),false,false); rm=__builtin_fmaxf(__uint_as_float(rr[0]),__uint_as_float(rr[1])); } \
      resc=false; \
      if(__builtin_expect(__any(rm>(float)THRL),0)){ const float dl=__builtin_fmaxf(rm,0.f); mhat+=dl; \
        _Pragma("unroll") for(int r=0;r<16;++r){C0[r]-=dl;C1[r]-=dl;} \
        const float f=__builtin_amdgcn_exp2f(-dl); l_reg*=f; if(hi==0)wsf[r32]=f; resc=true; } } \
    SBAR(); \
    GAPB(o[0]=__builtin_amdgcn_mfma_f32_32x32x16_bf16(PAF(0),VFR(0),o[0],0,0,0), C0,0); \
    GAPB(o[1]=__builtin_amdgcn_mfma_f32_32x32x16_bf16(PAF(0),VFR(4),o[1],0,0,0), C0,4); \
    KRD(GL,0); GAPB(o[0]=__builtin_amdgcn_mfma_f32_32x32x16_bf16(PAF(1),VFR(1),o[0],0,0,0), C0,8); \
    KRD(GL,1); GAPB(o[1]=__builtin_amdgcn_mfma_f32_32x32x16_bf16(PAF(1),VFR(5),o[1],0,0,0), C0,12); \
    KRD(GL,2); GAPB(o[0]=__builtin_amdgcn_mfma_f32_32x32x16_bf16(PAF(2),VFR(2),o[0],0,0,0), C1,0); \
    KRD(GL,3); GAPB(o[1]=__builtin_amdgcn_mfma_f32_32x32x16_bf16(PAF(2),VFR(6),o[1],0,0,0), C1,4); \
    GAPB(o[0]=__builtin_amdgcn_mfma_f32_32x32x16_bf16(PAF(3),VFR(3),o[0],0,0,0), C1,8); \
    GAPB(o[1]=__builtin_amdgcn_mfma_f32_32x32x16_bf16(PAF(3),VFR(7),o[1],0,0,0), C1,12); \
    }while(0)
  #define ENDW(tt) do{ if((tt)+3<NT){WAIT_BAR(2);} else if((tt)+2<NT){WAIT_BAR(1);} else {WAIT_BAR(0);} }while(0)
  { int t=1;
    for(;t+1<NT;t+=2){
      STEP(pB0,pB1,pA0,pA1,t,(t+3<NT),(t+1<NT),(t+1<NT),(t<4));       ENDW(t);   RESC(); ROT();
      STEP(pA0,pA1,pB0,pB1,t+1,(t+4<NT),(t+2<NT),(t+2<NT),(t+1<4));     ENDW(t+1); RESC(); ROT();
    }
    STEP(pB0,pB1,pA0,pA1,NT-1,false,false,false,(NT==4)); RESC();
  }
  { float sacc=pB0[0]+pB0[1]; _Pragma("unroll") for(int r=2;r<16;++r)sacc+=pB0[r]; _Pragma("unroll") for(int r=0;r<16;++r)sacc+=pB1[r]; l_reg+=sacc;
    pw0=(u32x4){PKW(pB0,0),PKW(pB0,2),PKW(pB0,4),PKW(pB0,6)};pw1=(u32x4){PKW(pB0,8),PKW(pB0,10),PKW(pB0,12),PKW(pB0,14)};pw2=(u32x4){PKW(pB1,0),PKW(pB1,2),PKW(pB1,4),PKW(pB1,6)};pw3=(u32x4){PKW(pB1,8),PKW(pB1,10),PKW(pB1,12),PKW(pB1,14)};
    SBAR(); pv(o,vb0+sl_cur,PAF(0),PAF(1),PAF(2),PAF(3)); }
  #undef PKW
  #undef PAF
  #undef VFR
  #undef PIN
  #undef MX3
  #undef GAPA
  #undef GAPB
  #undef EX
  #undef VRD
  #undef KRD
  #undef STEP
  #undef ENDW
  {auto rr=__builtin_amdgcn_permlane32_swap(__float_as_uint(l_reg),__float_as_uint(l_reg),false,false);l_reg=__uint_as_float(rr[0])+__uint_as_float(rr[1]);}
  if(hi==0)wsf[32+r32]=l_reg;asm volatile("s_waitcnt lgkmcnt(0)":::"memory");
  float rli[16];
  #pragma unroll
  for(int r=0;r<16;++r)rli[r]=__builtin_amdgcn_rcpf(wsf[32+crow(r,hi)]);
  bf16*Ow=O+(rowbase+q0+wid*QBLK)*PO+h*D;
  { bf16*stg=(bf16*)(shm+LDS_OST)+wid*2048;
    #pragma unroll
    for(int r=0;r<16;++r){const int orow=crow(r,hi);
      #pragma unroll
      for(int d0=0;d0<2;++d0)stg[orow*64+d0*32+r32]=__float2bfloat16(o[d0][r]*rli[r]);}
    asm volatile("s_waitcnt lgkmcnt(0)":::"memory");
    #pragma unroll
    for(int i=0;i<4;++i){const int row=i*8+(lane>>3),ch=lane&7; const u32x4 v=*(const u32x4*)(stg+row*64+ch*8); ATTN_STORE16(Ow+(long)row*PO+ch*8,v);} }
  asm volatile("s_waitcnt lgkmcnt(0)\n\ts_barrier":::"memory");
  #undef DMA_K
  #undef TROW
  #undef SUBREF
  #undef DMA_V
  #undef CMASK
  #undef START
  #undef RESC
  #undef ROT
}
constexpr int ATTN_LDS_BYTES=LDS_BYTES;
#undef SBAR
#undef WAIT_BAR
}
constexpr int DM = 1024, NB = 16, SEQ = 2048, NT = NB * SEQ;
constexpr int RWW = 512, WIN_N = 5376, INC = 4352, ZV = 1792, ZG = 2304;
constexpr int NEXP = 32, DEXP = 512;
constexpr int XS_ROWS = 2 * NT + NEXP * 256;
constexpr float C2 = 0.125f * 1.4426950408889634f;

#define LAS __attribute__((address_space(3)))
#define GAS __attribute__((address_space(1)))
typedef unsigned short bf16;
typedef unsigned v4u __attribute__((ext_vector_type(4)));
typedef unsigned v2u __attribute__((ext_vector_type(2)));
typedef float f32x4 __attribute__((ext_vector_type(4)));

typedef float f32x2_c __attribute__((ext_vector_type(2))); typedef __bf16 bf16x2_c __attribute__((ext_vector_type(2)));
__device__ __forceinline__ unsigned pk2(float lo, float hi) { const f32x2_c v = {lo, hi}; return __builtin_bit_cast(unsigned, __builtin_convertvector(v, bf16x2_c)); }
__device__ __forceinline__ unsigned f2bf(float f) { return pk2(f, f) & 0xffffu; }
__device__ __forceinline__ float bflo(unsigned w) { return __builtin_bit_cast(float, w << 16); }
__device__ __forceinline__ float bfhi(unsigned w) { return __builtin_bit_cast(float, w & 0xffff0000u); }
__device__ __forceinline__ float sigm(float x) { return __builtin_amdgcn_rcpf(1.0f + __expf(-x)); }

constexpr size_t MiB = 1u << 20;
constexpr size_t WS_CTL = 0;
constexpr size_t WS_MOD = 1 * MiB;
constexpr size_t WS_GM2 = 1 * MiB + 512 * 1024;
constexpr size_t WS_CB = 1 * MiB + 640 * 1024;
constexpr size_t WS_COS = 2 * MiB;
constexpr size_t WS_SIN = 2 * MiB + 512 * 1024;
constexpr size_t WS_KMEAN = 3 * MiB;
constexpr size_t WS_WRH = 3 * MiB + 512 * 1024;
constexpr size_t WS_WRL = 3 * MiB + 768 * 1024;
constexpr size_t WS_SEL = 4 * MiB;
constexpr size_t WS_RTE = 5 * MiB;
constexpr size_t WS_RTW = 5 * MiB + 256 * 1024;
constexpr size_t WS_RNK = 5 * MiB + 512 * 1024;
constexpr size_t WS_POS = 5 * MiB + 768 * 1024;
constexpr size_t WS_RSTD = 7 * MiB;
constexpr size_t WS_WLT = 6 * MiB;
constexpr size_t WS_WAT = 6 * MiB + 64 * 1024;
constexpr size_t WS_WGT = 6 * MiB + 128 * 1024;
constexpr size_t WS_WIN = 16 * MiB;
constexpr size_t WS_WBA = 27 * MiB;
constexpr size_t WS_WBB = 28 * MiB;
constexpr size_t WS_WOUT = 29 * MiB;
constexpr size_t WS_Z = 32 * MiB;
constexpr size_t WS_H = 368 * MiB;
constexpr size_t WS_Q = 304 * MiB, WS_K = 336 * MiB, WS_MRG = 304 * MiB;
constexpr size_t WS_YA = 432 * MiB, WS_YB = 464 * MiB;
constexpr size_t WS_WUP = 368 * MiB;
constexpr size_t WS_H2 = 128 * MiB;
constexpr size_t WS_XS = 64 * MiB;
constexpr size_t WS_HID = 208 * MiB;
constexpr size_t WS_X1B = 432 * MiB;
constexpr size_t WS_ACT = 496 * MiB;
constexpr size_t WS_END = 512 * MiB;
constexpr int CW_CNT = 64, CNT_PAD = 64;
constexpr int CW_NT = 2304;
constexpr int CW_TEXP = 2368;
static_assert(CW_CNT + NEXP * CNT_PAD <= CW_NT, "control words");

__device__ __forceinline__ void tr_item(const float* W, int K, int N, bf16* WT, int kb, int nb, int dst_row0, LAS float* scr, int lane) {
    const int k0 = 64 * kb, n0 = 32 * nb;
#pragma unroll
    for (int i = 0; i < 32; ++i) { const int kk = 2 * i + (lane >> 5); scr[kk * 33 + (lane & 31)] = W[(size_t)(k0 + kk) * N + n0 + (lane & 31)]; }
    asm volatile("s_waitcnt lgkmcnt(0)" ::: "memory");
    const int c = lane & 7;
#pragma unroll
    for (int j = 0; j < 4; ++j) { const int n = (lane >> 3) + 8 * j; const LAS float* s = scr + (8 * c) * 33 + n;
        v4u o; o.x = pk2(s[0 * 33], s[1 * 33]); o.y = pk2(s[2 * 33], s[3 * 33]); o.z = pk2(s[4 * 33], s[5 * 33]); o.w = pk2(s[6 * 33], s[7 * 33]);
        *(v4u*)(WT + (size_t)(dst_row0 + n) * K + k0 + 8 * c) = o; }
    asm volatile("s_waitcnt lgkmcnt(0)" ::: "memory");
}

struct PArgs { const float* in[30]; float* out; unsigned char* ws; };

__device__ __forceinline__ void p_prep_weights(const PArgs& a, unsigned char* lds, int wv) {
    const int tid = mktid(wv), lane = tid & 63, wave = tid >> 6;
    LAS float* scr = (LAS float*)lds + wave * (64 * 33);
    const int gw = blockIdx.x * 8 + wave, NGW = gridDim.x * 8;
    unsigned char* ws = a.ws;
    constexpr int I_IN = 16 * 168, I_BR = 8 * 32, I_OUT = 16 * 32;
    for (int it = gw; it < I_IN + 2 * I_BR + I_OUT; it += NGW) {
        int r = it;
        if (r < I_IN) { const int kb = r / 168, nb = r % 168; int dst = 32 * nb;
            if (dst >= 1792 && dst < 2816) { const int rel = dst - 1792, u = rel >> 8, hl = (rel & 255) >> 6, half = (rel & 63) >> 5; dst = 1792 + u * 256 + half * 128 + hl * 32; }
            tr_item(a.in[6], 1024, WIN_N, (bf16*)(ws + WS_WIN), kb, nb, dst, scr, lane); continue; } r -= I_IN;
        if (r < I_BR) { const int kb = r / 32, nb = r % 32; tr_item(a.in[20], 512, 1024, (bf16*)(ws + WS_WBA), kb, nb, 32 * nb, scr, lane); continue; } r -= I_BR;
        if (r < I_BR) { const int kb = r / 32, nb = r % 32; tr_item(a.in[21], 512, 1024, (bf16*)(ws + WS_WBB), kb, nb, 32 * nb, scr, lane); continue; } r -= I_BR;
        { const int kb = r / 32, nb = r % 32; tr_item(a.in[22], 1024, 1024, (bf16*)(ws + WS_WOUT), kb, nb, 32 * nb, scr, lane); }
    }
    const int gt = blockIdx.x * 512 + tid, NGT = gridDim.x * 512;
    float* cosT = (float*)(ws + WS_COS); float* sinT = (float*)(ws + WS_SIN);
    for (int i = gt; i < SEQ * 32; i += NGT) { const int s = i >> 5, f = i & 31; const float inv = powf(10000.0f, -(float)f / 32.0f); const float ang = (float)s * inv; cosT[i] = cosf(ang); sinT[i] = sinf(ang); }
    { bf16* wlt = (bf16*)(ws + WS_WLT); bf16* wat = (bf16*)(ws + WS_WAT); bf16* wgt = (bf16*)(ws + WS_WGT);
      for (int i = gt; i < 8 * 64 * 64; i += NGT) { const int hh = i >> 12, j = (i >> 6) & 63, m = i & 63; wlt[i] = (bf16)f2bf(a.in[9][m * 512 + hh * 64 + j]); wat[i] = (bf16)f2bf(a.in[11][m * 512 + hh * 64 + j]); }
      for (int i = gt; i < 8 * 64 * 128; i += NGT) { const int hh = i >> 13, j = (i >> 7) & 63, m = i & 127; wgt[i] = (bf16)f2bf(a.in[12][m * 512 + hh * 64 + j]); } }
    { bf16* wrh = (bf16*)(ws + WS_WRH); bf16* wrl = (bf16*)(ws + WS_WRL);
      for (int i = gt; i < 48 * 1024; i += NGT) { const int e = i >> 10, k = i & 1023; const float w = e < 4 ? a.in[23][k * 4 + e] : e < 36 ? a.in[25][k * 32 + (e - 4)] : 0.f;
          const unsigned hi = f2bf(w); wrh[i] = (bf16)hi; wrl[i] = (bf16)f2bf(w - bflo(hi)); } }
}

constexpr int CW_ZCNT = 3136, CW_AQ = 3200;
constexpr int CW_BAR = 4096, XB_TMO_W = 128, DOWN_MSK_OFF = 160 * 1024 - 256 + 64;
constexpr int CW_TCNT = 8192, TCNT_STRIDE = 16;
constexpr int CW_PEXP = 2816;
__device__ __forceinline__ void p_prep_experts_dyn(const PArgs& a, unsigned char* lds, int wv) {
    const int tid = mktid(wv), lane = tid & 63, wave = tid >> 6;
    LAS float* scr = (LAS float*)lds + wave * (64 * 33);
    unsigned* ctr = (unsigned*)(a.ws + WS_CTL) + CW_PEXP;
    constexpr int NITEM = NEXP * 768;
    for (;;) {
        unsigned base = 0; if (lane == 0) base = atomicAdd(ctr, 16u);
        base = (unsigned)__builtin_amdgcn_readfirstlane((int)base);
        if (base >= (unsigned)NITEM) break;
        for (int it = (int)base; it < (int)base + 16 && it < NITEM; ++it) {
            const int e = it / 768; int r = it % 768;
            bf16* wup = (bf16*)(a.ws + WS_WUP) + (size_t)e * 1024 * 1024;
            if (r < 256) { const int kb = r / 16, nb = r % 16, n0 = 32 * nb; tr_item(a.in[27] + (size_t)e * 1024 * 512, 1024, 512, wup, kb, nb, (n0 >> 7) * 256 + (n0 & 127), scr, lane); continue; } r -= 256;
            if (r < 256) { const int kb = r / 16, nb = r % 16, n0 = 32 * nb; tr_item(a.in[28] + (size_t)e * 1024 * 512, 1024, 512, wup, kb, nb, (n0 >> 7) * 256 + 128 + (n0 & 127), scr, lane); continue; } r -= 256;
            { const int kb = r / 32, nb = r % 32; tr_item(a.in[29] + (size_t)e * 512 * 1024, 512, 1024, (bf16*)a.out + (size_t)e * 1024 * 512, kb, nb, 32 * nb, scr, lane); }
        }
    }
}

__device__ __forceinline__ void p_ada_load(const PArgs& a, int tile, int tid, float (&wr)[64]) {
    const float* w = a.in[2] + (size_t)((tid >> 5) * 64) * 6144 + tile * 32 + (tid & 31);
#pragma unroll
    for (int i = 0; i < 64; ++i) wr[i] = w[(size_t)i * 6144];
}
__device__ __forceinline__ void p_ada_finish(const PArgs& a, const float* sc, float* red, int tile, int tid, const float (&wr)[64]) {
    const float* bias = a.in[3]; float* mod = (float*)(a.ws + WS_MOD);
    const int col = tid & 31, kg = tid >> 5;
    float acc[16];
#pragma unroll
    for (int b = 0; b < 16; ++b) acc[b] = 0.f;
#pragma unroll
    for (int b = 0; b < 16; ++b)
#pragma unroll
        for (int i4 = 0; i4 < 16; ++i4) { const f32x4 c4 = *(const f32x4*)(sc + b * 1024 + kg * 64 + 4 * i4);
            acc[b] += c4.x * wr[4 * i4]; acc[b] += c4.y * wr[4 * i4 + 1]; acc[b] += c4.z * wr[4 * i4 + 2]; acc[b] += c4.w * wr[4 * i4 + 3]; }
#pragma unroll
    for (int b = 0; b < 16; ++b) red[(kg * 16 + b) * 32 + col] = acc[b];
    __syncthreads();
    { const int b = tid >> 5, cc = tid & 31; float sm = 0.f;
#pragma unroll
        for (int k = 0; k < 16; ++k) sm += red[(k * 16 + b) * 32 + cc];
        mod[b * 6144 + tile * 32 + cc] = sm + bias[tile * 32 + cc]; }
    __syncthreads();
}

__device__ __forceinline__ void p_norm1(const PArgs& a, unsigned char* lds, int wv) {
    const int tid = mktid(wv), lane = tid & 63, gw = blockIdx.x * 8 + (tid >> 6), NGW = gridDim.x * 8;
    const float* x = a.in[0]; const float* g = a.in[4]; const float* mod = (const float*)(a.ws + WS_MOD);
    bf16* h = (bf16*)(a.ws + WS_H);
    f32x4 v[4][4];
    { const f32x4* xr = (const f32x4*)(x + (size_t)(4 * gw < NT ? 4 * gw : 0) * DM) + lane;
#pragma unroll
      for (int r = 0; r < 4; ++r)
#pragma unroll
          for (int j = 0; j < 4; ++j) v[r][j] = xr[256 * r + 64 * j]; }
    for (int m0 = 4 * gw; m0 < NT; m0 += 4 * NGW) {
        const int mn = m0 + 4 * NGW < NT ? m0 + 4 * NGW : m0;
        f32x4 nv[4][4];
        { const f32x4* xr = (const f32x4*)(x + (size_t)mn * DM) + lane;
#pragma unroll
          for (int r = 0; r < 4; ++r)
#pragma unroll
              for (int j = 0; j < 4; ++j) nv[r][j] = xr[256 * r + 64 * j]; }
        const int b = m0 >> 11; float rstd[4];
#pragma unroll
        for (int r = 0; r < 4; ++r) { float s = 0.f;
#pragma unroll
            for (int j = 0; j < 4; ++j) s += (v[r][j].x * v[r][j].x + v[r][j].y * v[r][j].y) + (v[r][j].z * v[r][j].z + v[r][j].w * v[r][j].w);
            rstd[r] = rsqrtf(wave_sum(s) * (1.0f / DM) + 1e-6f); }
#pragma unroll
        for (int j = 0; j < 4; ++j) { const int col = 4 * (lane + 64 * j);
            const f32x4 gg = *(const f32x4*)(g + col), sh = *(const f32x4*)(mod + b * 6144 + col), scl = *(const f32x4*)(mod + b * 6144 + 1024 + col);
#pragma unroll
            for (int r = 0; r < 4; ++r) { const f32x4 q = v[r][j] * rstd[r] * gg * (scl + 1.0f) + sh; v2u w; w.x = pk2(q.x, q.y); w.y = pk2(q.z, q.w); ((v2u*)(h + (size_t)(m0 + r) * DM) + lane)[64 * j] = w; } }
#pragma unroll
        for (int r = 0; r < 4; ++r)
#pragma unroll
            for (int j = 0; j < 4; ++j) v[r][j] = nv[r][j];
    }
    { float* gm2 = (float*)(a.ws + WS_GM2); float* cb = (float*)(a.ws + WS_CB); const float* g2 = a.in[5];
      for (int i = blockIdx.x * 512 + tid; i < 16 * 1024; i += gridDim.x * 512) { const int b = i >> 10, k = i & 1023; gm2[i] = g2[k] * (1.0f + mod[b * 6144 + 4096 + k]); }
      for (int p = blockIdx.x + gridDim.x * (tid >> 6); p < 16 * 48; p += NGW) {    const int b = p / 48, n = p % 48; float s = 0.f;
          if (n < 36) { for (int k = lane; k < 1024; k += 64) { const float w = n < 4 ? a.in[23][k * 4 + n] : a.in[25][k * 32 + (n - 4)]; s += mod[b * 6144 + 3072 + k] * w; } }
          s = wave_sum(s); if (lane == 0) cb[p] = n < 4 ? s + a.in[24][n] : n < 36 ? s + a.in[26][n - 4] : 0.f; } }
}

using pg8::Unit; using pg8::HALF; using pg8::BM; using pg8::cvt_pk_bf16;
typedef pg8::f32x4 pf4; typedef pg8::u32x4 pu4;

struct EpiStoreBf16 {
    static constexpr bool PERM = true, AFTER_DRAIN = false, CHAIN = false;
    bf16* O; int ldc;
    __device__ __forceinline__ void operator()(const pf4 (&acc)[2][2][4][2], const Unit& u, int wr, int wc, int fr, int fq) const {
        const int row0 = u.pm * BM + wr * 64 + fr, col0 = u.pn * BM + wc * 32 + 8 * fq;
#pragma unroll
        for (int ai = 0; ai < 2; ++ai)
#pragma unroll
            for (int m = 0; m < 4; ++m) { bf16* rowp = O + (size_t)(row0 + ai * HALF + m * 16) * ldc + col0;
#pragma unroll
                for (int bj = 0; bj < 2; ++bj) { const pf4 v0 = acc[ai][bj][m][0], v1 = acc[ai][bj][m][1]; pu4 w;
                    w.x = cvt_pk_bf16(v0[0], v0[1]); w.y = cvt_pk_bf16(v0[2], v0[3]); w.z = cvt_pk_bf16(v1[0], v1[1]); w.w = cvt_pk_bf16(v1[2], v1[3]);
                    *(pu4*)(rowp + bj * HALF) = w; } }
    }
};
struct EpiZ {
    static constexpr bool PERM = true, AFTER_DRAIN = false, CHAIN = false;
    bf16* z; bf16* Q; bf16* K; const float* qg; const float* kg; const float* cosT; const float* sinT; unsigned* zcnt;
    __device__ __forceinline__ void operator()(const pf4 (&acc)[2][2][4][2], const Unit& u, int wr, int wc, int fr, int fq) const {
        const int row0 = u.pm * BM + wr * 64 + fr;
        if (u.pn == 6) {
            const __amdgpu_buffer_rsrc_t zr = __builtin_amdgcn_make_buffer_rsrc((void*)z, 0, NT * INC * 2, 0x00020000);
            const int zc = 6 * 256 + wc * 32 + 8 * fq;
#pragma unroll
            for (int ai = 0; ai < 2; ++ai)
#pragma unroll
                for (int m = 0; m < 4; ++m) { const unsigned rowb = (unsigned)(((row0 + ai * HALF + m * 16) * INC + zc) * 2);
#pragma unroll
                    for (int bj = 0; bj < 2; ++bj) { const pf4 v0 = acc[ai][bj][m][0], v1 = acc[ai][bj][m][1]; pu4 w;
                        w.x = cvt_pk_bf16(v0[0], v0[1]); w.y = cvt_pk_bf16(v0[2], v0[3]); w.z = cvt_pk_bf16(v1[0], v1[1]); w.w = cvt_pk_bf16(v1[2], v1[3]);
                        __builtin_amdgcn_raw_buffer_store_b128(w, zr, rowb + (unsigned)(bj * HALF * 2), 0,   16); } }
            asm volatile("s_waitcnt vmcnt(0)" ::: "memory");
            if (fr == 0 && fq == 0) (void)__hip_atomic_fetch_add(zcnt, 1u, __ATOMIC_RELAXED, __HIP_MEMORY_SCOPE_AGENT);
            return;
        }
        if (u.pn < 7 || u.pn >= 11) {
            const int zc = (u.pn < 7 ? u.pn * 256 : (u.pn - 11) * 256 + 1792) + wc * 32 + 8 * fq;
#pragma unroll
            for (int ai = 0; ai < 2; ++ai)
#pragma unroll
                for (int m = 0; m < 4; ++m) { bf16* rowp = z + (size_t)(row0 + ai * HALF + m * 16) * INC + zc;
#pragma unroll
                    for (int bj = 0; bj < 2; ++bj) { const pf4 v0 = acc[ai][bj][m][0], v1 = acc[ai][bj][m][1]; pu4 w;
                        w.x = cvt_pk_bf16(v0[0], v0[1]); w.y = cvt_pk_bf16(v0[2], v0[3]); w.z = cvt_pk_bf16(v1[0], v1[1]); w.w = cvt_pk_bf16(v1[2], v1[3]);
                        *(pu4*)(rowp + bj * HALF) = w; } }
            return;
        }
        const bool isk = u.pn >= 9; const int head = 4 * ((u.pn - 7) & 1) + wc; const float* g = isk ? kg : qg; bf16* O = (isk ? K : Q) + head * 64 + 8 * fq;
        const float osc = isk ? 1.0f : C2;
        pf4 gl[2][2];
#pragma unroll
        for (int bj = 0; bj < 2; ++bj)
#pragma unroll
            for (int n = 0; n < 2; ++n) gl[bj][n] = *(const pf4*)(g + 32 * bj + 8 * fq + 4 * n);
#pragma unroll
        for (int aim = 0; aim < 4; ++aim) { const int ai = aim >> 1, m0 = 2 * (aim & 1);
            pf4 ct[2][2], st[2][2];
#pragma unroll
            for (int mm = 0; mm < 2; ++mm) { const int s = (row0 + ai * HALF + (m0 + mm) * 16) & (SEQ - 1);
#pragma unroll
                for (int n = 0; n < 2; ++n) { ct[mm][n] = *(const pf4*)(cosT + s * 32 + 8 * fq + 4 * n); st[mm][n] = *(const pf4*)(sinT + s * 32 + 8 * fq + 4 * n); } }
#pragma unroll
            for (int mm = 0; mm < 2; ++mm) { const int m = m0 + mm; const int row = row0 + ai * HALF + m * 16;
                float ss = 0.f;
#pragma unroll
                for (int bj = 0; bj < 2; ++bj)
#pragma unroll
                    for (int n = 0; n < 2; ++n) { const pf4 v = acc[ai][bj][m][n]; ss += (v[0] * v[0] + v[1] * v[1]) + (v[2] * v[2] + v[3] * v[3]); }
                ss += __builtin_bit_cast(float, __builtin_amdgcn_ds_swizzle(__builtin_bit_cast(int, ss), 0x401F));
                { const unsigned uu = __builtin_bit_cast(unsigned, ss); auto rr = __builtin_amdgcn_permlane32_swap(uu, uu, false, false); ss = __builtin_bit_cast(float, (unsigned)rr[0]) + __builtin_bit_cast(float, (unsigned)rr[1]); }
                const float rstd = rsqrtf(ss * (1.0f / 64.0f) + 1e-6f);
#pragma unroll
                for (int n = 0; n < 2; ++n) { const pf4 x1 = acc[ai][0][m][n] * rstd * gl[0][n], x2 = acc[ai][1][m][n] * rstd * gl[1][n];
                    const pf4 o1 = x1 * ct[mm][n] - x2 * st[mm][n], o2 = x2 * ct[mm][n] + x1 * st[mm][n];
                    v2u wa, wb; wa.x = cvt_pk_bf16(o1[0] * osc, o1[1] * osc); wa.y = cvt_pk_bf16(o1[2] * osc, o1[3] * osc); wb.x = cvt_pk_bf16(o2[0] * osc, o2[1] * osc); wb.y = cvt_pk_bf16(o2[2] * osc, o2[3] * osc);
                    bf16* op = O + (size_t)row * 512 + 4 * n; *(v2u*)op = wa; *(v2u*)(op + 32) = wb; } }
            asm volatile("" ::: "memory");
        }
    }
};
struct EpiMerge {
    static constexpr bool PERM = true, AFTER_DRAIN = false, CHAIN = true;
    const bf16* z; bf16* mrg;
    __device__ __forceinline__ bool chain(pf4 (&acc)[2][2][4][2], const Unit& u, int wr, int wc, int fr, int fq) const {
        const int row0 = u.pm * BM + wr * 64 + fr, col0 = u.pn * BM + wc * 32 + 8 * fq;
        if (u.aux == 0) {
#pragma unroll
            for (int ai = 0; ai < 2; ++ai) {
                pu4 za[4][2], zb[4][2];
#pragma unroll
                for (int m = 0; m < 4; ++m) { const size_t row = (size_t)(row0 + ai * HALF + m * 16);
#pragma unroll
                    for (int bj = 0; bj < 2; ++bj) { const int col = col0 + bj * HALF; za[m][bj] = *(const pu4*)(z + row * INC + ZG + col); zb[m][bj] = *(const pu4*)(z + row * INC + ZG + 1024 + col); } }
#pragma unroll
                for (int m = 0; m < 4; ++m)
#pragma unroll
                    for (int bj = 0; bj < 2; ++bj) { const pu4 a4 = za[m][bj], b4 = zb[m][bj];
                        const float a8[8] = {bflo(a4.x), bfhi(a4.x), bflo(a4.y), bfhi(a4.y), bflo(a4.z), bfhi(a4.z), bflo(a4.w), bfhi(a4.w)};
                        const float b8[8] = {bflo(b4.x), bfhi(b4.x), bflo(b4.y), bfhi(b4.y), bflo(b4.z), bfhi(b4.z), bflo(b4.w), bfhi(b4.w)};
#pragma unroll
                        for (int e = 0; e < 8; ++e) acc[ai][bj][m][e >> 2][e & 3] *= (1.0f + __expf(-b8[e])) * __builtin_amdgcn_rcpf(1.0f + __expf(-a8[e])); }
                asm volatile("" ::: "memory");
            }
            return true;
        }
        pu4 gz[2][4][2];
#pragma unroll
        for (int ai = 0; ai < 2; ++ai)
#pragma unroll
            for (int m = 0; m < 4; ++m) { const size_t row = (size_t)(row0 + ai * HALF + m * 16);
#pragma unroll
                for (int bj = 0; bj < 2; ++bj) gz[ai][m][bj] = *(const pu4*)(z + row * INC + ZG + 1024 + col0 + bj * HALF); }
#pragma unroll
        for (int ai = 0; ai < 2; ++ai)
#pragma unroll
            for (int m = 0; m < 4; ++m) { const size_t row = (size_t)(row0 + ai * HALF + m * 16);
#pragma unroll
                for (int bj = 0; bj < 2; ++bj) { const int col = col0 + bj * HALF; const pu4 g4 = gz[ai][m][bj]; const pf4 v0 = acc[ai][bj][m][0], v1 = acc[ai][bj][m][1];
                    pu4 w;
                    w.x = cvt_pk_bf16(sigm(bflo(g4.x)) * v0[0], sigm(bfhi(g4.x)) * v0[1]); w.y = cvt_pk_bf16(sigm(bflo(g4.y)) * v0[2], sigm(bfhi(g4.y)) * v0[3]);
                    w.z = cvt_pk_bf16(sigm(bflo(g4.z)) * v1[0], sigm(bfhi(g4.z)) * v1[1]); w.w = cvt_pk_bf16(sigm(bflo(g4.w)) * v1[2], sigm(bfhi(g4.w)) * v1[3]);
                    *(pu4*)(mrg + row * DM + col) = w; } }
        return false;
    }
};
struct EpiOut {
    static constexpr bool PERM = true, AFTER_DRAIN = false, CHAIN = false;
    const float* x; const float* mod; bf16* x1;
    __device__ __forceinline__ void operator()(const pf4 (&acc)[2][2][4][2], const Unit& u, int wr, int wc, int fr, int fq) const {
        const int row0 = u.pm * BM + wr * 64 + fr, col0 = u.pn * BM + wc * 32 + 8 * fq; const int b = u.pm >> 3;
        pf4 gt[2][2];
#pragma unroll
        for (int bj = 0; bj < 2; ++bj)
#pragma unroll
            for (int n = 0; n < 2; ++n) gt[bj][n] = *(const pf4*)(mod + b * 6144 + 2048 + col0 + bj * HALF + n * 4);
#pragma unroll
        for (int ai = 0; ai < 2; ++ai) {
            pf4 xv[4][2][2];
#pragma unroll
            for (int m = 0; m < 4; ++m) { const size_t off = (size_t)(row0 + ai * HALF + m * 16) * DM + col0;
#pragma unroll
                for (int bj = 0; bj < 2; ++bj) { xv[m][bj][0] = *(const pf4*)(x + off + bj * HALF); xv[m][bj][1] = *(const pf4*)(x + off + bj * HALF + 4); } }
#pragma unroll
            for (int m = 0; m < 4; ++m) { const size_t off = (size_t)(row0 + ai * HALF + m * 16) * DM + col0;
#pragma unroll
                for (int bj = 0; bj < 2; ++bj) { const pf4 o0 = xv[m][bj][0] + gt[bj][0] * acc[ai][bj][m][0], o1 = xv[m][bj][1] + gt[bj][1] * acc[ai][bj][m][1]; pu4 w;
                    w.x = cvt_pk_bf16(o0[0], o0[1]); w.y = cvt_pk_bf16(o0[2], o0[3]); w.z = cvt_pk_bf16(o1[0], o1[1]); w.w = cvt_pk_bf16(o1[2], o1[3]);
                    *(pu4*)(x1 + off + bj * HALF) = w; } }
            asm volatile("" ::: "memory");
        }
    }
};
struct EpiUp {
    static constexpr bool PERM = true, AFTER_DRAIN = false, CHAIN = false;
    bf16* hid; unsigned* tcnt;
    __device__ __forceinline__ void operator()(const pf4 (&acc)[2][2][4][2], const Unit& u, int wr, int wc, int fr, int fq) const {
        const int row0 = u.pm * BM + wr * 64 + fr, col0 = u.pn * 128 + wc * 32 + 8 * fq;
        const __amdgpu_buffer_rsrc_t hr = __builtin_amdgcn_make_buffer_rsrc((void*)hid, 0, 96 << 20, 0x00020000);
#pragma unroll
        for (int ai = 0; ai < 2; ++ai)
#pragma unroll
            for (int m = 0; m < 4; ++m) { const int row = row0 + ai * HALF + m * 16; float o[8];
#pragma unroll
                for (int n = 0; n < 2; ++n)
#pragma unroll
                    for (int e = 0; e < 4; ++e) { const float g = acc[ai][0][m][n][e], l = acc[ai][1][m][n][e]; o[4 * n + e] = g * sigm(g) * l; }
                pu4 w; w.x = cvt_pk_bf16(o[0], o[1]); w.y = cvt_pk_bf16(o[2], o[3]); w.z = cvt_pk_bf16(o[4], o[5]); w.w = cvt_pk_bf16(o[6], o[7]);
                __builtin_amdgcn_raw_buffer_store_b128(w, hr, (unsigned)((row * DEXP + col0) * 2), 0,   16); }
        asm volatile("s_waitcnt vmcnt(0)" ::: "memory");
        if (fr == 0 && fq == 0) (void)__hip_atomic_fetch_add(tcnt + TCNT_STRIDE * u.pm, 1u, __ATOMIC_RELAXED, __HIP_MEMORY_SCOPE_AGENT);
    }
};

struct GemmArgs { unsigned char* ws; const float* x; float* out; const float* qg; const float* kg; };
template <class Epi> __device__ __forceinline__ void run_dense(const void* A, const void* Bt, int M, int N, int K, const Epi& E, unsigned char* lds, int wv) {
    pg8::Gemm g{K}; pg8::StaticOrder S; S.init(A, Bt, M, N, K, (int)gridDim.x, (int)blockIdx.x);
    pg8::gemm_phase<Epi, pg8::StaticOrder, true, true>((PG8_LAS unsigned char*)lds, g, S, E, wv);
}
__device__ __forceinline__ void p_gemm_in(const GemmArgs& a, unsigned char* lds, int wv) {
    EpiZ E{(bf16*)(a.ws + WS_Z), (bf16*)(a.ws + WS_Q), (bf16*)(a.ws + WS_K), a.qg, a.kg, (const float*)(a.ws + WS_COS), (const float*)(a.ws + WS_SIN), (unsigned*)(a.ws + WS_CTL) + CW_ZCNT};
    run_dense(a.ws + WS_H, a.ws + WS_WIN, NT, WIN_N, 1024, E, lds, wv);
}
struct PairOrder {
    int nM, nN, nwg, G, c; const char *A0, *A1, *B0, *B1; size_t tstep;
    __device__ bool next(int i, Unit& u) const {
        const long L = (long)(i >> 1) * G + c; if (L >= nwg) return false;
        int wgid = (int)L; { const int q = nwg / pg8::NXCD, r = nwg % pg8::NXCD, xcd = wgid % pg8::NXCD, off = wgid / pg8::NXCD; wgid = (xcd < r ? xcd * (q + 1) : r * (q + 1) + (xcd - r) * q) + off; }
        const int nig = pg8::WGM * nN, gid = wgid / nig, fm = gid * pg8::WGM, gsz = (nM - fm) < pg8::WGM ? (nM - fm) : pg8::WGM;
        u.pm = fm + ((wgid % nig) % gsz); u.pn = (wgid % nig) / gsz; u.aux = i & 1;
        u.a = ((i & 1) ? A1 : A0) + (size_t)u.pm * tstep; u.b = ((i & 1) ? B1 : B0) + (size_t)u.pn * tstep; return true;
    }
    __device__ __forceinline__ void a_ready(const Unit&) const {}
    __device__ __forceinline__ void done(const Unit&) const {}
};
__device__ __forceinline__ void p_gemm_merge(const GemmArgs& a, unsigned char* lds, int wv) {
    PairOrder S{NT / 256, 4, (NT / 256) * 4, (int)gridDim.x, (int)blockIdx.x, (const char*)(a.ws + WS_YA), (const char*)(a.ws + WS_YB), (const char*)(a.ws + WS_WBA), (const char*)(a.ws + WS_WBB), (size_t)256 * 512 * 2};
    EpiMerge E{(const bf16*)(a.ws + WS_Z), (bf16*)(a.ws + WS_MRG)}; pg8::Gemm g{512};
    pg8::gemm_phase<EpiMerge, PairOrder, true, true>((PG8_LAS unsigned char*)lds, g, S, E, wv);
}
__device__ __forceinline__ void p_gemm_out(const GemmArgs& a, unsigned char* lds, int wv) {
    EpiOut E{a.x, (const float*)(a.ws + WS_MOD), (bf16*)(a.ws + WS_X1B)};
    run_dense(a.ws + WS_MRG, a.ws + WS_WOUT, NT, 1024, 1024, E, lds, wv);
}
struct GroupedOrder {
    const int* texp; int nT, nN, G, c; const char* A; size_t a_tile; const char* B; size_t b_exp, b_tile;
    __device__ bool next(int i, Unit& u) const {
        const long L = (long)i * G + c; if (L >= (long)nT * nN) return false;
        const int tile = (int)(L / nN), pn = (int)(L % nN); u.aux = 0; u.pm = tile; u.pn = pn; u.a = A + (size_t)tile * a_tile; u.b = B + (size_t)texp[tile] * b_exp + (size_t)pn * b_tile; return true;
    }
    __device__ __forceinline__ void a_ready(const Unit&) const {}
    __device__ __forceinline__ void done(const Unit&) const {}
};
__device__ __forceinline__ void p_gemm_up(const GemmArgs& a, unsigned char* lds, int wv) {
    const int* ctl = (const int*)(a.ws + WS_CTL);
    GroupedOrder S{ctl + CW_TEXP, ctl[CW_NT], 4, (int)gridDim.x, (int)blockIdx.x, (const char*)(a.ws + WS_XS), (size_t)256 * 1024 * 2, (const char*)(a.ws + WS_WUP), (size_t)1024 * 1024 * 2, (size_t)256 * 1024 * 2};
    EpiUp E{(bf16*)(a.ws + WS_HID), (unsigned*)(a.ws + WS_CTL) + CW_TCNT}; pg8::Gemm g{1024};
    pg8::gemm_phase<EpiUp, GroupedOrder, true, true>((PG8_LAS unsigned char*)lds, g, S, E, wv);
}
struct CountedGroupedOrder : GroupedOrder {
    unsigned* tcnt; unsigned* tmo; volatile LAS unsigned* msk; int wv;
    __device__ __forceinline__ long unit_of(int i) const { const long U = (long)nT * nN; const int nB = (int)(U % G);
        return c < nB ? (long)(i + 2) * G - 2 * nB + c : i == 0 ? (long)(c - nB) : (long)i * G - nB + (c - nB); }
    __device__ bool next(int i, Unit& u) const {
        const long L = unit_of(i); if (L >= (long)nT * nN) return false;
        const int tile = (int)(L / nN), pn = (int)(L % nN); u.aux = i; u.pm = tile; u.pn = pn; u.a = A + (size_t)tile * a_tile; u.b = B + (size_t)texp[tile] * b_exp + (size_t)pn * b_tile; return true; }
    __device__ __forceinline__ void wait_tile(int tile) const {
        unsigned sp = 0;
        while (__hip_atomic_load(tcnt + TCNT_STRIDE * tile, __ATOMIC_RELAXED, __HIP_MEMORY_SCOPE_AGENT) < 32u) { __builtin_amdgcn_s_sleep(1);
            if ((++sp & 255u) == 0u) { if (__hip_atomic_load(tmo, __ATOMIC_RELAXED, __HIP_MEMORY_SCOPE_AGENT)) break; if (sp > (1u << 22)) { atomicAdd(tmo, 1u); break; } } }
    }
    __device__ __forceinline__ void a_ready(const Unit& u) const {
        const int i = u.aux;
        if (i > 0) { const unsigned m = msk[0]; if ((m >> i) & 1u) return; }
        if (wv == 0) {
            unsigned m = 0u;
            if (i == 0) {
#pragma unroll 1
                for (int j = 1; j < 32; ++j) { const long L = unit_of(j); if (L >= (long)nT * nN) break;
                    if (__hip_atomic_load(tcnt + TCNT_STRIDE * (int)(L / nN), __ATOMIC_RELAXED, __HIP_MEMORY_SCOPE_AGENT) >= 32u) m |= 1u << j; } }
            wait_tile(u.pm);
            __builtin_amdgcn_fence(__ATOMIC_ACQUIRE, "agent");
            asm volatile("s_waitcnt vmcnt(0)" ::: "memory");
            if (i == 0 && mktid(wv) == 0) msk[0] = m;
            asm volatile("s_waitcnt lgkmcnt(0)" ::: "memory");
        }
        asm volatile("" ::: "memory"); __builtin_amdgcn_s_barrier(); asm volatile("" ::: "memory");
    }
};
__device__ __forceinline__ void p_gemm_down(const GemmArgs& a, unsigned char* lds, int wv) {
    const int* ctl = (const int*)(a.ws + WS_CTL);
    CountedGroupedOrder S{{ctl + CW_TEXP, ctl[CW_NT], 4, (int)gridDim.x, (int)blockIdx.x, (const char*)(a.ws + WS_HID), (size_t)256 * 512 * 2, (const char*)a.out, (size_t)1024 * 512 * 2, (size_t)256 * 512 * 2},
                          (unsigned*)(a.ws + WS_CTL) + CW_TCNT, (unsigned*)(a.ws + WS_CTL) + CW_BAR + XB_TMO_W, (volatile LAS unsigned*)((LAS unsigned char*)lds + DOWN_MSK_OFF), wv};
    EpiStoreBf16 E{(bf16*)(a.ws + WS_XS), 1024}; pg8::Gemm g{512};
    pg8::gemm_phase<EpiStoreBf16, CountedGroupedOrder, true, true>((PG8_LAS unsigned char*)lds, g, S, E, wv);
}

__device__ __forceinline__ void p_attn(const PArgs& a, unsigned char* lds, int vb, int nvb, int wv) {
    const attn_body::bf16* Q = (const attn_body::bf16*)(a.ws + WS_Q); const attn_body::bf16* K = (const attn_body::bf16*)(a.ws + WS_K);
    const attn_body::bf16* V = (const attn_body::bf16*)(a.ws + WS_Z) + ZV; attn_body::bf16* O = (attn_body::bf16*)(a.ws + WS_YB);
    for (int p = vb; p < 512; p += nvb)
        for (int which = 0; which < 2; ++which) { const int bh = p >> 2, s = p & 3, qb = which ? 7 - s : s;
            attn_body::attn_unit<8>(bh >> 3, bh & 7, qb, Q, K, V, O, (char*)lds, wv); }
}

__device__ __forceinline__ void p_actprep(const PArgs& a, unsigned char* lds, int wv) {
    const int tid = mktid(wv); const bf16* z = (const bf16*)(a.ws + WS_Z); bf16* act = (bf16*)(a.ws + WS_ACT); const float* mu = a.in[7];
    for (int i = blockIdx.x * 512 + tid; i < NT * 32; i += gridDim.x * 512) { const int t = i >> 5, cg = i & 31, col = 1536 + 8 * cg; const bool hasp = (t & (SEQ - 1)) > 0;
        const v4u cw = *(const v4u*)(z + (size_t)t * INC + col); v4u pw = {0u, 0u, 0u, 0u}; if (hasp) pw = *(const v4u*)(z + (size_t)(t - 1) * INC + col);
        const float c8[8] = {bflo(cw.x), bfhi(cw.x), bflo(cw.y), bfhi(cw.y), bflo(cw.z), bfhi(cw.z), bflo(cw.w), bfhi(cw.w)}, p8[8] = {bflo(pw.x), bfhi(pw.x), bflo(pw.y), bfhi(pw.y), bflo(pw.z), bfhi(pw.z), bflo(pw.w), bfhi(pw.w)};
        const f32x4 m0 = *(const f32x4*)(mu + col), m1 = *(const f32x4*)(mu + col + 4); const float m8[8] = {m0.x, m0.y, m0.z, m0.w, m1.x, m1.y, m1.z, m1.w}; float v[8];
#pragma unroll
        for (int e = 0; e < 8; ++e) { const float x = c8[e] + (p8[e] - c8[e]) * m8[e]; v[e] = cg < 8 ? 1.0f - 2.0f * __builtin_amdgcn_rcpf(1.0f + __expf(2.0f * x)) : cg < 16 ? x : sigm(x); }
        v4u w; w.x = pk2(v[0], v[1]); w.y = pk2(v[2], v[3]); w.z = pk2(v[4], v[5]); w.w = pk2(v[6], v[7]);
        *(v4u*)(act + (size_t)t * 256 + 8 * cg) = w; }
}

namespace rw {
typedef short bf16x8 __attribute__((ext_vector_type(8)));
constexpr int MB = 8192;
__device__ __forceinline__ int SW(int r, int c) { return r * 128 + ((((c >> 3) ^ (r >> 1)) & 7) << 4) + (c & 7) * 2; }
__device__ __forceinline__ int SWG(int r, int c) { return r * 256 + ((((c >> 3) ^ r) & 15) << 4) + (c & 7) * 2; }
__device__ __forceinline__ int SWF(int r, int c) { return r * 256 + ((((c >> 2) ^ r) & 15) << 4) + (c & 3) * 4; }
enum { I_AT = 0, I_BT, I_AJ, I_BHJ, I_KHJ, I_ABRT, I_X5, I_L, I_LT, I_R0, I_R1, I_KT, I_RT, I_VJ, I_X14, I_GATE, I_VT, I_VT2, NBUF };
constexpr int OFF_F32 = NBUF * MB;
constexpr int OFF_CST = OFF_F32 + (64 * 3 + 512) * 4;
constexpr int LDS_NEED = OFF_CST + 14 * 64 * 4;

__device__ __forceinline__ bf16x8 ldfrag(const unsigned char* M, int row, int k) { return *(const bf16x8*)(M + SW(row, k)); }
__device__ __forceinline__ void mm(f32x4 (&acc)[2], const unsigned char* X, const unsigned char* Y, int mt, int nh, int fr, int fq) {
    const bf16x8 a0 = ldfrag(X, 16 * mt + fr, 8 * fq), a1 = ldfrag(X, 16 * mt + fr, 8 * fq + 32);
#pragma unroll
    for (int nt = 0; nt < 2; ++nt) { const bf16x8 b0 = ldfrag(Y, 16 * (2 * nh + nt) + fr, 8 * fq), b1 = ldfrag(Y, 16 * (2 * nh + nt) + fr, 8 * fq + 32);
        acc[nt] = __builtin_amdgcn_mfma_f32_16x16x32_bf16(a0, b0, acc[nt], 0, 0, 0); acc[nt] = __builtin_amdgcn_mfma_f32_16x16x32_bf16(a1, b1, acc[nt], 0, 0, 0); }
}
typedef short s16x4 __attribute__((ext_vector_type(4)));
typedef __attribute__((address_space(3))) s16x4* lds_s16x4p;
__device__ __forceinline__ bf16x8 ldfragT(const unsigned char* M, int row0, int kb, int fr, int fq) {
    const int k0 = kb + 8 * fq + (fr >> 2), c0 = row0 + 4 * (fr & 3);
    const s16x4 lo = __builtin_amdgcn_ds_read_tr16_b64_v4i16((lds_s16x4p)(M + SW(k0, c0))), hi = __builtin_amdgcn_ds_read_tr16_b64_v4i16((lds_s16x4p)(M + SW(k0 + 4, c0)));
    return (bf16x8){lo[0], lo[1], lo[2], lo[3], hi[0], hi[1], hi[2], hi[3]};
}
struct FA { bf16x8 k0, k1; };
struct FB { bf16x8 k0[2], k1[2]; };
__device__ __forceinline__ FA ldA(const unsigned char* X, int mt, int fr, int fq) { FA f; f.k0 = ldfrag(X, 16 * mt + fr, 8 * fq); f.k1 = ldfrag(X, 16 * mt + fr, 8 * fq + 32); return f; }
__device__ __forceinline__ FB ldB(const unsigned char* Y, int nh, int fr, int fq) { FB f;
#pragma unroll
    for (int nt = 0; nt < 2; ++nt) { f.k0[nt] = ldfrag(Y, 16 * (2 * nh + nt) + fr, 8 * fq); f.k1[nt] = ldfrag(Y, 16 * (2 * nh + nt) + fr, 8 * fq + 32); }
    return f; }
__device__ __forceinline__ FA ldAT(const unsigned char* XT, int mt, int fr, int fq) { FA f; f.k0 = ldfragT(XT, 16 * mt, 0, fr, fq); f.k1 = ldfragT(XT, 16 * mt, 32, fr, fq); return f; }
__device__ __forceinline__ FB ldBT(const unsigned char* YT, int nh, int fr, int fq) { FB f;
#pragma unroll
    for (int nt = 0; nt < 2; ++nt) { f.k0[nt] = ldfragT(YT, 16 * (2 * nh + nt), 0, fr, fq); f.k1[nt] = ldfragT(YT, 16 * (2 * nh + nt), 32, fr, fq); }
    return f; }
__device__ __forceinline__ void mma(f32x4 (&acc)[2], const FA& a, const FB& b) {
    acc[0] = __builtin_amdgcn_mfma_f32_16x16x32_bf16(a.k0, b.k0[0], acc[0], 0, 0, 0); acc[1] = __builtin_amdgcn_mfma_f32_16x16x32_bf16(a.k0, b.k0[1], acc[1], 0, 0, 0);
    acc[0] = __builtin_amdgcn_mfma_f32_16x16x32_bf16(a.k1, b.k1[0], acc[0], 0, 0, 0); acc[1] = __builtin_amdgcn_mfma_f32_16x16x32_bf16(a.k1, b.k1[1], acc[1], 0, 0, 0);
}
__device__ __forceinline__ void ldC(f32x4 (&acc)[2], const unsigned char* Z, int mt, int nh, int fr, int fq) {
#pragma unroll
    for (int nt = 0; nt < 2; ++nt) { const v2u w = *(const v2u*)(Z + SW(16 * (2 * nh + nt) + fr, 16 * mt + 4 * fq)); acc[nt] = (f32x4){bflo(w.x), bfhi(w.x), bflo(w.y), bfhi(w.y)}; }
}
__device__ __forceinline__ void storeT(unsigned char* Z, const f32x4 (&acc)[2], int mt, int nh, int fr, int fq) {
#pragma unroll
    for (int nt = 0; nt < 2; ++nt) { v2u w; w.x = pk2(acc[nt][0], acc[nt][1]); w.y = pk2(acc[nt][2], acc[nt][3]); *(v2u*)(Z + SW(16 * (2 * nh + nt) + fr, 16 * mt + 4 * fq)) = w; }
}
__device__ __forceinline__ void storeN(unsigned char* Z, const f32x4 (&acc)[2], int mt, int nh, int fr, int fq) {
#pragma unroll
    for (int nt = 0; nt < 2; ++nt)
#pragma unroll
        for (int r = 0; r < 4; ++r) *(unsigned short*)(Z + SW(16 * mt + 4 * fq + r, 16 * (2 * nh + nt) + fr)) = (unsigned short)f2bf(acc[nt][r]);
}
__device__ __forceinline__ void ld8bf(const unsigned char* p, float (&v)[8]) { const v4u w = *(const v4u*)p; v[0] = bflo(w.x); v[1] = bfhi(w.x); v[2] = bflo(w.y); v[3] = bfhi(w.y); v[4] = bflo(w.z); v[5] = bfhi(w.z); v[6] = bflo(w.w); v[7] = bfhi(w.w); }
__device__ __forceinline__ void st8bf(unsigned char* p, const float (&v)[8]) { v4u w; w.x = pk2(v[0], v[1]); w.y = pk2(v[2], v[3]); w.z = pk2(v[4], v[5]); w.w = pk2(v[6], v[7]); *(v4u*)p = w; }
__device__ __forceinline__ void ld8f(const float* p, float (&v)[8]) { const f32x4 a = *(const f32x4*)p, b = *(const f32x4*)(p + 4); v[0] = a.x; v[1] = a.y; v[2] = a.z; v[3] = a.w; v[4] = b.x; v[5] = b.y; v[6] = b.z; v[7] = b.w; }
__device__ __forceinline__ void ld8fs(const unsigned char* M, int r, int c, float (&v)[8]) { const f32x4 a = *(const f32x4*)(M + SWF(r, c)), b = *(const f32x4*)(M + SWF(r, c + 4)); v[0] = a.x; v[1] = a.y; v[2] = a.z; v[3] = a.w; v[4] = b.x; v[5] = b.y; v[6] = b.z; v[7] = b.w; }
__device__ __forceinline__ void un8(const v4u w, float (&v)[8]) { v[0] = bflo(w.x); v[1] = bfhi(w.x); v[2] = bflo(w.y); v[3] = bfhi(w.y); v[4] = bflo(w.z); v[5] = bfhi(w.z); v[6] = bflo(w.w); v[7] = bfhi(w.w); }
__device__ __forceinline__ void shift8(const v4u cw, const v4u pw, bool hasp, const float* mu, float (&v)[8]) {
    float c[8], p[8], m[8]; un8(cw, c); un8(pw, p); ld8f(mu, m);
#pragma unroll
    for (int e = 0; e < 8; ++e) { const float pe = hasp ? p[e] : 0.f; v[e] = c[e] + (pe - c[e]) * m[e]; }
}
__device__ __forceinline__ float tanh_fast(float x) { return 1.0f - 2.0f * __builtin_amdgcn_rcpf(1.0f + __expf(2.0f * x)); }

#define LBAR() do { asm volatile("s_waitcnt lgkmcnt(0)" ::: "memory"); __builtin_amdgcn_s_barrier(); asm volatile("" ::: "memory"); } while (0)
__device__ __forceinline__ void scan_unit(const PArgs& a, unsigned char* lds, int bh, int wv) {
    const int tid = mktid(wv), lane = tid & 63, wid = __builtin_amdgcn_readfirstlane(tid >> 6);
    const int mt = wid >> 1, nh = wid & 1; int fr = lane & 15, fq = lane >> 4;
    const int b = bh >> 3, h = bh & 7;
#define BUF(i) (lds + (i) * MB)
    float* GC = (float*)(lds + OFF_F32); float* BON = GC + 64; float* SSQ = BON + 64; float* SEGT = SSQ + 64;
    unsigned char* LWR = BUF(I_AT); unsigned char* LAR = BUF(I_AJ); unsigned char* LGR = BUF(I_KHJ); unsigned char* YTF = BUF(I_KHJ);
    unsigned char* ACTW = BUF(I_L); unsigned char* ACTA = BUF(I_LT); unsigned char* ACTG = BUF(I_R0);
    const bf16* z = (const bf16*)(a.ws + WS_Z); bf16* ya = (bf16*)(a.ws + WS_YA);
    const float* mu = a.in[7];
    bf16x8 fw[2], fa[2], fg[4];
    { const bf16* wlt = (const bf16*)(a.ws + WS_WLT) + (size_t)h * 4096 + (16 * mt + fr) * 64 + 8 * fq; const bf16* wat = (const bf16*)(a.ws + WS_WAT) + (size_t)h * 4096 + (16 * mt + fr) * 64 + 8 * fq;
      const bf16* wgt = (const bf16*)(a.ws + WS_WGT) + (size_t)h * 8192 + (16 * mt + fr) * 128 + 8 * fq;
      fw[0] = *(const bf16x8*)wlt; fw[1] = *(const bf16x8*)(wlt + 32); fa[0] = *(const bf16x8*)wat; fa[1] = *(const bf16x8*)(wat + 32);
#pragma unroll
      for (int ks = 0; ks < 4; ++ks) fg[ks] = *(const bf16x8*)(wgt + 32 * ks); }
    float* CST = (float*)(lds + OFF_CST);
    for (int i = tid; i < 14 * 64; i += 512) { const int blk = i >> 6, jj = i & 63; float v;
        if (blk < 3) v = mu[blk * 512 + h * 64 + jj]; else if (blk < 7) v = mu[1536 + (blk - 3) * 64 + jj]; else v = a.in[blk == 7 ? 8 : blk == 8 ? 10 : blk == 9 ? 13 : blk == 10 ? 14 : blk == 11 ? 15 : blk == 12 ? 16 : 17][h * 64 + jj];
        CST[i] = v; }
    int s0i = I_X14, aki = I_X5;
    for (int i = tid; i < MB / 4; i += 512) ((unsigned*)BUF(I_X14))[i] = 0u;
    LBAR();
    int pt = tid >> 3, j0 = 8 * (tid & 7);
    const int colh = h * 64 + j0;
    const int zoff0 = colh, zoff1 = 512 + colh, zoff2 = 1024 + colh;
    const bf16* actb = (const bf16*)(a.ws + WS_ACT);
    v4u zc[3], zq[3], za[4];
#define ZLOAD(cc) do { const size_t tr_ = (size_t)b * SEQ + (cc) * 64 + pt; const bf16* zr_ = z + tr_ * INC; const bf16* zs_ = ((cc) * 64 + pt) > 0 ? zr_ - INC : zr_; const bf16* ar_ = actb + tr_ * 256 + j0; \
        zc[0] = *(const v4u*)(zr_ + zoff0); zc[1] = *(const v4u*)(zr_ + zoff1); zc[2] = *(const v4u*)(zr_ + zoff2); \
        zq[0] = *(const v4u*)(zs_ + zoff0); zq[1] = *(const v4u*)(zs_ + zoff1); zq[2] = *(const v4u*)(zs_ + zoff2); \
        za[0] = *(const v4u*)(ar_); za[1] = *(const v4u*)(ar_ + 64); za[2] = *(const v4u*)(ar_ + 128); za[3] = *(const v4u*)(ar_ + 192); } while (0)
#define ESTAGE(VTB, TT_) \
        { float y[8], vv[8], g8[8], lg[8], lb[8]; ld8fs(YTF, pt, j0, y); ld8bf((VTB) + SW(pt, j0), vv); ld8bf(BUF(I_GATE) + SW(pt, j0), g8); \
          ld8f(CST + 12 * 64 + j0, lg); ld8f(CST + 13 * 64 + j0, lb); \
          float sm = 0.f; \
_Pragma("unroll") \
          for (int e = 0; e < 8; ++e) sm += y[e]; \
          const float mean = red8(sm) * (1.0f / 64.0f); float sq = 0.f; \
_Pragma("unroll") \
          for (int e = 0; e < 8; ++e) { y[e] -= mean; sq += y[e] * y[e]; } \
          const float rstd = rsqrtf(red8(sq) * (1.0f / 64.0f) + 64e-5f), bon = BON[pt]; \
_Pragma("unroll") \
          for (int e = 0; e < 8; ++e) y[e] = (y[e] * rstd * lg[e] + lb[e] + bon * vv[e]) * g8[e]; \
          ypend.x = pk2(y[0], y[1]); ypend.y = pk2(y[2], y[3]); ypend.z = pk2(y[4], y[5]); ypend.w = pk2(y[6], y[7]); ypoff = (TT_) * RWW + colh; }
    ZLOAD(0);
    v4u ypend = {0u, 0u, 0u, 0u}; size_t ypoff = 0;
    for (int c = 0; c < SEQ / 64; ++c) {
        asm volatile("" : "+v"(fr), "+v"(fq), "+v"(pt), "+v"(j0));
        const int s = c * 64 + pt; const size_t t = (size_t)b * SEQ + s; const bool hasp = s > 0;
        if (c > 0) { ESTAGE(((c - 1) & 1) ? BUF(I_VT2) : BUF(I_VT), t - 64) }
        { float v[8];
          shift8(zc[0], zq[0], hasp, CST + 0 * 64 + j0, v); st8bf(BUF(I_RT) + SW(pt, j0), v);
          shift8(zc[1], zq[1], hasp, CST + 1 * 64 + j0, v); st8bf(BUF(I_KT) + SW(pt, j0), v);
          { float kkc[8], ss = 0.f; ld8f(CST + 9 * 64 + j0, kkc);
#pragma unroll
            for (int e = 0; e < 8; ++e) { const float q = v[e] * kkc[e]; ss += q * q; }
            ss = red8(ss); if (j0 == 0) SSQ[pt] = rsqrtf(fmaxf(ss, 1e-24f)); }
          shift8(zc[2], zq[2], hasp, CST + 2 * 64 + j0, v); st8bf(((c & 1) ? BUF(I_VT2) : BUF(I_VT)) + SW(pt, j0), v);
          *(v4u*)(ACTW + SW(pt, j0)) = za[0]; *(v4u*)(ACTA + SW(pt, j0)) = za[1]; *(v4u*)(ACTG + SWG(pt, j0)) = za[2]; *(v4u*)(ACTG + SWG(pt, 64 + j0)) = za[3]; }
        LBAR();
        f32x4 aw[2], aa[2], ag[2];
#pragma unroll
        for (int nt = 0; nt < 2; ++nt) { const int tr = 16 * (2 * nh + nt) + fr; const f32x4 zero = {0.f, 0.f, 0.f, 0.f};
            aw[nt] = __builtin_amdgcn_mfma_f32_16x16x32_bf16(fw[0], ldfrag(ACTW, tr, 8 * fq), zero, 0, 0, 0); aw[nt] = __builtin_amdgcn_mfma_f32_16x16x32_bf16(fw[1], ldfrag(ACTW, tr, 8 * fq + 32), aw[nt], 0, 0, 0);
            aa[nt] = __builtin_amdgcn_mfma_f32_16x16x32_bf16(fa[0], ldfrag(ACTA, tr, 8 * fq), zero, 0, 0, 0); aa[nt] = __builtin_amdgcn_mfma_f32_16x16x32_bf16(fa[1], ldfrag(ACTA, tr, 8 * fq + 32), aa[nt], 0, 0, 0);
            ag[nt] = zero;
#pragma unroll
            for (int ks = 0; ks < 4; ++ks) ag[nt] = __builtin_amdgcn_mfma_f32_16x16x32_bf16(fg[ks], *(const bf16x8*)(ACTG + SWG(tr, 8 * fq + 32 * ks)), ag[nt], 0, 0, 0); }
#pragma unroll
        for (int nt = 0; nt < 2; ++nt) { const int tr = 16 * (2 * nh + nt) + fr, jc = 16 * mt + 4 * fq;
            *(f32x4*)(LWR + SWF(tr, jc)) = aw[nt]; *(f32x4*)(LAR + SWF(tr, jc)) = aa[nt]; *(f32x4*)(LGR + SWF(tr, jc)) = ag[nt]; }
        LBAR();
        float lwv[8], an[8], bb[8], k2[8], rr[8], gg[8], vv8[8], p8[8];
        { const int j = lane, tw = wid;
          const float w0c = CST[7 * 64 + j], a0c = CST[8 * 64 + j], kkc = CST[9 * 64 + j], kac = CST[10 * 64 + j], rkc = CST[11 * 64 + j];
          const unsigned char* vtb = (c & 1) ? BUF(I_VT2) : BUF(I_VT);
          float bo[8], av[8];
#pragma unroll
          for (int u = 0; u < 8; ++u) { const int t8 = 8 * tw + u;
              const float lw = *(const float*)(LWR + SWF(t8, j)), la = *(const float*)(LAR + SWF(t8, j)); gg[u] = *(const float*)(LGR + SWF(t8, j));
              rr[u] = bflo(*(const unsigned short*)(BUF(I_RT) + SW(t8, j))); const float kx = bflo(*(const unsigned short*)(BUF(I_KT) + SW(t8, j))); vv8[u] = bflo(*(const unsigned short*)(vtb + SW(t8, j)));
              lwv[u] = -0.606531f * sigm(w0c + lw); av[u] = sigm(a0c + la);
              const float kn = kx * kkc * SSQ[t8]; an[u] = -kn; bb[u] = kn * av[u];
              k2[u] = kx * (1.0f + (av[u] - 1.0f) * kac); bo[u] = rr[u] * k2[u] * rkc; }
          wave_sum8(bo);
          if (j == 0) {
#pragma unroll
              for (int u = 0; u < 8; ++u) BON[8 * tw + u] = bo[u]; }
          p8[0] = lwv[0];
#pragma unroll
          for (int u = 1; u < 8; ++u) p8[u] = p8[u - 1] + lwv[u];
          SEGT[tw * 64 + j] = p8[7]; }
        LBAR();
        { const int j = lane, tw = wid; float sg8[8];
#pragma unroll
          for (int s2 = 0; s2 < 8; ++s2) sg8[s2] = SEGT[s2 * 64 + j];
          float base = 0.f, tot = 0.f;
#pragma unroll
          for (int s2 = 0; s2 < 8; ++s2) { tot += sg8[s2]; base += (s2 < tw) ? sg8[s2] : 0.f; }
          const float gcj = __expf(tot); if (tw == 7) GC[j] = gcj;
          float eprev = __expf(base);
          float o0[8], o1[8], o2[8], o3[8], ob[8], ok[8];
#pragma unroll
          for (int u = 0; u < 8; ++u) { const float L = p8[u] + base; const float e1 = __expf(L), ie1 = __builtin_amdgcn_rcpf(e1), ep = eprev, eh = gcj * ie1; eprev = e1;
              o0[u] = an[u] * ep; o1[u] = bb[u] * ie1; o2[u] = k2[u] * ie1; o3[u] = rr[u] * e1; ob[u] = bb[u] * eh; ok[u] = k2[u] * eh;
              *(unsigned short*)(BUF(I_GATE) + SW(8 * tw + u, j)) = (unsigned short)f2bf(gg[u]); }
          st8bf(BUF(I_AJ) + SW(j, 8 * tw), o0); st8bf(BUF(I_BT) + SW(j, 8 * tw), o1); st8bf(BUF(I_KT) + SW(j, 8 * tw), o2); st8bf(BUF(I_RT) + SW(j, 8 * tw), o3);
          st8bf(BUF(I_BHJ) + SW(j, 8 * tw), ob); st8bf(BUF(I_KHJ) + SW(j, 8 * tw), ok); st8bf(BUF(I_VJ) + SW(j, 8 * tw), vv8); }
        if (c > 0) *(v4u*)(ya + ypoff) = ypend;
        if (c + 1 < SEQ / 64) ZLOAD(c + 1);
        LBAR();
#define MASK(acc, cond) _Pragma("unroll") for (int nt = 0; nt < 2; ++nt) _Pragma("unroll") for (int r = 0; r < 4; ++r) { const int m_ = 16 * mt + 4 * fq + r, n_ = 16 * (2 * nh + nt) + fr; if (!(cond)) acc[nt][r] = 0.f; }
        { const f32x4 zero = {0.f, 0.f, 0.f, 0.f}; f32x4 aL[2] = {zero, zero}, aL2[2] = {zero, zero}, aK[2] = {zero, zero}, aR[2] = {zero, zero};
          const FA fAT = ldAT(BUF(I_AJ), mt, fr, fq), fBTa = ldAT(BUF(I_BT), mt, fr, fq); const FB fBT = ldBT(BUF(I_BT), nh, fr, fq), fKT = ldBT(BUF(I_KT), nh, fr, fq), fRT = ldBT(BUF(I_RT), nh, fr, fq), fATb = ldBT(BUF(I_AJ), nh, fr, fq);
          mma(aL, fAT, fBT);
          mma(aL2, fBTa, fATb);
          mma(aK, fAT, fKT);
          mma(aR, fBTa, fRT);
          MASK(aL, m_ > n_) MASK(aL2, n_ > m_) MASK(aK, n_ < m_) MASK(aR, m_ <= n_)
#pragma unroll
          for (int nt = 0; nt < 2; ++nt)
#pragma unroll
              for (int r = 0; r < 4; ++r) { const int m_ = 16 * mt + 4 * fq + r, n_ = 16 * (2 * nh + nt) + fr; if (m_ == n_) aL2[nt][r] = 1.0f; }
          storeT(BUF(I_L), aL, mt, nh, fr, fq); storeT(BUF(I_R0), aL2, mt, nh, fr, fq);
          storeT(BUF(aki), aK, mt, nh, fr, fq);
          storeT(BUF(I_ABRT), aR, mt, nh, fr, fq); }
        LBAR();
#pragma unroll
        for (int k = 1; k <= 6; ++k) {
            unsigned char* Pc = (k & 1) ? BUF(I_L) : BUF(I_AT); unsigned char* Pn = (k & 1) ? BUF(I_AT) : BUF(I_L);
            unsigned char* Rc = (k & 1) ? BUF(I_R1) : BUF(I_R0); unsigned char* Rn = (k & 1) ? BUF(I_R0) : BUF(I_R1);
            const f32x4 zero = {0.f, 0.f, 0.f, 0.f}; f32x4 aP[2] = {zero, zero}, aRr[2] = {zero, zero};
            FA fP, fPTa; FB fPT, fR;
            if (k <= 5) { fP = ldAT(Pc, mt, fr, fq); fPT = ldB(Pc, nh, fr, fq); }
            if (k >= 2) { fPTa = ldA(Pc, mt, fr, fq); fR = ldB(Rc, nh, fr, fq); ldC(aRr, Rc, mt, nh, fr, fq); }
            if (k <= 5) mma(aP, fP, fPT);
            if (k >= 2) mma(aRr, fPTa, fR);
            if (k <= 5) storeT(Pn, aP, mt, nh, fr, fq);
            if (k >= 2) storeT(Rn, aRr, mt, nh, fr, fq);
            LBAR();
        }
        { const f32x4 zero = {0.f, 0.f, 0.f, 0.f}; f32x4 a1[2] = {zero, zero}, a2[2] = {zero, zero};
          const FA fTT = ldA(BUF(I_R1), mt, fr, fq); const FB fAJ = ldB(BUF(I_AJ), nh, fr, fq), fAK = ldB(BUF(aki), nh, fr, fq);
          mma(a1, fTT, fAJ); mma(a2, fTT, fAK);
          storeT(BUF(I_L), a1, mt, nh, fr, fq);
          storeT(BUF(I_LT), a2, mt, nh, fr, fq); }
        LBAR();
        { const f32x4 zero = {0.f, 0.f, 0.f, 0.f}; f32x4 aMY[2], aNY[2] = {zero, zero}, aMS[2] = {zero, zero}, aNS[2];
          const FA fG1 = ldA(BUF(I_L), mt, fr, fq), fG2 = ldA(BUF(I_LT), mt, fr, fq), fKTa = ldAT(BUF(I_KT), mt, fr, fq);
          const FB fAB = ldB(BUF(I_ABRT), nh, fr, fq), fRT = ldBT(BUF(I_RT), nh, fr, fq), fBH = ldB(BUF(I_BHJ), nh, fr, fq);
#pragma unroll
          for (int nt = 0; nt < 2; ++nt)
#pragma unroll
              for (int r = 0; r < 4; ++r) aMY[nt][r] = bflo(*(const unsigned short*)(BUF(I_RT) + SW(16 * mt + 4 * fq + r, 16 * (2 * nh + nt) + fr)));
          ldC(aNS, BUF(I_KHJ), mt, nh, fr, fq);
          mma(aNY, fKTa, fRT);
          mma(aMY, fG1, fAB);
          mma(aMS, fG1, fBH);
          mma(aNS, fG2, fBH);
          MASK(aNY, m_ <= n_)
          mma(aNY, fG2, fAB);
#pragma unroll
          for (int nt = 0; nt < 2; ++nt)
#pragma unroll
              for (int r = 0; r < 4; ++r) { const int m_ = 16 * mt + 4 * fq + r, n_ = 16 * (2 * nh + nt) + fr; if (m_ == n_) aMS[nt][r] += GC[m_]; }
          storeT(BUF(I_AT), aMY, mt, nh, fr, fq); storeT(BUF(I_BT), aNY, mt, nh, fr, fq); storeT(BUF(I_AJ), aMS, mt, nh, fr, fq); storeT(BUF(I_R0), aNS, mt, nh, fr, fq); }
        LBAR();
        { const f32x4 zero = {0.f, 0.f, 0.f, 0.f}; f32x4 aY[2] = {zero, zero}, aS[2] = {zero, zero};
          const FA fS0a = ldA(BUF(s0i), mt, fr, fq), fVJa = ldA(BUF(I_VJ), mt, fr, fq), fMS = ldA(BUF(I_AJ), mt, fr, fq), fNS = ldA(BUF(I_R0), mt, fr, fq);
          const FB fMY = ldB(BUF(I_AT), nh, fr, fq), fNY = ldB(BUF(I_BT), nh, fr, fq), fS0 = ldB(BUF(s0i), nh, fr, fq), fVJ = ldB(BUF(I_VJ), nh, fr, fq);
          mma(aY, fS0a, fMY); mma(aS, fMS, fS0); mma(aY, fVJa, fNY); mma(aS, fNS, fVJ);
#pragma unroll
          for (int nt = 0; nt < 2; ++nt) *(f32x4*)(YTF + SWF(16 * (2 * nh + nt) + fr, 16 * mt + 4 * fq)) = aY[nt];
          storeT(BUF(aki), aS, mt, nh, fr, fq); }
        LBAR();
#undef MASK
        { const int tmp = s0i; s0i = aki; aki = tmp; }
    }
    { const int c = SEQ / 64; const size_t tprev = (size_t)b * SEQ + (c - 1) * 64 + pt; ESTAGE(((c - 1) & 1) ? BUF(I_VT2) : BUF(I_VT), tprev) }
    *(v4u*)(ya + ypoff) = ypend;
    LBAR();
#undef ESTAGE
#undef BUF
#undef ZLOAD
}
#undef LBAR
}

__device__ __forceinline__ void p_norm2_route(const PArgs& a, unsigned char* lds, int wv) {
    typedef short bf16x8 __attribute__((ext_vector_type(8)));
    const int tid = mktid(wv), lane = tid & 63, fr = lane & 15, fq = lane >> 4;
    const bf16* x1 = (const bf16*)(a.ws + WS_X1B); const float* mod = (const float*)(a.ws + WS_MOD); const float* gm2 = (const float*)(a.ws + WS_GM2); const float* cbt = (const float*)(a.ws + WS_CB);
    int* rte = (int*)(a.ws + WS_RTE); float* rtw = (float*)(a.ws + WS_RTW); int* rnk = (int*)(a.ws + WS_RNK); unsigned* cnt = (unsigned*)(a.ws + WS_CTL) + CW_CNT;
    float* PL = (float*)lds;
    float* PS = PL + 8 * 32 * 48;
    float* RS_ = PS + 8 * 32;
    float* FL = RS_ + 32;
    unsigned* HIST = (unsigned*)(FL + 32 * 48);
    unsigned* LRK = HIST + 32;
    if (tid < 32) HIST[tid] = 0u;
    __syncthreads();
    int gcount = 0;
    bf16x8 wh[4][3], wl[4][3];
    { const bf16* wrh = (const bf16*)(a.ws + WS_WRH) + fr * 1024 + 128 * wv + 8 * fq; const bf16* wrl = (const bf16*)(a.ws + WS_WRL) + fr * 1024 + 128 * wv + 8 * fq;
#pragma unroll
      for (int ks = 0; ks < 4; ++ks)
#pragma unroll
          for (int nt = 0; nt < 3; ++nt) { wh[ks][nt] = *(const bf16x8*)(wrh + nt * 16 * 1024 + 32 * ks); wl[ks][nt] = *(const bf16x8*)(wrl + nt * 16 * 1024 + 32 * ks); } }
    for (int grp = blockIdx.x; grp < NT / 32; grp += gridDim.x) {
        const int row0 = grp * 32, b = row0 >> 11;
        f32x4 acc[3][2];
#pragma unroll
        for (int nt = 0; nt < 3; ++nt) { acc[nt][0] = (f32x4){0.f, 0.f, 0.f, 0.f}; acc[nt][1] = acc[nt][0]; }
        float ssq[2] = {0.f, 0.f};
#pragma unroll
        for (int rt = 0; rt < 2; ++rt) {
            float xs[4][8];
#pragma unroll
            for (int ks = 0; ks < 4; ++ks) rw::ld8bf((const unsigned char*)(x1 + (size_t)(row0 + 16 * rt + fr) * DM + 128 * wv + 32 * ks + 8 * fq), xs[ks]);
#pragma unroll
            for (int ks = 0; ks < 4; ++ks) { float gm[8]; rw::ld8f(gm2 + b * 1024 + 128 * wv + 32 * ks + 8 * fq, gm); unsigned hw[4], lw[4];
#pragma unroll
                for (int e = 0; e < 4; ++e) { const float x0 = xs[ks][2 * e], x1v = xs[ks][2 * e + 1]; ssq[rt] += x0 * x0 + x1v * x1v; const float g0 = x0 * gm[2 * e], g1 = x1v * gm[2 * e + 1];
                    hw[e] = pk2(g0, g1); lw[e] = pk2(g0 - bflo(hw[e]), g1 - bfhi(hw[e])); }
                const v4u hv = {hw[0], hw[1], hw[2], hw[3]}, lv = {lw[0], lw[1], lw[2], lw[3]}; const bf16x8 bh = __builtin_bit_cast(bf16x8, hv), bl = __builtin_bit_cast(bf16x8, lv);
#pragma unroll
                for (int nt = 0; nt < 3; ++nt) { acc[nt][rt] = __builtin_amdgcn_mfma_f32_16x16x32_bf16(wh[ks][nt], bh, acc[nt][rt], 0, 0, 0); acc[nt][rt] = __builtin_amdgcn_mfma_f32_16x16x32_bf16(wl[ks][nt], bh, acc[nt][rt], 0, 0, 0);
                    acc[nt][rt] = __builtin_amdgcn_mfma_f32_16x16x32_bf16(wh[ks][nt], bl, acc[nt][rt], 0, 0, 0); } } }
#pragma unroll
        for (int rt = 0; rt < 2; ++rt) {
#pragma unroll
            for (int nt = 0; nt < 3; ++nt) *(f32x4*)(PL + (wv * 32 + 16 * rt + fr) * 48 + 16 * nt + 4 * fq) = acc[nt][rt];
            float s = ssq[rt]; s += __builtin_bit_cast(float, __builtin_amdgcn_ds_swizzle(__builtin_bit_cast(int, s), 0x401F));
            { const unsigned u = __builtin_bit_cast(unsigned, s); auto rr = __builtin_amdgcn_permlane32_swap(u, u, false, false); s = __builtin_bit_cast(float, (unsigned)rr[0]) + __builtin_bit_cast(float, (unsigned)rr[1]); }
            if (fq == 0) PS[wv * 32 + 16 * rt + fr] = s; }
        __syncthreads();
        { const int r = tid >> 4, c = tid & 15; float s0 = 0.f, s1 = 0.f, s2 = 0.f, sq = 0.f;
#pragma unroll
          for (int w = 0; w < 8; ++w) { const float* p = PL + (w * 32 + r) * 48; s0 += p[c]; s1 += p[c + 16]; s2 += p[c + 32]; sq += PS[w * 32 + r]; }
          const float rstd = rsqrtf(sq * (1.0f / DM) + 1e-6f); const float* cb = cbt + b * 48;
          FL[r * 48 + c] = rstd * s0 + cb[c]; FL[r * 48 + c + 16] = rstd * s1 + cb[c + 16]; FL[r * 48 + c + 32] = rstd * s2 + cb[c + 32];
          if (c == 0) ((float*)(a.ws + WS_RSTD))[row0 + r] = rstd; }
        __syncthreads();
        if (tid < 32) { const int m = row0 + tid; const float* lg = FL + tid * 48;
            int gi = 0; float gm = lg[0];
#pragma unroll
            for (int i = 1; i < 4; ++i) if (lg[i] > gm) { gm = lg[i]; gi = i; }
            float gs = 0.f;
#pragma unroll
            for (int i = 0; i < 4; ++i) gs += __expf(lg[i] - gm);
            const float pg = 1.0f / gs;
            float el[8];
#pragma unroll
            for (int k = 0; k < 8; ++k) el[k] = lg[4 + gi * 8 + k];
            int e1 = 0; float m1 = el[0];
#pragma unroll
            for (int k = 1; k < 8; ++k) if (el[k] > m1) { m1 = el[k]; e1 = k; }
            int e2 = -1; float m2 = -INFINITY;
#pragma unroll
            for (int k = 0; k < 8; ++k) if (k != e1 && el[k] > m2) { m2 = el[k]; e2 = k; }
            const float q2 = __expf(m2 - m1); const float w1 = pg / (1.0f + q2), w2 = pg * q2 / (1.0f + q2);
            const int ea = gi * 8 + e1, eb = gi * 8 + e2; rte[2 * m] = ea; rte[2 * m + 1] = eb; rtw[2 * m] = w1; rtw[2 * m + 1] = w2;
            LRK[gcount * 64 + 2 * tid] = atomicAdd(HIST + ea, 1u) | ((unsigned)ea << 24); LRK[gcount * 64 + 2 * tid + 1] = atomicAdd(HIST + eb, 1u) | ((unsigned)eb << 24); }
        ++gcount;
        __syncthreads();
    }
    if (tid < 32) { const unsigned n = HIST[tid]; HIST[tid] = n ? atomicAdd(cnt + tid * CNT_PAD, n) : 0u; }
    __syncthreads();
    for (int i = tid; i < gcount * 64; i += 512) { const int gi_ = i >> 6, e = i & 63; const int m2 = 2 * ((blockIdx.x + gi_ * gridDim.x) * 32) + e; const unsigned lr = LRK[i]; rnk[m2] = (int)(HIST[lr >> 24] + (lr & 0xffffffu)); }
    __syncthreads();
}
__device__ __forceinline__ void p_moe_gather(const PArgs& a, unsigned char* lds, int wv) {
    int* off = (int*)lds; int* tl = off + 64;
    const int tid = mktid(wv), lane = tid & 63, gw = blockIdx.x * 8 + (tid >> 6), NGW = gridDim.x * 8;
    int* ctl = (int*)(a.ws + WS_CTL); const unsigned* cnt = (const unsigned*)ctl + CW_CNT;
    if (tid < NEXP) tl[tid] = ((int)cnt[tid * CNT_PAD] + 255) >> 8;
    __syncthreads();
    if (tid < NEXP) { int o = 0; for (int e = 0; e < tid; ++e) o += tl[e];
        off[tid] = o * 256;
        if (blockIdx.x == 0) { const int n = tl[tid]; for (int i = 0; i < n; ++i) ctl[CW_TEXP + o + i] = tid; if (tid == NEXP - 1) ctl[CW_NT] = o + n; } }
    __syncthreads();
    const int* rte = (const int*)(a.ws + WS_RTE); const int* rnk = (const int*)(a.ws + WS_RNK); int* pos = (int*)(a.ws + WS_POS);
    const bf16* x1 = (const bf16*)(a.ws + WS_X1B); bf16* xs = (bf16*)(a.ws + WS_XS); const float* rstdv = (const float*)(a.ws + WS_RSTD);
    const float* mod = (const float*)(a.ws + WS_MOD); const float* gm2 = (const float*)(a.ws + WS_GM2);
    typedef int v4i_ __attribute__((ext_vector_type(4)));
    v4u xr[4][2]; v4i_ re[2], rk[2]; f32x4 rs;
    { const int t0 = 4 * gw < NT ? 4 * gw : 0;
#pragma unroll
      for (int r = 0; r < 4; ++r)
#pragma unroll
          for (int hf = 0; hf < 2; ++hf) xr[r][hf] = *(const v4u*)(x1 + (size_t)(t0 + r) * DM + 8 * lane + 512 * hf);
      re[0] = *(const v4i_*)(rte + 2 * t0); re[1] = *(const v4i_*)(rte + 2 * t0 + 4); rk[0] = *(const v4i_*)(rnk + 2 * t0); rk[1] = *(const v4i_*)(rnk + 2 * t0 + 4); rs = *(const f32x4*)(rstdv + t0); }
    for (int t0 = 4 * gw; t0 < NT; t0 += 4 * NGW) {
        const int tn = t0 + 4 * NGW < NT ? t0 + 4 * NGW : t0;
        v4u nx[4][2]; v4i_ ne[2], nk[2]; f32x4 ns;
#pragma unroll
        for (int r = 0; r < 4; ++r)
#pragma unroll
            for (int hf = 0; hf < 2; ++hf) nx[r][hf] = *(const v4u*)(x1 + (size_t)(tn + r) * DM + 8 * lane + 512 * hf);
        ne[0] = *(const v4i_*)(rte + 2 * tn); ne[1] = *(const v4i_*)(rte + 2 * tn + 4); nk[0] = *(const v4i_*)(rnk + 2 * tn); nk[1] = *(const v4i_*)(rnk + 2 * tn + 4); ns = *(const f32x4*)(rstdv + tn);
        const int b = t0 >> 11; int p0[4], p1[4];
#pragma unroll
        for (int r = 0; r < 4; ++r) { const int i0 = 2 * r, i1 = 2 * r + 1; p0[r] = off[re[i0 >> 2][i0 & 3]] + rk[i0 >> 2][i0 & 3]; p1[r] = off[re[i1 >> 2][i1 & 3]] + rk[i1 >> 2][i1 & 3]; }
        if (lane < 4) { const int r = lane; pos[2 * (t0 + r)] = r == 0 ? p0[0] : r == 1 ? p0[1] : r == 2 ? p0[2] : p0[3]; pos[2 * (t0 + r) + 1] = r == 0 ? p1[0] : r == 1 ? p1[1] : r == 2 ? p1[2] : p1[3]; }
#pragma unroll
        for (int hf = 0; hf < 2; ++hf) { const int col = 8 * lane + 512 * hf; float gm[8], sh[8];
            rw::ld8f(gm2 + b * 1024 + col, gm); rw::ld8f(mod + b * 6144 + 3072 + col, sh);
#pragma unroll
            for (int r = 0; r < 4; ++r) { const v4u xw = xr[r][hf]; const float rstd = rs[r];
                const float xv[8] = {bflo(xw.x), bfhi(xw.x), bflo(xw.y), bfhi(xw.y), bflo(xw.z), bfhi(xw.z), bflo(xw.w), bfhi(xw.w)}; float o[8];
#pragma unroll
                for (int e = 0; e < 8; ++e) o[e] = xv[e] * gm[e] * rstd + sh[e];
                v4u w; w.x = pk2(o[0], o[1]); w.y = pk2(o[2], o[3]); w.z = pk2(o[4], o[5]); w.w = pk2(o[6], o[7]);
                *(v4u*)(xs + (size_t)p0[r] * DM + col) = w; *(v4u*)(xs + (size_t)p1[r] * DM + col) = w; } }
#pragma unroll
        for (int r = 0; r < 4; ++r)
#pragma unroll
            for (int hf = 0; hf < 2; ++hf) xr[r][hf] = nx[r][hf];
        re[0] = ne[0]; re[1] = ne[1]; rk[0] = nk[0]; rk[1] = nk[1]; rs = ns;
    }
}
__device__ __forceinline__ void p_combine(const PArgs& a, unsigned char* lds, int wv) {
    const int tid = mktid(wv), lane = tid & 63, gw = blockIdx.x * 8 + (tid >> 6), NGW = gridDim.x * 8;
    const float* mod = (const float*)(a.ws + WS_MOD); const int* pos = (const int*)(a.ws + WS_POS); const float* rtw = (const float*)(a.ws + WS_RTW);
    const bf16* ys = (const bf16*)(a.ws + WS_XS); float* out = a.out; const bf16* x1 = (const bf16*)(a.ws + WS_X1B);
    typedef int v4i_ __attribute__((ext_vector_type(4)));
    v4i_ ps[2]; f32x4 wt[2];
    { const int m0 = 4 * gw < NT ? 4 * gw : 0; ps[0] = *(const v4i_*)(pos + 2 * m0); ps[1] = *(const v4i_*)(pos + 2 * m0 + 4); wt[0] = *(const f32x4*)(rtw + 2 * m0); wt[1] = *(const f32x4*)(rtw + 2 * m0 + 4); }
    for (int m0 = 4 * gw; m0 < NT; m0 += 4 * NGW) {
        const int mn = m0 + 4 * NGW < NT ? m0 + 4 * NGW : m0; const int b = m0 >> 11;
        v4u xw[4][2], y0[4][2], y1[4][2];
#pragma unroll
        for (int r = 0; r < 4; ++r) { const int i0 = 2 * r, i1 = 2 * r + 1; const int q0 = ps[i0 >> 2][i0 & 3], q1 = ps[i1 >> 2][i1 & 3];
#pragma unroll
            for (int hf = 0; hf < 2; ++hf) { const int col = 8 * lane + 512 * hf; xw[r][hf] = *(const v4u*)(x1 + (size_t)(m0 + r) * DM + col); y0[r][hf] = *(const v4u*)(ys + (size_t)q0 * DM + col); y1[r][hf] = *(const v4u*)(ys + (size_t)q1 * DM + col); } }
        v4i_ np[2]; f32x4 nw[2];
        np[0] = *(const v4i_*)(pos + 2 * mn); np[1] = *(const v4i_*)(pos + 2 * mn + 4); nw[0] = *(const f32x4*)(rtw + 2 * mn); nw[1] = *(const f32x4*)(rtw + 2 * mn + 4);
#pragma unroll
        for (int hf = 0; hf < 2; ++hf) { const int col = 8 * lane + 512 * hf; float g2[8]; rw::ld8f(mod + b * 6144 + 5120 + col, g2);
#pragma unroll
            for (int r = 0; r < 4; ++r) { const int i0 = 2 * r, i1 = 2 * r + 1; const float w0 = wt[i0 >> 2][i0 & 3], w1 = wt[i1 >> 2][i1 & 3];
                const v4u xa = xw[r][hf], a0 = y0[r][hf], a1 = y1[r][hf];
                const float xv[8] = {bflo(xa.x), bfhi(xa.x), bflo(xa.y), bfhi(xa.y), bflo(xa.z), bfhi(xa.z), bflo(xa.w), bfhi(xa.w)};
                const float e0[8] = {bflo(a0.x), bfhi(a0.x), bflo(a0.y), bfhi(a0.y), bflo(a0.z), bfhi(a0.z), bflo(a0.w), bfhi(a0.w)};
                const float e1[8] = {bflo(a1.x), bfhi(a1.x), bflo(a1.y), bfhi(a1.y), bflo(a1.z), bfhi(a1.z), bflo(a1.w), bfhi(a1.w)};
                float o[8];
#pragma unroll
                for (int e = 0; e < 8; ++e) o[e] = xv[e] + g2[e] * (e0[e] * w0 + e1[e] * w1);
                float* op = out + (size_t)(m0 + r) * DM + col; *(f32x4*)op = (f32x4){o[0], o[1], o[2], o[3]}; *(f32x4*)(op + 4) = (f32x4){o[4], o[5], o[6], o[7]}; } }
        ps[0] = np[0]; ps[1] = np[1]; wt[0] = nw[0]; wt[1] = nw[1];
    }
}

#define XB_TMO      128
#define XB_XCNT(j)  (256  + 64 * (j))
#define XB_XSUB(j)  (1280 + 64 * (j))
#define XB_XGEN(j)  (2304 + 64 * (j))
#define XB_TOP      3328
#define XB_TOPGEN   3392
#define XCD_BAR_WORDS 3456
#define XB_SPIN_CAP (1u << 22)

__device__ __forceinline__ unsigned xb_ld(unsigned* p)              { return __hip_atomic_load(p, __ATOMIC_RELAXED, __HIP_MEMORY_SCOPE_AGENT); }
__device__ __forceinline__ unsigned xb_add(unsigned* p, unsigned v) { return __hip_atomic_fetch_add(p, v, __ATOMIC_RELAXED, __HIP_MEMORY_SCOPE_AGENT); }
__device__ __forceinline__ unsigned xb_xcc_id() { return (unsigned)__builtin_amdgcn_s_getreg((3 << 11) | 20) & 0xFu; }
#define XB_SPIN(cond, bar) do { unsigned _sp = 0; while (cond) { __builtin_amdgcn_s_sleep(1); \
    if ((++_sp & 255u) == 0u) { if (xb_ld(&(bar)[XB_TMO])) break; if (_sp > XB_SPIN_CAP) { atomicAdd(&(bar)[XB_TMO], 1u); break; } } } } while (0)

struct XcdBarrier {
    unsigned* bar; unsigned x;
    volatile LAS unsigned* st;
};

__device__ __forceinline__ XcdBarrier xcd_barrier_post(unsigned* bar, volatile LAS unsigned* st, int wv) {
    XcdBarrier b; b.bar = bar; b.x = xb_xcc_id(); b.st = st;
    if (mktid(wv) == 0) (void)xb_add(&bar[XB_XCNT(b.x)], 1u);
    return b;
}
__device__ __forceinline__ void xcd_barrier_complete(unsigned* bar, unsigned x, unsigned& nloc, unsigned& nx) {
    const unsigned G = gridDim.x * gridDim.y * gridDim.z;
    unsigned sum, cnt, mine, sp = 0u;
    for (;;) {
        sum = 0u; cnt = 0u; mine = 0u;
#pragma unroll
        for (unsigned j = 0; j < 16; ++j) { const unsigned c = xb_ld(&bar[XB_XCNT(j)]); sum += c; cnt += (c > 0u) ? 1u : 0u; mine = (j == x) ? c : mine; }
        if (sum == G) break;
        __builtin_amdgcn_s_sleep(1);
        if ((++sp & 255u) == 0u) { if (xb_ld(&bar[XB_TMO])) break; if (sp > XB_SPIN_CAP) { atomicAdd(&bar[XB_TMO], 1u); break; } }
    }
    nloc = mine > 0u ? mine : 1u; nx = cnt > 0u ? cnt : 1u;
}

__device__ __forceinline__ void xcd_barrier(const XcdBarrier& b, int wv) {
    asm volatile("s_waitcnt vmcnt(0)" ::: "memory");
    __syncthreads();
    if (mktid(wv) == 0) {
        unsigned* bar = b.bar;
        __builtin_amdgcn_s_waitcnt(0);
        unsigned nloc = b.st[0], nx = b.st[1];
        if (nloc == 0u) { xcd_barrier_complete(bar, b.x, nloc, nx); b.st[0] = nloc; b.st[1] = nx; }
        const unsigned old = xb_add(&bar[XB_XSUB(b.x)], 1u);
        const unsigned gen = old / nloc;
        if (old + 1u == (gen + 1u) * nloc) {
            __builtin_amdgcn_fence(__ATOMIC_RELEASE, "agent");
            asm volatile("s_waitcnt vmcnt(0)" ::: "memory");
            const unsigned og = xb_add(&bar[XB_TOP], 1u);
            const unsigned tg = og / nx;
            if (og + 1u == (tg + 1u) * nx) xb_add(&bar[XB_TOPGEN], 1u);
            else XB_SPIN(xb_ld(&bar[XB_TOPGEN]) == tg, bar);
            __builtin_amdgcn_fence(__ATOMIC_ACQUIRE, "agent");
            xb_add(&bar[XB_XGEN(b.x)], 1u);
            asm volatile("s_waitcnt vmcnt(0)" ::: "memory");
        } else {
            XB_SPIN(xb_ld(&bar[XB_XGEN(b.x)]) == gen, bar);
            __builtin_amdgcn_fence(__ATOMIC_ACQUIRE, "agent");
            asm volatile("s_waitcnt vmcnt(0)" ::: "memory");
        }
    }
    __syncthreads();
}

constexpr int LDS_BYTES = 160 * 1024, MISC_OFF = LDS_BYTES - 256;
static_assert(rw::LDS_NEED <= MISC_OFF, "scan LDS");
static_assert(XB_TMO == XB_TMO_W && MISC_OFF + 64 == DOWN_MSK_OFF, "control word layout");

__device__ __forceinline__ void p_actprep_dyn(const PArgs& a, unsigned char* lds, int wv) {
    const int tid = mktid(wv), lane = tid & 63; const bf16* z = (const bf16*)(a.ws + WS_Z); bf16* act = (bf16*)(a.ws + WS_ACT); const float* mu = a.in[7];
    unsigned* ctl = (unsigned*)(a.ws + WS_CTL);
    __syncthreads();
    if (tid == 0) { XB_SPIN(xb_ld(ctl + CW_ZCNT) < (unsigned)(NT / 256 * 8), ctl + CW_BAR); __builtin_amdgcn_fence(__ATOMIC_ACQUIRE, "agent"); asm volatile("s_waitcnt vmcnt(0)" ::: "memory"); }
    __syncthreads();
    const int cg = lane & 31, col = 1536 + 8 * cg;
    const f32x4 m0 = *(const f32x4*)(mu + col), m1 = *(const f32x4*)(mu + col + 4); const float m8[8] = {m0.x, m0.y, m0.z, m0.w, m1.x, m1.y, m1.z, m1.w};
    for (;;) {
        unsigned grab = 0; if (lane == 0) grab = atomicAdd(ctl + CW_AQ, 1u);
        grab = (unsigned)__builtin_amdgcn_readfirstlane((int)grab);
        if (grab >= (unsigned)(NT / 64)) break;
        for (int sub = 0; sub < 8; ++sub) {
        const int t0 = (int)grab * 64 + sub * 8 + (lane >> 5);
        v4u cw[4], pw[4];
#pragma unroll
        for (int u = 0; u < 4; ++u) { const int t = t0 + 2 * u; const int tp = (t & (SEQ - 1)) > 0 ? t - 1 : t; cw[u] = *(const v4u*)(z + (size_t)t * INC + col); pw[u] = *(const v4u*)(z + (size_t)tp * INC + col); }
#pragma unroll
        for (int u = 0; u < 4; ++u) { const int t = t0 + 2 * u; const bool hasp = (t & (SEQ - 1)) > 0; const v4u c4 = cw[u]; v4u p4 = pw[u]; if (!hasp) p4 = (v4u){0u, 0u, 0u, 0u};
            const float c8[8] = {bflo(c4.x), bfhi(c4.x), bflo(c4.y), bfhi(c4.y), bflo(c4.z), bfhi(c4.z), bflo(c4.w), bfhi(c4.w)}, p8[8] = {bflo(p4.x), bfhi(p4.x), bflo(p4.y), bfhi(p4.y), bflo(p4.z), bfhi(p4.z), bflo(p4.w), bfhi(p4.w)}; float v[8];
#pragma unroll
            for (int e = 0; e < 8; ++e) { const float x = c8[e] + (p8[e] - c8[e]) * m8[e]; v[e] = cg < 8 ? 1.0f - 2.0f * __builtin_amdgcn_rcpf(1.0f + __expf(2.0f * x)) : cg < 16 ? x : sigm(x); }
            v4u w; w.x = pk2(v[0], v[1]); w.y = pk2(v[2], v[3]); w.z = pk2(v[4], v[5]); w.w = pk2(v[6], v[7]);
            *(v4u*)(act + (size_t)t * 256 + 8 * cg) = w; }
        }
    }
}

__global__ void __launch_bounds__(512, 2) mega_fwd(PArgs a) {
    extern __shared__ __attribute__((aligned(16))) unsigned char lds[];
    volatile LAS unsigned* MISC = (volatile LAS unsigned*)((LAS unsigned char*)lds + MISC_OFF);
    const int wv = __builtin_amdgcn_readfirstlane((int)threadIdx.x >> 6);
    { const int t0 = mktid(wv); if (t0 < 64) MISC[t0] = 0u; }
    __syncthreads();
    XcdBarrier bar = xcd_barrier_post((unsigned*)(a.ws + WS_CTL) + CW_BAR, MISC + 8, wv);
    GemmArgs g; g.ws = a.ws; g.x = a.in[0]; g.out = a.out; g.qg = a.in[18]; g.kg = a.in[19];
    const int G = (int)gridDim.x, bx = (int)blockIdx.x;

    { const int t0 = mktid(wv); float wr[64]; float* sc = (float*)(lds + 68 * 1024); float* red = (float*)lds;
      const bool has = bx < 192;
      if (has) p_ada_load(a, bx, t0, wr);
      for (int i = t0; i < 16 * 1024; i += 512) { const float v = a.in[1][i]; sc[i] = v / (1.0f + __expf(-v)); }
      p_prep_weights(a, lds, wv);
      __syncthreads();
      if (has) p_ada_finish(a, sc, red, bx, t0, wr);
      for (int tile = bx + G; tile < 192; tile += G) { p_ada_load(a, tile, t0, wr); p_ada_finish(a, sc, red, tile, t0, wr); } }
    xcd_barrier(bar, wv);
    p_norm1(a, lds, wv);
    xcd_barrier(bar, wv);
    p_gemm_in(g, lds, wv);
    p_actprep_dyn(a, lds, wv);
    xcd_barrier(bar, wv);
    { const int nscan = G / 2;
      if (bx < nscan) { for (int bh = bx; bh < 128; bh += nscan) rw::scan_unit(a, lds, bh, wv); }
      else p_attn(a, lds, bx - nscan, G - nscan, wv); }
    __syncthreads(); p_prep_experts_dyn(a, lds, wv);
    xcd_barrier(bar, wv);
    p_gemm_merge(g, lds, wv);
    xcd_barrier(bar, wv);
    p_gemm_out(g, lds, wv);
    xcd_barrier(bar, wv);
    p_norm2_route(a, lds, wv);
    xcd_barrier(bar, wv);
    p_moe_gather(a, lds, wv);
    xcd_barrier(bar, wv);
    p_gemm_up(g, lds, wv);
    __syncthreads();
    p_gemm_down(g, lds, wv);
    xcd_barrier(bar, wv);
    p_combine(a, lds, wv);
}

extern "C" void kernel_launch(void* const* d_in, const int* in_sizes, int n_in, void* d_out, int out_size, void* d_ws, size_t ws_size, hipStream_t stream) {
    static int grid = 0;
    if (grid == 0) {
        if (n_in != 30 || out_size != NT * DM || ws_size < WS_END) { fprintf(stderr, "kernel_launch: unexpected shapes (n_in %d, out %d, ws %zu)\n", n_in, out_size, ws_size); grid = -1; return; }
        int dev = 0, cus = 0, per_cu = 0;
        if (hipGetDevice(&dev) != hipSuccess || hipDeviceGetAttribute(&cus, hipDeviceAttributeMultiprocessorCount, dev) != hipSuccess) { grid = -1; return; }
        if (hipFuncSetAttribute((const void*)mega_fwd, hipFuncAttributeMaxDynamicSharedMemorySize, LDS_BYTES) != hipSuccess) { fprintf(stderr, "kernel_launch: hipFuncSetAttribute failed\n"); grid = -1; return; }
        if (hipOccupancyMaxActiveBlocksPerMultiprocessor(&per_cu, (const void*)mega_fwd, 512, LDS_BYTES) != hipSuccess || per_cu < 1) { fprintf(stderr, "kernel_launch: occupancy query says %d blocks per CU\n", per_cu); (void)hipGetLastError(); grid = -1; return; }
        grid = cus;
    }
    if (grid < 0) return;
    (void)hipMemsetAsync((char*)d_ws + WS_CTL, 0, 65536, stream);
    PArgs p{}; for (int i = 0; i < 30; ++i) p.in[i] = (const float*)d_in[i]; p.out = (float*)d_out; p.ws = (unsigned char*)d_ws;
    hipLaunchKernelGGL(mega_fwd, dim3(grid), dim3(512), LDS_BYTES, stream, p);
}
```

```cpp
#include <hip/hip_runtime.h>
#include <cstdio>
#include <cstdint>
__device__ __forceinline__ int mktid(int wv) { int l; asm volatile("v_mbcnt_lo_u32_b32 %0, -1, 0\n\tv_mbcnt_hi_u32_b32 %0, -1, %0" : "=v"(l)); return (wv << 6) | l; }
template <int CTRL> __device__ __forceinline__ float dppf(float v) { return __builtin_bit_cast(float, __builtin_amdgcn_update_dpp(0, __builtin_bit_cast(int, v), CTRL, 0xF, 0xF, true)); }
__device__ __forceinline__ float red4(float v) { v += dppf<0xB1>(v); v += dppf<0x4E>(v); return v; }
__device__ __forceinline__ float red8(float v) { v = red4(v); v += dppf<0x141>(v); return v; }
__device__ __forceinline__ float red16(float v) { v = red8(v); v += dppf<0x140>(v); return v; }
__device__ __forceinline__ float wave_sum(float v) { v = red16(v);
    v += __builtin_bit_cast(float, __builtin_amdgcn_ds_swizzle(__builtin_bit_cast(int, v), 0x401F));
    const unsigned u = __builtin_bit_cast(unsigned, v); auto rr = __builtin_amdgcn_permlane32_swap(u, u, false, false);
    return __builtin_bit_cast(float, (unsigned)rr[0]) + __builtin_bit_cast(float, (unsigned)rr[1]); }
__device__ __forceinline__ void wave_sum8(float (&v)[8]) {
#pragma unroll
    for (int i = 0; i < 8; ++i) v[i] += dppf<0xB1>(v[i]);
#pragma unroll
    for (int i = 0; i < 8; ++i) v[i] += dppf<0x4E>(v[i]);
#pragma unroll
    for (int i = 0; i < 8; ++i) v[i] += dppf<0x141>(v[i]);
#pragma unroll
    for (int i = 0; i < 8; ++i) v[i] += dppf<0x140>(v[i]);
#pragma unroll
    for (int i = 0; i < 8; ++i) v[i] += __builtin_bit_cast(float, __builtin_amdgcn_ds_swizzle(__builtin_bit_cast(int, v[i]), 0x401F));
#pragma unroll
    for (int i = 0; i < 8; ++i) { const unsigned u = __builtin_bit_cast(unsigned, v[i]); auto rr = __builtin_amdgcn_permlane32_swap(u, u, false, false); v[i] = __builtin_bit_cast(float, (unsigned)rr[0]) + __builtin_bit_cast(float, (unsigned)rr[1]); }
}
__device__ __forceinline__ float lane_get(float v, int src) { return __builtin_bit_cast(float, __builtin_amdgcn_ds_bpermute(src << 2, __builtin_bit_cast(int, v))); }
namespace pg8 {
#define PG8_LAS __attribute__((address_space(3)))
typedef unsigned short bf16_t;
typedef short bf16x8 __attribute__((ext_vector_type(8)));
typedef float f32x4 __attribute__((ext_vector_type(4)));
typedef unsigned u32x4 __attribute__((ext_vector_type(4)));
constexpr int BM = 256, BK = 64, HALF = 128, HTB = HALF * BK * 2  , STAGE_BYTES = 8 * HTB, NXCD = 8, WGM = 4;

__host__ __device__ __forceinline__ int lds_byte(int r, int c) { const int st = (r >> 4) * 2 + (c >> 5), rr = r & 15, cc = c & 31, ob = rr * 64 + cc * 2; return st * 1024 + (ob ^ (((ob >> 9) & 1) << 5)); }
__host__ __device__ __forceinline__ void stage_rc(int b, int& R, int& C) { const int st = b / 1024, sb = b % 1024, swz = sb ^ (((sb >> 9) & 1) << 5); R = (st >> 1) * 16 + swz / 64; C = (st & 1) * 32 + (swz % 64) / 2; }
__host__ __device__ __forceinline__ int perm32(int rho) { const int n = rho >> 4, i = rho & 15; return 8 * (i >> 2) + 4 * n + (i & 3); }
struct Unit { int pm, pn, aux; const char* a; const char* b; };
struct Gemm { int K; };

struct StaticOrder {
    int nM, nN, nwg, G, c; const char* A; const char* Bt; size_t tstep;
    __device__ void init(const void* A_, const void* Bt_, int M, int N, int K, int G_, int c_) { nM = M / BM; nN = N / BM; nwg = nM * nN; G = G_; c = c_; A = (const char*)A_; Bt = (const char*)Bt_; tstep = (size_t)BM * K * 2; }
    __device__ bool next(int i, Unit& u) const {
        const long L = (long)i * G + c; if (L >= nwg) return false;
        int wgid = (int)L; { const int q = nwg / NXCD, r = nwg % NXCD, xcd = wgid % NXCD, off = wgid / NXCD; wgid = (xcd < r ? xcd * (q + 1) : r * (q + 1) + (xcd - r) * q) + off; }
        const int nig = WGM * nN, gid = wgid / nig, fm = gid * WGM, gsz = (nM - fm) < WGM ? (nM - fm) : WGM;
        u.aux = 0; u.pm = fm + ((wgid % nig) % gsz); u.pn = (wgid % nig) / gsz; u.a = A + (size_t)u.pm * tstep; u.b = Bt + (size_t)u.pn * tstep; return true;
    }
    __device__ __forceinline__ void a_ready(const Unit&) const {}
    __device__ __forceinline__ void done(const Unit&) const {}
};
__device__ __forceinline__ unsigned cvt_pk_bf16(float lo, float hi) { unsigned r; asm volatile("v_cvt_pk_bf16_f32 %0, %1, %2" : "=v"(r) : "v"(lo), "v"(hi)); return r; }
template <class Epi, class Sched, bool ALIGN_EPI = false, bool SP2 = false>
__device__ __forceinline__ void gemm_phase(PG8_LAS unsigned char* lds, const Gemm g, const Sched& S, const Epi& E, int wv) {
    const int tid = mktid(wv), wid = __builtin_amdgcn_readfirstlane(tid >> 6), lane = tid & 63, wr = wid >> 2, wc = wid & 3, fr = lane & 15, fq = lane >> 4;
    const int K = g.K, nt = K / BK;
    unsigned voffA[2], voffB[2];
#pragma unroll
    for (int i = 0; i < 2; ++i) { int R, C; stage_rc(tid * 16 + i * 8192, R, C); const int Rb = Epi::PERM ? ((R & ~31) + perm32(R & 31)) : R;
        voffA[i] = (unsigned)(R * K + C) * 2u; voffB[i] = (unsigned)(Rb * K + C) * 2u; }
    const size_t kstep = (size_t)(BK * 2);
    const size_t hstep = (size_t)HALF * K * 2;
        const unsigned ldsw = (unsigned)wid * 1024u;
    const int aoff = lds_byte(wr * 64 + fr, fq * 8), boff = lds_byte(wc * 32 + fr, fq * 8);
#define PG8_SA(b, h) (((b) * 2 + (h)) * HTB)
#define PG8_SB(b, h) ((4 + (b) * 2 + (h)) * HTB)
#define PG8_STAGE(bufoff, gbase, voff) do { _Pragma("unroll") for (int _i = 0; _i < 2; ++_i) \
        __builtin_amdgcn_global_load_lds((const unsigned*)((const char*)(gbase) + (voff)[_i]), (PG8_LAS unsigned*)(lds + (bufoff) + ldsw + _i * 8192), 16, 0, 0); } while (0)
#define PG8_LDA(dst, b, h) do { _Pragma("unroll") for (int m = 0; m < 4; ++m) _Pragma("unroll") for (int k = 0; k < 2; ++k) dst[m][k] = *(const PG8_LAS bf16x8*)(lds + PG8_SA(b, h) + aoff + m * 2048 + k * 1024); } while (0)
#define PG8_LDB(dst, b, h) do { _Pragma("unroll") for (int n = 0; n < 2; ++n) _Pragma("unroll") for (int k = 0; k < 2; ++k) dst[n][k] = *(const PG8_LAS bf16x8*)(lds + PG8_SB(b, h) + boff + n * 2048 + k * 1024); } while (0)
#define PG8_MMA(ai, bj, At, Bt) do { __builtin_amdgcn_s_setprio(1); _Pragma("unroll") for (int m = 0; m < 4; ++m) _Pragma("unroll") for (int n = 0; n < 2; ++n) _Pragma("unroll") for (int k = 0; k < 2; ++k) \
        acc[ai][bj][m][n] = __builtin_amdgcn_mfma_f32_16x16x32_bf16(Bt[n][k], At[m][k], acc[ai][bj][m][n], 0, 0, 0); __builtin_amdgcn_s_setprio(0); } while (0)
#define PG8_WAIT_V(n) asm volatile("s_waitcnt vmcnt(" #n ")" ::: "memory")
#define PG8_WAIT_L(n) asm volatile("s_waitcnt lgkmcnt(" #n ")" ::: "memory")
#define PG8_BAR __builtin_amdgcn_s_barrier()
#define PG8_SCHED __builtin_amdgcn_sched_barrier(0)
    Unit cur, nxt; int ui = 0;
    if (!S.next(0, cur)) return;
    f32x4 acc[2][2][4][2];
#pragma unroll
    for (int a = 0; a < 2; ++a)
#pragma unroll
        for (int b = 0; b < 2; ++b)
#pragma unroll
            for (int m = 0; m < 4; ++m)
#pragma unroll
                for (int n = 0; n < 2; ++n) acc[a][b][m][n] = (f32x4){0.f, 0.f, 0.f, 0.f};
    bf16x8 At[4][2], B0[2][2], B1[2][2];
    const char* cA = cur.a; const char* cB = cur.b;
    S.a_ready(cur);
    if constexpr (SP2) {
        PG8_STAGE(PG8_SB(0, 0), cB, voffB); PG8_STAGE(PG8_SB(0, 1), cB + hstep, voffB); PG8_STAGE(PG8_SA(0, 0), cA, voffA); PG8_STAGE(PG8_SA(0, 1), cA + hstep, voffA);
        if (wr == 1) PG8_BAR;
        PG8_WAIT_V(2); PG8_BAR;
        PG8_STAGE(PG8_SB(1, 0), cB + kstep, voffB); PG8_STAGE(PG8_SA(1, 0), cA + kstep, voffA); PG8_STAGE(PG8_SB(1, 1), cB + hstep + kstep, voffB);
        PG8_WAIT_V(6); PG8_BAR;
    } else {
        PG8_STAGE(PG8_SB(0, 0), cB, voffB); PG8_STAGE(PG8_SA(0, 0), cA, voffA); PG8_STAGE(PG8_SB(0, 1), cB + hstep, voffB); PG8_STAGE(PG8_SA(0, 1), cA + hstep, voffA);
        if (wr == 1) PG8_BAR;
        PG8_WAIT_V(4); PG8_BAR;
        PG8_STAGE(PG8_SB(1, 0), cB + kstep, voffB); PG8_STAGE(PG8_SA(1, 0), cA + kstep, voffA); PG8_STAGE(PG8_SB(1, 1), cB + hstep + kstep, voffB);
        PG8_WAIT_V(6); PG8_BAR;
    }
    for (;;) {
        const bool has_next = S.next(ui + 1, nxt);
        const char* nA = has_next ? nxt.a : cA; const char* nB = has_next ? nxt.b : cB;
        for (int t = 0; t < nt; t += 2) {
            const bool last = (t == nt - 2);
            const char* a1 = cA + (size_t)(t + 1) * kstep;
            const char* a2 = last ? nA : cA + (size_t)(t + 2) * kstep; const char* b2 = last ? nB : cB + (size_t)(t + 2) * kstep;
            const char* a3 = a2 + kstep; const char* b3 = b2 + kstep;
            if (last && has_next) S.a_ready(nxt);
            if constexpr (SP2) {
            PG8_LDB(B0, 0, 0); PG8_LDB(B1, 0, 1); PG8_SCHED; PG8_LDA(At, 0, 0); PG8_STAGE(PG8_SA(1, 1), a1 + hstep, voffA);
            PG8_WAIT_V(8); PG8_WAIT_L(0); PG8_BAR; PG8_MMA(0, 0, At, B0); PG8_MMA(0, 1, At, B1); PG8_BAR; PG8_SCHED;
            PG8_LDA(At, 0, 1); PG8_STAGE(PG8_SB(0, 0), b2, voffB); PG8_STAGE(PG8_SB(0, 1), b2 + hstep, voffB); PG8_STAGE(PG8_SA(0, 0), a2, voffA);
            PG8_WAIT_V(8); PG8_WAIT_L(0); PG8_BAR; PG8_MMA(1, 0, At, B0); PG8_MMA(1, 1, At, B1); PG8_BAR; PG8_SCHED;
            PG8_LDB(B0, 1, 0); PG8_LDB(B1, 1, 1); PG8_SCHED; PG8_LDA(At, 1, 0); PG8_STAGE(PG8_SA(0, 1), a2 + hstep, voffA);
            PG8_WAIT_V(8); PG8_WAIT_L(0); PG8_BAR; PG8_MMA(0, 0, At, B0); PG8_MMA(0, 1, At, B1); PG8_BAR; PG8_SCHED;
            PG8_LDA(At, 1, 1); PG8_STAGE(PG8_SB(1, 0), b3, voffB); PG8_STAGE(PG8_SB(1, 1), b3 + hstep, voffB); PG8_STAGE(PG8_SA(1, 0), a3, voffA);
            PG8_WAIT_V(8); PG8_WAIT_L(0); PG8_BAR; PG8_MMA(1, 0, At, B0); PG8_MMA(1, 1, At, B1); PG8_BAR; PG8_SCHED;
            } else {
            PG8_LDB(B0, 0, 0); PG8_SCHED; PG8_LDA(At, 0, 0); PG8_STAGE(PG8_SA(1, 1), a1 + hstep, voffA);
            PG8_WAIT_L(8); PG8_BAR; PG8_WAIT_L(0); PG8_MMA(0, 0, At, B0); PG8_BAR; PG8_SCHED;
            PG8_LDB(B1, 0, 1); PG8_STAGE(PG8_SB(0, 0), b2, voffB);
            PG8_BAR; PG8_WAIT_L(0); PG8_MMA(0, 1, At, B1); PG8_BAR;
            PG8_LDA(At, 0, 1); PG8_STAGE(PG8_SA(0, 0), a2, voffA);
            PG8_BAR; PG8_WAIT_L(0); PG8_MMA(1, 0, At, B0); PG8_BAR; PG8_SCHED;
            PG8_STAGE(PG8_SB(0, 1), b2 + hstep, voffB);
            PG8_WAIT_V(6); PG8_BAR; PG8_MMA(1, 1, At, B1); PG8_BAR;
            PG8_LDB(B0, 1, 0); PG8_SCHED; PG8_LDA(At, 1, 0); PG8_STAGE(PG8_SA(0, 1), a2 + hstep, voffA);
            PG8_WAIT_L(8); PG8_BAR; PG8_WAIT_L(0); PG8_MMA(0, 0, At, B0); PG8_BAR; PG8_SCHED;
            PG8_LDB(B1, 1, 1); PG8_STAGE(PG8_SB(1, 0), b3, voffB);
            PG8_BAR; PG8_WAIT_L(0); PG8_MMA(0, 1, At, B1); PG8_BAR;
            PG8_LDA(At, 1, 1); PG8_STAGE(PG8_SA(1, 0), a3, voffA);
            PG8_BAR; PG8_WAIT_L(0); PG8_MMA(1, 0, At, B0); PG8_BAR; PG8_SCHED;
            PG8_STAGE(PG8_SB(1, 1), b3 + hstep, voffB);
            PG8_WAIT_V(6); PG8_BAR; PG8_MMA(1, 1, At, B1); PG8_BAR;
            }
        }
        if constexpr (ALIGN_EPI) { if (wr == 0) PG8_BAR; }
        bool keep = false;
        if constexpr (!Epi::AFTER_DRAIN) { if constexpr (Epi::CHAIN) keep = E.chain(acc, cur, wr, wc, fr, fq); else E(acc, cur, wr, wc, fr, fq); S.done(cur); }
        if (!has_next) break;
        if (!keep) {
#pragma unroll
        for (int a = 0; a < 2; ++a)
#pragma unroll
            for (int b = 0; b < 2; ++b)
#pragma unroll
                for (int m = 0; m < 4; ++m)
#pragma unroll
                    for (int n = 0; n < 2; ++n) acc[a][b][m][n] = (f32x4){0.f, 0.f, 0.f, 0.f};
        }
        cur = nxt; cA = nA; cB = nB; ++ui;
        if constexpr (ALIGN_EPI) { if (wr == 1) PG8_BAR; }
    }
    PG8_WAIT_V(0);
    if constexpr (!ALIGN_EPI) { if (wr == 0) PG8_BAR; }
    PG8_BAR;
    if constexpr (Epi::AFTER_DRAIN) { E.fused(acc, cur, wr, wc, fr, fq, lds, wid, lane); S.done(cur); }
#undef PG8_SA
#undef PG8_SB
#undef PG8_STAGE
#undef PG8_LDA
#undef PG8_LDB
#undef PG8_MMA
#undef PG8_WAIT_V
#undef PG8_WAIT_L
#undef PG8_BAR
#undef PG8_SCHED
}
}
#include <hip/hip_bf16.h>
#include <cmath>
namespace attn_body {
using bf16=__hip_bfloat16;
using bf16x8=__attribute__((ext_vector_type(8)))short;
using s16x4=__attribute__((ext_vector_type(4)))short;
using f32x16=__attribute__((ext_vector_type(16)))float;
using u32x4=__attribute__((ext_vector_type(4)))unsigned;
constexpr int NHEAD=8,SEQ=2048,D=64,PQ=512,PK=512,PV=4352,PO=512;
constexpr int NW=8,QBLK=32,QB=QBLK*NW,KVBLK=64,NQB=SEQ/QB;
__device__ __forceinline__ int crow(int r,int hi){return (r&3)+8*(r>>2)+4*hi;}
#define SBAR() __builtin_amdgcn_sched_barrier(0)
__device__ __forceinline__ void cmask(f32x16&p0,f32x16&p1,int jb,int qrel,int hi){
  const float NEG=-INFINITY; int kb=64*jb+4*hi;
  #pragma unroll
  for(int r=0;r<16;++r){int kv=kb+(r&3)+8*(r>>2); if(kv>qrel)p0[r]=NEG; if(kv+32>qrel)p1[r]=NEG;}
}

constexpr int NSLOT=3, SLOTB=8192;
constexpr int LDS_K=0, LDS_V=NSLOT*SLOTB, LDS_WS=2*NSLOT*SLOTB, LDS_OST=LDS_WS+NW*64*4, LDS_SEL=LDS_OST+NW*4096, LDS_KM=LDS_SEL+256, LDS_KP=LDS_KM+7*64*4, LDS_BYTES=LDS_KP+8*64*4;
constexpr float C2=0.125f*1.4426950408889634f;
__device__ __forceinline__ void glds16(const void*gsrc,unsigned lds_dst){unsigned keep;
  asm volatile("s_mov_b32 %0, m0\n\ts_mov_b32 m0, %2\n\ts_nop 0\n\tglobal_load_lds_dwordx4 %1, off\n\ts_mov_b32 m0, %0":"=&s"(keep):"v"(gsrc),"s"(lds_dst):"memory");}
__device__ __forceinline__ float max3f(float a,float b,float c){float r;asm("v_max3_f32 %0, %1, %2, %3":"=v"(r):"v"(a),"v"(b),"v"(c));return r;}
__device__ __forceinline__ float max2f(float a,float b){float r;asm("v_max_f32_e32 %0, %1, %2":"=v"(r):"v"(a),"v"(b));return r;}
__device__ __forceinline__ float fadd_s(float a,float b){float r;asm("v_add_f32_e32 %0, %1, %2":"=v"(r):"v"(a),"v"(b));return r;}
__device__ __forceinline__ float fsub_s(float a,float b){float r;asm("v_sub_f32_e32 %0, %1, %2":"=v"(r):"v"(a),"v"(b));return r;}
typedef float f32x2_t __attribute__((ext_vector_type(2))); typedef __bf16 bf16x2_t __attribute__((ext_vector_type(2)));
__device__ __forceinline__ unsigned cvtpk_s(float lo,float hi){f32x2_t v={lo,hi};bf16x2_t b=__builtin_convertvector(v,bf16x2_t);return __builtin_bit_cast(unsigned,b);}
#define WAIT_BAR(N) asm volatile("s_waitcnt vmcnt(" #N ") lgkmcnt(0)\n\ts_barrier":::"memory")

__device__ __forceinline__ void qkt(f32x16&p0,f32x16&p1,const char*Kslot,const bf16x8*qr,const f32x16&negm,int r32,int hi){
  const char*kb=Kslot+hi*1024+r32*16;
  #pragma unroll
  for(int d0=0;d0<4;++d0){
    const bf16x8 b0=*reinterpret_cast<const bf16x8*>(kb+d0*2048);
    const bf16x8 b1=*reinterpret_cast<const bf16x8*>(kb+d0*2048+512);
    if(d0==0){p0=__builtin_amdgcn_mfma_f32_32x32x16_bf16(b0,qr[0],negm,0,0,0);p1=__builtin_amdgcn_mfma_f32_32x32x16_bf16(b1,qr[0],negm,0,0,0);}
    else{p0=__builtin_amdgcn_mfma_f32_32x32x16_bf16(b0,qr[d0],p0,0,0,0);p1=__builtin_amdgcn_mfma_f32_32x32x16_bf16(b1,qr[d0],p1,0,0,0);}}
}
typedef __attribute__((address_space(3))) const char* lds_cptr;
typedef short v4i16_t __attribute__((ext_vector_type(4)));
__device__ __forceinline__ void kload8(bf16x8*kf,lds_cptr kp){
  kf[0]=*(const __attribute__((address_space(3))) bf16x8*)(kp);      kf[1]=*(const __attribute__((address_space(3))) bf16x8*)(kp+512);
  kf[2]=*(const __attribute__((address_space(3))) bf16x8*)(kp+2048); kf[3]=*(const __attribute__((address_space(3))) bf16x8*)(kp+2560);
  kf[4]=*(const __attribute__((address_space(3))) bf16x8*)(kp+4096); kf[5]=*(const __attribute__((address_space(3))) bf16x8*)(kp+4608);
  kf[6]=*(const __attribute__((address_space(3))) bf16x8*)(kp+6144); kf[7]=*(const __attribute__((address_space(3))) bf16x8*)(kp+6656);
}
__device__ __forceinline__ void kload2(bf16x8*kf,lds_cptr kp,int j){ kf[2*j]=*(const __attribute__((address_space(3))) bf16x8*)(kp+j*2048); kf[2*j+1]=*(const __attribute__((address_space(3))) bf16x8*)(kp+j*2048+512); }
__device__ __forceinline__ s16x4 vtr(lds_cptr p){ return __builtin_bit_cast(s16x4,__builtin_amdgcn_ds_read_tr16_b64_v4i16((__attribute__((address_space(3))) v4i16_t*)p)); }
__device__ __forceinline__ float rowmax(const f32x16&p0,const f32x16&p1){
  float a=max3f(p0[0],p0[1],p1[0]),b=max3f(p0[2],p0[3],p1[1]);a=max3f(a,p1[2],p1[3]);
  #pragma unroll
  for(int r=4;r<16;r+=4){a=max3f(a,p0[r],p0[r+1]);b=max3f(b,p0[r+2],p0[r+3]);a=max3f(a,p1[r],p1[r+1]);b=max3f(b,p1[r+2],p1[r+3]);}
  const float m=max2f(a,b);
  auto rr=__builtin_amdgcn_permlane32_swap(__float_as_uint(m),__float_as_uint(m),false,false);
  return max2f(__uint_as_float(rr[0]),__uint_as_float(rr[1]));
}
__device__ __forceinline__ void pv(f32x16*o,int vb,bf16x8 pa0,bf16x8 pa1,bf16x8 pa2,bf16x8 pa3){
  #pragma unroll
  for(int d0=0;d0<2;++d0){s16x4 lo[4],hi[4];
    #pragma unroll
    for(int ks=0;ks<4;++ks){
      asm volatile("ds_read_b64_tr_b16 %0,%1 offset:%c2":"=&v"(lo[ks]):"v"(vb),"i"(d0*4096+ks*1024):"memory");
      asm volatile("ds_read_b64_tr_b16 %0,%1 offset:%c2":"=&v"(hi[ks]):"v"(vb),"i"(d0*4096+ks*1024+512):"memory");}
    asm volatile("s_waitcnt lgkmcnt(0)":::"memory");SBAR();
    #define PK(k) (bf16x8){lo[k][0],lo[k][1],lo[k][2],lo[k][3],hi[k][0],hi[k][1],hi[k][2],hi[k][3]}
    o[d0]=__builtin_amdgcn_mfma_f32_32x32x16_bf16(pa0,PK(0),o[d0],0,0,0);
    o[d0]=__builtin_amdgcn_mfma_f32_32x32x16_bf16(pa1,PK(1),o[d0],0,0,0);
    o[d0]=__builtin_amdgcn_mfma_f32_32x32x16_bf16(pa2,PK(2),o[d0],0,0,0);
    o[d0]=__builtin_amdgcn_mfma_f32_32x32x16_bf16(pa3,PK(3),o[d0],0,0,0);
    #undef PK
  }
}

#ifndef ATTN_STORE16
#define ATTN_STORE16(p,v) (*(u32x4*)(p)=(v))
#endif
template<int THRL> __device__ __forceinline__ void attn_unit(int b,int h,int qb,const bf16*Q,const bf16*__restrict__ K,const bf16*__restrict__ V,bf16*O,char*shm,int wv){
  const int tid=mktid(wv),lane=tid&63,r32=lane&31,hi=lane>>5;     const int wid=__builtin_amdgcn_readfirstlane(tid>>6);
  const long rowbase=(long)b*SEQ; const int q0=qb*QB;
  if(qb>3){ float*KMl=(float*)(shm+LDS_KM); float*KPl=(float*)(shm+LDS_KP); const int c8=tid&7, rl=tid>>3;
    for(int n=0;n<qb;++n){ float sm[8];
      #pragma unroll
      for(int d=0;d<8;++d)sm[d]=0.f;
      #pragma unroll
      for(int rr=0;rr<4;++rr){ const u32x4 w=*reinterpret_cast<const u32x4*>(K+(rowbase+n*256+rl+64*rr)*PK+h*D+8*c8);
        sm[0]+=__uint_as_float(w[0]<<16);sm[1]+=__uint_as_float(w[0]&0xffff0000u);sm[2]+=__uint_as_float(w[1]<<16);sm[3]+=__uint_as_float(w[1]&0xffff0000u);
        sm[4]+=__uint_as_float(w[2]<<16);sm[5]+=__uint_as_float(w[2]&0xffff0000u);sm[6]+=__uint_as_float(w[3]<<16);sm[7]+=__uint_as_float(w[3]&0xffff0000u); }
      #pragma unroll
      for(int d=0;d<8;++d){ float v=sm[d];
        v+=__builtin_bit_cast(float,__builtin_amdgcn_ds_swizzle(__builtin_bit_cast(int,v),0x201F));
        v+=__builtin_bit_cast(float,__builtin_amdgcn_ds_swizzle(__builtin_bit_cast(int,v),0x401F));
        { const unsigned u=__builtin_bit_cast(unsigned,v); auto rr2=__builtin_amdgcn_permlane32_swap(u,u,false,false); v=__uint_as_float((unsigned)rr2[0])+__uint_as_float((unsigned)rr2[1]); }
        sm[d]=v; }
      if(lane<8){
        #pragma unroll
        for(int d=0;d<8;++d)KPl[wid*64+8*lane+d]=sm[d]; }
      asm volatile("s_waitcnt vmcnt(0) lgkmcnt(0)\n\ts_barrier":::"memory");
      if(tid<64){ float s8=0.f;
        #pragma unroll
        for(int w8=0;w8<8;++w8)s8+=KPl[w8*64+tid];
        KMl[n*64+tid]=s8*(1.0f/256.0f); }
      asm volatile("s_waitcnt lgkmcnt(0)\n\ts_barrier":::"memory"); } }
  if(tid<QB){ unsigned sel=(qb<=3)?((1u<<qb)-1u):0u;
    if(qb>3){ const bf16*qp=Q+(rowbase+q0+tid)*PQ+h*D; const float*km=(const float*)(shm+LDS_KM); float gate[7];
      #pragma unroll
      for(int j=0;j<7;++j)gate[j]=0.f;
      #pragma unroll 1
      for(int i=0;i<8;++i){ const u32x4 w=*reinterpret_cast<const u32x4*>(qp+8*i); float qv[8];
        qv[0]=__uint_as_float(w[0]<<16);qv[1]=__uint_as_float(w[0]&0xffff0000u);qv[2]=__uint_as_float(w[1]<<16);qv[3]=__uint_as_float(w[1]&0xffff0000u);
        qv[4]=__uint_as_float(w[2]<<16);qv[5]=__uint_as_float(w[2]&0xffff0000u);qv[6]=__uint_as_float(w[3]<<16);qv[7]=__uint_as_float(w[3]&0xffff0000u);
        #pragma unroll
        for(int j=0;j<7;++j) if(j<qb){ const float*kp=km+j*64+8*i;
          #pragma unroll
          for(int d=0;d<8;++d)gate[j]+=qv[d]*kp[d]; } }
      #pragma unroll
      for(int rep=0;rep<3;++rep){ float best=-INFINITY; int bi=0;
        #pragma unroll
        for(int j=0;j<7;++j) if(j<qb&&!((sel>>j)&1u)&&gate[j]>best){best=gate[j];bi=j;}
        sel|=1u<<bi; } }
    ((unsigned char*)(shm+LDS_SEL))[tid]=(unsigned char)sel; }
  asm volatile("s_waitcnt vmcnt(0) lgkmcnt(0)\n\ts_barrier":::"memory");
  const bf16*Qw=Q+(rowbase+q0+wid*QBLK)*PQ+h*D;
  const bf16*Kh=K+rowbase*PK+h*D,*Vh=V+rowbase*PV+h*D;
  const unsigned lds0=(unsigned)(uintptr_t)shm;
  float*wsf=(float*)(shm+LDS_WS)+wid*64;
  const bf16*ksrc=Kh+(long)lane*PK+wid*8;
  const bf16*vsrc=Vh+(long)(16*(wid&3)+(lane>>2))*PV+(wid>>2)*32+(lane&3)*8;
  const unsigned kdst=lds0+LDS_K+wid*1024, vdst=lds0+LDS_V+wid*1024;
  #define TROW(t) ((long)(((t)<4)?(q0+(t)*KVBLK):(((t)-4)*KVBLK)))
  #define DMA_K(t,slot) glds16(ksrc+TROW(t)*PK,(unsigned)__builtin_amdgcn_readfirstlane(kdst+(slot)))
  #define DMA_V(t,slot) glds16(vsrc+TROW(t)*PV,(unsigned)__builtin_amdgcn_readfirstlane(vdst+(slot)))
  const int vb0=(int)(lds0+LDS_V)+((lane>>4)&1)*32+(lane&3)*8+(4*hi+((lane&15)>>2))*64;
  const char*Kbase=shm+LDS_K; bf16x8 kf[8];
  const lds_cptr shm3=(lds_cptr)shm; const lds_cptr kp0=shm3+LDS_K+hi*1024+r32*16; const lds_cptr vp0=shm3+LDS_V+((lane>>4)&1)*32+(lane&3)*8+(4*hi+((lane&15)>>2))*64;
  const int NT=(q0+QB)/KVBLK;
  DMA_K(0,0);DMA_V(0,0);DMA_K(1,SLOTB);
  bf16x8 qr[4];
  #pragma unroll
  for(int d0=0;d0<4;++d0)qr[d0]=*reinterpret_cast<const bf16x8*>(&Qw[(long)r32*PQ+d0*16+hi*8]);
  float mhat=0.f,l_reg=0.f;f32x16 o[2];o[0]=f32x16{};o[1]=f32x16{};
  const int qrel=wid*QBLK+r32;
  const unsigned selb=((const unsigned char*)(shm+LDS_SEL))[qrel];
  #define CMASK(P0,P1,t) cmask(P0,P1,(t),qrel,hi)
  #define SUBREF(C0,C1,t) do{ const float sb_=(((t)<4)||((selb>>(((t)-4)>>2))&1u))?mhat:INFINITY; _Pragma("unroll") for(int r_=0;r_<16;++r_){C0[r_]-=sb_;C1[r_]-=sb_;} }while(0)
  bool resc=false;
  #define START(P0,P1) do{ const float rm=rowmax(P0,P1); resc=false; \
    { const float dl=rm; mhat=fadd_s(mhat,dl); \
      _Pragma("unroll") for(int r=0;r<16;++r){P0[r]=fsub_s(P0[r],dl);P1[r]=fsub_s(P1[r],dl);} \
      } \
    _Pragma("unroll") for(int r=0;r<16;++r)P0[r]=__builtin_amdgcn_exp2f(P0[r]); }while(0)
  #define RESC() do{ if(resc){ asm volatile("s_waitcnt lgkmcnt(0)":::"memory"); \
      _Pragma("unroll") for(int d_=0;d_<2;++d_) _Pragma("unroll") for(int r=0;r<16;++r)o[d_][r]*=wsf[crow(r,hi)]; } }while(0)
  f32x16 pA0,pA1,pB0,pB1;
  int sl_prev=0,sl_cur=0,sl_next=SLOTB;
  #define ROT() do{sl_prev=sl_cur;sl_cur=sl_next;sl_next=(sl_next==(NSLOT-1)*SLOTB)?0:sl_next+SLOTB;}while(0)
  DMA_K(2,2*SLOTB);
  WAIT_BAR(3);
  qkt(pA0,pA1,Kbase,qr,f32x16{},r32,hi);asm volatile("s_nop 15\n\ts_nop 7":"+v"(pA0),"+v"(pA1));CMASK(pA0,pA1,0);
  START(pA0,pA1);
  _Pragma("unroll") for(int r=0;r<16;++r)pA1[r]=__builtin_amdgcn_exp2f(pA1[r]);
  WAIT_BAR(0);
  DMA_K(3,0);DMA_V(1,SLOTB);
  ROT();
  kload8(kf,kp0+sl_cur);
  WAIT_BAR(2);
  s16x4 vlo[8],vhi[8]; u32x4 pw0,pw1,pw2,pw3;
  #define PKW(P,B) cvtpk_s(P[B],P[B+1])
  #define PAF(k) __builtin_bit_cast(bf16x8,pw##k)
  #define VFR(i) (bf16x8){vlo[i][0],vlo[i][1],vlo[i][2],vlo[i][3],vhi[i][0],vhi[i][1],vhi[i][2],vhi[i][3]}
  #define PIN(x) asm volatile("":"+v"(x))
  #define MX3(a,b,c) __builtin_fmaxf(__builtin_fmaxf((a),(b)),(c))
  #define GAPA(MF,A0,A1,A2,A3,W0,W1,PW) do{ MF; sacc+=A0; sacc+=A1; sacc+=A2; sacc+=A3; PIN(sacc); W0; W1; PIN(PW); SBAR(); }while(0)
  #define EX(v) __builtin_amdgcn_exp2f(v)
  #define GAPB(MF,X,B) do{ MF; X[B]=EX(X[B]); X[B+1]=EX(X[B+1]); X[B+2]=EX(X[B+2]); X[B+3]=EX(X[B+3]); PIN(X); SBAR(); }while(0)
  #define VRD(i) do{ vlo[i]=vtr(vp_+(((i)>>2)*4096+((i)&3)*1024)); vhi[i]=vtr(vp_+(((i)>>2)*4096+((i)&3)*1024+512)); }while(0)
  #define KRD(G,j) do{ if(G){ kload2(kf,kp0+sl_next,j); SBAR(); } }while(0)
  #define STEP(C0,C1,P0,P1,t,GK,GV,GL,MB) do{ SBAR(); \
    const lds_cptr vp_=vp0+sl_prev; \
    VRD(0); SBAR(); float sacc=(P0[0]+P0[1]); \
    GAPA(C0=__builtin_amdgcn_mfma_f32_32x32x16_bf16(kf[0],qr[0],f32x16{},0,0,0), P0[2],P0[3],P0[4],P0[5],     pw0[0]=PKW(P0,0), pw0[1]=PKW(P0,2), pw0); \
    VRD(4); SBAR(); GAPA(C1=__builtin_amdgcn_mfma_f32_32x32x16_bf16(kf[1],qr[0],f32x16{},0,0,0), P0[6],P0[7],P0[8],P0[9],     pw0[2]=PKW(P0,4), pw0[3]=PKW(P0,6), pw0); \
    VRD(1); SBAR(); GAPA(C0=__builtin_amdgcn_mfma_f32_32x32x16_bf16(kf[2],qr[1],C0,0,0,0),   P0[10],P0[11],P0[12],P0[13], pw1[0]=PKW(P0,8), pw1[1]=PKW(P0,10), pw1); \
    VRD(5); SBAR(); GAPA(C1=__builtin_amdgcn_mfma_f32_32x32x16_bf16(kf[3],qr[1],C1,0,0,0),   P0[14],P0[15],P1[0],P1[1],   pw1[2]=PKW(P0,12),pw1[3]=PKW(P0,14), pw1); \
    VRD(2); SBAR(); GAPA(C0=__builtin_amdgcn_mfma_f32_32x32x16_bf16(kf[4],qr[2],C0,0,0,0),   P1[2],P1[3],P1[4],P1[5],     pw2[0]=PKW(P1,0), pw2[1]=PKW(P1,2), pw2); \
    VRD(6); SBAR(); GAPA(C1=__builtin_amdgcn_mfma_f32_32x32x16_bf16(kf[5],qr[2],C1,0,0,0),   P1[6],P1[7],P1[8],P1[9],     pw2[2]=PKW(P1,4), pw2[3]=PKW(P1,6), pw2); \
    VRD(3); SBAR(); GAPA(C0=__builtin_amdgcn_mfma_f32_32x32x16_bf16(kf[6],qr[3],C0,0,0,0),   P1[10],P1[11],P1[12],P1[13], pw3[0]=PKW(P1,8), pw3[1]=PKW(P1,10), pw3); \
    VRD(7); SBAR(); GAPA(C1=__builtin_amdgcn_mfma_f32_32x32x16_bf16(kf[7],qr[3],C1,0,0,0),   P1[14],P1[15],0.f,0.f,       pw3[2]=PKW(P1,12),pw3[3]=PKW(P1,14), pw3); \
    l_reg+=sacc; \
    if(GK){DMA_K((t)+3,sl_cur);} if(GV){DMA_V((t)+1,sl_next);} \
    SUBREF(C0,C1,t); if(MB){CMASK(C0,C1,t);} \
    { float a=MX3(C0[0],C0[1],C1[0]),b=MX3(C0[2],C0[3],C1[1]); a=MX3(a,C1[2],C1[3]); \
      _Pragma("unroll") for(int r=4;r<16;r+=4){a=MX3(a,C0[r],C0[r+1]);b=MX3(b,C0[r+2],C0[r+3]);a=MX3(a,C1[r],C1[r+1]);b=MX3(b,C1[r+2],C1[r+3]);} \
      float rm=__builtin_fmaxf(a,b); { auto rr=__builtin_amdgcn_permlane32_swap(__float_as_uint(rm),__float_as_uint(rm),false,false); rm=__builtin_fmaxf(__uint_as_float(rr[0]),__uint_as_float(rr[1])); } \
      resc=false; \
      if(__builtin_expect(__any(rm>(float)THRL),0)){ const float dl=__builtin_fmaxf(rm,0.f); mhat+=dl; \
        _Pragma("unroll") for(int r=0;r<16;++r){C0[r]-=dl;C1[r]-=dl;} \
        const float f=__builtin_amdgcn_exp2f(-dl); l_reg*=f; if(hi==0)wsf[r32]=f; resc=true; } } \
    SBAR(); \
    GAPB(o[0]=__builtin_amdgcn_mfma_f32_32x32x16_bf16(PAF(0),VFR(0),o[0],0,0,0), C0,0); \
    GAPB(o[1]=__builtin_amdgcn_mfma_f32_32x32x16_bf16(PAF(0),VFR(4),o[1],0,0,0), C0,4); \
    KRD(GL,0); GAPB(o[0]=__builtin_amdgcn_mfma_f32_32x32x16_bf16(PAF(1),VFR(1),o[0],0,0,0), C0,8); \
    KRD(GL,1); GAPB(o[1]=__builtin_amdgcn_mfma_f32_32x32x16_bf16(PAF(1),VFR(5),o[1],0,0,0), C0,12); \
    KRD(GL,2); GAPB(o[0]=__builtin_amdgcn_mfma_f32_32x32x16_bf16(PAF(2),VFR(2),o[0],0,0,0), C1,0); \
    KRD(GL,3); GAPB(o[1]=__builtin_amdgcn_mfma_f32_32x32x16_bf16(PAF(2),VFR(6),o[1],0,0,0), C1,4); \
    GAPB(o[0]=__builtin_amdgcn_mfma_f32_32x32x16_bf16(PAF(3),VFR(3),o[0],0,0,0), C1,8); \
    GAPB(o[1]=__builtin_amdgcn_mfma_f32_32x32x16_bf16(PAF(3),VFR(7),o[1],0,0,0), C1,12); \
    }while(0)
  #define ENDW(tt) do{ if((tt)+3<NT){WAIT_BAR(2);} else if((tt)+2<NT){WAIT_BAR(1);} else {WAIT_BAR(0);} }while(0)
  { int t=1;
    for(;t+1<NT;t+=2){
      STEP(pB0,pB1,pA0,pA1,t,(t+3<NT),(t+1<NT),(t+1<NT),(t<4));       ENDW(t);   RESC(); ROT();
      STEP(pA0,pA1,pB0,pB1,t+1,(t+4<NT),(t+2<NT),(t+2<NT),(t+1<4));     ENDW(t+1); RESC(); ROT();
    }
    STEP(pB0,pB1,pA0,pA1,NT-1,false,false,false,(NT==4)); RESC();
  }
  { float sacc=pB0[0]+pB0[1]; _Pragma("unroll") for(int r=2;r<16;++r)sacc+=pB0[r]; _Pragma("unroll") for(int r=0;r<16;++r)sacc+=pB1[r]; l_reg+=sacc;
    pw0=(u32x4){PKW(pB0,0),PKW(pB0,2),PKW(pB0,4),PKW(pB0,6)};pw1=(u32x4){PKW(pB0,8),PKW(pB0,10),PKW(pB0,12),PKW(pB0,14)};pw2=(u32x4){PKW(pB1,0),PKW(pB1,2),PKW(pB1,4),PKW(pB1,6)};pw3=(u32x4){PKW(pB1,8),PKW(pB1,10),PKW(pB1,12),PKW(pB1,14)};
    SBAR(); pv(o,vb0+sl_cur,PAF(0),PAF(1),PAF(2),PAF(3)); }
  #undef PKW
  #undef PAF
  #undef VFR
  #undef PIN
  #undef MX3
  #undef GAPA
  #undef GAPB
  #undef EX
  #undef VRD
  #undef KRD
  #undef STEP
  #undef ENDW
  {auto rr=__builtin_amdgcn_permlane32_swap(__float_as_uint(l_reg),__float_as_uint(l_reg),false,false);l_reg=__uint_as_float(rr[0])+__uint_as_float(rr[1]);}
  if(hi==0)wsf[32+r32]=l_reg;asm volatile("s_waitcnt lgkmcnt(0)":::"memory");
  float rli[16];
  #pragma unroll
  for(int r=0;r<16;++r)rli[r]=__builtin_amdgcn_rcpf(wsf[32+crow(r,hi)]);
  bf16*Ow=O+(rowbase+q0+wid*QBLK)*PO+h*D;
  { bf16*stg=(bf16*)(shm+LDS_OST)+wid*2048;
    #pragma unroll
    for(int r=0;r<16;++r){const int orow=crow(r,hi);
      #pragma unroll
      for(int d0=0;d0<2;++d0)stg[orow*64+d0*32+r32]=__float2bfloat16(o[d0][r]*rli[r]);}
    asm volatile("s_waitcnt lgkmcnt(0)":::"memory");
    #pragma unroll
    for(int i=0;i<4;++i){const int row=i*8+(lane>>3),ch=lane&7; const u32x4 v=*(const u32x4*)(stg+row*64+ch*8); ATTN_STORE16(Ow+(long)row*PO+ch*8,v);} }
  asm volatile("s_waitcnt lgkmcnt(0)\n\ts_barrier":::"memory");
  #undef DMA_K
  #undef TROW
  #undef SUBREF
  #undef DMA_V
  #undef CMASK
  #undef START
  #undef RESC
  #undef ROT
}
constexpr int ATTN_LDS_BYTES=LDS_BYTES;
#undef SBAR
#undef WAIT_BAR
}
constexpr int DM = 1024, NB = 16, SEQ = 2048, NT = NB * SEQ;
constexpr int RWW = 512, WIN_N = 5376, INC = 4352, ZV = 1792, ZG = 2304;
constexpr int NEXP = 32, DEXP = 512;
constexpr int XS_ROWS = 2 * NT + NEXP * 256;
constexpr float C2 = 0.125f * 1.4426950408889634f;

#define LAS __attribute__((address_space(3)))
#define GAS __attribute__((address_space(1)))
typedef unsigned short bf16;
typedef unsigned v4u __attribute__((ext_vector_type(4)));
typedef unsigned v2u __attribute__((ext_vector_type(2)));
typedef float f32x4 __attribute__((ext_vector_type(4)));

typedef float f32x2_c __attribute__((ext_vector_type(2))); typedef __bf16 bf16x2_c __attribute__((ext_vector_type(2)));
__device__ __forceinline__ unsigned pk2(float lo, float hi) { const f32x2_c v = {lo, hi}; return __builtin_bit_cast(unsigned, __builtin_convertvector(v, bf16x2_c)); }
__device__ __forceinline__ unsigned f2bf(float f) { return pk2(f, f) & 0xffffu; }
__device__ __forceinline__ float bflo(unsigned w) { return __builtin_bit_cast(float, w << 16); }
__device__ __forceinline__ float bfhi(unsigned w) { return __builtin_bit_cast(float, w & 0xffff0000u); }
__device__ __forceinline__ float sigm(float x) { return __builtin_amdgcn_rcpf(1.0f + __expf(-x)); }

constexpr size_t MiB = 1u << 20;
constexpr size_t WS_CTL = 0;
constexpr size_t WS_MOD = 1 * MiB;
constexpr size_t WS_GM2 = 1 * MiB + 512 * 1024;
constexpr size_t WS_CB = 1 * MiB + 640 * 1024;
constexpr size_t WS_COS = 2 * MiB;
constexpr size_t WS_SIN = 2 * MiB + 512 * 1024;
constexpr size_t WS_KMEAN = 3 * MiB;
constexpr size_t WS_WRH = 3 * MiB + 512 * 1024;
constexpr size_t WS_WRL = 3 * MiB + 768 * 1024;
constexpr size_t WS_SEL = 4 * MiB;
constexpr size_t WS_RTE = 5 * MiB;
constexpr size_t WS_RTW = 5 * MiB + 256 * 1024;
constexpr size_t WS_RNK = 5 * MiB + 512 * 1024;
constexpr size_t WS_POS = 5 * MiB + 768 * 1024;
constexpr size_t WS_RSTD = 7 * MiB;
constexpr size_t WS_WLT = 6 * MiB;
constexpr size_t WS_WAT = 6 * MiB + 64 * 1024;
constexpr size_t WS_WGT = 6 * MiB + 128 * 1024;
constexpr size_t WS_WIN = 16 * MiB;
constexpr size_t WS_WBA = 27 * MiB;
constexpr size_t WS_WBB = 28 * MiB;
constexpr size_t WS_WOUT = 29 * MiB;
constexpr size_t WS_Z = 32 * MiB;
constexpr size_t WS_H = 368 * MiB;
constexpr size_t WS_Q = 304 * MiB, WS_K = 336 * MiB, WS_MRG = 304 * MiB;
constexpr size_t WS_YA = 432 * MiB, WS_YB = 464 * MiB;
constexpr size_t WS_WUP = 368 * MiB;
constexpr size_t WS_H2 = 128 * MiB;
constexpr size_t WS_XS = 64 * MiB;
constexpr size_t WS_HID = 208 * MiB;
constexpr size_t WS_X1B = 432 * MiB;
constexpr size_t WS_ACT = 496 * MiB;
constexpr size_t WS_END = 512 * MiB;
constexpr int CW_CNT = 64, CNT_PAD = 64;
constexpr int CW_NT = 2304;
constexpr int CW_TEXP = 2368;
static_assert(CW_CNT + NEXP * CNT_PAD <= CW_NT, "control words");

__device__ __forceinline__ void tr_item(const float* W, int K, int N, bf16* WT, int kb, int nb, int dst_row0, LAS float* scr, int lane) {
    const int k0 = 64 * kb, n0 = 32 * nb;
#pragma unroll
    for (int i = 0; i < 32; ++i) { const int kk = 2 * i + (lane >> 5); scr[kk * 33 + (lane & 31)] = W[(size_t)(k0 + kk) * N + n0 + (lane & 31)]; }
    asm volatile("s_waitcnt lgkmcnt(0)" ::: "memory");
    const int c = lane & 7;
#pragma unroll
    for (int j = 0; j < 4; ++j) { const int n = (lane >> 3) + 8 * j; const LAS float* s = scr + (8 * c) * 33 + n;
        v4u o; o.x = pk2(s[0 * 33], s[1 * 33]); o.y = pk2(s[2 * 33], s[3 * 33]); o.z = pk2(s[4 * 33], s[5 * 33]); o.w = pk2(s[6 * 33], s[7 * 33]);
        *(v4u*)(WT + (size_t)(dst_row0 + n) * K + k0 + 8 * c) = o; }
    asm volatile("s_waitcnt lgkmcnt(0)" ::: "memory");
}

struct PArgs { const float* in[30]; float* out; unsigned char* ws; };

__device__ __forceinline__ void p_prep_weights(const PArgs& a, unsigned char* lds, int wv) {
    const int tid = mktid(wv), lane = tid & 63, wave = tid >> 6;
    LAS float* scr = (LAS float*)lds + wave * (64 * 33);
    const int gw = blockIdx.x * 8 + wave, NGW = gridDim.x * 8;
    unsigned char* ws = a.ws;
    constexpr int I_IN = 16 * 168, I_BR = 8 * 32, I_OUT = 16 * 32;
    for (int it = gw; it < I_IN + 2 * I_BR + I_OUT; it += NGW) {
        int r = it;
        if (r < I_IN) { const int kb = r / 168, nb = r % 168; int dst = 32 * nb;
            if (dst >= 1792 && dst < 2816) { const int rel = dst - 1792, u = rel >> 8, hl = (rel & 255) >> 6, half = (rel & 63) >> 5; dst = 1792 + u * 256 + half * 128 + hl * 32; }
            tr_item(a.in[6], 1024, WIN_N, (bf16*)(ws + WS_WIN), kb, nb, dst, scr, lane); continue; } r -= I_IN;
        if (r < I_BR) { const int kb = r / 32, nb = r % 32; tr_item(a.in[20], 512, 1024, (bf16*)(ws + WS_WBA), kb, nb, 32 * nb, scr, lane); continue; } r -= I_BR;
        if (r < I_BR) { const int kb = r / 32, nb = r % 32; tr_item(a.in[21], 512, 1024, (bf16*)(ws + WS_WBB), kb, nb, 32 * nb, scr, lane); continue; } r -= I_BR;
        { const int kb = r / 32, nb = r % 32; tr_item(a.in[22], 1024, 1024, (bf16*)(ws + WS_WOUT), kb, nb, 32 * nb, scr, lane); }
    }
    const int gt = blockIdx.x * 512 + tid, NGT = gridDim.x * 512;
    float* cosT = (float*)(ws + WS_COS); float* sinT = (float*)(ws + WS_SIN);
    for (int i = gt; i < SEQ * 32; i += NGT) { const int s = i >> 5, f = i & 31; const float inv = powf(10000.0f, -(float)f / 32.0f); const float ang = (float)s * inv; cosT[i] = cosf(ang); sinT[i] = sinf(ang); }
    { bf16* wlt = (bf16*)(ws + WS_WLT); bf16* wat = (bf16*)(ws + WS_WAT); bf16* wgt = (bf16*)(ws + WS_WGT);
      for (int i = gt; i < 8 * 64 * 64; i += NGT) { const int hh = i >> 12, j = (i >> 6) & 63, m = i & 63; wlt[i] = (bf16)f2bf(a.in[9][m * 512 + hh * 64 + j]); wat[i] = (bf16)f2bf(a.in[11][m * 512 + hh * 64 + j]); }
      for (int i = gt; i < 8 * 64 * 128; i += NGT) { const int hh = i >> 13, j = (i >> 7) & 63, m = i & 127; wgt[i] = (bf16)f2bf(a.in[12][m * 512 + hh * 64 + j]); } }
    { bf16* wrh = (bf16*)(ws + WS_WRH); bf16* wrl = (bf16*)(ws + WS_WRL);
      for (int i = gt; i < 48 * 1024; i += NGT) { const int e = i >> 10, k = i & 1023; const float w = e < 4 ? a.in[23][k * 4 + e] : e < 36 ? a.in[25][k * 32 + (e - 4)] : 0.f;
          const unsigned hi = f2bf(w); wrh[i] = (bf16)hi; wrl[i] = (bf16)f2bf(w - bflo(hi)); } }
}

constexpr int CW_ZCNT = 3136, CW_AQ = 3200;
constexpr int CW_BAR = 4096, XB_TMO_W = 128, DOWN_MSK_OFF = 160 * 1024 - 256 + 64;
constexpr int CW_TCNT = 8192, TCNT_STRIDE = 16;
constexpr int CW_PEXP = 2816;
__device__ __forceinline__ void p_prep_experts_dyn(const PArgs& a, unsigned char* lds, int wv) {
    const int tid = mktid(wv), lane = tid & 63, wave = tid >> 6;
    LAS float* scr = (LAS float*)lds + wave * (64 * 33);
    unsigned* ctr = (unsigned*)(a.ws + WS_CTL) + CW_PEXP;
    constexpr int NITEM = NEXP * 768;
    for (;;) {
        unsigned base = 0; if (lane == 0) base = atomicAdd(ctr, 16u);
        base = (unsigned)__builtin_amdgcn_readfirstlane((int)base);
        if (base >= (unsigned)NITEM) break;
        for (int it = (int)base; it < (int)base + 16 && it < NITEM; ++it) {
            const int e = it / 768; int r = it % 768;
            bf16* wup = (bf16*)(a.ws + WS_WUP) + (size_t)e * 1024 * 1024;
            if (r < 256) { const int kb = r / 16, nb = r % 16, n0 = 32 * nb; tr_item(a.in[27] + (size_t)e * 1024 * 512, 1024, 512, wup, kb, nb, (n0 >> 7) * 256 + (n0 & 127), scr, lane); continue; } r -= 256;
            if (r < 256) { const int kb = r / 16, nb = r % 16, n0 = 32 * nb; tr_item(a.in[28] + (size_t)e * 1024 * 512, 1024, 512, wup, kb, nb, (n0 >> 7) * 256 + 128 + (n0 & 127), scr, lane); continue; } r -= 256;
            { const int kb = r / 32, nb = r % 32; tr_item(a.in[29] + (size_t)e * 512 * 1024, 512, 1024, (bf16*)a.out + (size_t)e * 1024 * 512, kb, nb, 32 * nb, scr, lane); }
        }
    }
}

__device__ __forceinline__ void p_ada_load(const PArgs& a, int tile, int tid, float (&wr)[64]) {
    const float* w = a.in[2] + (size_t)((tid >> 5) * 64) * 6144 + tile * 32 + (tid & 31);
#pragma unroll
    for (int i = 0; i < 64; ++i) wr[i] = w[(size_t)i * 6144];
}
__device__ __forceinline__ void p_ada_finish(const PArgs& a, const float* sc, float* red, int tile, int tid, const float (&wr)[64]) {
    const float* bias = a.in[3]; float* mod = (float*)(a.ws + WS_MOD);
    const int col = tid & 31, kg = tid >> 5;
    float acc[16];
#pragma unroll
    for (int b = 0; b < 16; ++b) acc[b] = 0.f;
#pragma unroll
    for (int i = 0; i < 64; ++i)
#pragma unroll
        for (int b = 0; b < 16; ++b) acc[b] += sc[b * 1024 + kg * 64 + i] * wr[i];
#pragma unroll
    for (int b = 0; b < 16; ++b) red[(kg * 16 + b) * 32 + col] = acc[b];
    __syncthreads();
    { const int b = tid >> 5, cc = tid & 31; float sm = 0.f;
#pragma unroll
        for (int k = 0; k < 16; ++k) sm += red[(k * 16 + b) * 32 + cc];
        mod[b * 6144 + tile * 32 + cc] = sm + bias[tile * 32 + cc]; }
    __syncthreads();
}

__device__ __forceinline__ void p_norm1(const PArgs& a, unsigned char* lds, int wv) {
    const int tid = mktid(wv), lane = tid & 63, gw = blockIdx.x * 8 + (tid >> 6), NGW = gridDim.x * 8;
    const float* x = a.in[0]; const float* g = a.in[4]; const float* mod = (const float*)(a.ws + WS_MOD);
    bf16* h = (bf16*)(a.ws + WS_H);
    f32x4 v[4][4];
    { const f32x4* xr = (const f32x4*)(x + (size_t)(4 * gw < NT ? 4 * gw : 0) * DM) + lane;
#pragma unroll
      for (int r = 0; r < 4; ++r)
#pragma unroll
          for (int j = 0; j < 4; ++j) v[r][j] = __builtin_nontemporal_load(xr + 256 * r + 64 * j); }
    for (int m0 = 4 * gw; m0 < NT; m0 += 4 * NGW) {
        const int mn = m0 + 4 * NGW < NT ? m0 + 4 * NGW : m0;
        f32x4 nv[4][4];
        { const f32x4* xr = (const f32x4*)(x + (size_t)mn * DM) + lane;
#pragma unroll
          for (int r = 0; r < 4; ++r)
#pragma unroll
              for (int j = 0; j < 4; ++j) nv[r][j] = __builtin_nontemporal_load(xr + 256 * r + 64 * j); }
        const int b = m0 >> 11; float rstd[4];
#pragma unroll
        for (int r = 0; r < 4; ++r) { float s = 0.f;
#pragma unroll
            for (int j = 0; j < 4; ++j) s += (v[r][j].x * v[r][j].x + v[r][j].y * v[r][j].y) + (v[r][j].z * v[r][j].z + v[r][j].w * v[r][j].w);
            rstd[r] = rsqrtf(wave_sum(s) * (1.0f / DM) + 1e-6f); }
#pragma unroll
        for (int j = 0; j < 4; ++j) { const int col = 4 * (lane + 64 * j);
            const f32x4 gg = *(const f32x4*)(g + col), sh = *(const f32x4*)(mod + b * 6144 + col), scl = *(const f32x4*)(mod + b * 6144 + 1024 + col);
#pragma unroll
            for (int r = 0; r < 4; ++r) { const f32x4 q = v[r][j] * rstd[r] * gg * (scl + 1.0f) + sh; v2u w; w.x = pk2(q.x, q.y); w.y = pk2(q.z, q.w); ((v2u*)(h + (size_t)(m0 + r) * DM) + lane)[64 * j] = w; } }
#pragma unroll
        for (int r = 0; r < 4; ++r)
#pragma unroll
            for (int j = 0; j < 4; ++j) v[r][j] = nv[r][j];
    }
    { float* gm2 = (float*)(a.ws + WS_GM2); float* cb = (float*)(a.ws + WS_CB); const float* g2 = a.in[5];
      for (int i = blockIdx.x * 512 + tid; i < 16 * 1024; i += gridDim.x * 512) { const int b = i >> 10, k = i & 1023; gm2[i] = g2[k] * (1.0f + mod[b * 6144 + 4096 + k]); }
      for (int p = blockIdx.x + gridDim.x * (tid >> 6); p < 16 * 48; p += NGW) {    const int b = p / 48, n = p % 48; float s = 0.f;
          if (n < 36) { for (int k = lane; k < 1024; k += 64) { const float w = n < 4 ? a.in[23][k * 4 + n] : a.in[25][k * 32 + (n - 4)]; s += mod[b * 6144 + 3072 + k] * w; } }
          s = wave_sum(s); if (lane == 0) cb[p] = n < 4 ? s + a.in[24][n] : n < 36 ? s + a.in[26][n - 4] : 0.f; } }
}

using pg8::Unit; using pg8::HALF; using pg8::BM; using pg8::cvt_pk_bf16;
typedef pg8::f32x4 pf4; typedef pg8::u32x4 pu4;

struct EpiStoreBf16 {
    static constexpr bool PERM = true, AFTER_DRAIN = false, CHAIN = false;
    bf16* O; int ldc;
    __device__ __forceinline__ void operator()(const pf4 (&acc)[2][2][4][2], const Unit& u, int wr, int wc, int fr, int fq) const {
        const int row0 = u.pm * BM + wr * 64 + fr, col0 = u.pn * BM + wc * 32 + 8 * fq;
#pragma unroll
        for (int ai = 0; ai < 2; ++ai)
#pragma unroll
            for (int m = 0; m < 4; ++m) { bf16* rowp = O + (size_t)(row0 + ai * HALF + m * 16) * ldc + col0;
#pragma unroll
                for (int bj = 0; bj < 2; ++bj) { const pf4 v0 = acc[ai][bj][m][0], v1 = acc[ai][bj][m][1]; pu4 w;
                    w.x = cvt_pk_bf16(v0[0], v0[1]); w.y = cvt_pk_bf16(v0[2], v0[3]); w.z = cvt_pk_bf16(v1[0], v1[1]); w.w = cvt_pk_bf16(v1[2], v1[3]);
                    *(pu4*)(rowp + bj * HALF) = w; } }
    }
};
struct EpiZ {
    static constexpr bool PERM = true, AFTER_DRAIN = false, CHAIN = false;
    bf16* z; bf16* Q; bf16* K; const float* qg; const float* kg; const float* cosT; const float* sinT; unsigned* zcnt;
    __device__ __forceinline__ void operator()(const pf4 (&acc)[2][2][4][2], const Unit& u, int wr, int wc, int fr, int fq) const {
        const int row0 = u.pm * BM + wr * 64 + fr;
        if (u.pn == 6) {
            const __amdgpu_buffer_rsrc_t zr = __builtin_amdgcn_make_buffer_rsrc((void*)z, 0, NT * INC * 2, 0x00020000);
            const int zc = 6 * 256 + wc * 32 + 8 * fq;
#pragma unroll
            for (int ai = 0; ai < 2; ++ai)
#pragma unroll
                for (int m = 0; m < 4; ++m) { const unsigned rowb = (unsigned)(((row0 + ai * HALF + m * 16) * INC + zc) * 2);
#pragma unroll
                    for (int bj = 0; bj < 2; ++bj) { const pf4 v0 = acc[ai][bj][m][0], v1 = acc[ai][bj][m][1]; pu4 w;
                        w.x = cvt_pk_bf16(v0[0], v0[1]); w.y = cvt_pk_bf16(v0[2], v0[3]); w.z = cvt_pk_bf16(v1[0], v1[1]); w.w = cvt_pk_bf16(v1[2], v1[3]);
                        __builtin_amdgcn_raw_buffer_store_b128(w, zr, rowb + (unsigned)(bj * HALF * 2), 0,   16); } }
            asm volatile("s_waitcnt vmcnt(0)" ::: "memory");
            if (fr == 0 && fq == 0) (void)__hip_atomic_fetch_add(zcnt, 1u, __ATOMIC_RELAXED, __HIP_MEMORY_SCOPE_AGENT);
            return;
        }
        if (u.pn < 7 || u.pn >= 11) {
            const int zc = (u.pn < 7 ? u.pn * 256 : (u.pn - 11) * 256 + 1792) + wc * 32 + 8 * fq;
#pragma unroll
            for (int ai = 0; ai < 2; ++ai)
#pragma unroll
                for (int m = 0; m < 4; ++m) { bf16* rowp = z + (size_t)(row0 + ai * HALF + m * 16) * INC + zc;
#pragma unroll
                    for (int bj = 0; bj < 2; ++bj) { const pf4 v0 = acc[ai][bj][m][0], v1 = acc[ai][bj][m][1]; pu4 w;
                        w.x = cvt_pk_bf16(v0[0], v0[1]); w.y = cvt_pk_bf16(v0[2], v0[3]); w.z = cvt_pk_bf16(v1[0], v1[1]); w.w = cvt_pk_bf16(v1[2], v1[3]);
                        *(pu4*)(rowp + bj * HALF) = w; } }
            return;
        }
        const bool isk = u.pn >= 9; const int head = 4 * ((u.pn - 7) & 1) + wc; const float* g = isk ? kg : qg; bf16* O = (isk ? K : Q) + head * 64 + 8 * fq;
        const float osc = isk ? 1.0f : C2;
        pf4 gl[2][2];
#pragma unroll
        for (int bj = 0; bj < 2; ++bj)
#pragma unroll
            for (int n = 0; n < 2; ++n) gl[bj][n] = *(const pf4*)(g + 32 * bj + 8 * fq + 4 * n);
#pragma unroll
        for (int aim = 0; aim < 4; ++aim) { const int ai = aim >> 1, m0 = 2 * (aim & 1);
            pf4 ct[2][2], st[2][2];
#pragma unroll
            for (int mm = 0; mm < 2; ++mm) { const int s = (row0 + ai * HALF + (m0 + mm) * 16) & (SEQ - 1);
#pragma unroll
                for (int n = 0; n < 2; ++n) { ct[mm][n] = *(const pf4*)(cosT + s * 32 + 8 * fq + 4 * n); st[mm][n] = *(const pf4*)(sinT + s * 32 + 8 * fq + 4 * n); } }
#pragma unroll
            for (int mm = 0; mm < 2; ++mm) { const int m = m0 + mm; const int row = row0 + ai * HALF + m * 16;
                float ss = 0.f;
#pragma unroll
                for (int bj = 0; bj < 2; ++bj)
#pragma unroll
                    for (int n = 0; n < 2; ++n) { const pf4 v = acc[ai][bj][m][n]; ss += (v[0] * v[0] + v[1] * v[1]) + (v[2] * v[2] + v[3] * v[3]); }
                ss += __builtin_bit_cast(float, __builtin_amdgcn_ds_swizzle(__builtin_bit_cast(int, ss), 0x401F));
                { const unsigned uu = __builtin_bit_cast(unsigned, ss); auto rr = __builtin_amdgcn_permlane32_swap(uu, uu, false, false); ss = __builtin_bit_cast(float, (unsigned)rr[0]) + __builtin_bit_cast(float, (unsigned)rr[1]); }
                const float rstd = rsqrtf(ss * (1.0f / 64.0f) + 1e-6f);
#pragma unroll
                for (int n = 0; n < 2; ++n) { const pf4 x1 = acc[ai][0][m][n] * rstd * gl[0][n], x2 = acc[ai][1][m][n] * rstd * gl[1][n];
                    const pf4 o1 = x1 * ct[mm][n] - x2 * st[mm][n], o2 = x2 * ct[mm][n] + x1 * st[mm][n];
                    v2u wa, wb; wa.x = cvt_pk_bf16(o1[0] * osc, o1[1] * osc); wa.y = cvt_pk_bf16(o1[2] * osc, o1[3] * osc); wb.x = cvt_pk_bf16(o2[0] * osc, o2[1] * osc); wb.y = cvt_pk_bf16(o2[2] * osc, o2[3] * osc);
                    bf16* op = O + (size_t)row * 512 + 4 * n; *(v2u*)op = wa; *(v2u*)(op + 32) = wb; } }
            asm volatile("" ::: "memory");
        }
    }
};
struct EpiMerge {
    static constexpr bool PERM = true, AFTER_DRAIN = false, CHAIN = true;
    const bf16* z; bf16* mrg;
    __device__ __forceinline__ bool chain(pf4 (&acc)[2][2][4][2], const Unit& u, int wr, int wc, int fr, int fq) const {
        const int row0 = u.pm * BM + wr * 64 + fr, col0 = u.pn * BM + wc * 32 + 8 * fq;
        if (u.aux == 0) {
#pragma unroll
            for (int ai = 0; ai < 2; ++ai) {
                pu4 za[4][2], zb[4][2];
#pragma unroll
                for (int m = 0; m < 4; ++m) { const size_t row = (size_t)(row0 + ai * HALF + m * 16);
#pragma unroll
                    for (int bj = 0; bj < 2; ++bj) { const int col = col0 + bj * HALF; za[m][bj] = *(const pu4*)(z + row * INC + ZG + col); zb[m][bj] = *(const pu4*)(z + row * INC + ZG + 1024 + col); } }
#pragma unroll
                for (int m = 0; m < 4; ++m)
#pragma unroll
                    for (int bj = 0; bj < 2; ++bj) { const pu4 a4 = za[m][bj], b4 = zb[m][bj];
                        const float a8[8] = {bflo(a4.x), bfhi(a4.x), bflo(a4.y), bfhi(a4.y), bflo(a4.z), bfhi(a4.z), bflo(a4.w), bfhi(a4.w)};
                        const float b8[8] = {bflo(b4.x), bfhi(b4.x), bflo(b4.y), bfhi(b4.y), bflo(b4.z), bfhi(b4.z), bflo(b4.w), bfhi(b4.w)};
#pragma unroll
                        for (int e = 0; e < 8; ++e) acc[ai][bj][m][e >> 2][e & 3] *= (1.0f + __expf(-b8[e])) * __builtin_amdgcn_rcpf(1.0f + __expf(-a8[e])); }
                asm volatile("" ::: "memory");
            }
            return true;
        }
        pu4 gz[2][4][2];
#pragma unroll
        for (int ai = 0; ai < 2; ++ai)
#pragma unroll
            for (int m = 0; m < 4; ++m) { const size_t row = (size_t)(row0 + ai * HALF + m * 16);
#pragma unroll
                for (int bj = 0; bj < 2; ++bj) gz[ai][m][bj] = *(const pu4*)(z + row * INC + ZG + 1024 + col0 + bj * HALF); }
#pragma unroll
        for (int ai = 0; ai < 2; ++ai)
#pragma unroll
            for (int m = 0; m < 4; ++m) { const size_t row = (size_t)(row0 + ai * HALF + m * 16);
#pragma unroll
                for (int bj = 0; bj < 2; ++bj) { const int col = col0 + bj * HALF; const pu4 g4 = gz[ai][m][bj]; const pf4 v0 = acc[ai][bj][m][0], v1 = acc[ai][bj][m][1];
                    pu4 w;
                    w.x = cvt_pk_bf16(sigm(bflo(g4.x)) * v0[0], sigm(bfhi(g4.x)) * v0[1]); w.y = cvt_pk_bf16(sigm(bflo(g4.y)) * v0[2], sigm(bfhi(g4.y)) * v0[3]);
                    w.z = cvt_pk_bf16(sigm(bflo(g4.z)) * v1[0], sigm(bfhi(g4.z)) * v1[1]); w.w = cvt_pk_bf16(sigm(bflo(g4.w)) * v1[2], sigm(bfhi(g4.w)) * v1[3]);
                    *(pu4*)(mrg + row * DM + col) = w; } }
        return false;
    }
};
struct EpiOut {
    static constexpr bool PERM = true, AFTER_DRAIN = false, CHAIN = false;
    const float* x; const float* mod; bf16* x1;
    __device__ __forceinline__ void operator()(const pf4 (&acc)[2][2][4][2], const Unit& u, int wr, int wc, int fr, int fq) const {
        const int row0 = u.pm * BM + wr * 64 + fr, col0 = u.pn * BM + wc * 32 + 8 * fq; const int b = u.pm >> 3;
        pf4 gt[2][2];
#pragma unroll
        for (int bj = 0; bj < 2; ++bj)
#pragma unroll
            for (int n = 0; n < 2; ++n) gt[bj][n] = *(const pf4*)(mod + b * 6144 + 2048 + col0 + bj * HALF + n * 4);
#pragma unroll
        for (int ai = 0; ai < 2; ++ai) {
            pf4 xv[4][2][2];
#pragma unroll
            for (int m = 0; m < 4; ++m) { const size_t off = (size_t)(row0 + ai * HALF + m * 16) * DM + col0;
#pragma unroll
                for (int bj = 0; bj < 2; ++bj) { xv[m][bj][0] = *(const pf4*)(x + off + bj * HALF); xv[m][bj][1] = *(const pf4*)(x + off + bj * HALF + 4); } }
#pragma unroll
            for (int m = 0; m < 4; ++m) { const size_t off = (size_t)(row0 + ai * HALF + m * 16) * DM + col0;
#pragma unroll
                for (int bj = 0; bj < 2; ++bj) { const pf4 o0 = xv[m][bj][0] + gt[bj][0] * acc[ai][bj][m][0], o1 = xv[m][bj][1] + gt[bj][1] * acc[ai][bj][m][1]; pu4 w;
                    w.x = cvt_pk_bf16(o0[0], o0[1]); w.y = cvt_pk_bf16(o0[2], o0[3]); w.z = cvt_pk_bf16(o1[0], o1[1]); w.w = cvt_pk_bf16(o1[2], o1[3]);
                    *(pu4*)(x1 + off + bj * HALF) = w; } }
            asm volatile("" ::: "memory");
        }
    }
};
struct EpiUp {
    static constexpr bool PERM = true, AFTER_DRAIN = false, CHAIN = false;
    bf16* hid; unsigned* tcnt;
    __device__ __forceinline__ void operator()(const pf4 (&acc)[2][2][4][2], const Unit& u, int wr, int wc, int fr, int fq) const {
        const int row0 = u.pm * BM + wr * 64 + fr, col0 = u.pn * 128 + wc * 32 + 8 * fq;
        const __amdgpu_buffer_rsrc_t hr = __builtin_amdgcn_make_buffer_rsrc((void*)hid, 0, 96 << 20, 0x00020000);
#pragma unroll
        for (int ai = 0; ai < 2; ++ai)
#pragma unroll
            for (int m = 0; m < 4; ++m) { const int row = row0 + ai * HALF + m * 16; float o[8];
#pragma unroll
                for (int n = 0; n < 2; ++n)
#pragma unroll
                    for (int e = 0; e < 4; ++e) { const float g = acc[ai][0][m][n][e], l = acc[ai][1][m][n][e]; o[4 * n + e] = g * sigm(g) * l; }
                pu4 w; w.x = cvt_pk_bf16(o[0], o[1]); w.y = cvt_pk_bf16(o[2], o[3]); w.z = cvt_pk_bf16(o[4], o[5]); w.w = cvt_pk_bf16(o[6], o[7]);
                __builtin_amdgcn_raw_buffer_store_b128(w, hr, (unsigned)((row * DEXP + col0) * 2), 0,   16); }
        asm volatile("s_waitcnt vmcnt(0)" ::: "memory");
        if (fr == 0 && fq == 0) (void)__hip_atomic_fetch_add(tcnt + TCNT_STRIDE * u.pm, 1u, __ATOMIC_RELAXED, __HIP_MEMORY_SCOPE_AGENT);
    }
};

struct GemmArgs { unsigned char* ws; const float* x; float* out; const float* qg; const float* kg; };
template <class Epi> __device__ __forceinline__ void run_dense(const void* A, const void* Bt, int M, int N, int K, const Epi& E, unsigned char* lds, int wv) {
    pg8::Gemm g{K}; pg8::StaticOrder S; S.init(A, Bt, M, N, K, (int)gridDim.x, (int)blockIdx.x);
    pg8::gemm_phase<Epi, pg8::StaticOrder, true, true>((PG8_LAS unsigned char*)lds, g, S, E, wv);
}
__device__ __forceinline__ void p_gemm_in(const GemmArgs& a, unsigned char* lds, int wv) {
    EpiZ E{(bf16*)(a.ws + WS_Z), (bf16*)(a.ws + WS_Q), (bf16*)(a.ws + WS_K), a.qg, a.kg, (const float*)(a.ws + WS_COS), (const float*)(a.ws + WS_SIN), (unsigned*)(a.ws + WS_CTL) + CW_ZCNT};
    run_dense(a.ws + WS_H, a.ws + WS_WIN, NT, WIN_N, 1024, E, lds, wv);
}
struct PairOrder {
    int nM, nN, nwg, G, c; const char *A0, *A1, *B0, *B1; size_t tstep;
    __device__ bool next(int i, Unit& u) const {
        const long L = (long)(i >> 1) * G + c; if (L >= nwg) return false;
        int wgid = (int)L; { const int q = nwg / pg8::NXCD, r = nwg % pg8::NXCD, xcd = wgid % pg8::NXCD, off = wgid / pg8::NXCD; wgid = (xcd < r ? xcd * (q + 1) : r * (q + 1) + (xcd - r) * q) + off; }
        const int nig = pg8::WGM * nN, gid = wgid / nig, fm = gid * pg8::WGM, gsz = (nM - fm) < pg8::WGM ? (nM - fm) : pg8::WGM;
        u.pm = fm + ((wgid % nig) % gsz); u.pn = (wgid % nig) / gsz; u.aux = i & 1;
        u.a = ((i & 1) ? A1 : A0) + (size_t)u.pm * tstep; u.b = ((i & 1) ? B1 : B0) + (size_t)u.pn * tstep; return true;
    }
    __device__ __forceinline__ void a_ready(const Unit&) const {}
    __device__ __forceinline__ void done(const Unit&) const {}
};
__device__ __forceinline__ void p_gemm_merge(const GemmArgs& a, unsigned char* lds, int wv) {
    PairOrder S{NT / 256, 4, (NT / 256) * 4, (int)gridDim.x, (int)blockIdx.x, (const char*)(a.ws + WS_YA), (const char*)(a.ws + WS_YB), (const char*)(a.ws + WS_WBA), (const char*)(a.ws + WS_WBB), (size_t)256 * 512 * 2};
    EpiMerge E{(const bf16*)(a.ws + WS_Z), (bf16*)(a.ws + WS_MRG)}; pg8::Gemm g{512};
    pg8::gemm_phase<EpiMerge, PairOrder, true, true>((PG8_LAS unsigned char*)lds, g, S, E, wv);
}
__device__ __forceinline__ void p_gemm_out(const GemmArgs& a, unsigned char* lds, int wv) {
    EpiOut E{a.x, (const float*)(a.ws + WS_MOD), (bf16*)(a.ws + WS_X1B)};
    run_dense(a.ws + WS_MRG, a.ws + WS_WOUT, NT, 1024, 1024, E, lds, wv);
}
struct GroupedOrder {
    const int* texp; int nT, nN, G, c; const char* A; size_t a_tile; const char* B; size_t b_exp, b_tile;
    __device__ bool next(int i, Unit& u) const {
        const long L = (long)i * G + c; if (L >= (long)nT * nN) return false;
        const int tile = (int)(L / nN), pn = (int)(L % nN); u.aux = 0; u.pm = tile; u.pn = pn; u.a = A + (size_t)tile * a_tile; u.b = B + (size_t)texp[tile] * b_exp + (size_t)pn * b_tile; return true;
    }
    __device__ __forceinline__ void a_ready(const Unit&) const {}
    __device__ __forceinline__ void done(const Unit&) const {}
};
__device__ __forceinline__ void p_gemm_up(const GemmArgs& a, unsigned char* lds, int wv) {
    const int* ctl = (const int*)(a.ws + WS_CTL);
    GroupedOrder S{ctl + CW_TEXP, ctl[CW_NT], 4, (int)gridDim.x, (int)blockIdx.x, (const char*)(a.ws + WS_XS), (size_t)256 * 1024 * 2, (const char*)(a.ws + WS_WUP), (size_t)1024 * 1024 * 2, (size_t)256 * 1024 * 2};
    EpiUp E{(bf16*)(a.ws + WS_HID), (unsigned*)(a.ws + WS_CTL) + CW_TCNT}; pg8::Gemm g{1024};
    pg8::gemm_phase<EpiUp, GroupedOrder, true, true>((PG8_LAS unsigned char*)lds, g, S, E, wv);
}
struct CountedGroupedOrder : GroupedOrder {
    unsigned* tcnt; unsigned* tmo; volatile LAS unsigned* msk; int wv;
    __device__ __forceinline__ long unit_of(int i) const { const long U = (long)nT * nN; const int nB = (int)(U % G);
        return c < nB ? (long)(i + 2) * G - 2 * nB + c : i == 0 ? (long)(c - nB) : (long)i * G - nB + (c - nB); }
    __device__ bool next(int i, Unit& u) const {
        const long L = unit_of(i); if (L >= (long)nT * nN) return false;
        const int tile = (int)(L / nN), pn = (int)(L % nN); u.aux = i; u.pm = tile; u.pn = pn; u.a = A + (size_t)tile * a_tile; u.b = B + (size_t)texp[tile] * b_exp + (size_t)pn * b_tile; return true; }
    __device__ __forceinline__ void wait_tile(int tile) const {
        unsigned sp = 0;
        while (__hip_atomic_load(tcnt + TCNT_STRIDE * tile, __ATOMIC_RELAXED, __HIP_MEMORY_SCOPE_AGENT) < 32u) { __builtin_amdgcn_s_sleep(1);
            if ((++sp & 255u) == 0u) { if (__hip_atomic_load(tmo, __ATOMIC_RELAXED, __HIP_MEMORY_SCOPE_AGENT)) break; if (sp > (1u << 22)) { atomicAdd(tmo, 1u); break; } } }
    }
    __device__ __forceinline__ void a_ready(const Unit& u) const {
        const int i = u.aux;
        if (i > 0) { const unsigned m = msk[0]; if ((m >> i) & 1u) return; }
        if (wv == 0) {
            unsigned m = 0u;
            if (i == 0) {
#pragma unroll 1
                for (int j = 1; j < 32; ++j) { const long L = unit_of(j); if (L >= (long)nT * nN) break;
                    if (__hip_atomic_load(tcnt + TCNT_STRIDE * (int)(L / nN), __ATOMIC_RELAXED, __HIP_MEMORY_SCOPE_AGENT) >= 32u) m |= 1u << j; } }
            wait_tile(u.pm);
            __builtin_amdgcn_fence(__ATOMIC_ACQUIRE, "agent");
            asm volatile("s_waitcnt vmcnt(0)" ::: "memory");
            if (i == 0 && mktid(wv) == 0) msk[0] = m;
            asm volatile("s_waitcnt lgkmcnt(0)" ::: "memory");
        }
        asm volatile("" ::: "memory"); __builtin_amdgcn_s_barrier(); asm volatile("" ::: "memory");
    }
};
__device__ __forceinline__ void p_gemm_down(const GemmArgs& a, unsigned char* lds, int wv) {
    const int* ctl = (const int*)(a.ws + WS_CTL);
    CountedGroupedOrder S{{ctl + CW_TEXP, ctl[CW_NT], 4, (int)gridDim.x, (int)blockIdx.x, (const char*)(a.ws + WS_HID), (size_t)256 * 512 * 2, (const char*)a.out, (size_t)1024 * 512 * 2, (size_t)256 * 512 * 2},
                          (unsigned*)(a.ws + WS_CTL) + CW_TCNT, (unsigned*)(a.ws + WS_CTL) + CW_BAR + XB_TMO_W, (volatile LAS unsigned*)((LAS unsigned char*)lds + DOWN_MSK_OFF), wv};
    EpiStoreBf16 E{(bf16*)(a.ws + WS_XS), 1024}; pg8::Gemm g{512};
    pg8::gemm_phase<EpiStoreBf16, CountedGroupedOrder, true, true>((PG8_LAS unsigned char*)lds, g, S, E, wv);
}

__device__ __forceinline__ void p_attn(const PArgs& a, unsigned char* lds, int vb, int nvb, int wv) {
    const attn_body::bf16* Q = (const attn_body::bf16*)(a.ws + WS_Q); const attn_body::bf16* K = (const attn_body::bf16*)(a.ws + WS_K);
    const attn_body::bf16* V = (const attn_body::bf16*)(a.ws + WS_Z) + ZV; attn_body::bf16* O = (attn_body::bf16*)(a.ws + WS_YB);
    for (int p = vb; p < 512; p += nvb)
        for (int which = 0; which < 2; ++which) { const int bh = p >> 2, s = p & 3, qb = which ? 7 - s : s;
            attn_body::attn_unit<8>(bh >> 3, bh & 7, qb, Q, K, V, O, (char*)lds, wv); }
}

__device__ __forceinline__ void p_actprep(const PArgs& a, unsigned char* lds, int wv) {
    const int tid = mktid(wv); const bf16* z = (const bf16*)(a.ws + WS_Z); bf16* act = (bf16*)(a.ws + WS_ACT); const float* mu = a.in[7];
    for (int i = blockIdx.x * 512 + tid; i < NT * 32; i += gridDim.x * 512) { const int t = i >> 5, cg = i & 31, col = 1536 + 8 * cg; const bool hasp = (t & (SEQ - 1)) > 0;
        const v4u cw = *(const v4u*)(z + (size_t)t * INC + col); v4u pw = {0u, 0u, 0u, 0u}; if (hasp) pw = *(const v4u*)(z + (size_t)(t - 1) * INC + col);
        const float c8[8] = {bflo(cw.x), bfhi(cw.x), bflo(cw.y), bfhi(cw.y), bflo(cw.z), bfhi(cw.z), bflo(cw.w), bfhi(cw.w)}, p8[8] = {bflo(pw.x), bfhi(pw.x), bflo(pw.y), bfhi(pw.y), bflo(pw.z), bfhi(pw.z), bflo(pw.w), bfhi(pw.w)};
        const f32x4 m0 = *(const f32x4*)(mu + col), m1 = *(const f32x4*)(mu + col + 4); const float m8[8] = {m0.x, m0.y, m0.z, m0.w, m1.x, m1.y, m1.z, m1.w}; float v[8];
#pragma unroll
        for (int e = 0; e < 8; ++e) { const float x = c8[e] + (p8[e] - c8[e]) * m8[e]; v[e] = cg < 8 ? 1.0f - 2.0f * __builtin_amdgcn_rcpf(1.0f + __expf(2.0f * x)) : cg < 16 ? x : sigm(x); }
        v4u w; w.x = pk2(v[0], v[1]); w.y = pk2(v[2], v[3]); w.z = pk2(v[4], v[5]); w.w = pk2(v[6], v[7]);
        *(v4u*)(act + (size_t)t * 256 + 8 * cg) = w; }
}

namespace rw {
typedef short bf16x8 __attribute__((ext_vector_type(8)));
constexpr int MB = 8192;
__device__ __forceinline__ int SW(int r, int c) { return r * 128 + ((((c >> 3) ^ (r >> 1)) & 7) << 4) + (c & 7) * 2; }
__device__ __forceinline__ int SWG(int r, int c) { return r * 256 + ((((c >> 3) ^ r) & 15) << 4) + (c & 7) * 2; }
__device__ __forceinline__ int SWF(int r, int c) { return r * 256 + ((((c >> 2) ^ r) & 15) << 4) + (c & 3) * 4; }
enum { I_AT = 0, I_BT, I_AJ, I_BHJ, I_KHJ, I_ABRT, I_X5, I_L, I_LT, I_R0, I_R1, I_KT, I_RT, I_VJ, I_X14, I_GATE, I_VT, I_VT2, NBUF };
constexpr int OFF_F32 = NBUF * MB;
constexpr int OFF_CST = OFF_F32 + (64 * 3 + 512) * 4;
constexpr int LDS_NEED = OFF_CST + 14 * 64 * 4;

__device__ __forceinline__ bf16x8 ldfrag(const unsigned char* M, int row, int k) { return *(const bf16x8*)(M + SW(row, k)); }
__device__ __forceinline__ void mm(f32x4 (&acc)[2], const unsigned char* X, const unsigned char* Y, int mt, int nh, int fr, int fq) {
    const bf16x8 a0 = ldfrag(X, 16 * mt + fr, 8 * fq), a1 = ldfrag(X, 16 * mt + fr, 8 * fq + 32);
#pragma unroll
    for (int nt = 0; nt < 2; ++nt) { const bf16x8 b0 = ldfrag(Y, 16 * (2 * nh + nt) + fr, 8 * fq), b1 = ldfrag(Y, 16 * (2 * nh + nt) + fr, 8 * fq + 32);
        acc[nt] = __builtin_amdgcn_mfma_f32_16x16x32_bf16(a0, b0, acc[nt], 0, 0, 0); acc[nt] = __builtin_amdgcn_mfma_f32_16x16x32_bf16(a1, b1, acc[nt], 0, 0, 0); }
}
typedef short s16x4 __attribute__((ext_vector_type(4)));
typedef __attribute__((address_space(3))) s16x4* lds_s16x4p;
__device__ __forceinline__ bf16x8 ldfragT(const unsigned char* M, int row0, int kb, int fr, int fq) {
    const int k0 = kb + 8 * fq + (fr >> 2), c0 = row0 + 4 * (fr & 3);
    const s16x4 lo = __builtin_amdgcn_ds_read_tr16_b64_v4i16((lds_s16x4p)(M + SW(k0, c0))), hi = __builtin_amdgcn_ds_read_tr16_b64_v4i16((lds_s16x4p)(M + SW(k0 + 4, c0)));
    return (bf16x8){lo[0], lo[1], lo[2], lo[3], hi[0], hi[1], hi[2], hi[3]};
}
struct FA { bf16x8 k0, k1; };
struct FB { bf16x8 k0[2], k1[2]; };
__device__ __forceinline__ FA ldA(const unsigned char* X, int mt, int fr, int fq) { FA f; f.k0 = ldfrag(X, 16 * mt + fr, 8 * fq); f.k1 = ldfrag(X, 16 * mt + fr, 8 * fq + 32); return f; }
__device__ __forceinline__ FB ldB(const unsigned char* Y, int nh, int fr, int fq) { FB f;
#pragma unroll
    for (int nt = 0; nt < 2; ++nt) { f.k0[nt] = ldfrag(Y, 16 * (2 * nh + nt) + fr, 8 * fq); f.k1[nt] = ldfrag(Y, 16 * (2 * nh + nt) + fr, 8 * fq + 32); }
    return f; }
__device__ __forceinline__ FA ldAT(const unsigned char* XT, int mt, int fr, int fq) { FA f; f.k0 = ldfragT(XT, 16 * mt, 0, fr, fq); f.k1 = ldfragT(XT, 16 * mt, 32, fr, fq); return f; }
__device__ __forceinline__ FB ldBT(const unsigned char* YT, int nh, int fr, int fq) { FB f;
#pragma unroll
    for (int nt = 0; nt < 2; ++nt) { f.k0[nt] = ldfragT(YT, 16 * (2 * nh + nt), 0, fr, fq); f.k1[nt] = ldfragT(YT, 16 * (2 * nh + nt), 32, fr, fq); }
    return f; }
__device__ __forceinline__ void mma(f32x4 (&acc)[2], const FA& a, const FB& b) {
    acc[0] = __builtin_amdgcn_mfma_f32_16x16x32_bf16(a.k0, b.k0[0], acc[0], 0, 0, 0); acc[1] = __builtin_amdgcn_mfma_f32_16x16x32_bf16(a.k0, b.k0[1], acc[1], 0, 0, 0);
    acc[0] = __builtin_amdgcn_mfma_f32_16x16x32_bf16(a.k1, b.k1[0], acc[0], 0, 0, 0); acc[1] = __builtin_amdgcn_mfma_f32_16x16x32_bf16(a.k1, b.k1[1], acc[1], 0, 0, 0);
}
__device__ __forceinline__ void ldC(f32x4 (&acc)[2], const unsigned char* Z, int mt, int nh, int fr, int fq) {
#pragma unroll
    for (int nt = 0; nt < 2; ++nt) { const v2u w = *(const v2u*)(Z + SW(16 * (2 * nh + nt) + fr, 16 * mt + 4 * fq)); acc[nt] = (f32x4){bflo(w.x), bfhi(w.x), bflo(w.y), bfhi(w.y)}; }
}
__device__ __forceinline__ void storeT(unsigned char* Z, const f32x4 (&acc)[2], int mt, int nh, int fr, int fq) {
#pragma unroll
    for (int nt = 0; nt < 2; ++nt) { v2u w; w.x = pk2(acc[nt][0], acc[nt][1]); w.y = pk2(acc[nt][2], acc[nt][3]); *(v2u*)(Z + SW(16 * (2 * nh + nt) + fr, 16 * mt + 4 * fq)) = w; }
}
__device__ __forceinline__ void storeN(unsigned char* Z, const f32x4 (&acc)[2], int mt, int nh, int fr, int fq) {
#pragma unroll
    for (int nt = 0; nt < 2; ++nt)
#pragma unroll
        for (int r = 0; r < 4; ++r) *(unsigned short*)(Z + SW(16 * mt + 4 * fq + r, 16 * (2 * nh + nt) + fr)) = (unsigned short)f2bf(acc[nt][r]);
}
__device__ __forceinline__ void ld8bf(const unsigned char* p, float (&v)[8]) { const v4u w = *(const v4u*)p; v[0] = bflo(w.x); v[1] = bfhi(w.x); v[2] = bflo(w.y); v[3] = bfhi(w.y); v[4] = bflo(w.z); v[5] = bfhi(w.z); v[6] = bflo(w.w); v[7] = bfhi(w.w); }
__device__ __forceinline__ void st8bf(unsigned char* p, const float (&v)[8]) { v4u w; w.x = pk2(v[0], v[1]); w.y = pk2(v[2], v[3]); w.z = pk2(v[4], v[5]); w.w = pk2(v[6], v[7]); *(v4u*)p = w; }
__device__ __forceinline__ void ld8f(const float* p, float (&v)[8]) { const f32x4 a = *(const f32x4*)p, b = *(const f32x4*)(p + 4); v[0] = a.x; v[1] = a.y; v[2] = a.z; v[3] = a.w; v[4] = b.x; v[5] = b.y; v[6] = b.z; v[7] = b.w; }
__device__ __forceinline__ void ld8fs(const unsigned char* M, int r, int c, float (&v)[8]) { const f32x4 a = *(const f32x4*)(M + SWF(r, c)), b = *(const f32x4*)(M + SWF(r, c + 4)); v[0] = a.x; v[1] = a.y; v[2] = a.z; v[3] = a.w; v[4] = b.x; v[5] = b.y; v[6] = b.z; v[7] = b.w; }
__device__ __forceinline__ void un8(const v4u w, float (&v)[8]) { v[0] = bflo(w.x); v[1] = bfhi(w.x); v[2] = bflo(w.y); v[3] = bfhi(w.y); v[4] = bflo(w.z); v[5] = bfhi(w.z); v[6] = bflo(w.w); v[7] = bfhi(w.w); }
__device__ __forceinline__ void shift8(const v4u cw, const v4u pw, bool hasp, const float* mu, float (&v)[8]) {
    float c[8], p[8], m[8]; un8(cw, c); un8(pw, p); ld8f(mu, m);
#pragma unroll
    for (int e = 0; e < 8; ++e) { const float pe = hasp ? p[e] : 0.f; v[e] = c[e] + (pe - c[e]) * m[e]; }
}
__device__ __forceinline__ float tanh_fast(float x) { return 1.0f - 2.0f * __builtin_amdgcn_rcpf(1.0f + __expf(2.0f * x)); }

#define LBAR() do { asm volatile("s_waitcnt lgkmcnt(0)" ::: "memory"); __builtin_amdgcn_s_barrier(); asm volatile("" ::: "memory"); } while (0)
__device__ __forceinline__ void scan_unit(const PArgs& a, unsigned char* lds, int bh, int wv) {
    const int tid = mktid(wv), lane = tid & 63, wid = __builtin_amdgcn_readfirstlane(tid >> 6);
    const int mt = wid >> 1, nh = wid & 1; int fr = lane & 15, fq = lane >> 4;
    const int b = bh >> 3, h = bh & 7;
#define BUF(i) (lds + (i) * MB)
    float* GC = (float*)(lds + OFF_F32); float* BON = GC + 64; float* SSQ = BON + 64; float* SEGT = SSQ + 64;
    unsigned char* LWR = BUF(I_AT); unsigned char* LAR = BUF(I_AJ); unsigned char* LGR = BUF(I_KHJ); unsigned char* YTF = BUF(I_KHJ);
    unsigned char* ACTW = BUF(I_L); unsigned char* ACTA = BUF(I_LT); unsigned char* ACTG = BUF(I_R0);
    const bf16* z = (const bf16*)(a.ws + WS_Z); bf16* ya = (bf16*)(a.ws + WS_YA);
    const float* mu = a.in[7];
    bf16x8 fw[2], fa[2], fg[4];
    { const bf16* wlt = (const bf16*)(a.ws + WS_WLT) + (size_t)h * 4096 + (16 * mt + fr) * 64 + 8 * fq; const bf16* wat = (const bf16*)(a.ws + WS_WAT) + (size_t)h * 4096 + (16 * mt + fr) * 64 + 8 * fq;
      const bf16* wgt = (const bf16*)(a.ws + WS_WGT) + (size_t)h * 8192 + (16 * mt + fr) * 128 + 8 * fq;
      fw[0] = *(const bf16x8*)wlt; fw[1] = *(const bf16x8*)(wlt + 32); fa[0] = *(const bf16x8*)wat; fa[1] = *(const bf16x8*)(wat + 32);
#pragma unroll
      for (int ks = 0; ks < 4; ++ks) fg[ks] = *(const bf16x8*)(wgt + 32 * ks); }
    float* CST = (float*)(lds + OFF_CST);
    for (int i = tid; i < 14 * 64; i += 512) { const int blk = i >> 6, jj = i & 63; float v;
        if (blk < 3) v = mu[blk * 512 + h * 64 + jj]; else if (blk < 7) v = mu[1536 + (blk - 3) * 64 + jj]; else v = a.in[blk == 7 ? 8 : blk == 8 ? 10 : blk == 9 ? 13 : blk == 10 ? 14 : blk == 11 ? 15 : blk == 12 ? 16 : 17][h * 64 + jj];
        CST[i] = v; }
    int s0i = I_X14, aki = I_X5;
    for (int i = tid; i < MB / 4; i += 512) ((unsigned*)BUF(I_X14))[i] = 0u;
    LBAR();
    int pt = tid >> 3, j0 = 8 * (tid & 7);
    const int colh = h * 64 + j0;
    const int zoff0 = colh, zoff1 = 512 + colh, zoff2 = 1024 + colh;
    const bf16* actb = (const bf16*)(a.ws + WS_ACT);
    v4u zc[3], zq[3], za[4];
#define ZLOAD(cc) do { const size_t tr_ = (size_t)b * SEQ + (cc) * 64 + pt; const bf16* zr_ = z + tr_ * INC; const bf16* zs_ = ((cc) * 64 + pt) > 0 ? zr_ - INC : zr_; const bf16* ar_ = actb + tr_ * 256 + j0; \
        zc[0] = *(const v4u*)(zr_ + zoff0); zc[1] = *(const v4u*)(zr_ + zoff1); zc[2] = *(const v4u*)(zr_ + zoff2); \
        zq[0] = *(const v4u*)(zs_ + zoff0); zq[1] = *(const v4u*)(zs_ + zoff1); zq[2] = *(const v4u*)(zs_ + zoff2); \
        za[0] = *(const v4u*)(ar_); za[1] = *(const v4u*)(ar_ + 64); za[2] = *(const v4u*)(ar_ + 128); za[3] = *(const v4u*)(ar_ + 192); } while (0)
#define ESTAGE(VTB, TT_) \
        { float y[8], vv[8], g8[8], lg[8], lb[8]; ld8fs(YTF, pt, j0, y); ld8bf((VTB) + SW(pt, j0), vv); ld8bf(BUF(I_GATE) + SW(pt, j0), g8); \
          ld8f(CST + 12 * 64 + j0, lg); ld8f(CST + 13 * 64 + j0, lb); \
          float sm = 0.f; \
_Pragma("unroll") \
          for (int e = 0; e < 8; ++e) sm += y[e]; \
          const float mean = red8(sm) * (1.0f / 64.0f); float sq = 0.f; \
_Pragma("unroll") \
          for (int e = 0; e < 8; ++e) { y[e] -= mean; sq += y[e] * y[e]; } \
          const float rstd = rsqrtf(red8(sq) * (1.0f / 64.0f) + 64e-5f), bon = BON[pt]; \
_Pragma("unroll") \
          for (int e = 0; e < 8; ++e) y[e] = (y[e] * rstd * lg[e] + lb[e] + bon * vv[e]) * g8[e]; \
          ypend.x = pk2(y[0], y[1]); ypend.y = pk2(y[2], y[3]); ypend.z = pk2(y[4], y[5]); ypend.w = pk2(y[6], y[7]); ypoff = (TT_) * RWW + colh; }
    ZLOAD(0);
    v4u ypend = {0u, 0u, 0u, 0u}; size_t ypoff = 0;
    for (int c = 0; c < SEQ / 64; ++c) {
        asm volatile("" : "+v"(fr), "+v"(fq), "+v"(pt), "+v"(j0));
        const int s = c * 64 + pt; const size_t t = (size_t)b * SEQ + s; const bool hasp = s > 0;
        if (c > 0) { ESTAGE(((c - 1) & 1) ? BUF(I_VT2) : BUF(I_VT), t - 64) }
        { float v[8];
          shift8(zc[0], zq[0], hasp, CST + 0 * 64 + j0, v); st8bf(BUF(I_RT) + SW(pt, j0), v);
          shift8(zc[1], zq[1], hasp, CST + 1 * 64 + j0, v); st8bf(BUF(I_KT) + SW(pt, j0), v);
          { float kkc[8], ss = 0.f; ld8f(CST + 9 * 64 + j0, kkc);
#pragma unroll
            for (int e = 0; e < 8; ++e) { const float q = v[e] * kkc[e]; ss += q * q; }
            ss = red8(ss); if (j0 == 0) SSQ[pt] = rsqrtf(fmaxf(ss, 1e-24f)); }
          shift8(zc[2], zq[2], hasp, CST + 2 * 64 + j0, v); st8bf(((c & 1) ? BUF(I_VT2) : BUF(I_VT)) + SW(pt, j0), v);
          *(v4u*)(ACTW + SW(pt, j0)) = za[0]; *(v4u*)(ACTA + SW(pt, j0)) = za[1]; *(v4u*)(ACTG + SWG(pt, j0)) = za[2]; *(v4u*)(ACTG + SWG(pt, 64 + j0)) = za[3]; }
        LBAR();
        f32x4 aw[2], aa[2], ag[2];
#pragma unroll
        for (int nt = 0; nt < 2; ++nt) { const int tr = 16 * (2 * nh + nt) + fr; const f32x4 zero = {0.f, 0.f, 0.f, 0.f};
            aw[nt] = __builtin_amdgcn_mfma_f32_16x16x32_bf16(fw[0], ldfrag(ACTW, tr, 8 * fq), zero, 0, 0, 0); aw[nt] = __builtin_amdgcn_mfma_f32_16x16x32_bf16(fw[1], ldfrag(ACTW, tr, 8 * fq + 32), aw[nt], 0, 0, 0);
            aa[nt] = __builtin_amdgcn_mfma_f32_16x16x32_bf16(fa[0], ldfrag(ACTA, tr, 8 * fq), zero, 0, 0, 0); aa[nt] = __builtin_amdgcn_mfma_f32_16x16x32_bf16(fa[1], ldfrag(ACTA, tr, 8 * fq + 32), aa[nt], 0, 0, 0);
            ag[nt] = zero;
#pragma unroll
            for (int ks = 0; ks < 4; ++ks) ag[nt] = __builtin_amdgcn_mfma_f32_16x16x32_bf16(fg[ks], *(const bf16x8*)(ACTG + SWG(tr, 8 * fq + 32 * ks)), ag[nt], 0, 0, 0); }
#pragma unroll
        for (int nt = 0; nt < 2; ++nt) { const int tr = 16 * (2 * nh + nt) + fr, jc = 16 * mt + 4 * fq;
            *(f32x4*)(LWR + SWF(tr, jc)) = aw[nt]; *(f32x4*)(LAR + SWF(tr, jc)) = aa[nt]; *(f32x4*)(LGR + SWF(tr, jc)) = ag[nt]; }
        LBAR();
        float lwv[8], an[8], bb[8], k2[8], rr[8], gg[8], vv8[8], p8[8];
        { const int j = lane, tw = wid;
          const float w0c = CST[7 * 64 + j], a0c = CST[8 * 64 + j], kkc = CST[9 * 64 + j], kac = CST[10 * 64 + j], rkc = CST[11 * 64 + j];
          const unsigned char* vtb = (c & 1) ? BUF(I_VT2) : BUF(I_VT);
          float bo[8], av[8];
#pragma unroll
          for (int u = 0; u < 8; ++u) { const int t8 = 8 * tw + u;
              const float lw = *(const float*)(LWR + SWF(t8, j)), la = *(const float*)(LAR + SWF(t8, j)); gg[u] = *(const float*)(LGR + SWF(t8, j));
              rr[u] = bflo(*(const unsigned short*)(BUF(I_RT) + SW(t8, j))); const float kx = bflo(*(const unsigned short*)(BUF(I_KT) + SW(t8, j))); vv8[u] = bflo(*(const unsigned short*)(vtb + SW(t8, j)));
              lwv[u] = -0.606531f * sigm(w0c + lw); av[u] = sigm(a0c + la);
              const float kn = kx * kkc * SSQ[t8]; an[u] = -kn; bb[u] = kn * av[u];
              k2[u] = kx * (1.0f + (av[u] - 1.0f) * kac); bo[u] = rr[u] * k2[u] * rkc; }
          wave_sum8(bo);
          if (j == 0) {
#pragma unroll
              for (int u = 0; u < 8; ++u) BON[8 * tw + u] = bo[u]; }
          p8[0] = lwv[0];
#pragma unroll
          for (int u = 1; u < 8; ++u) p8[u] = p8[u - 1] + lwv[u];
          SEGT[tw * 64 + j] = p8[7]; }
        LBAR();
        { const int j = lane, tw = wid; float sg8[8];
#pragma unroll
          for (int s2 = 0; s2 < 8; ++s2) sg8[s2] = SEGT[s2 * 64 + j];
          float base = 0.f, tot = 0.f;
#pragma unroll
          for (int s2 = 0; s2 < 8; ++s2) { tot += sg8[s2]; base += (s2 < tw) ? sg8[s2] : 0.f; }
          const float gcj = __expf(tot); if (tw == 7) GC[j] = gcj;
          float eprev = __expf(base);
          float o0[8], o1[8], o2[8], o3[8], ob[8], ok[8];
#pragma unroll
          for (int u = 0; u < 8; ++u) { const float L = p8[u] + base; const float e1 = __expf(L), ie1 = __builtin_amdgcn_rcpf(e1), ep = eprev, eh = gcj * ie1; eprev = e1;
              o0[u] = an[u] * ep; o1[u] = bb[u] * ie1; o2[u] = k2[u] * ie1; o3[u] = rr[u] * e1; ob[u] = bb[u] * eh; ok[u] = k2[u] * eh;
              *(unsigned short*)(BUF(I_GATE) + SW(8 * tw + u, j)) = (unsigned short)f2bf(gg[u]); }
          st8bf(BUF(I_AJ) + SW(j, 8 * tw), o0); st8bf(BUF(I_BT) + SW(j, 8 * tw), o1); st8bf(BUF(I_KT) + SW(j, 8 * tw), o2); st8bf(BUF(I_RT) + SW(j, 8 * tw), o3);
          st8bf(BUF(I_BHJ) + SW(j, 8 * tw), ob); st8bf(BUF(I_KHJ) + SW(j, 8 * tw), ok); st8bf(BUF(I_VJ) + SW(j, 8 * tw), vv8); }
        if (c > 0) *(v4u*)(ya + ypoff) = ypend;
        if (c + 1 < SEQ / 64) ZLOAD(c + 1);
        LBAR();
#define MASK(acc, cond) _Pragma("unroll") for (int nt = 0; nt < 2; ++nt) _Pragma("unroll") for (int r = 0; r < 4; ++r) { const int m_ = 16 * mt + 4 * fq + r, n_ = 16 * (2 * nh + nt) + fr; if (!(cond)) acc[nt][r] = 0.f; }
        { const f32x4 zero = {0.f, 0.f, 0.f, 0.f}; f32x4 aL[2] = {zero, zero}, aL2[2] = {zero, zero}, aK[2] = {zero, zero}, aR[2] = {zero, zero};
          const FA fAT = ldAT(BUF(I_AJ), mt, fr, fq), fBTa = ldAT(BUF(I_BT), mt, fr, fq); const FB fBT = ldBT(BUF(I_BT), nh, fr, fq), fKT = ldBT(BUF(I_KT), nh, fr, fq), fRT = ldBT(BUF(I_RT), nh, fr, fq), fATb = ldBT(BUF(I_AJ), nh, fr, fq);
          mma(aL, fAT, fBT);
          mma(aL2, fBTa, fATb);
          mma(aK, fAT, fKT);
          mma(aR, fBTa, fRT);
          MASK(aL, m_ > n_) MASK(aL2, n_ > m_) MASK(aK, n_ < m_) MASK(aR, m_ <= n_)
#pragma unroll
          for (int nt = 0; nt < 2; ++nt)
#pragma unroll
              for (int r = 0; r < 4; ++r) { const int m_ = 16 * mt + 4 * fq + r, n_ = 16 * (2 * nh + nt) + fr; if (m_ == n_) aL2[nt][r] = 1.0f; }
          storeT(BUF(I_L), aL, mt, nh, fr, fq); storeT(BUF(I_R0), aL2, mt, nh, fr, fq);
          storeT(BUF(aki), aK, mt, nh, fr, fq);
          storeT(BUF(I_ABRT), aR, mt, nh, fr, fq); }
        LBAR();
#pragma unroll
        for (int k = 1; k <= 6; ++k) {
            unsigned char* Pc = (k & 1) ? BUF(I_L) : BUF(I_AT); unsigned char* Pn = (k & 1) ? BUF(I_AT) : BUF(I_L);
            unsigned char* Rc = (k & 1) ? BUF(I_R1) : BUF(I_R0); unsigned char* Rn = (k & 1) ? BUF(I_R0) : BUF(I_R1);
            const f32x4 zero = {0.f, 0.f, 0.f, 0.f}; f32x4 aP[2] = {zero, zero}, aRr[2] = {zero, zero};
            FA fP, fPTa; FB fPT, fR;
            if (k <= 5) { fP = ldAT(Pc, mt, fr, fq); fPT = ldB(Pc, nh, fr, fq); }
            if (k >= 2) { fPTa = ldA(Pc, mt, fr, fq); fR = ldB(Rc, nh, fr, fq); ldC(aRr, Rc, mt, nh, fr, fq); }
            if (k <= 5) mma(aP, fP, fPT);
            if (k >= 2) mma(aRr, fPTa, fR);
            if (k <= 5) storeT(Pn, aP, mt, nh, fr, fq);
            if (k >= 2) storeT(Rn, aRr, mt, nh, fr, fq);
            LBAR();
        }
        { const f32x4 zero = {0.f, 0.f, 0.f, 0.f}; f32x4 a1[2] = {zero, zero}, a2[2] = {zero, zero};
          const FA fTT = ldA(BUF(I_R1), mt, fr, fq); const FB fAJ = ldB(BUF(I_AJ), nh, fr, fq), fAK = ldB(BUF(aki), nh, fr, fq);
          mma(a1, fTT, fAJ); mma(a2, fTT, fAK);
          storeT(BUF(I_L), a1, mt, nh, fr, fq);
          storeT(BUF(I_LT), a2, mt, nh, fr, fq); }
        LBAR();
        { const f32x4 zero = {0.f, 0.f, 0.f, 0.f}; f32x4 aMY[2], aNY[2] = {zero, zero}, aMS[2] = {zero, zero}, aNS[2];
          const FA fG1 = ldA(BUF(I_L), mt, fr, fq), fG2 = ldA(BUF(I_LT), mt, fr, fq), fKTa = ldAT(BUF(I_KT), mt, fr, fq);
          const FB fAB = ldB(BUF(I_ABRT), nh, fr, fq), fRT = ldBT(BUF(I_RT), nh, fr, fq), fBH = ldB(BUF(I_BHJ), nh, fr, fq);
#pragma unroll
          for (int nt = 0; nt < 2; ++nt)
#pragma unroll
              for (int r = 0; r < 4; ++r) aMY[nt][r] = bflo(*(const unsigned short*)(BUF(I_RT) + SW(16 * mt + 4 * fq + r, 16 * (2 * nh + nt) + fr)));
          ldC(aNS, BUF(I_KHJ), mt, nh, fr, fq);
          mma(aNY, fKTa, fRT);
          mma(aMY, fG1, fAB);
          mma(aMS, fG1, fBH);
          mma(aNS, fG2, fBH);
          MASK(aNY, m_ <= n_)
          mma(aNY, fG2, fAB);
#pragma unroll
          for (int nt = 0; nt < 2; ++nt)
#pragma unroll
              for (int r = 0; r < 4; ++r) { const int m_ = 16 * mt + 4 * fq + r, n_ = 16 * (2 * nh + nt) + fr; if (m_ == n_) aMS[nt][r] += GC[m_]; }
          storeT(BUF(I_AT), aMY, mt, nh, fr, fq); storeT(BUF(I_BT), aNY, mt, nh, fr, fq); storeT(BUF(I_AJ), aMS, mt, nh, fr, fq); storeT(BUF(I_R0), aNS, mt, nh, fr, fq); }
        LBAR();
        { const f32x4 zero = {0.f, 0.f, 0.f, 0.f}; f32x4 aY[2] = {zero, zero}, aS[2] = {zero, zero};
          const FA fS0a = ldA(BUF(s0i), mt, fr, fq), fVJa = ldA(BUF(I_VJ), mt, fr, fq), fMS = ldA(BUF(I_AJ), mt, fr, fq), fNS = ldA(BUF(I_R0), mt, fr, fq);
          const FB fMY = ldB(BUF(I_AT), nh, fr, fq), fNY = ldB(BUF(I_BT), nh, fr, fq), fS0 = ldB(BUF(s0i), nh, fr, fq), fVJ = ldB(BUF(I_VJ), nh, fr, fq);
          mma(aY, fS0a, fMY); mma(aS, fMS, fS0); mma(aY, fVJa, fNY); mma(aS, fNS, fVJ);
#pragma unroll
          for (int nt = 0; nt < 2; ++nt) *(f32x4*)(YTF + SWF(16 * (2 * nh + nt) + fr, 16 * mt + 4 * fq)) = aY[nt];
          storeT(BUF(aki), aS, mt, nh, fr, fq); }
        LBAR();
#undef MASK
        { const int tmp = s0i; s0i = aki; aki = tmp; }
    }
    { const int c = SEQ / 64; const size_t tprev = (size_t)b * SEQ + (c - 1) * 64 + pt; ESTAGE(((c - 1) & 1) ? BUF(I_VT2) : BUF(I_VT), tprev) }
    *(v4u*)(ya + ypoff) = ypend;
    LBAR();
#undef ESTAGE
#undef BUF
#undef ZLOAD
}
#undef LBAR
}

__device__ __forceinline__ void p_norm2_route(const PArgs& a, unsigned char* lds, int wv) {
    typedef short bf16x8 __attribute__((ext_vector_type(8)));
    const int tid = mktid(wv), lane = tid & 63, fr = lane & 15, fq = lane >> 4;
    const bf16* x1 = (const bf16*)(a.ws + WS_X1B); const float* mod = (const float*)(a.ws + WS_MOD); const float* gm2 = (const float*)(a.ws + WS_GM2); const float* cbt = (const float*)(a.ws + WS_CB);
    int* rte = (int*)(a.ws + WS_RTE); float* rtw = (float*)(a.ws + WS_RTW); int* rnk = (int*)(a.ws + WS_RNK); unsigned* cnt = (unsigned*)(a.ws + WS_CTL) + CW_CNT;
    float* PL = (float*)lds;
    float* PS = PL + 8 * 32 * 48;
    float* RS_ = PS + 8 * 32;
    float* FL = RS_ + 32;
    unsigned* HIST = (unsigned*)(FL + 32 * 48);
    unsigned* LRK = HIST + 32;
    if (tid < 32) HIST[tid] = 0u;
    __syncthreads();
    int gcount = 0;
    bf16x8 wh[4][3], wl[4][3];
    { const bf16* wrh = (const bf16*)(a.ws + WS_WRH) + fr * 1024 + 128 * wv + 8 * fq; const bf16* wrl = (const bf16*)(a.ws + WS_WRL) + fr * 1024 + 128 * wv + 8 * fq;
#pragma unroll
      for (int ks = 0; ks < 4; ++ks)
#pragma unroll
          for (int nt = 0; nt < 3; ++nt) { wh[ks][nt] = *(const bf16x8*)(wrh + nt * 16 * 1024 + 32 * ks); wl[ks][nt] = *(const bf16x8*)(wrl + nt * 16 * 1024 + 32 * ks); } }
    for (int grp = blockIdx.x; grp < NT / 32; grp += gridDim.x) {
        const int row0 = grp * 32, b = row0 >> 11;
        f32x4 acc[3][2];
#pragma unroll
        for (int nt = 0; nt < 3; ++nt) { acc[nt][0] = (f32x4){0.f, 0.f, 0.f, 0.f}; acc[nt][1] = acc[nt][0]; }
        float ssq[2] = {0.f, 0.f};
#pragma unroll
        for (int rt = 0; rt < 2; ++rt) {
            float xs[4][8];
#pragma unroll
            for (int ks = 0; ks < 4; ++ks) rw::ld8bf((const unsigned char*)(x1 + (size_t)(row0 + 16 * rt + fr) * DM + 128 * wv + 32 * ks + 8 * fq), xs[ks]);
#pragma unroll
            for (int ks = 0; ks < 4; ++ks) { float gm[8]; rw::ld8f(gm2 + b * 1024 + 128 * wv + 32 * ks + 8 * fq, gm); unsigned hw[4], lw[4];
#pragma unroll
                for (int e = 0; e < 4; ++e) { const float x0 = xs[ks][2 * e], x1v = xs[ks][2 * e + 1]; ssq[rt] += x0 * x0 + x1v * x1v; const float g0 = x0 * gm[2 * e], g1 = x1v * gm[2 * e + 1];
                    hw[e] = pk2(g0, g1); lw[e] = pk2(g0 - bflo(hw[e]), g1 - bfhi(hw[e])); }
                const v4u hv = {hw[0], hw[1], hw[2], hw[3]}, lv = {lw[0], lw[1], lw[2], lw[3]}; const bf16x8 bh = __builtin_bit_cast(bf16x8, hv), bl = __builtin_bit_cast(bf16x8, lv);
#pragma unroll
                for (int nt = 0; nt < 3; ++nt) { acc[nt][rt] = __builtin_amdgcn_mfma_f32_16x16x32_bf16(wh[ks][nt], bh, acc[nt][rt], 0, 0, 0); acc[nt][rt] = __builtin_amdgcn_mfma_f32_16x16x32_bf16(wl[ks][nt], bh, acc[nt][rt], 0, 0, 0);
                    acc[nt][rt] = __builtin_amdgcn_mfma_f32_16x16x32_bf16(wh[ks][nt], bl, acc[nt][rt], 0, 0, 0); } } }
#pragma unroll
        for (int rt = 0; rt < 2; ++rt) {
#pragma unroll
            for (int nt = 0; nt < 3; ++nt) *(f32x4*)(PL + (wv * 32 + 16 * rt + fr) * 48 + 16 * nt + 4 * fq) = acc[nt][rt];
            float s = ssq[rt]; s += __builtin_bit_cast(float, __builtin_amdgcn_ds_swizzle(__builtin_bit_cast(int, s), 0x401F));
            { const unsigned u = __builtin_bit_cast(unsigned, s); auto rr = __builtin_amdgcn_permlane32_swap(u, u, false, false); s = __builtin_bit_cast(float, (unsigned)rr[0]) + __builtin_bit_cast(float, (unsigned)rr[1]); }
            if (fq == 0) PS[wv * 32 + 16 * rt + fr] = s; }
        __syncthreads();
        { const int r = tid >> 4, c = tid & 15; float s0 = 0.f, s1 = 0.f, s2 = 0.f, sq = 0.f;
#pragma unroll
          for (int w = 0; w < 8; ++w) { const float* p = PL + (w * 32 + r) * 48; s0 += p[c]; s1 += p[c + 16]; s2 += p[c + 32]; sq += PS[w * 32 + r]; }
          const float rstd = rsqrtf(sq * (1.0f / DM) + 1e-6f); const float* cb = cbt + b * 48;
          FL[r * 48 + c] = rstd * s0 + cb[c]; FL[r * 48 + c + 16] = rstd * s1 + cb[c + 16]; FL[r * 48 + c + 32] = rstd * s2 + cb[c + 32];
          if (c == 0) ((float*)(a.ws + WS_RSTD))[row0 + r] = rstd; }
        __syncthreads();
        if (tid < 32) { const int m = row0 + tid; const float* lg = FL + tid * 48;
            int gi = 0; float gm = lg[0];
#pragma unroll
            for (int i = 1; i < 4; ++i) if (lg[i] > gm) { gm = lg[i]; gi = i; }
            float gs = 0.f;
#pragma unroll
            for (int i = 0; i < 4; ++i) gs += __expf(lg[i] - gm);
            const float pg = 1.0f / gs;
            float el[8];
#pragma unroll
            for (int k = 0; k < 8; ++k) el[k] = lg[4 + gi * 8 + k];
            int e1 = 0; float m1 = el[0];
#pragma unroll
            for (int k = 1; k < 8; ++k) if (el[k] > m1) { m1 = el[k]; e1 = k; }
            int e2 = -1; float m2 = -INFINITY;
#pragma unroll
            for (int k = 0; k < 8; ++k) if (k != e1 && el[k] > m2) { m2 = el[k]; e2 = k; }
            const float q2 = __expf(m2 - m1); const float w1 = pg / (1.0f + q2), w2 = pg * q2 / (1.0f + q2);
            const int ea = gi * 8 + e1, eb = gi * 8 + e2; rte[2 * m] = ea; rte[2 * m + 1] = eb; rtw[2 * m] = w1; rtw[2 * m + 1] = w2;
            LRK[gcount * 64 + 2 * tid] = atomicAdd(HIST + ea, 1u) | ((unsigned)ea << 24); LRK[gcount * 64 + 2 * tid + 1] = atomicAdd(HIST + eb, 1u) | ((unsigned)eb << 24); }
        ++gcount;
        __syncthreads();
    }
    if (tid < 32) { const unsigned n = HIST[tid]; HIST[tid] = n ? atomicAdd(cnt + tid * CNT_PAD, n) : 0u; }
    __syncthreads();
    for (int i = tid; i < gcount * 64; i += 512) { const int gi_ = i >> 6, e = i & 63; const int m2 = 2 * ((blockIdx.x + gi_ * gridDim.x) * 32) + e; const unsigned lr = LRK[i]; rnk[m2] = (int)(HIST[lr >> 24] + (lr & 0xffffffu)); }
    __syncthreads();
}
__device__ __forceinline__ void p_moe_gather(const PArgs& a, unsigned char* lds, int wv) {
    int* off = (int*)lds; int* tl = off + 64;
    const int tid = mktid(wv), lane = tid & 63, gw = blockIdx.x * 8 + (tid >> 6), NGW = gridDim.x * 8;
    int* ctl = (int*)(a.ws + WS_CTL); const unsigned* cnt = (const unsigned*)ctl + CW_CNT;
    if (tid < NEXP) tl[tid] = ((int)cnt[tid * CNT_PAD] + 255) >> 8;
    __syncthreads();
    if (tid < NEXP) { int o = 0; for (int e = 0; e < tid; ++e) o += tl[e];
        off[tid] = o * 256;
        if (blockIdx.x == 0) { const int n = tl[tid]; for (int i = 0; i < n; ++i) ctl[CW_TEXP + o + i] = tid; if (tid == NEXP - 1) ctl[CW_NT] = o + n; } }
    __syncthreads();
    const int* rte = (const int*)(a.ws + WS_RTE); const int* rnk = (const int*)(a.ws + WS_RNK); int* pos = (int*)(a.ws + WS_POS);
    const bf16* x1 = (const bf16*)(a.ws + WS_X1B); bf16* xs = (bf16*)(a.ws + WS_XS); const float* rstdv = (const float*)(a.ws + WS_RSTD);
    const float* mod = (const float*)(a.ws + WS_MOD); const float* gm2 = (const float*)(a.ws + WS_GM2);
    typedef int v4i_ __attribute__((ext_vector_type(4)));
    v4u xr[4][2]; v4i_ re[2], rk[2]; f32x4 rs;
    { const int t0 = 4 * gw < NT ? 4 * gw : 0;
#pragma unroll
      for (int r = 0; r < 4; ++r)
#pragma unroll
          for (int hf = 0; hf < 2; ++hf) xr[r][hf] = *(const v4u*)(x1 + (size_t)(t0 + r) * DM + 8 * lane + 512 * hf);
      re[0] = *(const v4i_*)(rte + 2 * t0); re[1] = *(const v4i_*)(rte + 2 * t0 + 4); rk[0] = *(const v4i_*)(rnk + 2 * t0); rk[1] = *(const v4i_*)(rnk + 2 * t0 + 4); rs = *(const f32x4*)(rstdv + t0); }
    for (int t0 = 4 * gw; t0 < NT; t0 += 4 * NGW) {
        const int tn = t0 + 4 * NGW < NT ? t0 + 4 * NGW : t0;
        v4u nx[4][2]; v4i_ ne[2], nk[2]; f32x4 ns;
#pragma unroll
        for (int r = 0; r < 4; ++r)
#pragma unroll
            for (int hf = 0; hf < 2; ++hf) nx[r][hf] = *(const v4u*)(x1 + (size_t)(tn + r) * DM + 8 * lane + 512 * hf);
        ne[0] = *(const v4i_*)(rte + 2 * tn); ne[1] = *(const v4i_*)(rte + 2 * tn + 4); nk[0] = *(const v4i_*)(rnk + 2 * tn); nk[1] = *(const v4i_*)(rnk + 2 * tn + 4); ns = *(const f32x4*)(rstdv + tn);
        const int b = t0 >> 11; int p0[4], p1[4];
#pragma unroll
        for (int r = 0; r < 4; ++r) { const int i0 = 2 * r, i1 = 2 * r + 1; p0[r] = off[re[i0 >> 2][i0 & 3]] + rk[i0 >> 2][i0 & 3]; p1[r] = off[re[i1 >> 2][i1 & 3]] + rk[i1 >> 2][i1 & 3]; }
        if (lane < 4) { const int r = lane; pos[2 * (t0 + r)] = r == 0 ? p0[0] : r == 1 ? p0[1] : r == 2 ? p0[2] : p0[3]; pos[2 * (t0 + r) + 1] = r == 0 ? p1[0] : r == 1 ? p1[1] : r == 2 ? p1[2] : p1[3]; }
#pragma unroll
        for (int hf = 0; hf < 2; ++hf) { const int col = 8 * lane + 512 * hf; float gm[8], sh[8];
            rw::ld8f(gm2 + b * 1024 + col, gm); rw::ld8f(mod + b * 6144 + 3072 + col, sh);
#pragma unroll
            for (int r = 0; r < 4; ++r) { const v4u xw = xr[r][hf]; const float rstd = rs[r];
                const float xv[8] = {bflo(xw.x), bfhi(xw.x), bflo(xw.y), bfhi(xw.y), bflo(xw.z), bfhi(xw.z), bflo(xw.w), bfhi(xw.w)}; float o[8];
#pragma unroll
                for (int e = 0; e < 8; ++e) o[e] = xv[e] * gm[e] * rstd + sh[e];
                v4u w; w.x = pk2(o[0], o[1]); w.y = pk2(o[2], o[3]); w.z = pk2(o[4], o[5]); w.w = pk2(o[6], o[7]);
                *(v4u*)(xs + (size_t)p0[r] * DM + col) = w; *(v4u*)(xs + (size_t)p1[r] * DM + col) = w; } }
#pragma unroll
        for (int r = 0; r < 4; ++r)
#pragma unroll
            for (int hf = 0; hf < 2; ++hf) xr[r][hf] = nx[r][hf];
        re[0] = ne[0]; re[1] = ne[1]; rk[0] = nk[0]; rk[1] = nk[1]; rs = ns;
    }
}
__device__ __forceinline__ void p_combine(const PArgs& a, unsigned char* lds, int wv) {
    const int tid = mktid(wv), lane = tid & 63, gw = blockIdx.x * 8 + (tid >> 6), NGW = gridDim.x * 8;
    const float* mod = (const float*)(a.ws + WS_MOD); const int* pos = (const int*)(a.ws + WS_POS); const float* rtw = (const float*)(a.ws + WS_RTW);
    const bf16* ys = (const bf16*)(a.ws + WS_XS); float* out = a.out; const bf16* x1 = (const bf16*)(a.ws + WS_X1B);
    typedef int v4i_ __attribute__((ext_vector_type(4)));
    v4i_ ps[2]; f32x4 wt[2];
    { const int m0 = 4 * gw < NT ? 4 * gw : 0; ps[0] = *(const v4i_*)(pos + 2 * m0); ps[1] = *(const v4i_*)(pos + 2 * m0 + 4); wt[0] = *(const f32x4*)(rtw + 2 * m0); wt[1] = *(const f32x4*)(rtw + 2 * m0 + 4); }
    for (int m0 = 4 * gw; m0 < NT; m0 += 4 * NGW) {
        const int mn = m0 + 4 * NGW < NT ? m0 + 4 * NGW : m0; const int b = m0 >> 11;
        v4u xw[4][2], y0[4][2], y1[4][2];
#pragma unroll
        for (int r = 0; r < 4; ++r) { const int i0 = 2 * r, i1 = 2 * r + 1; const int q0 = ps[i0 >> 2][i0 & 3], q1 = ps[i1 >> 2][i1 & 3];
#pragma unroll
            for (int hf = 0; hf < 2; ++hf) { const int col = 8 * lane + 512 * hf; xw[r][hf] = __builtin_nontemporal_load((const v4u*)(x1 + (size_t)(m0 + r) * DM + col)); y0[r][hf] = __builtin_nontemporal_load((const v4u*)(ys + (size_t)q0 * DM + col)); y1[r][hf] = __builtin_nontemporal_load((const v4u*)(ys + (size_t)q1 * DM + col)); } }
        v4i_ np[2]; f32x4 nw[2];
        np[0] = *(const v4i_*)(pos + 2 * mn); np[1] = *(const v4i_*)(pos + 2 * mn + 4); nw[0] = *(const f32x4*)(rtw + 2 * mn); nw[1] = *(const f32x4*)(rtw + 2 * mn + 4);
#pragma unroll
        for (int hf = 0; hf < 2; ++hf) { const int col = 8 * lane + 512 * hf; float g2[8]; rw::ld8f(mod + b * 6144 + 5120 + col, g2);
#pragma unroll
            for (int r = 0; r < 4; ++r) { const int i0 = 2 * r, i1 = 2 * r + 1; const float w0 = wt[i0 >> 2][i0 & 3], w1 = wt[i1 >> 2][i1 & 3];
                const v4u xa = xw[r][hf], a0 = y0[r][hf], a1 = y1[r][hf];
                const float xv[8] = {bflo(xa.x), bfhi(xa.x), bflo(xa.y), bfhi(xa.y), bflo(xa.z), bfhi(xa.z), bflo(xa.w), bfhi(xa.w)};
                const float e0[8] = {bflo(a0.x), bfhi(a0.x), bflo(a0.y), bfhi(a0.y), bflo(a0.z), bfhi(a0.z), bflo(a0.w), bfhi(a0.w)};
                const float e1[8] = {bflo(a1.x), bfhi(a1.x), bflo(a1.y), bfhi(a1.y), bflo(a1.z), bfhi(a1.z), bflo(a1.w), bfhi(a1.w)};
                float o[8];
#pragma unroll
                for (int e = 0; e < 8; ++e) o[e] = xv[e] + g2[e] * (e0[e] * w0 + e1[e] * w1);
                float* op = out + (size_t)(m0 + r) * DM + col; __builtin_nontemporal_store((f32x4){o[0], o[1], o[2], o[3]}, (f32x4*)op); __builtin_nontemporal_store((f32x4){o[4], o[5], o[6], o[7]}, (f32x4*)(op + 4)); } }
        ps[0] = np[0]; ps[1] = np[1]; wt[0] = nw[0]; wt[1] = nw[1];
    }
}

#define XB_TMO      128
#define XB_XCNT(j)  (256  + 64 * (j))
#define XB_XSUB(j)  (1280 + 64 * (j))
#define XB_XGEN(j)  (2304 + 64 * (j))
#define XB_TOP      3328
#define XB_TOPGEN   3392
#define XCD_BAR_WORDS 3456
#define XB_SPIN_CAP (1u << 22)

__device__ __forceinline__ unsigned xb_ld(unsigned* p)              { return __hip_atomic_load(p, __ATOMIC_RELAXED, __HIP_MEMORY_SCOPE_AGENT); }
__device__ __forceinline__ unsigned xb_add(unsigned* p, unsigned v) { return __hip_atomic_fetch_add(p, v, __ATOMIC_RELAXED, __HIP_MEMORY_SCOPE_AGENT); }
__device__ __forceinline__ unsigned xb_xcc_id() { return (unsigned)__builtin_amdgcn_s_getreg((3 << 11) | 20) & 0xFu; }
#define XB_SPIN(cond, bar) do { unsigned _sp = 0; while (cond) { __builtin_amdgcn_s_sleep(1); \
    if ((++_sp & 255u) == 0u) { if (xb_ld(&(bar)[XB_TMO])) break; if (_sp > XB_SPIN_CAP) { atomicAdd(&(bar)[XB_TMO], 1u); break; } } } } while (0)

struct XcdBarrier {
    unsigned* bar; unsigned x;
    volatile LAS unsigned* st;
};

__device__ __forceinline__ XcdBarrier xcd_barrier_post(unsigned* bar, volatile LAS unsigned* st, int wv) {
    XcdBarrier b; b.bar = bar; b.x = xb_xcc_id(); b.st = st;
    if (mktid(wv) == 0) (void)xb_add(&bar[XB_XCNT(b.x)], 1u);
    return b;
}
__device__ __forceinline__ void xcd_barrier_complete(unsigned* bar, unsigned x, unsigned& nloc, unsigned& nx) {
    const unsigned G = gridDim.x * gridDim.y * gridDim.z;
    unsigned sum, cnt, mine, sp = 0u;
    for (;;) {
        sum = 0u; cnt = 0u; mine = 0u;
#pragma unroll
        for (unsigned j = 0; j < 16; ++j) { const unsigned c = xb_ld(&bar[XB_XCNT(j)]); sum += c; cnt += (c > 0u) ? 1u : 0u; mine = (j == x) ? c : mine; }
        if (sum == G) break;
        __builtin_amdgcn_s_sleep(1);
        if ((++sp & 255u) == 0u) { if (xb_ld(&bar[XB_TMO])) break; if (sp > XB_SPIN_CAP) { atomicAdd(&bar[XB_TMO], 1u); break; } }
    }
    nloc = mine > 0u ? mine : 1u; nx = cnt > 0u ? cnt : 1u;
}

__device__ __forceinline__ void xcd_barrier(const XcdBarrier& b, int wv) {
    asm volatile("s_waitcnt vmcnt(0)" ::: "memory");
    __syncthreads();
    if (mktid(wv) == 0) {
        unsigned* bar = b.bar;
        __builtin_amdgcn_s_waitcnt(0);
        unsigned nloc = b.st[0], nx = b.st[1];
        if (nloc == 0u) { xcd_barrier_complete(bar, b.x, nloc, nx); b.st[0] = nloc; b.st[1] = nx; }
        const unsigned old = xb_add(&bar[XB_XSUB(b.x)], 1u);
        const unsigned gen = old / nloc;
        if (old + 1u == (gen + 1u) * nloc) {
            __builtin_amdgcn_fence(__ATOMIC_RELEASE, "agent");
            asm volatile("s_waitcnt vmcnt(0)" ::: "memory");
            const unsigned og = xb_add(&bar[XB_TOP], 1u);
            const unsigned tg = og / nx;
            if (og + 1u == (tg + 1u) * nx) xb_add(&bar[XB_TOPGEN], 1u);
            else XB_SPIN(xb_ld(&bar[XB_TOPGEN]) == tg, bar);
            __builtin_amdgcn_fence(__ATOMIC_ACQUIRE, "agent");
            xb_add(&bar[XB_XGEN(b.x)], 1u);
            asm volatile("s_waitcnt vmcnt(0)" ::: "memory");
        } else {
            XB_SPIN(xb_ld(&bar[XB_XGEN(b.x)]) == gen, bar);
            __builtin_amdgcn_fence(__ATOMIC_ACQUIRE, "agent");
            asm volatile("s_waitcnt vmcnt(0)" ::: "memory");
        }
    }
    __syncthreads();
}

constexpr int LDS_BYTES = 160 * 1024, MISC_OFF = LDS_BYTES - 256;
static_assert(rw::LDS_NEED <= MISC_OFF, "scan LDS");
static_assert(XB_TMO == XB_TMO_W && MISC_OFF + 64 == DOWN_MSK_OFF, "control word layout");

__device__ __forceinline__ void p_actprep_dyn(const PArgs& a, unsigned char* lds, int wv) {
    const int tid = mktid(wv), lane = tid & 63; const bf16* z = (const bf16*)(a.ws + WS_Z); bf16* act = (bf16*)(a.ws + WS_ACT); const float* mu = a.in[7];
    unsigned* ctl = (unsigned*)(a.ws + WS_CTL);
    __syncthreads();
    if (tid == 0) { XB_SPIN(xb_ld(ctl + CW_ZCNT) < (unsigned)(NT / 256 * 8), ctl + CW_BAR); __builtin_amdgcn_fence(__ATOMIC_ACQUIRE, "agent"); asm volatile("s_waitcnt vmcnt(0)" ::: "memory"); }
    __syncthreads();
    const int cg = lane & 31, col = 1536 + 8 * cg;
    const f32x4 m0 = *(const f32x4*)(mu + col), m1 = *(const f32x4*)(mu + col + 4); const float m8[8] = {m0.x, m0.y, m0.z, m0.w, m1.x, m1.y, m1.z, m1.w};
    for (;;) {
        unsigned grab = 0; if (lane == 0) grab = atomicAdd(ctl + CW_AQ, 1u);
        grab = (unsigned)__builtin_amdgcn_readfirstlane((int)grab);
        if (grab >= (unsigned)(NT / 64)) break;
        for (int sub = 0; sub < 8; ++sub) {
        const int t0 = (int)grab * 64 + sub * 8 + (lane >> 5);
        v4u cw[4], pw[4];
#pragma unroll
        for (int u = 0; u < 4; ++u) { const int t = t0 + 2 * u; const int tp = (t & (SEQ - 1)) > 0 ? t - 1 : t; cw[u] = *(const v4u*)(z + (size_t)t * INC + col); pw[u] = *(const v4u*)(z + (size_t)tp * INC + col); }
#pragma unroll
        for (int u = 0; u < 4; ++u) { const int t = t0 + 2 * u; const bool hasp = (t & (SEQ - 1)) > 0; const v4u c4 = cw[u]; v4u p4 = pw[u]; if (!hasp) p4 = (v4u){0u, 0u, 0u, 0u};
            const float c8[8] = {bflo(c4.x), bfhi(c4.x), bflo(c4.y), bfhi(c4.y), bflo(c4.z), bfhi(c4.z), bflo(c4.w), bfhi(c4.w)}, p8[8] = {bflo(p4.x), bfhi(p4.x), bflo(p4.y), bfhi(p4.y), bflo(p4.z), bfhi(p4.z), bflo(p4.w), bfhi(p4.w)}; float v[8];
#pragma unroll
            for (int e = 0; e < 8; ++e) { const float x = c8[e] + (p8[e] - c8[e]) * m8[e]; v[e] = cg < 8 ? 1.0f - 2.0f * __builtin_amdgcn_rcpf(1.0f + __expf(2.0f * x)) : cg < 16 ? x : sigm(x); }
            v4u w; w.x = pk2(v[0], v[1]); w.y = pk2(v[2], v[3]); w.z = pk2(v[4], v[5]); w.w = pk2(v[6], v[7]);
            *(v4u*)(act + (size_t)t * 256 + 8 * cg) = w; }
        }
    }
}

__global__ void __launch_bounds__(512, 2) mega_fwd(PArgs a) {
    extern __shared__ __attribute__((aligned(16))) unsigned char lds[];
    volatile LAS unsigned* MISC = (volatile LAS unsigned*)((LAS unsigned char*)lds + MISC_OFF);
    const int wv = __builtin_amdgcn_readfirstlane((int)threadIdx.x >> 6);
    { const int t0 = mktid(wv); if (t0 < 64) MISC[t0] = 0u; }
    __syncthreads();
    XcdBarrier bar = xcd_barrier_post((unsigned*)(a.ws + WS_CTL) + CW_BAR, MISC + 8, wv);
    GemmArgs g; g.ws = a.ws; g.x = a.in[0]; g.out = a.out; g.qg = a.in[18]; g.kg = a.in[19];
    const int G = (int)gridDim.x, bx = (int)blockIdx.x;

    { const int t0 = mktid(wv); float wr[64]; float* sc = (float*)(lds + 68 * 1024); float* red = (float*)lds;
      const bool has = bx < 192;
      if (has) p_ada_load(a, bx, t0, wr);
      for (int i = t0; i < 16 * 1024; i += 512) { const float v = a.in[1][i]; sc[i] = v / (1.0f + __expf(-v)); }
      p_prep_weights(a, lds, wv);
      __syncthreads();
      if (has) p_ada_finish(a, sc, red, bx, t0, wr);
      for (int tile = bx + G; tile < 192; tile += G) { p_ada_load(a, tile, t0, wr); p_ada_finish(a, sc, red, tile, t0, wr); } }
    xcd_barrier(bar, wv);
    p_norm1(a, lds, wv);
    xcd_barrier(bar, wv);
    p_gemm_in(g, lds, wv);
    p_actprep_dyn(a, lds, wv);
    xcd_barrier(bar, wv);
    { const int nscan = G / 2;
      if (bx < nscan) { for (int bh = bx; bh < 128; bh += nscan) rw::scan_unit(a, lds, bh, wv); }
      else p_attn(a, lds, bx - nscan, G - nscan, wv); }
    __syncthreads(); p_prep_experts_dyn(a, lds, wv);
    xcd_barrier(bar, wv);
    p_gemm_merge(g, lds, wv);
    xcd_barrier(bar, wv);
    p_gemm_out(g, lds, wv);
    xcd_barrier(bar, wv);
    p_norm2_route(a, lds, wv);
    xcd_barrier(bar, wv);
    p_moe_gather(a, lds, wv);
    xcd_barrier(bar, wv);
    p_gemm_up(g, lds, wv);
    __syncthreads();
    p_gemm_down(g, lds, wv);
    xcd_barrier(bar, wv);
    p_combine(a, lds, wv);
}

extern "C" void kernel_launch(void* const* d_in, const int* in_sizes, int n_in, void* d_out, int out_size, void* d_ws, size_t ws_size, hipStream_t stream) {
    static int grid = 0;
    if (grid == 0) {
        if (n_in != 30 || out_size != NT * DM || ws_size < WS_END) { fprintf(stderr, "kernel_launch: unexpected shapes (n_in %d, out %d, ws %zu)\n", n_in, out_size, ws_size); grid = -1; return; }
        int dev = 0, cus = 0, per_cu = 0;
        if (hipGetDevice(&dev) != hipSuccess || hipDeviceGetAttribute(&cus, hipDeviceAttributeMultiprocessorCount, dev) != hipSuccess) { grid = -1; return; }
        if (hipFuncSetAttribute((const void*)mega_fwd, hipFuncAttributeMaxDynamicSharedMemorySize, LDS_BYTES) != hipSuccess) { fprintf(stderr, "kernel_launch: hipFuncSetAttribute failed\n"); grid = -1; return; }
        if (hipOccupancyMaxActiveBlocksPerMultiprocessor(&per_cu, (const void*)mega_fwd, 512, LDS_BYTES) != hipSuccess || per_cu < 1) { fprintf(stderr, "kernel_launch: occupancy query says %d blocks per CU\n", per_cu); (void)hipGetLastError(); grid = -1; return; }
        grid = cus;
    }
    if (grid < 0) return;
    (void)hipMemsetAsync((char*)d_ws + WS_CTL, 0, 65536, stream);
    PArgs p{}; for (int i = 0; i < 30; ++i) p.in[i] = (const float*)d_in[i]; p.out = (float*)d_out; p.ws = (unsigned char*)d_ws;
    hipLaunchKernelGGL(mega_fwd, dim3(grid), dim3(512), LDS_BYTES, stream, p);
}
```

```cpp
#include <hip/hip_runtime.h>
#include <cstdio>
#include <cstdint>
__device__ __forceinline__ int mktid(int wv) { int l; asm volatile("v_mbcnt_lo_u32_b32 %0, -1, 0\n\tv_mbcnt_hi_u32_b32 %0, -1, %0" : "=v"(l)); return (wv << 6) | l; }
template <int CTRL> __device__ __forceinline__ float dppf(float v) { return __builtin_bit_cast(float, __builtin_amdgcn_update_dpp(0, __builtin_bit_cast(int, v), CTRL, 0xF, 0xF, true)); }
__device__ __forceinline__ float red4(float v) { v += dppf<0xB1>(v); v += dppf<0x4E>(v); return v; }
__device__ __forceinline__ float red8(float v) { v = red4(v); v += dppf<0x141>(v); return v; }
__device__ __forceinline__ float red16(float v) { v = red8(v); v += dppf<0x140>(v); return v; }
__device__ __forceinline__ float wave_sum(float v) { v = red16(v);
    v += __builtin_bit_cast(float, __builtin_amdgcn_ds_swizzle(__builtin_bit_cast(int, v), 0x401F));
    const unsigned u = __builtin_bit_cast(unsigned, v); auto rr = __builtin_amdgcn_permlane32_swap(u, u, false, false);
    return __builtin_bit_cast(float, (unsigned)rr[0]) + __builtin_bit_cast(float, (unsigned)rr[1]); }
__device__ __forceinline__ void wave_sum8(float (&v)[8]) {
#pragma unroll
    for (int i = 0; i < 8; ++i) v[i] += dppf<0xB1>(v[i]);
#pragma unroll
    for (int i = 0; i < 8; ++i) v[i] += dppf<0x4E>(v[i]);
#pragma unroll
    for (int i = 0; i < 8; ++i) v[i] += dppf<0x141>(v[i]);
#pragma unroll
    for (int i = 0; i < 8; ++i) v[i] += dppf<0x140>(v[i]);
#pragma unroll
    for (int i = 0; i < 8; ++i) v[i] += __builtin_bit_cast(float, __builtin_amdgcn_ds_swizzle(__builtin_bit_cast(int, v[i]), 0x401F));
#pragma unroll
    for (int i = 0; i < 8; ++i) { const unsigned u = __builtin_bit_cast(unsigned, v[i]); auto rr = __builtin_amdgcn_permlane32_swap(u, u, false, false); v[i] = __builtin_bit_cast(float, (unsigned)rr[0]) + __builtin_bit_cast(float, (unsigned)rr[1]); }
}
__device__ __forceinline__ float lane_get(float v, int src) { return __builtin_bit_cast(float, __builtin_amdgcn_ds_bpermute(src << 2, __builtin_bit_cast(int, v))); }
namespace pg8 {
#define PG8_LAS __attribute__((address_space(3)))
typedef unsigned short bf16_t;
typedef short bf16x8 __attribute__((ext_vector_type(8)));
typedef float f32x4 __attribute__((ext_vector_type(4)));
typedef unsigned u32x4 __attribute__((ext_vector_type(4)));
constexpr int BM = 256, BK = 64, HALF = 128, HTB = HALF * BK * 2  , STAGE_BYTES = 8 * HTB, NXCD = 8, WGM = 4;

__host__ __device__ __forceinline__ int lds_byte(int r, int c) { const int st = (r >> 4) * 2 + (c >> 5), rr = r & 15, cc = c & 31, ob = rr * 64 + cc * 2; return st * 1024 + (ob ^ (((ob >> 9) & 1) << 5)); }
__host__ __device__ __forceinline__ void stage_rc(int b, int& R, int& C) { const int st = b / 1024, sb = b % 1024, swz = sb ^ (((sb >> 9) & 1) << 5); R = (st >> 1) * 16 + swz / 64; C = (st & 1) * 32 + (swz % 64) / 2; }
__host__ __device__ __forceinline__ int perm32(int rho) { const int n = rho >> 4, i = rho & 15; return 8 * (i >> 2) + 4 * n + (i & 3); }
struct Unit { int pm, pn, aux; const char* a; const char* b; };
struct Gemm { int K; };

struct StaticOrder {
    int nM, nN, nwg, G, c; const char* A; const char* Bt; size_t tstep;
    __device__ void init(const void* A_, const void* Bt_, int M, int N, int K, int G_, int c_) { nM = M / BM; nN = N / BM; nwg = nM * nN; G = G_; c = c_; A = (const char*)A_; Bt = (const char*)Bt_; tstep = (size_t)BM * K * 2; }
    __device__ bool next(int i, Unit& u) const {
        const long L = (long)i * G + c; if (L >= nwg) return false;
        int wgid = (int)L; { const int q = nwg / NXCD, r = nwg % NXCD, xcd = wgid % NXCD, off = wgid / NXCD; wgid = (xcd < r ? xcd * (q + 1) : r * (q + 1) + (xcd - r) * q) + off; }
        const int nig = WGM * nN, gid = wgid / nig, fm = gid * WGM, gsz = (nM - fm) < WGM ? (nM - fm) : WGM;
        u.aux = 0; u.pm = fm + ((wgid % nig) % gsz); u.pn = (wgid % nig) / gsz; u.a = A + (size_t)u.pm * tstep; u.b = Bt + (size_t)u.pn * tstep; return true;
    }
    __device__ __forceinline__ void a_ready(const Unit&) const {}
    __device__ __forceinline__ void done(const Unit&) const {}
};
__device__ __forceinline__ unsigned cvt_pk_bf16(float lo, float hi) { unsigned r; asm volatile("v_cvt_pk_bf16_f32 %0, %1, %2" : "=v"(r) : "v"(lo), "v"(hi)); return r; }
template <class Epi, class Sched, bool ALIGN_EPI = false, bool SP2 = false>
__device__ __forceinline__ void gemm_phase(PG8_LAS unsigned char* lds, const Gemm g, const Sched& S, const Epi& E, int wv) {
    const int tid = mktid(wv), wid = __builtin_amdgcn_readfirstlane(tid >> 6), lane = tid & 63, wr = wid >> 2, wc = wid & 3, fr = lane & 15, fq = lane >> 4;
    const int K = g.K, nt = K / BK;
    unsigned voffA[2], voffB[2];
#pragma unroll
    for (int i = 0; i < 2; ++i) { int R, C; stage_rc(tid * 16 + i * 8192, R, C); const int Rb = Epi::PERM ? ((R & ~31) + perm32(R & 31)) : R;
        voffA[i] = (unsigned)(R * K + C) * 2u; voffB[i] = (unsigned)(Rb * K + C) * 2u; }
    const size_t kstep = (size_t)(BK * 2);
    const size_t hstep = (size_t)HALF * K * 2;
        const unsigned ldsw = (unsigned)wid * 1024u;
    const int aoff = lds_byte(wr * 64 + fr, fq * 8), boff = lds_byte(wc * 32 + fr, fq * 8);
#define PG8_SA(b, h) (((b) * 2 + (h)) * HTB)
#define PG8_SB(b, h) ((4 + (b) * 2 + (h)) * HTB)
#define PG8_STAGE(bufoff, gbase, voff) do { _Pragma("unroll") for (int _i = 0; _i < 2; ++_i) \
        __builtin_amdgcn_global_load_lds((const unsigned*)((const char*)(gbase) + (voff)[_i]), (PG8_LAS unsigned*)(lds + (bufoff) + ldsw + _i * 8192), 16, 0, 0); } while (0)
#define PG8_LDA(dst, b, h) do { _Pragma("unroll") for (int m = 0; m < 4; ++m) _Pragma("unroll") for (int k = 0; k < 2; ++k) dst[m][k] = *(const PG8_LAS bf16x8*)(lds + PG8_SA(b, h) + aoff + m * 2048 + k * 1024); } while (0)
#define PG8_LDB(dst, b, h) do { _Pragma("unroll") for (int n = 0; n < 2; ++n) _Pragma("unroll") for (int k = 0; k < 2; ++k) dst[n][k] = *(const PG8_LAS bf16x8*)(lds + PG8_SB(b, h) + boff + n * 2048 + k * 1024); } while (0)
#define PG8_MMA(ai, bj, At, Bt) do { __builtin_amdgcn_s_setprio(1); _Pragma("unroll") for (int m = 0; m < 4; ++m) _Pragma("unroll") for (int n = 0; n < 2; ++n) _Pragma("unroll") for (int k = 0; k < 2; ++k) \
        acc[ai][bj][m][n] = __builtin_amdgcn_mfma_f32_16x16x32_bf16(Bt[n][k], At[m][k], acc[ai][bj][m][n], 0, 0, 0); __builtin_amdgcn_s_setprio(0); } while (0)
#define PG8_WAIT_V(n) asm volatile("s_waitcnt vmcnt(" #n ")" ::: "memory")
#define PG8_WAIT_L(n) asm volatile("s_waitcnt lgkmcnt(" #n ")" ::: "memory")
#define PG8_BAR __builtin_amdgcn_s_barrier()
#define PG8_SCHED __builtin_amdgcn_sched_barrier(0)
    Unit cur, nxt; int ui = 0;
    if (!S.next(0, cur)) return;
    f32x4 acc[2][2][4][2];
#pragma unroll
    for (int a = 0; a < 2; ++a)
#pragma unroll
        for (int b = 0; b < 2; ++b)
#pragma unroll
            for (int m = 0; m < 4; ++m)
#pragma unroll
                for (int n = 0; n < 2; ++n) acc[a][b][m][n] = (f32x4){0.f, 0.f, 0.f, 0.f};
    bf16x8 At[4][2], B0[2][2], B1[2][2];
    const char* cA = cur.a; const char* cB = cur.b;
    S.a_ready(cur);
    if constexpr (SP2) {
        PG8_STAGE(PG8_SB(0, 0), cB, voffB); PG8_STAGE(PG8_SB(0, 1), cB + hstep, voffB); PG8_STAGE(PG8_SA(0, 0), cA, voffA); PG8_STAGE(PG8_SA(0, 1), cA + hstep, voffA);
        if (wr == 1) PG8_BAR;
        PG8_WAIT_V(2); PG8_BAR;
        PG8_STAGE(PG8_SB(1, 0), cB + kstep, voffB); PG8_STAGE(PG8_SA(1, 0), cA + kstep, voffA); PG8_STAGE(PG8_SB(1, 1), cB + hstep + kstep, voffB);
        PG8_WAIT_V(6); PG8_BAR;
    } else {
        PG8_STAGE(PG8_SB(0, 0), cB, voffB); PG8_STAGE(PG8_SA(0, 0), cA, voffA); PG8_STAGE(PG8_SB(0, 1), cB + hstep, voffB); PG8_STAGE(PG8_SA(0, 1), cA + hstep, voffA);
        if (wr == 1) PG8_BAR;
        PG8_WAIT_V(4); PG8_BAR;
        PG8_STAGE(PG8_SB(1, 0), cB + kstep, voffB); PG8_STAGE(PG8_SA(1, 0), cA + kstep, voffA); PG8_STAGE(PG8_SB(1, 1), cB + hstep + kstep, voffB);
        PG8_WAIT_V(6); PG8_BAR;
    }
    for (;;) {
        const bool has_next = S.next(ui + 1, nxt);
        const char* nA = has_next ? nxt.a : cA; const char* nB = has_next ? nxt.b : cB;
        for (int t = 0; t < nt; t += 2) {
            const bool last = (t == nt - 2);
            const char* a1 = cA + (size_t)(t + 1) * kstep;
            const char* a2 = last ? nA : cA + (size_t)(t + 2) * kstep; const char* b2 = last ? nB : cB + (size_t)(t + 2) * kstep;
            const char* a3 = a2 + kstep; const char* b3 = b2 + kstep;
            if (last && has_next) S.a_ready(nxt);
            if constexpr (SP2) {
            PG8_LDB(B0, 0, 0); PG8_LDB(B1, 0, 1); PG8_SCHED; PG8_LDA(At, 0, 0); PG8_STAGE(PG8_SA(1, 1), a1 + hstep, voffA);
            PG8_WAIT_V(8); PG8_WAIT_L(0); PG8_BAR; PG8_MMA(0, 0, At, B0); PG8_MMA(0, 1, At, B1); PG8_BAR; PG8_SCHED;
            PG8_LDA(At, 0, 1); PG8_STAGE(PG8_SB(0, 0), b2, voffB); PG8_STAGE(PG8_SB(0, 1), b2 + hstep, voffB); PG8_STAGE(PG8_SA(0, 0), a2, voffA);
            PG8_WAIT_V(8); PG8_WAIT_L(0); PG8_BAR; PG8_MMA(1, 0, At, B0); PG8_MMA(1, 1, At, B1); PG8_BAR; PG8_SCHED;
            PG8_LDB(B0, 1, 0); PG8_LDB(B1, 1, 1); PG8_SCHED; PG8_LDA(At, 1, 0); PG8_STAGE(PG8_SA(0, 1), a2 + hstep, voffA);
            PG8_WAIT_V(8); PG8_WAIT_L(0); PG8_BAR; PG8_MMA(0, 0, At, B0); PG8_MMA(0, 1, At, B1); PG8_BAR; PG8_SCHED;
            PG8_LDA(At, 1, 1); PG8_STAGE(PG8_SB(1, 0), b3, voffB); PG8_STAGE(PG8_SB(1, 1), b3 + hstep, voffB); PG8_STAGE(PG8_SA(1, 0), a3, voffA);
            PG8_WAIT_V(8); PG8_WAIT_L(0); PG8_BAR; PG8_MMA(1, 0, At, B0); PG8_MMA(1, 1, At, B1); PG8_BAR; PG8_SCHED;
            } else {
            PG8_LDB(B0, 0, 0); PG8_SCHED; PG8_LDA(At, 0, 0); PG8_STAGE(PG8_SA(1, 1), a1 + hstep, voffA);
            PG8_WAIT_L(8); PG8_BAR; PG8_WAIT_L(0); PG8_MMA(0, 0, At, B0); PG8_BAR; PG8_SCHED;
            PG8_LDB(B1, 0, 1); PG8_STAGE(PG8_SB(0, 0), b2, voffB);
            PG8_BAR; PG8_WAIT_L(0); PG8_MMA(0, 1, At, B1); PG8_BAR;
            PG8_LDA(At, 0, 1); PG8_STAGE(PG8_SA(0, 0), a2, voffA);
            PG8_BAR; PG8_WAIT_L(0); PG8_MMA(1, 0, At, B0); PG8_BAR; PG8_SCHED;
            PG8_STAGE(PG8_SB(0, 1), b2 + hstep, voffB);
            PG8_WAIT_V(6); PG8_BAR; PG8_MMA(1, 1, At, B1); PG8_BAR;
            PG8_LDB(B0, 1, 0); PG8_SCHED; PG8_LDA(At, 1, 0); PG8_STAGE(PG8_SA(0, 1), a2 + hstep, voffA);
            PG8_WAIT_L(8); PG8_BAR; PG8_WAIT_L(0); PG8_MMA(0, 0, At, B0); PG8_BAR; PG8_SCHED;
            PG8_LDB(B1, 1, 1); PG8_STAGE(PG8_SB(1, 0), b3, voffB);
            PG8_BAR; PG8_WAIT_L(0); PG8_MMA(0, 1, At, B1); PG8_BAR;
            PG8_LDA(At, 1, 1); PG8_STAGE(PG8_SA(1, 0), a3, voffA);
            PG8_BAR; PG8_WAIT_L(0); PG8_MMA(1, 0, At, B0); PG8_BAR; PG8_SCHED;
            PG8_STAGE(PG8_SB(1, 1), b3 + hstep, voffB);
            PG8_WAIT_V(6); PG8_BAR; PG8_MMA(1, 1, At, B1); PG8_BAR;
            }
        }
        if constexpr (ALIGN_EPI) { if (wr == 0) PG8_BAR; }
        bool keep = false;
        if constexpr (!Epi::AFTER_DRAIN) { if constexpr (Epi::CHAIN) keep = E.chain(acc, cur, wr, wc, fr, fq); else E(acc, cur, wr, wc, fr, fq); S.done(cur); }
        if (!has_next) break;
        if (!keep) {
#pragma unroll
        for (int a = 0; a < 2; ++a)
#pragma unroll
            for (int b = 0; b < 2; ++b)
#pragma unroll
                for (int m = 0; m < 4; ++m)
#pragma unroll
                    for (int n = 0; n < 2; ++n) acc[a][b][m][n] = (f32x4){0.f, 0.f, 0.f, 0.f};
        }
        cur = nxt; cA = nA; cB = nB; ++ui;
        if constexpr (ALIGN_EPI) { if (wr == 1) PG8_BAR; }
    }
    PG8_WAIT_V(0);
    if constexpr (!ALIGN_EPI) { if (wr == 0) PG8_BAR; }
    PG8_BAR;
    if constexpr (Epi::AFTER_DRAIN) { E.fused(acc, cur, wr, wc, fr, fq, lds, wid, lane); S.done(cur); }
#undef PG8_SA
#undef PG8_SB
#undef PG8_STAGE
#undef PG8_LDA
#undef PG8_LDB
#undef PG8_MMA
#undef PG8_WAIT_V
#undef PG8_WAIT_L
#undef PG8_BAR
#undef PG8_SCHED
}
}
#include <hip/hip_bf16.h>
#include <cmath>
namespace attn_body {
using bf16=__hip_bfloat16;
using bf16x8=__attribute__((ext_vector_type(8)))short;
using s16x4=__attribute__((ext_vector_type(4)))short;
using f32x16=__attribute__((ext_vector_type(16)))float;
using u32x4=__attribute__((ext_vector_type(4)))unsigned;
constexpr int NHEAD=8,SEQ=2048,D=64,PQ=512,PK=512,PV=4352,PO=512;
constexpr int NW=8,QBLK=32,QB=QBLK*NW,KVBLK=64,NQB=SEQ/QB;
__device__ __forceinline__ int crow(int r,int hi){return (r&3)+8*(r>>2)+4*hi;}
#define SBAR() __builtin_amdgcn_sched_barrier(0)
__device__ __forceinline__ void cmask(f32x16&p0,f32x16&p1,int jb,int qrel,int hi){
  const float NEG=-INFINITY; int kb=64*jb+4*hi;
  #pragma unroll
  for(int r=0;r<16;++r){int kv=kb+(r&3)+8*(r>>2); if(kv>qrel)p0[r]=NEG; if(kv+32>qrel)p1[r]=NEG;}
}

constexpr int NSLOT=3, SLOTB=8192;
constexpr int LDS_K=0, LDS_V=NSLOT*SLOTB, LDS_WS=2*NSLOT*SLOTB, LDS_OST=LDS_WS+NW*64*4, LDS_SEL=LDS_OST+NW*4096, LDS_KM=LDS_SEL+256, LDS_KP=LDS_KM+7*64*4, LDS_BYTES=LDS_KP+8*64*4;
constexpr float C2=0.125f*1.4426950408889634f;
__device__ __forceinline__ void glds16(const void*gsrc,unsigned lds_dst){unsigned keep;
  asm volatile("s_mov_b32 %0, m0\n\ts_mov_b32 m0, %2\n\ts_nop 0\n\tglobal_load_lds_dwordx4 %1, off\n\ts_mov_b32 m0, %0":"=&s"(keep):"v"(gsrc),"s"(lds_dst):"memory");}
__device__ __forceinline__ float max3f(float a,float b,float c){float r;asm("v_max3_f32 %0, %1, %2, %3":"=v"(r):"v"(a),"v"(b),"v"(c));return r;}
__device__ __forceinline__ float max2f(float a,float b){float r;asm("v_max_f32_e32 %0, %1, %2":"=v"(r):"v"(a),"v"(b));return r;}
__device__ __forceinline__ float fadd_s(float a,float b){float r;asm("v_add_f32_e32 %0, %1, %2":"=v"(r):"v"(a),"v"(b));return r;}
__device__ __forceinline__ float fsub_s(float a,float b){float r;asm("v_sub_f32_e32 %0, %1, %2":"=v"(r):"v"(a),"v"(b));return r;}
typedef float f32x2_t __attribute__((ext_vector_type(2))); typedef __bf16 bf16x2_t __attribute__((ext_vector_type(2)));
__device__ __forceinline__ unsigned cvtpk_s(float lo,float hi){f32x2_t v={lo,hi};bf16x2_t b=__builtin_convertvector(v,bf16x2_t);return __builtin_bit_cast(unsigned,b);}
#define WAIT_BAR(N) asm volatile("s_waitcnt vmcnt(" #N ") lgkmcnt(0)\n\ts_barrier":::"memory")

__device__ __forceinline__ void qkt(f32x16&p0,f32x16&p1,const char*Kslot,const bf16x8*qr,const f32x16&negm,int r32,int hi){
  const char*kb=Kslot+hi*1024+r32*16;
  #pragma unroll
  for(int d0=0;d0<4;++d0){
    const bf16x8 b0=*reinterpret_cast<const bf16x8*>(kb+d0*2048);
    const bf16x8 b1=*reinterpret_cast<const bf16x8*>(kb+d0*2048+512);
    if(d0==0){p0=__builtin_amdgcn_mfma_f32_32x32x16_bf16(b0,qr[0],negm,0,0,0);p1=__builtin_amdgcn_mfma_f32_32x32x16_bf16(b1,qr[0],negm,0,0,0);}
    else{p0=__builtin_amdgcn_mfma_f32_32x32x16_bf16(b0,qr[d0],p0,0,0,0);p1=__builtin_amdgcn_mfma_f32_32x32x16_bf16(b1,qr[d0],p1,0,0,0);}}
}
typedef __attribute__((address_space(3))) const char* lds_cptr;
typedef short v4i16_t __attribute__((ext_vector_type(4)));
__device__ __forceinline__ void kload8(bf16x8*kf,lds_cptr kp){
  kf[0]=*(const __attribute__((address_space(3))) bf16x8*)(kp);      kf[1]=*(const __attribute__((address_space(3))) bf16x8*)(kp+512);
  kf[2]=*(const __attribute__((address_space(3))) bf16x8*)(kp+2048); kf[3]=*(const __attribute__((address_space(3))) bf16x8*)(kp+2560);
  kf[4]=*(const __attribute__((address_space(3))) bf16x8*)(kp+4096); kf[5]=*(const __attribute__((address_space(3))) bf16x8*)(kp+4608);
  kf[6]=*(const __attribute__((address_space(3))) bf16x8*)(kp+6144); kf[7]=*(const __attribute__((address_space(3))) bf16x8*)(kp+6656);
}
__device__ __forceinline__ void kload2(bf16x8*kf,lds_cptr kp,int j){ kf[2*j]=*(const __attribute__((address_space(3))) bf16x8*)(kp+j*2048); kf[2*j+1]=*(const __attribute__((address_space(3))) bf16x8*)(kp+j*2048+512); }
__device__ __forceinline__ s16x4 vtr(lds_cptr p){ return __builtin_bit_cast(s16x4,__builtin_amdgcn_ds_read_tr16_b64_v4i16((__attribute__((address_space(3))) v4i16_t*)p)); }
__device__ __forceinline__ float rowmax(const f32x16&p0,const f32x16&p1){
  float a=max3f(p0[0],p0[1],p1[0]),b=max3f(p0[2],p0[3],p1[1]);a=max3f(a,p1[2],p1[3]);
  #pragma unroll
  for(int r=4;r<16;r+=4){a=max3f(a,p0[r],p0[r+1]);b=max3f(b,p0[r+2],p0[r+3]);a=max3f(a,p1[r],p1[r+1]);b=max3f(b,p1[r+2],p1[r+3]);}
  const float m=max2f(a,b);
  auto rr=__builtin_amdgcn_permlane32_swap(__float_as_uint(m),__float_as_uint(m),false,false);
  return max2f(__uint_as_float(rr[0]),__uint_as_float(rr[1]));
}
__device__ __forceinline__ void pv(f32x16*o,int vb,bf16x8 pa0,bf16x8 pa1,bf16x8 pa2,bf16x8 pa3){
  #pragma unroll
  for(int d0=0;d0<2;++d0){s16x4 lo[4],hi[4];
    #pragma unroll
    for(int ks=0;ks<4;++ks){
      asm volatile("ds_read_b64_tr_b16 %0,%1 offset:%c2":"=&v"(lo[ks]):"v"(vb),"i"(d0*4096+ks*1024):"memory");
      asm volatile("ds_read_b64_tr_b16 %0,%1 offset:%c2":"=&v"(hi[ks]):"v"(vb),"i"(d0*4096+ks*1024+512):"memory");}
    asm volatile("s_waitcnt lgkmcnt(0)":::"memory");SBAR();
    #define PK(k) (bf16x8){lo[k][0],lo[k][1],lo[k][2],lo[k][3],hi[k][0],hi[k][1],hi[k][2],hi[k][3]}
    o[d0]=__builtin_amdgcn_mfma_f32_32x32x16_bf16(pa0,PK(0),o[d0],0,0,0);
    o[d0]=__builtin_amdgcn_mfma_f32_32x32x16_bf16(pa1,PK(1),o[d0],0,0,0);
    o[d0]=__builtin_amdgcn_mfma_f32_32x32x16_bf16(pa2,PK(2),o[d0],0,0,0);
    o[d0]=__builtin_amdgcn_mfma_f32_32x32x16_bf16(pa3,PK(3),o[d0],0,0,0);
    #undef PK
  }
}

#ifndef ATTN_STORE16
#define ATTN_STORE16(p,v) (*(u32x4*)(p)=(v))
#endif
template<int THRL> __device__ __forceinline__ void attn_unit(int b,int h,int qb,const bf16*Q,const bf16*__restrict__ K,const bf16*__restrict__ V,bf16*O,char*shm,int wv){
  const int tid=mktid(wv),lane=tid&63,r32=lane&31,hi=lane>>5;     const int wid=__builtin_amdgcn_readfirstlane(tid>>6);
  const long rowbase=(long)b*SEQ; const int q0=qb*QB;
  if(qb>3){ float*KMl=(float*)(shm+LDS_KM); float*KPl=(float*)(shm+LDS_KP); const int c8=tid&7, rl=tid>>3;
    for(int n=0;n<qb;++n){ float sm[8];
      #pragma unroll
      for(int d=0;d<8;++d)sm[d]=0.f;
      #pragma unroll
      for(int rr=0;rr<4;++rr){ const u32x4 w=*reinterpret_cast<const u32x4*>(K+(rowbase+n*256+rl+64*rr)*PK+h*D+8*c8);
        sm[0]+=__uint_as_float(w[0]<<16);sm[1]+=__uint_as_float(w[0]&0xffff0000u);sm[2]+=__uint_as_float(w[1]<<16);sm[3]+=__uint_as_float(w[1]&0xffff0000u);
        sm[4]+=__uint_as_float(w[2]<<16);sm[5]+=__uint_as_float(w[2]&0xffff0000u);sm[6]+=__uint_as_float(w[3]<<16);sm[7]+=__uint_as_float(w[3]&0xffff0000u); }
      #pragma unroll
      for(int d=0;d<8;++d){ float v=sm[d];
        v+=__builtin_bit_cast(float,__builtin_amdgcn_ds_swizzle(__builtin_bit_cast(int,v),0x201F));
        v+=__builtin_bit_cast(float,__builtin_amdgcn_ds_swizzle(__builtin_bit_cast(int,v),0x401F));
        { const unsigned u=__builtin_bit_cast(unsigned,v); auto rr2=__builtin_amdgcn_permlane32_swap(u,u,false,false); v=__uint_as_float((unsigned)rr2[0])+__uint_as_float((unsigned)rr2[1]); }
        sm[d]=v; }
      if(lane<8){
        #pragma unroll
        for(int d=0;d<8;++d)KPl[wid*64+8*lane+d]=sm[d]; }
      asm volatile("s_waitcnt vmcnt(0) lgkmcnt(0)\n\ts_barrier":::"memory");
      if(tid<64){ float s8=0.f;
        #pragma unroll
        for(int w8=0;w8<8;++w8)s8+=KPl[w8*64+tid];
        KMl[n*64+tid]=s8*(1.0f/256.0f); }
      asm volatile("s_waitcnt lgkmcnt(0)\n\ts_barrier":::"memory"); } }
  if(tid<QB){ unsigned sel=(qb<=3)?((1u<<qb)-1u):0u;
    if(qb>3){ const bf16*qp=Q+(rowbase+q0+tid)*PQ+h*D; const float*km=(const float*)(shm+LDS_KM); float gate[7];
      #pragma unroll
      for(int j=0;j<7;++j)gate[j]=0.f;
      #pragma unroll 1
      for(int i=0;i<8;++i){ const u32x4 w=*reinterpret_cast<const u32x4*>(qp+8*i); float qv[8];
        qv[0]=__uint_as_float(w[0]<<16);qv[1]=__uint_as_float(w[0]&0xffff0000u);qv[2]=__uint_as_float(w[1]<<16);qv[3]=__uint_as_float(w[1]&0xffff0000u);
        qv[4]=__uint_as_float(w[2]<<16);qv[5]=__uint_as_float(w[2]&0xffff0000u);qv[6]=__uint_as_float(w[3]<<16);qv[7]=__uint_as_float(w[3]&0xffff0000u);
        #pragma unroll
        for(int j=0;j<7;++j) if(j<qb){ const float*kp=km+j*64+8*i;
          #pragma unroll
          for(int d=0;d<8;++d)gate[j]+=qv[d]*kp[d]; } }
      #pragma unroll
      for(int rep=0;rep<3;++rep){ float best=-INFINITY; int bi=0;
        #pragma unroll
        for(int j=0;j<7;++j) if(j<qb&&!((sel>>j)&1u)&&gate[j]>best){best=gate[j];bi=j;}
        sel|=1u<<bi; } }
    ((unsigned char*)(shm+LDS_SEL))[tid]=(unsigned char)sel; }
  asm volatile("s_waitcnt vmcnt(0) lgkmcnt(0)\n\ts_barrier":::"memory");
  const bf16*Qw=Q+(rowbase+q0+wid*QBLK)*PQ+h*D;
  const bf16*Kh=K+rowbase*PK+h*D,*Vh=V+rowbase*PV+h*D;
  const unsigned lds0=(unsigned)(uintptr_t)shm;
  float*wsf=(float*)(shm+LDS_WS)+wid*64;
  const bf16*ksrc=Kh+(long)lane*PK+wid*8;
  const bf16*vsrc=Vh+(long)(16*(wid&3)+(lane>>2))*PV+(wid>>2)*32+(lane&3)*8;
  const unsigned kdst=lds0+LDS_K+wid*1024, vdst=lds0+LDS_V+wid*1024;
  #define TROW(t) ((long)(((t)<4)?(q0+(t)*KVBLK):(((t)-4)*KVBLK)))
  #define DMA_K(t,slot) glds16(ksrc+TROW(t)*PK,(unsigned)__builtin_amdgcn_readfirstlane(kdst+(slot)))
  #define DMA_V(t,slot) glds16(vsrc+TROW(t)*PV,(unsigned)__builtin_amdgcn_readfirstlane(vdst+(slot)))
  const int vb0=(int)(lds0+LDS_V)+((lane>>4)&1)*32+(lane&3)*8+(4*hi+((lane&15)>>2))*64;
  const char*Kbase=shm+LDS_K; bf16x8 kf[8];
  const lds_cptr shm3=(lds_cptr)shm; const lds_cptr kp0=shm3+LDS_K+hi*1024+r32*16; const lds_cptr vp0=shm3+LDS_V+((lane>>4)&1)*32+(lane&3)*8+(4*hi+((lane&15)>>2))*64;
  const int NT=(q0+QB)/KVBLK;
  DMA_K(0,0);DMA_V(0,0);DMA_K(1,SLOTB);
  bf16x8 qr[4];
  #pragma unroll
  for(int d0=0;d0<4;++d0)qr[d0]=*reinterpret_cast<const bf16x8*>(&Qw[(long)r32*PQ+d0*16+hi*8]);
  float mhat=0.f,l_reg=0.f;f32x16 o[2];o[0]=f32x16{};o[1]=f32x16{};
  const int qrel=wid*QBLK+r32;
  const unsigned selb=((const unsigned char*)(shm+LDS_SEL))[qrel];
  #define CMASK(P0,P1,t) cmask(P0,P1,(t),qrel,hi)
  #define SUBREF(C0,C1,t) do{ const float sb_=(((t)<4)||((selb>>(((t)-4)>>2))&1u))?mhat:INFINITY; _Pragma("unroll") for(int r_=0;r_<16;++r_){C0[r_]-=sb_;C1[r_]-=sb_;} }while(0)
  bool resc=false;
  #define START(P0,P1) do{ const float rm=rowmax(P0,P1); resc=false; \
    { const float dl=rm; mhat=fadd_s(mhat,dl); \
      _Pragma("unroll") for(int r=0;r<16;++r){P0[r]=fsub_s(P0[r],dl);P1[r]=fsub_s(P1[r],dl);} \
      } \
    _Pragma("unroll") for(int r=0;r<16;++r)P0[r]=__builtin_amdgcn_exp2f(P0[r]); }while(0)
  #define RESC() do{ if(resc){ asm volatile("s_waitcnt lgkmcnt(0)":::"memory"); \
      _Pragma("unroll") for(int d_=0;d_<2;++d_) _Pragma("unroll") for(int r=0;r<16;++r)o[d_][r]*=wsf[crow(r,hi)]; } }while(0)
  f32x16 pA0,pA1,pB0,pB1;
  int sl_prev=0,sl_cur=0,sl_next=SLOTB;
  #define ROT() do{sl_prev=sl_cur;sl_cur=sl_next;sl_next=(sl_next==(NSLOT-1)*SLOTB)?0:sl_next+SLOTB;}while(0)
  DMA_K(2,2*SLOTB);
  WAIT_BAR(3);
  qkt(pA0,pA1,Kbase,qr,f32x16{},r32,hi);asm volatile("s_nop 15\n\ts_nop 7":"+v"(pA0),"+v"(pA1));CMASK(pA0,pA1,0);
  START(pA0,pA1);
  _Pragma("unroll") for(int r=0;r<16;++r)pA1[r]=__builtin_amdgcn_exp2f(pA1[r]);
  WAIT_BAR(0);
  DMA_K(3,0);DMA_V(1,SLOTB);
  ROT();
  kload8(kf,kp0+sl_cur);
  WAIT_BAR(2);
  s16x4 vlo[8],vhi[8]; u32x4 pw0,pw1,pw2,pw3;
  #define PKW(P,B) cvtpk_s(P[B],P[B+1])
  #define PAF(k) __builtin_bit_cast(bf16x8,pw##k)
  #define VFR(i) (bf16x8){vlo[i][0],vlo[i][1],vlo[i][2],vlo[i][3],vhi[i][0],vhi[i][1],vhi[i][2],vhi[i][3]}
  #define PIN(x) asm volatile("":"+v"(x))
  #define MX3(a,b,c) __builtin_fmaxf(__builtin_fmaxf((a),(b)),(c))
  #define GAPA(MF,A0,A1,A2,A3,W0,W1,PW) do{ MF; sacc+=A0; sacc+=A1; sacc+=A2; sacc+=A3; PIN(sacc); W0; W1; PIN(PW); SBAR(); }while(0)
  #define EX(v) __builtin_amdgcn_exp2f(v)
  #define GAPB(MF,X,B) do{ MF; X[B]=EX(X[B]); X[B+1]=EX(X[B+1]); X[B+2]=EX(X[B+2]); X[B+3]=EX(X[B+3]); PIN(X); SBAR(); }while(0)
  #define VRD(i) do{ vlo[i]=vtr(vp_+(((i)>>2)*4096+((i)&3)*1024)); vhi[i]=vtr(vp_+(((i)>>2)*4096+((i)&3)*1024+512)); }while(0)
  #define KRD(G,j) do{ if(G){ kload2(kf,kp0+sl_next,j); SBAR(); } }while(0)
  #define STEP(C0,C1,P0,P1,t,GK,GV,GL,MB) do{ SBAR(); \
    const lds_cptr vp_=vp0+sl_prev; \
    VRD(0); SBAR(); float sacc=(P0[0]+P0[1]); \
    GAPA(C0=__builtin_amdgcn_mfma_f32_32x32x16_bf16(kf[0],qr[0],f32x16{},0,0,0), P0[2],P0[3],P0[4],P0[5],     pw0[0]=PKW(P0,0), pw0[1]=PKW(P0,2), pw0); \
    VRD(4); SBAR(); GAPA(C1=__builtin_amdgcn_mfma_f32_32x32x16_bf16(kf[1],qr[0],f32x16{},0,0,0), P0[6],P0[7],P0[8],P0[9],     pw0[2]=PKW(P0,4), pw0[3]=PKW(P0,6), pw0); \
    VRD(1); SBAR(); GAPA(C0=__builtin_amdgcn_mfma_f32_32x32x16_bf16(kf[2],qr[1],C0,0,0,0),   P0[10],P0[11],P0[12],P0[13], pw1[0]=PKW(P0,8), pw1[1]=PKW(P0,10), pw1); \
    VRD(5); SBAR(); GAPA(C1=__builtin_amdgcn_mfma_f32_32x32x16_bf16(kf[3],qr[1],C1,0,0,0),   P0[14],P0[15],P1[0],P1[1],   pw1[2]=PKW(P0,12),pw1[3]=PKW(P0,14), pw1); \
    VRD(2); SBAR(); GAPA(C0=__builtin_amdgcn_mfma_f32_32x32x16_bf16(kf[4],qr[2],C0,0,0,0),   P1[2],P1[3],P1[4],P1[5],     pw2[0]=PKW(P1,0), pw2[1]=PKW(P1,2), pw2); \
    VRD(6); SBAR(); GAPA(C1=__builtin_amdgcn_mfma_f32_32x32x16_bf16(kf[5],qr[2],C1,0,0,0),   P1[6],P1[7],P1[8],P1[9],     pw2[2]=PKW(P1,4), pw2[3]=PKW(P1,6), pw2); \
    VRD(3); SBAR(); GAPA(C0=__builtin_amdgcn_mfma_f32_32x32x16_bf16(kf[6],qr[3],C0,0,0,0),   P1[10],P1[11],P1[12],P1[13], pw3[0]=PKW(P1,8), pw3[1]=PKW(P1,10), pw3); \
    VRD(7); SBAR(); GAPA(C1=__builtin_amdgcn_mfma_f32_32x32x16_bf16(kf[7],qr[3],C1,0,0,0),   P1[14],P1[15],0.f,0.f,       pw3[2]=PKW(P1,12),pw3[3]=PKW(P1,14), pw3); \
    l_reg+=sacc; \
    if(GK){DMA_K((t)+3,sl_cur);} if(GV){DMA_V((t)+1,sl_next);} \
    SUBREF(C0,C1,t); if(MB){CMASK(C0,C1,t);} \
    { float a=MX3(C0[0],C0[1],C1[0]),b=MX3(C0[2],C0[3],C1[1]); a=MX3(a,C1[2],C1[3]); \
      _Pragma("unroll") for(int r=4;r<16;r+=4){a=MX3(a,C0[r],C0[r+1]);b=MX3(b,C0[r+2],C0[r+3]);a=MX3(a,C1[r],C1[r+1]);b=MX3(b,C1[r+2],C1[r+3]);} \
      float rm=__builtin_fmaxf(a,b); { auto rr=__builtin_amdgcn_permlane32_swap(__float_as_uint(rm),__float_as_uint(rm),false,false); rm=__builtin_fmaxf(__uint_as_float(rr[0]),__uint_as_float(rr[1])); } \
      resc=false; \
      if(__builtin_expect(__any(rm>(float)THRL),0)){ const float dl=__builtin_fmaxf(rm,0.f); mhat+=dl; \
        _Pragma("unroll") for(int r=0;r<16;++r){C0[r]-=dl;C1[r]-=dl;} \
        const float f=__builtin_amdgcn_exp2f(-dl); l_reg*=f; if(hi==0)wsf[r32]=f; resc=true; } } \
    SBAR(); \
    GAPB(o[0]=__builtin_amdgcn_mfma_f32_32x32x16_bf16(PAF(0),VFR(0),o[0],0,0,0), C0,0); \
    GAPB(o[1]=__builtin_amdgcn_mfma_f32_32x32x16_bf16(PAF(0),VFR(4),o[1],0,0,0), C0,4); \
    KRD(GL,0); GAPB(o[0]=__builtin_amdgcn_mfma_f32_32x32x16_bf16(PAF(1),VFR(1),o[0],0,0,0), C0,8); \
    KRD(GL,1); GAPB(o[1]=__builtin_amdgcn_mfma_f32_32x32x16_bf16(PAF(1),VFR(5),o[1],0,0,0), C0,12); \
    KRD(GL,2); GAPB(o[0]=__builtin_amdgcn_mfma_f32_32x32x16_bf16(PAF(2),VFR(2),o[0],0,0,0), C1,0); \
    KRD(GL,3); GAPB(o[1]=__builtin_amdgcn_mfma_f32_32x32x16_bf16(PAF(2),VFR(6),o[1],0,0,0), C1,4); \
    GAPB(o[0]=__builtin_amdgcn_mfma_f32_32x32x16_bf16(PAF(3),VFR(3),o[0],0,0,0), C1,8); \
    GAPB(o[1]=__builtin_amdgcn_mfma_f32_32x32x16_bf16(PAF(3),VFR(7),o[1],0,0,0), C1,12); \
    }while(0)
  #define ENDW(tt) do{ if((tt)+3<NT){WAIT_BAR(2);} else if((tt)+2<NT){WAIT_BAR(1);} else {WAIT_BAR(0);} }while(0)
  { int t=1;
    for(;t+1<NT;t+=2){
      STEP(pB0,pB1,pA0,pA1,t,(t+3<NT),(t+1<NT),(t+1<NT),(t<4));       ENDW(t);   RESC(); ROT();
      STEP(pA0,pA1,pB0,pB1,t+1,(t+4<NT),(t+2<NT),(t+2<NT),(t+1<4));     ENDW(t+1); RESC(); ROT();
    }
    STEP(pB0,pB1,pA0,pA1,NT-1,false,false,false,(NT==4)); RESC();
  }
  { float sacc=pB0[0]+pB0[1]; _Pragma("unroll") for(int r=2;r<16;++r)sacc+=pB0[r]; _Pragma("unroll") for(int r=0;r<16;++r)sacc+=pB1[r]; l_reg+=sacc;
    pw0=(u32x4){PKW(pB0,0),PKW(pB0,2),PKW(pB0,4),PKW(pB0,6)};pw1=(u32x4){PKW(pB0,8),PKW(pB0,10),PKW(pB0,12),PKW(pB0,14)};pw2=(u32x4){PKW(pB1,0),PKW(pB1,2),PKW(pB1,4),PKW(pB1,6)};pw3=(u32x4){PKW(pB1,8),PKW(pB1,10),PKW(pB1,12),PKW(pB1,14)};
    SBAR(); pv(o,vb0+sl_cur,PAF(0),PAF(1),PAF(2),PAF(3)); }
  #undef PKW
  #undef PAF
  #undef VFR
  #undef PIN
  #undef MX3
  #undef GAPA
  #undef GAPB
  #undef EX
  #undef VRD
  #undef KRD
  #undef STEP
  #undef ENDW
  {auto rr=__builtin_amdgcn_permlane32_swap(__float_as_uint(l_reg),__float_as_uint(l_reg),false,false);l_reg=__uint_as_float(rr[0])+__uint_as_float(rr[1]);}
  if(hi==0)wsf[32+r32]=l_reg;asm volatile("s_waitcnt lgkmcnt(0)":::"memory");
  float rli[16];
  #pragma unroll
  for(int r=0;r<16;++r)rli[r]=__builtin_amdgcn_rcpf(wsf[32+crow(r,hi)]);
  bf16*Ow=O+(rowbase+q0+wid*QBLK)*PO+h*D;
  { bf16*stg=(bf16*)(shm+LDS_OST)+wid*2048;
    #pragma unroll
    for(int r=0;r<16;++r){const int orow=crow(r,hi);
      #pragma unroll
      for(int d0=0;d0<2;++d0)stg[orow*64+d0*32+r32]=__float2bfloat16(o[d0][r]*rli[r]);}
    asm volatile("s_waitcnt lgkmcnt(0)":::"memory");
    #pragma unroll
    for(int i=0;i<4;++i){const int row=i*8+(lane>>3),ch=lane&7; const u32x4 v=*(const u32x4*)(stg+row*64+ch*8); ATTN_STORE16(Ow+(long)row*PO+ch*8,v);} }
  asm volatile("s_waitcnt lgkmcnt(0)\n\ts_barrier":::"memory");
  #undef DMA_K
  #undef TROW
  #undef SUBREF
  #undef DMA_V
  #undef CMASK
  #undef START
  #undef RESC
  #undef ROT
}
constexpr int ATTN_LDS_BYTES=LDS_BYTES;
#undef SBAR
#undef WAIT_BAR
}
constexpr int DM = 1024, NB = 16, SEQ = 2048, NT = NB * SEQ;
constexpr int RWW = 512, WIN_N = 5376, INC = 4352, ZV = 1792, ZG = 2304;
constexpr int NEXP = 32, DEXP = 512;
constexpr int XS_ROWS = 2 * NT + NEXP * 256;
constexpr float C2 = 0.125f * 1.4426950408889634f;

#define LAS __attribute__((address_space(3)))
#define GAS __attribute__((address_space(1)))
typedef unsigned short bf16;
typedef unsigned v4u __attribute__((ext_vector_type(4)));
typedef unsigned v2u __attribute__((ext_vector_type(2)));
typedef float f32x4 __attribute__((ext_vector_type(4)));

typedef float f32x2_c __attribute__((ext_vector_type(2))); typedef __bf16 bf16x2_c __attribute__((ext_vector_type(2)));
__device__ __forceinline__ unsigned pk2(float lo, float hi) { const f32x2_c v = {lo, hi}; return __builtin_bit_cast(unsigned, __builtin_convertvector(v, bf16x2_c)); }
__device__ __forceinline__ unsigned f2bf(float f) { return pk2(f, f) & 0xffffu; }
__device__ __forceinline__ float bflo(unsigned w) { return __builtin_bit_cast(float, w << 16); }
__device__ __forceinline__ float bfhi(unsigned w) { return __builtin_bit_cast(float, w & 0xffff0000u); }
__device__ __forceinline__ float sigm(float x) { return __builtin_amdgcn_rcpf(1.0f + __expf(-x)); }

constexpr size_t MiB = 1u << 20;
constexpr size_t WS_CTL = 0;
constexpr size_t WS_MOD = 1 * MiB;
constexpr size_t WS_GM2 = 1 * MiB + 512 * 1024;
constexpr size_t WS_CB = 1 * MiB + 640 * 1024;
constexpr size_t WS_COS = 2 * MiB;
constexpr size_t WS_SIN = 2 * MiB + 512 * 1024;
constexpr size_t WS_KMEAN = 3 * MiB;
constexpr size_t WS_WRH = 3 * MiB + 512 * 1024;
constexpr size_t WS_WRL = 3 * MiB + 768 * 1024;
constexpr size_t WS_SEL = 4 * MiB;
constexpr size_t WS_RTE = 5 * MiB;
constexpr size_t WS_RTW = 5 * MiB + 256 * 1024;
constexpr size_t WS_RNK = 5 * MiB + 512 * 1024;
constexpr size_t WS_POS = 5 * MiB + 768 * 1024;
constexpr size_t WS_RSTD = 7 * MiB;
constexpr size_t WS_WLT = 6 * MiB;
constexpr size_t WS_WAT = 6 * MiB + 64 * 1024;
constexpr size_t WS_WGT = 6 * MiB + 128 * 1024;
constexpr size_t WS_WIN = 16 * MiB;
constexpr size_t WS_WBA = 27 * MiB;
constexpr size_t WS_WBB = 28 * MiB;
constexpr size_t WS_WOUT = 29 * MiB;
constexpr size_t WS_Z = 32 * MiB;
constexpr size_t WS_H = 368 * MiB;
constexpr size_t WS_Q = 304 * MiB, WS_K = 336 * MiB, WS_MRG = 304 * MiB;
constexpr size_t WS_YA = 432 * MiB, WS_YB = 464 * MiB;
constexpr size_t WS_WUP = 368 * MiB;
constexpr size_t WS_H2 = 128 * MiB;
constexpr size_t WS_XS = 64 * MiB;
constexpr size_t WS_HID = 208 * MiB;
constexpr size_t WS_X1B = 432 * MiB;
constexpr size_t WS_ACT = 496 * MiB;
constexpr size_t WS_END = 512 * MiB;
constexpr int CW_CNT = 64, CNT_PAD = 64;
constexpr int CW_NT = 2304;
constexpr int CW_TEXP = 2368;
static_assert(CW_CNT + NEXP * CNT_PAD <= CW_NT, "control words");

__device__ __forceinline__ void tr_item(const float* W, int K, int N, bf16* WT, int kb, int nb, int dst_row0, LAS float* scr, int lane) {
    const int k0 = 64 * kb, n0 = 32 * nb;
#pragma unroll
    for (int i = 0; i < 32; ++i) { const int kk = 2 * i + (lane >> 5); scr[kk * 33 + (lane & 31)] = W[(size_t)(k0 + kk) * N + n0 + (lane & 31)]; }
    asm volatile("s_waitcnt lgkmcnt(0)" ::: "memory");
    const int c = lane & 7;
#pragma unroll
    for (int j = 0; j < 4; ++j) { const int n = (lane >> 3) + 8 * j; const LAS float* s = scr + (8 * c) * 33 + n;
        v4u o; o.x = pk2(s[0 * 33], s[1 * 33]); o.y = pk2(s[2 * 33], s[3 * 33]); o.z = pk2(s[4 * 33], s[5 * 33]); o.w = pk2(s[6 * 33], s[7 * 33]);
        *(v4u*)(WT + (size_t)(dst_row0 + n) * K + k0 + 8 * c) = o; }
    asm volatile("s_waitcnt lgkmcnt(0)" ::: "memory");
}

struct PArgs { const float* in[30]; float* out; unsigned char* ws; };

__device__ __forceinline__ void p_prep_weights(const PArgs& a, unsigned char* lds, int wv) {
    const int tid = mktid(wv), lane = tid & 63, wave = tid >> 6;
    LAS float* scr = (LAS float*)lds + wave * (64 * 33);
    const int gw = blockIdx.x * 8 + wave, NGW = gridDim.x * 8;
    unsigned char* ws = a.ws;
    constexpr int I_IN = 16 * 168, I_BR = 8 * 32, I_OUT = 16 * 32;
    for (int it = gw; it < I_IN + 2 * I_BR + I_OUT; it += NGW) {
        int r = it;
        if (r < I_IN) { const int kb = r / 168, nb = r % 168; int dst = 32 * nb;
            if (dst >= 1792 && dst < 2816) { const int rel = dst - 1792, u = rel >> 8, hl = (rel & 255) >> 6, half = (rel & 63) >> 5; dst = 1792 + u * 256 + half * 128 + hl * 32; }
            tr_item(a.in[6], 1024, WIN_N, (bf16*)(ws + WS_WIN), kb, nb, dst, scr, lane); continue; } r -= I_IN;
        if (r < I_BR) { const int kb = r / 32, nb = r % 32; tr_item(a.in[20], 512, 1024, (bf16*)(ws + WS_WBA), kb, nb, 32 * nb, scr, lane); continue; } r -= I_BR;
        if (r < I_BR) { const int kb = r / 32, nb = r % 32; tr_item(a.in[21], 512, 1024, (bf16*)(ws + WS_WBB), kb, nb, 32 * nb, scr, lane); continue; } r -= I_BR;
        { const int kb = r / 32, nb = r % 32; tr_item(a.in[22], 1024, 1024, (bf16*)(ws + WS_WOUT), kb, nb, 32 * nb, scr, lane); }
    }
    const int gt = blockIdx.x * 512 + tid, NGT = gridDim.x * 512;
    float* cosT = (float*)(ws + WS_COS); float* sinT = (float*)(ws + WS_SIN);
    for (int i = gt; i < SEQ * 32; i += NGT) { const int s = i >> 5, f = i & 31; const float inv = powf(10000.0f, -(float)f / 32.0f); const float ang = (float)s * inv; cosT[i] = cosf(ang); sinT[i] = sinf(ang); }
    { bf16* wlt = (bf16*)(ws + WS_WLT); bf16* wat = (bf16*)(ws + WS_WAT); bf16* wgt = (bf16*)(ws + WS_WGT);
      for (int i = gt; i < 8 * 64 * 64; i += NGT) { const int hh = i >> 12, j = (i >> 6) & 63, m = i & 63; wlt[i] = (bf16)f2bf(a.in[9][m * 512 + hh * 64 + j]); wat[i] = (bf16)f2bf(a.in[11][m * 512 + hh * 64 + j]); }
      for (int i = gt; i < 8 * 64 * 128; i += NGT) { const int hh = i >> 13, j = (i >> 7) & 63, m = i & 127; wgt[i] = (bf16)f2bf(a.in[12][m * 512 + hh * 64 + j]); } }
    { bf16* wrh = (bf16*)(ws + WS_WRH); bf16* wrl = (bf16*)(ws + WS_WRL);
      for (int i = gt; i < 48 * 1024; i += NGT) { const int e = i >> 10, k = i & 1023; const float w = e < 4 ? a.in[23][k * 4 + e] : e < 36 ? a.in[25][k * 32 + (e - 4)] : 0.f;
          const unsigned hi = f2bf(w); wrh[i] = (bf16)hi; wrl[i] = (bf16)f2bf(w - bflo(hi)); } }
}

constexpr int CW_ZCNT = 3136, CW_AQ = 3200;
constexpr int CW_BAR = 4096, XB_TMO_W = 128, DOWN_MSK_OFF = 160 * 1024 - 256 + 64;
constexpr int CW_TCNT = 8192, TCNT_STRIDE = 16;
constexpr int CW_PEXP = 2816;
__device__ __forceinline__ void p_prep_experts_dyn(const PArgs& a, unsigned char* lds, int wv) {
    const int tid = mktid(wv), lane = tid & 63, wave = tid >> 6;
    LAS float* scr = (LAS float*)lds + wave * (64 * 33);
    unsigned* ctr = (unsigned*)(a.ws + WS_CTL) + CW_PEXP;
    constexpr int NITEM = NEXP * 768;
    for (;;) {
        unsigned base = 0; if (lane == 0) base = atomicAdd(ctr, 16u);
        base = (unsigned)__builtin_amdgcn_readfirstlane((int)base);
        if (base >= (unsigned)NITEM) break;
        for (int it = (int)base; it < (int)base + 16 && it < NITEM; ++it) {
            const int e = it / 768; int r = it % 768;
            bf16* wup = (bf16*)(a.ws + WS_WUP) + (size_t)e * 1024 * 1024;
            if (r < 256) { const int kb = r / 16, nb = r % 16, n0 = 32 * nb; tr_item(a.in[27] + (size_t)e * 1024 * 512, 1024, 512, wup, kb, nb, (n0 >> 7) * 256 + (n0 & 127), scr, lane); continue; } r -= 256;
            if (r < 256) { const int kb = r / 16, nb = r % 16, n0 = 32 * nb; tr_item(a.in[28] + (size_t)e * 1024 * 512, 1024, 512, wup, kb, nb, (n0 >> 7) * 256 + 128 + (n0 & 127), scr, lane); continue; } r -= 256;
            { const int kb = r / 32, nb = r % 32; tr_item(a.in[29] + (size_t)e * 512 * 1024, 512, 1024, (bf16*)a.out + (size_t)e * 1024 * 512, kb, nb, 32 * nb, scr, lane); }
        }
    }
}

__device__ __forceinline__ void p_ada_load(const PArgs& a, int tile, int tid, float (&wr)[64]) {
    const float* w = a.in[2] + (size_t)((tid >> 5) * 64) * 6144 + tile * 32 + (tid & 31);
#pragma unroll
    for (int i = 0; i < 64; ++i) wr[i] = w[(size_t)i * 6144];
}
__device__ __forceinline__ void p_ada_finish(const PArgs& a, const float* sc, float* red, int tile, int tid, const float (&wr)[64]) {
    const float* bias = a.in[3]; float* mod = (float*)(a.ws + WS_MOD);
    const int col = tid & 31, kg = tid >> 5;
    float acc[16];
#pragma unroll
    for (int b = 0; b < 16; ++b) acc[b] = 0.f;
#pragma unroll
    for (int i = 0; i < 64; ++i)
#pragma unroll
        for (int b = 0; b < 16; ++b) acc[b] += sc[b * 1024 + kg * 64 + i] * wr[i];
#pragma unroll
    for (int b = 0; b < 16; ++b) red[(kg * 16 + b) * 32 + col] = acc[b];
    __syncthreads();
    { const int b = tid >> 5, cc = tid & 31; float sm = 0.f;
#pragma unroll
        for (int k = 0; k < 16; ++k) sm += red[(k * 16 + b) * 32 + cc];
        mod[b * 6144 + tile * 32 + cc] = sm + bias[tile * 32 + cc]; }
    __syncthreads();
}

__device__ __forceinline__ void p_norm1(const PArgs& a, unsigned char* lds, int wv) {
    const int tid = mktid(wv), lane = tid & 63, gw = blockIdx.x * 8 + (tid >> 6), NGW = gridDim.x * 8;
    const float* x = a.in[0]; const float* g = a.in[4]; const float* mod = (const float*)(a.ws + WS_MOD);
    bf16* h = (bf16*)(a.ws + WS_H);
    f32x4 v[4][4];
    { const f32x4* xr = (const f32x4*)(x + (size_t)(4 * gw < NT ? 4 * gw : 0) * DM) + lane;
#pragma unroll
      for (int r = 0; r < 4; ++r)
#pragma unroll
          for (int j = 0; j < 4; ++j) v[r][j] = __builtin_nontemporal_load(xr + 256 * r + 64 * j); }
    for (int m0 = 4 * gw; m0 < NT; m0 += 4 * NGW) {
        const int mn = m0 + 4 * NGW < NT ? m0 + 4 * NGW : m0;
        f32x4 nv[4][4];
        { const f32x4* xr = (const f32x4*)(x + (size_t)mn * DM) + lane;
#pragma unroll
          for (int r = 0; r < 4; ++r)
#pragma unroll
              for (int j = 0; j < 4; ++j) nv[r][j] = __builtin_nontemporal_load(xr + 256 * r + 64 * j); }
        const int b = m0 >> 11; float rstd[4];
#pragma unroll
        for (int r = 0; r < 4; ++r) { float s = 0.f;
#pragma unroll
            for (int j = 0; j < 4; ++j) s += (v[r][j].x * v[r][j].x + v[r][j].y * v[r][j].y) + (v[r][j].z * v[r][j].z + v[r][j].w * v[r][j].w);
            rstd[r] = rsqrtf(wave_sum(s) * (1.0f / DM) + 1e-6f); }
#pragma unroll
        for (int j = 0; j < 4; ++j) { const int col = 4 * (lane + 64 * j);
            const f32x4 gg = *(const f32x4*)(g + col), sh = *(const f32x4*)(mod + b * 6144 + col), scl = *(const f32x4*)(mod + b * 6144 + 1024 + col);
#pragma unroll
            for (int r = 0; r < 4; ++r) { const f32x4 q = v[r][j] * rstd[r] * gg * (scl + 1.0f) + sh; v2u w; w.x = pk2(q.x, q.y); w.y = pk2(q.z, q.w); ((v2u*)(h + (size_t)(m0 + r) * DM) + lane)[64 * j] = w; } }
#pragma unroll
        for (int r = 0; r < 4; ++r)
#pragma unroll
            for (int j = 0; j < 4; ++j) v[r][j] = nv[r][j];
    }
    { float* gm2 = (float*)(a.ws + WS_GM2); float* cb = (float*)(a.ws + WS_CB); const float* g2 = a.in[5];
      for (int i = blockIdx.x * 512 + tid; i < 16 * 1024; i += gridDim.x * 512) { const int b = i >> 10, k = i & 1023; gm2[i] = g2[k] * (1.0f + mod[b * 6144 + 4096 + k]); }
      for (int p = blockIdx.x + gridDim.x * (tid >> 6); p < 16 * 48; p += NGW) {    const int b = p / 48, n = p % 48; float s = 0.f;
          if (n < 36) { for (int k = lane; k < 1024; k += 64) { const float w = n < 4 ? a.in[23][k * 4 + n] : a.in[25][k * 32 + (n - 4)]; s += mod[b * 6144 + 3072 + k] * w; } }
          s = wave_sum(s); if (lane == 0) cb[p] = n < 4 ? s + a.in[24][n] : n < 36 ? s + a.in[26][n - 4] : 0.f; } }
}

using pg8::Unit; using pg8::HALF; using pg8::BM; using pg8::cvt_pk_bf16;
typedef pg8::f32x4 pf4; typedef pg8::u32x4 pu4;

struct EpiStoreBf16 {
    static constexpr bool PERM = true, AFTER_DRAIN = false, CHAIN = false;
    bf16* O; int ldc;
    __device__ __forceinline__ void operator()(const pf4 (&acc)[2][2][4][2], const Unit& u, int wr, int wc, int fr, int fq) const {
        const int row0 = u.pm * BM + wr * 64 + fr, col0 = u.pn * BM + wc * 32 + 8 * fq;
#pragma unroll
        for (int ai = 0; ai < 2; ++ai)
#pragma unroll
            for (int m = 0; m < 4; ++m) { bf16* rowp = O + (size_t)(row0 + ai * HALF + m * 16) * ldc + col0;
#pragma unroll
                for (int bj = 0; bj < 2; ++bj) { const pf4 v0 = acc[ai][bj][m][0], v1 = acc[ai][bj][m][1]; pu4 w;
                    w.x = cvt_pk_bf16(v0[0], v0[1]); w.y = cvt_pk_bf16(v0[2], v0[3]); w.z = cvt_pk_bf16(v1[0], v1[1]); w.w = cvt_pk_bf16(v1[2], v1[3]);
                    *(pu4*)(rowp + bj * HALF) = w; } }
    }
};
struct EpiZ {
    static constexpr bool PERM = true, AFTER_DRAIN = false, CHAIN = false;
    bf16* z; bf16* Q; bf16* K; const float* qg; const float* kg; const float* cosT; const float* sinT; unsigned* zcnt;
    __device__ __forceinline__ void operator()(const pf4 (&acc)[2][2][4][2], const Unit& u, int wr, int wc, int fr, int fq) const {
        const int row0 = u.pm * BM + wr * 64 + fr;
        if (u.pn == 6) {
            const __amdgpu_buffer_rsrc_t zr = __builtin_amdgcn_make_buffer_rsrc((void*)z, 0, NT * INC * 2, 0x00020000);
            const int zc = 6 * 256 + wc * 32 + 8 * fq;
#pragma unroll
            for (int ai = 0; ai < 2; ++ai)
#pragma unroll
                for (int m = 0; m < 4; ++m) { const unsigned rowb = (unsigned)(((row0 + ai * HALF + m * 16) * INC + zc) * 2);
#pragma unroll
                    for (int bj = 0; bj < 2; ++bj) { const pf4 v0 = acc[ai][bj][m][0], v1 = acc[ai][bj][m][1]; pu4 w;
                        w.x = cvt_pk_bf16(v0[0], v0[1]); w.y = cvt_pk_bf16(v0[2], v0[3]); w.z = cvt_pk_bf16(v1[0], v1[1]); w.w = cvt_pk_bf16(v1[2], v1[3]);
                        __builtin_amdgcn_raw_buffer_store_b128(w, zr, rowb + (unsigned)(bj * HALF * 2), 0,   16); } }
            asm volatile("s_waitcnt vmcnt(0)" ::: "memory");
            if (fr == 0 && fq == 0) (void)__hip_atomic_fetch_add(zcnt, 1u, __ATOMIC_RELAXED, __HIP_MEMORY_SCOPE_AGENT);
            return;
        }
        if (u.pn < 7 || u.pn >= 11) {
            const int zc = (u.pn < 7 ? u.pn * 256 : (u.pn - 11) * 256 + 1792) + wc * 32 + 8 * fq;
#pragma unroll
            for (int ai = 0; ai < 2; ++ai)
#pragma unroll
                for (int m = 0; m < 4; ++m) { bf16* rowp = z + (size_t)(row0 + ai * HALF + m * 16) * INC + zc;
#pragma unroll
                    for (int bj = 0; bj < 2; ++bj) { const pf4 v0 = acc[ai][bj][m][0], v1 = acc[ai][bj][m][1]; pu4 w;
                        w.x = cvt_pk_bf16(v0[0], v0[1]); w.y = cvt_pk_bf16(v0[2], v0[3]); w.z = cvt_pk_bf16(v1[0], v1[1]); w.w = cvt_pk_bf16(v1[2], v1[3]);
                        __builtin_nontemporal_store(w, (pu4*)(rowp + bj * HALF)); } }
            return;
        }
        const bool isk = u.pn >= 9; const int head = 4 * ((u.pn - 7) & 1) + wc; const float* g = isk ? kg : qg; bf16* O = (isk ? K : Q) + head * 64 + 8 * fq;
        const float osc = isk ? 1.0f : C2;
        pf4 gl[2][2];
#pragma unroll
        for (int bj = 0; bj < 2; ++bj)
#pragma unroll
            for (int n = 0; n < 2; ++n) gl[bj][n] = *(const pf4*)(g + 32 * bj + 8 * fq + 4 * n);
#pragma unroll
        for (int aim = 0; aim < 4; ++aim) { const int ai = aim >> 1, m0 = 2 * (aim & 1);
            pf4 ct[2][2], st[2][2];
#pragma unroll
            for (int mm = 0; mm < 2; ++mm) { const int s = (row0 + ai * HALF + (m0 + mm) * 16) & (SEQ - 1);
#pragma unroll
                for (int n = 0; n < 2; ++n) { ct[mm][n] = *(const pf4*)(cosT + s * 32 + 8 * fq + 4 * n); st[mm][n] = *(const pf4*)(sinT + s * 32 + 8 * fq + 4 * n); } }
#pragma unroll
            for (int mm = 0; mm < 2; ++mm) { const int m = m0 + mm; const int row = row0 + ai * HALF + m * 16;
                float ss = 0.f;
#pragma unroll
                for (int bj = 0; bj < 2; ++bj)
#pragma unroll
                    for (int n = 0; n < 2; ++n) { const pf4 v = acc[ai][bj][m][n]; ss += (v[0] * v[0] + v[1] * v[1]) + (v[2] * v[2] + v[3] * v[3]); }
                ss += __builtin_bit_cast(float, __builtin_amdgcn_ds_swizzle(__builtin_bit_cast(int, ss), 0x401F));
                { const unsigned uu = __builtin_bit_cast(unsigned, ss); auto rr = __builtin_amdgcn_permlane32_swap(uu, uu, false, false); ss = __builtin_bit_cast(float, (unsigned)rr[0]) + __builtin_bit_cast(float, (unsigned)rr[1]); }
                const float rstd = rsqrtf(ss * (1.0f / 64.0f) + 1e-6f);
#pragma unroll
                for (int n = 0; n < 2; ++n) { const pf4 x1 = acc[ai][0][m][n] * rstd * gl[0][n], x2 = acc[ai][1][m][n] * rstd * gl[1][n];
                    const pf4 o1 = x1 * ct[mm][n] - x2 * st[mm][n], o2 = x2 * ct[mm][n] + x1 * st[mm][n];
                    v2u wa, wb; wa.x = cvt_pk_bf16(o1[0] * osc, o1[1] * osc); wa.y = cvt_pk_bf16(o1[2] * osc, o1[3] * osc); wb.x = cvt_pk_bf16(o2[0] * osc, o2[1] * osc); wb.y = cvt_pk_bf16(o2[2] * osc, o2[3] * osc);
                    bf16* op = O + (size_t)row * 512 + 4 * n; *(v2u*)op = wa; *(v2u*)(op + 32) = wb; } }
            asm volatile("" ::: "memory");
        }
    }
};
struct EpiMerge {
    static constexpr bool PERM = true, AFTER_DRAIN = false, CHAIN = true;
    const bf16* z; bf16* mrg;
    __device__ __forceinline__ bool chain(pf4 (&acc)[2][2][4][2], const Unit& u, int wr, int wc, int fr, int fq) const {
        const int row0 = u.pm * BM + wr * 64 + fr, col0 = u.pn * BM + wc * 32 + 8 * fq;
        if (u.aux == 0) {
#pragma unroll
            for (int ai = 0; ai < 2; ++ai) {
                pu4 za[4][2], zb[4][2];
#pragma unroll
                for (int m = 0; m < 4; ++m) { const size_t row = (size_t)(row0 + ai * HALF + m * 16);
#pragma unroll
                    for (int bj = 0; bj < 2; ++bj) { const int col = col0 + bj * HALF; za[m][bj] = *(const pu4*)(z + row * INC + ZG + col); zb[m][bj] = *(const pu4*)(z + row * INC + ZG + 1024 + col); } }
#pragma unroll
                for (int m = 0; m < 4; ++m)
#pragma unroll
                    for (int bj = 0; bj < 2; ++bj) { const pu4 a4 = za[m][bj], b4 = zb[m][bj];
                        const float a8[8] = {bflo(a4.x), bfhi(a4.x), bflo(a4.y), bfhi(a4.y), bflo(a4.z), bfhi(a4.z), bflo(a4.w), bfhi(a4.w)};
                        const float b8[8] = {bflo(b4.x), bfhi(b4.x), bflo(b4.y), bfhi(b4.y), bflo(b4.z), bfhi(b4.z), bflo(b4.w), bfhi(b4.w)};
#pragma unroll
                        for (int e = 0; e < 8; ++e) acc[ai][bj][m][e >> 2][e & 3] *= (1.0f + __expf(-b8[e])) * __builtin_amdgcn_rcpf(1.0f + __expf(-a8[e])); }
                asm volatile("" ::: "memory");
            }
            return true;
        }
        pu4 gz[2][4][2];
#pragma unroll
        for (int ai = 0; ai < 2; ++ai)
#pragma unroll
            for (int m = 0; m < 4; ++m) { const size_t row = (size_t)(row0 + ai * HALF + m * 16);
#pragma unroll
                for (int bj = 0; bj < 2; ++bj) gz[ai][m][bj] = *(const pu4*)(z + row * INC + ZG + 1024 + col0 + bj * HALF); }
#pragma unroll
        for (int ai = 0; ai < 2; ++ai)
#pragma unroll
            for (int m = 0; m < 4; ++m) { const size_t row = (size_t)(row0 + ai * HALF + m * 16);
#pragma unroll
                for (int bj = 0; bj < 2; ++bj) { const int col = col0 + bj * HALF; const pu4 g4 = gz[ai][m][bj]; const pf4 v0 = acc[ai][bj][m][0], v1 = acc[ai][bj][m][1];
                    pu4 w;
                    w.x = cvt_pk_bf16(sigm(bflo(g4.x)) * v0[0], sigm(bfhi(g4.x)) * v0[1]); w.y = cvt_pk_bf16(sigm(bflo(g4.y)) * v0[2], sigm(bfhi(g4.y)) * v0[3]);
                    w.z = cvt_pk_bf16(sigm(bflo(g4.z)) * v1[0], sigm(bfhi(g4.z)) * v1[1]); w.w = cvt_pk_bf16(sigm(bflo(g4.w)) * v1[2], sigm(bfhi(g4.w)) * v1[3]);
                    *(pu4*)(mrg + row * DM + col) = w; } }
        return false;
    }
};
struct EpiOut {
    static constexpr bool PERM = true, AFTER_DRAIN = false, CHAIN = false;
    const float* x; const float* mod; bf16* x1;
    __device__ __forceinline__ void operator()(const pf4 (&acc)[2][2][4][2], const Unit& u, int wr, int wc, int fr, int fq) const {
        const int row0 = u.pm * BM + wr * 64 + fr, col0 = u.pn * BM + wc * 32 + 8 * fq; const int b = u.pm >> 3;
        pf4 gt[2][2];
#pragma unroll
        for (int bj = 0; bj < 2; ++bj)
#pragma unroll
            for (int n = 0; n < 2; ++n) gt[bj][n] = *(const pf4*)(mod + b * 6144 + 2048 + col0 + bj * HALF + n * 4);
#pragma unroll
        for (int ai = 0; ai < 2; ++ai) {
            pf4 xv[4][2][2];
#pragma unroll
            for (int m = 0; m < 4; ++m) { const size_t off = (size_t)(row0 + ai * HALF + m * 16) * DM + col0;
#pragma unroll
                for (int bj = 0; bj < 2; ++bj) { xv[m][bj][0] = *(const pf4*)(x + off + bj * HALF); xv[m][bj][1] = *(const pf4*)(x + off + bj * HALF + 4); } }
#pragma unroll
            for (int m = 0; m < 4; ++m) { const size_t off = (size_t)(row0 + ai * HALF + m * 16) * DM + col0;
#pragma unroll
                for (int bj = 0; bj < 2; ++bj) { const pf4 o0 = xv[m][bj][0] + gt[bj][0] * acc[ai][bj][m][0], o1 = xv[m][bj][1] + gt[bj][1] * acc[ai][bj][m][1]; pu4 w;
                    w.x = cvt_pk_bf16(o0[0], o0[1]); w.y = cvt_pk_bf16(o0[2], o0[3]); w.z = cvt_pk_bf16(o1[0], o1[1]); w.w = cvt_pk_bf16(o1[2], o1[3]);
                    *(pu4*)(x1 + off + bj * HALF) = w; } }
            asm volatile("" ::: "memory");
        }
    }
};
struct EpiUp {
    static constexpr bool PERM = true, AFTER_DRAIN = false, CHAIN = false;
    bf16* hid; unsigned* tcnt;
    __device__ __forceinline__ void operator()(const pf4 (&acc)[2][2][4][2], const Unit& u, int wr, int wc, int fr, int fq) const {
        const int row0 = u.pm * BM + wr * 64 + fr, col0 = u.pn * 128 + wc * 32 + 8 * fq;
        const __amdgpu_buffer_rsrc_t hr = __builtin_amdgcn_make_buffer_rsrc((void*)hid, 0, 96 << 20, 0x00020000);
#pragma unroll
        for (int ai = 0; ai < 2; ++ai)
#pragma unroll
            for (int m = 0; m < 4; ++m) { const int row = row0 + ai * HALF + m * 16; float o[8];
#pragma unroll
                for (int n = 0; n < 2; ++n)
#pragma unroll
                    for (int e = 0; e < 4; ++e) { const float g = acc[ai][0][m][n][e], l = acc[ai][1][m][n][e]; o[4 * n + e] = g * sigm(g) * l; }
                pu4 w; w.x = cvt_pk_bf16(o[0], o[1]); w.y = cvt_pk_bf16(o[2], o[3]); w.z = cvt_pk_bf16(o[4], o[5]); w.w = cvt_pk_bf16(o[6], o[7]);
                __builtin_amdgcn_raw_buffer_store_b128(w, hr, (unsigned)((row * DEXP + col0) * 2), 0,   16); }
        asm volatile("s_waitcnt vmcnt(0)" ::: "memory");
        if (fr == 0 && fq == 0) (void)__hip_atomic_fetch_add(tcnt + TCNT_STRIDE * u.pm, 1u, __ATOMIC_RELAXED, __HIP_MEMORY_SCOPE_AGENT);
    }
};

struct GemmArgs { unsigned char* ws; const float* x; float* out; const float* qg; const float* kg; };
template <class Epi> __device__ __forceinline__ void run_dense(const void* A, const void* Bt, int M, int N, int K, const Epi& E, unsigned char* lds, int wv) {
    pg8::Gemm g{K}; pg8::StaticOrder S; S.init(A, Bt, M, N, K, (int)gridDim.x, (int)blockIdx.x);
    pg8::gemm_phase<Epi, pg8::StaticOrder, true, true>((PG8_LAS unsigned char*)lds, g, S, E, wv);
}
__device__ __forceinline__ void p_gemm_in(const GemmArgs& a, unsigned char* lds, int wv) {
    EpiZ E{(bf16*)(a.ws + WS_Z), (bf16*)(a.ws + WS_Q), (bf16*)(a.ws + WS_K), a.qg, a.kg, (const float*)(a.ws + WS_COS), (const float*)(a.ws + WS_SIN), (unsigned*)(a.ws + WS_CTL) + CW_ZCNT};
    run_dense(a.ws + WS_H, a.ws + WS_WIN, NT, WIN_N, 1024, E, lds, wv);
}
struct PairOrder {
    int nM, nN, nwg, G, c; const char *A0, *A1, *B0, *B1; size_t tstep;
    __device__ bool next(int i, Unit& u) const {
        const long L = (long)(i >> 1) * G + c; if (L >= nwg) return false;
        int wgid = (int)L; { const int q = nwg / pg8::NXCD, r = nwg % pg8::NXCD, xcd = wgid % pg8::NXCD, off = wgid / pg8::NXCD; wgid = (xcd < r ? xcd * (q + 1) : r * (q + 1) + (xcd - r) * q) + off; }
        const int nig = pg8::WGM * nN, gid = wgid / nig, fm = gid * pg8::WGM, gsz = (nM - fm) < pg8::WGM ? (nM - fm) : pg8::WGM;
        u.pm = fm + ((wgid % nig) % gsz); u.pn = (wgid % nig) / gsz; u.aux = i & 1;
        u.a = ((i & 1) ? A1 : A0) + (size_t)u.pm * tstep; u.b = ((i & 1) ? B1 : B0) + (size_t)u.pn * tstep; return true;
    }
    __device__ __forceinline__ void a_ready(const Unit&) const {}
    __device__ __forceinline__ void done(const Unit&) const {}
};
__device__ __forceinline__ void p_gemm_merge(const GemmArgs& a, unsigned char* lds, int wv) {
    PairOrder S{NT / 256, 4, (NT / 256) * 4, (int)gridDim.x, (int)blockIdx.x, (const char*)(a.ws + WS_YA), (const char*)(a.ws + WS_YB), (const char*)(a.ws + WS_WBA), (const char*)(a.ws + WS_WBB), (size_t)256 * 512 * 2};
    EpiMerge E{(const bf16*)(a.ws + WS_Z), (bf16*)(a.ws + WS_MRG)}; pg8::Gemm g{512};
    pg8::gemm_phase<EpiMerge, PairOrder, true, true>((PG8_LAS unsigned char*)lds, g, S, E, wv);
}
__device__ __forceinline__ void p_gemm_out(const GemmArgs& a, unsigned char* lds, int wv) {
    EpiOut E{a.x, (const float*)(a.ws + WS_MOD), (bf16*)(a.ws + WS_X1B)};
    run_dense(a.ws + WS_MRG, a.ws + WS_WOUT, NT, 1024, 1024, E, lds, wv);
}
struct GroupedOrder {
    const int* texp; int nT, nN, G, c; const char* A; size_t a_tile; const char* B; size_t b_exp, b_tile;
    __device__ bool next(int i, Unit& u) const {
        const long L = (long)i * G + c; if (L >= (long)nT * nN) return false;
        const int tile = (int)(L / nN), pn = (int)(L % nN); u.aux = 0; u.pm = tile; u.pn = pn; u.a = A + (size_t)tile * a_tile; u.b = B + (size_t)texp[tile] * b_exp + (size_t)pn * b_tile; return true;
    }
    __device__ __forceinline__ void a_ready(const Unit&) const {}
    __device__ __forceinline__ void done(const Unit&) const {}
};
__device__ __forceinline__ void p_gemm_up(const GemmArgs& a, unsigned char* lds, int wv) {
    const int* ctl = (const int*)(a.ws + WS_CTL);
    GroupedOrder S{ctl + CW_TEXP, ctl[CW_NT], 4, (int)gridDim.x, (int)blockIdx.x, (const char*)(a.ws + WS_XS), (size_t)256 * 1024 * 2, (const char*)(a.ws + WS_WUP), (size_t)1024 * 1024 * 2, (size_t)256 * 1024 * 2};
    EpiUp E{(bf16*)(a.ws + WS_HID), (unsigned*)(a.ws + WS_CTL) + CW_TCNT}; pg8::Gemm g{1024};
    pg8::gemm_phase<EpiUp, GroupedOrder, true, true>((PG8_LAS unsigned char*)lds, g, S, E, wv);
}
struct CountedGroupedOrder : GroupedOrder {
    unsigned* tcnt; unsigned* tmo; volatile LAS unsigned* msk; int wv;
    __device__ __forceinline__ long unit_of(int i) const { const long U = (long)nT * nN; const int nB = (int)(U % G);
        return c < nB ? (long)(i + 2) * G - 2 * nB + c : i == 0 ? (long)(c - nB) : (long)i * G - nB + (c - nB); }
    __device__ bool next(int i, Unit& u) const {
        const long L = unit_of(i); if (L >= (long)nT * nN) return false;
        const int tile = (int)(L / nN), pn = (int)(L % nN); u.aux = i; u.pm = tile; u.pn = pn; u.a = A + (size_t)tile * a_tile; u.b = B + (size_t)texp[tile] * b_exp + (size_t)pn * b_tile; return true; }
    __device__ __forceinline__ void wait_tile(int tile) const {
        unsigned sp = 0;
        while (__hip_atomic_load(tcnt + TCNT_STRIDE * tile, __ATOMIC_RELAXED, __HIP_MEMORY_SCOPE_AGENT) < 32u) { __builtin_amdgcn_s_sleep(1);
            if ((++sp & 255u) == 0u) { if (__hip_atomic_load(tmo, __ATOMIC_RELAXED, __HIP_MEMORY_SCOPE_AGENT)) break; if (sp > (1u << 22)) { atomicAdd(tmo, 1u); break; } } }
    }
    __device__ __forceinline__ void a_ready(const Unit& u) const {
        const int i = u.aux;
        if (i > 0) { const unsigned m = msk[0]; if ((m >> i) & 1u) return; }
        if (wv == 0) {
            unsigned m = 0u;
            if (i == 0) {
#pragma unroll 1
                for (int j = 1; j < 32; ++j) { const long L = unit_of(j); if (L >= (long)nT * nN) break;
                    if (__hip_atomic_load(tcnt + TCNT_STRIDE * (int)(L / nN), __ATOMIC_RELAXED, __HIP_MEMORY_SCOPE_AGENT) >= 32u) m |= 1u << j; } }
            wait_tile(u.pm);
            __builtin_amdgcn_fence(__ATOMIC_ACQUIRE, "agent");
            asm volatile("s_waitcnt vmcnt(0)" ::: "memory");
            if (i == 0 && mktid(wv) == 0) msk[0] = m;
            asm volatile("s_waitcnt lgkmcnt(0)" ::: "memory");
        }
        asm volatile("" ::: "memory"); __builtin_amdgcn_s_barrier(); asm volatile("" ::: "memory");
    }
};
__device__ __forceinline__ void p_gemm_down(const GemmArgs& a, unsigned char* lds, int wv) {
    const int* ctl = (const int*)(a.ws + WS_CTL);
    CountedGroupedOrder S{{ctl + CW_TEXP, ctl[CW_NT], 4, (int)gridDim.x, (int)blockIdx.x, (const char*)(a.ws + WS_HID), (size_t)256 * 512 * 2, (const char*)a.out, (size_t)1024 * 512 * 2, (size_t)256 * 512 * 2},
                          (unsigned*)(a.ws + WS_CTL) + CW_TCNT, (unsigned*)(a.ws + WS_CTL) + CW_BAR + XB_TMO_W, (volatile LAS unsigned*)((LAS unsigned char*)lds + DOWN_MSK_OFF), wv};
    EpiStoreBf16 E{(bf16*)(a.ws + WS_XS), 1024}; pg8::Gemm g{512};
    pg8::gemm_phase<EpiStoreBf16, CountedGroupedOrder, true, true>((PG8_LAS unsigned char*)lds, g, S, E, wv);
}

__device__ __forceinline__ void p_attn(const PArgs& a, unsigned char* lds, int vb, int nvb, int wv) {
    const attn_body::bf16* Q = (const attn_body::bf16*)(a.ws + WS_Q); const attn_body::bf16* K = (const attn_body::bf16*)(a.ws + WS_K);
    const attn_body::bf16* V = (const attn_body::bf16*)(a.ws + WS_Z) + ZV; attn_body::bf16* O = (attn_body::bf16*)(a.ws + WS_YB);
    for (int p = vb; p < 512; p += nvb)
        for (int which = 0; which < 2; ++which) { const int bh = p >> 2, s = p & 3, qb = which ? 7 - s : s;
            attn_body::attn_unit<8>(bh >> 3, bh & 7, qb, Q, K, V, O, (char*)lds, wv); }
}

__device__ __forceinline__ void p_actprep(const PArgs& a, unsigned char* lds, int wv) {
    const int tid = mktid(wv); const bf16* z = (const bf16*)(a.ws + WS_Z); bf16* act = (bf16*)(a.ws + WS_ACT); const float* mu = a.in[7];
    for (int i = blockIdx.x * 512 + tid; i < NT * 32; i += gridDim.x * 512) { const int t = i >> 5, cg = i & 31, col = 1536 + 8 * cg; const bool hasp = (t & (SEQ - 1)) > 0;
        const v4u cw = *(const v4u*)(z + (size_t)t * INC + col); v4u pw = {0u, 0u, 0u, 0u}; if (hasp) pw = *(const v4u*)(z + (size_t)(t - 1) * INC + col);
        const float c8[8] = {bflo(cw.x), bfhi(cw.x), bflo(cw.y), bfhi(cw.y), bflo(cw.z), bfhi(cw.z), bflo(cw.w), bfhi(cw.w)}, p8[8] = {bflo(pw.x), bfhi(pw.x), bflo(pw.y), bfhi(pw.y), bflo(pw.z), bfhi(pw.z), bflo(pw.w), bfhi(pw.w)};
        const f32x4 m0 = *(const f32x4*)(mu + col), m1 = *(const f32x4*)(mu + col + 4); const float m8[8] = {m0.x, m0.y, m0.z, m0.w, m1.x, m1.y, m1.z, m1.w}; float v[8];
#pragma unroll
        for (int e = 0; e < 8; ++e) { const float x = c8[e] + (p8[e] - c8[e]) * m8[e]; v[e] = cg < 8 ? 1.0f - 2.0f * __builtin_amdgcn_rcpf(1.0f + __expf(2.0f * x)) : cg < 16 ? x : sigm(x); }
        v4u w; w.x = pk2(v[0], v[1]); w.y = pk2(v[2], v[3]); w.z = pk2(v[4], v[5]); w.w = pk2(v[6], v[7]);
        *(v4u*)(act + (size_t)t * 256 + 8 * cg) = w; }
}

namespace rw {
typedef short bf16x8 __attribute__((ext_vector_type(8)));
constexpr int MB = 8192;
__device__ __forceinline__ int SW(int r, int c) { return r * 128 + ((((c >> 3) ^ (r >> 1)) & 7) << 4) + (c & 7) * 2; }
__device__ __forceinline__ int SWG(int r, int c) { return r * 256 + ((((c >> 3) ^ r) & 15) << 4) + (c & 7) * 2; }
__device__ __forceinline__ int SWF(int r, int c) { return r * 256 + ((((c >> 2) ^ r) & 15) << 4) + (c & 3) * 4; }
enum { I_AT = 0, I_BT, I_AJ, I_BHJ, I_KHJ, I_ABRT, I_X5, I_L, I_LT, I_R0, I_R1, I_KT, I_RT, I_VJ, I_X14, I_GATE, I_VT, I_VT2, NBUF };
constexpr int OFF_F32 = NBUF * MB;
constexpr int OFF_CST = OFF_F32 + (64 * 3 + 512) * 4;
constexpr int LDS_NEED = OFF_CST + 14 * 64 * 4;

__device__ __forceinline__ bf16x8 ldfrag(const unsigned char* M, int row, int k) { return *(const bf16x8*)(M + SW(row, k)); }
__device__ __forceinline__ void mm(f32x4 (&acc)[2], const unsigned char* X, const unsigned char* Y, int mt, int nh, int fr, int fq) {
    const bf16x8 a0 = ldfrag(X, 16 * mt + fr, 8 * fq), a1 = ldfrag(X, 16 * mt + fr, 8 * fq + 32);
#pragma unroll
    for (int nt = 0; nt < 2; ++nt) { const bf16x8 b0 = ldfrag(Y, 16 * (2 * nh + nt) + fr, 8 * fq), b1 = ldfrag(Y, 16 * (2 * nh + nt) + fr, 8 * fq + 32);
        acc[nt] = __builtin_amdgcn_mfma_f32_16x16x32_bf16(a0, b0, acc[nt], 0, 0, 0); acc[nt] = __builtin_amdgcn_mfma_f32_16x16x32_bf16(a1, b1, acc[nt], 0, 0, 0); }
}
typedef short s16x4 __attribute__((ext_vector_type(4)));
typedef __attribute__((address_space(3))) s16x4* lds_s16x4p;
__device__ __forceinline__ bf16x8 ldfragT(const unsigned char* M, int row0, int kb, int fr, int fq) {
    const int k0 = kb + 8 * fq + (fr >> 2), c0 = row0 + 4 * (fr & 3);
    const s16x4 lo = __builtin_amdgcn_ds_read_tr16_b64_v4i16((lds_s16x4p)(M + SW(k0, c0))), hi = __builtin_amdgcn_ds_read_tr16_b64_v4i16((lds_s16x4p)(M + SW(k0 + 4, c0)));
    return (bf16x8){lo[0], lo[1], lo[2], lo[3], hi[0], hi[1], hi[2], hi[3]};
}
struct FA { bf16x8 k0, k1; };
struct FB { bf16x8 k0[2], k1[2]; };
__device__ __forceinline__ FA ldA(const unsigned char* X, int mt, int fr, int fq) { FA f; f.k0 = ldfrag(X, 16 * mt + fr, 8 * fq); f.k1 = ldfrag(X, 16 * mt + fr, 8 * fq + 32); return f; }
__device__ __forceinline__ FB ldB(const unsigned char* Y, int nh, int fr, int fq) { FB f;
#pragma unroll
    for (int nt = 0; nt < 2; ++nt) { f.k0[nt] = ldfrag(Y, 16 * (2 * nh + nt) + fr, 8 * fq); f.k1[nt] = ldfrag(Y, 16 * (2 * nh + nt) + fr, 8 * fq + 32); }
    return f; }
__device__ __forceinline__ FA ldAT(const unsigned char* XT, int mt, int fr, int fq) { FA f; f.k0 = ldfragT(XT, 16 * mt, 0, fr, fq); f.k1 = ldfragT(XT, 16 * mt, 32, fr, fq); return f; }
__device__ __forceinline__ FB ldBT(const unsigned char* YT, int nh, int fr, int fq) { FB f;
#pragma unroll
    for (int nt = 0; nt < 2; ++nt) { f.k0[nt] = ldfragT(YT, 16 * (2 * nh + nt), 0, fr, fq); f.k1[nt] = ldfragT(YT, 16 * (2 * nh + nt), 32, fr, fq); }
    return f; }
__device__ __forceinline__ void mma(f32x4 (&acc)[2], const FA& a, const FB& b) {
    acc[0] = __builtin_amdgcn_mfma_f32_16x16x32_bf16(a.k0, b.k0[0], acc[0], 0, 0, 0); acc[1] = __builtin_amdgcn_mfma_f32_16x16x32_bf16(a.k0, b.k0[1], acc[1], 0, 0, 0);
    acc[0] = __builtin_amdgcn_mfma_f32_16x16x32_bf16(a.k1, b.k1[0], acc[0], 0, 0, 0); acc[1] = __builtin_amdgcn_mfma_f32_16x16x32_bf16(a.k1, b.k1[1], acc[1], 0, 0, 0);
}
__device__ __forceinline__ void ldC(f32x4 (&acc)[2], const unsigned char* Z, int mt, int nh, int fr, int fq) {
#pragma unroll
    for (int nt = 0; nt < 2; ++nt) { const v2u w = *(const v2u*)(Z + SW(16 * (2 * nh + nt) + fr, 16 * mt + 4 * fq)); acc[nt] = (f32x4){bflo(w.x), bfhi(w.x), bflo(w.y), bfhi(w.y)}; }
}
__device__ __forceinline__ void storeT(unsigned char* Z, const f32x4 (&acc)[2], int mt, int nh, int fr, int fq) {
#pragma unroll
    for (int nt = 0; nt < 2; ++nt) { v2u w; w.x = pk2(acc[nt][0], acc[nt][1]); w.y = pk2(acc[nt][2], acc[nt][3]); *(v2u*)(Z + SW(16 * (2 * nh + nt) + fr, 16 * mt + 4 * fq)) = w; }
}
__device__ __forceinline__ void storeN(unsigned char* Z, const f32x4 (&acc)[2], int mt, int nh, int fr, int fq) {
#pragma unroll
    for (int nt = 0; nt < 2; ++nt)
#pragma unroll
        for (int r = 0; r < 4; ++r) *(unsigned short*)(Z + SW(16 * mt + 4 * fq + r, 16 * (2 * nh + nt) + fr)) = (unsigned short)f2bf(acc[nt][r]);
}
__device__ __forceinline__ void ld8bf(const unsigned char* p, float (&v)[8]) { const v4u w = *(const v4u*)p; v[0] = bflo(w.x); v[1] = bfhi(w.x); v[2] = bflo(w.y); v[3] = bfhi(w.y); v[4] = bflo(w.z); v[5] = bfhi(w.z); v[6] = bflo(w.w); v[7] = bfhi(w.w); }
__device__ __forceinline__ void st8bf(unsigned char* p, const float (&v)[8]) { v4u w; w.x = pk2(v[0], v[1]); w.y = pk2(v[2], v[3]); w.z = pk2(v[4], v[5]); w.w = pk2(v[6], v[7]); *(v4u*)p = w; }
__device__ __forceinline__ void ld8f(const float* p, float (&v)[8]) { const f32x4 a = *(const f32x4*)p, b = *(const f32x4*)(p + 4); v[0] = a.x; v[1] = a.y; v[2] = a.z; v[3] = a.w; v[4] = b.x; v[5] = b.y; v[6] = b.z; v[7] = b.w; }
__device__ __forceinline__ void ld8fs(const unsigned char* M, int r, int c, float (&v)[8]) { const f32x4 a = *(const f32x4*)(M + SWF(r, c)), b = *(const f32x4*)(M + SWF(r, c + 4)); v[0] = a.x; v[1] = a.y; v[2] = a.z; v[3] = a.w; v[4] = b.x; v[5] = b.y; v[6] = b.z; v[7] = b.w; }
__device__ __forceinline__ void un8(const v4u w, float (&v)[8]) { v[0] = bflo(w.x); v[1] = bfhi(w.x); v[2] = bflo(w.y); v[3] = bfhi(w.y); v[4] = bflo(w.z); v[5] = bfhi(w.z); v[6] = bflo(w.w); v[7] = bfhi(w.w); }
__device__ __forceinline__ void shift8(const v4u cw, const v4u pw, bool hasp, const float* mu, float (&v)[8]) {
    float c[8], p[8], m[8]; un8(cw, c); un8(pw, p); ld8f(mu, m);
#pragma unroll
    for (int e = 0; e < 8; ++e) { const float pe = hasp ? p[e] : 0.f; v[e] = c[e] + (pe - c[e]) * m[e]; }
}
__device__ __forceinline__ float tanh_fast(float x) { return 1.0f - 2.0f * __builtin_amdgcn_rcpf(1.0f + __expf(2.0f * x)); }

#define LBAR() do { asm volatile("s_waitcnt lgkmcnt(0)" ::: "memory"); __builtin_amdgcn_s_barrier(); asm volatile("" ::: "memory"); } while (0)
__device__ __forceinline__ void scan_unit(const PArgs& a, unsigned char* lds, int bh, int wv) {
    const int tid = mktid(wv), lane = tid & 63, wid = __builtin_amdgcn_readfirstlane(tid >> 6);
    const int mt = wid >> 1, nh = wid & 1; int fr = lane & 15, fq = lane >> 4;
    const int b = bh >> 3, h = bh & 7;
#define BUF(i) (lds + (i) * MB)
    float* GC = (float*)(lds + OFF_F32); float* BON = GC + 64; float* SSQ = BON + 64; float* SEGT = SSQ + 64;
    unsigned char* LWR = BUF(I_AT); unsigned char* LAR = BUF(I_AJ); unsigned char* LGR = BUF(I_KHJ); unsigned char* YTF = BUF(I_KHJ);
    unsigned char* ACTW = BUF(I_L); unsigned char* ACTA = BUF(I_LT); unsigned char* ACTG = BUF(I_R0);
    const bf16* z = (const bf16*)(a.ws + WS_Z); bf16* ya = (bf16*)(a.ws + WS_YA);
    const float* mu = a.in[7];
    bf16x8 fw[2], fa[2], fg[4];
    { const bf16* wlt = (const bf16*)(a.ws + WS_WLT) + (size_t)h * 4096 + (16 * mt + fr) * 64 + 8 * fq; const bf16* wat = (const bf16*)(a.ws + WS_WAT) + (size_t)h * 4096 + (16 * mt + fr) * 64 + 8 * fq;
      const bf16* wgt = (const bf16*)(a.ws + WS_WGT) + (size_t)h * 8192 + (16 * mt + fr) * 128 + 8 * fq;
      fw[0] = *(const bf16x8*)wlt; fw[1] = *(const bf16x8*)(wlt + 32); fa[0] = *(const bf16x8*)wat; fa[1] = *(const bf16x8*)(wat + 32);
#pragma unroll
      for (int ks = 0; ks < 4; ++ks) fg[ks] = *(const bf16x8*)(wgt + 32 * ks); }
    float* CST = (float*)(lds + OFF_CST);
    for (int i = tid; i < 14 * 64; i += 512) { const int blk = i >> 6, jj = i & 63; float v;
        if (blk < 3) v = mu[blk * 512 + h * 64 + jj]; else if (blk < 7) v = mu[1536 + (blk - 3) * 64 + jj]; else v = a.in[blk == 7 ? 8 : blk == 8 ? 10 : blk == 9 ? 13 : blk == 10 ? 14 : blk == 11 ? 15 : blk == 12 ? 16 : 17][h * 64 + jj];
        CST[i] = v; }
    int s0i = I_X14, aki = I_X5;
    for (int i = tid; i < MB / 4; i += 512) ((unsigned*)BUF(I_X14))[i] = 0u;
    LBAR();
    int pt = tid >> 3, j0 = 8 * (tid & 7);
    const int colh = h * 64 + j0;
    const int zoff0 = colh, zoff1 = 512 + colh, zoff2 = 1024 + colh;
    const bf16* actb = (const bf16*)(a.ws + WS_ACT);
    v4u zc[3], zq[3], za[4];
#define ZLOAD(cc) do { const size_t tr_ = (size_t)b * SEQ + (cc) * 64 + pt; const bf16* zr_ = z + tr_ * INC; const bf16* zs_ = ((cc) * 64 + pt) > 0 ? zr_ - INC : zr_; const bf16* ar_ = actb + tr_ * 256 + j0; \
        zc[0] = *(const v4u*)(zr_ + zoff0); zc[1] = *(const v4u*)(zr_ + zoff1); zc[2] = *(const v4u*)(zr_ + zoff2); \
        zq[0] = *(const v4u*)(zs_ + zoff0); zq[1] = *(const v4u*)(zs_ + zoff1); zq[2] = *(const v4u*)(zs_ + zoff2); \
        za[0] = *(const v4u*)(ar_); za[1] = *(const v4u*)(ar_ + 64); za[2] = *(const v4u*)(ar_ + 128); za[3] = *(const v4u*)(ar_ + 192); } while (0)
#define ESTAGE(VTB, TT_) \
        { float y[8], vv[8], g8[8], lg[8], lb[8]; ld8fs(YTF, pt, j0, y); ld8bf((VTB) + SW(pt, j0), vv); ld8bf(BUF(I_GATE) + SW(pt, j0), g8); \
          ld8f(CST + 12 * 64 + j0, lg); ld8f(CST + 13 * 64 + j0, lb); \
          float sm = 0.f; \
_Pragma("unroll") \
          for (int e = 0; e < 8; ++e) sm += y[e]; \
          const float mean = red8(sm) * (1.0f / 64.0f); float sq = 0.f; \
_Pragma("unroll") \
          for (int e = 0; e < 8; ++e) { y[e] -= mean; sq += y[e] * y[e]; } \
          const float rstd = rsqrtf(red8(sq) * (1.0f / 64.0f) + 64e-5f), bon = BON[pt]; \
_Pragma("unroll") \
          for (int e = 0; e < 8; ++e) y[e] = (y[e] * rstd * lg[e] + lb[e] + bon * vv[e]) * g8[e]; \
          ypend.x = pk2(y[0], y[1]); ypend.y = pk2(y[2], y[3]); ypend.z = pk2(y[4], y[5]); ypend.w = pk2(y[6], y[7]); ypoff = (TT_) * RWW + colh; }
    ZLOAD(0);
    v4u ypend = {0u, 0u, 0u, 0u}; size_t ypoff = 0;
    for (int c = 0; c < SEQ / 64; ++c) {
        asm volatile("" : "+v"(fr), "+v"(fq), "+v"(pt), "+v"(j0));
        const int s = c * 64 + pt; const size_t t = (size_t)b * SEQ + s; const bool hasp = s > 0;
        if (c > 0) { ESTAGE(((c - 1) & 1) ? BUF(I_VT2) : BUF(I_VT), t - 64) }
        { float v[8];
          shift8(zc[0], zq[0], hasp, CST + 0 * 64 + j0, v); st8bf(BUF(I_RT) + SW(pt, j0), v);
          shift8(zc[1], zq[1], hasp, CST + 1 * 64 + j0, v); st8bf(BUF(I_KT) + SW(pt, j0), v);
          { float kkc[8], ss = 0.f; ld8f(CST + 9 * 64 + j0, kkc);
#pragma unroll
            for (int e = 0; e < 8; ++e) { const float q = v[e] * kkc[e]; ss += q * q; }
            ss = red8(ss); if (j0 == 0) SSQ[pt] = rsqrtf(fmaxf(ss, 1e-24f)); }
          shift8(zc[2], zq[2], hasp, CST + 2 * 64 + j0, v); st8bf(((c & 1) ? BUF(I_VT2) : BUF(I_VT)) + SW(pt, j0), v);
          *(v4u*)(ACTW + SW(pt, j0)) = za[0]; *(v4u*)(ACTA + SW(pt, j0)) = za[1]; *(v4u*)(ACTG + SWG(pt, j0)) = za[2]; *(v4u*)(ACTG + SWG(pt, 64 + j0)) = za[3]; }
        LBAR();
        f32x4 aw[2], aa[2], ag[2];
#pragma unroll
        for (int nt = 0; nt < 2; ++nt) { const int tr = 16 * (2 * nh + nt) + fr; const f32x4 zero = {0.f, 0.f, 0.f, 0.f};
            aw[nt] = __builtin_amdgcn_mfma_f32_16x16x32_bf16(fw[0], ldfrag(ACTW, tr, 8 * fq), zero, 0, 0, 0); aw[nt] = __builtin_amdgcn_mfma_f32_16x16x32_bf16(fw[1], ldfrag(ACTW, tr, 8 * fq + 32), aw[nt], 0, 0, 0);
            aa[nt] = __builtin_amdgcn_mfma_f32_16x16x32_bf16(fa[0], ldfrag(ACTA, tr, 8 * fq), zero, 0, 0, 0); aa[nt] = __builtin_amdgcn_mfma_f32_16x16x32_bf16(fa[1], ldfrag(ACTA, tr, 8 * fq + 32), aa[nt], 0, 0, 0);
            ag[nt] = zero;
#pragma unroll
            for (int ks = 0; ks < 4; ++ks) ag[nt] = __builtin_amdgcn_mfma_f32_16x16x32_bf16(fg[ks], *(const bf16x8*)(ACTG + SWG(tr, 8 * fq + 32 * ks)), ag[nt], 0, 0, 0); }
#pragma unroll
        for (int nt = 0; nt < 2; ++nt) { const int tr = 16 * (2 * nh + nt) + fr, jc = 16 * mt + 4 * fq;
            *(f32x4*)(LWR + SWF(tr, jc)) = aw[nt]; *(f32x4*)(LAR + SWF(tr, jc)) = aa[nt]; *(f32x4*)(LGR + SWF(tr, jc)) = ag[nt]; }
        LBAR();
        float lwv[8], an[8], bb[8], k2[8], rr[8], gg[8], vv8[8], p8[8];
        { const int j = lane, tw = wid;
          const float w0c = CST[7 * 64 + j], a0c = CST[8 * 64 + j], kkc = CST[9 * 64 + j], kac = CST[10 * 64 + j], rkc = CST[11 * 64 + j];
          const unsigned char* vtb = (c & 1) ? BUF(I_VT2) : BUF(I_VT);
          float bo[8], av[8];
#pragma unroll
          for (int u = 0; u < 8; ++u) { const int t8 = 8 * tw + u;
              const float lw = *(const float*)(LWR + SWF(t8, j)), la = *(const float*)(LAR + SWF(t8, j)); gg[u] = *(const float*)(LGR + SWF(t8, j));
              rr[u] = bflo(*(const unsigned short*)(BUF(I_RT) + SW(t8, j))); const float kx = bflo(*(const unsigned short*)(BUF(I_KT) + SW(t8, j))); vv8[u] = bflo(*(const unsigned short*)(vtb + SW(t8, j)));
              lwv[u] = -0.606531f * sigm(w0c + lw); av[u] = sigm(a0c + la);
              const float kn = kx * kkc * SSQ[t8]; an[u] = -kn; bb[u] = kn * av[u];
              k2[u] = kx * (1.0f + (av[u] - 1.0f) * kac); bo[u] = rr[u] * k2[u] * rkc; }
          wave_sum8(bo);
          if (j == 0) {
#pragma unroll
              for (int u = 0; u < 8; ++u) BON[8 * tw + u] = bo[u]; }
          p8[0] = lwv[0];
#pragma unroll
          for (int u = 1; u < 8; ++u) p8[u] = p8[u - 1] + lwv[u];
          SEGT[tw * 64 + j] = p8[7]; }
        LBAR();
        { const int j = lane, tw = wid; float sg8[8];
#pragma unroll
          for (int s2 = 0; s2 < 8; ++s2) sg8[s2] = SEGT[s2 * 64 + j];
          float base = 0.f, tot = 0.f;
#pragma unroll
          for (int s2 = 0; s2 < 8; ++s2) { tot += sg8[s2]; base += (s2 < tw) ? sg8[s2] : 0.f; }
          const float gcj = __expf(tot); if (tw == 7) GC[j] = gcj;
          float eprev = __expf(base);
          float o0[8], o1[8], o2[8], o3[8], ob[8], ok[8];
#pragma unroll
          for (int u = 0; u < 8; ++u) { const float L = p8[u] + base; const float e1 = __expf(L), ie1 = __builtin_amdgcn_rcpf(e1), ep = eprev, eh = gcj * ie1; eprev = e1;
              o0[u] = an[u] * ep; o1[u] = bb[u] * ie1; o2[u] = k2[u] * ie1; o3[u] = rr[u] * e1; ob[u] = bb[u] * eh; ok[u] = k2[u] * eh;
              *(unsigned short*)(BUF(I_GATE) + SW(8 * tw + u, j)) = (unsigned short)f2bf(gg[u]); }
          st8bf(BUF(I_AJ) + SW(j, 8 * tw), o0); st8bf(BUF(I_BT) + SW(j, 8 * tw), o1); st8bf(BUF(I_KT) + SW(j, 8 * tw), o2); st8bf(BUF(I_RT) + SW(j, 8 * tw), o3);
          st8bf(BUF(I_BHJ) + SW(j, 8 * tw), ob); st8bf(BUF(I_KHJ) + SW(j, 8 * tw), ok); st8bf(BUF(I_VJ) + SW(j, 8 * tw), vv8); }
        if (c > 0) *(v4u*)(ya + ypoff) = ypend;
        if (c + 1 < SEQ / 64) ZLOAD(c + 1);
        LBAR();
#define MASK(acc, cond) _Pragma("unroll") for (int nt = 0; nt < 2; ++nt) _Pragma("unroll") for (int r = 0; r < 4; ++r) { const int m_ = 16 * mt + 4 * fq + r, n_ = 16 * (2 * nh + nt) + fr; if (!(cond)) acc[nt][r] = 0.f; }
        { const f32x4 zero = {0.f, 0.f, 0.f, 0.f}; f32x4 aL[2] = {zero, zero}, aL2[2] = {zero, zero}, aK[2] = {zero, zero}, aR[2] = {zero, zero};
          const FA fAT = ldAT(BUF(I_AJ), mt, fr, fq), fBTa = ldAT(BUF(I_BT), mt, fr, fq); const FB fBT = ldBT(BUF(I_BT), nh, fr, fq), fKT = ldBT(BUF(I_KT), nh, fr, fq), fRT = ldBT(BUF(I_RT), nh, fr, fq), fATb = ldBT(BUF(I_AJ), nh, fr, fq);
          mma(aL, fAT, fBT);
          mma(aL2, fBTa, fATb);
          mma(aK, fAT, fKT);
          mma(aR, fBTa, fRT);
          MASK(aL, m_ > n_) MASK(aL2, n_ > m_) MASK(aK, n_ < m_) MASK(aR, m_ <= n_)
#pragma unroll
          for (int nt = 0; nt < 2; ++nt)
#pragma unroll
              for (int r = 0; r < 4; ++r) { const int m_ = 16 * mt + 4 * fq + r, n_ = 16 * (2 * nh + nt) + fr; if (m_ == n_) aL2[nt][r] = 1.0f; }
          storeT(BUF(I_L), aL, mt, nh, fr, fq); storeT(BUF(I_R0), aL2, mt, nh, fr, fq);
          storeT(BUF(aki), aK, mt, nh, fr, fq);
          storeT(BUF(I_ABRT), aR, mt, nh, fr, fq); }
        LBAR();
#pragma unroll
        for (int k = 1; k <= 6; ++k) {
            unsigned char* Pc = (k & 1) ? BUF(I_L) : BUF(I_AT); unsigned char* Pn = (k & 1) ? BUF(I_AT) : BUF(I_L);
            unsigned char* Rc = (k & 1) ? BUF(I_R1) : BUF(I_R0); unsigned char* Rn = (k & 1) ? BUF(I_R0) : BUF(I_R1);
            const f32x4 zero = {0.f, 0.f, 0.f, 0.f}; f32x4 aP[2] = {zero, zero}, aRr[2] = {zero, zero};
            FA fP, fPTa; FB fPT, fR;
            if (k <= 5) { fP = ldAT(Pc, mt, fr, fq); fPT = ldB(Pc, nh, fr, fq); }
            if (k >= 2) { fPTa = ldA(Pc, mt, fr, fq); fR = ldB(Rc, nh, fr, fq); ldC(aRr, Rc, mt, nh, fr, fq); }
            if (k <= 5) mma(aP, fP, fPT);
            if (k >= 2) mma(aRr, fPTa, fR);
            if (k <= 5) storeT(Pn, aP, mt, nh, fr, fq);
            if (k >= 2) storeT(Rn, aRr, mt, nh, fr, fq);
            LBAR();
        }
        { const f32x4 zero = {0.f, 0.f, 0.f, 0.f}; f32x4 a1[2] = {zero, zero}, a2[2] = {zero, zero};
          const FA fTT = ldA(BUF(I_R1), mt, fr, fq); const FB fAJ = ldB(BUF(I_AJ), nh, fr, fq), fAK = ldB(BUF(aki), nh, fr, fq);
          mma(a1, fTT, fAJ); mma(a2, fTT, fAK);
          storeT(BUF(I_L), a1, mt, nh, fr, fq);
          storeT(BUF(I_LT), a2, mt, nh, fr, fq); }
        LBAR();
        { const f32x4 zero = {0.f, 0.f, 0.f, 0.f}; f32x4 aMY[2], aNY[2] = {zero, zero}, aMS[2] = {zero, zero}, aNS[2];
          const FA fG1 = ldA(BUF(I_L), mt, fr, fq), fG2 = ldA(BUF(I_LT), mt, fr, fq), fKTa = ldAT(BUF(I_KT), mt, fr, fq);
          const FB fAB = ldB(BUF(I_ABRT), nh, fr, fq), fRT = ldBT(BUF(I_RT), nh, fr, fq), fBH = ldB(BUF(I_BHJ), nh, fr, fq);
#pragma unroll
          for (int nt = 0; nt < 2; ++nt)
#pragma unroll
              for (int r = 0; r < 4; ++r) aMY[nt][r] = bflo(*(const unsigned short*)(BUF(I_RT) + SW(16 * mt + 4 * fq + r, 16 * (2 * nh + nt) + fr)));
          ldC(aNS, BUF(I_KHJ), mt, nh, fr, fq);
          mma(aNY, fKTa, fRT);
          mma(aMY, fG1, fAB);
          mma(aMS, fG1, fBH);
          mma(aNS, fG2, fBH);
          MASK(aNY, m_ <= n_)
          mma(aNY, fG2, fAB);
#pragma unroll
          for (int nt = 0; nt < 2; ++nt)
#pragma unroll
              for (int r = 0; r < 4; ++r) { const int m_ = 16 * mt + 4 * fq + r, n_ = 16 * (2 * nh + nt) + fr; if (m_ == n_) aMS[nt][r] += GC[m_]; }
          storeT(BUF(I_AT), aMY, mt, nh, fr, fq); storeT(BUF(I_BT), aNY, mt, nh, fr, fq); storeT(BUF(I_AJ), aMS, mt, nh, fr, fq); storeT(BUF(I_R0), aNS, mt, nh, fr, fq); }
        LBAR();
        { const f32x4 zero = {0.f, 0.f, 0.f, 0.f}; f32x4 aY[2] = {zero, zero}, aS[2] = {zero, zero};
          const FA fS0a = ldA(BUF(s0i), mt, fr, fq), fVJa = ldA(BUF(I_VJ), mt, fr, fq), fMS = ldA(BUF(I_AJ), mt, fr, fq), fNS = ldA(BUF(I_R0), mt, fr, fq);
          const FB fMY = ldB(BUF(I_AT), nh, fr, fq), fNY = ldB(BUF(I_BT), nh, fr, fq), fS0 = ldB(BUF(s0i), nh, fr, fq), fVJ = ldB(BUF(I_VJ), nh, fr, fq);
          mma(aY, fS0a, fMY); mma(aS, fMS, fS0); mma(aY, fVJa, fNY); mma(aS, fNS, fVJ);
#pragma unroll
          for (int nt = 0; nt < 2; ++nt) *(f32x4*)(YTF + SWF(16 * (2 * nh + nt) + fr, 16 * mt + 4 * fq)) = aY[nt];
          storeT(BUF(aki), aS, mt, nh, fr, fq); }
        LBAR();
#undef MASK
        { const int tmp = s0i; s0i = aki; aki = tmp; }
    }
    { const int c = SEQ / 64; const size_t tprev = (size_t)b * SEQ + (c - 1) * 64 + pt; ESTAGE(((c - 1) & 1) ? BUF(I_VT2) : BUF(I_VT), tprev) }
    *(v4u*)(ya + ypoff) = ypend;
    LBAR();
#undef ESTAGE
#undef BUF
#undef ZLOAD
}
#undef LBAR
}

__device__ __forceinline__ void p_norm2_route(const PArgs& a, unsigned char* lds, int wv) {
    typedef short bf16x8 __attribute__((ext_vector_type(8)));
    const int tid = mktid(wv), lane = tid & 63, fr = lane & 15, fq = lane >> 4;
    const bf16* x1 = (const bf16*)(a.ws + WS_X1B); const float* mod = (const float*)(a.ws + WS_MOD); const float* gm2 = (const float*)(a.ws + WS_GM2); const float* cbt = (const float*)(a.ws + WS_CB);
    int* rte = (int*)(a.ws + WS_RTE); float* rtw = (float*)(a.ws + WS_RTW); int* rnk = (int*)(a.ws + WS_RNK); unsigned* cnt = (unsigned*)(a.ws + WS_CTL) + CW_CNT;
    float* PL = (float*)lds;
    float* PS = PL + 8 * 32 * 48;
    float* RS_ = PS + 8 * 32;
    float* FL = RS_ + 32;
    unsigned* HIST = (unsigned*)(FL + 32 * 48);
    unsigned* LRK = HIST + 32;
    if (tid < 32) HIST[tid] = 0u;
    __syncthreads();
    int gcount = 0;
    bf16x8 wh[4][3], wl[4][3];
    { const bf16* wrh = (const bf16*)(a.ws + WS_WRH) + fr * 1024 + 128 * wv + 8 * fq; const bf16* wrl = (const bf16*)(a.ws + WS_WRL) + fr * 1024 + 128 * wv + 8 * fq;
#pragma unroll
      for (int ks = 0; ks < 4; ++ks)
#pragma unroll
          for (int nt = 0; nt < 3; ++nt) { wh[ks][nt] = *(const bf16x8*)(wrh + nt * 16 * 1024 + 32 * ks); wl[ks][nt] = *(const bf16x8*)(wrl + nt * 16 * 1024 + 32 * ks); } }
    for (int grp = blockIdx.x; grp < NT / 32; grp += gridDim.x) {
        const int row0 = grp * 32, b = row0 >> 11;
        f32x4 acc[3][2];
#pragma unroll
        for (int nt = 0; nt < 3; ++nt) { acc[nt][0] = (f32x4){0.f, 0.f, 0.f, 0.f}; acc[nt][1] = acc[nt][0]; }
        float ssq[2] = {0.f, 0.f};
#pragma unroll
        for (int rt = 0; rt < 2; ++rt) {
            float xs[4][8];
#pragma unroll
            for (int ks = 0; ks < 4; ++ks) rw::ld8bf((const unsigned char*)(x1 + (size_t)(row0 + 16 * rt + fr) * DM + 128 * wv + 32 * ks + 8 * fq), xs[ks]);
#pragma unroll
            for (int ks = 0; ks < 4; ++ks) { float gm[8]; rw::ld8f(gm2 + b * 1024 + 128 * wv + 32 * ks + 8 * fq, gm); unsigned hw[4], lw[4];
#pragma unroll
                for (int e = 0; e < 4; ++e) { const float x0 = xs[ks][2 * e], x1v = xs[ks][2 * e + 1]; ssq[rt] += x0 * x0 + x1v * x1v; const float g0 = x0 * gm[2 * e], g1 = x1v * gm[2 * e + 1];
                    hw[e] = pk2(g0, g1); lw[e] = pk2(g0 - bflo(hw[e]), g1 - bfhi(hw[e])); }
                const v4u hv = {hw[0], hw[1], hw[2], hw[3]}, lv = {lw[0], lw[1], lw[2], lw[3]}; const bf16x8 bh = __builtin_bit_cast(bf16x8, hv), bl = __builtin_bit_cast(bf16x8, lv);
#pragma unroll
                for (int nt = 0; nt < 3; ++nt) { acc[nt][rt] = __builtin_amdgcn_mfma_f32_16x16x32_bf16(wh[ks][nt], bh, acc[nt][rt], 0, 0, 0); acc[nt][rt] = __builtin_amdgcn_mfma_f32_16x16x32_bf16(wl[ks][nt], bh, acc[nt][rt], 0, 0, 0);
                    acc[nt][rt] = __builtin_amdgcn_mfma_f32_16x16x32_bf16(wh[ks][nt], bl, acc[nt][rt], 0, 0, 0); } } }
#pragma unroll
        for (int rt = 0; rt < 2; ++rt) {
#pragma unroll
            for (int nt = 0; nt < 3; ++nt) *(f32x4*)(PL + (wv * 32 + 16 * rt + fr) * 48 + 16 * nt + 4 * fq) = acc[nt][rt];
            float s = ssq[rt]; s += __builtin_bit_cast(float, __builtin_amdgcn_ds_swizzle(__builtin_bit_cast(int, s), 0x401F));
            { const unsigned u = __builtin_bit_cast(unsigned, s); auto rr = __builtin_amdgcn_permlane32_swap(u, u, false, false); s = __builtin_bit_cast(float, (unsigned)rr[0]) + __builtin_bit_cast(float, (unsigned)rr[1]); }
            if (fq == 0) PS[wv * 32 + 16 * rt + fr] = s; }
        __syncthreads();
        { const int r = tid >> 4, c = tid & 15; float s0 = 0.f, s1 = 0.f, s2 = 0.f, sq = 0.f;
#pragma unroll
          for (int w = 0; w < 8; ++w) { const float* p = PL + (w * 32 + r) * 48; s0 += p[c]; s1 += p[c + 16]; s2 += p[c + 32]; sq += PS[w * 32 + r]; }
          const float rstd = rsqrtf(sq * (1.0f / DM) + 1e-6f); const float* cb = cbt + b * 48;
          FL[r * 48 + c] = rstd * s0 + cb[c]; FL[r * 48 + c + 16] = rstd * s1 + cb[c + 16]; FL[r * 48 + c + 32] = rstd * s2 + cb[c + 32];
          if (c == 0) ((float*)(a.ws + WS_RSTD))[row0 + r] = rstd; }
        __syncthreads();
        if (tid < 32) { const int m = row0 + tid; const float* lg = FL + tid * 48;
            int gi = 0; float gm = lg[0];
#pragma unroll
            for (int i = 1; i < 4; ++i) if (lg[i] > gm) { gm = lg[i]; gi = i; }
            float gs = 0.f;
#pragma unroll
            for (int i = 0; i < 4; ++i) gs += __expf(lg[i] - gm);
            const float pg = 1.0f / gs;
            float el[8];
#pragma unroll
            for (int k = 0; k < 8; ++k) el[k] = lg[4 + gi * 8 + k];
            int e1 = 0; float m1 = el[0];
#pragma unroll
            for (int k = 1; k < 8; ++k) if (el[k] > m1) { m1 = el[k]; e1 = k; }
            int e2 = -1; float m2 = -INFINITY;
#pragma unroll
            for (int k = 0; k < 8; ++k) if (k != e1 && el[k] > m2) { m2 = el[k]; e2 = k; }
            const float q2 = __expf(m2 - m1); const float w1 = pg / (1.0f + q2), w2 = pg * q2 / (1.0f + q2);
            const int ea = gi * 8 + e1, eb = gi * 8 + e2; rte[2 * m] = ea; rte[2 * m + 1] = eb; rtw[2 * m] = w1; rtw[2 * m + 1] = w2;
            LRK[gcount * 64 + 2 * tid] = atomicAdd(HIST + ea, 1u) | ((unsigned)ea << 24); LRK[gcount * 64 + 2 * tid + 1] = atomicAdd(HIST + eb, 1u) | ((unsigned)eb << 24); }
        ++gcount;
        __syncthreads();
    }
    if (tid < 32) { const unsigned n = HIST[tid]; HIST[tid] = n ? atomicAdd(cnt + tid * CNT_PAD, n) : 0u; }
    __syncthreads();
    for (int i = tid; i < gcount * 64; i += 512) { const int gi_ = i >> 6, e = i & 63; const int m2 = 2 * ((blockIdx.x + gi_ * gridDim.x) * 32) + e; const unsigned lr = LRK[i]; rnk[m2] = (int)(HIST[lr >> 24] + (lr & 0xffffffu)); }
    __syncthreads();
}
__device__ __forceinline__ void p_moe_gather(const PArgs& a, unsigned char* lds, int wv) {
    int* off = (int*)lds; int* tl = off + 64;
    const int tid = mktid(wv), lane = tid & 63, gw = blockIdx.x * 8 + (tid >> 6), NGW = gridDim.x * 8;
    int* ctl = (int*)(a.ws + WS_CTL); const unsigned* cnt = (const unsigned*)ctl + CW_CNT;
    if (tid < NEXP) tl[tid] = ((int)cnt[tid * CNT_PAD] + 255) >> 8;
    __syncthreads();
    if (tid < NEXP) { int o = 0; for (int e = 0; e < tid; ++e) o += tl[e];
        off[tid] = o * 256;
        if (blockIdx.x == 0) { const int n = tl[tid]; for (int i = 0; i < n; ++i) ctl[CW_TEXP + o + i] = tid; if (tid == NEXP - 1) ctl[CW_NT] = o + n; } }
    __syncthreads();
    const int* rte = (const int*)(a.ws + WS_RTE); const int* rnk = (const int*)(a.ws + WS_RNK); int* pos = (int*)(a.ws + WS_POS);
    const bf16* x1 = (const bf16*)(a.ws + WS_X1B); bf16* xs = (bf16*)(a.ws + WS_XS); const float* rstdv = (const float*)(a.ws + WS_RSTD);
    const float* mod = (const float*)(a.ws + WS_MOD); const float* gm2 = (const float*)(a.ws + WS_GM2);
    typedef int v4i_ __attribute__((ext_vector_type(4)));
    v4u xr[4][2]; v4i_ re[2], rk[2]; f32x4 rs;
    { const int t0 = 4 * gw < NT ? 4 * gw : 0;
#pragma unroll
      for (int r = 0; r < 4; ++r)
#pragma unroll
          for (int hf = 0; hf < 2; ++hf) xr[r][hf] = *(const v4u*)(x1 + (size_t)(t0 + r) * DM + 8 * lane + 512 * hf);
      re[0] = *(const v4i_*)(rte + 2 * t0); re[1] = *(const v4i_*)(rte + 2 * t0 + 4); rk[0] = *(const v4i_*)(rnk + 2 * t0); rk[1] = *(const v4i_*)(rnk + 2 * t0 + 4); rs = *(const f32x4*)(rstdv + t0); }
    for (int t0 = 4 * gw; t0 < NT; t0 += 4 * NGW) {
        const int tn = t0 + 4 * NGW < NT ? t0 + 4 * NGW : t0;
        v4u nx[4][2]; v4i_ ne[2], nk[2]; f32x4 ns;
#pragma unroll
        for (int r = 0; r < 4; ++r)
#pragma unroll
            for (int hf = 0; hf < 2; ++hf) nx[r][hf] = *(const v4u*)(x1 + (size_t)(tn + r) * DM + 8 * lane + 512 * hf);
        ne[0] = *(const v4i_*)(rte + 2 * tn); ne[1] = *(const v4i_*)(rte + 2 * tn + 4); nk[0] = *(const v4i_*)(rnk + 2 * tn); nk[1] = *(const v4i_*)(rnk + 2 * tn + 4); ns = *(const f32x4*)(rstdv + tn);
        const int b = t0 >> 11; int p0[4], p1[4];
#pragma unroll
        for (int r = 0; r < 4; ++r) { const int i0 = 2 * r, i1 = 2 * r + 1; p0[r] = off[re[i0 >> 2][i0 & 3]] + rk[i0 >> 2][i0 & 3]; p1[r] = off[re[i1 >> 2][i1 & 3]] + rk[i1 >> 2][i1 & 3]; }
        if (lane < 4) { const int r = lane; pos[2 * (t0 + r)] = r == 0 ? p0[0] : r == 1 ? p0[1] : r == 2 ? p0[2] : p0[3]; pos[2 * (t0 + r) + 1] = r == 0 ? p1[0] : r == 1 ? p1[1] : r == 2 ? p1[2] : p1[3]; }
#pragma unroll
        for (int hf = 0; hf < 2; ++hf) { const int col = 8 * lane + 512 * hf; float gm[8], sh[8];
            rw::ld8f(gm2 + b * 1024 + col, gm); rw::ld8f(mod + b * 6144 + 3072 + col, sh);
#pragma unroll
            for (int r = 0; r < 4; ++r) { const v4u xw = xr[r][hf]; const float rstd = rs[r];
                const float xv[8] = {bflo(xw.x), bfhi(xw.x), bflo(xw.y), bfhi(xw.y), bflo(xw.z), bfhi(xw.z), bflo(xw.w), bfhi(xw.w)}; float o[8];
#pragma unroll
                for (int e = 0; e < 8; ++e) o[e] = xv[e] * gm[e] * rstd + sh[e];
                v4u w; w.x = pk2(o[0], o[1]); w.y = pk2(o[2], o[3]); w.z = pk2(o[4], o[5]); w.w = pk2(o[6], o[7]);
                *(v4u*)(xs + (size_t)p0[r] * DM + col) = w; *(v4u*)(xs + (size_t)p1[r] * DM + col) = w; } }
#pragma unroll
        for (int r = 0; r < 4; ++r)
#pragma unroll
            for (int hf = 0; hf < 2; ++hf) xr[r][hf] = nx[r][hf];
        re[0] = ne[0]; re[1] = ne[1]; rk[0] = nk[0]; rk[1] = nk[1]; rs = ns;
    }
}
__device__ __forceinline__ void p_combine(const PArgs& a, unsigned char* lds, int wv) {
    const int tid = mktid(wv), lane = tid & 63, gw = blockIdx.x * 8 + (tid >> 6), NGW = gridDim.x * 8;
    const float* mod = (const float*)(a.ws + WS_MOD); const int* pos = (const int*)(a.ws + WS_POS); const float* rtw = (const float*)(a.ws + WS_RTW);
    const bf16* ys = (const bf16*)(a.ws + WS_XS); float* out = a.out; const bf16* x1 = (const bf16*)(a.ws + WS_X1B);
    typedef int v4i_ __attribute__((ext_vector_type(4)));
    v4i_ ps[2]; f32x4 wt[2];
    { const int m0 = 4 * gw < NT ? 4 * gw : 0; ps[0] = *(const v4i_*)(pos + 2 * m0); ps[1] = *(const v4i_*)(pos + 2 * m0 + 4); wt[0] = *(const f32x4*)(rtw + 2 * m0); wt[1] = *(const f32x4*)(rtw + 2 * m0 + 4); }
    for (int m0 = 4 * gw; m0 < NT; m0 += 4 * NGW) {
        const int mn = m0 + 4 * NGW < NT ? m0 + 4 * NGW : m0; const int b = m0 >> 11;
        v4u xw[4][2], y0[4][2], y1[4][2];
#pragma unroll
        for (int r = 0; r < 4; ++r) { const int i0 = 2 * r, i1 = 2 * r + 1; const int q0 = ps[i0 >> 2][i0 & 3], q1 = ps[i1 >> 2][i1 & 3];
#pragma unroll
            for (int hf = 0; hf < 2; ++hf) { const int col = 8 * lane + 512 * hf; xw[r][hf] = __builtin_nontemporal_load((const v4u*)(x1 + (size_t)(m0 + r) * DM + col)); y0[r][hf] = __builtin_nontemporal_load((const v4u*)(ys + (size_t)q0 * DM + col)); y1[r][hf] = __builtin_nontemporal_load((const v4u*)(ys + (size_t)q1 * DM + col)); } }
        v4i_ np[2]; f32x4 nw[2];
        np[0] = *(const v4i_*)(pos + 2 * mn); np[1] = *(const v4i_*)(pos + 2 * mn + 4); nw[0] = *(const f32x4*)(rtw + 2 * mn); nw[1] = *(const f32x4*)(rtw + 2 * mn + 4);
#pragma unroll
        for (int hf = 0; hf < 2; ++hf) { const int col = 8 * lane + 512 * hf; float g2[8]; rw::ld8f(mod + b * 6144 + 5120 + col, g2);
#pragma unroll
            for (int r = 0; r < 4; ++r) { const int i0 = 2 * r, i1 = 2 * r + 1; const float w0 = wt[i0 >> 2][i0 & 3], w1 = wt[i1 >> 2][i1 & 3];
                const v4u xa = xw[r][hf], a0 = y0[r][hf], a1 = y1[r][hf];
                const float xv[8] = {bflo(xa.x), bfhi(xa.x), bflo(xa.y), bfhi(xa.y), bflo(xa.z), bfhi(xa.z), bflo(xa.w), bfhi(xa.w)};
                const float e0[8] = {bflo(a0.x), bfhi(a0.x), bflo(a0.y), bfhi(a0.y), bflo(a0.z), bfhi(a0.z), bflo(a0.w), bfhi(a0.w)};
                const float e1[8] = {bflo(a1.x), bfhi(a1.x), bflo(a1.y), bfhi(a1.y), bflo(a1.z), bfhi(a1.z), bflo(a1.w), bfhi(a1.w)};
                float o[8];
#pragma unroll
                for (int e = 0; e < 8; ++e) o[e] = xv[e] + g2[e] * (e0[e] * w0 + e1[e] * w1);
                float* op = out + (size_t)(m0 + r) * DM + col; __builtin_nontemporal_store((f32x4){o[0], o[1], o[2], o[3]}, (f32x4*)op); __builtin_nontemporal_store((f32x4){o[4], o[5], o[6], o[7]}, (f32x4*)(op + 4)); } }
        ps[0] = np[0]; ps[1] = np[1]; wt[0] = nw[0]; wt[1] = nw[1];
    }
}

#define XB_TMO      128
#define XB_XCNT(j)  (256  + 64 * (j))
#define XB_XSUB(j)  (1280 + 64 * (j))
#define XB_XGEN(j)  (2304 + 64 * (j))
#define XB_TOP      3328
#define XB_TOPGEN   3392
#define XCD_BAR_WORDS 3456
#define XB_SPIN_CAP (1u << 22)

__device__ __forceinline__ unsigned xb_ld(unsigned* p)              { return __hip_atomic_load(p, __ATOMIC_RELAXED, __HIP_MEMORY_SCOPE_AGENT); }
__device__ __forceinline__ unsigned xb_add(unsigned* p, unsigned v) { return __hip_atomic_fetch_add(p, v, __ATOMIC_RELAXED, __HIP_MEMORY_SCOPE_AGENT); }
__device__ __forceinline__ unsigned xb_xcc_id() { return (unsigned)__builtin_amdgcn_s_getreg((3 << 11) | 20) & 0xFu; }
#define XB_SPIN(cond, bar) do { unsigned _sp = 0; while (cond) { __builtin_amdgcn_s_sleep(1); \
    if ((++_sp & 255u) == 0u) { if (xb_ld(&(bar)[XB_TMO])) break; if (_sp > XB_SPIN_CAP) { atomicAdd(&(bar)[XB_TMO], 1u); break; } } } } while (0)

struct XcdBarrier {
    unsigned* bar; unsigned x;
    volatile LAS unsigned* st;
};

__device__ __forceinline__ XcdBarrier xcd_barrier_post(unsigned* bar, volatile LAS unsigned* st, int wv) {
    XcdBarrier b; b.bar = bar; b.x = xb_xcc_id(); b.st = st;
    if (mktid(wv) == 0) (void)xb_add(&bar[XB_XCNT(b.x)], 1u);
    return b;
}
__device__ __forceinline__ void xcd_barrier_complete(unsigned* bar, unsigned x, unsigned& nloc, unsigned& nx) {
    const unsigned G = gridDim.x * gridDim.y * gridDim.z;
    unsigned sum, cnt, mine, sp = 0u;
    for (;;) {
        sum = 0u; cnt = 0u; mine = 0u;
#pragma unroll
        for (unsigned j = 0; j < 16; ++j) { const unsigned c = xb_ld(&bar[XB_XCNT(j)]); sum += c; cnt += (c > 0u) ? 1u : 0u; mine = (j == x) ? c : mine; }
        if (sum == G) break;
        __builtin_amdgcn_s_sleep(1);
        if ((++sp & 255u) == 0u) { if (xb_ld(&bar[XB_TMO])) break; if (sp > XB_SPIN_CAP) { atomicAdd(&bar[XB_TMO], 1u); break; } }
    }
    nloc = mine > 0u ? mine : 1u; nx = cnt > 0u ? cnt : 1u;
}

__device__ __forceinline__ void xcd_barrier(const XcdBarrier& b, int wv) {
    asm volatile("s_waitcnt vmcnt(0)" ::: "memory");
    __syncthreads();
    if (mktid(wv) == 0) {
        unsigned* bar = b.bar;
        __builtin_amdgcn_s_waitcnt(0);
        unsigned nloc = b.st[0], nx = b.st[1];
        if (nloc == 0u) { xcd_barrier_complete(bar, b.x, nloc, nx); b.st[0] = nloc; b.st[1] = nx; }
        const unsigned old = xb_add(&bar[XB_XSUB(b.x)], 1u);
        const unsigned gen = old / nloc;
        if (old + 1u == (gen + 1u) * nloc) {
            __builtin_amdgcn_fence(__ATOMIC_RELEASE, "agent");
            asm volatile("s_waitcnt vmcnt(0)" ::: "memory");
            const unsigned og = xb_add(&bar[XB_TOP], 1u);
            const unsigned tg = og / nx;
            if (og + 1u == (tg + 1u) * nx) xb_add(&bar[XB_TOPGEN], 1u);
            else XB_SPIN(xb_ld(&bar[XB_TOPGEN]) == tg, bar);
            __builtin_amdgcn_fence(__ATOMIC_ACQUIRE, "agent");
            xb_add(&bar[XB_XGEN(b.x)], 1u);
            asm volatile("s_waitcnt vmcnt(0)" ::: "memory");
        } else {
            XB_SPIN(xb_ld(&bar[XB_XGEN(b.x)]) == gen, bar);
            __builtin_amdgcn_fence(__ATOMIC_ACQUIRE, "agent");
            asm volatile("s_waitcnt vmcnt(0)" ::: "memory");
        }
    }
    __syncthreads();
}

constexpr int LDS_BYTES = 160 * 1024, MISC_OFF = LDS_BYTES - 256;
static_assert(rw::LDS_NEED <= MISC_OFF, "scan LDS");
static_assert(XB_TMO == XB_TMO_W && MISC_OFF + 64 == DOWN_MSK_OFF, "control word layout");

__device__ __forceinline__ void p_actprep_dyn(const PArgs& a, unsigned char* lds, int wv) {
    const int tid = mktid(wv), lane = tid & 63; const bf16* z = (const bf16*)(a.ws + WS_Z); bf16* act = (bf16*)(a.ws + WS_ACT); const float* mu = a.in[7];
    unsigned* ctl = (unsigned*)(a.ws + WS_CTL);
    __syncthreads();
    if (tid == 0) { XB_SPIN(xb_ld(ctl + CW_ZCNT) < (unsigned)(NT / 256 * 8), ctl + CW_BAR); __builtin_amdgcn_fence(__ATOMIC_ACQUIRE, "agent"); asm volatile("s_waitcnt vmcnt(0)" ::: "memory"); }
    __syncthreads();
    const int cg = lane & 31, col = 1536 + 8 * cg;
    const f32x4 m0 = *(const f32x4*)(mu + col), m1 = *(const f32x4*)(mu + col + 4); const float m8[8] = {m0.x, m0.y, m0.z, m0.w, m1.x, m1.y, m1.z, m1.w};
    for (;;) {
        unsigned grab = 0; if (lane == 0) grab = atomicAdd(ctl + CW_AQ, 1u);
        grab = (unsigned)__builtin_amdgcn_readfirstlane((int)grab);
        if (grab >= (unsigned)(NT / 64)) break;
        for (int sub = 0; sub < 8; ++sub) {
        const int t0 = (int)grab * 64 + sub * 8 + (lane >> 5);
        v4u cw[4], pw[4];
#pragma unroll
        for (int u = 0; u < 4; ++u) { const int t = t0 + 2 * u; const int tp = (t & (SEQ - 1)) > 0 ? t - 1 : t; cw[u] = *(const v4u*)(z + (size_t)t * INC + col); pw[u] = *(const v4u*)(z + (size_t)tp * INC + col); }
#pragma unroll
        for (int u = 0; u < 4; ++u) { const int t = t0 + 2 * u; const bool hasp = (t & (SEQ - 1)) > 0; const v4u c4 = cw[u]; v4u p4 = pw[u]; if (!hasp) p4 = (v4u){0u, 0u, 0u, 0u};
            const float c8[8] = {bflo(c4.x), bfhi(c4.x), bflo(c4.y), bfhi(c4.y), bflo(c4.z), bfhi(c4.z), bflo(c4.w), bfhi(c4.w)}, p8[8] = {bflo(p4.x), bfhi(p4.x), bflo(p4.y), bfhi(p4.y), bflo(p4.z), bfhi(p4.z), bflo(p4.w), bfhi(p4.w)}; float v[8];
#pragma unroll
            for (int e = 0; e < 8; ++e) { const float x = c8[e] + (p8[e] - c8[e]) * m8[e]; v[e] = cg < 8 ? 1.0f - 2.0f * __builtin_amdgcn_rcpf(1.0f + __expf(2.0f * x)) : cg < 16 ? x : sigm(x); }
            v4u w; w.x = pk2(v[0], v[1]); w.y = pk2(v[2], v[3]); w.z = pk2(v[4], v[5]); w.w = pk2(v[6], v[7]);
            *(v4u*)(act + (size_t)t * 256 + 8 * cg) = w; }
        }
    }
}

__global__ void __launch_bounds__(512, 2) mega_fwd(PArgs a) {
    extern __shared__ __attribute__((aligned(16))) unsigned char lds[];
    volatile LAS unsigned* MISC = (volatile LAS unsigned*)((LAS unsigned char*)lds + MISC_OFF);
    const int wv = __builtin_amdgcn_readfirstlane((int)threadIdx.x >> 6);
    { const int t0 = mktid(wv); if (t0 < 64) MISC[t0] = 0u; }
    __syncthreads();
    XcdBarrier bar = xcd_barrier_post((unsigned*)(a.ws + WS_CTL) + CW_BAR, MISC + 8, wv);
    GemmArgs g; g.ws = a.ws; g.x = a.in[0]; g.out = a.out; g.qg = a.in[18]; g.kg = a.in[19];
    const int G = (int)gridDim.x, bx = (int)blockIdx.x;

    { const int t0 = mktid(wv); float wr[64]; float* sc = (float*)(lds + 68 * 1024); float* red = (float*)lds;
      const bool has = bx < 192;
      if (has) p_ada_load(a, bx, t0, wr);
      for (int i = t0; i < 16 * 1024; i += 512) { const float v = a.in[1][i]; sc[i] = v / (1.0f + __expf(-v)); }
      p_prep_weights(a, lds, wv);
      __syncthreads();
      if (has) p_ada_finish(a, sc, red, bx, t0, wr);
      for (int tile = bx + G; tile < 192; tile += G) { p_ada_load(a, tile, t0, wr); p_ada_finish(a, sc, red, tile, t0, wr); } }
    xcd_barrier(bar, wv);
    p_norm1(a, lds, wv);
    xcd_barrier(bar, wv);
    p_gemm_in(g, lds, wv);
    p_actprep_dyn(a, lds, wv);
    xcd_barrier(bar, wv);
    { const int nscan = G / 2;
      if (bx < nscan) { for (int bh = bx; bh < 128; bh += nscan) rw::scan_unit(a, lds, bh, wv); }
      else p_attn(a, lds, bx - nscan, G - nscan, wv); }
    __syncthreads(); p_prep_experts_dyn(a, lds, wv);
    xcd_barrier(bar, wv);
    p_gemm_merge(g, lds, wv);
    xcd_barrier(bar, wv);
    p_gemm_out(g, lds, wv);
    xcd_barrier(bar, wv);
    p_norm2_route(a, lds, wv);
    xcd_barrier(bar, wv);
    p_moe_gather(a, lds, wv);
    xcd_barrier(bar, wv);
    p_gemm_up(g, lds, wv);
    __syncthreads();
    p_gemm_down(g, lds, wv);
    xcd_barrier(bar, wv);
    p_combine(a, lds, wv);
}

extern "C" void kernel_launch(void* const* d_in, const int* in_sizes, int n_in, void* d_out, int out_size, void* d_ws, size_t ws_size, hipStream_t stream) {
    static int grid = 0;
    if (grid == 0) {
        if (n_in != 30 || out_size != NT * DM || ws_size < WS_END) { fprintf(stderr, "kernel_launch: unexpected shapes (n_in %d, out %d, ws %zu)\n", n_in, out_size, ws_size); grid = -1; return; }
        int dev = 0, cus = 0, per_cu = 0;
        if (hipGetDevice(&dev) != hipSuccess || hipDeviceGetAttribute(&cus, hipDeviceAttributeMultiprocessorCount, dev) != hipSuccess) { grid = -1; return; }
        if (hipFuncSetAttribute((const void*)mega_fwd, hipFuncAttributeMaxDynamicSharedMemorySize, LDS_BYTES) != hipSuccess) { fprintf(stderr, "kernel_launch: hipFuncSetAttribute failed\n"); grid = -1; return; }
        if (hipOccupancyMaxActiveBlocksPerMultiprocessor(&per_cu, (const void*)mega_fwd, 512, LDS_BYTES) != hipSuccess || per_cu < 1) { fprintf(stderr, "kernel_launch: occupancy query says %d blocks per CU\n", per_cu); (void)hipGetLastError(); grid = -1; return; }
        grid = cus;
    }
    if (grid < 0) return;
    (void)hipMemsetAsync((char*)d_ws + WS_CTL, 0, 65536, stream);
    PArgs p{}; for (int i = 0; i < 30; ++i) p.in[i] = (const float*)d_in[i]; p.out = (float*)d_out; p.ws = (unsigned char*)d_ws;
    hipLaunchKernelGGL(mega_fwd, dim3(grid), dim3(512), LDS_BYTES, stream, p);
}
```

```cpp
#include <hip/hip_runtime.h>
#include <cstdio>
#include <cstdint>
__device__ __forceinline__ int mktid(int wv) { int l; asm volatile("v_mbcnt_lo_u32_b32 %0, -1, 0\n\tv_mbcnt_hi_u32_b32 %0, -1, %0" : "=v"(l)); return (wv << 6) | l; }
template <int CTRL> __device__ __forceinline__ float dppf(float v) { return __builtin_bit_cast(float, __builtin_amdgcn_update_dpp(0, __builtin_bit_cast(int, v), CTRL, 0xF, 0xF, true)); }
__device__ __forceinline__ float red4(float v) { v += dppf<0xB1>(v); v += dppf<0x4E>(v); return v; }
__device__ __forceinline__ float red8(float v) { v = red4(v); v += dppf<0x141>(v); return v; }
__device__ __forceinline__ float red16(float v) { v = red8(v); v += dppf<0x140>(v); return v; }
__device__ __forceinline__ float wave_sum(float v) { v = red16(v);
    v += __builtin_bit_cast(float, __builtin_amdgcn_ds_swizzle(__builtin_bit_cast(int, v), 0x401F));
    const unsigned u = __builtin_bit_cast(unsigned, v); auto rr = __builtin_amdgcn_permlane32_swap(u, u, false, false);
    return __builtin_bit_cast(float, (unsigned)rr[0]) + __builtin_bit_cast(float, (unsigned)rr[1]); }
__device__ __forceinline__ void wave_sum8(float (&v)[8]) {
#pragma unroll
    for (int i = 0; i < 8; ++i) v[i] += dppf<0xB1>(v[i]);
#pragma unroll
    for (int i = 0; i < 8; ++i) v[i] += dppf<0x4E>(v[i]);
#pragma unroll
    for (int i = 0; i < 8; ++i) v[i] += dppf<0x141>(v[i]);
#pragma unroll
    for (int i = 0; i < 8; ++i) v[i] += dppf<0x140>(v[i]);
#pragma unroll
    for (int i = 0; i < 8; ++i) v[i] += __builtin_bit_cast(float, __builtin_amdgcn_ds_swizzle(__builtin_bit_cast(int, v[i]), 0x401F));
#pragma unroll
    for (int i = 0; i < 8; ++i) { const unsigned u = __builtin_bit_cast(unsigned, v[i]); auto rr = __builtin_amdgcn_permlane32_swap(u, u, false, false); v[i] = __builtin_bit_cast(float, (unsigned)rr[0]) + __builtin_bit_cast(float, (unsigned)rr[1]); }
}
__device__ __forceinline__ float lane_get(float v, int src) { return __builtin_bit_cast(float, __builtin_amdgcn_ds_bpermute(src << 2, __builtin_bit_cast(int, v))); }
namespace pg8 {
#define PG8_LAS __attribute__((address_space(3)))
typedef unsigned short bf16_t;
typedef short bf16x8 __attribute__((ext_vector_type(8)));
typedef float f32x4 __attribute__((ext_vector_type(4)));
typedef unsigned u32x4 __attribute__((ext_vector_type(4)));
constexpr int BM = 256, BK = 64, HALF = 128, HTB = HALF * BK * 2  , STAGE_BYTES = 8 * HTB, NXCD = 8, WGM = 4;

__host__ __device__ __forceinline__ int lds_byte(int r, int c) { const int st = (r >> 4) * 2 + (c >> 5), rr = r & 15, cc = c & 31, ob = rr * 64 + cc * 2; return st * 1024 + (ob ^ (((ob >> 9) & 1) << 5)); }
__host__ __device__ __forceinline__ void stage_rc(int b, int& R, int& C) { const int st = b / 1024, sb = b % 1024, swz = sb ^ (((sb >> 9) & 1) << 5); R = (st >> 1) * 16 + swz / 64; C = (st & 1) * 32 + (swz % 64) / 2; }
__host__ __device__ __forceinline__ int perm32(int rho) { const int n = rho >> 4, i = rho & 15; return 8 * (i >> 2) + 4 * n + (i & 3); }
struct Unit { int pm, pn, aux; const char* a; const char* b; };
struct Gemm { int K; };

struct StaticOrder {
    int nM, nN, nwg, G, c; const char* A; const char* Bt; size_t tstep;
    __device__ void init(const void* A_, const void* Bt_, int M, int N, int K, int G_, int c_) { nM = M / BM; nN = N / BM; nwg = nM * nN; G = G_; c = c_; A = (const char*)A_; Bt = (const char*)Bt_; tstep = (size_t)BM * K * 2; }
    __device__ bool next(int i, Unit& u) const {
        const long L = (long)i * G + c; if (L >= nwg) return false;
        int wgid = (int)L; { const int q = nwg / NXCD, r = nwg % NXCD, xcd = wgid % NXCD, off = wgid / NXCD; wgid = (xcd < r ? xcd * (q + 1) : r * (q + 1) + (xcd - r) * q) + off; }
        const int nig = WGM * nN, gid = wgid / nig, fm = gid * WGM, gsz = (nM - fm) < WGM ? (nM - fm) : WGM;
        u.aux = 0; u.pm = fm + ((wgid % nig) % gsz); u.pn = (wgid % nig) / gsz; u.a = A + (size_t)u.pm * tstep; u.b = Bt + (size_t)u.pn * tstep; return true;
    }
    __device__ __forceinline__ void a_ready(const Unit&) const {}
    __device__ __forceinline__ void done(const Unit&) const {}
};
__device__ __forceinline__ unsigned cvt_pk_bf16(float lo, float hi) { unsigned r; asm volatile("v_cvt_pk_bf16_f32 %0, %1, %2" : "=v"(r) : "v"(lo), "v"(hi)); return r; }
template <class Epi, class Sched, bool ALIGN_EPI = false, bool SP2 = false>
__device__ __forceinline__ void gemm_phase(PG8_LAS unsigned char* lds, const Gemm g, const Sched& S, const Epi& E, int wv) {
    const int tid = mktid(wv), wid = __builtin_amdgcn_readfirstlane(tid >> 6), lane = tid & 63, wr = wid >> 2, wc = wid & 3, fr = lane & 15, fq = lane >> 4;
    const int K = g.K, nt = K / BK;
    unsigned voffA[2], voffB[2];
#pragma unroll
    for (int i = 0; i < 2; ++i) { int R, C; stage_rc(tid * 16 + i * 8192, R, C); const int Rb = Epi::PERM ? ((R & ~31) + perm32(R & 31)) : R;
        voffA[i] = (unsigned)(R * K + C) * 2u; voffB[i] = (unsigned)(Rb * K + C) * 2u; }
    const size_t kstep = (size_t)(BK * 2);
    const size_t hstep = (size_t)HALF * K * 2;
        const unsigned ldsw = (unsigned)wid * 1024u;
    const int aoff = lds_byte(wr * 64 + fr, fq * 8), boff = lds_byte(wc * 32 + fr, fq * 8);
#define PG8_SA(b, h) (((b) * 2 + (h)) * HTB)
#define PG8_SB(b, h) ((4 + (b) * 2 + (h)) * HTB)
#define PG8_STAGE(bufoff, gbase, voff) do { _Pragma("unroll") for (int _i = 0; _i < 2; ++_i) \
        __builtin_amdgcn_global_load_lds((const unsigned*)((const char*)(gbase) + (voff)[_i]), (PG8_LAS unsigned*)(lds + (bufoff) + ldsw + _i * 8192), 16, 0, 0); } while (0)
#define PG8_LDA(dst, b, h) do { _Pragma("unroll") for (int m = 0; m < 4; ++m) _Pragma("unroll") for (int k = 0; k < 2; ++k) dst[m][k] = *(const PG8_LAS bf16x8*)(lds + PG8_SA(b, h) + aoff + m * 2048 + k * 1024); } while (0)
#define PG8_LDB(dst, b, h) do { _Pragma("unroll") for (int n = 0; n < 2; ++n) _Pragma("unroll") for (int k = 0; k < 2; ++k) dst[n][k] = *(const PG8_LAS bf16x8*)(lds + PG8_SB(b, h) + boff + n * 2048 + k * 1024); } while (0)
#define PG8_MMA(ai, bj, At, Bt) do { __builtin_amdgcn_s_setprio(1); _Pragma("unroll") for (int m = 0; m < 4; ++m) _Pragma("unroll") for (int n = 0; n < 2; ++n) _Pragma("unroll") for (int k = 0; k < 2; ++k) \
        acc[ai][bj][m][n] = __builtin_amdgcn_mfma_f32_16x16x32_bf16(Bt[n][k], At[m][k], acc[ai][bj][m][n], 0, 0, 0); __builtin_amdgcn_s_setprio(0); } while (0)
#define PG8_WAIT_V(n) asm volatile("s_waitcnt vmcnt(" #n ")" ::: "memory")
#define PG8_WAIT_L(n) asm volatile("s_waitcnt lgkmcnt(" #n ")" ::: "memory")
#define PG8_BAR __builtin_amdgcn_s_barrier()
#define PG8_SCHED __builtin_amdgcn_sched_barrier(0)
    Unit cur, nxt; int ui = 0;
    if (!S.next(0, cur)) return;
    f32x4 acc[2][2][4][2];
#pragma unroll
    for (int a = 0; a < 2; ++a)
#pragma unroll
        for (int b = 0; b < 2; ++b)
#pragma unroll
            for (int m = 0; m < 4; ++m)
#pragma unroll
                for (int n = 0; n < 2; ++n) acc[a][b][m][n] = (f32x4){0.f, 0.f, 0.f, 0.f};
    bf16x8 At[4][2], B0[2][2], B1[2][2];
    const char* cA = cur.a; const char* cB = cur.b;
    S.a_ready(cur);
    if constexpr (SP2) {
        PG8_STAGE(PG8_SB(0, 0), cB, voffB); PG8_STAGE(PG8_SB(0, 1), cB + hstep, voffB); PG8_STAGE(PG8_SA(0, 0), cA, voffA); PG8_STAGE(PG8_SA(0, 1), cA + hstep, voffA);
        if (wr == 1) PG8_BAR;
        PG8_WAIT_V(2); PG8_BAR;
        PG8_STAGE(PG8_SB(1, 0), cB + kstep, voffB); PG8_STAGE(PG8_SA(1, 0), cA + kstep, voffA); PG8_STAGE(PG8_SB(1, 1), cB + hstep + kstep, voffB);
        PG8_WAIT_V(6); PG8_BAR;
    } else {
        PG8_STAGE(PG8_SB(0, 0), cB, voffB); PG8_STAGE(PG8_SA(0, 0), cA, voffA); PG8_STAGE(PG8_SB(0, 1), cB + hstep, voffB); PG8_STAGE(PG8_SA(0, 1), cA + hstep, voffA);
        if (wr == 1) PG8_BAR;
        PG8_WAIT_V(4); PG8_BAR;
        PG8_STAGE(PG8_SB(1, 0), cB + kstep, voffB); PG8_STAGE(PG8_SA(1, 0), cA + kstep, voffA); PG8_STAGE(PG8_SB(1, 1), cB + hstep + kstep, voffB);
        PG8_WAIT_V(6); PG8_BAR;
    }
    for (;;) {
        const bool has_next = S.next(ui + 1, nxt);
        const char* nA = has_next ? nxt.a : cA; const char* nB = has_next ? nxt.b : cB;
        for (int t = 0; t < nt; t += 2) {
            const bool last = (t == nt - 2);
            const char* a1 = cA + (size_t)(t + 1) * kstep;
            const char* a2 = last ? nA : cA + (size_t)(t + 2) * kstep; const char* b2 = last ? nB : cB + (size_t)(t + 2) * kstep;
            const char* a3 = a2 + kstep; const char* b3 = b2 + kstep;
            if (last && has_next) S.a_ready(nxt);
            if constexpr (SP2) {
            PG8_LDB(B0, 0, 0); PG8_LDB(B1, 0, 1); PG8_SCHED; PG8_LDA(At, 0, 0); PG8_STAGE(PG8_SA(1, 1), a1 + hstep, voffA);
            PG8_WAIT_V(8); PG8_WAIT_L(0); PG8_BAR; PG8_MMA(0, 0, At, B0); PG8_MMA(0, 1, At, B1); PG8_BAR; PG8_SCHED;
            PG8_LDA(At, 0, 1); PG8_STAGE(PG8_SB(0, 0), b2, voffB); PG8_STAGE(PG8_SB(0, 1), b2 + hstep, voffB); PG8_STAGE(PG8_SA(0, 0), a2, voffA);
            PG8_WAIT_V(8); PG8_WAIT_L(0); PG8_BAR; PG8_MMA(1, 0, At, B0); PG8_MMA(1, 1, At, B1); PG8_BAR; PG8_SCHED;
            PG8_LDB(B0, 1, 0); PG8_LDB(B1, 1, 1); PG8_SCHED; PG8_LDA(At, 1, 0); PG8_STAGE(PG8_SA(0, 1), a2 + hstep, voffA);
            PG8_WAIT_V(8); PG8_WAIT_L(0); PG8_BAR; PG8_MMA(0, 0, At, B0); PG8_MMA(0, 1, At, B1); PG8_BAR; PG8_SCHED;
            PG8_LDA(At, 1, 1); PG8_STAGE(PG8_SB(1, 0), b3, voffB); PG8_STAGE(PG8_SB(1, 1), b3 + hstep, voffB); PG8_STAGE(PG8_SA(1, 0), a3, voffA);
            PG8_WAIT_V(8); PG8_WAIT_L(0); PG8_BAR; PG8_MMA(1, 0, At, B0); PG8_MMA(1, 1, At, B1); PG8_BAR; PG8_SCHED;
            } else {
            PG8_LDB(B0, 0, 0); PG8_SCHED; PG8_LDA(At, 0, 0); PG8_STAGE(PG8_SA(1, 1), a1 + hstep, voffA);
            PG8_WAIT_L(8); PG8_BAR; PG8_WAIT_L(0); PG8_MMA(0, 0, At, B0); PG8_BAR; PG8_SCHED;
            PG8_LDB(B1, 0, 1); PG8_STAGE(PG8_SB(0, 0), b2, voffB);
            PG8_BAR; PG8_WAIT_L(0); PG8_MMA(0, 1, At, B1); PG8_BAR;
            PG8_LDA(At, 0, 1); PG8_STAGE(PG8_SA(0, 0), a2, voffA);
            PG8_BAR; PG8_WAIT_L(0); PG8_MMA(1, 0, At, B0); PG8_BAR; PG8_SCHED;
            PG8_STAGE(PG8_SB(0, 1), b2 + hstep, voffB);
            PG8_WAIT_V(6); PG8_BAR; PG8_MMA(1, 1, At, B1); PG8_BAR;
            PG8_LDB(B0, 1, 0); PG8_SCHED; PG8_LDA(At, 1, 0); PG8_STAGE(PG8_SA(0, 1), a2 + hstep, voffA);
            PG8_WAIT_L(8); PG8_BAR; PG8_WAIT_L(0); PG8_MMA(0, 0, At, B0); PG8_BAR; PG8_SCHED;
            PG8_LDB(B1, 1, 1); PG8_STAGE(PG8_SB(1, 0), b3, voffB);
            PG8_BAR; PG8_WAIT_L(0); PG8_MMA(0, 1, At, B1); PG8_BAR;
            PG8_LDA(At, 1, 1); PG8_STAGE(PG8_SA(1, 0), a3, voffA);
            PG8_BAR; PG8_WAIT_L(0); PG8_MMA(1, 0, At, B0); PG8_BAR; PG8_SCHED;
            PG8_STAGE(PG8_SB(1, 1), b3 + hstep, voffB);
            PG8_WAIT_V(6); PG8_BAR; PG8_MMA(1, 1, At, B1); PG8_BAR;
            }
        }
        if constexpr (ALIGN_EPI) { if (wr == 0) PG8_BAR; }
        bool keep = false;
        if constexpr (!Epi::AFTER_DRAIN) { if constexpr (Epi::CHAIN) keep = E.chain(acc, cur, wr, wc, fr, fq); else E(acc, cur, wr, wc, fr, fq); S.done(cur); }
        if (!has_next) break;
        if (!keep) {
#pragma unroll
        for (int a = 0; a < 2; ++a)
#pragma unroll
            for (int b = 0; b < 2; ++b)
#pragma unroll
                for (int m = 0; m < 4; ++m)
#pragma unroll
                    for (int n = 0; n < 2; ++n) acc[a][b][m][n] = (f32x4){0.f, 0.f, 0.f, 0.f};
        }
        cur = nxt; cA = nA; cB = nB; ++ui;
        if constexpr (ALIGN_EPI) { if (wr == 1) PG8_BAR; }
    }
    PG8_WAIT_V(0);
    if constexpr (!ALIGN_EPI) { if (wr == 0) PG8_BAR; }
    PG8_BAR;
    if constexpr (Epi::AFTER_DRAIN) { E.fused(acc, cur, wr, wc, fr, fq, lds, wid, lane); S.done(cur); }
#undef PG8_SA
#undef PG8_SB
#undef PG8_STAGE
#undef PG8_LDA
#undef PG8_LDB
#undef PG8_MMA
#undef PG8_WAIT_V
#undef PG8_WAIT_L
#undef PG8_BAR
#undef PG8_SCHED
}
}
#include <hip/hip_bf16.h>
#include <cmath>
namespace attn_body {
using bf16=__hip_bfloat16;
using bf16x8=__attribute__((ext_vector_type(8)))short;
using s16x4=__attribute__((ext_vector_type(4)))short;
using f32x16=__attribute__((ext_vector_type(16)))float;
using u32x4=__attribute__((ext_vector_type(4)))unsigned;
constexpr int NHEAD=8,SEQ=2048,D=64,PQ=512,PK=512,PV=4352,PO=512;
constexpr int NW=8,QBLK=32,QB=QBLK*NW,KVBLK=64,NQB=SEQ/QB;
__device__ __forceinline__ int crow(int r,int hi){return (r&3)+8*(r>>2)+4*hi;}
#define SBAR() __builtin_amdgcn_sched_barrier(0)
__device__ __forceinline__ void cmask(f32x16&p0,f32x16&p1,int jb,int qrel,int hi){
  const float NEG=-INFINITY; int kb=64*jb+4*hi;
  #pragma unroll
  for(int r=0;r<16;++r){int kv=kb+(r&3)+8*(r>>2); if(kv>qrel)p0[r]=NEG; if(kv+32>qrel)p1[r]=NEG;}
}

constexpr int NSLOT=3, SLOTB=8192;
constexpr int LDS_K=0, LDS_V=NSLOT*SLOTB, LDS_WS=2*NSLOT*SLOTB, LDS_OST=LDS_WS+NW*64*4, LDS_SEL=LDS_OST+NW*4096, LDS_KM=LDS_SEL+256, LDS_KP=LDS_KM+7*64*4, LDS_BYTES=LDS_KP+8*64*4;
constexpr float C2=0.125f*1.4426950408889634f;
__device__ __forceinline__ void glds16(const void*gsrc,unsigned lds_dst){unsigned keep;
  asm volatile("s_mov_b32 %0, m0\n\ts_mov_b32 m0, %2\n\ts_nop 0\n\tglobal_load_lds_dwordx4 %1, off\n\ts_mov_b32 m0, %0":"=&s"(keep):"v"(gsrc),"s"(lds_dst):"memory");}
__device__ __forceinline__ float max3f(float a,float b,float c){float r;asm("v_max3_f32 %0, %1, %2, %3":"=v"(r):"v"(a),"v"(b),"v"(c));return r;}
__device__ __forceinline__ float max2f(float a,float b){float r;asm("v_max_f32_e32 %0, %1, %2":"=v"(r):"v"(a),"v"(b));return r;}
__device__ __forceinline__ float fadd_s(float a,float b){float r;asm("v_add_f32_e32 %0, %1, %2":"=v"(r):"v"(a),"v"(b));return r;}
__device__ __forceinline__ float fsub_s(float a,float b){float r;asm("v_sub_f32_e32 %0, %1, %2":"=v"(r):"v"(a),"v"(b));return r;}
typedef float f32x2_t __attribute__((ext_vector_type(2))); typedef __bf16 bf16x2_t __attribute__((ext_vector_type(2)));
__device__ __forceinline__ unsigned cvtpk_s(float lo,float hi){f32x2_t v={lo,hi};bf16x2_t b=__builtin_convertvector(v,bf16x2_t);return __builtin_bit_cast(unsigned,b);}
#define WAIT_BAR(N) asm volatile("s_waitcnt vmcnt(" #N ") lgkmcnt(0)\n\ts_barrier":::"memory")

__device__ __forceinline__ void qkt(f32x16&p0,f32x16&p1,const char*Kslot,const bf16x8*qr,const f32x16&negm,int r32,int hi){
  const char*kb=Kslot+hi*1024+r32*16;
  #pragma unroll
  for(int d0=0;d0<4;++d0){
    const bf16x8 b0=*reinterpret_cast<const bf16x8*>(kb+d0*2048);
    const bf16x8 b1=*reinterpret_cast<const bf16x8*>(kb+d0*2048+512);
    if(d0==0){p0=__builtin_amdgcn_mfma_f32_32x32x16_bf16(b0,qr[0],negm,0,0,0);p1=__builtin_amdgcn_mfma_f32_32x32x16_bf16(b1,qr[0],negm,0,0,0);}
    else{p0=__builtin_amdgcn_mfma_f32_32x32x16_bf16(b0,qr[d0],p0,0,0,0);p1=__builtin_amdgcn_mfma_f32_32x32x16_bf16(b1,qr[d0],p1,0,0,0);}}
}
typedef __attribute__((address_space(3))) const char* lds_cptr;
typedef short v4i16_t __attribute__((ext_vector_type(4)));
__device__ __forceinline__ void kload8(bf16x8*kf,lds_cptr kp){
  kf[0]=*(const __attribute__((address_space(3))) bf16x8*)(kp);      kf[1]=*(const __attribute__((address_space(3))) bf16x8*)(kp+512);
  kf[2]=*(const __attribute__((address_space(3))) bf16x8*)(kp+2048); kf[3]=*(const __attribute__((address_space(3))) bf16x8*)(kp+2560);
  kf[4]=*(const __attribute__((address_space(3))) bf16x8*)(kp+4096); kf[5]=*(const __attribute__((address_space(3))) bf16x8*)(kp+4608);
  kf[6]=*(const __attribute__((address_space(3))) bf16x8*)(kp+6144); kf[7]=*(const __attribute__((address_space(3))) bf16x8*)(kp+6656);
}
__device__ __forceinline__ void kload2(bf16x8*kf,lds_cptr kp,int j){ kf[2*j]=*(const __attribute__((address_space(3))) bf16x8*)(kp+j*2048); kf[2*j+1]=*(const __attribute__((address_space(3))) bf16x8*)(kp+j*2048+512); }
__device__ __forceinline__ s16x4 vtr(lds_cptr p){ return __builtin_bit_cast(s16x4,__builtin_amdgcn_ds_read_tr16_b64_v4i16((__attribute__((address_space(3))) v4i16_t*)p)); }
__device__ __forceinline__ float rowmax(const f32x16&p0,const f32x16&p1){
  float a=max3f(p0[0],p0[1],p1[0]),b=max3f(p0[2],p0[3],p1[1]);a=max3f(a,p1[2],p1[3]);
  #pragma unroll
  for(int r=4;r<16;r+=4){a=max3f(a,p0[r],p0[r+1]);b=max3f(b,p0[r+2],p0[r+3]);a=max3f(a,p1[r],p1[r+1]);b=max3f(b,p1[r+2],p1[r+3]);}
  const float m=max2f(a,b);
  auto rr=__builtin_amdgcn_permlane32_swap(__float_as_uint(m),__float_as_uint(m),false,false);
  return max2f(__uint_as_float(rr[0]),__uint_as_float(rr[1]));
}
__device__ __forceinline__ void pv(f32x16*o,int vb,bf16x8 pa0,bf16x8 pa1,bf16x8 pa2,bf16x8 pa3){
  #pragma unroll
  for(int d0=0;d0<2;++d0){s16x4 lo[4],hi[4];
    #pragma unroll
    for(int ks=0;ks<4;++ks){
      asm volatile("ds_read_b64_tr_b16 %0,%1 offset:%c2":"=&v"(lo[ks]):"v"(vb),"i"(d0*4096+ks*1024):"memory");
      asm volatile("ds_read_b64_tr_b16 %0,%1 offset:%c2":"=&v"(hi[ks]):"v"(vb),"i"(d0*4096+ks*1024+512):"memory");}
    asm volatile("s_waitcnt lgkmcnt(0)":::"memory");SBAR();
    #define PK(k) (bf16x8){lo[k][0],lo[k][1],lo[k][2],lo[k][3],hi[k][0],hi[k][1],hi[k][2],hi[k][3]}
    o[d0]=__builtin_amdgcn_mfma_f32_32x32x16_bf16(pa0,PK(0),o[d0],0,0,0);
    o[d0]=__builtin_amdgcn_mfma_f32_32x32x16_bf16(pa1,PK(1),o[d0],0,0,0);
    o[d0]=__builtin_amdgcn_mfma_f32_32x32x16_bf16(pa2,PK(2),o[d0],0,0,0);
    o[d0]=__builtin_amdgcn_mfma_f32_32x32x16_bf16(pa3,PK(3),o[d0],0,0,0);
    #undef PK
  }
}

#ifndef ATTN_STORE16
#define ATTN_STORE16(p,v) (*(u32x4*)(p)=(v))
#endif
template<int THRL> __device__ __forceinline__ void attn_unit(int b,int h,int qb,const bf16*Q,const bf16*__restrict__ K,const bf16*__restrict__ V,bf16*O,char*shm,int wv){
  const int tid=mktid(wv),lane=tid&63,r32=lane&31,hi=lane>>5;     const int wid=__builtin_amdgcn_readfirstlane(tid>>6);
  const long rowbase=(long)b*SEQ; const int q0=qb*QB;
  if(qb>3){ float*KMl=(float*)(shm+LDS_KM); float*KPl=(float*)(shm+LDS_KP); const int c8=tid&7, rl=tid>>3;
    for(int n=0;n<qb;++n){ float sm[8];
      #pragma unroll
      for(int d=0;d<8;++d)sm[d]=0.f;
      #pragma unroll
      for(int rr=0;rr<4;++rr){ const u32x4 w=*reinterpret_cast<const u32x4*>(K+(rowbase+n*256+rl+64*rr)*PK+h*D+8*c8);
        sm[0]+=__uint_as_float(w[0]<<16);sm[1]+=__uint_as_float(w[0]&0xffff0000u);sm[2]+=__uint_as_float(w[1]<<16);sm[3]+=__uint_as_float(w[1]&0xffff0000u);
        sm[4]+=__uint_as_float(w[2]<<16);sm[5]+=__uint_as_float(w[2]&0xffff0000u);sm[6]+=__uint_as_float(w[3]<<16);sm[7]+=__uint_as_float(w[3]&0xffff0000u); }
      #pragma unroll
      for(int d=0;d<8;++d){ float v=sm[d];
        v+=__builtin_bit_cast(float,__builtin_amdgcn_ds_swizzle(__builtin_bit_cast(int,v),0x201F));
        v+=__builtin_bit_cast(float,__builtin_amdgcn_ds_swizzle(__builtin_bit_cast(int,v),0x401F));
        { const unsigned u=__builtin_bit_cast(unsigned,v); auto rr2=__builtin_amdgcn_permlane32_swap(u,u,false,false); v=__uint_as_float((unsigned)rr2[0])+__uint_as_float((unsigned)rr2[1]); }
        sm[d]=v; }
      if(lane<8){
        #pragma unroll
        for(int d=0;d<8;++d)KPl[wid*64+8*lane+d]=sm[d]; }
      asm volatile("s_waitcnt vmcnt(0) lgkmcnt(0)\n\ts_barrier":::"memory");
      if(tid<64){ float s8=0.f;
        #pragma unroll
        for(int w8=0;w8<8;++w8)s8+=KPl[w8*64+tid];
        KMl[n*64+tid]=s8*(1.0f/256.0f); }
      asm volatile("s_waitcnt lgkmcnt(0)\n\ts_barrier":::"memory"); } }
  if(tid<QB){ unsigned sel=(qb<=3)?((1u<<qb)-1u):0u;
    if(qb>3){ const bf16*qp=Q+(rowbase+q0+tid)*PQ+h*D; const float*km=(const float*)(shm+LDS_KM); float gate[7];
      #pragma unroll
      for(int j=0;j<7;++j)gate[j]=0.f;
      #pragma unroll 1
      for(int i=0;i<8;++i){ const u32x4 w=*reinterpret_cast<const u32x4*>(qp+8*i); float qv[8];
        qv[0]=__uint_as_float(w[0]<<16);qv[1]=__uint_as_float(w[0]&0xffff0000u);qv[2]=__uint_as_float(w[1]<<16);qv[3]=__uint_as_float(w[1]&0xffff0000u);
        qv[4]=__uint_as_float(w[2]<<16);qv[5]=__uint_as_float(w[2]&0xffff0000u);qv[6]=__uint_as_float(w[3]<<16);qv[7]=__uint_as_float(w[3]&0xffff0000u);
        #pragma unroll
        for(int j=0;j<7;++j) if(j<qb){ const float*kp=km+j*64+8*i;
          #pragma unroll
          for(int d=0;d<8;++d)gate[j]+=qv[d]*kp[d]; } }
      #pragma unroll
      for(int rep=0;rep<3;++rep){ float best=-INFINITY; int bi=0;
        #pragma unroll
        for(int j=0;j<7;++j) if(j<qb&&!((sel>>j)&1u)&&gate[j]>best){best=gate[j];bi=j;}
        sel|=1u<<bi; } }
    ((unsigned char*)(shm+LDS_SEL))[tid]=(unsigned char)sel; }
  asm volatile("s_waitcnt vmcnt(0) lgkmcnt(0)\n\ts_barrier":::"memory");
  const bf16*Qw=Q+(rowbase+q0+wid*QBLK)*PQ+h*D;
  const bf16*Kh=K+rowbase*PK+h*D,*Vh=V+rowbase*PV+h*D;
  const unsigned lds0=(unsigned)(uintptr_t)shm;
  float*wsf=(float*)(shm+LDS_WS)+wid*64;
  const bf16*ksrc=Kh+(long)lane*PK+wid*8;
  const bf16*vsrc=Vh+(long)(16*(wid&3)+(lane>>2))*PV+(wid>>2)*32+(lane&3)*8;
  const unsigned kdst=lds0+LDS_K+wid*1024, vdst=lds0+LDS_V+wid*1024;
  #define TROW(t) ((long)(((t)<4)?(q0+(t)*KVBLK):(((t)-4)*KVBLK)))
  #define DMA_K(t,slot) glds16(ksrc+TROW(t)*PK,(unsigned)__builtin_amdgcn_readfirstlane(kdst+(slot)))
  #define DMA_V(t,slot) glds16(vsrc+TROW(t)*PV,(unsigned)__builtin_amdgcn_readfirstlane(vdst+(slot)))
  const int vb0=(int)(lds0+LDS_V)+((lane>>4)&1)*32+(lane&3)*8+(4*hi+((lane&15)>>2))*64;
  const char*Kbase=shm+LDS_K; bf16x8 kf[8];
  const lds_cptr shm3=(lds_cptr)shm; const lds_cptr kp0=shm3+LDS_K+hi*1024+r32*16; const lds_cptr vp0=shm3+LDS_V+((lane>>4)&1)*32+(lane&3)*8+(4*hi+((lane&15)>>2))*64;
  const int NT=(q0+QB)/KVBLK;
  DMA_K(0,0);DMA_V(0,0);DMA_K(1,SLOTB);
  bf16x8 qr[4];
  #pragma unroll
  for(int d0=0;d0<4;++d0)qr[d0]=*reinterpret_cast<const bf16x8*>(&Qw[(long)r32*PQ+d0*16+hi*8]);
  float mhat=0.f,l_reg=0.f;f32x16 o[2];o[0]=f32x16{};o[1]=f32x16{};
  const int qrel=wid*QBLK+r32;
  const unsigned selb=((const unsigned char*)(shm+LDS_SEL))[qrel];
  #define CMASK(P0,P1,t) cmask(P0,P1,(t),qrel,hi)
  #define SUBREF(C0,C1,t) do{ const float sb_=(((t)<4)||((selb>>(((t)-4)>>2))&1u))?mhat:INFINITY; _Pragma("unroll") for(int r_=0;r_<16;++r_){C0[r_]-=sb_;C1[r_]-=sb_;} }while(0)
  bool resc=false;
  #define START(P0,P1) do{ const float rm=rowmax(P0,P1); resc=false; \
    { const float dl=rm; mhat=fadd_s(mhat,dl); \
      _Pragma("unroll") for(int r=0;r<16;++r){P0[r]=fsub_s(P0[r],dl);P1[r]=fsub_s(P1[r],dl);} \
      } \
    _Pragma("unroll") for(int r=0;r<16;++r)P0[r]=__builtin_amdgcn_exp2f(P0[r]); }while(0)
  #define RESC() do{ if(resc){ asm volatile("s_waitcnt lgkmcnt(0)":::"memory"); \
      _Pragma("unroll") for(int d_=0;d_<2;++d_) _Pragma("unroll") for(int r=0;r<16;++r)o[d_][r]*=wsf[crow(r,hi)]; } }while(0)
  f32x16 pA0,pA1,pB0,pB1;
  int sl_prev=0,sl_cur=0,sl_next=SLOTB;
  #define ROT() do{sl_prev=sl_cur;sl_cur=sl_next;sl_next=(sl_next==(NSLOT-1)*SLOTB)?0:sl_next+SLOTB;}while(0)
  DMA_K(2,2*SLOTB);
  WAIT_BAR(3);
  qkt(pA0,pA1,Kbase,qr,f32x16{},r32,hi);asm volatile("s_nop 15\n\ts_nop 7":"+v"(pA0),"+v"(pA1));CMASK(pA0,pA1,0);
  START(pA0,pA1);
  _Pragma("unroll") for(int r=0;r<16;++r)pA1[r]=__builtin_amdgcn_exp2f(pA1[r]);
  WAIT_BAR(0);
  DMA_K(3,0);DMA_V(1,SLOTB);
  ROT();
  kload8(kf,kp0+sl_cur);
  WAIT_BAR(2);
  s16x4 vlo[8],vhi[8]; u32x4 pw0,pw1,pw2,pw3;
  #define PKW(P,B) cvtpk_s(P[B],P[B+1])
  #define PAF(k) __builtin_bit_cast(bf16x8,pw##k)
  #define VFR(i) (bf16x8){vlo[i][0],vlo[i][1],vlo[i][2],vlo[i][3],vhi[i][0],vhi[i][1],vhi[i][2],vhi[i][3]}
  #define PIN(x) asm volatile("":"+v"(x))
  #define MX3(a,b,c) __builtin_fmaxf(__builtin_fmaxf((a),(b)),(c))
  #define GAPA(MF,A0,A1,A2,A3,W0,W1,PW) do{ MF; sacc+=A0; sacc+=A1; sacc+=A2; sacc+=A3; PIN(sacc); W0; W1; PIN(PW); SBAR(); }while(0)
  #define EX(v) __builtin_amdgcn_exp2f(v)
  #define GAPB(MF,X,B) do{ MF; X[B]=EX(X[B]); X[B+1]=EX(X[B+1]); X[B+2]=EX(X[B+2]); X[B+3]=EX(X[B+3]); PIN(X); SBAR(); }while(0)
  #define VRD(i) do{ vlo[i]=vtr(vp_+(((i)>>2)*4096+((i)&3)*1024)); vhi[i]=vtr(vp_+(((i)>>2)*4096+((i)&3)*1024+512)); }while(0)
  #define KRD(G,j) do{ if(G){ kload2(kf,kp0+sl_next,j); SBAR(); } }while(0)
  #define STEP(C0,C1,P0,P1,t,GK,GV,GL,MB) do{ SBAR(); \
    const lds_cptr vp_=vp0+sl_prev; \
    VRD(0); SBAR(); float sacc=(P0[0]+P0[1]); \
    GAPA(C0=__builtin_amdgcn_mfma_f32_32x32x16_bf16(kf[0],qr[0],f32x16{},0,0,0), P0[2],P0[3],P0[4],P0[5],     pw0[0]=PKW(P0,0), pw0[1]=PKW(P0,2), pw0); \
    VRD(4); SBAR(); GAPA(C1=__builtin_amdgcn_mfma_f32_32x32x16_bf16(kf[1],qr[0],f32x16{},0,0,0), P0[6],P0[7],P0[8],P0[9],     pw0[2]=PKW(P0,4), pw0[3]=PKW(P0,6), pw0); \
    VRD(1); SBAR(); GAPA(C0=__builtin_amdgcn_mfma_f32_32x32x16_bf16(kf[2],qr[1],C0,0,0,0),   P0[10],P0[11],P0[12],P0[13], pw1[0]=PKW(P0,8), pw1[1]=PKW(P0,10), pw1); \
    VRD(5); SBAR(); GAPA(C1=__builtin_amdgcn_mfma_f32_32x32x16_bf16(kf[3],qr[1],C1,0,0,0),   P0[14],P0[15],P1[0],P1[1],   pw1[2]=PKW(P0,12),pw1[3]=PKW(P0,14), pw1); \
    VRD(2); SBAR(); GAPA(C0=__builtin_amdgcn_mfma_f32_32x32x16_bf16(kf[4],qr[2],C0,0,0,0),   P1[2],P1[3],P1[4],P1[5],     pw2[0]=PKW(P1,0), pw2[1]=PKW(P1,2), pw2); \
    VRD(6); SBAR(); GAPA(C1=__builtin_amdgcn_mfma_f32_32x32x16_bf16(kf[5],qr[2],C1,0,0,0),   P1[6],P1[7],P1[8],P1[9],     pw2[2]=PKW(P1,4), pw2[3]=PKW(P1,6), pw2); \
    VRD(3); SBAR(); GAPA(C0=__builtin_amdgcn_mfma_f32_32x32x16_bf16(kf[6],qr[3],C0,0,0,0),   P1[10],P1[11],P1[12],P1[13], pw3[0]=PKW(P1,8), pw3[1]=PKW(P1,10), pw3); \
    VRD(7); SBAR(); GAPA(C1=__builtin_amdgcn_mfma_f32_32x32x16_bf16(kf[7],qr[3],C1,0,0,0),   P1[14],P1[15],0.f,0.f,       pw3[2]=PKW(P1,12),pw3[3]=PKW(P1,14), pw3); \
    l_reg+=sacc; \
    if(GK){DMA_K((t)+3,sl_cur);} if(GV){DMA_V((t)+1,sl_next);} \
    SUBREF(C0,C1,t); if(MB){CMASK(C0,C1,t);} \
    { float a=MX3(C0[0],C0[1],C1[0]),b=MX3(C0[2],C0[3],C1[1]); a=MX3(a,C1[2],C1[3]); \
      _Pragma("unroll") for(int r=4;r<16;r+=4){a=MX3(a,C0[r],C0[r+1]);b=MX3(b,C0[r+2],C0[r+3]);a=MX3(a,C1[r],C1[r+1]);b=MX3(b,C1[r+2],C1[r+3]);} \
      float rm=__builtin_fmaxf(a,b); { auto rr=__builtin_amdgcn_permlane32_swap(__float_as_uint(rm),__float_as_uint(rm),false,false); rm=__builtin_fmaxf(__uint_as_float(rr[0]),__uint_as_float(rr[1])); } \
      resc=false; \
      if(__builtin_expect(__any(rm>(float)THRL),0)){ const float dl=__builtin_fmaxf(rm,0.f); mhat+=dl; \
        _Pragma("unroll") for(int r=0;r<16;++r){C0[r]-=dl;C1[r]-=dl;} \
        const float f=__builtin_amdgcn_exp2f(-dl); l_reg*=f; if(hi==0)wsf[r32]=f; resc=true; } } \
    SBAR(); \
    GAPB(o[0]=__builtin_amdgcn_mfma_f32_32x32x16_bf16(PAF(0),VFR(0),o[0],0,0,0), C0,0); \
    GAPB(o[1]=__builtin_amdgcn_mfma_f32_32x32x16_bf16(PAF(0),VFR(4),o[1],0,0,0), C0,4); \
    KRD(GL,0); GAPB(o[0]=__builtin_amdgcn_mfma_f32_32x32x16_bf16(PAF(1),VFR(1),o[0],0,0,0), C0,8); \
    KRD(GL,1); GAPB(o[1]=__builtin_amdgcn_mfma_f32_32x32x16_bf16(PAF(1),VFR(5),o[1],0,0,0), C0,12); \
    KRD(GL,2); GAPB(o[0]=__builtin_amdgcn_mfma_f32_32x32x16_bf16(PAF(2),VFR(2),o[0],0,0,0), C1,0); \
    KRD(GL,3); GAPB(o[1]=__builtin_amdgcn_mfma_f32_32x32x16_bf16(PAF(2),VFR(6),o[1],0,0,0), C1,4); \
    GAPB(o[0]=__builtin_amdgcn_mfma_f32_32x32x16_bf16(PAF(3),VFR(3),o[0],0,0,0), C1,8); \
    GAPB(o[1]=__builtin_amdgcn_mfma_f32_32x32x16_bf16(PAF(3),VFR(7),o[1],0,0,0), C1,12); \
    }while(0)
  #define ENDW(tt) do{ if((tt)+3<NT){WAIT_BAR(2);} else if((tt)+2<NT){WAIT_BAR(1);} else {WAIT_BAR(0);} }while(0)
  { int t=1;
    for(;t+1<NT;t+=2){
      STEP(pB0,pB1,pA0,pA1,t,(t+3<NT),(t+1<NT),(t+1<NT),(t<4));       ENDW(t);   RESC(); ROT();
      STEP(pA0,pA1,pB0,pB1,t+1,(t+4<NT),(t+2<NT),(t+2<NT),(t+1<4));     ENDW(t+1); RESC(); ROT();
    }
    STEP(pB0,pB1,pA0,pA1,NT-1,false,false,false,(NT==4)); RESC();
  }
  { float sacc=pB0[0]+pB0[1]; _Pragma("unroll") for(int r=2;r<16;++r)sacc+=pB0[r]; _Pragma("unroll") for(int r=0;r<16;++r)sacc+=pB1[r]; l_reg+=sacc;
    pw0=(u32x4){PKW(pB0,0),PKW(pB0,2),PKW(pB0,4),PKW(pB0,6)};pw1=(u32x4){PKW(pB0,8),PKW(pB0,10),PKW(pB0,12),PKW(pB0,14)};pw2=(u32x4){PKW(pB1,0),PKW(pB1,2),PKW(pB1,4),PKW(pB1,6)};pw3=(u32x4){PKW(pB1,8),PKW(pB1,10),PKW(pB1,12),PKW(pB1,14)};
    SBAR(); pv(o,vb0+sl_cur,PAF(0),PAF(1),PAF(2),PAF(3)); }
  #undef PKW
  #undef PAF
  #undef VFR
  #undef PIN
  #undef MX3
  #undef GAPA
  #undef GAPB
  #undef EX
  #undef VRD
  #undef KRD
  #undef STEP
  #undef ENDW
  {auto rr=__builtin_amdgcn_permlane32_swap(__float_as_uint(l_reg),__float_as_uint(l_reg),false,false);l_reg=__uint_as_float(rr[0])+__uint_as_float(rr[1]);}
  if(hi==0)wsf[32+r32]=l_reg;asm volatile("s_waitcnt lgkmcnt(0)":::"memory");
  float rli[16];
  #pragma unroll
  for(int r=0;r<16;++r)rli[r]=__builtin_amdgcn_rcpf(wsf[32+crow(r,hi)]);
  bf16*Ow=O+(rowbase+q0+wid*QBLK)*PO+h*D;
  { bf16*stg=(bf16*)(shm+LDS_OST)+wid*2048;
    #pragma unroll
    for(int r=0;r<16;++r){const int orow=crow(r,hi);
      #pragma unroll
      for(int d0=0;d0<2;++d0)stg[orow*64+d0*32+r32]=__float2bfloat16(o[d0][r]*rli[r]);}
    asm volatile("s_waitcnt lgkmcnt(0)":::"memory");
    #pragma unroll
    for(int i=0;i<4;++i){const int row=i*8+(lane>>3),ch=lane&7; const u32x4 v=*(const u32x4*)(stg+row*64+ch*8); ATTN_STORE16(Ow+(long)row*PO+ch*8,v);} }
  asm volatile("s_waitcnt lgkmcnt(0)\n\ts_barrier":::"memory");
  #undef DMA_K
  #undef TROW
  #undef SUBREF
  #undef DMA_V
  #undef CMASK
  #undef START
  #undef RESC
  #undef ROT
}
constexpr int ATTN_LDS_BYTES=LDS_BYTES;
#undef SBAR
#undef WAIT_BAR
}
constexpr int DM = 1024, NB = 16, SEQ = 2048, NT = NB * SEQ;
constexpr int RWW = 512, WIN_N = 5376, INC = 4352, ZV = 1792, ZG = 2304;
constexpr int NEXP = 32, DEXP = 512;
constexpr int XS_ROWS = 2 * NT + NEXP * 256;
constexpr float C2 = 0.125f * 1.4426950408889634f;

#define LAS __attribute__((address_space(3)))
#define GAS __attribute__((address_space(1)))
typedef unsigned short bf16;
typedef unsigned v4u __attribute__((ext_vector_type(4)));
typedef unsigned v2u __attribute__((ext_vector_type(2)));
typedef float f32x4 __attribute__((ext_vector_type(4)));

typedef float f32x2_c __attribute__((ext_vector_type(2))); typedef __bf16 bf16x2_c __attribute__((ext_vector_type(2)));
__device__ __forceinline__ unsigned pk2(float lo, float hi) { const f32x2_c v = {lo, hi}; return __builtin_bit_cast(unsigned, __builtin_convertvector(v, bf16x2_c)); }
__device__ __forceinline__ unsigned f2bf(float f) { return pk2(f, f) & 0xffffu; }
__device__ __forceinline__ float bflo(unsigned w) { return __builtin_bit_cast(float, w << 16); }
__device__ __forceinline__ float bfhi(unsigned w) { return __builtin_bit_cast(float, w & 0xffff0000u); }
__device__ __forceinline__ float sigm(float x) { return __builtin_amdgcn_rcpf(1.0f + __expf(-x)); }

constexpr size_t MiB = 1u << 20;
constexpr size_t WS_CTL = 0;
constexpr size_t WS_MOD = 1 * MiB;
constexpr size_t WS_GM2 = 1 * MiB + 512 * 1024;
constexpr size_t WS_CB = 1 * MiB + 640 * 1024;
constexpr size_t WS_COS = 2 * MiB;
constexpr size_t WS_SIN = 2 * MiB + 512 * 1024;
constexpr size_t WS_KMEAN = 3 * MiB;
constexpr size_t WS_WRH = 3 * MiB + 512 * 1024;
constexpr size_t WS_WRL = 3 * MiB + 768 * 1024;
constexpr size_t WS_SEL = 4 * MiB;
constexpr size_t WS_RTE = 5 * MiB;
constexpr size_t WS_RTW = 5 * MiB + 256 * 1024;
constexpr size_t WS_RNK = 5 * MiB + 512 * 1024;
constexpr size_t WS_POS = 5 * MiB + 768 * 1024;
constexpr size_t WS_RSTD = 7 * MiB;
constexpr size_t WS_WLT = 6 * MiB;
constexpr size_t WS_WAT = 6 * MiB + 64 * 1024;
constexpr size_t WS_WGT = 6 * MiB + 128 * 1024;
constexpr size_t WS_WIN = 16 * MiB;
constexpr size_t WS_WBA = 27 * MiB;
constexpr size_t WS_WBB = 28 * MiB;
constexpr size_t WS_WOUT = 29 * MiB;
constexpr size_t WS_Z = 32 * MiB;
constexpr size_t WS_H = 368 * MiB;
constexpr size_t WS_Q = 304 * MiB, WS_K = 336 * MiB, WS_MRG = 304 * MiB;
constexpr size_t WS_YA = 432 * MiB, WS_YB = 464 * MiB;
constexpr size_t WS_WUP = 368 * MiB;
constexpr size_t WS_H2 = 128 * MiB;
constexpr size_t WS_XS = 64 * MiB;
constexpr size_t WS_HID = 208 * MiB;
constexpr size_t WS_X1B = 432 * MiB;
constexpr size_t WS_ACT = 496 * MiB;
constexpr size_t WS_END = 512 * MiB;
constexpr int CW_CNT = 64, CNT_PAD = 64;
constexpr int CW_NT = 2304;
constexpr int CW_TEXP = 2368;
static_assert(CW_CNT + NEXP * CNT_PAD <= CW_NT, "control words");

__device__ __forceinline__ void tr_item(const float* W, int K, int N, bf16* WT, int kb, int nb, int dst_row0, LAS float* scr, int lane) {
    const int k0 = 64 * kb, n0 = 32 * nb;
#pragma unroll
    for (int i = 0; i < 32; ++i) { const int kk = 2 * i + (lane >> 5); scr[kk * 33 + (lane & 31)] = __builtin_nontemporal_load(W + (size_t)(k0 + kk) * N + n0 + (lane & 31)); }
    asm volatile("s_waitcnt lgkmcnt(0)" ::: "memory");
    const int c = lane & 7;
#pragma unroll
    for (int j = 0; j < 4; ++j) { const int n = (lane >> 3) + 8 * j; const LAS float* s = scr + (8 * c) * 33 + n;
        v4u o; o.x = pk2(s[0 * 33], s[1 * 33]); o.y = pk2(s[2 * 33], s[3 * 33]); o.z = pk2(s[4 * 33], s[5 * 33]); o.w = pk2(s[6 * 33], s[7 * 33]);
        *(v4u*)(WT + (size_t)(dst_row0 + n) * K + k0 + 8 * c) = o; }
    asm volatile("s_waitcnt lgkmcnt(0)" ::: "memory");
}

struct PArgs { const float* in[30]; float* out; unsigned char* ws; };

__device__ __forceinline__ void p_prep_weights(const PArgs& a, unsigned char* lds, int wv) {
    const int tid = mktid(wv), lane = tid & 63, wave = tid >> 6;
    LAS float* scr = (LAS float*)lds + wave * (64 * 33);
    const int gw = blockIdx.x * 8 + wave, NGW = gridDim.x * 8;
    unsigned char* ws = a.ws;
    constexpr int I_IN = 16 * 168, I_BR = 8 * 32, I_OUT = 16 * 32;
    for (int it = gw; it < I_IN + 2 * I_BR + I_OUT; it += NGW) {
        int r = it;
        if (r < I_IN) { const int kb = r / 168, nb = r % 168; int dst = 32 * nb;
            if (dst >= 1792 && dst < 2816) { const int rel = dst - 1792, u = rel >> 8, hl = (rel & 255) >> 6, half = (rel & 63) >> 5; dst = 1792 + u * 256 + half * 128 + hl * 32; }
            tr_item(a.in[6], 1024, WIN_N, (bf16*)(ws + WS_WIN), kb, nb, dst, scr, lane); continue; } r -= I_IN;
        if (r < I_BR) { const int kb = r / 32, nb = r % 32; tr_item(a.in[20], 512, 1024, (bf16*)(ws + WS_WBA), kb, nb, 32 * nb, scr, lane); continue; } r -= I_BR;
        if (r < I_BR) { const int kb = r / 32, nb = r % 32; tr_item(a.in[21], 512, 1024, (bf16*)(ws + WS_WBB), kb, nb, 32 * nb, scr, lane); continue; } r -= I_BR;
        { const int kb = r / 32, nb = r % 32; tr_item(a.in[22], 1024, 1024, (bf16*)(ws + WS_WOUT), kb, nb, 32 * nb, scr, lane); }
    }
    const int gt = blockIdx.x * 512 + tid, NGT = gridDim.x * 512;
    float* cosT = (float*)(ws + WS_COS); float* sinT = (float*)(ws + WS_SIN);
    for (int i = gt; i < SEQ * 32; i += NGT) { const int s = i >> 5, f = i & 31; const float inv = powf(10000.0f, -(float)f / 32.0f); const float ang = (float)s * inv; cosT[i] = cosf(ang); sinT[i] = sinf(ang); }
    { bf16* wlt = (bf16*)(ws + WS_WLT); bf16* wat = (bf16*)(ws + WS_WAT); bf16* wgt = (bf16*)(ws + WS_WGT);
      for (int i = gt; i < 8 * 64 * 64; i += NGT) { const int hh = i >> 12, j = (i >> 6) & 63, m = i & 63; wlt[i] = (bf16)f2bf(a.in[9][m * 512 + hh * 64 + j]); wat[i] = (bf16)f2bf(a.in[11][m * 512 + hh * 64 + j]); }
      for (int i = gt; i < 8 * 64 * 128; i += NGT) { const int hh = i >> 13, j = (i >> 7) & 63, m = i & 127; wgt[i] = (bf16)f2bf(a.in[12][m * 512 + hh * 64 + j]); } }
    { bf16* wrh = (bf16*)(ws + WS_WRH); bf16* wrl = (bf16*)(ws + WS_WRL);
      for (int i = gt; i < 48 * 1024; i += NGT) { const int e = i >> 10, k = i & 1023; const float w = e < 4 ? a.in[23][k * 4 + e] : e < 36 ? a.in[25][k * 32 + (e - 4)] : 0.f;
          const unsigned hi = f2bf(w); wrh[i] = (bf16)hi; wrl[i] = (bf16)f2bf(w - bflo(hi)); } }
}

constexpr int CW_ZCNT = 3136, CW_AQ = 3200;
constexpr int CW_BAR = 4096, XB_TMO_W = 128, DOWN_MSK_OFF = 160 * 1024 - 256 + 64;
constexpr int CW_TCNT = 8192, TCNT_STRIDE = 16;
constexpr int CW_PEXP = 2816;
__device__ __forceinline__ void p_prep_experts_dyn(const PArgs& a, unsigned char* lds, int wv) {
    const int tid = mktid(wv), lane = tid & 63, wave = tid >> 6;
    LAS float* scr = (LAS float*)lds + wave * (64 * 33);
    unsigned* ctr = (unsigned*)(a.ws + WS_CTL) + CW_PEXP;
    constexpr int NITEM = NEXP * 768;
    for (;;) {
        unsigned base = 0; if (lane == 0) base = atomicAdd(ctr, 16u);
        base = (unsigned)__builtin_amdgcn_readfirstlane((int)base);
        if (base >= (unsigned)NITEM) break;
        for (int it = (int)base; it < (int)base + 16 && it < NITEM; ++it) {
            const int e = it / 768; int r = it % 768;
            bf16* wup = (bf16*)(a.ws + WS_WUP) + (size_t)e * 1024 * 1024;
            if (r < 256) { const int kb = r / 16, nb = r % 16, n0 = 32 * nb; tr_item(a.in[27] + (size_t)e * 1024 * 512, 1024, 512, wup, kb, nb, (n0 >> 7) * 256 + (n0 & 127), scr, lane); continue; } r -= 256;
            if (r < 256) { const int kb = r / 16, nb = r % 16, n0 = 32 * nb; tr_item(a.in[28] + (size_t)e * 1024 * 512, 1024, 512, wup, kb, nb, (n0 >> 7) * 256 + 128 + (n0 & 127), scr, lane); continue; } r -= 256;
            { const int kb = r / 32, nb = r % 32; tr_item(a.in[29] + (size_t)e * 512 * 1024, 512, 1024, (bf16*)a.out + (size_t)e * 1024 * 512, kb, nb, 32 * nb, scr, lane); }
        }
    }
}

__device__ __forceinline__ void p_ada_load(const PArgs& a, int tile, int tid, float (&wr)[64]) {
    const float* w = a.in[2] + (size_t)((tid >> 5) * 64) * 6144 + tile * 32 + (tid & 31);
#pragma unroll
    for (int i = 0; i < 64; ++i) wr[i] = __builtin_nontemporal_load(w + (size_t)i * 6144);
}
__device__ __forceinline__ void p_ada_finish(const PArgs& a, const float* sc, float* red, int tile, int tid, const float (&wr)[64]) {
    const float* bias = a.in[3]; float* mod = (float*)(a.ws + WS_MOD);
    const int col = tid & 31, kg = tid >> 5;
    float acc[16];
#pragma unroll
    for (int b = 0; b < 16; ++b) acc[b] = 0.f;
#pragma unroll
    for (int i = 0; i < 64; ++i)
#pragma unroll
        for (int b = 0; b < 16; ++b) acc[b] += sc[b * 1024 + kg * 64 + i] * wr[i];
#pragma unroll
    for (int b = 0; b < 16; ++b) red[(kg * 16 + b) * 32 + col] = acc[b];
    __syncthreads();
    { const int b = tid >> 5, cc = tid & 31; float sm = 0.f;
#pragma unroll
        for (int k = 0; k < 16; ++k) sm += red[(k * 16 + b) * 32 + cc];
        mod[b * 6144 + tile * 32 + cc] = sm + bias[tile * 32 + cc]; }
    __syncthreads();
}

__device__ __forceinline__ void p_norm1(const PArgs& a, unsigned char* lds, int wv) {
    const int tid = mktid(wv), lane = tid & 63, gw = blockIdx.x * 8 + (tid >> 6), NGW = gridDim.x * 8;
    const float* x = a.in[0]; const float* g = a.in[4]; const float* mod = (const float*)(a.ws + WS_MOD);
    bf16* h = (bf16*)(a.ws + WS_H);
    f32x4 v[4][4];
    { const f32x4* xr = (const f32x4*)(x + (size_t)(4 * gw < NT ? 4 * gw : 0) * DM) + lane;
#pragma unroll
      for (int r = 0; r < 4; ++r)
#pragma unroll
          for (int j = 0; j < 4; ++j) v[r][j] = __builtin_nontemporal_load(xr + 256 * r + 64 * j); }
    for (int m0 = 4 * gw; m0 < NT; m0 += 4 * NGW) {
        const int mn = m0 + 4 * NGW < NT ? m0 + 4 * NGW : m0;
        f32x4 nv[4][4];
        { const f32x4* xr = (const f32x4*)(x + (size_t)mn * DM) + lane;
#pragma unroll
          for (int r = 0; r < 4; ++r)
#pragma unroll
              for (int j = 0; j < 4; ++j) nv[r][j] = __builtin_nontemporal_load(xr + 256 * r + 64 * j); }
        const int b = m0 >> 11; float rstd[4];
#pragma unroll
        for (int r = 0; r < 4; ++r) { float s = 0.f;
#pragma unroll
            for (int j = 0; j < 4; ++j) s += (v[r][j].x * v[r][j].x + v[r][j].y * v[r][j].y) + (v[r][j].z * v[r][j].z + v[r][j].w * v[r][j].w);
            rstd[r] = rsqrtf(wave_sum(s) * (1.0f / DM) + 1e-6f); }
#pragma unroll
        for (int j = 0; j < 4; ++j) { const int col = 4 * (lane + 64 * j);
            const f32x4 gg = *(const f32x4*)(g + col), sh = *(const f32x4*)(mod + b * 6144 + col), scl = *(const f32x4*)(mod + b * 6144 + 1024 + col);
#pragma unroll
            for (int r = 0; r < 4; ++r) { const f32x4 q = v[r][j] * rstd[r] * gg * (scl + 1.0f) + sh; v2u w; w.x = pk2(q.x, q.y); w.y = pk2(q.z, q.w); ((v2u*)(h + (size_t)(m0 + r) * DM) + lane)[64 * j] = w; } }
#pragma unroll
        for (int r = 0; r < 4; ++r)
#pragma unroll
            for (int j = 0; j < 4; ++j) v[r][j] = nv[r][j];
    }
    { float* gm2 = (float*)(a.ws + WS_GM2); float* cb = (float*)(a.ws + WS_CB); const float* g2 = a.in[5];
      for (int i = blockIdx.x * 512 + tid; i < 16 * 1024; i += gridDim.x * 512) { const int b = i >> 10, k = i & 1023; gm2[i] = g2[k] * (1.0f + mod[b * 6144 + 4096 + k]); }
      for (int p = blockIdx.x + gridDim.x * (tid >> 6); p < 16 * 48; p += NGW) {    const int b = p / 48, n = p % 48; float s = 0.f;
          if (n < 36) { for (int k = lane; k < 1024; k += 64) { const float w = n < 4 ? a.in[23][k * 4 + n] : a.in[25][k * 32 + (n - 4)]; s += mod[b * 6144 + 3072 + k] * w; } }
          s = wave_sum(s); if (lane == 0) cb[p] = n < 4 ? s + a.in[24][n] : n < 36 ? s + a.in[26][n - 4] : 0.f; } }
}

using pg8::Unit; using pg8::HALF; using pg8::BM; using pg8::cvt_pk_bf16;
typedef pg8::f32x4 pf4; typedef pg8::u32x4 pu4;

struct EpiStoreBf16 {
    static constexpr bool PERM = true, AFTER_DRAIN = false, CHAIN = false;
    bf16* O; int ldc;
    __device__ __forceinline__ void operator()(const pf4 (&acc)[2][2][4][2], const Unit& u, int wr, int wc, int fr, int fq) const {
        const int row0 = u.pm * BM + wr * 64 + fr, col0 = u.pn * BM + wc * 32 + 8 * fq;
#pragma unroll
        for (int ai = 0; ai < 2; ++ai)
#pragma unroll
            for (int m = 0; m < 4; ++m) { bf16* rowp = O + (size_t)(row0 + ai * HALF + m * 16) * ldc + col0;
#pragma unroll
                for (int bj = 0; bj < 2; ++bj) { const pf4 v0 = acc[ai][bj][m][0], v1 = acc[ai][bj][m][1]; pu4 w;
                    w.x = cvt_pk_bf16(v0[0], v0[1]); w.y = cvt_pk_bf16(v0[2], v0[3]); w.z = cvt_pk_bf16(v1[0], v1[1]); w.w = cvt_pk_bf16(v1[2], v1[3]);
                    *(pu4*)(rowp + bj * HALF) = w; } }
    }
};
struct EpiZ {
    static constexpr bool PERM = true, AFTER_DRAIN = false, CHAIN = false;
    bf16* z; bf16* Q; bf16* K; const float* qg; const float* kg; const float* cosT; const float* sinT; unsigned* zcnt;
    __device__ __forceinline__ void operator()(const pf4 (&acc)[2][2][4][2], const Unit& u, int wr, int wc, int fr, int fq) const {
        const int row0 = u.pm * BM + wr * 64 + fr;
        if (u.pn == 6) {
            const __amdgpu_buffer_rsrc_t zr = __builtin_amdgcn_make_buffer_rsrc((void*)z, 0, NT * INC * 2, 0x00020000);
            const int zc = 6 * 256 + wc * 32 + 8 * fq;
#pragma unroll
            for (int ai = 0; ai < 2; ++ai)
#pragma unroll
                for (int m = 0; m < 4; ++m) { const unsigned rowb = (unsigned)(((row0 + ai * HALF + m * 16) * INC + zc) * 2);
#pragma unroll
                    for (int bj = 0; bj < 2; ++bj) { const pf4 v0 = acc[ai][bj][m][0], v1 = acc[ai][bj][m][1]; pu4 w;
                        w.x = cvt_pk_bf16(v0[0], v0[1]); w.y = cvt_pk_bf16(v0[2], v0[3]); w.z = cvt_pk_bf16(v1[0], v1[1]); w.w = cvt_pk_bf16(v1[2], v1[3]);
                        __builtin_amdgcn_raw_buffer_store_b128(w, zr, rowb + (unsigned)(bj * HALF * 2), 0,   16); } }
            asm volatile("s_waitcnt vmcnt(0)" ::: "memory");
            if (fr == 0 && fq == 0) (void)__hip_atomic_fetch_add(zcnt, 1u, __ATOMIC_RELAXED, __HIP_MEMORY_SCOPE_AGENT);
            return;
        }
        if (u.pn < 7 || u.pn >= 11) {
            const int zc = (u.pn < 7 ? u.pn * 256 : (u.pn - 11) * 256 + 1792) + wc * 32 + 8 * fq;
#pragma unroll
            for (int ai = 0; ai < 2; ++ai)
#pragma unroll
                for (int m = 0; m < 4; ++m) { bf16* rowp = z + (size_t)(row0 + ai * HALF + m * 16) * INC + zc;
#pragma unroll
                    for (int bj = 0; bj < 2; ++bj) { const pf4 v0 = acc[ai][bj][m][0], v1 = acc[ai][bj][m][1]; pu4 w;
                        w.x = cvt_pk_bf16(v0[0], v0[1]); w.y = cvt_pk_bf16(v0[2], v0[3]); w.z = cvt_pk_bf16(v1[0], v1[1]); w.w = cvt_pk_bf16(v1[2], v1[3]);
                        __builtin_nontemporal_store(w, (pu4*)(rowp + bj * HALF)); } }
            return;
        }
        const bool isk = u.pn >= 9; const int head = 4 * ((u.pn - 7) & 1) + wc; const float* g = isk ? kg : qg; bf16* O = (isk ? K : Q) + head * 64 + 8 * fq;
        const float osc = isk ? 1.0f : C2;
        pf4 gl[2][2];
#pragma unroll
        for (int bj = 0; bj < 2; ++bj)
#pragma unroll
            for (int n = 0; n < 2; ++n) gl[bj][n] = *(const pf4*)(g + 32 * bj + 8 * fq + 4 * n);
#pragma unroll
        for (int aim = 0; aim < 4; ++aim) { const int ai = aim >> 1, m0 = 2 * (aim & 1);
            pf4 ct[2][2], st[2][2];
#pragma unroll
            for (int mm = 0; mm < 2; ++mm) { const int s = (row0 + ai * HALF + (m0 + mm) * 16) & (SEQ - 1);
#pragma unroll
                for (int n = 0; n < 2; ++n) { ct[mm][n] = *(const pf4*)(cosT + s * 32 + 8 * fq + 4 * n); st[mm][n] = *(const pf4*)(sinT + s * 32 + 8 * fq + 4 * n); } }
#pragma unroll
            for (int mm = 0; mm < 2; ++mm) { const int m = m0 + mm; const int row = row0 + ai * HALF + m * 16;
                float ss = 0.f;
#pragma unroll
                for (int bj = 0; bj < 2; ++bj)
#pragma unroll
                    for (int n = 0; n < 2; ++n) { const pf4 v = acc[ai][bj][m][n]; ss += (v[0] * v[0] + v[1] * v[1]) + (v[2] * v[2] + v[3] * v[3]); }
                ss += __builtin_bit_cast(float, __builtin_amdgcn_ds_swizzle(__builtin_bit_cast(int, ss), 0x401F));
                { const unsigned uu = __builtin_bit_cast(unsigned, ss); auto rr = __builtin_amdgcn_permlane32_swap(uu, uu, false, false); ss = __builtin_bit_cast(float, (unsigned)rr[0]) + __builtin_bit_cast(float, (unsigned)rr[1]); }
                const float rstd = rsqrtf(ss * (1.0f / 64.0f) + 1e-6f);
#pragma unroll
                for (int n = 0; n < 2; ++n) { const pf4 x1 = acc[ai][0][m][n] * rstd * gl[0][n], x2 = acc[ai][1][m][n] * rstd * gl[1][n];
                    const pf4 o1 = x1 * ct[mm][n] - x2 * st[mm][n], o2 = x2 * ct[mm][n] + x1 * st[mm][n];
                    v2u wa, wb; wa.x = cvt_pk_bf16(o1[0] * osc, o1[1] * osc); wa.y = cvt_pk_bf16(o1[2] * osc, o1[3] * osc); wb.x = cvt_pk_bf16(o2[0] * osc, o2[1] * osc); wb.y = cvt_pk_bf16(o2[2] * osc, o2[3] * osc);
                    bf16* op = O + (size_t)row * 512 + 4 * n; *(v2u*)op = wa; *(v2u*)(op + 32) = wb; } }
            asm volatile("" ::: "memory");
        }
    }
};
struct EpiMerge {
    static constexpr bool PERM = true, AFTER_DRAIN = false, CHAIN = true;
    const bf16* z; bf16* mrg;
    __device__ __forceinline__ bool chain(pf4 (&acc)[2][2][4][2], const Unit& u, int wr, int wc, int fr, int fq) const {
        const int row0 = u.pm * BM + wr * 64 + fr, col0 = u.pn * BM + wc * 32 + 8 * fq;
        if (u.aux == 0) {
#pragma unroll
            for (int ai = 0; ai < 2; ++ai) {
                pu4 za[4][2], zb[4][2];
#pragma unroll
                for (int m = 0; m < 4; ++m) { const size_t row = (size_t)(row0 + ai * HALF + m * 16);
#pragma unroll
                    for (int bj = 0; bj < 2; ++bj) { const int col = col0 + bj * HALF; za[m][bj] = *(const pu4*)(z + row * INC + ZG + col); zb[m][bj] = *(const pu4*)(z + row * INC + ZG + 1024 + col); } }
#pragma unroll
                for (int m = 0; m < 4; ++m)
#pragma unroll
                    for (int bj = 0; bj < 2; ++bj) { const pu4 a4 = za[m][bj], b4 = zb[m][bj];
                        const float a8[8] = {bflo(a4.x), bfhi(a4.x), bflo(a4.y), bfhi(a4.y), bflo(a4.z), bfhi(a4.z), bflo(a4.w), bfhi(a4.w)};
                        const float b8[8] = {bflo(b4.x), bfhi(b4.x), bflo(b4.y), bfhi(b4.y), bflo(b4.z), bfhi(b4.z), bflo(b4.w), bfhi(b4.w)};
#pragma unroll
                        for (int e = 0; e < 8; ++e) acc[ai][bj][m][e >> 2][e & 3] *= (1.0f + __expf(-b8[e])) * __builtin_amdgcn_rcpf(1.0f + __expf(-a8[e])); }
                asm volatile("" ::: "memory");
            }
            return true;
        }
        pu4 gz[2][4][2];
#pragma unroll
        for (int ai = 0; ai < 2; ++ai)
#pragma unroll
            for (int m = 0; m < 4; ++m) { const size_t row = (size_t)(row0 + ai * HALF + m * 16);
#pragma unroll
                for (int bj = 0; bj < 2; ++bj) gz[ai][m][bj] = *(const pu4*)(z + row * INC + ZG + 1024 + col0 + bj * HALF); }
#pragma unroll
        for (int ai = 0; ai < 2; ++ai)
#pragma unroll
            for (int m = 0; m < 4; ++m) { const size_t row = (size_t)(row0 + ai * HALF + m * 16);
#pragma unroll
                for (int bj = 0; bj < 2; ++bj) { const int col = col0 + bj * HALF; const pu4 g4 = gz[ai][m][bj]; const pf4 v0 = acc[ai][bj][m][0], v1 = acc[ai][bj][m][1];
                    pu4 w;
                    w.x = cvt_pk_bf16(sigm(bflo(g4.x)) * v0[0], sigm(bfhi(g4.x)) * v0[1]); w.y = cvt_pk_bf16(sigm(bflo(g4.y)) * v0[2], sigm(bfhi(g4.y)) * v0[3]);
                    w.z = cvt_pk_bf16(sigm(bflo(g4.z)) * v1[0], sigm(bfhi(g4.z)) * v1[1]); w.w = cvt_pk_bf16(sigm(bflo(g4.w)) * v1[2], sigm(bfhi(g4.w)) * v1[3]);
                    *(pu4*)(mrg + row * DM + col) = w; } }
        return false;
    }
};
struct EpiOut {
    static constexpr bool PERM = true, AFTER_DRAIN = false, CHAIN = false;
    const float* x; const float* mod; bf16* x1;
    __device__ __forceinline__ void operator()(const pf4 (&acc)[2][2][4][2], const Unit& u, int wr, int wc, int fr, int fq) const {
        const int row0 = u.pm * BM + wr * 64 + fr, col0 = u.pn * BM + wc * 32 + 8 * fq; const int b = u.pm >> 3;
        pf4 gt[2][2];
#pragma unroll
        for (int bj = 0; bj < 2; ++bj)
#pragma unroll
            for (int n = 0; n < 2; ++n) gt[bj][n] = *(const pf4*)(mod + b * 6144 + 2048 + col0 + bj * HALF + n * 4);
#pragma unroll
        for (int ai = 0; ai < 2; ++ai) {
            pf4 xv[4][2][2];
#pragma unroll
            for (int m = 0; m < 4; ++m) { const size_t off = (size_t)(row0 + ai * HALF + m * 16) * DM + col0;
#pragma unroll
                for (int bj = 0; bj < 2; ++bj) { xv[m][bj][0] = *(const pf4*)(x + off + bj * HALF); xv[m][bj][1] = *(const pf4*)(x + off + bj * HALF + 4); } }
#pragma unroll
            for (int m = 0; m < 4; ++m) { const size_t off = (size_t)(row0 + ai * HALF + m * 16) * DM + col0;
#pragma unroll
                for (int bj = 0; bj < 2; ++bj) { const pf4 o0 = xv[m][bj][0] + gt[bj][0] * acc[ai][bj][m][0], o1 = xv[m][bj][1] + gt[bj][1] * acc[ai][bj][m][1]; pu4 w;
                    w.x = cvt_pk_bf16(o0[0], o0[1]); w.y = cvt_pk_bf16(o0[2], o0[3]); w.z = cvt_pk_bf16(o1[0], o1[1]); w.w = cvt_pk_bf16(o1[2], o1[3]);
                    *(pu4*)(x1 + off + bj * HALF) = w; } }
            asm volatile("" ::: "memory");
        }
    }
};
struct EpiUp {
    static constexpr bool PERM = true, AFTER_DRAIN = false, CHAIN = false;
    bf16* hid; unsigned* tcnt;
    __device__ __forceinline__ void operator()(const pf4 (&acc)[2][2][4][2], const Unit& u, int wr, int wc, int fr, int fq) const {
        const int row0 = u.pm * BM + wr * 64 + fr, col0 = u.pn * 128 + wc * 32 + 8 * fq;
        const __amdgpu_buffer_rsrc_t hr = __builtin_amdgcn_make_buffer_rsrc((void*)hid, 0, 96 << 20, 0x00020000);
#pragma unroll
        for (int ai = 0; ai < 2; ++ai)
#pragma unroll
            for (int m = 0; m < 4; ++m) { const int row = row0 + ai * HALF + m * 16; float o[8];
#pragma unroll
                for (int n = 0; n < 2; ++n)
#pragma unroll
                    for (int e = 0; e < 4; ++e) { const float g = acc[ai][0][m][n][e], l = acc[ai][1][m][n][e]; o[4 * n + e] = g * sigm(g) * l; }
                pu4 w; w.x = cvt_pk_bf16(o[0], o[1]); w.y = cvt_pk_bf16(o[2], o[3]); w.z = cvt_pk_bf16(o[4], o[5]); w.w = cvt_pk_bf16(o[6], o[7]);
                __builtin_amdgcn_raw_buffer_store_b128(w, hr, (unsigned)((row * DEXP + col0) * 2), 0,   16); }
        asm volatile("s_waitcnt vmcnt(0)" ::: "memory");
        if (fr == 0 && fq == 0) (void)__hip_atomic_fetch_add(tcnt + TCNT_STRIDE * u.pm, 1u, __ATOMIC_RELAXED, __HIP_MEMORY_SCOPE_AGENT);
    }
};

struct GemmArgs { unsigned char* ws; const float* x; float* out; const float* qg; const float* kg; };
template <class Epi> __device__ __forceinline__ void run_dense(const void* A, const void* Bt, int M, int N, int K, const Epi& E, unsigned char* lds, int wv) {
    pg8::Gemm g{K}; pg8::StaticOrder S; S.init(A, Bt, M, N, K, (int)gridDim.x, (int)blockIdx.x);
    pg8::gemm_phase<Epi, pg8::StaticOrder, true, true>((PG8_LAS unsigned char*)lds, g, S, E, wv);
}
__device__ __forceinline__ void p_gemm_in(const GemmArgs& a, unsigned char* lds, int wv) {
    EpiZ E{(bf16*)(a.ws + WS_Z), (bf16*)(a.ws + WS_Q), (bf16*)(a.ws + WS_K), a.qg, a.kg, (const float*)(a.ws + WS_COS), (const float*)(a.ws + WS_SIN), (unsigned*)(a.ws + WS_CTL) + CW_ZCNT};
    run_dense(a.ws + WS_H, a.ws + WS_WIN, NT, WIN_N, 1024, E, lds, wv);
}
struct PairOrder {
    int nM, nN, nwg, G, c; const char *A0, *A1, *B0, *B1; size_t tstep;
    __device__ bool next(int i, Unit& u) const {
        const long L = (long)(i >> 1) * G + c; if (L >= nwg) return false;
        int wgid = (int)L; { const int q = nwg / pg8::NXCD, r = nwg % pg8::NXCD, xcd = wgid % pg8::NXCD, off = wgid / pg8::NXCD; wgid = (xcd < r ? xcd * (q + 1) : r * (q + 1) + (xcd - r) * q) + off; }
        const int nig = pg8::WGM * nN, gid = wgid / nig, fm = gid * pg8::WGM, gsz = (nM - fm) < pg8::WGM ? (nM - fm) : pg8::WGM;
        u.pm = fm + ((wgid % nig) % gsz); u.pn = (wgid % nig) / gsz; u.aux = i & 1;
        u.a = ((i & 1) ? A1 : A0) + (size_t)u.pm * tstep; u.b = ((i & 1) ? B1 : B0) + (size_t)u.pn * tstep; return true;
    }
    __device__ __forceinline__ void a_ready(const Unit&) const {}
    __device__ __forceinline__ void done(const Unit&) const {}
};
__device__ __forceinline__ void p_gemm_merge(const GemmArgs& a, unsigned char* lds, int wv) {
    PairOrder S{NT / 256, 4, (NT / 256) * 4, (int)gridDim.x, (int)blockIdx.x, (const char*)(a.ws + WS_YA), (const char*)(a.ws + WS_YB), (const char*)(a.ws + WS_WBA), (const char*)(a.ws + WS_WBB), (size_t)256 * 512 * 2};
    EpiMerge E{(const bf16*)(a.ws + WS_Z), (bf16*)(a.ws + WS_MRG)}; pg8::Gemm g{512};
    pg8::gemm_phase<EpiMerge, PairOrder, true, true>((PG8_LAS unsigned char*)lds, g, S, E, wv);
}
__device__ __forceinline__ void p_gemm_out(const GemmArgs& a, unsigned char* lds, int wv) {
    EpiOut E{a.x, (const float*)(a.ws + WS_MOD), (bf16*)(a.ws + WS_X1B)};
    run_dense(a.ws + WS_MRG, a.ws + WS_WOUT, NT, 1024, 1024, E, lds, wv);
}
struct GroupedOrder {
    const int* texp; int nT, nN, G, c; const char* A; size_t a_tile; const char* B; size_t b_exp, b_tile;
    __device__ bool next(int i, Unit& u) const {
        const long L = (long)i * G + c; if (L >= (long)nT * nN) return false;
        const int tile = (int)(L / nN), pn = (int)(L % nN); u.aux = 0; u.pm = tile; u.pn = pn; u.a = A + (size_t)tile * a_tile; u.b = B + (size_t)texp[tile] * b_exp + (size_t)pn * b_tile; return true;
    }
    __device__ __forceinline__ void a_ready(const Unit&) const {}
    __device__ __forceinline__ void done(const Unit&) const {}
};
__device__ __forceinline__ void p_gemm_up(const GemmArgs& a, unsigned char* lds, int wv) {
    const int* ctl = (const int*)(a.ws + WS_CTL);
    GroupedOrder S{ctl + CW_TEXP, ctl[CW_NT], 4, (int)gridDim.x, (int)blockIdx.x, (const char*)(a.ws + WS_XS), (size_t)256 * 1024 * 2, (const char*)(a.ws + WS_WUP), (size_t)1024 * 1024 * 2, (size_t)256 * 1024 * 2};
    EpiUp E{(bf16*)(a.ws + WS_HID), (unsigned*)(a.ws + WS_CTL) + CW_TCNT}; pg8::Gemm g{1024};
    pg8::gemm_phase<EpiUp, GroupedOrder, true, true>((PG8_LAS unsigned char*)lds, g, S, E, wv);
}
struct CountedGroupedOrder : GroupedOrder {
    unsigned* tcnt; unsigned* tmo; volatile LAS unsigned* msk; int wv;
    __device__ __forceinline__ long unit_of(int i) const { const long U = (long)nT * nN; const int nB = (int)(U % G);
        return c < nB ? (long)(i + 2) * G - 2 * nB + c : i == 0 ? (long)(c - nB) : (long)i * G - nB + (c - nB); }
    __device__ bool next(int i, Unit& u) const {
        const long L = unit_of(i); if (L >= (long)nT * nN) return false;
        const int tile = (int)(L / nN), pn = (int)(L % nN); u.aux = i; u.pm = tile; u.pn = pn; u.a = A + (size_t)tile * a_tile; u.b = B + (size_t)texp[tile] * b_exp + (size_t)pn * b_tile; return true; }
    __device__ __forceinline__ void wait_tile(int tile) const {
        unsigned sp = 0;
        while (__hip_atomic_load(tcnt + TCNT_STRIDE * tile, __ATOMIC_RELAXED, __HIP_MEMORY_SCOPE_AGENT) < 32u) { __builtin_amdgcn_s_sleep(1);
            if ((++sp & 255u) == 0u) { if (__hip_atomic_load(tmo, __ATOMIC_RELAXED, __HIP_MEMORY_SCOPE_AGENT)) break; if (sp > (1u << 22)) { atomicAdd(tmo, 1u); break; } } }
    }
    __device__ __forceinline__ void a_ready(const Unit& u) const {
        const int i = u.aux;
        if (i > 0) { const unsigned m = msk[0]; if ((m >> i) & 1u) return; }
        if (wv == 0) {
            unsigned m = 0u;
            if (i == 0) {
#pragma unroll 1
                for (int j = 1; j < 32; ++j) { const long L = unit_of(j); if (L >= (long)nT * nN) break;
                    if (__hip_atomic_load(tcnt + TCNT_STRIDE * (int)(L / nN), __ATOMIC_RELAXED, __HIP_MEMORY_SCOPE_AGENT) >= 32u) m |= 1u << j; } }
            wait_tile(u.pm);
            __builtin_amdgcn_fence(__ATOMIC_ACQUIRE, "agent");
            asm volatile("s_waitcnt vmcnt(0)" ::: "memory");
            if (i == 0 && mktid(wv) == 0) msk[0] = m;
            asm volatile("s_waitcnt lgkmcnt(0)" ::: "memory");
        }
        asm volatile("" ::: "memory"); __builtin_amdgcn_s_barrier(); asm volatile("" ::: "memory");
    }
};
__device__ __forceinline__ void p_gemm_down(const GemmArgs& a, unsigned char* lds, int wv) {
    const int* ctl = (const int*)(a.ws + WS_CTL);
    CountedGroupedOrder S{{ctl + CW_TEXP, ctl[CW_NT], 4, (int)gridDim.x, (int)blockIdx.x, (const char*)(a.ws + WS_HID), (size_t)256 * 512 * 2, (const char*)a.out, (size_t)1024 * 512 * 2, (size_t)256 * 512 * 2},
                          (unsigned*)(a.ws + WS_CTL) + CW_TCNT, (unsigned*)(a.ws + WS_CTL) + CW_BAR + XB_TMO_W, (volatile LAS unsigned*)((LAS unsigned char*)lds + DOWN_MSK_OFF), wv};
    EpiStoreBf16 E{(bf16*)(a.ws + WS_XS), 1024}; pg8::Gemm g{512};
    pg8::gemm_phase<EpiStoreBf16, CountedGroupedOrder, true, true>((PG8_LAS unsigned char*)lds, g, S, E, wv);
}

__device__ __forceinline__ void p_attn(const PArgs& a, unsigned char* lds, int vb, int nvb, int wv) {
    const attn_body::bf16* Q = (const attn_body::bf16*)(a.ws + WS_Q); const attn_body::bf16* K = (const attn_body::bf16*)(a.ws + WS_K);
    const attn_body::bf16* V = (const attn_body::bf16*)(a.ws + WS_Z) + ZV; attn_body::bf16* O = (attn_body::bf16*)(a.ws + WS_YB);
    for (int p = vb; p < 512; p += nvb)
        for (int which = 0; which < 2; ++which) { const int bh = p >> 2, s = p & 3, qb = which ? 7 - s : s;
            attn_body::attn_unit<8>(bh >> 3, bh & 7, qb, Q, K, V, O, (char*)lds, wv); }
}

__device__ __forceinline__ void p_actprep(const PArgs& a, unsigned char* lds, int wv) {
    const int tid = mktid(wv); const bf16* z = (const bf16*)(a.ws + WS_Z); bf16* act = (bf16*)(a.ws + WS_ACT); const float* mu = a.in[7];
    for (int i = blockIdx.x * 512 + tid; i < NT * 32; i += gridDim.x * 512) { const int t = i >> 5, cg = i & 31, col = 1536 + 8 * cg; const bool hasp = (t & (SEQ - 1)) > 0;
        const v4u cw = *(const v4u*)(z + (size_t)t * INC + col); v4u pw = {0u, 0u, 0u, 0u}; if (hasp) pw = *(const v4u*)(z + (size_t)(t - 1) * INC + col);
        const float c8[8] = {bflo(cw.x), bfhi(cw.x), bflo(cw.y), bfhi(cw.y), bflo(cw.z), bfhi(cw.z), bflo(cw.w), bfhi(cw.w)}, p8[8] = {bflo(pw.x), bfhi(pw.x), bflo(pw.y), bfhi(pw.y), bflo(pw.z), bfhi(pw.z), bflo(pw.w), bfhi(pw.w)};
        const f32x4 m0 = *(const f32x4*)(mu + col), m1 = *(const f32x4*)(mu + col + 4); const float m8[8] = {m0.x, m0.y, m0.z, m0.w, m1.x, m1.y, m1.z, m1.w}; float v[8];
#pragma unroll
        for (int e = 0; e < 8; ++e) { const float x = c8[e] + (p8[e] - c8[e]) * m8[e]; v[e] = cg < 8 ? 1.0f - 2.0f * __builtin_amdgcn_rcpf(1.0f + __expf(2.0f * x)) : cg < 16 ? x : sigm(x); }
        v4u w; w.x = pk2(v[0], v[1]); w.y = pk2(v[2], v[3]); w.z = pk2(v[4], v[5]); w.w = pk2(v[6], v[7]);
        *(v4u*)(act + (size_t)t * 256 + 8 * cg) = w; }
}

namespace rw {
typedef short bf16x8 __attribute__((ext_vector_type(8)));
constexpr int MB = 8192;
__device__ __forceinline__ int SW(int r, int c) { return r * 128 + ((((c >> 3) ^ (r >> 1)) & 7) << 4) + (c & 7) * 2; }
__device__ __forceinline__ int SWG(int r, int c) { return r * 256 + ((((c >> 3) ^ r) & 15) << 4) + (c & 7) * 2; }
__device__ __forceinline__ int SWF(int r, int c) { return r * 256 + ((((c >> 2) ^ r) & 15) << 4) + (c & 3) * 4; }
enum { I_AT = 0, I_BT, I_AJ, I_BHJ, I_KHJ, I_ABRT, I_X5, I_L, I_LT, I_R0, I_R1, I_KT, I_RT, I_VJ, I_X14, I_GATE, I_VT, I_VT2, NBUF };
constexpr int OFF_F32 = NBUF * MB;
constexpr int OFF_CST = OFF_F32 + (64 * 3 + 512) * 4;
constexpr int LDS_NEED = OFF_CST + 14 * 64 * 4;

__device__ __forceinline__ bf16x8 ldfrag(const unsigned char* M, int row, int k) { return *(const bf16x8*)(M + SW(row, k)); }
__device__ __forceinline__ void mm(f32x4 (&acc)[2], const unsigned char* X, const unsigned char* Y, int mt, int nh, int fr, int fq) {
    const bf16x8 a0 = ldfrag(X, 16 * mt + fr, 8 * fq), a1 = ldfrag(X, 16 * mt + fr, 8 * fq + 32);
#pragma unroll
    for (int nt = 0; nt < 2; ++nt) { const bf16x8 b0 = ldfrag(Y, 16 * (2 * nh + nt) + fr, 8 * fq), b1 = ldfrag(Y, 16 * (2 * nh + nt) + fr, 8 * fq + 32);
        acc[nt] = __builtin_amdgcn_mfma_f32_16x16x32_bf16(a0, b0, acc[nt], 0, 0, 0); acc[nt] = __builtin_amdgcn_mfma_f32_16x16x32_bf16(a1, b1, acc[nt], 0, 0, 0); }
}
typedef short s16x4 __attribute__((ext_vector_type(4)));
typedef __attribute__((address_space(3))) s16x4* lds_s16x4p;
__device__ __forceinline__ bf16x8 ldfragT(const unsigned char* M, int row0, int kb, int fr, int fq) {
    const int k0 = kb + 8 * fq + (fr >> 2), c0 = row0 + 4 * (fr & 3);
    const s16x4 lo = __builtin_amdgcn_ds_read_tr16_b64_v4i16((lds_s16x4p)(M + SW(k0, c0))), hi = __builtin_amdgcn_ds_read_tr16_b64_v4i16((lds_s16x4p)(M + SW(k0 + 4, c0)));
    return (bf16x8){lo[0], lo[1], lo[2], lo[3], hi[0], hi[1], hi[2], hi[3]};
}
struct FA { bf16x8 k0, k1; };
struct FB { bf16x8 k0[2], k1[2]; };
__device__ __forceinline__ FA ldA(const unsigned char* X, int mt, int fr, int fq) { FA f; f.k0 = ldfrag(X, 16 * mt + fr, 8 * fq); f.k1 = ldfrag(X, 16 * mt + fr, 8 * fq + 32); return f; }
__device__ __forceinline__ FB ldB(const unsigned char* Y, int nh, int fr, int fq) { FB f;
#pragma unroll
    for (int nt = 0; nt < 2; ++nt) { f.k0[nt] = ldfrag(Y, 16 * (2 * nh + nt) + fr, 8 * fq); f.k1[nt] = ldfrag(Y, 16 * (2 * nh + nt) + fr, 8 * fq + 32); }
    return f; }
__device__ __forceinline__ FA ldAT(const unsigned char* XT, int mt, int fr, int fq) { FA f; f.k0 = ldfragT(XT, 16 * mt, 0, fr, fq); f.k1 = ldfragT(XT, 16 * mt, 32, fr, fq); return f; }
__device__ __forceinline__ FB ldBT(const unsigned char* YT, int nh, int fr, int fq) { FB f;
#pragma unroll
    for (int nt = 0; nt < 2; ++nt) { f.k0[nt] = ldfragT(YT, 16 * (2 * nh + nt), 0, fr, fq); f.k1[nt] = ldfragT(YT, 16 * (2 * nh + nt), 32, fr, fq); }
    return f; }
__device__ __forceinline__ void mma(f32x4 (&acc)[2], const FA& a, const FB& b) {
    acc[0] = __builtin_amdgcn_mfma_f32_16x16x32_bf16(a.k0, b.k0[0], acc[0], 0, 0, 0); acc[1] = __builtin_amdgcn_mfma_f32_16x16x32_bf16(a.k0, b.k0[1], acc[1], 0, 0, 0);
    acc[0] = __builtin_amdgcn_mfma_f32_16x16x32_bf16(a.k1, b.k1[0], acc[0], 0, 0, 0); acc[1] = __builtin_amdgcn_mfma_f32_16x16x32_bf16(a.k1, b.k1[1], acc[1], 0, 0, 0);
}
__device__ __forceinline__ void ldC(f32x4 (&acc)[2], const unsigned char* Z, int mt, int nh, int fr, int fq) {
#pragma unroll
    for (int nt = 0; nt < 2; ++nt) { const v2u w = *(const v2u*)(Z + SW(16 * (2 * nh + nt) + fr, 16 * mt + 4 * fq)); acc[nt] = (f32x4){bflo(w.x), bfhi(w.x), bflo(w.y), bfhi(w.y)}; }
}
__device__ __forceinline__ void storeT(unsigned char* Z, const f32x4 (&acc)[2], int mt, int nh, int fr, int fq) {
#pragma unroll
    for (int nt = 0; nt < 2; ++nt) { v2u w; w.x = pk2(acc[nt][0], acc[nt][1]); w.y = pk2(acc[nt][2], acc[nt][3]); *(v2u*)(Z + SW(16 * (2 * nh + nt) + fr, 16 * mt + 4 * fq)) = w; }
}
__device__ __forceinline__ void storeN(unsigned char* Z, const f32x4 (&acc)[2], int mt, int nh, int fr, int fq) {
#pragma unroll
    for (int nt = 0; nt < 2; ++nt)
#pragma unroll
        for (int r = 0; r < 4; ++r) *(unsigned short*)(Z + SW(16 * mt + 4 * fq + r, 16 * (2 * nh + nt) + fr)) = (unsigned short)f2bf(acc[nt][r]);
}
__device__ __forceinline__ void ld8bf(const unsigned char* p, float (&v)[8]) { const v4u w = *(const v4u*)p; v[0] = bflo(w.x); v[1] = bfhi(w.x); v[2] = bflo(w.y); v[3] = bfhi(w.y); v[4] = bflo(w.z); v[5] = bfhi(w.z); v[6] = bflo(w.w); v[7] = bfhi(w.w); }
__device__ __forceinline__ void st8bf(unsigned char* p, const float (&v)[8]) { v4u w; w.x = pk2(v[0], v[1]); w.y = pk2(v[2], v[3]); w.z = pk2(v[4], v[5]); w.w = pk2(v[6], v[7]); *(v4u*)p = w; }
__device__ __forceinline__ void ld8f(const float* p, float (&v)[8]) { const f32x4 a = *(const f32x4*)p, b = *(const f32x4*)(p + 4); v[0] = a.x; v[1] = a.y; v[2] = a.z; v[3] = a.w; v[4] = b.x; v[5] = b.y; v[6] = b.z; v[7] = b.w; }
__device__ __forceinline__ void ld8fs(const unsigned char* M, int r, int c, float (&v)[8]) { const f32x4 a = *(const f32x4*)(M + SWF(r, c)), b = *(const f32x4*)(M + SWF(r, c + 4)); v[0] = a.x; v[1] = a.y; v[2] = a.z; v[3] = a.w; v[4] = b.x; v[5] = b.y; v[6] = b.z; v[7] = b.w; }
__device__ __forceinline__ void un8(const v4u w, float (&v)[8]) { v[0] = bflo(w.x); v[1] = bfhi(w.x); v[2] = bflo(w.y); v[3] = bfhi(w.y); v[4] = bflo(w.z); v[5] = bfhi(w.z); v[6] = bflo(w.w); v[7] = bfhi(w.w); }
__device__ __forceinline__ void shift8(const v4u cw, const v4u pw, bool hasp, const float* mu, float (&v)[8]) {
    float c[8], p[8], m[8]; un8(cw, c); un8(pw, p); ld8f(mu, m);
#pragma unroll
    for (int e = 0; e < 8; ++e) { const float pe = hasp ? p[e] : 0.f; v[e] = c[e] + (pe - c[e]) * m[e]; }
}
__device__ __forceinline__ float tanh_fast(float x) { return 1.0f - 2.0f * __builtin_amdgcn_rcpf(1.0f + __expf(2.0f * x)); }

#define LBAR() do { asm volatile("s_waitcnt lgkmcnt(0)" ::: "memory"); __builtin_amdgcn_s_barrier(); asm volatile("" ::: "memory"); } while (0)
__device__ __forceinline__ void scan_unit(const PArgs& a, unsigned char* lds, int bh, int wv) {
    const int tid = mktid(wv), lane = tid & 63, wid = __builtin_amdgcn_readfirstlane(tid >> 6);
    const int mt = wid >> 1, nh = wid & 1; int fr = lane & 15, fq = lane >> 4;
    const int b = bh >> 3, h = bh & 7;
#define BUF(i) (lds + (i) * MB)
    float* GC = (float*)(lds + OFF_F32); float* BON = GC + 64; float* SSQ = BON + 64; float* SEGT = SSQ + 64;
    unsigned char* LWR = BUF(I_AT); unsigned char* LAR = BUF(I_AJ); unsigned char* LGR = BUF(I_KHJ); unsigned char* YTF = BUF(I_KHJ);
    unsigned char* ACTW = BUF(I_L); unsigned char* ACTA = BUF(I_LT); unsigned char* ACTG = BUF(I_R0);
    const bf16* z = (const bf16*)(a.ws + WS_Z); bf16* ya = (bf16*)(a.ws + WS_YA);
    const float* mu = a.in[7];
    bf16x8 fw[2], fa[2], fg[4];
    { const bf16* wlt = (const bf16*)(a.ws + WS_WLT) + (size_t)h * 4096 + (16 * mt + fr) * 64 + 8 * fq; const bf16* wat = (const bf16*)(a.ws + WS_WAT) + (size_t)h * 4096 + (16 * mt + fr) * 64 + 8 * fq;
      const bf16* wgt = (const bf16*)(a.ws + WS_WGT) + (size_t)h * 8192 + (16 * mt + fr) * 128 + 8 * fq;
      fw[0] = *(const bf16x8*)wlt; fw[1] = *(const bf16x8*)(wlt + 32); fa[0] = *(const bf16x8*)wat; fa[1] = *(const bf16x8*)(wat + 32);
#pragma unroll
      for (int ks = 0; ks < 4; ++ks) fg[ks] = *(const bf16x8*)(wgt + 32 * ks); }
    float* CST = (float*)(lds + OFF_CST);
    for (int i = tid; i < 14 * 64; i += 512) { const int blk = i >> 6, jj = i & 63; float v;
        if (blk < 3) v = mu[blk * 512 + h * 64 + jj]; else if (blk < 7) v = mu[1536 + (blk - 3) * 64 + jj]; else v = a.in[blk == 7 ? 8 : blk == 8 ? 10 : blk == 9 ? 13 : blk == 10 ? 14 : blk == 11 ? 15 : blk == 12 ? 16 : 17][h * 64 + jj];
        CST[i] = v; }
    int s0i = I_X14, aki = I_X5;
    for (int i = tid; i < MB / 4; i += 512) ((unsigned*)BUF(I_X14))[i] = 0u;
    LBAR();
    int pt = tid >> 3, j0 = 8 * (tid & 7);
    const int colh = h * 64 + j0;
    const int zoff0 = colh, zoff1 = 512 + colh, zoff2 = 1024 + colh;
    const bf16* actb = (const bf16*)(a.ws + WS_ACT);
    v4u zc[3], zq[3], za[4];
#define ZLOAD(cc) do { const size_t tr_ = (size_t)b * SEQ + (cc) * 64 + pt; const bf16* zr_ = z + tr_ * INC; const bf16* zs_ = ((cc) * 64 + pt) > 0 ? zr_ - INC : zr_; const bf16* ar_ = actb + tr_ * 256 + j0; \
        zc[0] = *(const v4u*)(zr_ + zoff0); zc[1] = *(const v4u*)(zr_ + zoff1); zc[2] = *(const v4u*)(zr_ + zoff2); \
        zq[0] = *(const v4u*)(zs_ + zoff0); zq[1] = *(const v4u*)(zs_ + zoff1); zq[2] = *(const v4u*)(zs_ + zoff2); \
        za[0] = *(const v4u*)(ar_); za[1] = *(const v4u*)(ar_ + 64); za[2] = *(const v4u*)(ar_ + 128); za[3] = *(const v4u*)(ar_ + 192); } while (0)
#define ESTAGE(VTB, TT_) \
        { float y[8], vv[8], g8[8], lg[8], lb[8]; ld8fs(YTF, pt, j0, y); ld8bf((VTB) + SW(pt, j0), vv); ld8bf(BUF(I_GATE) + SW(pt, j0), g8); \
          ld8f(CST + 12 * 64 + j0, lg); ld8f(CST + 13 * 64 + j0, lb); \
          float sm = 0.f; \
_Pragma("unroll") \
          for (int e = 0; e < 8; ++e) sm += y[e]; \
          const float mean = red8(sm) * (1.0f / 64.0f); float sq = 0.f; \
_Pragma("unroll") \
          for (int e = 0; e < 8; ++e) { y[e] -= mean; sq += y[e] * y[e]; } \
          const float rstd = rsqrtf(red8(sq) * (1.0f / 64.0f) + 64e-5f), bon = BON[pt]; \
_Pragma("unroll") \
          for (int e = 0; e < 8; ++e) y[e] = (y[e] * rstd * lg[e] + lb[e] + bon * vv[e]) * g8[e]; \
          ypend.x = pk2(y[0], y[1]); ypend.y = pk2(y[2], y[3]); ypend.z = pk2(y[4], y[5]); ypend.w = pk2(y[6], y[7]); ypoff = (TT_) * RWW + colh; }
    ZLOAD(0);
    v4u ypend = {0u, 0u, 0u, 0u}; size_t ypoff = 0;
    for (int c = 0; c < SEQ / 64; ++c) {
        asm volatile("" : "+v"(fr), "+v"(fq), "+v"(pt), "+v"(j0));
        const int s = c * 64 + pt; const size_t t = (size_t)b * SEQ + s; const bool hasp = s > 0;
        if (c > 0) { ESTAGE(((c - 1) & 1) ? BUF(I_VT2) : BUF(I_VT), t - 64) }
        { float v[8];
          shift8(zc[0], zq[0], hasp, CST + 0 * 64 + j0, v); st8bf(BUF(I_RT) + SW(pt, j0), v);
          shift8(zc[1], zq[1], hasp, CST + 1 * 64 + j0, v); st8bf(BUF(I_KT) + SW(pt, j0), v);
          { float kkc[8], ss = 0.f; ld8f(CST + 9 * 64 + j0, kkc);
#pragma unroll
            for (int e = 0; e < 8; ++e) { const float q = v[e] * kkc[e]; ss += q * q; }
            ss = red8(ss); if (j0 == 0) SSQ[pt] = rsqrtf(fmaxf(ss, 1e-24f)); }
          shift8(zc[2], zq[2], hasp, CST + 2 * 64 + j0, v); st8bf(((c & 1) ? BUF(I_VT2) : BUF(I_VT)) + SW(pt, j0), v);
          *(v4u*)(ACTW + SW(pt, j0)) = za[0]; *(v4u*)(ACTA + SW(pt, j0)) = za[1]; *(v4u*)(ACTG + SWG(pt, j0)) = za[2]; *(v4u*)(ACTG + SWG(pt, 64 + j0)) = za[3]; }
        LBAR();
        f32x4 aw[2], aa[2], ag[2];
#pragma unroll
        for (int nt = 0; nt < 2; ++nt) { const int tr = 16 * (2 * nh + nt) + fr; const f32x4 zero = {0.f, 0.f, 0.f, 0.f};
            aw[nt] = __builtin_amdgcn_mfma_f32_16x16x32_bf16(fw[0], ldfrag(ACTW, tr, 8 * fq), zero, 0, 0, 0); aw[nt] = __builtin_amdgcn_mfma_f32_16x16x32_bf16(fw[1], ldfrag(ACTW, tr, 8 * fq + 32), aw[nt], 0, 0, 0);
            aa[nt] = __builtin_amdgcn_mfma_f32_16x16x32_bf16(fa[0], ldfrag(ACTA, tr, 8 * fq), zero, 0, 0, 0); aa[nt] = __builtin_amdgcn_mfma_f32_16x16x32_bf16(fa[1], ldfrag(ACTA, tr, 8 * fq + 32), aa[nt], 0, 0, 0);
            ag[nt] = zero;
#pragma unroll
            for (int ks = 0; ks < 4; ++ks) ag[nt] = __builtin_amdgcn_mfma_f32_16x16x32_bf16(fg[ks], *(const bf16x8*)(ACTG + SWG(tr, 8 * fq + 32 * ks)), ag[nt], 0, 0, 0); }
#pragma unroll
        for (int nt = 0; nt < 2; ++nt) { const int tr = 16 * (2 * nh + nt) + fr, jc = 16 * mt + 4 * fq;
            *(f32x4*)(LWR + SWF(tr, jc)) = aw[nt]; *(f32x4*)(LAR + SWF(tr, jc)) = aa[nt]; *(f32x4*)(LGR + SWF(tr, jc)) = ag[nt]; }
        LBAR();
        float lwv[8], an[8], bb[8], k2[8], rr[8], gg[8], vv8[8], p8[8];
        { const int j = lane, tw = wid;
          const float w0c = CST[7 * 64 + j], a0c = CST[8 * 64 + j], kkc = CST[9 * 64 + j], kac = CST[10 * 64 + j], rkc = CST[11 * 64 + j];
          const unsigned char* vtb = (c & 1) ? BUF(I_VT2) : BUF(I_VT);
          float bo[8], av[8];
#pragma unroll
          for (int u = 0; u < 8; ++u) { const int t8 = 8 * tw + u;
              const float lw = *(const float*)(LWR + SWF(t8, j)), la = *(const float*)(LAR + SWF(t8, j)); gg[u] = *(const float*)(LGR + SWF(t8, j));
              rr[u] = bflo(*(const unsigned short*)(BUF(I_RT) + SW(t8, j))); const float kx = bflo(*(const unsigned short*)(BUF(I_KT) + SW(t8, j))); vv8[u] = bflo(*(const unsigned short*)(vtb + SW(t8, j)));
              lwv[u] = -0.606531f * sigm(w0c + lw); av[u] = sigm(a0c + la);
              const float kn = kx * kkc * SSQ[t8]; an[u] = -kn; bb[u] = kn * av[u];
              k2[u] = kx * (1.0f + (av[u] - 1.0f) * kac); bo[u] = rr[u] * k2[u] * rkc; }
          wave_sum8(bo);
          if (j == 0) {
#pragma unroll
              for (int u = 0; u < 8; ++u) BON[8 * tw + u] = bo[u]; }
          p8[0] = lwv[0];
#pragma unroll
          for (int u = 1; u < 8; ++u) p8[u] = p8[u - 1] + lwv[u];
          SEGT[tw * 64 + j] = p8[7]; }
        LBAR();
        { const int j = lane, tw = wid; float sg8[8];
#pragma unroll
          for (int s2 = 0; s2 < 8; ++s2) sg8[s2] = SEGT[s2 * 64 + j];
          float base = 0.f, tot = 0.f;
#pragma unroll
          for (int s2 = 0; s2 < 8; ++s2) { tot += sg8[s2]; base += (s2 < tw) ? sg8[s2] : 0.f; }
          const float gcj = __expf(tot); if (tw == 7) GC[j] = gcj;
          float eprev = __expf(base);
          float o0[8], o1[8], o2[8], o3[8], ob[8], ok[8];
#pragma unroll
          for (int u = 0; u < 8; ++u) { const float L = p8[u] + base; const float e1 = __expf(L), ie1 = __builtin_amdgcn_rcpf(e1), ep = eprev, eh = gcj * ie1; eprev = e1;
              o0[u] = an[u] * ep; o1[u] = bb[u] * ie1; o2[u] = k2[u] * ie1; o3[u] = rr[u] * e1; ob[u] = bb[u] * eh; ok[u] = k2[u] * eh;
              *(unsigned short*)(BUF(I_GATE) + SW(8 * tw + u, j)) = (unsigned short)f2bf(gg[u]); }
          st8bf(BUF(I_AJ) + SW(j, 8 * tw), o0); st8bf(BUF(I_BT) + SW(j, 8 * tw), o1); st8bf(BUF(I_KT) + SW(j, 8 * tw), o2); st8bf(BUF(I_RT) + SW(j, 8 * tw), o3);
          st8bf(BUF(I_BHJ) + SW(j, 8 * tw), ob); st8bf(BUF(I_KHJ) + SW(j, 8 * tw), ok); st8bf(BUF(I_VJ) + SW(j, 8 * tw), vv8); }
        if (c > 0) *(v4u*)(ya + ypoff) = ypend;
        if (c + 1 < SEQ / 64) ZLOAD(c + 1);
        LBAR();
#define MASK(acc, cond) _Pragma("unroll") for (int nt = 0; nt < 2; ++nt) _Pragma("unroll") for (int r = 0; r < 4; ++r) { const int m_ = 16 * mt + 4 * fq + r, n_ = 16 * (2 * nh + nt) + fr; if (!(cond)) acc[nt][r] = 0.f; }
        { const f32x4 zero = {0.f, 0.f, 0.f, 0.f}; f32x4 aL[2] = {zero, zero}, aL2[2] = {zero, zero}, aK[2] = {zero, zero}, aR[2] = {zero, zero};
          const FA fAT = ldAT(BUF(I_AJ), mt, fr, fq), fBTa = ldAT(BUF(I_BT), mt, fr, fq); const FB fBT = ldBT(BUF(I_BT), nh, fr, fq), fKT = ldBT(BUF(I_KT), nh, fr, fq), fRT = ldBT(BUF(I_RT), nh, fr, fq), fATb = ldBT(BUF(I_AJ), nh, fr, fq);
          mma(aL, fAT, fBT);
          mma(aL2, fBTa, fATb);
          mma(aK, fAT, fKT);
          mma(aR, fBTa, fRT);
          MASK(aL, m_ > n_) MASK(aL2, n_ > m_) MASK(aK, n_ < m_) MASK(aR, m_ <= n_)
#pragma unroll
          for (int nt = 0; nt < 2; ++nt)
#pragma unroll
              for (int r = 0; r < 4; ++r) { const int m_ = 16 * mt + 4 * fq + r, n_ = 16 * (2 * nh + nt) + fr; if (m_ == n_) aL2[nt][r] = 1.0f; }
          storeT(BUF(I_L), aL, mt, nh, fr, fq); storeT(BUF(I_R0), aL2, mt, nh, fr, fq);
          storeT(BUF(aki), aK, mt, nh, fr, fq);
          storeT(BUF(I_ABRT), aR, mt, nh, fr, fq); }
        LBAR();
#pragma unroll
        for (int k = 1; k <= 6; ++k) {
            unsigned char* Pc = (k & 1) ? BUF(I_L) : BUF(I_AT); unsigned char* Pn = (k & 1) ? BUF(I_AT) : BUF(I_L);
            unsigned char* Rc = (k & 1) ? BUF(I_R1) : BUF(I_R0); unsigned char* Rn = (k & 1) ? BUF(I_R0) : BUF(I_R1);
            const f32x4 zero = {0.f, 0.f, 0.f, 0.f}; f32x4 aP[2] = {zero, zero}, aRr[2] = {zero, zero};
            FA fP, fPTa; FB fPT, fR;
            if (k <= 5) { fP = ldAT(Pc, mt, fr, fq); fPT = ldB(Pc, nh, fr, fq); }
            if (k >= 2) { fPTa = ldA(Pc, mt, fr, fq); fR = ldB(Rc, nh, fr, fq); ldC(aRr, Rc, mt, nh, fr, fq); }
            if (k <= 5) mma(aP, fP, fPT);
            if (k >= 2) mma(aRr, fPTa, fR);
            if (k <= 5) storeT(Pn, aP, mt, nh, fr, fq);
            if (k >= 2) storeT(Rn, aRr, mt, nh, fr, fq);
            LBAR();
        }
        { const f32x4 zero = {0.f, 0.f, 0.f, 0.f}; f32x4 a1[2] = {zero, zero}, a2[2] = {zero, zero};
          const FA fTT = ldA(BUF(I_R1), mt, fr, fq); const FB fAJ = ldB(BUF(I_AJ), nh, fr, fq), fAK = ldB(BUF(aki), nh, fr, fq);
          mma(a1, fTT, fAJ); mma(a2, fTT, fAK);
          storeT(BUF(I_L), a1, mt, nh, fr, fq);
          storeT(BUF(I_LT), a2, mt, nh, fr, fq); }
        LBAR();
        { const f32x4 zero = {0.f, 0.f, 0.f, 0.f}; f32x4 aMY[2], aNY[2] = {zero, zero}, aMS[2] = {zero, zero}, aNS[2];
          const FA fG1 = ldA(BUF(I_L), mt, fr, fq), fG2 = ldA(BUF(I_LT), mt, fr, fq), fKTa = ldAT(BUF(I_KT), mt, fr, fq);
          const FB fAB = ldB(BUF(I_ABRT), nh, fr, fq), fRT = ldBT(BUF(I_RT), nh, fr, fq), fBH = ldB(BUF(I_BHJ), nh, fr, fq);
#pragma unroll
          for (int nt = 0; nt < 2; ++nt)
#pragma unroll
              for (int r = 0; r < 4; ++r) aMY[nt][r] = bflo(*(const unsigned short*)(BUF(I_RT) + SW(16 * mt + 4 * fq + r, 16 * (2 * nh + nt) + fr)));
          ldC(aNS, BUF(I_KHJ), mt, nh, fr, fq);
          mma(aNY, fKTa, fRT);
          mma(aMY, fG1, fAB);
          mma(aMS, fG1, fBH);
          mma(aNS, fG2, fBH);
          MASK(aNY, m_ <= n_)
          mma(aNY, fG2, fAB);
#pragma unroll
          for (int nt = 0; nt < 2; ++nt)
#pragma unroll
              for (int r = 0; r < 4; ++r) { const int m_ = 16 * mt + 4 * fq + r, n_ = 16 * (2 * nh + nt) + fr; if (m_ == n_) aMS[nt][r] += GC[m_]; }
          storeT(BUF(I_AT), aMY, mt, nh, fr, fq); storeT(BUF(I_BT), aNY, mt, nh, fr, fq); storeT(BUF(I_AJ), aMS, mt, nh, fr, fq); storeT(BUF(I_R0), aNS, mt, nh, fr, fq); }
        LBAR();
        { const f32x4 zero = {0.f, 0.f, 0.f, 0.f}; f32x4 aY[2] = {zero, zero}, aS[2] = {zero, zero};
          const FA fS0a = ldA(BUF(s0i), mt, fr, fq), fVJa = ldA(BUF(I_VJ), mt, fr, fq), fMS = ldA(BUF(I_AJ), mt, fr, fq), fNS = ldA(BUF(I_R0), mt, fr, fq);
          const FB fMY = ldB(BUF(I_AT), nh, fr, fq), fNY = ldB(BUF(I_BT), nh, fr, fq), fS0 = ldB(BUF(s0i), nh, fr, fq), fVJ = ldB(BUF(I_VJ), nh, fr, fq);
          mma(aY, fS0a, fMY); mma(aS, fMS, fS0); mma(aY, fVJa, fNY); mma(aS, fNS, fVJ);
#pragma unroll
          for (int nt = 0; nt < 2; ++nt) *(f32x4*)(YTF + SWF(16 * (2 * nh + nt) + fr, 16 * mt + 4 * fq)) = aY[nt];
          storeT(BUF(aki), aS, mt, nh, fr, fq); }
        LBAR();
#undef MASK
        { const int tmp = s0i; s0i = aki; aki = tmp; }
    }
    { const int c = SEQ / 64; const size_t tprev = (size_t)b * SEQ + (c - 1) * 64 + pt; ESTAGE(((c - 1) & 1) ? BUF(I_VT2) : BUF(I_VT), tprev) }
    *(v4u*)(ya + ypoff) = ypend;
    LBAR();
#undef ESTAGE
#undef BUF
#undef ZLOAD
}
#undef LBAR
}

__device__ __forceinline__ void p_norm2_route(const PArgs& a, unsigned char* lds, int wv) {
    typedef short bf16x8 __attribute__((ext_vector_type(8)));
    const int tid = mktid(wv), lane = tid & 63, fr = lane & 15, fq = lane >> 4;
    const bf16* x1 = (const bf16*)(a.ws + WS_X1B); const float* mod = (const float*)(a.ws + WS_MOD); const float* gm2 = (const float*)(a.ws + WS_GM2); const float* cbt = (const float*)(a.ws + WS_CB);
    int* rte = (int*)(a.ws + WS_RTE); float* rtw = (float*)(a.ws + WS_RTW); int* rnk = (int*)(a.ws + WS_RNK); unsigned* cnt = (unsigned*)(a.ws + WS_CTL) + CW_CNT;
    float* PL = (float*)lds;
    float* PS = PL + 8 * 32 * 48;
    float* RS_ = PS + 8 * 32;
    float* FL = RS_ + 32;
    unsigned* HIST = (unsigned*)(FL + 32 * 48);
    unsigned* LRK = HIST + 32;
    if (tid < 32) HIST[tid] = 0u;
    __syncthreads();
    int gcount = 0;
    bf16x8 wh[4][3], wl[4][3];
    { const bf16* wrh = (const bf16*)(a.ws + WS_WRH) + fr * 1024 + 128 * wv + 8 * fq; const bf16* wrl = (const bf16*)(a.ws + WS_WRL) + fr * 1024 + 128 * wv + 8 * fq;
#pragma unroll
      for (int ks = 0; ks < 4; ++ks)
#pragma unroll
          for (int nt = 0; nt < 3; ++nt) { wh[ks][nt] = *(const bf16x8*)(wrh + nt * 16 * 1024 + 32 * ks); wl[ks][nt] = *(const bf16x8*)(wrl + nt * 16 * 1024 + 32 * ks); } }
    for (int grp = blockIdx.x; grp < NT / 32; grp += gridDim.x) {
        const int row0 = grp * 32, b = row0 >> 11;
        f32x4 acc[3][2];
#pragma unroll
        for (int nt = 0; nt < 3; ++nt) { acc[nt][0] = (f32x4){0.f, 0.f, 0.f, 0.f}; acc[nt][1] = acc[nt][0]; }
        float ssq[2] = {0.f, 0.f};
#pragma unroll
        for (int rt = 0; rt < 2; ++rt) {
            float xs[4][8];
#pragma unroll
            for (int ks = 0; ks < 4; ++ks) rw::ld8bf((const unsigned char*)(x1 + (size_t)(row0 + 16 * rt + fr) * DM + 128 * wv + 32 * ks + 8 * fq), xs[ks]);
#pragma unroll
            for (int ks = 0; ks < 4; ++ks) { float gm[8]; rw::ld8f(gm2 + b * 1024 + 128 * wv + 32 * ks + 8 * fq, gm); unsigned hw[4], lw[4];
#pragma unroll
                for (int e = 0; e < 4; ++e) { const float x0 = xs[ks][2 * e], x1v = xs[ks][2 * e + 1]; ssq[rt] += x0 * x0 + x1v * x1v; const float g0 = x0 * gm[2 * e], g1 = x1v * gm[2 * e + 1];
                    hw[e] = pk2(g0, g1); lw[e] = pk2(g0 - bflo(hw[e]), g1 - bfhi(hw[e])); }
                const v4u hv = {hw[0], hw[1], hw[2], hw[3]}, lv = {lw[0], lw[1], lw[2], lw[3]}; const bf16x8 bh = __builtin_bit_cast(bf16x8, hv), bl = __builtin_bit_cast(bf16x8, lv);
#pragma unroll
                for (int nt = 0; nt < 3; ++nt) { acc[nt][rt] = __builtin_amdgcn_mfma_f32_16x16x32_bf16(wh[ks][nt], bh, acc[nt][rt], 0, 0, 0); acc[nt][rt] = __builtin_amdgcn_mfma_f32_16x16x32_bf16(wl[ks][nt], bh, acc[nt][rt], 0, 0, 0);
                    acc[nt][rt] = __builtin_amdgcn_mfma_f32_16x16x32_bf16(wh[ks][nt], bl, acc[nt][rt], 0, 0, 0); } } }
#pragma unroll
        for (int rt = 0; rt < 2; ++rt) {
#pragma unroll
            for (int nt = 0; nt < 3; ++nt) *(f32x4*)(PL + (wv * 32 + 16 * rt + fr) * 48 + 16 * nt + 4 * fq) = acc[nt][rt];
            float s = ssq[rt]; s += __builtin_bit_cast(float, __builtin_amdgcn_ds_swizzle(__builtin_bit_cast(int, s), 0x401F));
            { const unsigned u = __builtin_bit_cast(unsigned, s); auto rr = __builtin_amdgcn_permlane32_swap(u, u, false, false); s = __builtin_bit_cast(float, (unsigned)rr[0]) + __builtin_bit_cast(float, (unsigned)rr[1]); }
            if (fq == 0) PS[wv * 32 + 16 * rt + fr] = s; }
        __syncthreads();
        { const int r = tid >> 4, c = tid & 15; float s0 = 0.f, s1 = 0.f, s2 = 0.f, sq = 0.f;
#pragma unroll
          for (int w = 0; w < 8; ++w) { const float* p = PL + (w * 32 + r) * 48; s0 += p[c]; s1 += p[c + 16]; s2 += p[c + 32]; sq += PS[w * 32 + r]; }
          const float rstd = rsqrtf(sq * (1.0f / DM) + 1e-6f); const float* cb = cbt + b * 48;
          FL[r * 48 + c] = rstd * s0 + cb[c]; FL[r * 48 + c + 16] = rstd * s1 + cb[c + 16]; FL[r * 48 + c + 32] = rstd * s2 + cb[c + 32];
          if (c == 0) ((float*)(a.ws + WS_RSTD))[row0 + r] = rstd; }
        __syncthreads();
        if (tid < 32) { const int m = row0 + tid; const float* lg = FL + tid * 48;
            int gi = 0; float gm = lg[0];
#pragma unroll
            for (int i = 1; i < 4; ++i) if (lg[i] > gm) { gm = lg[i]; gi = i; }
            float gs = 0.f;
#pragma unroll
            for (int i = 0; i < 4; ++i) gs += __expf(lg[i] - gm);
            const float pg = 1.0f / gs;
            float el[8];
#pragma unroll
            for (int k = 0; k < 8; ++k) el[k] = lg[4 + gi * 8 + k];
            int e1 = 0; float m1 = el[0];
#pragma unroll
            for (int k = 1; k < 8; ++k) if (el[k] > m1) { m1 = el[k]; e1 = k; }
            int e2 = -1; float m2 = -INFINITY;
#pragma unroll
            for (int k = 0; k < 8; ++k) if (k != e1 && el[k] > m2) { m2 = el[k]; e2 = k; }
            const float q2 = __expf(m2 - m1); const float w1 = pg / (1.0f + q2), w2 = pg * q2 / (1.0f + q2);
            const int ea = gi * 8 + e1, eb = gi * 8 + e2; rte[2 * m] = ea; rte[2 * m + 1] = eb; rtw[2 * m] = w1; rtw[2 * m + 1] = w2;
            LRK[gcount * 64 + 2 * tid] = atomicAdd(HIST + ea, 1u) | ((unsigned)ea << 24); LRK[gcount * 64 + 2 * tid + 1] = atomicAdd(HIST + eb, 1u) | ((unsigned)eb << 24); }
        ++gcount;
        __syncthreads();
    }
    if (tid < 32) { const unsigned n = HIST[tid]; HIST[tid] = n ? atomicAdd(cnt + tid * CNT_PAD, n) : 0u; }
    __syncthreads();
    for (int i = tid; i < gcount * 64; i += 512) { const int gi_ = i >> 6, e = i & 63; const int m2 = 2 * ((blockIdx.x + gi_ * gridDim.x) * 32) + e; const unsigned lr = LRK[i]; rnk[m2] = (int)(HIST[lr >> 24] + (lr & 0xffffffu)); }
    __syncthreads();
}
__device__ __forceinline__ void p_moe_gather(const PArgs& a, unsigned char* lds, int wv) {
    int* off = (int*)lds; int* tl = off + 64;
    const int tid = mktid(wv), lane = tid & 63, gw = blockIdx.x * 8 + (tid >> 6), NGW = gridDim.x * 8;
    int* ctl = (int*)(a.ws + WS_CTL); const unsigned* cnt = (const unsigned*)ctl + CW_CNT;
    if (tid < NEXP) tl[tid] = ((int)cnt[tid * CNT_PAD] + 255) >> 8;
    __syncthreads();
    if (tid < NEXP) { int o = 0; for (int e = 0; e < tid; ++e) o += tl[e];
        off[tid] = o * 256;
        if (blockIdx.x == 0) { const int n = tl[tid]; for (int i = 0; i < n; ++i) ctl[CW_TEXP + o + i] = tid; if (tid == NEXP - 1) ctl[CW_NT] = o + n; } }
    __syncthreads();
    const int* rte = (const int*)(a.ws + WS_RTE); const int* rnk = (const int*)(a.ws + WS_RNK); int* pos = (int*)(a.ws + WS_POS);
    const bf16* x1 = (const bf16*)(a.ws + WS_X1B); bf16* xs = (bf16*)(a.ws + WS_XS); const float* rstdv = (const float*)(a.ws + WS_RSTD);
    const float* mod = (const float*)(a.ws + WS_MOD); const float* gm2 = (const float*)(a.ws + WS_GM2);
    typedef int v4i_ __attribute__((ext_vector_type(4)));
    v4u xr[4][2]; v4i_ re[2], rk[2]; f32x4 rs;
    { const int t0 = 4 * gw < NT ? 4 * gw : 0;
#pragma unroll
      for (int r = 0; r < 4; ++r)
#pragma unroll
          for (int hf = 0; hf < 2; ++hf) xr[r][hf] = *(const v4u*)(x1 + (size_t)(t0 + r) * DM + 8 * lane + 512 * hf);
      re[0] = *(const v4i_*)(rte + 2 * t0); re[1] = *(const v4i_*)(rte + 2 * t0 + 4); rk[0] = *(const v4i_*)(rnk + 2 * t0); rk[1] = *(const v4i_*)(rnk + 2 * t0 + 4); rs = *(const f32x4*)(rstdv + t0); }
    for (int t0 = 4 * gw; t0 < NT; t0 += 4 * NGW) {
        const int tn = t0 + 4 * NGW < NT ? t0 + 4 * NGW : t0;
        v4u nx[4][2]; v4i_ ne[2], nk[2]; f32x4 ns;
#pragma unroll
        for (int r = 0; r < 4; ++r)
#pragma unroll
            for (int hf = 0; hf < 2; ++hf) nx[r][hf] = *(const v4u*)(x1 + (size_t)(tn + r) * DM + 8 * lane + 512 * hf);
        ne[0] = *(const v4i_*)(rte + 2 * tn); ne[1] = *(const v4i_*)(rte + 2 * tn + 4); nk[0] = *(const v4i_*)(rnk + 2 * tn); nk[1] = *(const v4i_*)(rnk + 2 * tn + 4); ns = *(const f32x4*)(rstdv + tn);
        const int b = t0 >> 11; int p0[4], p1[4];
#pragma unroll
        for (int r = 0; r < 4; ++r) { const int i0 = 2 * r, i1 = 2 * r + 1; p0[r] = off[re[i0 >> 2][i0 & 3]] + rk[i0 >> 2][i0 & 3]; p1[r] = off[re[i1 >> 2][i1 & 3]] + rk[i1 >> 2][i1 & 3]; }
        if (lane < 4) { const int r = lane; pos[2 * (t0 + r)] = r == 0 ? p0[0] : r == 1 ? p0[1] : r == 2 ? p0[2] : p0[3]; pos[2 * (t0 + r) + 1] = r == 0 ? p1[0] : r == 1 ? p1[1] : r == 2 ? p1[2] : p1[3]; }
#pragma unroll
        for (int hf = 0; hf < 2; ++hf) { const int col = 8 * lane + 512 * hf; float gm[8], sh[8];
            rw::ld8f(gm2 + b * 1024 + col, gm); rw::ld8f(mod + b * 6144 + 3072 + col, sh);
#pragma unroll
            for (int r = 0; r < 4; ++r) { const v4u xw = xr[r][hf]; const float rstd = rs[r];
                const float xv[8] = {bflo(xw.x), bfhi(xw.x), bflo(xw.y), bfhi(xw.y), bflo(xw.z), bfhi(xw.z), bflo(xw.w), bfhi(xw.w)}; float o[8];
#pragma unroll
                for (int e = 0; e < 8; ++e) o[e] = xv[e] * gm[e] * rstd + sh[e];
                v4u w; w.x = pk2(o[0], o[1]); w.y = pk2(o[2], o[3]); w.z = pk2(o[4], o[5]); w.w = pk2(o[6], o[7]);
                *(v4u*)(xs + (size_t)p0[r] * DM + col) = w; *(v4u*)(xs + (size_t)p1[r] * DM + col) = w; } }
#pragma unroll
        for (int r = 0; r < 4; ++r)
#pragma unroll
            for (int hf = 0; hf < 2; ++hf) xr[r][hf] = nx[r][hf];
        re[0] = ne[0]; re[1] = ne[1]; rk[0] = nk[0]; rk[1] = nk[1]; rs = ns;
    }
}
__device__ __forceinline__ void p_combine(const PArgs& a, unsigned char* lds, int wv) {
    const int tid = mktid(wv), lane = tid & 63, gw = blockIdx.x * 8 + (tid >> 6), NGW = gridDim.x * 8;
    const float* mod = (const float*)(a.ws + WS_MOD); const int* pos = (const int*)(a.ws + WS_POS); const float* rtw = (const float*)(a.ws + WS_RTW);
    const bf16* ys = (const bf16*)(a.ws + WS_XS); float* out = a.out; const bf16* x1 = (const bf16*)(a.ws + WS_X1B);
    typedef int v4i_ __attribute__((ext_vector_type(4)));
    v4i_ ps[2]; f32x4 wt[2];
    { const int m0 = 4 * gw < NT ? 4 * gw : 0; ps[0] = *(const v4i_*)(pos + 2 * m0); ps[1] = *(const v4i_*)(pos + 2 * m0 + 4); wt[0] = *(const f32x4*)(rtw + 2 * m0); wt[1] = *(const f32x4*)(rtw + 2 * m0 + 4); }
    for (int m0 = 4 * gw; m0 < NT; m0 += 4 * NGW) {
        const int mn = m0 + 4 * NGW < NT ? m0 + 4 * NGW : m0; const int b = m0 >> 11;
        v4u xw[4][2], y0[4][2], y1[4][2];
#pragma unroll
        for (int r = 0; r < 4; ++r) { const int i0 = 2 * r, i1 = 2 * r + 1; const int q0 = ps[i0 >> 2][i0 & 3], q1 = ps[i1 >> 2][i1 & 3];
#pragma unroll
            for (int hf = 0; hf < 2; ++hf) { const int col = 8 * lane + 512 * hf; xw[r][hf] = __builtin_nontemporal_load((const v4u*)(x1 + (size_t)(m0 + r) * DM + col)); y0[r][hf] = __builtin_nontemporal_load((const v4u*)(ys + (size_t)q0 * DM + col)); y1[r][hf] = __builtin_nontemporal_load((const v4u*)(ys + (size_t)q1 * DM + col)); } }
        v4i_ np[2]; f32x4 nw[2];
        np[0] = *(const v4i_*)(pos + 2 * mn); np[1] = *(const v4i_*)(pos + 2 * mn + 4); nw[0] = *(const f32x4*)(rtw + 2 * mn); nw[1] = *(const f32x4*)(rtw + 2 * mn + 4);
#pragma unroll
        for (int hf = 0; hf < 2; ++hf) { const int col = 8 * lane + 512 * hf; float g2[8]; rw::ld8f(mod + b * 6144 + 5120 + col, g2);
#pragma unroll
            for (int r = 0; r < 4; ++r) { const int i0 = 2 * r, i1 = 2 * r + 1; const float w0 = wt[i0 >> 2][i0 & 3], w1 = wt[i1 >> 2][i1 & 3];
                const v4u xa = xw[r][hf], a0 = y0[r][hf], a1 = y1[r][hf];
                const float xv[8] = {bflo(xa.x), bfhi(xa.x), bflo(xa.y), bfhi(xa.y), bflo(xa.z), bfhi(xa.z), bflo(xa.w), bfhi(xa.w)};
                const float e0[8] = {bflo(a0.x), bfhi(a0.x), bflo(a0.y), bfhi(a0.y), bflo(a0.z), bfhi(a0.z), bflo(a0.w), bfhi(a0.w)};
                const float e1[8] = {bflo(a1.x), bfhi(a1.x), bflo(a1.y), bfhi(a1.y), bflo(a1.z), bfhi(a1.z), bflo(a1.w), bfhi(a1.w)};
                float o[8];
#pragma unroll
                for (int e = 0; e < 8; ++e) o[e] = xv[e] + g2[e] * (e0[e] * w0 + e1[e] * w1);
                float* op = out + (size_t)(m0 + r) * DM + col; __builtin_nontemporal_store((f32x4){o[0], o[1], o[2], o[3]}, (f32x4*)op); __builtin_nontemporal_store((f32x4){o[4], o[5], o[6], o[7]}, (f32x4*)(op + 4)); } }
        ps[0] = np[0]; ps[1] = np[1]; wt[0] = nw[0]; wt[1] = nw[1];
    }
}

#define XB_TMO      128
#define XB_XCNT(j)  (256  + 64 * (j))
#define XB_XSUB(j)  (1280 + 64 * (j))
#define XB_XGEN(j)  (2304 + 64 * (j))
#define XB_TOP      3328
#define XB_TOPGEN   3392
#define XCD_BAR_WORDS 3456
#define XB_SPIN_CAP (1u << 22)

__device__ __forceinline__ unsigned xb_ld(unsigned* p)              { return __hip_atomic_load(p, __ATOMIC_RELAXED, __HIP_MEMORY_SCOPE_AGENT); }
__device__ __forceinline__ unsigned xb_add(unsigned* p, unsigned v) { return __hip_atomic_fetch_add(p, v, __ATOMIC_RELAXED, __HIP_MEMORY_SCOPE_AGENT); }
__device__ __forceinline__ unsigned xb_xcc_id() { return (unsigned)__builtin_amdgcn_s_getreg((3 << 11) | 20) & 0xFu; }
#define XB_SPIN(cond, bar) do { unsigned _sp = 0; while (cond) { __builtin_amdgcn_s_sleep(1); \
    if ((++_sp & 255u) == 0u) { if (xb_ld(&(bar)[XB_TMO])) break; if (_sp > XB_SPIN_CAP) { atomicAdd(&(bar)[XB_TMO], 1u); break; } } } } while (0)

struct XcdBarrier {
    unsigned* bar; unsigned x;
    volatile LAS unsigned* st;
};

__device__ __forceinline__ XcdBarrier xcd_barrier_post(unsigned* bar, volatile LAS unsigned* st, int wv) {
    XcdBarrier b; b.bar = bar; b.x = xb_xcc_id(); b.st = st;
    if (mktid(wv) == 0) (void)xb_add(&bar[XB_XCNT(b.x)], 1u);
    return b;
}
__device__ __forceinline__ void xcd_barrier_complete(unsigned* bar, unsigned x, unsigned& nloc, unsigned& nx) {
    const unsigned G = gridDim.x * gridDim.y * gridDim.z;
    unsigned sum, cnt, mine, sp = 0u;
    for (;;) {
        sum = 0u; cnt = 0u; mine = 0u;
#pragma unroll
        for (unsigned j = 0; j < 16; ++j) { const unsigned c = xb_ld(&bar[XB_XCNT(j)]); sum += c; cnt += (c > 0u) ? 1u : 0u; mine = (j == x) ? c : mine; }
        if (sum == G) break;
        __builtin_amdgcn_s_sleep(1);
        if ((++sp & 255u) == 0u) { if (xb_ld(&bar[XB_TMO])) break; if (sp > XB_SPIN_CAP) { atomicAdd(&bar[XB_TMO], 1u); break; } }
    }
    nloc = mine > 0u ? mine : 1u; nx = cnt > 0u ? cnt : 1u;
}

__device__ __forceinline__ void xcd_barrier(const XcdBarrier& b, int wv) {
    asm volatile("s_waitcnt vmcnt(0)" ::: "memory");
    __syncthreads();
    if (mktid(wv) == 0) {
        unsigned* bar = b.bar;
        __builtin_amdgcn_s_waitcnt(0);
        unsigned nloc = b.st[0], nx = b.st[1];
        if (nloc == 0u) { xcd_barrier_complete(bar, b.x, nloc, nx); b.st[0] = nloc; b.st[1] = nx; }
        const unsigned old = xb_add(&bar[XB_XSUB(b.x)], 1u);
        const unsigned gen = old / nloc;
        if (old + 1u == (gen + 1u) * nloc) {
            __builtin_amdgcn_fence(__ATOMIC_RELEASE, "agent");
            asm volatile("s_waitcnt vmcnt(0)" ::: "memory");
            const unsigned og = xb_add(&bar[XB_TOP], 1u);
            const unsigned tg = og / nx;
            if (og + 1u == (tg + 1u) * nx) xb_add(&bar[XB_TOPGEN], 1u);
            else XB_SPIN(xb_ld(&bar[XB_TOPGEN]) == tg, bar);
            __builtin_amdgcn_fence(__ATOMIC_ACQUIRE, "agent");
            xb_add(&bar[XB_XGEN(b.x)], 1u);
            asm volatile("s_waitcnt vmcnt(0)" ::: "memory");
        } else {
            XB_SPIN(xb_ld(&bar[XB_XGEN(b.x)]) == gen, bar);
            __builtin_amdgcn_fence(__ATOMIC_ACQUIRE, "agent");
            asm volatile("s_waitcnt vmcnt(0)" ::: "memory");
        }
    }
    __syncthreads();
}

constexpr int LDS_BYTES = 160 * 1024, MISC_OFF = LDS_BYTES - 256;
static_assert(rw::LDS_NEED <= MISC_OFF, "scan LDS");
static_assert(XB_TMO == XB_TMO_W && MISC_OFF + 64 == DOWN_MSK_OFF, "control word layout");

__device__ __forceinline__ void p_actprep_dyn(const PArgs& a, unsigned char* lds, int wv) {
    const int tid = mktid(wv), lane = tid & 63; const bf16* z = (const bf16*)(a.ws + WS_Z); bf16* act = (bf16*)(a.ws + WS_ACT); const float* mu = a.in[7];
    unsigned* ctl = (unsigned*)(a.ws + WS_CTL);
    __syncthreads();
    if (tid == 0) { XB_SPIN(xb_ld(ctl + CW_ZCNT) < (unsigned)(NT / 256 * 8), ctl + CW_BAR); __builtin_amdgcn_fence(__ATOMIC_ACQUIRE, "agent"); asm volatile("s_waitcnt vmcnt(0)" ::: "memory"); }
    __syncthreads();
    const int cg = lane & 31, col = 1536 + 8 * cg;
    const f32x4 m0 = *(const f32x4*)(mu + col), m1 = *(const f32x4*)(mu + col + 4); const float m8[8] = {m0.x, m0.y, m0.z, m0.w, m1.x, m1.y, m1.z, m1.w};
    for (;;) {
        unsigned grab = 0; if (lane == 0) grab = atomicAdd(ctl + CW_AQ, 1u);
        grab = (unsigned)__builtin_amdgcn_readfirstlane((int)grab);
        if (grab >= (unsigned)(NT / 64)) break;
        for (int sub = 0; sub < 8; ++sub) {
        const int t0 = (int)grab * 64 + sub * 8 + (lane >> 5);
        v4u cw[4], pw[4];
#pragma unroll
        for (int u = 0; u < 4; ++u) { const int t = t0 + 2 * u; const int tp = (t & (SEQ - 1)) > 0 ? t - 1 : t; cw[u] = *(const v4u*)(z + (size_t)t * INC + col); pw[u] = *(const v4u*)(z + (size_t)tp * INC + col); }
#pragma unroll
        for (int u = 0; u < 4; ++u) { const int t = t0 + 2 * u; const bool hasp = (t & (SEQ - 1)) > 0; const v4u c4 = cw[u]; v4u p4 = pw[u]; if (!hasp) p4 = (v4u){0u, 0u, 0u, 0u};
            const float c8[8] = {bflo(c4.x), bfhi(c4.x), bflo(c4.y), bfhi(c4.y), bflo(c4.z), bfhi(c4.z), bflo(c4.w), bfhi(c4.w)}, p8[8] = {bflo(p4.x), bfhi(p4.x), bflo(p4.y), bfhi(p4.y), bflo(p4.z), bfhi(p4.z), bflo(p4.w), bfhi(p4.w)}; float v[8];
#pragma unroll
            for (int e = 0; e < 8; ++e) { const float x = c8[e] + (p8[e] - c8[e]) * m8[e]; v[e] = cg < 8 ? 1.0f - 2.0f * __builtin_amdgcn_rcpf(1.0f + __expf(2.0f * x)) : cg < 16 ? x : sigm(x); }
            v4u w; w.x = pk2(v[0], v[1]); w.y = pk2(v[2], v[3]); w.z = pk2(v[4], v[5]); w.w = pk2(v[6], v[7]);
            *(v4u*)(act + (size_t)t * 256 + 8 * cg) = w; }
        }
    }
}

__global__ void __launch_bounds__(512, 2) mega_fwd(PArgs a) {
    extern __shared__ __attribute__((aligned(16))) unsigned char lds[];
    volatile LAS unsigned* MISC = (volatile LAS unsigned*)((LAS unsigned char*)lds + MISC_OFF);
    const int wv = __builtin_amdgcn_readfirstlane((int)threadIdx.x >> 6);
    { const int t0 = mktid(wv); if (t0 < 64) MISC[t0] = 0u; }
    __syncthreads();
    XcdBarrier bar = xcd_barrier_post((unsigned*)(a.ws + WS_CTL) + CW_BAR, MISC + 8, wv);
    GemmArgs g; g.ws = a.ws; g.x = a.in[0]; g.out = a.out; g.qg = a.in[18]; g.kg = a.in[19];
    const int G = (int)gridDim.x, bx = (int)blockIdx.x;

    { const int t0 = mktid(wv); float wr[64]; float* sc = (float*)(lds + 68 * 1024); float* red = (float*)lds;
      const bool has = bx < 192;
      if (has) p_ada_load(a, bx, t0, wr);
      for (int i = t0; i < 16 * 1024; i += 512) { const float v = a.in[1][i]; sc[i] = v / (1.0f + __expf(-v)); }
      p_prep_weights(a, lds, wv);
      __syncthreads();
      if (has) p_ada_finish(a, sc, red, bx, t0, wr);
      for (int tile = bx + G; tile < 192; tile += G) { p_ada_load(a, tile, t0, wr); p_ada_finish(a, sc, red, tile, t0, wr); } }
    xcd_barrier(bar, wv);
    p_norm1(a, lds, wv);
    xcd_barrier(bar, wv);
    p_gemm_in(g, lds, wv);
    p_actprep_dyn(a, lds, wv);
    xcd_barrier(bar, wv);
    { const int nscan = G / 2;
      if (bx < nscan) { for (int bh = bx; bh < 128; bh += nscan) rw::scan_unit(a, lds, bh, wv); }
      else p_attn(a, lds, bx - nscan, G - nscan, wv); }
    __syncthreads(); p_prep_experts_dyn(a, lds, wv);
    xcd_barrier(bar, wv);
    p_gemm_merge(g, lds, wv);
    xcd_barrier(bar, wv);
    p_gemm_out(g, lds, wv);
    xcd_barrier(bar, wv);
    p_norm2_route(a, lds, wv);
    xcd_barrier(bar, wv);
    p_moe_gather(a, lds, wv);
    xcd_barrier(bar, wv);
    p_gemm_up(g, lds, wv);
    __syncthreads();
    p_gemm_down(g, lds, wv);
    xcd_barrier(bar, wv);
    p_combine(a, lds, wv);
}

extern "C" void kernel_launch(void* const* d_in, const int* in_sizes, int n_in, void* d_out, int out_size, void* d_ws, size_t ws_size, hipStream_t stream) {
    static int grid = 0;
    if (grid == 0) {
        if (n_in != 30 || out_size != NT * DM || ws_size < WS_END) { fprintf(stderr, "kernel_launch: unexpected shapes (n_in %d, out %d, ws %zu)\n", n_in, out_size, ws_size); grid = -1; return; }
        int dev = 0, cus = 0, per_cu = 0;
        if (hipGetDevice(&dev) != hipSuccess || hipDeviceGetAttribute(&cus, hipDeviceAttributeMultiprocessorCount, dev) != hipSuccess) { grid = -1; return; }
        if (hipFuncSetAttribute((const void*)mega_fwd, hipFuncAttributeMaxDynamicSharedMemorySize, LDS_BYTES) != hipSuccess) { fprintf(stderr, "kernel_launch: hipFuncSetAttribute failed\n"); grid = -1; return; }
        if (hipOccupancyMaxActiveBlocksPerMultiprocessor(&per_cu, (const void*)mega_fwd, 512, LDS_BYTES) != hipSuccess || per_cu < 1) { fprintf(stderr, "kernel_launch: occupancy query says %d blocks per CU\n", per_cu); (void)hipGetLastError(); grid = -1; return; }
        grid = cus;
    }
    if (grid < 0) return;
    (void)hipMemsetAsync((char*)d_ws + WS_CTL, 0, 65536, stream);
    PArgs p{}; for (int i = 0; i < 30; ++i) p.in[i] = (const float*)d_in[i]; p.out = (float*)d_out; p.ws = (unsigned char*)d_ws;
    hipLaunchKernelGGL(mega_fwd, dim3(grid), dim3(512), LDS_BYTES, stream, p);
}
```
